# Optimizing an MI355X kernel written in HIP

```python
import jax, jax.numpy as jnp
from jax import lax
import numpy as np

D_MODEL = 1024
BATCH = 4
SEQ = 8192
DEPTH = 2

D_CONV = D_MODEL // 4
CONV_HEADS = 4
CONV_K = 3
D_POOL = D_MODEL // 4
POOL_WINDOWS = (2, 4, 8, 16)
POOL_GROUPS = len(POOL_WINDOWS)
POOL_CH = D_POOL // POOL_GROUPS
D_ATTN = D_MODEL // 2
MLA_HEADS = 8
QK_NOPE = 64
QK_ROPE = 32
V_DIM = D_ATTN // MLA_HEADS
Q_RANK = 3 * D_MODEL // 8
KV_RANK = D_MODEL // 4
D_MIX = D_CONV + D_POOL + D_ATTN
IN_SPLITS = (D_CONV, D_CONV, D_CONV, D_POOL, Q_RANK, KV_RANK, QK_ROPE)
D_IN = sum(IN_SPLITS)
ROPE_THETA = 10000.0
Q_BLOCK = 128
NORM_EPS = 1e-6
PEER_HEADS = 8
PEER_NKEYS = 128
N_EXPERTS = PEER_NKEYS * PEER_NKEYS
PEER_TOPK = 16
PEER_DQ = 256
PEER_DHALF = PEER_DQ // 2
PEER_CHUNK = 128

kernel_name = "hybrid_conv_pool_mla_peer"


def rms_norm(x, g):
    xf = x.astype(jnp.float32)
    y = xf * lax.rsqrt(jnp.mean(xf * xf, axis=-1, keepdims=True) + NORM_EPS)
    return (y * g.astype(jnp.float32)).astype(x.dtype)


def rope_tables(seq, dim):
    pos = jnp.arange(seq, dtype=jnp.float32)
    inv = ROPE_THETA ** (-jnp.arange(0, dim, 2, dtype=jnp.float32) / dim)
    ang = pos[:, None] * inv[None, :]
    return jnp.cos(ang), jnp.sin(ang)


def apply_rope(x, cos, sin):
    xf = x.astype(jnp.float32)
    x1, x2 = jnp.split(xf, 2, axis=-1)
    out = jnp.concatenate([x1 * cos - x2 * sin, x2 * cos + x1 * sin], axis=-1)
    return out.astype(x.dtype)


def short_conv_mixer(b_gate, c_gate, h, conv_w):
    u = c_gate * h
    kern = conv_w[:, None, :].astype(u.dtype)
    conv = lax.conv_general_dilated(
        u, kern, window_strides=(1,), padding=[(CONV_K - 1, 0)],
        dimension_numbers=("NWC", "WIO", "NWC"), feature_group_count=D_CONV)
    return b_gate * conv


def pool_mixer(h, pool_w, pool_scale):
    b, s, _ = h.shape
    hf = h.astype(jnp.float32).reshape(b, s, POOL_GROUPS, POOL_CH)
    cs0 = jnp.concatenate([jnp.zeros((b, 1, POOL_GROUPS, POOL_CH), jnp.float32),
                           lax.cumsum(hf, axis=1)], axis=1)
    t = jnp.arange(s)
    outs = []
    for g, w in enumerate(POOL_WINDOWS):
        lo = jnp.maximum(t + 1 - w, 0)
        cnt = (t + 1 - lo).astype(jnp.float32)
        csg = cs0[:, :, g]
        win = csg[:, 1:] - jnp.take(csg, lo, axis=1)
        outs.append(win / cnt[None, :, None] - hf[:, :, g])
    pooled = jnp.stack(outs, axis=2)
    mixed = jnp.einsum('bsgc,gcd->bsgd', pooled, pool_w.astype(jnp.float32))
    y = mixed.reshape(b, s, D_POOL) * pool_scale.astype(jnp.float32)
    return y.astype(h.dtype)


def mla_mixer(c_q, c_kv, k_rope, q_norm, w_uq, kv_norm, w_uk, w_uv):
    b, s, _ = c_q.shape
    q = (rms_norm(c_q, q_norm) @ w_uq).reshape(b, s, MLA_HEADS, QK_NOPE + QK_ROPE)
    q_nope, q_rope = q[..., :QK_NOPE], q[..., QK_NOPE:]
    ckv = rms_norm(c_kv, kv_norm)
    k_nope = (ckv @ w_uk).reshape(b, s, MLA_HEADS, QK_NOPE)
    v = (ckv @ w_uv).reshape(b, s, MLA_HEADS, V_DIM)
    cos, sin = rope_tables(s, QK_ROPE)
    q_rope = apply_rope(q_rope, cos[None, :, None, :], sin[None, :, None, :])
    k_rope = apply_rope(k_rope, cos[None], sin[None])
    scale = (QK_NOPE + QK_ROPE) ** -0.5
    kpos = jnp.arange(s)

    def block(i):
        start = i * Q_BLOCK
        qn = lax.dynamic_slice_in_dim(q_nope, start, Q_BLOCK, axis=1)
        qr = lax.dynamic_slice_in_dim(q_rope, start, Q_BLOCK, axis=1)
        sc = (jnp.einsum('bqhd,bkhd->bhqk', qn, k_nope).astype(jnp.float32)
              + jnp.einsum('bqhd,bkd->bhqk', qr, k_rope).astype(jnp.float32)) * scale
        qpos = start + jnp.arange(Q_BLOCK)
        mask = kpos[None, :] <= qpos[:, None]
        sc = jnp.where(mask[None, None], sc, jnp.finfo(jnp.float32).min)
        p = jax.nn.softmax(sc, axis=-1).astype(v.dtype)
        return jnp.einsum('bhqk,bkhd->bqhd', p, v)

    o = lax.map(block, jnp.arange(s // Q_BLOCK))
    o = jnp.transpose(o, (1, 0, 2, 3, 4)).reshape(b, s, D_ATTN)
    return o


def token_mixer(xn, w_in, conv_w, pool_w, pool_scale, q_norm, w_uq, kv_norm, w_uk, w_uv, w_out):
    proj = xn @ w_in
    cuts = [int(c) for c in np.cumsum(IN_SPLITS)[:-1]]
    b_gate, c_gate, h_conv, h_pool, c_q, c_kv, k_rope = jnp.split(proj, cuts, axis=-1)
    y_conv = short_conv_mixer(b_gate, c_gate, h_conv, conv_w)
    y_pool = pool_mixer(h_pool, pool_w, pool_scale)
    y_attn = mla_mixer(c_q, c_kv, k_rope, q_norm, w_uq, kv_norm, w_uk, w_uv)
    y = jnp.concatenate([y_conv, y_pool, y_attn], axis=-1)
    return y @ w_out


def peer_ffn(xn, w_q, subkeys, u_tab, v_tab):
    b, s, d = xn.shape
    t = b * s
    xt = xn.reshape(t, d)
    q = (xt @ w_q).reshape(t, PEER_HEADS, 2, PEER_DHALF)
    sc = jnp.einsum('thpd,pnd->thpn', q, subkeys).astype(jnp.float32)
    s1, i1 = lax.top_k(sc[:, :, 0], PEER_TOPK)
    s2, i2 = lax.top_k(sc[:, :, 1], PEER_TOPK)
    cand = (s1[..., :, None] + s2[..., None, :]).reshape(t, PEER_HEADS, PEER_TOPK * PEER_TOPK)
    top_s, ci = lax.top_k(cand, PEER_TOPK)
    e1 = jnp.take_along_axis(i1, ci // PEER_TOPK, axis=-1)
    e2 = jnp.take_along_axis(i2, ci % PEER_TOPK, axis=-1)
    experts = e1 * PEER_NKEYS + e2
    gates = jax.nn.softmax(top_s, axis=-1).astype(xn.dtype)
    nc = t // PEER_CHUNK
    hk = PEER_HEADS * PEER_TOPK
    xr = xt.reshape(nc, PEER_CHUNK, d)
    er = experts.reshape(nc, PEER_CHUNK, hk)
    gr = gates.reshape(nc, PEER_CHUNK, hk)

    def chunk(args):
        xc, ec, gc = args
        uc = jnp.take(u_tab, ec, axis=0)
        act = jax.nn.gelu(jnp.einsum('td,tkd->tk', xc, uc), approximate=False)
        vc = jnp.take(v_tab, ec, axis=0)
        return jnp.einsum('tk,tkd->td', gc * act, vc)

    out = lax.map(chunk, (xr, er, gr))
    return out.reshape(b, s, d)


def setup_inputs(seed: int = 0) -> dict:
    key = jax.random.key(seed)
    ks = jax.random.split(key, 20)
    L, D = DEPTH, D_MODEL
    f32 = jnp.float32
    nrm = lambda k, shape, sc: jax.random.normal(k, shape, f32) * sc
    gain = lambda k, shape: 1.0 + 0.02 * jax.random.normal(k, shape, f32)
    return {
        "x": jax.random.normal(ks[0], (BATCH, SEQ, D), f32),
        "norm_mix": gain(ks[1], (L, D)),
        "w_in": nrm(ks[2], (L, D, D_IN), D ** -0.5),
        "conv_w": nrm(ks[3], (L, CONV_K, D_CONV), CONV_K ** -0.5),
        "pool_w": nrm(ks[4], (L, POOL_GROUPS, POOL_CH, POOL_CH), POOL_CH ** -0.5),
        "pool_scale": 1.0 + 0.1 * jax.random.normal(ks[5], (L, D_POOL), f32),
        "q_norm": gain(ks[6], (L, Q_RANK)),
        "w_uq": nrm(ks[7], (L, Q_RANK, MLA_HEADS * (QK_NOPE + QK_ROPE)), Q_RANK ** -0.5),
        "kv_norm": gain(ks[8], (L, KV_RANK)),
        "w_uk": nrm(ks[9], (L, KV_RANK, MLA_HEADS * QK_NOPE), KV_RANK ** -0.5),
        "w_uv": nrm(ks[10], (L, KV_RANK, MLA_HEADS * V_DIM), KV_RANK ** -0.5),
        "w_out": nrm(ks[11], (L, D_MIX, D), D_MIX ** -0.5),
        "norm_ffn": gain(ks[12], (L, D)),
        "peer_wq": nrm(ks[13], (L, D, PEER_HEADS * PEER_DQ), D ** -0.5),
        "peer_subkeys": nrm(ks[14], (L, 2, PEER_NKEYS, PEER_DHALF), PEER_DHALF ** -0.5),
        "peer_u": nrm(ks[15], (L, N_EXPERTS, D), D ** -0.5),
        "peer_v": nrm(ks[16], (L, N_EXPERTS, D), PEER_HEADS ** -0.5),
        "norm_final": gain(ks[17], (D,)),
    }


def reference(x, norm_mix, w_in, conv_w, pool_w, pool_scale, q_norm, w_uq, kv_norm,
              w_uk, w_uv, w_out, norm_ffn, peer_wq, peer_subkeys, peer_u, peer_v, norm_final):
    h = x
    for l in range(DEPTH):
        h = h + token_mixer(rms_norm(h, norm_mix[l]), w_in[l], conv_w[l], pool_w[l],
                            pool_scale[l], q_norm[l], w_uq[l], kv_norm[l], w_uk[l],
                            w_uv[l], w_out[l])
        h = h + peer_ffn(rms_norm(h, norm_ffn[l]), peer_wq[l], peer_subkeys[l],
                         peer_u[l], peer_v[l])
    return rms_norm(h, norm_final)
```

```cpp
#include <hip/hip_runtime.h>
#include <hip/hip_cooperative_groups.h>
#include <cstdio>
#include <cstdint>
namespace cg = cooperative_groups;

#ifndef ONE_LAUNCH
#define ONE_LAUNCH 0
#endif

constexpr int NB = 4, S = 8192, T = NB * S, D = 1024, DEPTH = 2;
constexpr int DIN = 1696, DINP = 1792;
constexpr int C_BG = 0, C_CG = 256, C_HC = 512, C_HP = 768, C_CQ = 1024, C_CKV = 1408, C_KR = 1664;
constexpr int QR = 384, KVR = 256, NH = 8, DQK = 96, DV = 64;
constexpr int PH = 8, NKEY = 128, NEXP = NKEY * NKEY, TOPK = 16, HK = PH * TOPK;
constexpr float EPS = 1e-6f;

typedef unsigned short bf16;

constexpr size_t MB = 1024 * 1024;
constexpr size_t WS_CTL   = 0;
constexpr size_t WS_ROPE  = 64 * 1024;
constexpr size_t WS_WIN   = WS_ROPE + (size_t)S * 16 * 2 * 4;
constexpr size_t WS_WUQ   = WS_WIN + (size_t)DEPTH * DINP * D * 2;
constexpr size_t WS_WUKV  = WS_WUQ + (size_t)DEPTH * 768 * QR * 2;
constexpr size_t WS_WOUT  = WS_WUKV + (size_t)DEPTH * 1024 * KVR * 2;
constexpr size_t WS_WPQ   = WS_WOUT + (size_t)DEPTH * D * D * 2;
constexpr size_t WS_XN    = ((WS_WPQ + (size_t)DEPTH * 2048 * D * 2 + 4095) / 4096) * 4096;
constexpr size_t WS_PROJ  = WS_XN + (size_t)T * D * 2;
constexpr size_t WS_Q     = WS_PROJ + (size_t)T * DINP * 2;
constexpr size_t WS_K     = WS_Q + (size_t)T * NH * DQK * 2;
constexpr size_t WS_V     = WS_K + (size_t)T * NH * DQK * 2;
constexpr size_t WS_EXP   = WS_V + (size_t)T * NH * DV * 2;
constexpr size_t WS_GATE  = WS_EXP + (size_t)T * HK * 4;
constexpr size_t WS_END   = WS_GATE + (size_t)T * HK * 4;
constexpr size_t WS_QP    = WS_PROJ;
static_assert((size_t)T * 2048 * 2 <= WS_K - WS_PROJ, "QP alias");

struct Params {
    const float* x; const float* norm_mix; const float* w_in; const float* conv_w; const float* pool_w; const float* pool_scale;
    const float* q_norm; const float* w_uq; const float* kv_norm; const float* w_uk; const float* w_uv; const float* w_out;
    const float* norm_ffn; const float* peer_wq; const float* peer_subkeys; const float* peer_u; const float* peer_v; const float* norm_final;
    float* out; unsigned char* ws;
};

__device__ __forceinline__ bf16 f2bf(float f) { unsigned u = __float_as_uint(f); u += 0x7fffu + ((u >> 16) & 1u); return (bf16)(u >> 16); }
__device__ __forceinline__ float bf2f(bf16 h) { return __uint_as_float(((unsigned)h) << 16); }
__device__ __forceinline__ float bflo(unsigned u) { return __uint_as_float(u << 16); }
__device__ __forceinline__ float bfhi(unsigned u) { return __uint_as_float(u & 0xffff0000u); }
__device__ __forceinline__ unsigned pack2(float a, float b) { return (unsigned)f2bf(a) | ((unsigned)f2bf(b) << 16); }
__device__ __forceinline__ float wave_sum(float v) {
#pragma unroll
    for (int m = 32; m >= 1; m >>= 1) v += __shfl_xor(v, m, 64);
    return v;
}
__device__ __forceinline__ float gelu_exact(float x) { return 0.5f * x * (1.f + erff(x * 0.70710678118654752f)); }

#define NTHREADS 256
__device__ __forceinline__ int gwave() { return blockIdx.x * (NTHREADS / 64) + (threadIdx.x >> 6); }
__device__ __forceinline__ int nwave() { return gridDim.x * (NTHREADS / 64); }
__device__ __forceinline__ size_t gtid() { return (size_t)blockIdx.x * NTHREADS + threadIdx.x; }
__device__ __forceinline__ size_t gnth() { return (size_t)gridDim.x * NTHREADS; }

template <class AL, class BL, class EP>
__device__ __forceinline__ void gemm_naive(int M, int N, int K, AL aload, BL bload, EP epi, float* sm) {
    float (*As)[68] = (float (*)[68])sm;
    float (*Bs)[68] = (float (*)[68])(sm + 16 * 68);
    const int tid = threadIdx.x, tx = tid & 15, ty = tid >> 4;
    const int tilesN = (N + 63) / 64, tilesM = M / 64;
    for (int tile = blockIdx.x; tile < tilesM * tilesN; tile += gridDim.x) {
        const int tm = tile / tilesN, tn = tile % tilesN;
        const int row0 = tm * 64, col0 = tn * 64;
        float acc[4][4];
#pragma unroll
        for (int i = 0; i < 4; ++i)
#pragma unroll
            for (int j = 0; j < 4; ++j) acc[i][j] = 0.f;
        for (int k0 = 0; k0 < K; k0 += 16) {
            {
                const int r = tid >> 2, kk = (tid & 3) * 4;
#pragma unroll
                for (int i = 0; i < 4; ++i) As[kk + i][r] = aload(row0 + r, k0 + kk + i);
            }
            {
                const int kk = tid >> 4, c = (tid & 15) * 4;
#pragma unroll
                for (int j = 0; j < 4; ++j) { const int col = col0 + c + j; Bs[kk][c + j] = (col < N) ? bload(k0 + kk, col) : 0.f; }
            }
            __syncthreads();
#pragma unroll
            for (int kk = 0; kk < 16; ++kk) {
                float a[4], b[4];
#pragma unroll
                for (int i = 0; i < 4; ++i) a[i] = As[kk][ty * 4 + i];
#pragma unroll
                for (int j = 0; j < 4; ++j) b[j] = Bs[kk][tx * 4 + j];
#pragma unroll
                for (int i = 0; i < 4; ++i)
#pragma unroll
                    for (int j = 0; j < 4; ++j) acc[i][j] = fmaf(a[i], b[j], acc[i][j]);
            }
            __syncthreads();
        }
#pragma unroll
        for (int i = 0; i < 4; ++i)
#pragma unroll
            for (int j = 0; j < 4; ++j) { const int col = col0 + tx * 4 + j; if (col < N) epi(row0 + ty * 4 + i, col, acc[i][j]); }
    }
}

__device__ __forceinline__ void transpose_bf16(const float* __restrict__ W, bf16* __restrict__ Wt, int K, int N, int Npad) {
    const size_t tot = (size_t)Npad * K;
    for (size_t i = gtid(); i < tot; i += gnth()) {
        const int n = (int)(i / K), k = (int)(i % K);
        Wt[i] = (n < N) ? f2bf(W[(size_t)k * N + n]) : (bf16)0;
    }
}
__device__ __forceinline__ void phase_prep(const Params& P) {
    unsigned char* ws = P.ws;
    for (int l = 0; l < DEPTH; ++l) {
        transpose_bf16(P.w_in + (size_t)l * D * DIN, (bf16*)(ws + WS_WIN) + (size_t)l * DINP * D, D, DIN, DINP);
        transpose_bf16(P.w_uq + (size_t)l * QR * 768, (bf16*)(ws + WS_WUQ) + (size_t)l * 768 * QR, QR, 768, 768);
        transpose_bf16(P.w_uk + (size_t)l * KVR * 512, (bf16*)(ws + WS_WUKV) + (size_t)l * 1024 * KVR, KVR, 512, 512);
        transpose_bf16(P.w_uv + (size_t)l * KVR * 512, (bf16*)(ws + WS_WUKV) + (size_t)l * 1024 * KVR + (size_t)512 * KVR, KVR, 512, 512);
        transpose_bf16(P.w_out + (size_t)l * D * D, (bf16*)(ws + WS_WOUT) + (size_t)l * D * D, D, D, D);
        transpose_bf16(P.peer_wq + (size_t)l * D * 2048, (bf16*)(ws + WS_WPQ) + (size_t)l * 2048 * D, D, 2048, 2048);
    }
    float* rope = (float*)(ws + WS_ROPE);
    for (size_t i = gtid(); i < (size_t)S * 16; i += gnth()) {
        const int s = (int)(i >> 4), f = (int)(i & 15);
        const double inv = pow(10000.0, -(double)f / 16.0);
        const double ang = (double)s * inv;
        rope[2 * i] = (float)cos(ang); rope[2 * i + 1] = (float)sin(ang);
    }
}

__device__ __forceinline__ void phase_norm(const float* __restrict__ h, const float* __restrict__ g, bf16* __restrict__ xn) {
    const int lane = threadIdx.x & 63;
    for (int t = gwave(); t < T; t += nwave()) {
        const float4* hr = (const float4*)(h + (size_t)t * D);
        float4 v[4]; float ss = 0.f;
#pragma unroll
        for (int j = 0; j < 4; ++j) { v[j] = hr[j * 64 + lane]; ss += v[j].x * v[j].x + v[j].y * v[j].y + v[j].z * v[j].z + v[j].w * v[j].w; }
        ss = wave_sum(ss);
        const float r = rsqrtf(ss * (1.f / D) + EPS);
#pragma unroll
        for (int j = 0; j < 4; ++j) {
            const float4 gg = ((const float4*)g)[j * 64 + lane];
            uint2 o; o.x = pack2(v[j].x * r * gg.x, v[j].y * r * gg.y); o.y = pack2(v[j].z * r * gg.z, v[j].w * r * gg.w);
            ((uint2*)(xn + (size_t)t * D))[j * 64 + lane] = o;
        }
    }
}

__device__ __forceinline__ void phase_mixprep(const Params& P, int l) {
    unsigned char* ws = P.ws;
    bf16* proj = (bf16*)(ws + WS_PROJ);
    bf16* Y = (bf16*)(ws + WS_XN);
    bf16* Kb = (bf16*)(ws + WS_K);
    const float* rope = (const float*)(ws + WS_ROPE);
    const float* qn = P.q_norm + l * QR; const float* kvn = P.kv_norm + l * KVR;
    const float* cw = P.conv_w + (size_t)l * 3 * 256;
    const float* pw = P.pool_w + (size_t)l * 4 * 64 * 64;
    const float* psc = P.pool_scale + l * 256;
    const int lane = threadIdx.x & 63;
    for (int t = gwave(); t < T; t += nwave()) {
        const int b = t / S, s = t % S;
        bf16* pr = proj + (size_t)t * DINP;
        {
            float v[6]; float ss = 0.f;
#pragma unroll
            for (int j = 0; j < 6; ++j) { v[j] = bf2f(pr[C_CQ + j * 64 + lane]); ss += v[j] * v[j]; }
            ss = wave_sum(ss);
            const float r = rsqrtf(ss * (1.f / QR) + EPS);
#pragma unroll
            for (int j = 0; j < 6; ++j) pr[C_CQ + j * 64 + lane] = f2bf(v[j] * r * qn[j * 64 + lane]);
        }
        {
            float v[4]; float ss = 0.f;
#pragma unroll
            for (int j = 0; j < 4; ++j) { v[j] = bf2f(pr[C_CKV + j * 64 + lane]); ss += v[j] * v[j]; }
            ss = wave_sum(ss);
            const float r = rsqrtf(ss * (1.f / KVR) + EPS);
#pragma unroll
            for (int j = 0; j < 4; ++j) pr[C_CKV + j * 64 + lane] = f2bf(v[j] * r * kvn[j * 64 + lane]);
        }
        if (lane < 16) {
            const float x1 = bf2f(pr[C_KR + lane]), x2 = bf2f(pr[C_KR + 16 + lane]);
            const float c = rope[(s * 16 + lane) * 2], sn = rope[(s * 16 + lane) * 2 + 1];
            const bf16 o1 = f2bf(x1 * c - x2 * sn), o2 = f2bf(x2 * c + x1 * sn);
#pragma unroll
            for (int h = 0; h < NH; ++h) {
                bf16* kr = Kb + ((size_t)(b * NH + h) * S + s) * DQK;
                kr[64 + lane] = o1; kr[80 + lane] = o2;
            }
        }
#pragma unroll
        for (int r = 0; r < 4; ++r) {
            const int c = r * 64 + lane;
            float acc = 0.f;
#pragma unroll
            for (int j = 0; j < 3; ++j) {
                const int sp = s - 2 + j;
                if (sp >= 0) {
                    const bf16* pp = proj + (size_t)(t - 2 + j) * DINP;
                    acc += cw[j * 256 + c] * (bf2f(pp[C_CG + c]) * bf2f(pp[C_HC + c]));
                }
            }
            Y[(size_t)t * D + c] = f2bf(bf2f(pr[C_BG + c]) * acc);
        }
        const int wins[4] = {2, 4, 8, 16};
#pragma unroll
        for (int g = 0; g < 4; ++g) {
            const int w = wins[g];
            const int lo = (s + 1 - w) > 0 ? (s + 1 - w) : 0;
            const int cnt = s + 1 - lo;
            float sum = 0.f;
            for (int sp = lo; sp <= s; ++sp) sum += bf2f(proj[(size_t)(b * S + sp) * DINP + C_HP + g * 64 + lane]);
            const float pooled = sum / (float)cnt - bf2f(pr[C_HP + g * 64 + lane]);
            float m = 0.f;
            for (int c = 0; c < 64; ++c) m = fmaf(__shfl(pooled, c, 64), pw[(g * 64 + c) * 64 + lane], m);
            Y[(size_t)t * D + 256 + g * 64 + lane] = f2bf(m * psc[g * 64 + lane]);
        }
    }
}

__device__ __forceinline__ void phase_qrope(const Params& P) {
    bf16* Qb = (bf16*)(P.ws + WS_Q);
    const float* rope = (const float*)(P.ws + WS_ROPE);
    const size_t tot = (size_t)T * NH * 16;
    for (size_t i = gtid(); i < tot; i += gnth()) {
        const int f = (int)(i & 15); const size_t row = i >> 4;
        const int s = (int)(row % S);
        bf16* q = Qb + row * DQK;
        const float x1 = bf2f(q[64 + f]), x2 = bf2f(q[80 + f]);
        const float c = rope[(s * 16 + f) * 2], sn = rope[(s * 16 + f) * 2 + 1];
        q[64 + f] = f2bf(x1 * c - x2 * sn); q[80 + f] = f2bf(x2 * c + x1 * sn);
    }
}

__device__ __forceinline__ void phase_attn_naive(const Params& P) {
    const bf16* Qb = (const bf16*)(P.ws + WS_Q);
    const bf16* Kb = (const bf16*)(P.ws + WS_K);
    const bf16* Vb = (const bf16*)(P.ws + WS_V);
    bf16* Y = (bf16*)(P.ws + WS_XN);
    const int lane = threadIdx.x & 63, qr = lane & 31, half = lane >> 5;
    const int gw = gwave(), nw = nwave();
    const int total = NB * NH * (S / 32);
    const float scale = 0.10206207261596575f;
    for (int pass = 0; pass * nw < total; ++pass) {
        const int u = (pass & 1) ? ((pass + 1) * nw - 1 - gw) : (pass * nw + gw);
        if (u >= total) continue;
        const int qblk = (S / 32 - 1) - (u >> 5), bh = u & 31;
        const int qpos = qblk * 32 + qr;
        unsigned q[DQK / 2];
        {
            const uint4* qp = (const uint4*)(Qb + ((size_t)bh * S + qpos) * DQK);
#pragma unroll
            for (int c = 0; c < 12; ++c) { const uint4 v = qp[c]; q[c * 4 + 0] = v.x; q[c * 4 + 1] = v.y; q[c * 4 + 2] = v.z; q[c * 4 + 3] = v.w; }
        }
        float o[32];
#pragma unroll
        for (int d = 0; d < 32; ++d) o[d] = 0.f;
        float m = -3.0e38f, lsum = 0.f;
        const int kmax = qblk * 32 + 31;
        const bf16* Kp = Kb + (size_t)bh * S * DQK;
        const bf16* Vp = Vb + (size_t)bh * S * DV + half * 32;
        for (int j = 0; j <= kmax; ++j) {
            const uint4* kr = (const uint4*)(Kp + (size_t)j * DQK);
            float sc = 0.f;
#pragma unroll
            for (int c = 0; c < 12; ++c) {
                const uint4 v = kr[c];
                sc = fmaf(bflo(q[c * 4 + 0]), bflo(v.x), sc); sc = fmaf(bfhi(q[c * 4 + 0]), bfhi(v.x), sc);
                sc = fmaf(bflo(q[c * 4 + 1]), bflo(v.y), sc); sc = fmaf(bfhi(q[c * 4 + 1]), bfhi(v.y), sc);
                sc = fmaf(bflo(q[c * 4 + 2]), bflo(v.z), sc); sc = fmaf(bfhi(q[c * 4 + 2]), bfhi(v.z), sc);
                sc = fmaf(bflo(q[c * 4 + 3]), bflo(v.w), sc); sc = fmaf(bfhi(q[c * 4 + 3]), bfhi(v.w), sc);
            }
            sc *= scale;
            if (j <= qpos) {
                const float mn = fmaxf(m, sc);
                const float alpha = __expf(m - mn);
                const float p = __expf(sc - mn);
                lsum = lsum * alpha + p; m = mn;
                const uint4* vr = (const uint4*)(Vp + (size_t)j * DV);
#pragma unroll
                for (int c = 0; c < 4; ++c) {
                    const uint4 v = vr[c];
                    o[c * 8 + 0] = fmaf(p, bflo(v.x), o[c * 8 + 0] * alpha); o[c * 8 + 1] = fmaf(p, bfhi(v.x), o[c * 8 + 1] * alpha);
                    o[c * 8 + 2] = fmaf(p, bflo(v.y), o[c * 8 + 2] * alpha); o[c * 8 + 3] = fmaf(p, bfhi(v.y), o[c * 8 + 3] * alpha);
                    o[c * 8 + 4] = fmaf(p, bflo(v.z), o[c * 8 + 4] * alpha); o[c * 8 + 5] = fmaf(p, bfhi(v.z), o[c * 8 + 5] * alpha);
                    o[c * 8 + 6] = fmaf(p, bflo(v.w), o[c * 8 + 6] * alpha); o[c * 8 + 7] = fmaf(p, bfhi(v.w), o[c * 8 + 7] * alpha);
                }
            }
        }
        const float inv = 1.f / lsum;
        const int b = bh >> 3, h = bh & 7;
        uint4* yo = (uint4*)(Y + ((size_t)(b * S + qpos)) * D + 512 + h * 64 + half * 32);
#pragma unroll
        for (int c = 0; c < 4; ++c) {
            uint4 v;
            v.x = pack2(o[c * 8 + 0] * inv, o[c * 8 + 1] * inv); v.y = pack2(o[c * 8 + 2] * inv, o[c * 8 + 3] * inv);
            v.z = pack2(o[c * 8 + 4] * inv, o[c * 8 + 5] * inv); v.w = pack2(o[c * 8 + 6] * inv, o[c * 8 + 7] * inv);
            yo[c] = v;
        }
    }
}

__device__ __forceinline__ void wave_argmax(float& bv, int& bi) {
#pragma unroll
    for (int m = 32; m >= 1; m >>= 1) {
        const float ov = __shfl_xor(bv, m, 64); const int oi = __shfl_xor(bi, m, 64);
        if (ov > bv || (ov == bv && oi < bi)) { bv = ov; bi = oi; }
    }
}
__device__ __forceinline__ void peer_half_top16(const float* __restrict__ skp, const float* qs, int, int lane, float& sp, int& ip) {
    const float NEG = -3.0e38f;
    float v0 = 0.f, v1 = 0.f;
    const float4* r0 = (const float4*)(skp + (size_t)lane * 128);
    const float4* r1 = (const float4*)(skp + (size_t)(lane + 64) * 128);
    for (int d = 0; d < 32; ++d) {
        const float4 a = r0[d], bq = r1[d];
        const float q0 = qs[d * 4 + 0], q1 = qs[d * 4 + 1], q2 = qs[d * 4 + 2], q3 = qs[d * 4 + 3];
        v0 = fmaf(q0, a.x, v0); v0 = fmaf(q1, a.y, v0); v0 = fmaf(q2, a.z, v0); v0 = fmaf(q3, a.w, v0);
        v1 = fmaf(q0, bq.x, v1); v1 = fmaf(q1, bq.y, v1); v1 = fmaf(q2, bq.z, v1); v1 = fmaf(q3, bq.w, v1);
    }
    sp = 0.f; ip = 0;
    for (int k = 0; k < TOPK; ++k) {
        float bv; int bi;
        if (v0 >= v1) { bv = v0; bi = lane; } else { bv = v1; bi = lane + 64; }
        wave_argmax(bv, bi);
        if (lane == k) { sp = bv; ip = bi; }
        if (bi == lane) v0 = NEG; else if (bi == lane + 64) v1 = NEG;
    }
}
__device__ __forceinline__ void phase_topk_naive(const Params& P, int l, float* sm) {
    const bf16* QP = (const bf16*)(P.ws + WS_QP);
    int* EXPp = (int*)(P.ws + WS_EXP);
    float* GATEp = (float*)(P.ws + WS_GATE);
    const float* sk = P.peer_subkeys + (size_t)l * 2 * NKEY * 128;
    const int lane = threadIdx.x & 63, wv = threadIdx.x >> 6;
    float* qs = sm + wv * 256;
    const float NEG = -3.0e38f;
    for (int u = gwave(); u < T * PH; u += nwave()) {
        const int t = u >> 3, h = u & 7;
        {
            const bf16* qp = QP + (size_t)t * 2048 + h * 256;
#pragma unroll
            for (int j = 0; j < 4; ++j) qs[j * 64 + lane] = bf2f(qp[j * 64 + lane]);
        }
        __builtin_amdgcn_s_waitcnt(0);
        __builtin_amdgcn_wave_barrier();
        float stop0, stop1; int itop0, itop1;
        peer_half_top16(sk, qs, 0, lane, stop0, itop0);
        peer_half_top16(sk + (size_t)NKEY * 128, qs + 128, 0, lane, stop1, itop1);
        __builtin_amdgcn_wave_barrier();
        float cv[4];
#pragma unroll
        for (int r = 0; r < 4; ++r) { const int c = lane + 64 * r; cv[r] = __shfl(stop0, c >> 4, 64) + __shfl(stop1, c & 15, 64); }
        float ts = 0.f; int ci = 0;
        for (int k = 0; k < TOPK; ++k) {
            float bv = cv[0]; int bi = lane;
#pragma unroll
            for (int r = 1; r < 4; ++r) if (cv[r] > bv) { bv = cv[r]; bi = lane + 64 * r; }
            wave_argmax(bv, bi);
            if (lane == k) { ts = bv; ci = bi; }
#pragma unroll
            for (int r = 0; r < 4; ++r) if (bi == lane + 64 * r) cv[r] = NEG;
        }
        const int e1 = __shfl(itop0, ci >> 4, 64), e2 = __shfl(itop1, ci & 15, 64);
        const float smax = __shfl(ts, 0, 64);
        float ex = (lane < 16) ? __expf(ts - smax) : 0.f;
        float den = ex;
#pragma unroll
        for (int m = 8; m >= 1; m >>= 1) den += __shfl_xor(den, m, 64);
        if (lane < 16) {
            EXPp[(size_t)t * HK + h * 16 + lane] = e1 * NKEY + e2;
            GATEp[(size_t)t * HK + h * 16 + lane] = ex / den;
        }
    }
}

__device__ __forceinline__ void phase_gather_naive(const Params& P, int l) {
    const bf16* XN = (const bf16*)(P.ws + WS_XN);
    const int* EXPp = (const int*)(P.ws + WS_EXP);
    const float* GATEp = (const float*)(P.ws + WS_GATE);
    const float* U = P.peer_u + (size_t)l * NEXP * D;
    const float* V = P.peer_v + (size_t)l * NEXP * D;
    const int lane = threadIdx.x & 63;
    for (int t = gwave(); t < T; t += nwave()) {
        float4 xv[4];
#pragma unroll
        for (int j = 0; j < 4; ++j) {
            const uint2 r = ((const uint2*)(XN + (size_t)t * D))[j * 64 + lane];
            xv[j] = make_float4(bflo(r.x), bfhi(r.x), bflo(r.y), bfhi(r.y));
        }
        float4 acc[4];
#pragma unroll
        for (int j = 0; j < 4; ++j) acc[j] = make_float4(0.f, 0.f, 0.f, 0.f);
        for (int k = 0; k < HK; ++k) {
            const int e = EXPp[(size_t)t * HK + k];
            const float g = GATEp[(size_t)t * HK + k];
            const float4* ur = (const float4*)(U + (size_t)e * D);
            float d = 0.f;
#pragma unroll
            for (int j = 0; j < 4; ++j) { const float4 u = ur[j * 64 + lane]; d += xv[j].x * u.x + xv[j].y * u.y + xv[j].z * u.z + xv[j].w * u.w; }
            d = wave_sum(d);
            const float a = g * gelu_exact(d);
            const float4* vr = (const float4*)(V + (size_t)e * D);
#pragma unroll
            for (int j = 0; j < 4; ++j) { const float4 v = vr[j * 64 + lane]; acc[j].x = fmaf(a, v.x, acc[j].x); acc[j].y = fmaf(a, v.y, acc[j].y); acc[j].z = fmaf(a, v.z, acc[j].z); acc[j].w = fmaf(a, v.w, acc[j].w); }
        }
        float4* hr = (float4*)(P.out + (size_t)t * D);
        float ss = 0.f;
#pragma unroll
        for (int j = 0; j < 4; ++j) {
            const float4 hv = hr[j * 64 + lane];
            acc[j].x += hv.x; acc[j].y += hv.y; acc[j].z += hv.z; acc[j].w += hv.w;
            ss += acc[j].x * acc[j].x + acc[j].y * acc[j].y + acc[j].z * acc[j].z + acc[j].w * acc[j].w;
        }
        if (l == DEPTH - 1) {
            ss = wave_sum(ss);
            const float r = rsqrtf(ss * (1.f / D) + EPS);
#pragma unroll
            for (int j = 0; j < 4; ++j) {
                const float4 gg = ((const float4*)P.norm_final)[j * 64 + lane];
                hr[j * 64 + lane] = make_float4(acc[j].x * r * gg.x, acc[j].y * r * gg.y, acc[j].z * r * gg.z, acc[j].w * r * gg.w);
            }
        } else {
#pragma unroll
            for (int j = 0; j < 4; ++j) hr[j * 64 + lane] = acc[j];
        }
    }
}

constexpr int PH_PER_LAYER = 11;
constexpr int NPHASES = 1 + DEPTH * PH_PER_LAYER;

__device__ __forceinline__ void run_phase(const Params& P, int ph, float* sm) {
    unsigned char* ws = P.ws;
    if (ph == 0) { phase_prep(P); return; }
    const int l = (ph - 1) / PH_PER_LAYER, s = (ph - 1) % PH_PER_LAYER;
    bf16* XN = (bf16*)(ws + WS_XN);
    bf16* PROJ = (bf16*)(ws + WS_PROJ);
    const float* hin = (l == 0) ? P.x : P.out;
    switch (s) {
    case 0: phase_norm(hin, P.norm_mix + l * D, XN); break;
    case 1: {
        const bf16* W = (const bf16*)(ws + WS_WIN) + (size_t)l * DINP * D;
        gemm_naive(T, DIN, D,
            [&](int r, int k) { return bf2f(XN[(size_t)r * D + k]); },
            [&](int k, int c) { return bf2f(W[(size_t)c * D + k]); },
            [&](int r, int c, float v) { PROJ[(size_t)r * DINP + c] = f2bf(v); }, sm);
    } break;
    case 2: phase_mixprep(P, l); break;
    case 3: {
        const bf16* W = (const bf16*)(ws + WS_WUQ) + (size_t)l * 768 * QR;
        bf16* Qb = (bf16*)(ws + WS_Q);
        gemm_naive(T, 768, QR,
            [&](int r, int k) { return bf2f(PROJ[(size_t)r * DINP + C_CQ + k]); },
            [&](int k, int c) { return bf2f(W[(size_t)c * QR + k]); },
            [&](int r, int c, float v) { const int b = r / S, s2 = r % S, h = c / DQK, d = c % DQK; Qb[((size_t)(b * NH + h) * S + s2) * DQK + d] = f2bf(v); }, sm);
    } break;
    case 4: {
        const bf16* W = (const bf16*)(ws + WS_WUKV) + (size_t)l * 1024 * KVR;
        bf16* Kb = (bf16*)(ws + WS_K); bf16* Vb = (bf16*)(ws + WS_V);
        gemm_naive(T, 1024, KVR,
            [&](int r, int k) { return bf2f(PROJ[(size_t)r * DINP + C_CKV + k]); },
            [&](int k, int c) { return bf2f(W[(size_t)c * KVR + k]); },
            [&](int r, int c, float v) {
                const int b = r / S, s2 = r % S;
                if (c < 512) { const int h = c >> 6, d = c & 63; Kb[((size_t)(b * NH + h) * S + s2) * DQK + d] = f2bf(v); }
                else { const int c2 = c - 512, h = c2 >> 6, d = c2 & 63; Vb[((size_t)(b * NH + h) * S + s2) * DV + d] = f2bf(v); }
            }, sm);
    } break;
    case 5: phase_qrope(P); break;
    case 6: phase_attn_naive(P); break;
    case 7: {
        const bf16* W = (const bf16*)(ws + WS_WOUT) + (size_t)l * D * D;
        float* out = P.out;
        gemm_naive(T, D, D,
            [&](int r, int k) { return bf2f(XN[(size_t)r * D + k]); },
            [&](int k, int c) { return bf2f(W[(size_t)c * D + k]); },
            [&](int r, int c, float v) { out[(size_t)r * D + c] = hin[(size_t)r * D + c] + v; }, sm);
    } break;
    case 8: phase_norm(P.out, P.norm_ffn + l * D, XN); break;
    case 9: {
        const bf16* W = (const bf16*)(ws + WS_WPQ) + (size_t)l * 2048 * D;
        bf16* QP = (bf16*)(ws + WS_QP);
        gemm_naive(T, 2048, D,
            [&](int r, int k) { return bf2f(XN[(size_t)r * D + k]); },
            [&](int k, int c) { return bf2f(W[(size_t)c * D + k]); },
            [&](int r, int c, float v) { QP[(size_t)r * 2048 + c] = f2bf(v); }, sm);
    } break;
    case 10: phase_topk_naive(P, l, sm); break;
    }
}

__global__ void __launch_bounds__(NTHREADS, 2) k_phase(Params P, int ph) {
    __shared__ __attribute__((aligned(16))) float sm[16 * 68 * 2];
    if (ph >= 0) run_phase(P, ph, sm);
    else phase_gather_naive(P, -ph - 1);
}

#if ONE_LAUNCH
__global__ void __launch_bounds__(NTHREADS, 2) k_all(Params P) {
    __shared__ __attribute__((aligned(16))) float sm[16 * 68 * 2];
    cg::grid_group grid = cg::this_grid();
    for (int ph = 0; ph < NPHASES; ++ph) {
        run_phase(P, ph, sm);
        grid.sync();
        if (ph > 0 && (ph - 1) % PH_PER_LAYER == PH_PER_LAYER - 1) { phase_gather_naive(P, (ph - 1) / PH_PER_LAYER); grid.sync(); }
    }
}

#endif

extern "C" void kernel_launch(void* const* d_in, const int* in_sizes, int n_in, void* d_out, int out_size, void* d_ws, size_t ws_size, hipStream_t stream) {
    static int grid = 0;
    if (grid == 0) {
        if (n_in != 18 || out_size != T * D || ws_size < WS_END) { fprintf(stderr, "kernel_launch: bad sizes n_in %d out %d ws %zu need %zu\n", n_in, out_size, ws_size, (size_t)WS_END); grid = -1; return; }
        int dev = 0, cus = 0, per_cu = 0;
        hipGetDevice(&dev);
        hipDeviceGetAttribute(&cus, hipDeviceAttributeMultiprocessorCount, dev);
#if ONE_LAUNCH
        hipOccupancyMaxActiveBlocksPerMultiprocessor(&per_cu, (const void*)k_all, NTHREADS, 0);
#else
        hipOccupancyMaxActiveBlocksPerMultiprocessor(&per_cu, (const void*)k_phase, NTHREADS, 0);
#endif
        if (per_cu > 2) per_cu = 2;
        if (per_cu < 1) { fprintf(stderr, "kernel_launch: occupancy query says %d\n", per_cu); grid = -1; return; }
        grid = cus * per_cu;
    }
    if (grid < 0) return;
    Params p{};
    p.x = (const float*)d_in[0]; p.norm_mix = (const float*)d_in[1]; p.w_in = (const float*)d_in[2]; p.conv_w = (const float*)d_in[3];
    p.pool_w = (const float*)d_in[4]; p.pool_scale = (const float*)d_in[5]; p.q_norm = (const float*)d_in[6]; p.w_uq = (const float*)d_in[7];
    p.kv_norm = (const float*)d_in[8]; p.w_uk = (const float*)d_in[9]; p.w_uv = (const float*)d_in[10]; p.w_out = (const float*)d_in[11];
    p.norm_ffn = (const float*)d_in[12]; p.peer_wq = (const float*)d_in[13]; p.peer_subkeys = (const float*)d_in[14]; p.peer_u = (const float*)d_in[15];
    p.peer_v = (const float*)d_in[16]; p.norm_final = (const float*)d_in[17];
    p.out = (float*)d_out; p.ws = (unsigned char*)d_ws;
#if ONE_LAUNCH
    void* args[] = {&p};
    hipError_t e = hipLaunchCooperativeKernel((const void*)k_all, dim3(grid), dim3(NTHREADS), args, 0, stream);
    if (e != hipSuccess) fprintf(stderr, "cooperative launch failed: %s (grid %d)\n", hipGetErrorString(e), grid);
#else
    for (int ph = 0; ph < NPHASES; ++ph) {
        hipLaunchKernelGGL(k_phase, dim3(grid), dim3(NTHREADS), 0, stream, p, ph);
        if (ph > 0 && (ph - 1) % PH_PER_LAYER == PH_PER_LAYER - 1) hipLaunchKernelGGL(k_phase, dim3(grid), dim3(NTHREADS), 0, stream, p, -((ph - 1) / PH_PER_LAYER) - 1);
    }
#endif
}
```

```cpp
#include <hip/hip_runtime.h>
#include <hip/hip_cooperative_groups.h>
#include <cstdio>
#include <cstdint>
namespace cg = cooperative_groups;

#ifndef ONE_LAUNCH
#define ONE_LAUNCH 1
#endif

constexpr int NB = 4, S = 8192, T = NB * S, D = 1024, DEPTH = 2;
constexpr int DIN = 1696, DINP = 1792;
constexpr int C_BG = 0, C_CG = 256, C_HC = 512, C_HP = 768, C_CQ = 1024, C_CKV = 1408, C_KR = 1664;
constexpr int QR = 384, KVR = 256, NH = 8, DQK = 96, DV = 64;
constexpr int PH = 8, NKEY = 128, NEXP = NKEY * NKEY, TOPK = 16, HK = PH * TOPK;
constexpr float EPS = 1e-6f;

typedef unsigned short bf16;

constexpr size_t MB = 1024 * 1024;
constexpr size_t WS_CTL   = 0;
constexpr size_t WS_ROPE  = 64 * 1024;
constexpr size_t WS_WIN   = WS_ROPE + (size_t)S * 16 * 2 * 4;
constexpr size_t WS_WUQ   = WS_WIN + (size_t)DEPTH * DINP * D * 2;
constexpr size_t WS_WUKV  = WS_WUQ + (size_t)DEPTH * 768 * QR * 2;
constexpr size_t WS_WOUT  = WS_WUKV + (size_t)DEPTH * 1024 * KVR * 2;
constexpr size_t WS_WPQ   = WS_WOUT + (size_t)DEPTH * D * D * 2;
constexpr size_t WS_XN    = ((WS_WPQ + (size_t)DEPTH * 2048 * D * 2 + 4095) / 4096) * 4096;
constexpr size_t WS_PROJ  = WS_XN + (size_t)T * D * 2;
constexpr size_t WS_Q     = WS_PROJ + (size_t)T * DINP * 2;
constexpr size_t WS_K     = WS_Q + (size_t)T * NH * DQK * 2;
constexpr size_t WS_V     = WS_K + (size_t)T * NH * DQK * 2;
constexpr size_t WS_EXP   = WS_V + (size_t)T * NH * DV * 2;
constexpr size_t WS_GATE  = WS_EXP + (size_t)T * HK * 4;
constexpr size_t WS_END   = WS_GATE + (size_t)T * HK * 4;
constexpr size_t WS_QP    = WS_PROJ;
static_assert((size_t)T * 2048 * 2 <= WS_K - WS_PROJ, "QP alias");

struct Params {
    const float* x; const float* norm_mix; const float* w_in; const float* conv_w; const float* pool_w; const float* pool_scale;
    const float* q_norm; const float* w_uq; const float* kv_norm; const float* w_uk; const float* w_uv; const float* w_out;
    const float* norm_ffn; const float* peer_wq; const float* peer_subkeys; const float* peer_u; const float* peer_v; const float* norm_final;
    float* out; unsigned char* ws;
};

__device__ __forceinline__ bf16 f2bf(float f) { unsigned u = __float_as_uint(f); u += 0x7fffu + ((u >> 16) & 1u); return (bf16)(u >> 16); }
__device__ __forceinline__ float bf2f(bf16 h) { return __uint_as_float(((unsigned)h) << 16); }
__device__ __forceinline__ float bflo(unsigned u) { return __uint_as_float(u << 16); }
__device__ __forceinline__ float bfhi(unsigned u) { return __uint_as_float(u & 0xffff0000u); }
__device__ __forceinline__ unsigned pack2(float a, float b) { return (unsigned)f2bf(a) | ((unsigned)f2bf(b) << 16); }
__device__ __forceinline__ float wave_sum(float v) {
#pragma unroll
    for (int m = 32; m >= 1; m >>= 1) v += __shfl_xor(v, m, 64);
    return v;
}
__device__ __forceinline__ float gelu_exact(float x) { return 0.5f * x * (1.f + erff(x * 0.70710678118654752f)); }

#define NTHREADS 256
__device__ __forceinline__ int tidx() { int t = (int)__builtin_amdgcn_workitem_id_x(); asm volatile("" : "+v"(t)); return t; }
__device__ __forceinline__ int gwave() { return blockIdx.x * (NTHREADS / 64) + (tidx() >> 6); }
__device__ __forceinline__ int nwave() { return gridDim.x * (NTHREADS / 64); }
__device__ __forceinline__ size_t gtid() { return (size_t)blockIdx.x * NTHREADS + tidx(); }
__device__ __forceinline__ size_t gnth() { return (size_t)gridDim.x * NTHREADS; }


__device__ __forceinline__ Params launder(const Params& P) {
    Params Q = P;
    asm volatile("" : "+s"(Q.x), "+s"(Q.norm_mix), "+s"(Q.w_in), "+s"(Q.conv_w), "+s"(Q.pool_w), "+s"(Q.pool_scale), "+s"(Q.q_norm), "+s"(Q.w_uq), "+s"(Q.kv_norm), "+s"(Q.w_uk));
    asm volatile("" : "+s"(Q.w_uv), "+s"(Q.w_out), "+s"(Q.norm_ffn), "+s"(Q.peer_wq), "+s"(Q.peer_subkeys), "+s"(Q.peer_u), "+s"(Q.peer_v), "+s"(Q.norm_final), "+s"(Q.out), "+s"(Q.ws));
    return Q;
}

template <class AL, class BL, class EP>
__device__ __forceinline__ void gemm_naive(int M, int N, int K, AL aload, BL bload, EP epi, float* sm) {
    float (*As)[68] = (float (*)[68])sm;
    float (*Bs)[68] = (float (*)[68])(sm + 16 * 68);
    const int tid = tidx(), tx = tid & 15, ty = tid >> 4;
    const int tilesN = (N + 63) / 64, tilesM = M / 64;
    for (int tile = blockIdx.x; tile < tilesM * tilesN; tile += gridDim.x) {
        const int tm = tile / tilesN, tn = tile % tilesN;
        const int row0 = tm * 64, col0 = tn * 64;
        float acc[4][4];
#pragma unroll
        for (int i = 0; i < 4; ++i)
#pragma unroll
            for (int j = 0; j < 4; ++j) acc[i][j] = 0.f;
        for (int k0 = 0; k0 < K; k0 += 16) {
            {
                const int r = tid >> 2, kk = (tid & 3) * 4;
#pragma unroll
                for (int i = 0; i < 4; ++i) As[kk + i][r] = aload(row0 + r, k0 + kk + i);
            }
            {
                const int kk = tid >> 4, c = (tid & 15) * 4;
#pragma unroll
                for (int j = 0; j < 4; ++j) { const int col = col0 + c + j; Bs[kk][c + j] = (col < N) ? bload(k0 + kk, col) : 0.f; }
            }
            __syncthreads();
#pragma unroll
            for (int kk = 0; kk < 16; ++kk) {
                float a[4], b[4];
#pragma unroll
                for (int i = 0; i < 4; ++i) a[i] = As[kk][ty * 4 + i];
#pragma unroll
                for (int j = 0; j < 4; ++j) b[j] = Bs[kk][tx * 4 + j];
#pragma unroll
                for (int i = 0; i < 4; ++i)
#pragma unroll
                    for (int j = 0; j < 4; ++j) acc[i][j] = fmaf(a[i], b[j], acc[i][j]);
            }
            __syncthreads();
        }
#pragma unroll
        for (int i = 0; i < 4; ++i)
#pragma unroll
            for (int j = 0; j < 4; ++j) { const int col = col0 + tx * 4 + j; if (col < N) epi(row0 + ty * 4 + i, col, acc[i][j]); }
    }
}

__device__ __forceinline__ void transpose_bf16(const float* __restrict__ W, bf16* __restrict__ Wt, int K, int N, int Npad) {
    const size_t tot = (size_t)Npad * K;
    for (size_t i = gtid(); i < tot; i += gnth()) {
        const int n = (int)(i / K), k = (int)(i % K);
        Wt[i] = (n < N) ? f2bf(W[(size_t)k * N + n]) : (bf16)0;
    }
}
__device__ __forceinline__ void phase_prep(const Params& P) {
    unsigned char* ws = P.ws;
    for (int l = 0; l < DEPTH; ++l) {
        transpose_bf16(P.w_in + (size_t)l * D * DIN, (bf16*)(ws + WS_WIN) + (size_t)l * DINP * D, D, DIN, DINP);
        transpose_bf16(P.w_uq + (size_t)l * QR * 768, (bf16*)(ws + WS_WUQ) + (size_t)l * 768 * QR, QR, 768, 768);
        transpose_bf16(P.w_uk + (size_t)l * KVR * 512, (bf16*)(ws + WS_WUKV) + (size_t)l * 1024 * KVR, KVR, 512, 512);
        transpose_bf16(P.w_uv + (size_t)l * KVR * 512, (bf16*)(ws + WS_WUKV) + (size_t)l * 1024 * KVR + (size_t)512 * KVR, KVR, 512, 512);
        transpose_bf16(P.w_out + (size_t)l * D * D, (bf16*)(ws + WS_WOUT) + (size_t)l * D * D, D, D, D);
        transpose_bf16(P.peer_wq + (size_t)l * D * 2048, (bf16*)(ws + WS_WPQ) + (size_t)l * 2048 * D, D, 2048, 2048);
    }
    float* rope = (float*)(ws + WS_ROPE);
    for (size_t i = gtid(); i < (size_t)S * 16; i += gnth()) {
        const int s = (int)(i >> 4), f = (int)(i & 15);
        const double inv = pow(10000.0, -(double)f / 16.0);
        const double ang = (double)s * inv;
        rope[2 * i] = (float)cos(ang); rope[2 * i + 1] = (float)sin(ang);
    }
}

__device__ __forceinline__ void phase_norm(const float* __restrict__ h, const float* __restrict__ g, bf16* __restrict__ xn) {
    const int lane = tidx() & 63;
    for (int t = gwave(); t < T; t += nwave()) {
        const float4* hr = (const float4*)(h + (size_t)t * D);
        float4 v[4]; float ss = 0.f;
#pragma unroll
        for (int j = 0; j < 4; ++j) { v[j] = hr[j * 64 + lane]; ss += v[j].x * v[j].x + v[j].y * v[j].y + v[j].z * v[j].z + v[j].w * v[j].w; }
        ss = wave_sum(ss);
        const float r = rsqrtf(ss * (1.f / D) + EPS);
#pragma unroll
        for (int j = 0; j < 4; ++j) {
            const float4 gg = ((const float4*)g)[j * 64 + lane];
            uint2 o; o.x = pack2(v[j].x * r * gg.x, v[j].y * r * gg.y); o.y = pack2(v[j].z * r * gg.z, v[j].w * r * gg.w);
            ((uint2*)(xn + (size_t)t * D))[j * 64 + lane] = o;
        }
    }
}

__device__ __forceinline__ void phase_mixprep(const Params& P, int l) {
    unsigned char* ws = P.ws;
    bf16* proj = (bf16*)(ws + WS_PROJ);
    bf16* Y = (bf16*)(ws + WS_XN);
    bf16* Kb = (bf16*)(ws + WS_K);
    const float* rope = (const float*)(ws + WS_ROPE);
    const float* qn = P.q_norm + l * QR; const float* kvn = P.kv_norm + l * KVR;
    const float* cw = P.conv_w + (size_t)l * 3 * 256;
    const float* pw = P.pool_w + (size_t)l * 4 * 64 * 64;
    const float* psc = P.pool_scale + l * 256;
    const int lane = tidx() & 63;
    for (int t = gwave(); t < T; t += nwave()) {
        const int b = t / S, s = t % S;
        bf16* pr = proj + (size_t)t * DINP;
        {
            float v[6]; float ss = 0.f;
#pragma unroll
            for (int j = 0; j < 6; ++j) { v[j] = bf2f(pr[C_CQ + j * 64 + lane]); ss += v[j] * v[j]; }
            ss = wave_sum(ss);
            const float r = rsqrtf(ss * (1.f / QR) + EPS);
#pragma unroll
            for (int j = 0; j < 6; ++j) pr[C_CQ + j * 64 + lane] = f2bf(v[j] * r * qn[j * 64 + lane]);
        }
        {
            float v[4]; float ss = 0.f;
#pragma unroll
            for (int j = 0; j < 4; ++j) { v[j] = bf2f(pr[C_CKV + j * 64 + lane]); ss += v[j] * v[j]; }
            ss = wave_sum(ss);
            const float r = rsqrtf(ss * (1.f / KVR) + EPS);
#pragma unroll
            for (int j = 0; j < 4; ++j) pr[C_CKV + j * 64 + lane] = f2bf(v[j] * r * kvn[j * 64 + lane]);
        }
        if (lane < 16) {
            const float x1 = bf2f(pr[C_KR + lane]), x2 = bf2f(pr[C_KR + 16 + lane]);
            const float c = rope[(s * 16 + lane) * 2], sn = rope[(s * 16 + lane) * 2 + 1];
            const bf16 o1 = f2bf(x1 * c - x2 * sn), o2 = f2bf(x2 * c + x1 * sn);
#pragma unroll
            for (int h = 0; h < NH; ++h) {
                bf16* kr = Kb + ((size_t)(b * NH + h) * S + s) * DQK;
                kr[64 + lane] = o1; kr[80 + lane] = o2;
            }
        }
#pragma unroll
        for (int r = 0; r < 4; ++r) {
            const int c = r * 64 + lane;
            float acc = 0.f;
#pragma unroll
            for (int j = 0; j < 3; ++j) {
                const int sp = s - 2 + j;
                if (sp >= 0) {
                    const bf16* pp = proj + (size_t)(t - 2 + j) * DINP;
                    acc += cw[j * 256 + c] * (bf2f(pp[C_CG + c]) * bf2f(pp[C_HC + c]));
                }
            }
            Y[(size_t)t * D + c] = f2bf(bf2f(pr[C_BG + c]) * acc);
        }
        const int wins[4] = {2, 4, 8, 16};
#pragma unroll
        for (int g = 0; g < 4; ++g) {
            const int w = wins[g];
            const int lo = (s + 1 - w) > 0 ? (s + 1 - w) : 0;
            const int cnt = s + 1 - lo;
            float sum = 0.f;
            for (int sp = lo; sp <= s; ++sp) sum += bf2f(proj[(size_t)(b * S + sp) * DINP + C_HP + g * 64 + lane]);
            const float pooled = sum / (float)cnt - bf2f(pr[C_HP + g * 64 + lane]);
            float m = 0.f;
            for (int c = 0; c < 64; ++c) m = fmaf(__shfl(pooled, c, 64), pw[(g * 64 + c) * 64 + lane], m);
            Y[(size_t)t * D + 256 + g * 64 + lane] = f2bf(m * psc[g * 64 + lane]);
        }
    }
}

__device__ __forceinline__ void phase_qrope(const Params& P) {
    bf16* Qb = (bf16*)(P.ws + WS_Q);
    const float* rope = (const float*)(P.ws + WS_ROPE);
    const size_t tot = (size_t)T * NH * 16;
    for (size_t i = gtid(); i < tot; i += gnth()) {
        const int f = (int)(i & 15); const size_t row = i >> 4;
        const int s = (int)(row % S);
        bf16* q = Qb + row * DQK;
        const float x1 = bf2f(q[64 + f]), x2 = bf2f(q[80 + f]);
        const float c = rope[(s * 16 + f) * 2], sn = rope[(s * 16 + f) * 2 + 1];
        q[64 + f] = f2bf(x1 * c - x2 * sn); q[80 + f] = f2bf(x2 * c + x1 * sn);
    }
}

__device__ __forceinline__ void phase_attn_naive(const Params& P) {
    const bf16* Qb = (const bf16*)(P.ws + WS_Q);
    const bf16* Kb = (const bf16*)(P.ws + WS_K);
    const bf16* Vb = (const bf16*)(P.ws + WS_V);
    bf16* Y = (bf16*)(P.ws + WS_XN);
    const int lane = tidx() & 63, qr = lane & 31, half = lane >> 5;
    const int gw = gwave(), nw = nwave();
    const int total = NB * NH * (S / 32);
    const float scale = 0.10206207261596575f;
    for (int pass = 0; pass * nw < total; ++pass) {
        const int u = (pass & 1) ? ((pass + 1) * nw - 1 - gw) : (pass * nw + gw);
        if (u >= total) continue;
        const int qblk = (S / 32 - 1) - (u >> 5), bh = u & 31;
        const int qpos = qblk * 32 + qr;
        unsigned q[DQK / 2];
        {
            const uint4* qp = (const uint4*)(Qb + ((size_t)bh * S + qpos) * DQK);
#pragma unroll
            for (int c = 0; c < 12; ++c) { const uint4 v = qp[c]; q[c * 4 + 0] = v.x; q[c * 4 + 1] = v.y; q[c * 4 + 2] = v.z; q[c * 4 + 3] = v.w; }
        }
        float o[32];
#pragma unroll
        for (int d = 0; d < 32; ++d) o[d] = 0.f;
        float m = -3.0e38f, lsum = 0.f;
        const int kmax = qblk * 32 + 31;
        const bf16* Kp = Kb + (size_t)bh * S * DQK;
        const bf16* Vp = Vb + (size_t)bh * S * DV + half * 32;
        for (int j = 0; j <= kmax; ++j) {
            const uint4* kr = (const uint4*)(Kp + (size_t)j * DQK);
            float sc = 0.f;
#pragma unroll
            for (int c = 0; c < 12; ++c) {
                const uint4 v = kr[c];
                sc = fmaf(bflo(q[c * 4 + 0]), bflo(v.x), sc); sc = fmaf(bfhi(q[c * 4 + 0]), bfhi(v.x), sc);
                sc = fmaf(bflo(q[c * 4 + 1]), bflo(v.y), sc); sc = fmaf(bfhi(q[c * 4 + 1]), bfhi(v.y), sc);
                sc = fmaf(bflo(q[c * 4 + 2]), bflo(v.z), sc); sc = fmaf(bfhi(q[c * 4 + 2]), bfhi(v.z), sc);
                sc = fmaf(bflo(q[c * 4 + 3]), bflo(v.w), sc); sc = fmaf(bfhi(q[c * 4 + 3]), bfhi(v.w), sc);
            }
            sc *= scale;
            if (j <= qpos) {
                const float mn = fmaxf(m, sc);
                const float alpha = __expf(m - mn);
                const float p = __expf(sc - mn);
                lsum = lsum * alpha + p; m = mn;
                const uint4* vr = (const uint4*)(Vp + (size_t)j * DV);
#pragma unroll
                for (int c = 0; c < 4; ++c) {
                    const uint4 v = vr[c];
                    o[c * 8 + 0] = fmaf(p, bflo(v.x), o[c * 8 + 0] * alpha); o[c * 8 + 1] = fmaf(p, bfhi(v.x), o[c * 8 + 1] * alpha);
                    o[c * 8 + 2] = fmaf(p, bflo(v.y), o[c * 8 + 2] * alpha); o[c * 8 + 3] = fmaf(p, bfhi(v.y), o[c * 8 + 3] * alpha);
                    o[c * 8 + 4] = fmaf(p, bflo(v.z), o[c * 8 + 4] * alpha); o[c * 8 + 5] = fmaf(p, bfhi(v.z), o[c * 8 + 5] * alpha);
                    o[c * 8 + 6] = fmaf(p, bflo(v.w), o[c * 8 + 6] * alpha); o[c * 8 + 7] = fmaf(p, bfhi(v.w), o[c * 8 + 7] * alpha);
                }
            }
        }
        const float inv = 1.f / lsum;
        const int b = bh >> 3, h = bh & 7;
        uint4* yo = (uint4*)(Y + ((size_t)(b * S + qpos)) * D + 512 + h * 64 + half * 32);
#pragma unroll
        for (int c = 0; c < 4; ++c) {
            uint4 v;
            v.x = pack2(o[c * 8 + 0] * inv, o[c * 8 + 1] * inv); v.y = pack2(o[c * 8 + 2] * inv, o[c * 8 + 3] * inv);
            v.z = pack2(o[c * 8 + 4] * inv, o[c * 8 + 5] * inv); v.w = pack2(o[c * 8 + 6] * inv, o[c * 8 + 7] * inv);
            yo[c] = v;
        }
    }
}

__device__ __forceinline__ void wave_argmax(float& bv, int& bi) {
#pragma unroll
    for (int m = 32; m >= 1; m >>= 1) {
        const float ov = __shfl_xor(bv, m, 64); const int oi = __shfl_xor(bi, m, 64);
        if (ov > bv || (ov == bv && oi < bi)) { bv = ov; bi = oi; }
    }
}
__device__ __forceinline__ void peer_half_top16(const float* __restrict__ skp, const float* qs, int, int lane, float& sp, int& ip) {
    const float NEG = -3.0e38f;
    float v0 = 0.f, v1 = 0.f;
    const float4* r0 = (const float4*)(skp + (size_t)lane * 128);
    const float4* r1 = (const float4*)(skp + (size_t)(lane + 64) * 128);
    for (int d = 0; d < 32; ++d) {
        const float4 a = r0[d], bq = r1[d];
        const float q0 = qs[d * 4 + 0], q1 = qs[d * 4 + 1], q2 = qs[d * 4 + 2], q3 = qs[d * 4 + 3];
        v0 = fmaf(q0, a.x, v0); v0 = fmaf(q1, a.y, v0); v0 = fmaf(q2, a.z, v0); v0 = fmaf(q3, a.w, v0);
        v1 = fmaf(q0, bq.x, v1); v1 = fmaf(q1, bq.y, v1); v1 = fmaf(q2, bq.z, v1); v1 = fmaf(q3, bq.w, v1);
    }
    sp = 0.f; ip = 0;
    for (int k = 0; k < TOPK; ++k) {
        float bv; int bi;
        if (v0 >= v1) { bv = v0; bi = lane; } else { bv = v1; bi = lane + 64; }
        wave_argmax(bv, bi);
        if (lane == k) { sp = bv; ip = bi; }
        if (bi == lane) v0 = NEG; else if (bi == lane + 64) v1 = NEG;
    }
}
__device__ __forceinline__ void phase_topk_naive(const Params& P, int l, float* sm) {
    const bf16* QP = (const bf16*)(P.ws + WS_QP);
    int* EXPp = (int*)(P.ws + WS_EXP);
    float* GATEp = (float*)(P.ws + WS_GATE);
    const float* sk = P.peer_subkeys + (size_t)l * 2 * NKEY * 128;
    const int lane = tidx() & 63, wv = tidx() >> 6;
    float* qs = sm + wv * 256;
    const float NEG = -3.0e38f;
    for (int u = gwave(); u < T * PH; u += nwave()) {
        const int t = u >> 3, h = u & 7;
        {
            const bf16* qp = QP + (size_t)t * 2048 + h * 256;
#pragma unroll
            for (int j = 0; j < 4; ++j) qs[j * 64 + lane] = bf2f(qp[j * 64 + lane]);
        }
        __builtin_amdgcn_s_waitcnt(0);
        __builtin_amdgcn_wave_barrier();
        float stop0, stop1; int itop0, itop1;
        peer_half_top16(sk, qs, 0, lane, stop0, itop0);
        peer_half_top16(sk + (size_t)NKEY * 128, qs + 128, 0, lane, stop1, itop1);
        __builtin_amdgcn_wave_barrier();
        float cv[4];
#pragma unroll
        for (int r = 0; r < 4; ++r) { const int c = lane + 64 * r; cv[r] = __shfl(stop0, c >> 4, 64) + __shfl(stop1, c & 15, 64); }
        float ts = 0.f; int ci = 0;
        for (int k = 0; k < TOPK; ++k) {
            float bv = cv[0]; int bi = lane;
#pragma unroll
            for (int r = 1; r < 4; ++r) if (cv[r] > bv) { bv = cv[r]; bi = lane + 64 * r; }
            wave_argmax(bv, bi);
            if (lane == k) { ts = bv; ci = bi; }
#pragma unroll
            for (int r = 0; r < 4; ++r) if (bi == lane + 64 * r) cv[r] = NEG;
        }
        const int e1 = __shfl(itop0, ci >> 4, 64), e2 = __shfl(itop1, ci & 15, 64);
        const float smax = __shfl(ts, 0, 64);
        float ex = (lane < 16) ? __expf(ts - smax) : 0.f;
        float den = ex;
#pragma unroll
        for (int m = 8; m >= 1; m >>= 1) den += __shfl_xor(den, m, 64);
        if (lane < 16) {
            EXPp[(size_t)t * HK + h * 16 + lane] = e1 * NKEY + e2;
            GATEp[(size_t)t * HK + h * 16 + lane] = ex / den;
        }
    }
}

__device__ __forceinline__ void phase_gather_naive(const Params& P, int l) {
    const bf16* XN = (const bf16*)(P.ws + WS_XN);
    const int* EXPp = (const int*)(P.ws + WS_EXP);
    const float* GATEp = (const float*)(P.ws + WS_GATE);
    const float* U = P.peer_u + (size_t)l * NEXP * D;
    const float* V = P.peer_v + (size_t)l * NEXP * D;
    const int lane = tidx() & 63;
    for (int t = gwave(); t < T; t += nwave()) {
        float4 xv[4];
#pragma unroll
        for (int j = 0; j < 4; ++j) {
            const uint2 r = ((const uint2*)(XN + (size_t)t * D))[j * 64 + lane];
            xv[j] = make_float4(bflo(r.x), bfhi(r.x), bflo(r.y), bfhi(r.y));
        }
        float4 acc[4];
#pragma unroll
        for (int j = 0; j < 4; ++j) acc[j] = make_float4(0.f, 0.f, 0.f, 0.f);
        for (int k = 0; k < HK; ++k) {
            const int e = EXPp[(size_t)t * HK + k];
            const float g = GATEp[(size_t)t * HK + k];
            const float4* ur = (const float4*)(U + (size_t)e * D);
            float d = 0.f;
#pragma unroll
            for (int j = 0; j < 4; ++j) { const float4 u = ur[j * 64 + lane]; d += xv[j].x * u.x + xv[j].y * u.y + xv[j].z * u.z + xv[j].w * u.w; }
            d = wave_sum(d);
            const float a = g * gelu_exact(d);
            const float4* vr = (const float4*)(V + (size_t)e * D);
#pragma unroll
            for (int j = 0; j < 4; ++j) { const float4 v = vr[j * 64 + lane]; acc[j].x = fmaf(a, v.x, acc[j].x); acc[j].y = fmaf(a, v.y, acc[j].y); acc[j].z = fmaf(a, v.z, acc[j].z); acc[j].w = fmaf(a, v.w, acc[j].w); }
        }
        float4* hr = (float4*)(P.out + (size_t)t * D);
        float ss = 0.f;
#pragma unroll
        for (int j = 0; j < 4; ++j) {
            const float4 hv = hr[j * 64 + lane];
            acc[j].x += hv.x; acc[j].y += hv.y; acc[j].z += hv.z; acc[j].w += hv.w;
            ss += acc[j].x * acc[j].x + acc[j].y * acc[j].y + acc[j].z * acc[j].z + acc[j].w * acc[j].w;
        }
        if (l == DEPTH - 1) {
            ss = wave_sum(ss);
            const float r = rsqrtf(ss * (1.f / D) + EPS);
#pragma unroll
            for (int j = 0; j < 4; ++j) {
                const float4 gg = ((const float4*)P.norm_final)[j * 64 + lane];
                hr[j * 64 + lane] = make_float4(acc[j].x * r * gg.x, acc[j].y * r * gg.y, acc[j].z * r * gg.z, acc[j].w * r * gg.w);
            }
        } else {
#pragma unroll
            for (int j = 0; j < 4; ++j) hr[j * 64 + lane] = acc[j];
        }
    }
}

constexpr int PH_PER_LAYER = 11;
constexpr int NPHASES = 1 + DEPTH * PH_PER_LAYER;

template <int s>
__device__ __forceinline__ void layer_phase(const Params& P, int l, float* sm) {
    unsigned char* ws = P.ws;
    bf16* XN = (bf16*)(ws + WS_XN);
    bf16* PROJ = (bf16*)(ws + WS_PROJ);
    const float* hin = (l == 0) ? P.x : P.out;
    switch (s) {
    case 0: phase_norm(hin, P.norm_mix + l * D, XN); break;
    case 1: {
        const bf16* W = (const bf16*)(ws + WS_WIN) + (size_t)l * DINP * D;
        gemm_naive(T, DIN, D,
            [&](int r, int k) { return bf2f(XN[(size_t)r * D + k]); },
            [&](int k, int c) { return bf2f(W[(size_t)c * D + k]); },
            [&](int r, int c, float v) { PROJ[(size_t)r * DINP + c] = f2bf(v); }, sm);
    } break;
    case 2: phase_mixprep(P, l); break;
    case 3: {
        const bf16* W = (const bf16*)(ws + WS_WUQ) + (size_t)l * 768 * QR;
        bf16* Qb = (bf16*)(ws + WS_Q);
        gemm_naive(T, 768, QR,
            [&](int r, int k) { return bf2f(PROJ[(size_t)r * DINP + C_CQ + k]); },
            [&](int k, int c) { return bf2f(W[(size_t)c * QR + k]); },
            [&](int r, int c, float v) { const int b = r / S, s2 = r % S, h = c / DQK, d = c % DQK; Qb[((size_t)(b * NH + h) * S + s2) * DQK + d] = f2bf(v); }, sm);
    } break;
    case 4: {
        const bf16* W = (const bf16*)(ws + WS_WUKV) + (size_t)l * 1024 * KVR;
        bf16* Kb = (bf16*)(ws + WS_K); bf16* Vb = (bf16*)(ws + WS_V);
        gemm_naive(T, 1024, KVR,
            [&](int r, int k) { return bf2f(PROJ[(size_t)r * DINP + C_CKV + k]); },
            [&](int k, int c) { return bf2f(W[(size_t)c * KVR + k]); },
            [&](int r, int c, float v) {
                const int b = r / S, s2 = r % S;
                if (c < 512) { const int h = c >> 6, d = c & 63; Kb[((size_t)(b * NH + h) * S + s2) * DQK + d] = f2bf(v); }
                else { const int c2 = c - 512, h = c2 >> 6, d = c2 & 63; Vb[((size_t)(b * NH + h) * S + s2) * DV + d] = f2bf(v); }
            }, sm);
    } break;
    case 5: phase_qrope(P); break;
    case 6: phase_attn_naive(P); break;
    case 7: {
        const bf16* W = (const bf16*)(ws + WS_WOUT) + (size_t)l * D * D;
        float* out = P.out;
        gemm_naive(T, D, D,
            [&](int r, int k) { return bf2f(XN[(size_t)r * D + k]); },
            [&](int k, int c) { return bf2f(W[(size_t)c * D + k]); },
            [&](int r, int c, float v) { out[(size_t)r * D + c] = hin[(size_t)r * D + c] + v; }, sm);
    } break;
    case 8: phase_norm(P.out, P.norm_ffn + l * D, XN); break;
    case 9: {
        const bf16* W = (const bf16*)(ws + WS_WPQ) + (size_t)l * 2048 * D;
        bf16* QP = (bf16*)(ws + WS_QP);
        gemm_naive(T, 2048, D,
            [&](int r, int k) { return bf2f(XN[(size_t)r * D + k]); },
            [&](int k, int c) { return bf2f(W[(size_t)c * D + k]); },
            [&](int r, int c, float v) { QP[(size_t)r * 2048 + c] = f2bf(v); }, sm);
    } break;
    case 10: phase_topk_naive(P, l, sm); break;
    }
}


__device__ __forceinline__ void layer_phase_dyn(const Params& P, int l, int s, float* sm) {
    switch (s) {
    case 0: layer_phase<0>(P, l, sm); break; case 1: layer_phase<1>(P, l, sm); break; case 2: layer_phase<2>(P, l, sm); break;
    case 3: layer_phase<3>(P, l, sm); break; case 4: layer_phase<4>(P, l, sm); break; case 5: layer_phase<5>(P, l, sm); break;
    case 6: layer_phase<6>(P, l, sm); break; case 7: layer_phase<7>(P, l, sm); break; case 8: layer_phase<8>(P, l, sm); break;
    case 9: layer_phase<9>(P, l, sm); break; case 10: layer_phase<10>(P, l, sm); break; default: phase_gather_naive(P, l); break;
    }
}
#if !ONE_LAUNCH
__global__ void __launch_bounds__(NTHREADS, 2) k_phase(Params P, int ph) {
    __shared__ __attribute__((aligned(16))) float sm[16 * 68 * 2];
    if (ph == 0) { phase_prep(P); return; }
    layer_phase_dyn(P, (ph - 1) / (PH_PER_LAYER + 1), (ph - 1) % (PH_PER_LAYER + 1), sm);
}
#else
#define GSYNC() grid.sync()
__global__ void __launch_bounds__(NTHREADS, 2) k_all(Params P) {
    __shared__ __attribute__((aligned(16))) float sm[16 * 68 * 2];
    cg::grid_group grid = cg::this_grid();
    { const Params Q = launder(P); phase_prep(Q); } GSYNC();
    for (int l = 0; l < DEPTH; ++l) {
#define LP(s) { const Params Q = launder(P); layer_phase<s>(Q, l, sm); }
        LP(0); GSYNC();
        LP(1); GSYNC();
        LP(2); GSYNC();
        LP(3);
        LP(4); GSYNC();
        LP(5); GSYNC();
        LP(6); GSYNC();
        LP(7); GSYNC();
        LP(8); GSYNC();
        LP(9); GSYNC();
        LP(10); GSYNC();
        { const Params Q = launder(P); phase_gather_naive(Q, l); } GSYNC();
    }
}
#endif

extern "C" void kernel_launch(void* const* d_in, const int* in_sizes, int n_in, void* d_out, int out_size, void* d_ws, size_t ws_size, hipStream_t stream) {
    static int grid = 0;
    if (grid == 0) {
        if (n_in != 18 || out_size != T * D || ws_size < WS_END) { fprintf(stderr, "kernel_launch: bad sizes n_in %d out %d ws %zu need %zu\n", n_in, out_size, ws_size, (size_t)WS_END); grid = -1; return; }
        int dev = 0, cus = 0, per_cu = 0;
        hipGetDevice(&dev);
        hipDeviceGetAttribute(&cus, hipDeviceAttributeMultiprocessorCount, dev);
#if ONE_LAUNCH
        hipOccupancyMaxActiveBlocksPerMultiprocessor(&per_cu, (const void*)k_all, NTHREADS, 0);
#else
        hipOccupancyMaxActiveBlocksPerMultiprocessor(&per_cu, (const void*)k_phase, NTHREADS, 0);
#endif
        if (per_cu > 2) per_cu = 2;
        if (per_cu < 1) { fprintf(stderr, "kernel_launch: occupancy query says %d\n", per_cu); grid = -1; return; }
        grid = cus * per_cu;
    }
    if (grid < 0) return;
    Params p{};
    p.x = (const float*)d_in[0]; p.norm_mix = (const float*)d_in[1]; p.w_in = (const float*)d_in[2]; p.conv_w = (const float*)d_in[3];
    p.pool_w = (const float*)d_in[4]; p.pool_scale = (const float*)d_in[5]; p.q_norm = (const float*)d_in[6]; p.w_uq = (const float*)d_in[7];
    p.kv_norm = (const float*)d_in[8]; p.w_uk = (const float*)d_in[9]; p.w_uv = (const float*)d_in[10]; p.w_out = (const float*)d_in[11];
    p.norm_ffn = (const float*)d_in[12]; p.peer_wq = (const float*)d_in[13]; p.peer_subkeys = (const float*)d_in[14]; p.peer_u = (const float*)d_in[15];
    p.peer_v = (const float*)d_in[16]; p.norm_final = (const float*)d_in[17];
    p.out = (float*)d_out; p.ws = (unsigned char*)d_ws;
#if ONE_LAUNCH
    void* args[] = {&p};
    hipError_t e = hipLaunchCooperativeKernel((const void*)k_all, dim3(grid), dim3(NTHREADS), args, 0, stream);
    if (e != hipSuccess) fprintf(stderr, "cooperative launch failed: %s (grid %d)\n", hipGetErrorString(e), grid);
#else
    for (int ph = 0; ph < 1 + DEPTH * (PH_PER_LAYER + 1); ++ph) hipLaunchKernelGGL(k_phase, dim3(grid), dim3(NTHREADS), 0, stream, p, ph);
#endif
}
```

```cpp
#include <hip/hip_runtime.h>
#include <hip/hip_cooperative_groups.h>
#include <cstdio>
#include <cstdint>
namespace cg = cooperative_groups;

#ifndef ONE_LAUNCH
#define ONE_LAUNCH 1
#endif

constexpr int NB = 4, S = 8192, T = NB * S, D = 1024, DEPTH = 2;
constexpr int DIN = 1696, DINP = 1792;
constexpr int C_BG = 0, C_CG = 256, C_HC = 512, C_HP = 768, C_CQ = 1024, C_CKV = 1408, C_KR = 1664;
constexpr int QR = 384, KVR = 256, NH = 8, DQK = 96, DV = 64;
constexpr int PH = 8, NKEY = 128, NEXP = NKEY * NKEY, TOPK = 16, HK = PH * TOPK;
constexpr float EPS = 1e-6f;

typedef unsigned short bf16;

constexpr size_t MB = 1024 * 1024;
constexpr size_t WS_CTL   = 0;
constexpr size_t WS_ROPE  = 64 * 1024;
constexpr size_t WS_WIN   = WS_ROPE + (size_t)S * 16 * 2 * 4;
constexpr size_t WS_WUQ   = WS_WIN + (size_t)DEPTH * DINP * D * 2;
constexpr size_t WS_WUKV  = WS_WUQ + (size_t)DEPTH * 768 * QR * 2;
constexpr size_t WS_WOUT  = WS_WUKV + (size_t)DEPTH * 1024 * KVR * 2;
constexpr size_t WS_WPQ   = WS_WOUT + (size_t)DEPTH * D * D * 2;
constexpr size_t WS_XN    = ((WS_WPQ + (size_t)DEPTH * 2048 * D * 2 + 4095) / 4096) * 4096;
constexpr size_t WS_PROJ  = WS_XN + (size_t)T * D * 2;
constexpr size_t WS_Q     = WS_PROJ + (size_t)T * DINP * 2;
constexpr size_t WS_K     = WS_Q + (size_t)T * NH * DQK * 2;
constexpr size_t WS_V     = WS_K + (size_t)T * NH * DQK * 2;
constexpr size_t WS_EXP   = WS_V + (size_t)T * NH * DV * 2;
constexpr size_t WS_GATE  = WS_EXP + (size_t)T * HK * 4;
constexpr size_t WS_END   = WS_GATE + (size_t)T * HK * 4;
constexpr size_t WS_QP    = WS_PROJ;
static_assert((size_t)T * 2048 * 2 <= WS_K - WS_PROJ, "QP alias");

struct Params {
    const float* x; const float* norm_mix; const float* w_in; const float* conv_w; const float* pool_w; const float* pool_scale;
    const float* q_norm; const float* w_uq; const float* kv_norm; const float* w_uk; const float* w_uv; const float* w_out;
    const float* norm_ffn; const float* peer_wq; const float* peer_subkeys; const float* peer_u; const float* peer_v; const float* norm_final;
    float* out; unsigned char* ws;
};

__device__ __forceinline__ bf16 f2bf(float f) { unsigned u = __float_as_uint(f); u += 0x7fffu + ((u >> 16) & 1u); return (bf16)(u >> 16); }
__device__ __forceinline__ float bf2f(bf16 h) { return __uint_as_float(((unsigned)h) << 16); }
__device__ __forceinline__ float bflo(unsigned u) { return __uint_as_float(u << 16); }
__device__ __forceinline__ float bfhi(unsigned u) { return __uint_as_float(u & 0xffff0000u); }
__device__ __forceinline__ unsigned pack2(float a, float b) { return (unsigned)f2bf(a) | ((unsigned)f2bf(b) << 16); }
__device__ __forceinline__ float wave_sum(float v) {
#pragma unroll
    for (int m = 32; m >= 1; m >>= 1) v += __shfl_xor(v, m, 64);
    return v;
}
__device__ __forceinline__ float gelu_exact(float x) { return 0.5f * x * (1.f + erff(x * 0.70710678118654752f)); }

#define NTHREADS 256
__device__ __forceinline__ int tidx() { int t = (int)__builtin_amdgcn_workitem_id_x(); asm volatile("" : "+v"(t)); return t; }
__device__ __forceinline__ int gwave() { return blockIdx.x * (NTHREADS / 64) + (tidx() >> 6); }
__device__ __forceinline__ int nwave() { return gridDim.x * (NTHREADS / 64); }
__device__ __forceinline__ size_t gtid() { return (size_t)blockIdx.x * NTHREADS + tidx(); }
__device__ __forceinline__ size_t gnth() { return (size_t)gridDim.x * NTHREADS; }


__device__ __forceinline__ Params launder(const Params& P) {
    Params Q = P;
    asm volatile("" : "+s"(Q.x), "+s"(Q.norm_mix), "+s"(Q.w_in), "+s"(Q.conv_w), "+s"(Q.pool_w), "+s"(Q.pool_scale), "+s"(Q.q_norm), "+s"(Q.w_uq), "+s"(Q.kv_norm), "+s"(Q.w_uk));
    asm volatile("" : "+s"(Q.w_uv), "+s"(Q.w_out), "+s"(Q.norm_ffn), "+s"(Q.peer_wq), "+s"(Q.peer_subkeys), "+s"(Q.peer_u), "+s"(Q.peer_v), "+s"(Q.norm_final), "+s"(Q.out), "+s"(Q.ws));
    return Q;
}

template <class AL, class BL, class EP>
__device__ __forceinline__ void gemm_naive(int M, int N, int K, AL aload, BL bload, EP epi, float* sm) {
    float (*As)[68] = (float (*)[68])sm;
    float (*Bs)[68] = (float (*)[68])(sm + 16 * 68);
    const int tid = tidx(), tx = tid & 15, ty = tid >> 4;
    const int tilesN = (N + 63) / 64, tilesM = M / 64;
    for (int tile = blockIdx.x; tile < tilesM * tilesN; tile += gridDim.x) {
        const int tm = tile / tilesN, tn = tile % tilesN;
        const int row0 = tm * 64, col0 = tn * 64;
        float acc[4][4];
#pragma unroll
        for (int i = 0; i < 4; ++i)
#pragma unroll
            for (int j = 0; j < 4; ++j) acc[i][j] = 0.f;
        for (int k0 = 0; k0 < K; k0 += 16) {
            {
                const int r = tid >> 2, kk = (tid & 3) * 4;
#pragma unroll
                for (int i = 0; i < 4; ++i) As[kk + i][r] = aload(row0 + r, k0 + kk + i);
            }
            {
                const int kk = tid >> 4, c = (tid & 15) * 4;
#pragma unroll
                for (int j = 0; j < 4; ++j) { const int col = col0 + c + j; Bs[kk][c + j] = (col < N) ? bload(k0 + kk, col) : 0.f; }
            }
            __syncthreads();
#pragma unroll
            for (int kk = 0; kk < 16; ++kk) {
                float a[4], b[4];
#pragma unroll
                for (int i = 0; i < 4; ++i) a[i] = As[kk][ty * 4 + i];
#pragma unroll
                for (int j = 0; j < 4; ++j) b[j] = Bs[kk][tx * 4 + j];
#pragma unroll
                for (int i = 0; i < 4; ++i)
#pragma unroll
                    for (int j = 0; j < 4; ++j) acc[i][j] = fmaf(a[i], b[j], acc[i][j]);
            }
            __syncthreads();
        }
#pragma unroll
        for (int i = 0; i < 4; ++i)
#pragma unroll
            for (int j = 0; j < 4; ++j) { const int col = col0 + tx * 4 + j; if (col < N) epi(row0 + ty * 4 + i, col, acc[i][j]); }
    }
}


typedef __attribute__((ext_vector_type(8))) short bf16x8;
typedef __attribute__((ext_vector_type(16))) float f32x16;
#define MFMA32(a, b, c) __builtin_amdgcn_mfma_f32_32x32x16_bf16(a, b, c, 0, 0, 0)
__device__ __forceinline__ int crow(int r, int hi) { return (r & 3) + 8 * (r >> 2) + 4 * hi; }
constexpr int G_LDT = 144;
constexpr int G_OPB = 128 * G_LDT;
constexpr int G_BUF = 2 * G_OPB;
constexpr int GEMM_LDS = 2 * G_BUF;

template <class EPI>
__device__ __forceinline__ void gemm_mfma(const bf16* __restrict__ A, int lda, const bf16* __restrict__ Bt, int ldb, int M, int N, int K, EPI epi, char* lds) {
    const int tid = tidx(), lane = tid & 63, w = tid >> 6, r32 = lane & 31, hi = lane >> 5;
    const int wm = w >> 1, wn = w & 1;
    const int tilesN = N / 128, tilesM = M / 128, nk = K / 64;
    const int srow = tid >> 3, sch = tid & 7;
    for (int tile = blockIdx.x; tile < tilesM * tilesN; tile += gridDim.x) {
        const int tm = tile / tilesN, tn = tile % tilesN;
        const bf16* Ag = A + (size_t)(tm * 128 + srow) * lda + sch * 8;
        const bf16* Bg = Bt + (size_t)(tn * 128 + srow) * ldb + sch * 8;
        f32x16 acc[2][2];
#pragma unroll
        for (int i = 0; i < 2; ++i)
#pragma unroll
            for (int j = 0; j < 2; ++j)
#pragma unroll
                for (int r = 0; r < 16; ++r) acc[i][j][r] = 0.f;
        uint4 ra0, ra1, ra2, ra3, rb0, rb1, rb2, rb3;
#define G_LOAD(kofs) do { \
        ra0 = *(const uint4*)(Ag + (kofs)); ra1 = *(const uint4*)(Ag + (size_t)32 * lda + (kofs)); ra2 = *(const uint4*)(Ag + (size_t)64 * lda + (kofs)); ra3 = *(const uint4*)(Ag + (size_t)96 * lda + (kofs)); \
        rb0 = *(const uint4*)(Bg + (kofs)); rb1 = *(const uint4*)(Bg + (size_t)32 * ldb + (kofs)); rb2 = *(const uint4*)(Bg + (size_t)64 * ldb + (kofs)); rb3 = *(const uint4*)(Bg + (size_t)96 * ldb + (kofs)); } while (0)
        G_LOAD(0);
        for (int kt = 0; kt < nk; ++kt) {
            char* bA = lds + (kt & 1) * G_BUF; char* bB = bA + G_OPB;
            {
                char* wa = bA + srow * G_LDT + sch * 16; char* wb = bB + srow * G_LDT + sch * 16;
                *(uint4*)(wa) = ra0; *(uint4*)(wa + 32 * G_LDT) = ra1; *(uint4*)(wa + 64 * G_LDT) = ra2; *(uint4*)(wa + 96 * G_LDT) = ra3;
                *(uint4*)(wb) = rb0; *(uint4*)(wb + 32 * G_LDT) = rb1; *(uint4*)(wb + 64 * G_LDT) = rb2; *(uint4*)(wb + 96 * G_LDT) = rb3;
            }
            __syncthreads();
            if (kt + 1 < nk) G_LOAD((kt + 1) * 64);
            const char* pa = bA + (wm * 64 + r32) * G_LDT + hi * 16;
            const char* pb = bB + (wn * 64 + r32) * G_LDT + hi * 16;
#pragma unroll
            for (int ks = 0; ks < 4; ++ks) {
                const bf16x8 a0 = *(const bf16x8*)(pa + ks * 32), a1 = *(const bf16x8*)(pa + 32 * G_LDT + ks * 32);
                const bf16x8 b0 = *(const bf16x8*)(pb + ks * 32), b1 = *(const bf16x8*)(pb + 32 * G_LDT + ks * 32);
                acc[0][0] = MFMA32(a0, b0, acc[0][0]); acc[0][1] = MFMA32(a0, b1, acc[0][1]);
                acc[1][0] = MFMA32(a1, b0, acc[1][0]); acc[1][1] = MFMA32(a1, b1, acc[1][1]);
            }
        }
#pragma unroll
        for (int i = 0; i < 2; ++i)
#pragma unroll
            for (int j = 0; j < 2; ++j) epi(tm * 128 + wm * 64 + i * 32, tn * 128 + wn * 64 + j * 32, acc[i][j], r32, hi);
        __syncthreads();
    }
}

__device__ __forceinline__ void transpose_bf16(const float* __restrict__ W, bf16* __restrict__ Wt, int K, int N, int Npad) {
    const size_t tot = (size_t)Npad * K;
    for (size_t i = gtid(); i < tot; i += gnth()) {
        const int n = (int)(i / K), k = (int)(i % K);
        Wt[i] = (n < N) ? f2bf(W[(size_t)k * N + n]) : (bf16)0;
    }
}
__device__ __forceinline__ void phase_prep(const Params& P) {
    unsigned char* ws = P.ws;
    for (int l = 0; l < DEPTH; ++l) {
        transpose_bf16(P.w_in + (size_t)l * D * DIN, (bf16*)(ws + WS_WIN) + (size_t)l * DINP * D, D, DIN, DINP);
        transpose_bf16(P.w_uq + (size_t)l * QR * 768, (bf16*)(ws + WS_WUQ) + (size_t)l * 768 * QR, QR, 768, 768);
        transpose_bf16(P.w_uk + (size_t)l * KVR * 512, (bf16*)(ws + WS_WUKV) + (size_t)l * 1024 * KVR, KVR, 512, 512);
        transpose_bf16(P.w_uv + (size_t)l * KVR * 512, (bf16*)(ws + WS_WUKV) + (size_t)l * 1024 * KVR + (size_t)512 * KVR, KVR, 512, 512);
        transpose_bf16(P.w_out + (size_t)l * D * D, (bf16*)(ws + WS_WOUT) + (size_t)l * D * D, D, D, D);
        transpose_bf16(P.peer_wq + (size_t)l * D * 2048, (bf16*)(ws + WS_WPQ) + (size_t)l * 2048 * D, D, 2048, 2048);
    }
    float* rope = (float*)(ws + WS_ROPE);
    for (size_t i = gtid(); i < (size_t)S * 16; i += gnth()) {
        const int s = (int)(i >> 4), f = (int)(i & 15);
        const double inv = pow(10000.0, -(double)f / 16.0);
        const double ang = (double)s * inv;
        rope[2 * i] = (float)cos(ang); rope[2 * i + 1] = (float)sin(ang);
    }
}

__device__ __forceinline__ void phase_norm(const float* __restrict__ h, const float* __restrict__ g, bf16* __restrict__ xn) {
    const int lane = tidx() & 63;
    for (int t = gwave(); t < T; t += nwave()) {
        const float4* hr = (const float4*)(h + (size_t)t * D);
        float4 v[4]; float ss = 0.f;
#pragma unroll
        for (int j = 0; j < 4; ++j) { v[j] = hr[j * 64 + lane]; ss += v[j].x * v[j].x + v[j].y * v[j].y + v[j].z * v[j].z + v[j].w * v[j].w; }
        ss = wave_sum(ss);
        const float r = rsqrtf(ss * (1.f / D) + EPS);
#pragma unroll
        for (int j = 0; j < 4; ++j) {
            const float4 gg = ((const float4*)g)[j * 64 + lane];
            uint2 o; o.x = pack2(v[j].x * r * gg.x, v[j].y * r * gg.y); o.y = pack2(v[j].z * r * gg.z, v[j].w * r * gg.w);
            ((uint2*)(xn + (size_t)t * D))[j * 64 + lane] = o;
        }
    }
}

__device__ __forceinline__ void phase_mixprep(const Params& P, int l) {
    unsigned char* ws = P.ws;
    bf16* proj = (bf16*)(ws + WS_PROJ);
    bf16* Y = (bf16*)(ws + WS_XN);
    bf16* Kb = (bf16*)(ws + WS_K);
    const float* rope = (const float*)(ws + WS_ROPE);
    const float* qn = P.q_norm + l * QR; const float* kvn = P.kv_norm + l * KVR;
    const float* cw = P.conv_w + (size_t)l * 3 * 256;
    const float* pw = P.pool_w + (size_t)l * 4 * 64 * 64;
    const float* psc = P.pool_scale + l * 256;
    const int lane = tidx() & 63;
    for (int t = gwave(); t < T; t += nwave()) {
        const int b = t / S, s = t % S;
        bf16* pr = proj + (size_t)t * DINP;
        {
            float v[6]; float ss = 0.f;
#pragma unroll
            for (int j = 0; j < 6; ++j) { v[j] = bf2f(pr[C_CQ + j * 64 + lane]); ss += v[j] * v[j]; }
            ss = wave_sum(ss);
            const float r = rsqrtf(ss * (1.f / QR) + EPS);
#pragma unroll
            for (int j = 0; j < 6; ++j) pr[C_CQ + j * 64 + lane] = f2bf(v[j] * r * qn[j * 64 + lane]);
        }
        {
            float v[4]; float ss = 0.f;
#pragma unroll
            for (int j = 0; j < 4; ++j) { v[j] = bf2f(pr[C_CKV + j * 64 + lane]); ss += v[j] * v[j]; }
            ss = wave_sum(ss);
            const float r = rsqrtf(ss * (1.f / KVR) + EPS);
#pragma unroll
            for (int j = 0; j < 4; ++j) pr[C_CKV + j * 64 + lane] = f2bf(v[j] * r * kvn[j * 64 + lane]);
        }
        if (lane < 16) {
            const float x1 = bf2f(pr[C_KR + lane]), x2 = bf2f(pr[C_KR + 16 + lane]);
            const float c = rope[(s * 16 + lane) * 2], sn = rope[(s * 16 + lane) * 2 + 1];
            const bf16 o1 = f2bf(x1 * c - x2 * sn), o2 = f2bf(x2 * c + x1 * sn);
#pragma unroll
            for (int h = 0; h < NH; ++h) {
                bf16* kr = Kb + ((size_t)(b * NH + h) * S + s) * DQK;
                kr[64 + lane] = o1; kr[80 + lane] = o2;
            }
        }
#pragma unroll
        for (int r = 0; r < 4; ++r) {
            const int c = r * 64 + lane;
            float acc = 0.f;
#pragma unroll
            for (int j = 0; j < 3; ++j) {
                const int sp = s - 2 + j;
                if (sp >= 0) {
                    const bf16* pp = proj + (size_t)(t - 2 + j) * DINP;
                    acc += cw[j * 256 + c] * (bf2f(pp[C_CG + c]) * bf2f(pp[C_HC + c]));
                }
            }
            Y[(size_t)t * D + c] = f2bf(bf2f(pr[C_BG + c]) * acc);
        }
        const int wins[4] = {2, 4, 8, 16};
#pragma unroll
        for (int g = 0; g < 4; ++g) {
            const int w = wins[g];
            const int lo = (s + 1 - w) > 0 ? (s + 1 - w) : 0;
            const int cnt = s + 1 - lo;
            float sum = 0.f;
            for (int sp = lo; sp <= s; ++sp) sum += bf2f(proj[(size_t)(b * S + sp) * DINP + C_HP + g * 64 + lane]);
            const float pooled = sum / (float)cnt - bf2f(pr[C_HP + g * 64 + lane]);
            float m = 0.f;
            for (int c = 0; c < 64; ++c) m = fmaf(__shfl(pooled, c, 64), pw[(g * 64 + c) * 64 + lane], m);
            Y[(size_t)t * D + 256 + g * 64 + lane] = f2bf(m * psc[g * 64 + lane]);
        }
    }
}

__device__ __forceinline__ void phase_qrope(const Params& P) {
    bf16* Qb = (bf16*)(P.ws + WS_Q);
    const float* rope = (const float*)(P.ws + WS_ROPE);
    const size_t tot = (size_t)T * NH * 16;
    for (size_t i = gtid(); i < tot; i += gnth()) {
        const int f = (int)(i & 15); const size_t row = i >> 4;
        const int s = (int)(row % S);
        bf16* q = Qb + row * DQK;
        const float x1 = bf2f(q[64 + f]), x2 = bf2f(q[80 + f]);
        const float c = rope[(s * 16 + f) * 2], sn = rope[(s * 16 + f) * 2 + 1];
        q[64 + f] = f2bf(x1 * c - x2 * sn); q[80 + f] = f2bf(x2 * c + x1 * sn);
    }
}

__device__ __forceinline__ void phase_attn_naive(const Params& P) {
    const bf16* Qb = (const bf16*)(P.ws + WS_Q);
    const bf16* Kb = (const bf16*)(P.ws + WS_K);
    const bf16* Vb = (const bf16*)(P.ws + WS_V);
    bf16* Y = (bf16*)(P.ws + WS_XN);
    const int lane = tidx() & 63, qr = lane & 31, half = lane >> 5;
    const int gw = gwave(), nw = nwave();
    const int total = NB * NH * (S / 32);
    for (int pass = 0; pass * nw < total; ++pass) {
        const int u = (pass & 1) ? ((pass + 1) * nw - 1 - gw) : (pass * nw + gw);
        if (u >= total) continue;
        const int qblk = (S / 32 - 1) - (u >> 5), bh = u & 31;
        const int qpos = qblk * 32 + qr;
        unsigned q[DQK / 2];
        {
            const uint4* qp = (const uint4*)(Qb + ((size_t)bh * S + qpos) * DQK);
#pragma unroll
            for (int c = 0; c < 12; ++c) { const uint4 v = qp[c]; q[c * 4 + 0] = v.x; q[c * 4 + 1] = v.y; q[c * 4 + 2] = v.z; q[c * 4 + 3] = v.w; }
        }
        float o[32];
#pragma unroll
        for (int d = 0; d < 32; ++d) o[d] = 0.f;
        float m = -3.0e38f, lsum = 0.f;
        const int kmax = qblk * 32 + 31;
        const bf16* Kp = Kb + (size_t)bh * S * DQK;
        const bf16* Vp = Vb + (size_t)bh * S * DV + half * 32;
        for (int j = 0; j <= kmax; ++j) {
            const uint4* kr = (const uint4*)(Kp + (size_t)j * DQK);
            float sc = 0.f;
#pragma unroll
            for (int c = 0; c < 12; ++c) {
                const uint4 v = kr[c];
                sc = fmaf(bflo(q[c * 4 + 0]), bflo(v.x), sc); sc = fmaf(bfhi(q[c * 4 + 0]), bfhi(v.x), sc);
                sc = fmaf(bflo(q[c * 4 + 1]), bflo(v.y), sc); sc = fmaf(bfhi(q[c * 4 + 1]), bfhi(v.y), sc);
                sc = fmaf(bflo(q[c * 4 + 2]), bflo(v.z), sc); sc = fmaf(bfhi(q[c * 4 + 2]), bfhi(v.z), sc);
                sc = fmaf(bflo(q[c * 4 + 3]), bflo(v.w), sc); sc = fmaf(bfhi(q[c * 4 + 3]), bfhi(v.w), sc);
            }
            if (j <= qpos) {
                const float mn = fmaxf(m, sc);
                const float alpha = exp2f(m - mn);
                const float p = exp2f(sc - mn);
                lsum = lsum * alpha + p; m = mn;
                const uint4* vr = (const uint4*)(Vp + (size_t)j * DV);
#pragma unroll
                for (int c = 0; c < 4; ++c) {
                    const uint4 v = vr[c];
                    o[c * 8 + 0] = fmaf(p, bflo(v.x), o[c * 8 + 0] * alpha); o[c * 8 + 1] = fmaf(p, bfhi(v.x), o[c * 8 + 1] * alpha);
                    o[c * 8 + 2] = fmaf(p, bflo(v.y), o[c * 8 + 2] * alpha); o[c * 8 + 3] = fmaf(p, bfhi(v.y), o[c * 8 + 3] * alpha);
                    o[c * 8 + 4] = fmaf(p, bflo(v.z), o[c * 8 + 4] * alpha); o[c * 8 + 5] = fmaf(p, bfhi(v.z), o[c * 8 + 5] * alpha);
                    o[c * 8 + 6] = fmaf(p, bflo(v.w), o[c * 8 + 6] * alpha); o[c * 8 + 7] = fmaf(p, bfhi(v.w), o[c * 8 + 7] * alpha);
                }
            }
        }
        const float inv = 1.f / lsum;
        const int b = bh >> 3, h = bh & 7;
        uint4* yo = (uint4*)(Y + ((size_t)(b * S + qpos)) * D + 512 + h * 64 + half * 32);
#pragma unroll
        for (int c = 0; c < 4; ++c) {
            uint4 v;
            v.x = pack2(o[c * 8 + 0] * inv, o[c * 8 + 1] * inv); v.y = pack2(o[c * 8 + 2] * inv, o[c * 8 + 3] * inv);
            v.z = pack2(o[c * 8 + 4] * inv, o[c * 8 + 5] * inv); v.w = pack2(o[c * 8 + 6] * inv, o[c * 8 + 7] * inv);
            yo[c] = v;
        }
    }
}

__device__ __forceinline__ void wave_argmax(float& bv, int& bi) {
#pragma unroll
    for (int m = 32; m >= 1; m >>= 1) {
        const float ov = __shfl_xor(bv, m, 64); const int oi = __shfl_xor(bi, m, 64);
        if (ov > bv || (ov == bv && oi < bi)) { bv = ov; bi = oi; }
    }
}
__device__ __forceinline__ void peer_half_top16(const float* __restrict__ skp, const float* qs, int, int lane, float& sp, int& ip) {
    const float NEG = -3.0e38f;
    float v0 = 0.f, v1 = 0.f;
    const float4* r0 = (const float4*)(skp + (size_t)lane * 128);
    const float4* r1 = (const float4*)(skp + (size_t)(lane + 64) * 128);
    for (int d = 0; d < 32; ++d) {
        const float4 a = r0[d], bq = r1[d];
        const float q0 = qs[d * 4 + 0], q1 = qs[d * 4 + 1], q2 = qs[d * 4 + 2], q3 = qs[d * 4 + 3];
        v0 = fmaf(q0, a.x, v0); v0 = fmaf(q1, a.y, v0); v0 = fmaf(q2, a.z, v0); v0 = fmaf(q3, a.w, v0);
        v1 = fmaf(q0, bq.x, v1); v1 = fmaf(q1, bq.y, v1); v1 = fmaf(q2, bq.z, v1); v1 = fmaf(q3, bq.w, v1);
    }
    sp = 0.f; ip = 0;
    for (int k = 0; k < TOPK; ++k) {
        float bv; int bi;
        if (v0 >= v1) { bv = v0; bi = lane; } else { bv = v1; bi = lane + 64; }
        wave_argmax(bv, bi);
        if (lane == k) { sp = bv; ip = bi; }
        if (bi == lane) v0 = NEG; else if (bi == lane + 64) v1 = NEG;
    }
}
__device__ __forceinline__ void phase_topk_naive(const Params& P, int l, float* sm) {
    const bf16* QP = (const bf16*)(P.ws + WS_QP);
    int* EXPp = (int*)(P.ws + WS_EXP);
    float* GATEp = (float*)(P.ws + WS_GATE);
    const float* sk = P.peer_subkeys + (size_t)l * 2 * NKEY * 128;
    const int lane = tidx() & 63, wv = tidx() >> 6;
    float* qs = sm + wv * 256;
    const float NEG = -3.0e38f;
    for (int u = gwave(); u < T * PH; u += nwave()) {
        const int t = u >> 3, h = u & 7;
        {
            const bf16* qp = QP + (size_t)t * 2048 + h * 256;
#pragma unroll
            for (int j = 0; j < 4; ++j) qs[j * 64 + lane] = bf2f(qp[j * 64 + lane]);
        }
        __builtin_amdgcn_s_waitcnt(0);
        __builtin_amdgcn_wave_barrier();
        float stop0, stop1; int itop0, itop1;
        peer_half_top16(sk, qs, 0, lane, stop0, itop0);
        peer_half_top16(sk + (size_t)NKEY * 128, qs + 128, 0, lane, stop1, itop1);
        __builtin_amdgcn_wave_barrier();
        float cv[4];
#pragma unroll
        for (int r = 0; r < 4; ++r) { const int c = lane + 64 * r; cv[r] = __shfl(stop0, c >> 4, 64) + __shfl(stop1, c & 15, 64); }
        float ts = 0.f; int ci = 0;
        for (int k = 0; k < TOPK; ++k) {
            float bv = cv[0]; int bi = lane;
#pragma unroll
            for (int r = 1; r < 4; ++r) if (cv[r] > bv) { bv = cv[r]; bi = lane + 64 * r; }
            wave_argmax(bv, bi);
            if (lane == k) { ts = bv; ci = bi; }
#pragma unroll
            for (int r = 0; r < 4; ++r) if (bi == lane + 64 * r) cv[r] = NEG;
        }
        const int e1 = __shfl(itop0, ci >> 4, 64), e2 = __shfl(itop1, ci & 15, 64);
        const float smax = __shfl(ts, 0, 64);
        float ex = (lane < 16) ? __expf(ts - smax) : 0.f;
        float den = ex;
#pragma unroll
        for (int m = 8; m >= 1; m >>= 1) den += __shfl_xor(den, m, 64);
        if (lane < 16) {
            EXPp[(size_t)t * HK + h * 16 + lane] = e1 * NKEY + e2;
            GATEp[(size_t)t * HK + h * 16 + lane] = ex / den;
        }
    }
}

__device__ __forceinline__ void phase_gather_naive(const Params& P, int l) {
    const bf16* XN = (const bf16*)(P.ws + WS_XN);
    const int* EXPp = (const int*)(P.ws + WS_EXP);
    const float* GATEp = (const float*)(P.ws + WS_GATE);
    const float* U = P.peer_u + (size_t)l * NEXP * D;
    const float* V = P.peer_v + (size_t)l * NEXP * D;
    const int lane = tidx() & 63;
    for (int t = gwave(); t < T; t += nwave()) {
        float4 xv[4];
#pragma unroll
        for (int j = 0; j < 4; ++j) {
            const uint2 r = ((const uint2*)(XN + (size_t)t * D))[j * 64 + lane];
            xv[j] = make_float4(bflo(r.x), bfhi(r.x), bflo(r.y), bfhi(r.y));
        }
        float4 acc[4];
#pragma unroll
        for (int j = 0; j < 4; ++j) acc[j] = make_float4(0.f, 0.f, 0.f, 0.f);
        for (int k = 0; k < HK; ++k) {
            const int e = EXPp[(size_t)t * HK + k];
            const float g = GATEp[(size_t)t * HK + k];
            const float4* ur = (const float4*)(U + (size_t)e * D);
            float d = 0.f;
#pragma unroll
            for (int j = 0; j < 4; ++j) { const float4 u = ur[j * 64 + lane]; d += xv[j].x * u.x + xv[j].y * u.y + xv[j].z * u.z + xv[j].w * u.w; }
            d = wave_sum(d);
            const float a = g * gelu_exact(d);
            const float4* vr = (const float4*)(V + (size_t)e * D);
#pragma unroll
            for (int j = 0; j < 4; ++j) { const float4 v = vr[j * 64 + lane]; acc[j].x = fmaf(a, v.x, acc[j].x); acc[j].y = fmaf(a, v.y, acc[j].y); acc[j].z = fmaf(a, v.z, acc[j].z); acc[j].w = fmaf(a, v.w, acc[j].w); }
        }
        float4* hr = (float4*)(P.out + (size_t)t * D);
        float ss = 0.f;
#pragma unroll
        for (int j = 0; j < 4; ++j) {
            const float4 hv = hr[j * 64 + lane];
            acc[j].x += hv.x; acc[j].y += hv.y; acc[j].z += hv.z; acc[j].w += hv.w;
            ss += acc[j].x * acc[j].x + acc[j].y * acc[j].y + acc[j].z * acc[j].z + acc[j].w * acc[j].w;
        }
        if (l == DEPTH - 1) {
            ss = wave_sum(ss);
            const float r = rsqrtf(ss * (1.f / D) + EPS);
#pragma unroll
            for (int j = 0; j < 4; ++j) {
                const float4 gg = ((const float4*)P.norm_final)[j * 64 + lane];
                hr[j * 64 + lane] = make_float4(acc[j].x * r * gg.x, acc[j].y * r * gg.y, acc[j].z * r * gg.z, acc[j].w * r * gg.w);
            }
        } else {
#pragma unroll
            for (int j = 0; j < 4; ++j) hr[j * 64 + lane] = acc[j];
        }
    }
}

constexpr int PH_PER_LAYER = 11;
constexpr int NPHASES = 1 + DEPTH * PH_PER_LAYER;

constexpr float QSCALE = 0.10206207261596575f * 1.4426950408889634f;
template <int s>
__device__ __forceinline__ void layer_phase(const Params& P, int l, char* lds) {
    unsigned char* ws = P.ws;
    float* sm = (float*)lds;
    bf16* XN = (bf16*)(ws + WS_XN);
    bf16* PROJ = (bf16*)(ws + WS_PROJ);
    const float* hin = (l == 0) ? P.x : P.out;
    if constexpr (s == 0) phase_norm(hin, P.norm_mix + l * D, XN);
    if constexpr (s == 1) {
        const bf16* W = (const bf16*)(ws + WS_WIN) + (size_t)l * DINP * D;
        gemm_mfma(XN, D, W, D, T, DINP, D, [&](int m0, int n0, const f32x16& acc, int r32, int hi) {
            const int n = n0 + r32;
            if (n < DIN) {
#pragma unroll
                for (int r = 0; r < 16; ++r) PROJ[(size_t)(m0 + crow(r, hi)) * DINP + n] = f2bf(acc[r]);
            }
        }, lds);
    }
    if constexpr (s == 2) phase_mixprep(P, l);
    if constexpr (s == 3) {
        const bf16* W = (const bf16*)(ws + WS_WUQ) + (size_t)l * 768 * QR;
        bf16* Qb = (bf16*)(ws + WS_Q);
        const float* rope = (const float*)(ws + WS_ROPE);
        gemm_mfma(PROJ + C_CQ, DINP, W, QR, T, 768, QR, [&](int m0, int n0, const f32x16& acc, int r32, int hi) {
            const int h = n0 / DQK, d0 = n0 % DQK;
            const int b = m0 / S, s0 = m0 % S;
            bf16* qb = Qb + ((size_t)(b * NH + h) * S + s0) * DQK + d0 + r32;
            if (d0 == 64) {
                const int f = r32 & 15;
#pragma unroll
                for (int r = 0; r < 16; ++r) {
                    const int sr = crow(r, hi);
                    const float v = acc[r], o = __shfl_xor(v, 16, 64);
                    const float2 cs = *(const float2*)(rope + ((size_t)(s0 + sr) * 16 + f) * 2);
                    const float res = (r32 < 16) ? (v * cs.x - o * cs.y) : (v * cs.x + o * cs.y);
                    qb[(size_t)sr * DQK] = f2bf(res * QSCALE);
                }
            } else {
#pragma unroll
                for (int r = 0; r < 16; ++r) qb[(size_t)crow(r, hi) * DQK] = f2bf(acc[r] * QSCALE);
            }
        }, lds);
    }
    if constexpr (s == 4) {
        const bf16* W = (const bf16*)(ws + WS_WUKV) + (size_t)l * 1024 * KVR;
        bf16* Kb = (bf16*)(ws + WS_K); bf16* Vb = (bf16*)(ws + WS_V);
        gemm_mfma(PROJ + C_CKV, DINP, W, KVR, T, 1024, KVR, [&](int m0, int n0, const f32x16& acc, int r32, int hi) {
            const int b = m0 / S, s0 = m0 % S;
            if (n0 < 512) {
                const int h = n0 >> 6, d = (n0 & 63) + r32;
                bf16* kb = Kb + ((size_t)(b * NH + h) * S + s0) * DQK + d;
#pragma unroll
                for (int r = 0; r < 16; ++r) kb[(size_t)crow(r, hi) * DQK] = f2bf(acc[r]);
            } else {
                const int h = (n0 - 512) >> 6, d = (n0 & 63) + r32;
                bf16* vb = Vb + ((size_t)(b * NH + h) * S + s0) * DV + d;
#pragma unroll
                for (int r = 0; r < 16; ++r) vb[(size_t)crow(r, hi) * DV] = f2bf(acc[r]);
            }
        }, lds);
    }
    if constexpr (s == 5) { }
    if constexpr (s == 6) phase_attn_naive(P);
    if constexpr (s == 7) {
        const bf16* W = (const bf16*)(ws + WS_WOUT) + (size_t)l * D * D;
        float* out = P.out;
        gemm_mfma(XN, D, W, D, T, D, D, [&](int m0, int n0, const f32x16& acc, int r32, int hi) {
#pragma unroll
            for (int r = 0; r < 16; ++r) { const size_t idx = (size_t)(m0 + crow(r, hi)) * D + n0 + r32; out[idx] = hin[idx] + acc[r]; }
        }, lds);
    }
    if constexpr (s == 8) phase_norm(P.out, P.norm_ffn + l * D, XN);
    if constexpr (s == 9) {
        const bf16* W = (const bf16*)(ws + WS_WPQ) + (size_t)l * 2048 * D;
        bf16* QP = (bf16*)(ws + WS_QP);
        gemm_mfma(XN, D, W, D, T, 2048, D, [&](int m0, int n0, const f32x16& acc, int r32, int hi) {
#pragma unroll
            for (int r = 0; r < 16; ++r) QP[(size_t)(m0 + crow(r, hi)) * 2048 + n0 + r32] = f2bf(acc[r]);
        }, lds);
    }
    if constexpr (s == 10) phase_topk_naive(P, l, sm);
}

__device__ __forceinline__ void layer_phase_dyn(const Params& P, int l, int s, char* sm) {
    switch (s) {
    case 0: layer_phase<0>(P, l, sm); break; case 1: layer_phase<1>(P, l, sm); break; case 2: layer_phase<2>(P, l, sm); break;
    case 3: layer_phase<3>(P, l, sm); break; case 4: layer_phase<4>(P, l, sm); break; case 5: layer_phase<5>(P, l, sm); break;
    case 6: layer_phase<6>(P, l, sm); break; case 7: layer_phase<7>(P, l, sm); break; case 8: layer_phase<8>(P, l, sm); break;
    case 9: layer_phase<9>(P, l, sm); break; case 10: layer_phase<10>(P, l, sm); break; default: phase_gather_naive(P, l); break;
    }
}
#if !ONE_LAUNCH
__global__ void __launch_bounds__(NTHREADS, 2) k_phase(Params P, int ph) {
    __shared__ __attribute__((aligned(16))) char sm[GEMM_LDS];
    if (ph == 0) { phase_prep(P); return; }
    layer_phase_dyn(P, (ph - 1) / (PH_PER_LAYER + 1), (ph - 1) % (PH_PER_LAYER + 1), sm);
}
#else
#define GSYNC() grid.sync()
__global__ void __launch_bounds__(NTHREADS, 2) k_all(Params P) {
    __shared__ __attribute__((aligned(16))) char sm[GEMM_LDS];
    cg::grid_group grid = cg::this_grid();
    { const Params Q = launder(P); phase_prep(Q); } GSYNC();
    for (int l = 0; l < DEPTH; ++l) {
#define LP(s) { const Params Q = launder(P); layer_phase<s>(Q, l, sm); }
        LP(0); GSYNC();
        LP(1); GSYNC();
        LP(2); GSYNC();
        LP(3);
        LP(4); GSYNC();
        LP(6); GSYNC();
        LP(7); GSYNC();
        LP(8); GSYNC();
        LP(9); GSYNC();
        LP(10); GSYNC();
        { const Params Q = launder(P); phase_gather_naive(Q, l); } GSYNC();
    }
}
#endif

extern "C" void kernel_launch(void* const* d_in, const int* in_sizes, int n_in, void* d_out, int out_size, void* d_ws, size_t ws_size, hipStream_t stream) {
    static int grid = 0;
    if (grid == 0) {
        if (n_in != 18 || out_size != T * D || ws_size < WS_END) { fprintf(stderr, "kernel_launch: bad sizes n_in %d out %d ws %zu need %zu\n", n_in, out_size, ws_size, (size_t)WS_END); grid = -1; return; }
        int dev = 0, cus = 0, per_cu = 0;
        hipGetDevice(&dev);
        hipDeviceGetAttribute(&cus, hipDeviceAttributeMultiprocessorCount, dev);
#if ONE_LAUNCH
        hipOccupancyMaxActiveBlocksPerMultiprocessor(&per_cu, (const void*)k_all, NTHREADS, 0);
#else
        hipOccupancyMaxActiveBlocksPerMultiprocessor(&per_cu, (const void*)k_phase, NTHREADS, 0);
#endif
        if (per_cu > 2) per_cu = 2;
        if (per_cu < 1) { fprintf(stderr, "kernel_launch: occupancy query says %d\n", per_cu); grid = -1; return; }
        grid = cus * per_cu;
    }
    if (grid < 0) return;
    Params p{};
    p.x = (const float*)d_in[0]; p.norm_mix = (const float*)d_in[1]; p.w_in = (const float*)d_in[2]; p.conv_w = (const float*)d_in[3];
    p.pool_w = (const float*)d_in[4]; p.pool_scale = (const float*)d_in[5]; p.q_norm = (const float*)d_in[6]; p.w_uq = (const float*)d_in[7];
    p.kv_norm = (const float*)d_in[8]; p.w_uk = (const float*)d_in[9]; p.w_uv = (const float*)d_in[10]; p.w_out = (const float*)d_in[11];
    p.norm_ffn = (const float*)d_in[12]; p.peer_wq = (const float*)d_in[13]; p.peer_subkeys = (const float*)d_in[14]; p.peer_u = (const float*)d_in[15];
    p.peer_v = (const float*)d_in[16]; p.norm_final = (const float*)d_in[17];
    p.out = (float*)d_out; p.ws = (unsigned char*)d_ws;
#if ONE_LAUNCH
    void* args[] = {&p};
    hipError_t e = hipLaunchCooperativeKernel((const void*)k_all, dim3(grid), dim3(NTHREADS), args, 0, stream);
    if (e != hipSuccess) fprintf(stderr, "cooperative launch failed: %s (grid %d)\n", hipGetErrorString(e), grid);
#else
    for (int ph = 0; ph < 1 + DEPTH * (PH_PER_LAYER + 1); ++ph) hipLaunchKernelGGL(k_phase, dim3(grid), dim3(NTHREADS), 0, stream, p, ph);
#endif
}
```

```cpp
#include <hip/hip_runtime.h>
#include <hip/hip_cooperative_groups.h>
#include <cstdio>
#include <cstdint>
namespace cg = cooperative_groups;

#ifndef ATTN_MFMA
#define ATTN_MFMA 1
#endif
#ifndef ONE_LAUNCH
#define ONE_LAUNCH 1
#endif

constexpr int NB = 4, S = 8192, T = NB * S, D = 1024, DEPTH = 2;
constexpr int DIN = 1696, DINP = 1792;
constexpr int C_BG = 0, C_CG = 256, C_HC = 512, C_HP = 768, C_CQ = 1024, C_CKV = 1408, C_KR = 1664;
constexpr int QR = 384, KVR = 256, NH = 8, DQK = 96, DV = 64;
constexpr int PH = 8, NKEY = 128, NEXP = NKEY * NKEY, TOPK = 16, HK = PH * TOPK;
constexpr float EPS = 1e-6f;

typedef unsigned short bf16;

constexpr size_t MB = 1024 * 1024;
constexpr size_t WS_CTL   = 0;
constexpr size_t WS_ROPE  = 64 * 1024;
constexpr size_t WS_WIN   = WS_ROPE + (size_t)S * 16 * 2 * 4;
constexpr size_t WS_WUQ   = WS_WIN + (size_t)DEPTH * DINP * D * 2;
constexpr size_t WS_WUKV  = WS_WUQ + (size_t)DEPTH * 768 * QR * 2;
constexpr size_t WS_WOUT  = WS_WUKV + (size_t)DEPTH * 1024 * KVR * 2;
constexpr size_t WS_WPQ   = WS_WOUT + (size_t)DEPTH * D * D * 2;
constexpr size_t WS_XN    = ((WS_WPQ + (size_t)DEPTH * 2048 * D * 2 + 4095) / 4096) * 4096;
constexpr size_t WS_PROJ  = WS_XN + (size_t)T * D * 2;
constexpr size_t WS_Q     = WS_PROJ + (size_t)T * DINP * 2;
constexpr size_t WS_K     = WS_Q + (size_t)T * NH * DQK * 2;
constexpr size_t WS_V     = WS_K + (size_t)T * NH * DQK * 2;
constexpr size_t WS_EXP   = WS_V + (size_t)T * NH * DV * 2;
constexpr size_t WS_GATE  = WS_EXP + (size_t)T * HK * 4;
constexpr size_t WS_END   = WS_GATE + (size_t)T * HK * 4;
constexpr size_t WS_QP    = WS_PROJ;
static_assert((size_t)T * 2048 * 2 <= WS_K - WS_PROJ, "QP alias");

struct Params {
    const float* x; const float* norm_mix; const float* w_in; const float* conv_w; const float* pool_w; const float* pool_scale;
    const float* q_norm; const float* w_uq; const float* kv_norm; const float* w_uk; const float* w_uv; const float* w_out;
    const float* norm_ffn; const float* peer_wq; const float* peer_subkeys; const float* peer_u; const float* peer_v; const float* norm_final;
    float* out; unsigned char* ws;
};

__device__ __forceinline__ bf16 f2bf(float f) { unsigned u = __float_as_uint(f); u += 0x7fffu + ((u >> 16) & 1u); return (bf16)(u >> 16); }
__device__ __forceinline__ float bf2f(bf16 h) { return __uint_as_float(((unsigned)h) << 16); }
__device__ __forceinline__ float bflo(unsigned u) { return __uint_as_float(u << 16); }
__device__ __forceinline__ float bfhi(unsigned u) { return __uint_as_float(u & 0xffff0000u); }
__device__ __forceinline__ unsigned pack2(float a, float b) { return (unsigned)f2bf(a) | ((unsigned)f2bf(b) << 16); }
__device__ __forceinline__ float wave_sum(float v) {
#pragma unroll
    for (int m = 32; m >= 1; m >>= 1) v += __shfl_xor(v, m, 64);
    return v;
}
__device__ __forceinline__ float gelu_exact(float x) { return 0.5f * x * (1.f + erff(x * 0.70710678118654752f)); }

#define NTHREADS 256
__device__ __forceinline__ int tidx() { int t = (int)__builtin_amdgcn_workitem_id_x(); asm volatile("" : "+v"(t)); return t; }
__device__ __forceinline__ int gwave() { return blockIdx.x * (NTHREADS / 64) + (tidx() >> 6); }
__device__ __forceinline__ int nwave() { return gridDim.x * (NTHREADS / 64); }
__device__ __forceinline__ size_t gtid() { return (size_t)blockIdx.x * NTHREADS + tidx(); }
__device__ __forceinline__ size_t gnth() { return (size_t)gridDim.x * NTHREADS; }


__device__ __forceinline__ Params launder(const Params& P) {
    Params Q = P;
    asm volatile("" : "+s"(Q.x), "+s"(Q.norm_mix), "+s"(Q.w_in), "+s"(Q.conv_w), "+s"(Q.pool_w), "+s"(Q.pool_scale), "+s"(Q.q_norm), "+s"(Q.w_uq), "+s"(Q.kv_norm), "+s"(Q.w_uk));
    asm volatile("" : "+s"(Q.w_uv), "+s"(Q.w_out), "+s"(Q.norm_ffn), "+s"(Q.peer_wq), "+s"(Q.peer_subkeys), "+s"(Q.peer_u), "+s"(Q.peer_v), "+s"(Q.norm_final), "+s"(Q.out), "+s"(Q.ws));
    return Q;
}

template <class AL, class BL, class EP>
__device__ __forceinline__ void gemm_naive(int M, int N, int K, AL aload, BL bload, EP epi, float* sm) {
    float (*As)[68] = (float (*)[68])sm;
    float (*Bs)[68] = (float (*)[68])(sm + 16 * 68);
    const int tid = tidx(), tx = tid & 15, ty = tid >> 4;
    const int tilesN = (N + 63) / 64, tilesM = M / 64;
    for (int tile = blockIdx.x; tile < tilesM * tilesN; tile += gridDim.x) {
        const int tm = tile / tilesN, tn = tile % tilesN;
        const int row0 = tm * 64, col0 = tn * 64;
        float acc[4][4];
#pragma unroll
        for (int i = 0; i < 4; ++i)
#pragma unroll
            for (int j = 0; j < 4; ++j) acc[i][j] = 0.f;
        for (int k0 = 0; k0 < K; k0 += 16) {
            {
                const int r = tid >> 2, kk = (tid & 3) * 4;
#pragma unroll
                for (int i = 0; i < 4; ++i) As[kk + i][r] = aload(row0 + r, k0 + kk + i);
            }
            {
                const int kk = tid >> 4, c = (tid & 15) * 4;
#pragma unroll
                for (int j = 0; j < 4; ++j) { const int col = col0 + c + j; Bs[kk][c + j] = (col < N) ? bload(k0 + kk, col) : 0.f; }
            }
            __syncthreads();
#pragma unroll
            for (int kk = 0; kk < 16; ++kk) {
                float a[4], b[4];
#pragma unroll
                for (int i = 0; i < 4; ++i) a[i] = As[kk][ty * 4 + i];
#pragma unroll
                for (int j = 0; j < 4; ++j) b[j] = Bs[kk][tx * 4 + j];
#pragma unroll
                for (int i = 0; i < 4; ++i)
#pragma unroll
                    for (int j = 0; j < 4; ++j) acc[i][j] = fmaf(a[i], b[j], acc[i][j]);
            }
            __syncthreads();
        }
#pragma unroll
        for (int i = 0; i < 4; ++i)
#pragma unroll
            for (int j = 0; j < 4; ++j) { const int col = col0 + tx * 4 + j; if (col < N) epi(row0 + ty * 4 + i, col, acc[i][j]); }
    }
}


typedef __attribute__((ext_vector_type(8))) short bf16x8;
typedef __attribute__((ext_vector_type(16))) float f32x16;
#define MFMA32(a, b, c) __builtin_amdgcn_mfma_f32_32x32x16_bf16(a, b, c, 0, 0, 0)
__device__ __forceinline__ int crow(int r, int hi) { return (r & 3) + 8 * (r >> 2) + 4 * hi; }
constexpr int G_LDT = 144;
constexpr int G_OPB = 128 * G_LDT;
constexpr int G_BUF = 2 * G_OPB;
constexpr int GEMM_LDS = 2 * G_BUF;

template <class EPI>
__device__ __forceinline__ void gemm_mfma(const bf16* __restrict__ A, int lda, const bf16* __restrict__ Bt, int ldb, int M, int N, int K, EPI epi, char* lds) {
    const int tid = tidx(), lane = tid & 63, w = tid >> 6, r32 = lane & 31, hi = lane >> 5;
    const int wm = w >> 1, wn = w & 1;
    const int tilesN = N / 128, tilesM = M / 128, nk = K / 64;
    const int srow = tid >> 3, sch = tid & 7;
    for (int tile = blockIdx.x; tile < tilesM * tilesN; tile += gridDim.x) {
        const int tm = tile / tilesN, tn = tile % tilesN;
        const bf16* Ag = A + (size_t)(tm * 128 + srow) * lda + sch * 8;
        const bf16* Bg = Bt + (size_t)(tn * 128 + srow) * ldb + sch * 8;
        f32x16 acc[2][2];
#pragma unroll
        for (int i = 0; i < 2; ++i)
#pragma unroll
            for (int j = 0; j < 2; ++j)
#pragma unroll
                for (int r = 0; r < 16; ++r) acc[i][j][r] = 0.f;
        uint4 ra0, ra1, ra2, ra3, rb0, rb1, rb2, rb3;
#define G_LOAD(kofs) do { \
        ra0 = *(const uint4*)(Ag + (kofs)); ra1 = *(const uint4*)(Ag + (size_t)32 * lda + (kofs)); ra2 = *(const uint4*)(Ag + (size_t)64 * lda + (kofs)); ra3 = *(const uint4*)(Ag + (size_t)96 * lda + (kofs)); \
        rb0 = *(const uint4*)(Bg + (kofs)); rb1 = *(const uint4*)(Bg + (size_t)32 * ldb + (kofs)); rb2 = *(const uint4*)(Bg + (size_t)64 * ldb + (kofs)); rb3 = *(const uint4*)(Bg + (size_t)96 * ldb + (kofs)); } while (0)
        G_LOAD(0);
        for (int kt = 0; kt < nk; ++kt) {
            char* bA = lds + (kt & 1) * G_BUF; char* bB = bA + G_OPB;
            {
                char* wa = bA + srow * G_LDT + sch * 16; char* wb = bB + srow * G_LDT + sch * 16;
                *(uint4*)(wa) = ra0; *(uint4*)(wa + 32 * G_LDT) = ra1; *(uint4*)(wa + 64 * G_LDT) = ra2; *(uint4*)(wa + 96 * G_LDT) = ra3;
                *(uint4*)(wb) = rb0; *(uint4*)(wb + 32 * G_LDT) = rb1; *(uint4*)(wb + 64 * G_LDT) = rb2; *(uint4*)(wb + 96 * G_LDT) = rb3;
            }
            __syncthreads();
            if (kt + 1 < nk) G_LOAD((kt + 1) * 64);
            const char* pa = bA + (wm * 64 + r32) * G_LDT + hi * 16;
            const char* pb = bB + (wn * 64 + r32) * G_LDT + hi * 16;
#pragma unroll
            for (int ks = 0; ks < 4; ++ks) {
                const bf16x8 a0 = *(const bf16x8*)(pa + ks * 32), a1 = *(const bf16x8*)(pa + 32 * G_LDT + ks * 32);
                const bf16x8 b0 = *(const bf16x8*)(pb + ks * 32), b1 = *(const bf16x8*)(pb + 32 * G_LDT + ks * 32);
                acc[0][0] = MFMA32(a0, b0, acc[0][0]); acc[0][1] = MFMA32(a0, b1, acc[0][1]);
                acc[1][0] = MFMA32(a1, b0, acc[1][0]); acc[1][1] = MFMA32(a1, b1, acc[1][1]);
            }
        }
#pragma unroll
        for (int i = 0; i < 2; ++i)
#pragma unroll
            for (int j = 0; j < 2; ++j) epi(tm * 128 + wm * 64 + i * 32, tn * 128 + wn * 64 + j * 32, acc[i][j], r32, hi);
        __syncthreads();
    }
}

__device__ __forceinline__ void transpose_bf16(const float* __restrict__ W, bf16* __restrict__ Wt, int K, int N, int Npad) {
    const size_t tot = (size_t)Npad * K;
    for (size_t i = gtid(); i < tot; i += gnth()) {
        const int n = (int)(i / K), k = (int)(i % K);
        Wt[i] = (n < N) ? f2bf(W[(size_t)k * N + n]) : (bf16)0;
    }
}
__device__ __forceinline__ void phase_prep(const Params& P) {
    unsigned char* ws = P.ws;
    for (int l = 0; l < DEPTH; ++l) {
        transpose_bf16(P.w_in + (size_t)l * D * DIN, (bf16*)(ws + WS_WIN) + (size_t)l * DINP * D, D, DIN, DINP);
        transpose_bf16(P.w_uq + (size_t)l * QR * 768, (bf16*)(ws + WS_WUQ) + (size_t)l * 768 * QR, QR, 768, 768);
        transpose_bf16(P.w_uk + (size_t)l * KVR * 512, (bf16*)(ws + WS_WUKV) + (size_t)l * 1024 * KVR, KVR, 512, 512);
        transpose_bf16(P.w_uv + (size_t)l * KVR * 512, (bf16*)(ws + WS_WUKV) + (size_t)l * 1024 * KVR + (size_t)512 * KVR, KVR, 512, 512);
        transpose_bf16(P.w_out + (size_t)l * D * D, (bf16*)(ws + WS_WOUT) + (size_t)l * D * D, D, D, D);
        transpose_bf16(P.peer_wq + (size_t)l * D * 2048, (bf16*)(ws + WS_WPQ) + (size_t)l * 2048 * D, D, 2048, 2048);
    }
    float* rope = (float*)(ws + WS_ROPE);
    for (size_t i = gtid(); i < (size_t)S * 16; i += gnth()) {
        const int s = (int)(i >> 4), f = (int)(i & 15);
        const double inv = pow(10000.0, -(double)f / 16.0);
        const double ang = (double)s * inv;
        rope[2 * i] = (float)cos(ang); rope[2 * i + 1] = (float)sin(ang);
    }
}

__device__ __forceinline__ void phase_norm(const float* __restrict__ h, const float* __restrict__ g, bf16* __restrict__ xn) {
    const int lane = tidx() & 63;
    for (int t = gwave(); t < T; t += nwave()) {
        const float4* hr = (const float4*)(h + (size_t)t * D);
        float4 v[4]; float ss = 0.f;
#pragma unroll
        for (int j = 0; j < 4; ++j) { v[j] = hr[j * 64 + lane]; ss += v[j].x * v[j].x + v[j].y * v[j].y + v[j].z * v[j].z + v[j].w * v[j].w; }
        ss = wave_sum(ss);
        const float r = rsqrtf(ss * (1.f / D) + EPS);
#pragma unroll
        for (int j = 0; j < 4; ++j) {
            const float4 gg = ((const float4*)g)[j * 64 + lane];
            uint2 o; o.x = pack2(v[j].x * r * gg.x, v[j].y * r * gg.y); o.y = pack2(v[j].z * r * gg.z, v[j].w * r * gg.w);
            ((uint2*)(xn + (size_t)t * D))[j * 64 + lane] = o;
        }
    }
}

__device__ __forceinline__ void phase_mixprep(const Params& P, int l) {
    unsigned char* ws = P.ws;
    bf16* proj = (bf16*)(ws + WS_PROJ);
    bf16* Y = (bf16*)(ws + WS_XN);
    bf16* Kb = (bf16*)(ws + WS_K);
    const float* rope = (const float*)(ws + WS_ROPE);
    const float* qn = P.q_norm + l * QR; const float* kvn = P.kv_norm + l * KVR;
    const float* cw = P.conv_w + (size_t)l * 3 * 256;
    const float* pw = P.pool_w + (size_t)l * 4 * 64 * 64;
    const float* psc = P.pool_scale + l * 256;
    const int lane = tidx() & 63;
    for (int t = gwave(); t < T; t += nwave()) {
        const int b = t / S, s = t % S;
        bf16* pr = proj + (size_t)t * DINP;
        {
            float v[6]; float ss = 0.f;
#pragma unroll
            for (int j = 0; j < 6; ++j) { v[j] = bf2f(pr[C_CQ + j * 64 + lane]); ss += v[j] * v[j]; }
            ss = wave_sum(ss);
            const float r = rsqrtf(ss * (1.f / QR) + EPS);
#pragma unroll
            for (int j = 0; j < 6; ++j) pr[C_CQ + j * 64 + lane] = f2bf(v[j] * r * qn[j * 64 + lane]);
        }
        {
            float v[4]; float ss = 0.f;
#pragma unroll
            for (int j = 0; j < 4; ++j) { v[j] = bf2f(pr[C_CKV + j * 64 + lane]); ss += v[j] * v[j]; }
            ss = wave_sum(ss);
            const float r = rsqrtf(ss * (1.f / KVR) + EPS);
#pragma unroll
            for (int j = 0; j < 4; ++j) pr[C_CKV + j * 64 + lane] = f2bf(v[j] * r * kvn[j * 64 + lane]);
        }
        if (lane < 16) {
            const float x1 = bf2f(pr[C_KR + lane]), x2 = bf2f(pr[C_KR + 16 + lane]);
            const float c = rope[(s * 16 + lane) * 2], sn = rope[(s * 16 + lane) * 2 + 1];
            const bf16 o1 = f2bf(x1 * c - x2 * sn), o2 = f2bf(x2 * c + x1 * sn);
#pragma unroll
            for (int h = 0; h < NH; ++h) {
                bf16* kr = Kb + ((size_t)(b * NH + h) * S + s) * DQK;
                kr[64 + lane] = o1; kr[80 + lane] = o2;
            }
        }
#pragma unroll
        for (int r = 0; r < 4; ++r) {
            const int c = r * 64 + lane;
            float acc = 0.f;
#pragma unroll
            for (int j = 0; j < 3; ++j) {
                const int sp = s - 2 + j;
                if (sp >= 0) {
                    const bf16* pp = proj + (size_t)(t - 2 + j) * DINP;
                    acc += cw[j * 256 + c] * (bf2f(pp[C_CG + c]) * bf2f(pp[C_HC + c]));
                }
            }
            Y[(size_t)t * D + c] = f2bf(bf2f(pr[C_BG + c]) * acc);
        }
        const int wins[4] = {2, 4, 8, 16};
#pragma unroll
        for (int g = 0; g < 4; ++g) {
            const int w = wins[g];
            const int lo = (s + 1 - w) > 0 ? (s + 1 - w) : 0;
            const int cnt = s + 1 - lo;
            float sum = 0.f;
            for (int sp = lo; sp <= s; ++sp) sum += bf2f(proj[(size_t)(b * S + sp) * DINP + C_HP + g * 64 + lane]);
            const float pooled = sum / (float)cnt - bf2f(pr[C_HP + g * 64 + lane]);
            float m = 0.f;
            for (int c = 0; c < 64; ++c) m = fmaf(__shfl(pooled, c, 64), pw[(g * 64 + c) * 64 + lane], m);
            Y[(size_t)t * D + 256 + g * 64 + lane] = f2bf(m * psc[g * 64 + lane]);
        }
    }
}

__device__ __forceinline__ void phase_qrope(const Params& P) {
    bf16* Qb = (bf16*)(P.ws + WS_Q);
    const float* rope = (const float*)(P.ws + WS_ROPE);
    const size_t tot = (size_t)T * NH * 16;
    for (size_t i = gtid(); i < tot; i += gnth()) {
        const int f = (int)(i & 15); const size_t row = i >> 4;
        const int s = (int)(row % S);
        bf16* q = Qb + row * DQK;
        const float x1 = bf2f(q[64 + f]), x2 = bf2f(q[80 + f]);
        const float c = rope[(s * 16 + f) * 2], sn = rope[(s * 16 + f) * 2 + 1];
        q[64 + f] = f2bf(x1 * c - x2 * sn); q[80 + f] = f2bf(x2 * c + x1 * sn);
    }
}

__device__ __forceinline__ void phase_attn_naive(const Params& P) {
    const bf16* Qb = (const bf16*)(P.ws + WS_Q);
    const bf16* Kb = (const bf16*)(P.ws + WS_K);
    const bf16* Vb = (const bf16*)(P.ws + WS_V);
    bf16* Y = (bf16*)(P.ws + WS_XN);
    const int lane = tidx() & 63, qr = lane & 31, half = lane >> 5;
    const int gw = gwave(), nw = nwave();
    const int total = NB * NH * (S / 32);
    for (int pass = 0; pass * nw < total; ++pass) {
        const int u = (pass & 1) ? ((pass + 1) * nw - 1 - gw) : (pass * nw + gw);
        if (u >= total) continue;
        const int qblk = (S / 32 - 1) - (u >> 5), bh = u & 31;
        const int qpos = qblk * 32 + qr;
        unsigned q[DQK / 2];
        {
            const uint4* qp = (const uint4*)(Qb + ((size_t)bh * S + qpos) * DQK);
#pragma unroll
            for (int c = 0; c < 12; ++c) { const uint4 v = qp[c]; q[c * 4 + 0] = v.x; q[c * 4 + 1] = v.y; q[c * 4 + 2] = v.z; q[c * 4 + 3] = v.w; }
        }
        float o[32];
#pragma unroll
        for (int d = 0; d < 32; ++d) o[d] = 0.f;
        float m = -3.0e38f, lsum = 0.f;
        const int kmax = qblk * 32 + 31;
        const bf16* Kp = Kb + (size_t)bh * S * DQK;
        const bf16* Vp = Vb + (size_t)bh * S * DV + half * 32;
        for (int j = 0; j <= kmax; ++j) {
            const uint4* kr = (const uint4*)(Kp + (size_t)j * DQK);
            float sc = 0.f;
#pragma unroll
            for (int c = 0; c < 12; ++c) {
                const uint4 v = kr[c];
                sc = fmaf(bflo(q[c * 4 + 0]), bflo(v.x), sc); sc = fmaf(bfhi(q[c * 4 + 0]), bfhi(v.x), sc);
                sc = fmaf(bflo(q[c * 4 + 1]), bflo(v.y), sc); sc = fmaf(bfhi(q[c * 4 + 1]), bfhi(v.y), sc);
                sc = fmaf(bflo(q[c * 4 + 2]), bflo(v.z), sc); sc = fmaf(bfhi(q[c * 4 + 2]), bfhi(v.z), sc);
                sc = fmaf(bflo(q[c * 4 + 3]), bflo(v.w), sc); sc = fmaf(bfhi(q[c * 4 + 3]), bfhi(v.w), sc);
            }
            if (j <= qpos) {
                const float mn = fmaxf(m, sc);
                const float alpha = exp2f(m - mn);
                const float p = exp2f(sc - mn);
                lsum = lsum * alpha + p; m = mn;
                const uint4* vr = (const uint4*)(Vp + (size_t)j * DV);
#pragma unroll
                for (int c = 0; c < 4; ++c) {
                    const uint4 v = vr[c];
                    o[c * 8 + 0] = fmaf(p, bflo(v.x), o[c * 8 + 0] * alpha); o[c * 8 + 1] = fmaf(p, bfhi(v.x), o[c * 8 + 1] * alpha);
                    o[c * 8 + 2] = fmaf(p, bflo(v.y), o[c * 8 + 2] * alpha); o[c * 8 + 3] = fmaf(p, bfhi(v.y), o[c * 8 + 3] * alpha);
                    o[c * 8 + 4] = fmaf(p, bflo(v.z), o[c * 8 + 4] * alpha); o[c * 8 + 5] = fmaf(p, bfhi(v.z), o[c * 8 + 5] * alpha);
                    o[c * 8 + 6] = fmaf(p, bflo(v.w), o[c * 8 + 6] * alpha); o[c * 8 + 7] = fmaf(p, bfhi(v.w), o[c * 8 + 7] * alpha);
                }
            }
        }
        const float inv = 1.f / lsum;
        const int b = bh >> 3, h = bh & 7;
        uint4* yo = (uint4*)(Y + ((size_t)(b * S + qpos)) * D + 512 + h * 64 + half * 32);
#pragma unroll
        for (int c = 0; c < 4; ++c) {
            uint4 v;
            v.x = pack2(o[c * 8 + 0] * inv, o[c * 8 + 1] * inv); v.y = pack2(o[c * 8 + 2] * inv, o[c * 8 + 3] * inv);
            v.z = pack2(o[c * 8 + 4] * inv, o[c * 8 + 5] * inv); v.w = pack2(o[c * 8 + 6] * inv, o[c * 8 + 7] * inv);
            yo[c] = v;
        }
    }
}


typedef short v4i16_t __attribute__((ext_vector_type(4)));
typedef __attribute__((address_space(3))) v4i16_t* lds_v4p;
__device__ __forceinline__ unsigned cvtpk(float lo, float hi) { unsigned r; asm("v_cvt_pk_bf16_f32 %0, %1, %2" : "=v"(r) : "v"(lo), "v"(hi)); return r; }
__device__ __forceinline__ v4i16_t vtr(const char* p) { return __builtin_amdgcn_ds_read_tr16_b64_v4i16((lds_v4p)p); }
constexpr int A_KP = 208, A_VP = 192;
constexpr int A_KB = 64 * A_KP, A_VB = 64 * A_VP, A_BUF = A_KB + A_VB, ATTN_LDS = 2 * A_BUF;
static_assert(ATTN_LDS <= GEMM_LDS, "attention LDS");

__device__ __forceinline__ void attn_unit(const bf16* __restrict__ Qb, const bf16* __restrict__ Kb, const bf16* __restrict__ Vb, bf16* __restrict__ Y, int bh, int qblk, char* lds) {
    const int tid = tidx(), lane = tid & 63, w = tid >> 6, r32 = lane & 31, hi = lane >> 5;
    const int q0 = qblk * 128, qw0 = q0 + w * 32;
    const int NT = 2 * qblk + 2;
    bf16x8 qf[6];
    {
        const bf16* qp = Qb + ((size_t)bh * S + qw0 + r32) * DQK + hi * 8;
#pragma unroll
        for (int ks = 0; ks < 6; ++ks) qf[ks] = *(const bf16x8*)(qp + ks * 16);
    }
    f32x16 o0, o1;
#pragma unroll
    for (int r = 0; r < 16; ++r) { o0[r] = 0.f; o1[r] = 0.f; }
    float m = -1e30f, lsum = 0.f;
    const char* Kg = (const char*)(Kb + (size_t)bh * S * DQK) + tid * 16;
    const char* Vg = (const char*)(Vb + (size_t)bh * S * DV) + tid * 16;
    const int kl0 = (tid / 12) * A_KP + (tid % 12) * 16, kl1 = ((tid + 256) / 12) * A_KP + ((tid + 256) % 12) * 16, kl2 = ((tid + 512) / 12) * A_KP + ((tid + 512) % 12) * 16;
    const int vl0 = (tid >> 3) * A_VP + (tid & 7) * 16, vl1 = vl0 + 32 * A_VP;
    uint4 k0, k1, k2, v0, v1;
#define A_LOAD(t) do { const char* kg = Kg + (size_t)(t) * (64 * 192); const char* vg = Vg + (size_t)(t) * (64 * 128); \
        k0 = *(const uint4*)(kg); k1 = *(const uint4*)(kg + 4096); k2 = *(const uint4*)(kg + 8192); v0 = *(const uint4*)(vg); v1 = *(const uint4*)(vg + 4096); } while (0)
    A_LOAD(0);
    const int pvo = (4 * hi + ((lane & 15) >> 2)) * A_VP + (16 * ((lane >> 4) & 1) + 4 * (lane & 3)) * 2;
    for (int t = 0; t < NT; ++t) {
        char* bK = lds + (t & 1) * A_BUF; char* bV = bK + A_KB;
        *(uint4*)(bK + kl0) = k0; *(uint4*)(bK + kl1) = k1; *(uint4*)(bK + kl2) = k2; *(uint4*)(bV + vl0) = v0; *(uint4*)(bV + vl1) = v1;
        __syncthreads();
        if (t + 1 < NT) A_LOAD(t + 1);
        const int kt0 = t * 64;
        if (kt0 <= qw0) {
            f32x16 s0, s1;
#pragma unroll
            for (int r = 0; r < 16; ++r) { s0[r] = 0.f; s1[r] = 0.f; }
            const char* pk = bK + r32 * A_KP + hi * 16;
#pragma unroll
            for (int ks = 0; ks < 6; ++ks) {
                const bf16x8 a0 = *(const bf16x8*)(pk + ks * 32), a1 = *(const bf16x8*)(pk + 32 * A_KP + ks * 32);
                s0 = MFMA32(a0, qf[ks], s0); s1 = MFMA32(a1, qf[ks], s1);
            }
            if (kt0 + 63 > qw0) {
                const int qrow = qw0 + r32;
#pragma unroll
                for (int r = 0; r < 16; ++r) { const int key = kt0 + crow(r, hi); if (key > qrow) s0[r] = -INFINITY; if (key + 32 > qrow) s1[r] = -INFINITY; }
            }
            float mx = fmaxf(s0[0], s1[0]);
#pragma unroll
            for (int r = 1; r < 16; ++r) mx = fmaxf(mx, fmaxf(s0[r], s1[r]));
            mx = fmaxf(mx, __shfl_xor(mx, 32, 64));
            const float mn = fmaxf(m, mx);
            const float alpha = __builtin_amdgcn_exp2f(m - mn);
            m = mn;
            float ps = 0.f;
#pragma unroll
            for (int r = 0; r < 16; ++r) { s0[r] = __builtin_amdgcn_exp2f(s0[r] - mn); s1[r] = __builtin_amdgcn_exp2f(s1[r] - mn); ps += s0[r] + s1[r]; }
            lsum = lsum * alpha + ps;
#pragma unroll
            for (int r = 0; r < 16; ++r) { o0[r] *= alpha; o1[r] *= alpha; }
            union { unsigned u[4]; bf16x8 v; } p00, p01, p10, p11;
#pragma unroll
            for (int j = 0; j < 4; ++j) { p00.u[j] = cvtpk(s0[2 * j], s0[2 * j + 1]); p01.u[j] = cvtpk(s0[8 + 2 * j], s0[9 + 2 * j]); p10.u[j] = cvtpk(s1[2 * j], s1[2 * j + 1]); p11.u[j] = cvtpk(s1[8 + 2 * j], s1[9 + 2 * j]); }
            const char* pv = bV + pvo;
#define A_PV(pf, kofs) do { \
            { const v4i16_t lo = vtr(pv + (kofs) * A_VP), hh = vtr(pv + ((kofs) + 8) * A_VP); const bf16x8 vf = {lo[0], lo[1], lo[2], lo[3], hh[0], hh[1], hh[2], hh[3]}; o0 = MFMA32(vf, pf.v, o0); } \
            { const v4i16_t lo = vtr(pv + (kofs) * A_VP + 64), hh = vtr(pv + ((kofs) + 8) * A_VP + 64); const bf16x8 vf = {lo[0], lo[1], lo[2], lo[3], hh[0], hh[1], hh[2], hh[3]}; o1 = MFMA32(vf, pf.v, o1); } } while (0)
            A_PV(p00, 0); A_PV(p01, 16); A_PV(p10, 32); A_PV(p11, 48);
        }
    }
    lsum += __shfl_xor(lsum, 32, 64);
    const float inv = 1.f / lsum;
    const int b = bh >> 3, h = bh & 7;
    bf16* yo = Y + (size_t)(b * S + qw0 + r32) * D + 512 + h * 64 + 4 * hi;
#pragma unroll
    for (int g = 0; g < 4; ++g) {
        uint2 a, c;
        a.x = cvtpk(o0[4 * g] * inv, o0[4 * g + 1] * inv); a.y = cvtpk(o0[4 * g + 2] * inv, o0[4 * g + 3] * inv);
        c.x = cvtpk(o1[4 * g] * inv, o1[4 * g + 1] * inv); c.y = cvtpk(o1[4 * g + 2] * inv, o1[4 * g + 3] * inv);
        *(uint2*)(yo + 8 * g) = a; *(uint2*)(yo + 32 + 8 * g) = c;
    }
    __syncthreads();
}
__device__ __forceinline__ void phase_attn(const Params& P, char* lds) {
    const bf16* Qb = (const bf16*)(P.ws + WS_Q);
    const bf16* Kb = (const bf16*)(P.ws + WS_K);
    const bf16* Vb = (const bf16*)(P.ws + WS_V);
    bf16* Y = (bf16*)(P.ws + WS_XN);
    for (int u = blockIdx.x; u < NB * NH * (S / 128); u += gridDim.x) {
        const int bh = u & 31, v = u >> 5;
        const int qblk = (v < 16) ? (63 - v) : (v < 32) ? (v - 16) : (v < 48) ? (79 - v) : (v - 32);
        attn_unit(Qb, Kb, Vb, Y, bh, qblk, lds);
    }
}

__device__ __forceinline__ void wave_argmax(float& bv, int& bi) {
#pragma unroll
    for (int m = 32; m >= 1; m >>= 1) {
        const float ov = __shfl_xor(bv, m, 64); const int oi = __shfl_xor(bi, m, 64);
        if (ov > bv || (ov == bv && oi < bi)) { bv = ov; bi = oi; }
    }
}
__device__ __forceinline__ void peer_half_top16(const float* __restrict__ skp, const float* qs, int, int lane, float& sp, int& ip) {
    const float NEG = -3.0e38f;
    float v0 = 0.f, v1 = 0.f;
    const float4* r0 = (const float4*)(skp + (size_t)lane * 128);
    const float4* r1 = (const float4*)(skp + (size_t)(lane + 64) * 128);
    for (int d = 0; d < 32; ++d) {
        const float4 a = r0[d], bq = r1[d];
        const float q0 = qs[d * 4 + 0], q1 = qs[d * 4 + 1], q2 = qs[d * 4 + 2], q3 = qs[d * 4 + 3];
        v0 = fmaf(q0, a.x, v0); v0 = fmaf(q1, a.y, v0); v0 = fmaf(q2, a.z, v0); v0 = fmaf(q3, a.w, v0);
        v1 = fmaf(q0, bq.x, v1); v1 = fmaf(q1, bq.y, v1); v1 = fmaf(q2, bq.z, v1); v1 = fmaf(q3, bq.w, v1);
    }
    sp = 0.f; ip = 0;
    for (int k = 0; k < TOPK; ++k) {
        float bv; int bi;
        if (v0 >= v1) { bv = v0; bi = lane; } else { bv = v1; bi = lane + 64; }
        wave_argmax(bv, bi);
        if (lane == k) { sp = bv; ip = bi; }
        if (bi == lane) v0 = NEG; else if (bi == lane + 64) v1 = NEG;
    }
}
__device__ __forceinline__ void phase_topk_naive(const Params& P, int l, float* sm) {
    const bf16* QP = (const bf16*)(P.ws + WS_QP);
    int* EXPp = (int*)(P.ws + WS_EXP);
    float* GATEp = (float*)(P.ws + WS_GATE);
    const float* sk = P.peer_subkeys + (size_t)l * 2 * NKEY * 128;
    const int lane = tidx() & 63, wv = tidx() >> 6;
    float* qs = sm + wv * 256;
    const float NEG = -3.0e38f;
    for (int u = gwave(); u < T * PH; u += nwave()) {
        const int t = u >> 3, h = u & 7;
        {
            const bf16* qp = QP + (size_t)t * 2048 + h * 256;
#pragma unroll
            for (int j = 0; j < 4; ++j) qs[j * 64 + lane] = bf2f(qp[j * 64 + lane]);
        }
        __builtin_amdgcn_s_waitcnt(0);
        __builtin_amdgcn_wave_barrier();
        float stop0, stop1; int itop0, itop1;
        peer_half_top16(sk, qs, 0, lane, stop0, itop0);
        peer_half_top16(sk + (size_t)NKEY * 128, qs + 128, 0, lane, stop1, itop1);
        __builtin_amdgcn_wave_barrier();
        float cv[4];
#pragma unroll
        for (int r = 0; r < 4; ++r) { const int c = lane + 64 * r; cv[r] = __shfl(stop0, c >> 4, 64) + __shfl(stop1, c & 15, 64); }
        float ts = 0.f; int ci = 0;
        for (int k = 0; k < TOPK; ++k) {
            float bv = cv[0]; int bi = lane;
#pragma unroll
            for (int r = 1; r < 4; ++r) if (cv[r] > bv) { bv = cv[r]; bi = lane + 64 * r; }
            wave_argmax(bv, bi);
            if (lane == k) { ts = bv; ci = bi; }
#pragma unroll
            for (int r = 0; r < 4; ++r) if (bi == lane + 64 * r) cv[r] = NEG;
        }
        const int e1 = __shfl(itop0, ci >> 4, 64), e2 = __shfl(itop1, ci & 15, 64);
        const float smax = __shfl(ts, 0, 64);
        float ex = (lane < 16) ? __expf(ts - smax) : 0.f;
        float den = ex;
#pragma unroll
        for (int m = 8; m >= 1; m >>= 1) den += __shfl_xor(den, m, 64);
        if (lane < 16) {
            EXPp[(size_t)t * HK + h * 16 + lane] = e1 * NKEY + e2;
            GATEp[(size_t)t * HK + h * 16 + lane] = ex / den;
        }
    }
}

__device__ __forceinline__ void phase_gather_naive(const Params& P, int l) {
    const bf16* XN = (const bf16*)(P.ws + WS_XN);
    const int* EXPp = (const int*)(P.ws + WS_EXP);
    const float* GATEp = (const float*)(P.ws + WS_GATE);
    const float* U = P.peer_u + (size_t)l * NEXP * D;
    const float* V = P.peer_v + (size_t)l * NEXP * D;
    const int lane = tidx() & 63;
    for (int t = gwave(); t < T; t += nwave()) {
        float4 xv[4];
#pragma unroll
        for (int j = 0; j < 4; ++j) {
            const uint2 r = ((const uint2*)(XN + (size_t)t * D))[j * 64 + lane];
            xv[j] = make_float4(bflo(r.x), bfhi(r.x), bflo(r.y), bfhi(r.y));
        }
        float4 acc[4];
#pragma unroll
        for (int j = 0; j < 4; ++j) acc[j] = make_float4(0.f, 0.f, 0.f, 0.f);
        for (int k = 0; k < HK; ++k) {
            const int e = EXPp[(size_t)t * HK + k];
            const float g = GATEp[(size_t)t * HK + k];
            const float4* ur = (const float4*)(U + (size_t)e * D);
            float d = 0.f;
#pragma unroll
            for (int j = 0; j < 4; ++j) { const float4 u = ur[j * 64 + lane]; d += xv[j].x * u.x + xv[j].y * u.y + xv[j].z * u.z + xv[j].w * u.w; }
            d = wave_sum(d);
            const float a = g * gelu_exact(d);
            const float4* vr = (const float4*)(V + (size_t)e * D);
#pragma unroll
            for (int j = 0; j < 4; ++j) { const float4 v = vr[j * 64 + lane]; acc[j].x = fmaf(a, v.x, acc[j].x); acc[j].y = fmaf(a, v.y, acc[j].y); acc[j].z = fmaf(a, v.z, acc[j].z); acc[j].w = fmaf(a, v.w, acc[j].w); }
        }
        float4* hr = (float4*)(P.out + (size_t)t * D);
        float ss = 0.f;
#pragma unroll
        for (int j = 0; j < 4; ++j) {
            const float4 hv = hr[j * 64 + lane];
            acc[j].x += hv.x; acc[j].y += hv.y; acc[j].z += hv.z; acc[j].w += hv.w;
            ss += acc[j].x * acc[j].x + acc[j].y * acc[j].y + acc[j].z * acc[j].z + acc[j].w * acc[j].w;
        }
        if (l == DEPTH - 1) {
            ss = wave_sum(ss);
            const float r = rsqrtf(ss * (1.f / D) + EPS);
#pragma unroll
            for (int j = 0; j < 4; ++j) {
                const float4 gg = ((const float4*)P.norm_final)[j * 64 + lane];
                hr[j * 64 + lane] = make_float4(acc[j].x * r * gg.x, acc[j].y * r * gg.y, acc[j].z * r * gg.z, acc[j].w * r * gg.w);
            }
        } else {
#pragma unroll
            for (int j = 0; j < 4; ++j) hr[j * 64 + lane] = acc[j];
        }
    }
}

constexpr int PH_PER_LAYER = 11;
constexpr int NPHASES = 1 + DEPTH * PH_PER_LAYER;

constexpr float QSCALE = 0.10206207261596575f * 1.4426950408889634f;
template <int s>
__device__ __forceinline__ void layer_phase(const Params& P, int l, char* lds) {
    unsigned char* ws = P.ws;
    float* sm = (float*)lds;
    bf16* XN = (bf16*)(ws + WS_XN);
    bf16* PROJ = (bf16*)(ws + WS_PROJ);
    const float* hin = (l == 0) ? P.x : P.out;
    if constexpr (s == 0) phase_norm(hin, P.norm_mix + l * D, XN);
    if constexpr (s == 1) {
        const bf16* W = (const bf16*)(ws + WS_WIN) + (size_t)l * DINP * D;
        gemm_mfma(XN, D, W, D, T, DINP, D, [&](int m0, int n0, const f32x16& acc, int r32, int hi) {
            const int n = n0 + r32;
            if (n < DIN) {
#pragma unroll
                for (int r = 0; r < 16; ++r) PROJ[(size_t)(m0 + crow(r, hi)) * DINP + n] = f2bf(acc[r]);
            }
        }, lds);
    }
    if constexpr (s == 2) phase_mixprep(P, l);
    if constexpr (s == 3) {
        const bf16* W = (const bf16*)(ws + WS_WUQ) + (size_t)l * 768 * QR;
        bf16* Qb = (bf16*)(ws + WS_Q);
        const float* rope = (const float*)(ws + WS_ROPE);
        gemm_mfma(PROJ + C_CQ, DINP, W, QR, T, 768, QR, [&](int m0, int n0, const f32x16& acc, int r32, int hi) {
            const int h = n0 / DQK, d0 = n0 % DQK;
            const int b = m0 / S, s0 = m0 % S;
            bf16* qb = Qb + ((size_t)(b * NH + h) * S + s0) * DQK + d0 + r32;
            if (d0 == 64) {
                const int f = r32 & 15;
#pragma unroll
                for (int r = 0; r < 16; ++r) {
                    const int sr = crow(r, hi);
                    const float v = acc[r], o = __shfl_xor(v, 16, 64);
                    const float2 cs = *(const float2*)(rope + ((size_t)(s0 + sr) * 16 + f) * 2);
                    const float res = (r32 < 16) ? (v * cs.x - o * cs.y) : (v * cs.x + o * cs.y);
                    qb[(size_t)sr * DQK] = f2bf(res * QSCALE);
                }
            } else {
#pragma unroll
                for (int r = 0; r < 16; ++r) qb[(size_t)crow(r, hi) * DQK] = f2bf(acc[r] * QSCALE);
            }
        }, lds);
    }
    if constexpr (s == 4) {
        const bf16* W = (const bf16*)(ws + WS_WUKV) + (size_t)l * 1024 * KVR;
        bf16* Kb = (bf16*)(ws + WS_K); bf16* Vb = (bf16*)(ws + WS_V);
        gemm_mfma(PROJ + C_CKV, DINP, W, KVR, T, 1024, KVR, [&](int m0, int n0, const f32x16& acc, int r32, int hi) {
            const int b = m0 / S, s0 = m0 % S;
            if (n0 < 512) {
                const int h = n0 >> 6, d = (n0 & 63) + r32;
                bf16* kb = Kb + ((size_t)(b * NH + h) * S + s0) * DQK + d;
#pragma unroll
                for (int r = 0; r < 16; ++r) kb[(size_t)crow(r, hi) * DQK] = f2bf(acc[r]);
            } else {
                const int h = (n0 - 512) >> 6, d = (n0 & 63) + r32;
                bf16* vb = Vb + ((size_t)(b * NH + h) * S + s0) * DV + d;
#pragma unroll
                for (int r = 0; r < 16; ++r) vb[(size_t)crow(r, hi) * DV] = f2bf(acc[r]);
            }
        }, lds);
    }
    if constexpr (s == 5) { }
#if ATTN_MFMA
    if constexpr (s == 6) phase_attn(P, lds);
#else
    if constexpr (s == 6) phase_attn_naive(P);
#endif
    if constexpr (s == 7) {
        const bf16* W = (const bf16*)(ws + WS_WOUT) + (size_t)l * D * D;
        float* out = P.out;
        gemm_mfma(XN, D, W, D, T, D, D, [&](int m0, int n0, const f32x16& acc, int r32, int hi) {
#pragma unroll
            for (int r = 0; r < 16; ++r) { const size_t idx = (size_t)(m0 + crow(r, hi)) * D + n0 + r32; out[idx] = hin[idx] + acc[r]; }
        }, lds);
    }
    if constexpr (s == 8) phase_norm(P.out, P.norm_ffn + l * D, XN);
    if constexpr (s == 9) {
        const bf16* W = (const bf16*)(ws + WS_WPQ) + (size_t)l * 2048 * D;
        bf16* QP = (bf16*)(ws + WS_QP);
        gemm_mfma(XN, D, W, D, T, 2048, D, [&](int m0, int n0, const f32x16& acc, int r32, int hi) {
#pragma unroll
            for (int r = 0; r < 16; ++r) QP[(size_t)(m0 + crow(r, hi)) * 2048 + n0 + r32] = f2bf(acc[r]);
        }, lds);
    }
    if constexpr (s == 10) phase_topk_naive(P, l, sm);
}

__device__ __forceinline__ void layer_phase_dyn(const Params& P, int l, int s, char* sm) {
    switch (s) {
    case 0: layer_phase<0>(P, l, sm); break; case 1: layer_phase<1>(P, l, sm); break; case 2: layer_phase<2>(P, l, sm); break;
    case 3: layer_phase<3>(P, l, sm); break; case 4: layer_phase<4>(P, l, sm); break; case 5: layer_phase<5>(P, l, sm); break;
    case 6: layer_phase<6>(P, l, sm); break; case 7: layer_phase<7>(P, l, sm); break; case 8: layer_phase<8>(P, l, sm); break;
    case 9: layer_phase<9>(P, l, sm); break; case 10: layer_phase<10>(P, l, sm); break; default: phase_gather_naive(P, l); break;
    }
}
#if !ONE_LAUNCH
__global__ void __launch_bounds__(NTHREADS, 2) k_phase(Params P, int ph) {
    __shared__ __attribute__((aligned(16))) char sm[GEMM_LDS];
    if (ph == 0) { phase_prep(P); return; }
    layer_phase_dyn(P, (ph - 1) / (PH_PER_LAYER + 1), (ph - 1) % (PH_PER_LAYER + 1), sm);
}
#else
#define GSYNC() grid.sync()
__global__ void __launch_bounds__(NTHREADS, 2) k_all(Params P) {
    __shared__ __attribute__((aligned(16))) char sm[GEMM_LDS];
    cg::grid_group grid = cg::this_grid();
    { const Params Q = launder(P); phase_prep(Q); } GSYNC();
    for (int l = 0; l < DEPTH; ++l) {
#define LP(s) { const Params Q = launder(P); layer_phase<s>(Q, l, sm); }
        LP(0); GSYNC();
        LP(1); GSYNC();
        LP(2); GSYNC();
        LP(3);
        LP(4); GSYNC();
        LP(6); GSYNC();
        LP(7); GSYNC();
        LP(8); GSYNC();
        LP(9); GSYNC();
        LP(10); GSYNC();
        { const Params Q = launder(P); phase_gather_naive(Q, l); } GSYNC();
    }
}
#endif

extern "C" void kernel_launch(void* const* d_in, const int* in_sizes, int n_in, void* d_out, int out_size, void* d_ws, size_t ws_size, hipStream_t stream) {
    static int grid = 0;
    if (grid == 0) {
        if (n_in != 18 || out_size != T * D || ws_size < WS_END) { fprintf(stderr, "kernel_launch: bad sizes n_in %d out %d ws %zu need %zu\n", n_in, out_size, ws_size, (size_t)WS_END); grid = -1; return; }
        int dev = 0, cus = 0, per_cu = 0;
        hipGetDevice(&dev);
        hipDeviceGetAttribute(&cus, hipDeviceAttributeMultiprocessorCount, dev);
#if ONE_LAUNCH
        hipOccupancyMaxActiveBlocksPerMultiprocessor(&per_cu, (const void*)k_all, NTHREADS, 0);
#else
        hipOccupancyMaxActiveBlocksPerMultiprocessor(&per_cu, (const void*)k_phase, NTHREADS, 0);
#endif
        if (per_cu > 2) per_cu = 2;
        if (per_cu < 1) { fprintf(stderr, "kernel_launch: occupancy query says %d\n", per_cu); grid = -1; return; }
        grid = cus * per_cu;
    }
    if (grid < 0) return;
    Params p{};
    p.x = (const float*)d_in[0]; p.norm_mix = (const float*)d_in[1]; p.w_in = (const float*)d_in[2]; p.conv_w = (const float*)d_in[3];
    p.pool_w = (const float*)d_in[4]; p.pool_scale = (const float*)d_in[5]; p.q_norm = (const float*)d_in[6]; p.w_uq = (const float*)d_in[7];
    p.kv_norm = (const float*)d_in[8]; p.w_uk = (const float*)d_in[9]; p.w_uv = (const float*)d_in[10]; p.w_out = (const float*)d_in[11];
    p.norm_ffn = (const float*)d_in[12]; p.peer_wq = (const float*)d_in[13]; p.peer_subkeys = (const float*)d_in[14]; p.peer_u = (const float*)d_in[15];
    p.peer_v = (const float*)d_in[16]; p.norm_final = (const float*)d_in[17];
    p.out = (float*)d_out; p.ws = (unsigned char*)d_ws;
#if ONE_LAUNCH
    void* args[] = {&p};
    hipError_t e = hipLaunchCooperativeKernel((const void*)k_all, dim3(grid), dim3(NTHREADS), args, 0, stream);
    if (e != hipSuccess) fprintf(stderr, "cooperative launch failed: %s (grid %d)\n", hipGetErrorString(e), grid);
#else
    for (int ph = 0; ph < 1 + DEPTH * (PH_PER_LAYER + 1); ++ph) hipLaunchKernelGGL(k_phase, dim3(grid), dim3(NTHREADS), 0, stream, p, ph);
#endif
}
```

```cpp
#include <hip/hip_runtime.h>
#include <hip/hip_cooperative_groups.h>
#include <cstdio>
#include <cstdint>
namespace cg = cooperative_groups;

#ifndef ATTN_MFMA
#define ATTN_MFMA 1
#endif
#ifndef TAB_FP8
#define TAB_FP8 0
#endif
#ifndef ONE_LAUNCH
#define ONE_LAUNCH 1
#endif

constexpr int NB = 4, S = 8192, T = NB * S, D = 1024, DEPTH = 2;
constexpr int DIN = 1696, DINP = 1792;
constexpr int C_BG = 0, C_CG = 256, C_HC = 512, C_HP = 768, C_CQ = 1024, C_CKV = 1408, C_KR = 1664;
constexpr int QR = 384, KVR = 256, NH = 8, DQK = 96, DV = 64;
constexpr int PH = 8, NKEY = 128, NEXP = NKEY * NKEY, TOPK = 16, HK = PH * TOPK;
constexpr float EPS = 1e-6f;

typedef unsigned short bf16;

constexpr size_t MB = 1024 * 1024;
constexpr size_t WS_CTL   = 0;
constexpr size_t WS_ROPE  = 64 * 1024;
constexpr size_t WS_WIN   = WS_ROPE + (size_t)S * 16 * 2 * 4;
constexpr size_t WS_WUQ   = WS_WIN + (size_t)DEPTH * DINP * D * 2;
constexpr size_t WS_WUKV  = WS_WUQ + (size_t)DEPTH * 768 * QR * 2;
constexpr size_t WS_WOUT  = WS_WUKV + (size_t)DEPTH * 1024 * KVR * 2;
constexpr size_t WS_WPQ   = WS_WOUT + (size_t)DEPTH * D * D * 2;
constexpr size_t WS_XN    = ((WS_WPQ + (size_t)DEPTH * 2048 * D * 2 + 4095) / 4096) * 4096;
constexpr size_t WS_PROJ  = WS_XN + (size_t)T * D * 2;
constexpr size_t WS_Q     = WS_PROJ + (size_t)T * DINP * 2;
constexpr size_t WS_K     = WS_Q + (size_t)T * NH * DQK * 2;
constexpr size_t WS_V     = WS_K + (size_t)T * NH * DQK * 2;
constexpr size_t WS_EXP   = WS_V + (size_t)T * NH * DV * 2;
constexpr size_t WS_GATE  = WS_EXP + (size_t)T * HK * 4;
constexpr size_t TAB_ROWB = TAB_FP8 ? 1024 : 2048;
constexpr size_t WS_TABU  = WS_GATE + (size_t)T * HK * 4;
constexpr size_t WS_TABV  = WS_TABU + (size_t)DEPTH * NEXP * TAB_ROWB;
constexpr size_t WS_TSCU  = WS_TABV + (size_t)DEPTH * NEXP * TAB_ROWB;
constexpr size_t WS_TSCV  = WS_TSCU + (size_t)DEPTH * NEXP * 4;
constexpr size_t WS_END   = WS_TSCV + (size_t)DEPTH * NEXP * 4;
static_assert(WS_END <= (size_t)512 * 1024 * 1024, "workspace budget");
constexpr size_t WS_QP    = WS_PROJ;
static_assert((size_t)T * 2048 * 2 <= WS_K - WS_PROJ, "QP alias");

struct Params {
    const float* x; const float* norm_mix; const float* w_in; const float* conv_w; const float* pool_w; const float* pool_scale;
    const float* q_norm; const float* w_uq; const float* kv_norm; const float* w_uk; const float* w_uv; const float* w_out;
    const float* norm_ffn; const float* peer_wq; const float* peer_subkeys; const float* peer_u; const float* peer_v; const float* norm_final;
    float* out; unsigned char* ws;
};

__device__ __forceinline__ bf16 f2bf(float f) { unsigned u = __float_as_uint(f); u += 0x7fffu + ((u >> 16) & 1u); return (bf16)(u >> 16); }
__device__ __forceinline__ float bf2f(bf16 h) { return __uint_as_float(((unsigned)h) << 16); }
__device__ __forceinline__ float bflo(unsigned u) { return __uint_as_float(u << 16); }
__device__ __forceinline__ float bfhi(unsigned u) { return __uint_as_float(u & 0xffff0000u); }
__device__ __forceinline__ unsigned pack2(float a, float b) { return (unsigned)f2bf(a) | ((unsigned)f2bf(b) << 16); }
__device__ __forceinline__ float wave_sum(float v) {
#pragma unroll
    for (int m = 32; m >= 1; m >>= 1) v += __shfl_xor(v, m, 64);
    return v;
}
__device__ __forceinline__ float gelu_exact(float x) { return 0.5f * x * (1.f + erff(x * 0.70710678118654752f)); }

#define NTHREADS 256
__device__ __forceinline__ int tidx() { int t = (int)__builtin_amdgcn_workitem_id_x(); asm volatile("" : "+v"(t)); return t; }
__device__ __forceinline__ int gwave() { return blockIdx.x * (NTHREADS / 64) + (tidx() >> 6); }
__device__ __forceinline__ int nwave() { return gridDim.x * (NTHREADS / 64); }
__device__ __forceinline__ size_t gtid() { return (size_t)blockIdx.x * NTHREADS + tidx(); }
__device__ __forceinline__ size_t gnth() { return (size_t)gridDim.x * NTHREADS; }


__device__ __forceinline__ Params launder(const Params& P) {
    Params Q = P;
    asm volatile("" : "+s"(Q.x), "+s"(Q.norm_mix), "+s"(Q.w_in), "+s"(Q.conv_w), "+s"(Q.pool_w), "+s"(Q.pool_scale), "+s"(Q.q_norm), "+s"(Q.w_uq), "+s"(Q.kv_norm), "+s"(Q.w_uk));
    asm volatile("" : "+s"(Q.w_uv), "+s"(Q.w_out), "+s"(Q.norm_ffn), "+s"(Q.peer_wq), "+s"(Q.peer_subkeys), "+s"(Q.peer_u), "+s"(Q.peer_v), "+s"(Q.norm_final), "+s"(Q.out), "+s"(Q.ws));
    return Q;
}

template <class AL, class BL, class EP>
__device__ __forceinline__ void gemm_naive(int M, int N, int K, AL aload, BL bload, EP epi, float* sm) {
    float (*As)[68] = (float (*)[68])sm;
    float (*Bs)[68] = (float (*)[68])(sm + 16 * 68);
    const int tid = tidx(), tx = tid & 15, ty = tid >> 4;
    const int tilesN = (N + 63) / 64, tilesM = M / 64;
    for (int tile = blockIdx.x; tile < tilesM * tilesN; tile += gridDim.x) {
        const int tm = tile / tilesN, tn = tile % tilesN;
        const int row0 = tm * 64, col0 = tn * 64;
        float acc[4][4];
#pragma unroll
        for (int i = 0; i < 4; ++i)
#pragma unroll
            for (int j = 0; j < 4; ++j) acc[i][j] = 0.f;
        for (int k0 = 0; k0 < K; k0 += 16) {
            {
                const int r = tid >> 2, kk = (tid & 3) * 4;
#pragma unroll
                for (int i = 0; i < 4; ++i) As[kk + i][r] = aload(row0 + r, k0 + kk + i);
            }
            {
                const int kk = tid >> 4, c = (tid & 15) * 4;
#pragma unroll
                for (int j = 0; j < 4; ++j) { const int col = col0 + c + j; Bs[kk][c + j] = (col < N) ? bload(k0 + kk, col) : 0.f; }
            }
            __syncthreads();
#pragma unroll
            for (int kk = 0; kk < 16; ++kk) {
                float a[4], b[4];
#pragma unroll
                for (int i = 0; i < 4; ++i) a[i] = As[kk][ty * 4 + i];
#pragma unroll
                for (int j = 0; j < 4; ++j) b[j] = Bs[kk][tx * 4 + j];
#pragma unroll
                for (int i = 0; i < 4; ++i)
#pragma unroll
                    for (int j = 0; j < 4; ++j) acc[i][j] = fmaf(a[i], b[j], acc[i][j]);
            }
            __syncthreads();
        }
#pragma unroll
        for (int i = 0; i < 4; ++i)
#pragma unroll
            for (int j = 0; j < 4; ++j) { const int col = col0 + tx * 4 + j; if (col < N) epi(row0 + ty * 4 + i, col, acc[i][j]); }
    }
}


typedef __attribute__((ext_vector_type(8))) short bf16x8;
typedef __attribute__((ext_vector_type(16))) float f32x16;
#define MFMA32(a, b, c) __builtin_amdgcn_mfma_f32_32x32x16_bf16(a, b, c, 0, 0, 0)
__device__ __forceinline__ int crow(int r, int hi) { return (r & 3) + 8 * (r >> 2) + 4 * hi; }
constexpr int G_LDT = 144;
constexpr int G_OPB = 128 * G_LDT;
constexpr int G_BUF = 2 * G_OPB;
constexpr int GEMM_LDS = 2 * G_BUF;

template <class EPI>
__device__ __forceinline__ void gemm_mfma(const bf16* __restrict__ A, int lda, const bf16* __restrict__ Bt, int ldb, int M, int N, int K, EPI epi, char* lds) {
    const int tid = tidx(), lane = tid & 63, w = tid >> 6, r32 = lane & 31, hi = lane >> 5;
    const int wm = w >> 1, wn = w & 1;
    const int tilesN = N / 128, tilesM = M / 128, nk = K / 64;
    const int srow = tid >> 3, sch = tid & 7;
    for (int tile = blockIdx.x; tile < tilesM * tilesN; tile += gridDim.x) {
        const int tm = tile / tilesN, tn = tile % tilesN;
        const bf16* Ag = A + (size_t)(tm * 128 + srow) * lda + sch * 8;
        const bf16* Bg = Bt + (size_t)(tn * 128 + srow) * ldb + sch * 8;
        f32x16 acc[2][2];
#pragma unroll
        for (int i = 0; i < 2; ++i)
#pragma unroll
            for (int j = 0; j < 2; ++j)
#pragma unroll
                for (int r = 0; r < 16; ++r) acc[i][j][r] = 0.f;
        uint4 ra0, ra1, ra2, ra3, rb0, rb1, rb2, rb3;
#define G_LOAD(kofs) do { \
        ra0 = *(const uint4*)(Ag + (kofs)); ra1 = *(const uint4*)(Ag + (size_t)32 * lda + (kofs)); ra2 = *(const uint4*)(Ag + (size_t)64 * lda + (kofs)); ra3 = *(const uint4*)(Ag + (size_t)96 * lda + (kofs)); \
        rb0 = *(const uint4*)(Bg + (kofs)); rb1 = *(const uint4*)(Bg + (size_t)32 * ldb + (kofs)); rb2 = *(const uint4*)(Bg + (size_t)64 * ldb + (kofs)); rb3 = *(const uint4*)(Bg + (size_t)96 * ldb + (kofs)); } while (0)
        G_LOAD(0);
        for (int kt = 0; kt < nk; ++kt) {
            char* bA = lds + (kt & 1) * G_BUF; char* bB = bA + G_OPB;
            {
                char* wa = bA + srow * G_LDT + sch * 16; char* wb = bB + srow * G_LDT + sch * 16;
                *(uint4*)(wa) = ra0; *(uint4*)(wa + 32 * G_LDT) = ra1; *(uint4*)(wa + 64 * G_LDT) = ra2; *(uint4*)(wa + 96 * G_LDT) = ra3;
                *(uint4*)(wb) = rb0; *(uint4*)(wb + 32 * G_LDT) = rb1; *(uint4*)(wb + 64 * G_LDT) = rb2; *(uint4*)(wb + 96 * G_LDT) = rb3;
            }
            __syncthreads();
            if (kt + 1 < nk) G_LOAD((kt + 1) * 64);
            const char* pa = bA + (wm * 64 + r32) * G_LDT + hi * 16;
            const char* pb = bB + (wn * 64 + r32) * G_LDT + hi * 16;
#pragma unroll
            for (int ks = 0; ks < 4; ++ks) {
                const bf16x8 a0 = *(const bf16x8*)(pa + ks * 32), a1 = *(const bf16x8*)(pa + 32 * G_LDT + ks * 32);
                const bf16x8 b0 = *(const bf16x8*)(pb + ks * 32), b1 = *(const bf16x8*)(pb + 32 * G_LDT + ks * 32);
                acc[0][0] = MFMA32(a0, b0, acc[0][0]); acc[0][1] = MFMA32(a0, b1, acc[0][1]);
                acc[1][0] = MFMA32(a1, b0, acc[1][0]); acc[1][1] = MFMA32(a1, b1, acc[1][1]);
            }
        }
#pragma unroll
        for (int i = 0; i < 2; ++i)
#pragma unroll
            for (int j = 0; j < 2; ++j) epi(tm * 128 + wm * 64 + i * 32, tn * 128 + wn * 64 + j * 32, acc[i][j], r32, hi);
        __syncthreads();
    }
}

__device__ __forceinline__ void transpose_bf16(const float* __restrict__ W, bf16* __restrict__ Wt, int K, int N, int Npad) {
    const size_t tot = (size_t)Npad * K;
    for (size_t i = gtid(); i < tot; i += gnth()) {
        const int n = (int)(i / K), k = (int)(i % K);
        Wt[i] = (n < N) ? f2bf(W[(size_t)k * N + n]) : (bf16)0;
    }
}

__device__ __forceinline__ void convert_table(const float* __restrict__ src, unsigned char* __restrict__ dst, float* __restrict__ scl, int rows) {
    const int lane = tidx() & 63;
    for (int r = gwave(); r < rows; r += nwave()) {
        const float4* sr = (const float4*)(src + (size_t)r * D);
        if (TAB_FP8) {
            float4 v[4]; float am = 0.f;
#pragma unroll
            for (int j = 0; j < 4; ++j) { v[j] = sr[lane * 4 + j]; am = fmaxf(am, fmaxf(fmaxf(fabsf(v[j].x), fabsf(v[j].y)), fmaxf(fabsf(v[j].z), fabsf(v[j].w)))); }
#pragma unroll
            for (int m = 32; m >= 1; m >>= 1) am = fmaxf(am, __shfl_xor(am, m, 64));
            const float sc = (am > 0.f) ? am * (1.f / 448.f) : 1.f;
            const float is = 1.f / sc;
            uint4 o;
            { int w = 0; w = __builtin_amdgcn_cvt_pk_fp8_f32(v[0].x * is, v[0].y * is, w, false); w = __builtin_amdgcn_cvt_pk_fp8_f32(v[0].z * is, v[0].w * is, w, true); o.x = (unsigned)w; }
            { int w = 0; w = __builtin_amdgcn_cvt_pk_fp8_f32(v[1].x * is, v[1].y * is, w, false); w = __builtin_amdgcn_cvt_pk_fp8_f32(v[1].z * is, v[1].w * is, w, true); o.y = (unsigned)w; }
            { int w = 0; w = __builtin_amdgcn_cvt_pk_fp8_f32(v[2].x * is, v[2].y * is, w, false); w = __builtin_amdgcn_cvt_pk_fp8_f32(v[2].z * is, v[2].w * is, w, true); o.z = (unsigned)w; }
            { int w = 0; w = __builtin_amdgcn_cvt_pk_fp8_f32(v[3].x * is, v[3].y * is, w, false); w = __builtin_amdgcn_cvt_pk_fp8_f32(v[3].z * is, v[3].w * is, w, true); o.w = (unsigned)w; }
            *(uint4*)(dst + (size_t)r * 1024 + lane * 16) = o;
            if (lane == 0) scl[r] = sc;
        } else {
#pragma unroll
            for (int j = 0; j < 2; ++j) {
                const float4 a = sr[j * 128 + lane * 2], b = sr[j * 128 + lane * 2 + 1];
                uint4 o; o.x = pack2(a.x, a.y); o.y = pack2(a.z, a.w); o.z = pack2(b.x, b.y); o.w = pack2(b.z, b.w);
                *(uint4*)(dst + (size_t)r * 2048 + j * 1024 + lane * 16) = o;
            }
        }
    }
}
__device__ __forceinline__ void phase_prep(const Params& P) {
    unsigned char* ws = P.ws;
    for (int l = 0; l < DEPTH; ++l) {
        transpose_bf16(P.w_in + (size_t)l * D * DIN, (bf16*)(ws + WS_WIN) + (size_t)l * DINP * D, D, DIN, DINP);
        transpose_bf16(P.w_uq + (size_t)l * QR * 768, (bf16*)(ws + WS_WUQ) + (size_t)l * 768 * QR, QR, 768, 768);
        transpose_bf16(P.w_uk + (size_t)l * KVR * 512, (bf16*)(ws + WS_WUKV) + (size_t)l * 1024 * KVR, KVR, 512, 512);
        transpose_bf16(P.w_uv + (size_t)l * KVR * 512, (bf16*)(ws + WS_WUKV) + (size_t)l * 1024 * KVR + (size_t)512 * KVR, KVR, 512, 512);
        transpose_bf16(P.w_out + (size_t)l * D * D, (bf16*)(ws + WS_WOUT) + (size_t)l * D * D, D, D, D);
        transpose_bf16(P.peer_wq + (size_t)l * D * 2048, (bf16*)(ws + WS_WPQ) + (size_t)l * 2048 * D, D, 2048, 2048);
    }
    convert_table(P.peer_u, ws + WS_TABU, (float*)(ws + WS_TSCU), DEPTH * NEXP);
    convert_table(P.peer_v, ws + WS_TABV, (float*)(ws + WS_TSCV), DEPTH * NEXP);
    float* rope = (float*)(ws + WS_ROPE);
    for (size_t i = gtid(); i < (size_t)S * 16; i += gnth()) {
        const int s = (int)(i >> 4), f = (int)(i & 15);
        const double inv = pow(10000.0, -(double)f / 16.0);
        const double ang = (double)s * inv;
        rope[2 * i] = (float)cos(ang); rope[2 * i + 1] = (float)sin(ang);
    }
}

__device__ __forceinline__ void phase_norm(const float* __restrict__ h, const float* __restrict__ g, bf16* __restrict__ xn) {
    const int lane = tidx() & 63;
    for (int t = gwave(); t < T; t += nwave()) {
        const float4* hr = (const float4*)(h + (size_t)t * D);
        float4 v[4]; float ss = 0.f;
#pragma unroll
        for (int j = 0; j < 4; ++j) { v[j] = hr[j * 64 + lane]; ss += v[j].x * v[j].x + v[j].y * v[j].y + v[j].z * v[j].z + v[j].w * v[j].w; }
        ss = wave_sum(ss);
        const float r = rsqrtf(ss * (1.f / D) + EPS);
#pragma unroll
        for (int j = 0; j < 4; ++j) {
            const float4 gg = ((const float4*)g)[j * 64 + lane];
            uint2 o; o.x = pack2(v[j].x * r * gg.x, v[j].y * r * gg.y); o.y = pack2(v[j].z * r * gg.z, v[j].w * r * gg.w);
            ((uint2*)(xn + (size_t)t * D))[j * 64 + lane] = o;
        }
    }
}

__device__ __forceinline__ void phase_mixprep(const Params& P, int l) {
    unsigned char* ws = P.ws;
    bf16* proj = (bf16*)(ws + WS_PROJ);
    bf16* Y = (bf16*)(ws + WS_XN);
    bf16* Kb = (bf16*)(ws + WS_K);
    const float* rope = (const float*)(ws + WS_ROPE);
    const float* qn = P.q_norm + l * QR; const float* kvn = P.kv_norm + l * KVR;
    const float* cw = P.conv_w + (size_t)l * 3 * 256;
    const float* pw = P.pool_w + (size_t)l * 4 * 64 * 64;
    const float* psc = P.pool_scale + l * 256;
    const int lane = tidx() & 63;
    for (int t = gwave(); t < T; t += nwave()) {
        const int b = t / S, s = t % S;
        bf16* pr = proj + (size_t)t * DINP;
        {
            float v[6]; float ss = 0.f;
#pragma unroll
            for (int j = 0; j < 6; ++j) { v[j] = bf2f(pr[C_CQ + j * 64 + lane]); ss += v[j] * v[j]; }
            ss = wave_sum(ss);
            const float r = rsqrtf(ss * (1.f / QR) + EPS);
#pragma unroll
            for (int j = 0; j < 6; ++j) pr[C_CQ + j * 64 + lane] = f2bf(v[j] * r * qn[j * 64 + lane]);
        }
        {
            float v[4]; float ss = 0.f;
#pragma unroll
            for (int j = 0; j < 4; ++j) { v[j] = bf2f(pr[C_CKV + j * 64 + lane]); ss += v[j] * v[j]; }
            ss = wave_sum(ss);
            const float r = rsqrtf(ss * (1.f / KVR) + EPS);
#pragma unroll
            for (int j = 0; j < 4; ++j) pr[C_CKV + j * 64 + lane] = f2bf(v[j] * r * kvn[j * 64 + lane]);
        }
        if (lane < 16) {
            const float x1 = bf2f(pr[C_KR + lane]), x2 = bf2f(pr[C_KR + 16 + lane]);
            const float c = rope[(s * 16 + lane) * 2], sn = rope[(s * 16 + lane) * 2 + 1];
            const bf16 o1 = f2bf(x1 * c - x2 * sn), o2 = f2bf(x2 * c + x1 * sn);
#pragma unroll
            for (int h = 0; h < NH; ++h) {
                bf16* kr = Kb + ((size_t)(b * NH + h) * S + s) * DQK;
                kr[64 + lane] = o1; kr[80 + lane] = o2;
            }
        }
#pragma unroll
        for (int r = 0; r < 4; ++r) {
            const int c = r * 64 + lane;
            float acc = 0.f;
#pragma unroll
            for (int j = 0; j < 3; ++j) {
                const int sp = s - 2 + j;
                if (sp >= 0) {
                    const bf16* pp = proj + (size_t)(t - 2 + j) * DINP;
                    acc += cw[j * 256 + c] * (bf2f(pp[C_CG + c]) * bf2f(pp[C_HC + c]));
                }
            }
            Y[(size_t)t * D + c] = f2bf(bf2f(pr[C_BG + c]) * acc);
        }
        const int wins[4] = {2, 4, 8, 16};
#pragma unroll
        for (int g = 0; g < 4; ++g) {
            const int w = wins[g];
            const int lo = (s + 1 - w) > 0 ? (s + 1 - w) : 0;
            const int cnt = s + 1 - lo;
            float sum = 0.f;
            for (int sp = lo; sp <= s; ++sp) sum += bf2f(proj[(size_t)(b * S + sp) * DINP + C_HP + g * 64 + lane]);
            const float pooled = sum / (float)cnt - bf2f(pr[C_HP + g * 64 + lane]);
            float m = 0.f;
            for (int c = 0; c < 64; ++c) m = fmaf(__shfl(pooled, c, 64), pw[(g * 64 + c) * 64 + lane], m);
            Y[(size_t)t * D + 256 + g * 64 + lane] = f2bf(m * psc[g * 64 + lane]);
        }
    }
}

__device__ __forceinline__ void phase_qrope(const Params& P) {
    bf16* Qb = (bf16*)(P.ws + WS_Q);
    const float* rope = (const float*)(P.ws + WS_ROPE);
    const size_t tot = (size_t)T * NH * 16;
    for (size_t i = gtid(); i < tot; i += gnth()) {
        const int f = (int)(i & 15); const size_t row = i >> 4;
        const int s = (int)(row % S);
        bf16* q = Qb + row * DQK;
        const float x1 = bf2f(q[64 + f]), x2 = bf2f(q[80 + f]);
        const float c = rope[(s * 16 + f) * 2], sn = rope[(s * 16 + f) * 2 + 1];
        q[64 + f] = f2bf(x1 * c - x2 * sn); q[80 + f] = f2bf(x2 * c + x1 * sn);
    }
}

__device__ __forceinline__ void phase_attn_naive(const Params& P) {
    const bf16* Qb = (const bf16*)(P.ws + WS_Q);
    const bf16* Kb = (const bf16*)(P.ws + WS_K);
    const bf16* Vb = (const bf16*)(P.ws + WS_V);
    bf16* Y = (bf16*)(P.ws + WS_XN);
    const int lane = tidx() & 63, qr = lane & 31, half = lane >> 5;
    const int gw = gwave(), nw = nwave();
    const int total = NB * NH * (S / 32);
    for (int pass = 0; pass * nw < total; ++pass) {
        const int u = (pass & 1) ? ((pass + 1) * nw - 1 - gw) : (pass * nw + gw);
        if (u >= total) continue;
        const int qblk = (S / 32 - 1) - (u >> 5), bh = u & 31;
        const int qpos = qblk * 32 + qr;
        unsigned q[DQK / 2];
        {
            const uint4* qp = (const uint4*)(Qb + ((size_t)bh * S + qpos) * DQK);
#pragma unroll
            for (int c = 0; c < 12; ++c) { const uint4 v = qp[c]; q[c * 4 + 0] = v.x; q[c * 4 + 1] = v.y; q[c * 4 + 2] = v.z; q[c * 4 + 3] = v.w; }
        }
        float o[32];
#pragma unroll
        for (int d = 0; d < 32; ++d) o[d] = 0.f;
        float m = -3.0e38f, lsum = 0.f;
        const int kmax = qblk * 32 + 31;
        const bf16* Kp = Kb + (size_t)bh * S * DQK;
        const bf16* Vp = Vb + (size_t)bh * S * DV + half * 32;
        for (int j = 0; j <= kmax; ++j) {
            const uint4* kr = (const uint4*)(Kp + (size_t)j * DQK);
            float sc = 0.f;
#pragma unroll
            for (int c = 0; c < 12; ++c) {
                const uint4 v = kr[c];
                sc = fmaf(bflo(q[c * 4 + 0]), bflo(v.x), sc); sc = fmaf(bfhi(q[c * 4 + 0]), bfhi(v.x), sc);
                sc = fmaf(bflo(q[c * 4 + 1]), bflo(v.y), sc); sc = fmaf(bfhi(q[c * 4 + 1]), bfhi(v.y), sc);
                sc = fmaf(bflo(q[c * 4 + 2]), bflo(v.z), sc); sc = fmaf(bfhi(q[c * 4 + 2]), bfhi(v.z), sc);
                sc = fmaf(bflo(q[c * 4 + 3]), bflo(v.w), sc); sc = fmaf(bfhi(q[c * 4 + 3]), bfhi(v.w), sc);
            }
            if (j <= qpos) {
                const float mn = fmaxf(m, sc);
                const float alpha = exp2f(m - mn);
                const float p = exp2f(sc - mn);
                lsum = lsum * alpha + p; m = mn;
                const uint4* vr = (const uint4*)(Vp + (size_t)j * DV);
#pragma unroll
                for (int c = 0; c < 4; ++c) {
                    const uint4 v = vr[c];
                    o[c * 8 + 0] = fmaf(p, bflo(v.x), o[c * 8 + 0] * alpha); o[c * 8 + 1] = fmaf(p, bfhi(v.x), o[c * 8 + 1] * alpha);
                    o[c * 8 + 2] = fmaf(p, bflo(v.y), o[c * 8 + 2] * alpha); o[c * 8 + 3] = fmaf(p, bfhi(v.y), o[c * 8 + 3] * alpha);
                    o[c * 8 + 4] = fmaf(p, bflo(v.z), o[c * 8 + 4] * alpha); o[c * 8 + 5] = fmaf(p, bfhi(v.z), o[c * 8 + 5] * alpha);
                    o[c * 8 + 6] = fmaf(p, bflo(v.w), o[c * 8 + 6] * alpha); o[c * 8 + 7] = fmaf(p, bfhi(v.w), o[c * 8 + 7] * alpha);
                }
            }
        }
        const float inv = 1.f / lsum;
        const int b = bh >> 3, h = bh & 7;
        uint4* yo = (uint4*)(Y + ((size_t)(b * S + qpos)) * D + 512 + h * 64 + half * 32);
#pragma unroll
        for (int c = 0; c < 4; ++c) {
            uint4 v;
            v.x = pack2(o[c * 8 + 0] * inv, o[c * 8 + 1] * inv); v.y = pack2(o[c * 8 + 2] * inv, o[c * 8 + 3] * inv);
            v.z = pack2(o[c * 8 + 4] * inv, o[c * 8 + 5] * inv); v.w = pack2(o[c * 8 + 6] * inv, o[c * 8 + 7] * inv);
            yo[c] = v;
        }
    }
}


typedef short v4i16_t __attribute__((ext_vector_type(4)));
typedef __attribute__((address_space(3))) v4i16_t* lds_v4p;
__device__ __forceinline__ unsigned cvtpk(float lo, float hi) { unsigned r; asm("v_cvt_pk_bf16_f32 %0, %1, %2" : "=v"(r) : "v"(lo), "v"(hi)); return r; }
__device__ __forceinline__ v4i16_t vtr(const char* p) { return __builtin_amdgcn_ds_read_tr16_b64_v4i16((lds_v4p)p); }
constexpr int A_KP = 208, A_VP = 192;
constexpr int A_KB = 64 * A_KP, A_VB = 64 * A_VP, A_BUF = A_KB + A_VB, ATTN_LDS = 2 * A_BUF;
static_assert(ATTN_LDS <= GEMM_LDS, "attention LDS");

__device__ __forceinline__ void attn_unit(const bf16* __restrict__ Qb, const bf16* __restrict__ Kb, const bf16* __restrict__ Vb, bf16* __restrict__ Y, int bh, int qblk, char* lds) {
    const int tid = tidx(), lane = tid & 63, w = tid >> 6, r32 = lane & 31, hi = lane >> 5;
    const int q0 = qblk * 128, qw0 = q0 + w * 32;
    const int NT = 2 * qblk + 2;
    bf16x8 qf[6];
    {
        const bf16* qp = Qb + ((size_t)bh * S + qw0 + r32) * DQK + hi * 8;
#pragma unroll
        for (int ks = 0; ks < 6; ++ks) qf[ks] = *(const bf16x8*)(qp + ks * 16);
    }
    f32x16 o0, o1;
#pragma unroll
    for (int r = 0; r < 16; ++r) { o0[r] = 0.f; o1[r] = 0.f; }
    float m = -1e30f, lsum = 0.f;
    const char* Kg = (const char*)(Kb + (size_t)bh * S * DQK) + tid * 16;
    const char* Vg = (const char*)(Vb + (size_t)bh * S * DV) + tid * 16;
    const int kl0 = (tid / 12) * A_KP + (tid % 12) * 16, kl1 = ((tid + 256) / 12) * A_KP + ((tid + 256) % 12) * 16, kl2 = ((tid + 512) / 12) * A_KP + ((tid + 512) % 12) * 16;
    const int vl0 = (tid >> 3) * A_VP + (tid & 7) * 16, vl1 = vl0 + 32 * A_VP;
    uint4 k0, k1, k2, v0, v1;
#define A_LOAD(t) do { const char* kg = Kg + (size_t)(t) * (64 * 192); const char* vg = Vg + (size_t)(t) * (64 * 128); \
        k0 = *(const uint4*)(kg); k1 = *(const uint4*)(kg + 4096); k2 = *(const uint4*)(kg + 8192); v0 = *(const uint4*)(vg); v1 = *(const uint4*)(vg + 4096); } while (0)
    A_LOAD(0);
    const int pvo = (4 * hi + ((lane & 15) >> 2)) * A_VP + (16 * ((lane >> 4) & 1) + 4 * (lane & 3)) * 2;
    for (int t = 0; t < NT; ++t) {
        char* bK = lds + (t & 1) * A_BUF; char* bV = bK + A_KB;
        *(uint4*)(bK + kl0) = k0; *(uint4*)(bK + kl1) = k1; *(uint4*)(bK + kl2) = k2; *(uint4*)(bV + vl0) = v0; *(uint4*)(bV + vl1) = v1;
        __syncthreads();
        if (t + 1 < NT) A_LOAD(t + 1);
        const int kt0 = t * 64;
        if (kt0 <= qw0) {
            f32x16 s0, s1;
#pragma unroll
            for (int r = 0; r < 16; ++r) { s0[r] = 0.f; s1[r] = 0.f; }
            const char* pk = bK + r32 * A_KP + hi * 16;
#pragma unroll
            for (int ks = 0; ks < 6; ++ks) {
                const bf16x8 a0 = *(const bf16x8*)(pk + ks * 32), a1 = *(const bf16x8*)(pk + 32 * A_KP + ks * 32);
                s0 = MFMA32(a0, qf[ks], s0); s1 = MFMA32(a1, qf[ks], s1);
            }
            if (kt0 + 63 > qw0) {
                const int qrow = qw0 + r32;
#pragma unroll
                for (int r = 0; r < 16; ++r) { const int key = kt0 + crow(r, hi); if (key > qrow) s0[r] = -INFINITY; if (key + 32 > qrow) s1[r] = -INFINITY; }
            }
            float mx = fmaxf(s0[0], s1[0]);
#pragma unroll
            for (int r = 1; r < 16; ++r) mx = fmaxf(mx, fmaxf(s0[r], s1[r]));
            mx = fmaxf(mx, __shfl_xor(mx, 32, 64));
            const float mn = fmaxf(m, mx);
            const float alpha = __builtin_amdgcn_exp2f(m - mn);
            m = mn;
            float ps = 0.f;
#pragma unroll
            for (int r = 0; r < 16; ++r) { s0[r] = __builtin_amdgcn_exp2f(s0[r] - mn); s1[r] = __builtin_amdgcn_exp2f(s1[r] - mn); ps += s0[r] + s1[r]; }
            lsum = lsum * alpha + ps;
#pragma unroll
            for (int r = 0; r < 16; ++r) { o0[r] *= alpha; o1[r] *= alpha; }
            union { unsigned u[4]; bf16x8 v; } p00, p01, p10, p11;
#pragma unroll
            for (int j = 0; j < 4; ++j) { p00.u[j] = cvtpk(s0[2 * j], s0[2 * j + 1]); p01.u[j] = cvtpk(s0[8 + 2 * j], s0[9 + 2 * j]); p10.u[j] = cvtpk(s1[2 * j], s1[2 * j + 1]); p11.u[j] = cvtpk(s1[8 + 2 * j], s1[9 + 2 * j]); }
            const char* pv = bV + pvo;
#define A_PV(pf, kofs) do { \
            { const v4i16_t lo = vtr(pv + (kofs) * A_VP), hh = vtr(pv + ((kofs) + 8) * A_VP); const bf16x8 vf = {lo[0], lo[1], lo[2], lo[3], hh[0], hh[1], hh[2], hh[3]}; o0 = MFMA32(vf, pf.v, o0); } \
            { const v4i16_t lo = vtr(pv + (kofs) * A_VP + 64), hh = vtr(pv + ((kofs) + 8) * A_VP + 64); const bf16x8 vf = {lo[0], lo[1], lo[2], lo[3], hh[0], hh[1], hh[2], hh[3]}; o1 = MFMA32(vf, pf.v, o1); } } while (0)
            A_PV(p00, 0); A_PV(p01, 16); A_PV(p10, 32); A_PV(p11, 48);
        }
    }
    lsum += __shfl_xor(lsum, 32, 64);
    const float inv = 1.f / lsum;
    const int b = bh >> 3, h = bh & 7;
    bf16* yo = Y + (size_t)(b * S + qw0 + r32) * D + 512 + h * 64 + 4 * hi;
#pragma unroll
    for (int g = 0; g < 4; ++g) {
        uint2 a, c;
        a.x = cvtpk(o0[4 * g] * inv, o0[4 * g + 1] * inv); a.y = cvtpk(o0[4 * g + 2] * inv, o0[4 * g + 3] * inv);
        c.x = cvtpk(o1[4 * g] * inv, o1[4 * g + 1] * inv); c.y = cvtpk(o1[4 * g + 2] * inv, o1[4 * g + 3] * inv);
        *(uint2*)(yo + 8 * g) = a; *(uint2*)(yo + 32 + 8 * g) = c;
    }
    __syncthreads();
}
__device__ __forceinline__ void phase_attn(const Params& P, char* lds) {
    const bf16* Qb = (const bf16*)(P.ws + WS_Q);
    const bf16* Kb = (const bf16*)(P.ws + WS_K);
    const bf16* Vb = (const bf16*)(P.ws + WS_V);
    bf16* Y = (bf16*)(P.ws + WS_XN);
    for (int u = blockIdx.x; u < NB * NH * (S / 128); u += gridDim.x) {
        const int bh = u & 31, v = u >> 5;
        const int qblk = (v < 16) ? (63 - v) : (v < 32) ? (v - 16) : (v < 48) ? (79 - v) : (v - 32);
        attn_unit(Qb, Kb, Vb, Y, bh, qblk, lds);
    }
}

__device__ __forceinline__ void wave_argmax(float& bv, int& bi) {
#pragma unroll
    for (int m = 32; m >= 1; m >>= 1) {
        const float ov = __shfl_xor(bv, m, 64); const int oi = __shfl_xor(bi, m, 64);
        if (ov > bv || (ov == bv && oi < bi)) { bv = ov; bi = oi; }
    }
}
__device__ __forceinline__ void peer_half_top16(const float* __restrict__ skp, const float* qs, int, int lane, float& sp, int& ip) {
    const float NEG = -3.0e38f;
    float v0 = 0.f, v1 = 0.f;
    const float4* r0 = (const float4*)(skp + (size_t)lane * 128);
    const float4* r1 = (const float4*)(skp + (size_t)(lane + 64) * 128);
    for (int d = 0; d < 32; ++d) {
        const float4 a = r0[d], bq = r1[d];
        const float q0 = qs[d * 4 + 0], q1 = qs[d * 4 + 1], q2 = qs[d * 4 + 2], q3 = qs[d * 4 + 3];
        v0 = fmaf(q0, a.x, v0); v0 = fmaf(q1, a.y, v0); v0 = fmaf(q2, a.z, v0); v0 = fmaf(q3, a.w, v0);
        v1 = fmaf(q0, bq.x, v1); v1 = fmaf(q1, bq.y, v1); v1 = fmaf(q2, bq.z, v1); v1 = fmaf(q3, bq.w, v1);
    }
    sp = 0.f; ip = 0;
    for (int k = 0; k < TOPK; ++k) {
        float bv; int bi;
        if (v0 >= v1) { bv = v0; bi = lane; } else { bv = v1; bi = lane + 64; }
        wave_argmax(bv, bi);
        if (lane == k) { sp = bv; ip = bi; }
        if (bi == lane) v0 = NEG; else if (bi == lane + 64) v1 = NEG;
    }
}
__device__ __forceinline__ void phase_topk_naive(const Params& P, int l, float* sm) {
    const bf16* QP = (const bf16*)(P.ws + WS_QP);
    int* EXPp = (int*)(P.ws + WS_EXP);
    float* GATEp = (float*)(P.ws + WS_GATE);
    const float* sk = P.peer_subkeys + (size_t)l * 2 * NKEY * 128;
    const int lane = tidx() & 63, wv = tidx() >> 6;
    float* qs = sm + wv * 256;
    const float NEG = -3.0e38f;
    for (int u = gwave(); u < T * PH; u += nwave()) {
        const int t = u >> 3, h = u & 7;
        {
            const bf16* qp = QP + (size_t)t * 2048 + h * 256;
#pragma unroll
            for (int j = 0; j < 4; ++j) qs[j * 64 + lane] = bf2f(qp[j * 64 + lane]);
        }
        __builtin_amdgcn_s_waitcnt(0);
        __builtin_amdgcn_wave_barrier();
        float stop0, stop1; int itop0, itop1;
        peer_half_top16(sk, qs, 0, lane, stop0, itop0);
        peer_half_top16(sk + (size_t)NKEY * 128, qs + 128, 0, lane, stop1, itop1);
        __builtin_amdgcn_wave_barrier();
        float cv[4];
#pragma unroll
        for (int r = 0; r < 4; ++r) { const int c = lane + 64 * r; cv[r] = __shfl(stop0, c >> 4, 64) + __shfl(stop1, c & 15, 64); }
        float ts = 0.f; int ci = 0;
        for (int k = 0; k < TOPK; ++k) {
            float bv = cv[0]; int bi = lane;
#pragma unroll
            for (int r = 1; r < 4; ++r) if (cv[r] > bv) { bv = cv[r]; bi = lane + 64 * r; }
            wave_argmax(bv, bi);
            if (lane == k) { ts = bv; ci = bi; }
#pragma unroll
            for (int r = 0; r < 4; ++r) if (bi == lane + 64 * r) cv[r] = NEG;
        }
        const int e1 = __shfl(itop0, ci >> 4, 64), e2 = __shfl(itop1, ci & 15, 64);
        const float smax = __shfl(ts, 0, 64);
        float ex = (lane < 16) ? __expf(ts - smax) : 0.f;
        float den = ex;
#pragma unroll
        for (int m = 8; m >= 1; m >>= 1) den += __shfl_xor(den, m, 64);
        if (lane < 16) {
            EXPp[(size_t)t * HK + h * 16 + lane] = e1 * NKEY + e2;
            GATEp[(size_t)t * HK + h * 16 + lane] = ex / den;
        }
    }
}

__device__ __forceinline__ void phase_gather_naive(const Params& P, int l) {
    const bf16* XN = (const bf16*)(P.ws + WS_XN);
    const int* EXPp = (const int*)(P.ws + WS_EXP);
    const float* GATEp = (const float*)(P.ws + WS_GATE);
    const float* U = P.peer_u + (size_t)l * NEXP * D;
    const float* V = P.peer_v + (size_t)l * NEXP * D;
    const int lane = tidx() & 63;
    for (int t = gwave(); t < T; t += nwave()) {
        float4 xv[4];
#pragma unroll
        for (int j = 0; j < 4; ++j) {
            const uint2 r = ((const uint2*)(XN + (size_t)t * D))[j * 64 + lane];
            xv[j] = make_float4(bflo(r.x), bfhi(r.x), bflo(r.y), bfhi(r.y));
        }
        float4 acc[4];
#pragma unroll
        for (int j = 0; j < 4; ++j) acc[j] = make_float4(0.f, 0.f, 0.f, 0.f);
        for (int k = 0; k < HK; ++k) {
            const int e = EXPp[(size_t)t * HK + k];
            const float g = GATEp[(size_t)t * HK + k];
            const float4* ur = (const float4*)(U + (size_t)e * D);
            float d = 0.f;
#pragma unroll
            for (int j = 0; j < 4; ++j) { const float4 u = ur[j * 64 + lane]; d += xv[j].x * u.x + xv[j].y * u.y + xv[j].z * u.z + xv[j].w * u.w; }
            d = wave_sum(d);
            const float a = g * gelu_exact(d);
            const float4* vr = (const float4*)(V + (size_t)e * D);
#pragma unroll
            for (int j = 0; j < 4; ++j) { const float4 v = vr[j * 64 + lane]; acc[j].x = fmaf(a, v.x, acc[j].x); acc[j].y = fmaf(a, v.y, acc[j].y); acc[j].z = fmaf(a, v.z, acc[j].z); acc[j].w = fmaf(a, v.w, acc[j].w); }
        }
        float4* hr = (float4*)(P.out + (size_t)t * D);
        float ss = 0.f;
#pragma unroll
        for (int j = 0; j < 4; ++j) {
            const float4 hv = hr[j * 64 + lane];
            acc[j].x += hv.x; acc[j].y += hv.y; acc[j].z += hv.z; acc[j].w += hv.w;
            ss += acc[j].x * acc[j].x + acc[j].y * acc[j].y + acc[j].z * acc[j].z + acc[j].w * acc[j].w;
        }
        if (l == DEPTH - 1) {
            ss = wave_sum(ss);
            const float r = rsqrtf(ss * (1.f / D) + EPS);
#pragma unroll
            for (int j = 0; j < 4; ++j) {
                const float4 gg = ((const float4*)P.norm_final)[j * 64 + lane];
                hr[j * 64 + lane] = make_float4(acc[j].x * r * gg.x, acc[j].y * r * gg.y, acc[j].z * r * gg.z, acc[j].w * r * gg.w);
            }
        } else {
#pragma unroll
            for (int j = 0; j < 4; ++j) hr[j * 64 + lane] = acc[j];
        }
    }
}


__device__ __forceinline__ float red16(float (&p)[16], int lane) {
#pragma unroll
    for (int i = 0; i < 8; ++i) { const bool up = lane & 32; const float send = up ? p[i] : p[i + 8], keep = up ? p[i + 8] : p[i]; p[i] = keep + __shfl_xor(send, 32, 64); }
#pragma unroll
    for (int i = 0; i < 4; ++i) { const bool up = lane & 16; const float send = up ? p[i] : p[i + 4], keep = up ? p[i + 4] : p[i]; p[i] = keep + __shfl_xor(send, 16, 64); }
#pragma unroll
    for (int i = 0; i < 2; ++i) { const bool up = lane & 8; const float send = up ? p[i] : p[i + 2], keep = up ? p[i + 2] : p[i]; p[i] = keep + __shfl_xor(send, 8, 64); }
    { const bool up = lane & 4; const float send = up ? p[0] : p[1], keep = up ? p[1] : p[0]; p[0] = keep + __shfl_xor(send, 4, 64); }
    float r = p[0];
    r += __shfl_xor(r, 2, 64); r += __shfl_xor(r, 1, 64);
    return r;
}
typedef __attribute__((ext_vector_type(2))) __bf16 bf2_t;
__device__ __forceinline__ float dot2bf(unsigned a, unsigned b, float c) { return __builtin_amdgcn_fdot2_f32_bf16(__builtin_bit_cast(bf2_t, a), __builtin_bit_cast(bf2_t, b), c, false); }

__device__ __forceinline__ void phase_gather(const Params& P, int l) {
    const bf16* XN = (const bf16*)(P.ws + WS_XN);
    bf16* XNw = (bf16*)(P.ws + WS_XN);
    const int* EXPp = (const int*)(P.ws + WS_EXP);
    const float* GATEp = (const float*)(P.ws + WS_GATE);
    const unsigned char* U = P.ws + WS_TABU + (size_t)l * NEXP * TAB_ROWB;
    const unsigned char* V = P.ws + WS_TABV + (size_t)l * NEXP * TAB_ROWB;
    const float* SU = (const float*)(P.ws + WS_TSCU) + (size_t)l * NEXP;
    const float* SV = (const float*)(P.ws + WS_TSCV) + (size_t)l * NEXP;
    const int lane = tidx() & 63;
    for (int t = gwave(); t < T; t += nwave()) {
        const int e_lo = EXPp[(size_t)t * HK + lane], e_hi = EXPp[(size_t)t * HK + 64 + lane];
#if TAB_FP8
        float xf[16];
        {
            const uint4 a = ((const uint4*)(XN + (size_t)t * D))[lane * 2], b = ((const uint4*)(XN + (size_t)t * D))[lane * 2 + 1];
            xf[0] = bflo(a.x); xf[1] = bfhi(a.x); xf[2] = bflo(a.y); xf[3] = bfhi(a.y); xf[4] = bflo(a.z); xf[5] = bfhi(a.z); xf[6] = bflo(a.w); xf[7] = bfhi(a.w);
            xf[8] = bflo(b.x); xf[9] = bfhi(b.x); xf[10] = bflo(b.y); xf[11] = bfhi(b.y); xf[12] = bflo(b.z); xf[13] = bfhi(b.z); xf[14] = bflo(b.w); xf[15] = bfhi(b.w);
        }
#else
        const uint4 xa = ((const uint4*)(XN + (size_t)t * D))[lane], xb = ((const uint4*)(XN + (size_t)t * D))[64 + lane];
#endif
        float acc[16];
#pragma unroll
        for (int i = 0; i < 16; ++i) acc[i] = 0.f;
        for (int c = 0; c < 8; ++c) {
            const int esel = (c < 4) ? e_lo : e_hi;
            const int kb = (c & 3) * 16;
            float part[16];
#pragma unroll
            for (int hb = 0; hb < 2; ++hb) {
#if TAB_FP8
                uint4 r[8];
#pragma unroll
                for (int i = 0; i < 8; ++i) { const int e = __builtin_amdgcn_readlane(esel, kb + hb * 8 + i); r[i] = *(const uint4*)(U + (size_t)e * 1024 + lane * 16); }
#pragma unroll
                for (int i = 0; i < 8; ++i) {
                    float d0 = 0.f, d1 = 0.f;
                    const unsigned w[4] = {r[i].x, r[i].y, r[i].z, r[i].w};
#pragma unroll
                    for (int q = 0; q < 4; ++q) {
                        const auto lo = __builtin_amdgcn_cvt_pk_f32_fp8((int)w[q], false); const auto hh = __builtin_amdgcn_cvt_pk_f32_fp8((int)w[q], true);
                        d0 = fmaf(xf[4 * q], lo[0], d0); d1 = fmaf(xf[4 * q + 1], lo[1], d1); d0 = fmaf(xf[4 * q + 2], hh[0], d0); d1 = fmaf(xf[4 * q + 3], hh[1], d1);
                    }
                    part[hb * 8 + i] = d0 + d1;
                }
#else
                uint4 r0[8], r1[8];
#pragma unroll
                for (int i = 0; i < 8; ++i) { const int e = __builtin_amdgcn_readlane(esel, kb + hb * 8 + i); const unsigned char* rp = U + (size_t)e * 2048 + lane * 16; r0[i] = *(const uint4*)(rp); r1[i] = *(const uint4*)(rp + 1024); }
#pragma unroll
                for (int i = 0; i < 8; ++i) {
                    float d0 = 0.f, d1 = 0.f;
                    d0 = dot2bf(xa.x, r0[i].x, d0); d1 = dot2bf(xa.y, r0[i].y, d1); d0 = dot2bf(xa.z, r0[i].z, d0); d1 = dot2bf(xa.w, r0[i].w, d1);
                    d0 = dot2bf(xb.x, r1[i].x, d0); d1 = dot2bf(xb.y, r1[i].y, d1); d0 = dot2bf(xb.z, r1[i].z, d0); d1 = dot2bf(xb.w, r1[i].w, d1);
                    part[hb * 8 + i] = d0 + d1;
                }
#endif
            }
            float dsum = red16(part, lane);
            const int kk = c * 16 + (lane >> 2);
            const int eme = __shfl(esel, kb + (lane >> 2), 64);
            float wv = GATEp[(size_t)t * HK + kk];
#if TAB_FP8
            dsum *= SU[eme];
            wv *= SV[eme];
#endif
            wv *= gelu_exact(dsum);
#pragma unroll
            for (int hb = 0; hb < 2; ++hb) {
#if TAB_FP8
                uint4 r[8];
#pragma unroll
                for (int i = 0; i < 8; ++i) { const int e = __builtin_amdgcn_readlane(esel, kb + hb * 8 + i); r[i] = *(const uint4*)(V + (size_t)e * 1024 + lane * 16); }
#pragma unroll
                for (int i = 0; i < 8; ++i) {
                    const float w = __int_as_float(__builtin_amdgcn_readlane(__float_as_int(wv), (hb * 8 + i) * 4));
                    const unsigned ww[4] = {r[i].x, r[i].y, r[i].z, r[i].w};
#pragma unroll
                    for (int q = 0; q < 4; ++q) {
                        const auto lo = __builtin_amdgcn_cvt_pk_f32_fp8((int)ww[q], false); const auto hh = __builtin_amdgcn_cvt_pk_f32_fp8((int)ww[q], true);
                        acc[4 * q] = fmaf(w, lo[0], acc[4 * q]); acc[4 * q + 1] = fmaf(w, lo[1], acc[4 * q + 1]); acc[4 * q + 2] = fmaf(w, hh[0], acc[4 * q + 2]); acc[4 * q + 3] = fmaf(w, hh[1], acc[4 * q + 3]);
                    }
                }
#else
                uint4 r0[8], r1[8];
#pragma unroll
                for (int i = 0; i < 8; ++i) { const int e = __builtin_amdgcn_readlane(esel, kb + hb * 8 + i); const unsigned char* rp = V + (size_t)e * 2048 + lane * 16; r0[i] = *(const uint4*)(rp); r1[i] = *(const uint4*)(rp + 1024); }
#pragma unroll
                for (int i = 0; i < 8; ++i) {
                    const float w = __int_as_float(__builtin_amdgcn_readlane(__float_as_int(wv), (hb * 8 + i) * 4));
                    acc[0] = fmaf(w, bflo(r0[i].x), acc[0]); acc[1] = fmaf(w, bfhi(r0[i].x), acc[1]); acc[2] = fmaf(w, bflo(r0[i].y), acc[2]); acc[3] = fmaf(w, bfhi(r0[i].y), acc[3]);
                    acc[4] = fmaf(w, bflo(r0[i].z), acc[4]); acc[5] = fmaf(w, bfhi(r0[i].z), acc[5]); acc[6] = fmaf(w, bflo(r0[i].w), acc[6]); acc[7] = fmaf(w, bfhi(r0[i].w), acc[7]);
                    acc[8] = fmaf(w, bflo(r1[i].x), acc[8]); acc[9] = fmaf(w, bfhi(r1[i].x), acc[9]); acc[10] = fmaf(w, bflo(r1[i].y), acc[10]); acc[11] = fmaf(w, bfhi(r1[i].y), acc[11]);
                    acc[12] = fmaf(w, bflo(r1[i].z), acc[12]); acc[13] = fmaf(w, bfhi(r1[i].z), acc[13]); acc[14] = fmaf(w, bflo(r1[i].w), acc[14]); acc[15] = fmaf(w, bfhi(r1[i].w), acc[15]);
                }
#endif
            }
        }
        float* hrow = P.out + (size_t)t * D;
#if TAB_FP8
        const int c0 = lane * 16, c1 = lane * 16 + 8;
#else
        const int c0 = lane * 8, c1 = 512 + lane * 8;
#endif
        float4 h0 = *(const float4*)(hrow + c0), h1 = *(const float4*)(hrow + c0 + 4), h2 = *(const float4*)(hrow + c1), h3 = *(const float4*)(hrow + c1 + 4);
        h0.x += acc[0]; h0.y += acc[1]; h0.z += acc[2]; h0.w += acc[3]; h1.x += acc[4]; h1.y += acc[5]; h1.z += acc[6]; h1.w += acc[7];
        h2.x += acc[8]; h2.y += acc[9]; h2.z += acc[10]; h2.w += acc[11]; h3.x += acc[12]; h3.y += acc[13]; h3.z += acc[14]; h3.w += acc[15];
        float ss = h0.x * h0.x + h0.y * h0.y + h0.z * h0.z + h0.w * h0.w + h1.x * h1.x + h1.y * h1.y + h1.z * h1.z + h1.w * h1.w
                 + h2.x * h2.x + h2.y * h2.y + h2.z * h2.z + h2.w * h2.w + h3.x * h3.x + h3.y * h3.y + h3.z * h3.z + h3.w * h3.w;
        ss = wave_sum(ss);
        const float rn = rsqrtf(ss * (1.f / D) + EPS);
        if (l == DEPTH - 1) {
            const float* g = P.norm_final;
            const float4 g0 = *(const float4*)(g + c0), g1 = *(const float4*)(g + c0 + 4), g2 = *(const float4*)(g + c1), g3 = *(const float4*)(g + c1 + 4);
            *(float4*)(hrow + c0) = make_float4(h0.x * rn * g0.x, h0.y * rn * g0.y, h0.z * rn * g0.z, h0.w * rn * g0.w);
            *(float4*)(hrow + c0 + 4) = make_float4(h1.x * rn * g1.x, h1.y * rn * g1.y, h1.z * rn * g1.z, h1.w * rn * g1.w);
            *(float4*)(hrow + c1) = make_float4(h2.x * rn * g2.x, h2.y * rn * g2.y, h2.z * rn * g2.z, h2.w * rn * g2.w);
            *(float4*)(hrow + c1 + 4) = make_float4(h3.x * rn * g3.x, h3.y * rn * g3.y, h3.z * rn * g3.z, h3.w * rn * g3.w);
        } else {
            *(float4*)(hrow + c0) = h0; *(float4*)(hrow + c0 + 4) = h1; *(float4*)(hrow + c1) = h2; *(float4*)(hrow + c1 + 4) = h3;
            const float* g = P.norm_mix + (l + 1) * D;
            const float4 g0 = *(const float4*)(g + c0), g1 = *(const float4*)(g + c0 + 4), g2 = *(const float4*)(g + c1), g3 = *(const float4*)(g + c1 + 4);
            uint4 o0, o1;
            o0.x = pack2(h0.x * rn * g0.x, h0.y * rn * g0.y); o0.y = pack2(h0.z * rn * g0.z, h0.w * rn * g0.w); o0.z = pack2(h1.x * rn * g1.x, h1.y * rn * g1.y); o0.w = pack2(h1.z * rn * g1.z, h1.w * rn * g1.w);
            o1.x = pack2(h2.x * rn * g2.x, h2.y * rn * g2.y); o1.y = pack2(h2.z * rn * g2.z, h2.w * rn * g2.w); o1.z = pack2(h3.x * rn * g3.x, h3.y * rn * g3.y); o1.w = pack2(h3.z * rn * g3.z, h3.w * rn * g3.w);
            *(uint4*)(XNw + (size_t)t * D + c0) = o0; *(uint4*)(XNw + (size_t)t * D + c1) = o1;
        }
    }
}

constexpr int PH_PER_LAYER = 11;
constexpr int NPHASES = 1 + DEPTH * PH_PER_LAYER;

constexpr float QSCALE = 0.10206207261596575f * 1.4426950408889634f;
template <int s>
__device__ __forceinline__ void layer_phase(const Params& P, int l, char* lds) {
    unsigned char* ws = P.ws;
    float* sm = (float*)lds;
    bf16* XN = (bf16*)(ws + WS_XN);
    bf16* PROJ = (bf16*)(ws + WS_PROJ);
    const float* hin = (l == 0) ? P.x : P.out;
    if constexpr (s == 0) phase_norm(hin, P.norm_mix + l * D, XN);
    if constexpr (s == 1) {
        const bf16* W = (const bf16*)(ws + WS_WIN) + (size_t)l * DINP * D;
        gemm_mfma(XN, D, W, D, T, DINP, D, [&](int m0, int n0, const f32x16& acc, int r32, int hi) {
            const int n = n0 + r32;
            if (n < DIN) {
#pragma unroll
                for (int r = 0; r < 16; ++r) PROJ[(size_t)(m0 + crow(r, hi)) * DINP + n] = f2bf(acc[r]);
            }
        }, lds);
    }
    if constexpr (s == 2) phase_mixprep(P, l);
    if constexpr (s == 3) {
        const bf16* W = (const bf16*)(ws + WS_WUQ) + (size_t)l * 768 * QR;
        bf16* Qb = (bf16*)(ws + WS_Q);
        const float* rope = (const float*)(ws + WS_ROPE);
        gemm_mfma(PROJ + C_CQ, DINP, W, QR, T, 768, QR, [&](int m0, int n0, const f32x16& acc, int r32, int hi) {
            const int h = n0 / DQK, d0 = n0 % DQK;
            const int b = m0 / S, s0 = m0 % S;
            bf16* qb = Qb + ((size_t)(b * NH + h) * S + s0) * DQK + d0 + r32;
            if (d0 == 64) {
                const int f = r32 & 15;
#pragma unroll
                for (int r = 0; r < 16; ++r) {
                    const int sr = crow(r, hi);
                    const float v = acc[r], o = __shfl_xor(v, 16, 64);
                    const float2 cs = *(const float2*)(rope + ((size_t)(s0 + sr) * 16 + f) * 2);
                    const float res = (r32 < 16) ? (v * cs.x - o * cs.y) : (v * cs.x + o * cs.y);
                    qb[(size_t)sr * DQK] = f2bf(res * QSCALE);
                }
            } else {
#pragma unroll
                for (int r = 0; r < 16; ++r) qb[(size_t)crow(r, hi) * DQK] = f2bf(acc[r] * QSCALE);
            }
        }, lds);
    }
    if constexpr (s == 4) {
        const bf16* W = (const bf16*)(ws + WS_WUKV) + (size_t)l * 1024 * KVR;
        bf16* Kb = (bf16*)(ws + WS_K); bf16* Vb = (bf16*)(ws + WS_V);
        gemm_mfma(PROJ + C_CKV, DINP, W, KVR, T, 1024, KVR, [&](int m0, int n0, const f32x16& acc, int r32, int hi) {
            const int b = m0 / S, s0 = m0 % S;
            if (n0 < 512) {
                const int h = n0 >> 6, d = (n0 & 63) + r32;
                bf16* kb = Kb + ((size_t)(b * NH + h) * S + s0) * DQK + d;
#pragma unroll
                for (int r = 0; r < 16; ++r) kb[(size_t)crow(r, hi) * DQK] = f2bf(acc[r]);
            } else {
                const int h = (n0 - 512) >> 6, d = (n0 & 63) + r32;
                bf16* vb = Vb + ((size_t)(b * NH + h) * S + s0) * DV + d;
#pragma unroll
                for (int r = 0; r < 16; ++r) vb[(size_t)crow(r, hi) * DV] = f2bf(acc[r]);
            }
        }, lds);
    }
    if constexpr (s == 5) { }
#if ATTN_MFMA
    if constexpr (s == 6) phase_attn(P, lds);
#else
    if constexpr (s == 6) phase_attn_naive(P);
#endif
    if constexpr (s == 7) {
        const bf16* W = (const bf16*)(ws + WS_WOUT) + (size_t)l * D * D;
        float* out = P.out;
        gemm_mfma(XN, D, W, D, T, D, D, [&](int m0, int n0, const f32x16& acc, int r32, int hi) {
#pragma unroll
            for (int r = 0; r < 16; ++r) { const size_t idx = (size_t)(m0 + crow(r, hi)) * D + n0 + r32; out[idx] = hin[idx] + acc[r]; }
        }, lds);
    }
    if constexpr (s == 8) phase_norm(P.out, P.norm_ffn + l * D, XN);
    if constexpr (s == 9) {
        const bf16* W = (const bf16*)(ws + WS_WPQ) + (size_t)l * 2048 * D;
        bf16* QP = (bf16*)(ws + WS_QP);
        gemm_mfma(XN, D, W, D, T, 2048, D, [&](int m0, int n0, const f32x16& acc, int r32, int hi) {
#pragma unroll
            for (int r = 0; r < 16; ++r) QP[(size_t)(m0 + crow(r, hi)) * 2048 + n0 + r32] = f2bf(acc[r]);
        }, lds);
    }
    if constexpr (s == 10) phase_topk_naive(P, l, sm);
}

__device__ __forceinline__ void layer_phase_dyn(const Params& P, int l, int s, char* sm) {
    switch (s) {
    case 0: layer_phase<0>(P, l, sm); break; case 1: layer_phase<1>(P, l, sm); break; case 2: layer_phase<2>(P, l, sm); break;
    case 3: layer_phase<3>(P, l, sm); break; case 4: layer_phase<4>(P, l, sm); break; case 5: layer_phase<5>(P, l, sm); break;
    case 6: layer_phase<6>(P, l, sm); break; case 7: layer_phase<7>(P, l, sm); break; case 8: layer_phase<8>(P, l, sm); break;
    case 9: layer_phase<9>(P, l, sm); break; case 10: layer_phase<10>(P, l, sm); break; default: phase_gather_naive(P, l); break;
    }
}
#if !ONE_LAUNCH
__global__ void __launch_bounds__(NTHREADS, 2) k_phase(Params P, int ph) {
    __shared__ __attribute__((aligned(16))) char sm[GEMM_LDS];
    if (ph == 0) { phase_prep(P); return; }
    layer_phase_dyn(P, (ph - 1) / (PH_PER_LAYER + 1), (ph - 1) % (PH_PER_LAYER + 1), sm);
}
#else
#define GSYNC() grid.sync()
__global__ void __launch_bounds__(NTHREADS, 2) k_all(Params P) {
    __shared__ __attribute__((aligned(16))) char sm[GEMM_LDS];
    cg::grid_group grid = cg::this_grid();
    { const Params Q = launder(P); phase_prep(Q); } GSYNC();
    for (int l = 0; l < DEPTH; ++l) {
#define LP(s) { const Params Q = launder(P); layer_phase<s>(Q, l, sm); }
        if (l == 0) { LP(0); GSYNC(); }
        LP(1); GSYNC();
        LP(2); GSYNC();
        LP(3);
        LP(4); GSYNC();
        LP(6); GSYNC();
        LP(7); GSYNC();
        LP(8); GSYNC();
        LP(9); GSYNC();
        LP(10); GSYNC();
        { const Params Q = launder(P); phase_gather(Q, l); } GSYNC();
    }
}
#endif

extern "C" void kernel_launch(void* const* d_in, const int* in_sizes, int n_in, void* d_out, int out_size, void* d_ws, size_t ws_size, hipStream_t stream) {
    static int grid = 0;
    if (grid == 0) {
        if (n_in != 18 || out_size != T * D || ws_size < WS_END) { fprintf(stderr, "kernel_launch: bad sizes n_in %d out %d ws %zu need %zu\n", n_in, out_size, ws_size, (size_t)WS_END); grid = -1; return; }
        int dev = 0, cus = 0, per_cu = 0;
        hipGetDevice(&dev);
        hipDeviceGetAttribute(&cus, hipDeviceAttributeMultiprocessorCount, dev);
#if ONE_LAUNCH
        hipOccupancyMaxActiveBlocksPerMultiprocessor(&per_cu, (const void*)k_all, NTHREADS, 0);
#else
        hipOccupancyMaxActiveBlocksPerMultiprocessor(&per_cu, (const void*)k_phase, NTHREADS, 0);
#endif
        if (per_cu > 2) per_cu = 2;
        if (per_cu < 1) { fprintf(stderr, "kernel_launch: occupancy query says %d\n", per_cu); grid = -1; return; }
        grid = cus * per_cu;
    }
    if (grid < 0) return;
    Params p{};
    p.x = (const float*)d_in[0]; p.norm_mix = (const float*)d_in[1]; p.w_in = (const float*)d_in[2]; p.conv_w = (const float*)d_in[3];
    p.pool_w = (const float*)d_in[4]; p.pool_scale = (const float*)d_in[5]; p.q_norm = (const float*)d_in[6]; p.w_uq = (const float*)d_in[7];
    p.kv_norm = (const float*)d_in[8]; p.w_uk = (const float*)d_in[9]; p.w_uv = (const float*)d_in[10]; p.w_out = (const float*)d_in[11];
    p.norm_ffn = (const float*)d_in[12]; p.peer_wq = (const float*)d_in[13]; p.peer_subkeys = (const float*)d_in[14]; p.peer_u = (const float*)d_in[15];
    p.peer_v = (const float*)d_in[16]; p.norm_final = (const float*)d_in[17];
    p.out = (float*)d_out; p.ws = (unsigned char*)d_ws;
#if ONE_LAUNCH
    void* args[] = {&p};
    hipError_t e = hipLaunchCooperativeKernel((const void*)k_all, dim3(grid), dim3(NTHREADS), args, 0, stream);
    if (e != hipSuccess) fprintf(stderr, "cooperative launch failed: %s (grid %d)\n", hipGetErrorString(e), grid);
#else
    for (int ph = 0; ph < 1 + DEPTH * (PH_PER_LAYER + 1); ++ph) hipLaunchKernelGGL(k_phase, dim3(grid), dim3(NTHREADS), 0, stream, p, ph);
#endif
}
```

```cpp
#include <hip/hip_runtime.h>
#include <hip/hip_cooperative_groups.h>
#include <cstdio>
#include <cstdint>
namespace cg = cooperative_groups;

#ifndef ATTN_MFMA
#define ATTN_MFMA 1
#endif
#ifndef TAB_FP8
#define TAB_FP8 1
#endif
#ifndef ONE_LAUNCH
#define ONE_LAUNCH 1
#endif

constexpr int NB = 4, S = 8192, T = NB * S, D = 1024, DEPTH = 2;
constexpr int DIN = 1696, DINP = 1792;
constexpr int C_BG = 0, C_CG = 256, C_HC = 512, C_HP = 768, C_CQ = 1024, C_CKV = 1408, C_KR = 1664;
constexpr int QR = 384, KVR = 256, NH = 8, DQK = 96, DV = 64;
constexpr int PH = 8, NKEY = 128, NEXP = NKEY * NKEY, TOPK = 16, HK = PH * TOPK;
constexpr float EPS = 1e-6f;

typedef unsigned short bf16;

constexpr size_t MB = 1024 * 1024;
constexpr size_t WS_CTL   = 0;
constexpr size_t WS_ROPE  = 64 * 1024;
constexpr size_t WS_WIN   = WS_ROPE + (size_t)S * 16 * 2 * 4;
constexpr size_t WS_WUQ   = WS_WIN + (size_t)DEPTH * DINP * D * 2;
constexpr size_t WS_WUKV  = WS_WUQ + (size_t)DEPTH * 768 * QR * 2;
constexpr size_t WS_WOUT  = WS_WUKV + (size_t)DEPTH * 1024 * KVR * 2;
constexpr size_t WS_WPQ   = WS_WOUT + (size_t)DEPTH * D * D * 2;
constexpr size_t WS_XN    = ((WS_WPQ + (size_t)DEPTH * 2048 * D * 2 + 4095) / 4096) * 4096;
constexpr size_t WS_PROJ  = WS_XN + (size_t)T * D * 2;
constexpr size_t WS_Q     = WS_PROJ + (size_t)T * DINP * 2;
constexpr size_t WS_K     = WS_Q + (size_t)T * NH * DQK * 2;
constexpr size_t WS_V     = WS_K + (size_t)T * NH * DQK * 2;
constexpr size_t WS_EXP   = WS_V + (size_t)T * NH * DV * 2;
constexpr size_t WS_GATE  = WS_EXP + (size_t)T * HK * 4;
constexpr size_t TAB_ROWB = TAB_FP8 ? 1024 : 2048;
constexpr size_t WS_TABU  = WS_GATE + (size_t)T * HK * 4;
constexpr size_t WS_TABV  = WS_TABU + (size_t)DEPTH * NEXP * TAB_ROWB;
constexpr size_t WS_TSCU  = WS_TABV + (size_t)DEPTH * NEXP * TAB_ROWB;
constexpr size_t WS_TSCV  = WS_TSCU + (size_t)DEPTH * NEXP * 4;
constexpr size_t WS_END   = WS_TSCV + (size_t)DEPTH * NEXP * 4;
static_assert(WS_END <= (size_t)512 * 1024 * 1024, "workspace budget");
constexpr size_t WS_QP    = WS_PROJ;
static_assert((size_t)T * 2048 * 2 <= WS_K - WS_PROJ, "QP alias");

struct Params {
    const float* x; const float* norm_mix; const float* w_in; const float* conv_w; const float* pool_w; const float* pool_scale;
    const float* q_norm; const float* w_uq; const float* kv_norm; const float* w_uk; const float* w_uv; const float* w_out;
    const float* norm_ffn; const float* peer_wq; const float* peer_subkeys; const float* peer_u; const float* peer_v; const float* norm_final;
    float* out; unsigned char* ws;
};

__device__ __forceinline__ bf16 f2bf(float f) { unsigned u = __float_as_uint(f); u += 0x7fffu + ((u >> 16) & 1u); return (bf16)(u >> 16); }
__device__ __forceinline__ float bf2f(bf16 h) { return __uint_as_float(((unsigned)h) << 16); }
__device__ __forceinline__ float bflo(unsigned u) { return __uint_as_float(u << 16); }
__device__ __forceinline__ float bfhi(unsigned u) { return __uint_as_float(u & 0xffff0000u); }
__device__ __forceinline__ unsigned pack2(float a, float b) { return (unsigned)f2bf(a) | ((unsigned)f2bf(b) << 16); }
__device__ __forceinline__ float wave_sum(float v) {
#pragma unroll
    for (int m = 32; m >= 1; m >>= 1) v += __shfl_xor(v, m, 64);
    return v;
}
__device__ __forceinline__ float gelu_exact(float x) { return 0.5f * x * (1.f + erff(x * 0.70710678118654752f)); }

#define NTHREADS 256
__device__ __forceinline__ int tidx() { int t = (int)__builtin_amdgcn_workitem_id_x(); asm volatile("" : "+v"(t)); return t; }
__device__ __forceinline__ int gwave() { return blockIdx.x * (NTHREADS / 64) + (tidx() >> 6); }
__device__ __forceinline__ int nwave() { return gridDim.x * (NTHREADS / 64); }
__device__ __forceinline__ size_t gtid() { return (size_t)blockIdx.x * NTHREADS + tidx(); }
__device__ __forceinline__ size_t gnth() { return (size_t)gridDim.x * NTHREADS; }


__device__ __forceinline__ Params launder(const Params& P) {
    Params Q = P;
    asm volatile("" : "+s"(Q.x), "+s"(Q.norm_mix), "+s"(Q.w_in), "+s"(Q.conv_w), "+s"(Q.pool_w), "+s"(Q.pool_scale), "+s"(Q.q_norm), "+s"(Q.w_uq), "+s"(Q.kv_norm), "+s"(Q.w_uk));
    asm volatile("" : "+s"(Q.w_uv), "+s"(Q.w_out), "+s"(Q.norm_ffn), "+s"(Q.peer_wq), "+s"(Q.peer_subkeys), "+s"(Q.peer_u), "+s"(Q.peer_v), "+s"(Q.norm_final), "+s"(Q.out), "+s"(Q.ws));
    return Q;
}

template <class AL, class BL, class EP>
__device__ __forceinline__ void gemm_naive(int M, int N, int K, AL aload, BL bload, EP epi, float* sm) {
    float (*As)[68] = (float (*)[68])sm;
    float (*Bs)[68] = (float (*)[68])(sm + 16 * 68);
    const int tid = tidx(), tx = tid & 15, ty = tid >> 4;
    const int tilesN = (N + 63) / 64, tilesM = M / 64;
    for (int tile = blockIdx.x; tile < tilesM * tilesN; tile += gridDim.x) {
        const int tm = tile / tilesN, tn = tile % tilesN;
        const int row0 = tm * 64, col0 = tn * 64;
        float acc[4][4];
#pragma unroll
        for (int i = 0; i < 4; ++i)
#pragma unroll
            for (int j = 0; j < 4; ++j) acc[i][j] = 0.f;
        for (int k0 = 0; k0 < K; k0 += 16) {
            {
                const int r = tid >> 2, kk = (tid & 3) * 4;
#pragma unroll
                for (int i = 0; i < 4; ++i) As[kk + i][r] = aload(row0 + r, k0 + kk + i);
            }
            {
                const int kk = tid >> 4, c = (tid & 15) * 4;
#pragma unroll
                for (int j = 0; j < 4; ++j) { const int col = col0 + c + j; Bs[kk][c + j] = (col < N) ? bload(k0 + kk, col) : 0.f; }
            }
            __syncthreads();
#pragma unroll
            for (int kk = 0; kk < 16; ++kk) {
                float a[4], b[4];
#pragma unroll
                for (int i = 0; i < 4; ++i) a[i] = As[kk][ty * 4 + i];
#pragma unroll
                for (int j = 0; j < 4; ++j) b[j] = Bs[kk][tx * 4 + j];
#pragma unroll
                for (int i = 0; i < 4; ++i)
#pragma unroll
                    for (int j = 0; j < 4; ++j) acc[i][j] = fmaf(a[i], b[j], acc[i][j]);
            }
            __syncthreads();
        }
#pragma unroll
        for (int i = 0; i < 4; ++i)
#pragma unroll
            for (int j = 0; j < 4; ++j) { const int col = col0 + tx * 4 + j; if (col < N) epi(row0 + ty * 4 + i, col, acc[i][j]); }
    }
}


typedef __attribute__((ext_vector_type(8))) short bf16x8;
typedef __attribute__((ext_vector_type(16))) float f32x16;
#define MFMA32(a, b, c) __builtin_amdgcn_mfma_f32_32x32x16_bf16(a, b, c, 0, 0, 0)
__device__ __forceinline__ int crow(int r, int hi) { return (r & 3) + 8 * (r >> 2) + 4 * hi; }
constexpr int G_LDT = 144;
constexpr int G_OPB = 128 * G_LDT;
constexpr int G_BUF = 2 * G_OPB;
constexpr int GEMM_LDS = 2 * G_BUF;

template <class EPI>
__device__ __forceinline__ void gemm_mfma(const bf16* __restrict__ A, int lda, const bf16* __restrict__ Bt, int ldb, int M, int N, int K, EPI epi, char* lds) {
    const int tid = tidx(), lane = tid & 63, w = tid >> 6, r32 = lane & 31, hi = lane >> 5;
    const int wm = w >> 1, wn = w & 1;
    const int tilesN = N / 128, tilesM = M / 128, nk = K / 64;
    const int srow = tid >> 3, sch = tid & 7;
    for (int tile = blockIdx.x; tile < tilesM * tilesN; tile += gridDim.x) {
        const int tm = tile / tilesN, tn = tile % tilesN;
        const bf16* Ag = A + (size_t)(tm * 128 + srow) * lda + sch * 8;
        const bf16* Bg = Bt + (size_t)(tn * 128 + srow) * ldb + sch * 8;
        f32x16 acc[2][2];
#pragma unroll
        for (int i = 0; i < 2; ++i)
#pragma unroll
            for (int j = 0; j < 2; ++j)
#pragma unroll
                for (int r = 0; r < 16; ++r) acc[i][j][r] = 0.f;
        uint4 ra0, ra1, ra2, ra3, rb0, rb1, rb2, rb3;
#define G_LOAD(kofs) do { \
        ra0 = *(const uint4*)(Ag + (kofs)); ra1 = *(const uint4*)(Ag + (size_t)32 * lda + (kofs)); ra2 = *(const uint4*)(Ag + (size_t)64 * lda + (kofs)); ra3 = *(const uint4*)(Ag + (size_t)96 * lda + (kofs)); \
        rb0 = *(const uint4*)(Bg + (kofs)); rb1 = *(const uint4*)(Bg + (size_t)32 * ldb + (kofs)); rb2 = *(const uint4*)(Bg + (size_t)64 * ldb + (kofs)); rb3 = *(const uint4*)(Bg + (size_t)96 * ldb + (kofs)); } while (0)
        G_LOAD(0);
        for (int kt = 0; kt < nk; ++kt) {
            char* bA = lds + (kt & 1) * G_BUF; char* bB = bA + G_OPB;
            {
                char* wa = bA + srow * G_LDT + sch * 16; char* wb = bB + srow * G_LDT + sch * 16;
                *(uint4*)(wa) = ra0; *(uint4*)(wa + 32 * G_LDT) = ra1; *(uint4*)(wa + 64 * G_LDT) = ra2; *(uint4*)(wa + 96 * G_LDT) = ra3;
                *(uint4*)(wb) = rb0; *(uint4*)(wb + 32 * G_LDT) = rb1; *(uint4*)(wb + 64 * G_LDT) = rb2; *(uint4*)(wb + 96 * G_LDT) = rb3;
            }
            __syncthreads();
            if (kt + 1 < nk) G_LOAD((kt + 1) * 64);
            const char* pa = bA + (wm * 64 + r32) * G_LDT + hi * 16;
            const char* pb = bB + (wn * 64 + r32) * G_LDT + hi * 16;
#pragma unroll
            for (int ks = 0; ks < 4; ++ks) {
                const bf16x8 a0 = *(const bf16x8*)(pa + ks * 32), a1 = *(const bf16x8*)(pa + 32 * G_LDT + ks * 32);
                const bf16x8 b0 = *(const bf16x8*)(pb + ks * 32), b1 = *(const bf16x8*)(pb + 32 * G_LDT + ks * 32);
                acc[0][0] = MFMA32(a0, b0, acc[0][0]); acc[0][1] = MFMA32(a0, b1, acc[0][1]);
                acc[1][0] = MFMA32(a1, b0, acc[1][0]); acc[1][1] = MFMA32(a1, b1, acc[1][1]);
            }
        }
#pragma unroll
        for (int i = 0; i < 2; ++i)
#pragma unroll
            for (int j = 0; j < 2; ++j) epi(tm * 128 + wm * 64 + i * 32, tn * 128 + wn * 64 + j * 32, acc[i][j], r32, hi);
        __syncthreads();
    }
}

__device__ __forceinline__ void transpose_bf16(const float* __restrict__ W, bf16* __restrict__ Wt, int K, int N, int Npad) {
    const size_t tot = (size_t)Npad * K;
    for (size_t i = gtid(); i < tot; i += gnth()) {
        const int n = (int)(i / K), k = (int)(i % K);
        Wt[i] = (n < N) ? f2bf(W[(size_t)k * N + n]) : (bf16)0;
    }
}

__device__ __forceinline__ void convert_table(const float* __restrict__ src, unsigned char* __restrict__ dst, float* __restrict__ scl, int rows) {
    const int lane = tidx() & 63;
    for (int r = gwave(); r < rows; r += nwave()) {
        const float4* sr = (const float4*)(src + (size_t)r * D);
        if (TAB_FP8) {
            float4 v[4]; float am = 0.f;
#pragma unroll
            for (int j = 0; j < 4; ++j) { v[j] = sr[lane * 4 + j]; am = fmaxf(am, fmaxf(fmaxf(fabsf(v[j].x), fabsf(v[j].y)), fmaxf(fabsf(v[j].z), fabsf(v[j].w)))); }
#pragma unroll
            for (int m = 32; m >= 1; m >>= 1) am = fmaxf(am, __shfl_xor(am, m, 64));
            const float sc = (am > 0.f) ? am * (1.f / 448.f) : 1.f;
            const float is = 1.f / sc;
            uint4 o;
            { int w = 0; w = __builtin_amdgcn_cvt_pk_fp8_f32(v[0].x * is, v[0].y * is, w, false); w = __builtin_amdgcn_cvt_pk_fp8_f32(v[0].z * is, v[0].w * is, w, true); o.x = (unsigned)w; }
            { int w = 0; w = __builtin_amdgcn_cvt_pk_fp8_f32(v[1].x * is, v[1].y * is, w, false); w = __builtin_amdgcn_cvt_pk_fp8_f32(v[1].z * is, v[1].w * is, w, true); o.y = (unsigned)w; }
            { int w = 0; w = __builtin_amdgcn_cvt_pk_fp8_f32(v[2].x * is, v[2].y * is, w, false); w = __builtin_amdgcn_cvt_pk_fp8_f32(v[2].z * is, v[2].w * is, w, true); o.z = (unsigned)w; }
            { int w = 0; w = __builtin_amdgcn_cvt_pk_fp8_f32(v[3].x * is, v[3].y * is, w, false); w = __builtin_amdgcn_cvt_pk_fp8_f32(v[3].z * is, v[3].w * is, w, true); o.w = (unsigned)w; }
            *(uint4*)(dst + (size_t)r * 1024 + lane * 16) = o;
            if (lane == 0) scl[r] = sc;
        } else {
#pragma unroll
            for (int j = 0; j < 2; ++j) {
                const float4 a = sr[j * 128 + lane * 2], b = sr[j * 128 + lane * 2 + 1];
                uint4 o; o.x = pack2(a.x, a.y); o.y = pack2(a.z, a.w); o.z = pack2(b.x, b.y); o.w = pack2(b.z, b.w);
                *(uint4*)(dst + (size_t)r * 2048 + j * 1024 + lane * 16) = o;
            }
        }
    }
}
__device__ __forceinline__ void phase_prep(const Params& P) {
    unsigned char* ws = P.ws;
    for (int l = 0; l < DEPTH; ++l) {
        transpose_bf16(P.w_in + (size_t)l * D * DIN, (bf16*)(ws + WS_WIN) + (size_t)l * DINP * D, D, DIN, DINP);
        transpose_bf16(P.w_uq + (size_t)l * QR * 768, (bf16*)(ws + WS_WUQ) + (size_t)l * 768 * QR, QR, 768, 768);
        transpose_bf16(P.w_uk + (size_t)l * KVR * 512, (bf16*)(ws + WS_WUKV) + (size_t)l * 1024 * KVR, KVR, 512, 512);
        transpose_bf16(P.w_uv + (size_t)l * KVR * 512, (bf16*)(ws + WS_WUKV) + (size_t)l * 1024 * KVR + (size_t)512 * KVR, KVR, 512, 512);
        transpose_bf16(P.w_out + (size_t)l * D * D, (bf16*)(ws + WS_WOUT) + (size_t)l * D * D, D, D, D);
        transpose_bf16(P.peer_wq + (size_t)l * D * 2048, (bf16*)(ws + WS_WPQ) + (size_t)l * 2048 * D, D, 2048, 2048);
    }
    convert_table(P.peer_u, ws + WS_TABU, (float*)(ws + WS_TSCU), DEPTH * NEXP);
    convert_table(P.peer_v, ws + WS_TABV, (float*)(ws + WS_TSCV), DEPTH * NEXP);
    float* rope = (float*)(ws + WS_ROPE);
    for (size_t i = gtid(); i < (size_t)S * 16; i += gnth()) {
        const int s = (int)(i >> 4), f = (int)(i & 15);
        const double inv = pow(10000.0, -(double)f / 16.0);
        const double ang = (double)s * inv;
        rope[2 * i] = (float)cos(ang); rope[2 * i + 1] = (float)sin(ang);
    }
}

__device__ __forceinline__ void phase_norm(const float* __restrict__ h, const float* __restrict__ g, bf16* __restrict__ xn) {
    const int lane = tidx() & 63;
    for (int t = gwave(); t < T; t += nwave()) {
        const float4* hr = (const float4*)(h + (size_t)t * D);
        float4 v[4]; float ss = 0.f;
#pragma unroll
        for (int j = 0; j < 4; ++j) { v[j] = hr[j * 64 + lane]; ss += v[j].x * v[j].x + v[j].y * v[j].y + v[j].z * v[j].z + v[j].w * v[j].w; }
        ss = wave_sum(ss);
        const float r = rsqrtf(ss * (1.f / D) + EPS);
#pragma unroll
        for (int j = 0; j < 4; ++j) {
            const float4 gg = ((const float4*)g)[j * 64 + lane];
            uint2 o; o.x = pack2(v[j].x * r * gg.x, v[j].y * r * gg.y); o.y = pack2(v[j].z * r * gg.z, v[j].w * r * gg.w);
            ((uint2*)(xn + (size_t)t * D))[j * 64 + lane] = o;
        }
    }
}

__device__ __forceinline__ void phase_mixprep(const Params& P, int l) {
    unsigned char* ws = P.ws;
    bf16* proj = (bf16*)(ws + WS_PROJ);
    bf16* Y = (bf16*)(ws + WS_XN);
    bf16* Kb = (bf16*)(ws + WS_K);
    const float* rope = (const float*)(ws + WS_ROPE);
    const float* qn = P.q_norm + l * QR; const float* kvn = P.kv_norm + l * KVR;
    const float* cw = P.conv_w + (size_t)l * 3 * 256;
    const float* pw = P.pool_w + (size_t)l * 4 * 64 * 64;
    const float* psc = P.pool_scale + l * 256;
    const int lane = tidx() & 63;
    for (int t = gwave(); t < T; t += nwave()) {
        const int b = t / S, s = t % S;
        bf16* pr = proj + (size_t)t * DINP;
        {
            float v[6]; float ss = 0.f;
#pragma unroll
            for (int j = 0; j < 6; ++j) { v[j] = bf2f(pr[C_CQ + j * 64 + lane]); ss += v[j] * v[j]; }
            ss = wave_sum(ss);
            const float r = rsqrtf(ss * (1.f / QR) + EPS);
#pragma unroll
            for (int j = 0; j < 6; ++j) pr[C_CQ + j * 64 + lane] = f2bf(v[j] * r * qn[j * 64 + lane]);
        }
        {
            float v[4]; float ss = 0.f;
#pragma unroll
            for (int j = 0; j < 4; ++j) { v[j] = bf2f(pr[C_CKV + j * 64 + lane]); ss += v[j] * v[j]; }
            ss = wave_sum(ss);
            const float r = rsqrtf(ss * (1.f / KVR) + EPS);
#pragma unroll
            for (int j = 0; j < 4; ++j) pr[C_CKV + j * 64 + lane] = f2bf(v[j] * r * kvn[j * 64 + lane]);
        }
        if (lane < 16) {
            const float x1 = bf2f(pr[C_KR + lane]), x2 = bf2f(pr[C_KR + 16 + lane]);
            const float c = rope[(s * 16 + lane) * 2], sn = rope[(s * 16 + lane) * 2 + 1];
            const bf16 o1 = f2bf(x1 * c - x2 * sn), o2 = f2bf(x2 * c + x1 * sn);
#pragma unroll
            for (int h = 0; h < NH; ++h) {
                bf16* kr = Kb + ((size_t)(b * NH + h) * S + s) * DQK;
                kr[64 + lane] = o1; kr[80 + lane] = o2;
            }
        }
#pragma unroll
        for (int r = 0; r < 4; ++r) {
            const int c = r * 64 + lane;
            float acc = 0.f;
#pragma unroll
            for (int j = 0; j < 3; ++j) {
                const int sp = s - 2 + j;
                if (sp >= 0) {
                    const bf16* pp = proj + (size_t)(t - 2 + j) * DINP;
                    acc += cw[j * 256 + c] * (bf2f(pp[C_CG + c]) * bf2f(pp[C_HC + c]));
                }
            }
            Y[(size_t)t * D + c] = f2bf(bf2f(pr[C_BG + c]) * acc);
        }
        const int wins[4] = {2, 4, 8, 16};
#pragma unroll
        for (int g = 0; g < 4; ++g) {
            const int w = wins[g];
            const int lo = (s + 1 - w) > 0 ? (s + 1 - w) : 0;
            const int cnt = s + 1 - lo;
            float sum = 0.f;
            for (int sp = lo; sp <= s; ++sp) sum += bf2f(proj[(size_t)(b * S + sp) * DINP + C_HP + g * 64 + lane]);
            const float pooled = sum / (float)cnt - bf2f(pr[C_HP + g * 64 + lane]);
            float m = 0.f;
            for (int c = 0; c < 64; ++c) m = fmaf(__shfl(pooled, c, 64), pw[(g * 64 + c) * 64 + lane], m);
            Y[(size_t)t * D + 256 + g * 64 + lane] = f2bf(m * psc[g * 64 + lane]);
        }
    }
}

__device__ __forceinline__ void phase_qrope(const Params& P) {
    bf16* Qb = (bf16*)(P.ws + WS_Q);
    const float* rope = (const float*)(P.ws + WS_ROPE);
    const size_t tot = (size_t)T * NH * 16;
    for (size_t i = gtid(); i < tot; i += gnth()) {
        const int f = (int)(i & 15); const size_t row = i >> 4;
        const int s = (int)(row % S);
        bf16* q = Qb + row * DQK;
        const float x1 = bf2f(q[64 + f]), x2 = bf2f(q[80 + f]);
        const float c = rope[(s * 16 + f) * 2], sn = rope[(s * 16 + f) * 2 + 1];
        q[64 + f] = f2bf(x1 * c - x2 * sn); q[80 + f] = f2bf(x2 * c + x1 * sn);
    }
}

__device__ __forceinline__ void phase_attn_naive(const Params& P) {
    const bf16* Qb = (const bf16*)(P.ws + WS_Q);
    const bf16* Kb = (const bf16*)(P.ws + WS_K);
    const bf16* Vb = (const bf16*)(P.ws + WS_V);
    bf16* Y = (bf16*)(P.ws + WS_XN);
    const int lane = tidx() & 63, qr = lane & 31, half = lane >> 5;
    const int gw = gwave(), nw = nwave();
    const int total = NB * NH * (S / 32);
    for (int pass = 0; pass * nw < total; ++pass) {
        const int u = (pass & 1) ? ((pass + 1) * nw - 1 - gw) : (pass * nw + gw);
        if (u >= total) continue;
        const int qblk = (S / 32 - 1) - (u >> 5), bh = u & 31;
        const int qpos = qblk * 32 + qr;
        unsigned q[DQK / 2];
        {
            const uint4* qp = (const uint4*)(Qb + ((size_t)bh * S + qpos) * DQK);
#pragma unroll
            for (int c = 0; c < 12; ++c) { const uint4 v = qp[c]; q[c * 4 + 0] = v.x; q[c * 4 + 1] = v.y; q[c * 4 + 2] = v.z; q[c * 4 + 3] = v.w; }
        }
        float o[32];
#pragma unroll
        for (int d = 0; d < 32; ++d) o[d] = 0.f;
        float m = -3.0e38f, lsum = 0.f;
        const int kmax = qblk * 32 + 31;
        const bf16* Kp = Kb + (size_t)bh * S * DQK;
        const bf16* Vp = Vb + (size_t)bh * S * DV + half * 32;
        for (int j = 0; j <= kmax; ++j) {
            const uint4* kr = (const uint4*)(Kp + (size_t)j * DQK);
            float sc = 0.f;
#pragma unroll
            for (int c = 0; c < 12; ++c) {
                const uint4 v = kr[c];
                sc = fmaf(bflo(q[c * 4 + 0]), bflo(v.x), sc); sc = fmaf(bfhi(q[c * 4 + 0]), bfhi(v.x), sc);
                sc = fmaf(bflo(q[c * 4 + 1]), bflo(v.y), sc); sc = fmaf(bfhi(q[c * 4 + 1]), bfhi(v.y), sc);
                sc = fmaf(bflo(q[c * 4 + 2]), bflo(v.z), sc); sc = fmaf(bfhi(q[c * 4 + 2]), bfhi(v.z), sc);
                sc = fmaf(bflo(q[c * 4 + 3]), bflo(v.w), sc); sc = fmaf(bfhi(q[c * 4 + 3]), bfhi(v.w), sc);
            }
            if (j <= qpos) {
                const float mn = fmaxf(m, sc);
                const float alpha = exp2f(m - mn);
                const float p = exp2f(sc - mn);
                lsum = lsum * alpha + p; m = mn;
                const uint4* vr = (const uint4*)(Vp + (size_t)j * DV);
#pragma unroll
                for (int c = 0; c < 4; ++c) {
                    const uint4 v = vr[c];
                    o[c * 8 + 0] = fmaf(p, bflo(v.x), o[c * 8 + 0] * alpha); o[c * 8 + 1] = fmaf(p, bfhi(v.x), o[c * 8 + 1] * alpha);
                    o[c * 8 + 2] = fmaf(p, bflo(v.y), o[c * 8 + 2] * alpha); o[c * 8 + 3] = fmaf(p, bfhi(v.y), o[c * 8 + 3] * alpha);
                    o[c * 8 + 4] = fmaf(p, bflo(v.z), o[c * 8 + 4] * alpha); o[c * 8 + 5] = fmaf(p, bfhi(v.z), o[c * 8 + 5] * alpha);
                    o[c * 8 + 6] = fmaf(p, bflo(v.w), o[c * 8 + 6] * alpha); o[c * 8 + 7] = fmaf(p, bfhi(v.w), o[c * 8 + 7] * alpha);
                }
            }
        }
        const float inv = 1.f / lsum;
        const int b = bh >> 3, h = bh & 7;
        uint4* yo = (uint4*)(Y + ((size_t)(b * S + qpos)) * D + 512 + h * 64 + half * 32);
#pragma unroll
        for (int c = 0; c < 4; ++c) {
            uint4 v;
            v.x = pack2(o[c * 8 + 0] * inv, o[c * 8 + 1] * inv); v.y = pack2(o[c * 8 + 2] * inv, o[c * 8 + 3] * inv);
            v.z = pack2(o[c * 8 + 4] * inv, o[c * 8 + 5] * inv); v.w = pack2(o[c * 8 + 6] * inv, o[c * 8 + 7] * inv);
            yo[c] = v;
        }
    }
}


typedef short v4i16_t __attribute__((ext_vector_type(4)));
typedef __attribute__((address_space(3))) v4i16_t* lds_v4p;
__device__ __forceinline__ unsigned cvtpk(float lo, float hi) { unsigned r; asm("v_cvt_pk_bf16_f32 %0, %1, %2" : "=v"(r) : "v"(lo), "v"(hi)); return r; }
__device__ __forceinline__ v4i16_t vtr(const char* p) { return __builtin_amdgcn_ds_read_tr16_b64_v4i16((lds_v4p)p); }
constexpr int A_KP = 208, A_VP = 192;
constexpr int A_KB = 64 * A_KP, A_VB = 64 * A_VP, A_BUF = A_KB + A_VB, ATTN_LDS = 2 * A_BUF;
static_assert(ATTN_LDS <= GEMM_LDS, "attention LDS");

__device__ __forceinline__ void attn_unit(const bf16* __restrict__ Qb, const bf16* __restrict__ Kb, const bf16* __restrict__ Vb, bf16* __restrict__ Y, int bh, int qblk, char* lds) {
    const int tid = tidx(), lane = tid & 63, w = tid >> 6, r32 = lane & 31, hi = lane >> 5;
    const int q0 = qblk * 128, qw0 = q0 + w * 32;
    const int NT = 2 * qblk + 2;
    bf16x8 qf[6];
    {
        const bf16* qp = Qb + ((size_t)bh * S + qw0 + r32) * DQK + hi * 8;
#pragma unroll
        for (int ks = 0; ks < 6; ++ks) qf[ks] = *(const bf16x8*)(qp + ks * 16);
    }
    f32x16 o0, o1;
#pragma unroll
    for (int r = 0; r < 16; ++r) { o0[r] = 0.f; o1[r] = 0.f; }
    float m = -1e30f, lsum = 0.f;
    const char* Kg = (const char*)(Kb + (size_t)bh * S * DQK) + tid * 16;
    const char* Vg = (const char*)(Vb + (size_t)bh * S * DV) + tid * 16;
    const int kl0 = (tid / 12) * A_KP + (tid % 12) * 16, kl1 = ((tid + 256) / 12) * A_KP + ((tid + 256) % 12) * 16, kl2 = ((tid + 512) / 12) * A_KP + ((tid + 512) % 12) * 16;
    const int vl0 = (tid >> 3) * A_VP + (tid & 7) * 16, vl1 = vl0 + 32 * A_VP;
    uint4 k0, k1, k2, v0, v1;
#define A_LOAD(t) do { const char* kg = Kg + (size_t)(t) * (64 * 192); const char* vg = Vg + (size_t)(t) * (64 * 128); \
        k0 = *(const uint4*)(kg); k1 = *(const uint4*)(kg + 4096); k2 = *(const uint4*)(kg + 8192); v0 = *(const uint4*)(vg); v1 = *(const uint4*)(vg + 4096); } while (0)
    A_LOAD(0);
    const int pvo = (4 * hi + ((lane & 15) >> 2)) * A_VP + (16 * ((lane >> 4) & 1) + 4 * (lane & 3)) * 2;
    for (int t = 0; t < NT; ++t) {
        char* bK = lds + (t & 1) * A_BUF; char* bV = bK + A_KB;
        *(uint4*)(bK + kl0) = k0; *(uint4*)(bK + kl1) = k1; *(uint4*)(bK + kl2) = k2; *(uint4*)(bV + vl0) = v0; *(uint4*)(bV + vl1) = v1;
        __syncthreads();
        if (t + 1 < NT) A_LOAD(t + 1);
        const int kt0 = t * 64;
        if (kt0 <= qw0) {
            f32x16 s0, s1;
#pragma unroll
            for (int r = 0; r < 16; ++r) { s0[r] = 0.f; s1[r] = 0.f; }
            const char* pk = bK + r32 * A_KP + hi * 16;
#pragma unroll
            for (int ks = 0; ks < 6; ++ks) {
                const bf16x8 a0 = *(const bf16x8*)(pk + ks * 32), a1 = *(const bf16x8*)(pk + 32 * A_KP + ks * 32);
                s0 = MFMA32(a0, qf[ks], s0); s1 = MFMA32(a1, qf[ks], s1);
            }
            if (kt0 + 63 > qw0) {
                const int qrow = qw0 + r32;
#pragma unroll
                for (int r = 0; r < 16; ++r) { const int key = kt0 + crow(r, hi); if (key > qrow) s0[r] = -INFINITY; if (key + 32 > qrow) s1[r] = -INFINITY; }
            }
            float mx = fmaxf(s0[0], s1[0]);
#pragma unroll
            for (int r = 1; r < 16; ++r) mx = fmaxf(mx, fmaxf(s0[r], s1[r]));
            mx = fmaxf(mx, __shfl_xor(mx, 32, 64));
            const float mn = fmaxf(m, mx);
            const float alpha = __builtin_amdgcn_exp2f(m - mn);
            m = mn;
            float ps = 0.f;
#pragma unroll
            for (int r = 0; r < 16; ++r) { s0[r] = __builtin_amdgcn_exp2f(s0[r] - mn); s1[r] = __builtin_amdgcn_exp2f(s1[r] - mn); ps += s0[r] + s1[r]; }
            lsum = lsum * alpha + ps;
#pragma unroll
            for (int r = 0; r < 16; ++r) { o0[r] *= alpha; o1[r] *= alpha; }
            union { unsigned u[4]; bf16x8 v; } p00, p01, p10, p11;
#pragma unroll
            for (int j = 0; j < 4; ++j) { p00.u[j] = cvtpk(s0[2 * j], s0[2 * j + 1]); p01.u[j] = cvtpk(s0[8 + 2 * j], s0[9 + 2 * j]); p10.u[j] = cvtpk(s1[2 * j], s1[2 * j + 1]); p11.u[j] = cvtpk(s1[8 + 2 * j], s1[9 + 2 * j]); }
            const char* pv = bV + pvo;
#define A_PV(pf, kofs) do { \
            { const v4i16_t lo = vtr(pv + (kofs) * A_VP), hh = vtr(pv + ((kofs) + 8) * A_VP); const bf16x8 vf = {lo[0], lo[1], lo[2], lo[3], hh[0], hh[1], hh[2], hh[3]}; o0 = MFMA32(vf, pf.v, o0); } \
            { const v4i16_t lo = vtr(pv + (kofs) * A_VP + 64), hh = vtr(pv + ((kofs) + 8) * A_VP + 64); const bf16x8 vf = {lo[0], lo[1], lo[2], lo[3], hh[0], hh[1], hh[2], hh[3]}; o1 = MFMA32(vf, pf.v, o1); } } while (0)
            A_PV(p00, 0); A_PV(p01, 16); A_PV(p10, 32); A_PV(p11, 48);
        }
    }
    lsum += __shfl_xor(lsum, 32, 64);
    const float inv = 1.f / lsum;
    const int b = bh >> 3, h = bh & 7;
    bf16* yo = Y + (size_t)(b * S + qw0 + r32) * D + 512 + h * 64 + 4 * hi;
#pragma unroll
    for (int g = 0; g < 4; ++g) {
        uint2 a, c;
        a.x = cvtpk(o0[4 * g] * inv, o0[4 * g + 1] * inv); a.y = cvtpk(o0[4 * g + 2] * inv, o0[4 * g + 3] * inv);
        c.x = cvtpk(o1[4 * g] * inv, o1[4 * g + 1] * inv); c.y = cvtpk(o1[4 * g + 2] * inv, o1[4 * g + 3] * inv);
        *(uint2*)(yo + 8 * g) = a; *(uint2*)(yo + 32 + 8 * g) = c;
    }
    __syncthreads();
}
__device__ __forceinline__ void phase_attn(const Params& P, char* lds) {
    const bf16* Qb = (const bf16*)(P.ws + WS_Q);
    const bf16* Kb = (const bf16*)(P.ws + WS_K);
    const bf16* Vb = (const bf16*)(P.ws + WS_V);
    bf16* Y = (bf16*)(P.ws + WS_XN);
    for (int u = blockIdx.x; u < NB * NH * (S / 128); u += gridDim.x) {
        const int bh = u & 31, v = u >> 5;
        const int qblk = (v < 16) ? (63 - v) : (v < 32) ? (v - 16) : (v < 48) ? (79 - v) : (v - 32);
        attn_unit(Qb, Kb, Vb, Y, bh, qblk, lds);
    }
}

__device__ __forceinline__ void wave_argmax(float& bv, int& bi) {
#pragma unroll
    for (int m = 32; m >= 1; m >>= 1) {
        const float ov = __shfl_xor(bv, m, 64); const int oi = __shfl_xor(bi, m, 64);
        if (ov > bv || (ov == bv && oi < bi)) { bv = ov; bi = oi; }
    }
}
__device__ __forceinline__ void peer_half_top16(const float* __restrict__ skp, const float* qs, int, int lane, float& sp, int& ip) {
    const float NEG = -3.0e38f;
    float v0 = 0.f, v1 = 0.f;
    const float4* r0 = (const float4*)(skp + (size_t)lane * 128);
    const float4* r1 = (const float4*)(skp + (size_t)(lane + 64) * 128);
    for (int d = 0; d < 32; ++d) {
        const float4 a = r0[d], bq = r1[d];
        const float q0 = qs[d * 4 + 0], q1 = qs[d * 4 + 1], q2 = qs[d * 4 + 2], q3 = qs[d * 4 + 3];
        v0 = fmaf(q0, a.x, v0); v0 = fmaf(q1, a.y, v0); v0 = fmaf(q2, a.z, v0); v0 = fmaf(q3, a.w, v0);
        v1 = fmaf(q0, bq.x, v1); v1 = fmaf(q1, bq.y, v1); v1 = fmaf(q2, bq.z, v1); v1 = fmaf(q3, bq.w, v1);
    }
    sp = 0.f; ip = 0;
    for (int k = 0; k < TOPK; ++k) {
        float bv; int bi;
        if (v0 >= v1) { bv = v0; bi = lane; } else { bv = v1; bi = lane + 64; }
        wave_argmax(bv, bi);
        if (lane == k) { sp = bv; ip = bi; }
        if (bi == lane) v0 = NEG; else if (bi == lane + 64) v1 = NEG;
    }
}
__device__ __forceinline__ void phase_topk_naive(const Params& P, int l, float* sm) {
    const bf16* QP = (const bf16*)(P.ws + WS_QP);
    int* EXPp = (int*)(P.ws + WS_EXP);
    float* GATEp = (float*)(P.ws + WS_GATE);
    const float* sk = P.peer_subkeys + (size_t)l * 2 * NKEY * 128;
    const int lane = tidx() & 63, wv = tidx() >> 6;
    float* qs = sm + wv * 256;
    const float NEG = -3.0e38f;
    for (int u = gwave(); u < T * PH; u += nwave()) {
        const int t = u >> 3, h = u & 7;
        {
            const bf16* qp = QP + (size_t)t * 2048 + h * 256;
#pragma unroll
            for (int j = 0; j < 4; ++j) qs[j * 64 + lane] = bf2f(qp[j * 64 + lane]);
        }
        __builtin_amdgcn_s_waitcnt(0);
        __builtin_amdgcn_wave_barrier();
        float stop0, stop1; int itop0, itop1;
        peer_half_top16(sk, qs, 0, lane, stop0, itop0);
        peer_half_top16(sk + (size_t)NKEY * 128, qs + 128, 0, lane, stop1, itop1);
        __builtin_amdgcn_wave_barrier();
        float cv[4];
#pragma unroll
        for (int r = 0; r < 4; ++r) { const int c = lane + 64 * r; cv[r] = __shfl(stop0, c >> 4, 64) + __shfl(stop1, c & 15, 64); }
        float ts = 0.f; int ci = 0;
        for (int k = 0; k < TOPK; ++k) {
            float bv = cv[0]; int bi = lane;
#pragma unroll
            for (int r = 1; r < 4; ++r) if (cv[r] > bv) { bv = cv[r]; bi = lane + 64 * r; }
            wave_argmax(bv, bi);
            if (lane == k) { ts = bv; ci = bi; }
#pragma unroll
            for (int r = 0; r < 4; ++r) if (bi == lane + 64 * r) cv[r] = NEG;
        }
        const int e1 = __shfl(itop0, ci >> 4, 64), e2 = __shfl(itop1, ci & 15, 64);
        const float smax = __shfl(ts, 0, 64);
        float ex = (lane < 16) ? __expf(ts - smax) : 0.f;
        float den = ex;
#pragma unroll
        for (int m = 8; m >= 1; m >>= 1) den += __shfl_xor(den, m, 64);
        if (lane < 16) {
            EXPp[(size_t)t * HK + h * 16 + lane] = e1 * NKEY + e2;
            GATEp[(size_t)t * HK + h * 16 + lane] = ex / den;
        }
    }
}

__device__ __forceinline__ void phase_gather_naive(const Params& P, int l) {
    const bf16* XN = (const bf16*)(P.ws + WS_XN);
    const int* EXPp = (const int*)(P.ws + WS_EXP);
    const float* GATEp = (const float*)(P.ws + WS_GATE);
    const float* U = P.peer_u + (size_t)l * NEXP * D;
    const float* V = P.peer_v + (size_t)l * NEXP * D;
    const int lane = tidx() & 63;
    for (int t = gwave(); t < T; t += nwave()) {
        float4 xv[4];
#pragma unroll
        for (int j = 0; j < 4; ++j) {
            const uint2 r = ((const uint2*)(XN + (size_t)t * D))[j * 64 + lane];
            xv[j] = make_float4(bflo(r.x), bfhi(r.x), bflo(r.y), bfhi(r.y));
        }
        float4 acc[4];
#pragma unroll
        for (int j = 0; j < 4; ++j) acc[j] = make_float4(0.f, 0.f, 0.f, 0.f);
        for (int k = 0; k < HK; ++k) {
            const int e = EXPp[(size_t)t * HK + k];
            const float g = GATEp[(size_t)t * HK + k];
            const float4* ur = (const float4*)(U + (size_t)e * D);
            float d = 0.f;
#pragma unroll
            for (int j = 0; j < 4; ++j) { const float4 u = ur[j * 64 + lane]; d += xv[j].x * u.x + xv[j].y * u.y + xv[j].z * u.z + xv[j].w * u.w; }
            d = wave_sum(d);
            const float a = g * gelu_exact(d);
            const float4* vr = (const float4*)(V + (size_t)e * D);
#pragma unroll
            for (int j = 0; j < 4; ++j) { const float4 v = vr[j * 64 + lane]; acc[j].x = fmaf(a, v.x, acc[j].x); acc[j].y = fmaf(a, v.y, acc[j].y); acc[j].z = fmaf(a, v.z, acc[j].z); acc[j].w = fmaf(a, v.w, acc[j].w); }
        }
        float4* hr = (float4*)(P.out + (size_t)t * D);
        float ss = 0.f;
#pragma unroll
        for (int j = 0; j < 4; ++j) {
            const float4 hv = hr[j * 64 + lane];
            acc[j].x += hv.x; acc[j].y += hv.y; acc[j].z += hv.z; acc[j].w += hv.w;
            ss += acc[j].x * acc[j].x + acc[j].y * acc[j].y + acc[j].z * acc[j].z + acc[j].w * acc[j].w;
        }
        if (l == DEPTH - 1) {
            ss = wave_sum(ss);
            const float r = rsqrtf(ss * (1.f / D) + EPS);
#pragma unroll
            for (int j = 0; j < 4; ++j) {
                const float4 gg = ((const float4*)P.norm_final)[j * 64 + lane];
                hr[j * 64 + lane] = make_float4(acc[j].x * r * gg.x, acc[j].y * r * gg.y, acc[j].z * r * gg.z, acc[j].w * r * gg.w);
            }
        } else {
#pragma unroll
            for (int j = 0; j < 4; ++j) hr[j * 64 + lane] = acc[j];
        }
    }
}


__device__ __forceinline__ float red16(float (&p)[16], int lane) {
#pragma unroll
    for (int i = 0; i < 8; ++i) { const bool up = lane & 32; const float send = up ? p[i] : p[i + 8], keep = up ? p[i + 8] : p[i]; p[i] = keep + __shfl_xor(send, 32, 64); }
#pragma unroll
    for (int i = 0; i < 4; ++i) { const bool up = lane & 16; const float send = up ? p[i] : p[i + 4], keep = up ? p[i + 4] : p[i]; p[i] = keep + __shfl_xor(send, 16, 64); }
#pragma unroll
    for (int i = 0; i < 2; ++i) { const bool up = lane & 8; const float send = up ? p[i] : p[i + 2], keep = up ? p[i + 2] : p[i]; p[i] = keep + __shfl_xor(send, 8, 64); }
    { const bool up = lane & 4; const float send = up ? p[0] : p[1], keep = up ? p[1] : p[0]; p[0] = keep + __shfl_xor(send, 4, 64); }
    float r = p[0];
    r += __shfl_xor(r, 2, 64); r += __shfl_xor(r, 1, 64);
    return r;
}
typedef __attribute__((ext_vector_type(2))) __bf16 bf2_t;
__device__ __forceinline__ float dot2bf(unsigned a, unsigned b, float c) { return __builtin_amdgcn_fdot2_f32_bf16(__builtin_bit_cast(bf2_t, a), __builtin_bit_cast(bf2_t, b), c, false); }

__device__ __forceinline__ void phase_gather(const Params& P, int l) {
    const bf16* XN = (const bf16*)(P.ws + WS_XN);
    bf16* XNw = (bf16*)(P.ws + WS_XN);
    const int* EXPp = (const int*)(P.ws + WS_EXP);
    const float* GATEp = (const float*)(P.ws + WS_GATE);
    const unsigned char* U = P.ws + WS_TABU + (size_t)l * NEXP * TAB_ROWB;
    const unsigned char* V = P.ws + WS_TABV + (size_t)l * NEXP * TAB_ROWB;
    const float* SU = (const float*)(P.ws + WS_TSCU) + (size_t)l * NEXP;
    const float* SV = (const float*)(P.ws + WS_TSCV) + (size_t)l * NEXP;
    const int lane = tidx() & 63;
    for (int t = gwave(); t < T; t += nwave()) {
        const int e_lo = EXPp[(size_t)t * HK + lane], e_hi = EXPp[(size_t)t * HK + 64 + lane];
#if TAB_FP8
        float xf[16];
        {
            const uint4 a = ((const uint4*)(XN + (size_t)t * D))[lane * 2], b = ((const uint4*)(XN + (size_t)t * D))[lane * 2 + 1];
            xf[0] = bflo(a.x); xf[1] = bfhi(a.x); xf[2] = bflo(a.y); xf[3] = bfhi(a.y); xf[4] = bflo(a.z); xf[5] = bfhi(a.z); xf[6] = bflo(a.w); xf[7] = bfhi(a.w);
            xf[8] = bflo(b.x); xf[9] = bfhi(b.x); xf[10] = bflo(b.y); xf[11] = bfhi(b.y); xf[12] = bflo(b.z); xf[13] = bfhi(b.z); xf[14] = bflo(b.w); xf[15] = bfhi(b.w);
        }
#else
        const uint4 xa = ((const uint4*)(XN + (size_t)t * D))[lane], xb = ((const uint4*)(XN + (size_t)t * D))[64 + lane];
#endif
        float acc[16];
#pragma unroll
        for (int i = 0; i < 16; ++i) acc[i] = 0.f;
        for (int c = 0; c < 8; ++c) {
            const int esel = (c < 4) ? e_lo : e_hi;
            const int kb = (c & 3) * 16;
            float part[16];
#pragma unroll
            for (int hb = 0; hb < 2; ++hb) {
#if TAB_FP8
                uint4 r[8];
#pragma unroll
                for (int i = 0; i < 8; ++i) { const int e = __builtin_amdgcn_readlane(esel, kb + hb * 8 + i); r[i] = *(const uint4*)(U + (size_t)e * 1024 + lane * 16); }
#pragma unroll
                for (int i = 0; i < 8; ++i) {
                    float d0 = 0.f, d1 = 0.f;
                    const unsigned w[4] = {r[i].x, r[i].y, r[i].z, r[i].w};
#pragma unroll
                    for (int q = 0; q < 4; ++q) {
                        const auto lo = __builtin_amdgcn_cvt_pk_f32_fp8((int)w[q], false); const auto hh = __builtin_amdgcn_cvt_pk_f32_fp8((int)w[q], true);
                        d0 = fmaf(xf[4 * q], lo[0], d0); d1 = fmaf(xf[4 * q + 1], lo[1], d1); d0 = fmaf(xf[4 * q + 2], hh[0], d0); d1 = fmaf(xf[4 * q + 3], hh[1], d1);
                    }
                    part[hb * 8 + i] = d0 + d1;
                }
#else
                uint4 r0[8], r1[8];
#pragma unroll
                for (int i = 0; i < 8; ++i) { const int e = __builtin_amdgcn_readlane(esel, kb + hb * 8 + i); const unsigned char* rp = U + (size_t)e * 2048 + lane * 16; r0[i] = *(const uint4*)(rp); r1[i] = *(const uint4*)(rp + 1024); }
#pragma unroll
                for (int i = 0; i < 8; ++i) {
                    float d0 = 0.f, d1 = 0.f;
                    d0 = dot2bf(xa.x, r0[i].x, d0); d1 = dot2bf(xa.y, r0[i].y, d1); d0 = dot2bf(xa.z, r0[i].z, d0); d1 = dot2bf(xa.w, r0[i].w, d1);
                    d0 = dot2bf(xb.x, r1[i].x, d0); d1 = dot2bf(xb.y, r1[i].y, d1); d0 = dot2bf(xb.z, r1[i].z, d0); d1 = dot2bf(xb.w, r1[i].w, d1);
                    part[hb * 8 + i] = d0 + d1;
                }
#endif
            }
            float dsum = red16(part, lane);
            const int kk = c * 16 + (lane >> 2);
            const int eme = __shfl(esel, kb + (lane >> 2), 64);
            float wv = GATEp[(size_t)t * HK + kk];
#if TAB_FP8
            dsum *= SU[eme];
            wv *= SV[eme];
#endif
            wv *= gelu_exact(dsum);
#pragma unroll
            for (int hb = 0; hb < 2; ++hb) {
#if TAB_FP8
                uint4 r[8];
#pragma unroll
                for (int i = 0; i < 8; ++i) { const int e = __builtin_amdgcn_readlane(esel, kb + hb * 8 + i); r[i] = *(const uint4*)(V + (size_t)e * 1024 + lane * 16); }
#pragma unroll
                for (int i = 0; i < 8; ++i) {
                    const float w = __int_as_float(__builtin_amdgcn_readlane(__float_as_int(wv), (hb * 8 + i) * 4));
                    const unsigned ww[4] = {r[i].x, r[i].y, r[i].z, r[i].w};
#pragma unroll
                    for (int q = 0; q < 4; ++q) {
                        const auto lo = __builtin_amdgcn_cvt_pk_f32_fp8((int)ww[q], false); const auto hh = __builtin_amdgcn_cvt_pk_f32_fp8((int)ww[q], true);
                        acc[4 * q] = fmaf(w, lo[0], acc[4 * q]); acc[4 * q + 1] = fmaf(w, lo[1], acc[4 * q + 1]); acc[4 * q + 2] = fmaf(w, hh[0], acc[4 * q + 2]); acc[4 * q + 3] = fmaf(w, hh[1], acc[4 * q + 3]);
                    }
                }
#else
                uint4 r0[8], r1[8];
#pragma unroll
                for (int i = 0; i < 8; ++i) { const int e = __builtin_amdgcn_readlane(esel, kb + hb * 8 + i); const unsigned char* rp = V + (size_t)e * 2048 + lane * 16; r0[i] = *(const uint4*)(rp); r1[i] = *(const uint4*)(rp + 1024); }
#pragma unroll
                for (int i = 0; i < 8; ++i) {
                    const float w = __int_as_float(__builtin_amdgcn_readlane(__float_as_int(wv), (hb * 8 + i) * 4));
                    acc[0] = fmaf(w, bflo(r0[i].x), acc[0]); acc[1] = fmaf(w, bfhi(r0[i].x), acc[1]); acc[2] = fmaf(w, bflo(r0[i].y), acc[2]); acc[3] = fmaf(w, bfhi(r0[i].y), acc[3]);
                    acc[4] = fmaf(w, bflo(r0[i].z), acc[4]); acc[5] = fmaf(w, bfhi(r0[i].z), acc[5]); acc[6] = fmaf(w, bflo(r0[i].w), acc[6]); acc[7] = fmaf(w, bfhi(r0[i].w), acc[7]);
                    acc[8] = fmaf(w, bflo(r1[i].x), acc[8]); acc[9] = fmaf(w, bfhi(r1[i].x), acc[9]); acc[10] = fmaf(w, bflo(r1[i].y), acc[10]); acc[11] = fmaf(w, bfhi(r1[i].y), acc[11]);
                    acc[12] = fmaf(w, bflo(r1[i].z), acc[12]); acc[13] = fmaf(w, bfhi(r1[i].z), acc[13]); acc[14] = fmaf(w, bflo(r1[i].w), acc[14]); acc[15] = fmaf(w, bfhi(r1[i].w), acc[15]);
                }
#endif
            }
        }
        float* hrow = P.out + (size_t)t * D;
#if TAB_FP8
        const int c0 = lane * 16, c1 = lane * 16 + 8;
#else
        const int c0 = lane * 8, c1 = 512 + lane * 8;
#endif
        float4 h0 = *(const float4*)(hrow + c0), h1 = *(const float4*)(hrow + c0 + 4), h2 = *(const float4*)(hrow + c1), h3 = *(const float4*)(hrow + c1 + 4);
        h0.x += acc[0]; h0.y += acc[1]; h0.z += acc[2]; h0.w += acc[3]; h1.x += acc[4]; h1.y += acc[5]; h1.z += acc[6]; h1.w += acc[7];
        h2.x += acc[8]; h2.y += acc[9]; h2.z += acc[10]; h2.w += acc[11]; h3.x += acc[12]; h3.y += acc[13]; h3.z += acc[14]; h3.w += acc[15];
        float ss = h0.x * h0.x + h0.y * h0.y + h0.z * h0.z + h0.w * h0.w + h1.x * h1.x + h1.y * h1.y + h1.z * h1.z + h1.w * h1.w
                 + h2.x * h2.x + h2.y * h2.y + h2.z * h2.z + h2.w * h2.w + h3.x * h3.x + h3.y * h3.y + h3.z * h3.z + h3.w * h3.w;
        ss = wave_sum(ss);
        const float rn = rsqrtf(ss * (1.f / D) + EPS);
        if (l == DEPTH - 1) {
            const float* g = P.norm_final;
            const float4 g0 = *(const float4*)(g + c0), g1 = *(const float4*)(g + c0 + 4), g2 = *(const float4*)(g + c1), g3 = *(const float4*)(g + c1 + 4);
            *(float4*)(hrow + c0) = make_float4(h0.x * rn * g0.x, h0.y * rn * g0.y, h0.z * rn * g0.z, h0.w * rn * g0.w);
            *(float4*)(hrow + c0 + 4) = make_float4(h1.x * rn * g1.x, h1.y * rn * g1.y, h1.z * rn * g1.z, h1.w * rn * g1.w);
            *(float4*)(hrow + c1) = make_float4(h2.x * rn * g2.x, h2.y * rn * g2.y, h2.z * rn * g2.z, h2.w * rn * g2.w);
            *(float4*)(hrow + c1 + 4) = make_float4(h3.x * rn * g3.x, h3.y * rn * g3.y, h3.z * rn * g3.z, h3.w * rn * g3.w);
        } else {
            *(float4*)(hrow + c0) = h0; *(float4*)(hrow + c0 + 4) = h1; *(float4*)(hrow + c1) = h2; *(float4*)(hrow + c1 + 4) = h3;
            const float* g = P.norm_mix + (l + 1) * D;
            const float4 g0 = *(const float4*)(g + c0), g1 = *(const float4*)(g + c0 + 4), g2 = *(const float4*)(g + c1), g3 = *(const float4*)(g + c1 + 4);
            uint4 o0, o1;
            o0.x = pack2(h0.x * rn * g0.x, h0.y * rn * g0.y); o0.y = pack2(h0.z * rn * g0.z, h0.w * rn * g0.w); o0.z = pack2(h1.x * rn * g1.x, h1.y * rn * g1.y); o0.w = pack2(h1.z * rn * g1.z, h1.w * rn * g1.w);
            o1.x = pack2(h2.x * rn * g2.x, h2.y * rn * g2.y); o1.y = pack2(h2.z * rn * g2.z, h2.w * rn * g2.w); o1.z = pack2(h3.x * rn * g3.x, h3.y * rn * g3.y); o1.w = pack2(h3.z * rn * g3.z, h3.w * rn * g3.w);
            *(uint4*)(XNw + (size_t)t * D + c0) = o0; *(uint4*)(XNw + (size_t)t * D + c1) = o1;
        }
    }
}

constexpr int PH_PER_LAYER = 11;
constexpr int NPHASES = 1 + DEPTH * PH_PER_LAYER;

constexpr float QSCALE = 0.10206207261596575f * 1.4426950408889634f;
template <int s>
__device__ __forceinline__ void layer_phase(const Params& P, int l, char* lds) {
    unsigned char* ws = P.ws;
    float* sm = (float*)lds;
    bf16* XN = (bf16*)(ws + WS_XN);
    bf16* PROJ = (bf16*)(ws + WS_PROJ);
    const float* hin = (l == 0) ? P.x : P.out;
    if constexpr (s == 0) phase_norm(hin, P.norm_mix + l * D, XN);
    if constexpr (s == 1) {
        const bf16* W = (const bf16*)(ws + WS_WIN) + (size_t)l * DINP * D;
        gemm_mfma(XN, D, W, D, T, DINP, D, [&](int m0, int n0, const f32x16& acc, int r32, int hi) {
            const int n = n0 + r32;
            if (n < DIN) {
#pragma unroll
                for (int r = 0; r < 16; ++r) PROJ[(size_t)(m0 + crow(r, hi)) * DINP + n] = f2bf(acc[r]);
            }
        }, lds);
    }
    if constexpr (s == 2) phase_mixprep(P, l);
    if constexpr (s == 3) {
        const bf16* W = (const bf16*)(ws + WS_WUQ) + (size_t)l * 768 * QR;
        bf16* Qb = (bf16*)(ws + WS_Q);
        const float* rope = (const float*)(ws + WS_ROPE);
        gemm_mfma(PROJ + C_CQ, DINP, W, QR, T, 768, QR, [&](int m0, int n0, const f32x16& acc, int r32, int hi) {
            const int h = n0 / DQK, d0 = n0 % DQK;
            const int b = m0 / S, s0 = m0 % S;
            bf16* qb = Qb + ((size_t)(b * NH + h) * S + s0) * DQK + d0 + r32;
            if (d0 == 64) {
                const int f = r32 & 15;
#pragma unroll
                for (int r = 0; r < 16; ++r) {
                    const int sr = crow(r, hi);
                    const float v = acc[r], o = __shfl_xor(v, 16, 64);
                    const float2 cs = *(const float2*)(rope + ((size_t)(s0 + sr) * 16 + f) * 2);
                    const float res = (r32 < 16) ? (v * cs.x - o * cs.y) : (v * cs.x + o * cs.y);
                    qb[(size_t)sr * DQK] = f2bf(res * QSCALE);
                }
            } else {
#pragma unroll
                for (int r = 0; r < 16; ++r) qb[(size_t)crow(r, hi) * DQK] = f2bf(acc[r] * QSCALE);
            }
        }, lds);
    }
    if constexpr (s == 4) {
        const bf16* W = (const bf16*)(ws + WS_WUKV) + (size_t)l * 1024 * KVR;
        bf16* Kb = (bf16*)(ws + WS_K); bf16* Vb = (bf16*)(ws + WS_V);
        gemm_mfma(PROJ + C_CKV, DINP, W, KVR, T, 1024, KVR, [&](int m0, int n0, const f32x16& acc, int r32, int hi) {
            const int b = m0 / S, s0 = m0 % S;
            if (n0 < 512) {
                const int h = n0 >> 6, d = (n0 & 63) + r32;
                bf16* kb = Kb + ((size_t)(b * NH + h) * S + s0) * DQK + d;
#pragma unroll
                for (int r = 0; r < 16; ++r) kb[(size_t)crow(r, hi) * DQK] = f2bf(acc[r]);
            } else {
                const int h = (n0 - 512) >> 6, d = (n0 & 63) + r32;
                bf16* vb = Vb + ((size_t)(b * NH + h) * S + s0) * DV + d;
#pragma unroll
                for (int r = 0; r < 16; ++r) vb[(size_t)crow(r, hi) * DV] = f2bf(acc[r]);
            }
        }, lds);
    }
    if constexpr (s == 5) { }
#if ATTN_MFMA
    if constexpr (s == 6) phase_attn(P, lds);
#else
    if constexpr (s == 6) phase_attn_naive(P);
#endif
    if constexpr (s == 7) {
        const bf16* W = (const bf16*)(ws + WS_WOUT) + (size_t)l * D * D;
        float* out = P.out;
        gemm_mfma(XN, D, W, D, T, D, D, [&](int m0, int n0, const f32x16& acc, int r32, int hi) {
#pragma unroll
            for (int r = 0; r < 16; ++r) { const size_t idx = (size_t)(m0 + crow(r, hi)) * D + n0 + r32; out[idx] = hin[idx] + acc[r]; }
        }, lds);
    }
    if constexpr (s == 8) phase_norm(P.out, P.norm_ffn + l * D, XN);
    if constexpr (s == 9) {
        const bf16* W = (const bf16*)(ws + WS_WPQ) + (size_t)l * 2048 * D;
        bf16* QP = (bf16*)(ws + WS_QP);
        gemm_mfma(XN, D, W, D, T, 2048, D, [&](int m0, int n0, const f32x16& acc, int r32, int hi) {
#pragma unroll
            for (int r = 0; r < 16; ++r) QP[(size_t)(m0 + crow(r, hi)) * 2048 + n0 + r32] = f2bf(acc[r]);
        }, lds);
    }
    if constexpr (s == 10) phase_topk_naive(P, l, sm);
}

__device__ __forceinline__ void layer_phase_dyn(const Params& P, int l, int s, char* sm) {
    switch (s) {
    case 0: layer_phase<0>(P, l, sm); break; case 1: layer_phase<1>(P, l, sm); break; case 2: layer_phase<2>(P, l, sm); break;
    case 3: layer_phase<3>(P, l, sm); break; case 4: layer_phase<4>(P, l, sm); break; case 5: layer_phase<5>(P, l, sm); break;
    case 6: layer_phase<6>(P, l, sm); break; case 7: layer_phase<7>(P, l, sm); break; case 8: layer_phase<8>(P, l, sm); break;
    case 9: layer_phase<9>(P, l, sm); break; case 10: layer_phase<10>(P, l, sm); break; default: phase_gather_naive(P, l); break;
    }
}
#if !ONE_LAUNCH
__global__ void __launch_bounds__(NTHREADS, 2) k_phase(Params P, int ph) {
    __shared__ __attribute__((aligned(16))) char sm[GEMM_LDS];
    if (ph == 0) { phase_prep(P); return; }
    layer_phase_dyn(P, (ph - 1) / (PH_PER_LAYER + 1), (ph - 1) % (PH_PER_LAYER + 1), sm);
}
#else
#define GSYNC() grid.sync()
__global__ void __launch_bounds__(NTHREADS, 2) k_all(Params P) {
    __shared__ __attribute__((aligned(16))) char sm[GEMM_LDS];
    cg::grid_group grid = cg::this_grid();
    { const Params Q = launder(P); phase_prep(Q); } GSYNC();
    for (int l = 0; l < DEPTH; ++l) {
#define LP(s) { const Params Q = launder(P); layer_phase<s>(Q, l, sm); }
        if (l == 0) { LP(0); GSYNC(); }
        LP(1); GSYNC();
        LP(2); GSYNC();
        LP(3);
        LP(4); GSYNC();
        LP(6); GSYNC();
        LP(7); GSYNC();
        LP(8); GSYNC();
        LP(9); GSYNC();
        LP(10); GSYNC();
        { const Params Q = launder(P); phase_gather(Q, l); } GSYNC();
    }
}
#endif

extern "C" void kernel_launch(void* const* d_in, const int* in_sizes, int n_in, void* d_out, int out_size, void* d_ws, size_t ws_size, hipStream_t stream) {
    static int grid = 0;
    if (grid == 0) {
        if (n_in != 18 || out_size != T * D || ws_size < WS_END) { fprintf(stderr, "kernel_launch: bad sizes n_in %d out %d ws %zu need %zu\n", n_in, out_size, ws_size, (size_t)WS_END); grid = -1; return; }
        int dev = 0, cus = 0, per_cu = 0;
        hipGetDevice(&dev);
        hipDeviceGetAttribute(&cus, hipDeviceAttributeMultiprocessorCount, dev);
#if ONE_LAUNCH
        hipOccupancyMaxActiveBlocksPerMultiprocessor(&per_cu, (const void*)k_all, NTHREADS, 0);
#else
        hipOccupancyMaxActiveBlocksPerMultiprocessor(&per_cu, (const void*)k_phase, NTHREADS, 0);
#endif
        if (per_cu > 2) per_cu = 2;
        if (per_cu < 1) { fprintf(stderr, "kernel_launch: occupancy query says %d\n", per_cu); grid = -1; return; }
        grid = cus * per_cu;
    }
    if (grid < 0) return;
    Params p{};
    p.x = (const float*)d_in[0]; p.norm_mix = (const float*)d_in[1]; p.w_in = (const float*)d_in[2]; p.conv_w = (const float*)d_in[3];
    p.pool_w = (const float*)d_in[4]; p.pool_scale = (const float*)d_in[5]; p.q_norm = (const float*)d_in[6]; p.w_uq = (const float*)d_in[7];
    p.kv_norm = (const float*)d_in[8]; p.w_uk = (const float*)d_in[9]; p.w_uv = (const float*)d_in[10]; p.w_out = (const float*)d_in[11];
    p.norm_ffn = (const float*)d_in[12]; p.peer_wq = (const float*)d_in[13]; p.peer_subkeys = (const float*)d_in[14]; p.peer_u = (const float*)d_in[15];
    p.peer_v = (const float*)d_in[16]; p.norm_final = (const float*)d_in[17];
    p.out = (float*)d_out; p.ws = (unsigned char*)d_ws;
#if ONE_LAUNCH
    void* args[] = {&p};
    hipError_t e = hipLaunchCooperativeKernel((const void*)k_all, dim3(grid), dim3(NTHREADS), args, 0, stream);
    if (e != hipSuccess) fprintf(stderr, "cooperative launch failed: %s (grid %d)\n", hipGetErrorString(e), grid);
#else
    for (int ph = 0; ph < 1 + DEPTH * (PH_PER_LAYER + 1); ++ph) hipLaunchKernelGGL(k_phase, dim3(grid), dim3(NTHREADS), 0, stream, p, ph);
#endif
}
```

```cpp
#include <hip/hip_runtime.h>
#include <hip/hip_cooperative_groups.h>
#include <cstdio>
#include <cstdint>
namespace cg = cooperative_groups;

#ifndef ATTN_MFMA
#define ATTN_MFMA 1
#endif
#ifndef TAB_FP8
#define TAB_FP8 1
#endif
#ifndef ONE_LAUNCH
#define ONE_LAUNCH 1
#endif

constexpr int NB = 4, S = 8192, T = NB * S, D = 1024, DEPTH = 2;
constexpr int DIN = 1696, DINP = 1792;
constexpr int C_BG = 0, C_CG = 256, C_HC = 512, C_HP = 768, C_CQ = 1024, C_CKV = 1408, C_KR = 1664;
constexpr int QR = 384, KVR = 256, NH = 8, DQK = 96, DV = 64;
constexpr int PH = 8, NKEY = 128, NEXP = NKEY * NKEY, TOPK = 16, HK = PH * TOPK;
constexpr float EPS = 1e-6f;

typedef unsigned short bf16;

constexpr size_t MB = 1024 * 1024;
constexpr size_t WS_CTL   = 0;
constexpr size_t WS_ROPE  = 64 * 1024;
constexpr size_t WS_WIN   = WS_ROPE + (size_t)S * 16 * 2 * 4;
constexpr size_t WS_WUQ   = WS_WIN + (size_t)DEPTH * DINP * D * 2;
constexpr size_t WS_WUKV  = WS_WUQ + (size_t)DEPTH * 768 * QR * 2;
constexpr size_t WS_WOUT  = WS_WUKV + (size_t)DEPTH * 1024 * KVR * 2;
constexpr size_t WS_WPQ   = WS_WOUT + (size_t)DEPTH * D * D * 2;
constexpr size_t WS_XN    = ((WS_WPQ + (size_t)DEPTH * 2048 * D * 2 + 4095) / 4096) * 4096;
constexpr size_t WS_PROJ  = WS_XN + (size_t)T * D * 2;
constexpr size_t WS_Q     = WS_PROJ + (size_t)T * DINP * 2;
constexpr size_t WS_K     = WS_Q + (size_t)T * NH * DQK * 2;
constexpr size_t WS_V     = WS_K + (size_t)T * NH * DQK * 2;
constexpr size_t WS_EXP   = WS_V + (size_t)T * NH * DV * 2;
constexpr size_t WS_GATE  = WS_EXP + (size_t)T * HK * 4;
constexpr size_t TAB_ROWB = TAB_FP8 ? 1024 : 2048;
constexpr size_t WS_TABU  = WS_GATE + (size_t)T * HK * 4;
constexpr size_t WS_TABV  = WS_TABU + (size_t)DEPTH * NEXP * TAB_ROWB;
constexpr size_t WS_TSCU  = WS_TABV + (size_t)DEPTH * NEXP * TAB_ROWB;
constexpr size_t WS_TSCV  = WS_TSCU + (size_t)DEPTH * NEXP * 4;
constexpr size_t WS_END   = WS_TSCV + (size_t)DEPTH * NEXP * 4;
static_assert(WS_END <= (size_t)512 * 1024 * 1024, "workspace budget");
constexpr size_t WS_QP    = WS_PROJ;
static_assert((size_t)T * 2048 * 2 <= WS_K - WS_PROJ, "QP alias");

struct Params {
    const float* x; const float* norm_mix; const float* w_in; const float* conv_w; const float* pool_w; const float* pool_scale;
    const float* q_norm; const float* w_uq; const float* kv_norm; const float* w_uk; const float* w_uv; const float* w_out;
    const float* norm_ffn; const float* peer_wq; const float* peer_subkeys; const float* peer_u; const float* peer_v; const float* norm_final;
    float* out; unsigned char* ws;
};

__device__ __forceinline__ bf16 f2bf(float f) { unsigned u = __float_as_uint(f); u += 0x7fffu + ((u >> 16) & 1u); return (bf16)(u >> 16); }
__device__ __forceinline__ float bf2f(bf16 h) { return __uint_as_float(((unsigned)h) << 16); }
__device__ __forceinline__ float bflo(unsigned u) { return __uint_as_float(u << 16); }
__device__ __forceinline__ float bfhi(unsigned u) { return __uint_as_float(u & 0xffff0000u); }
__device__ __forceinline__ unsigned pack2(float a, float b) { return (unsigned)f2bf(a) | ((unsigned)f2bf(b) << 16); }
__device__ __forceinline__ float wave_sum(float v) {
#pragma unroll
    for (int m = 32; m >= 1; m >>= 1) v += __shfl_xor(v, m, 64);
    return v;
}
__device__ __forceinline__ float gelu_exact(float x) { return 0.5f * x * (1.f + erff(x * 0.70710678118654752f)); }

#define NTHREADS 256
__device__ __forceinline__ int tidx() { int t = (int)__builtin_amdgcn_workitem_id_x(); asm volatile("" : "+v"(t)); return t; }
__device__ __forceinline__ int gwave() { return blockIdx.x * (NTHREADS / 64) + (tidx() >> 6); }
__device__ __forceinline__ int nwave() { return gridDim.x * (NTHREADS / 64); }
__device__ __forceinline__ size_t gtid() { return (size_t)blockIdx.x * NTHREADS + tidx(); }
__device__ __forceinline__ size_t gnth() { return (size_t)gridDim.x * NTHREADS; }


__device__ __forceinline__ Params launder(const Params& P) {
    Params Q = P;
    asm volatile("" : "+s"(Q.x), "+s"(Q.norm_mix), "+s"(Q.w_in), "+s"(Q.conv_w), "+s"(Q.pool_w), "+s"(Q.pool_scale), "+s"(Q.q_norm), "+s"(Q.w_uq), "+s"(Q.kv_norm), "+s"(Q.w_uk));
    asm volatile("" : "+s"(Q.w_uv), "+s"(Q.w_out), "+s"(Q.norm_ffn), "+s"(Q.peer_wq), "+s"(Q.peer_subkeys), "+s"(Q.peer_u), "+s"(Q.peer_v), "+s"(Q.norm_final), "+s"(Q.out), "+s"(Q.ws));
    return Q;
}

template <class AL, class BL, class EP>
__device__ __forceinline__ void gemm_naive(int M, int N, int K, AL aload, BL bload, EP epi, float* sm) {
    float (*As)[68] = (float (*)[68])sm;
    float (*Bs)[68] = (float (*)[68])(sm + 16 * 68);
    const int tid = tidx(), tx = tid & 15, ty = tid >> 4;
    const int tilesN = (N + 63) / 64, tilesM = M / 64;
    for (int tile = blockIdx.x; tile < tilesM * tilesN; tile += gridDim.x) {
        const int tm = tile / tilesN, tn = tile % tilesN;
        const int row0 = tm * 64, col0 = tn * 64;
        float acc[4][4];
#pragma unroll
        for (int i = 0; i < 4; ++i)
#pragma unroll
            for (int j = 0; j < 4; ++j) acc[i][j] = 0.f;
        for (int k0 = 0; k0 < K; k0 += 16) {
            {
                const int r = tid >> 2, kk = (tid & 3) * 4;
#pragma unroll
                for (int i = 0; i < 4; ++i) As[kk + i][r] = aload(row0 + r, k0 + kk + i);
            }
            {
                const int kk = tid >> 4, c = (tid & 15) * 4;
#pragma unroll
                for (int j = 0; j < 4; ++j) { const int col = col0 + c + j; Bs[kk][c + j] = (col < N) ? bload(k0 + kk, col) : 0.f; }
            }
            __syncthreads();
#pragma unroll
            for (int kk = 0; kk < 16; ++kk) {
                float a[4], b[4];
#pragma unroll
                for (int i = 0; i < 4; ++i) a[i] = As[kk][ty * 4 + i];
#pragma unroll
                for (int j = 0; j < 4; ++j) b[j] = Bs[kk][tx * 4 + j];
#pragma unroll
                for (int i = 0; i < 4; ++i)
#pragma unroll
                    for (int j = 0; j < 4; ++j) acc[i][j] = fmaf(a[i], b[j], acc[i][j]);
            }
            __syncthreads();
        }
#pragma unroll
        for (int i = 0; i < 4; ++i)
#pragma unroll
            for (int j = 0; j < 4; ++j) { const int col = col0 + tx * 4 + j; if (col < N) epi(row0 + ty * 4 + i, col, acc[i][j]); }
    }
}


typedef __attribute__((ext_vector_type(8))) short bf16x8;
typedef __attribute__((ext_vector_type(16))) float f32x16;
#define MFMA32(a, b, c) __builtin_amdgcn_mfma_f32_32x32x16_bf16(a, b, c, 0, 0, 0)
__device__ __forceinline__ int crow(int r, int hi) { return (r & 3) + 8 * (r >> 2) + 4 * hi; }
constexpr int G_LDT = 144;
constexpr int G_OPB = 128 * G_LDT;
constexpr int G_BUF = 2 * G_OPB;
constexpr int GEMM_LDS = 2 * G_BUF;

template <int WT>
__device__ __forceinline__ void gemm_kloop(const bf16* __restrict__ Ag0, int lda, const bf16* __restrict__ Bg0, int ldb, int nk, f32x16 (&acc)[4], char* lds, int tid) {
    const int lane = tid & 63, w = tid >> 6, r32 = lane & 31, hi = lane >> 5;
    const int srow = tid >> 3, sch = tid & 7;
    const bf16* Ag = Ag0 + (size_t)srow * lda + sch * 8;
    const bf16* Bg = Bg0 + (size_t)srow * ldb + sch * 8;
#pragma unroll
    for (int i = 0; i < 4; ++i)
#pragma unroll
        for (int r = 0; r < 16; ++r) acc[i][r] = 0.f;
    uint4 ra0, ra1, ra2, ra3, rb0, rb1, rb2, rb3;
#define G_LOAD(kofs) do { \
    ra0 = *(const uint4*)(Ag + (kofs)); ra1 = *(const uint4*)(Ag + (size_t)32 * lda + (kofs)); ra2 = *(const uint4*)(Ag + (size_t)64 * lda + (kofs)); ra3 = *(const uint4*)(Ag + (size_t)96 * lda + (kofs)); \
    rb0 = *(const uint4*)(Bg + (kofs)); rb1 = *(const uint4*)(Bg + (size_t)32 * ldb + (kofs)); rb2 = *(const uint4*)(Bg + (size_t)64 * ldb + (kofs)); rb3 = *(const uint4*)(Bg + (size_t)96 * ldb + (kofs)); } while (0)
    G_LOAD(0);
    for (int kt = 0; kt < nk; ++kt) {
        char* bA = lds + (kt & 1) * G_BUF; char* bB = bA + G_OPB;
        {
            char* wa = bA + srow * G_LDT + sch * 16; char* wb = bB + srow * G_LDT + sch * 16;
            *(uint4*)(wa) = ra0; *(uint4*)(wa + 32 * G_LDT) = ra1; *(uint4*)(wa + 64 * G_LDT) = ra2; *(uint4*)(wa + 96 * G_LDT) = ra3;
            *(uint4*)(wb) = rb0; *(uint4*)(wb + 32 * G_LDT) = rb1; *(uint4*)(wb + 64 * G_LDT) = rb2; *(uint4*)(wb + 96 * G_LDT) = rb3;
        }
        __syncthreads();
        if (kt + 1 < nk) G_LOAD((kt + 1) * 64);
        if (WT == 0) {
            const char* pa = bA + ((w >> 1) * 64 + r32) * G_LDT + hi * 16;
            const char* pb = bB + ((w & 1) * 64 + r32) * G_LDT + hi * 16;
#pragma unroll
            for (int ks = 0; ks < 4; ++ks) {
                const bf16x8 a0 = *(const bf16x8*)(pa + ks * 32), a1 = *(const bf16x8*)(pa + 32 * G_LDT + ks * 32);
                const bf16x8 b0 = *(const bf16x8*)(pb + ks * 32), b1 = *(const bf16x8*)(pb + 32 * G_LDT + ks * 32);
                acc[0] = MFMA32(a0, b0, acc[0]); acc[1] = MFMA32(a0, b1, acc[1]);
                acc[2] = MFMA32(a1, b0, acc[2]); acc[3] = MFMA32(a1, b1, acc[3]);
            }
        } else {
            const char* pa = bA + r32 * G_LDT + hi * 16;
            const char* pb = bB + (w * 32 + r32) * G_LDT + hi * 16;
#pragma unroll
            for (int ks = 0; ks < 4; ++ks) {
                const bf16x8 b0 = *(const bf16x8*)(pb + ks * 32);
                const bf16x8 a0 = *(const bf16x8*)(pa + ks * 32), a1 = *(const bf16x8*)(pa + 32 * G_LDT + ks * 32);
                const bf16x8 a2 = *(const bf16x8*)(pa + 64 * G_LDT + ks * 32), a3 = *(const bf16x8*)(pa + 96 * G_LDT + ks * 32);
                acc[0] = MFMA32(a0, b0, acc[0]); acc[1] = MFMA32(a1, b0, acc[1]);
                acc[2] = MFMA32(a2, b0, acc[2]); acc[3] = MFMA32(a3, b0, acc[3]);
            }
        }
    }
#undef G_LOAD
}

template <class EPI>
__device__ __forceinline__ void gemm_mfma(const bf16* __restrict__ A, int lda, const bf16* __restrict__ Bt, int ldb, int M, int N, int K, EPI epi, char* lds) {
    const int tid = tidx(), lane = tid & 63, w = tid >> 6, r32 = lane & 31, hi = lane >> 5;
    const int wm = w >> 1, wn = w & 1;
    const int tilesN = N / 128, tilesM = M / 128, nk = K / 64;
    for (int tile = blockIdx.x; tile < tilesM * tilesN; tile += gridDim.x) {
        const int tm = tile / tilesN, tn = tile % tilesN;
        f32x16 acc[4];
        gemm_kloop<0>(A + (size_t)(tm * 128) * lda, lda, Bt + (size_t)(tn * 128) * ldb, ldb, nk, acc, lds, tid);
#pragma unroll
        for (int i = 0; i < 2; ++i)
#pragma unroll
            for (int j = 0; j < 2; ++j) epi(tm * 128 + wm * 64 + i * 32, tn * 128 + wn * 64 + j * 32, acc[i * 2 + j], r32, hi);
        __syncthreads();
    }
}

__device__ __forceinline__ void transpose_bf16(const float* __restrict__ W, bf16* __restrict__ Wt, int K, int N, int Npad) {
    const size_t tot = (size_t)Npad * K;
    for (size_t i = gtid(); i < tot; i += gnth()) {
        const int n = (int)(i / K), k = (int)(i % K);
        Wt[i] = (n < N) ? f2bf(W[(size_t)k * N + n]) : (bf16)0;
    }
}

__device__ __forceinline__ void convert_table(const float* __restrict__ src, unsigned char* __restrict__ dst, float* __restrict__ scl, int rows) {
    const int lane = tidx() & 63;
    for (int r = gwave(); r < rows; r += nwave()) {
        const float4* sr = (const float4*)(src + (size_t)r * D);
        if (TAB_FP8) {
            float4 v[4]; float am = 0.f;
#pragma unroll
            for (int j = 0; j < 4; ++j) { v[j] = sr[lane * 4 + j]; am = fmaxf(am, fmaxf(fmaxf(fabsf(v[j].x), fabsf(v[j].y)), fmaxf(fabsf(v[j].z), fabsf(v[j].w)))); }
#pragma unroll
            for (int m = 32; m >= 1; m >>= 1) am = fmaxf(am, __shfl_xor(am, m, 64));
            const float sc = (am > 0.f) ? am * (1.f / 448.f) : 1.f;
            const float is = 1.f / sc;
            uint4 o;
            { int w = 0; w = __builtin_amdgcn_cvt_pk_fp8_f32(v[0].x * is, v[0].y * is, w, false); w = __builtin_amdgcn_cvt_pk_fp8_f32(v[0].z * is, v[0].w * is, w, true); o.x = (unsigned)w; }
            { int w = 0; w = __builtin_amdgcn_cvt_pk_fp8_f32(v[1].x * is, v[1].y * is, w, false); w = __builtin_amdgcn_cvt_pk_fp8_f32(v[1].z * is, v[1].w * is, w, true); o.y = (unsigned)w; }
            { int w = 0; w = __builtin_amdgcn_cvt_pk_fp8_f32(v[2].x * is, v[2].y * is, w, false); w = __builtin_amdgcn_cvt_pk_fp8_f32(v[2].z * is, v[2].w * is, w, true); o.z = (unsigned)w; }
            { int w = 0; w = __builtin_amdgcn_cvt_pk_fp8_f32(v[3].x * is, v[3].y * is, w, false); w = __builtin_amdgcn_cvt_pk_fp8_f32(v[3].z * is, v[3].w * is, w, true); o.w = (unsigned)w; }
            *(uint4*)(dst + (size_t)r * 1024 + lane * 16) = o;
            if (lane == 0) scl[r] = sc;
        } else {
#pragma unroll
            for (int j = 0; j < 2; ++j) {
                const float4 a = sr[j * 128 + lane * 2], b = sr[j * 128 + lane * 2 + 1];
                uint4 o; o.x = pack2(a.x, a.y); o.y = pack2(a.z, a.w); o.z = pack2(b.x, b.y); o.w = pack2(b.z, b.w);
                *(uint4*)(dst + (size_t)r * 2048 + j * 1024 + lane * 16) = o;
            }
        }
    }
}
__device__ __forceinline__ void phase_prep(const Params& P) {
    unsigned char* ws = P.ws;
    for (int l = 0; l < DEPTH; ++l) {
        transpose_bf16(P.w_in + (size_t)l * D * DIN, (bf16*)(ws + WS_WIN) + (size_t)l * DINP * D, D, DIN, DINP);
        transpose_bf16(P.w_uq + (size_t)l * QR * 768, (bf16*)(ws + WS_WUQ) + (size_t)l * 768 * QR, QR, 768, 768);
        transpose_bf16(P.w_uk + (size_t)l * KVR * 512, (bf16*)(ws + WS_WUKV) + (size_t)l * 1024 * KVR, KVR, 512, 512);
        transpose_bf16(P.w_uv + (size_t)l * KVR * 512, (bf16*)(ws + WS_WUKV) + (size_t)l * 1024 * KVR + (size_t)512 * KVR, KVR, 512, 512);
        transpose_bf16(P.w_out + (size_t)l * D * D, (bf16*)(ws + WS_WOUT) + (size_t)l * D * D, D, D, D);
    }
    {
        bf16* Wc = (bf16*)(ws + WS_WPQ);
        const size_t tot = (size_t)DEPTH * 2048 * D;
        for (size_t i = gtid(); i < tot; i += gnth()) {
            const int k = (int)(i & (D - 1)); const int row = (int)(i >> 10);
            const int l = row >> 11, hp = (row >> 7) & 15, n = row & 127;
            const float4* wq = (const float4*)(P.peer_wq + ((size_t)l * D + k) * 2048 + hp * 128);
            const float4* sk = (const float4*)(P.peer_subkeys + (((size_t)l * 2 + (hp & 1)) * NKEY + n) * 128);
            float s0 = 0.f, s1 = 0.f, s2 = 0.f, s3 = 0.f;
            for (int d = 0; d < 32; ++d) { const float4 a = wq[d], b = sk[d]; s0 = fmaf(a.x, b.x, s0); s1 = fmaf(a.y, b.y, s1); s2 = fmaf(a.z, b.z, s2); s3 = fmaf(a.w, b.w, s3); }
            Wc[i] = f2bf((s0 + s1) + (s2 + s3));
        }
    }
    convert_table(P.peer_u, ws + WS_TABU, (float*)(ws + WS_TSCU), DEPTH * NEXP);
    convert_table(P.peer_v, ws + WS_TABV, (float*)(ws + WS_TSCV), DEPTH * NEXP);
    float* rope = (float*)(ws + WS_ROPE);
    for (size_t i = gtid(); i < (size_t)S * 16; i += gnth()) {
        const int s = (int)(i >> 4), f = (int)(i & 15);
        const double inv = pow(10000.0, -(double)f / 16.0);
        const double ang = (double)s * inv;
        rope[2 * i] = (float)cos(ang); rope[2 * i + 1] = (float)sin(ang);
    }
}

__device__ __forceinline__ void phase_norm(const float* __restrict__ h, const float* __restrict__ g, bf16* __restrict__ xn) {
    const int lane = tidx() & 63;
    for (int t = gwave(); t < T; t += nwave()) {
        const float4* hr = (const float4*)(h + (size_t)t * D);
        float4 v[4]; float ss = 0.f;
#pragma unroll
        for (int j = 0; j < 4; ++j) { v[j] = hr[j * 64 + lane]; ss += v[j].x * v[j].x + v[j].y * v[j].y + v[j].z * v[j].z + v[j].w * v[j].w; }
        ss = wave_sum(ss);
        const float r = rsqrtf(ss * (1.f / D) + EPS);
#pragma unroll
        for (int j = 0; j < 4; ++j) {
            const float4 gg = ((const float4*)g)[j * 64 + lane];
            uint2 o; o.x = pack2(v[j].x * r * gg.x, v[j].y * r * gg.y); o.y = pack2(v[j].z * r * gg.z, v[j].w * r * gg.w);
            ((uint2*)(xn + (size_t)t * D))[j * 64 + lane] = o;
        }
    }
}

__device__ __forceinline__ void phase_mixprep(const Params& P, int l) {
    unsigned char* ws = P.ws;
    bf16* proj = (bf16*)(ws + WS_PROJ);
    bf16* Y = (bf16*)(ws + WS_XN);
    bf16* Kb = (bf16*)(ws + WS_K);
    const float* rope = (const float*)(ws + WS_ROPE);
    const float* qn = P.q_norm + l * QR; const float* kvn = P.kv_norm + l * KVR;
    const float* cw = P.conv_w + (size_t)l * 3 * 256;
    const float* pw = P.pool_w + (size_t)l * 4 * 64 * 64;
    const float* psc = P.pool_scale + l * 256;
    const int lane = tidx() & 63;
    for (int t = gwave(); t < T; t += nwave()) {
        const int b = t / S, s = t % S;
        bf16* pr = proj + (size_t)t * DINP;
        {
            float v[6]; float ss = 0.f;
#pragma unroll
            for (int j = 0; j < 6; ++j) { v[j] = bf2f(pr[C_CQ + j * 64 + lane]); ss += v[j] * v[j]; }
            ss = wave_sum(ss);
            const float r = rsqrtf(ss * (1.f / QR) + EPS);
#pragma unroll
            for (int j = 0; j < 6; ++j) pr[C_CQ + j * 64 + lane] = f2bf(v[j] * r * qn[j * 64 + lane]);
        }
        {
            float v[4]; float ss = 0.f;
#pragma unroll
            for (int j = 0; j < 4; ++j) { v[j] = bf2f(pr[C_CKV + j * 64 + lane]); ss += v[j] * v[j]; }
            ss = wave_sum(ss);
            const float r = rsqrtf(ss * (1.f / KVR) + EPS);
#pragma unroll
            for (int j = 0; j < 4; ++j) pr[C_CKV + j * 64 + lane] = f2bf(v[j] * r * kvn[j * 64 + lane]);
        }
        if (lane < 16) {
            const float x1 = bf2f(pr[C_KR + lane]), x2 = bf2f(pr[C_KR + 16 + lane]);
            const float c = rope[(s * 16 + lane) * 2], sn = rope[(s * 16 + lane) * 2 + 1];
            const bf16 o1 = f2bf(x1 * c - x2 * sn), o2 = f2bf(x2 * c + x1 * sn);
#pragma unroll
            for (int h = 0; h < NH; ++h) {
                bf16* kr = Kb + ((size_t)(b * NH + h) * S + s) * DQK;
                kr[64 + lane] = o1; kr[80 + lane] = o2;
            }
        }
#pragma unroll
        for (int r = 0; r < 4; ++r) {
            const int c = r * 64 + lane;
            float acc = 0.f;
#pragma unroll
            for (int j = 0; j < 3; ++j) {
                const int sp = s - 2 + j;
                if (sp >= 0) {
                    const bf16* pp = proj + (size_t)(t - 2 + j) * DINP;
                    acc += cw[j * 256 + c] * (bf2f(pp[C_CG + c]) * bf2f(pp[C_HC + c]));
                }
            }
            Y[(size_t)t * D + c] = f2bf(bf2f(pr[C_BG + c]) * acc);
        }
        const int wins[4] = {2, 4, 8, 16};
#pragma unroll
        for (int g = 0; g < 4; ++g) {
            const int w = wins[g];
            const int lo = (s + 1 - w) > 0 ? (s + 1 - w) : 0;
            const int cnt = s + 1 - lo;
            float sum = 0.f;
            for (int sp = lo; sp <= s; ++sp) sum += bf2f(proj[(size_t)(b * S + sp) * DINP + C_HP + g * 64 + lane]);
            const float pooled = sum / (float)cnt - bf2f(pr[C_HP + g * 64 + lane]);
            float m = 0.f;
            for (int c = 0; c < 64; ++c) m = fmaf(__shfl(pooled, c, 64), pw[(g * 64 + c) * 64 + lane], m);
            Y[(size_t)t * D + 256 + g * 64 + lane] = f2bf(m * psc[g * 64 + lane]);
        }
    }
}

__device__ __forceinline__ void phase_qrope(const Params& P) {
    bf16* Qb = (bf16*)(P.ws + WS_Q);
    const float* rope = (const float*)(P.ws + WS_ROPE);
    const size_t tot = (size_t)T * NH * 16;
    for (size_t i = gtid(); i < tot; i += gnth()) {
        const int f = (int)(i & 15); const size_t row = i >> 4;
        const int s = (int)(row % S);
        bf16* q = Qb + row * DQK;
        const float x1 = bf2f(q[64 + f]), x2 = bf2f(q[80 + f]);
        const float c = rope[(s * 16 + f) * 2], sn = rope[(s * 16 + f) * 2 + 1];
        q[64 + f] = f2bf(x1 * c - x2 * sn); q[80 + f] = f2bf(x2 * c + x1 * sn);
    }
}

__device__ __forceinline__ void phase_attn_naive(const Params& P) {
    const bf16* Qb = (const bf16*)(P.ws + WS_Q);
    const bf16* Kb = (const bf16*)(P.ws + WS_K);
    const bf16* Vb = (const bf16*)(P.ws + WS_V);
    bf16* Y = (bf16*)(P.ws + WS_XN);
    const int lane = tidx() & 63, qr = lane & 31, half = lane >> 5;
    const int gw = gwave(), nw = nwave();
    const int total = NB * NH * (S / 32);
    for (int pass = 0; pass * nw < total; ++pass) {
        const int u = (pass & 1) ? ((pass + 1) * nw - 1 - gw) : (pass * nw + gw);
        if (u >= total) continue;
        const int qblk = (S / 32 - 1) - (u >> 5), bh = u & 31;
        const int qpos = qblk * 32 + qr;
        unsigned q[DQK / 2];
        {
            const uint4* qp = (const uint4*)(Qb + ((size_t)bh * S + qpos) * DQK);
#pragma unroll
            for (int c = 0; c < 12; ++c) { const uint4 v = qp[c]; q[c * 4 + 0] = v.x; q[c * 4 + 1] = v.y; q[c * 4 + 2] = v.z; q[c * 4 + 3] = v.w; }
        }
        float o[32];
#pragma unroll
        for (int d = 0; d < 32; ++d) o[d] = 0.f;
        float m = -3.0e38f, lsum = 0.f;
        const int kmax = qblk * 32 + 31;
        const bf16* Kp = Kb + (size_t)bh * S * DQK;
        const bf16* Vp = Vb + (size_t)bh * S * DV + half * 32;
        for (int j = 0; j <= kmax; ++j) {
            const uint4* kr = (const uint4*)(Kp + (size_t)j * DQK);
            float sc = 0.f;
#pragma unroll
            for (int c = 0; c < 12; ++c) {
                const uint4 v = kr[c];
                sc = fmaf(bflo(q[c * 4 + 0]), bflo(v.x), sc); sc = fmaf(bfhi(q[c * 4 + 0]), bfhi(v.x), sc);
                sc = fmaf(bflo(q[c * 4 + 1]), bflo(v.y), sc); sc = fmaf(bfhi(q[c * 4 + 1]), bfhi(v.y), sc);
                sc = fmaf(bflo(q[c * 4 + 2]), bflo(v.z), sc); sc = fmaf(bfhi(q[c * 4 + 2]), bfhi(v.z), sc);
                sc = fmaf(bflo(q[c * 4 + 3]), bflo(v.w), sc); sc = fmaf(bfhi(q[c * 4 + 3]), bfhi(v.w), sc);
            }
            if (j <= qpos) {
                const float mn = fmaxf(m, sc);
                const float alpha = exp2f(m - mn);
                const float p = exp2f(sc - mn);
                lsum = lsum * alpha + p; m = mn;
                const uint4* vr = (const uint4*)(Vp + (size_t)j * DV);
#pragma unroll
                for (int c = 0; c < 4; ++c) {
                    const uint4 v = vr[c];
                    o[c * 8 + 0] = fmaf(p, bflo(v.x), o[c * 8 + 0] * alpha); o[c * 8 + 1] = fmaf(p, bfhi(v.x), o[c * 8 + 1] * alpha);
                    o[c * 8 + 2] = fmaf(p, bflo(v.y), o[c * 8 + 2] * alpha); o[c * 8 + 3] = fmaf(p, bfhi(v.y), o[c * 8 + 3] * alpha);
                    o[c * 8 + 4] = fmaf(p, bflo(v.z), o[c * 8 + 4] * alpha); o[c * 8 + 5] = fmaf(p, bfhi(v.z), o[c * 8 + 5] * alpha);
                    o[c * 8 + 6] = fmaf(p, bflo(v.w), o[c * 8 + 6] * alpha); o[c * 8 + 7] = fmaf(p, bfhi(v.w), o[c * 8 + 7] * alpha);
                }
            }
        }
        const float inv = 1.f / lsum;
        const int b = bh >> 3, h = bh & 7;
        uint4* yo = (uint4*)(Y + ((size_t)(b * S + qpos)) * D + 512 + h * 64 + half * 32);
#pragma unroll
        for (int c = 0; c < 4; ++c) {
            uint4 v;
            v.x = pack2(o[c * 8 + 0] * inv, o[c * 8 + 1] * inv); v.y = pack2(o[c * 8 + 2] * inv, o[c * 8 + 3] * inv);
            v.z = pack2(o[c * 8 + 4] * inv, o[c * 8 + 5] * inv); v.w = pack2(o[c * 8 + 6] * inv, o[c * 8 + 7] * inv);
            yo[c] = v;
        }
    }
}


typedef short v4i16_t __attribute__((ext_vector_type(4)));
typedef __attribute__((address_space(3))) v4i16_t* lds_v4p;
__device__ __forceinline__ unsigned cvtpk(float lo, float hi) { unsigned r; asm("v_cvt_pk_bf16_f32 %0, %1, %2" : "=v"(r) : "v"(lo), "v"(hi)); return r; }
__device__ __forceinline__ v4i16_t vtr(const char* p) { return __builtin_amdgcn_ds_read_tr16_b64_v4i16((lds_v4p)p); }
constexpr int A_KP = 208, A_VP = 192;
constexpr int A_KB = 64 * A_KP, A_VB = 64 * A_VP, A_BUF = A_KB + A_VB, ATTN_LDS = 2 * A_BUF;
static_assert(ATTN_LDS <= GEMM_LDS, "attention LDS");

__device__ __forceinline__ void attn_unit(const bf16* __restrict__ Qb, const bf16* __restrict__ Kb, const bf16* __restrict__ Vb, bf16* __restrict__ Y, int bh, int qblk, char* lds) {
    const int tid = tidx(), lane = tid & 63, w = tid >> 6, r32 = lane & 31, hi = lane >> 5;
    const int q0 = qblk * 128, qw0 = q0 + w * 32;
    const int NT = 2 * qblk + 2;
    bf16x8 qf[6];
    {
        const bf16* qp = Qb + ((size_t)bh * S + qw0 + r32) * DQK + hi * 8;
#pragma unroll
        for (int ks = 0; ks < 6; ++ks) qf[ks] = *(const bf16x8*)(qp + ks * 16);
    }
    f32x16 o0, o1;
#pragma unroll
    for (int r = 0; r < 16; ++r) { o0[r] = 0.f; o1[r] = 0.f; }
    float m = -1e30f, lsum = 0.f;
    const char* Kg = (const char*)(Kb + (size_t)bh * S * DQK) + tid * 16;
    const char* Vg = (const char*)(Vb + (size_t)bh * S * DV) + tid * 16;
    const int kl0 = (tid / 12) * A_KP + (tid % 12) * 16, kl1 = ((tid + 256) / 12) * A_KP + ((tid + 256) % 12) * 16, kl2 = ((tid + 512) / 12) * A_KP + ((tid + 512) % 12) * 16;
    const int vl0 = (tid >> 3) * A_VP + (tid & 7) * 16, vl1 = vl0 + 32 * A_VP;
    uint4 k0, k1, k2, v0, v1;
#define A_LOAD(t) do { const char* kg = Kg + (size_t)(t) * (64 * 192); const char* vg = Vg + (size_t)(t) * (64 * 128); \
        k0 = *(const uint4*)(kg); k1 = *(const uint4*)(kg + 4096); k2 = *(const uint4*)(kg + 8192); v0 = *(const uint4*)(vg); v1 = *(const uint4*)(vg + 4096); } while (0)
    A_LOAD(0);
    const int pvo = (4 * hi + ((lane & 15) >> 2)) * A_VP + (16 * ((lane >> 4) & 1) + 4 * (lane & 3)) * 2;
    for (int t = 0; t < NT; ++t) {
        char* bK = lds + (t & 1) * A_BUF; char* bV = bK + A_KB;
        *(uint4*)(bK + kl0) = k0; *(uint4*)(bK + kl1) = k1; *(uint4*)(bK + kl2) = k2; *(uint4*)(bV + vl0) = v0; *(uint4*)(bV + vl1) = v1;
        __syncthreads();
        if (t + 1 < NT) A_LOAD(t + 1);
        const int kt0 = t * 64;
        if (kt0 <= qw0) {
            f32x16 s0, s1;
#pragma unroll
            for (int r = 0; r < 16; ++r) { s0[r] = 0.f; s1[r] = 0.f; }
            const char* pk = bK + r32 * A_KP + hi * 16;
#pragma unroll
            for (int ks = 0; ks < 6; ++ks) {
                const bf16x8 a0 = *(const bf16x8*)(pk + ks * 32), a1 = *(const bf16x8*)(pk + 32 * A_KP + ks * 32);
                s0 = MFMA32(a0, qf[ks], s0); s1 = MFMA32(a1, qf[ks], s1);
            }
            if (kt0 + 63 > qw0) {
                const int qrow = qw0 + r32;
#pragma unroll
                for (int r = 0; r < 16; ++r) { const int key = kt0 + crow(r, hi); if (key > qrow) s0[r] = -INFINITY; if (key + 32 > qrow) s1[r] = -INFINITY; }
            }
            float mx = fmaxf(s0[0], s1[0]);
#pragma unroll
            for (int r = 1; r < 16; ++r) mx = fmaxf(mx, fmaxf(s0[r], s1[r]));
            mx = fmaxf(mx, __shfl_xor(mx, 32, 64));
            const float mn = fmaxf(m, mx);
            const float alpha = __builtin_amdgcn_exp2f(m - mn);
            m = mn;
            float ps = 0.f;
#pragma unroll
            for (int r = 0; r < 16; ++r) { s0[r] = __builtin_amdgcn_exp2f(s0[r] - mn); s1[r] = __builtin_amdgcn_exp2f(s1[r] - mn); ps += s0[r] + s1[r]; }
            lsum = lsum * alpha + ps;
#pragma unroll
            for (int r = 0; r < 16; ++r) { o0[r] *= alpha; o1[r] *= alpha; }
            union { unsigned u[4]; bf16x8 v; } p00, p01, p10, p11;
#pragma unroll
            for (int j = 0; j < 4; ++j) { p00.u[j] = cvtpk(s0[2 * j], s0[2 * j + 1]); p01.u[j] = cvtpk(s0[8 + 2 * j], s0[9 + 2 * j]); p10.u[j] = cvtpk(s1[2 * j], s1[2 * j + 1]); p11.u[j] = cvtpk(s1[8 + 2 * j], s1[9 + 2 * j]); }
            const char* pv = bV + pvo;
#define A_PV(pf, kofs) do { \
            { const v4i16_t lo = vtr(pv + (kofs) * A_VP), hh = vtr(pv + ((kofs) + 8) * A_VP); const bf16x8 vf = {lo[0], lo[1], lo[2], lo[3], hh[0], hh[1], hh[2], hh[3]}; o0 = MFMA32(vf, pf.v, o0); } \
            { const v4i16_t lo = vtr(pv + (kofs) * A_VP + 64), hh = vtr(pv + ((kofs) + 8) * A_VP + 64); const bf16x8 vf = {lo[0], lo[1], lo[2], lo[3], hh[0], hh[1], hh[2], hh[3]}; o1 = MFMA32(vf, pf.v, o1); } } while (0)
            A_PV(p00, 0); A_PV(p01, 16); A_PV(p10, 32); A_PV(p11, 48);
        }
    }
    lsum += __shfl_xor(lsum, 32, 64);
    const float inv = 1.f / lsum;
    const int b = bh >> 3, h = bh & 7;
    bf16* yo = Y + (size_t)(b * S + qw0 + r32) * D + 512 + h * 64 + 4 * hi;
#pragma unroll
    for (int g = 0; g < 4; ++g) {
        uint2 a, c;
        a.x = cvtpk(o0[4 * g] * inv, o0[4 * g + 1] * inv); a.y = cvtpk(o0[4 * g + 2] * inv, o0[4 * g + 3] * inv);
        c.x = cvtpk(o1[4 * g] * inv, o1[4 * g + 1] * inv); c.y = cvtpk(o1[4 * g + 2] * inv, o1[4 * g + 3] * inv);
        *(uint2*)(yo + 8 * g) = a; *(uint2*)(yo + 32 + 8 * g) = c;
    }
    __syncthreads();
}
__device__ __forceinline__ void phase_attn(const Params& P, char* lds) {
    const bf16* Qb = (const bf16*)(P.ws + WS_Q);
    const bf16* Kb = (const bf16*)(P.ws + WS_K);
    const bf16* Vb = (const bf16*)(P.ws + WS_V);
    bf16* Y = (bf16*)(P.ws + WS_XN);
    for (int u = blockIdx.x; u < NB * NH * (S / 128); u += gridDim.x) {
        const int bh = u & 31, v = u >> 5;
        const int qblk = (v < 16) ? (63 - v) : (v < 32) ? (v - 16) : (v < 48) ? (79 - v) : (v - 32);
        attn_unit(Qb, Kb, Vb, Y, bh, qblk, lds);
    }
}

__device__ __forceinline__ void wave_argmax(float& bv, int& bi) {
#pragma unroll
    for (int m = 32; m >= 1; m >>= 1) {
        const float ov = __shfl_xor(bv, m, 64); const int oi = __shfl_xor(bi, m, 64);
        if (ov > bv || (ov == bv && oi < bi)) { bv = ov; bi = oi; }
    }
}
__device__ __forceinline__ void peer_half_top16(const float* __restrict__ skp, const float* qs, int, int lane, float& sp, int& ip) {
    const float NEG = -3.0e38f;
    float v0 = 0.f, v1 = 0.f;
    const float4* r0 = (const float4*)(skp + (size_t)lane * 128);
    const float4* r1 = (const float4*)(skp + (size_t)(lane + 64) * 128);
    for (int d = 0; d < 32; ++d) {
        const float4 a = r0[d], bq = r1[d];
        const float q0 = qs[d * 4 + 0], q1 = qs[d * 4 + 1], q2 = qs[d * 4 + 2], q3 = qs[d * 4 + 3];
        v0 = fmaf(q0, a.x, v0); v0 = fmaf(q1, a.y, v0); v0 = fmaf(q2, a.z, v0); v0 = fmaf(q3, a.w, v0);
        v1 = fmaf(q0, bq.x, v1); v1 = fmaf(q1, bq.y, v1); v1 = fmaf(q2, bq.z, v1); v1 = fmaf(q3, bq.w, v1);
    }
    sp = 0.f; ip = 0;
    for (int k = 0; k < TOPK; ++k) {
        float bv; int bi;
        if (v0 >= v1) { bv = v0; bi = lane; } else { bv = v1; bi = lane + 64; }
        wave_argmax(bv, bi);
        if (lane == k) { sp = bv; ip = bi; }
        if (bi == lane) v0 = NEG; else if (bi == lane + 64) v1 = NEG;
    }
}
__device__ __forceinline__ void phase_topk_naive(const Params& P, int l, float* sm) {
    const bf16* QP = (const bf16*)(P.ws + WS_QP);
    int* EXPp = (int*)(P.ws + WS_EXP);
    float* GATEp = (float*)(P.ws + WS_GATE);
    const float* sk = P.peer_subkeys + (size_t)l * 2 * NKEY * 128;
    const int lane = tidx() & 63, wv = tidx() >> 6;
    float* qs = sm + wv * 256;
    const float NEG = -3.0e38f;
    for (int u = gwave(); u < T * PH; u += nwave()) {
        const int t = u >> 3, h = u & 7;
        {
            const bf16* qp = QP + (size_t)t * 2048 + h * 256;
#pragma unroll
            for (int j = 0; j < 4; ++j) qs[j * 64 + lane] = bf2f(qp[j * 64 + lane]);
        }
        __builtin_amdgcn_s_waitcnt(0);
        __builtin_amdgcn_wave_barrier();
        float stop0, stop1; int itop0, itop1;
        peer_half_top16(sk, qs, 0, lane, stop0, itop0);
        peer_half_top16(sk + (size_t)NKEY * 128, qs + 128, 0, lane, stop1, itop1);
        __builtin_amdgcn_wave_barrier();
        float cv[4];
#pragma unroll
        for (int r = 0; r < 4; ++r) { const int c = lane + 64 * r; cv[r] = __shfl(stop0, c >> 4, 64) + __shfl(stop1, c & 15, 64); }
        float ts = 0.f; int ci = 0;
        for (int k = 0; k < TOPK; ++k) {
            float bv = cv[0]; int bi = lane;
#pragma unroll
            for (int r = 1; r < 4; ++r) if (cv[r] > bv) { bv = cv[r]; bi = lane + 64 * r; }
            wave_argmax(bv, bi);
            if (lane == k) { ts = bv; ci = bi; }
#pragma unroll
            for (int r = 0; r < 4; ++r) if (bi == lane + 64 * r) cv[r] = NEG;
        }
        const int e1 = __shfl(itop0, ci >> 4, 64), e2 = __shfl(itop1, ci & 15, 64);
        const float smax = __shfl(ts, 0, 64);
        float ex = (lane < 16) ? __expf(ts - smax) : 0.f;
        float den = ex;
#pragma unroll
        for (int m = 8; m >= 1; m >>= 1) den += __shfl_xor(den, m, 64);
        if (lane < 16) {
            EXPp[(size_t)t * HK + h * 16 + lane] = e1 * NKEY + e2;
            GATEp[(size_t)t * HK + h * 16 + lane] = ex / den;
        }
    }
}

__device__ __forceinline__ void phase_gather_naive(const Params& P, int l) {
    const bf16* XN = (const bf16*)(P.ws + WS_XN);
    const int* EXPp = (const int*)(P.ws + WS_EXP);
    const float* GATEp = (const float*)(P.ws + WS_GATE);
    const float* U = P.peer_u + (size_t)l * NEXP * D;
    const float* V = P.peer_v + (size_t)l * NEXP * D;
    const int lane = tidx() & 63;
    for (int t = gwave(); t < T; t += nwave()) {
        float4 xv[4];
#pragma unroll
        for (int j = 0; j < 4; ++j) {
            const uint2 r = ((const uint2*)(XN + (size_t)t * D))[j * 64 + lane];
            xv[j] = make_float4(bflo(r.x), bfhi(r.x), bflo(r.y), bfhi(r.y));
        }
        float4 acc[4];
#pragma unroll
        for (int j = 0; j < 4; ++j) acc[j] = make_float4(0.f, 0.f, 0.f, 0.f);
        for (int k = 0; k < HK; ++k) {
            const int e = EXPp[(size_t)t * HK + k];
            const float g = GATEp[(size_t)t * HK + k];
            const float4* ur = (const float4*)(U + (size_t)e * D);
            float d = 0.f;
#pragma unroll
            for (int j = 0; j < 4; ++j) { const float4 u = ur[j * 64 + lane]; d += xv[j].x * u.x + xv[j].y * u.y + xv[j].z * u.z + xv[j].w * u.w; }
            d = wave_sum(d);
            const float a = g * gelu_exact(d);
            const float4* vr = (const float4*)(V + (size_t)e * D);
#pragma unroll
            for (int j = 0; j < 4; ++j) { const float4 v = vr[j * 64 + lane]; acc[j].x = fmaf(a, v.x, acc[j].x); acc[j].y = fmaf(a, v.y, acc[j].y); acc[j].z = fmaf(a, v.z, acc[j].z); acc[j].w = fmaf(a, v.w, acc[j].w); }
        }
        float4* hr = (float4*)(P.out + (size_t)t * D);
        float ss = 0.f;
#pragma unroll
        for (int j = 0; j < 4; ++j) {
            const float4 hv = hr[j * 64 + lane];
            acc[j].x += hv.x; acc[j].y += hv.y; acc[j].z += hv.z; acc[j].w += hv.w;
            ss += acc[j].x * acc[j].x + acc[j].y * acc[j].y + acc[j].z * acc[j].z + acc[j].w * acc[j].w;
        }
        if (l == DEPTH - 1) {
            ss = wave_sum(ss);
            const float r = rsqrtf(ss * (1.f / D) + EPS);
#pragma unroll
            for (int j = 0; j < 4; ++j) {
                const float4 gg = ((const float4*)P.norm_final)[j * 64 + lane];
                hr[j * 64 + lane] = make_float4(acc[j].x * r * gg.x, acc[j].y * r * gg.y, acc[j].z * r * gg.z, acc[j].w * r * gg.w);
            }
        } else {
#pragma unroll
            for (int j = 0; j < 4; ++j) hr[j * 64 + lane] = acc[j];
        }
    }
}


#define NET_HD __device__ __forceinline__
#define NET_U2F(u) __uint_as_float(u)
#define NET_F2U(f) __float_as_uint(f)
#define CE_DESC(a, b) do { const float hi__ = fmaxf(a, b), lo__ = fminf(a, b); a = hi__; b = lo__; } while (0)
NET_HD void sort16_desc(float (&v)[16]) {
#pragma unroll
    for (int k = 2; k <= 16; k <<= 1) {
#pragma unroll
        for (int j = k >> 1; j > 0; j >>= 1) {
#pragma unroll
            for (int i = 0; i < 16; ++i) {
                const int l = i ^ j;
                if (l > i) { if ((i & k) == 0) CE_DESC(v[i], v[l]); else CE_DESC(v[l], v[i]); }
            }
        }
    }
}
NET_HD void merge16_desc(float (&a)[16], const float (&b)[16]) {
#pragma unroll
    for (int i = 0; i < 16; ++i) a[i] = fmaxf(a[i], b[15 - i]);
#pragma unroll
    for (int j = 8; j > 0; j >>= 1) {
#pragma unroll
        for (int i = 0; i < 16; ++i) { const int l = i ^ j; if (l > i) CE_DESC(a[i], a[l]); }
    }
}
NET_HD void top16_of_64(float (&g0)[16], float (&g1)[16], float (&g2)[16], float (&g3)[16]) {
    sort16_desc(g0); sort16_desc(g1); sort16_desc(g2); sort16_desc(g3);
    merge16_desc(g0, g1); merge16_desc(g2, g3); merge16_desc(g0, g2);
}
NET_HD float u2f(unsigned u) { return NET_U2F(u); }
NET_HD unsigned f2u(float f) { return NET_F2U(f); }
template <class V16>
NET_HD void lane_top16(const V16& s0, const V16& s1, const V16& s2, const V16& s3, int hi, float (&out)[16]) {
    float g0[16], g1[16], g2[16], g3[16];
#pragma unroll
    for (int r = 0; r < 16; ++r) {
        const unsigned nb = (unsigned)((r & 3) + 8 * (r >> 2));
        g0[r] = u2f((f2u(s0[r]) & 0xFFFFFF80u) | nb); g1[r] = u2f((f2u(s1[r]) & 0xFFFFFF80u) | (nb + 32u));
        g2[r] = u2f((f2u(s2[r]) & 0xFFFFFF80u) | (nb + 64u)); g3[r] = u2f((f2u(s3[r]) & 0xFFFFFF80u) | (nb + 96u));
    }
    top16_of_64(g0, g1, g2, g3);
    const unsigned h4 = (unsigned)hi << 2;
#pragma unroll
    for (int i = 0; i < 16; ++i) out[i] = u2f(f2u(g0[i]) | h4);
}
constexpr int cand_slot(int a, int b) { int n = 0; for (int x = 0; x < 16; ++x) for (int y = 0; y < 16; ++y) { if (x == a && y == b) return n; if ((x + 1) * (y + 1) <= 16) ++n; } return n; }
NET_HD void cand_top16(const float (&s1)[16], const float (&s2)[16], float (&c)[16]) {
    float g0[16], g1[16], g2[16], g3[16];
#pragma unroll
    for (int i = 0; i < 16; ++i) { g0[i] = -3.0e38f; g1[i] = -3.0e38f; g2[i] = -3.0e38f; g3[i] = -3.0e38f; }
#pragma unroll
    for (int a = 0; a < 16; ++a) {
#pragma unroll
        for (int b = 0; b < 16; ++b) {
            if ((a + 1) * (b + 1) <= 16) {
                const int sl = cand_slot(a, b);
                const float v = u2f((f2u(s1[a] + s2[b]) & 0xFFFFFF00u) | (unsigned)(a * 16 + b));
                if (sl < 16) g0[sl & 15] = v; else if (sl < 32) g1[sl & 15] = v; else if (sl < 48) g2[sl & 15] = v; else g3[sl & 15] = v;
            }
        }
    }
    top16_of_64(g0, g1, g2, g3);
#pragma unroll
    for (int i = 0; i < 16; ++i) c[i] = g0[i];
}

__device__ __forceinline__ void phase_route(const Params& P, int l, char* lds) {
    const bf16* XN = (const bf16*)(P.ws + WS_XN);
    const bf16* Wc = (const bf16*)(P.ws + WS_WPQ) + (size_t)l * 2048 * D;
    int* EXPp = (int*)(P.ws + WS_EXP);
    float* GATEp = (float*)(P.ws + WS_GATE);
    const int tid = tidx(), lane = tid & 63, w = tid >> 6, r32 = lane & 31, hi = lane >> 5;
    for (int u = blockIdx.x; u < (T / 128) * PH; u += gridDim.x) {
        const int tm = u >> 3, h = u & 7;
        float L0[16], L1[16];
        {
            f32x16 acc[4];
            gemm_kloop<1>(Wc + (size_t)((h * 2 + 0) * 128) * D, D, XN + (size_t)(tm * 128) * D, D, D / 64, acc, lds, tid);
            lane_top16(acc[0], acc[1], acc[2], acc[3], hi, L0);
            float o[16];
#pragma unroll
            for (int i = 0; i < 16; ++i) o[i] = __shfl_xor(L0[i], 32, 64);
            merge16_desc(L0, o);
        }
        {
            f32x16 acc[4];
            gemm_kloop<1>(Wc + (size_t)((h * 2 + 1) * 128) * D, D, XN + (size_t)(tm * 128) * D, D, D / 64, acc, lds, tid);
            lane_top16(acc[0], acc[1], acc[2], acc[3], hi, L1);
            float o[16];
#pragma unroll
            for (int i = 0; i < 16; ++i) o[i] = __shfl_xor(L1[i], 32, 64);
            merge16_desc(L1, o);
        }
        float c[16];
        cand_top16(L0, L1, c);
        __syncthreads();
        unsigned char* my = (unsigned char*)lds + tid * 32;
        {
            uint4 a, b;
#define PK4(L, i) ((__float_as_uint(L[i]) & 127u) | ((__float_as_uint(L[i + 1]) & 127u) << 8) | ((__float_as_uint(L[i + 2]) & 127u) << 16) | ((__float_as_uint(L[i + 3]) & 127u) << 24))
            a.x = PK4(L0, 0); a.y = PK4(L0, 4); a.z = PK4(L0, 8); a.w = PK4(L0, 12);
            b.x = PK4(L1, 0); b.y = PK4(L1, 4); b.z = PK4(L1, 8); b.w = PK4(L1, 12);
#undef PK4
            *(uint4*)my = a; *(uint4*)(my + 16) = b;
        }
        int ev[16]; float gv[16]; float den = 0.f;
#pragma unroll
        for (int k = 0; k < 16; ++k) {
            const unsigned ci = __float_as_uint(c[k]) & 255u;
            const int n1 = my[ci >> 4], n2 = my[16 + (ci & 15)];
            ev[k] = n1 * NKEY + n2;
            gv[k] = __expf(c[k] - c[0]); den += gv[k];
        }
        const float iden = 1.f / den;
        if (hi == 0) {
            const int t = tm * 128 + w * 32 + r32;
            uint4* ep = (uint4*)(EXPp + (size_t)t * HK + h * 16);
            float4* gp = (float4*)(GATEp + (size_t)t * HK + h * 16);
#pragma unroll
            for (int q = 0; q < 4; ++q) {
                ep[q] = make_uint4((unsigned)ev[4 * q], (unsigned)ev[4 * q + 1], (unsigned)ev[4 * q + 2], (unsigned)ev[4 * q + 3]);
                gp[q] = make_float4(gv[4 * q] * iden, gv[4 * q + 1] * iden, gv[4 * q + 2] * iden, gv[4 * q + 3] * iden);
            }
        }
        __syncthreads();
    }
}

__device__ __forceinline__ float red16(float (&p)[16], int lane) {
#pragma unroll
    for (int i = 0; i < 8; ++i) { const bool up = lane & 32; const float send = up ? p[i] : p[i + 8], keep = up ? p[i + 8] : p[i]; p[i] = keep + __shfl_xor(send, 32, 64); }
#pragma unroll
    for (int i = 0; i < 4; ++i) { const bool up = lane & 16; const float send = up ? p[i] : p[i + 4], keep = up ? p[i + 4] : p[i]; p[i] = keep + __shfl_xor(send, 16, 64); }
#pragma unroll
    for (int i = 0; i < 2; ++i) { const bool up = lane & 8; const float send = up ? p[i] : p[i + 2], keep = up ? p[i + 2] : p[i]; p[i] = keep + __shfl_xor(send, 8, 64); }
    { const bool up = lane & 4; const float send = up ? p[0] : p[1], keep = up ? p[1] : p[0]; p[0] = keep + __shfl_xor(send, 4, 64); }
    float r = p[0];
    r += __shfl_xor(r, 2, 64); r += __shfl_xor(r, 1, 64);
    return r;
}
typedef __attribute__((ext_vector_type(2))) __bf16 bf2_t;
__device__ __forceinline__ float dot2bf(unsigned a, unsigned b, float c) { return __builtin_amdgcn_fdot2_f32_bf16(__builtin_bit_cast(bf2_t, a), __builtin_bit_cast(bf2_t, b), c, false); }

__device__ __forceinline__ void phase_gather(const Params& P, int l) {
    const bf16* XN = (const bf16*)(P.ws + WS_XN);
    bf16* XNw = (bf16*)(P.ws + WS_XN);
    const int* EXPp = (const int*)(P.ws + WS_EXP);
    const float* GATEp = (const float*)(P.ws + WS_GATE);
    const unsigned char* U = P.ws + WS_TABU + (size_t)l * NEXP * TAB_ROWB;
    const unsigned char* V = P.ws + WS_TABV + (size_t)l * NEXP * TAB_ROWB;
    const float* SU = (const float*)(P.ws + WS_TSCU) + (size_t)l * NEXP;
    const float* SV = (const float*)(P.ws + WS_TSCV) + (size_t)l * NEXP;
    const int lane = tidx() & 63;
    for (int t = gwave(); t < T; t += nwave()) {
        const int e_lo = EXPp[(size_t)t * HK + lane], e_hi = EXPp[(size_t)t * HK + 64 + lane];
#if TAB_FP8
        float xf[16];
        {
            const uint4 a = ((const uint4*)(XN + (size_t)t * D))[lane * 2], b = ((const uint4*)(XN + (size_t)t * D))[lane * 2 + 1];
            xf[0] = bflo(a.x); xf[1] = bfhi(a.x); xf[2] = bflo(a.y); xf[3] = bfhi(a.y); xf[4] = bflo(a.z); xf[5] = bfhi(a.z); xf[6] = bflo(a.w); xf[7] = bfhi(a.w);
            xf[8] = bflo(b.x); xf[9] = bfhi(b.x); xf[10] = bflo(b.y); xf[11] = bfhi(b.y); xf[12] = bflo(b.z); xf[13] = bfhi(b.z); xf[14] = bflo(b.w); xf[15] = bfhi(b.w);
        }
#else
        const uint4 xa = ((const uint4*)(XN + (size_t)t * D))[lane], xb = ((const uint4*)(XN + (size_t)t * D))[64 + lane];
#endif
        float acc[16];
#pragma unroll
        for (int i = 0; i < 16; ++i) acc[i] = 0.f;
        for (int c = 0; c < 8; ++c) {
            const int esel = (c < 4) ? e_lo : e_hi;
            const int kb = (c & 3) * 16;
            float part[16];
#pragma unroll
            for (int hb = 0; hb < 2; ++hb) {
#if TAB_FP8
                uint4 r[8];
#pragma unroll
                for (int i = 0; i < 8; ++i) { const int e = __builtin_amdgcn_readlane(esel, kb + hb * 8 + i); r[i] = *(const uint4*)(U + (size_t)e * 1024 + lane * 16); }
#pragma unroll
                for (int i = 0; i < 8; ++i) {
                    float d0 = 0.f, d1 = 0.f;
                    const unsigned w[4] = {r[i].x, r[i].y, r[i].z, r[i].w};
#pragma unroll
                    for (int q = 0; q < 4; ++q) {
                        const auto lo = __builtin_amdgcn_cvt_pk_f32_fp8((int)w[q], false); const auto hh = __builtin_amdgcn_cvt_pk_f32_fp8((int)w[q], true);
                        d0 = fmaf(xf[4 * q], lo[0], d0); d1 = fmaf(xf[4 * q + 1], lo[1], d1); d0 = fmaf(xf[4 * q + 2], hh[0], d0); d1 = fmaf(xf[4 * q + 3], hh[1], d1);
                    }
                    part[hb * 8 + i] = d0 + d1;
                }
#else
                uint4 r0[8], r1[8];
#pragma unroll
                for (int i = 0; i < 8; ++i) { const int e = __builtin_amdgcn_readlane(esel, kb + hb * 8 + i); const unsigned char* rp = U + (size_t)e * 2048 + lane * 16; r0[i] = *(const uint4*)(rp); r1[i] = *(const uint4*)(rp + 1024); }
#pragma unroll
                for (int i = 0; i < 8; ++i) {
                    float d0 = 0.f, d1 = 0.f;
                    d0 = dot2bf(xa.x, r0[i].x, d0); d1 = dot2bf(xa.y, r0[i].y, d1); d0 = dot2bf(xa.z, r0[i].z, d0); d1 = dot2bf(xa.w, r0[i].w, d1);
                    d0 = dot2bf(xb.x, r1[i].x, d0); d1 = dot2bf(xb.y, r1[i].y, d1); d0 = dot2bf(xb.z, r1[i].z, d0); d1 = dot2bf(xb.w, r1[i].w, d1);
                    part[hb * 8 + i] = d0 + d1;
                }
#endif
            }
            float dsum = red16(part, lane);
            const int kk = c * 16 + (lane >> 2);
            const int eme = __shfl(esel, kb + (lane >> 2), 64);
            float wv = GATEp[(size_t)t * HK + kk];
#if TAB_FP8
            dsum *= SU[eme];
            wv *= SV[eme];
#endif
            wv *= gelu_exact(dsum);
#pragma unroll
            for (int hb = 0; hb < 2; ++hb) {
#if TAB_FP8
                uint4 r[8];
#pragma unroll
                for (int i = 0; i < 8; ++i) { const int e = __builtin_amdgcn_readlane(esel, kb + hb * 8 + i); r[i] = *(const uint4*)(V + (size_t)e * 1024 + lane * 16); }
#pragma unroll
                for (int i = 0; i < 8; ++i) {
                    const float w = __int_as_float(__builtin_amdgcn_readlane(__float_as_int(wv), (hb * 8 + i) * 4));
                    const unsigned ww[4] = {r[i].x, r[i].y, r[i].z, r[i].w};
#pragma unroll
                    for (int q = 0; q < 4; ++q) {
                        const auto lo = __builtin_amdgcn_cvt_pk_f32_fp8((int)ww[q], false); const auto hh = __builtin_amdgcn_cvt_pk_f32_fp8((int)ww[q], true);
                        acc[4 * q] = fmaf(w, lo[0], acc[4 * q]); acc[4 * q + 1] = fmaf(w, lo[1], acc[4 * q + 1]); acc[4 * q + 2] = fmaf(w, hh[0], acc[4 * q + 2]); acc[4 * q + 3] = fmaf(w, hh[1], acc[4 * q + 3]);
                    }
                }
#else
                uint4 r0[8], r1[8];
#pragma unroll
                for (int i = 0; i < 8; ++i) { const int e = __builtin_amdgcn_readlane(esel, kb + hb * 8 + i); const unsigned char* rp = V + (size_t)e * 2048 + lane * 16; r0[i] = *(const uint4*)(rp); r1[i] = *(const uint4*)(rp + 1024); }
#pragma unroll
                for (int i = 0; i < 8; ++i) {
                    const float w = __int_as_float(__builtin_amdgcn_readlane(__float_as_int(wv), (hb * 8 + i) * 4));
                    acc[0] = fmaf(w, bflo(r0[i].x), acc[0]); acc[1] = fmaf(w, bfhi(r0[i].x), acc[1]); acc[2] = fmaf(w, bflo(r0[i].y), acc[2]); acc[3] = fmaf(w, bfhi(r0[i].y), acc[3]);
                    acc[4] = fmaf(w, bflo(r0[i].z), acc[4]); acc[5] = fmaf(w, bfhi(r0[i].z), acc[5]); acc[6] = fmaf(w, bflo(r0[i].w), acc[6]); acc[7] = fmaf(w, bfhi(r0[i].w), acc[7]);
                    acc[8] = fmaf(w, bflo(r1[i].x), acc[8]); acc[9] = fmaf(w, bfhi(r1[i].x), acc[9]); acc[10] = fmaf(w, bflo(r1[i].y), acc[10]); acc[11] = fmaf(w, bfhi(r1[i].y), acc[11]);
                    acc[12] = fmaf(w, bflo(r1[i].z), acc[12]); acc[13] = fmaf(w, bfhi(r1[i].z), acc[13]); acc[14] = fmaf(w, bflo(r1[i].w), acc[14]); acc[15] = fmaf(w, bfhi(r1[i].w), acc[15]);
                }
#endif
            }
        }
        float* hrow = P.out + (size_t)t * D;
#if TAB_FP8
        const int c0 = lane * 16, c1 = lane * 16 + 8;
#else
        const int c0 = lane * 8, c1 = 512 + lane * 8;
#endif
        float4 h0 = *(const float4*)(hrow + c0), h1 = *(const float4*)(hrow + c0 + 4), h2 = *(const float4*)(hrow + c1), h3 = *(const float4*)(hrow + c1 + 4);
        h0.x += acc[0]; h0.y += acc[1]; h0.z += acc[2]; h0.w += acc[3]; h1.x += acc[4]; h1.y += acc[5]; h1.z += acc[6]; h1.w += acc[7];
        h2.x += acc[8]; h2.y += acc[9]; h2.z += acc[10]; h2.w += acc[11]; h3.x += acc[12]; h3.y += acc[13]; h3.z += acc[14]; h3.w += acc[15];
        float ss = h0.x * h0.x + h0.y * h0.y + h0.z * h0.z + h0.w * h0.w + h1.x * h1.x + h1.y * h1.y + h1.z * h1.z + h1.w * h1.w
                 + h2.x * h2.x + h2.y * h2.y + h2.z * h2.z + h2.w * h2.w + h3.x * h3.x + h3.y * h3.y + h3.z * h3.z + h3.w * h3.w;
        ss = wave_sum(ss);
        const float rn = rsqrtf(ss * (1.f / D) + EPS);
        if (l == DEPTH - 1) {
            const float* g = P.norm_final;
            const float4 g0 = *(const float4*)(g + c0), g1 = *(const float4*)(g + c0 + 4), g2 = *(const float4*)(g + c1), g3 = *(const float4*)(g + c1 + 4);
            *(float4*)(hrow + c0) = make_float4(h0.x * rn * g0.x, h0.y * rn * g0.y, h0.z * rn * g0.z, h0.w * rn * g0.w);
            *(float4*)(hrow + c0 + 4) = make_float4(h1.x * rn * g1.x, h1.y * rn * g1.y, h1.z * rn * g1.z, h1.w * rn * g1.w);
            *(float4*)(hrow + c1) = make_float4(h2.x * rn * g2.x, h2.y * rn * g2.y, h2.z * rn * g2.z, h2.w * rn * g2.w);
            *(float4*)(hrow + c1 + 4) = make_float4(h3.x * rn * g3.x, h3.y * rn * g3.y, h3.z * rn * g3.z, h3.w * rn * g3.w);
        } else {
            *(float4*)(hrow + c0) = h0; *(float4*)(hrow + c0 + 4) = h1; *(float4*)(hrow + c1) = h2; *(float4*)(hrow + c1 + 4) = h3;
            const float* g = P.norm_mix + (l + 1) * D;
            const float4 g0 = *(const float4*)(g + c0), g1 = *(const float4*)(g + c0 + 4), g2 = *(const float4*)(g + c1), g3 = *(const float4*)(g + c1 + 4);
            uint4 o0, o1;
            o0.x = pack2(h0.x * rn * g0.x, h0.y * rn * g0.y); o0.y = pack2(h0.z * rn * g0.z, h0.w * rn * g0.w); o0.z = pack2(h1.x * rn * g1.x, h1.y * rn * g1.y); o0.w = pack2(h1.z * rn * g1.z, h1.w * rn * g1.w);
            o1.x = pack2(h2.x * rn * g2.x, h2.y * rn * g2.y); o1.y = pack2(h2.z * rn * g2.z, h2.w * rn * g2.w); o1.z = pack2(h3.x * rn * g3.x, h3.y * rn * g3.y); o1.w = pack2(h3.z * rn * g3.z, h3.w * rn * g3.w);
            *(uint4*)(XNw + (size_t)t * D + c0) = o0; *(uint4*)(XNw + (size_t)t * D + c1) = o1;
        }
    }
}

constexpr int PH_PER_LAYER = 11;
constexpr int NPHASES = 1 + DEPTH * PH_PER_LAYER;

constexpr float QSCALE = 0.10206207261596575f * 1.4426950408889634f;
template <int s>
__device__ __forceinline__ void layer_phase(const Params& P, int l, char* lds) {
    unsigned char* ws = P.ws;
    float* sm = (float*)lds;
    bf16* XN = (bf16*)(ws + WS_XN);
    bf16* PROJ = (bf16*)(ws + WS_PROJ);
    const float* hin = (l == 0) ? P.x : P.out;
    if constexpr (s == 0) phase_norm(hin, P.norm_mix + l * D, XN);
    if constexpr (s == 1) {
        const bf16* W = (const bf16*)(ws + WS_WIN) + (size_t)l * DINP * D;
        gemm_mfma(XN, D, W, D, T, DINP, D, [&](int m0, int n0, const f32x16& acc, int r32, int hi) {
            const int n = n0 + r32;
            if (n < DIN) {
#pragma unroll
                for (int r = 0; r < 16; ++r) PROJ[(size_t)(m0 + crow(r, hi)) * DINP + n] = f2bf(acc[r]);
            }
        }, lds);
    }
    if constexpr (s == 2) phase_mixprep(P, l);
    if constexpr (s == 3) {
        const bf16* W = (const bf16*)(ws + WS_WUQ) + (size_t)l * 768 * QR;
        bf16* Qb = (bf16*)(ws + WS_Q);
        const float* rope = (const float*)(ws + WS_ROPE);
        gemm_mfma(PROJ + C_CQ, DINP, W, QR, T, 768, QR, [&](int m0, int n0, const f32x16& acc, int r32, int hi) {
            const int h = n0 / DQK, d0 = n0 % DQK;
            const int b = m0 / S, s0 = m0 % S;
            bf16* qb = Qb + ((size_t)(b * NH + h) * S + s0) * DQK + d0 + r32;
            if (d0 == 64) {
                const int f = r32 & 15;
#pragma unroll
                for (int r = 0; r < 16; ++r) {
                    const int sr = crow(r, hi);
                    const float v = acc[r], o = __shfl_xor(v, 16, 64);
                    const float2 cs = *(const float2*)(rope + ((size_t)(s0 + sr) * 16 + f) * 2);
                    const float res = (r32 < 16) ? (v * cs.x - o * cs.y) : (v * cs.x + o * cs.y);
                    qb[(size_t)sr * DQK] = f2bf(res * QSCALE);
                }
            } else {
#pragma unroll
                for (int r = 0; r < 16; ++r) qb[(size_t)crow(r, hi) * DQK] = f2bf(acc[r] * QSCALE);
            }
        }, lds);
    }
    if constexpr (s == 4) {
        const bf16* W = (const bf16*)(ws + WS_WUKV) + (size_t)l * 1024 * KVR;
        bf16* Kb = (bf16*)(ws + WS_K); bf16* Vb = (bf16*)(ws + WS_V);
        gemm_mfma(PROJ + C_CKV, DINP, W, KVR, T, 1024, KVR, [&](int m0, int n0, const f32x16& acc, int r32, int hi) {
            const int b = m0 / S, s0 = m0 % S;
            if (n0 < 512) {
                const int h = n0 >> 6, d = (n0 & 63) + r32;
                bf16* kb = Kb + ((size_t)(b * NH + h) * S + s0) * DQK + d;
#pragma unroll
                for (int r = 0; r < 16; ++r) kb[(size_t)crow(r, hi) * DQK] = f2bf(acc[r]);
            } else {
                const int h = (n0 - 512) >> 6, d = (n0 & 63) + r32;
                bf16* vb = Vb + ((size_t)(b * NH + h) * S + s0) * DV + d;
#pragma unroll
                for (int r = 0; r < 16; ++r) vb[(size_t)crow(r, hi) * DV] = f2bf(acc[r]);
            }
        }, lds);
    }
    if constexpr (s == 5) { }
#if ATTN_MFMA
    if constexpr (s == 6) phase_attn(P, lds);
#else
    if constexpr (s == 6) phase_attn_naive(P);
#endif
    if constexpr (s == 7) {
        const bf16* W = (const bf16*)(ws + WS_WOUT) + (size_t)l * D * D;
        float* out = P.out;
        gemm_mfma(XN, D, W, D, T, D, D, [&](int m0, int n0, const f32x16& acc, int r32, int hi) {
#pragma unroll
            for (int r = 0; r < 16; ++r) { const size_t idx = (size_t)(m0 + crow(r, hi)) * D + n0 + r32; out[idx] = hin[idx] + acc[r]; }
        }, lds);
    }
    if constexpr (s == 8) phase_norm(P.out, P.norm_ffn + l * D, XN);
    if constexpr (s == 9) {
        const bf16* W = (const bf16*)(ws + WS_WPQ) + (size_t)l * 2048 * D;
        bf16* QP = (bf16*)(ws + WS_QP);
        gemm_mfma(XN, D, W, D, T, 2048, D, [&](int m0, int n0, const f32x16& acc, int r32, int hi) {
#pragma unroll
            for (int r = 0; r < 16; ++r) QP[(size_t)(m0 + crow(r, hi)) * 2048 + n0 + r32] = f2bf(acc[r]);
        }, lds);
    }
    if constexpr (s == 10) phase_topk_naive(P, l, sm);
}

__device__ __forceinline__ void layer_phase_dyn(const Params& P, int l, int s, char* sm) {
    switch (s) {
    case 0: layer_phase<0>(P, l, sm); break; case 1: layer_phase<1>(P, l, sm); break; case 2: layer_phase<2>(P, l, sm); break;
    case 3: layer_phase<3>(P, l, sm); break; case 4: layer_phase<4>(P, l, sm); break; case 5: layer_phase<5>(P, l, sm); break;
    case 6: layer_phase<6>(P, l, sm); break; case 7: layer_phase<7>(P, l, sm); break; case 8: layer_phase<8>(P, l, sm); break;
    case 9: layer_phase<9>(P, l, sm); break; case 10: layer_phase<10>(P, l, sm); break; default: phase_gather_naive(P, l); break;
    }
}
#if !ONE_LAUNCH
__global__ void __launch_bounds__(NTHREADS, 2) k_phase(Params P, int ph) {
    __shared__ __attribute__((aligned(16))) char sm[GEMM_LDS];
    if (ph == 0) { phase_prep(P); return; }
    layer_phase_dyn(P, (ph - 1) / (PH_PER_LAYER + 1), (ph - 1) % (PH_PER_LAYER + 1), sm);
}
#else
#define GSYNC() grid.sync()
__global__ void __launch_bounds__(NTHREADS, 2) k_all(Params P) {
    __shared__ __attribute__((aligned(16))) char sm[GEMM_LDS];
    cg::grid_group grid = cg::this_grid();
    { const Params Q = launder(P); phase_prep(Q); } GSYNC();
    for (int l = 0; l < DEPTH; ++l) {
#define LP(s) { const Params Q = launder(P); layer_phase<s>(Q, l, sm); }
        if (l == 0) { LP(0); GSYNC(); }
        LP(1); GSYNC();
        LP(2); GSYNC();
        LP(3);
        LP(4); GSYNC();
        LP(6); GSYNC();
        LP(7); GSYNC();
        LP(8); GSYNC();
        { const Params Q = launder(P); phase_route(Q, l, sm); } GSYNC();
        { const Params Q = launder(P); phase_gather(Q, l); } GSYNC();
    }
}
#endif

extern "C" void kernel_launch(void* const* d_in, const int* in_sizes, int n_in, void* d_out, int out_size, void* d_ws, size_t ws_size, hipStream_t stream) {
    static int grid = 0;
    if (grid == 0) {
        if (n_in != 18 || out_size != T * D || ws_size < WS_END) { fprintf(stderr, "kernel_launch: bad sizes n_in %d out %d ws %zu need %zu\n", n_in, out_size, ws_size, (size_t)WS_END); grid = -1; return; }
        int dev = 0, cus = 0, per_cu = 0;
        hipGetDevice(&dev);
        hipDeviceGetAttribute(&cus, hipDeviceAttributeMultiprocessorCount, dev);
#if ONE_LAUNCH
        hipOccupancyMaxActiveBlocksPerMultiprocessor(&per_cu, (const void*)k_all, NTHREADS, 0);
#else
        hipOccupancyMaxActiveBlocksPerMultiprocessor(&per_cu, (const void*)k_phase, NTHREADS, 0);
#endif
        if (per_cu > 2) per_cu = 2;
        if (per_cu < 1) { fprintf(stderr, "kernel_launch: occupancy query says %d\n", per_cu); grid = -1; return; }
        grid = cus * per_cu;
    }
    if (grid < 0) return;
    Params p{};
    p.x = (const float*)d_in[0]; p.norm_mix = (const float*)d_in[1]; p.w_in = (const float*)d_in[2]; p.conv_w = (const float*)d_in[3];
    p.pool_w = (const float*)d_in[4]; p.pool_scale = (const float*)d_in[5]; p.q_norm = (const float*)d_in[6]; p.w_uq = (const float*)d_in[7];
    p.kv_norm = (const float*)d_in[8]; p.w_uk = (const float*)d_in[9]; p.w_uv = (const float*)d_in[10]; p.w_out = (const float*)d_in[11];
    p.norm_ffn = (const float*)d_in[12]; p.peer_wq = (const float*)d_in[13]; p.peer_subkeys = (const float*)d_in[14]; p.peer_u = (const float*)d_in[15];
    p.peer_v = (const float*)d_in[16]; p.norm_final = (const float*)d_in[17];
    p.out = (float*)d_out; p.ws = (unsigned char*)d_ws;
#if ONE_LAUNCH
    void* args[] = {&p};
    hipError_t e = hipLaunchCooperativeKernel((const void*)k_all, dim3(grid), dim3(NTHREADS), args, 0, stream);
    if (e != hipSuccess) fprintf(stderr, "cooperative launch failed: %s (grid %d)\n", hipGetErrorString(e), grid);
#else
    for (int ph = 0; ph < 1 + DEPTH * (PH_PER_LAYER + 1); ++ph) hipLaunchKernelGGL(k_phase, dim3(grid), dim3(NTHREADS), 0, stream, p, ph);
#endif
}
```

```cpp
#include <hip/hip_runtime.h>
#include <hip/hip_cooperative_groups.h>
#include <cstdio>
#include <cstdint>
namespace cg = cooperative_groups;

#ifndef ATTN_MFMA
#define ATTN_MFMA 1
#endif
#ifndef TAB_FP8
#define TAB_FP8 1
#endif
#ifndef ONE_LAUNCH
#define ONE_LAUNCH 1
#endif

constexpr int NB = 4, S = 8192, T = NB * S, D = 1024, DEPTH = 2;
constexpr int DIN = 1696, DINP = 1792;
constexpr int C_BG = 0, C_CG = 256, C_HC = 512, C_HP = 768, C_CQ = 1024, C_CKV = 1408, C_KR = 1664;
constexpr int QR = 384, KVR = 256, NH = 8, DQK = 96, DV = 64;
constexpr int PH = 8, NKEY = 128, NEXP = NKEY * NKEY, TOPK = 16, HK = PH * TOPK;
constexpr float EPS = 1e-6f;

typedef unsigned short bf16;

constexpr size_t MB = 1024 * 1024;
constexpr size_t WS_CTL   = 0;
constexpr size_t WS_ROPE  = 64 * 1024;
constexpr size_t WS_WIN   = WS_ROPE + (size_t)S * 16 * 2 * 4;
constexpr size_t WS_WUQ   = WS_WIN + (size_t)DEPTH * DINP * D * 2;
constexpr size_t WS_WUKV  = WS_WUQ + (size_t)DEPTH * 768 * QR * 2;
constexpr size_t WS_WOUT  = WS_WUKV + (size_t)DEPTH * 1024 * KVR * 2;
constexpr size_t WS_WPQ   = WS_WOUT + (size_t)DEPTH * D * D * 2;
constexpr size_t WS_XN    = ((WS_WPQ + (size_t)DEPTH * 2048 * D * 2 + 4095) / 4096) * 4096;
constexpr size_t WS_PROJ  = WS_XN + (size_t)T * D * 2;
constexpr size_t WS_Q     = WS_PROJ + (size_t)T * DINP * 2;
constexpr size_t WS_K     = WS_Q + (size_t)T * NH * DQK * 2;
constexpr size_t WS_V     = WS_K + (size_t)T * NH * DQK * 2;
constexpr size_t WS_EXP   = WS_V + (size_t)T * NH * DV * 2;
constexpr size_t WS_GATE  = WS_EXP + (size_t)T * HK * 4;
constexpr size_t TAB_ROWB = TAB_FP8 ? 1024 : 2048;
constexpr size_t WS_TABU  = WS_GATE + (size_t)T * HK * 4;
constexpr size_t WS_TABV  = WS_TABU + (size_t)DEPTH * NEXP * TAB_ROWB;
constexpr size_t WS_TSCU  = WS_TABV + (size_t)DEPTH * NEXP * TAB_ROWB;
constexpr size_t WS_TSCV  = WS_TSCU + (size_t)DEPTH * NEXP * 4;
constexpr size_t WS_END   = WS_TSCV + (size_t)DEPTH * NEXP * 4;
static_assert(WS_END <= (size_t)512 * 1024 * 1024, "workspace budget");
constexpr size_t WS_QP    = WS_PROJ;
static_assert((size_t)T * 2048 * 2 <= WS_K - WS_PROJ, "QP alias");

struct Params {
    const float* x; const float* norm_mix; const float* w_in; const float* conv_w; const float* pool_w; const float* pool_scale;
    const float* q_norm; const float* w_uq; const float* kv_norm; const float* w_uk; const float* w_uv; const float* w_out;
    const float* norm_ffn; const float* peer_wq; const float* peer_subkeys; const float* peer_u; const float* peer_v; const float* norm_final;
    float* out; unsigned char* ws;
};

__device__ __forceinline__ bf16 f2bf(float f) { unsigned u = __float_as_uint(f); u += 0x7fffu + ((u >> 16) & 1u); return (bf16)(u >> 16); }
__device__ __forceinline__ float bf2f(bf16 h) { return __uint_as_float(((unsigned)h) << 16); }
__device__ __forceinline__ float bflo(unsigned u) { return __uint_as_float(u << 16); }
__device__ __forceinline__ float bfhi(unsigned u) { return __uint_as_float(u & 0xffff0000u); }
__device__ __forceinline__ unsigned pack2(float a, float b) { return (unsigned)f2bf(a) | ((unsigned)f2bf(b) << 16); }
__device__ __forceinline__ float wave_sum(float v) {
#pragma unroll
    for (int m = 32; m >= 1; m >>= 1) v += __shfl_xor(v, m, 64);
    return v;
}
__device__ __forceinline__ float gelu_exact(float x) { return 0.5f * x * (1.f + erff(x * 0.70710678118654752f)); }

#define NTHREADS 256
__device__ __forceinline__ int tidx() { int t = (int)__builtin_amdgcn_workitem_id_x(); asm volatile("" : "+v"(t)); return t; }
__device__ __forceinline__ int gwave() { return blockIdx.x * (NTHREADS / 64) + (tidx() >> 6); }
__device__ __forceinline__ int nwave() { return gridDim.x * (NTHREADS / 64); }
__device__ __forceinline__ size_t gtid() { return (size_t)blockIdx.x * NTHREADS + tidx(); }
__device__ __forceinline__ size_t gnth() { return (size_t)gridDim.x * NTHREADS; }


__device__ __forceinline__ Params launder(const Params& P) {
    Params Q = P;
    asm volatile("" : "+s"(Q.x), "+s"(Q.norm_mix), "+s"(Q.w_in), "+s"(Q.conv_w), "+s"(Q.pool_w), "+s"(Q.pool_scale), "+s"(Q.q_norm), "+s"(Q.w_uq), "+s"(Q.kv_norm), "+s"(Q.w_uk));
    asm volatile("" : "+s"(Q.w_uv), "+s"(Q.w_out), "+s"(Q.norm_ffn), "+s"(Q.peer_wq), "+s"(Q.peer_subkeys), "+s"(Q.peer_u), "+s"(Q.peer_v), "+s"(Q.norm_final), "+s"(Q.out), "+s"(Q.ws));
    return Q;
}

template <class AL, class BL, class EP>
__device__ __forceinline__ void gemm_naive(int M, int N, int K, AL aload, BL bload, EP epi, float* sm) {
    float (*As)[68] = (float (*)[68])sm;
    float (*Bs)[68] = (float (*)[68])(sm + 16 * 68);
    const int tid = tidx(), tx = tid & 15, ty = tid >> 4;
    const int tilesN = (N + 63) / 64, tilesM = M / 64;
    for (int tile = blockIdx.x; tile < tilesM * tilesN; tile += gridDim.x) {
        const int tm = tile / tilesN, tn = tile % tilesN;
        const int row0 = tm * 64, col0 = tn * 64;
        float acc[4][4];
#pragma unroll
        for (int i = 0; i < 4; ++i)
#pragma unroll
            for (int j = 0; j < 4; ++j) acc[i][j] = 0.f;
        for (int k0 = 0; k0 < K; k0 += 16) {
            {
                const int r = tid >> 2, kk = (tid & 3) * 4;
#pragma unroll
                for (int i = 0; i < 4; ++i) As[kk + i][r] = aload(row0 + r, k0 + kk + i);
            }
            {
                const int kk = tid >> 4, c = (tid & 15) * 4;
#pragma unroll
                for (int j = 0; j < 4; ++j) { const int col = col0 + c + j; Bs[kk][c + j] = (col < N) ? bload(k0 + kk, col) : 0.f; }
            }
            __syncthreads();
#pragma unroll
            for (int kk = 0; kk < 16; ++kk) {
                float a[4], b[4];
#pragma unroll
                for (int i = 0; i < 4; ++i) a[i] = As[kk][ty * 4 + i];
#pragma unroll
                for (int j = 0; j < 4; ++j) b[j] = Bs[kk][tx * 4 + j];
#pragma unroll
                for (int i = 0; i < 4; ++i)
#pragma unroll
                    for (int j = 0; j < 4; ++j) acc[i][j] = fmaf(a[i], b[j], acc[i][j]);
            }
            __syncthreads();
        }
#pragma unroll
        for (int i = 0; i < 4; ++i)
#pragma unroll
            for (int j = 0; j < 4; ++j) { const int col = col0 + tx * 4 + j; if (col < N) epi(row0 + ty * 4 + i, col, acc[i][j]); }
    }
}


typedef __attribute__((ext_vector_type(8))) short bf16x8;
typedef __attribute__((ext_vector_type(16))) float f32x16;
#define MFMA32(a, b, c) __builtin_amdgcn_mfma_f32_32x32x16_bf16(a, b, c, 0, 0, 0)
__device__ __forceinline__ int crow(int r, int hi) { return (r & 3) + 8 * (r >> 2) + 4 * hi; }
constexpr int G_LDT = 144;
constexpr int G_OPB = 128 * G_LDT;
constexpr int G_BUF = 2 * G_OPB;
constexpr int GEMM_LDS = 2 * G_BUF;

template <int WT>
__device__ __forceinline__ void gemm_kloop(const bf16* __restrict__ Ag0, int lda, const bf16* __restrict__ Bg0, int ldb, int nk, f32x16 (&acc)[4], char* lds, int tid) {
    const int lane = tid & 63, w = tid >> 6, r32 = lane & 31, hi = lane >> 5;
    const int srow = tid >> 3, sch = tid & 7;
    const bf16* Ag = Ag0 + (size_t)srow * lda + sch * 8;
    const bf16* Bg = Bg0 + (size_t)srow * ldb + sch * 8;
#pragma unroll
    for (int i = 0; i < 4; ++i)
#pragma unroll
        for (int r = 0; r < 16; ++r) acc[i][r] = 0.f;
    uint4 ra0, ra1, ra2, ra3, rb0, rb1, rb2, rb3;
#define G_LOAD(kofs) do { \
    ra0 = *(const uint4*)(Ag + (kofs)); ra1 = *(const uint4*)(Ag + (size_t)32 * lda + (kofs)); ra2 = *(const uint4*)(Ag + (size_t)64 * lda + (kofs)); ra3 = *(const uint4*)(Ag + (size_t)96 * lda + (kofs)); \
    rb0 = *(const uint4*)(Bg + (kofs)); rb1 = *(const uint4*)(Bg + (size_t)32 * ldb + (kofs)); rb2 = *(const uint4*)(Bg + (size_t)64 * ldb + (kofs)); rb3 = *(const uint4*)(Bg + (size_t)96 * ldb + (kofs)); } while (0)
    G_LOAD(0);
    for (int kt = 0; kt < nk; ++kt) {
        char* bA = lds + (kt & 1) * G_BUF; char* bB = bA + G_OPB;
        {
            char* wa = bA + srow * G_LDT + sch * 16; char* wb = bB + srow * G_LDT + sch * 16;
            *(uint4*)(wa) = ra0; *(uint4*)(wa + 32 * G_LDT) = ra1; *(uint4*)(wa + 64 * G_LDT) = ra2; *(uint4*)(wa + 96 * G_LDT) = ra3;
            *(uint4*)(wb) = rb0; *(uint4*)(wb + 32 * G_LDT) = rb1; *(uint4*)(wb + 64 * G_LDT) = rb2; *(uint4*)(wb + 96 * G_LDT) = rb3;
        }
        __syncthreads();
        if (kt + 1 < nk) G_LOAD((kt + 1) * 64);
        if (WT == 0) {
            const char* pa = bA + ((w >> 1) * 64 + r32) * G_LDT + hi * 16;
            const char* pb = bB + ((w & 1) * 64 + r32) * G_LDT + hi * 16;
#pragma unroll
            for (int ks = 0; ks < 4; ++ks) {
                const bf16x8 a0 = *(const bf16x8*)(pa + ks * 32), a1 = *(const bf16x8*)(pa + 32 * G_LDT + ks * 32);
                const bf16x8 b0 = *(const bf16x8*)(pb + ks * 32), b1 = *(const bf16x8*)(pb + 32 * G_LDT + ks * 32);
                acc[0] = MFMA32(a0, b0, acc[0]); acc[1] = MFMA32(a0, b1, acc[1]);
                acc[2] = MFMA32(a1, b0, acc[2]); acc[3] = MFMA32(a1, b1, acc[3]);
            }
        } else {
            const char* pa = bA + r32 * G_LDT + hi * 16;
            const char* pb = bB + (w * 32 + r32) * G_LDT + hi * 16;
#pragma unroll
            for (int ks = 0; ks < 4; ++ks) {
                const bf16x8 b0 = *(const bf16x8*)(pb + ks * 32);
                const bf16x8 a0 = *(const bf16x8*)(pa + ks * 32), a1 = *(const bf16x8*)(pa + 32 * G_LDT + ks * 32);
                const bf16x8 a2 = *(const bf16x8*)(pa + 64 * G_LDT + ks * 32), a3 = *(const bf16x8*)(pa + 96 * G_LDT + ks * 32);
                acc[0] = MFMA32(a0, b0, acc[0]); acc[1] = MFMA32(a1, b0, acc[1]);
                acc[2] = MFMA32(a2, b0, acc[2]); acc[3] = MFMA32(a3, b0, acc[3]);
            }
        }
    }
#undef G_LOAD
}

template <class EPI>
__device__ __forceinline__ void gemm_mfma(const bf16* __restrict__ A, int lda, const bf16* __restrict__ Bt, int ldb, int M, int N, int K, EPI epi, char* lds) {
    const int tid = tidx(), lane = tid & 63, w = tid >> 6, r32 = lane & 31, hi = lane >> 5;
    const int wm = w >> 1, wn = w & 1;
    const int tilesN = N / 128, tilesM = M / 128, nk = K / 64;
    for (int tile = blockIdx.x; tile < tilesM * tilesN; tile += gridDim.x) {
        const int tm = tile / tilesN, tn = tile % tilesN;
        f32x16 acc[4];
        gemm_kloop<0>(A + (size_t)(tm * 128) * lda, lda, Bt + (size_t)(tn * 128) * ldb, ldb, nk, acc, lds, tid);
#pragma unroll
        for (int i = 0; i < 2; ++i)
#pragma unroll
            for (int j = 0; j < 2; ++j) epi(tm * 128 + wm * 64 + i * 32, tn * 128 + wn * 64 + j * 32, acc[i * 2 + j], r32, hi);
        __syncthreads();
    }
}

__device__ __forceinline__ void transpose_bf16(const float* __restrict__ W, bf16* __restrict__ Wt, int K, int N, int Npad) {
    const size_t tot = (size_t)Npad * K;
    for (size_t i = gtid(); i < tot; i += gnth()) {
        const int n = (int)(i / K), k = (int)(i % K);
        Wt[i] = (n < N) ? f2bf(W[(size_t)k * N + n]) : (bf16)0;
    }
}

__device__ __forceinline__ void convert_table(const float* __restrict__ src, unsigned char* __restrict__ dst, float* __restrict__ scl, int rows) {
    const int lane = tidx() & 63;
    for (int r = gwave(); r < rows; r += nwave()) {
        const float4* sr = (const float4*)(src + (size_t)r * D);
        if (TAB_FP8) {
            float4 v[4]; float am = 0.f;
#pragma unroll
            for (int j = 0; j < 4; ++j) { v[j] = sr[lane * 4 + j]; am = fmaxf(am, fmaxf(fmaxf(fabsf(v[j].x), fabsf(v[j].y)), fmaxf(fabsf(v[j].z), fabsf(v[j].w)))); }
#pragma unroll
            for (int m = 32; m >= 1; m >>= 1) am = fmaxf(am, __shfl_xor(am, m, 64));
            const float sc = (am > 0.f) ? am * (1.f / 448.f) : 1.f;
            const float is = 1.f / sc;
            uint4 o;
            { int w = 0; w = __builtin_amdgcn_cvt_pk_fp8_f32(v[0].x * is, v[0].y * is, w, false); w = __builtin_amdgcn_cvt_pk_fp8_f32(v[0].z * is, v[0].w * is, w, true); o.x = (unsigned)w; }
            { int w = 0; w = __builtin_amdgcn_cvt_pk_fp8_f32(v[1].x * is, v[1].y * is, w, false); w = __builtin_amdgcn_cvt_pk_fp8_f32(v[1].z * is, v[1].w * is, w, true); o.y = (unsigned)w; }
            { int w = 0; w = __builtin_amdgcn_cvt_pk_fp8_f32(v[2].x * is, v[2].y * is, w, false); w = __builtin_amdgcn_cvt_pk_fp8_f32(v[2].z * is, v[2].w * is, w, true); o.z = (unsigned)w; }
            { int w = 0; w = __builtin_amdgcn_cvt_pk_fp8_f32(v[3].x * is, v[3].y * is, w, false); w = __builtin_amdgcn_cvt_pk_fp8_f32(v[3].z * is, v[3].w * is, w, true); o.w = (unsigned)w; }
            *(uint4*)(dst + (size_t)r * 1024 + lane * 16) = o;
            if (lane == 0) scl[r] = sc;
        } else {
#pragma unroll
            for (int j = 0; j < 2; ++j) {
                const float4 a = sr[j * 128 + lane * 2], b = sr[j * 128 + lane * 2 + 1];
                uint4 o; o.x = pack2(a.x, a.y); o.y = pack2(a.z, a.w); o.z = pack2(b.x, b.y); o.w = pack2(b.z, b.w);
                *(uint4*)(dst + (size_t)r * 2048 + j * 1024 + lane * 16) = o;
            }
        }
    }
}
__device__ __forceinline__ void phase_prep(const Params& P) {
    unsigned char* ws = P.ws;
    for (int l = 0; l < DEPTH; ++l) {
        transpose_bf16(P.w_in + (size_t)l * D * DIN, (bf16*)(ws + WS_WIN) + (size_t)l * DINP * D, D, DIN, DINP);
        transpose_bf16(P.w_uq + (size_t)l * QR * 768, (bf16*)(ws + WS_WUQ) + (size_t)l * 768 * QR, QR, 768, 768);
        transpose_bf16(P.w_uk + (size_t)l * KVR * 512, (bf16*)(ws + WS_WUKV) + (size_t)l * 1024 * KVR, KVR, 512, 512);
        transpose_bf16(P.w_uv + (size_t)l * KVR * 512, (bf16*)(ws + WS_WUKV) + (size_t)l * 1024 * KVR + (size_t)512 * KVR, KVR, 512, 512);
        transpose_bf16(P.w_out + (size_t)l * D * D, (bf16*)(ws + WS_WOUT) + (size_t)l * D * D, D, D, D);
    }
    {
        bf16* Wc = (bf16*)(ws + WS_WPQ);
        const size_t tot = (size_t)DEPTH * 2048 * D;
        for (size_t i = gtid(); i < tot; i += gnth()) {
            const int k = (int)(i & (D - 1)); const int row = (int)(i >> 10);
            const int l = row >> 11, hp = (row >> 7) & 15, n = row & 127;
            const float4* wq = (const float4*)(P.peer_wq + ((size_t)l * D + k) * 2048 + hp * 128);
            const float4* sk = (const float4*)(P.peer_subkeys + (((size_t)l * 2 + (hp & 1)) * NKEY + n) * 128);
            float s0 = 0.f, s1 = 0.f, s2 = 0.f, s3 = 0.f;
            for (int d = 0; d < 32; ++d) { const float4 a = wq[d], b = sk[d]; s0 = fmaf(a.x, b.x, s0); s1 = fmaf(a.y, b.y, s1); s2 = fmaf(a.z, b.z, s2); s3 = fmaf(a.w, b.w, s3); }
            Wc[i] = f2bf((s0 + s1) + (s2 + s3));
        }
    }
    convert_table(P.peer_u, ws + WS_TABU, (float*)(ws + WS_TSCU), DEPTH * NEXP);
    convert_table(P.peer_v, ws + WS_TABV, (float*)(ws + WS_TSCV), DEPTH * NEXP);
    float* rope = (float*)(ws + WS_ROPE);
    for (size_t i = gtid(); i < (size_t)S * 16; i += gnth()) {
        const int s = (int)(i >> 4), f = (int)(i & 15);
        const double inv = pow(10000.0, -(double)f / 16.0);
        const double ang = (double)s * inv;
        rope[2 * i] = (float)cos(ang); rope[2 * i + 1] = (float)sin(ang);
    }
}

__device__ __forceinline__ void phase_norm(const float* __restrict__ h, const float* __restrict__ g, bf16* __restrict__ xn) {
    const int lane = tidx() & 63;
    for (int t = gwave(); t < T; t += nwave()) {
        const float4* hr = (const float4*)(h + (size_t)t * D);
        float4 v[4]; float ss = 0.f;
#pragma unroll
        for (int j = 0; j < 4; ++j) { v[j] = hr[j * 64 + lane]; ss += v[j].x * v[j].x + v[j].y * v[j].y + v[j].z * v[j].z + v[j].w * v[j].w; }
        ss = wave_sum(ss);
        const float r = rsqrtf(ss * (1.f / D) + EPS);
#pragma unroll
        for (int j = 0; j < 4; ++j) {
            const float4 gg = ((const float4*)g)[j * 64 + lane];
            uint2 o; o.x = pack2(v[j].x * r * gg.x, v[j].y * r * gg.y); o.y = pack2(v[j].z * r * gg.z, v[j].w * r * gg.w);
            ((uint2*)(xn + (size_t)t * D))[j * 64 + lane] = o;
        }
    }
}

__device__ __forceinline__ void phase_mixprep(const Params& P, int l) {
    unsigned char* ws = P.ws;
    bf16* proj = (bf16*)(ws + WS_PROJ);
    bf16* Y = (bf16*)(ws + WS_XN);
    bf16* Kb = (bf16*)(ws + WS_K);
    const float* rope = (const float*)(ws + WS_ROPE);
    const float* qn = P.q_norm + l * QR; const float* kvn = P.kv_norm + l * KVR;
    const float* cw = P.conv_w + (size_t)l * 3 * 256;
    const float* pw = P.pool_w + (size_t)l * 4 * 64 * 64;
    const float* psc = P.pool_scale + l * 256;
    const int lane = tidx() & 63;
    for (int t = gwave(); t < T; t += nwave()) {
        const int b = t / S, s = t % S;
        bf16* pr = proj + (size_t)t * DINP;
        {
            float v[6]; float ss = 0.f;
#pragma unroll
            for (int j = 0; j < 6; ++j) { v[j] = bf2f(pr[C_CQ + j * 64 + lane]); ss += v[j] * v[j]; }
            ss = wave_sum(ss);
            const float r = rsqrtf(ss * (1.f / QR) + EPS);
#pragma unroll
            for (int j = 0; j < 6; ++j) pr[C_CQ + j * 64 + lane] = f2bf(v[j] * r * qn[j * 64 + lane]);
        }
        {
            float v[4]; float ss = 0.f;
#pragma unroll
            for (int j = 0; j < 4; ++j) { v[j] = bf2f(pr[C_CKV + j * 64 + lane]); ss += v[j] * v[j]; }
            ss = wave_sum(ss);
            const float r = rsqrtf(ss * (1.f / KVR) + EPS);
#pragma unroll
            for (int j = 0; j < 4; ++j) pr[C_CKV + j * 64 + lane] = f2bf(v[j] * r * kvn[j * 64 + lane]);
        }
        if (lane < 16) {
            const float x1 = bf2f(pr[C_KR + lane]), x2 = bf2f(pr[C_KR + 16 + lane]);
            const float c = rope[(s * 16 + lane) * 2], sn = rope[(s * 16 + lane) * 2 + 1];
            const bf16 o1 = f2bf(x1 * c - x2 * sn), o2 = f2bf(x2 * c + x1 * sn);
#pragma unroll
            for (int h = 0; h < NH; ++h) {
                bf16* kr = Kb + ((size_t)(b * NH + h) * S + s) * DQK;
                kr[64 + lane] = o1; kr[80 + lane] = o2;
            }
        }
#pragma unroll
        for (int r = 0; r < 4; ++r) {
            const int c = r * 64 + lane;
            float acc = 0.f;
#pragma unroll
            for (int j = 0; j < 3; ++j) {
                const int sp = s - 2 + j;
                if (sp >= 0) {
                    const bf16* pp = proj + (size_t)(t - 2 + j) * DINP;
                    acc += cw[j * 256 + c] * (bf2f(pp[C_CG + c]) * bf2f(pp[C_HC + c]));
                }
            }
            Y[(size_t)t * D + c] = f2bf(bf2f(pr[C_BG + c]) * acc);
        }
        const int wins[4] = {2, 4, 8, 16};
#pragma unroll
        for (int g = 0; g < 4; ++g) {
            const int w = wins[g];
            const int lo = (s + 1 - w) > 0 ? (s + 1 - w) : 0;
            const int cnt = s + 1 - lo;
            float sum = 0.f;
            for (int sp = lo; sp <= s; ++sp) sum += bf2f(proj[(size_t)(b * S + sp) * DINP + C_HP + g * 64 + lane]);
            const float pooled = sum / (float)cnt - bf2f(pr[C_HP + g * 64 + lane]);
            float m = 0.f;
            for (int c = 0; c < 64; ++c) m = fmaf(__shfl(pooled, c, 64), pw[(g * 64 + c) * 64 + lane], m);
            Y[(size_t)t * D + 256 + g * 64 + lane] = f2bf(m * psc[g * 64 + lane]);
        }
    }
}

__device__ __forceinline__ void phase_qrope(const Params& P) {
    bf16* Qb = (bf16*)(P.ws + WS_Q);
    const float* rope = (const float*)(P.ws + WS_ROPE);
    const size_t tot = (size_t)T * NH * 16;
    for (size_t i = gtid(); i < tot; i += gnth()) {
        const int f = (int)(i & 15); const size_t row = i >> 4;
        const int s = (int)(row % S);
        bf16* q = Qb + row * DQK;
        const float x1 = bf2f(q[64 + f]), x2 = bf2f(q[80 + f]);
        const float c = rope[(s * 16 + f) * 2], sn = rope[(s * 16 + f) * 2 + 1];
        q[64 + f] = f2bf(x1 * c - x2 * sn); q[80 + f] = f2bf(x2 * c + x1 * sn);
    }
}

__device__ __forceinline__ void phase_attn_naive(const Params& P) {
    const bf16* Qb = (const bf16*)(P.ws + WS_Q);
    const bf16* Kb = (const bf16*)(P.ws + WS_K);
    const bf16* Vb = (const bf16*)(P.ws + WS_V);
    bf16* Y = (bf16*)(P.ws + WS_XN);
    const int lane = tidx() & 63, qr = lane & 31, half = lane >> 5;
    const int gw = gwave(), nw = nwave();
    const int total = NB * NH * (S / 32);
    for (int pass = 0; pass * nw < total; ++pass) {
        const int u = (pass & 1) ? ((pass + 1) * nw - 1 - gw) : (pass * nw + gw);
        if (u >= total) continue;
        const int qblk = (S / 32 - 1) - (u >> 5), bh = u & 31;
        const int qpos = qblk * 32 + qr;
        unsigned q[DQK / 2];
        {
            const uint4* qp = (const uint4*)(Qb + ((size_t)bh * S + qpos) * DQK);
#pragma unroll
            for (int c = 0; c < 12; ++c) { const uint4 v = qp[c]; q[c * 4 + 0] = v.x; q[c * 4 + 1] = v.y; q[c * 4 + 2] = v.z; q[c * 4 + 3] = v.w; }
        }
        float o[32];
#pragma unroll
        for (int d = 0; d < 32; ++d) o[d] = 0.f;
        float m = -3.0e38f, lsum = 0.f;
        const int kmax = qblk * 32 + 31;
        const bf16* Kp = Kb + (size_t)bh * S * DQK;
        const bf16* Vp = Vb + (size_t)bh * S * DV + half * 32;
        for (int j = 0; j <= kmax; ++j) {
            const uint4* kr = (const uint4*)(Kp + (size_t)j * DQK);
            float sc = 0.f;
#pragma unroll
            for (int c = 0; c < 12; ++c) {
                const uint4 v = kr[c];
                sc = fmaf(bflo(q[c * 4 + 0]), bflo(v.x), sc); sc = fmaf(bfhi(q[c * 4 + 0]), bfhi(v.x), sc);
                sc = fmaf(bflo(q[c * 4 + 1]), bflo(v.y), sc); sc = fmaf(bfhi(q[c * 4 + 1]), bfhi(v.y), sc);
                sc = fmaf(bflo(q[c * 4 + 2]), bflo(v.z), sc); sc = fmaf(bfhi(q[c * 4 + 2]), bfhi(v.z), sc);
                sc = fmaf(bflo(q[c * 4 + 3]), bflo(v.w), sc); sc = fmaf(bfhi(q[c * 4 + 3]), bfhi(v.w), sc);
            }
            if (j <= qpos) {
                const float mn = fmaxf(m, sc);
                const float alpha = exp2f(m - mn);
                const float p = exp2f(sc - mn);
                lsum = lsum * alpha + p; m = mn;
                const uint4* vr = (const uint4*)(Vp + (size_t)j * DV);
#pragma unroll
                for (int c = 0; c < 4; ++c) {
                    const uint4 v = vr[c];
                    o[c * 8 + 0] = fmaf(p, bflo(v.x), o[c * 8 + 0] * alpha); o[c * 8 + 1] = fmaf(p, bfhi(v.x), o[c * 8 + 1] * alpha);
                    o[c * 8 + 2] = fmaf(p, bflo(v.y), o[c * 8 + 2] * alpha); o[c * 8 + 3] = fmaf(p, bfhi(v.y), o[c * 8 + 3] * alpha);
                    o[c * 8 + 4] = fmaf(p, bflo(v.z), o[c * 8 + 4] * alpha); o[c * 8 + 5] = fmaf(p, bfhi(v.z), o[c * 8 + 5] * alpha);
                    o[c * 8 + 6] = fmaf(p, bflo(v.w), o[c * 8 + 6] * alpha); o[c * 8 + 7] = fmaf(p, bfhi(v.w), o[c * 8 + 7] * alpha);
                }
            }
        }
        const float inv = 1.f / lsum;
        const int b = bh >> 3, h = bh & 7;
        uint4* yo = (uint4*)(Y + ((size_t)(b * S + qpos)) * D + 512 + h * 64 + half * 32);
#pragma unroll
        for (int c = 0; c < 4; ++c) {
            uint4 v;
            v.x = pack2(o[c * 8 + 0] * inv, o[c * 8 + 1] * inv); v.y = pack2(o[c * 8 + 2] * inv, o[c * 8 + 3] * inv);
            v.z = pack2(o[c * 8 + 4] * inv, o[c * 8 + 5] * inv); v.w = pack2(o[c * 8 + 6] * inv, o[c * 8 + 7] * inv);
            yo[c] = v;
        }
    }
}


typedef short v4i16_t __attribute__((ext_vector_type(4)));
typedef __attribute__((address_space(3))) v4i16_t* lds_v4p;
__device__ __forceinline__ unsigned cvtpk(float lo, float hi) { unsigned r; asm("v_cvt_pk_bf16_f32 %0, %1, %2" : "=v"(r) : "v"(lo), "v"(hi)); return r; }
__device__ __forceinline__ v4i16_t vtr(const char* p) { return __builtin_amdgcn_ds_read_tr16_b64_v4i16((lds_v4p)p); }
constexpr int A_KP = 208, A_VP = 192;
constexpr int A_KB = 64 * A_KP, A_VB = 64 * A_VP, A_BUF = A_KB + A_VB, ATTN_LDS = 2 * A_BUF;
static_assert(ATTN_LDS <= GEMM_LDS, "attention LDS");

__device__ __forceinline__ void attn_unit(const bf16* __restrict__ Qb, const bf16* __restrict__ Kb, const bf16* __restrict__ Vb, bf16* __restrict__ Y, int bh, int qblk, char* lds) {
    const int tid = tidx(), lane = tid & 63, w = tid >> 6, r32 = lane & 31, hi = lane >> 5;
    const int q0 = qblk * 128, qw0 = q0 + w * 32;
    const int NT = 2 * qblk + 2;
    bf16x8 qf[6];
    {
        const bf16* qp = Qb + ((size_t)bh * S + qw0 + r32) * DQK + hi * 8;
#pragma unroll
        for (int ks = 0; ks < 6; ++ks) qf[ks] = *(const bf16x8*)(qp + ks * 16);
    }
    f32x16 o0, o1;
#pragma unroll
    for (int r = 0; r < 16; ++r) { o0[r] = 0.f; o1[r] = 0.f; }
    float m = -1e30f, lsum = 0.f;
    const char* Kg = (const char*)(Kb + (size_t)bh * S * DQK) + tid * 16;
    const char* Vg = (const char*)(Vb + (size_t)bh * S * DV) + tid * 16;
    const int kl0 = (tid / 12) * A_KP + (tid % 12) * 16, kl1 = ((tid + 256) / 12) * A_KP + ((tid + 256) % 12) * 16, kl2 = ((tid + 512) / 12) * A_KP + ((tid + 512) % 12) * 16;
    const int vl0 = (tid >> 3) * A_VP + (tid & 7) * 16, vl1 = vl0 + 32 * A_VP;
    uint4 k0, k1, k2, v0, v1;
#define A_LOAD(t) do { const char* kg = Kg + (size_t)(t) * (64 * 192); const char* vg = Vg + (size_t)(t) * (64 * 128); \
        k0 = *(const uint4*)(kg); k1 = *(const uint4*)(kg + 4096); k2 = *(const uint4*)(kg + 8192); v0 = *(const uint4*)(vg); v1 = *(const uint4*)(vg + 4096); } while (0)
    A_LOAD(0);
    const int pvo = (4 * hi + ((lane & 15) >> 2)) * A_VP + (16 * ((lane >> 4) & 1) + 4 * (lane & 3)) * 2;
    for (int t = 0; t < NT; ++t) {
        char* bK = lds + (t & 1) * A_BUF; char* bV = bK + A_KB;
        *(uint4*)(bK + kl0) = k0; *(uint4*)(bK + kl1) = k1; *(uint4*)(bK + kl2) = k2; *(uint4*)(bV + vl0) = v0; *(uint4*)(bV + vl1) = v1;
        __syncthreads();
        if (t + 1 < NT) A_LOAD(t + 1);
        const int kt0 = t * 64;
        if (kt0 <= qw0) {
            f32x16 s0, s1;
#pragma unroll
            for (int r = 0; r < 16; ++r) { s0[r] = 0.f; s1[r] = 0.f; }
            const char* pk = bK + r32 * A_KP + hi * 16;
#pragma unroll
            for (int ks = 0; ks < 6; ++ks) {
                const bf16x8 a0 = *(const bf16x8*)(pk + ks * 32), a1 = *(const bf16x8*)(pk + 32 * A_KP + ks * 32);
                s0 = MFMA32(a0, qf[ks], s0); s1 = MFMA32(a1, qf[ks], s1);
            }
            if (kt0 + 63 > qw0) {
                const int qrow = qw0 + r32;
#pragma unroll
                for (int r = 0; r < 16; ++r) { const int key = kt0 + crow(r, hi); if (key > qrow) s0[r] = -INFINITY; if (key + 32 > qrow) s1[r] = -INFINITY; }
            }
            float mx = fmaxf(s0[0], s1[0]);
#pragma unroll
            for (int r = 1; r < 16; ++r) mx = fmaxf(mx, fmaxf(s0[r], s1[r]));
            mx = fmaxf(mx, __shfl_xor(mx, 32, 64));
            const float mn = fmaxf(m, mx);
            const float alpha = __builtin_amdgcn_exp2f(m - mn);
            m = mn;
            float ps = 0.f;
#pragma unroll
            for (int r = 0; r < 16; ++r) { s0[r] = __builtin_amdgcn_exp2f(s0[r] - mn); s1[r] = __builtin_amdgcn_exp2f(s1[r] - mn); ps += s0[r] + s1[r]; }
            lsum = lsum * alpha + ps;
#pragma unroll
            for (int r = 0; r < 16; ++r) { o0[r] *= alpha; o1[r] *= alpha; }
            union { unsigned u[4]; bf16x8 v; } p00, p01, p10, p11;
#pragma unroll
            for (int j = 0; j < 4; ++j) { p00.u[j] = cvtpk(s0[2 * j], s0[2 * j + 1]); p01.u[j] = cvtpk(s0[8 + 2 * j], s0[9 + 2 * j]); p10.u[j] = cvtpk(s1[2 * j], s1[2 * j + 1]); p11.u[j] = cvtpk(s1[8 + 2 * j], s1[9 + 2 * j]); }
            const char* pv = bV + pvo;
#define A_PV(pf, kofs) do { \
            { const v4i16_t lo = vtr(pv + (kofs) * A_VP), hh = vtr(pv + ((kofs) + 8) * A_VP); const bf16x8 vf = {lo[0], lo[1], lo[2], lo[3], hh[0], hh[1], hh[2], hh[3]}; o0 = MFMA32(vf, pf.v, o0); } \
            { const v4i16_t lo = vtr(pv + (kofs) * A_VP + 64), hh = vtr(pv + ((kofs) + 8) * A_VP + 64); const bf16x8 vf = {lo[0], lo[1], lo[2], lo[3], hh[0], hh[1], hh[2], hh[3]}; o1 = MFMA32(vf, pf.v, o1); } } while (0)
            A_PV(p00, 0); A_PV(p01, 16); A_PV(p10, 32); A_PV(p11, 48);
        }
    }
    lsum += __shfl_xor(lsum, 32, 64);
    const float inv = 1.f / lsum;
    const int b = bh >> 3, h = bh & 7;
    bf16* yo = Y + (size_t)(b * S + qw0 + r32) * D + 512 + h * 64 + 4 * hi;
#pragma unroll
    for (int g = 0; g < 4; ++g) {
        uint2 a, c;
        a.x = cvtpk(o0[4 * g] * inv, o0[4 * g + 1] * inv); a.y = cvtpk(o0[4 * g + 2] * inv, o0[4 * g + 3] * inv);
        c.x = cvtpk(o1[4 * g] * inv, o1[4 * g + 1] * inv); c.y = cvtpk(o1[4 * g + 2] * inv, o1[4 * g + 3] * inv);
        *(uint2*)(yo + 8 * g) = a; *(uint2*)(yo + 32 + 8 * g) = c;
    }
    __syncthreads();
}
__device__ __forceinline__ void phase_attn(const Params& P, char* lds) {
    const bf16* Qb = (const bf16*)(P.ws + WS_Q);
    const bf16* Kb = (const bf16*)(P.ws + WS_K);
    const bf16* Vb = (const bf16*)(P.ws + WS_V);
    bf16* Y = (bf16*)(P.ws + WS_XN);
    for (int u = blockIdx.x; u < NB * NH * (S / 128); u += gridDim.x) {
        const int bh = u & 31, v = u >> 5;
        const int qblk = (v < 16) ? (63 - v) : (v < 32) ? (v - 16) : (v < 48) ? (79 - v) : (v - 32);
        attn_unit(Qb, Kb, Vb, Y, bh, qblk, lds);
    }
}

__device__ __forceinline__ void wave_argmax(float& bv, int& bi) {
#pragma unroll
    for (int m = 32; m >= 1; m >>= 1) {
        const float ov = __shfl_xor(bv, m, 64); const int oi = __shfl_xor(bi, m, 64);
        if (ov > bv || (ov == bv && oi < bi)) { bv = ov; bi = oi; }
    }
}
__device__ __forceinline__ void peer_half_top16(const float* __restrict__ skp, const float* qs, int, int lane, float& sp, int& ip) {
    const float NEG = -3.0e38f;
    float v0 = 0.f, v1 = 0.f;
    const float4* r0 = (const float4*)(skp + (size_t)lane * 128);
    const float4* r1 = (const float4*)(skp + (size_t)(lane + 64) * 128);
    for (int d = 0; d < 32; ++d) {
        const float4 a = r0[d], bq = r1[d];
        const float q0 = qs[d * 4 + 0], q1 = qs[d * 4 + 1], q2 = qs[d * 4 + 2], q3 = qs[d * 4 + 3];
        v0 = fmaf(q0, a.x, v0); v0 = fmaf(q1, a.y, v0); v0 = fmaf(q2, a.z, v0); v0 = fmaf(q3, a.w, v0);
        v1 = fmaf(q0, bq.x, v1); v1 = fmaf(q1, bq.y, v1); v1 = fmaf(q2, bq.z, v1); v1 = fmaf(q3, bq.w, v1);
    }
    sp = 0.f; ip = 0;
    for (int k = 0; k < TOPK; ++k) {
        float bv; int bi;
        if (v0 >= v1) { bv = v0; bi = lane; } else { bv = v1; bi = lane + 64; }
        wave_argmax(bv, bi);
        if (lane == k) { sp = bv; ip = bi; }
        if (bi == lane) v0 = NEG; else if (bi == lane + 64) v1 = NEG;
    }
}
__device__ __forceinline__ void phase_topk_naive(const Params& P, int l, float* sm) {
    const bf16* QP = (const bf16*)(P.ws + WS_QP);
    int* EXPp = (int*)(P.ws + WS_EXP);
    float* GATEp = (float*)(P.ws + WS_GATE);
    const float* sk = P.peer_subkeys + (size_t)l * 2 * NKEY * 128;
    const int lane = tidx() & 63, wv = tidx() >> 6;
    float* qs = sm + wv * 256;
    const float NEG = -3.0e38f;
    for (int u = gwave(); u < T * PH; u += nwave()) {
        const int t = u >> 3, h = u & 7;
        {
            const bf16* qp = QP + (size_t)t * 2048 + h * 256;
#pragma unroll
            for (int j = 0; j < 4; ++j) qs[j * 64 + lane] = bf2f(qp[j * 64 + lane]);
        }
        __builtin_amdgcn_s_waitcnt(0);
        __builtin_amdgcn_wave_barrier();
        float stop0, stop1; int itop0, itop1;
        peer_half_top16(sk, qs, 0, lane, stop0, itop0);
        peer_half_top16(sk + (size_t)NKEY * 128, qs + 128, 0, lane, stop1, itop1);
        __builtin_amdgcn_wave_barrier();
        float cv[4];
#pragma unroll
        for (int r = 0; r < 4; ++r) { const int c = lane + 64 * r; cv[r] = __shfl(stop0, c >> 4, 64) + __shfl(stop1, c & 15, 64); }
        float ts = 0.f; int ci = 0;
        for (int k = 0; k < TOPK; ++k) {
            float bv = cv[0]; int bi = lane;
#pragma unroll
            for (int r = 1; r < 4; ++r) if (cv[r] > bv) { bv = cv[r]; bi = lane + 64 * r; }
            wave_argmax(bv, bi);
            if (lane == k) { ts = bv; ci = bi; }
#pragma unroll
            for (int r = 0; r < 4; ++r) if (bi == lane + 64 * r) cv[r] = NEG;
        }
        const int e1 = __shfl(itop0, ci >> 4, 64), e2 = __shfl(itop1, ci & 15, 64);
        const float smax = __shfl(ts, 0, 64);
        float ex = (lane < 16) ? __expf(ts - smax) : 0.f;
        float den = ex;
#pragma unroll
        for (int m = 8; m >= 1; m >>= 1) den += __shfl_xor(den, m, 64);
        if (lane < 16) {
            EXPp[(size_t)t * HK + h * 16 + lane] = e1 * NKEY + e2;
            GATEp[(size_t)t * HK + h * 16 + lane] = ex / den;
        }
    }
}

__device__ __forceinline__ void phase_gather_naive(const Params& P, int l) {
    const bf16* XN = (const bf16*)(P.ws + WS_XN);
    const int* EXPp = (const int*)(P.ws + WS_EXP);
    const float* GATEp = (const float*)(P.ws + WS_GATE);
    const float* U = P.peer_u + (size_t)l * NEXP * D;
    const float* V = P.peer_v + (size_t)l * NEXP * D;
    const int lane = tidx() & 63;
    for (int t = gwave(); t < T; t += nwave()) {
        float4 xv[4];
#pragma unroll
        for (int j = 0; j < 4; ++j) {
            const uint2 r = ((const uint2*)(XN + (size_t)t * D))[j * 64 + lane];
            xv[j] = make_float4(bflo(r.x), bfhi(r.x), bflo(r.y), bfhi(r.y));
        }
        float4 acc[4];
#pragma unroll
        for (int j = 0; j < 4; ++j) acc[j] = make_float4(0.f, 0.f, 0.f, 0.f);
        for (int k = 0; k < HK; ++k) {
            const int e = EXPp[(size_t)t * HK + k];
            const float g = GATEp[(size_t)t * HK + k];
            const float4* ur = (const float4*)(U + (size_t)e * D);
            float d = 0.f;
#pragma unroll
            for (int j = 0; j < 4; ++j) { const float4 u = ur[j * 64 + lane]; d += xv[j].x * u.x + xv[j].y * u.y + xv[j].z * u.z + xv[j].w * u.w; }
            d = wave_sum(d);
            const float a = g * gelu_exact(d);
            const float4* vr = (const float4*)(V + (size_t)e * D);
#pragma unroll
            for (int j = 0; j < 4; ++j) { const float4 v = vr[j * 64 + lane]; acc[j].x = fmaf(a, v.x, acc[j].x); acc[j].y = fmaf(a, v.y, acc[j].y); acc[j].z = fmaf(a, v.z, acc[j].z); acc[j].w = fmaf(a, v.w, acc[j].w); }
        }
        float4* hr = (float4*)(P.out + (size_t)t * D);
        float ss = 0.f;
#pragma unroll
        for (int j = 0; j < 4; ++j) {
            const float4 hv = hr[j * 64 + lane];
            acc[j].x += hv.x; acc[j].y += hv.y; acc[j].z += hv.z; acc[j].w += hv.w;
            ss += acc[j].x * acc[j].x + acc[j].y * acc[j].y + acc[j].z * acc[j].z + acc[j].w * acc[j].w;
        }
        if (l == DEPTH - 1) {
            ss = wave_sum(ss);
            const float r = rsqrtf(ss * (1.f / D) + EPS);
#pragma unroll
            for (int j = 0; j < 4; ++j) {
                const float4 gg = ((const float4*)P.norm_final)[j * 64 + lane];
                hr[j * 64 + lane] = make_float4(acc[j].x * r * gg.x, acc[j].y * r * gg.y, acc[j].z * r * gg.z, acc[j].w * r * gg.w);
            }
        } else {
#pragma unroll
            for (int j = 0; j < 4; ++j) hr[j * 64 + lane] = acc[j];
        }
    }
}


#define NET_HD __device__ __forceinline__
#define NET_U2F(u) __uint_as_float(u)
#define NET_F2U(f) __float_as_uint(f)
#define CE_DESC(a, b) do { const float hi__ = fmaxf(a, b), lo__ = fminf(a, b); a = hi__; b = lo__; } while (0)
NET_HD void sort16_desc(float (&v)[16]) {
#pragma unroll
    for (int k = 2; k <= 16; k <<= 1) {
#pragma unroll
        for (int j = k >> 1; j > 0; j >>= 1) {
#pragma unroll
            for (int i = 0; i < 16; ++i) {
                const int l = i ^ j;
                if (l > i) { if ((i & k) == 0) CE_DESC(v[i], v[l]); else CE_DESC(v[l], v[i]); }
            }
        }
    }
}
NET_HD void merge16_desc(float (&a)[16], const float (&b)[16]) {
#pragma unroll
    for (int i = 0; i < 16; ++i) a[i] = fmaxf(a[i], b[15 - i]);
#pragma unroll
    for (int j = 8; j > 0; j >>= 1) {
#pragma unroll
        for (int i = 0; i < 16; ++i) { const int l = i ^ j; if (l > i) CE_DESC(a[i], a[l]); }
    }
}
NET_HD void top16_of_64(float (&g0)[16], float (&g1)[16], float (&g2)[16], float (&g3)[16]) {
    sort16_desc(g0); sort16_desc(g1); sort16_desc(g2); sort16_desc(g3);
    merge16_desc(g0, g1); merge16_desc(g2, g3); merge16_desc(g0, g2);
}
NET_HD float u2f(unsigned u) { return NET_U2F(u); }
NET_HD unsigned f2u(float f) { return NET_F2U(f); }
template <class V16>
NET_HD void lane_top16(const V16& s0, const V16& s1, const V16& s2, const V16& s3, int hi, float (&out)[16]) {
    float g0[16], g1[16], g2[16], g3[16];
#pragma unroll
    for (int r = 0; r < 16; ++r) {
        const unsigned nb = (unsigned)((r & 3) + 8 * (r >> 2));
        g0[r] = u2f((f2u(s0[r]) & 0xFFFFFF80u) | nb); g1[r] = u2f((f2u(s1[r]) & 0xFFFFFF80u) | (nb + 32u));
        g2[r] = u2f((f2u(s2[r]) & 0xFFFFFF80u) | (nb + 64u)); g3[r] = u2f((f2u(s3[r]) & 0xFFFFFF80u) | (nb + 96u));
    }
    top16_of_64(g0, g1, g2, g3);
    const unsigned h4 = (unsigned)hi << 2;
#pragma unroll
    for (int i = 0; i < 16; ++i) out[i] = u2f(f2u(g0[i]) | h4);
}
constexpr int cand_slot(int a, int b) { int n = 0; for (int x = 0; x < 16; ++x) for (int y = 0; y < 16; ++y) { if (x == a && y == b) return n; if ((x + 1) * (y + 1) <= 16) ++n; } return n; }
NET_HD void cand_top16(const float (&s1)[16], const float (&s2)[16], float (&c)[16]) {
    float g0[16], g1[16], g2[16], g3[16];
#pragma unroll
    for (int i = 0; i < 16; ++i) { g0[i] = -3.0e38f; g1[i] = -3.0e38f; g2[i] = -3.0e38f; g3[i] = -3.0e38f; }
#pragma unroll
    for (int a = 0; a < 16; ++a) {
#pragma unroll
        for (int b = 0; b < 16; ++b) {
            if ((a + 1) * (b + 1) <= 16) {
                const int sl = cand_slot(a, b);
                const float v = u2f((f2u(s1[a] + s2[b]) & 0xFFFFFF00u) | (unsigned)(a * 16 + b));
                if (sl < 16) g0[sl & 15] = v; else if (sl < 32) g1[sl & 15] = v; else if (sl < 48) g2[sl & 15] = v; else g3[sl & 15] = v;
            }
        }
    }
    top16_of_64(g0, g1, g2, g3);
#pragma unroll
    for (int i = 0; i < 16; ++i) c[i] = g0[i];
}

__device__ __forceinline__ void phase_route(const Params& P, int l, char* lds) {
    const bf16* XN = (const bf16*)(P.ws + WS_XN);
    const bf16* Wc = (const bf16*)(P.ws + WS_WPQ) + (size_t)l * 2048 * D;
    int* EXPp = (int*)(P.ws + WS_EXP);
    float* GATEp = (float*)(P.ws + WS_GATE);
    const int tid = tidx(), lane = tid & 63, w = tid >> 6, r32 = lane & 31, hi = lane >> 5;
    for (int u = blockIdx.x; u < (T / 128) * PH; u += gridDim.x) {
        const int tm = u >> 3, h = u & 7;
        float L0[16], L1[16];
        {
            f32x16 acc[4];
            gemm_kloop<1>(Wc + (size_t)((h * 2 + 0) * 128) * D, D, XN + (size_t)(tm * 128) * D, D, D / 64, acc, lds, tid);
            lane_top16(acc[0], acc[1], acc[2], acc[3], hi, L0);
            float o[16];
#pragma unroll
            for (int i = 0; i < 16; ++i) o[i] = __shfl_xor(L0[i], 32, 64);
            merge16_desc(L0, o);
        }
        {
            f32x16 acc[4];
            gemm_kloop<1>(Wc + (size_t)((h * 2 + 1) * 128) * D, D, XN + (size_t)(tm * 128) * D, D, D / 64, acc, lds, tid);
            lane_top16(acc[0], acc[1], acc[2], acc[3], hi, L1);
            float o[16];
#pragma unroll
            for (int i = 0; i < 16; ++i) o[i] = __shfl_xor(L1[i], 32, 64);
            merge16_desc(L1, o);
        }
        float c[16];
        cand_top16(L0, L1, c);
        __syncthreads();
        unsigned char* my = (unsigned char*)lds + tid * 32;
        {
            uint4 a, b;
#define PK4(L, i) ((__float_as_uint(L[i]) & 127u) | ((__float_as_uint(L[i + 1]) & 127u) << 8) | ((__float_as_uint(L[i + 2]) & 127u) << 16) | ((__float_as_uint(L[i + 3]) & 127u) << 24))
            a.x = PK4(L0, 0); a.y = PK4(L0, 4); a.z = PK4(L0, 8); a.w = PK4(L0, 12);
            b.x = PK4(L1, 0); b.y = PK4(L1, 4); b.z = PK4(L1, 8); b.w = PK4(L1, 12);
#undef PK4
            *(uint4*)my = a; *(uint4*)(my + 16) = b;
        }
        int ev[16]; float gv[16]; float den = 0.f;
#pragma unroll
        for (int k = 0; k < 16; ++k) {
            const unsigned ci = __float_as_uint(c[k]) & 255u;
            const int n1 = my[ci >> 4], n2 = my[16 + (ci & 15)];
            ev[k] = n1 * NKEY + n2;
            gv[k] = __expf(c[k] - c[0]); den += gv[k];
        }
        const float iden = 1.f / den;
        if (hi == 0) {
            const int t = tm * 128 + w * 32 + r32;
            uint4* ep = (uint4*)(EXPp + (size_t)t * HK + h * 16);
            float4* gp = (float4*)(GATEp + (size_t)t * HK + h * 16);
#pragma unroll
            for (int q = 0; q < 4; ++q) {
                ep[q] = make_uint4((unsigned)ev[4 * q], (unsigned)ev[4 * q + 1], (unsigned)ev[4 * q + 2], (unsigned)ev[4 * q + 3]);
                gp[q] = make_float4(gv[4 * q] * iden, gv[4 * q + 1] * iden, gv[4 * q + 2] * iden, gv[4 * q + 3] * iden);
            }
        }
        __syncthreads();
    }
}

__device__ __forceinline__ float red16(float (&p)[16], int lane) {
#pragma unroll
    for (int i = 0; i < 8; ++i) { const bool up = lane & 32; const float send = up ? p[i] : p[i + 8], keep = up ? p[i + 8] : p[i]; p[i] = keep + __shfl_xor(send, 32, 64); }
#pragma unroll
    for (int i = 0; i < 4; ++i) { const bool up = lane & 16; const float send = up ? p[i] : p[i + 4], keep = up ? p[i + 4] : p[i]; p[i] = keep + __shfl_xor(send, 16, 64); }
#pragma unroll
    for (int i = 0; i < 2; ++i) { const bool up = lane & 8; const float send = up ? p[i] : p[i + 2], keep = up ? p[i + 2] : p[i]; p[i] = keep + __shfl_xor(send, 8, 64); }
    { const bool up = lane & 4; const float send = up ? p[0] : p[1], keep = up ? p[1] : p[0]; p[0] = keep + __shfl_xor(send, 4, 64); }
    float r = p[0];
    r += __shfl_xor(r, 2, 64); r += __shfl_xor(r, 1, 64);
    return r;
}
typedef __attribute__((ext_vector_type(2))) __bf16 bf2_t;
__device__ __forceinline__ float dot2bf(unsigned a, unsigned b, float c) { return __builtin_amdgcn_fdot2_f32_bf16(__builtin_bit_cast(bf2_t, a), __builtin_bit_cast(bf2_t, b), c, false); }

__device__ __forceinline__ void phase_gather(const Params& P, int l) {
    const bf16* XN = (const bf16*)(P.ws + WS_XN);
    bf16* XNw = (bf16*)(P.ws + WS_XN);
    const int* EXPp = (const int*)(P.ws + WS_EXP);
    const float* GATEp = (const float*)(P.ws + WS_GATE);
    const unsigned char* U = P.ws + WS_TABU + (size_t)l * NEXP * TAB_ROWB;
    const unsigned char* V = P.ws + WS_TABV + (size_t)l * NEXP * TAB_ROWB;
    const float* SU = (const float*)(P.ws + WS_TSCU) + (size_t)l * NEXP;
    const float* SV = (const float*)(P.ws + WS_TSCV) + (size_t)l * NEXP;
    const int lane = tidx() & 63;
    for (int t = gwave(); t < T; t += nwave()) {
        const int e_lo = EXPp[(size_t)t * HK + lane], e_hi = EXPp[(size_t)t * HK + 64 + lane];
#if TAB_FP8
        float xf[16];
        {
            const uint4 a = ((const uint4*)(XN + (size_t)t * D))[lane * 2], b = ((const uint4*)(XN + (size_t)t * D))[lane * 2 + 1];
            xf[0] = bflo(a.x); xf[1] = bfhi(a.x); xf[2] = bflo(a.y); xf[3] = bfhi(a.y); xf[4] = bflo(a.z); xf[5] = bfhi(a.z); xf[6] = bflo(a.w); xf[7] = bfhi(a.w);
            xf[8] = bflo(b.x); xf[9] = bfhi(b.x); xf[10] = bflo(b.y); xf[11] = bfhi(b.y); xf[12] = bflo(b.z); xf[13] = bfhi(b.z); xf[14] = bflo(b.w); xf[15] = bfhi(b.w);
        }
#else
        const uint4 xa = ((const uint4*)(XN + (size_t)t * D))[lane], xb = ((const uint4*)(XN + (size_t)t * D))[64 + lane];
#endif
        float acc[16];
#pragma unroll
        for (int i = 0; i < 16; ++i) acc[i] = 0.f;
        for (int c = 0; c < 8; ++c) {
            const int esel = (c < 4) ? e_lo : e_hi;
            const int kb = (c & 3) * 16;
            float part[16];
#pragma unroll
            for (int hb = 0; hb < 2; ++hb) {
#if TAB_FP8
                uint4 r[8];
#pragma unroll
                for (int i = 0; i < 8; ++i) { const int e = __builtin_amdgcn_readlane(esel, kb + hb * 8 + i); r[i] = *(const uint4*)(U + (size_t)e * 1024 + lane * 16); }
#pragma unroll
                for (int i = 0; i < 8; ++i) {
                    float d0 = 0.f, d1 = 0.f;
                    const unsigned w[4] = {r[i].x, r[i].y, r[i].z, r[i].w};
#pragma unroll
                    for (int q = 0; q < 4; ++q) {
                        const auto lo = __builtin_amdgcn_cvt_pk_f32_fp8((int)w[q], false); const auto hh = __builtin_amdgcn_cvt_pk_f32_fp8((int)w[q], true);
                        d0 = fmaf(xf[4 * q], lo[0], d0); d1 = fmaf(xf[4 * q + 1], lo[1], d1); d0 = fmaf(xf[4 * q + 2], hh[0], d0); d1 = fmaf(xf[4 * q + 3], hh[1], d1);
                    }
                    part[hb * 8 + i] = d0 + d1;
                }
#else
                uint4 r0[8], r1[8];
#pragma unroll
                for (int i = 0; i < 8; ++i) { const int e = __builtin_amdgcn_readlane(esel, kb + hb * 8 + i); const unsigned char* rp = U + (size_t)e * 2048 + lane * 16; r0[i] = *(const uint4*)(rp); r1[i] = *(const uint4*)(rp + 1024); }
#pragma unroll
                for (int i = 0; i < 8; ++i) {
                    float d0 = 0.f, d1 = 0.f;
                    d0 = dot2bf(xa.x, r0[i].x, d0); d1 = dot2bf(xa.y, r0[i].y, d1); d0 = dot2bf(xa.z, r0[i].z, d0); d1 = dot2bf(xa.w, r0[i].w, d1);
                    d0 = dot2bf(xb.x, r1[i].x, d0); d1 = dot2bf(xb.y, r1[i].y, d1); d0 = dot2bf(xb.z, r1[i].z, d0); d1 = dot2bf(xb.w, r1[i].w, d1);
                    part[hb * 8 + i] = d0 + d1;
                }
#endif
            }
            float dsum = red16(part, lane);
            const int kk = c * 16 + (lane >> 2);
            const int eme = __shfl(esel, kb + (lane >> 2), 64);
            float wv = GATEp[(size_t)t * HK + kk];
#if TAB_FP8
            dsum *= SU[eme];
            wv *= SV[eme];
#endif
            wv *= gelu_exact(dsum);
#pragma unroll
            for (int hb = 0; hb < 2; ++hb) {
#if TAB_FP8
                uint4 r[8];
#pragma unroll
                for (int i = 0; i < 8; ++i) { const int e = __builtin_amdgcn_readlane(esel, kb + hb * 8 + i); r[i] = *(const uint4*)(V + (size_t)e * 1024 + lane * 16); }
#pragma unroll
                for (int i = 0; i < 8; ++i) {
                    const float w = __int_as_float(__builtin_amdgcn_readlane(__float_as_int(wv), (hb * 8 + i) * 4));
                    const unsigned ww[4] = {r[i].x, r[i].y, r[i].z, r[i].w};
#pragma unroll
                    for (int q = 0; q < 4; ++q) {
                        const auto lo = __builtin_amdgcn_cvt_pk_f32_fp8((int)ww[q], false); const auto hh = __builtin_amdgcn_cvt_pk_f32_fp8((int)ww[q], true);
                        acc[4 * q] = fmaf(w, lo[0], acc[4 * q]); acc[4 * q + 1] = fmaf(w, lo[1], acc[4 * q + 1]); acc[4 * q + 2] = fmaf(w, hh[0], acc[4 * q + 2]); acc[4 * q + 3] = fmaf(w, hh[1], acc[4 * q + 3]);
                    }
                }
#else
                uint4 r0[8], r1[8];
#pragma unroll
                for (int i = 0; i < 8; ++i) { const int e = __builtin_amdgcn_readlane(esel, kb + hb * 8 + i); const unsigned char* rp = V + (size_t)e * 2048 + lane * 16; r0[i] = *(const uint4*)(rp); r1[i] = *(const uint4*)(rp + 1024); }
#pragma unroll
                for (int i = 0; i < 8; ++i) {
                    const float w = __int_as_float(__builtin_amdgcn_readlane(__float_as_int(wv), (hb * 8 + i) * 4));
                    acc[0] = fmaf(w, bflo(r0[i].x), acc[0]); acc[1] = fmaf(w, bfhi(r0[i].x), acc[1]); acc[2] = fmaf(w, bflo(r0[i].y), acc[2]); acc[3] = fmaf(w, bfhi(r0[i].y), acc[3]);
                    acc[4] = fmaf(w, bflo(r0[i].z), acc[4]); acc[5] = fmaf(w, bfhi(r0[i].z), acc[5]); acc[6] = fmaf(w, bflo(r0[i].w), acc[6]); acc[7] = fmaf(w, bfhi(r0[i].w), acc[7]);
                    acc[8] = fmaf(w, bflo(r1[i].x), acc[8]); acc[9] = fmaf(w, bfhi(r1[i].x), acc[9]); acc[10] = fmaf(w, bflo(r1[i].y), acc[10]); acc[11] = fmaf(w, bfhi(r1[i].y), acc[11]);
                    acc[12] = fmaf(w, bflo(r1[i].z), acc[12]); acc[13] = fmaf(w, bfhi(r1[i].z), acc[13]); acc[14] = fmaf(w, bflo(r1[i].w), acc[14]); acc[15] = fmaf(w, bfhi(r1[i].w), acc[15]);
                }
#endif
            }
        }
        float* hrow = P.out + (size_t)t * D;
#if TAB_FP8
        const int c0 = lane * 16, c1 = lane * 16 + 8;
#else
        const int c0 = lane * 8, c1 = 512 + lane * 8;
#endif
        float4 h0 = *(const float4*)(hrow + c0), h1 = *(const float4*)(hrow + c0 + 4), h2 = *(const float4*)(hrow + c1), h3 = *(const float4*)(hrow + c1 + 4);
        h0.x += acc[0]; h0.y += acc[1]; h0.z += acc[2]; h0.w += acc[3]; h1.x += acc[4]; h1.y += acc[5]; h1.z += acc[6]; h1.w += acc[7];
        h2.x += acc[8]; h2.y += acc[9]; h2.z += acc[10]; h2.w += acc[11]; h3.x += acc[12]; h3.y += acc[13]; h3.z += acc[14]; h3.w += acc[15];
        float ss = h0.x * h0.x + h0.y * h0.y + h0.z * h0.z + h0.w * h0.w + h1.x * h1.x + h1.y * h1.y + h1.z * h1.z + h1.w * h1.w
                 + h2.x * h2.x + h2.y * h2.y + h2.z * h2.z + h2.w * h2.w + h3.x * h3.x + h3.y * h3.y + h3.z * h3.z + h3.w * h3.w;
        ss = wave_sum(ss);
        const float rn = rsqrtf(ss * (1.f / D) + EPS);
        if (l == DEPTH - 1) {
            const float* g = P.norm_final;
            const float4 g0 = *(const float4*)(g + c0), g1 = *(const float4*)(g + c0 + 4), g2 = *(const float4*)(g + c1), g3 = *(const float4*)(g + c1 + 4);
            *(float4*)(hrow + c0) = make_float4(h0.x * rn * g0.x, h0.y * rn * g0.y, h0.z * rn * g0.z, h0.w * rn * g0.w);
            *(float4*)(hrow + c0 + 4) = make_float4(h1.x * rn * g1.x, h1.y * rn * g1.y, h1.z * rn * g1.z, h1.w * rn * g1.w);
            *(float4*)(hrow + c1) = make_float4(h2.x * rn * g2.x, h2.y * rn * g2.y, h2.z * rn * g2.z, h2.w * rn * g2.w);
            *(float4*)(hrow + c1 + 4) = make_float4(h3.x * rn * g3.x, h3.y * rn * g3.y, h3.z * rn * g3.z, h3.w * rn * g3.w);
        } else {
            *(float4*)(hrow + c0) = h0; *(float4*)(hrow + c0 + 4) = h1; *(float4*)(hrow + c1) = h2; *(float4*)(hrow + c1 + 4) = h3;
            const float* g = P.norm_mix + (l + 1) * D;
            const float4 g0 = *(const float4*)(g + c0), g1 = *(const float4*)(g + c0 + 4), g2 = *(const float4*)(g + c1), g3 = *(const float4*)(g + c1 + 4);
            uint4 o0, o1;
            o0.x = pack2(h0.x * rn * g0.x, h0.y * rn * g0.y); o0.y = pack2(h0.z * rn * g0.z, h0.w * rn * g0.w); o0.z = pack2(h1.x * rn * g1.x, h1.y * rn * g1.y); o0.w = pack2(h1.z * rn * g1.z, h1.w * rn * g1.w);
            o1.x = pack2(h2.x * rn * g2.x, h2.y * rn * g2.y); o1.y = pack2(h2.z * rn * g2.z, h2.w * rn * g2.w); o1.z = pack2(h3.x * rn * g3.x, h3.y * rn * g3.y); o1.w = pack2(h3.z * rn * g3.z, h3.w * rn * g3.w);
            *(uint4*)(XNw + (size_t)t * D + c0) = o0; *(uint4*)(XNw + (size_t)t * D + c1) = o1;
        }
    }
}


#define XB_TMO      128
#define XB_XCNT(j)  (256  + 64 * (j))
#define XB_XSUB(j)  (1280 + 64 * (j))
#define XB_XGEN(j)  (2304 + 64 * (j))
#define XB_TOP      3328
#define XB_TOPGEN   3392
#define XCD_BAR_WORDS 3456
#define XB_SPIN_CAP (1u << 22)
#define LAS __attribute__((address_space(3)))
__device__ __forceinline__ unsigned xb_ld(unsigned* p)              { return __hip_atomic_load(p, __ATOMIC_RELAXED, __HIP_MEMORY_SCOPE_AGENT); }
__device__ __forceinline__ unsigned xb_add(unsigned* p, unsigned v) { return __hip_atomic_fetch_add(p, v, __ATOMIC_RELAXED, __HIP_MEMORY_SCOPE_AGENT); }
__device__ __forceinline__ unsigned xb_xcc_id() { return (unsigned)__builtin_amdgcn_s_getreg((3 << 11) | 20) & 0xFu; }
#define XB_SPIN(cond, bar) do { unsigned _sp = 0; while (cond) { __builtin_amdgcn_s_sleep(1); \
    if ((++_sp & 255u) == 0u) { if (xb_ld(&(bar)[XB_TMO])) break; if (_sp > XB_SPIN_CAP) { atomicAdd(&(bar)[XB_TMO], 1u); break; } } } } while (0)
struct XcdBarrier { unsigned* bar; unsigned x; volatile LAS unsigned* st; };
__device__ __forceinline__ XcdBarrier xcd_barrier_post(unsigned* bar, volatile LAS unsigned* st) {
    XcdBarrier b; b.bar = bar; b.x = xb_xcc_id(); b.st = st;
    if (__builtin_amdgcn_workitem_id_x() == 0) (void)xb_add(&bar[XB_XCNT(b.x)], 1u);
    return b;
}
__device__ __forceinline__ void xcd_barrier_complete(unsigned* bar, unsigned x, unsigned& nloc, unsigned& nx) {
    const unsigned G = gridDim.x * gridDim.y * gridDim.z;
    unsigned sum, cnt, mine, sp = 0u;
    for (;;) {
        sum = 0u; cnt = 0u; mine = 0u;
#pragma unroll
        for (unsigned j = 0; j < 16; ++j) { const unsigned c = xb_ld(&bar[XB_XCNT(j)]); sum += c; cnt += (c > 0u) ? 1u : 0u; mine = (j == x) ? c : mine; }
        if (sum == G) break;
        __builtin_amdgcn_s_sleep(1);
        if ((++sp & 255u) == 0u) { if (xb_ld(&bar[XB_TMO])) break; if (sp > XB_SPIN_CAP) { atomicAdd(&bar[XB_TMO], 1u); break; } }
    }
    nloc = mine > 0u ? mine : 1u; nx = cnt > 0u ? cnt : 1u;
}
__device__ __forceinline__ void xcd_barrier(const XcdBarrier& b) {
    asm volatile("s_waitcnt vmcnt(0)" ::: "memory");
    __syncthreads();
    if (__builtin_amdgcn_workitem_id_x() == 0) {
        unsigned* bar = b.bar;
        __builtin_amdgcn_s_waitcnt(0);
        unsigned nloc = b.st[0], nx = b.st[1];
        if (nloc == 0u) { xcd_barrier_complete(bar, b.x, nloc, nx); b.st[0] = nloc; b.st[1] = nx; }
        const unsigned old = xb_add(&bar[XB_XSUB(b.x)], 1u);
        const unsigned gen = old / nloc;
        if (old + 1u == (gen + 1u) * nloc) {
            __builtin_amdgcn_fence(__ATOMIC_RELEASE, "agent");
            asm volatile("s_waitcnt vmcnt(0)" ::: "memory");
            const unsigned og = xb_add(&bar[XB_TOP], 1u);
            const unsigned tg = og / nx;
            if (og + 1u == (tg + 1u) * nx) xb_add(&bar[XB_TOPGEN], 1u);
            else XB_SPIN(xb_ld(&bar[XB_TOPGEN]) == tg, bar);
            __builtin_amdgcn_fence(__ATOMIC_ACQUIRE, "agent");
            xb_add(&bar[XB_XGEN(b.x)], 1u);
            asm volatile("s_waitcnt vmcnt(0)" ::: "memory");
        } else {
            XB_SPIN(xb_ld(&bar[XB_XGEN(b.x)]) == gen, bar);
            __builtin_amdgcn_fence(__ATOMIC_ACQUIRE, "agent");
            asm volatile("s_waitcnt vmcnt(0)" ::: "memory");
        }
    }
    __syncthreads();
}

constexpr int PH_PER_LAYER = 11;
constexpr int NPHASES = 1 + DEPTH * PH_PER_LAYER;

constexpr float QSCALE = 0.10206207261596575f * 1.4426950408889634f;
template <int s>
__device__ __forceinline__ void layer_phase(const Params& P, int l, char* lds) {
    unsigned char* ws = P.ws;
    float* sm = (float*)lds;
    bf16* XN = (bf16*)(ws + WS_XN);
    bf16* PROJ = (bf16*)(ws + WS_PROJ);
    const float* hin = (l == 0) ? P.x : P.out;
    if constexpr (s == 0) phase_norm(hin, P.norm_mix + l * D, XN);
    if constexpr (s == 1) {
        const bf16* W = (const bf16*)(ws + WS_WIN) + (size_t)l * DINP * D;
        gemm_mfma(XN, D, W, D, T, DINP, D, [&](int m0, int n0, const f32x16& acc, int r32, int hi) {
            const int n = n0 + r32;
            if (n < DIN) {
#pragma unroll
                for (int r = 0; r < 16; ++r) PROJ[(size_t)(m0 + crow(r, hi)) * DINP + n] = f2bf(acc[r]);
            }
        }, lds);
    }
    if constexpr (s == 2) phase_mixprep(P, l);
    if constexpr (s == 3) {
        const bf16* W = (const bf16*)(ws + WS_WUQ) + (size_t)l * 768 * QR;
        bf16* Qb = (bf16*)(ws + WS_Q);
        const float* rope = (const float*)(ws + WS_ROPE);
        gemm_mfma(PROJ + C_CQ, DINP, W, QR, T, 768, QR, [&](int m0, int n0, const f32x16& acc, int r32, int hi) {
            const int h = n0 / DQK, d0 = n0 % DQK;
            const int b = m0 / S, s0 = m0 % S;
            bf16* qb = Qb + ((size_t)(b * NH + h) * S + s0) * DQK + d0 + r32;
            if (d0 == 64) {
                const int f = r32 & 15;
#pragma unroll
                for (int r = 0; r < 16; ++r) {
                    const int sr = crow(r, hi);
                    const float v = acc[r], o = __shfl_xor(v, 16, 64);
                    const float2 cs = *(const float2*)(rope + ((size_t)(s0 + sr) * 16 + f) * 2);
                    const float res = (r32 < 16) ? (v * cs.x - o * cs.y) : (v * cs.x + o * cs.y);
                    qb[(size_t)sr * DQK] = f2bf(res * QSCALE);
                }
            } else {
#pragma unroll
                for (int r = 0; r < 16; ++r) qb[(size_t)crow(r, hi) * DQK] = f2bf(acc[r] * QSCALE);
            }
        }, lds);
    }
    if constexpr (s == 4) {
        const bf16* W = (const bf16*)(ws + WS_WUKV) + (size_t)l * 1024 * KVR;
        bf16* Kb = (bf16*)(ws + WS_K); bf16* Vb = (bf16*)(ws + WS_V);
        gemm_mfma(PROJ + C_CKV, DINP, W, KVR, T, 1024, KVR, [&](int m0, int n0, const f32x16& acc, int r32, int hi) {
            const int b = m0 / S, s0 = m0 % S;
            if (n0 < 512) {
                const int h = n0 >> 6, d = (n0 & 63) + r32;
                bf16* kb = Kb + ((size_t)(b * NH + h) * S + s0) * DQK + d;
#pragma unroll
                for (int r = 0; r < 16; ++r) kb[(size_t)crow(r, hi) * DQK] = f2bf(acc[r]);
            } else {
                const int h = (n0 - 512) >> 6, d = (n0 & 63) + r32;
                bf16* vb = Vb + ((size_t)(b * NH + h) * S + s0) * DV + d;
#pragma unroll
                for (int r = 0; r < 16; ++r) vb[(size_t)crow(r, hi) * DV] = f2bf(acc[r]);
            }
        }, lds);
    }
    if constexpr (s == 5) { }
#if ATTN_MFMA
    if constexpr (s == 6) phase_attn(P, lds);
#else
    if constexpr (s == 6) phase_attn_naive(P);
#endif
    if constexpr (s == 7) {
        const bf16* W = (const bf16*)(ws + WS_WOUT) + (size_t)l * D * D;
        float* out = P.out;
        gemm_mfma(XN, D, W, D, T, D, D, [&](int m0, int n0, const f32x16& acc, int r32, int hi) {
#pragma unroll
            for (int r = 0; r < 16; ++r) { const size_t idx = (size_t)(m0 + crow(r, hi)) * D + n0 + r32; out[idx] = hin[idx] + acc[r]; }
        }, lds);
    }
    if constexpr (s == 8) phase_norm(P.out, P.norm_ffn + l * D, XN);
    if constexpr (s == 9) {
        const bf16* W = (const bf16*)(ws + WS_WPQ) + (size_t)l * 2048 * D;
        bf16* QP = (bf16*)(ws + WS_QP);
        gemm_mfma(XN, D, W, D, T, 2048, D, [&](int m0, int n0, const f32x16& acc, int r32, int hi) {
#pragma unroll
            for (int r = 0; r < 16; ++r) QP[(size_t)(m0 + crow(r, hi)) * 2048 + n0 + r32] = f2bf(acc[r]);
        }, lds);
    }
    if constexpr (s == 10) phase_topk_naive(P, l, sm);
}

__device__ __forceinline__ void layer_phase_dyn(const Params& P, int l, int s, char* sm) {
    switch (s) {
    case 0: layer_phase<0>(P, l, sm); break; case 1: layer_phase<1>(P, l, sm); break; case 2: layer_phase<2>(P, l, sm); break;
    case 3: layer_phase<3>(P, l, sm); break; case 4: layer_phase<4>(P, l, sm); break; case 5: layer_phase<5>(P, l, sm); break;
    case 6: layer_phase<6>(P, l, sm); break; case 7: layer_phase<7>(P, l, sm); break; case 8: layer_phase<8>(P, l, sm); break;
    case 9: layer_phase<9>(P, l, sm); break; case 10: layer_phase<10>(P, l, sm); break; default: phase_gather_naive(P, l); break;
    }
}
#if !ONE_LAUNCH
__global__ void __launch_bounds__(NTHREADS, 2) k_phase(Params P, int ph) {
    __shared__ __attribute__((aligned(16))) char sm[GEMM_LDS];
    if (ph == 0) { phase_prep(P); return; }
    layer_phase_dyn(P, (ph - 1) / (PH_PER_LAYER + 1), (ph - 1) % (PH_PER_LAYER + 1), sm);
}
#else
#define GSYNC() do { XcdBarrier xb_; xb_.bar = (unsigned*)(P.ws + WS_CTL); xb_.x = xb_xcc_id(); xb_.st = (volatile LAS unsigned*)&xb_words; xcd_barrier(xb_); } while (0)
__global__ void __launch_bounds__(NTHREADS, 2) k_all(Params P) {
    __shared__ __attribute__((aligned(16))) char sm[GEMM_LDS];
    cg::grid_group grid = cg::this_grid();
    __shared__ uint4 xb_words;
    if (__builtin_amdgcn_workitem_id_x() == 0) xb_words = make_uint4(0u, 0u, 0u, 0u);
    __syncthreads();
    (void)xcd_barrier_post((unsigned*)(P.ws + WS_CTL), (volatile LAS unsigned*)&xb_words);
    { const Params Q = launder(P); phase_prep(Q); } grid.sync();
    for (int l = 0; l < DEPTH; ++l) {
#define LP(s) { const Params Q = launder(P); layer_phase<s>(Q, l, sm); }
        if (l == 0) { LP(0); GSYNC(); }
        LP(1); GSYNC();
        LP(2); GSYNC();
        LP(3);
        LP(4); GSYNC();
        LP(6); GSYNC();
        LP(7); GSYNC();
        LP(8); GSYNC();
        { const Params Q = launder(P); phase_route(Q, l, sm); } GSYNC();
        { const Params Q = launder(P); phase_gather(Q, l); } GSYNC();
    }
}
#endif

extern "C" void kernel_launch(void* const* d_in, const int* in_sizes, int n_in, void* d_out, int out_size, void* d_ws, size_t ws_size, hipStream_t stream) {
    static int grid = 0;
    if (grid == 0) {
        if (n_in != 18 || out_size != T * D || ws_size < WS_END) { fprintf(stderr, "kernel_launch: bad sizes n_in %d out %d ws %zu need %zu\n", n_in, out_size, ws_size, (size_t)WS_END); grid = -1; return; }
        int dev = 0, cus = 0, per_cu = 0;
        hipGetDevice(&dev);
        hipDeviceGetAttribute(&cus, hipDeviceAttributeMultiprocessorCount, dev);
#if ONE_LAUNCH
        hipOccupancyMaxActiveBlocksPerMultiprocessor(&per_cu, (const void*)k_all, NTHREADS, 0);
#else
        hipOccupancyMaxActiveBlocksPerMultiprocessor(&per_cu, (const void*)k_phase, NTHREADS, 0);
#endif
        if (per_cu > 2) per_cu = 2;
        if (per_cu < 1) { fprintf(stderr, "kernel_launch: occupancy query says %d\n", per_cu); grid = -1; return; }
        grid = cus * per_cu;
    }
    if (grid < 0) return;
    Params p{};
    p.x = (const float*)d_in[0]; p.norm_mix = (const float*)d_in[1]; p.w_in = (const float*)d_in[2]; p.conv_w = (const float*)d_in[3];
    p.pool_w = (const float*)d_in[4]; p.pool_scale = (const float*)d_in[5]; p.q_norm = (const float*)d_in[6]; p.w_uq = (const float*)d_in[7];
    p.kv_norm = (const float*)d_in[8]; p.w_uk = (const float*)d_in[9]; p.w_uv = (const float*)d_in[10]; p.w_out = (const float*)d_in[11];
    p.norm_ffn = (const float*)d_in[12]; p.peer_wq = (const float*)d_in[13]; p.peer_subkeys = (const float*)d_in[14]; p.peer_u = (const float*)d_in[15];
    p.peer_v = (const float*)d_in[16]; p.norm_final = (const float*)d_in[17];
    p.out = (float*)d_out; p.ws = (unsigned char*)d_ws;
#if ONE_LAUNCH
    if (hipMemsetAsync((char*)d_ws + WS_CTL, 0, XCD_BAR_WORDS * 4, stream) != hipSuccess) { fprintf(stderr, "kernel_launch: memset failed\n"); return; }
    void* args[] = {&p};
    hipError_t e = hipLaunchCooperativeKernel((const void*)k_all, dim3(grid), dim3(NTHREADS), args, 0, stream);
    if (e != hipSuccess) fprintf(stderr, "cooperative launch failed: %s (grid %d)\n", hipGetErrorString(e), grid);
#else
    for (int ph = 0; ph < 1 + DEPTH * (PH_PER_LAYER + 1); ++ph) hipLaunchKernelGGL(k_phase, dim3(grid), dim3(NTHREADS), 0, stream, p, ph);
#endif
}
```

```cpp
#include <hip/hip_runtime.h>
#include <hip/hip_cooperative_groups.h>
#include <cstdio>
#include <cstdint>
namespace cg = cooperative_groups;

#ifndef TAB_FP8
#define TAB_FP8 1
#endif
#ifndef PROBE_DUP
#define PROBE_DUP 0
#endif

constexpr int NB = 4, S = 8192, T = NB * S, D = 1024, DEPTH = 2;
constexpr int DIN = 1696, DINP = 1792;
constexpr int C_BG = 0, C_CG = 256, C_HC = 512, C_HP = 768, C_CQ = 1024, C_CKV = 1408, C_KR = 1664;
constexpr int QR = 384, KVR = 256, NH = 8, DQK = 96, DV = 64;
constexpr int PH = 8, NKEY = 128, NEXP = NKEY * NKEY, TOPK = 16, HK = PH * TOPK;
constexpr float EPS = 1e-6f;

typedef unsigned short bf16;

constexpr size_t WS_CTL   = 0;
constexpr size_t WS_ROPE  = 64 * 1024;
constexpr size_t WS_WIN   = WS_ROPE + (size_t)S * 16 * 2 * 4;
constexpr size_t WS_WUQ   = WS_WIN + (size_t)DEPTH * DINP * D * 2;
constexpr size_t WS_WUKV  = WS_WUQ + (size_t)DEPTH * 768 * QR * 2;
constexpr size_t WS_WOUT  = WS_WUKV + (size_t)DEPTH * 1024 * KVR * 2;
constexpr size_t WS_WPQ   = WS_WOUT + (size_t)DEPTH * D * D * 2;
constexpr size_t WS_XN    = ((WS_WPQ + (size_t)DEPTH * 2048 * D * 2 + 4095) / 4096) * 4096;
constexpr size_t WS_PROJ  = WS_XN + (size_t)T * D * 2;
constexpr size_t WS_Q     = WS_PROJ + (size_t)T * DINP * 2;
constexpr size_t WS_K     = WS_Q + (size_t)T * NH * DQK * 2;
constexpr size_t WS_V     = WS_K + (size_t)T * NH * DQK * 2;
constexpr size_t WS_EXP   = WS_V + (size_t)T * NH * DV * 2;
constexpr size_t WS_GATE  = WS_EXP + (size_t)T * HK * 4;
constexpr size_t TAB_ROWB = TAB_FP8 ? 1024 : 2048;
constexpr size_t WS_TABU  = WS_GATE + (size_t)T * HK * 4;
constexpr size_t WS_TABV  = WS_TABU + (size_t)DEPTH * NEXP * TAB_ROWB;
constexpr size_t WS_TSCU  = WS_TABV + (size_t)DEPTH * NEXP * TAB_ROWB;
constexpr size_t WS_TSCV  = WS_TSCU + (size_t)DEPTH * NEXP * 4;
constexpr size_t WS_END   = WS_TSCV + (size_t)DEPTH * NEXP * 4;
static_assert(WS_END <= (size_t)512 * 1024 * 1024, "workspace budget");

struct Params {
    const float* x; const float* norm_mix; const float* w_in; const float* conv_w; const float* pool_w; const float* pool_scale;
    const float* q_norm; const float* w_uq; const float* kv_norm; const float* w_uk; const float* w_uv; const float* w_out;
    const float* norm_ffn; const float* peer_wq; const float* peer_subkeys; const float* peer_u; const float* peer_v; const float* norm_final;
    float* out; unsigned char* ws;
};

__device__ __forceinline__ bf16 f2bf(float f) { unsigned u = __float_as_uint(f); u += 0x7fffu + ((u >> 16) & 1u); return (bf16)(u >> 16); }
__device__ __forceinline__ float bf2f(bf16 h) { return __uint_as_float(((unsigned)h) << 16); }
__device__ __forceinline__ float bflo(unsigned u) { return __uint_as_float(u << 16); }
__device__ __forceinline__ float bfhi(unsigned u) { return __uint_as_float(u & 0xffff0000u); }
__device__ __forceinline__ unsigned pack2(float a, float b) { return (unsigned)f2bf(a) | ((unsigned)f2bf(b) << 16); }
__device__ __forceinline__ float wave_sum(float v) {
#pragma unroll
    for (int m = 32; m >= 1; m >>= 1) v += __shfl_xor(v, m, 64);
    return v;
}
__device__ __forceinline__ float gelu_exact(float x) { return 0.5f * x * (1.f + erff(x * 0.70710678118654752f)); }

#define NTHREADS 256
__device__ __forceinline__ int tidx() { int t = (int)__builtin_amdgcn_workitem_id_x(); asm volatile("" : "+v"(t)); return t; }
__device__ __forceinline__ int gwave() { return blockIdx.x * (NTHREADS / 64) + (tidx() >> 6); }
__device__ __forceinline__ int nwave() { return gridDim.x * (NTHREADS / 64); }
__device__ __forceinline__ size_t gtid() { return (size_t)blockIdx.x * NTHREADS + tidx(); }
__device__ __forceinline__ size_t gnth() { return (size_t)gridDim.x * NTHREADS; }


__device__ __forceinline__ Params launder(const Params& P) {
    Params Q = P;
    asm volatile("" : "+s"(Q.x), "+s"(Q.norm_mix), "+s"(Q.w_in), "+s"(Q.conv_w), "+s"(Q.pool_w), "+s"(Q.pool_scale), "+s"(Q.q_norm), "+s"(Q.w_uq), "+s"(Q.kv_norm), "+s"(Q.w_uk));
    asm volatile("" : "+s"(Q.w_uv), "+s"(Q.w_out), "+s"(Q.norm_ffn), "+s"(Q.peer_wq), "+s"(Q.peer_subkeys), "+s"(Q.peer_u), "+s"(Q.peer_v), "+s"(Q.norm_final), "+s"(Q.out), "+s"(Q.ws));
    return Q;
}

typedef __attribute__((ext_vector_type(8))) short bf16x8;
typedef __attribute__((ext_vector_type(16))) float f32x16;
typedef __attribute__((ext_vector_type(2))) __bf16 bf2_t;
#define MFMA32(a, b, c) __builtin_amdgcn_mfma_f32_32x32x16_bf16(a, b, c, 0, 0, 0)
__device__ __forceinline__ int crow(int r, int hi) { return (r & 3) + 8 * (r >> 2) + 4 * hi; }
__device__ __forceinline__ float dot2bf(unsigned a, unsigned b, float c) { return __builtin_amdgcn_fdot2_f32_bf16(__builtin_bit_cast(bf2_t, a), __builtin_bit_cast(bf2_t, b), c, false); }
__device__ __forceinline__ unsigned cvtpk(float lo, float hi) { unsigned r; asm("v_cvt_pk_bf16_f32 %0, %1, %2" : "=v"(r) : "v"(lo), "v"(hi)); return r; }
constexpr int G_LDT = 144;
constexpr int G_OPB = 128 * G_LDT;
constexpr int G_BUF = 2 * G_OPB;
constexpr int GEMM_LDS = 2 * G_BUF;
constexpr int LDS_TOTAL = GEMM_LDS + 512;

template <int WT, bool ROWSS>
__device__ __forceinline__ void gemm_kloop(const bf16* __restrict__ Ag0, int lda, const bf16* __restrict__ Bg0, int ldb, int nk, f32x16 (&acc)[4], float (&ss)[4], char* lds, int tid) {
    const int lane = tid & 63, w = tid >> 6, r32 = lane & 31, hi = lane >> 5;
    const int srow = tid >> 3, sch = tid & 7;
    const bf16* Ag = Ag0 + (size_t)srow * lda + sch * 8;
    const bf16* Bg = Bg0 + (size_t)srow * ldb + sch * 8;
#pragma unroll
    for (int i = 0; i < 4; ++i)
#pragma unroll
        for (int r = 0; r < 16; ++r) acc[i][r] = 0.f;
    ss[0] = 0.f; ss[1] = 0.f; ss[2] = 0.f; ss[3] = 0.f;
    uint4 ra0, ra1, ra2, ra3, rb0, rb1, rb2, rb3;
#define G_LOAD(kofs) do { \
    ra0 = *(const uint4*)(Ag + (kofs)); ra1 = *(const uint4*)(Ag + (size_t)32 * lda + (kofs)); ra2 = *(const uint4*)(Ag + (size_t)64 * lda + (kofs)); ra3 = *(const uint4*)(Ag + (size_t)96 * lda + (kofs)); \
    rb0 = *(const uint4*)(Bg + (kofs)); rb1 = *(const uint4*)(Bg + (size_t)32 * ldb + (kofs)); rb2 = *(const uint4*)(Bg + (size_t)64 * ldb + (kofs)); rb3 = *(const uint4*)(Bg + (size_t)96 * ldb + (kofs)); } while (0)
#define G_SS(s_, r_) do { s_ = dot2bf(r_.x, r_.x, s_); s_ = dot2bf(r_.y, r_.y, s_); s_ = dot2bf(r_.z, r_.z, s_); s_ = dot2bf(r_.w, r_.w, s_); } while (0)
    G_LOAD(0);
    for (int kt = 0; kt < nk; ++kt) {
        char* bA = lds + (kt & 1) * G_BUF; char* bB = bA + G_OPB;
        {
            char* wa = bA + srow * G_LDT + sch * 16; char* wb = bB + srow * G_LDT + sch * 16;
            *(uint4*)(wa) = ra0; *(uint4*)(wa + 32 * G_LDT) = ra1; *(uint4*)(wa + 64 * G_LDT) = ra2; *(uint4*)(wa + 96 * G_LDT) = ra3;
            *(uint4*)(wb) = rb0; *(uint4*)(wb + 32 * G_LDT) = rb1; *(uint4*)(wb + 64 * G_LDT) = rb2; *(uint4*)(wb + 96 * G_LDT) = rb3;
            if (ROWSS) { G_SS(ss[0], rb0); G_SS(ss[1], rb1); G_SS(ss[2], rb2); G_SS(ss[3], rb3); }
        }
        __syncthreads();
        if (kt + 1 < nk) G_LOAD((kt + 1) * 64);
        if (WT == 0) {
            const char* pa = bA + ((w >> 1) * 64 + r32) * G_LDT + hi * 16;
            const char* pb = bB + ((w & 1) * 64 + r32) * G_LDT + hi * 16;
#pragma unroll
            for (int ks = 0; ks < 4; ++ks) {
                const bf16x8 a0 = *(const bf16x8*)(pa + ks * 32), a1 = *(const bf16x8*)(pa + 32 * G_LDT + ks * 32);
                const bf16x8 b0 = *(const bf16x8*)(pb + ks * 32), b1 = *(const bf16x8*)(pb + 32 * G_LDT + ks * 32);
                acc[0] = MFMA32(a0, b0, acc[0]); acc[1] = MFMA32(a0, b1, acc[1]);
                acc[2] = MFMA32(a1, b0, acc[2]); acc[3] = MFMA32(a1, b1, acc[3]);
            }
        } else {
            const char* pa = bA + r32 * G_LDT + hi * 16;
            const char* pb = bB + (w * 32 + r32) * G_LDT + hi * 16;
#pragma unroll
            for (int ks = 0; ks < 4; ++ks) {
                const bf16x8 b0 = *(const bf16x8*)(pb + ks * 32);
                const bf16x8 a0 = *(const bf16x8*)(pa + ks * 32), a1 = *(const bf16x8*)(pa + 32 * G_LDT + ks * 32);
                const bf16x8 a2 = *(const bf16x8*)(pa + 64 * G_LDT + ks * 32), a3 = *(const bf16x8*)(pa + 96 * G_LDT + ks * 32);
                acc[0] = MFMA32(a0, b0, acc[0]); acc[1] = MFMA32(a1, b0, acc[1]);
                acc[2] = MFMA32(a2, b0, acc[2]); acc[3] = MFMA32(a3, b0, acc[3]);
            }
        }
    }
#undef G_LOAD
#undef G_SS
}

template <bool ROWSS, class EPI>
__device__ __forceinline__ void gemm_t(const bf16* __restrict__ Wt, int ldw, int N, const bf16* __restrict__ X, int ldx, int M, int K, EPI epi, char* lds) {
    const int tid = tidx(), lane = tid & 63, w = tid >> 6, r32 = lane & 31, hi = lane >> 5;
    const int tilesN = N / 128, tilesM = M / 128, nk = K / 64;
    float* rowss = (float*)(lds + GEMM_LDS);
    for (int tile = blockIdx.x; tile < tilesM * tilesN; tile += gridDim.x) {
        const int tm = tile / tilesN, tn = tile % tilesN;
        f32x16 acc[4]; float ss[4];
        gemm_kloop<0, ROWSS>(Wt + (size_t)(tn * 128) * ldw, ldw, X + (size_t)(tm * 128) * ldx, ldx, nk, acc, ss, lds, tid);
        if (ROWSS) {
#pragma unroll
            for (int i = 0; i < 4; ++i) { float v = ss[i]; v += __shfl_xor(v, 1, 64); v += __shfl_xor(v, 2, 64); v += __shfl_xor(v, 4, 64); if ((tid & 7) == 0) rowss[(tid >> 3) + 32 * i] = v; }
            __syncthreads();
        }
#pragma unroll
        for (int i = 0; i < 2; ++i)
#pragma unroll
            for (int j = 0; j < 2; ++j) {
                const int tl = (w & 1) * 64 + j * 32;
                epi(tn * 128 + (w >> 1) * 64 + i * 32, tm * 128 + tl, acc[i * 2 + j], r32, hi, ROWSS ? rowss[tl + r32] : 0.f);
            }
        __syncthreads();
    }
}

__device__ __forceinline__ void transpose_tiled(const float* __restrict__ W, bf16* __restrict__ Wt, int K, int N, int Npad, const float* __restrict__ gain, char* lds) {
    float (*tl)[65] = (float (*)[65])lds;
    const int tid = tidx(), a = tid & 63, q = tid >> 6;
    const int tK = K / 64, tN = Npad / 64;
    for (int tile = blockIdx.x; tile < tK * tN; tile += gridDim.x) {
        const int k0 = (tile / tN) * 64, n0 = (tile % tN) * 64;
#pragma unroll 4
        for (int i = 0; i < 16; ++i) {
            const int k = k0 + q * 16 + i, n = n0 + a;
            float v = (n < N) ? W[(size_t)k * N + n] : 0.f;
            if (gain) v *= gain[k];
            tl[q * 16 + i][a] = v;
        }
        __syncthreads();
#pragma unroll 4
        for (int i = 0; i < 16; ++i) { const int nl = q * 16 + i; Wt[(size_t)(n0 + nl) * K + k0 + a] = f2bf(tl[a][nl]); }
        __syncthreads();
    }
}

__device__ __forceinline__ void convert_table(const float* __restrict__ src, unsigned char* __restrict__ dst, float* __restrict__ scl, int rows) {
    const int lane = tidx() & 63;
    for (int r = gwave(); r < rows; r += nwave()) {
        const float4* sr = (const float4*)(src + (size_t)r * D);
        if (TAB_FP8) {
            float4 v[4]; float am = 0.f;
#pragma unroll
            for (int j = 0; j < 4; ++j) { v[j] = sr[lane * 4 + j]; am = fmaxf(am, fmaxf(fmaxf(fabsf(v[j].x), fabsf(v[j].y)), fmaxf(fabsf(v[j].z), fabsf(v[j].w)))); }
#pragma unroll
            for (int m = 32; m >= 1; m >>= 1) am = fmaxf(am, __shfl_xor(am, m, 64));
            const float sc = (am > 0.f) ? am * (1.f / 448.f) : 1.f;
            const float is = 1.f / sc;
            uint4 o;
            { int w = 0; w = __builtin_amdgcn_cvt_pk_fp8_f32(v[0].x * is, v[0].y * is, w, false); w = __builtin_amdgcn_cvt_pk_fp8_f32(v[0].z * is, v[0].w * is, w, true); o.x = (unsigned)w; }
            { int w = 0; w = __builtin_amdgcn_cvt_pk_fp8_f32(v[1].x * is, v[1].y * is, w, false); w = __builtin_amdgcn_cvt_pk_fp8_f32(v[1].z * is, v[1].w * is, w, true); o.y = (unsigned)w; }
            { int w = 0; w = __builtin_amdgcn_cvt_pk_fp8_f32(v[2].x * is, v[2].y * is, w, false); w = __builtin_amdgcn_cvt_pk_fp8_f32(v[2].z * is, v[2].w * is, w, true); o.z = (unsigned)w; }
            { int w = 0; w = __builtin_amdgcn_cvt_pk_fp8_f32(v[3].x * is, v[3].y * is, w, false); w = __builtin_amdgcn_cvt_pk_fp8_f32(v[3].z * is, v[3].w * is, w, true); o.w = (unsigned)w; }
            *(uint4*)(dst + (size_t)r * 1024 + lane * 16) = o;
            if (lane == 0) scl[r] = sc;
        } else {
#pragma unroll
            for (int j = 0; j < 2; ++j) {
                const float4 a = sr[j * 128 + lane * 2], b = sr[j * 128 + lane * 2 + 1];
                uint4 o; o.x = pack2(a.x, a.y); o.y = pack2(a.z, a.w); o.z = pack2(b.x, b.y); o.w = pack2(b.z, b.w);
                *(uint4*)(dst + (size_t)r * 2048 + j * 1024 + lane * 16) = o;
            }
        }
    }
}
__device__ __forceinline__ void phase_prep(const Params& P, char* lds) {
    unsigned char* ws = P.ws;
    for (int l = 0; l < DEPTH; ++l) {
        transpose_tiled(P.w_in + (size_t)l * D * DIN, (bf16*)(ws + WS_WIN) + (size_t)l * DINP * D, D, DIN, DINP, nullptr, lds);
        transpose_tiled(P.w_uq + (size_t)l * QR * 768, (bf16*)(ws + WS_WUQ) + (size_t)l * 768 * QR, QR, 768, 768, P.q_norm + l * QR, lds);
        transpose_tiled(P.w_uk + (size_t)l * KVR * 512, (bf16*)(ws + WS_WUKV) + (size_t)l * 1024 * KVR, KVR, 512, 512, P.kv_norm + l * KVR, lds);
        transpose_tiled(P.w_uv + (size_t)l * KVR * 512, (bf16*)(ws + WS_WUKV) + (size_t)l * 1024 * KVR + (size_t)512 * KVR, KVR, 512, 512, P.kv_norm + l * KVR, lds);
        transpose_tiled(P.w_out + (size_t)l * D * D, (bf16*)(ws + WS_WOUT) + (size_t)l * D * D, D, D, D, nullptr, lds);
    }
    {
        bf16* Wc = (bf16*)(ws + WS_WPQ);
        const size_t tot = (size_t)DEPTH * 2048 * D;
        for (size_t i = gtid(); i < tot; i += gnth()) {
            const int k = (int)(i & (D - 1)); const int row = (int)(i >> 10);
            const int l = row >> 11, hp = (row >> 7) & 15, n = row & 127;
            const float4* wq = (const float4*)(P.peer_wq + ((size_t)l * D + k) * 2048 + hp * 128);
            const float4* sk = (const float4*)(P.peer_subkeys + (((size_t)l * 2 + (hp & 1)) * NKEY + n) * 128);
            float s0 = 0.f, s1 = 0.f, s2 = 0.f, s3 = 0.f;
            for (int d = 0; d < 32; ++d) { const float4 a = wq[d], b = sk[d]; s0 = fmaf(a.x, b.x, s0); s1 = fmaf(a.y, b.y, s1); s2 = fmaf(a.z, b.z, s2); s3 = fmaf(a.w, b.w, s3); }
            Wc[i] = f2bf((s0 + s1) + (s2 + s3));
        }
    }
    convert_table(P.peer_u, ws + WS_TABU, (float*)(ws + WS_TSCU), DEPTH * NEXP);
    convert_table(P.peer_v, ws + WS_TABV, (float*)(ws + WS_TSCV), DEPTH * NEXP);
    float* rope = (float*)(ws + WS_ROPE);
    for (size_t i = gtid(); i < (size_t)S * 16; i += gnth()) {
        const int s = (int)(i >> 4), f = (int)(i & 15);
        const double inv = pow(10000.0, -(double)f / 16.0);
        const double ang = (double)s * inv;
        rope[2 * i] = (float)cos(ang); rope[2 * i + 1] = (float)sin(ang);
    }
}

__device__ __forceinline__ void phase_norm(const float* __restrict__ h, const float* __restrict__ g, bf16* __restrict__ xn) {
    const int lane = tidx() & 63;
    for (int t = gwave(); t < T; t += nwave()) {
        const float4* hr = (const float4*)(h + (size_t)t * D);
        float4 v[4]; float ss = 0.f;
#pragma unroll
        for (int j = 0; j < 4; ++j) { v[j] = hr[j * 64 + lane]; ss += v[j].x * v[j].x + v[j].y * v[j].y + v[j].z * v[j].z + v[j].w * v[j].w; }
        ss = wave_sum(ss);
        const float r = rsqrtf(ss * (1.f / D) + EPS);
#pragma unroll
        for (int j = 0; j < 4; ++j) {
            const float4 gg = ((const float4*)g)[j * 64 + lane];
            uint2 o; o.x = pack2(v[j].x * r * gg.x, v[j].y * r * gg.y); o.y = pack2(v[j].z * r * gg.z, v[j].w * r * gg.w);
            ((uint2*)(xn + (size_t)t * D))[j * 64 + lane] = o;
        }
    }
}

__device__ __forceinline__ void phase_mixlocal(const Params& P, int l, char* lds) {
    const bf16* proj = (const bf16*)(P.ws + WS_PROJ);
    bf16* Y = (bf16*)(P.ws + WS_XN);
    const int tid = tidx();
    {
        const float* cw = P.conv_w + (size_t)l * 3 * 256;
        for (size_t i = gtid(); i < (size_t)T * 32; i += gnth()) {
            const int t = (int)(i >> 5), c0 = (int)(i & 31) * 8, s = t & (S - 1);
            const bf16* pr = proj + (size_t)t * DINP;
            float acc[8];
#pragma unroll
            for (int e = 0; e < 8; ++e) acc[e] = 0.f;
#pragma unroll
            for (int j = 0; j < 3; ++j) {
                if (s - 2 + j >= 0) {
                    const bf16* pp = pr - (size_t)(2 - j) * DINP;
                    const uint4 g = *(const uint4*)(pp + C_CG + c0), hc = *(const uint4*)(pp + C_HC + c0);
                    const float4 w0 = *(const float4*)(cw + j * 256 + c0), w1 = *(const float4*)(cw + j * 256 + c0 + 4);
                    acc[0] = fmaf(w0.x, bflo(g.x) * bflo(hc.x), acc[0]); acc[1] = fmaf(w0.y, bfhi(g.x) * bfhi(hc.x), acc[1]);
                    acc[2] = fmaf(w0.z, bflo(g.y) * bflo(hc.y), acc[2]); acc[3] = fmaf(w0.w, bfhi(g.y) * bfhi(hc.y), acc[3]);
                    acc[4] = fmaf(w1.x, bflo(g.z) * bflo(hc.z), acc[4]); acc[5] = fmaf(w1.y, bfhi(g.z) * bfhi(hc.z), acc[5]);
                    acc[6] = fmaf(w1.z, bflo(g.w) * bflo(hc.w), acc[6]); acc[7] = fmaf(w1.w, bfhi(g.w) * bfhi(hc.w), acc[7]);
                }
            }
            const uint4 bg = *(const uint4*)(pr + C_BG + c0);
            uint4 o;
            o.x = pack2(bflo(bg.x) * acc[0], bfhi(bg.x) * acc[1]); o.y = pack2(bflo(bg.y) * acc[2], bfhi(bg.y) * acc[3]);
            o.z = pack2(bflo(bg.z) * acc[4], bfhi(bg.z) * acc[5]); o.w = pack2(bflo(bg.w) * acc[6], bfhi(bg.w) * acc[7]);
            *(uint4*)(Y + (size_t)t * D + c0) = o;
        }
    }
    {
        float (*pl)[68] = (float (*)[68])lds;
        const float* pw = P.pool_w + (size_t)l * 4 * 64 * 64;
        const float* psc = P.pool_scale + l * 256;
        const int a = tid & 63, q = tid >> 6;
        for (int tile = blockIdx.x; tile < (T / 64) * 4; tile += gridDim.x) {
            const int g = tile & 3, t0 = (tile >> 2) * 64;
            const int w = 2 << g;
            {
                const bf16* col = proj + C_HP + g * 64 + a;
                const int tf = t0 + q * 16, sf = tf & (S - 1);
                float sum = 0.f;
                for (int d = 1; d < w; ++d) if (sf - d >= 0) sum += bf2f(col[(size_t)(tf - d) * DINP]);
#pragma unroll 4
                for (int i = 0; i < 16; ++i) {
                    const int s = sf + i;
                    const float xv = bf2f(col[(size_t)(tf + i) * DINP]);
                    sum += xv;
                    const int cnt = (s + 1 < w) ? (s + 1) : w;
                    pl[q * 16 + i][a] = sum / (float)cnt - xv;
                    if (s - w + 1 >= 0) sum -= bf2f(col[(size_t)(tf + i - w + 1) * DINP]);
                }
            }
            __syncthreads();
            {
                float pc[64];
#pragma unroll
                for (int c = 0; c < 64; ++c) pc[c] = pw[(g * 64 + c) * 64 + a];
                const float sc = psc[g * 64 + a];
#pragma unroll 2
                for (int i = 0; i < 16; ++i) {
                    const float4* row = (const float4*)&pl[q * 16 + i][0];
                    float m0 = 0.f, m1 = 0.f;
#pragma unroll
                    for (int c4 = 0; c4 < 16; ++c4) { const float4 v = row[c4]; m0 = fmaf(v.x, pc[4 * c4], m0); m1 = fmaf(v.y, pc[4 * c4 + 1], m1); m0 = fmaf(v.z, pc[4 * c4 + 2], m0); m1 = fmaf(v.w, pc[4 * c4 + 3], m1); }
                    Y[(size_t)(t0 + q * 16 + i) * D + 256 + g * 64 + a] = f2bf((m0 + m1) * sc);
                }
            }
            __syncthreads();
        }
    }
}

typedef short v4i16_t __attribute__((ext_vector_type(4)));
typedef __attribute__((address_space(3))) v4i16_t* lds_v4p;
__device__ __forceinline__ v4i16_t vtr(const char* p) { return __builtin_amdgcn_ds_read_tr16_b64_v4i16((lds_v4p)p); }
constexpr int A_KP = 208, A_VP = 192;
constexpr int A_KB = 64 * A_KP, A_VB = 64 * A_VP, A_BUF = A_KB + A_VB, ATTN_LDS = 2 * A_BUF;
static_assert(ATTN_LDS <= GEMM_LDS, "attention LDS");

__device__ __forceinline__ void attn_unit(const bf16* __restrict__ Qb, const bf16* __restrict__ Kb, const bf16* __restrict__ Vb, bf16* __restrict__ Y, int bh, int qblk, char* lds) {
    const int tid = tidx(), lane = tid & 63, w = tid >> 6, r32 = lane & 31, hi = lane >> 5;
    const int q0 = qblk * 128, qw0 = q0 + w * 32;
    const int NT = 2 * qblk + 2;
    bf16x8 qf[6];
    {
        const bf16* qp = Qb + ((size_t)bh * S + qw0 + r32) * DQK + hi * 8;
#pragma unroll
        for (int ks = 0; ks < 6; ++ks) qf[ks] = *(const bf16x8*)(qp + ks * 16);
    }
    f32x16 o0, o1;
#pragma unroll
    for (int r = 0; r < 16; ++r) { o0[r] = 0.f; o1[r] = 0.f; }
    float m = -1e30f, lsum = 0.f;
    const char* Kg = (const char*)(Kb + (size_t)bh * S * DQK) + tid * 16;
    const char* Vg = (const char*)(Vb + (size_t)bh * S * DV) + tid * 16;
    const int kl0 = (tid / 12) * A_KP + (tid % 12) * 16, kl1 = ((tid + 256) / 12) * A_KP + ((tid + 256) % 12) * 16, kl2 = ((tid + 512) / 12) * A_KP + ((tid + 512) % 12) * 16;
    const int vl0 = (tid >> 3) * A_VP + (tid & 7) * 16, vl1 = vl0 + 32 * A_VP;
    uint4 k0, k1, k2, v0, v1;
#define A_LOAD(t) do { const char* kg = Kg + (size_t)(t) * (64 * 192); const char* vg = Vg + (size_t)(t) * (64 * 128); \
        k0 = *(const uint4*)(kg); k1 = *(const uint4*)(kg + 4096); k2 = *(const uint4*)(kg + 8192); v0 = *(const uint4*)(vg); v1 = *(const uint4*)(vg + 4096); } while (0)
    A_LOAD(0);
    const int pvo = (4 * hi + ((lane & 15) >> 2)) * A_VP + (16 * ((lane >> 4) & 1) + 4 * (lane & 3)) * 2;
    for (int t = 0; t < NT; ++t) {
        char* bK = lds + (t & 1) * A_BUF; char* bV = bK + A_KB;
        *(uint4*)(bK + kl0) = k0; *(uint4*)(bK + kl1) = k1; *(uint4*)(bK + kl2) = k2; *(uint4*)(bV + vl0) = v0; *(uint4*)(bV + vl1) = v1;
        __syncthreads();
        if (t + 1 < NT) A_LOAD(t + 1);
        const int kt0 = t * 64;
        if (kt0 <= qw0) {
            f32x16 s0, s1;
#pragma unroll
            for (int r = 0; r < 16; ++r) { s0[r] = 0.f; s1[r] = 0.f; }
            const char* pk = bK + r32 * A_KP + hi * 16;
#pragma unroll
            for (int ks = 0; ks < 6; ++ks) {
                const bf16x8 a0 = *(const bf16x8*)(pk + ks * 32), a1 = *(const bf16x8*)(pk + 32 * A_KP + ks * 32);
                s0 = MFMA32(a0, qf[ks], s0); s1 = MFMA32(a1, qf[ks], s1);
            }
            if (kt0 + 63 > qw0) {
                const int qrow = qw0 + r32;
#pragma unroll
                for (int r = 0; r < 16; ++r) { const int key = kt0 + crow(r, hi); if (key > qrow) s0[r] = -INFINITY; if (key + 32 > qrow) s1[r] = -INFINITY; }
            }
            float mx = fmaxf(s0[0], s1[0]);
#pragma unroll
            for (int r = 1; r < 16; ++r) mx = fmaxf(mx, fmaxf(s0[r], s1[r]));
            mx = fmaxf(mx, __shfl_xor(mx, 32, 64));
            const float mn = fmaxf(m, mx);
            const float alpha = __builtin_amdgcn_exp2f(m - mn);
            m = mn;
            float ps = 0.f;
#pragma unroll
            for (int r = 0; r < 16; ++r) { s0[r] = __builtin_amdgcn_exp2f(s0[r] - mn); s1[r] = __builtin_amdgcn_exp2f(s1[r] - mn); ps += s0[r] + s1[r]; }
            lsum = lsum * alpha + ps;
#pragma unroll
            for (int r = 0; r < 16; ++r) { o0[r] *= alpha; o1[r] *= alpha; }
            union { unsigned u[4]; bf16x8 v; } p00, p01, p10, p11;
#pragma unroll
            for (int j = 0; j < 4; ++j) { p00.u[j] = cvtpk(s0[2 * j], s0[2 * j + 1]); p01.u[j] = cvtpk(s0[8 + 2 * j], s0[9 + 2 * j]); p10.u[j] = cvtpk(s1[2 * j], s1[2 * j + 1]); p11.u[j] = cvtpk(s1[8 + 2 * j], s1[9 + 2 * j]); }
            const char* pv = bV + pvo;
#define A_PV(pf, kofs) do { \
            { const v4i16_t lo = vtr(pv + (kofs) * A_VP), hh = vtr(pv + ((kofs) + 8) * A_VP); const bf16x8 vf = {lo[0], lo[1], lo[2], lo[3], hh[0], hh[1], hh[2], hh[3]}; o0 = MFMA32(vf, pf.v, o0); } \
            { const v4i16_t lo = vtr(pv + (kofs) * A_VP + 64), hh = vtr(pv + ((kofs) + 8) * A_VP + 64); const bf16x8 vf = {lo[0], lo[1], lo[2], lo[3], hh[0], hh[1], hh[2], hh[3]}; o1 = MFMA32(vf, pf.v, o1); } } while (0)
            A_PV(p00, 0); A_PV(p01, 16); A_PV(p10, 32); A_PV(p11, 48);
        }
    }
    lsum += __shfl_xor(lsum, 32, 64);
    const float inv = 1.f / lsum;
    const int b = bh >> 3, h = bh & 7;
    bf16* yo = Y + (size_t)(b * S + qw0 + r32) * D + 512 + h * 64 + 4 * hi;
#pragma unroll
    for (int g = 0; g < 4; ++g) {
        uint2 a, c;
        a.x = cvtpk(o0[4 * g] * inv, o0[4 * g + 1] * inv); a.y = cvtpk(o0[4 * g + 2] * inv, o0[4 * g + 3] * inv);
        c.x = cvtpk(o1[4 * g] * inv, o1[4 * g + 1] * inv); c.y = cvtpk(o1[4 * g + 2] * inv, o1[4 * g + 3] * inv);
        *(uint2*)(yo + 8 * g) = a; *(uint2*)(yo + 32 + 8 * g) = c;
    }
    __syncthreads();
}
__device__ __forceinline__ void phase_attn(const Params& P, char* lds) {
    const bf16* Qb = (const bf16*)(P.ws + WS_Q);
    const bf16* Kb = (const bf16*)(P.ws + WS_K);
    const bf16* Vb = (const bf16*)(P.ws + WS_V);
    bf16* Y = (bf16*)(P.ws + WS_XN);
    for (int u = blockIdx.x; u < NB * NH * (S / 128); u += gridDim.x) {
        const int bh = u & 31, v = u >> 5;
        const int qblk = (v < 16) ? (63 - v) : (v < 32) ? (v - 16) : (v < 48) ? (79 - v) : (v - 32);
        attn_unit(Qb, Kb, Vb, Y, bh, qblk, lds);
    }
}

#define NET_HD __device__ __forceinline__
#define NET_U2F(u) __uint_as_float(u)
#define NET_F2U(f) __float_as_uint(f)
#define CE_DESC(a, b) do { const float hi__ = fmaxf(a, b), lo__ = fminf(a, b); a = hi__; b = lo__; } while (0)
NET_HD void sort16_desc(float (&v)[16]) {
#pragma unroll
    for (int k = 2; k <= 16; k <<= 1) {
#pragma unroll
        for (int j = k >> 1; j > 0; j >>= 1) {
#pragma unroll
            for (int i = 0; i < 16; ++i) {
                const int l = i ^ j;
                if (l > i) { if ((i & k) == 0) CE_DESC(v[i], v[l]); else CE_DESC(v[l], v[i]); }
            }
        }
    }
}
NET_HD void merge16_desc(float (&a)[16], const float (&b)[16]) {
#pragma unroll
    for (int i = 0; i < 16; ++i) a[i] = fmaxf(a[i], b[15 - i]);
#pragma unroll
    for (int j = 8; j > 0; j >>= 1) {
#pragma unroll
        for (int i = 0; i < 16; ++i) { const int l = i ^ j; if (l > i) CE_DESC(a[i], a[l]); }
    }
}
NET_HD void top16_of_64(float (&g0)[16], float (&g1)[16], float (&g2)[16], float (&g3)[16]) {
    sort16_desc(g0); sort16_desc(g1); sort16_desc(g2); sort16_desc(g3);
    merge16_desc(g0, g1); merge16_desc(g2, g3); merge16_desc(g0, g2);
}
NET_HD float u2f(unsigned u) { return NET_U2F(u); }
NET_HD unsigned f2u(float f) { return NET_F2U(f); }
template <class V16>
NET_HD void lane_top16(const V16& s0, const V16& s1, const V16& s2, const V16& s3, int hi, float (&out)[16]) {
    float g0[16], g1[16], g2[16], g3[16];
#pragma unroll
    for (int r = 0; r < 16; ++r) {
        const unsigned nb = (unsigned)((r & 3) + 8 * (r >> 2));
        g0[r] = u2f((f2u(s0[r]) & 0xFFFFFF80u) | nb); g1[r] = u2f((f2u(s1[r]) & 0xFFFFFF80u) | (nb + 32u));
        g2[r] = u2f((f2u(s2[r]) & 0xFFFFFF80u) | (nb + 64u)); g3[r] = u2f((f2u(s3[r]) & 0xFFFFFF80u) | (nb + 96u));
    }
    top16_of_64(g0, g1, g2, g3);
    const unsigned h4 = (unsigned)hi << 2;
#pragma unroll
    for (int i = 0; i < 16; ++i) out[i] = u2f(f2u(g0[i]) | h4);
}
constexpr int cand_slot(int a, int b) { int n = 0; for (int x = 0; x < 16; ++x) for (int y = 0; y < 16; ++y) { if (x == a && y == b) return n; if ((x + 1) * (y + 1) <= 16) ++n; } return n; }
NET_HD void cand_top16(const float (&s1)[16], const float (&s2)[16], float (&c)[16]) {
    float g0[16], g1[16], g2[16], g3[16];
#pragma unroll
    for (int i = 0; i < 16; ++i) { g0[i] = -3.0e38f; g1[i] = -3.0e38f; g2[i] = -3.0e38f; g3[i] = -3.0e38f; }
#pragma unroll
    for (int a = 0; a < 16; ++a) {
#pragma unroll
        for (int b = 0; b < 16; ++b) {
            if ((a + 1) * (b + 1) <= 16) {
                const int sl = cand_slot(a, b);
                const float v = u2f((f2u(s1[a] + s2[b]) & 0xFFFFFF00u) | (unsigned)(a * 16 + b));
                if (sl < 16) g0[sl & 15] = v; else if (sl < 32) g1[sl & 15] = v; else if (sl < 48) g2[sl & 15] = v; else g3[sl & 15] = v;
            }
        }
    }
    top16_of_64(g0, g1, g2, g3);
#pragma unroll
    for (int i = 0; i < 16; ++i) c[i] = g0[i];
}

__device__ __forceinline__ void phase_route(const Params& P, int l, char* lds) {
    const bf16* XN = (const bf16*)(P.ws + WS_XN);
    const bf16* Wc = (const bf16*)(P.ws + WS_WPQ) + (size_t)l * 2048 * D;
    int* EXPp = (int*)(P.ws + WS_EXP);
    float* GATEp = (float*)(P.ws + WS_GATE);
    const int tid = tidx(), lane = tid & 63, w = tid >> 6, r32 = lane & 31, hi = lane >> 5;
    for (int u = blockIdx.x; u < (T / 128) * PH; u += gridDim.x) {
        const int tm = u >> 3, h = u & 7;
        float L0[16], L1[16];
        {
            f32x16 acc[4]; float ssd[4];
            gemm_kloop<1, false>(Wc + (size_t)((h * 2 + 0) * 128) * D, D, XN + (size_t)(tm * 128) * D, D, D / 64, acc, ssd, lds, tid);
            lane_top16(acc[0], acc[1], acc[2], acc[3], hi, L0);
            float o[16];
#pragma unroll
            for (int i = 0; i < 16; ++i) o[i] = __shfl_xor(L0[i], 32, 64);
            merge16_desc(L0, o);
        }
        {
            f32x16 acc[4]; float ssd[4];
            gemm_kloop<1, false>(Wc + (size_t)((h * 2 + 1) * 128) * D, D, XN + (size_t)(tm * 128) * D, D, D / 64, acc, ssd, lds, tid);
            lane_top16(acc[0], acc[1], acc[2], acc[3], hi, L1);
            float o[16];
#pragma unroll
            for (int i = 0; i < 16; ++i) o[i] = __shfl_xor(L1[i], 32, 64);
            merge16_desc(L1, o);
        }
        float c[16];
        cand_top16(L0, L1, c);
        __syncthreads();
        unsigned char* my = (unsigned char*)lds + tid * 32;
        {
            uint4 a, b;
#define PK4(L, i) ((__float_as_uint(L[i]) & 127u) | ((__float_as_uint(L[i + 1]) & 127u) << 8) | ((__float_as_uint(L[i + 2]) & 127u) << 16) | ((__float_as_uint(L[i + 3]) & 127u) << 24))
            a.x = PK4(L0, 0); a.y = PK4(L0, 4); a.z = PK4(L0, 8); a.w = PK4(L0, 12);
            b.x = PK4(L1, 0); b.y = PK4(L1, 4); b.z = PK4(L1, 8); b.w = PK4(L1, 12);
#undef PK4
            *(uint4*)my = a; *(uint4*)(my + 16) = b;
        }
        int ev[16]; float gv[16]; float den = 0.f;
#pragma unroll
        for (int k = 0; k < 16; ++k) {
            const unsigned ci = __float_as_uint(c[k]) & 255u;
            const int n1 = my[ci >> 4], n2 = my[16 + (ci & 15)];
            ev[k] = n1 * NKEY + n2;
            gv[k] = __expf(c[k] - c[0]); den += gv[k];
        }
        const float iden = 1.f / den;
        if (hi == 0) {
            const int t = tm * 128 + w * 32 + r32;
            uint4* ep = (uint4*)(EXPp + (size_t)t * HK + h * 16);
            float4* gp = (float4*)(GATEp + (size_t)t * HK + h * 16);
#pragma unroll
            for (int q = 0; q < 4; ++q) {
                ep[q] = make_uint4((unsigned)ev[4 * q], (unsigned)ev[4 * q + 1], (unsigned)ev[4 * q + 2], (unsigned)ev[4 * q + 3]);
                gp[q] = make_float4(gv[4 * q] * iden, gv[4 * q + 1] * iden, gv[4 * q + 2] * iden, gv[4 * q + 3] * iden);
            }
        }
        __syncthreads();
    }
}

__device__ __forceinline__ float red16(float (&p)[16], int lane) {
#pragma unroll
    for (int i = 0; i < 8; ++i) { const bool up = lane & 32; const float send = up ? p[i] : p[i + 8], keep = up ? p[i + 8] : p[i]; p[i] = keep + __shfl_xor(send, 32, 64); }
#pragma unroll
    for (int i = 0; i < 4; ++i) { const bool up = lane & 16; const float send = up ? p[i] : p[i + 4], keep = up ? p[i + 4] : p[i]; p[i] = keep + __shfl_xor(send, 16, 64); }
#pragma unroll
    for (int i = 0; i < 2; ++i) { const bool up = lane & 8; const float send = up ? p[i] : p[i + 2], keep = up ? p[i + 2] : p[i]; p[i] = keep + __shfl_xor(send, 8, 64); }
    { const bool up = lane & 4; const float send = up ? p[0] : p[1], keep = up ? p[1] : p[0]; p[0] = keep + __shfl_xor(send, 4, 64); }
    float r = p[0];
    r += __shfl_xor(r, 2, 64); r += __shfl_xor(r, 1, 64);
    return r;
}

__device__ __forceinline__ void phase_gather(const Params& P, int l) {
    const bf16* XN = (const bf16*)(P.ws + WS_XN);
    bf16* XNw = (bf16*)(P.ws + WS_XN);
    const int* EXPp = (const int*)(P.ws + WS_EXP);
    const float* GATEp = (const float*)(P.ws + WS_GATE);
    const unsigned char* U = P.ws + WS_TABU + (size_t)l * NEXP * TAB_ROWB;
    const unsigned char* V = P.ws + WS_TABV + (size_t)l * NEXP * TAB_ROWB;
    const float* SU = (const float*)(P.ws + WS_TSCU) + (size_t)l * NEXP;
    const float* SV = (const float*)(P.ws + WS_TSCV) + (size_t)l * NEXP;
    const int lane = tidx() & 63;
    for (int t = gwave(); t < T; t += nwave()) {
        const int e_lo = EXPp[(size_t)t * HK + lane], e_hi = EXPp[(size_t)t * HK + 64 + lane];
#if TAB_FP8
        float xf[16];
        {
            const uint4 a = ((const uint4*)(XN + (size_t)t * D))[lane * 2], b = ((const uint4*)(XN + (size_t)t * D))[lane * 2 + 1];
            xf[0] = bflo(a.x); xf[1] = bfhi(a.x); xf[2] = bflo(a.y); xf[3] = bfhi(a.y); xf[4] = bflo(a.z); xf[5] = bfhi(a.z); xf[6] = bflo(a.w); xf[7] = bfhi(a.w);
            xf[8] = bflo(b.x); xf[9] = bfhi(b.x); xf[10] = bflo(b.y); xf[11] = bfhi(b.y); xf[12] = bflo(b.z); xf[13] = bfhi(b.z); xf[14] = bflo(b.w); xf[15] = bfhi(b.w);
        }
#else
        const uint4 xa = ((const uint4*)(XN + (size_t)t * D))[lane], xb = ((const uint4*)(XN + (size_t)t * D))[64 + lane];
#endif
        float acc[16];
#pragma unroll
        for (int i = 0; i < 16; ++i) acc[i] = 0.f;
        for (int c = 0; c < 8; ++c) {
            const int esel = (c < 4) ? e_lo : e_hi;
            const int kb = (c & 3) * 16;
            float part[16];
#pragma unroll
            for (int hb = 0; hb < 2; ++hb) {
#if TAB_FP8
                uint4 r[8];
#pragma unroll
                for (int i = 0; i < 8; ++i) { const int e = __builtin_amdgcn_readlane(esel, kb + hb * 8 + i); r[i] = *(const uint4*)(U + (size_t)e * 1024 + lane * 16); }
#pragma unroll
                for (int i = 0; i < 8; ++i) {
                    float d0 = 0.f, d1 = 0.f;
                    const unsigned w[4] = {r[i].x, r[i].y, r[i].z, r[i].w};
#pragma unroll
                    for (int q = 0; q < 4; ++q) {
                        const auto lo = __builtin_amdgcn_cvt_pk_f32_fp8((int)w[q], false); const auto hh = __builtin_amdgcn_cvt_pk_f32_fp8((int)w[q], true);
                        d0 = fmaf(xf[4 * q], lo[0], d0); d1 = fmaf(xf[4 * q + 1], lo[1], d1); d0 = fmaf(xf[4 * q + 2], hh[0], d0); d1 = fmaf(xf[4 * q + 3], hh[1], d1);
                    }
                    part[hb * 8 + i] = d0 + d1;
                }
#else
                uint4 r0[8], r1[8];
#pragma unroll
                for (int i = 0; i < 8; ++i) { const int e = __builtin_amdgcn_readlane(esel, kb + hb * 8 + i); const unsigned char* rp = U + (size_t)e * 2048 + lane * 16; r0[i] = *(const uint4*)(rp); r1[i] = *(const uint4*)(rp + 1024); }
#pragma unroll
                for (int i = 0; i < 8; ++i) {
                    float d0 = 0.f, d1 = 0.f;
                    d0 = dot2bf(xa.x, r0[i].x, d0); d1 = dot2bf(xa.y, r0[i].y, d1); d0 = dot2bf(xa.z, r0[i].z, d0); d1 = dot2bf(xa.w, r0[i].w, d1);
                    d0 = dot2bf(xb.x, r1[i].x, d0); d1 = dot2bf(xb.y, r1[i].y, d1); d0 = dot2bf(xb.z, r1[i].z, d0); d1 = dot2bf(xb.w, r1[i].w, d1);
                    part[hb * 8 + i] = d0 + d1;
                }
#endif
            }
            float dsum = red16(part, lane);
            const int kk = c * 16 + (lane >> 2);
            const int eme = __shfl(esel, kb + (lane >> 2), 64);
            float wv = GATEp[(size_t)t * HK + kk];
#if TAB_FP8
            dsum *= SU[eme];
            wv *= SV[eme];
#endif
            wv *= gelu_exact(dsum);
#pragma unroll
            for (int hb = 0; hb < 2; ++hb) {
#if TAB_FP8
                uint4 r[8];
#pragma unroll
                for (int i = 0; i < 8; ++i) { const int e = __builtin_amdgcn_readlane(esel, kb + hb * 8 + i); r[i] = *(const uint4*)(V + (size_t)e * 1024 + lane * 16); }
#pragma unroll
                for (int i = 0; i < 8; ++i) {
                    const float w = __int_as_float(__builtin_amdgcn_readlane(__float_as_int(wv), (hb * 8 + i) * 4));
                    const unsigned ww[4] = {r[i].x, r[i].y, r[i].z, r[i].w};
#pragma unroll
                    for (int q = 0; q < 4; ++q) {
                        const auto lo = __builtin_amdgcn_cvt_pk_f32_fp8((int)ww[q], false); const auto hh = __builtin_amdgcn_cvt_pk_f32_fp8((int)ww[q], true);
                        acc[4 * q] = fmaf(w, lo[0], acc[4 * q]); acc[4 * q + 1] = fmaf(w, lo[1], acc[4 * q + 1]); acc[4 * q + 2] = fmaf(w, hh[0], acc[4 * q + 2]); acc[4 * q + 3] = fmaf(w, hh[1], acc[4 * q + 3]);
                    }
                }
#else
                uint4 r0[8], r1[8];
#pragma unroll
                for (int i = 0; i < 8; ++i) { const int e = __builtin_amdgcn_readlane(esel, kb + hb * 8 + i); const unsigned char* rp = V + (size_t)e * 2048 + lane * 16; r0[i] = *(const uint4*)(rp); r1[i] = *(const uint4*)(rp + 1024); }
#pragma unroll
                for (int i = 0; i < 8; ++i) {
                    const float w = __int_as_float(__builtin_amdgcn_readlane(__float_as_int(wv), (hb * 8 + i) * 4));
                    acc[0] = fmaf(w, bflo(r0[i].x), acc[0]); acc[1] = fmaf(w, bfhi(r0[i].x), acc[1]); acc[2] = fmaf(w, bflo(r0[i].y), acc[2]); acc[3] = fmaf(w, bfhi(r0[i].y), acc[3]);
                    acc[4] = fmaf(w, bflo(r0[i].z), acc[4]); acc[5] = fmaf(w, bfhi(r0[i].z), acc[5]); acc[6] = fmaf(w, bflo(r0[i].w), acc[6]); acc[7] = fmaf(w, bfhi(r0[i].w), acc[7]);
                    acc[8] = fmaf(w, bflo(r1[i].x), acc[8]); acc[9] = fmaf(w, bfhi(r1[i].x), acc[9]); acc[10] = fmaf(w, bflo(r1[i].y), acc[10]); acc[11] = fmaf(w, bfhi(r1[i].y), acc[11]);
                    acc[12] = fmaf(w, bflo(r1[i].z), acc[12]); acc[13] = fmaf(w, bfhi(r1[i].z), acc[13]); acc[14] = fmaf(w, bflo(r1[i].w), acc[14]); acc[15] = fmaf(w, bfhi(r1[i].w), acc[15]);
                }
#endif
            }
        }
        float* hrow = P.out + (size_t)t * D;
#if TAB_FP8
        const int c0 = lane * 16, c1 = lane * 16 + 8;
#else
        const int c0 = lane * 8, c1 = 512 + lane * 8;
#endif
        float4 h0 = *(const float4*)(hrow + c0), h1 = *(const float4*)(hrow + c0 + 4), h2 = *(const float4*)(hrow + c1), h3 = *(const float4*)(hrow + c1 + 4);
        h0.x += acc[0]; h0.y += acc[1]; h0.z += acc[2]; h0.w += acc[3]; h1.x += acc[4]; h1.y += acc[5]; h1.z += acc[6]; h1.w += acc[7];
        h2.x += acc[8]; h2.y += acc[9]; h2.z += acc[10]; h2.w += acc[11]; h3.x += acc[12]; h3.y += acc[13]; h3.z += acc[14]; h3.w += acc[15];
        float ss = h0.x * h0.x + h0.y * h0.y + h0.z * h0.z + h0.w * h0.w + h1.x * h1.x + h1.y * h1.y + h1.z * h1.z + h1.w * h1.w
                 + h2.x * h2.x + h2.y * h2.y + h2.z * h2.z + h2.w * h2.w + h3.x * h3.x + h3.y * h3.y + h3.z * h3.z + h3.w * h3.w;
        ss = wave_sum(ss);
        const float rn = rsqrtf(ss * (1.f / D) + EPS);
        if (l == DEPTH - 1) {
            const float* g = P.norm_final;
            const float4 g0 = *(const float4*)(g + c0), g1 = *(const float4*)(g + c0 + 4), g2 = *(const float4*)(g + c1), g3 = *(const float4*)(g + c1 + 4);
            *(float4*)(hrow + c0) = make_float4(h0.x * rn * g0.x, h0.y * rn * g0.y, h0.z * rn * g0.z, h0.w * rn * g0.w);
            *(float4*)(hrow + c0 + 4) = make_float4(h1.x * rn * g1.x, h1.y * rn * g1.y, h1.z * rn * g1.z, h1.w * rn * g1.w);
            *(float4*)(hrow + c1) = make_float4(h2.x * rn * g2.x, h2.y * rn * g2.y, h2.z * rn * g2.z, h2.w * rn * g2.w);
            *(float4*)(hrow + c1 + 4) = make_float4(h3.x * rn * g3.x, h3.y * rn * g3.y, h3.z * rn * g3.z, h3.w * rn * g3.w);
        } else {
            *(float4*)(hrow + c0) = h0; *(float4*)(hrow + c0 + 4) = h1; *(float4*)(hrow + c1) = h2; *(float4*)(hrow + c1 + 4) = h3;
            const float* g = P.norm_mix + (l + 1) * D;
            const float4 g0 = *(const float4*)(g + c0), g1 = *(const float4*)(g + c0 + 4), g2 = *(const float4*)(g + c1), g3 = *(const float4*)(g + c1 + 4);
            uint4 o0, o1;
            o0.x = pack2(h0.x * rn * g0.x, h0.y * rn * g0.y); o0.y = pack2(h0.z * rn * g0.z, h0.w * rn * g0.w); o0.z = pack2(h1.x * rn * g1.x, h1.y * rn * g1.y); o0.w = pack2(h1.z * rn * g1.z, h1.w * rn * g1.w);
            o1.x = pack2(h2.x * rn * g2.x, h2.y * rn * g2.y); o1.y = pack2(h2.z * rn * g2.z, h2.w * rn * g2.w); o1.z = pack2(h3.x * rn * g3.x, h3.y * rn * g3.y); o1.w = pack2(h3.z * rn * g3.z, h3.w * rn * g3.w);
            *(uint4*)(XNw + (size_t)t * D + c0) = o0; *(uint4*)(XNw + (size_t)t * D + c1) = o1;
        }
    }
}


#define XB_TMO      128
#define XB_XCNT(j)  (256  + 64 * (j))
#define XB_XSUB(j)  (1280 + 64 * (j))
#define XB_XGEN(j)  (2304 + 64 * (j))
#define XB_TOP      3328
#define XB_TOPGEN   3392
#define XCD_BAR_WORDS 3456
#define XB_SPIN_CAP (1u << 22)
#define LAS __attribute__((address_space(3)))
__device__ __forceinline__ unsigned xb_ld(unsigned* p)              { return __hip_atomic_load(p, __ATOMIC_RELAXED, __HIP_MEMORY_SCOPE_AGENT); }
__device__ __forceinline__ unsigned xb_add(unsigned* p, unsigned v) { return __hip_atomic_fetch_add(p, v, __ATOMIC_RELAXED, __HIP_MEMORY_SCOPE_AGENT); }
__device__ __forceinline__ unsigned xb_xcc_id() { return (unsigned)__builtin_amdgcn_s_getreg((3 << 11) | 20) & 0xFu; }
#define XB_SPIN(cond, bar) do { unsigned _sp = 0; while (cond) { __builtin_amdgcn_s_sleep(1); \
    if ((++_sp & 255u) == 0u) { if (xb_ld(&(bar)[XB_TMO])) break; if (_sp > XB_SPIN_CAP) { atomicAdd(&(bar)[XB_TMO], 1u); break; } } } } while (0)
struct XcdBarrier { unsigned* bar; unsigned x; volatile LAS unsigned* st; };
__device__ __forceinline__ XcdBarrier xcd_barrier_post(unsigned* bar, volatile LAS unsigned* st) {
    XcdBarrier b; b.bar = bar; b.x = xb_xcc_id(); b.st = st;
    if (__builtin_amdgcn_workitem_id_x() == 0) (void)xb_add(&bar[XB_XCNT(b.x)], 1u);
    return b;
}
__device__ __forceinline__ void xcd_barrier_complete(unsigned* bar, unsigned x, unsigned& nloc, unsigned& nx) {
    const unsigned G = gridDim.x * gridDim.y * gridDim.z;
    unsigned sum, cnt, mine, sp = 0u;
    for (;;) {
        sum = 0u; cnt = 0u; mine = 0u;
#pragma unroll
        for (unsigned j = 0; j < 16; ++j) { const unsigned c = xb_ld(&bar[XB_XCNT(j)]); sum += c; cnt += (c > 0u) ? 1u : 0u; mine = (j == x) ? c : mine; }
        if (sum == G) break;
        __builtin_amdgcn_s_sleep(1);
        if ((++sp & 255u) == 0u) { if (xb_ld(&bar[XB_TMO])) break; if (sp > XB_SPIN_CAP) { atomicAdd(&bar[XB_TMO], 1u); break; } }
    }
    nloc = mine > 0u ? mine : 1u; nx = cnt > 0u ? cnt : 1u;
}
__device__ __forceinline__ void xcd_barrier(const XcdBarrier& b) {
    asm volatile("s_waitcnt vmcnt(0)" ::: "memory");
    __syncthreads();
    if (__builtin_amdgcn_workitem_id_x() == 0) {
        unsigned* bar = b.bar;
        __builtin_amdgcn_s_waitcnt(0);
        unsigned nloc = b.st[0], nx = b.st[1];
        if (nloc == 0u) { xcd_barrier_complete(bar, b.x, nloc, nx); b.st[0] = nloc; b.st[1] = nx; }
        const unsigned old = xb_add(&bar[XB_XSUB(b.x)], 1u);
        const unsigned gen = old / nloc;
        if (old + 1u == (gen + 1u) * nloc) {
            __builtin_amdgcn_fence(__ATOMIC_RELEASE, "agent");
            asm volatile("s_waitcnt vmcnt(0)" ::: "memory");
            const unsigned og = xb_add(&bar[XB_TOP], 1u);
            const unsigned tg = og / nx;
            if (og + 1u == (tg + 1u) * nx) xb_add(&bar[XB_TOPGEN], 1u);
            else XB_SPIN(xb_ld(&bar[XB_TOPGEN]) == tg, bar);
            __builtin_amdgcn_fence(__ATOMIC_ACQUIRE, "agent");
            xb_add(&bar[XB_XGEN(b.x)], 1u);
            asm volatile("s_waitcnt vmcnt(0)" ::: "memory");
        } else {
            XB_SPIN(xb_ld(&bar[XB_XGEN(b.x)]) == gen, bar);
            __builtin_amdgcn_fence(__ATOMIC_ACQUIRE, "agent");
            asm volatile("s_waitcnt vmcnt(0)" ::: "memory");
        }
    }
    __syncthreads();
}

constexpr float QSCALE = 0.10206207261596575f * 1.4426950408889634f;

__device__ __forceinline__ void phase_gemm1(const Params& P, int l, char* lds) {
    unsigned char* ws = P.ws;
    const bf16* XN = (const bf16*)(ws + WS_XN);
    bf16* PROJ = (bf16*)(ws + WS_PROJ);
    bf16* Kb = (bf16*)(ws + WS_K);
    const float* rope = (const float*)(ws + WS_ROPE);
    const bf16* W = (const bf16*)(ws + WS_WIN) + (size_t)l * DINP * D;
    gemm_t<false>(W, D, DINP, XN, D, T, D, [&](int n0, int t0, const f32x16& acc, int r32, int hi, float) {
        const int t = t0 + r32;
        if (n0 < C_KR) {
            bf16* pr = PROJ + (size_t)t * DINP + n0 + 4 * hi;
#pragma unroll
            for (int g = 0; g < 4; ++g) { uint2 o; o.x = cvtpk(acc[4 * g], acc[4 * g + 1]); o.y = cvtpk(acc[4 * g + 2], acc[4 * g + 3]); *(uint2*)(pr + 8 * g) = o; }
        } else if (n0 == C_KR) {
            const int b = t / S, s = t % S;
            uint2 o1[2], o2[2];
#pragma unroll
            for (int g = 0; g < 2; ++g) {
                const float4 cs0 = *(const float4*)(rope + ((size_t)s * 16 + 8 * g + 4 * hi) * 2), cs1 = *(const float4*)(rope + ((size_t)s * 16 + 8 * g + 4 * hi) * 2 + 4);
                const float x10 = acc[4 * g], x11 = acc[4 * g + 1], x12 = acc[4 * g + 2], x13 = acc[4 * g + 3];
                const float x20 = acc[8 + 4 * g], x21 = acc[8 + 4 * g + 1], x22 = acc[8 + 4 * g + 2], x23 = acc[8 + 4 * g + 3];
                o1[g].x = cvtpk(x10 * cs0.x - x20 * cs0.y, x11 * cs0.z - x21 * cs0.w); o1[g].y = cvtpk(x12 * cs1.x - x22 * cs1.y, x13 * cs1.z - x23 * cs1.w);
                o2[g].x = cvtpk(x20 * cs0.x + x10 * cs0.y, x21 * cs0.z + x11 * cs0.w); o2[g].y = cvtpk(x22 * cs1.x + x12 * cs1.y, x23 * cs1.z + x13 * cs1.w);
            }
#pragma unroll
            for (int h = 0; h < NH; ++h) {
                bf16* kr = Kb + ((size_t)(b * NH + h) * S + s) * DQK + 64 + 4 * hi;
                *(uint2*)(kr) = o1[0]; *(uint2*)(kr + 8) = o1[1]; *(uint2*)(kr + 16) = o2[0]; *(uint2*)(kr + 24) = o2[1];
            }
        }
    }, lds);
}
__device__ __forceinline__ void phase_gemm2(const Params& P, int l, char* lds) {
    unsigned char* ws = P.ws;
    const bf16* PROJ = (const bf16*)(ws + WS_PROJ);
    const float* rope = (const float*)(ws + WS_ROPE);
    {
        const bf16* W = (const bf16*)(ws + WS_WUQ) + (size_t)l * 768 * QR;
        bf16* Qb = (bf16*)(ws + WS_Q);
        gemm_t<true>(W, QR, 768, PROJ + C_CQ, DINP, T, QR, [&](int n0, int t0, const f32x16& acc, int r32, int hi, float ssq) {
            const int t = t0 + r32, b = t / S, s = t % S;
            const int h = n0 / DQK, d0 = n0 % DQK;
            const float sc = rsqrtf(ssq * (1.f / QR) + EPS) * QSCALE;
            bf16* qb = Qb + ((size_t)(b * NH + h) * S + s) * DQK + d0 + 4 * hi;
            if (d0 == 64) {
#pragma unroll
                for (int g = 0; g < 2; ++g) {
                    const float4 cs0 = *(const float4*)(rope + ((size_t)s * 16 + 8 * g + 4 * hi) * 2), cs1 = *(const float4*)(rope + ((size_t)s * 16 + 8 * g + 4 * hi) * 2 + 4);
                    const float x10 = acc[4 * g] * sc, x11 = acc[4 * g + 1] * sc, x12 = acc[4 * g + 2] * sc, x13 = acc[4 * g + 3] * sc;
                    const float x20 = acc[8 + 4 * g] * sc, x21 = acc[8 + 4 * g + 1] * sc, x22 = acc[8 + 4 * g + 2] * sc, x23 = acc[8 + 4 * g + 3] * sc;
                    uint2 o1, o2;
                    o1.x = cvtpk(x10 * cs0.x - x20 * cs0.y, x11 * cs0.z - x21 * cs0.w); o1.y = cvtpk(x12 * cs1.x - x22 * cs1.y, x13 * cs1.z - x23 * cs1.w);
                    o2.x = cvtpk(x20 * cs0.x + x10 * cs0.y, x21 * cs0.z + x11 * cs0.w); o2.y = cvtpk(x22 * cs1.x + x12 * cs1.y, x23 * cs1.z + x13 * cs1.w);
                    *(uint2*)(qb + 8 * g) = o1; *(uint2*)(qb + 16 + 8 * g) = o2;
                }
            } else {
#pragma unroll
                for (int g = 0; g < 4; ++g) { uint2 o; o.x = cvtpk(acc[4 * g] * sc, acc[4 * g + 1] * sc); o.y = cvtpk(acc[4 * g + 2] * sc, acc[4 * g + 3] * sc); *(uint2*)(qb + 8 * g) = o; }
            }
        }, lds);
    }
    {
        const bf16* W = (const bf16*)(ws + WS_WUKV) + (size_t)l * 1024 * KVR;
        bf16* Kb = (bf16*)(ws + WS_K); bf16* Vb = (bf16*)(ws + WS_V);
        gemm_t<true>(W, KVR, 1024, PROJ + C_CKV, DINP, T, KVR, [&](int n0, int t0, const f32x16& acc, int r32, int hi, float ssq) {
            const int t = t0 + r32, b = t / S, s = t % S;
            const float sc = rsqrtf(ssq * (1.f / KVR) + EPS);
            bf16* dst;
            if (n0 < 512) dst = Kb + ((size_t)(b * NH + (n0 >> 6)) * S + s) * DQK + (n0 & 63) + 4 * hi;
            else          dst = Vb + ((size_t)(b * NH + ((n0 - 512) >> 6)) * S + s) * DV + (n0 & 63) + 4 * hi;
#pragma unroll
            for (int g = 0; g < 4; ++g) { uint2 o; o.x = cvtpk(acc[4 * g] * sc, acc[4 * g + 1] * sc); o.y = cvtpk(acc[4 * g + 2] * sc, acc[4 * g + 3] * sc); *(uint2*)(dst + 8 * g) = o; }
        }, lds);
    }
}
__device__ __forceinline__ void phase_gemm3(const Params& P, int l, char* lds) {
    unsigned char* ws = P.ws;
    const bf16* Yb = (const bf16*)(ws + WS_XN);
    const bf16* W = (const bf16*)(ws + WS_WOUT) + (size_t)l * D * D;
    const float* hin = (l == 0) ? P.x : P.out;
    float* out = P.out;
    gemm_t<false>(W, D, D, Yb, D, T, D, [&](int n0, int t0, const f32x16& acc, int r32, int hi, float) {
        const size_t base = (size_t)(t0 + r32) * D + n0 + 4 * hi;
#pragma unroll
        for (int g = 0; g < 4; ++g) {
            const float4 hv = *(const float4*)(hin + base + 8 * g);
            *(float4*)(out + base + 8 * g) = make_float4(hv.x + acc[4 * g], hv.y + acc[4 * g + 1], hv.z + acc[4 * g + 2], hv.w + acc[4 * g + 3]);
        }
    }, lds);
}

#define GSYNC() do { XcdBarrier xb_; xb_.bar = (unsigned*)(P.ws + WS_CTL); xb_.x = xb_xcc_id(); xb_.st = (volatile LAS unsigned*)&xb_words; xcd_barrier(xb_); } while (0)
#define PHASE(stmt) { const Params Q = launder(P); stmt; }
__global__ void __launch_bounds__(NTHREADS, 2) k_all(Params P) {
    __shared__ __attribute__((aligned(16))) char sm[LDS_TOTAL];
    __shared__ uint4 xb_words;
    cg::grid_group grid = cg::this_grid();
    if (__builtin_amdgcn_workitem_id_x() == 0) xb_words = make_uint4(0u, 0u, 0u, 0u);
    __syncthreads();
    (void)xcd_barrier_post((unsigned*)(P.ws + WS_CTL), (volatile LAS unsigned*)&xb_words);
    PHASE(phase_prep(Q, sm));
    PHASE(phase_norm(Q.x, Q.norm_mix, (bf16*)(Q.ws + WS_XN)));
    grid.sync();
    for (int l = 0; l < DEPTH; ++l) {
        PHASE(phase_gemm1(Q, l, sm));
#if PROBE_DUP & 2
        PHASE(phase_gemm1(Q, l, sm));
#endif
        GSYNC();
        PHASE(phase_mixlocal(Q, l, sm));
#if PROBE_DUP & 256
        PHASE(phase_mixlocal(Q, l, sm));
#endif
        PHASE(phase_gemm2(Q, l, sm));
        GSYNC();
        PHASE(phase_attn(Q, sm));
        GSYNC();
        PHASE(phase_gemm3(Q, l, sm));
#if PROBE_DUP & 16
        if (l == 0) PHASE(phase_gemm3(Q, l, sm));
#endif
        GSYNC();
        PHASE(phase_norm(Q.out, Q.norm_ffn + l * D, (bf16*)(Q.ws + WS_XN)));
        GSYNC();
        PHASE(phase_route(Q, l, sm));
        GSYNC();
        PHASE(phase_gather(Q, l));
        GSYNC();
    }
}

extern "C" void kernel_launch(void* const* d_in, const int* in_sizes, int n_in, void* d_out, int out_size, void* d_ws, size_t ws_size, hipStream_t stream) {
    static int grid = 0;
    if (grid == 0) {
        if (n_in != 18 || out_size != T * D || ws_size < WS_END) { fprintf(stderr, "kernel_launch: bad sizes n_in %d out %d ws %zu need %zu\n", n_in, out_size, ws_size, (size_t)WS_END); grid = -1; return; }
        int dev = 0, cus = 0, per_cu = 0;
        (void)hipGetDevice(&dev);
        (void)hipDeviceGetAttribute(&cus, hipDeviceAttributeMultiprocessorCount, dev);
        (void)hipOccupancyMaxActiveBlocksPerMultiprocessor(&per_cu, (const void*)k_all, NTHREADS, 0);
        if (per_cu > 2) per_cu = 2;
        if (per_cu < 1) { fprintf(stderr, "kernel_launch: occupancy query says %d\n", per_cu); grid = -1; return; }
        grid = cus * per_cu;
    }
    if (grid < 0) return;
    Params p{};
    p.x = (const float*)d_in[0]; p.norm_mix = (const float*)d_in[1]; p.w_in = (const float*)d_in[2]; p.conv_w = (const float*)d_in[3];
    p.pool_w = (const float*)d_in[4]; p.pool_scale = (const float*)d_in[5]; p.q_norm = (const float*)d_in[6]; p.w_uq = (const float*)d_in[7];
    p.kv_norm = (const float*)d_in[8]; p.w_uk = (const float*)d_in[9]; p.w_uv = (const float*)d_in[10]; p.w_out = (const float*)d_in[11];
    p.norm_ffn = (const float*)d_in[12]; p.peer_wq = (const float*)d_in[13]; p.peer_subkeys = (const float*)d_in[14]; p.peer_u = (const float*)d_in[15];
    p.peer_v = (const float*)d_in[16]; p.norm_final = (const float*)d_in[17];
    p.out = (float*)d_out; p.ws = (unsigned char*)d_ws;
    if (hipMemsetAsync((char*)d_ws + WS_CTL, 0, XCD_BAR_WORDS * 4, stream) != hipSuccess) { fprintf(stderr, "kernel_launch: memset failed\n"); return; }
    void* args[] = {&p};
    hipError_t e = hipLaunchCooperativeKernel((const void*)k_all, dim3(grid), dim3(NTHREADS), args, 0, stream);
    if (e != hipSuccess) fprintf(stderr, "cooperative launch failed: %s (grid %d)\n", hipGetErrorString(e), grid);
}
```

```cpp
#include <hip/hip_runtime.h>
#include <hip/hip_cooperative_groups.h>
#include <cstdio>
#include <cstdint>
namespace cg = cooperative_groups;

#ifndef TAB_FP8
#define TAB_FP8 1
#endif
#ifndef PROBE_DUP
#define PROBE_DUP 0
#endif

constexpr int NB = 4, S = 8192, T = NB * S, D = 1024, DEPTH = 2;
constexpr int DIN = 1696, DINP = 1792;
constexpr int C_BG = 0, C_CG = 256, C_HC = 512, C_HP = 768, C_CQ = 1024, C_CKV = 1408, C_KR = 1664;
constexpr int QR = 384, KVR = 256, NH = 8, DQK = 96, DV = 64;
constexpr int PH = 8, NKEY = 128, NEXP = NKEY * NKEY, TOPK = 16, HK = PH * TOPK;
constexpr float EPS = 1e-6f;

typedef unsigned short bf16;

constexpr size_t WS_CTL   = 0;
constexpr size_t WS_ROPE  = 64 * 1024;
constexpr size_t WS_WIN   = WS_ROPE + (size_t)S * 16 * 2 * 4;
constexpr size_t WS_WUQ   = WS_WIN + (size_t)DEPTH * DINP * D * 2;
constexpr size_t WS_WUKV  = WS_WUQ + (size_t)DEPTH * 768 * QR * 2;
constexpr size_t WS_WOUT  = WS_WUKV + (size_t)DEPTH * 1024 * KVR * 2;
constexpr size_t WS_WPQ   = WS_WOUT + (size_t)DEPTH * D * D * 2;
constexpr size_t WS_XN    = ((WS_WPQ + (size_t)DEPTH * 2048 * D * 2 + 4095) / 4096) * 4096;
constexpr size_t WS_PROJ  = WS_XN + (size_t)T * D * 2;
constexpr size_t WS_Q     = WS_PROJ + (size_t)T * DINP * 2;
constexpr size_t WS_K     = WS_Q + (size_t)T * NH * DQK * 2;
constexpr size_t WS_V     = WS_K + (size_t)T * NH * DQK * 2;
constexpr size_t WS_EXP   = WS_V + (size_t)T * NH * DV * 2;
constexpr size_t WS_GATE  = WS_EXP + (size_t)T * HK * 4;
constexpr size_t TAB_ROWB = TAB_FP8 ? 1024 : 2048;
constexpr size_t WS_TABU  = WS_GATE + (size_t)T * HK * 4;
constexpr size_t WS_TABV  = WS_TABU + (size_t)DEPTH * NEXP * TAB_ROWB;
constexpr size_t WS_TSCU  = WS_TABV + (size_t)DEPTH * NEXP * TAB_ROWB;
constexpr size_t WS_TSCV  = WS_TSCU + (size_t)DEPTH * NEXP * 4;
constexpr size_t WS_END   = WS_TSCV + (size_t)DEPTH * NEXP * 4;
static_assert(WS_END <= (size_t)512 * 1024 * 1024, "workspace budget");

struct Params {
    const float* x; const float* norm_mix; const float* w_in; const float* conv_w; const float* pool_w; const float* pool_scale;
    const float* q_norm; const float* w_uq; const float* kv_norm; const float* w_uk; const float* w_uv; const float* w_out;
    const float* norm_ffn; const float* peer_wq; const float* peer_subkeys; const float* peer_u; const float* peer_v; const float* norm_final;
    float* out; unsigned char* ws;
};

__device__ __forceinline__ bf16 f2bf(float f) { unsigned u = __float_as_uint(f); u += 0x7fffu + ((u >> 16) & 1u); return (bf16)(u >> 16); }
__device__ __forceinline__ float bf2f(bf16 h) { return __uint_as_float(((unsigned)h) << 16); }
__device__ __forceinline__ float bflo(unsigned u) { return __uint_as_float(u << 16); }
__device__ __forceinline__ float bfhi(unsigned u) { return __uint_as_float(u & 0xffff0000u); }
__device__ __forceinline__ unsigned pack2(float a, float b) { return (unsigned)f2bf(a) | ((unsigned)f2bf(b) << 16); }
__device__ __forceinline__ float wave_sum(float v) {
#pragma unroll
    for (int m = 32; m >= 1; m >>= 1) v += __shfl_xor(v, m, 64);
    return v;
}
__device__ __forceinline__ float gelu_exact(float x) { return 0.5f * x * (1.f + erff(x * 0.70710678118654752f)); }

#define NTHREADS 256
__device__ __forceinline__ int tidx() { int t = (int)__builtin_amdgcn_workitem_id_x(); asm volatile("" : "+v"(t)); return t; }
__device__ __forceinline__ int gwave() { return blockIdx.x * (NTHREADS / 64) + (tidx() >> 6); }
__device__ __forceinline__ int nwave() { return gridDim.x * (NTHREADS / 64); }
__device__ __forceinline__ size_t gtid() { return (size_t)blockIdx.x * NTHREADS + tidx(); }
__device__ __forceinline__ size_t gnth() { return (size_t)gridDim.x * NTHREADS; }


__device__ __forceinline__ Params launder(const Params& P) {
    Params Q = P;
    asm volatile("" : "+s"(Q.x), "+s"(Q.norm_mix), "+s"(Q.w_in), "+s"(Q.conv_w), "+s"(Q.pool_w), "+s"(Q.pool_scale), "+s"(Q.q_norm), "+s"(Q.w_uq), "+s"(Q.kv_norm), "+s"(Q.w_uk));
    asm volatile("" : "+s"(Q.w_uv), "+s"(Q.w_out), "+s"(Q.norm_ffn), "+s"(Q.peer_wq), "+s"(Q.peer_subkeys), "+s"(Q.peer_u), "+s"(Q.peer_v), "+s"(Q.norm_final), "+s"(Q.out), "+s"(Q.ws));
    return Q;
}

typedef __attribute__((ext_vector_type(8))) short bf16x8;
typedef __attribute__((ext_vector_type(16))) float f32x16;
typedef __attribute__((ext_vector_type(2))) __bf16 bf2_t;
#define MFMA32(a, b, c) __builtin_amdgcn_mfma_f32_32x32x16_bf16(a, b, c, 0, 0, 0)
__device__ __forceinline__ int crow(int r, int hi) { return (r & 3) + 8 * (r >> 2) + 4 * hi; }
__device__ __forceinline__ float dot2bf(unsigned a, unsigned b, float c) { return __builtin_amdgcn_fdot2_f32_bf16(__builtin_bit_cast(bf2_t, a), __builtin_bit_cast(bf2_t, b), c, false); }
__device__ __forceinline__ unsigned cvtpk(float lo, float hi) { unsigned r; asm("v_cvt_pk_bf16_f32 %0, %1, %2" : "=v"(r) : "v"(lo), "v"(hi)); return r; }
constexpr int G_LDT = 144;
constexpr int G_OPB = 128 * G_LDT;
constexpr int G_BUF = 2 * G_OPB;
constexpr int GEMM_LDS = 2 * G_BUF;
constexpr int LDS_TOTAL = GEMM_LDS + 512;

template <int WT, bool ROWSS>
__device__ __forceinline__ void gemm_kloop(const bf16* __restrict__ Ag0, int lda, const bf16* __restrict__ Bg0, int ldb, int nk, f32x16 (&acc)[4], float (&ss)[4], char* lds, int tid) {
    const int lane = tid & 63, w = tid >> 6, r32 = lane & 31, hi = lane >> 5;
    const int srow = tid >> 3, sch = tid & 7;
    const bf16* Ag = Ag0 + (size_t)srow * lda + sch * 8;
    const bf16* Bg = Bg0 + (size_t)srow * ldb + sch * 8;
#pragma unroll
    for (int i = 0; i < 4; ++i)
#pragma unroll
        for (int r = 0; r < 16; ++r) acc[i][r] = 0.f;
    ss[0] = 0.f; ss[1] = 0.f; ss[2] = 0.f; ss[3] = 0.f;
    uint4 ra0, ra1, ra2, ra3, rb0, rb1, rb2, rb3;
#define G_LOAD(kofs) do { \
    ra0 = *(const uint4*)(Ag + (kofs)); ra1 = *(const uint4*)(Ag + (size_t)32 * lda + (kofs)); ra2 = *(const uint4*)(Ag + (size_t)64 * lda + (kofs)); ra3 = *(const uint4*)(Ag + (size_t)96 * lda + (kofs)); \
    rb0 = *(const uint4*)(Bg + (kofs)); rb1 = *(const uint4*)(Bg + (size_t)32 * ldb + (kofs)); rb2 = *(const uint4*)(Bg + (size_t)64 * ldb + (kofs)); rb3 = *(const uint4*)(Bg + (size_t)96 * ldb + (kofs)); } while (0)
#define G_SS(s_, r_) do { s_ = dot2bf(r_.x, r_.x, s_); s_ = dot2bf(r_.y, r_.y, s_); s_ = dot2bf(r_.z, r_.z, s_); s_ = dot2bf(r_.w, r_.w, s_); } while (0)
    G_LOAD(0);
    for (int kt = 0; kt < nk; ++kt) {
        char* bA = lds + (kt & 1) * G_BUF; char* bB = bA + G_OPB;
        {
            char* wa = bA + srow * G_LDT + sch * 16; char* wb = bB + srow * G_LDT + sch * 16;
            *(uint4*)(wa) = ra0; *(uint4*)(wa + 32 * G_LDT) = ra1; *(uint4*)(wa + 64 * G_LDT) = ra2; *(uint4*)(wa + 96 * G_LDT) = ra3;
            *(uint4*)(wb) = rb0; *(uint4*)(wb + 32 * G_LDT) = rb1; *(uint4*)(wb + 64 * G_LDT) = rb2; *(uint4*)(wb + 96 * G_LDT) = rb3;
            if (ROWSS) { G_SS(ss[0], rb0); G_SS(ss[1], rb1); G_SS(ss[2], rb2); G_SS(ss[3], rb3); }
        }
        __syncthreads();
        if (kt + 1 < nk) G_LOAD((kt + 1) * 64);
        if (WT == 0) {
            const char* pa = bA + ((w >> 1) * 64 + r32) * G_LDT + hi * 16;
            const char* pb = bB + ((w & 1) * 64 + r32) * G_LDT + hi * 16;
#pragma unroll
            for (int ks = 0; ks < 4; ++ks) {
                const bf16x8 a0 = *(const bf16x8*)(pa + ks * 32), a1 = *(const bf16x8*)(pa + 32 * G_LDT + ks * 32);
                const bf16x8 b0 = *(const bf16x8*)(pb + ks * 32), b1 = *(const bf16x8*)(pb + 32 * G_LDT + ks * 32);
                acc[0] = MFMA32(a0, b0, acc[0]); acc[1] = MFMA32(a0, b1, acc[1]);
                acc[2] = MFMA32(a1, b0, acc[2]); acc[3] = MFMA32(a1, b1, acc[3]);
            }
        } else {
            const char* pa = bA + r32 * G_LDT + hi * 16;
            const char* pb = bB + (w * 32 + r32) * G_LDT + hi * 16;
#pragma unroll
            for (int ks = 0; ks < 4; ++ks) {
                const bf16x8 b0 = *(const bf16x8*)(pb + ks * 32);
                const bf16x8 a0 = *(const bf16x8*)(pa + ks * 32), a1 = *(const bf16x8*)(pa + 32 * G_LDT + ks * 32);
                const bf16x8 a2 = *(const bf16x8*)(pa + 64 * G_LDT + ks * 32), a3 = *(const bf16x8*)(pa + 96 * G_LDT + ks * 32);
                acc[0] = MFMA32(a0, b0, acc[0]); acc[1] = MFMA32(a1, b0, acc[1]);
                acc[2] = MFMA32(a2, b0, acc[2]); acc[3] = MFMA32(a3, b0, acc[3]);
            }
        }
    }
#undef G_LOAD
#undef G_SS
}

template <bool ROWSS, class EPI>
__device__ __forceinline__ void gemm_t(const bf16* __restrict__ Wt, int ldw, int N, const bf16* __restrict__ X, int ldx, int M, int K, EPI epi, char* lds) {
    const int tid = tidx(), lane = tid & 63, w = tid >> 6, r32 = lane & 31, hi = lane >> 5;
    const int tilesN = N / 128, tilesM = M / 128, nk = K / 64;
    float* rowss = (float*)(lds + GEMM_LDS);
    for (int tile = blockIdx.x; tile < tilesM * tilesN; tile += gridDim.x) {
        const int tm = tile / tilesN, tn = tile % tilesN;
        f32x16 acc[4]; float ss[4];
        gemm_kloop<0, ROWSS>(Wt + (size_t)(tn * 128) * ldw, ldw, X + (size_t)(tm * 128) * ldx, ldx, nk, acc, ss, lds, tid);
        if (ROWSS) {
#pragma unroll
            for (int i = 0; i < 4; ++i) { float v = ss[i]; v += __shfl_xor(v, 1, 64); v += __shfl_xor(v, 2, 64); v += __shfl_xor(v, 4, 64); if ((tid & 7) == 0) rowss[(tid >> 3) + 32 * i] = v; }
            __syncthreads();
        }
#pragma unroll
        for (int i = 0; i < 2; ++i)
#pragma unroll
            for (int j = 0; j < 2; ++j) {
                const int tl = (w & 1) * 64 + j * 32;
                epi(tn * 128 + (w >> 1) * 64 + i * 32, tm * 128 + tl, acc[i * 2 + j], r32, hi, ROWSS ? rowss[tl + r32] : 0.f);
            }
        __syncthreads();
    }
}

__device__ __forceinline__ void transpose_tiled(const float* __restrict__ W, bf16* __restrict__ Wt, int K, int N, int Npad, const float* __restrict__ gain, char* lds) {
    float (*tl)[65] = (float (*)[65])lds;
    const int tid = tidx(), a = tid & 63, q = tid >> 6;
    const int tK = K / 64, tN = Npad / 64;
    for (int tile = blockIdx.x; tile < tK * tN; tile += gridDim.x) {
        const int k0 = (tile / tN) * 64, n0 = (tile % tN) * 64;
#pragma unroll 4
        for (int i = 0; i < 16; ++i) {
            const int k = k0 + q * 16 + i, n = n0 + a;
            float v = (n < N) ? W[(size_t)k * N + n] : 0.f;
            if (gain) v *= gain[k];
            tl[q * 16 + i][a] = v;
        }
        __syncthreads();
#pragma unroll 4
        for (int i = 0; i < 16; ++i) { const int nl = q * 16 + i; Wt[(size_t)(n0 + nl) * K + k0 + a] = f2bf(tl[a][nl]); }
        __syncthreads();
    }
}

__device__ __forceinline__ void quant_row(const float4 (&v)[4], unsigned char* __restrict__ dst, float* __restrict__ scl, int r, int lane) {
    float am = 0.f;
#pragma unroll
    for (int j = 0; j < 4; ++j) am = fmaxf(am, fmaxf(fmaxf(fabsf(v[j].x), fabsf(v[j].y)), fmaxf(fabsf(v[j].z), fabsf(v[j].w))));
#pragma unroll
    for (int m = 32; m >= 1; m >>= 1) am = fmaxf(am, __shfl_xor(am, m, 64));
    const float sc = (am > 0.f) ? am * (1.f / 448.f) : 1.f;
    const float is = 1.f / sc;
    uint4 o;
    { int w = 0; w = __builtin_amdgcn_cvt_pk_fp8_f32(v[0].x * is, v[0].y * is, w, false); w = __builtin_amdgcn_cvt_pk_fp8_f32(v[0].z * is, v[0].w * is, w, true); o.x = (unsigned)w; }
    { int w = 0; w = __builtin_amdgcn_cvt_pk_fp8_f32(v[1].x * is, v[1].y * is, w, false); w = __builtin_amdgcn_cvt_pk_fp8_f32(v[1].z * is, v[1].w * is, w, true); o.y = (unsigned)w; }
    { int w = 0; w = __builtin_amdgcn_cvt_pk_fp8_f32(v[2].x * is, v[2].y * is, w, false); w = __builtin_amdgcn_cvt_pk_fp8_f32(v[2].z * is, v[2].w * is, w, true); o.z = (unsigned)w; }
    { int w = 0; w = __builtin_amdgcn_cvt_pk_fp8_f32(v[3].x * is, v[3].y * is, w, false); w = __builtin_amdgcn_cvt_pk_fp8_f32(v[3].z * is, v[3].w * is, w, true); o.w = (unsigned)w; }
    *(uint4*)(dst + (size_t)r * 1024 + lane * 16) = o;
    if (lane == 0) scl[r] = sc;
}
__device__ __forceinline__ void convert_table(const float* __restrict__ src, unsigned char* __restrict__ dst, float* __restrict__ scl, int rows) {
    static_assert(TAB_FP8, "fp8 tables");
    const int lane = tidx() & 63;
    const int nw = nwave();
    for (int r = gwave(); r < rows; r += 2 * nw) {
        const int r2 = r + nw;
        float4 v0[4], v1[4];
        const float4* s0 = (const float4*)(src + (size_t)r * D);
        const float4* s1 = (const float4*)(src + (size_t)(r2 < rows ? r2 : r) * D);
#pragma unroll
        for (int j = 0; j < 4; ++j) { v0[j] = s0[lane * 4 + j]; v1[j] = s1[lane * 4 + j]; }
        quant_row(v0, dst, scl, r, lane);
        if (r2 < rows) quant_row(v1, dst, scl, r2, lane);
    }
}
__device__ __forceinline__ void phase_prep(const Params& P, char* lds) {
    unsigned char* ws = P.ws;
    for (int l = 0; l < DEPTH; ++l) {
        transpose_tiled(P.w_in + (size_t)l * D * DIN, (bf16*)(ws + WS_WIN) + (size_t)l * DINP * D, D, DIN, DINP, nullptr, lds);
        transpose_tiled(P.w_uq + (size_t)l * QR * 768, (bf16*)(ws + WS_WUQ) + (size_t)l * 768 * QR, QR, 768, 768, P.q_norm + l * QR, lds);
        transpose_tiled(P.w_uk + (size_t)l * KVR * 512, (bf16*)(ws + WS_WUKV) + (size_t)l * 1024 * KVR, KVR, 512, 512, P.kv_norm + l * KVR, lds);
        transpose_tiled(P.w_uv + (size_t)l * KVR * 512, (bf16*)(ws + WS_WUKV) + (size_t)l * 1024 * KVR + (size_t)512 * KVR, KVR, 512, 512, P.kv_norm + l * KVR, lds);
        transpose_tiled(P.w_out + (size_t)l * D * D, (bf16*)(ws + WS_WOUT) + (size_t)l * D * D, D, D, D, nullptr, lds);
    }
    {
        bf16* Wc = (bf16*)(ws + WS_WPQ);
        float (*As)[68] = (float (*)[68])lds;
        float (*Bs)[68] = (float (*)[68])(lds + 16 * 68 * 4);
        const int tid = tidx(), tx = tid & 15, ty = tid >> 4;
        const int lr = tid >> 2, ld4 = (tid & 3) * 4;
        for (int tile = blockIdx.x; tile < (DEPTH * 2048 / 64) * (D / 64); tile += gridDim.x) {
            const int row0 = (tile >> 4) * 64, k0 = (tile & 15) * 64;
            const int l = row0 >> 11, hp = (row0 >> 7) & 15, n0 = row0 & 127;
            const float* skp = P.peer_subkeys + (((size_t)l * 2 + (hp & 1)) * NKEY + n0 + lr) * 128 + ld4;
            const float* wqp = P.peer_wq + ((size_t)l * D + k0 + lr) * 2048 + hp * 128 + ld4;
            float acc[4][4];
#pragma unroll
            for (int i = 0; i < 4; ++i)
#pragma unroll
                for (int j = 0; j < 4; ++j) acc[i][j] = 0.f;
            for (int d0 = 0; d0 < 128; d0 += 16) {
                const float4 av = *(const float4*)(skp + d0), bv = *(const float4*)(wqp + d0);
                As[ld4 + 0][lr] = av.x; As[ld4 + 1][lr] = av.y; As[ld4 + 2][lr] = av.z; As[ld4 + 3][lr] = av.w;
                Bs[ld4 + 0][lr] = bv.x; Bs[ld4 + 1][lr] = bv.y; Bs[ld4 + 2][lr] = bv.z; Bs[ld4 + 3][lr] = bv.w;
                __syncthreads();
#pragma unroll
                for (int kk = 0; kk < 16; ++kk) {
                    const float4 a4 = *(const float4*)&As[kk][ty * 4], b4 = *(const float4*)&Bs[kk][tx * 4];
                    const float aa[4] = {a4.x, a4.y, a4.z, a4.w}, bb[4] = {b4.x, b4.y, b4.z, b4.w};
#pragma unroll
                    for (int i = 0; i < 4; ++i)
#pragma unroll
                        for (int j = 0; j < 4; ++j) acc[i][j] = fmaf(aa[i], bb[j], acc[i][j]);
                }
                __syncthreads();
            }
#pragma unroll
            for (int i = 0; i < 4; ++i) {
                uint2 o; o.x = pack2(acc[i][0], acc[i][1]); o.y = pack2(acc[i][2], acc[i][3]);
                *(uint2*)(Wc + (size_t)(row0 + ty * 4 + i) * D + k0 + tx * 4) = o;
            }
        }
    }
    convert_table(P.peer_u, ws + WS_TABU, (float*)(ws + WS_TSCU), DEPTH * NEXP);
    convert_table(P.peer_v, ws + WS_TABV, (float*)(ws + WS_TSCV), DEPTH * NEXP);
    float* rope = (float*)(ws + WS_ROPE);
    for (size_t i = gtid(); i < (size_t)S * 16; i += gnth()) {
        const int s = (int)(i >> 4), f = (int)(i & 15);
        const double inv = pow(10000.0, -(double)f / 16.0);
        const double ang = (double)s * inv;
        rope[2 * i] = (float)cos(ang); rope[2 * i + 1] = (float)sin(ang);
    }
}

__device__ __forceinline__ void phase_norm(const float* __restrict__ h, const float* __restrict__ g, bf16* __restrict__ xn) {
    const int lane = tidx() & 63;
    for (int t = gwave(); t < T; t += nwave()) {
        const float4* hr = (const float4*)(h + (size_t)t * D);
        float4 v[4]; float ss = 0.f;
#pragma unroll
        for (int j = 0; j < 4; ++j) { v[j] = hr[j * 64 + lane]; ss += v[j].x * v[j].x + v[j].y * v[j].y + v[j].z * v[j].z + v[j].w * v[j].w; }
        ss = wave_sum(ss);
        const float r = rsqrtf(ss * (1.f / D) + EPS);
#pragma unroll
        for (int j = 0; j < 4; ++j) {
            const float4 gg = ((const float4*)g)[j * 64 + lane];
            uint2 o; o.x = pack2(v[j].x * r * gg.x, v[j].y * r * gg.y); o.y = pack2(v[j].z * r * gg.z, v[j].w * r * gg.w);
            ((uint2*)(xn + (size_t)t * D))[j * 64 + lane] = o;
        }
    }
}

__device__ __forceinline__ void phase_mixlocal(const Params& P, int l, char* lds) {
    const bf16* proj = (const bf16*)(P.ws + WS_PROJ);
    bf16* Y = (bf16*)(P.ws + WS_XN);
    const int tid = tidx();
    {
        const float* cw = P.conv_w + (size_t)l * 3 * 256;
        for (size_t i = gtid(); i < (size_t)T * 32; i += gnth()) {
            const int t = (int)(i >> 5), c0 = (int)(i & 31) * 8, s = t & (S - 1);
            const bf16* pr = proj + (size_t)t * DINP;
            float acc[8];
#pragma unroll
            for (int e = 0; e < 8; ++e) acc[e] = 0.f;
#pragma unroll
            for (int j = 0; j < 3; ++j) {
                if (s - 2 + j >= 0) {
                    const bf16* pp = pr - (size_t)(2 - j) * DINP;
                    const uint4 g = *(const uint4*)(pp + C_CG + c0), hc = *(const uint4*)(pp + C_HC + c0);
                    const float4 w0 = *(const float4*)(cw + j * 256 + c0), w1 = *(const float4*)(cw + j * 256 + c0 + 4);
                    acc[0] = fmaf(w0.x, bflo(g.x) * bflo(hc.x), acc[0]); acc[1] = fmaf(w0.y, bfhi(g.x) * bfhi(hc.x), acc[1]);
                    acc[2] = fmaf(w0.z, bflo(g.y) * bflo(hc.y), acc[2]); acc[3] = fmaf(w0.w, bfhi(g.y) * bfhi(hc.y), acc[3]);
                    acc[4] = fmaf(w1.x, bflo(g.z) * bflo(hc.z), acc[4]); acc[5] = fmaf(w1.y, bfhi(g.z) * bfhi(hc.z), acc[5]);
                    acc[6] = fmaf(w1.z, bflo(g.w) * bflo(hc.w), acc[6]); acc[7] = fmaf(w1.w, bfhi(g.w) * bfhi(hc.w), acc[7]);
                }
            }
            const uint4 bg = *(const uint4*)(pr + C_BG + c0);
            uint4 o;
            o.x = pack2(bflo(bg.x) * acc[0], bfhi(bg.x) * acc[1]); o.y = pack2(bflo(bg.y) * acc[2], bfhi(bg.y) * acc[3]);
            o.z = pack2(bflo(bg.z) * acc[4], bfhi(bg.z) * acc[5]); o.w = pack2(bflo(bg.w) * acc[6], bfhi(bg.w) * acc[7]);
            *(uint4*)(Y + (size_t)t * D + c0) = o;
        }
    }
    {
        float (*pl)[68] = (float (*)[68])lds;
        const float* pw = P.pool_w + (size_t)l * 4 * 64 * 64;
        const float* psc = P.pool_scale + l * 256;
        const int a = tid & 63, q = tid >> 6;
        for (int tile = blockIdx.x; tile < (T / 64) * 4; tile += gridDim.x) {
            const int g = tile & 3, t0 = (tile >> 2) * 64;
            const int w = 2 << g;
            {
                const bf16* col = proj + C_HP + g * 64 + a;
                const int tf = t0 + q * 16, sf = tf & (S - 1);
                float sum = 0.f;
                for (int d = 1; d < w; ++d) if (sf - d >= 0) sum += bf2f(col[(size_t)(tf - d) * DINP]);
#pragma unroll 4
                for (int i = 0; i < 16; ++i) {
                    const int s = sf + i;
                    const float xv = bf2f(col[(size_t)(tf + i) * DINP]);
                    sum += xv;
                    const int cnt = (s + 1 < w) ? (s + 1) : w;
                    pl[q * 16 + i][a] = sum / (float)cnt - xv;
                    if (s - w + 1 >= 0) sum -= bf2f(col[(size_t)(tf + i - w + 1) * DINP]);
                }
            }
            __syncthreads();
            {
                float pc[64];
#pragma unroll
                for (int c = 0; c < 64; ++c) pc[c] = pw[(g * 64 + c) * 64 + a];
                const float sc = psc[g * 64 + a];
#pragma unroll 2
                for (int i = 0; i < 16; ++i) {
                    const float4* row = (const float4*)&pl[q * 16 + i][0];
                    float m0 = 0.f, m1 = 0.f;
#pragma unroll
                    for (int c4 = 0; c4 < 16; ++c4) { const float4 v = row[c4]; m0 = fmaf(v.x, pc[4 * c4], m0); m1 = fmaf(v.y, pc[4 * c4 + 1], m1); m0 = fmaf(v.z, pc[4 * c4 + 2], m0); m1 = fmaf(v.w, pc[4 * c4 + 3], m1); }
                    Y[(size_t)(t0 + q * 16 + i) * D + 256 + g * 64 + a] = f2bf((m0 + m1) * sc);
                }
            }
            __syncthreads();
        }
    }
}

typedef short v4i16_t __attribute__((ext_vector_type(4)));
typedef __attribute__((address_space(3))) v4i16_t* lds_v4p;
__device__ __forceinline__ v4i16_t vtr(const char* p) { return __builtin_amdgcn_ds_read_tr16_b64_v4i16((lds_v4p)p); }
constexpr int A_KP = 208, A_VP = 192;
constexpr int A_KB = 64 * A_KP, A_VB = 64 * A_VP, A_BUF = A_KB + A_VB, ATTN_LDS = 2 * A_BUF;
static_assert(ATTN_LDS <= GEMM_LDS, "attention LDS");

__device__ __forceinline__ void attn_unit(const bf16* __restrict__ Qb, const bf16* __restrict__ Kb, const bf16* __restrict__ Vb, bf16* __restrict__ Y, int bh, int qblk, char* lds) {
    const int tid = tidx(), lane = tid & 63, w = tid >> 6, r32 = lane & 31, hi = lane >> 5;
    const int q0 = qblk * 128, qw0 = q0 + w * 32;
    const int NT = 2 * qblk + 2;
    bf16x8 qf[6];
    {
        const bf16* qp = Qb + ((size_t)bh * S + qw0 + r32) * DQK + hi * 8;
#pragma unroll
        for (int ks = 0; ks < 6; ++ks) qf[ks] = *(const bf16x8*)(qp + ks * 16);
    }
    f32x16 o0, o1;
#pragma unroll
    for (int r = 0; r < 16; ++r) { o0[r] = 0.f; o1[r] = 0.f; }
    float m = -1e30f, lsum = 0.f;
    const char* Kg = (const char*)(Kb + (size_t)bh * S * DQK) + tid * 16;
    const char* Vg = (const char*)(Vb + (size_t)bh * S * DV) + tid * 16;
    const int kl0 = (tid / 12) * A_KP + (tid % 12) * 16, kl1 = ((tid + 256) / 12) * A_KP + ((tid + 256) % 12) * 16, kl2 = ((tid + 512) / 12) * A_KP + ((tid + 512) % 12) * 16;
    const int vl0 = (tid >> 3) * A_VP + (tid & 7) * 16, vl1 = vl0 + 32 * A_VP;
    uint4 k0, k1, k2, v0, v1;
#define A_LOAD(t) do { const char* kg = Kg + (size_t)(t) * (64 * 192); const char* vg = Vg + (size_t)(t) * (64 * 128); \
        k0 = *(const uint4*)(kg); k1 = *(const uint4*)(kg + 4096); k2 = *(const uint4*)(kg + 8192); v0 = *(const uint4*)(vg); v1 = *(const uint4*)(vg + 4096); } while (0)
    A_LOAD(0);
    const int pvo = (4 * hi + ((lane & 15) >> 2)) * A_VP + (16 * ((lane >> 4) & 1) + 4 * (lane & 3)) * 2;
    for (int t = 0; t < NT; ++t) {
        char* bK = lds + (t & 1) * A_BUF; char* bV = bK + A_KB;
        *(uint4*)(bK + kl0) = k0; *(uint4*)(bK + kl1) = k1; *(uint4*)(bK + kl2) = k2; *(uint4*)(bV + vl0) = v0; *(uint4*)(bV + vl1) = v1;
        __syncthreads();
        if (t + 1 < NT) A_LOAD(t + 1);
        const int kt0 = t * 64;
        if (kt0 <= qw0) {
            f32x16 s0, s1;
#pragma unroll
            for (int r = 0; r < 16; ++r) { s0[r] = 0.f; s1[r] = 0.f; }
            const char* pk = bK + r32 * A_KP + hi * 16;
#pragma unroll
            for (int ks = 0; ks < 6; ++ks) {
                const bf16x8 a0 = *(const bf16x8*)(pk + ks * 32), a1 = *(const bf16x8*)(pk + 32 * A_KP + ks * 32);
                s0 = MFMA32(a0, qf[ks], s0); s1 = MFMA32(a1, qf[ks], s1);
            }
            if (kt0 + 63 > qw0) {
                const int qrow = qw0 + r32;
#pragma unroll
                for (int r = 0; r < 16; ++r) { const int key = kt0 + crow(r, hi); if (key > qrow) s0[r] = -INFINITY; if (key + 32 > qrow) s1[r] = -INFINITY; }
            }
            float mx = fmaxf(s0[0], s1[0]);
#pragma unroll
            for (int r = 1; r < 16; ++r) mx = fmaxf(mx, fmaxf(s0[r], s1[r]));
            mx = fmaxf(mx, __shfl_xor(mx, 32, 64));
            const float mn = fmaxf(m, mx);
            const float alpha = __builtin_amdgcn_exp2f(m - mn);
            m = mn;
            float ps = 0.f;
#pragma unroll
            for (int r = 0; r < 16; ++r) { s0[r] = __builtin_amdgcn_exp2f(s0[r] - mn); s1[r] = __builtin_amdgcn_exp2f(s1[r] - mn); ps += s0[r] + s1[r]; }
            lsum = lsum * alpha + ps;
#pragma unroll
            for (int r = 0; r < 16; ++r) { o0[r] *= alpha; o1[r] *= alpha; }
            union { unsigned u[4]; bf16x8 v; } p00, p01, p10, p11;
#pragma unroll
            for (int j = 0; j < 4; ++j) { p00.u[j] = cvtpk(s0[2 * j], s0[2 * j + 1]); p01.u[j] = cvtpk(s0[8 + 2 * j], s0[9 + 2 * j]); p10.u[j] = cvtpk(s1[2 * j], s1[2 * j + 1]); p11.u[j] = cvtpk(s1[8 + 2 * j], s1[9 + 2 * j]); }
            const char* pv = bV + pvo;
#define A_PV(pf, kofs) do { \
            { const v4i16_t lo = vtr(pv + (kofs) * A_VP), hh = vtr(pv + ((kofs) + 8) * A_VP); const bf16x8 vf = {lo[0], lo[1], lo[2], lo[3], hh[0], hh[1], hh[2], hh[3]}; o0 = MFMA32(vf, pf.v, o0); } \
            { const v4i16_t lo = vtr(pv + (kofs) * A_VP + 64), hh = vtr(pv + ((kofs) + 8) * A_VP + 64); const bf16x8 vf = {lo[0], lo[1], lo[2], lo[3], hh[0], hh[1], hh[2], hh[3]}; o1 = MFMA32(vf, pf.v, o1); } } while (0)
            A_PV(p00, 0); A_PV(p01, 16); A_PV(p10, 32); A_PV(p11, 48);
        }
    }
    lsum += __shfl_xor(lsum, 32, 64);
    const float inv = 1.f / lsum;
    const int b = bh >> 3, h = bh & 7;
    bf16* yo = Y + (size_t)(b * S + qw0 + r32) * D + 512 + h * 64 + 4 * hi;
#pragma unroll
    for (int g = 0; g < 4; ++g) {
        uint2 a, c;
        a.x = cvtpk(o0[4 * g] * inv, o0[4 * g + 1] * inv); a.y = cvtpk(o0[4 * g + 2] * inv, o0[4 * g + 3] * inv);
        c.x = cvtpk(o1[4 * g] * inv, o1[4 * g + 1] * inv); c.y = cvtpk(o1[4 * g + 2] * inv, o1[4 * g + 3] * inv);
        *(uint2*)(yo + 8 * g) = a; *(uint2*)(yo + 32 + 8 * g) = c;
    }
    __syncthreads();
}
__device__ __forceinline__ void phase_attn(const Params& P, char* lds) {
    const bf16* Qb = (const bf16*)(P.ws + WS_Q);
    const bf16* Kb = (const bf16*)(P.ws + WS_K);
    const bf16* Vb = (const bf16*)(P.ws + WS_V);
    bf16* Y = (bf16*)(P.ws + WS_XN);
    for (int u = blockIdx.x; u < NB * NH * (S / 128); u += gridDim.x) {
        const int bh = u & 31, v = u >> 5;
        const int qblk = (v < 16) ? (63 - v) : (v < 32) ? (v - 16) : (v < 48) ? (79 - v) : (v - 32);
        attn_unit(Qb, Kb, Vb, Y, bh, qblk, lds);
    }
}

#define NET_HD __device__ __forceinline__
#define NET_U2F(u) __uint_as_float(u)
#define NET_F2U(f) __float_as_uint(f)
#define CE_DESC(a, b) do { const float hi__ = fmaxf(a, b), lo__ = fminf(a, b); a = hi__; b = lo__; } while (0)
NET_HD void sort16_desc(float (&v)[16]) {
#pragma unroll
    for (int k = 2; k <= 16; k <<= 1) {
#pragma unroll
        for (int j = k >> 1; j > 0; j >>= 1) {
#pragma unroll
            for (int i = 0; i < 16; ++i) {
                const int l = i ^ j;
                if (l > i) { if ((i & k) == 0) CE_DESC(v[i], v[l]); else CE_DESC(v[l], v[i]); }
            }
        }
    }
}
NET_HD void merge16_desc(float (&a)[16], const float (&b)[16]) {
#pragma unroll
    for (int i = 0; i < 16; ++i) a[i] = fmaxf(a[i], b[15 - i]);
#pragma unroll
    for (int j = 8; j > 0; j >>= 1) {
#pragma unroll
        for (int i = 0; i < 16; ++i) { const int l = i ^ j; if (l > i) CE_DESC(a[i], a[l]); }
    }
}
NET_HD void top16_of_64(float (&g0)[16], float (&g1)[16], float (&g2)[16], float (&g3)[16]) {
    sort16_desc(g0); sort16_desc(g1); sort16_desc(g2); sort16_desc(g3);
    merge16_desc(g0, g1); merge16_desc(g2, g3); merge16_desc(g0, g2);
}
NET_HD float u2f(unsigned u) { return NET_U2F(u); }
NET_HD unsigned f2u(float f) { return NET_F2U(f); }
template <class V16>
NET_HD void lane_top16(const V16& s0, const V16& s1, const V16& s2, const V16& s3, int hi, float (&out)[16]) {
    float g0[16], g1[16], g2[16], g3[16];
#pragma unroll
    for (int r = 0; r < 16; ++r) {
        const unsigned nb = (unsigned)((r & 3) + 8 * (r >> 2));
        g0[r] = u2f((f2u(s0[r]) & 0xFFFFFF80u) | nb); g1[r] = u2f((f2u(s1[r]) & 0xFFFFFF80u) | (nb + 32u));
        g2[r] = u2f((f2u(s2[r]) & 0xFFFFFF80u) | (nb + 64u)); g3[r] = u2f((f2u(s3[r]) & 0xFFFFFF80u) | (nb + 96u));
    }
    top16_of_64(g0, g1, g2, g3);
    const unsigned h4 = (unsigned)hi << 2;
#pragma unroll
    for (int i = 0; i < 16; ++i) out[i] = u2f(f2u(g0[i]) | h4);
}
constexpr int cand_slot(int a, int b) { int n = 0; for (int x = 0; x < 16; ++x) for (int y = 0; y < 16; ++y) { if (x == a && y == b) return n; if ((x + 1) * (y + 1) <= 16) ++n; } return n; }
NET_HD void cand_top16(const float (&s1)[16], const float (&s2)[16], float (&c)[16]) {
    float g0[16], g1[16], g2[16], g3[16];
#pragma unroll
    for (int i = 0; i < 16; ++i) { g0[i] = -3.0e38f; g1[i] = -3.0e38f; g2[i] = -3.0e38f; g3[i] = -3.0e38f; }
#pragma unroll
    for (int a = 0; a < 16; ++a) {
#pragma unroll
        for (int b = 0; b < 16; ++b) {
            if ((a + 1) * (b + 1) <= 16) {
                const int sl = cand_slot(a, b);
                const float v = u2f((f2u(s1[a] + s2[b]) & 0xFFFFFF00u) | (unsigned)(a * 16 + b));
                if (sl < 16) g0[sl & 15] = v; else if (sl < 32) g1[sl & 15] = v; else if (sl < 48) g2[sl & 15] = v; else g3[sl & 15] = v;
            }
        }
    }
    top16_of_64(g0, g1, g2, g3);
#pragma unroll
    for (int i = 0; i < 16; ++i) c[i] = g0[i];
}

__device__ __forceinline__ void phase_route(const Params& P, int l, char* lds) {
    const bf16* XN = (const bf16*)(P.ws + WS_XN);
    const bf16* Wc = (const bf16*)(P.ws + WS_WPQ) + (size_t)l * 2048 * D;
    int* EXPp = (int*)(P.ws + WS_EXP);
    float* GATEp = (float*)(P.ws + WS_GATE);
    const int tid = tidx(), lane = tid & 63, w = tid >> 6, r32 = lane & 31, hi = lane >> 5;
    for (int u = blockIdx.x; u < (T / 128) * PH; u += gridDim.x) {
        const int tm = u >> 3, h = u & 7;
        float L0[16], L1[16];
        {
            f32x16 acc[4]; float ssd[4];
            gemm_kloop<1, false>(Wc + (size_t)((h * 2 + 0) * 128) * D, D, XN + (size_t)(tm * 128) * D, D, D / 64, acc, ssd, lds, tid);
            lane_top16(acc[0], acc[1], acc[2], acc[3], hi, L0);
            float o[16];
#pragma unroll
            for (int i = 0; i < 16; ++i) o[i] = __shfl_xor(L0[i], 32, 64);
            merge16_desc(L0, o);
        }
        {
            f32x16 acc[4]; float ssd[4];
            gemm_kloop<1, false>(Wc + (size_t)((h * 2 + 1) * 128) * D, D, XN + (size_t)(tm * 128) * D, D, D / 64, acc, ssd, lds, tid);
            lane_top16(acc[0], acc[1], acc[2], acc[3], hi, L1);
            float o[16];
#pragma unroll
            for (int i = 0; i < 16; ++i) o[i] = __shfl_xor(L1[i], 32, 64);
            merge16_desc(L1, o);
        }
        float c[16];
        cand_top16(L0, L1, c);
        __syncthreads();
        unsigned char* my = (unsigned char*)lds + tid * 32;
        {
            uint4 a, b;
#define PK4(L, i) ((__float_as_uint(L[i]) & 127u) | ((__float_as_uint(L[i + 1]) & 127u) << 8) | ((__float_as_uint(L[i + 2]) & 127u) << 16) | ((__float_as_uint(L[i + 3]) & 127u) << 24))
            a.x = PK4(L0, 0); a.y = PK4(L0, 4); a.z = PK4(L0, 8); a.w = PK4(L0, 12);
            b.x = PK4(L1, 0); b.y = PK4(L1, 4); b.z = PK4(L1, 8); b.w = PK4(L1, 12);
#undef PK4
            *(uint4*)my = a; *(uint4*)(my + 16) = b;
        }
        int ev[16]; float gv[16]; float den = 0.f;
#pragma unroll
        for (int k = 0; k < 16; ++k) {
            const unsigned ci = __float_as_uint(c[k]) & 255u;
            const int n1 = my[ci >> 4], n2 = my[16 + (ci & 15)];
            ev[k] = n1 * NKEY + n2;
            gv[k] = __expf(c[k] - c[0]); den += gv[k];
        }
        const float iden = 1.f / den;
        if (hi == 0) {
            const int t = tm * 128 + w * 32 + r32;
            uint4* ep = (uint4*)(EXPp + (size_t)t * HK + h * 16);
            float4* gp = (float4*)(GATEp + (size_t)t * HK + h * 16);
#pragma unroll
            for (int q = 0; q < 4; ++q) {
                ep[q] = make_uint4((unsigned)ev[4 * q], (unsigned)ev[4 * q + 1], (unsigned)ev[4 * q + 2], (unsigned)ev[4 * q + 3]);
                gp[q] = make_float4(gv[4 * q] * iden, gv[4 * q + 1] * iden, gv[4 * q + 2] * iden, gv[4 * q + 3] * iden);
            }
        }
        __syncthreads();
    }
}

__device__ __forceinline__ float red16(float (&p)[16], int lane) {
#pragma unroll
    for (int i = 0; i < 8; ++i) { const bool up = lane & 32; const float send = up ? p[i] : p[i + 8], keep = up ? p[i + 8] : p[i]; p[i] = keep + __shfl_xor(send, 32, 64); }
#pragma unroll
    for (int i = 0; i < 4; ++i) { const bool up = lane & 16; const float send = up ? p[i] : p[i + 4], keep = up ? p[i + 4] : p[i]; p[i] = keep + __shfl_xor(send, 16, 64); }
#pragma unroll
    for (int i = 0; i < 2; ++i) { const bool up = lane & 8; const float send = up ? p[i] : p[i + 2], keep = up ? p[i + 2] : p[i]; p[i] = keep + __shfl_xor(send, 8, 64); }
    { const bool up = lane & 4; const float send = up ? p[0] : p[1], keep = up ? p[1] : p[0]; p[0] = keep + __shfl_xor(send, 4, 64); }
    float r = p[0];
    r += __shfl_xor(r, 2, 64); r += __shfl_xor(r, 1, 64);
    return r;
}

__device__ __forceinline__ void phase_gather(const Params& P, int l) {
    const bf16* XN = (const bf16*)(P.ws + WS_XN);
    bf16* XNw = (bf16*)(P.ws + WS_XN);
    const int* EXPp = (const int*)(P.ws + WS_EXP);
    const float* GATEp = (const float*)(P.ws + WS_GATE);
    const unsigned char* U = P.ws + WS_TABU + (size_t)l * NEXP * TAB_ROWB;
    const unsigned char* V = P.ws + WS_TABV + (size_t)l * NEXP * TAB_ROWB;
    const float* SU = (const float*)(P.ws + WS_TSCU) + (size_t)l * NEXP;
    const float* SV = (const float*)(P.ws + WS_TSCV) + (size_t)l * NEXP;
    const int lane = tidx() & 63;
    for (int t = gwave(); t < T; t += nwave()) {
        const int e_lo = EXPp[(size_t)t * HK + lane], e_hi = EXPp[(size_t)t * HK + 64 + lane];
#if TAB_FP8
        float xf[16];
        {
            const uint4 a = ((const uint4*)(XN + (size_t)t * D))[lane * 2], b = ((const uint4*)(XN + (size_t)t * D))[lane * 2 + 1];
            xf[0] = bflo(a.x); xf[1] = bfhi(a.x); xf[2] = bflo(a.y); xf[3] = bfhi(a.y); xf[4] = bflo(a.z); xf[5] = bfhi(a.z); xf[6] = bflo(a.w); xf[7] = bfhi(a.w);
            xf[8] = bflo(b.x); xf[9] = bfhi(b.x); xf[10] = bflo(b.y); xf[11] = bfhi(b.y); xf[12] = bflo(b.z); xf[13] = bfhi(b.z); xf[14] = bflo(b.w); xf[15] = bfhi(b.w);
        }
#else
        const uint4 xa = ((const uint4*)(XN + (size_t)t * D))[lane], xb = ((const uint4*)(XN + (size_t)t * D))[64 + lane];
#endif
        float acc[16];
#pragma unroll
        for (int i = 0; i < 16; ++i) acc[i] = 0.f;
        for (int c = 0; c < 8; ++c) {
            const int esel = (c < 4) ? e_lo : e_hi;
            const int kb = (c & 3) * 16;
            float part[16];
#pragma unroll
            for (int hb = 0; hb < 2; ++hb) {
#if TAB_FP8
                uint4 r[8];
#pragma unroll
                for (int i = 0; i < 8; ++i) { const int e = __builtin_amdgcn_readlane(esel, kb + hb * 8 + i); r[i] = *(const uint4*)(U + (size_t)e * 1024 + lane * 16); }
#pragma unroll
                for (int i = 0; i < 8; ++i) {
                    float d0 = 0.f, d1 = 0.f;
                    const unsigned w[4] = {r[i].x, r[i].y, r[i].z, r[i].w};
#pragma unroll
                    for (int q = 0; q < 4; ++q) {
                        const auto lo = __builtin_amdgcn_cvt_pk_f32_fp8((int)w[q], false); const auto hh = __builtin_amdgcn_cvt_pk_f32_fp8((int)w[q], true);
                        d0 = fmaf(xf[4 * q], lo[0], d0); d1 = fmaf(xf[4 * q + 1], lo[1], d1); d0 = fmaf(xf[4 * q + 2], hh[0], d0); d1 = fmaf(xf[4 * q + 3], hh[1], d1);
                    }
                    part[hb * 8 + i] = d0 + d1;
                }
#else
                uint4 r0[8], r1[8];
#pragma unroll
                for (int i = 0; i < 8; ++i) { const int e = __builtin_amdgcn_readlane(esel, kb + hb * 8 + i); const unsigned char* rp = U + (size_t)e * 2048 + lane * 16; r0[i] = *(const uint4*)(rp); r1[i] = *(const uint4*)(rp + 1024); }
#pragma unroll
                for (int i = 0; i < 8; ++i) {
                    float d0 = 0.f, d1 = 0.f;
                    d0 = dot2bf(xa.x, r0[i].x, d0); d1 = dot2bf(xa.y, r0[i].y, d1); d0 = dot2bf(xa.z, r0[i].z, d0); d1 = dot2bf(xa.w, r0[i].w, d1);
                    d0 = dot2bf(xb.x, r1[i].x, d0); d1 = dot2bf(xb.y, r1[i].y, d1); d0 = dot2bf(xb.z, r1[i].z, d0); d1 = dot2bf(xb.w, r1[i].w, d1);
                    part[hb * 8 + i] = d0 + d1;
                }
#endif
            }
            float dsum = red16(part, lane);
            const int kk = c * 16 + (lane >> 2);
            const int eme = __shfl(esel, kb + (lane >> 2), 64);
            float wv = GATEp[(size_t)t * HK + kk];
#if TAB_FP8
            dsum *= SU[eme];
            wv *= SV[eme];
#endif
            wv *= gelu_exact(dsum);
#pragma unroll
            for (int hb = 0; hb < 2; ++hb) {
#if TAB_FP8
                uint4 r[8];
#pragma unroll
                for (int i = 0; i < 8; ++i) { const int e = __builtin_amdgcn_readlane(esel, kb + hb * 8 + i); r[i] = *(const uint4*)(V + (size_t)e * 1024 + lane * 16); }
#pragma unroll
                for (int i = 0; i < 8; ++i) {
                    const float w = __int_as_float(__builtin_amdgcn_readlane(__float_as_int(wv), (hb * 8 + i) * 4));
                    const unsigned ww[4] = {r[i].x, r[i].y, r[i].z, r[i].w};
#pragma unroll
                    for (int q = 0; q < 4; ++q) {
                        const auto lo = __builtin_amdgcn_cvt_pk_f32_fp8((int)ww[q], false); const auto hh = __builtin_amdgcn_cvt_pk_f32_fp8((int)ww[q], true);
                        acc[4 * q] = fmaf(w, lo[0], acc[4 * q]); acc[4 * q + 1] = fmaf(w, lo[1], acc[4 * q + 1]); acc[4 * q + 2] = fmaf(w, hh[0], acc[4 * q + 2]); acc[4 * q + 3] = fmaf(w, hh[1], acc[4 * q + 3]);
                    }
                }
#else
                uint4 r0[8], r1[8];
#pragma unroll
                for (int i = 0; i < 8; ++i) { const int e = __builtin_amdgcn_readlane(esel, kb + hb * 8 + i); const unsigned char* rp = V + (size_t)e * 2048 + lane * 16; r0[i] = *(const uint4*)(rp); r1[i] = *(const uint4*)(rp + 1024); }
#pragma unroll
                for (int i = 0; i < 8; ++i) {
                    const float w = __int_as_float(__builtin_amdgcn_readlane(__float_as_int(wv), (hb * 8 + i) * 4));
                    acc[0] = fmaf(w, bflo(r0[i].x), acc[0]); acc[1] = fmaf(w, bfhi(r0[i].x), acc[1]); acc[2] = fmaf(w, bflo(r0[i].y), acc[2]); acc[3] = fmaf(w, bfhi(r0[i].y), acc[3]);
                    acc[4] = fmaf(w, bflo(r0[i].z), acc[4]); acc[5] = fmaf(w, bfhi(r0[i].z), acc[5]); acc[6] = fmaf(w, bflo(r0[i].w), acc[6]); acc[7] = fmaf(w, bfhi(r0[i].w), acc[7]);
                    acc[8] = fmaf(w, bflo(r1[i].x), acc[8]); acc[9] = fmaf(w, bfhi(r1[i].x), acc[9]); acc[10] = fmaf(w, bflo(r1[i].y), acc[10]); acc[11] = fmaf(w, bfhi(r1[i].y), acc[11]);
                    acc[12] = fmaf(w, bflo(r1[i].z), acc[12]); acc[13] = fmaf(w, bfhi(r1[i].z), acc[13]); acc[14] = fmaf(w, bflo(r1[i].w), acc[14]); acc[15] = fmaf(w, bfhi(r1[i].w), acc[15]);
                }
#endif
            }
        }
        float* hrow = P.out + (size_t)t * D;
#if TAB_FP8
        const int c0 = lane * 16, c1 = lane * 16 + 8;
#else
        const int c0 = lane * 8, c1 = 512 + lane * 8;
#endif
        float4 h0 = *(const float4*)(hrow + c0), h1 = *(const float4*)(hrow + c0 + 4), h2 = *(const float4*)(hrow + c1), h3 = *(const float4*)(hrow + c1 + 4);
        h0.x += acc[0]; h0.y += acc[1]; h0.z += acc[2]; h0.w += acc[3]; h1.x += acc[4]; h1.y += acc[5]; h1.z += acc[6]; h1.w += acc[7];
        h2.x += acc[8]; h2.y += acc[9]; h2.z += acc[10]; h2.w += acc[11]; h3.x += acc[12]; h3.y += acc[13]; h3.z += acc[14]; h3.w += acc[15];
        float ss = h0.x * h0.x + h0.y * h0.y + h0.z * h0.z + h0.w * h0.w + h1.x * h1.x + h1.y * h1.y + h1.z * h1.z + h1.w * h1.w
                 + h2.x * h2.x + h2.y * h2.y + h2.z * h2.z + h2.w * h2.w + h3.x * h3.x + h3.y * h3.y + h3.z * h3.z + h3.w * h3.w;
        ss = wave_sum(ss);
        const float rn = rsqrtf(ss * (1.f / D) + EPS);
        if (l == DEPTH - 1) {
            const float* g = P.norm_final;
            const float4 g0 = *(const float4*)(g + c0), g1 = *(const float4*)(g + c0 + 4), g2 = *(const float4*)(g + c1), g3 = *(const float4*)(g + c1 + 4);
            *(float4*)(hrow + c0) = make_float4(h0.x * rn * g0.x, h0.y * rn * g0.y, h0.z * rn * g0.z, h0.w * rn * g0.w);
            *(float4*)(hrow + c0 + 4) = make_float4(h1.x * rn * g1.x, h1.y * rn * g1.y, h1.z * rn * g1.z, h1.w * rn * g1.w);
            *(float4*)(hrow + c1) = make_float4(h2.x * rn * g2.x, h2.y * rn * g2.y, h2.z * rn * g2.z, h2.w * rn * g2.w);
            *(float4*)(hrow + c1 + 4) = make_float4(h3.x * rn * g3.x, h3.y * rn * g3.y, h3.z * rn * g3.z, h3.w * rn * g3.w);
        } else {
            *(float4*)(hrow + c0) = h0; *(float4*)(hrow + c0 + 4) = h1; *(float4*)(hrow + c1) = h2; *(float4*)(hrow + c1 + 4) = h3;
            const float* g = P.norm_mix + (l + 1) * D;
            const float4 g0 = *(const float4*)(g + c0), g1 = *(const float4*)(g + c0 + 4), g2 = *(const float4*)(g + c1), g3 = *(const float4*)(g + c1 + 4);
            uint4 o0, o1;
            o0.x = pack2(h0.x * rn * g0.x, h0.y * rn * g0.y); o0.y = pack2(h0.z * rn * g0.z, h0.w * rn * g0.w); o0.z = pack2(h1.x * rn * g1.x, h1.y * rn * g1.y); o0.w = pack2(h1.z * rn * g1.z, h1.w * rn * g1.w);
            o1.x = pack2(h2.x * rn * g2.x, h2.y * rn * g2.y); o1.y = pack2(h2.z * rn * g2.z, h2.w * rn * g2.w); o1.z = pack2(h3.x * rn * g3.x, h3.y * rn * g3.y); o1.w = pack2(h3.z * rn * g3.z, h3.w * rn * g3.w);
            *(uint4*)(XNw + (size_t)t * D + c0) = o0; *(uint4*)(XNw + (size_t)t * D + c1) = o1;
        }
    }
}


#define XB_TMO      128
#define XB_XCNT(j)  (256  + 64 * (j))
#define XB_XSUB(j)  (1280 + 64 * (j))
#define XB_XGEN(j)  (2304 + 64 * (j))
#define XB_TOP      3328
#define XB_TOPGEN   3392
#define XCD_BAR_WORDS 3456
#define XB_SPIN_CAP (1u << 22)
#define LAS __attribute__((address_space(3)))
__device__ __forceinline__ unsigned xb_ld(unsigned* p)              { return __hip_atomic_load(p, __ATOMIC_RELAXED, __HIP_MEMORY_SCOPE_AGENT); }
__device__ __forceinline__ unsigned xb_add(unsigned* p, unsigned v) { return __hip_atomic_fetch_add(p, v, __ATOMIC_RELAXED, __HIP_MEMORY_SCOPE_AGENT); }
__device__ __forceinline__ unsigned xb_xcc_id() { return (unsigned)__builtin_amdgcn_s_getreg((3 << 11) | 20) & 0xFu; }
#define XB_SPIN(cond, bar) do { unsigned _sp = 0; while (cond) { __builtin_amdgcn_s_sleep(1); \
    if ((++_sp & 255u) == 0u) { if (xb_ld(&(bar)[XB_TMO])) break; if (_sp > XB_SPIN_CAP) { atomicAdd(&(bar)[XB_TMO], 1u); break; } } } } while (0)
struct XcdBarrier { unsigned* bar; unsigned x; volatile LAS unsigned* st; };
__device__ __forceinline__ XcdBarrier xcd_barrier_post(unsigned* bar, volatile LAS unsigned* st) {
    XcdBarrier b; b.bar = bar; b.x = xb_xcc_id(); b.st = st;
    if (__builtin_amdgcn_workitem_id_x() == 0) (void)xb_add(&bar[XB_XCNT(b.x)], 1u);
    return b;
}
__device__ __forceinline__ void xcd_barrier_complete(unsigned* bar, unsigned x, unsigned& nloc, unsigned& nx) {
    const unsigned G = gridDim.x * gridDim.y * gridDim.z;
    unsigned sum, cnt, mine, sp = 0u;
    for (;;) {
        sum = 0u; cnt = 0u; mine = 0u;
#pragma unroll
        for (unsigned j = 0; j < 16; ++j) { const unsigned c = xb_ld(&bar[XB_XCNT(j)]); sum += c; cnt += (c > 0u) ? 1u : 0u; mine = (j == x) ? c : mine; }
        if (sum == G) break;
        __builtin_amdgcn_s_sleep(1);
        if ((++sp & 255u) == 0u) { if (xb_ld(&bar[XB_TMO])) break; if (sp > XB_SPIN_CAP) { atomicAdd(&bar[XB_TMO], 1u); break; } }
    }
    nloc = mine > 0u ? mine : 1u; nx = cnt > 0u ? cnt : 1u;
}
__device__ __forceinline__ void xcd_barrier(const XcdBarrier& b) {
    asm volatile("s_waitcnt vmcnt(0)" ::: "memory");
    __syncthreads();
    if (__builtin_amdgcn_workitem_id_x() == 0) {
        unsigned* bar = b.bar;
        __builtin_amdgcn_s_waitcnt(0);
        unsigned nloc = b.st[0], nx = b.st[1];
        if (nloc == 0u) { xcd_barrier_complete(bar, b.x, nloc, nx); b.st[0] = nloc; b.st[1] = nx; }
        const unsigned old = xb_add(&bar[XB_XSUB(b.x)], 1u);
        const unsigned gen = old / nloc;
        if (old + 1u == (gen + 1u) * nloc) {
            __builtin_amdgcn_fence(__ATOMIC_RELEASE, "agent");
            asm volatile("s_waitcnt vmcnt(0)" ::: "memory");
            const unsigned og = xb_add(&bar[XB_TOP], 1u);
            const unsigned tg = og / nx;
            if (og + 1u == (tg + 1u) * nx) xb_add(&bar[XB_TOPGEN], 1u);
            else XB_SPIN(xb_ld(&bar[XB_TOPGEN]) == tg, bar);
            __builtin_amdgcn_fence(__ATOMIC_ACQUIRE, "agent");
            xb_add(&bar[XB_XGEN(b.x)], 1u);
            asm volatile("s_waitcnt vmcnt(0)" ::: "memory");
        } else {
            XB_SPIN(xb_ld(&bar[XB_XGEN(b.x)]) == gen, bar);
            __builtin_amdgcn_fence(__ATOMIC_ACQUIRE, "agent");
            asm volatile("s_waitcnt vmcnt(0)" ::: "memory");
        }
    }
    __syncthreads();
}

constexpr float QSCALE = 0.10206207261596575f * 1.4426950408889634f;

__device__ __forceinline__ void phase_gemm1(const Params& P, int l, char* lds) {
    unsigned char* ws = P.ws;
    const bf16* XN = (const bf16*)(ws + WS_XN);
    bf16* PROJ = (bf16*)(ws + WS_PROJ);
    bf16* Kb = (bf16*)(ws + WS_K);
    const float* rope = (const float*)(ws + WS_ROPE);
    const bf16* W = (const bf16*)(ws + WS_WIN) + (size_t)l * DINP * D;
    gemm_t<false>(W, D, DINP, XN, D, T, D, [&](int n0, int t0, const f32x16& acc, int r32, int hi, float) {
        const int t = t0 + r32;
        if (n0 < C_KR) {
            bf16* pr = PROJ + (size_t)t * DINP + n0 + 4 * hi;
#pragma unroll
            for (int g = 0; g < 4; ++g) { uint2 o; o.x = cvtpk(acc[4 * g], acc[4 * g + 1]); o.y = cvtpk(acc[4 * g + 2], acc[4 * g + 3]); *(uint2*)(pr + 8 * g) = o; }
        } else if (n0 == C_KR) {
            const int b = t / S, s = t % S;
            uint2 o1[2], o2[2];
#pragma unroll
            for (int g = 0; g < 2; ++g) {
                const float4 cs0 = *(const float4*)(rope + ((size_t)s * 16 + 8 * g + 4 * hi) * 2), cs1 = *(const float4*)(rope + ((size_t)s * 16 + 8 * g + 4 * hi) * 2 + 4);
                const float x10 = acc[4 * g], x11 = acc[4 * g + 1], x12 = acc[4 * g + 2], x13 = acc[4 * g + 3];
                const float x20 = acc[8 + 4 * g], x21 = acc[8 + 4 * g + 1], x22 = acc[8 + 4 * g + 2], x23 = acc[8 + 4 * g + 3];
                o1[g].x = cvtpk(x10 * cs0.x - x20 * cs0.y, x11 * cs0.z - x21 * cs0.w); o1[g].y = cvtpk(x12 * cs1.x - x22 * cs1.y, x13 * cs1.z - x23 * cs1.w);
                o2[g].x = cvtpk(x20 * cs0.x + x10 * cs0.y, x21 * cs0.z + x11 * cs0.w); o2[g].y = cvtpk(x22 * cs1.x + x12 * cs1.y, x23 * cs1.z + x13 * cs1.w);
            }
#pragma unroll
            for (int h = 0; h < NH; ++h) {
                bf16* kr = Kb + ((size_t)(b * NH + h) * S + s) * DQK + 64 + 4 * hi;
                *(uint2*)(kr) = o1[0]; *(uint2*)(kr + 8) = o1[1]; *(uint2*)(kr + 16) = o2[0]; *(uint2*)(kr + 24) = o2[1];
            }
        }
    }, lds);
}
__device__ __forceinline__ void phase_gemm2(const Params& P, int l, char* lds) {
    unsigned char* ws = P.ws;
    const bf16* PROJ = (const bf16*)(ws + WS_PROJ);
    const float* rope = (const float*)(ws + WS_ROPE);
    {
        const bf16* W = (const bf16*)(ws + WS_WUQ) + (size_t)l * 768 * QR;
        bf16* Qb = (bf16*)(ws + WS_Q);
        gemm_t<true>(W, QR, 768, PROJ + C_CQ, DINP, T, QR, [&](int n0, int t0, const f32x16& acc, int r32, int hi, float ssq) {
            const int t = t0 + r32, b = t / S, s = t % S;
            const int h = n0 / DQK, d0 = n0 % DQK;
            const float sc = rsqrtf(ssq * (1.f / QR) + EPS) * QSCALE;
            bf16* qb = Qb + ((size_t)(b * NH + h) * S + s) * DQK + d0 + 4 * hi;
            if (d0 == 64) {
#pragma unroll
                for (int g = 0; g < 2; ++g) {
                    const float4 cs0 = *(const float4*)(rope + ((size_t)s * 16 + 8 * g + 4 * hi) * 2), cs1 = *(const float4*)(rope + ((size_t)s * 16 + 8 * g + 4 * hi) * 2 + 4);
                    const float x10 = acc[4 * g] * sc, x11 = acc[4 * g + 1] * sc, x12 = acc[4 * g + 2] * sc, x13 = acc[4 * g + 3] * sc;
                    const float x20 = acc[8 + 4 * g] * sc, x21 = acc[8 + 4 * g + 1] * sc, x22 = acc[8 + 4 * g + 2] * sc, x23 = acc[8 + 4 * g + 3] * sc;
                    uint2 o1, o2;
                    o1.x = cvtpk(x10 * cs0.x - x20 * cs0.y, x11 * cs0.z - x21 * cs0.w); o1.y = cvtpk(x12 * cs1.x - x22 * cs1.y, x13 * cs1.z - x23 * cs1.w);
                    o2.x = cvtpk(x20 * cs0.x + x10 * cs0.y, x21 * cs0.z + x11 * cs0.w); o2.y = cvtpk(x22 * cs1.x + x12 * cs1.y, x23 * cs1.z + x13 * cs1.w);
                    *(uint2*)(qb + 8 * g) = o1; *(uint2*)(qb + 16 + 8 * g) = o2;
                }
            } else {
#pragma unroll
                for (int g = 0; g < 4; ++g) { uint2 o; o.x = cvtpk(acc[4 * g] * sc, acc[4 * g + 1] * sc); o.y = cvtpk(acc[4 * g + 2] * sc, acc[4 * g + 3] * sc); *(uint2*)(qb + 8 * g) = o; }
            }
        }, lds);
    }
    {
        const bf16* W = (const bf16*)(ws + WS_WUKV) + (size_t)l * 1024 * KVR;
        bf16* Kb = (bf16*)(ws + WS_K); bf16* Vb = (bf16*)(ws + WS_V);
        gemm_t<true>(W, KVR, 1024, PROJ + C_CKV, DINP, T, KVR, [&](int n0, int t0, const f32x16& acc, int r32, int hi, float ssq) {
            const int t = t0 + r32, b = t / S, s = t % S;
            const float sc = rsqrtf(ssq * (1.f / KVR) + EPS);
            bf16* dst;
            if (n0 < 512) dst = Kb + ((size_t)(b * NH + (n0 >> 6)) * S + s) * DQK + (n0 & 63) + 4 * hi;
            else          dst = Vb + ((size_t)(b * NH + ((n0 - 512) >> 6)) * S + s) * DV + (n0 & 63) + 4 * hi;
#pragma unroll
            for (int g = 0; g < 4; ++g) { uint2 o; o.x = cvtpk(acc[4 * g] * sc, acc[4 * g + 1] * sc); o.y = cvtpk(acc[4 * g + 2] * sc, acc[4 * g + 3] * sc); *(uint2*)(dst + 8 * g) = o; }
        }, lds);
    }
}
__device__ __forceinline__ void phase_gemm3(const Params& P, int l, char* lds) {
    unsigned char* ws = P.ws;
    const bf16* Yb = (const bf16*)(ws + WS_XN);
    const bf16* W = (const bf16*)(ws + WS_WOUT) + (size_t)l * D * D;
    const float* hin = (l == 0) ? P.x : P.out;
    float* out = P.out;
    gemm_t<false>(W, D, D, Yb, D, T, D, [&](int n0, int t0, const f32x16& acc, int r32, int hi, float) {
        const size_t base = (size_t)(t0 + r32) * D + n0 + 4 * hi;
#pragma unroll
        for (int g = 0; g < 4; ++g) {
            const float4 hv = *(const float4*)(hin + base + 8 * g);
            *(float4*)(out + base + 8 * g) = make_float4(hv.x + acc[4 * g], hv.y + acc[4 * g + 1], hv.z + acc[4 * g + 2], hv.w + acc[4 * g + 3]);
        }
    }, lds);
}

#define GSYNC() do { XcdBarrier xb_; xb_.bar = (unsigned*)(P.ws + WS_CTL); xb_.x = xb_xcc_id(); xb_.st = (volatile LAS unsigned*)&xb_words; xcd_barrier(xb_); } while (0)
#define PHASE(stmt) { const Params Q = launder(P); stmt; }
__global__ void __launch_bounds__(NTHREADS, 2) k_all(Params P) {
    __shared__ __attribute__((aligned(16))) char sm[LDS_TOTAL];
    __shared__ uint4 xb_words;
    cg::grid_group grid = cg::this_grid();
    if (__builtin_amdgcn_workitem_id_x() == 0) xb_words = make_uint4(0u, 0u, 0u, 0u);
    __syncthreads();
    (void)xcd_barrier_post((unsigned*)(P.ws + WS_CTL), (volatile LAS unsigned*)&xb_words);
    PHASE(phase_prep(Q, sm));
    PHASE(phase_norm(Q.x, Q.norm_mix, (bf16*)(Q.ws + WS_XN)));
    grid.sync();
    for (int l = 0; l < DEPTH; ++l) {
        PHASE(phase_gemm1(Q, l, sm));
#if PROBE_DUP & 2
        PHASE(phase_gemm1(Q, l, sm));
#endif
        GSYNC();
        PHASE(phase_mixlocal(Q, l, sm));
#if PROBE_DUP & 256
        PHASE(phase_mixlocal(Q, l, sm));
#endif
        PHASE(phase_gemm2(Q, l, sm));
        GSYNC();
        PHASE(phase_attn(Q, sm));
        GSYNC();
        PHASE(phase_gemm3(Q, l, sm));
#if PROBE_DUP & 16
        if (l == 0) PHASE(phase_gemm3(Q, l, sm));
#endif
        GSYNC();
        PHASE(phase_norm(Q.out, Q.norm_ffn + l * D, (bf16*)(Q.ws + WS_XN)));
        GSYNC();
        PHASE(phase_route(Q, l, sm));
        GSYNC();
        PHASE(phase_gather(Q, l));
        GSYNC();
    }
}

extern "C" void kernel_launch(void* const* d_in, const int* in_sizes, int n_in, void* d_out, int out_size, void* d_ws, size_t ws_size, hipStream_t stream) {
    static int grid = 0;
    if (grid == 0) {
        if (n_in != 18 || out_size != T * D || ws_size < WS_END) { fprintf(stderr, "kernel_launch: bad sizes n_in %d out %d ws %zu need %zu\n", n_in, out_size, ws_size, (size_t)WS_END); grid = -1; return; }
        int dev = 0, cus = 0, per_cu = 0;
        (void)hipGetDevice(&dev);
        (void)hipDeviceGetAttribute(&cus, hipDeviceAttributeMultiprocessorCount, dev);
        (void)hipOccupancyMaxActiveBlocksPerMultiprocessor(&per_cu, (const void*)k_all, NTHREADS, 0);
        if (per_cu > 2) per_cu = 2;
        if (per_cu < 1) { fprintf(stderr, "kernel_launch: occupancy query says %d\n", per_cu); grid = -1; return; }
        grid = cus * per_cu;
    }
    if (grid < 0) return;
    Params p{};
    p.x = (const float*)d_in[0]; p.norm_mix = (const float*)d_in[1]; p.w_in = (const float*)d_in[2]; p.conv_w = (const float*)d_in[3];
    p.pool_w = (const float*)d_in[4]; p.pool_scale = (const float*)d_in[5]; p.q_norm = (const float*)d_in[6]; p.w_uq = (const float*)d_in[7];
    p.kv_norm = (const float*)d_in[8]; p.w_uk = (const float*)d_in[9]; p.w_uv = (const float*)d_in[10]; p.w_out = (const float*)d_in[11];
    p.norm_ffn = (const float*)d_in[12]; p.peer_wq = (const float*)d_in[13]; p.peer_subkeys = (const float*)d_in[14]; p.peer_u = (const float*)d_in[15];
    p.peer_v = (const float*)d_in[16]; p.norm_final = (const float*)d_in[17];
    p.out = (float*)d_out; p.ws = (unsigned char*)d_ws;
    if (hipMemsetAsync((char*)d_ws + WS_CTL, 0, XCD_BAR_WORDS * 4, stream) != hipSuccess) { fprintf(stderr, "kernel_launch: memset failed\n"); return; }
    void* args[] = {&p};
    hipError_t e = hipLaunchCooperativeKernel((const void*)k_all, dim3(grid), dim3(NTHREADS), args, 0, stream);
    if (e != hipSuccess) fprintf(stderr, "cooperative launch failed: %s (grid %d)\n", hipGetErrorString(e), grid);
}
```

```cpp
#include <hip/hip_runtime.h>
#include <hip/hip_cooperative_groups.h>
#include <cstdio>
#include <cstdint>
namespace cg = cooperative_groups;

#ifndef TAB_FP8
#define TAB_FP8 1
#endif
#ifndef PROBE_DUP
#define PROBE_DUP 0
#endif

constexpr int NB = 4, S = 8192, T = NB * S, D = 1024, DEPTH = 2;
constexpr int DIN = 1696, DINP = 1792;
constexpr int C_BG = 0, C_CG = 256, C_HC = 512, C_HP = 768, C_CQ = 1024, C_CKV = 1408, C_KR = 1664;
constexpr int QR = 384, KVR = 256, NH = 8, DQK = 96, DV = 64;
constexpr int PH = 8, NKEY = 128, NEXP = NKEY * NKEY, TOPK = 16, HK = PH * TOPK;
constexpr float EPS = 1e-6f;

typedef unsigned short bf16;

constexpr size_t WS_CTL   = 0;
constexpr size_t WS_ROPE  = 64 * 1024;
constexpr size_t WS_WIN   = WS_ROPE + (size_t)S * 16 * 2 * 4;
constexpr size_t WS_WUQ   = WS_WIN + (size_t)DEPTH * DINP * D * 2;
constexpr size_t WS_WUKV  = WS_WUQ + (size_t)DEPTH * 768 * QR * 2;
constexpr size_t WS_WOUT  = WS_WUKV + (size_t)DEPTH * 1024 * KVR * 2;
constexpr size_t WS_WPQ   = WS_WOUT + (size_t)DEPTH * D * D * 2;
constexpr size_t WS_XN    = ((WS_WPQ + (size_t)DEPTH * 2048 * D * 2 + 4095) / 4096) * 4096;
constexpr size_t WS_PROJ  = WS_XN + (size_t)T * D * 2;
constexpr size_t WS_Q     = WS_PROJ + (size_t)T * DINP * 2;
constexpr size_t WS_K     = WS_Q + (size_t)T * NH * DQK * 2;
constexpr size_t WS_V     = WS_K + (size_t)T * NH * DQK * 2;
constexpr size_t WS_EXP   = WS_V + (size_t)T * NH * DV * 2;
constexpr size_t WS_GATE  = WS_EXP + (size_t)T * HK * 4;
constexpr size_t TAB_ROWB = TAB_FP8 ? 1024 : 2048;
constexpr size_t WS_TABU  = WS_GATE + (size_t)T * HK * 4;
constexpr size_t WS_TABV  = WS_TABU + (size_t)DEPTH * NEXP * TAB_ROWB;
constexpr size_t WS_TSCU  = WS_TABV + (size_t)DEPTH * NEXP * TAB_ROWB;
constexpr size_t WS_TSCV  = WS_TSCU + (size_t)DEPTH * NEXP * 4;
constexpr size_t WS_END   = WS_TSCV + (size_t)DEPTH * NEXP * 4;
static_assert(WS_END <= (size_t)512 * 1024 * 1024, "workspace budget");

struct Params {
    const float* x; const float* norm_mix; const float* w_in; const float* conv_w; const float* pool_w; const float* pool_scale;
    const float* q_norm; const float* w_uq; const float* kv_norm; const float* w_uk; const float* w_uv; const float* w_out;
    const float* norm_ffn; const float* peer_wq; const float* peer_subkeys; const float* peer_u; const float* peer_v; const float* norm_final;
    float* out; unsigned char* ws;
};

__device__ __forceinline__ bf16 f2bf(float f) { unsigned u = __float_as_uint(f); u += 0x7fffu + ((u >> 16) & 1u); return (bf16)(u >> 16); }
__device__ __forceinline__ float bf2f(bf16 h) { return __uint_as_float(((unsigned)h) << 16); }
__device__ __forceinline__ float bflo(unsigned u) { return __uint_as_float(u << 16); }
__device__ __forceinline__ float bfhi(unsigned u) { return __uint_as_float(u & 0xffff0000u); }
__device__ __forceinline__ unsigned pack2(float a, float b) { return (unsigned)f2bf(a) | ((unsigned)f2bf(b) << 16); }
__device__ __forceinline__ float wave_sum(float v) {
#pragma unroll
    for (int m = 32; m >= 1; m >>= 1) v += __shfl_xor(v, m, 64);
    return v;
}
__device__ __forceinline__ float gelu_exact(float x) { return 0.5f * x * (1.f + erff(x * 0.70710678118654752f)); }

#define NTHREADS 256
__device__ __forceinline__ int tidx() { int t = (int)__builtin_amdgcn_workitem_id_x(); asm volatile("" : "+v"(t)); return t; }
__device__ __forceinline__ int gwave() { return blockIdx.x * (NTHREADS / 64) + (tidx() >> 6); }
__device__ __forceinline__ int nwave() { return gridDim.x * (NTHREADS / 64); }
__device__ __forceinline__ size_t gtid() { return (size_t)blockIdx.x * NTHREADS + tidx(); }
__device__ __forceinline__ size_t gnth() { return (size_t)gridDim.x * NTHREADS; }


__device__ __forceinline__ Params launder(const Params& P) {
    typedef __attribute__((address_space(1))) char* gp_t;
    gp_t g[20] = {(gp_t)(char*)P.x, (gp_t)(char*)P.norm_mix, (gp_t)(char*)P.w_in, (gp_t)(char*)P.conv_w, (gp_t)(char*)P.pool_w, (gp_t)(char*)P.pool_scale, (gp_t)(char*)P.q_norm, (gp_t)(char*)P.w_uq,
                  (gp_t)(char*)P.kv_norm, (gp_t)(char*)P.w_uk, (gp_t)(char*)P.w_uv, (gp_t)(char*)P.w_out, (gp_t)(char*)P.norm_ffn, (gp_t)(char*)P.peer_wq, (gp_t)(char*)P.peer_subkeys,
                  (gp_t)(char*)P.peer_u, (gp_t)(char*)P.peer_v, (gp_t)(char*)P.norm_final, (gp_t)(char*)P.out, (gp_t)(char*)P.ws};
    asm volatile("" : "+s"(g[0]), "+s"(g[1]), "+s"(g[2]), "+s"(g[3]), "+s"(g[4]), "+s"(g[5]), "+s"(g[6]), "+s"(g[7]), "+s"(g[8]), "+s"(g[9]));
    asm volatile("" : "+s"(g[10]), "+s"(g[11]), "+s"(g[12]), "+s"(g[13]), "+s"(g[14]), "+s"(g[15]), "+s"(g[16]), "+s"(g[17]), "+s"(g[18]), "+s"(g[19]));
    Params Q;
    Q.x = (const float*)(char*)g[0]; Q.norm_mix = (const float*)(char*)g[1]; Q.w_in = (const float*)(char*)g[2]; Q.conv_w = (const float*)(char*)g[3]; Q.pool_w = (const float*)(char*)g[4];
    Q.pool_scale = (const float*)(char*)g[5]; Q.q_norm = (const float*)(char*)g[6]; Q.w_uq = (const float*)(char*)g[7]; Q.kv_norm = (const float*)(char*)g[8]; Q.w_uk = (const float*)(char*)g[9];
    Q.w_uv = (const float*)(char*)g[10]; Q.w_out = (const float*)(char*)g[11]; Q.norm_ffn = (const float*)(char*)g[12]; Q.peer_wq = (const float*)(char*)g[13]; Q.peer_subkeys = (const float*)(char*)g[14];
    Q.peer_u = (const float*)(char*)g[15]; Q.peer_v = (const float*)(char*)g[16]; Q.norm_final = (const float*)(char*)g[17]; Q.out = (float*)(char*)g[18]; Q.ws = (unsigned char*)(char*)g[19];
    return Q;
}

typedef __attribute__((ext_vector_type(8))) short bf16x8;
typedef __attribute__((ext_vector_type(16))) float f32x16;
typedef __attribute__((ext_vector_type(2))) __bf16 bf2_t;
#define MFMA32(a, b, c) __builtin_amdgcn_mfma_f32_32x32x16_bf16(a, b, c, 0, 0, 0)
__device__ __forceinline__ int crow(int r, int hi) { return (r & 3) + 8 * (r >> 2) + 4 * hi; }
__device__ __forceinline__ float dot2bf(unsigned a, unsigned b, float c) { return __builtin_amdgcn_fdot2_f32_bf16(__builtin_bit_cast(bf2_t, a), __builtin_bit_cast(bf2_t, b), c, false); }
__device__ __forceinline__ unsigned cvtpk(float lo, float hi) { unsigned r; asm("v_cvt_pk_bf16_f32 %0, %1, %2" : "=v"(r) : "v"(lo), "v"(hi)); return r; }
constexpr int G_LDT = 144;
constexpr int G_OPB = 128 * G_LDT;
constexpr int G_BUF = 2 * G_OPB;
constexpr int GEMM_LDS = 2 * G_BUF;
constexpr int LDS_TOTAL = GEMM_LDS + 512;

template <int WT, bool ROWSS>
__device__ __forceinline__ void gemm_kloop(const bf16* __restrict__ Ag0, int lda, const bf16* __restrict__ Bg0, int ldb, int nk, f32x16 (&acc)[4], float (&ss)[4], char* lds, int tid) {
    const int lane = tid & 63, w = tid >> 6, r32 = lane & 31, hi = lane >> 5;
    const int srow = tid >> 3, sch = tid & 7;
    const bf16* Ag = Ag0 + (size_t)srow * lda + sch * 8;
    const bf16* Bg = Bg0 + (size_t)srow * ldb + sch * 8;
#pragma unroll
    for (int i = 0; i < 4; ++i)
#pragma unroll
        for (int r = 0; r < 16; ++r) acc[i][r] = 0.f;
    ss[0] = 0.f; ss[1] = 0.f; ss[2] = 0.f; ss[3] = 0.f;
    uint4 pa0, pa1, pa2, pa3, pb0, pb1, pb2, pb3, qa0, qa1, qa2, qa3, qb0, qb1, qb2, qb3;
#define G_LOAD(S, kofs) do { \
    S##a0 = *(const uint4*)(Ag + (kofs)); S##a1 = *(const uint4*)(Ag + (size_t)32 * lda + (kofs)); S##a2 = *(const uint4*)(Ag + (size_t)64 * lda + (kofs)); S##a3 = *(const uint4*)(Ag + (size_t)96 * lda + (kofs)); \
    S##b0 = *(const uint4*)(Bg + (kofs)); S##b1 = *(const uint4*)(Bg + (size_t)32 * ldb + (kofs)); S##b2 = *(const uint4*)(Bg + (size_t)64 * ldb + (kofs)); S##b3 = *(const uint4*)(Bg + (size_t)96 * ldb + (kofs)); } while (0)
#define G_SS(s_, r_) do { s_ = dot2bf(r_.x, r_.x, s_); s_ = dot2bf(r_.y, r_.y, s_); s_ = dot2bf(r_.z, r_.z, s_); s_ = dot2bf(r_.w, r_.w, s_); } while (0)
#define G_STORE(S, buf) do { \
    char* wa = lds + (buf) * G_BUF + srow * G_LDT + sch * 16; char* wb = wa + G_OPB; \
    *(uint4*)(wa) = S##a0; *(uint4*)(wa + 32 * G_LDT) = S##a1; *(uint4*)(wa + 64 * G_LDT) = S##a2; *(uint4*)(wa + 96 * G_LDT) = S##a3; \
    *(uint4*)(wb) = S##b0; *(uint4*)(wb + 32 * G_LDT) = S##b1; *(uint4*)(wb + 64 * G_LDT) = S##b2; *(uint4*)(wb + 96 * G_LDT) = S##b3; \
    if (ROWSS) { G_SS(ss[0], S##b0); G_SS(ss[1], S##b1); G_SS(ss[2], S##b2); G_SS(ss[3], S##b3); } } while (0)
#define G_COMPUTE(buf) do { \
    const char* bA = lds + (buf) * G_BUF; const char* bB = bA + G_OPB; \
    if (WT == 0) { \
        const char* pa = bA + ((w >> 1) * 64 + r32) * G_LDT + hi * 16; \
        const char* pb = bB + ((w & 1) * 64 + r32) * G_LDT + hi * 16; \
        _Pragma("unroll") for (int ks = 0; ks < 4; ++ks) { \
            const bf16x8 a0 = *(const bf16x8*)(pa + ks * 32), a1 = *(const bf16x8*)(pa + 32 * G_LDT + ks * 32); \
            const bf16x8 b0 = *(const bf16x8*)(pb + ks * 32), b1 = *(const bf16x8*)(pb + 32 * G_LDT + ks * 32); \
            acc[0] = MFMA32(a0, b0, acc[0]); acc[1] = MFMA32(a0, b1, acc[1]); \
            acc[2] = MFMA32(a1, b0, acc[2]); acc[3] = MFMA32(a1, b1, acc[3]); } \
    } else { \
        const char* pa = bA + r32 * G_LDT + hi * 16; \
        const char* pb = bB + (w * 32 + r32) * G_LDT + hi * 16; \
        _Pragma("unroll") for (int ks = 0; ks < 4; ++ks) { \
            const bf16x8 b0 = *(const bf16x8*)(pb + ks * 32); \
            const bf16x8 a0 = *(const bf16x8*)(pa + ks * 32), a1 = *(const bf16x8*)(pa + 32 * G_LDT + ks * 32); \
            const bf16x8 a2 = *(const bf16x8*)(pa + 64 * G_LDT + ks * 32), a3 = *(const bf16x8*)(pa + 96 * G_LDT + ks * 32); \
            acc[0] = MFMA32(a0, b0, acc[0]); acc[1] = MFMA32(a1, b0, acc[1]); \
            acc[2] = MFMA32(a2, b0, acc[2]); acc[3] = MFMA32(a3, b0, acc[3]); } \
    } } while (0)
    G_LOAD(p, 0); G_LOAD(q, 64);
    for (int kt = 0; kt < nk; kt += 2) {
        G_STORE(p, 0);
        __syncthreads();
        { const int kn = (kt + 2 < nk) ? (kt + 2) : (nk - 2); G_LOAD(p, kn * 64); }
        G_COMPUTE(0);
        G_STORE(q, 1);
        __syncthreads();
        { const int kn = (kt + 3 < nk) ? (kt + 3) : (nk - 1); G_LOAD(q, kn * 64); }
        G_COMPUTE(1);
    }
#undef G_STORE
#undef G_COMPUTE
#undef G_LOAD
#undef G_SS
}

template <bool ROWSS, class EPI>
__device__ __forceinline__ void gemm_t(const bf16* __restrict__ Wt, int ldw, int N, const bf16* __restrict__ X, int ldx, int M, int K, EPI epi, char* lds) {
    const int tid = tidx(), lane = tid & 63, w = tid >> 6, r32 = lane & 31, hi = lane >> 5;
    const int tilesN = N / 128, tilesM = M / 128, nk = K / 64;
    float* rowss = (float*)(lds + GEMM_LDS);
    for (int tile = blockIdx.x; tile < tilesM * tilesN; tile += gridDim.x) {
        const int tm = tile / tilesN, tn = tile % tilesN;
        f32x16 acc[4]; float ss[4];
        gemm_kloop<0, ROWSS>(Wt + (size_t)(tn * 128) * ldw, ldw, X + (size_t)(tm * 128) * ldx, ldx, nk, acc, ss, lds, tid);
        if (ROWSS) {
#pragma unroll
            for (int i = 0; i < 4; ++i) { float v = ss[i]; v += __shfl_xor(v, 1, 64); v += __shfl_xor(v, 2, 64); v += __shfl_xor(v, 4, 64); if ((tid & 7) == 0) rowss[(tid >> 3) + 32 * i] = v; }
            __syncthreads();
        }
#pragma unroll
        for (int i = 0; i < 2; ++i)
#pragma unroll
            for (int j = 0; j < 2; ++j) {
                const int tl = (w & 1) * 64 + j * 32;
                epi(tn * 128 + (w >> 1) * 64 + i * 32, tm * 128 + tl, acc[i * 2 + j], r32, hi, ROWSS ? rowss[tl + r32] : 0.f);
            }
        __syncthreads();
    }
}

__device__ __forceinline__ void transpose_tiled(const float* __restrict__ W, bf16* __restrict__ Wt, int K, int N, int Npad, const float* __restrict__ gain, char* lds) {
    float (*tl)[65] = (float (*)[65])lds;
    const int tid = tidx(), a = tid & 63, q = tid >> 6;
    const int tK = K / 64, tN = Npad / 64;
    for (int tile = blockIdx.x; tile < tK * tN; tile += gridDim.x) {
        const int k0 = (tile / tN) * 64, n0 = (tile % tN) * 64;
#pragma unroll 4
        for (int i = 0; i < 16; ++i) {
            const int k = k0 + q * 16 + i, n = n0 + a;
            float v = (n < N) ? W[(size_t)k * N + n] : 0.f;
            if (gain) v *= gain[k];
            tl[q * 16 + i][a] = v;
        }
        __syncthreads();
#pragma unroll 4
        for (int i = 0; i < 16; ++i) { const int nl = q * 16 + i; Wt[(size_t)(n0 + nl) * K + k0 + a] = f2bf(tl[a][nl]); }
        __syncthreads();
    }
}

__device__ __forceinline__ void quant_row(const float4 (&v)[4], unsigned char* __restrict__ dst, float* __restrict__ scl, int r, int lane) {
    float am = 0.f;
#pragma unroll
    for (int j = 0; j < 4; ++j) am = fmaxf(am, fmaxf(fmaxf(fabsf(v[j].x), fabsf(v[j].y)), fmaxf(fabsf(v[j].z), fabsf(v[j].w))));
#pragma unroll
    for (int m = 32; m >= 1; m >>= 1) am = fmaxf(am, __shfl_xor(am, m, 64));
    const float sc = (am > 0.f) ? am * (1.f / 448.f) : 1.f;
    const float is = 1.f / sc;
    uint4 o;
    { int w = 0; w = __builtin_amdgcn_cvt_pk_fp8_f32(v[0].x * is, v[0].y * is, w, false); w = __builtin_amdgcn_cvt_pk_fp8_f32(v[0].z * is, v[0].w * is, w, true); o.x = (unsigned)w; }
    { int w = 0; w = __builtin_amdgcn_cvt_pk_fp8_f32(v[1].x * is, v[1].y * is, w, false); w = __builtin_amdgcn_cvt_pk_fp8_f32(v[1].z * is, v[1].w * is, w, true); o.y = (unsigned)w; }
    { int w = 0; w = __builtin_amdgcn_cvt_pk_fp8_f32(v[2].x * is, v[2].y * is, w, false); w = __builtin_amdgcn_cvt_pk_fp8_f32(v[2].z * is, v[2].w * is, w, true); o.z = (unsigned)w; }
    { int w = 0; w = __builtin_amdgcn_cvt_pk_fp8_f32(v[3].x * is, v[3].y * is, w, false); w = __builtin_amdgcn_cvt_pk_fp8_f32(v[3].z * is, v[3].w * is, w, true); o.w = (unsigned)w; }
    *(uint4*)(dst + (size_t)r * 1024 + lane * 16) = o;
    if (lane == 0) scl[r] = sc;
}
__device__ __forceinline__ void convert_table(const float* __restrict__ src, unsigned char* __restrict__ dst, float* __restrict__ scl, int rows) {
    static_assert(TAB_FP8, "fp8 tables");
    const int lane = tidx() & 63;
    const int nw = nwave();
    for (int r = gwave(); r < rows; r += 2 * nw) {
        const int r2 = r + nw;
        float4 v0[4], v1[4];
        const float4* s0 = (const float4*)(src + (size_t)r * D);
        const float4* s1 = (const float4*)(src + (size_t)(r2 < rows ? r2 : r) * D);
#pragma unroll
        for (int j = 0; j < 4; ++j) { v0[j] = s0[lane * 4 + j]; v1[j] = s1[lane * 4 + j]; }
        quant_row(v0, dst, scl, r, lane);
        if (r2 < rows) quant_row(v1, dst, scl, r2, lane);
    }
}
__device__ __forceinline__ void phase_prep(const Params& P, char* lds) {
    unsigned char* ws = P.ws;
    for (int l = 0; l < DEPTH; ++l) {
        transpose_tiled(P.w_in + (size_t)l * D * DIN, (bf16*)(ws + WS_WIN) + (size_t)l * DINP * D, D, DIN, DINP, nullptr, lds);
        transpose_tiled(P.w_uq + (size_t)l * QR * 768, (bf16*)(ws + WS_WUQ) + (size_t)l * 768 * QR, QR, 768, 768, P.q_norm + l * QR, lds);
        transpose_tiled(P.w_uk + (size_t)l * KVR * 512, (bf16*)(ws + WS_WUKV) + (size_t)l * 1024 * KVR, KVR, 512, 512, P.kv_norm + l * KVR, lds);
        transpose_tiled(P.w_uv + (size_t)l * KVR * 512, (bf16*)(ws + WS_WUKV) + (size_t)l * 1024 * KVR + (size_t)512 * KVR, KVR, 512, 512, P.kv_norm + l * KVR, lds);
        transpose_tiled(P.w_out + (size_t)l * D * D, (bf16*)(ws + WS_WOUT) + (size_t)l * D * D, D, D, D, nullptr, lds);
    }
    {
        bf16* Wc = (bf16*)(ws + WS_WPQ);
        float (*As)[68] = (float (*)[68])lds;
        float (*Bs)[68] = (float (*)[68])(lds + 16 * 68 * 4);
        const int tid = tidx(), tx = tid & 15, ty = tid >> 4;
        const int lr = tid >> 2, ld4 = (tid & 3) * 4;
        for (int tile = blockIdx.x; tile < (DEPTH * 2048 / 64) * (D / 64); tile += gridDim.x) {
            const int row0 = (tile >> 4) * 64, k0 = (tile & 15) * 64;
            const int l = row0 >> 11, hp = (row0 >> 7) & 15, n0 = row0 & 127;
            const float* skp = P.peer_subkeys + (((size_t)l * 2 + (hp & 1)) * NKEY + n0 + lr) * 128 + ld4;
            const float* wqp = P.peer_wq + ((size_t)l * D + k0 + lr) * 2048 + hp * 128 + ld4;
            float acc[4][4];
#pragma unroll
            for (int i = 0; i < 4; ++i)
#pragma unroll
                for (int j = 0; j < 4; ++j) acc[i][j] = 0.f;
            for (int d0 = 0; d0 < 128; d0 += 16) {
                const float4 av = *(const float4*)(skp + d0), bv = *(const float4*)(wqp + d0);
                As[ld4 + 0][lr] = av.x; As[ld4 + 1][lr] = av.y; As[ld4 + 2][lr] = av.z; As[ld4 + 3][lr] = av.w;
                Bs[ld4 + 0][lr] = bv.x; Bs[ld4 + 1][lr] = bv.y; Bs[ld4 + 2][lr] = bv.z; Bs[ld4 + 3][lr] = bv.w;
                __syncthreads();
#pragma unroll
                for (int kk = 0; kk < 16; ++kk) {
                    const float4 a4 = *(const float4*)&As[kk][ty * 4], b4 = *(const float4*)&Bs[kk][tx * 4];
                    const float aa[4] = {a4.x, a4.y, a4.z, a4.w}, bb[4] = {b4.x, b4.y, b4.z, b4.w};
#pragma unroll
                    for (int i = 0; i < 4; ++i)
#pragma unroll
                        for (int j = 0; j < 4; ++j) acc[i][j] = fmaf(aa[i], bb[j], acc[i][j]);
                }
                __syncthreads();
            }
#pragma unroll
            for (int i = 0; i < 4; ++i) {
                uint2 o; o.x = pack2(acc[i][0], acc[i][1]); o.y = pack2(acc[i][2], acc[i][3]);
                *(uint2*)(Wc + (size_t)(row0 + ty * 4 + i) * D + k0 + tx * 4) = o;
            }
        }
    }
    convert_table(P.peer_u, ws + WS_TABU, (float*)(ws + WS_TSCU), DEPTH * NEXP);
    convert_table(P.peer_v, ws + WS_TABV, (float*)(ws + WS_TSCV), DEPTH * NEXP);
    float* rope = (float*)(ws + WS_ROPE);
    for (size_t i = gtid(); i < (size_t)S * 16; i += gnth()) {
        const int s = (int)(i >> 4), f = (int)(i & 15);
        const double inv = pow(10000.0, -(double)f / 16.0);
        const double ang = (double)s * inv;
        rope[2 * i] = (float)cos(ang); rope[2 * i + 1] = (float)sin(ang);
    }
}

__device__ __forceinline__ void phase_norm(const float* __restrict__ h, const float* __restrict__ g, bf16* __restrict__ xn) {
    const int lane = tidx() & 63;
    for (int t = gwave(); t < T; t += nwave()) {
        const float4* hr = (const float4*)(h + (size_t)t * D);
        float4 v[4]; float ss = 0.f;
#pragma unroll
        for (int j = 0; j < 4; ++j) { v[j] = hr[j * 64 + lane]; ss += v[j].x * v[j].x + v[j].y * v[j].y + v[j].z * v[j].z + v[j].w * v[j].w; }
        ss = wave_sum(ss);
        const float r = rsqrtf(ss * (1.f / D) + EPS);
#pragma unroll
        for (int j = 0; j < 4; ++j) {
            const float4 gg = ((const float4*)g)[j * 64 + lane];
            uint2 o; o.x = pack2(v[j].x * r * gg.x, v[j].y * r * gg.y); o.y = pack2(v[j].z * r * gg.z, v[j].w * r * gg.w);
            ((uint2*)(xn + (size_t)t * D))[j * 64 + lane] = o;
        }
    }
}

__device__ __forceinline__ void phase_mixlocal(const Params& P, int l, char* lds) {
    const bf16* proj = (const bf16*)(P.ws + WS_PROJ);
    bf16* Y = (bf16*)(P.ws + WS_XN);
    const int tid = tidx();
    {
        const float* cw = P.conv_w + (size_t)l * 3 * 256;
        for (size_t i = gtid(); i < (size_t)T * 32; i += gnth()) {
            const int t = (int)(i >> 5), c0 = (int)(i & 31) * 8, s = t & (S - 1);
            const bf16* pr = proj + (size_t)t * DINP;
            float acc[8];
#pragma unroll
            for (int e = 0; e < 8; ++e) acc[e] = 0.f;
#pragma unroll
            for (int j = 0; j < 3; ++j) {
                if (s - 2 + j >= 0) {
                    const bf16* pp = pr - (size_t)(2 - j) * DINP;
                    const uint4 g = *(const uint4*)(pp + C_CG + c0), hc = *(const uint4*)(pp + C_HC + c0);
                    const float4 w0 = *(const float4*)(cw + j * 256 + c0), w1 = *(const float4*)(cw + j * 256 + c0 + 4);
                    acc[0] = fmaf(w0.x, bflo(g.x) * bflo(hc.x), acc[0]); acc[1] = fmaf(w0.y, bfhi(g.x) * bfhi(hc.x), acc[1]);
                    acc[2] = fmaf(w0.z, bflo(g.y) * bflo(hc.y), acc[2]); acc[3] = fmaf(w0.w, bfhi(g.y) * bfhi(hc.y), acc[3]);
                    acc[4] = fmaf(w1.x, bflo(g.z) * bflo(hc.z), acc[4]); acc[5] = fmaf(w1.y, bfhi(g.z) * bfhi(hc.z), acc[5]);
                    acc[6] = fmaf(w1.z, bflo(g.w) * bflo(hc.w), acc[6]); acc[7] = fmaf(w1.w, bfhi(g.w) * bfhi(hc.w), acc[7]);
                }
            }
            const uint4 bg = *(const uint4*)(pr + C_BG + c0);
            uint4 o;
            o.x = pack2(bflo(bg.x) * acc[0], bfhi(bg.x) * acc[1]); o.y = pack2(bflo(bg.y) * acc[2], bfhi(bg.y) * acc[3]);
            o.z = pack2(bflo(bg.z) * acc[4], bfhi(bg.z) * acc[5]); o.w = pack2(bflo(bg.w) * acc[6], bfhi(bg.w) * acc[7]);
            *(uint4*)(Y + (size_t)t * D + c0) = o;
        }
    }
    {
        float (*pl)[68] = (float (*)[68])lds;
        const float* pw = P.pool_w + (size_t)l * 4 * 64 * 64;
        const float* psc = P.pool_scale + l * 256;
        const int a = tid & 63, q = tid >> 6;
        for (int tile = blockIdx.x; tile < (T / 64) * 4; tile += gridDim.x) {
            const int g = tile & 3, t0 = (tile >> 2) * 64;
            const int w = 2 << g;
            {
                const bf16* col = proj + C_HP + g * 64 + a;
                const int tf = t0 + q * 16, sf = tf & (S - 1);
                float sum = 0.f;
                for (int d = 1; d < w; ++d) if (sf - d >= 0) sum += bf2f(col[(size_t)(tf - d) * DINP]);
#pragma unroll 4
                for (int i = 0; i < 16; ++i) {
                    const int s = sf + i;
                    const float xv = bf2f(col[(size_t)(tf + i) * DINP]);
                    sum += xv;
                    const int cnt = (s + 1 < w) ? (s + 1) : w;
                    pl[q * 16 + i][a] = sum / (float)cnt - xv;
                    if (s - w + 1 >= 0) sum -= bf2f(col[(size_t)(tf + i - w + 1) * DINP]);
                }
            }
            __syncthreads();
            {
                float pc[64];
#pragma unroll
                for (int c = 0; c < 64; ++c) pc[c] = pw[(g * 64 + c) * 64 + a];
                const float sc = psc[g * 64 + a];
#pragma unroll 2
                for (int i = 0; i < 16; ++i) {
                    const float4* row = (const float4*)&pl[q * 16 + i][0];
                    float m0 = 0.f, m1 = 0.f;
#pragma unroll
                    for (int c4 = 0; c4 < 16; ++c4) { const float4 v = row[c4]; m0 = fmaf(v.x, pc[4 * c4], m0); m1 = fmaf(v.y, pc[4 * c4 + 1], m1); m0 = fmaf(v.z, pc[4 * c4 + 2], m0); m1 = fmaf(v.w, pc[4 * c4 + 3], m1); }
                    Y[(size_t)(t0 + q * 16 + i) * D + 256 + g * 64 + a] = f2bf((m0 + m1) * sc);
                }
            }
            __syncthreads();
        }
    }
}

typedef short v4i16_t __attribute__((ext_vector_type(4)));
typedef __attribute__((address_space(3))) v4i16_t* lds_v4p;
__device__ __forceinline__ v4i16_t vtr(const char* p) { return __builtin_amdgcn_ds_read_tr16_b64_v4i16((lds_v4p)p); }
constexpr int A_KP = 208, A_VP = 192;
constexpr int A_KB = 64 * A_KP, A_VB = 64 * A_VP, A_BUF = A_KB + A_VB, ATTN_LDS = 2 * A_BUF;
static_assert(ATTN_LDS <= GEMM_LDS, "attention LDS");

__device__ __forceinline__ void attn_unit(const bf16* __restrict__ Qb, const bf16* __restrict__ Kb, const bf16* __restrict__ Vb, bf16* __restrict__ Y, int bh, int qblk, char* lds) {
    const int tid = tidx(), lane = tid & 63, w = tid >> 6, r32 = lane & 31, hi = lane >> 5;
    const int q0 = qblk * 128, qw0 = q0 + w * 32;
    const int NT = 2 * qblk + 2;
    bf16x8 qf[6];
    {
        const bf16* qp = Qb + ((size_t)bh * S + qw0 + r32) * DQK + hi * 8;
#pragma unroll
        for (int ks = 0; ks < 6; ++ks) qf[ks] = *(const bf16x8*)(qp + ks * 16);
    }
    f32x16 o0, o1;
#pragma unroll
    for (int r = 0; r < 16; ++r) { o0[r] = 0.f; o1[r] = 0.f; }
    float m = -1e30f, lsum = 0.f;
    const char* Kg = (const char*)(Kb + (size_t)bh * S * DQK) + tid * 16;
    const char* Vg = (const char*)(Vb + (size_t)bh * S * DV) + tid * 16;
    const int kl0 = (tid / 12) * A_KP + (tid % 12) * 16, kl1 = ((tid + 256) / 12) * A_KP + ((tid + 256) % 12) * 16, kl2 = ((tid + 512) / 12) * A_KP + ((tid + 512) % 12) * 16;
    const int vl0 = (tid >> 3) * A_VP + (tid & 7) * 16, vl1 = vl0 + 32 * A_VP;
    uint4 pk0, pk1, pk2, pv0, pv1, qk0, qk1, qk2, qv0, qv1;
#define A_LOAD(S, t) do { const char* kg = Kg + (size_t)(t) * (64 * 192); const char* vg = Vg + (size_t)(t) * (64 * 128); \
        S##k0 = *(const uint4*)(kg); S##k1 = *(const uint4*)(kg + 4096); S##k2 = *(const uint4*)(kg + 8192); S##v0 = *(const uint4*)(vg); S##v1 = *(const uint4*)(vg + 4096); } while (0)
#define A_STORE(S, bK, bV) do { *(uint4*)(bK + kl0) = S##k0; *(uint4*)(bK + kl1) = S##k1; *(uint4*)(bK + kl2) = S##k2; *(uint4*)(bV + vl0) = S##v0; *(uint4*)(bV + vl1) = S##v1; } while (0)
#define A_PV(pf, kofs) do { \
            { const v4i16_t lo = vtr(pv + (kofs) * A_VP), hh = vtr(pv + ((kofs) + 8) * A_VP); const bf16x8 vf = {lo[0], lo[1], lo[2], lo[3], hh[0], hh[1], hh[2], hh[3]}; o0 = MFMA32(vf, pf.v, o0); } \
            { const v4i16_t lo = vtr(pv + (kofs) * A_VP + 64), hh = vtr(pv + ((kofs) + 8) * A_VP + 64); const bf16x8 vf = {lo[0], lo[1], lo[2], lo[3], hh[0], hh[1], hh[2], hh[3]}; o1 = MFMA32(vf, pf.v, o1); } } while (0)
    const int pvo = (4 * hi + ((lane & 15) >> 2)) * A_VP + (16 * ((lane >> 4) & 1) + 4 * (lane & 3)) * 2;
    A_LOAD(p, 0); A_LOAD(q, 1);
    for (int t2 = 0; t2 < NT; t2 += 2) {
#pragma unroll
        for (int half = 0; half < 2; ++half) {
            const int t = t2 + half;
            char* bK = lds + half * A_BUF; char* bV = bK + A_KB;
            if (half == 0) A_STORE(p, bK, bV); else A_STORE(q, bK, bV);
            __syncthreads();
            { const int tn = (t + 2 < NT) ? (t + 2) : (NT - 2 + half); if (half == 0) A_LOAD(p, tn); else A_LOAD(q, tn); }
        const int kt0 = t * 64;
        if (kt0 <= qw0) {
            f32x16 s0, s1;
#pragma unroll
            for (int r = 0; r < 16; ++r) { s0[r] = 0.f; s1[r] = 0.f; }
            const char* pk = bK + r32 * A_KP + hi * 16;
#pragma unroll
            for (int ks = 0; ks < 6; ++ks) {
                const bf16x8 a0 = *(const bf16x8*)(pk + ks * 32), a1 = *(const bf16x8*)(pk + 32 * A_KP + ks * 32);
                s0 = MFMA32(a0, qf[ks], s0); s1 = MFMA32(a1, qf[ks], s1);
            }
            if (kt0 + 63 > qw0) {
                const int qrow = qw0 + r32;
#pragma unroll
                for (int r = 0; r < 16; ++r) { const int key = kt0 + crow(r, hi); if (key > qrow) s0[r] = -INFINITY; if (key + 32 > qrow) s1[r] = -INFINITY; }
            }
            float mx = fmaxf(s0[0], s1[0]);
#pragma unroll
            for (int r = 1; r < 16; ++r) mx = fmaxf(mx, fmaxf(s0[r], s1[r]));
            mx = fmaxf(mx, __shfl_xor(mx, 32, 64));
            const float mn = fmaxf(m, mx);
            const float alpha = __builtin_amdgcn_exp2f(m - mn);
            m = mn;
            float ps = 0.f;
#pragma unroll
            for (int r = 0; r < 16; ++r) { s0[r] = __builtin_amdgcn_exp2f(s0[r] - mn); s1[r] = __builtin_amdgcn_exp2f(s1[r] - mn); ps += s0[r] + s1[r]; }
            lsum = lsum * alpha + ps;
#pragma unroll
            for (int r = 0; r < 16; ++r) { o0[r] *= alpha; o1[r] *= alpha; }
            union { unsigned u[4]; bf16x8 v; } p00, p01, p10, p11;
#pragma unroll
            for (int j = 0; j < 4; ++j) { p00.u[j] = cvtpk(s0[2 * j], s0[2 * j + 1]); p01.u[j] = cvtpk(s0[8 + 2 * j], s0[9 + 2 * j]); p10.u[j] = cvtpk(s1[2 * j], s1[2 * j + 1]); p11.u[j] = cvtpk(s1[8 + 2 * j], s1[9 + 2 * j]); }
            const char* pv = bV + pvo;
            A_PV(p00, 0); A_PV(p01, 16); A_PV(p10, 32); A_PV(p11, 48);
        }
        }
    }
    lsum += __shfl_xor(lsum, 32, 64);
    const float inv = 1.f / lsum;
    const int b = bh >> 3, h = bh & 7;
    bf16* yo = Y + (size_t)(b * S + qw0 + r32) * D + 512 + h * 64 + 4 * hi;
#pragma unroll
    for (int g = 0; g < 4; ++g) {
        uint2 a, c;
        a.x = cvtpk(o0[4 * g] * inv, o0[4 * g + 1] * inv); a.y = cvtpk(o0[4 * g + 2] * inv, o0[4 * g + 3] * inv);
        c.x = cvtpk(o1[4 * g] * inv, o1[4 * g + 1] * inv); c.y = cvtpk(o1[4 * g + 2] * inv, o1[4 * g + 3] * inv);
        *(uint2*)(yo + 8 * g) = a; *(uint2*)(yo + 32 + 8 * g) = c;
    }
    __syncthreads();
}
__device__ __forceinline__ void phase_attn(const Params& P, char* lds) {
    const bf16* Qb = (const bf16*)(P.ws + WS_Q);
    const bf16* Kb = (const bf16*)(P.ws + WS_K);
    const bf16* Vb = (const bf16*)(P.ws + WS_V);
    bf16* Y = (bf16*)(P.ws + WS_XN);
    for (int u = blockIdx.x; u < NB * NH * (S / 128); u += gridDim.x) {
        const int bh = u & 31, v = u >> 5;
        const int qblk = (v < 16) ? (63 - v) : (v < 32) ? (v - 16) : (v < 48) ? (79 - v) : (v - 32);
        attn_unit(Qb, Kb, Vb, Y, bh, qblk, lds);
    }
}

#define NET_HD __device__ __forceinline__
#define NET_U2F(u) __uint_as_float(u)
#define NET_F2U(f) __float_as_uint(f)
#define CE_DESC(a, b) do { const float hi__ = fmaxf(a, b), lo__ = fminf(a, b); a = hi__; b = lo__; } while (0)
NET_HD void sort16_desc(float (&v)[16]) {
#pragma unroll
    for (int k = 2; k <= 16; k <<= 1) {
#pragma unroll
        for (int j = k >> 1; j > 0; j >>= 1) {
#pragma unroll
            for (int i = 0; i < 16; ++i) {
                const int l = i ^ j;
                if (l > i) { if ((i & k) == 0) CE_DESC(v[i], v[l]); else CE_DESC(v[l], v[i]); }
            }
        }
    }
}
NET_HD void merge16_desc(float (&a)[16], const float (&b)[16]) {
#pragma unroll
    for (int i = 0; i < 16; ++i) a[i] = fmaxf(a[i], b[15 - i]);
#pragma unroll
    for (int j = 8; j > 0; j >>= 1) {
#pragma unroll
        for (int i = 0; i < 16; ++i) { const int l = i ^ j; if (l > i) CE_DESC(a[i], a[l]); }
    }
}
NET_HD void top16_of_64(float (&g0)[16], float (&g1)[16], float (&g2)[16], float (&g3)[16]) {
    sort16_desc(g0); sort16_desc(g1); sort16_desc(g2); sort16_desc(g3);
    merge16_desc(g0, g1); merge16_desc(g2, g3); merge16_desc(g0, g2);
}
NET_HD float u2f(unsigned u) { return NET_U2F(u); }
NET_HD unsigned f2u(float f) { return NET_F2U(f); }
template <class V16>
NET_HD void lane_top16(const V16& s0, const V16& s1, const V16& s2, const V16& s3, int hi, float (&out)[16]) {
    float g0[16], g1[16], g2[16], g3[16];
#pragma unroll
    for (int r = 0; r < 16; ++r) {
        const unsigned nb = (unsigned)((r & 3) + 8 * (r >> 2));
        g0[r] = u2f((f2u(s0[r]) & 0xFFFFFF80u) | nb); g1[r] = u2f((f2u(s1[r]) & 0xFFFFFF80u) | (nb + 32u));
        g2[r] = u2f((f2u(s2[r]) & 0xFFFFFF80u) | (nb + 64u)); g3[r] = u2f((f2u(s3[r]) & 0xFFFFFF80u) | (nb + 96u));
    }
    top16_of_64(g0, g1, g2, g3);
    const unsigned h4 = (unsigned)hi << 2;
#pragma unroll
    for (int i = 0; i < 16; ++i) out[i] = u2f(f2u(g0[i]) | h4);
}
constexpr int cand_slot(int a, int b) { int n = 0; for (int x = 0; x < 16; ++x) for (int y = 0; y < 16; ++y) { if (x == a && y == b) return n; if ((x + 1) * (y + 1) <= 16) ++n; } return n; }
NET_HD void cand_top16(const float (&s1)[16], const float (&s2)[16], float (&c)[16]) {
    float g0[16], g1[16], g2[16], g3[16];
#pragma unroll
    for (int i = 0; i < 16; ++i) { g0[i] = -3.0e38f; g1[i] = -3.0e38f; g2[i] = -3.0e38f; g3[i] = -3.0e38f; }
#pragma unroll
    for (int a = 0; a < 16; ++a) {
#pragma unroll
        for (int b = 0; b < 16; ++b) {
            if ((a + 1) * (b + 1) <= 16) {
                const int sl = cand_slot(a, b);
                const float v = u2f((f2u(s1[a] + s2[b]) & 0xFFFFFF00u) | (unsigned)(a * 16 + b));
                if (sl < 16) g0[sl & 15] = v; else if (sl < 32) g1[sl & 15] = v; else if (sl < 48) g2[sl & 15] = v; else g3[sl & 15] = v;
            }
        }
    }
    top16_of_64(g0, g1, g2, g3);
#pragma unroll
    for (int i = 0; i < 16; ++i) c[i] = g0[i];
}

__device__ __forceinline__ void phase_route(const Params& P, int l, char* lds) {
    const bf16* XN = (const bf16*)(P.ws + WS_XN);
    const bf16* Wc = (const bf16*)(P.ws + WS_WPQ) + (size_t)l * 2048 * D;
    int* EXPp = (int*)(P.ws + WS_EXP);
    float* GATEp = (float*)(P.ws + WS_GATE);
    const int tid = tidx(), lane = tid & 63, w = tid >> 6, r32 = lane & 31, hi = lane >> 5;
    for (int u = blockIdx.x; u < (T / 128) * PH; u += gridDim.x) {
        const int tm = u >> 3, h = u & 7;
        float L0[16], L1[16];
        {
            f32x16 acc[4]; float ssd[4];
            gemm_kloop<1, false>(Wc + (size_t)((h * 2 + 0) * 128) * D, D, XN + (size_t)(tm * 128) * D, D, D / 64, acc, ssd, lds, tid);
            lane_top16(acc[0], acc[1], acc[2], acc[3], hi, L0);
            float o[16];
#pragma unroll
            for (int i = 0; i < 16; ++i) o[i] = __shfl_xor(L0[i], 32, 64);
            merge16_desc(L0, o);
        }
        {
            f32x16 acc[4]; float ssd[4];
            gemm_kloop<1, false>(Wc + (size_t)((h * 2 + 1) * 128) * D, D, XN + (size_t)(tm * 128) * D, D, D / 64, acc, ssd, lds, tid);
            lane_top16(acc[0], acc[1], acc[2], acc[3], hi, L1);
            float o[16];
#pragma unroll
            for (int i = 0; i < 16; ++i) o[i] = __shfl_xor(L1[i], 32, 64);
            merge16_desc(L1, o);
        }
        float c[16];
        cand_top16(L0, L1, c);
        __syncthreads();
        unsigned char* my = (unsigned char*)lds + tid * 32;
        {
            uint4 a, b;
#define PK4(L, i) ((__float_as_uint(L[i]) & 127u) | ((__float_as_uint(L[i + 1]) & 127u) << 8) | ((__float_as_uint(L[i + 2]) & 127u) << 16) | ((__float_as_uint(L[i + 3]) & 127u) << 24))
            a.x = PK4(L0, 0); a.y = PK4(L0, 4); a.z = PK4(L0, 8); a.w = PK4(L0, 12);
            b.x = PK4(L1, 0); b.y = PK4(L1, 4); b.z = PK4(L1, 8); b.w = PK4(L1, 12);
#undef PK4
            *(uint4*)my = a; *(uint4*)(my + 16) = b;
        }
        int ev[16]; float gv[16]; float den = 0.f;
#pragma unroll
        for (int k = 0; k < 16; ++k) {
            const unsigned ci = __float_as_uint(c[k]) & 255u;
            const int n1 = my[ci >> 4], n2 = my[16 + (ci & 15)];
            ev[k] = n1 * NKEY + n2;
            gv[k] = __expf(c[k] - c[0]); den += gv[k];
        }
        const float iden = 1.f / den;
        if (hi == 0) {
            const int t = tm * 128 + w * 32 + r32;
            uint4* ep = (uint4*)(EXPp + (size_t)t * HK + h * 16);
            float4* gp = (float4*)(GATEp + (size_t)t * HK + h * 16);
#pragma unroll
            for (int q = 0; q < 4; ++q) {
                ep[q] = make_uint4((unsigned)ev[4 * q], (unsigned)ev[4 * q + 1], (unsigned)ev[4 * q + 2], (unsigned)ev[4 * q + 3]);
                gp[q] = make_float4(gv[4 * q] * iden, gv[4 * q + 1] * iden, gv[4 * q + 2] * iden, gv[4 * q + 3] * iden);
            }
        }
        __syncthreads();
    }
}

__device__ __forceinline__ float red16(float (&p)[16], int lane) {
#pragma unroll
    for (int i = 0; i < 8; ++i) { const bool up = lane & 32; const float send = up ? p[i] : p[i + 8], keep = up ? p[i + 8] : p[i]; p[i] = keep + __shfl_xor(send, 32, 64); }
#pragma unroll
    for (int i = 0; i < 4; ++i) { const bool up = lane & 16; const float send = up ? p[i] : p[i + 4], keep = up ? p[i + 4] : p[i]; p[i] = keep + __shfl_xor(send, 16, 64); }
#pragma unroll
    for (int i = 0; i < 2; ++i) { const bool up = lane & 8; const float send = up ? p[i] : p[i + 2], keep = up ? p[i + 2] : p[i]; p[i] = keep + __shfl_xor(send, 8, 64); }
    { const bool up = lane & 4; const float send = up ? p[0] : p[1], keep = up ? p[1] : p[0]; p[0] = keep + __shfl_xor(send, 4, 64); }
    float r = p[0];
    r += __shfl_xor(r, 2, 64); r += __shfl_xor(r, 1, 64);
    return r;
}

__device__ __forceinline__ void phase_gather(const Params& P, int l) {
    const bf16* XN = (const bf16*)(P.ws + WS_XN);
    bf16* XNw = (bf16*)(P.ws + WS_XN);
    const int* EXPp = (const int*)(P.ws + WS_EXP);
    const float* GATEp = (const float*)(P.ws + WS_GATE);
    const unsigned char* U = P.ws + WS_TABU + (size_t)l * NEXP * TAB_ROWB;
    const unsigned char* V = P.ws + WS_TABV + (size_t)l * NEXP * TAB_ROWB;
    const float* SU = (const float*)(P.ws + WS_TSCU) + (size_t)l * NEXP;
    const float* SV = (const float*)(P.ws + WS_TSCV) + (size_t)l * NEXP;
    const int lane = tidx() & 63;
    for (int t = gwave(); t < T; t += nwave()) {
        const int e_lo = EXPp[(size_t)t * HK + lane], e_hi = EXPp[(size_t)t * HK + 64 + lane];
#if TAB_FP8
        float xf[16];
        {
            const uint4 a = ((const uint4*)(XN + (size_t)t * D))[lane * 2], b = ((const uint4*)(XN + (size_t)t * D))[lane * 2 + 1];
            xf[0] = bflo(a.x); xf[1] = bfhi(a.x); xf[2] = bflo(a.y); xf[3] = bfhi(a.y); xf[4] = bflo(a.z); xf[5] = bfhi(a.z); xf[6] = bflo(a.w); xf[7] = bfhi(a.w);
            xf[8] = bflo(b.x); xf[9] = bfhi(b.x); xf[10] = bflo(b.y); xf[11] = bfhi(b.y); xf[12] = bflo(b.z); xf[13] = bfhi(b.z); xf[14] = bflo(b.w); xf[15] = bfhi(b.w);
        }
#else
        const uint4 xa = ((const uint4*)(XN + (size_t)t * D))[lane], xb = ((const uint4*)(XN + (size_t)t * D))[64 + lane];
#endif
        float acc[16];
#pragma unroll
        for (int i = 0; i < 16; ++i) acc[i] = 0.f;
        for (int c = 0; c < 8; ++c) {
            const int esel = (c < 4) ? e_lo : e_hi;
            const int kb = (c & 3) * 16;
            float part[16];
#pragma unroll
            for (int hb = 0; hb < 2; ++hb) {
#if TAB_FP8
                uint4 r[8];
#pragma unroll
                for (int i = 0; i < 8; ++i) { const int e = __builtin_amdgcn_readlane(esel, kb + hb * 8 + i); r[i] = *(const uint4*)(U + (size_t)e * 1024 + lane * 16); }
#pragma unroll
                for (int i = 0; i < 8; ++i) {
                    float d0 = 0.f, d1 = 0.f;
                    const unsigned w[4] = {r[i].x, r[i].y, r[i].z, r[i].w};
#pragma unroll
                    for (int q = 0; q < 4; ++q) {
                        const auto lo = __builtin_amdgcn_cvt_pk_f32_fp8((int)w[q], false); const auto hh = __builtin_amdgcn_cvt_pk_f32_fp8((int)w[q], true);
                        d0 = fmaf(xf[4 * q], lo[0], d0); d1 = fmaf(xf[4 * q + 1], lo[1], d1); d0 = fmaf(xf[4 * q + 2], hh[0], d0); d1 = fmaf(xf[4 * q + 3], hh[1], d1);
                    }
                    part[hb * 8 + i] = d0 + d1;
                }
#else
                uint4 r0[8], r1[8];
#pragma unroll
                for (int i = 0; i < 8; ++i) { const int e = __builtin_amdgcn_readlane(esel, kb + hb * 8 + i); const unsigned char* rp = U + (size_t)e * 2048 + lane * 16; r0[i] = *(const uint4*)(rp); r1[i] = *(const uint4*)(rp + 1024); }
#pragma unroll
                for (int i = 0; i < 8; ++i) {
                    float d0 = 0.f, d1 = 0.f;
                    d0 = dot2bf(xa.x, r0[i].x, d0); d1 = dot2bf(xa.y, r0[i].y, d1); d0 = dot2bf(xa.z, r0[i].z, d0); d1 = dot2bf(xa.w, r0[i].w, d1);
                    d0 = dot2bf(xb.x, r1[i].x, d0); d1 = dot2bf(xb.y, r1[i].y, d1); d0 = dot2bf(xb.z, r1[i].z, d0); d1 = dot2bf(xb.w, r1[i].w, d1);
                    part[hb * 8 + i] = d0 + d1;
                }
#endif
            }
            float dsum = red16(part, lane);
            const int kk = c * 16 + (lane >> 2);
            const int eme = __shfl(esel, kb + (lane >> 2), 64);
            float wv = GATEp[(size_t)t * HK + kk];
#if TAB_FP8
            dsum *= SU[eme];
            wv *= SV[eme];
#endif
            wv *= gelu_exact(dsum);
#pragma unroll
            for (int hb = 0; hb < 2; ++hb) {
#if TAB_FP8
                uint4 r[8];
#pragma unroll
                for (int i = 0; i < 8; ++i) { const int e = __builtin_amdgcn_readlane(esel, kb + hb * 8 + i); r[i] = *(const uint4*)(V + (size_t)e * 1024 + lane * 16); }
#pragma unroll
                for (int i = 0; i < 8; ++i) {
                    const float w = __int_as_float(__builtin_amdgcn_readlane(__float_as_int(wv), (hb * 8 + i) * 4));
                    const unsigned ww[4] = {r[i].x, r[i].y, r[i].z, r[i].w};
#pragma unroll
                    for (int q = 0; q < 4; ++q) {
                        const auto lo = __builtin_amdgcn_cvt_pk_f32_fp8((int)ww[q], false); const auto hh = __builtin_amdgcn_cvt_pk_f32_fp8((int)ww[q], true);
                        acc[4 * q] = fmaf(w, lo[0], acc[4 * q]); acc[4 * q + 1] = fmaf(w, lo[1], acc[4 * q + 1]); acc[4 * q + 2] = fmaf(w, hh[0], acc[4 * q + 2]); acc[4 * q + 3] = fmaf(w, hh[1], acc[4 * q + 3]);
                    }
                }
#else
                uint4 r0[8], r1[8];
#pragma unroll
                for (int i = 0; i < 8; ++i) { const int e = __builtin_amdgcn_readlane(esel, kb + hb * 8 + i); const unsigned char* rp = V + (size_t)e * 2048 + lane * 16; r0[i] = *(const uint4*)(rp); r1[i] = *(const uint4*)(rp + 1024); }
#pragma unroll
                for (int i = 0; i < 8; ++i) {
                    const float w = __int_as_float(__builtin_amdgcn_readlane(__float_as_int(wv), (hb * 8 + i) * 4));
                    acc[0] = fmaf(w, bflo(r0[i].x), acc[0]); acc[1] = fmaf(w, bfhi(r0[i].x), acc[1]); acc[2] = fmaf(w, bflo(r0[i].y), acc[2]); acc[3] = fmaf(w, bfhi(r0[i].y), acc[3]);
                    acc[4] = fmaf(w, bflo(r0[i].z), acc[4]); acc[5] = fmaf(w, bfhi(r0[i].z), acc[5]); acc[6] = fmaf(w, bflo(r0[i].w), acc[6]); acc[7] = fmaf(w, bfhi(r0[i].w), acc[7]);
                    acc[8] = fmaf(w, bflo(r1[i].x), acc[8]); acc[9] = fmaf(w, bfhi(r1[i].x), acc[9]); acc[10] = fmaf(w, bflo(r1[i].y), acc[10]); acc[11] = fmaf(w, bfhi(r1[i].y), acc[11]);
                    acc[12] = fmaf(w, bflo(r1[i].z), acc[12]); acc[13] = fmaf(w, bfhi(r1[i].z), acc[13]); acc[14] = fmaf(w, bflo(r1[i].w), acc[14]); acc[15] = fmaf(w, bfhi(r1[i].w), acc[15]);
                }
#endif
            }
        }
        float* hrow = P.out + (size_t)t * D;
#if TAB_FP8
        const int c0 = lane * 16, c1 = lane * 16 + 8;
#else
        const int c0 = lane * 8, c1 = 512 + lane * 8;
#endif
        float4 h0 = *(const float4*)(hrow + c0), h1 = *(const float4*)(hrow + c0 + 4), h2 = *(const float4*)(hrow + c1), h3 = *(const float4*)(hrow + c1 + 4);
        h0.x += acc[0]; h0.y += acc[1]; h0.z += acc[2]; h0.w += acc[3]; h1.x += acc[4]; h1.y += acc[5]; h1.z += acc[6]; h1.w += acc[7];
        h2.x += acc[8]; h2.y += acc[9]; h2.z += acc[10]; h2.w += acc[11]; h3.x += acc[12]; h3.y += acc[13]; h3.z += acc[14]; h3.w += acc[15];
        float ss = h0.x * h0.x + h0.y * h0.y + h0.z * h0.z + h0.w * h0.w + h1.x * h1.x + h1.y * h1.y + h1.z * h1.z + h1.w * h1.w
                 + h2.x * h2.x + h2.y * h2.y + h2.z * h2.z + h2.w * h2.w + h3.x * h3.x + h3.y * h3.y + h3.z * h3.z + h3.w * h3.w;
        ss = wave_sum(ss);
        const float rn = rsqrtf(ss * (1.f / D) + EPS);
        if (l == DEPTH - 1) {
            const float* g = P.norm_final;
            const float4 g0 = *(const float4*)(g + c0), g1 = *(const float4*)(g + c0 + 4), g2 = *(const float4*)(g + c1), g3 = *(const float4*)(g + c1 + 4);
            *(float4*)(hrow + c0) = make_float4(h0.x * rn * g0.x, h0.y * rn * g0.y, h0.z * rn * g0.z, h0.w * rn * g0.w);
            *(float4*)(hrow + c0 + 4) = make_float4(h1.x * rn * g1.x, h1.y * rn * g1.y, h1.z * rn * g1.z, h1.w * rn * g1.w);
            *(float4*)(hrow + c1) = make_float4(h2.x * rn * g2.x, h2.y * rn * g2.y, h2.z * rn * g2.z, h2.w * rn * g2.w);
            *(float4*)(hrow + c1 + 4) = make_float4(h3.x * rn * g3.x, h3.y * rn * g3.y, h3.z * rn * g3.z, h3.w * rn * g3.w);
        } else {
            *(float4*)(hrow + c0) = h0; *(float4*)(hrow + c0 + 4) = h1; *(float4*)(hrow + c1) = h2; *(float4*)(hrow + c1 + 4) = h3;
            const float* g = P.norm_mix + (l + 1) * D;
            const float4 g0 = *(const float4*)(g + c0), g1 = *(const float4*)(g + c0 + 4), g2 = *(const float4*)(g + c1), g3 = *(const float4*)(g + c1 + 4);
            uint4 o0, o1;
            o0.x = pack2(h0.x * rn * g0.x, h0.y * rn * g0.y); o0.y = pack2(h0.z * rn * g0.z, h0.w * rn * g0.w); o0.z = pack2(h1.x * rn * g1.x, h1.y * rn * g1.y); o0.w = pack2(h1.z * rn * g1.z, h1.w * rn * g1.w);
            o1.x = pack2(h2.x * rn * g2.x, h2.y * rn * g2.y); o1.y = pack2(h2.z * rn * g2.z, h2.w * rn * g2.w); o1.z = pack2(h3.x * rn * g3.x, h3.y * rn * g3.y); o1.w = pack2(h3.z * rn * g3.z, h3.w * rn * g3.w);
            *(uint4*)(XNw + (size_t)t * D + c0) = o0; *(uint4*)(XNw + (size_t)t * D + c1) = o1;
        }
    }
}


#define XB_TMO      128
#define XB_XCNT(j)  (256  + 64 * (j))
#define XB_XSUB(j)  (1280 + 64 * (j))
#define XB_XGEN(j)  (2304 + 64 * (j))
#define XB_TOP      3328
#define XB_TOPGEN   3392
#define XCD_BAR_WORDS 3456
#define XB_SPIN_CAP (1u << 22)
#define LAS __attribute__((address_space(3)))
__device__ __forceinline__ unsigned xb_ld(unsigned* p)              { return __hip_atomic_load(p, __ATOMIC_RELAXED, __HIP_MEMORY_SCOPE_AGENT); }
__device__ __forceinline__ unsigned xb_add(unsigned* p, unsigned v) { return __hip_atomic_fetch_add(p, v, __ATOMIC_RELAXED, __HIP_MEMORY_SCOPE_AGENT); }
__device__ __forceinline__ unsigned xb_xcc_id() { return (unsigned)__builtin_amdgcn_s_getreg((3 << 11) | 20) & 0xFu; }
#define XB_SPIN(cond, bar) do { unsigned _sp = 0; while (cond) { __builtin_amdgcn_s_sleep(1); \
    if ((++_sp & 255u) == 0u) { if (xb_ld(&(bar)[XB_TMO])) break; if (_sp > XB_SPIN_CAP) { atomicAdd(&(bar)[XB_TMO], 1u); break; } } } } while (0)
struct XcdBarrier { unsigned* bar; unsigned x; volatile LAS unsigned* st; };
__device__ __forceinline__ XcdBarrier xcd_barrier_post(unsigned* bar, volatile LAS unsigned* st) {
    XcdBarrier b; b.bar = bar; b.x = xb_xcc_id(); b.st = st;
    if (__builtin_amdgcn_workitem_id_x() == 0) (void)xb_add(&bar[XB_XCNT(b.x)], 1u);
    return b;
}
__device__ __forceinline__ void xcd_barrier_complete(unsigned* bar, unsigned x, unsigned& nloc, unsigned& nx) {
    const unsigned G = gridDim.x * gridDim.y * gridDim.z;
    unsigned sum, cnt, mine, sp = 0u;
    for (;;) {
        sum = 0u; cnt = 0u; mine = 0u;
#pragma unroll
        for (unsigned j = 0; j < 16; ++j) { const unsigned c = xb_ld(&bar[XB_XCNT(j)]); sum += c; cnt += (c > 0u) ? 1u : 0u; mine = (j == x) ? c : mine; }
        if (sum == G) break;
        __builtin_amdgcn_s_sleep(1);
        if ((++sp & 255u) == 0u) { if (xb_ld(&bar[XB_TMO])) break; if (sp > XB_SPIN_CAP) { atomicAdd(&bar[XB_TMO], 1u); break; } }
    }
    nloc = mine > 0u ? mine : 1u; nx = cnt > 0u ? cnt : 1u;
}
__device__ __forceinline__ void xcd_barrier(const XcdBarrier& b) {
    asm volatile("s_waitcnt vmcnt(0)" ::: "memory");
    __syncthreads();
    if (__builtin_amdgcn_workitem_id_x() == 0) {
        unsigned* bar = b.bar;
        __builtin_amdgcn_s_waitcnt(0);
        unsigned nloc = b.st[0], nx = b.st[1];
        if (nloc == 0u) { xcd_barrier_complete(bar, b.x, nloc, nx); b.st[0] = nloc; b.st[1] = nx; }
        const unsigned old = xb_add(&bar[XB_XSUB(b.x)], 1u);
        const unsigned gen = old / nloc;
        if (old + 1u == (gen + 1u) * nloc) {
            __builtin_amdgcn_fence(__ATOMIC_RELEASE, "agent");
            asm volatile("s_waitcnt vmcnt(0)" ::: "memory");
            const unsigned og = xb_add(&bar[XB_TOP], 1u);
            const unsigned tg = og / nx;
            if (og + 1u == (tg + 1u) * nx) xb_add(&bar[XB_TOPGEN], 1u);
            else XB_SPIN(xb_ld(&bar[XB_TOPGEN]) == tg, bar);
            __builtin_amdgcn_fence(__ATOMIC_ACQUIRE, "agent");
            xb_add(&bar[XB_XGEN(b.x)], 1u);
            asm volatile("s_waitcnt vmcnt(0)" ::: "memory");
        } else {
            XB_SPIN(xb_ld(&bar[XB_XGEN(b.x)]) == gen, bar);
            __builtin_amdgcn_fence(__ATOMIC_ACQUIRE, "agent");
            asm volatile("s_waitcnt vmcnt(0)" ::: "memory");
        }
    }
    __syncthreads();
}

constexpr float QSCALE = 0.10206207261596575f * 1.4426950408889634f;

__device__ __forceinline__ void phase_gemm1(const Params& P, int l, char* lds) {
    unsigned char* ws = P.ws;
    const bf16* XN = (const bf16*)(ws + WS_XN);
    bf16* PROJ = (bf16*)(ws + WS_PROJ);
    bf16* Kb = (bf16*)(ws + WS_K);
    const float* rope = (const float*)(ws + WS_ROPE);
    const bf16* W = (const bf16*)(ws + WS_WIN) + (size_t)l * DINP * D;
    gemm_t<false>(W, D, DINP, XN, D, T, D, [&](int n0, int t0, const f32x16& acc, int r32, int hi, float) {
        const int t = t0 + r32;
        if (n0 < C_KR) {
            bf16* pr = PROJ + (size_t)t * DINP + n0 + 4 * hi;
#pragma unroll
            for (int g = 0; g < 4; ++g) { uint2 o; o.x = cvtpk(acc[4 * g], acc[4 * g + 1]); o.y = cvtpk(acc[4 * g + 2], acc[4 * g + 3]); *(uint2*)(pr + 8 * g) = o; }
        } else if (n0 == C_KR) {
            const int b = t / S, s = t % S;
            uint2 o1[2], o2[2];
#pragma unroll
            for (int g = 0; g < 2; ++g) {
                const float4 cs0 = *(const float4*)(rope + ((size_t)s * 16 + 8 * g + 4 * hi) * 2), cs1 = *(const float4*)(rope + ((size_t)s * 16 + 8 * g + 4 * hi) * 2 + 4);
                const float x10 = acc[4 * g], x11 = acc[4 * g + 1], x12 = acc[4 * g + 2], x13 = acc[4 * g + 3];
                const float x20 = acc[8 + 4 * g], x21 = acc[8 + 4 * g + 1], x22 = acc[8 + 4 * g + 2], x23 = acc[8 + 4 * g + 3];
                o1[g].x = cvtpk(x10 * cs0.x - x20 * cs0.y, x11 * cs0.z - x21 * cs0.w); o1[g].y = cvtpk(x12 * cs1.x - x22 * cs1.y, x13 * cs1.z - x23 * cs1.w);
                o2[g].x = cvtpk(x20 * cs0.x + x10 * cs0.y, x21 * cs0.z + x11 * cs0.w); o2[g].y = cvtpk(x22 * cs1.x + x12 * cs1.y, x23 * cs1.z + x13 * cs1.w);
            }
#pragma unroll
            for (int h = 0; h < NH; ++h) {
                bf16* kr = Kb + ((size_t)(b * NH + h) * S + s) * DQK + 64 + 4 * hi;
                *(uint2*)(kr) = o1[0]; *(uint2*)(kr + 8) = o1[1]; *(uint2*)(kr + 16) = o2[0]; *(uint2*)(kr + 24) = o2[1];
            }
        }
    }, lds);
}
__device__ __forceinline__ void phase_gemm2(const Params& P, int l, char* lds) {
    unsigned char* ws = P.ws;
    const bf16* PROJ = (const bf16*)(ws + WS_PROJ);
    const float* rope = (const float*)(ws + WS_ROPE);
    {
        const bf16* W = (const bf16*)(ws + WS_WUQ) + (size_t)l * 768 * QR;
        bf16* Qb = (bf16*)(ws + WS_Q);
        gemm_t<true>(W, QR, 768, PROJ + C_CQ, DINP, T, QR, [&](int n0, int t0, const f32x16& acc, int r32, int hi, float ssq) {
            const int t = t0 + r32, b = t / S, s = t % S;
            const int h = n0 / DQK, d0 = n0 % DQK;
            const float sc = rsqrtf(ssq * (1.f / QR) + EPS) * QSCALE;
            bf16* qb = Qb + ((size_t)(b * NH + h) * S + s) * DQK + d0 + 4 * hi;
            if (d0 == 64) {
#pragma unroll
                for (int g = 0; g < 2; ++g) {
                    const float4 cs0 = *(const float4*)(rope + ((size_t)s * 16 + 8 * g + 4 * hi) * 2), cs1 = *(const float4*)(rope + ((size_t)s * 16 + 8 * g + 4 * hi) * 2 + 4);
                    const float x10 = acc[4 * g] * sc, x11 = acc[4 * g + 1] * sc, x12 = acc[4 * g + 2] * sc, x13 = acc[4 * g + 3] * sc;
                    const float x20 = acc[8 + 4 * g] * sc, x21 = acc[8 + 4 * g + 1] * sc, x22 = acc[8 + 4 * g + 2] * sc, x23 = acc[8 + 4 * g + 3] * sc;
                    uint2 o1, o2;
                    o1.x = cvtpk(x10 * cs0.x - x20 * cs0.y, x11 * cs0.z - x21 * cs0.w); o1.y = cvtpk(x12 * cs1.x - x22 * cs1.y, x13 * cs1.z - x23 * cs1.w);
                    o2.x = cvtpk(x20 * cs0.x + x10 * cs0.y, x21 * cs0.z + x11 * cs0.w); o2.y = cvtpk(x22 * cs1.x + x12 * cs1.y, x23 * cs1.z + x13 * cs1.w);
                    *(uint2*)(qb + 8 * g) = o1; *(uint2*)(qb + 16 + 8 * g) = o2;
                }
            } else {
#pragma unroll
                for (int g = 0; g < 4; ++g) { uint2 o; o.x = cvtpk(acc[4 * g] * sc, acc[4 * g + 1] * sc); o.y = cvtpk(acc[4 * g + 2] * sc, acc[4 * g + 3] * sc); *(uint2*)(qb + 8 * g) = o; }
            }
        }, lds);
    }
    {
        const bf16* W = (const bf16*)(ws + WS_WUKV) + (size_t)l * 1024 * KVR;
        bf16* Kb = (bf16*)(ws + WS_K); bf16* Vb = (bf16*)(ws + WS_V);
        gemm_t<true>(W, KVR, 1024, PROJ + C_CKV, DINP, T, KVR, [&](int n0, int t0, const f32x16& acc, int r32, int hi, float ssq) {
            const int t = t0 + r32, b = t / S, s = t % S;
            const float sc = rsqrtf(ssq * (1.f / KVR) + EPS);
            bf16* dst;
            if (n0 < 512) dst = Kb + ((size_t)(b * NH + (n0 >> 6)) * S + s) * DQK + (n0 & 63) + 4 * hi;
            else          dst = Vb + ((size_t)(b * NH + ((n0 - 512) >> 6)) * S + s) * DV + (n0 & 63) + 4 * hi;
#pragma unroll
            for (int g = 0; g < 4; ++g) { uint2 o; o.x = cvtpk(acc[4 * g] * sc, acc[4 * g + 1] * sc); o.y = cvtpk(acc[4 * g + 2] * sc, acc[4 * g + 3] * sc); *(uint2*)(dst + 8 * g) = o; }
        }, lds);
    }
}
__device__ __forceinline__ void phase_gemm3(const Params& P, int l, char* lds) {
    unsigned char* ws = P.ws;
    const bf16* Yb = (const bf16*)(ws + WS_XN);
    const bf16* W = (const bf16*)(ws + WS_WOUT) + (size_t)l * D * D;
    const float* hin = (l == 0) ? P.x : P.out;
    float* out = P.out;
    gemm_t<false>(W, D, D, Yb, D, T, D, [&](int n0, int t0, const f32x16& acc, int r32, int hi, float) {
        const size_t base = (size_t)(t0 + r32) * D + n0 + 4 * hi;
#pragma unroll
        for (int g = 0; g < 4; ++g) {
            const float4 hv = *(const float4*)(hin + base + 8 * g);
            *(float4*)(out + base + 8 * g) = make_float4(hv.x + acc[4 * g], hv.y + acc[4 * g + 1], hv.z + acc[4 * g + 2], hv.w + acc[4 * g + 3]);
        }
    }, lds);
}

#define GSYNC() do { XcdBarrier xb_; xb_.bar = (unsigned*)(P.ws + WS_CTL); xb_.x = xb_xcc_id(); xb_.st = (volatile LAS unsigned*)&xb_words; xcd_barrier(xb_); } while (0)
#define PHASE(stmt) { const Params Q = launder(P); stmt; }
__global__ void __launch_bounds__(NTHREADS, 2) k_all(Params P) {
    __shared__ __attribute__((aligned(16))) char sm[LDS_TOTAL];
    __shared__ uint4 xb_words;
    cg::grid_group grid = cg::this_grid();
    if (__builtin_amdgcn_workitem_id_x() == 0) xb_words = make_uint4(0u, 0u, 0u, 0u);
    __syncthreads();
    (void)xcd_barrier_post((unsigned*)(P.ws + WS_CTL), (volatile LAS unsigned*)&xb_words);
    PHASE(phase_prep(Q, sm));
    PHASE(phase_norm(Q.x, Q.norm_mix, (bf16*)(Q.ws + WS_XN)));
    grid.sync();
    for (int l = 0; l < DEPTH; ++l) {
        PHASE(phase_gemm1(Q, l, sm));
#if PROBE_DUP & 2
        PHASE(phase_gemm1(Q, l, sm));
#endif
        GSYNC();
        PHASE(phase_mixlocal(Q, l, sm));
#if PROBE_DUP & 256
        PHASE(phase_mixlocal(Q, l, sm));
#endif
        PHASE(phase_gemm2(Q, l, sm));
        GSYNC();
        PHASE(phase_attn(Q, sm));
        GSYNC();
        PHASE(phase_gemm3(Q, l, sm));
#if PROBE_DUP & 16
        if (l == 0) PHASE(phase_gemm3(Q, l, sm));
#endif
        GSYNC();
        PHASE(phase_norm(Q.out, Q.norm_ffn + l * D, (bf16*)(Q.ws + WS_XN)));
        GSYNC();
        PHASE(phase_route(Q, l, sm));
        GSYNC();
        PHASE(phase_gather(Q, l));
        GSYNC();
    }
}

extern "C" void kernel_launch(void* const* d_in, const int* in_sizes, int n_in, void* d_out, int out_size, void* d_ws, size_t ws_size, hipStream_t stream) {
    static int grid = 0;
    if (grid == 0) {
        if (n_in != 18 || out_size != T * D || ws_size < WS_END) { fprintf(stderr, "kernel_launch: bad sizes n_in %d out %d ws %zu need %zu\n", n_in, out_size, ws_size, (size_t)WS_END); grid = -1; return; }
        int dev = 0, cus = 0, per_cu = 0;
        (void)hipGetDevice(&dev);
        (void)hipDeviceGetAttribute(&cus, hipDeviceAttributeMultiprocessorCount, dev);
        (void)hipOccupancyMaxActiveBlocksPerMultiprocessor(&per_cu, (const void*)k_all, NTHREADS, 0);
        if (per_cu > 2) per_cu = 2;
        if (per_cu < 1) { fprintf(stderr, "kernel_launch: occupancy query says %d\n", per_cu); grid = -1; return; }
        grid = cus * per_cu;
    }
    if (grid < 0) return;
    Params p{};
    p.x = (const float*)d_in[0]; p.norm_mix = (const float*)d_in[1]; p.w_in = (const float*)d_in[2]; p.conv_w = (const float*)d_in[3];
    p.pool_w = (const float*)d_in[4]; p.pool_scale = (const float*)d_in[5]; p.q_norm = (const float*)d_in[6]; p.w_uq = (const float*)d_in[7];
    p.kv_norm = (const float*)d_in[8]; p.w_uk = (const float*)d_in[9]; p.w_uv = (const float*)d_in[10]; p.w_out = (const float*)d_in[11];
    p.norm_ffn = (const float*)d_in[12]; p.peer_wq = (const float*)d_in[13]; p.peer_subkeys = (const float*)d_in[14]; p.peer_u = (const float*)d_in[15];
    p.peer_v = (const float*)d_in[16]; p.norm_final = (const float*)d_in[17];
    p.out = (float*)d_out; p.ws = (unsigned char*)d_ws;
    if (hipMemsetAsync((char*)d_ws + WS_CTL, 0, XCD_BAR_WORDS * 4, stream) != hipSuccess) { fprintf(stderr, "kernel_launch: memset failed\n"); return; }
    void* args[] = {&p};
    hipError_t e = hipLaunchCooperativeKernel((const void*)k_all, dim3(grid), dim3(NTHREADS), args, 0, stream);
    if (e != hipSuccess) fprintf(stderr, "cooperative launch failed: %s (grid %d)\n", hipGetErrorString(e), grid);
}
```

```cpp
#include <hip/hip_runtime.h>
#include <hip/hip_cooperative_groups.h>
#include <cstdio>
#include <cstdint>
namespace cg = cooperative_groups;

#ifndef TAB_FP8
#define TAB_FP8 1
#endif
#ifndef PROBE_DUP
#define PROBE_DUP 0
#endif

constexpr int NB = 4, S = 8192, T = NB * S, D = 1024, DEPTH = 2;
constexpr int DIN = 1696, DINP = 1792;
constexpr int C_BG = 0, C_CG = 256, C_HC = 512, C_HP = 768, C_CQ = 1024, C_CKV = 1408, C_KR = 1664;
constexpr int QR = 384, KVR = 256, NH = 8, DQK = 96, DV = 64;
constexpr int PH = 8, NKEY = 128, NEXP = NKEY * NKEY, TOPK = 16, HK = PH * TOPK;
constexpr float EPS = 1e-6f;

typedef unsigned short bf16;

constexpr size_t WS_CTL   = 0;
constexpr size_t WS_ROPE  = 64 * 1024;
constexpr size_t WS_WIN   = WS_ROPE + (size_t)S * 16 * 2 * 4;
constexpr size_t WS_WUQ   = WS_WIN + (size_t)DEPTH * DINP * D * 2;
constexpr size_t WS_WUKV  = WS_WUQ + (size_t)DEPTH * 768 * QR * 2;
constexpr size_t WS_WOUT  = WS_WUKV + (size_t)DEPTH * 1024 * KVR * 2;
constexpr size_t WS_WPQ   = WS_WOUT + (size_t)DEPTH * D * D * 2;
constexpr size_t WS_XN    = ((WS_WPQ + (size_t)DEPTH * 2048 * D * 2 + 4095) / 4096) * 4096;
constexpr size_t WS_PROJ  = WS_XN + (size_t)T * D * 2;
constexpr size_t WS_Q     = WS_PROJ + (size_t)T * DINP * 2;
constexpr size_t WS_K     = WS_Q + (size_t)T * NH * DQK * 2;
constexpr size_t WS_V     = WS_K + (size_t)T * NH * DQK * 2;
constexpr size_t WS_EXP   = WS_V + (size_t)T * NH * DV * 2;
constexpr size_t WS_GATE  = WS_EXP + (size_t)T * HK * 4;
constexpr size_t TAB_ROWB = TAB_FP8 ? 1024 : 2048;
constexpr size_t WS_TABU  = WS_GATE + (size_t)T * HK * 4;
constexpr size_t WS_TABV  = WS_TABU + (size_t)DEPTH * NEXP * TAB_ROWB;
constexpr size_t WS_TSCU  = WS_TABV + (size_t)DEPTH * NEXP * TAB_ROWB;
constexpr size_t WS_TSCV  = WS_TSCU + (size_t)DEPTH * NEXP * 4;
constexpr size_t WS_END   = WS_TSCV + (size_t)DEPTH * NEXP * 4;
static_assert(WS_END <= (size_t)512 * 1024 * 1024, "workspace budget");

struct Params {
    const float* x; const float* norm_mix; const float* w_in; const float* conv_w; const float* pool_w; const float* pool_scale;
    const float* q_norm; const float* w_uq; const float* kv_norm; const float* w_uk; const float* w_uv; const float* w_out;
    const float* norm_ffn; const float* peer_wq; const float* peer_subkeys; const float* peer_u; const float* peer_v; const float* norm_final;
    float* out; unsigned char* ws;
};

__device__ __forceinline__ bf16 f2bf(float f) { unsigned u = __float_as_uint(f); u += 0x7fffu + ((u >> 16) & 1u); return (bf16)(u >> 16); }
__device__ __forceinline__ float bf2f(bf16 h) { return __uint_as_float(((unsigned)h) << 16); }
__device__ __forceinline__ float bflo(unsigned u) { return __uint_as_float(u << 16); }
__device__ __forceinline__ float bfhi(unsigned u) { return __uint_as_float(u & 0xffff0000u); }
__device__ __forceinline__ unsigned pack2(float a, float b) { return (unsigned)f2bf(a) | ((unsigned)f2bf(b) << 16); }
__device__ __forceinline__ float wave_sum(float v) {
#pragma unroll
    for (int m = 32; m >= 1; m >>= 1) v += __shfl_xor(v, m, 64);
    return v;
}
__device__ __forceinline__ float gelu_exact(float x) { return 0.5f * x * (1.f + erff(x * 0.70710678118654752f)); }

#define NTHREADS 256
__device__ __forceinline__ int tidx() { int t = (int)__builtin_amdgcn_workitem_id_x(); asm volatile("" : "+v"(t)); return t; }
__device__ __forceinline__ int gwave() { return blockIdx.x * (NTHREADS / 64) + (tidx() >> 6); }
__device__ __forceinline__ int nwave() { return gridDim.x * (NTHREADS / 64); }
__device__ __forceinline__ size_t gtid() { return (size_t)blockIdx.x * NTHREADS + tidx(); }
__device__ __forceinline__ size_t gnth() { return (size_t)gridDim.x * NTHREADS; }


__device__ __forceinline__ Params launder(const Params& P) {
    typedef __attribute__((address_space(1))) char* gp_t;
    gp_t g[20] = {(gp_t)(char*)P.x, (gp_t)(char*)P.norm_mix, (gp_t)(char*)P.w_in, (gp_t)(char*)P.conv_w, (gp_t)(char*)P.pool_w, (gp_t)(char*)P.pool_scale, (gp_t)(char*)P.q_norm, (gp_t)(char*)P.w_uq,
                  (gp_t)(char*)P.kv_norm, (gp_t)(char*)P.w_uk, (gp_t)(char*)P.w_uv, (gp_t)(char*)P.w_out, (gp_t)(char*)P.norm_ffn, (gp_t)(char*)P.peer_wq, (gp_t)(char*)P.peer_subkeys,
                  (gp_t)(char*)P.peer_u, (gp_t)(char*)P.peer_v, (gp_t)(char*)P.norm_final, (gp_t)(char*)P.out, (gp_t)(char*)P.ws};
    asm volatile("" : "+s"(g[0]), "+s"(g[1]), "+s"(g[2]), "+s"(g[3]), "+s"(g[4]), "+s"(g[5]), "+s"(g[6]), "+s"(g[7]), "+s"(g[8]), "+s"(g[9]));
    asm volatile("" : "+s"(g[10]), "+s"(g[11]), "+s"(g[12]), "+s"(g[13]), "+s"(g[14]), "+s"(g[15]), "+s"(g[16]), "+s"(g[17]), "+s"(g[18]), "+s"(g[19]));
    Params Q;
    Q.x = (const float*)(char*)g[0]; Q.norm_mix = (const float*)(char*)g[1]; Q.w_in = (const float*)(char*)g[2]; Q.conv_w = (const float*)(char*)g[3]; Q.pool_w = (const float*)(char*)g[4];
    Q.pool_scale = (const float*)(char*)g[5]; Q.q_norm = (const float*)(char*)g[6]; Q.w_uq = (const float*)(char*)g[7]; Q.kv_norm = (const float*)(char*)g[8]; Q.w_uk = (const float*)(char*)g[9];
    Q.w_uv = (const float*)(char*)g[10]; Q.w_out = (const float*)(char*)g[11]; Q.norm_ffn = (const float*)(char*)g[12]; Q.peer_wq = (const float*)(char*)g[13]; Q.peer_subkeys = (const float*)(char*)g[14];
    Q.peer_u = (const float*)(char*)g[15]; Q.peer_v = (const float*)(char*)g[16]; Q.norm_final = (const float*)(char*)g[17]; Q.out = (float*)(char*)g[18]; Q.ws = (unsigned char*)(char*)g[19];
    return Q;
}

typedef __attribute__((ext_vector_type(8))) short bf16x8;
typedef __attribute__((ext_vector_type(16))) float f32x16;
typedef __attribute__((ext_vector_type(2))) __bf16 bf2_t;
#define MFMA32(a, b, c) __builtin_amdgcn_mfma_f32_32x32x16_bf16(a, b, c, 0, 0, 0)
__device__ __forceinline__ int crow(int r, int hi) { return (r & 3) + 8 * (r >> 2) + 4 * hi; }
__device__ __forceinline__ float dot2bf(unsigned a, unsigned b, float c) { return __builtin_amdgcn_fdot2_f32_bf16(__builtin_bit_cast(bf2_t, a), __builtin_bit_cast(bf2_t, b), c, false); }
__device__ __forceinline__ unsigned cvtpk(float lo, float hi) { unsigned r; asm("v_cvt_pk_bf16_f32 %0, %1, %2" : "=v"(r) : "v"(lo), "v"(hi)); return r; }
constexpr int G_LDT = 144;
constexpr int G_OPB = 128 * G_LDT;
constexpr int G_BUF = 2 * G_OPB;
constexpr int GEMM_LDS = 2 * G_BUF;
constexpr int LDS_TOTAL = GEMM_LDS + 512;

template <int WT, bool ROWSS>
__device__ __forceinline__ void gemm_kloop(const bf16* __restrict__ Ag0, int lda, const bf16* __restrict__ Bg0, int ldb, int nk, f32x16 (&acc)[4], float (&ss)[4], char* lds, int tid) {
    const int lane = tid & 63, w = tid >> 6, r32 = lane & 31, hi = lane >> 5;
    const int srow = tid >> 3, sch = tid & 7;
    const bf16* Ag = Ag0 + (size_t)srow * lda + sch * 8;
    const bf16* Bg = Bg0 + (size_t)srow * ldb + sch * 8;
#pragma unroll
    for (int i = 0; i < 4; ++i)
#pragma unroll
        for (int r = 0; r < 16; ++r) acc[i][r] = 0.f;
    ss[0] = 0.f; ss[1] = 0.f; ss[2] = 0.f; ss[3] = 0.f;
    uint4 pa0, pa1, pa2, pa3, pb0, pb1, pb2, pb3, qa0, qa1, qa2, qa3, qb0, qb1, qb2, qb3;
#define G_LOAD(S, kofs) do { \
    S##a0 = *(const uint4*)(Ag + (kofs)); S##a1 = *(const uint4*)(Ag + (size_t)32 * lda + (kofs)); S##a2 = *(const uint4*)(Ag + (size_t)64 * lda + (kofs)); S##a3 = *(const uint4*)(Ag + (size_t)96 * lda + (kofs)); \
    S##b0 = *(const uint4*)(Bg + (kofs)); S##b1 = *(const uint4*)(Bg + (size_t)32 * ldb + (kofs)); S##b2 = *(const uint4*)(Bg + (size_t)64 * ldb + (kofs)); S##b3 = *(const uint4*)(Bg + (size_t)96 * ldb + (kofs)); } while (0)
#define G_SS(s_, r_) do { s_ = dot2bf(r_.x, r_.x, s_); s_ = dot2bf(r_.y, r_.y, s_); s_ = dot2bf(r_.z, r_.z, s_); s_ = dot2bf(r_.w, r_.w, s_); } while (0)
#define G_STORE(S, buf) do { \
    char* wa = lds + (buf) * G_BUF + srow * G_LDT + sch * 16; char* wb = wa + G_OPB; \
    *(uint4*)(wa) = S##a0; *(uint4*)(wa + 32 * G_LDT) = S##a1; *(uint4*)(wa + 64 * G_LDT) = S##a2; *(uint4*)(wa + 96 * G_LDT) = S##a3; \
    *(uint4*)(wb) = S##b0; *(uint4*)(wb + 32 * G_LDT) = S##b1; *(uint4*)(wb + 64 * G_LDT) = S##b2; *(uint4*)(wb + 96 * G_LDT) = S##b3; \
    if (ROWSS) { G_SS(ss[0], S##b0); G_SS(ss[1], S##b1); G_SS(ss[2], S##b2); G_SS(ss[3], S##b3); } } while (0)
#define G_COMPUTE(buf) do { \
    const char* bA = lds + (buf) * G_BUF; const char* bB = bA + G_OPB; \
    if (WT == 0) { \
        const char* pa = bA + ((w >> 1) * 64 + r32) * G_LDT + hi * 16; \
        const char* pb = bB + ((w & 1) * 64 + r32) * G_LDT + hi * 16; \
        _Pragma("unroll") for (int ks = 0; ks < 4; ++ks) { \
            const bf16x8 a0 = *(const bf16x8*)(pa + ks * 32), a1 = *(const bf16x8*)(pa + 32 * G_LDT + ks * 32); \
            const bf16x8 b0 = *(const bf16x8*)(pb + ks * 32), b1 = *(const bf16x8*)(pb + 32 * G_LDT + ks * 32); \
            acc[0] = MFMA32(a0, b0, acc[0]); acc[1] = MFMA32(a0, b1, acc[1]); \
            acc[2] = MFMA32(a1, b0, acc[2]); acc[3] = MFMA32(a1, b1, acc[3]); } \
    } else { \
        const char* pa = bA + r32 * G_LDT + hi * 16; \
        const char* pb = bB + (w * 32 + r32) * G_LDT + hi * 16; \
        _Pragma("unroll") for (int ks = 0; ks < 4; ++ks) { \
            const bf16x8 b0 = *(const bf16x8*)(pb + ks * 32); \
            const bf16x8 a0 = *(const bf16x8*)(pa + ks * 32), a1 = *(const bf16x8*)(pa + 32 * G_LDT + ks * 32); \
            const bf16x8 a2 = *(const bf16x8*)(pa + 64 * G_LDT + ks * 32), a3 = *(const bf16x8*)(pa + 96 * G_LDT + ks * 32); \
            acc[0] = MFMA32(a0, b0, acc[0]); acc[1] = MFMA32(a1, b0, acc[1]); \
            acc[2] = MFMA32(a2, b0, acc[2]); acc[3] = MFMA32(a3, b0, acc[3]); } \
    } } while (0)
    G_LOAD(p, 0); G_LOAD(q, 64);
    for (int kt = 0; kt < nk; kt += 2) {
        G_STORE(p, 0);
        __syncthreads();
        { const int kn = (kt + 2 < nk) ? (kt + 2) : (nk - 2); G_LOAD(p, kn * 64); }
        G_COMPUTE(0);
        G_STORE(q, 1);
        __syncthreads();
        { const int kn = (kt + 3 < nk) ? (kt + 3) : (nk - 1); G_LOAD(q, kn * 64); }
        G_COMPUTE(1);
    }
#undef G_STORE
#undef G_COMPUTE
#undef G_LOAD
#undef G_SS
}

template <bool ROWSS, class EPI>
__device__ __forceinline__ void gemm_t(const bf16* __restrict__ Wt, int ldw, int N, const bf16* __restrict__ X, int ldx, int M, int K, EPI epi, char* lds) {
    const int tid = tidx(), lane = tid & 63, w = tid >> 6, r32 = lane & 31, hi = lane >> 5;
    const int tilesN = N / 128, tilesM = M / 128, nk = K / 64;
    float* rowss = (float*)(lds + GEMM_LDS);
    for (int tile = blockIdx.x; tile < tilesM * tilesN; tile += gridDim.x) {
        const int tm = tile / tilesN, tn = tile % tilesN;
        f32x16 acc[4]; float ss[4];
        gemm_kloop<0, ROWSS>(Wt + (size_t)(tn * 128) * ldw, ldw, X + (size_t)(tm * 128) * ldx, ldx, nk, acc, ss, lds, tid);
        if (ROWSS) {
#pragma unroll
            for (int i = 0; i < 4; ++i) { float v = ss[i]; v += __shfl_xor(v, 1, 64); v += __shfl_xor(v, 2, 64); v += __shfl_xor(v, 4, 64); if ((tid & 7) == 0) rowss[(tid >> 3) + 32 * i] = v; }
            __syncthreads();
        }
#pragma unroll
        for (int i = 0; i < 2; ++i)
#pragma unroll
            for (int j = 0; j < 2; ++j) {
                const int tl = (w & 1) * 64 + j * 32;
                epi(tn * 128 + (w >> 1) * 64 + i * 32, tm * 128 + tl, acc[i * 2 + j], r32, hi, ROWSS ? rowss[tl + r32] : 0.f);
            }
        __syncthreads();
    }
}

__device__ __forceinline__ void transpose_tiled(const float* __restrict__ W, bf16* __restrict__ Wt, int K, int N, int Npad, const float* __restrict__ gain, char* lds) {
    float (*tl)[65] = (float (*)[65])lds;
    const int tid = tidx(), a = tid & 63, q = tid >> 6;
    const int tK = K / 64, tN = Npad / 64;
    for (int tile = blockIdx.x; tile < tK * tN; tile += gridDim.x) {
        const int k0 = (tile / tN) * 64, n0 = (tile % tN) * 64;
#pragma unroll 4
        for (int i = 0; i < 16; ++i) {
            const int k = k0 + q * 16 + i, n = n0 + a;
            float v = (n < N) ? W[(size_t)k * N + n] : 0.f;
            if (gain) v *= gain[k];
            tl[q * 16 + i][a] = v;
        }
        __syncthreads();
#pragma unroll 4
        for (int i = 0; i < 16; ++i) { const int nl = q * 16 + i; Wt[(size_t)(n0 + nl) * K + k0 + a] = f2bf(tl[a][nl]); }
        __syncthreads();
    }
}

__device__ __forceinline__ void quant_row(const float4 (&v)[4], unsigned char* __restrict__ dst, float* __restrict__ scl, int r, int lane) {
    float am = 0.f;
#pragma unroll
    for (int j = 0; j < 4; ++j) am = fmaxf(am, fmaxf(fmaxf(fabsf(v[j].x), fabsf(v[j].y)), fmaxf(fabsf(v[j].z), fabsf(v[j].w))));
#pragma unroll
    for (int m = 32; m >= 1; m >>= 1) am = fmaxf(am, __shfl_xor(am, m, 64));
    const float sc = (am > 0.f) ? am * (1.f / 448.f) : 1.f;
    const float is = 1.f / sc;
    uint4 o;
    { int w = 0; w = __builtin_amdgcn_cvt_pk_fp8_f32(v[0].x * is, v[0].y * is, w, false); w = __builtin_amdgcn_cvt_pk_fp8_f32(v[0].z * is, v[0].w * is, w, true); o.x = (unsigned)w; }
    { int w = 0; w = __builtin_amdgcn_cvt_pk_fp8_f32(v[1].x * is, v[1].y * is, w, false); w = __builtin_amdgcn_cvt_pk_fp8_f32(v[1].z * is, v[1].w * is, w, true); o.y = (unsigned)w; }
    { int w = 0; w = __builtin_amdgcn_cvt_pk_fp8_f32(v[2].x * is, v[2].y * is, w, false); w = __builtin_amdgcn_cvt_pk_fp8_f32(v[2].z * is, v[2].w * is, w, true); o.z = (unsigned)w; }
    { int w = 0; w = __builtin_amdgcn_cvt_pk_fp8_f32(v[3].x * is, v[3].y * is, w, false); w = __builtin_amdgcn_cvt_pk_fp8_f32(v[3].z * is, v[3].w * is, w, true); o.w = (unsigned)w; }
    { const int lay = r / NEXP, e = r % NEXP; *(uint4*)(dst + (((size_t)(lay * 8 + (lane >> 3)) * NEXP + e) * 128) + (lane & 7) * 16) = o; }
    if (lane == 0) scl[r] = sc;
}
__device__ __forceinline__ void convert_table(const float* __restrict__ src, unsigned char* __restrict__ dst, float* __restrict__ scl, int rows) {
    static_assert(TAB_FP8, "fp8 tables");
    const int lane = tidx() & 63;
    const int nw = nwave();
    for (int r = gwave(); r < rows; r += 2 * nw) {
        const int r2 = r + nw;
        float4 v0[4], v1[4];
        const float4* s0 = (const float4*)(src + (size_t)r * D);
        const float4* s1 = (const float4*)(src + (size_t)(r2 < rows ? r2 : r) * D);
#pragma unroll
        for (int j = 0; j < 4; ++j) { v0[j] = s0[lane * 4 + j]; v1[j] = s1[lane * 4 + j]; }
        quant_row(v0, dst, scl, r, lane);
        if (r2 < rows) quant_row(v1, dst, scl, r2, lane);
    }
}
__device__ __forceinline__ void phase_prep(const Params& P, char* lds) {
    unsigned char* ws = P.ws;
    for (int l = 0; l < DEPTH; ++l) {
        transpose_tiled(P.w_in + (size_t)l * D * DIN, (bf16*)(ws + WS_WIN) + (size_t)l * DINP * D, D, DIN, DINP, nullptr, lds);
        transpose_tiled(P.w_uq + (size_t)l * QR * 768, (bf16*)(ws + WS_WUQ) + (size_t)l * 768 * QR, QR, 768, 768, P.q_norm + l * QR, lds);
        transpose_tiled(P.w_uk + (size_t)l * KVR * 512, (bf16*)(ws + WS_WUKV) + (size_t)l * 1024 * KVR, KVR, 512, 512, P.kv_norm + l * KVR, lds);
        transpose_tiled(P.w_uv + (size_t)l * KVR * 512, (bf16*)(ws + WS_WUKV) + (size_t)l * 1024 * KVR + (size_t)512 * KVR, KVR, 512, 512, P.kv_norm + l * KVR, lds);
        transpose_tiled(P.w_out + (size_t)l * D * D, (bf16*)(ws + WS_WOUT) + (size_t)l * D * D, D, D, D, nullptr, lds);
    }
    {
        bf16* Wc = (bf16*)(ws + WS_WPQ);
        float (*As)[68] = (float (*)[68])lds;
        float (*Bs)[68] = (float (*)[68])(lds + 16 * 68 * 4);
        const int tid = tidx(), tx = tid & 15, ty = tid >> 4;
        const int lr = tid >> 2, ld4 = (tid & 3) * 4;
        for (int tile = blockIdx.x; tile < (DEPTH * 2048 / 64) * (D / 64); tile += gridDim.x) {
            const int row0 = (tile >> 4) * 64, k0 = (tile & 15) * 64;
            const int l = row0 >> 11, hp = (row0 >> 7) & 15, n0 = row0 & 127;
            const float* skp = P.peer_subkeys + (((size_t)l * 2 + (hp & 1)) * NKEY + n0 + lr) * 128 + ld4;
            const float* wqp = P.peer_wq + ((size_t)l * D + k0 + lr) * 2048 + hp * 128 + ld4;
            float acc[4][4];
#pragma unroll
            for (int i = 0; i < 4; ++i)
#pragma unroll
                for (int j = 0; j < 4; ++j) acc[i][j] = 0.f;
            for (int d0 = 0; d0 < 128; d0 += 16) {
                const float4 av = *(const float4*)(skp + d0), bv = *(const float4*)(wqp + d0);
                As[ld4 + 0][lr] = av.x; As[ld4 + 1][lr] = av.y; As[ld4 + 2][lr] = av.z; As[ld4 + 3][lr] = av.w;
                Bs[ld4 + 0][lr] = bv.x; Bs[ld4 + 1][lr] = bv.y; Bs[ld4 + 2][lr] = bv.z; Bs[ld4 + 3][lr] = bv.w;
                __syncthreads();
#pragma unroll
                for (int kk = 0; kk < 16; ++kk) {
                    const float4 a4 = *(const float4*)&As[kk][ty * 4], b4 = *(const float4*)&Bs[kk][tx * 4];
                    const float aa[4] = {a4.x, a4.y, a4.z, a4.w}, bb[4] = {b4.x, b4.y, b4.z, b4.w};
#pragma unroll
                    for (int i = 0; i < 4; ++i)
#pragma unroll
                        for (int j = 0; j < 4; ++j) acc[i][j] = fmaf(aa[i], bb[j], acc[i][j]);
                }
                __syncthreads();
            }
#pragma unroll
            for (int i = 0; i < 4; ++i) {
                uint2 o; o.x = pack2(acc[i][0], acc[i][1]); o.y = pack2(acc[i][2], acc[i][3]);
                *(uint2*)(Wc + (size_t)(row0 + ty * 4 + i) * D + k0 + tx * 4) = o;
            }
        }
    }
    convert_table(P.peer_u, ws + WS_TABU, (float*)(ws + WS_TSCU), DEPTH * NEXP);
    convert_table(P.peer_v, ws + WS_TABV, (float*)(ws + WS_TSCV), DEPTH * NEXP);
    float* rope = (float*)(ws + WS_ROPE);
    for (size_t i = gtid(); i < (size_t)S * 16; i += gnth()) {
        const int s = (int)(i >> 4), f = (int)(i & 15);
        const double inv = pow(10000.0, -(double)f / 16.0);
        const double ang = (double)s * inv;
        rope[2 * i] = (float)cos(ang); rope[2 * i + 1] = (float)sin(ang);
    }
}

__device__ __forceinline__ void phase_norm(const float* __restrict__ h, const float* __restrict__ g, bf16* __restrict__ xn) {
    const int lane = tidx() & 63;
    for (int t = gwave(); t < T; t += nwave()) {
        const float4* hr = (const float4*)(h + (size_t)t * D);
        float4 v[4]; float ss = 0.f;
#pragma unroll
        for (int j = 0; j < 4; ++j) { v[j] = hr[j * 64 + lane]; ss += v[j].x * v[j].x + v[j].y * v[j].y + v[j].z * v[j].z + v[j].w * v[j].w; }
        ss = wave_sum(ss);
        const float r = rsqrtf(ss * (1.f / D) + EPS);
#pragma unroll
        for (int j = 0; j < 4; ++j) {
            const float4 gg = ((const float4*)g)[j * 64 + lane];
            uint2 o; o.x = pack2(v[j].x * r * gg.x, v[j].y * r * gg.y); o.y = pack2(v[j].z * r * gg.z, v[j].w * r * gg.w);
            ((uint2*)(xn + (size_t)t * D))[j * 64 + lane] = o;
        }
    }
}

__device__ __forceinline__ void phase_mixlocal(const Params& P, int l, char* lds) {
    const bf16* proj = (const bf16*)(P.ws + WS_PROJ);
    bf16* Y = (bf16*)(P.ws + WS_XN);
    const int tid = tidx();
    {
        const float* cw = P.conv_w + (size_t)l * 3 * 256;
        for (size_t i = gtid(); i < (size_t)T * 32; i += gnth()) {
            const int t = (int)(i >> 5), c0 = (int)(i & 31) * 8, s = t & (S - 1);
            const bf16* pr = proj + (size_t)t * DINP;
            float acc[8];
#pragma unroll
            for (int e = 0; e < 8; ++e) acc[e] = 0.f;
#pragma unroll
            for (int j = 0; j < 3; ++j) {
                if (s - 2 + j >= 0) {
                    const bf16* pp = pr - (size_t)(2 - j) * DINP;
                    const uint4 g = *(const uint4*)(pp + C_CG + c0), hc = *(const uint4*)(pp + C_HC + c0);
                    const float4 w0 = *(const float4*)(cw + j * 256 + c0), w1 = *(const float4*)(cw + j * 256 + c0 + 4);
                    acc[0] = fmaf(w0.x, bflo(g.x) * bflo(hc.x), acc[0]); acc[1] = fmaf(w0.y, bfhi(g.x) * bfhi(hc.x), acc[1]);
                    acc[2] = fmaf(w0.z, bflo(g.y) * bflo(hc.y), acc[2]); acc[3] = fmaf(w0.w, bfhi(g.y) * bfhi(hc.y), acc[3]);
                    acc[4] = fmaf(w1.x, bflo(g.z) * bflo(hc.z), acc[4]); acc[5] = fmaf(w1.y, bfhi(g.z) * bfhi(hc.z), acc[5]);
                    acc[6] = fmaf(w1.z, bflo(g.w) * bflo(hc.w), acc[6]); acc[7] = fmaf(w1.w, bfhi(g.w) * bfhi(hc.w), acc[7]);
                }
            }
            const uint4 bg = *(const uint4*)(pr + C_BG + c0);
            uint4 o;
            o.x = pack2(bflo(bg.x) * acc[0], bfhi(bg.x) * acc[1]); o.y = pack2(bflo(bg.y) * acc[2], bfhi(bg.y) * acc[3]);
            o.z = pack2(bflo(bg.z) * acc[4], bfhi(bg.z) * acc[5]); o.w = pack2(bflo(bg.w) * acc[6], bfhi(bg.w) * acc[7]);
            *(uint4*)(Y + (size_t)t * D + c0) = o;
        }
    }
    {
        float (*pl)[68] = (float (*)[68])lds;
        const float* pw = P.pool_w + (size_t)l * 4 * 64 * 64;
        const float* psc = P.pool_scale + l * 256;
        const int a = tid & 63, q = tid >> 6;
        for (int tile = blockIdx.x; tile < (T / 64) * 4; tile += gridDim.x) {
            const int g = tile & 3, t0 = (tile >> 2) * 64;
            const int w = 2 << g;
            {
                const bf16* col = proj + C_HP + g * 64 + a;
                const int tf = t0 + q * 16, sf = tf & (S - 1);
                float sum = 0.f;
                for (int d = 1; d < w; ++d) if (sf - d >= 0) sum += bf2f(col[(size_t)(tf - d) * DINP]);
#pragma unroll 4
                for (int i = 0; i < 16; ++i) {
                    const int s = sf + i;
                    const float xv = bf2f(col[(size_t)(tf + i) * DINP]);
                    sum += xv;
                    const int cnt = (s + 1 < w) ? (s + 1) : w;
                    pl[q * 16 + i][a] = sum / (float)cnt - xv;
                    if (s - w + 1 >= 0) sum -= bf2f(col[(size_t)(tf + i - w + 1) * DINP]);
                }
            }
            __syncthreads();
            {
                float pc[64];
#pragma unroll
                for (int c = 0; c < 64; ++c) pc[c] = pw[(g * 64 + c) * 64 + a];
                const float sc = psc[g * 64 + a];
#pragma unroll 2
                for (int i = 0; i < 16; ++i) {
                    const float4* row = (const float4*)&pl[q * 16 + i][0];
                    float m0 = 0.f, m1 = 0.f;
#pragma unroll
                    for (int c4 = 0; c4 < 16; ++c4) { const float4 v = row[c4]; m0 = fmaf(v.x, pc[4 * c4], m0); m1 = fmaf(v.y, pc[4 * c4 + 1], m1); m0 = fmaf(v.z, pc[4 * c4 + 2], m0); m1 = fmaf(v.w, pc[4 * c4 + 3], m1); }
                    Y[(size_t)(t0 + q * 16 + i) * D + 256 + g * 64 + a] = f2bf((m0 + m1) * sc);
                }
            }
            __syncthreads();
        }
    }
}

typedef short v4i16_t __attribute__((ext_vector_type(4)));
typedef __attribute__((address_space(3))) v4i16_t* lds_v4p;
__device__ __forceinline__ v4i16_t vtr(const char* p) { return __builtin_amdgcn_ds_read_tr16_b64_v4i16((lds_v4p)p); }
constexpr int A_KP = 208, A_VP = 192;
constexpr int A_KB = 64 * A_KP, A_VB = 64 * A_VP, A_BUF = A_KB + A_VB, ATTN_LDS = 2 * A_BUF;
static_assert(ATTN_LDS <= GEMM_LDS, "attention LDS");

__device__ __forceinline__ void attn_unit(const bf16* __restrict__ Qb, const bf16* __restrict__ Kb, const bf16* __restrict__ Vb, bf16* __restrict__ Y, int bh, int qblk, char* lds) {
    const int tid = tidx(), lane = tid & 63, w = tid >> 6, r32 = lane & 31, hi = lane >> 5;
    const int q0 = qblk * 128, qw0 = q0 + w * 32;
    const int NT = 2 * qblk + 2;
    bf16x8 qf[6];
    {
        const bf16* qp = Qb + ((size_t)bh * S + qw0 + r32) * DQK + hi * 8;
#pragma unroll
        for (int ks = 0; ks < 6; ++ks) qf[ks] = *(const bf16x8*)(qp + ks * 16);
    }
    f32x16 o0, o1;
#pragma unroll
    for (int r = 0; r < 16; ++r) { o0[r] = 0.f; o1[r] = 0.f; }
    float m = -1e30f, lsum = 0.f;
    const char* Kg = (const char*)(Kb + (size_t)bh * S * DQK) + tid * 16;
    const char* Vg = (const char*)(Vb + (size_t)bh * S * DV) + tid * 16;
    const int kl0 = (tid / 12) * A_KP + (tid % 12) * 16, kl1 = ((tid + 256) / 12) * A_KP + ((tid + 256) % 12) * 16, kl2 = ((tid + 512) / 12) * A_KP + ((tid + 512) % 12) * 16;
    const int vl0 = (tid >> 3) * A_VP + (tid & 7) * 16, vl1 = vl0 + 32 * A_VP;
    uint4 pk0, pk1, pk2, pv0, pv1, qk0, qk1, qk2, qv0, qv1;
#define A_LOAD(S, t) do { const char* kg = Kg + (size_t)(t) * (64 * 192); const char* vg = Vg + (size_t)(t) * (64 * 128); \
        S##k0 = *(const uint4*)(kg); S##k1 = *(const uint4*)(kg + 4096); S##k2 = *(const uint4*)(kg + 8192); S##v0 = *(const uint4*)(vg); S##v1 = *(const uint4*)(vg + 4096); } while (0)
#define A_STORE(S, bK, bV) do { *(uint4*)(bK + kl0) = S##k0; *(uint4*)(bK + kl1) = S##k1; *(uint4*)(bK + kl2) = S##k2; *(uint4*)(bV + vl0) = S##v0; *(uint4*)(bV + vl1) = S##v1; } while (0)
#define A_PV(pf, kofs) do { \
            { const v4i16_t lo = vtr(pv + (kofs) * A_VP), hh = vtr(pv + ((kofs) + 8) * A_VP); const bf16x8 vf = {lo[0], lo[1], lo[2], lo[3], hh[0], hh[1], hh[2], hh[3]}; o0 = MFMA32(vf, pf.v, o0); } \
            { const v4i16_t lo = vtr(pv + (kofs) * A_VP + 64), hh = vtr(pv + ((kofs) + 8) * A_VP + 64); const bf16x8 vf = {lo[0], lo[1], lo[2], lo[3], hh[0], hh[1], hh[2], hh[3]}; o1 = MFMA32(vf, pf.v, o1); } } while (0)
    const int pvo = (4 * hi + ((lane & 15) >> 2)) * A_VP + (16 * ((lane >> 4) & 1) + 4 * (lane & 3)) * 2;
    A_LOAD(p, 0); A_LOAD(q, 1);
    for (int t2 = 0; t2 < NT; t2 += 2) {
#pragma unroll
        for (int half = 0; half < 2; ++half) {
            const int t = t2 + half;
            char* bK = lds + half * A_BUF; char* bV = bK + A_KB;
            if (half == 0) A_STORE(p, bK, bV); else A_STORE(q, bK, bV);
            __syncthreads();
            { const int tn = (t + 2 < NT) ? (t + 2) : (NT - 2 + half); if (half == 0) A_LOAD(p, tn); else A_LOAD(q, tn); }
        const int kt0 = t * 64;
        if (kt0 <= qw0) {
            f32x16 s0, s1;
#pragma unroll
            for (int r = 0; r < 16; ++r) { s0[r] = 0.f; s1[r] = 0.f; }
            const char* pk = bK + r32 * A_KP + hi * 16;
#pragma unroll
            for (int ks = 0; ks < 6; ++ks) {
                const bf16x8 a0 = *(const bf16x8*)(pk + ks * 32), a1 = *(const bf16x8*)(pk + 32 * A_KP + ks * 32);
                s0 = MFMA32(a0, qf[ks], s0); s1 = MFMA32(a1, qf[ks], s1);
            }
            if (kt0 + 63 > qw0) {
                const int qrow = qw0 + r32;
#pragma unroll
                for (int r = 0; r < 16; ++r) { const int key = kt0 + crow(r, hi); if (key > qrow) s0[r] = -INFINITY; if (key + 32 > qrow) s1[r] = -INFINITY; }
            }
            float mx = fmaxf(s0[0], s1[0]);
#pragma unroll
            for (int r = 1; r < 16; ++r) mx = fmaxf(mx, fmaxf(s0[r], s1[r]));
            mx = fmaxf(mx, __shfl_xor(mx, 32, 64));
            const float mn = fmaxf(m, mx);
            const float alpha = __builtin_amdgcn_exp2f(m - mn);
            m = mn;
            float ps = 0.f;
#pragma unroll
            for (int r = 0; r < 16; ++r) { s0[r] = __builtin_amdgcn_exp2f(s0[r] - mn); s1[r] = __builtin_amdgcn_exp2f(s1[r] - mn); ps += s0[r] + s1[r]; }
            lsum = lsum * alpha + ps;
#pragma unroll
            for (int r = 0; r < 16; ++r) { o0[r] *= alpha; o1[r] *= alpha; }
            union { unsigned u[4]; bf16x8 v; } p00, p01, p10, p11;
#pragma unroll
            for (int j = 0; j < 4; ++j) { p00.u[j] = cvtpk(s0[2 * j], s0[2 * j + 1]); p01.u[j] = cvtpk(s0[8 + 2 * j], s0[9 + 2 * j]); p10.u[j] = cvtpk(s1[2 * j], s1[2 * j + 1]); p11.u[j] = cvtpk(s1[8 + 2 * j], s1[9 + 2 * j]); }
            const char* pv = bV + pvo;
            A_PV(p00, 0); A_PV(p01, 16); A_PV(p10, 32); A_PV(p11, 48);
        }
        }
    }
    lsum += __shfl_xor(lsum, 32, 64);
    const float inv = 1.f / lsum;
    const int b = bh >> 3, h = bh & 7;
    bf16* yo = Y + (size_t)(b * S + qw0 + r32) * D + 512 + h * 64 + 4 * hi;
#pragma unroll
    for (int g = 0; g < 4; ++g) {
        uint2 a, c;
        a.x = cvtpk(o0[4 * g] * inv, o0[4 * g + 1] * inv); a.y = cvtpk(o0[4 * g + 2] * inv, o0[4 * g + 3] * inv);
        c.x = cvtpk(o1[4 * g] * inv, o1[4 * g + 1] * inv); c.y = cvtpk(o1[4 * g + 2] * inv, o1[4 * g + 3] * inv);
        *(uint2*)(yo + 8 * g) = a; *(uint2*)(yo + 32 + 8 * g) = c;
    }
    __syncthreads();
}
__device__ __forceinline__ void phase_attn(const Params& P, char* lds) {
    const bf16* Qb = (const bf16*)(P.ws + WS_Q);
    const bf16* Kb = (const bf16*)(P.ws + WS_K);
    const bf16* Vb = (const bf16*)(P.ws + WS_V);
    bf16* Y = (bf16*)(P.ws + WS_XN);
    for (int u = blockIdx.x; u < NB * NH * (S / 128); u += gridDim.x) {
        const int bh = u & 31, v = u >> 5;
        const int qblk = (v < 16) ? (63 - v) : (v < 32) ? (v - 16) : (v < 48) ? (79 - v) : (v - 32);
        attn_unit(Qb, Kb, Vb, Y, bh, qblk, lds);
    }
}

#define NET_HD __device__ __forceinline__
#define NET_U2F(u) __uint_as_float(u)
#define NET_F2U(f) __float_as_uint(f)
#define CE_DESC(a, b) do { const float hi__ = fmaxf(a, b), lo__ = fminf(a, b); a = hi__; b = lo__; } while (0)
NET_HD void sort16_desc(float (&v)[16]) {
#pragma unroll
    for (int k = 2; k <= 16; k <<= 1) {
#pragma unroll
        for (int j = k >> 1; j > 0; j >>= 1) {
#pragma unroll
            for (int i = 0; i < 16; ++i) {
                const int l = i ^ j;
                if (l > i) { if ((i & k) == 0) CE_DESC(v[i], v[l]); else CE_DESC(v[l], v[i]); }
            }
        }
    }
}
NET_HD void merge16_desc(float (&a)[16], const float (&b)[16]) {
#pragma unroll
    for (int i = 0; i < 16; ++i) a[i] = fmaxf(a[i], b[15 - i]);
#pragma unroll
    for (int j = 8; j > 0; j >>= 1) {
#pragma unroll
        for (int i = 0; i < 16; ++i) { const int l = i ^ j; if (l > i) CE_DESC(a[i], a[l]); }
    }
}
NET_HD void top16_of_64(float (&g0)[16], float (&g1)[16], float (&g2)[16], float (&g3)[16]) {
    sort16_desc(g0); sort16_desc(g1); sort16_desc(g2); sort16_desc(g3);
    merge16_desc(g0, g1); merge16_desc(g2, g3); merge16_desc(g0, g2);
}
NET_HD float u2f(unsigned u) { return NET_U2F(u); }
NET_HD unsigned f2u(float f) { return NET_F2U(f); }
template <class V16>
NET_HD void lane_top16(const V16& s0, const V16& s1, const V16& s2, const V16& s3, int hi, float (&out)[16]) {
    float g0[16], g1[16], g2[16], g3[16];
#pragma unroll
    for (int r = 0; r < 16; ++r) {
        const unsigned nb = (unsigned)((r & 3) + 8 * (r >> 2));
        g0[r] = u2f((f2u(s0[r]) & 0xFFFFFF80u) | nb); g1[r] = u2f((f2u(s1[r]) & 0xFFFFFF80u) | (nb + 32u));
        g2[r] = u2f((f2u(s2[r]) & 0xFFFFFF80u) | (nb + 64u)); g3[r] = u2f((f2u(s3[r]) & 0xFFFFFF80u) | (nb + 96u));
    }
    top16_of_64(g0, g1, g2, g3);
    const unsigned h4 = (unsigned)hi << 2;
#pragma unroll
    for (int i = 0; i < 16; ++i) out[i] = u2f(f2u(g0[i]) | h4);
}
constexpr int cand_slot(int a, int b) { int n = 0; for (int x = 0; x < 16; ++x) for (int y = 0; y < 16; ++y) { if (x == a && y == b) return n; if ((x + 1) * (y + 1) <= 16) ++n; } return n; }
NET_HD void cand_top16(const float (&s1)[16], const float (&s2)[16], float (&c)[16]) {
    float g0[16], g1[16], g2[16], g3[16];
#pragma unroll
    for (int i = 0; i < 16; ++i) { g0[i] = -3.0e38f; g1[i] = -3.0e38f; g2[i] = -3.0e38f; g3[i] = -3.0e38f; }
#pragma unroll
    for (int a = 0; a < 16; ++a) {
#pragma unroll
        for (int b = 0; b < 16; ++b) {
            if ((a + 1) * (b + 1) <= 16) {
                const int sl = cand_slot(a, b);
                const float v = u2f((f2u(s1[a] + s2[b]) & 0xFFFFFF00u) | (unsigned)(a * 16 + b));
                if (sl < 16) g0[sl & 15] = v; else if (sl < 32) g1[sl & 15] = v; else if (sl < 48) g2[sl & 15] = v; else g3[sl & 15] = v;
            }
        }
    }
    top16_of_64(g0, g1, g2, g3);
#pragma unroll
    for (int i = 0; i < 16; ++i) c[i] = g0[i];
}

__device__ __forceinline__ void phase_route(const Params& P, int l, char* lds) {
    const bf16* XN = (const bf16*)(P.ws + WS_XN);
    const bf16* Wc = (const bf16*)(P.ws + WS_WPQ) + (size_t)l * 2048 * D;
    int* EXPp = (int*)(P.ws + WS_EXP);
    float* GATEp = (float*)(P.ws + WS_GATE);
    const int tid = tidx(), lane = tid & 63, w = tid >> 6, r32 = lane & 31, hi = lane >> 5;
    for (int u = blockIdx.x; u < (T / 128) * PH; u += gridDim.x) {
        const int tm = u >> 3, h = u & 7;
        float L0[16], L1[16];
        {
            f32x16 acc[4]; float ssd[4];
            gemm_kloop<1, false>(Wc + (size_t)((h * 2 + 0) * 128) * D, D, XN + (size_t)(tm * 128) * D, D, D / 64, acc, ssd, lds, tid);
            lane_top16(acc[0], acc[1], acc[2], acc[3], hi, L0);
            float o[16];
#pragma unroll
            for (int i = 0; i < 16; ++i) o[i] = __shfl_xor(L0[i], 32, 64);
            merge16_desc(L0, o);
        }
        {
            f32x16 acc[4]; float ssd[4];
            gemm_kloop<1, false>(Wc + (size_t)((h * 2 + 1) * 128) * D, D, XN + (size_t)(tm * 128) * D, D, D / 64, acc, ssd, lds, tid);
            lane_top16(acc[0], acc[1], acc[2], acc[3], hi, L1);
            float o[16];
#pragma unroll
            for (int i = 0; i < 16; ++i) o[i] = __shfl_xor(L1[i], 32, 64);
            merge16_desc(L1, o);
        }
        float c[16];
        cand_top16(L0, L1, c);
        __syncthreads();
        unsigned char* my = (unsigned char*)lds + tid * 32;
        {
            uint4 a, b;
#define PK4(L, i) ((__float_as_uint(L[i]) & 127u) | ((__float_as_uint(L[i + 1]) & 127u) << 8) | ((__float_as_uint(L[i + 2]) & 127u) << 16) | ((__float_as_uint(L[i + 3]) & 127u) << 24))
            a.x = PK4(L0, 0); a.y = PK4(L0, 4); a.z = PK4(L0, 8); a.w = PK4(L0, 12);
            b.x = PK4(L1, 0); b.y = PK4(L1, 4); b.z = PK4(L1, 8); b.w = PK4(L1, 12);
#undef PK4
            *(uint4*)my = a; *(uint4*)(my + 16) = b;
        }
        int ev[16]; float gv[16]; float den = 0.f;
#pragma unroll
        for (int k = 0; k < 16; ++k) {
            const unsigned ci = __float_as_uint(c[k]) & 255u;
            const int n1 = my[ci >> 4], n2 = my[16 + (ci & 15)];
            ev[k] = n1 * NKEY + n2;
            gv[k] = __expf(c[k] - c[0]); den += gv[k];
        }
        const float iden = 1.f / den;
        if (hi == 0) {
            const int t = tm * 128 + w * 32 + r32;
            uint4* ep = (uint4*)(EXPp + (size_t)t * HK + h * 16);
            float4* gp = (float4*)(GATEp + (size_t)t * HK + h * 16);
#pragma unroll
            for (int q = 0; q < 4; ++q) {
                ep[q] = make_uint4((unsigned)ev[4 * q], (unsigned)ev[4 * q + 1], (unsigned)ev[4 * q + 2], (unsigned)ev[4 * q + 3]);
                gp[q] = make_float4(gv[4 * q] * iden, gv[4 * q + 1] * iden, gv[4 * q + 2] * iden, gv[4 * q + 3] * iden);
            }
        }
        __syncthreads();
    }
}

__device__ __forceinline__ float red16(float (&p)[16], int lane) {
#pragma unroll
    for (int i = 0; i < 8; ++i) { const bool up = lane & 32; const float send = up ? p[i] : p[i + 8], keep = up ? p[i + 8] : p[i]; p[i] = keep + __shfl_xor(send, 32, 64); }
#pragma unroll
    for (int i = 0; i < 4; ++i) { const bool up = lane & 16; const float send = up ? p[i] : p[i + 4], keep = up ? p[i + 4] : p[i]; p[i] = keep + __shfl_xor(send, 16, 64); }
#pragma unroll
    for (int i = 0; i < 2; ++i) { const bool up = lane & 8; const float send = up ? p[i] : p[i + 2], keep = up ? p[i + 2] : p[i]; p[i] = keep + __shfl_xor(send, 8, 64); }
    { const bool up = lane & 4; const float send = up ? p[0] : p[1], keep = up ? p[1] : p[0]; p[0] = keep + __shfl_xor(send, 4, 64); }
    float r = p[0];
    r += __shfl_xor(r, 2, 64); r += __shfl_xor(r, 1, 64);
    return r;
}

__device__ __forceinline__ void phase_gather(const Params& P, int l) {
    const bf16* XN = (const bf16*)(P.ws + WS_XN);
    bf16* XNw = (bf16*)(P.ws + WS_XN);
    const int* EXPp = (const int*)(P.ws + WS_EXP);
    const float* GATEp = (const float*)(P.ws + WS_GATE);
    const unsigned char* U = P.ws + WS_TABU + (size_t)l * NEXP * TAB_ROWB;
    const unsigned char* V = P.ws + WS_TABV + (size_t)l * NEXP * TAB_ROWB;
    const float* SU = (const float*)(P.ws + WS_TSCU) + (size_t)l * NEXP;
    const float* SV = (const float*)(P.ws + WS_TSCV) + (size_t)l * NEXP;
    const int lane = tidx() & 63;
    for (int t = gwave(); t < T; t += nwave()) {
        const int e_lo = EXPp[(size_t)t * HK + lane], e_hi = EXPp[(size_t)t * HK + 64 + lane];
#if TAB_FP8
        float xf[16];
        {
            const uint4 a = ((const uint4*)(XN + (size_t)t * D))[lane * 2], b = ((const uint4*)(XN + (size_t)t * D))[lane * 2 + 1];
            xf[0] = bflo(a.x); xf[1] = bfhi(a.x); xf[2] = bflo(a.y); xf[3] = bfhi(a.y); xf[4] = bflo(a.z); xf[5] = bfhi(a.z); xf[6] = bflo(a.w); xf[7] = bfhi(a.w);
            xf[8] = bflo(b.x); xf[9] = bfhi(b.x); xf[10] = bflo(b.y); xf[11] = bfhi(b.y); xf[12] = bflo(b.z); xf[13] = bfhi(b.z); xf[14] = bflo(b.w); xf[15] = bfhi(b.w);
        }
#else
        const uint4 xa = ((const uint4*)(XN + (size_t)t * D))[lane], xb = ((const uint4*)(XN + (size_t)t * D))[64 + lane];
#endif
        float acc[16];
#pragma unroll
        for (int i = 0; i < 16; ++i) acc[i] = 0.f;
        for (int c = 0; c < 8; ++c) {
            const int esel = (c < 4) ? e_lo : e_hi;
            const int kb = (c & 3) * 16;
            float part[16];
#pragma unroll
            for (int hb = 0; hb < 2; ++hb) {
#if TAB_FP8
                uint4 r[8];
#pragma unroll
                for (int i = 0; i < 8; ++i) { const int e = __builtin_amdgcn_readlane(esel, kb + hb * 8 + i); r[i] = *(const uint4*)(U + (size_t)e * 1024 + lane * 16); }
#pragma unroll
                for (int i = 0; i < 8; ++i) {
                    float d0 = 0.f, d1 = 0.f;
                    const unsigned w[4] = {r[i].x, r[i].y, r[i].z, r[i].w};
#pragma unroll
                    for (int q = 0; q < 4; ++q) {
                        const auto lo = __builtin_amdgcn_cvt_pk_f32_fp8((int)w[q], false); const auto hh = __builtin_amdgcn_cvt_pk_f32_fp8((int)w[q], true);
                        d0 = fmaf(xf[4 * q], lo[0], d0); d1 = fmaf(xf[4 * q + 1], lo[1], d1); d0 = fmaf(xf[4 * q + 2], hh[0], d0); d1 = fmaf(xf[4 * q + 3], hh[1], d1);
                    }
                    part[hb * 8 + i] = d0 + d1;
                }
#else
                uint4 r0[8], r1[8];
#pragma unroll
                for (int i = 0; i < 8; ++i) { const int e = __builtin_amdgcn_readlane(esel, kb + hb * 8 + i); const unsigned char* rp = U + (size_t)e * 2048 + lane * 16; r0[i] = *(const uint4*)(rp); r1[i] = *(const uint4*)(rp + 1024); }
#pragma unroll
                for (int i = 0; i < 8; ++i) {
                    float d0 = 0.f, d1 = 0.f;
                    d0 = dot2bf(xa.x, r0[i].x, d0); d1 = dot2bf(xa.y, r0[i].y, d1); d0 = dot2bf(xa.z, r0[i].z, d0); d1 = dot2bf(xa.w, r0[i].w, d1);
                    d0 = dot2bf(xb.x, r1[i].x, d0); d1 = dot2bf(xb.y, r1[i].y, d1); d0 = dot2bf(xb.z, r1[i].z, d0); d1 = dot2bf(xb.w, r1[i].w, d1);
                    part[hb * 8 + i] = d0 + d1;
                }
#endif
            }
            float dsum = red16(part, lane);
            const int kk = c * 16 + (lane >> 2);
            const int eme = __shfl(esel, kb + (lane >> 2), 64);
            float wv = GATEp[(size_t)t * HK + kk];
#if TAB_FP8
            dsum *= SU[eme];
            wv *= SV[eme];
#endif
            wv *= gelu_exact(dsum);
#pragma unroll
            for (int hb = 0; hb < 2; ++hb) {
#if TAB_FP8
                uint4 r[8];
#pragma unroll
                for (int i = 0; i < 8; ++i) { const int e = __builtin_amdgcn_readlane(esel, kb + hb * 8 + i); r[i] = *(const uint4*)(V + (size_t)e * 1024 + lane * 16); }
#pragma unroll
                for (int i = 0; i < 8; ++i) {
                    const float w = __int_as_float(__builtin_amdgcn_readlane(__float_as_int(wv), (hb * 8 + i) * 4));
                    const unsigned ww[4] = {r[i].x, r[i].y, r[i].z, r[i].w};
#pragma unroll
                    for (int q = 0; q < 4; ++q) {
                        const auto lo = __builtin_amdgcn_cvt_pk_f32_fp8((int)ww[q], false); const auto hh = __builtin_amdgcn_cvt_pk_f32_fp8((int)ww[q], true);
                        acc[4 * q] = fmaf(w, lo[0], acc[4 * q]); acc[4 * q + 1] = fmaf(w, lo[1], acc[4 * q + 1]); acc[4 * q + 2] = fmaf(w, hh[0], acc[4 * q + 2]); acc[4 * q + 3] = fmaf(w, hh[1], acc[4 * q + 3]);
                    }
                }
#else
                uint4 r0[8], r1[8];
#pragma unroll
                for (int i = 0; i < 8; ++i) { const int e = __builtin_amdgcn_readlane(esel, kb + hb * 8 + i); const unsigned char* rp = V + (size_t)e * 2048 + lane * 16; r0[i] = *(const uint4*)(rp); r1[i] = *(const uint4*)(rp + 1024); }
#pragma unroll
                for (int i = 0; i < 8; ++i) {
                    const float w = __int_as_float(__builtin_amdgcn_readlane(__float_as_int(wv), (hb * 8 + i) * 4));
                    acc[0] = fmaf(w, bflo(r0[i].x), acc[0]); acc[1] = fmaf(w, bfhi(r0[i].x), acc[1]); acc[2] = fmaf(w, bflo(r0[i].y), acc[2]); acc[3] = fmaf(w, bfhi(r0[i].y), acc[3]);
                    acc[4] = fmaf(w, bflo(r0[i].z), acc[4]); acc[5] = fmaf(w, bfhi(r0[i].z), acc[5]); acc[6] = fmaf(w, bflo(r0[i].w), acc[6]); acc[7] = fmaf(w, bfhi(r0[i].w), acc[7]);
                    acc[8] = fmaf(w, bflo(r1[i].x), acc[8]); acc[9] = fmaf(w, bfhi(r1[i].x), acc[9]); acc[10] = fmaf(w, bflo(r1[i].y), acc[10]); acc[11] = fmaf(w, bfhi(r1[i].y), acc[11]);
                    acc[12] = fmaf(w, bflo(r1[i].z), acc[12]); acc[13] = fmaf(w, bfhi(r1[i].z), acc[13]); acc[14] = fmaf(w, bflo(r1[i].w), acc[14]); acc[15] = fmaf(w, bfhi(r1[i].w), acc[15]);
                }
#endif
            }
        }
        float* hrow = P.out + (size_t)t * D;
#if TAB_FP8
        const int c0 = lane * 16, c1 = lane * 16 + 8;
#else
        const int c0 = lane * 8, c1 = 512 + lane * 8;
#endif
        float4 h0 = *(const float4*)(hrow + c0), h1 = *(const float4*)(hrow + c0 + 4), h2 = *(const float4*)(hrow + c1), h3 = *(const float4*)(hrow + c1 + 4);
        h0.x += acc[0]; h0.y += acc[1]; h0.z += acc[2]; h0.w += acc[3]; h1.x += acc[4]; h1.y += acc[5]; h1.z += acc[6]; h1.w += acc[7];
        h2.x += acc[8]; h2.y += acc[9]; h2.z += acc[10]; h2.w += acc[11]; h3.x += acc[12]; h3.y += acc[13]; h3.z += acc[14]; h3.w += acc[15];
        float ss = h0.x * h0.x + h0.y * h0.y + h0.z * h0.z + h0.w * h0.w + h1.x * h1.x + h1.y * h1.y + h1.z * h1.z + h1.w * h1.w
                 + h2.x * h2.x + h2.y * h2.y + h2.z * h2.z + h2.w * h2.w + h3.x * h3.x + h3.y * h3.y + h3.z * h3.z + h3.w * h3.w;
        ss = wave_sum(ss);
        const float rn = rsqrtf(ss * (1.f / D) + EPS);
        if (l == DEPTH - 1) {
            const float* g = P.norm_final;
            const float4 g0 = *(const float4*)(g + c0), g1 = *(const float4*)(g + c0 + 4), g2 = *(const float4*)(g + c1), g3 = *(const float4*)(g + c1 + 4);
            *(float4*)(hrow + c0) = make_float4(h0.x * rn * g0.x, h0.y * rn * g0.y, h0.z * rn * g0.z, h0.w * rn * g0.w);
            *(float4*)(hrow + c0 + 4) = make_float4(h1.x * rn * g1.x, h1.y * rn * g1.y, h1.z * rn * g1.z, h1.w * rn * g1.w);
            *(float4*)(hrow + c1) = make_float4(h2.x * rn * g2.x, h2.y * rn * g2.y, h2.z * rn * g2.z, h2.w * rn * g2.w);
            *(float4*)(hrow + c1 + 4) = make_float4(h3.x * rn * g3.x, h3.y * rn * g3.y, h3.z * rn * g3.z, h3.w * rn * g3.w);
        } else {
            *(float4*)(hrow + c0) = h0; *(float4*)(hrow + c0 + 4) = h1; *(float4*)(hrow + c1) = h2; *(float4*)(hrow + c1 + 4) = h3;
            const float* g = P.norm_mix + (l + 1) * D;
            const float4 g0 = *(const float4*)(g + c0), g1 = *(const float4*)(g + c0 + 4), g2 = *(const float4*)(g + c1), g3 = *(const float4*)(g + c1 + 4);
            uint4 o0, o1;
            o0.x = pack2(h0.x * rn * g0.x, h0.y * rn * g0.y); o0.y = pack2(h0.z * rn * g0.z, h0.w * rn * g0.w); o0.z = pack2(h1.x * rn * g1.x, h1.y * rn * g1.y); o0.w = pack2(h1.z * rn * g1.z, h1.w * rn * g1.w);
            o1.x = pack2(h2.x * rn * g2.x, h2.y * rn * g2.y); o1.y = pack2(h2.z * rn * g2.z, h2.w * rn * g2.w); o1.z = pack2(h3.x * rn * g3.x, h3.y * rn * g3.y); o1.w = pack2(h3.z * rn * g3.z, h3.w * rn * g3.w);
            *(uint4*)(XNw + (size_t)t * D + c0) = o0; *(uint4*)(XNw + (size_t)t * D + c1) = o1;
        }
    }
}


constexpr size_t WS_PART = WS_PROJ;
static_assert((size_t)8 * T * HK * 4 <= WS_K - WS_PROJ, "PART alias");
constexpr int XI_X = 0, XI_RANK = 1, XI_J = 2, XI_NX = 3, XI_NLOC = 4;
constexpr int CTL_CENSUS = 4096;
constexpr int CTL_BYTES = (CTL_CENSUS + 16) * 4;

__device__ __forceinline__ float dot16_fp8(const float (&xf)[16], const uint4& r) {
    float d0 = 0.f, d1 = 0.f;
    const unsigned w[4] = {r.x, r.y, r.z, r.w};
#pragma unroll
    for (int q = 0; q < 4; ++q) {
        const auto lo = __builtin_amdgcn_cvt_pk_f32_fp8((int)w[q], false); const auto hh = __builtin_amdgcn_cvt_pk_f32_fp8((int)w[q], true);
        d0 = fmaf(xf[4 * q], lo[0], d0); d1 = fmaf(xf[4 * q + 1], lo[1], d1); d0 = fmaf(xf[4 * q + 2], hh[0], d0); d1 = fmaf(xf[4 * q + 3], hh[1], d1);
    }
    return d0 + d1;
}
template <int M1, int M2, int M3>
__device__ __forceinline__ void red16x3(float (&p)[16], int lane) {
#pragma unroll
    for (int i = 0; i < 8; ++i) { const bool up = lane & M1; const float send = up ? p[i] : p[i + 8], keep = up ? p[i + 8] : p[i]; p[i] = keep + __shfl_xor(send, M1, 64); }
#pragma unroll
    for (int i = 0; i < 4; ++i) { const bool up = lane & M2; const float send = up ? p[i] : p[i + 4], keep = up ? p[i + 4] : p[i]; p[i] = keep + __shfl_xor(send, M2, 64); }
#pragma unroll
    for (int i = 0; i < 2; ++i) { const bool up = lane & M3; const float send = up ? p[i] : p[i + 2], keep = up ? p[i + 2] : p[i]; p[i] = keep + __shfl_xor(send, M3, 64); }
}
__device__ __forceinline__ void phase_gu(const Params& P, int l, const volatile int* xi) {
    const bf16* XN = (const bf16*)(P.ws + WS_XN);
    const int* EXPp = (const int*)(P.ws + WS_EXP);
    float* PART = (float*)(P.ws + WS_PART);
    const int tid = tidx(), lane = tid & 63, w = tid >> 6, g = lane >> 3, c = lane & 7;
    const int j = xi[XI_J], nx = xi[XI_NX], nloc = xi[XI_NLOC], rank = xi[XI_RANK];
    for (int sl = j; sl < 8; sl += nx) {
        const unsigned char* Us = P.ws + WS_TABU + ((size_t)(l * 8 + sl) * NEXP) * 128 + c * 16;
        float* part = PART + (size_t)sl * T * HK;
        for (int t = rank * 4 + w; t < T; t += nloc * 4) {
            const int e_lo = EXPp[(size_t)t * HK + lane], e_hi = EXPp[(size_t)t * HK + 64 + lane];
            float xf[16];
            {
                const uint4 a = *(const uint4*)(XN + (size_t)t * D + sl * 128 + c * 16), b = *(const uint4*)(XN + (size_t)t * D + sl * 128 + c * 16 + 8);
                xf[0] = bflo(a.x); xf[1] = bfhi(a.x); xf[2] = bflo(a.y); xf[3] = bfhi(a.y); xf[4] = bflo(a.z); xf[5] = bfhi(a.z); xf[6] = bflo(a.w); xf[7] = bfhi(a.w);
                xf[8] = bflo(b.x); xf[9] = bfhi(b.x); xf[10] = bflo(b.y); xf[11] = bfhi(b.y); xf[12] = bflo(b.z); xf[13] = bfhi(b.z); xf[14] = bflo(b.w); xf[15] = bfhi(b.w);
            }
            uint4 r[16];
#pragma unroll
            for (int i = 0; i < 16; ++i) {
                const int e = __builtin_amdgcn_ds_bpermute((((8 * i) & 63) + g) << 2, (i < 8) ? e_lo : e_hi);
                r[i] = *(const uint4*)(Us + (size_t)e * 128);
            }
            float p[16];
#pragma unroll
            for (int i = 0; i < 16; ++i) p[i] = dot16_fp8(xf, r[i]);
            red16x3<1, 2, 4>(p, lane);
            const int i0 = 8 * (c & 1) + 4 * ((c >> 1) & 1) + 2 * ((c >> 2) & 1);
            part[(size_t)t * HK + 8 * i0 + g] = p[0];
            part[(size_t)t * HK + 8 * (i0 + 1) + g] = p[1];
        }
    }
}
__device__ __forceinline__ void phase_gw(const Params& P, int l) {
    const int* EXPp = (const int*)(P.ws + WS_EXP);
    float* GATEp = (float*)(P.ws + WS_GATE);
    const float* PART = (const float*)(P.ws + WS_PART);
    const float* SU = (const float*)(P.ws + WS_TSCU) + (size_t)l * NEXP;
    const float* SV = (const float*)(P.ws + WS_TSCV) + (size_t)l * NEXP;
    for (size_t i = gtid(); i < (size_t)T * HK; i += gnth()) {
        float s = 0.f;
#pragma unroll
        for (int x = 0; x < 8; ++x) s += PART[(size_t)x * T * HK + i];
        const int e = EXPp[i];
        GATEp[i] = GATEp[i] * gelu_exact(s * SU[e]) * SV[e];
    }
}
__device__ __forceinline__ void phase_gv(const Params& P, int l, const volatile int* xi) {
    const int* EXPp = (const int*)(P.ws + WS_EXP);
    const float* WGT = (const float*)(P.ws + WS_GATE);
    const int tid = tidx(), lane = tid & 63, w = tid >> 6, g = lane >> 3, c = lane & 7;
    const int j = xi[XI_J], nx = xi[XI_NX], nloc = xi[XI_NLOC], rank = xi[XI_RANK];
    for (int sl = j; sl < 8; sl += nx) {
        const unsigned char* Vs = P.ws + WS_TABV + ((size_t)(l * 8 + sl) * NEXP) * 128 + c * 16;
        for (int t = rank * 4 + w; t < T; t += nloc * 4) {
            const int e_lo = EXPp[(size_t)t * HK + lane], e_hi = EXPp[(size_t)t * HK + 64 + lane];
            const int w_lo = __float_as_int(WGT[(size_t)t * HK + lane]), w_hi = __float_as_int(WGT[(size_t)t * HK + 64 + lane]);
            float acc[16];
#pragma unroll
            for (int q = 0; q < 16; ++q) acc[q] = 0.f;
#pragma unroll 1
            for (int hb = 0; hb < 2; ++hb) {
                const int esel = hb ? e_hi : e_lo, wsel = hb ? w_hi : w_lo;
                uint4 r[8]; float wk[8];
#pragma unroll
                for (int i = 0; i < 8; ++i) {
                    const int src = (8 * i + g) << 2;
                    const int e = __builtin_amdgcn_ds_bpermute(src, esel);
                    wk[i] = __int_as_float(__builtin_amdgcn_ds_bpermute(src, wsel));
                    r[i] = *(const uint4*)(Vs + (size_t)e * 128);
                }
#pragma unroll
                for (int i = 0; i < 8; ++i) {
                    const unsigned ww[4] = {r[i].x, r[i].y, r[i].z, r[i].w};
#pragma unroll
                    for (int q = 0; q < 4; ++q) {
                        const auto lo = __builtin_amdgcn_cvt_pk_f32_fp8((int)ww[q], false); const auto hh = __builtin_amdgcn_cvt_pk_f32_fp8((int)ww[q], true);
                        acc[4 * q] = fmaf(wk[i], lo[0], acc[4 * q]); acc[4 * q + 1] = fmaf(wk[i], lo[1], acc[4 * q + 1]); acc[4 * q + 2] = fmaf(wk[i], hh[0], acc[4 * q + 2]); acc[4 * q + 3] = fmaf(wk[i], hh[1], acc[4 * q + 3]);
                    }
                }
            }
            red16x3<8, 16, 32>(acc, lane);
            const int j0 = 8 * (g & 1) + 4 * ((g >> 1) & 1) + 2 * ((g >> 2) & 1);
            float2* hp = (float2*)(P.out + (size_t)t * D + sl * 128 + c * 16 + j0);
            float2 hv = *hp; hv.x += acc[0]; hv.y += acc[1]; *hp = hv;
        }
    }
}
__device__ __forceinline__ void phase_gnorm(const Params& P, int l) {
    const int lane = tidx() & 63;
    bf16* XNw = (bf16*)(P.ws + WS_XN);
    for (int t = gwave(); t < T; t += nwave()) {
        float4* hr = (float4*)(P.out + (size_t)t * D);
        float4 v[4]; float ss = 0.f;
#pragma unroll
        for (int q = 0; q < 4; ++q) { v[q] = hr[q * 64 + lane]; ss += v[q].x * v[q].x + v[q].y * v[q].y + v[q].z * v[q].z + v[q].w * v[q].w; }
        ss = wave_sum(ss);
        const float rn = rsqrtf(ss * (1.f / D) + EPS);
        const float4* g = (const float4*)((l == DEPTH - 1) ? P.norm_final : (P.norm_mix + (l + 1) * D));
#pragma unroll
        for (int q = 0; q < 4; ++q) {
            const float4 gg = g[q * 64 + lane];
            const float4 o = make_float4(v[q].x * rn * gg.x, v[q].y * rn * gg.y, v[q].z * rn * gg.z, v[q].w * rn * gg.w);
            if (l == DEPTH - 1) hr[q * 64 + lane] = o;
            else { uint2 u; u.x = pack2(o.x, o.y); u.y = pack2(o.z, o.w); ((uint2*)(XNw + (size_t)t * D))[q * 64 + lane] = u; }
        }
    }
}

#define XB_TMO      128
#define XB_XCNT(j)  (256  + 64 * (j))
#define XB_XSUB(j)  (1280 + 64 * (j))
#define XB_XGEN(j)  (2304 + 64 * (j))
#define XB_TOP      3328
#define XB_TOPGEN   3392
#define XCD_BAR_WORDS 3456
#define XB_SPIN_CAP (1u << 22)
#define LAS __attribute__((address_space(3)))
__device__ __forceinline__ unsigned xb_ld(unsigned* p)              { return __hip_atomic_load(p, __ATOMIC_RELAXED, __HIP_MEMORY_SCOPE_AGENT); }
__device__ __forceinline__ unsigned xb_add(unsigned* p, unsigned v) { return __hip_atomic_fetch_add(p, v, __ATOMIC_RELAXED, __HIP_MEMORY_SCOPE_AGENT); }
__device__ __forceinline__ unsigned xb_xcc_id() { return (unsigned)__builtin_amdgcn_s_getreg((3 << 11) | 20) & 0xFu; }
#define XB_SPIN(cond, bar) do { unsigned _sp = 0; while (cond) { __builtin_amdgcn_s_sleep(1); \
    if ((++_sp & 255u) == 0u) { if (xb_ld(&(bar)[XB_TMO])) break; if (_sp > XB_SPIN_CAP) { atomicAdd(&(bar)[XB_TMO], 1u); break; } } } } while (0)
struct XcdBarrier { unsigned* bar; unsigned x; volatile LAS unsigned* st; };
__device__ __forceinline__ XcdBarrier xcd_barrier_post(unsigned* bar, volatile LAS unsigned* st) {
    XcdBarrier b; b.bar = bar; b.x = xb_xcc_id(); b.st = st;
    if (__builtin_amdgcn_workitem_id_x() == 0) (void)xb_add(&bar[XB_XCNT(b.x)], 1u);
    return b;
}
__device__ __forceinline__ void xcd_barrier_complete(unsigned* bar, unsigned x, unsigned& nloc, unsigned& nx) {
    const unsigned G = gridDim.x * gridDim.y * gridDim.z;
    unsigned sum, cnt, mine, sp = 0u;
    for (;;) {
        sum = 0u; cnt = 0u; mine = 0u;
#pragma unroll
        for (unsigned j = 0; j < 16; ++j) { const unsigned c = xb_ld(&bar[XB_XCNT(j)]); sum += c; cnt += (c > 0u) ? 1u : 0u; mine = (j == x) ? c : mine; }
        if (sum == G) break;
        __builtin_amdgcn_s_sleep(1);
        if ((++sp & 255u) == 0u) { if (xb_ld(&bar[XB_TMO])) break; if (sp > XB_SPIN_CAP) { atomicAdd(&bar[XB_TMO], 1u); break; } }
    }
    nloc = mine > 0u ? mine : 1u; nx = cnt > 0u ? cnt : 1u;
}
__device__ __forceinline__ void xcd_barrier(const XcdBarrier& b) {
    asm volatile("s_waitcnt vmcnt(0)" ::: "memory");
    __syncthreads();
    if (__builtin_amdgcn_workitem_id_x() == 0) {
        unsigned* bar = b.bar;
        __builtin_amdgcn_s_waitcnt(0);
        unsigned nloc = b.st[0], nx = b.st[1];
        if (nloc == 0u) { xcd_barrier_complete(bar, b.x, nloc, nx); b.st[0] = nloc; b.st[1] = nx; }
        const unsigned old = xb_add(&bar[XB_XSUB(b.x)], 1u);
        const unsigned gen = old / nloc;
        if (old + 1u == (gen + 1u) * nloc) {
            __builtin_amdgcn_fence(__ATOMIC_RELEASE, "agent");
            asm volatile("s_waitcnt vmcnt(0)" ::: "memory");
            const unsigned og = xb_add(&bar[XB_TOP], 1u);
            const unsigned tg = og / nx;
            if (og + 1u == (tg + 1u) * nx) xb_add(&bar[XB_TOPGEN], 1u);
            else XB_SPIN(xb_ld(&bar[XB_TOPGEN]) == tg, bar);
            __builtin_amdgcn_fence(__ATOMIC_ACQUIRE, "agent");
            xb_add(&bar[XB_XGEN(b.x)], 1u);
            asm volatile("s_waitcnt vmcnt(0)" ::: "memory");
        } else {
            XB_SPIN(xb_ld(&bar[XB_XGEN(b.x)]) == gen, bar);
            __builtin_amdgcn_fence(__ATOMIC_ACQUIRE, "agent");
            asm volatile("s_waitcnt vmcnt(0)" ::: "memory");
        }
    }
    __syncthreads();
}

constexpr float QSCALE = 0.10206207261596575f * 1.4426950408889634f;

__device__ __forceinline__ void phase_gemm1(const Params& P, int l, char* lds) {
    unsigned char* ws = P.ws;
    const bf16* XN = (const bf16*)(ws + WS_XN);
    bf16* PROJ = (bf16*)(ws + WS_PROJ);
    bf16* Kb = (bf16*)(ws + WS_K);
    const float* rope = (const float*)(ws + WS_ROPE);
    const bf16* W = (const bf16*)(ws + WS_WIN) + (size_t)l * DINP * D;
    gemm_t<false>(W, D, DINP, XN, D, T, D, [&](int n0, int t0, const f32x16& acc, int r32, int hi, float) {
        const int t = t0 + r32;
        if (n0 < C_KR) {
            bf16* pr = PROJ + (size_t)t * DINP + n0 + 4 * hi;
#pragma unroll
            for (int g = 0; g < 4; ++g) { uint2 o; o.x = cvtpk(acc[4 * g], acc[4 * g + 1]); o.y = cvtpk(acc[4 * g + 2], acc[4 * g + 3]); *(uint2*)(pr + 8 * g) = o; }
        } else if (n0 == C_KR) {
            const int b = t / S, s = t % S;
            uint2 o1[2], o2[2];
#pragma unroll
            for (int g = 0; g < 2; ++g) {
                const float4 cs0 = *(const float4*)(rope + ((size_t)s * 16 + 8 * g + 4 * hi) * 2), cs1 = *(const float4*)(rope + ((size_t)s * 16 + 8 * g + 4 * hi) * 2 + 4);
                const float x10 = acc[4 * g], x11 = acc[4 * g + 1], x12 = acc[4 * g + 2], x13 = acc[4 * g + 3];
                const float x20 = acc[8 + 4 * g], x21 = acc[8 + 4 * g + 1], x22 = acc[8 + 4 * g + 2], x23 = acc[8 + 4 * g + 3];
                o1[g].x = cvtpk(x10 * cs0.x - x20 * cs0.y, x11 * cs0.z - x21 * cs0.w); o1[g].y = cvtpk(x12 * cs1.x - x22 * cs1.y, x13 * cs1.z - x23 * cs1.w);
                o2[g].x = cvtpk(x20 * cs0.x + x10 * cs0.y, x21 * cs0.z + x11 * cs0.w); o2[g].y = cvtpk(x22 * cs1.x + x12 * cs1.y, x23 * cs1.z + x13 * cs1.w);
            }
#pragma unroll
            for (int h = 0; h < NH; ++h) {
                bf16* kr = Kb + ((size_t)(b * NH + h) * S + s) * DQK + 64 + 4 * hi;
                *(uint2*)(kr) = o1[0]; *(uint2*)(kr + 8) = o1[1]; *(uint2*)(kr + 16) = o2[0]; *(uint2*)(kr + 24) = o2[1];
            }
        }
    }, lds);
}
__device__ __forceinline__ void phase_gemm2(const Params& P, int l, char* lds) {
    unsigned char* ws = P.ws;
    const bf16* PROJ = (const bf16*)(ws + WS_PROJ);
    const float* rope = (const float*)(ws + WS_ROPE);
    {
        const bf16* W = (const bf16*)(ws + WS_WUQ) + (size_t)l * 768 * QR;
        bf16* Qb = (bf16*)(ws + WS_Q);
        gemm_t<true>(W, QR, 768, PROJ + C_CQ, DINP, T, QR, [&](int n0, int t0, const f32x16& acc, int r32, int hi, float ssq) {
            const int t = t0 + r32, b = t / S, s = t % S;
            const int h = n0 / DQK, d0 = n0 % DQK;
            const float sc = rsqrtf(ssq * (1.f / QR) + EPS) * QSCALE;
            bf16* qb = Qb + ((size_t)(b * NH + h) * S + s) * DQK + d0 + 4 * hi;
            if (d0 == 64) {
#pragma unroll
                for (int g = 0; g < 2; ++g) {
                    const float4 cs0 = *(const float4*)(rope + ((size_t)s * 16 + 8 * g + 4 * hi) * 2), cs1 = *(const float4*)(rope + ((size_t)s * 16 + 8 * g + 4 * hi) * 2 + 4);
                    const float x10 = acc[4 * g] * sc, x11 = acc[4 * g + 1] * sc, x12 = acc[4 * g + 2] * sc, x13 = acc[4 * g + 3] * sc;
                    const float x20 = acc[8 + 4 * g] * sc, x21 = acc[8 + 4 * g + 1] * sc, x22 = acc[8 + 4 * g + 2] * sc, x23 = acc[8 + 4 * g + 3] * sc;
                    uint2 o1, o2;
                    o1.x = cvtpk(x10 * cs0.x - x20 * cs0.y, x11 * cs0.z - x21 * cs0.w); o1.y = cvtpk(x12 * cs1.x - x22 * cs1.y, x13 * cs1.z - x23 * cs1.w);
                    o2.x = cvtpk(x20 * cs0.x + x10 * cs0.y, x21 * cs0.z + x11 * cs0.w); o2.y = cvtpk(x22 * cs1.x + x12 * cs1.y, x23 * cs1.z + x13 * cs1.w);
                    *(uint2*)(qb + 8 * g) = o1; *(uint2*)(qb + 16 + 8 * g) = o2;
                }
            } else {
#pragma unroll
                for (int g = 0; g < 4; ++g) { uint2 o; o.x = cvtpk(acc[4 * g] * sc, acc[4 * g + 1] * sc); o.y = cvtpk(acc[4 * g + 2] * sc, acc[4 * g + 3] * sc); *(uint2*)(qb + 8 * g) = o; }
            }
        }, lds);
    }
    {
        const bf16* W = (const bf16*)(ws + WS_WUKV) + (size_t)l * 1024 * KVR;
        bf16* Kb = (bf16*)(ws + WS_K); bf16* Vb = (bf16*)(ws + WS_V);
        gemm_t<true>(W, KVR, 1024, PROJ + C_CKV, DINP, T, KVR, [&](int n0, int t0, const f32x16& acc, int r32, int hi, float ssq) {
            const int t = t0 + r32, b = t / S, s = t % S;
            const float sc = rsqrtf(ssq * (1.f / KVR) + EPS);
            bf16* dst;
            if (n0 < 512) dst = Kb + ((size_t)(b * NH + (n0 >> 6)) * S + s) * DQK + (n0 & 63) + 4 * hi;
            else          dst = Vb + ((size_t)(b * NH + ((n0 - 512) >> 6)) * S + s) * DV + (n0 & 63) + 4 * hi;
#pragma unroll
            for (int g = 0; g < 4; ++g) { uint2 o; o.x = cvtpk(acc[4 * g] * sc, acc[4 * g + 1] * sc); o.y = cvtpk(acc[4 * g + 2] * sc, acc[4 * g + 3] * sc); *(uint2*)(dst + 8 * g) = o; }
        }, lds);
    }
}
__device__ __forceinline__ void phase_gemm3(const Params& P, int l, char* lds) {
    unsigned char* ws = P.ws;
    const bf16* Yb = (const bf16*)(ws + WS_XN);
    const bf16* W = (const bf16*)(ws + WS_WOUT) + (size_t)l * D * D;
    const float* hin = (l == 0) ? P.x : P.out;
    float* out = P.out;
    gemm_t<false>(W, D, D, Yb, D, T, D, [&](int n0, int t0, const f32x16& acc, int r32, int hi, float) {
        const size_t base = (size_t)(t0 + r32) * D + n0 + 4 * hi;
#pragma unroll
        for (int g = 0; g < 4; ++g) {
            const float4 hv = *(const float4*)(hin + base + 8 * g);
            *(float4*)(out + base + 8 * g) = make_float4(hv.x + acc[4 * g], hv.y + acc[4 * g + 1], hv.z + acc[4 * g + 2], hv.w + acc[4 * g + 3]);
        }
    }, lds);
}

#define GSYNC() do { XcdBarrier xb_; xb_.bar = (unsigned*)(P.ws + WS_CTL); xb_.x = xb_xcc_id(); xb_.st = (volatile LAS unsigned*)&xb_words; xcd_barrier(xb_); } while (0)
#define PHASE(stmt) { const Params Q = launder(P); stmt; }
__global__ void __launch_bounds__(NTHREADS, 2) k_all(Params P) {
    __shared__ __attribute__((aligned(16))) char sm[LDS_TOTAL];
    __shared__ uint4 xb_words;
    cg::grid_group grid = cg::this_grid();
    if (__builtin_amdgcn_workitem_id_x() == 0) xb_words = make_uint4(0u, 0u, 0u, 0u);
    __syncthreads();
    (void)xcd_barrier_post((unsigned*)(P.ws + WS_CTL), (volatile LAS unsigned*)&xb_words);
    __shared__ int xinfo[8];
    if (__builtin_amdgcn_workitem_id_x() == 0) {
        const unsigned x = xb_xcc_id();
        xinfo[XI_X] = (int)x; xinfo[XI_RANK] = (int)xb_add((unsigned*)(P.ws + WS_CTL) + CTL_CENSUS + x, 1u);
    }
    PHASE(phase_prep(Q, sm));
    PHASE(phase_norm(Q.x, Q.norm_mix, (bf16*)(Q.ws + WS_XN)));
    grid.sync();
    if (__builtin_amdgcn_workitem_id_x() == 0) {
        unsigned* cen = (unsigned*)(P.ws + WS_CTL) + CTL_CENSUS;
        const int x = xinfo[XI_X]; int nx = 0, jj = 0;
        for (int q = 0; q < 16; ++q) { const unsigned cq = xb_ld(cen + q); if (cq) { if (q < x) ++jj; ++nx; } }
        xinfo[XI_J] = jj; xinfo[XI_NX] = nx; xinfo[XI_NLOC] = (int)xb_ld(cen + x);
    }
    __syncthreads();
    for (int l = 0; l < DEPTH; ++l) {
        PHASE(phase_gemm1(Q, l, sm));
#if PROBE_DUP & 2
        PHASE(phase_gemm1(Q, l, sm));
#endif
        GSYNC();
        PHASE(phase_mixlocal(Q, l, sm));
#if PROBE_DUP & 256
        PHASE(phase_mixlocal(Q, l, sm));
#endif
        PHASE(phase_gemm2(Q, l, sm));
        GSYNC();
        PHASE(phase_attn(Q, sm));
        GSYNC();
        PHASE(phase_gemm3(Q, l, sm));
#if PROBE_DUP & 16
        if (l == 0) PHASE(phase_gemm3(Q, l, sm));
#endif
        GSYNC();
        PHASE(phase_norm(Q.out, Q.norm_ffn + l * D, (bf16*)(Q.ws + WS_XN)));
        GSYNC();
        PHASE(phase_route(Q, l, sm));
        GSYNC();
        PHASE(phase_gu(Q, l, xinfo));
        GSYNC();
        PHASE(phase_gw(Q, l));
        GSYNC();
        PHASE(phase_gv(Q, l, xinfo));
        GSYNC();
        PHASE(phase_gnorm(Q, l));
        GSYNC();
    }
}

extern "C" void kernel_launch(void* const* d_in, const int* in_sizes, int n_in, void* d_out, int out_size, void* d_ws, size_t ws_size, hipStream_t stream) {
    static int grid = 0;
    if (grid == 0) {
        if (n_in != 18 || out_size != T * D || ws_size < WS_END) { fprintf(stderr, "kernel_launch: bad sizes n_in %d out %d ws %zu need %zu\n", n_in, out_size, ws_size, (size_t)WS_END); grid = -1; return; }
        int dev = 0, cus = 0, per_cu = 0;
        (void)hipGetDevice(&dev);
        (void)hipDeviceGetAttribute(&cus, hipDeviceAttributeMultiprocessorCount, dev);
        (void)hipOccupancyMaxActiveBlocksPerMultiprocessor(&per_cu, (const void*)k_all, NTHREADS, 0);
        if (per_cu > 2) per_cu = 2;
        if (per_cu < 1) { fprintf(stderr, "kernel_launch: occupancy query says %d\n", per_cu); grid = -1; return; }
        grid = cus * per_cu;
    }
    if (grid < 0) return;
    Params p{};
    p.x = (const float*)d_in[0]; p.norm_mix = (const float*)d_in[1]; p.w_in = (const float*)d_in[2]; p.conv_w = (const float*)d_in[3];
    p.pool_w = (const float*)d_in[4]; p.pool_scale = (const float*)d_in[5]; p.q_norm = (const float*)d_in[6]; p.w_uq = (const float*)d_in[7];
    p.kv_norm = (const float*)d_in[8]; p.w_uk = (const float*)d_in[9]; p.w_uv = (const float*)d_in[10]; p.w_out = (const float*)d_in[11];
    p.norm_ffn = (const float*)d_in[12]; p.peer_wq = (const float*)d_in[13]; p.peer_subkeys = (const float*)d_in[14]; p.peer_u = (const float*)d_in[15];
    p.peer_v = (const float*)d_in[16]; p.norm_final = (const float*)d_in[17];
    p.out = (float*)d_out; p.ws = (unsigned char*)d_ws;
    if (hipMemsetAsync((char*)d_ws + WS_CTL, 0, CTL_BYTES, stream) != hipSuccess) { fprintf(stderr, "kernel_launch: memset failed\n"); return; }
    void* args[] = {&p};
    hipError_t e = hipLaunchCooperativeKernel((const void*)k_all, dim3(grid), dim3(NTHREADS), args, 0, stream);
    if (e != hipSuccess) fprintf(stderr, "cooperative launch failed: %s (grid %d)\n", hipGetErrorString(e), grid);
}
```

```cpp
#include <hip/hip_runtime.h>
#include <hip/hip_cooperative_groups.h>
#include <cstdio>
#include <cstdint>
namespace cg = cooperative_groups;

#ifndef TAB_FP8
#define TAB_FP8 1
#endif
#ifndef PROBE_DUP
#define PROBE_DUP 0
#endif

constexpr int NB = 4, S = 8192, T = NB * S, D = 1024, DEPTH = 2;
constexpr int DIN = 1696, DINP = 1792;
constexpr int C_BG = 0, C_CG = 256, C_HC = 512, C_HP = 768, C_CQ = 1024, C_CKV = 1408, C_KR = 1664;
constexpr int QR = 384, KVR = 256, NH = 8, DQK = 96, DV = 64;
constexpr int PH = 8, NKEY = 128, NEXP = NKEY * NKEY, TOPK = 16, HK = PH * TOPK;
constexpr float EPS = 1e-6f;

typedef unsigned short bf16;

constexpr size_t WS_CTL   = 0;
constexpr size_t WS_ROPE  = 64 * 1024;
constexpr size_t WS_WIN   = WS_ROPE + (size_t)S * 16 * 2 * 4;
constexpr size_t WS_WUQ   = WS_WIN + (size_t)DEPTH * DINP * D * 2;
constexpr size_t WS_WUKV  = WS_WUQ + (size_t)DEPTH * 768 * QR * 2;
constexpr size_t WS_WOUT  = WS_WUKV + (size_t)DEPTH * 1024 * KVR * 2;
constexpr size_t WS_WPQ   = WS_WOUT + (size_t)DEPTH * D * D * 2;
constexpr size_t WS_XN    = ((WS_WPQ + (size_t)DEPTH * 2048 * D * 2 + 4095) / 4096) * 4096;
constexpr size_t WS_PROJ  = WS_XN + (size_t)T * D * 2;
constexpr size_t WS_Q     = WS_PROJ + (size_t)T * DINP * 2;
constexpr size_t WS_K     = WS_Q + (size_t)T * NH * DQK * 2;
constexpr size_t WS_V     = WS_K + (size_t)T * NH * DQK * 2;
constexpr size_t WS_EXP   = WS_V + (size_t)T * NH * DV * 2;
constexpr size_t WS_GATE  = WS_EXP + (size_t)T * HK * 4;
constexpr size_t TAB_ROWB = TAB_FP8 ? 1024 : 2048;
constexpr size_t WS_TABU  = WS_GATE + (size_t)T * HK * 4;
constexpr size_t WS_TABV  = WS_TABU + (size_t)DEPTH * NEXP * TAB_ROWB;
constexpr size_t WS_TSCU  = WS_TABV + (size_t)DEPTH * NEXP * TAB_ROWB;
constexpr size_t WS_TSCV  = WS_TSCU + (size_t)DEPTH * NEXP * 4;
constexpr size_t WS_END   = WS_TSCV + (size_t)DEPTH * NEXP * 4;
static_assert(WS_END <= (size_t)512 * 1024 * 1024, "workspace budget");

struct Params {
    const float* x; const float* norm_mix; const float* w_in; const float* conv_w; const float* pool_w; const float* pool_scale;
    const float* q_norm; const float* w_uq; const float* kv_norm; const float* w_uk; const float* w_uv; const float* w_out;
    const float* norm_ffn; const float* peer_wq; const float* peer_subkeys; const float* peer_u; const float* peer_v; const float* norm_final;
    float* out; unsigned char* ws;
};

__device__ __forceinline__ bf16 f2bf(float f) { unsigned u = __float_as_uint(f); u += 0x7fffu + ((u >> 16) & 1u); return (bf16)(u >> 16); }
__device__ __forceinline__ float bf2f(bf16 h) { return __uint_as_float(((unsigned)h) << 16); }
__device__ __forceinline__ float bflo(unsigned u) { return __uint_as_float(u << 16); }
__device__ __forceinline__ float bfhi(unsigned u) { return __uint_as_float(u & 0xffff0000u); }
__device__ __forceinline__ unsigned pack2(float a, float b) { return (unsigned)f2bf(a) | ((unsigned)f2bf(b) << 16); }
__device__ __forceinline__ float wave_sum(float v) {
#pragma unroll
    for (int m = 32; m >= 1; m >>= 1) v += __shfl_xor(v, m, 64);
    return v;
}
__device__ __forceinline__ float gelu_exact(float x) { return 0.5f * x * (1.f + erff(x * 0.70710678118654752f)); }

#define NTHREADS 256
__device__ __forceinline__ int tidx() { int t = (int)__builtin_amdgcn_workitem_id_x(); asm volatile("" : "+v"(t)); return t; }
__device__ __forceinline__ int gwave() { return blockIdx.x * (NTHREADS / 64) + (tidx() >> 6); }
__device__ __forceinline__ int nwave() { return gridDim.x * (NTHREADS / 64); }
__device__ __forceinline__ size_t gtid() { return (size_t)blockIdx.x * NTHREADS + tidx(); }
__device__ __forceinline__ size_t gnth() { return (size_t)gridDim.x * NTHREADS; }


__device__ __forceinline__ Params launder(const Params& P) {
    typedef __attribute__((address_space(1))) char* gp_t;
    gp_t g[20] = {(gp_t)(char*)P.x, (gp_t)(char*)P.norm_mix, (gp_t)(char*)P.w_in, (gp_t)(char*)P.conv_w, (gp_t)(char*)P.pool_w, (gp_t)(char*)P.pool_scale, (gp_t)(char*)P.q_norm, (gp_t)(char*)P.w_uq,
                  (gp_t)(char*)P.kv_norm, (gp_t)(char*)P.w_uk, (gp_t)(char*)P.w_uv, (gp_t)(char*)P.w_out, (gp_t)(char*)P.norm_ffn, (gp_t)(char*)P.peer_wq, (gp_t)(char*)P.peer_subkeys,
                  (gp_t)(char*)P.peer_u, (gp_t)(char*)P.peer_v, (gp_t)(char*)P.norm_final, (gp_t)(char*)P.out, (gp_t)(char*)P.ws};
    asm volatile("" : "+s"(g[0]), "+s"(g[1]), "+s"(g[2]), "+s"(g[3]), "+s"(g[4]), "+s"(g[5]), "+s"(g[6]), "+s"(g[7]), "+s"(g[8]), "+s"(g[9]));
    asm volatile("" : "+s"(g[10]), "+s"(g[11]), "+s"(g[12]), "+s"(g[13]), "+s"(g[14]), "+s"(g[15]), "+s"(g[16]), "+s"(g[17]), "+s"(g[18]), "+s"(g[19]));
    Params Q;
    Q.x = (const float*)(char*)g[0]; Q.norm_mix = (const float*)(char*)g[1]; Q.w_in = (const float*)(char*)g[2]; Q.conv_w = (const float*)(char*)g[3]; Q.pool_w = (const float*)(char*)g[4];
    Q.pool_scale = (const float*)(char*)g[5]; Q.q_norm = (const float*)(char*)g[6]; Q.w_uq = (const float*)(char*)g[7]; Q.kv_norm = (const float*)(char*)g[8]; Q.w_uk = (const float*)(char*)g[9];
    Q.w_uv = (const float*)(char*)g[10]; Q.w_out = (const float*)(char*)g[11]; Q.norm_ffn = (const float*)(char*)g[12]; Q.peer_wq = (const float*)(char*)g[13]; Q.peer_subkeys = (const float*)(char*)g[14];
    Q.peer_u = (const float*)(char*)g[15]; Q.peer_v = (const float*)(char*)g[16]; Q.norm_final = (const float*)(char*)g[17]; Q.out = (float*)(char*)g[18]; Q.ws = (unsigned char*)(char*)g[19];
    return Q;
}

typedef __attribute__((ext_vector_type(8))) short bf16x8;
typedef __attribute__((ext_vector_type(16))) float f32x16;
typedef __attribute__((ext_vector_type(2))) __bf16 bf2_t;
#define MFMA32(a, b, c) __builtin_amdgcn_mfma_f32_32x32x16_bf16(a, b, c, 0, 0, 0)
__device__ __forceinline__ int crow(int r, int hi) { return (r & 3) + 8 * (r >> 2) + 4 * hi; }
__device__ __forceinline__ float dot2bf(unsigned a, unsigned b, float c) { return __builtin_amdgcn_fdot2_f32_bf16(__builtin_bit_cast(bf2_t, a), __builtin_bit_cast(bf2_t, b), c, false); }
__device__ __forceinline__ unsigned cvtpk(float lo, float hi) { unsigned r; asm("v_cvt_pk_bf16_f32 %0, %1, %2" : "=v"(r) : "v"(lo), "v"(hi)); return r; }
constexpr int G_LDT = 144;
constexpr int G_OPB = 128 * G_LDT;
constexpr int G_BUF = 2 * G_OPB;
constexpr int GEMM_LDS = 2 * G_BUF;
constexpr int LDS_TOTAL = GEMM_LDS + 512;

template <int WT, bool ROWSS>
__device__ __forceinline__ void gemm_kloop(const bf16* __restrict__ Ag0, int lda, const bf16* __restrict__ Bg0, int ldb, int nk, f32x16 (&acc)[4], float (&ss)[4], char* lds, int tid) {
    const int lane = tid & 63, w = tid >> 6, r32 = lane & 31, hi = lane >> 5;
    const int srow = tid >> 3, sch = tid & 7;
    const bf16* Ag = Ag0 + (size_t)srow * lda + sch * 8;
    const bf16* Bg = Bg0 + (size_t)srow * ldb + sch * 8;
#pragma unroll
    for (int i = 0; i < 4; ++i)
#pragma unroll
        for (int r = 0; r < 16; ++r) acc[i][r] = 0.f;
    ss[0] = 0.f; ss[1] = 0.f; ss[2] = 0.f; ss[3] = 0.f;
    uint4 pa0, pa1, pa2, pa3, pb0, pb1, pb2, pb3, qa0, qa1, qa2, qa3, qb0, qb1, qb2, qb3;
#define G_LOAD(S, kofs) do { \
    S##a0 = *(const uint4*)(Ag + (kofs)); S##a1 = *(const uint4*)(Ag + (size_t)32 * lda + (kofs)); S##a2 = *(const uint4*)(Ag + (size_t)64 * lda + (kofs)); S##a3 = *(const uint4*)(Ag + (size_t)96 * lda + (kofs)); \
    S##b0 = *(const uint4*)(Bg + (kofs)); S##b1 = *(const uint4*)(Bg + (size_t)32 * ldb + (kofs)); S##b2 = *(const uint4*)(Bg + (size_t)64 * ldb + (kofs)); S##b3 = *(const uint4*)(Bg + (size_t)96 * ldb + (kofs)); } while (0)
#define G_SS(s_, r_) do { s_ = dot2bf(r_.x, r_.x, s_); s_ = dot2bf(r_.y, r_.y, s_); s_ = dot2bf(r_.z, r_.z, s_); s_ = dot2bf(r_.w, r_.w, s_); } while (0)
#define G_STORE(S, buf) do { \
    char* wa = lds + (buf) * G_BUF + srow * G_LDT + sch * 16; char* wb = wa + G_OPB; \
    *(uint4*)(wa) = S##a0; *(uint4*)(wa + 32 * G_LDT) = S##a1; *(uint4*)(wa + 64 * G_LDT) = S##a2; *(uint4*)(wa + 96 * G_LDT) = S##a3; \
    *(uint4*)(wb) = S##b0; *(uint4*)(wb + 32 * G_LDT) = S##b1; *(uint4*)(wb + 64 * G_LDT) = S##b2; *(uint4*)(wb + 96 * G_LDT) = S##b3; \
    if (ROWSS) { G_SS(ss[0], S##b0); G_SS(ss[1], S##b1); G_SS(ss[2], S##b2); G_SS(ss[3], S##b3); } } while (0)
#define G_COMPUTE(buf) do { \
    const char* bA = lds + (buf) * G_BUF; const char* bB = bA + G_OPB; \
    if (WT == 0) { \
        const char* pa = bA + ((w >> 1) * 64 + r32) * G_LDT + hi * 16; \
        const char* pb = bB + ((w & 1) * 64 + r32) * G_LDT + hi * 16; \
        _Pragma("unroll") for (int ks = 0; ks < 4; ++ks) { \
            const bf16x8 a0 = *(const bf16x8*)(pa + ks * 32), a1 = *(const bf16x8*)(pa + 32 * G_LDT + ks * 32); \
            const bf16x8 b0 = *(const bf16x8*)(pb + ks * 32), b1 = *(const bf16x8*)(pb + 32 * G_LDT + ks * 32); \
            acc[0] = MFMA32(a0, b0, acc[0]); acc[1] = MFMA32(a0, b1, acc[1]); \
            acc[2] = MFMA32(a1, b0, acc[2]); acc[3] = MFMA32(a1, b1, acc[3]); } \
    } else { \
        const char* pa = bA + r32 * G_LDT + hi * 16; \
        const char* pb = bB + (w * 32 + r32) * G_LDT + hi * 16; \
        _Pragma("unroll") for (int ks = 0; ks < 4; ++ks) { \
            const bf16x8 b0 = *(const bf16x8*)(pb + ks * 32); \
            const bf16x8 a0 = *(const bf16x8*)(pa + ks * 32), a1 = *(const bf16x8*)(pa + 32 * G_LDT + ks * 32); \
            const bf16x8 a2 = *(const bf16x8*)(pa + 64 * G_LDT + ks * 32), a3 = *(const bf16x8*)(pa + 96 * G_LDT + ks * 32); \
            acc[0] = MFMA32(a0, b0, acc[0]); acc[1] = MFMA32(a1, b0, acc[1]); \
            acc[2] = MFMA32(a2, b0, acc[2]); acc[3] = MFMA32(a3, b0, acc[3]); } \
    } } while (0)
    G_LOAD(p, 0); G_LOAD(q, 64);
    for (int kt = 0; kt < nk; kt += 2) {
        G_STORE(p, 0);
        __syncthreads();
        { const int kn = (kt + 2 < nk) ? (kt + 2) : (nk - 2); G_LOAD(p, kn * 64); }
        G_COMPUTE(0);
        G_STORE(q, 1);
        __syncthreads();
        { const int kn = (kt + 3 < nk) ? (kt + 3) : (nk - 1); G_LOAD(q, kn * 64); }
        G_COMPUTE(1);
    }
#undef G_STORE
#undef G_COMPUTE
#undef G_LOAD
#undef G_SS
}

template <bool ROWSS, class EPI>
__device__ __forceinline__ void gemm_t(const bf16* __restrict__ Wt, int ldw, int N, const bf16* __restrict__ X, int ldx, int M, int K, EPI epi, char* lds) {
    const int tid = tidx(), lane = tid & 63, w = tid >> 6, r32 = lane & 31, hi = lane >> 5;
    const int tilesN = N / 128, tilesM = M / 128, nk = K / 64;
    float* rowss = (float*)(lds + GEMM_LDS);
    for (int tile = blockIdx.x; tile < tilesM * tilesN; tile += gridDim.x) {
        const int tm = tile / tilesN, tn = tile % tilesN;
        f32x16 acc[4]; float ss[4];
        gemm_kloop<0, ROWSS>(Wt + (size_t)(tn * 128) * ldw, ldw, X + (size_t)(tm * 128) * ldx, ldx, nk, acc, ss, lds, tid);
        if (ROWSS) {
#pragma unroll
            for (int i = 0; i < 4; ++i) { float v = ss[i]; v += __shfl_xor(v, 1, 64); v += __shfl_xor(v, 2, 64); v += __shfl_xor(v, 4, 64); if ((tid & 7) == 0) rowss[(tid >> 3) + 32 * i] = v; }
            __syncthreads();
        }
#pragma unroll
        for (int i = 0; i < 2; ++i)
#pragma unroll
            for (int j = 0; j < 2; ++j) {
                const int tl = (w & 1) * 64 + j * 32;
                epi(tn * 128 + (w >> 1) * 64 + i * 32, tm * 128 + tl, acc[i * 2 + j], r32, hi, ROWSS ? rowss[tl + r32] : 0.f);
            }
        __syncthreads();
    }
}

__device__ __forceinline__ void transpose_tiled(const float* __restrict__ W, bf16* __restrict__ Wt, int K, int N, int Npad, const float* __restrict__ gain, char* lds) {
    float (*tl)[65] = (float (*)[65])lds;
    const int tid = tidx(), a = tid & 63, q = tid >> 6;
    const int tK = K / 64, tN = Npad / 64;
    for (int tile = blockIdx.x; tile < tK * tN; tile += gridDim.x) {
        const int k0 = (tile / tN) * 64, n0 = (tile % tN) * 64;
#pragma unroll 4
        for (int i = 0; i < 16; ++i) {
            const int k = k0 + q * 16 + i, n = n0 + a;
            float v = (n < N) ? W[(size_t)k * N + n] : 0.f;
            if (gain) v *= gain[k];
            tl[q * 16 + i][a] = v;
        }
        __syncthreads();
#pragma unroll 4
        for (int i = 0; i < 16; ++i) { const int nl = q * 16 + i; Wt[(size_t)(n0 + nl) * K + k0 + a] = f2bf(tl[a][nl]); }
        __syncthreads();
    }
}

__device__ __forceinline__ void quant_row(const float4 (&v)[4], unsigned char* __restrict__ dst, float* __restrict__ scl, int r, int lane) {
    float am = 0.f;
#pragma unroll
    for (int j = 0; j < 4; ++j) am = fmaxf(am, fmaxf(fmaxf(fabsf(v[j].x), fabsf(v[j].y)), fmaxf(fabsf(v[j].z), fabsf(v[j].w))));
#pragma unroll
    for (int m = 32; m >= 1; m >>= 1) am = fmaxf(am, __shfl_xor(am, m, 64));
    const float sc = (am > 0.f) ? am * (1.f / 448.f) : 1.f;
    const float is = 1.f / sc;
    uint4 o;
    { int w = 0; w = __builtin_amdgcn_cvt_pk_fp8_f32(v[0].x * is, v[0].y * is, w, false); w = __builtin_amdgcn_cvt_pk_fp8_f32(v[0].z * is, v[0].w * is, w, true); o.x = (unsigned)w; }
    { int w = 0; w = __builtin_amdgcn_cvt_pk_fp8_f32(v[1].x * is, v[1].y * is, w, false); w = __builtin_amdgcn_cvt_pk_fp8_f32(v[1].z * is, v[1].w * is, w, true); o.y = (unsigned)w; }
    { int w = 0; w = __builtin_amdgcn_cvt_pk_fp8_f32(v[2].x * is, v[2].y * is, w, false); w = __builtin_amdgcn_cvt_pk_fp8_f32(v[2].z * is, v[2].w * is, w, true); o.z = (unsigned)w; }
    { int w = 0; w = __builtin_amdgcn_cvt_pk_fp8_f32(v[3].x * is, v[3].y * is, w, false); w = __builtin_amdgcn_cvt_pk_fp8_f32(v[3].z * is, v[3].w * is, w, true); o.w = (unsigned)w; }
    { const int lay = r / NEXP, e = r % NEXP; *(uint4*)(dst + (((size_t)(lay * 8 + (lane >> 3)) * NEXP + e) * 128) + (lane & 7) * 16) = o; }
    if (lane == 0) scl[r] = sc;
}
__device__ __forceinline__ void convert_table(const float* __restrict__ src, unsigned char* __restrict__ dst, float* __restrict__ scl, int rows) {
    static_assert(TAB_FP8, "fp8 tables");
    const int lane = tidx() & 63;
    const int nw = nwave();
    for (int r = gwave(); r < rows; r += 2 * nw) {
        const int r2 = r + nw;
        float4 v0[4], v1[4];
        const float4* s0 = (const float4*)(src + (size_t)r * D);
        const float4* s1 = (const float4*)(src + (size_t)(r2 < rows ? r2 : r) * D);
#pragma unroll
        for (int j = 0; j < 4; ++j) { v0[j] = s0[lane * 4 + j]; v1[j] = s1[lane * 4 + j]; }
        quant_row(v0, dst, scl, r, lane);
        if (r2 < rows) quant_row(v1, dst, scl, r2, lane);
    }
}
__device__ __forceinline__ void phase_prep(const Params& P, char* lds) {
    unsigned char* ws = P.ws;
    for (int l = 0; l < DEPTH; ++l) {
        transpose_tiled(P.w_in + (size_t)l * D * DIN, (bf16*)(ws + WS_WIN) + (size_t)l * DINP * D, D, DIN, DINP, nullptr, lds);
        transpose_tiled(P.w_uq + (size_t)l * QR * 768, (bf16*)(ws + WS_WUQ) + (size_t)l * 768 * QR, QR, 768, 768, P.q_norm + l * QR, lds);
        transpose_tiled(P.w_uk + (size_t)l * KVR * 512, (bf16*)(ws + WS_WUKV) + (size_t)l * 1024 * KVR, KVR, 512, 512, P.kv_norm + l * KVR, lds);
        transpose_tiled(P.w_uv + (size_t)l * KVR * 512, (bf16*)(ws + WS_WUKV) + (size_t)l * 1024 * KVR + (size_t)512 * KVR, KVR, 512, 512, P.kv_norm + l * KVR, lds);
        transpose_tiled(P.w_out + (size_t)l * D * D, (bf16*)(ws + WS_WOUT) + (size_t)l * D * D, D, D, D, nullptr, lds);
    }
    {
        bf16* Wc = (bf16*)(ws + WS_WPQ);
        float (*As)[68] = (float (*)[68])lds;
        float (*Bs)[68] = (float (*)[68])(lds + 16 * 68 * 4);
        const int tid = tidx(), tx = tid & 15, ty = tid >> 4;
        const int lr = tid >> 2, ld4 = (tid & 3) * 4;
        for (int tile = blockIdx.x; tile < (DEPTH * 2048 / 64) * (D / 64); tile += gridDim.x) {
            const int row0 = (tile >> 4) * 64, k0 = (tile & 15) * 64;
            const int l = row0 >> 11, hp = (row0 >> 7) & 15, n0 = row0 & 127;
            const float* skp = P.peer_subkeys + (((size_t)l * 2 + (hp & 1)) * NKEY + n0 + lr) * 128 + ld4;
            const float* wqp = P.peer_wq + ((size_t)l * D + k0 + lr) * 2048 + hp * 128 + ld4;
            float acc[4][4];
#pragma unroll
            for (int i = 0; i < 4; ++i)
#pragma unroll
                for (int j = 0; j < 4; ++j) acc[i][j] = 0.f;
            for (int d0 = 0; d0 < 128; d0 += 16) {
                const float4 av = *(const float4*)(skp + d0), bv = *(const float4*)(wqp + d0);
                As[ld4 + 0][lr] = av.x; As[ld4 + 1][lr] = av.y; As[ld4 + 2][lr] = av.z; As[ld4 + 3][lr] = av.w;
                Bs[ld4 + 0][lr] = bv.x; Bs[ld4 + 1][lr] = bv.y; Bs[ld4 + 2][lr] = bv.z; Bs[ld4 + 3][lr] = bv.w;
                __syncthreads();
#pragma unroll
                for (int kk = 0; kk < 16; ++kk) {
                    const float4 a4 = *(const float4*)&As[kk][ty * 4], b4 = *(const float4*)&Bs[kk][tx * 4];
                    const float aa[4] = {a4.x, a4.y, a4.z, a4.w}, bb[4] = {b4.x, b4.y, b4.z, b4.w};
#pragma unroll
                    for (int i = 0; i < 4; ++i)
#pragma unroll
                        for (int j = 0; j < 4; ++j) acc[i][j] = fmaf(aa[i], bb[j], acc[i][j]);
                }
                __syncthreads();
            }
#pragma unroll
            for (int i = 0; i < 4; ++i) {
                uint2 o; o.x = pack2(acc[i][0], acc[i][1]); o.y = pack2(acc[i][2], acc[i][3]);
                *(uint2*)(Wc + (size_t)(row0 + ty * 4 + i) * D + k0 + tx * 4) = o;
            }
        }
    }
    convert_table(P.peer_u, ws + WS_TABU, (float*)(ws + WS_TSCU), DEPTH * NEXP);
    convert_table(P.peer_v, ws + WS_TABV, (float*)(ws + WS_TSCV), DEPTH * NEXP);
    float* rope = (float*)(ws + WS_ROPE);
    for (size_t i = gtid(); i < (size_t)S * 16; i += gnth()) {
        const int s = (int)(i >> 4), f = (int)(i & 15);
        const double inv = pow(10000.0, -(double)f / 16.0);
        const double ang = (double)s * inv;
        rope[2 * i] = (float)cos(ang); rope[2 * i + 1] = (float)sin(ang);
    }
}

__device__ __forceinline__ void phase_norm(const float* __restrict__ h, const float* __restrict__ g, bf16* __restrict__ xn) {
    const int lane = tidx() & 63;
    for (int t = gwave(); t < T; t += nwave()) {
        const float4* hr = (const float4*)(h + (size_t)t * D);
        float4 v[4]; float ss = 0.f;
#pragma unroll
        for (int j = 0; j < 4; ++j) { v[j] = hr[j * 64 + lane]; ss += v[j].x * v[j].x + v[j].y * v[j].y + v[j].z * v[j].z + v[j].w * v[j].w; }
        ss = wave_sum(ss);
        const float r = rsqrtf(ss * (1.f / D) + EPS);
#pragma unroll
        for (int j = 0; j < 4; ++j) {
            const float4 gg = ((const float4*)g)[j * 64 + lane];
            uint2 o; o.x = pack2(v[j].x * r * gg.x, v[j].y * r * gg.y); o.y = pack2(v[j].z * r * gg.z, v[j].w * r * gg.w);
            ((uint2*)(xn + (size_t)t * D))[j * 64 + lane] = o;
        }
    }
}

__device__ __forceinline__ void phase_mixlocal(const Params& P, int l, char* lds) {
    const bf16* proj = (const bf16*)(P.ws + WS_PROJ);
    bf16* Y = (bf16*)(P.ws + WS_XN);
    const int tid = tidx();
    {
        const float* cw = P.conv_w + (size_t)l * 3 * 256;
        for (size_t i = gtid(); i < (size_t)T * 32; i += gnth()) {
            const int t = (int)(i >> 5), c0 = (int)(i & 31) * 8, s = t & (S - 1);
            const bf16* pr = proj + (size_t)t * DINP;
            float acc[8];
#pragma unroll
            for (int e = 0; e < 8; ++e) acc[e] = 0.f;
#pragma unroll
            for (int j = 0; j < 3; ++j) {
                if (s - 2 + j >= 0) {
                    const bf16* pp = pr - (size_t)(2 - j) * DINP;
                    const uint4 g = *(const uint4*)(pp + C_CG + c0), hc = *(const uint4*)(pp + C_HC + c0);
                    const float4 w0 = *(const float4*)(cw + j * 256 + c0), w1 = *(const float4*)(cw + j * 256 + c0 + 4);
                    acc[0] = fmaf(w0.x, bflo(g.x) * bflo(hc.x), acc[0]); acc[1] = fmaf(w0.y, bfhi(g.x) * bfhi(hc.x), acc[1]);
                    acc[2] = fmaf(w0.z, bflo(g.y) * bflo(hc.y), acc[2]); acc[3] = fmaf(w0.w, bfhi(g.y) * bfhi(hc.y), acc[3]);
                    acc[4] = fmaf(w1.x, bflo(g.z) * bflo(hc.z), acc[4]); acc[5] = fmaf(w1.y, bfhi(g.z) * bfhi(hc.z), acc[5]);
                    acc[6] = fmaf(w1.z, bflo(g.w) * bflo(hc.w), acc[6]); acc[7] = fmaf(w1.w, bfhi(g.w) * bfhi(hc.w), acc[7]);
                }
            }
            const uint4 bg = *(const uint4*)(pr + C_BG + c0);
            uint4 o;
            o.x = pack2(bflo(bg.x) * acc[0], bfhi(bg.x) * acc[1]); o.y = pack2(bflo(bg.y) * acc[2], bfhi(bg.y) * acc[3]);
            o.z = pack2(bflo(bg.z) * acc[4], bfhi(bg.z) * acc[5]); o.w = pack2(bflo(bg.w) * acc[6], bfhi(bg.w) * acc[7]);
            *(uint4*)(Y + (size_t)t * D + c0) = o;
        }
    }
    {
        float (*pl)[68] = (float (*)[68])lds;
        const float* pw = P.pool_w + (size_t)l * 4 * 64 * 64;
        const float* psc = P.pool_scale + l * 256;
        const int a = tid & 63, q = tid >> 6;
        for (int tile = blockIdx.x; tile < (T / 64) * 4; tile += gridDim.x) {
            const int g = tile & 3, t0 = (tile >> 2) * 64;
            const int w = 2 << g;
            {
                const bf16* col = proj + C_HP + g * 64 + a;
                const int tf = t0 + q * 16, sf = tf & (S - 1);
                float sum = 0.f;
                for (int d = 1; d < w; ++d) if (sf - d >= 0) sum += bf2f(col[(size_t)(tf - d) * DINP]);
#pragma unroll 4
                for (int i = 0; i < 16; ++i) {
                    const int s = sf + i;
                    const float xv = bf2f(col[(size_t)(tf + i) * DINP]);
                    sum += xv;
                    const int cnt = (s + 1 < w) ? (s + 1) : w;
                    pl[q * 16 + i][a] = sum / (float)cnt - xv;
                    if (s - w + 1 >= 0) sum -= bf2f(col[(size_t)(tf + i - w + 1) * DINP]);
                }
            }
            __syncthreads();
            {
                float pc[64];
#pragma unroll
                for (int c = 0; c < 64; ++c) pc[c] = pw[(g * 64 + c) * 64 + a];
                const float sc = psc[g * 64 + a];
#pragma unroll 2
                for (int i = 0; i < 16; ++i) {
                    const float4* row = (const float4*)&pl[q * 16 + i][0];
                    float m0 = 0.f, m1 = 0.f;
#pragma unroll
                    for (int c4 = 0; c4 < 16; ++c4) { const float4 v = row[c4]; m0 = fmaf(v.x, pc[4 * c4], m0); m1 = fmaf(v.y, pc[4 * c4 + 1], m1); m0 = fmaf(v.z, pc[4 * c4 + 2], m0); m1 = fmaf(v.w, pc[4 * c4 + 3], m1); }
                    Y[(size_t)(t0 + q * 16 + i) * D + 256 + g * 64 + a] = f2bf((m0 + m1) * sc);
                }
            }
            __syncthreads();
        }
    }
}

typedef short v4i16_t __attribute__((ext_vector_type(4)));
typedef __attribute__((address_space(3))) v4i16_t* lds_v4p;
__device__ __forceinline__ v4i16_t vtr(const char* p) { return __builtin_amdgcn_ds_read_tr16_b64_v4i16((lds_v4p)p); }
constexpr int A_KP = 208, A_VP = 192;
constexpr int A_KB = 64 * A_KP, A_VB = 64 * A_VP, A_BUF = A_KB + A_VB, ATTN_LDS = 2 * A_BUF;
static_assert(ATTN_LDS <= GEMM_LDS, "attention LDS");

__device__ __forceinline__ void attn_unit(const bf16* __restrict__ Qb, const bf16* __restrict__ Kb, const bf16* __restrict__ Vb, bf16* __restrict__ Y, int bh, int qblk, char* lds) {
    const int tid = tidx(), lane = tid & 63, w = tid >> 6, r32 = lane & 31, hi = lane >> 5;
    const int q0 = qblk * 128, qw0 = q0 + w * 32;
    const int NT = 2 * qblk + 2;
    bf16x8 qf[6];
    {
        const bf16* qp = Qb + ((size_t)bh * S + qw0 + r32) * DQK + hi * 8;
#pragma unroll
        for (int ks = 0; ks < 6; ++ks) qf[ks] = *(const bf16x8*)(qp + ks * 16);
    }
    f32x16 o0, o1;
#pragma unroll
    for (int r = 0; r < 16; ++r) { o0[r] = 0.f; o1[r] = 0.f; }
    float m = -1e30f, lsum = 0.f;
    const char* Kg = (const char*)(Kb + (size_t)bh * S * DQK) + tid * 16;
    const char* Vg = (const char*)(Vb + (size_t)bh * S * DV) + tid * 16;
    const int kl0 = (tid / 12) * A_KP + (tid % 12) * 16, kl1 = ((tid + 256) / 12) * A_KP + ((tid + 256) % 12) * 16, kl2 = ((tid + 512) / 12) * A_KP + ((tid + 512) % 12) * 16;
    const int vl0 = (tid >> 3) * A_VP + (tid & 7) * 16, vl1 = vl0 + 32 * A_VP;
    uint4 pk0, pk1, pk2, pv0, pv1, qk0, qk1, qk2, qv0, qv1;
#define A_LOAD(S, t) do { const char* kg = Kg + (size_t)(t) * (64 * 192); const char* vg = Vg + (size_t)(t) * (64 * 128); \
        S##k0 = *(const uint4*)(kg); S##k1 = *(const uint4*)(kg + 4096); S##k2 = *(const uint4*)(kg + 8192); S##v0 = *(const uint4*)(vg); S##v1 = *(const uint4*)(vg + 4096); } while (0)
#define A_STORE(S, bK, bV) do { *(uint4*)(bK + kl0) = S##k0; *(uint4*)(bK + kl1) = S##k1; *(uint4*)(bK + kl2) = S##k2; *(uint4*)(bV + vl0) = S##v0; *(uint4*)(bV + vl1) = S##v1; } while (0)
#define A_PV(pf, kofs) do { \
            { const v4i16_t lo = vtr(pv + (kofs) * A_VP), hh = vtr(pv + ((kofs) + 8) * A_VP); const bf16x8 vf = {lo[0], lo[1], lo[2], lo[3], hh[0], hh[1], hh[2], hh[3]}; o0 = MFMA32(vf, pf.v, o0); } \
            { const v4i16_t lo = vtr(pv + (kofs) * A_VP + 64), hh = vtr(pv + ((kofs) + 8) * A_VP + 64); const bf16x8 vf = {lo[0], lo[1], lo[2], lo[3], hh[0], hh[1], hh[2], hh[3]}; o1 = MFMA32(vf, pf.v, o1); } } while (0)
    const int pvo = (4 * hi + ((lane & 15) >> 2)) * A_VP + (16 * ((lane >> 4) & 1) + 4 * (lane & 3)) * 2;
    A_LOAD(p, 0); A_LOAD(q, 1);
    for (int t2 = 0; t2 < NT; t2 += 2) {
#pragma unroll
        for (int half = 0; half < 2; ++half) {
            const int t = t2 + half;
            char* bK = lds + half * A_BUF; char* bV = bK + A_KB;
            if (half == 0) A_STORE(p, bK, bV); else A_STORE(q, bK, bV);
            __syncthreads();
            { const int tn = (t + 2 < NT) ? (t + 2) : (NT - 2 + half); if (half == 0) A_LOAD(p, tn); else A_LOAD(q, tn); }
        const int kt0 = t * 64;
        if (kt0 <= qw0) {
            f32x16 s0, s1;
#pragma unroll
            for (int r = 0; r < 16; ++r) { s0[r] = 0.f; s1[r] = 0.f; }
            const char* pk = bK + r32 * A_KP + hi * 16;
#pragma unroll
            for (int ks = 0; ks < 6; ++ks) {
                const bf16x8 a0 = *(const bf16x8*)(pk + ks * 32), a1 = *(const bf16x8*)(pk + 32 * A_KP + ks * 32);
                s0 = MFMA32(a0, qf[ks], s0); s1 = MFMA32(a1, qf[ks], s1);
            }
            if (kt0 + 63 > qw0) {
                const int qrow = qw0 + r32;
#pragma unroll
                for (int r = 0; r < 16; ++r) { const int key = kt0 + crow(r, hi); if (key > qrow) s0[r] = -INFINITY; if (key + 32 > qrow) s1[r] = -INFINITY; }
            }
            float mx = fmaxf(s0[0], s1[0]);
#pragma unroll
            for (int r = 1; r < 16; ++r) mx = fmaxf(mx, fmaxf(s0[r], s1[r]));
            mx = fmaxf(mx, __shfl_xor(mx, 32, 64));
            const float mn = fmaxf(m, mx);
            const float alpha = __builtin_amdgcn_exp2f(m - mn);
            m = mn;
            float ps = 0.f;
#pragma unroll
            for (int r = 0; r < 16; ++r) { s0[r] = __builtin_amdgcn_exp2f(s0[r] - mn); s1[r] = __builtin_amdgcn_exp2f(s1[r] - mn); ps += s0[r] + s1[r]; }
            lsum = lsum * alpha + ps;
#pragma unroll
            for (int r = 0; r < 16; ++r) { o0[r] *= alpha; o1[r] *= alpha; }
            union { unsigned u[4]; bf16x8 v; } p00, p01, p10, p11;
#pragma unroll
            for (int j = 0; j < 4; ++j) { p00.u[j] = cvtpk(s0[2 * j], s0[2 * j + 1]); p01.u[j] = cvtpk(s0[8 + 2 * j], s0[9 + 2 * j]); p10.u[j] = cvtpk(s1[2 * j], s1[2 * j + 1]); p11.u[j] = cvtpk(s1[8 + 2 * j], s1[9 + 2 * j]); }
            const char* pv = bV + pvo;
            A_PV(p00, 0); A_PV(p01, 16); A_PV(p10, 32); A_PV(p11, 48);
        }
        }
    }
    lsum += __shfl_xor(lsum, 32, 64);
    const float inv = 1.f / lsum;
    const int b = bh >> 3, h = bh & 7;
    bf16* yo = Y + (size_t)(b * S + qw0 + r32) * D + 512 + h * 64 + 4 * hi;
#pragma unroll
    for (int g = 0; g < 4; ++g) {
        uint2 a, c;
        a.x = cvtpk(o0[4 * g] * inv, o0[4 * g + 1] * inv); a.y = cvtpk(o0[4 * g + 2] * inv, o0[4 * g + 3] * inv);
        c.x = cvtpk(o1[4 * g] * inv, o1[4 * g + 1] * inv); c.y = cvtpk(o1[4 * g + 2] * inv, o1[4 * g + 3] * inv);
        *(uint2*)(yo + 8 * g) = a; *(uint2*)(yo + 32 + 8 * g) = c;
    }
    __syncthreads();
}
__device__ __forceinline__ void phase_attn(const Params& P, char* lds) {
    const bf16* Qb = (const bf16*)(P.ws + WS_Q);
    const bf16* Kb = (const bf16*)(P.ws + WS_K);
    const bf16* Vb = (const bf16*)(P.ws + WS_V);
    bf16* Y = (bf16*)(P.ws + WS_XN);
    for (int u = blockIdx.x; u < NB * NH * (S / 128); u += gridDim.x) {
        const int bh = u & 31, v = u >> 5;
        const int qblk = (v < 16) ? (63 - v) : (v < 32) ? (v - 16) : (v < 48) ? (79 - v) : (v - 32);
        attn_unit(Qb, Kb, Vb, Y, bh, qblk, lds);
    }
}

#define NET_HD __device__ __forceinline__
#define NET_U2F(u) __uint_as_float(u)
#define NET_F2U(f) __float_as_uint(f)
#define CE_DESC(a, b) do { const float hi__ = fmaxf(a, b), lo__ = fminf(a, b); a = hi__; b = lo__; } while (0)
NET_HD void sort16_desc(float (&v)[16]) {
#pragma unroll
    for (int k = 2; k <= 16; k <<= 1) {
#pragma unroll
        for (int j = k >> 1; j > 0; j >>= 1) {
#pragma unroll
            for (int i = 0; i < 16; ++i) {
                const int l = i ^ j;
                if (l > i) { if ((i & k) == 0) CE_DESC(v[i], v[l]); else CE_DESC(v[l], v[i]); }
            }
        }
    }
}
NET_HD void merge16_desc(float (&a)[16], const float (&b)[16]) {
#pragma unroll
    for (int i = 0; i < 16; ++i) a[i] = fmaxf(a[i], b[15 - i]);
#pragma unroll
    for (int j = 8; j > 0; j >>= 1) {
#pragma unroll
        for (int i = 0; i < 16; ++i) { const int l = i ^ j; if (l > i) CE_DESC(a[i], a[l]); }
    }
}
NET_HD void top16_of_64(float (&g0)[16], float (&g1)[16], float (&g2)[16], float (&g3)[16]) {
    sort16_desc(g0); sort16_desc(g1); sort16_desc(g2); sort16_desc(g3);
    merge16_desc(g0, g1); merge16_desc(g2, g3); merge16_desc(g0, g2);
}
NET_HD float u2f(unsigned u) { return NET_U2F(u); }
NET_HD unsigned f2u(float f) { return NET_F2U(f); }
template <class V16>
NET_HD void lane_top16(const V16& s0, const V16& s1, const V16& s2, const V16& s3, int hi, float (&out)[16]) {
    float g0[16], g1[16], g2[16], g3[16];
#pragma unroll
    for (int r = 0; r < 16; ++r) {
        const unsigned nb = (unsigned)((r & 3) + 8 * (r >> 2));
        g0[r] = u2f((f2u(s0[r]) & 0xFFFFFF80u) | nb); g1[r] = u2f((f2u(s1[r]) & 0xFFFFFF80u) | (nb + 32u));
        g2[r] = u2f((f2u(s2[r]) & 0xFFFFFF80u) | (nb + 64u)); g3[r] = u2f((f2u(s3[r]) & 0xFFFFFF80u) | (nb + 96u));
    }
    top16_of_64(g0, g1, g2, g3);
    const unsigned h4 = (unsigned)hi << 2;
#pragma unroll
    for (int i = 0; i < 16; ++i) out[i] = u2f(f2u(g0[i]) | h4);
}
constexpr int cand_slot(int a, int b) { int n = 0; for (int x = 0; x < 16; ++x) for (int y = 0; y < 16; ++y) { if (x == a && y == b) return n; if ((x + 1) * (y + 1) <= 16) ++n; } return n; }
NET_HD void cand_top16(const float (&s1)[16], const float (&s2)[16], float (&c)[16]) {
    float g0[16], g1[16], g2[16], g3[16];
#pragma unroll
    for (int i = 0; i < 16; ++i) { g0[i] = -3.0e38f; g1[i] = -3.0e38f; g2[i] = -3.0e38f; g3[i] = -3.0e38f; }
#pragma unroll
    for (int a = 0; a < 16; ++a) {
#pragma unroll
        for (int b = 0; b < 16; ++b) {
            if ((a + 1) * (b + 1) <= 16) {
                const int sl = cand_slot(a, b);
                const float v = u2f((f2u(s1[a] + s2[b]) & 0xFFFFFF00u) | (unsigned)(a * 16 + b));
                if (sl < 16) g0[sl & 15] = v; else if (sl < 32) g1[sl & 15] = v; else if (sl < 48) g2[sl & 15] = v; else g3[sl & 15] = v;
            }
        }
    }
    top16_of_64(g0, g1, g2, g3);
#pragma unroll
    for (int i = 0; i < 16; ++i) c[i] = g0[i];
}

__device__ __forceinline__ void phase_route(const Params& P, int l, char* lds) {
    const bf16* XN = (const bf16*)(P.ws + WS_XN);
    const bf16* Wc = (const bf16*)(P.ws + WS_WPQ) + (size_t)l * 2048 * D;
    int* EXPp = (int*)(P.ws + WS_EXP);
    float* GATEp = (float*)(P.ws + WS_GATE);
    const int tid = tidx(), lane = tid & 63, w = tid >> 6, r32 = lane & 31, hi = lane >> 5;
    for (int u = blockIdx.x; u < (T / 128) * PH; u += gridDim.x) {
        const int tm = u >> 3, h = u & 7;
        float L0[16], L1[16];
        {
            f32x16 acc[4]; float ssd[4];
            gemm_kloop<1, false>(Wc + (size_t)((h * 2 + 0) * 128) * D, D, XN + (size_t)(tm * 128) * D, D, D / 64, acc, ssd, lds, tid);
            lane_top16(acc[0], acc[1], acc[2], acc[3], hi, L0);
            float o[16];
#pragma unroll
            for (int i = 0; i < 16; ++i) o[i] = __shfl_xor(L0[i], 32, 64);
            merge16_desc(L0, o);
        }
        {
            f32x16 acc[4]; float ssd[4];
            gemm_kloop<1, false>(Wc + (size_t)((h * 2 + 1) * 128) * D, D, XN + (size_t)(tm * 128) * D, D, D / 64, acc, ssd, lds, tid);
            lane_top16(acc[0], acc[1], acc[2], acc[3], hi, L1);
            float o[16];
#pragma unroll
            for (int i = 0; i < 16; ++i) o[i] = __shfl_xor(L1[i], 32, 64);
            merge16_desc(L1, o);
        }
        float c[16];
        cand_top16(L0, L1, c);
        __syncthreads();
        unsigned char* my = (unsigned char*)lds + tid * 32;
        {
            uint4 a, b;
#define PK4(L, i) ((__float_as_uint(L[i]) & 127u) | ((__float_as_uint(L[i + 1]) & 127u) << 8) | ((__float_as_uint(L[i + 2]) & 127u) << 16) | ((__float_as_uint(L[i + 3]) & 127u) << 24))
            a.x = PK4(L0, 0); a.y = PK4(L0, 4); a.z = PK4(L0, 8); a.w = PK4(L0, 12);
            b.x = PK4(L1, 0); b.y = PK4(L1, 4); b.z = PK4(L1, 8); b.w = PK4(L1, 12);
#undef PK4
            *(uint4*)my = a; *(uint4*)(my + 16) = b;
        }
        int ev[16]; float gv[16]; float den = 0.f;
#pragma unroll
        for (int k = 0; k < 16; ++k) {
            const unsigned ci = __float_as_uint(c[k]) & 255u;
            const int n1 = my[ci >> 4], n2 = my[16 + (ci & 15)];
            ev[k] = n1 * NKEY + n2;
            gv[k] = __expf(c[k] - c[0]); den += gv[k];
        }
        const float iden = 1.f / den;
        if (hi == 0) {
            const int t = tm * 128 + w * 32 + r32;
            uint4* ep = (uint4*)(EXPp + (size_t)t * HK + h * 16);
            float4* gp = (float4*)(GATEp + (size_t)t * HK + h * 16);
#pragma unroll
            for (int q = 0; q < 4; ++q) {
                ep[q] = make_uint4((unsigned)ev[4 * q], (unsigned)ev[4 * q + 1], (unsigned)ev[4 * q + 2], (unsigned)ev[4 * q + 3]);
                gp[q] = make_float4(gv[4 * q] * iden, gv[4 * q + 1] * iden, gv[4 * q + 2] * iden, gv[4 * q + 3] * iden);
            }
        }
        __syncthreads();
    }
}

__device__ __forceinline__ float red16(float (&p)[16], int lane) {
#pragma unroll
    for (int i = 0; i < 8; ++i) { const bool up = lane & 32; const float send = up ? p[i] : p[i + 8], keep = up ? p[i + 8] : p[i]; p[i] = keep + __shfl_xor(send, 32, 64); }
#pragma unroll
    for (int i = 0; i < 4; ++i) { const bool up = lane & 16; const float send = up ? p[i] : p[i + 4], keep = up ? p[i + 4] : p[i]; p[i] = keep + __shfl_xor(send, 16, 64); }
#pragma unroll
    for (int i = 0; i < 2; ++i) { const bool up = lane & 8; const float send = up ? p[i] : p[i + 2], keep = up ? p[i + 2] : p[i]; p[i] = keep + __shfl_xor(send, 8, 64); }
    { const bool up = lane & 4; const float send = up ? p[0] : p[1], keep = up ? p[1] : p[0]; p[0] = keep + __shfl_xor(send, 4, 64); }
    float r = p[0];
    r += __shfl_xor(r, 2, 64); r += __shfl_xor(r, 1, 64);
    return r;
}

__device__ __forceinline__ void phase_gather(const Params& P, int l) {
    const bf16* XN = (const bf16*)(P.ws + WS_XN);
    bf16* XNw = (bf16*)(P.ws + WS_XN);
    const int* EXPp = (const int*)(P.ws + WS_EXP);
    const float* GATEp = (const float*)(P.ws + WS_GATE);
    const unsigned char* U = P.ws + WS_TABU + (size_t)l * NEXP * TAB_ROWB;
    const unsigned char* V = P.ws + WS_TABV + (size_t)l * NEXP * TAB_ROWB;
    const float* SU = (const float*)(P.ws + WS_TSCU) + (size_t)l * NEXP;
    const float* SV = (const float*)(P.ws + WS_TSCV) + (size_t)l * NEXP;
    const int lane = tidx() & 63;
    for (int t = gwave(); t < T; t += nwave()) {
        const int e_lo = EXPp[(size_t)t * HK + lane], e_hi = EXPp[(size_t)t * HK + 64 + lane];
#if TAB_FP8
        float xf[16];
        {
            const uint4 a = ((const uint4*)(XN + (size_t)t * D))[lane * 2], b = ((const uint4*)(XN + (size_t)t * D))[lane * 2 + 1];
            xf[0] = bflo(a.x); xf[1] = bfhi(a.x); xf[2] = bflo(a.y); xf[3] = bfhi(a.y); xf[4] = bflo(a.z); xf[5] = bfhi(a.z); xf[6] = bflo(a.w); xf[7] = bfhi(a.w);
            xf[8] = bflo(b.x); xf[9] = bfhi(b.x); xf[10] = bflo(b.y); xf[11] = bfhi(b.y); xf[12] = bflo(b.z); xf[13] = bfhi(b.z); xf[14] = bflo(b.w); xf[15] = bfhi(b.w);
        }
#else
        const uint4 xa = ((const uint4*)(XN + (size_t)t * D))[lane], xb = ((const uint4*)(XN + (size_t)t * D))[64 + lane];
#endif
        float acc[16];
#pragma unroll
        for (int i = 0; i < 16; ++i) acc[i] = 0.f;
        for (int c = 0; c < 8; ++c) {
            const int esel = (c < 4) ? e_lo : e_hi;
            const int kb = (c & 3) * 16;
            float part[16];
#pragma unroll
            for (int hb = 0; hb < 2; ++hb) {
#if TAB_FP8
                uint4 r[8];
#pragma unroll
                for (int i = 0; i < 8; ++i) { const int e = __builtin_amdgcn_readlane(esel, kb + hb * 8 + i); r[i] = *(const uint4*)(U + (size_t)e * 1024 + lane * 16); }
#pragma unroll
                for (int i = 0; i < 8; ++i) {
                    float d0 = 0.f, d1 = 0.f;
                    const unsigned w[4] = {r[i].x, r[i].y, r[i].z, r[i].w};
#pragma unroll
                    for (int q = 0; q < 4; ++q) {
                        const auto lo = __builtin_amdgcn_cvt_pk_f32_fp8((int)w[q], false); const auto hh = __builtin_amdgcn_cvt_pk_f32_fp8((int)w[q], true);
                        d0 = fmaf(xf[4 * q], lo[0], d0); d1 = fmaf(xf[4 * q + 1], lo[1], d1); d0 = fmaf(xf[4 * q + 2], hh[0], d0); d1 = fmaf(xf[4 * q + 3], hh[1], d1);
                    }
                    part[hb * 8 + i] = d0 + d1;
                }
#else
                uint4 r0[8], r1[8];
#pragma unroll
                for (int i = 0; i < 8; ++i) { const int e = __builtin_amdgcn_readlane(esel, kb + hb * 8 + i); const unsigned char* rp = U + (size_t)e * 2048 + lane * 16; r0[i] = *(const uint4*)(rp); r1[i] = *(const uint4*)(rp + 1024); }
#pragma unroll
                for (int i = 0; i < 8; ++i) {
                    float d0 = 0.f, d1 = 0.f;
                    d0 = dot2bf(xa.x, r0[i].x, d0); d1 = dot2bf(xa.y, r0[i].y, d1); d0 = dot2bf(xa.z, r0[i].z, d0); d1 = dot2bf(xa.w, r0[i].w, d1);
                    d0 = dot2bf(xb.x, r1[i].x, d0); d1 = dot2bf(xb.y, r1[i].y, d1); d0 = dot2bf(xb.z, r1[i].z, d0); d1 = dot2bf(xb.w, r1[i].w, d1);
                    part[hb * 8 + i] = d0 + d1;
                }
#endif
            }
            float dsum = red16(part, lane);
            const int kk = c * 16 + (lane >> 2);
            const int eme = __shfl(esel, kb + (lane >> 2), 64);
            float wv = GATEp[(size_t)t * HK + kk];
#if TAB_FP8
            dsum *= SU[eme];
            wv *= SV[eme];
#endif
            wv *= gelu_exact(dsum);
#pragma unroll
            for (int hb = 0; hb < 2; ++hb) {
#if TAB_FP8
                uint4 r[8];
#pragma unroll
                for (int i = 0; i < 8; ++i) { const int e = __builtin_amdgcn_readlane(esel, kb + hb * 8 + i); r[i] = *(const uint4*)(V + (size_t)e * 1024 + lane * 16); }
#pragma unroll
                for (int i = 0; i < 8; ++i) {
                    const float w = __int_as_float(__builtin_amdgcn_readlane(__float_as_int(wv), (hb * 8 + i) * 4));
                    const unsigned ww[4] = {r[i].x, r[i].y, r[i].z, r[i].w};
#pragma unroll
                    for (int q = 0; q < 4; ++q) {
                        const auto lo = __builtin_amdgcn_cvt_pk_f32_fp8((int)ww[q], false); const auto hh = __builtin_amdgcn_cvt_pk_f32_fp8((int)ww[q], true);
                        acc[4 * q] = fmaf(w, lo[0], acc[4 * q]); acc[4 * q + 1] = fmaf(w, lo[1], acc[4 * q + 1]); acc[4 * q + 2] = fmaf(w, hh[0], acc[4 * q + 2]); acc[4 * q + 3] = fmaf(w, hh[1], acc[4 * q + 3]);
                    }
                }
#else
                uint4 r0[8], r1[8];
#pragma unroll
                for (int i = 0; i < 8; ++i) { const int e = __builtin_amdgcn_readlane(esel, kb + hb * 8 + i); const unsigned char* rp = V + (size_t)e * 2048 + lane * 16; r0[i] = *(const uint4*)(rp); r1[i] = *(const uint4*)(rp + 1024); }
#pragma unroll
                for (int i = 0; i < 8; ++i) {
                    const float w = __int_as_float(__builtin_amdgcn_readlane(__float_as_int(wv), (hb * 8 + i) * 4));
                    acc[0] = fmaf(w, bflo(r0[i].x), acc[0]); acc[1] = fmaf(w, bfhi(r0[i].x), acc[1]); acc[2] = fmaf(w, bflo(r0[i].y), acc[2]); acc[3] = fmaf(w, bfhi(r0[i].y), acc[3]);
                    acc[4] = fmaf(w, bflo(r0[i].z), acc[4]); acc[5] = fmaf(w, bfhi(r0[i].z), acc[5]); acc[6] = fmaf(w, bflo(r0[i].w), acc[6]); acc[7] = fmaf(w, bfhi(r0[i].w), acc[7]);
                    acc[8] = fmaf(w, bflo(r1[i].x), acc[8]); acc[9] = fmaf(w, bfhi(r1[i].x), acc[9]); acc[10] = fmaf(w, bflo(r1[i].y), acc[10]); acc[11] = fmaf(w, bfhi(r1[i].y), acc[11]);
                    acc[12] = fmaf(w, bflo(r1[i].z), acc[12]); acc[13] = fmaf(w, bfhi(r1[i].z), acc[13]); acc[14] = fmaf(w, bflo(r1[i].w), acc[14]); acc[15] = fmaf(w, bfhi(r1[i].w), acc[15]);
                }
#endif
            }
        }
        float* hrow = P.out + (size_t)t * D;
#if TAB_FP8
        const int c0 = lane * 16, c1 = lane * 16 + 8;
#else
        const int c0 = lane * 8, c1 = 512 + lane * 8;
#endif
        float4 h0 = *(const float4*)(hrow + c0), h1 = *(const float4*)(hrow + c0 + 4), h2 = *(const float4*)(hrow + c1), h3 = *(const float4*)(hrow + c1 + 4);
        h0.x += acc[0]; h0.y += acc[1]; h0.z += acc[2]; h0.w += acc[3]; h1.x += acc[4]; h1.y += acc[5]; h1.z += acc[6]; h1.w += acc[7];
        h2.x += acc[8]; h2.y += acc[9]; h2.z += acc[10]; h2.w += acc[11]; h3.x += acc[12]; h3.y += acc[13]; h3.z += acc[14]; h3.w += acc[15];
        float ss = h0.x * h0.x + h0.y * h0.y + h0.z * h0.z + h0.w * h0.w + h1.x * h1.x + h1.y * h1.y + h1.z * h1.z + h1.w * h1.w
                 + h2.x * h2.x + h2.y * h2.y + h2.z * h2.z + h2.w * h2.w + h3.x * h3.x + h3.y * h3.y + h3.z * h3.z + h3.w * h3.w;
        ss = wave_sum(ss);
        const float rn = rsqrtf(ss * (1.f / D) + EPS);
        if (l == DEPTH - 1) {
            const float* g = P.norm_final;
            const float4 g0 = *(const float4*)(g + c0), g1 = *(const float4*)(g + c0 + 4), g2 = *(const float4*)(g + c1), g3 = *(const float4*)(g + c1 + 4);
            *(float4*)(hrow + c0) = make_float4(h0.x * rn * g0.x, h0.y * rn * g0.y, h0.z * rn * g0.z, h0.w * rn * g0.w);
            *(float4*)(hrow + c0 + 4) = make_float4(h1.x * rn * g1.x, h1.y * rn * g1.y, h1.z * rn * g1.z, h1.w * rn * g1.w);
            *(float4*)(hrow + c1) = make_float4(h2.x * rn * g2.x, h2.y * rn * g2.y, h2.z * rn * g2.z, h2.w * rn * g2.w);
            *(float4*)(hrow + c1 + 4) = make_float4(h3.x * rn * g3.x, h3.y * rn * g3.y, h3.z * rn * g3.z, h3.w * rn * g3.w);
        } else {
            *(float4*)(hrow + c0) = h0; *(float4*)(hrow + c0 + 4) = h1; *(float4*)(hrow + c1) = h2; *(float4*)(hrow + c1 + 4) = h3;
            const float* g = P.norm_mix + (l + 1) * D;
            const float4 g0 = *(const float4*)(g + c0), g1 = *(const float4*)(g + c0 + 4), g2 = *(const float4*)(g + c1), g3 = *(const float4*)(g + c1 + 4);
            uint4 o0, o1;
            o0.x = pack2(h0.x * rn * g0.x, h0.y * rn * g0.y); o0.y = pack2(h0.z * rn * g0.z, h0.w * rn * g0.w); o0.z = pack2(h1.x * rn * g1.x, h1.y * rn * g1.y); o0.w = pack2(h1.z * rn * g1.z, h1.w * rn * g1.w);
            o1.x = pack2(h2.x * rn * g2.x, h2.y * rn * g2.y); o1.y = pack2(h2.z * rn * g2.z, h2.w * rn * g2.w); o1.z = pack2(h3.x * rn * g3.x, h3.y * rn * g3.y); o1.w = pack2(h3.z * rn * g3.z, h3.w * rn * g3.w);
            *(uint4*)(XNw + (size_t)t * D + c0) = o0; *(uint4*)(XNw + (size_t)t * D + c1) = o1;
        }
    }
}


constexpr size_t WS_PART = WS_PROJ;
static_assert((size_t)8 * T * HK * 4 <= WS_K - WS_PROJ, "PART alias");
constexpr int XI_X = 0, XI_RANK = 1, XI_J = 2, XI_NX = 3, XI_NLOC = 4;
constexpr int CTL_CENSUS = 4096;
constexpr int CTL_BYTES = (CTL_CENSUS + 16) * 4;

__device__ __forceinline__ float dot16_fp8(const float (&xf)[16], const uint4& r) {
    float d0 = 0.f, d1 = 0.f;
    const unsigned w[4] = {r.x, r.y, r.z, r.w};
#pragma unroll
    for (int q = 0; q < 4; ++q) {
        const auto lo = __builtin_amdgcn_cvt_pk_f32_fp8((int)w[q], false); const auto hh = __builtin_amdgcn_cvt_pk_f32_fp8((int)w[q], true);
        d0 = fmaf(xf[4 * q], lo[0], d0); d1 = fmaf(xf[4 * q + 1], lo[1], d1); d0 = fmaf(xf[4 * q + 2], hh[0], d0); d1 = fmaf(xf[4 * q + 3], hh[1], d1);
    }
    return d0 + d1;
}
template <int M1, int M2, int M3>
__device__ __forceinline__ void red16x3(float (&p)[16], int lane) {
#pragma unroll
    for (int i = 0; i < 8; ++i) { const bool up = lane & M1; const float send = up ? p[i] : p[i + 8], keep = up ? p[i + 8] : p[i]; p[i] = keep + __shfl_xor(send, M1, 64); }
#pragma unroll
    for (int i = 0; i < 4; ++i) { const bool up = lane & M2; const float send = up ? p[i] : p[i + 4], keep = up ? p[i + 4] : p[i]; p[i] = keep + __shfl_xor(send, M2, 64); }
#pragma unroll
    for (int i = 0; i < 2; ++i) { const bool up = lane & M3; const float send = up ? p[i] : p[i + 2], keep = up ? p[i + 2] : p[i]; p[i] = keep + __shfl_xor(send, M3, 64); }
}
__device__ __forceinline__ void phase_gu(const Params& P, int l, const volatile int* xi) {
    const bf16* XN = (const bf16*)(P.ws + WS_XN);
    const int* EXPp = (const int*)(P.ws + WS_EXP);
    float* PART = (float*)(P.ws + WS_PART);
    const int tid = tidx(), lane = tid & 63, w = tid >> 6, g = lane >> 3, c = lane & 7;
    const int j = xi[XI_J], nx = xi[XI_NX], nloc = xi[XI_NLOC], rank = xi[XI_RANK];
    const int t0 = rank * 4 + w, st = nloc * 4;
    const int n = (t0 < T) ? (T - t0 + st - 1) / st : 0;
    const int i0 = 8 * (c & 1) + 4 * ((c >> 1) & 1) + 2 * ((c >> 2) & 1);
    for (int sl = j; sl < 8 && n > 0; sl += nx) {
        const unsigned char* Us = P.ws + WS_TABU + ((size_t)(l * 8 + sl) * NEXP) * 128 + c * 16;
        float* part = PART + (size_t)sl * T * HK;
        const bf16* xs = XN + sl * 128 + c * 16;
#define GU_TK(k) (t0 + (((k) < n) ? (k) : (n - 1)) * st)
#define GU_LOADE(S, t) do { S##lo = EXPp[(size_t)(t) * HK + lane]; S##hi = EXPp[(size_t)(t) * HK + 64 + lane]; } while (0)
#define GU_LOADX(S, t) do { S##a = *(const uint4*)(xs + (size_t)(t) * D); S##b = *(const uint4*)(xs + (size_t)(t) * D + 8); } while (0)
#define GU_ISSUE(R, S) do { _Pragma("unroll") for (int i = 0; i < 16; ++i) { \
            const int e = __builtin_amdgcn_ds_bpermute((((8 * i) & 63) + g) << 2, (i < 8) ? S##lo : S##hi); R[i] = *(const uint4*)(Us + (size_t)e * 128); } } while (0)
#define GU_FINISH(R, S, t) do { \
            float xf[16]; \
            xf[0] = bflo(S##a.x); xf[1] = bfhi(S##a.x); xf[2] = bflo(S##a.y); xf[3] = bfhi(S##a.y); xf[4] = bflo(S##a.z); xf[5] = bfhi(S##a.z); xf[6] = bflo(S##a.w); xf[7] = bfhi(S##a.w); \
            xf[8] = bflo(S##b.x); xf[9] = bfhi(S##b.x); xf[10] = bflo(S##b.y); xf[11] = bfhi(S##b.y); xf[12] = bflo(S##b.z); xf[13] = bfhi(S##b.z); xf[14] = bflo(S##b.w); xf[15] = bfhi(S##b.w); \
            float p[16]; \
            _Pragma("unroll") for (int i = 0; i < 16; ++i) { p[i] = dot16_fp8(xf, R[i]); __builtin_amdgcn_sched_barrier(0); } \
            red16x3<1, 2, 4>(p, lane); \
            part[(size_t)(t) * HK + 8 * i0 + g] = p[0]; part[(size_t)(t) * HK + 8 * (i0 + 1) + g] = p[1]; } while (0)
        int eAlo, eAhi, eBlo, eBhi; uint4 xAa, xAb, xBa, xBb; uint4 rA[16], rB[16];
        GU_LOADE(eA, GU_TK(0)); GU_LOADX(xA, GU_TK(0)); GU_LOADE(eB, GU_TK(1));
        GU_ISSUE(rA, eA);
        for (int k = 0; k < n; k += 2) {
            GU_LOADX(xB, GU_TK(k + 1)); GU_ISSUE(rB, eB); GU_LOADE(eA, GU_TK(k + 2));
            GU_FINISH(rA, xA, GU_TK(k));
            GU_LOADX(xA, GU_TK(k + 2)); GU_ISSUE(rA, eA); GU_LOADE(eB, GU_TK(k + 3));
            GU_FINISH(rB, xB, GU_TK(k + 1));
        }
#undef GU_TK
#undef GU_LOADE
#undef GU_LOADX
#undef GU_ISSUE
#undef GU_FINISH
    }
}
__device__ __forceinline__ void phase_gw(const Params& P, int l) {
    const int* EXPp = (const int*)(P.ws + WS_EXP);
    float* GATEp = (float*)(P.ws + WS_GATE);
    const float* PART = (const float*)(P.ws + WS_PART);
    const float* SU = (const float*)(P.ws + WS_TSCU) + (size_t)l * NEXP;
    const float* SV = (const float*)(P.ws + WS_TSCV) + (size_t)l * NEXP;
    for (size_t i = gtid(); i < (size_t)T * HK; i += gnth()) {
        float s = 0.f;
#pragma unroll
        for (int x = 0; x < 8; ++x) s += PART[(size_t)x * T * HK + i];
        const int e = EXPp[i];
        GATEp[i] = GATEp[i] * gelu_exact(s * SU[e]) * SV[e];
    }
}
__device__ __forceinline__ void phase_gv(const Params& P, int l, const volatile int* xi) {
    const int* EXPp = (const int*)(P.ws + WS_EXP);
    const float* WGT = (const float*)(P.ws + WS_GATE);
    const int tid = tidx(), lane = tid & 63, w = tid >> 6, g = lane >> 3, c = lane & 7;
    const int j = xi[XI_J], nx = xi[XI_NX], nloc = xi[XI_NLOC], rank = xi[XI_RANK];
    const int t0 = rank * 4 + w, st = nloc * 4;
    const int n = (t0 < T) ? (T - t0 + st - 1) / st : 0;
    const int j0 = 8 * (g & 1) + 4 * ((g >> 1) & 1) + 2 * ((g >> 2) & 1);
    for (int sl = j; sl < 8 && n > 0; sl += nx) {
        const unsigned char* Vs = P.ws + WS_TABV + ((size_t)(l * 8 + sl) * NEXP) * 128 + c * 16;
        float* hcol = P.out + sl * 128 + c * 16 + j0;
#define GV_TK(k) (t0 + (((k) < n) ? (k) : (n - 1)) * st)
#define GV_LOADE(S, t) do { S##el = EXPp[(size_t)(t) * HK + lane]; S##eh = EXPp[(size_t)(t) * HK + 64 + lane]; \
            S##wl = __float_as_int(WGT[(size_t)(t) * HK + lane]); S##wh = __float_as_int(WGT[(size_t)(t) * HK + 64 + lane]); } while (0)
#define GV_ISSUE(R, W, ESEL, WSEL) do { _Pragma("unroll") for (int i = 0; i < 8; ++i) { const int src = (8 * i + g) << 2; \
            const int e = __builtin_amdgcn_ds_bpermute(src, ESEL); W[i] = __int_as_float(__builtin_amdgcn_ds_bpermute(src, WSEL)); R[i] = *(const uint4*)(Vs + (size_t)e * 128); } } while (0)
#define GV_FINISH(R, W) do { _Pragma("unroll") for (int i = 0; i < 8; ++i) { const unsigned ww[4] = {R[i].x, R[i].y, R[i].z, R[i].w}; \
            _Pragma("unroll") for (int q = 0; q < 4; ++q) { \
                const auto lo = __builtin_amdgcn_cvt_pk_f32_fp8((int)ww[q], false); const auto hh = __builtin_amdgcn_cvt_pk_f32_fp8((int)ww[q], true); \
                acc[4 * q] = fmaf(W[i], lo[0], acc[4 * q]); acc[4 * q + 1] = fmaf(W[i], lo[1], acc[4 * q + 1]); acc[4 * q + 2] = fmaf(W[i], hh[0], acc[4 * q + 2]); acc[4 * q + 3] = fmaf(W[i], hh[1], acc[4 * q + 3]); } __builtin_amdgcn_sched_barrier(0); } } while (0)
        int Cel, Ceh, Cwl, Cwh, Nel, Neh, Nwl, Nwh, Fel, Feh, Fwl, Fwh;
        uint4 r0[8], r1[8]; float wk0[8], wk1[8];
        GV_LOADE(C, GV_TK(0)); GV_LOADE(N, GV_TK(1));
        GV_ISSUE(r0, wk0, Cel, Cwl);
        for (int k = 0; k < n; ++k) {
            const int t = GV_TK(k);
            GV_ISSUE(r1, wk1, Ceh, Cwh);
            float2* hp = (float2*)(hcol + (size_t)t * D);
            const float2 hv = *hp;
            GV_LOADE(F, GV_TK(k + 2));
            float acc[16];
#pragma unroll
            for (int q = 0; q < 16; ++q) acc[q] = 0.f;
            GV_FINISH(r0, wk0);
            GV_ISSUE(r0, wk0, Nel, Nwl);
            GV_FINISH(r1, wk1);
            red16x3<8, 16, 32>(acc, lane);
            *hp = make_float2(hv.x + acc[0], hv.y + acc[1]);
            Cel = Nel; Ceh = Neh; Cwl = Nwl; Cwh = Nwh; Nel = Fel; Neh = Feh; Nwl = Fwl; Nwh = Fwh;
        }
#undef GV_TK
#undef GV_LOADE
#undef GV_ISSUE
#undef GV_FINISH
    }
}
__device__ __forceinline__ void phase_gnorm(const Params& P, int l) {
    const int lane = tidx() & 63;
    bf16* XNw = (bf16*)(P.ws + WS_XN);
    for (int t = gwave(); t < T; t += nwave()) {
        float4* hr = (float4*)(P.out + (size_t)t * D);
        float4 v[4]; float ss = 0.f;
#pragma unroll
        for (int q = 0; q < 4; ++q) { v[q] = hr[q * 64 + lane]; ss += v[q].x * v[q].x + v[q].y * v[q].y + v[q].z * v[q].z + v[q].w * v[q].w; }
        ss = wave_sum(ss);
        const float rn = rsqrtf(ss * (1.f / D) + EPS);
        const float4* g = (const float4*)((l == DEPTH - 1) ? P.norm_final : (P.norm_mix + (l + 1) * D));
#pragma unroll
        for (int q = 0; q < 4; ++q) {
            const float4 gg = g[q * 64 + lane];
            const float4 o = make_float4(v[q].x * rn * gg.x, v[q].y * rn * gg.y, v[q].z * rn * gg.z, v[q].w * rn * gg.w);
            if (l == DEPTH - 1) hr[q * 64 + lane] = o;
            else { uint2 u; u.x = pack2(o.x, o.y); u.y = pack2(o.z, o.w); ((uint2*)(XNw + (size_t)t * D))[q * 64 + lane] = u; }
        }
    }
}

#define XB_TMO      128
#define XB_XCNT(j)  (256  + 64 * (j))
#define XB_XSUB(j)  (1280 + 64 * (j))
#define XB_XGEN(j)  (2304 + 64 * (j))
#define XB_TOP      3328
#define XB_TOPGEN   3392
#define XCD_BAR_WORDS 3456
#define XB_SPIN_CAP (1u << 22)
#define LAS __attribute__((address_space(3)))
__device__ __forceinline__ unsigned xb_ld(unsigned* p)              { return __hip_atomic_load(p, __ATOMIC_RELAXED, __HIP_MEMORY_SCOPE_AGENT); }
__device__ __forceinline__ unsigned xb_add(unsigned* p, unsigned v) { return __hip_atomic_fetch_add(p, v, __ATOMIC_RELAXED, __HIP_MEMORY_SCOPE_AGENT); }
__device__ __forceinline__ unsigned xb_xcc_id() { return (unsigned)__builtin_amdgcn_s_getreg((3 << 11) | 20) & 0xFu; }
#define XB_SPIN(cond, bar) do { unsigned _sp = 0; while (cond) { __builtin_amdgcn_s_sleep(1); \
    if ((++_sp & 255u) == 0u) { if (xb_ld(&(bar)[XB_TMO])) break; if (_sp > XB_SPIN_CAP) { atomicAdd(&(bar)[XB_TMO], 1u); break; } } } } while (0)
struct XcdBarrier { unsigned* bar; unsigned x; volatile LAS unsigned* st; };
__device__ __forceinline__ XcdBarrier xcd_barrier_post(unsigned* bar, volatile LAS unsigned* st) {
    XcdBarrier b; b.bar = bar; b.x = xb_xcc_id(); b.st = st;
    if (__builtin_amdgcn_workitem_id_x() == 0) (void)xb_add(&bar[XB_XCNT(b.x)], 1u);
    return b;
}
__device__ __forceinline__ void xcd_barrier_complete(unsigned* bar, unsigned x, unsigned& nloc, unsigned& nx) {
    const unsigned G = gridDim.x * gridDim.y * gridDim.z;
    unsigned sum, cnt, mine, sp = 0u;
    for (;;) {
        sum = 0u; cnt = 0u; mine = 0u;
#pragma unroll
        for (unsigned j = 0; j < 16; ++j) { const unsigned c = xb_ld(&bar[XB_XCNT(j)]); sum += c; cnt += (c > 0u) ? 1u : 0u; mine = (j == x) ? c : mine; }
        if (sum == G) break;
        __builtin_amdgcn_s_sleep(1);
        if ((++sp & 255u) == 0u) { if (xb_ld(&bar[XB_TMO])) break; if (sp > XB_SPIN_CAP) { atomicAdd(&bar[XB_TMO], 1u); break; } }
    }
    nloc = mine > 0u ? mine : 1u; nx = cnt > 0u ? cnt : 1u;
}
__device__ __forceinline__ void xcd_barrier(const XcdBarrier& b) {
    asm volatile("s_waitcnt vmcnt(0)" ::: "memory");
    __syncthreads();
    if (__builtin_amdgcn_workitem_id_x() == 0) {
        unsigned* bar = b.bar;
        __builtin_amdgcn_s_waitcnt(0);
        unsigned nloc = b.st[0], nx = b.st[1];
        if (nloc == 0u) { xcd_barrier_complete(bar, b.x, nloc, nx); b.st[0] = nloc; b.st[1] = nx; }
        const unsigned old = xb_add(&bar[XB_XSUB(b.x)], 1u);
        const unsigned gen = old / nloc;
        if (old + 1u == (gen + 1u) * nloc) {
            __builtin_amdgcn_fence(__ATOMIC_RELEASE, "agent");
            asm volatile("s_waitcnt vmcnt(0)" ::: "memory");
            const unsigned og = xb_add(&bar[XB_TOP], 1u);
            const unsigned tg = og / nx;
            if (og + 1u == (tg + 1u) * nx) xb_add(&bar[XB_TOPGEN], 1u);
            else XB_SPIN(xb_ld(&bar[XB_TOPGEN]) == tg, bar);
            __builtin_amdgcn_fence(__ATOMIC_ACQUIRE, "agent");
            xb_add(&bar[XB_XGEN(b.x)], 1u);
            asm volatile("s_waitcnt vmcnt(0)" ::: "memory");
        } else {
            XB_SPIN(xb_ld(&bar[XB_XGEN(b.x)]) == gen, bar);
            __builtin_amdgcn_fence(__ATOMIC_ACQUIRE, "agent");
            asm volatile("s_waitcnt vmcnt(0)" ::: "memory");
        }
    }
    __syncthreads();
}

constexpr float QSCALE = 0.10206207261596575f * 1.4426950408889634f;

__device__ __forceinline__ void phase_gemm1(const Params& P, int l, char* lds) {
    unsigned char* ws = P.ws;
    const bf16* XN = (const bf16*)(ws + WS_XN);
    bf16* PROJ = (bf16*)(ws + WS_PROJ);
    bf16* Kb = (bf16*)(ws + WS_K);
    const float* rope = (const float*)(ws + WS_ROPE);
    const bf16* W = (const bf16*)(ws + WS_WIN) + (size_t)l * DINP * D;
    gemm_t<false>(W, D, DINP, XN, D, T, D, [&](int n0, int t0, const f32x16& acc, int r32, int hi, float) {
        const int t = t0 + r32;
        if (n0 < C_KR) {
            bf16* pr = PROJ + (size_t)t * DINP + n0 + 4 * hi;
#pragma unroll
            for (int g = 0; g < 4; ++g) { uint2 o; o.x = cvtpk(acc[4 * g], acc[4 * g + 1]); o.y = cvtpk(acc[4 * g + 2], acc[4 * g + 3]); *(uint2*)(pr + 8 * g) = o; }
        } else if (n0 == C_KR) {
            const int b = t / S, s = t % S;
            uint2 o1[2], o2[2];
#pragma unroll
            for (int g = 0; g < 2; ++g) {
                const float4 cs0 = *(const float4*)(rope + ((size_t)s * 16 + 8 * g + 4 * hi) * 2), cs1 = *(const float4*)(rope + ((size_t)s * 16 + 8 * g + 4 * hi) * 2 + 4);
                const float x10 = acc[4 * g], x11 = acc[4 * g + 1], x12 = acc[4 * g + 2], x13 = acc[4 * g + 3];
                const float x20 = acc[8 + 4 * g], x21 = acc[8 + 4 * g + 1], x22 = acc[8 + 4 * g + 2], x23 = acc[8 + 4 * g + 3];
                o1[g].x = cvtpk(x10 * cs0.x - x20 * cs0.y, x11 * cs0.z - x21 * cs0.w); o1[g].y = cvtpk(x12 * cs1.x - x22 * cs1.y, x13 * cs1.z - x23 * cs1.w);
                o2[g].x = cvtpk(x20 * cs0.x + x10 * cs0.y, x21 * cs0.z + x11 * cs0.w); o2[g].y = cvtpk(x22 * cs1.x + x12 * cs1.y, x23 * cs1.z + x13 * cs1.w);
            }
#pragma unroll
            for (int h = 0; h < NH; ++h) {
                bf16* kr = Kb + ((size_t)(b * NH + h) * S + s) * DQK + 64 + 4 * hi;
                *(uint2*)(kr) = o1[0]; *(uint2*)(kr + 8) = o1[1]; *(uint2*)(kr + 16) = o2[0]; *(uint2*)(kr + 24) = o2[1];
            }
        }
    }, lds);
}
__device__ __forceinline__ void phase_gemm2(const Params& P, int l, char* lds) {
    unsigned char* ws = P.ws;
    const bf16* PROJ = (const bf16*)(ws + WS_PROJ);
    const float* rope = (const float*)(ws + WS_ROPE);
    {
        const bf16* W = (const bf16*)(ws + WS_WUQ) + (size_t)l * 768 * QR;
        bf16* Qb = (bf16*)(ws + WS_Q);
        gemm_t<true>(W, QR, 768, PROJ + C_CQ, DINP, T, QR, [&](int n0, int t0, const f32x16& acc, int r32, int hi, float ssq) {
            const int t = t0 + r32, b = t / S, s = t % S;
            const int h = n0 / DQK, d0 = n0 % DQK;
            const float sc = rsqrtf(ssq * (1.f / QR) + EPS) * QSCALE;
            bf16* qb = Qb + ((size_t)(b * NH + h) * S + s) * DQK + d0 + 4 * hi;
            if (d0 == 64) {
#pragma unroll
                for (int g = 0; g < 2; ++g) {
                    const float4 cs0 = *(const float4*)(rope + ((size_t)s * 16 + 8 * g + 4 * hi) * 2), cs1 = *(const float4*)(rope + ((size_t)s * 16 + 8 * g + 4 * hi) * 2 + 4);
                    const float x10 = acc[4 * g] * sc, x11 = acc[4 * g + 1] * sc, x12 = acc[4 * g + 2] * sc, x13 = acc[4 * g + 3] * sc;
                    const float x20 = acc[8 + 4 * g] * sc, x21 = acc[8 + 4 * g + 1] * sc, x22 = acc[8 + 4 * g + 2] * sc, x23 = acc[8 + 4 * g + 3] * sc;
                    uint2 o1, o2;
                    o1.x = cvtpk(x10 * cs0.x - x20 * cs0.y, x11 * cs0.z - x21 * cs0.w); o1.y = cvtpk(x12 * cs1.x - x22 * cs1.y, x13 * cs1.z - x23 * cs1.w);
                    o2.x = cvtpk(x20 * cs0.x + x10 * cs0.y, x21 * cs0.z + x11 * cs0.w); o2.y = cvtpk(x22 * cs1.x + x12 * cs1.y, x23 * cs1.z + x13 * cs1.w);
                    *(uint2*)(qb + 8 * g) = o1; *(uint2*)(qb + 16 + 8 * g) = o2;
                }
            } else {
#pragma unroll
                for (int g = 0; g < 4; ++g) { uint2 o; o.x = cvtpk(acc[4 * g] * sc, acc[4 * g + 1] * sc); o.y = cvtpk(acc[4 * g + 2] * sc, acc[4 * g + 3] * sc); *(uint2*)(qb + 8 * g) = o; }
            }
        }, lds);
    }
    {
        const bf16* W = (const bf16*)(ws + WS_WUKV) + (size_t)l * 1024 * KVR;
        bf16* Kb = (bf16*)(ws + WS_K); bf16* Vb = (bf16*)(ws + WS_V);
        gemm_t<true>(W, KVR, 1024, PROJ + C_CKV, DINP, T, KVR, [&](int n0, int t0, const f32x16& acc, int r32, int hi, float ssq) {
            const int t = t0 + r32, b = t / S, s = t % S;
            const float sc = rsqrtf(ssq * (1.f / KVR) + EPS);
            bf16* dst;
            if (n0 < 512) dst = Kb + ((size_t)(b * NH + (n0 >> 6)) * S + s) * DQK + (n0 & 63) + 4 * hi;
            else          dst = Vb + ((size_t)(b * NH + ((n0 - 512) >> 6)) * S + s) * DV + (n0 & 63) + 4 * hi;
#pragma unroll
            for (int g = 0; g < 4; ++g) { uint2 o; o.x = cvtpk(acc[4 * g] * sc, acc[4 * g + 1] * sc); o.y = cvtpk(acc[4 * g + 2] * sc, acc[4 * g + 3] * sc); *(uint2*)(dst + 8 * g) = o; }
        }, lds);
    }
}
__device__ __forceinline__ void phase_gemm3(const Params& P, int l, char* lds) {
    unsigned char* ws = P.ws;
    const bf16* Yb = (const bf16*)(ws + WS_XN);
    const bf16* W = (const bf16*)(ws + WS_WOUT) + (size_t)l * D * D;
    const float* hin = (l == 0) ? P.x : P.out;
    float* out = P.out;
    gemm_t<false>(W, D, D, Yb, D, T, D, [&](int n0, int t0, const f32x16& acc, int r32, int hi, float) {
        const size_t base = (size_t)(t0 + r32) * D + n0 + 4 * hi;
#pragma unroll
        for (int g = 0; g < 4; ++g) {
            const float4 hv = *(const float4*)(hin + base + 8 * g);
            *(float4*)(out + base + 8 * g) = make_float4(hv.x + acc[4 * g], hv.y + acc[4 * g + 1], hv.z + acc[4 * g + 2], hv.w + acc[4 * g + 3]);
        }
    }, lds);
}

#define GSYNC() do { XcdBarrier xb_; xb_.bar = (unsigned*)(P.ws + WS_CTL); xb_.x = xb_xcc_id(); xb_.st = (volatile LAS unsigned*)&xb_words; xcd_barrier(xb_); } while (0)
#define PHASE(stmt) { const Params Q = launder(P); stmt; }
__global__ void __launch_bounds__(NTHREADS, 2) k_all(Params P) {
    __shared__ __attribute__((aligned(16))) char sm[LDS_TOTAL];
    __shared__ uint4 xb_words;
    cg::grid_group grid = cg::this_grid();
    if (__builtin_amdgcn_workitem_id_x() == 0) xb_words = make_uint4(0u, 0u, 0u, 0u);
    __syncthreads();
    (void)xcd_barrier_post((unsigned*)(P.ws + WS_CTL), (volatile LAS unsigned*)&xb_words);
    __shared__ int xinfo[8];
    if (__builtin_amdgcn_workitem_id_x() == 0) {
        const unsigned x = xb_xcc_id();
        xinfo[XI_X] = (int)x; xinfo[XI_RANK] = (int)xb_add((unsigned*)(P.ws + WS_CTL) + CTL_CENSUS + x, 1u);
    }
    PHASE(phase_prep(Q, sm));
    PHASE(phase_norm(Q.x, Q.norm_mix, (bf16*)(Q.ws + WS_XN)));
    grid.sync();
    if (__builtin_amdgcn_workitem_id_x() == 0) {
        unsigned* cen = (unsigned*)(P.ws + WS_CTL) + CTL_CENSUS;
        const int x = xinfo[XI_X]; int nx = 0, jj = 0;
        for (int q = 0; q < 16; ++q) { const unsigned cq = xb_ld(cen + q); if (cq) { if (q < x) ++jj; ++nx; } }
        xinfo[XI_J] = jj; xinfo[XI_NX] = nx; xinfo[XI_NLOC] = (int)xb_ld(cen + x);
    }
    __syncthreads();
    for (int l = 0; l < DEPTH; ++l) {
        PHASE(phase_gemm1(Q, l, sm));
#if PROBE_DUP & 2
        PHASE(phase_gemm1(Q, l, sm));
#endif
        GSYNC();
        PHASE(phase_mixlocal(Q, l, sm));
#if PROBE_DUP & 256
        PHASE(phase_mixlocal(Q, l, sm));
#endif
        PHASE(phase_gemm2(Q, l, sm));
        GSYNC();
        PHASE(phase_attn(Q, sm));
        GSYNC();
        PHASE(phase_gemm3(Q, l, sm));
#if PROBE_DUP & 16
        if (l == 0) PHASE(phase_gemm3(Q, l, sm));
#endif
        GSYNC();
        PHASE(phase_norm(Q.out, Q.norm_ffn + l * D, (bf16*)(Q.ws + WS_XN)));
        GSYNC();
        PHASE(phase_route(Q, l, sm));
        GSYNC();
        PHASE(phase_gu(Q, l, xinfo));
        GSYNC();
        PHASE(phase_gw(Q, l));
        GSYNC();
        PHASE(phase_gv(Q, l, xinfo));
        GSYNC();
        PHASE(phase_gnorm(Q, l));
        GSYNC();
    }
}

extern "C" void kernel_launch(void* const* d_in, const int* in_sizes, int n_in, void* d_out, int out_size, void* d_ws, size_t ws_size, hipStream_t stream) {
    static int grid = 0;
    if (grid == 0) {
        if (n_in != 18 || out_size != T * D || ws_size < WS_END) { fprintf(stderr, "kernel_launch: bad sizes n_in %d out %d ws %zu need %zu\n", n_in, out_size, ws_size, (size_t)WS_END); grid = -1; return; }
        int dev = 0, cus = 0, per_cu = 0;
        (void)hipGetDevice(&dev);
        (void)hipDeviceGetAttribute(&cus, hipDeviceAttributeMultiprocessorCount, dev);
        (void)hipOccupancyMaxActiveBlocksPerMultiprocessor(&per_cu, (const void*)k_all, NTHREADS, 0);
        if (per_cu > 2) per_cu = 2;
        if (per_cu < 1) { fprintf(stderr, "kernel_launch: occupancy query says %d\n", per_cu); grid = -1; return; }
        grid = cus * per_cu;
    }
    if (grid < 0) return;
    Params p{};
    p.x = (const float*)d_in[0]; p.norm_mix = (const float*)d_in[1]; p.w_in = (const float*)d_in[2]; p.conv_w = (const float*)d_in[3];
    p.pool_w = (const float*)d_in[4]; p.pool_scale = (const float*)d_in[5]; p.q_norm = (const float*)d_in[6]; p.w_uq = (const float*)d_in[7];
    p.kv_norm = (const float*)d_in[8]; p.w_uk = (const float*)d_in[9]; p.w_uv = (const float*)d_in[10]; p.w_out = (const float*)d_in[11];
    p.norm_ffn = (const float*)d_in[12]; p.peer_wq = (const float*)d_in[13]; p.peer_subkeys = (const float*)d_in[14]; p.peer_u = (const float*)d_in[15];
    p.peer_v = (const float*)d_in[16]; p.norm_final = (const float*)d_in[17];
    p.out = (float*)d_out; p.ws = (unsigned char*)d_ws;
    if (hipMemsetAsync((char*)d_ws + WS_CTL, 0, CTL_BYTES, stream) != hipSuccess) { fprintf(stderr, "kernel_launch: memset failed\n"); return; }
    void* args[] = {&p};
    hipError_t e = hipLaunchCooperativeKernel((const void*)k_all, dim3(grid), dim3(NTHREADS), args, 0, stream);
    if (e != hipSuccess) fprintf(stderr, "cooperative launch failed: %s (grid %d)\n", hipGetErrorString(e), grid);
}
```

```cpp
#include <hip/hip_runtime.h>
#include <hip/hip_cooperative_groups.h>
#include <cstdio>
#include <cstdint>
namespace cg = cooperative_groups;

#ifndef TAB_FP8
#define TAB_FP8 1
#endif
#ifndef PROBE_DUP
#define PROBE_DUP 0
#endif

constexpr int NB = 4, S = 8192, T = NB * S, D = 1024, DEPTH = 2;
constexpr int DIN = 1696, DINP = 1792;
constexpr int C_BG = 0, C_CG = 256, C_HC = 512, C_HP = 768, C_CQ = 1024, C_CKV = 1408, C_KR = 1664;
constexpr int QR = 384, KVR = 256, NH = 8, DQK = 96, DV = 64;
constexpr int PH = 8, NKEY = 128, NEXP = NKEY * NKEY, TOPK = 16, HK = PH * TOPK;
constexpr float EPS = 1e-6f;
constexpr int LDX = 1088;
constexpr int LDW = 1088;

typedef unsigned short bf16;

constexpr size_t WS_CTL   = 0;
constexpr size_t WS_ROPE  = 64 * 1024;
constexpr size_t WS_WIN   = WS_ROPE + (size_t)S * 16 * 2 * 4;
constexpr size_t WS_WUQ   = WS_WIN + (size_t)DEPTH * DINP * LDW * 2;
constexpr size_t WS_WUKV  = WS_WUQ + (size_t)DEPTH * 768 * QR * 2;
constexpr size_t WS_WOUT  = WS_WUKV + (size_t)DEPTH * 1024 * KVR * 2;
constexpr size_t WS_WPQ   = WS_WOUT + (size_t)DEPTH * D * LDW * 2;
constexpr size_t WS_XN    = ((WS_WPQ + (size_t)DEPTH * 2048 * LDW * 2 + 4095) / 4096) * 4096;
constexpr size_t WS_PROJ  = WS_XN + (size_t)T * LDX * 2;
constexpr size_t WS_Q     = WS_PROJ + (size_t)T * DINP * 2;
constexpr size_t WS_K     = WS_Q + (size_t)T * NH * DQK * 2;
constexpr size_t WS_V     = WS_K + (size_t)T * NH * DQK * 2;
constexpr size_t WS_EXP   = WS_V + (size_t)T * NH * DV * 2;
constexpr size_t WS_GATE  = WS_EXP + (size_t)T * HK * 4;
constexpr size_t TAB_ROWB = TAB_FP8 ? 1024 : 2048;
constexpr size_t WS_TABU  = WS_GATE + (size_t)T * HK * 4;
constexpr size_t WS_TABV  = WS_TABU + (size_t)DEPTH * NEXP * TAB_ROWB;
constexpr size_t WS_TSCU  = WS_TABV + (size_t)DEPTH * NEXP * TAB_ROWB;
constexpr size_t WS_TSCV  = WS_TSCU + (size_t)DEPTH * NEXP * 4;
constexpr size_t WS_END   = WS_TSCV + (size_t)DEPTH * NEXP * 4;
static_assert(WS_END <= (size_t)512 * 1024 * 1024, "workspace budget");

struct Params {
    const float* x; const float* norm_mix; const float* w_in; const float* conv_w; const float* pool_w; const float* pool_scale;
    const float* q_norm; const float* w_uq; const float* kv_norm; const float* w_uk; const float* w_uv; const float* w_out;
    const float* norm_ffn; const float* peer_wq; const float* peer_subkeys; const float* peer_u; const float* peer_v; const float* norm_final;
    float* out; unsigned char* ws;
};

__device__ __forceinline__ bf16 f2bf(float f) { unsigned u = __float_as_uint(f); u += 0x7fffu + ((u >> 16) & 1u); return (bf16)(u >> 16); }
__device__ __forceinline__ float bf2f(bf16 h) { return __uint_as_float(((unsigned)h) << 16); }
__device__ __forceinline__ float bflo(unsigned u) { return __uint_as_float(u << 16); }
__device__ __forceinline__ float bfhi(unsigned u) { return __uint_as_float(u & 0xffff0000u); }
__device__ __forceinline__ unsigned pack2(float a, float b) { return (unsigned)f2bf(a) | ((unsigned)f2bf(b) << 16); }
__device__ __forceinline__ float wave_sum(float v) {
#pragma unroll
    for (int m = 32; m >= 1; m >>= 1) v += __shfl_xor(v, m, 64);
    return v;
}
__device__ __forceinline__ float gelu_exact(float x) { return 0.5f * x * (1.f + erff(x * 0.70710678118654752f)); }

#define NTHREADS 256
__device__ __forceinline__ int tidx() { int t = (int)__builtin_amdgcn_workitem_id_x(); asm volatile("" : "+v"(t)); return t; }
__device__ __forceinline__ int gwave() { return blockIdx.x * (NTHREADS / 64) + (tidx() >> 6); }
__device__ __forceinline__ int nwave() { return gridDim.x * (NTHREADS / 64); }
__device__ __forceinline__ size_t gtid() { return (size_t)blockIdx.x * NTHREADS + tidx(); }
__device__ __forceinline__ size_t gnth() { return (size_t)gridDim.x * NTHREADS; }


__device__ __forceinline__ Params launder(const Params& P) {
    typedef __attribute__((address_space(1))) char* gp_t;
    gp_t g[20] = {(gp_t)(char*)P.x, (gp_t)(char*)P.norm_mix, (gp_t)(char*)P.w_in, (gp_t)(char*)P.conv_w, (gp_t)(char*)P.pool_w, (gp_t)(char*)P.pool_scale, (gp_t)(char*)P.q_norm, (gp_t)(char*)P.w_uq,
                  (gp_t)(char*)P.kv_norm, (gp_t)(char*)P.w_uk, (gp_t)(char*)P.w_uv, (gp_t)(char*)P.w_out, (gp_t)(char*)P.norm_ffn, (gp_t)(char*)P.peer_wq, (gp_t)(char*)P.peer_subkeys,
                  (gp_t)(char*)P.peer_u, (gp_t)(char*)P.peer_v, (gp_t)(char*)P.norm_final, (gp_t)(char*)P.out, (gp_t)(char*)P.ws};
    asm volatile("" : "+s"(g[0]), "+s"(g[1]), "+s"(g[2]), "+s"(g[3]), "+s"(g[4]), "+s"(g[5]), "+s"(g[6]), "+s"(g[7]), "+s"(g[8]), "+s"(g[9]));
    asm volatile("" : "+s"(g[10]), "+s"(g[11]), "+s"(g[12]), "+s"(g[13]), "+s"(g[14]), "+s"(g[15]), "+s"(g[16]), "+s"(g[17]), "+s"(g[18]), "+s"(g[19]));
    Params Q;
    Q.x = (const float*)(char*)g[0]; Q.norm_mix = (const float*)(char*)g[1]; Q.w_in = (const float*)(char*)g[2]; Q.conv_w = (const float*)(char*)g[3]; Q.pool_w = (const float*)(char*)g[4];
    Q.pool_scale = (const float*)(char*)g[5]; Q.q_norm = (const float*)(char*)g[6]; Q.w_uq = (const float*)(char*)g[7]; Q.kv_norm = (const float*)(char*)g[8]; Q.w_uk = (const float*)(char*)g[9];
    Q.w_uv = (const float*)(char*)g[10]; Q.w_out = (const float*)(char*)g[11]; Q.norm_ffn = (const float*)(char*)g[12]; Q.peer_wq = (const float*)(char*)g[13]; Q.peer_subkeys = (const float*)(char*)g[14];
    Q.peer_u = (const float*)(char*)g[15]; Q.peer_v = (const float*)(char*)g[16]; Q.norm_final = (const float*)(char*)g[17]; Q.out = (float*)(char*)g[18]; Q.ws = (unsigned char*)(char*)g[19];
    return Q;
}

typedef __attribute__((ext_vector_type(8))) short bf16x8;
typedef __attribute__((ext_vector_type(16))) float f32x16;
typedef __attribute__((ext_vector_type(2))) __bf16 bf2_t;
#define MFMA32(a, b, c) __builtin_amdgcn_mfma_f32_32x32x16_bf16(a, b, c, 0, 0, 0)
__device__ __forceinline__ int crow(int r, int hi) { return (r & 3) + 8 * (r >> 2) + 4 * hi; }
__device__ __forceinline__ float dot2bf(unsigned a, unsigned b, float c) { return __builtin_amdgcn_fdot2_f32_bf16(__builtin_bit_cast(bf2_t, a), __builtin_bit_cast(bf2_t, b), c, false); }
__device__ __forceinline__ unsigned cvtpk(float lo, float hi) { unsigned r; asm("v_cvt_pk_bf16_f32 %0, %1, %2" : "=v"(r) : "v"(lo), "v"(hi)); return r; }
constexpr int G_OPB = 128 * 128;
constexpr int G_BUF = 2 * G_OPB;
constexpr int GEMM_LDS = 2 * G_BUF;
constexpr int LDS_TOTAL = GEMM_LDS + 8192;

template <int WT, bool ROWSS>
__device__ __forceinline__ void gemm_kloop(const bf16* __restrict__ Ag0, int lda, const bf16* __restrict__ Bg0, int ldb, int nk, f32x16 (&acc)[4], float (&ss)[4], char* lds, int tid) {
    const int lane = tid & 63, w = __builtin_amdgcn_readfirstlane(tid >> 6), r32 = lane & 31, hi = lane >> 5;
    const int srow = 8 * w + (lane >> 3);
    const int sch = (lane & 7) ^ ((srow >> 1) & 7);
    const bf16* Ag = Ag0 + (size_t)srow * lda + sch * 8;
    const bf16* Bg = Bg0 + (size_t)srow * ldb + sch * 8;
#pragma unroll
    for (int i = 0; i < 4; ++i)
#pragma unroll
        for (int r = 0; r < 16; ++r) acc[i][r] = 0.f;
    ss[0] = 0.f; ss[1] = 0.f; ss[2] = 0.f; ss[3] = 0.f;
    typedef __attribute__((address_space(3))) unsigned* ldsp_t;
    typedef const __attribute__((address_space(1))) unsigned* glbp_t;
#define G_DMA(buf, kofs) do { char* d_ = lds + (buf) * G_BUF + (8 * w) * 128; \
    _Pragma("unroll") for (int i = 0; i < 4; ++i) { \
        __builtin_amdgcn_global_load_lds((glbp_t)(const void*)(Ag + (size_t)(32 * i) * lda + (kofs)), (ldsp_t)(void*)(d_ + i * 4096), 16, 0, 0); \
        __builtin_amdgcn_global_load_lds((glbp_t)(const void*)(Bg + (size_t)(32 * i) * ldb + (kofs)), (ldsp_t)(void*)(d_ + G_OPB + i * 4096), 16, 0, 0); } } while (0)
    const int xr = (r32 >> 1) & 7;
    const int o0 = ((0 + hi) ^ xr) << 4, o1 = ((2 + hi) ^ xr) << 4, o2 = ((4 + hi) ^ xr) << 4, o3 = ((6 + hi) ^ xr) << 4;
#define G_SS(s_, r_) do { union { bf16x8 v; uint4 u; } c_; c_.v = r_; s_ = dot2bf(c_.u.x, c_.u.x, s_); s_ = dot2bf(c_.u.y, c_.u.y, s_); s_ = dot2bf(c_.u.z, c_.u.z, s_); s_ = dot2bf(c_.u.w, c_.u.w, s_); } while (0)
#define G_STEP(pa, pb, off) do { \
    if (WT == 0) { \
        const bf16x8 a0 = *(const bf16x8*)(pa + off), a1 = *(const bf16x8*)(pa + 32 * 128 + off); \
        const bf16x8 b0 = *(const bf16x8*)(pb + off), b1 = *(const bf16x8*)(pb + 32 * 128 + off); \
        if (ROWSS) { G_SS(ss[0], b0); G_SS(ss[1], b1); } \
        acc[0] = MFMA32(a0, b0, acc[0]); acc[1] = MFMA32(a0, b1, acc[1]); \
        acc[2] = MFMA32(a1, b0, acc[2]); acc[3] = MFMA32(a1, b1, acc[3]); \
    } else { \
        const bf16x8 b0 = *(const bf16x8*)(pb + off); \
        const bf16x8 a0 = *(const bf16x8*)(pa + off), a1 = *(const bf16x8*)(pa + 32 * 128 + off); \
        const bf16x8 a2 = *(const bf16x8*)(pa + 64 * 128 + off), a3 = *(const bf16x8*)(pa + 96 * 128 + off); \
        acc[0] = MFMA32(a0, b0, acc[0]); acc[1] = MFMA32(a1, b0, acc[1]); \
        acc[2] = MFMA32(a2, b0, acc[2]); acc[3] = MFMA32(a3, b0, acc[3]); \
    } } while (0)
    const int arow = (WT == 0) ? ((w >> 1) * 64 + r32) : r32;
    const int brow = (WT == 0) ? ((w & 1) * 64 + r32) : (w * 32 + r32);
    G_DMA(0, 0);
    for (int kt = 0; kt < nk; ++kt) {
        __syncthreads();
        if (kt + 1 < nk) G_DMA((kt + 1) & 1, (kt + 1) * 64);
        const char* pa = lds + (kt & 1) * G_BUF + arow * 128;
        const char* pb = lds + (kt & 1) * G_BUF + G_OPB + brow * 128;
        G_STEP(pa, pb, o0); G_STEP(pa, pb, o1); G_STEP(pa, pb, o2); G_STEP(pa, pb, o3);
    }
    if (ROWSS) { ss[0] += __shfl_xor(ss[0], 32, 64); ss[1] += __shfl_xor(ss[1], 32, 64); }
#undef G_DMA
#undef G_SS
#undef G_STEP
}

constexpr int ST_P = 68;
static_assert(4 * 64 * ST_P * 4 <= LDS_TOTAL, "staging LDS");
template <bool ROWSS, class EPI, class EPIROW>
__device__ __forceinline__ void gemm_t(const bf16* __restrict__ Wt, int ldw, int N, const bf16* __restrict__ X, int ldx, int M, int K, int tn_direct, EPI epi, EPIROW epirow, char* lds) {
    const int tid = tidx(), lane = tid & 63, w = tid >> 6, r32 = lane & 31, hi = lane >> 5;
    const int tilesN = N / 128, tilesM = M / 128, nk = K / 64;
    for (int tile = blockIdx.x; tile < tilesM * tilesN; tile += gridDim.x) {
        const int tm = tile / tilesN, tn = tile % tilesN;
        f32x16 acc[4]; float ss[4];
        gemm_kloop<0, ROWSS>(Wt + (size_t)(tn * 128) * ldw, ldw, X + (size_t)(tm * 128) * ldx, ldx, nk, acc, ss, lds, tid);
        if (tn < tn_direct) {
            __syncthreads();
            float* st = (float*)lds + w * (64 * ST_P);
#pragma unroll
            for (int i = 0; i < 2; ++i)
#pragma unroll
                for (int j = 0; j < 2; ++j)
#pragma unroll
                    for (int g = 0; g < 4; ++g)
                        *(float4*)(st + (32 * j + r32) * ST_P + 32 * i + 8 * g + 4 * hi) = make_float4(acc[i * 2 + j][4 * g], acc[i * 2 + j][4 * g + 1], acc[i * 2 + j][4 * g + 2], acc[i * 2 + j][4 * g + 3]);
            const int rr = lane >> 4, ch = lane & 15;
#pragma unroll 4
            for (int it = 0; it < 16; ++it) {
                const int row = it * 4 + rr;
                const float4 v = *(const float4*)(st + row * ST_P + ch * 4);
                epirow(tm * 128 + (w & 1) * 64 + row, tn * 128 + (w >> 1) * 64 + ch * 4, v);
            }
        } else {
#pragma unroll
            for (int i = 0; i < 2; ++i)
#pragma unroll
                for (int j = 0; j < 2; ++j) {
                    const int tl = (w & 1) * 64 + j * 32;
                    epi(tn * 128 + (w >> 1) * 64 + i * 32, tm * 128 + tl, acc[i * 2 + j], r32, hi, ss[j]);
                }
        }
        __syncthreads();
    }
}

__device__ __forceinline__ void transpose_tiled(const float* __restrict__ W, bf16* __restrict__ Wt, int K, int N, int Npad, int ldk, const float* __restrict__ gain, char* lds) {
    float (*tl)[65] = (float (*)[65])lds;
    const int tid = tidx(), a = tid & 63, q = tid >> 6;
    const int tK = K / 64, tN = Npad / 64;
    for (int tile = blockIdx.x; tile < tK * tN; tile += gridDim.x) {
        const int k0 = (tile / tN) * 64, n0 = (tile % tN) * 64;
#pragma unroll 4
        for (int i = 0; i < 16; ++i) {
            const int k = k0 + q * 16 + i, n = n0 + a;
            float v = (n < N) ? W[(size_t)k * N + n] : 0.f;
            if (gain) v *= gain[k];
            tl[q * 16 + i][a] = v;
        }
        __syncthreads();
#pragma unroll 4
        for (int i = 0; i < 16; ++i) { const int nl = q * 16 + i; Wt[(size_t)(n0 + nl) * ldk + k0 + a] = f2bf(tl[a][nl]); }
        __syncthreads();
    }
}

__device__ __forceinline__ void quant_row(const float4 (&v)[4], unsigned char* __restrict__ dst, float* __restrict__ scl, int r, int lane) {
    float am = 0.f;
#pragma unroll
    for (int j = 0; j < 4; ++j) am = fmaxf(am, fmaxf(fmaxf(fabsf(v[j].x), fabsf(v[j].y)), fmaxf(fabsf(v[j].z), fabsf(v[j].w))));
#pragma unroll
    for (int m = 32; m >= 1; m >>= 1) am = fmaxf(am, __shfl_xor(am, m, 64));
    const float sc = (am > 0.f) ? am * (1.f / 448.f) : 1.f;
    const float is = 1.f / sc;
    uint4 o;
    { int w = 0; w = __builtin_amdgcn_cvt_pk_fp8_f32(v[0].x * is, v[0].y * is, w, false); w = __builtin_amdgcn_cvt_pk_fp8_f32(v[0].z * is, v[0].w * is, w, true); o.x = (unsigned)w; }
    { int w = 0; w = __builtin_amdgcn_cvt_pk_fp8_f32(v[1].x * is, v[1].y * is, w, false); w = __builtin_amdgcn_cvt_pk_fp8_f32(v[1].z * is, v[1].w * is, w, true); o.y = (unsigned)w; }
    { int w = 0; w = __builtin_amdgcn_cvt_pk_fp8_f32(v[2].x * is, v[2].y * is, w, false); w = __builtin_amdgcn_cvt_pk_fp8_f32(v[2].z * is, v[2].w * is, w, true); o.z = (unsigned)w; }
    { int w = 0; w = __builtin_amdgcn_cvt_pk_fp8_f32(v[3].x * is, v[3].y * is, w, false); w = __builtin_amdgcn_cvt_pk_fp8_f32(v[3].z * is, v[3].w * is, w, true); o.w = (unsigned)w; }
    { const int lay = r / NEXP, e = r % NEXP; *(uint4*)(dst + (((size_t)(lay * 8 + (lane >> 3)) * NEXP + e) * 128) + (lane & 7) * 16) = o; }
    if (lane == 0) scl[r] = sc;
}
__device__ __forceinline__ void convert_table(const float* __restrict__ src, unsigned char* __restrict__ dst, float* __restrict__ scl, int rows) {
    static_assert(TAB_FP8, "fp8 tables");
    const int lane = tidx() & 63;
    const int nw = nwave();
    for (int r = gwave(); r < rows; r += 2 * nw) {
        const int r2 = r + nw;
        float4 v0[4], v1[4];
        const float4* s0 = (const float4*)(src + (size_t)r * D);
        const float4* s1 = (const float4*)(src + (size_t)(r2 < rows ? r2 : r) * D);
#pragma unroll
        for (int j = 0; j < 4; ++j) { v0[j] = s0[lane * 4 + j]; v1[j] = s1[lane * 4 + j]; }
        quant_row(v0, dst, scl, r, lane);
        if (r2 < rows) quant_row(v1, dst, scl, r2, lane);
    }
}
__device__ __forceinline__ void phase_prep(const Params& P, char* lds) {
    unsigned char* ws = P.ws;
    for (int l = 0; l < DEPTH; ++l) {
        transpose_tiled(P.w_in + (size_t)l * D * DIN, (bf16*)(ws + WS_WIN) + (size_t)l * DINP * LDW, D, DIN, DINP, LDW, nullptr, lds);
        transpose_tiled(P.w_uq + (size_t)l * QR * 768, (bf16*)(ws + WS_WUQ) + (size_t)l * 768 * QR, QR, 768, 768, QR, P.q_norm + l * QR, lds);
        transpose_tiled(P.w_uk + (size_t)l * KVR * 512, (bf16*)(ws + WS_WUKV) + (size_t)l * 1024 * KVR, KVR, 512, 512, KVR, P.kv_norm + l * KVR, lds);
        transpose_tiled(P.w_uv + (size_t)l * KVR * 512, (bf16*)(ws + WS_WUKV) + (size_t)l * 1024 * KVR + (size_t)512 * KVR, KVR, 512, 512, KVR, P.kv_norm + l * KVR, lds);
        transpose_tiled(P.w_out + (size_t)l * D * D, (bf16*)(ws + WS_WOUT) + (size_t)l * D * LDW, D, D, D, LDW, nullptr, lds);
    }
    {
        bf16* Wc = (bf16*)(ws + WS_WPQ);
        float (*As)[68] = (float (*)[68])lds;
        float (*Bs)[68] = (float (*)[68])(lds + 16 * 68 * 4);
        const int tid = tidx(), tx = tid & 15, ty = tid >> 4;
        const int lr = tid >> 2, ld4 = (tid & 3) * 4;
        for (int tile = blockIdx.x; tile < (DEPTH * 2048 / 64) * (D / 64); tile += gridDim.x) {
            const int row0 = (tile >> 4) * 64, k0 = (tile & 15) * 64;
            const int l = row0 >> 11, hp = (row0 >> 7) & 15, n0 = row0 & 127;
            const float* skp = P.peer_subkeys + (((size_t)l * 2 + (hp & 1)) * NKEY + n0 + lr) * 128 + ld4;
            const float* wqp = P.peer_wq + ((size_t)l * D + k0 + lr) * 2048 + hp * 128 + ld4;
            float acc[4][4];
#pragma unroll
            for (int i = 0; i < 4; ++i)
#pragma unroll
                for (int j = 0; j < 4; ++j) acc[i][j] = 0.f;
            for (int d0 = 0; d0 < 128; d0 += 16) {
                const float4 av = *(const float4*)(skp + d0), bv = *(const float4*)(wqp + d0);
                As[ld4 + 0][lr] = av.x; As[ld4 + 1][lr] = av.y; As[ld4 + 2][lr] = av.z; As[ld4 + 3][lr] = av.w;
                Bs[ld4 + 0][lr] = bv.x; Bs[ld4 + 1][lr] = bv.y; Bs[ld4 + 2][lr] = bv.z; Bs[ld4 + 3][lr] = bv.w;
                __syncthreads();
#pragma unroll
                for (int kk = 0; kk < 16; ++kk) {
                    const float4 a4 = *(const float4*)&As[kk][ty * 4], b4 = *(const float4*)&Bs[kk][tx * 4];
                    const float aa[4] = {a4.x, a4.y, a4.z, a4.w}, bb[4] = {b4.x, b4.y, b4.z, b4.w};
#pragma unroll
                    for (int i = 0; i < 4; ++i)
#pragma unroll
                        for (int j = 0; j < 4; ++j) acc[i][j] = fmaf(aa[i], bb[j], acc[i][j]);
                }
                __syncthreads();
            }
#pragma unroll
            for (int i = 0; i < 4; ++i) {
                uint2 o; o.x = pack2(acc[i][0], acc[i][1]); o.y = pack2(acc[i][2], acc[i][3]);
                *(uint2*)(Wc + (size_t)(row0 + ty * 4 + i) * LDW + k0 + tx * 4) = o;
            }
        }
    }
    convert_table(P.peer_u, ws + WS_TABU, (float*)(ws + WS_TSCU), DEPTH * NEXP);
    convert_table(P.peer_v, ws + WS_TABV, (float*)(ws + WS_TSCV), DEPTH * NEXP);
    float* rope = (float*)(ws + WS_ROPE);
    for (size_t i = gtid(); i < (size_t)S * 16; i += gnth()) {
        const int s = (int)(i >> 4), f = (int)(i & 15);
        const double inv = pow(10000.0, -(double)f / 16.0);
        const double ang = (double)s * inv;
        rope[2 * i] = (float)cos(ang); rope[2 * i + 1] = (float)sin(ang);
    }
}

__device__ __forceinline__ void phase_norm(const float* __restrict__ h, const float* __restrict__ g, bf16* __restrict__ xn) {
    const int lane = tidx() & 63;
    for (int t = gwave(); t < T; t += nwave()) {
        const float4* hr = (const float4*)(h + (size_t)t * D);
        float4 v[4]; float ss = 0.f;
#pragma unroll
        for (int j = 0; j < 4; ++j) { v[j] = hr[j * 64 + lane]; ss += v[j].x * v[j].x + v[j].y * v[j].y + v[j].z * v[j].z + v[j].w * v[j].w; }
        ss = wave_sum(ss);
        const float r = rsqrtf(ss * (1.f / D) + EPS);
#pragma unroll
        for (int j = 0; j < 4; ++j) {
            const float4 gg = ((const float4*)g)[j * 64 + lane];
            uint2 o; o.x = pack2(v[j].x * r * gg.x, v[j].y * r * gg.y); o.y = pack2(v[j].z * r * gg.z, v[j].w * r * gg.w);
            ((uint2*)(xn + (size_t)t * LDX))[j * 64 + lane] = o;
        }
    }
}

__device__ __forceinline__ void phase_mixlocal(const Params& P, int l, char* lds) {
    const bf16* proj = (const bf16*)(P.ws + WS_PROJ);
    bf16* Y = (bf16*)(P.ws + WS_XN);
    const int tid = tidx();
    {
        const float* cw = P.conv_w + (size_t)l * 3 * 256;
        for (size_t i = gtid(); i < (size_t)T * 32; i += gnth()) {
            const int t = (int)(i >> 5), c0 = (int)(i & 31) * 8, s = t & (S - 1);
            const bf16* pr = proj + (size_t)t * DINP;
            float acc[8];
#pragma unroll
            for (int e = 0; e < 8; ++e) acc[e] = 0.f;
#pragma unroll
            for (int j = 0; j < 3; ++j) {
                if (s - 2 + j >= 0) {
                    const bf16* pp = pr - (size_t)(2 - j) * DINP;
                    const uint4 g = *(const uint4*)(pp + C_CG + c0), hc = *(const uint4*)(pp + C_HC + c0);
                    const float4 w0 = *(const float4*)(cw + j * 256 + c0), w1 = *(const float4*)(cw + j * 256 + c0 + 4);
                    acc[0] = fmaf(w0.x, bflo(g.x) * bflo(hc.x), acc[0]); acc[1] = fmaf(w0.y, bfhi(g.x) * bfhi(hc.x), acc[1]);
                    acc[2] = fmaf(w0.z, bflo(g.y) * bflo(hc.y), acc[2]); acc[3] = fmaf(w0.w, bfhi(g.y) * bfhi(hc.y), acc[3]);
                    acc[4] = fmaf(w1.x, bflo(g.z) * bflo(hc.z), acc[4]); acc[5] = fmaf(w1.y, bfhi(g.z) * bfhi(hc.z), acc[5]);
                    acc[6] = fmaf(w1.z, bflo(g.w) * bflo(hc.w), acc[6]); acc[7] = fmaf(w1.w, bfhi(g.w) * bfhi(hc.w), acc[7]);
                }
            }
            const uint4 bg = *(const uint4*)(pr + C_BG + c0);
            uint4 o;
            o.x = pack2(bflo(bg.x) * acc[0], bfhi(bg.x) * acc[1]); o.y = pack2(bflo(bg.y) * acc[2], bfhi(bg.y) * acc[3]);
            o.z = pack2(bflo(bg.z) * acc[4], bfhi(bg.z) * acc[5]); o.w = pack2(bflo(bg.w) * acc[6], bfhi(bg.w) * acc[7]);
            *(uint4*)(Y + (size_t)t * LDX + c0) = o;
        }
    }
    {
        float (*pl)[68] = (float (*)[68])lds;
        const float* pw = P.pool_w + (size_t)l * 4 * 64 * 64;
        const float* psc = P.pool_scale + l * 256;
        const int a = tid & 63, q = tid >> 6;
        for (int tile = blockIdx.x; tile < (T / 64) * 4; tile += gridDim.x) {
            const int g = tile & 3, t0 = (tile >> 2) * 64;
            const int w = 2 << g;
            {
                const bf16* col = proj + C_HP + g * 64 + a;
                const int tf = t0 + q * 16, sf = tf & (S - 1);
                float sum = 0.f;
                for (int d = 1; d < w; ++d) if (sf - d >= 0) sum += bf2f(col[(size_t)(tf - d) * DINP]);
#pragma unroll 4
                for (int i = 0; i < 16; ++i) {
                    const int s = sf + i;
                    const float xv = bf2f(col[(size_t)(tf + i) * DINP]);
                    sum += xv;
                    const int cnt = (s + 1 < w) ? (s + 1) : w;
                    pl[q * 16 + i][a] = sum / (float)cnt - xv;
                    if (s - w + 1 >= 0) sum -= bf2f(col[(size_t)(tf + i - w + 1) * DINP]);
                }
            }
            __syncthreads();
            {
                float pc[64];
#pragma unroll
                for (int c = 0; c < 64; ++c) pc[c] = pw[(g * 64 + c) * 64 + a];
                const float sc = psc[g * 64 + a];
#pragma unroll 2
                for (int i = 0; i < 16; ++i) {
                    const float4* row = (const float4*)&pl[q * 16 + i][0];
                    float m0 = 0.f, m1 = 0.f;
#pragma unroll
                    for (int c4 = 0; c4 < 16; ++c4) { const float4 v = row[c4]; m0 = fmaf(v.x, pc[4 * c4], m0); m1 = fmaf(v.y, pc[4 * c4 + 1], m1); m0 = fmaf(v.z, pc[4 * c4 + 2], m0); m1 = fmaf(v.w, pc[4 * c4 + 3], m1); }
                    Y[(size_t)(t0 + q * 16 + i) * LDX + 256 + g * 64 + a] = f2bf((m0 + m1) * sc);
                }
            }
            __syncthreads();
        }
    }
}

typedef short v4i16_t __attribute__((ext_vector_type(4)));
typedef __attribute__((address_space(3))) v4i16_t* lds_v4p;
__device__ __forceinline__ v4i16_t vtr(const char* p) { return __builtin_amdgcn_ds_read_tr16_b64_v4i16((lds_v4p)p); }
constexpr int A_KP = 208, A_VP = 192;
constexpr int A_KB = 64 * A_KP, A_VB = 64 * A_VP, A_BUF = A_KB + A_VB, ATTN_LDS = 2 * A_BUF;
static_assert(ATTN_LDS <= GEMM_LDS, "attention LDS");

__device__ __forceinline__ void attn_unit(const bf16* __restrict__ Qb, const bf16* __restrict__ Kb, const bf16* __restrict__ Vb, bf16* __restrict__ Y, int bh, int qblk, char* lds) {
    const int tid = tidx(), lane = tid & 63, w = tid >> 6, r32 = lane & 31, hi = lane >> 5;
    const int q0 = qblk * 128, qw0 = q0 + w * 32;
    const int NT = 2 * qblk + 2;
    bf16x8 qf[6];
    {
        const bf16* qp = Qb + ((size_t)bh * S + qw0 + r32) * DQK + hi * 8;
#pragma unroll
        for (int ks = 0; ks < 6; ++ks) qf[ks] = *(const bf16x8*)(qp + ks * 16);
    }
    f32x16 o0, o1;
#pragma unroll
    for (int r = 0; r < 16; ++r) { o0[r] = 0.f; o1[r] = 0.f; }
    float m = -1e30f, lsum = 0.f;
    const char* Kg = (const char*)(Kb + (size_t)bh * S * DQK) + tid * 16;
    const char* Vg = (const char*)(Vb + (size_t)bh * S * DV) + tid * 16;
    const int kl0 = (tid / 12) * A_KP + (tid % 12) * 16, kl1 = ((tid + 256) / 12) * A_KP + ((tid + 256) % 12) * 16, kl2 = ((tid + 512) / 12) * A_KP + ((tid + 512) % 12) * 16;
    const int vl0 = (tid >> 3) * A_VP + (tid & 7) * 16, vl1 = vl0 + 32 * A_VP;
    uint4 pk0, pk1, pk2, pv0, pv1, qk0, qk1, qk2, qv0, qv1;
#define A_LOAD(S, t) do { const char* kg = Kg + (size_t)(t) * (64 * 192); const char* vg = Vg + (size_t)(t) * (64 * 128); \
        S##k0 = *(const uint4*)(kg); S##k1 = *(const uint4*)(kg + 4096); S##k2 = *(const uint4*)(kg + 8192); S##v0 = *(const uint4*)(vg); S##v1 = *(const uint4*)(vg + 4096); } while (0)
#define A_STORE(S, bK, bV) do { *(uint4*)(bK + kl0) = S##k0; *(uint4*)(bK + kl1) = S##k1; *(uint4*)(bK + kl2) = S##k2; *(uint4*)(bV + vl0) = S##v0; *(uint4*)(bV + vl1) = S##v1; } while (0)
#define A_PV(pf, kofs) do { \
            { const v4i16_t lo = vtr(pv + (kofs) * A_VP), hh = vtr(pv + ((kofs) + 8) * A_VP); const bf16x8 vf = {lo[0], lo[1], lo[2], lo[3], hh[0], hh[1], hh[2], hh[3]}; o0 = MFMA32(vf, pf.v, o0); } \
            { const v4i16_t lo = vtr(pv + (kofs) * A_VP + 64), hh = vtr(pv + ((kofs) + 8) * A_VP + 64); const bf16x8 vf = {lo[0], lo[1], lo[2], lo[3], hh[0], hh[1], hh[2], hh[3]}; o1 = MFMA32(vf, pf.v, o1); } } while (0)
    const int pvo = (4 * hi + ((lane & 15) >> 2)) * A_VP + (16 * ((lane >> 4) & 1) + 4 * (lane & 3)) * 2;
    A_LOAD(p, 0); A_LOAD(q, 1);
    for (int t2 = 0; t2 < NT; t2 += 2) {
#pragma unroll
        for (int half = 0; half < 2; ++half) {
            const int t = t2 + half;
            char* bK = lds + half * A_BUF; char* bV = bK + A_KB;
            if (half == 0) A_STORE(p, bK, bV); else A_STORE(q, bK, bV);
            __syncthreads();
            { const int tn = (t + 2 < NT) ? (t + 2) : (NT - 2 + half); if (half == 0) A_LOAD(p, tn); else A_LOAD(q, tn); }
        const int kt0 = t * 64;
        if (kt0 <= qw0) {
            f32x16 s0, s1;
#pragma unroll
            for (int r = 0; r < 16; ++r) { s0[r] = 0.f; s1[r] = 0.f; }
            const char* pk = bK + r32 * A_KP + hi * 16;
#pragma unroll
            for (int ks = 0; ks < 6; ++ks) {
                const bf16x8 a0 = *(const bf16x8*)(pk + ks * 32), a1 = *(const bf16x8*)(pk + 32 * A_KP + ks * 32);
                s0 = MFMA32(a0, qf[ks], s0); s1 = MFMA32(a1, qf[ks], s1);
            }
            if (kt0 + 63 > qw0) {
                const int qrow = qw0 + r32;
#pragma unroll
                for (int r = 0; r < 16; ++r) { const int key = kt0 + crow(r, hi); if (key > qrow) s0[r] = -INFINITY; if (key + 32 > qrow) s1[r] = -INFINITY; }
            }
            float mx = fmaxf(s0[0], s1[0]);
#pragma unroll
            for (int r = 1; r < 16; ++r) mx = fmaxf(mx, fmaxf(s0[r], s1[r]));
            mx = fmaxf(mx, __shfl_xor(mx, 32, 64));
            const float mn = fmaxf(m, mx);
            const float alpha = __builtin_amdgcn_exp2f(m - mn);
            m = mn;
            float ps = 0.f;
#pragma unroll
            for (int r = 0; r < 16; ++r) { s0[r] = __builtin_amdgcn_exp2f(s0[r] - mn); s1[r] = __builtin_amdgcn_exp2f(s1[r] - mn); ps += s0[r] + s1[r]; }
            lsum = lsum * alpha + ps;
#pragma unroll
            for (int r = 0; r < 16; ++r) { o0[r] *= alpha; o1[r] *= alpha; }
            union { unsigned u[4]; bf16x8 v; } p00, p01, p10, p11;
#pragma unroll
            for (int j = 0; j < 4; ++j) { p00.u[j] = cvtpk(s0[2 * j], s0[2 * j + 1]); p01.u[j] = cvtpk(s0[8 + 2 * j], s0[9 + 2 * j]); p10.u[j] = cvtpk(s1[2 * j], s1[2 * j + 1]); p11.u[j] = cvtpk(s1[8 + 2 * j], s1[9 + 2 * j]); }
            const char* pv = bV + pvo;
            A_PV(p00, 0); A_PV(p01, 16); A_PV(p10, 32); A_PV(p11, 48);
        }
        }
    }
    lsum += __shfl_xor(lsum, 32, 64);
    const float inv = 1.f / lsum;
    const int b = bh >> 3, h = bh & 7;
    bf16* yo = Y + (size_t)(b * S + qw0 + r32) * LDX + 512 + h * 64 + 4 * hi;
#pragma unroll
    for (int g = 0; g < 4; ++g) {
        uint2 a, c;
        a.x = cvtpk(o0[4 * g] * inv, o0[4 * g + 1] * inv); a.y = cvtpk(o0[4 * g + 2] * inv, o0[4 * g + 3] * inv);
        c.x = cvtpk(o1[4 * g] * inv, o1[4 * g + 1] * inv); c.y = cvtpk(o1[4 * g + 2] * inv, o1[4 * g + 3] * inv);
        *(uint2*)(yo + 8 * g) = a; *(uint2*)(yo + 32 + 8 * g) = c;
    }
    __syncthreads();
}
__device__ __forceinline__ void phase_attn(const Params& P, char* lds) {
    const bf16* Qb = (const bf16*)(P.ws + WS_Q);
    const bf16* Kb = (const bf16*)(P.ws + WS_K);
    const bf16* Vb = (const bf16*)(P.ws + WS_V);
    bf16* Y = (bf16*)(P.ws + WS_XN);
    for (int u = blockIdx.x; u < NB * NH * (S / 128); u += gridDim.x) {
        const int bh = u & 31, v = u >> 5;
        const int qblk = (v < 16) ? (63 - v) : (v < 32) ? (v - 16) : (v < 48) ? (79 - v) : (v - 32);
        attn_unit(Qb, Kb, Vb, Y, bh, qblk, lds);
    }
}

#define NET_HD __device__ __forceinline__
#define NET_U2F(u) __uint_as_float(u)
#define NET_F2U(f) __float_as_uint(f)
#define CE_DESC(a, b) do { const float hi__ = fmaxf(a, b), lo__ = fminf(a, b); a = hi__; b = lo__; } while (0)
NET_HD void sort16_desc(float (&v)[16]) {
#pragma unroll
    for (int k = 2; k <= 16; k <<= 1) {
#pragma unroll
        for (int j = k >> 1; j > 0; j >>= 1) {
#pragma unroll
            for (int i = 0; i < 16; ++i) {
                const int l = i ^ j;
                if (l > i) { if ((i & k) == 0) CE_DESC(v[i], v[l]); else CE_DESC(v[l], v[i]); }
            }
        }
    }
}
NET_HD void merge16_desc(float (&a)[16], const float (&b)[16]) {
#pragma unroll
    for (int i = 0; i < 16; ++i) a[i] = fmaxf(a[i], b[15 - i]);
#pragma unroll
    for (int j = 8; j > 0; j >>= 1) {
#pragma unroll
        for (int i = 0; i < 16; ++i) { const int l = i ^ j; if (l > i) CE_DESC(a[i], a[l]); }
    }
}
NET_HD void top16_of_64(float (&g0)[16], float (&g1)[16], float (&g2)[16], float (&g3)[16]) {
    sort16_desc(g0); sort16_desc(g1); sort16_desc(g2); sort16_desc(g3);
    merge16_desc(g0, g1); merge16_desc(g2, g3); merge16_desc(g0, g2);
}
NET_HD float u2f(unsigned u) { return NET_U2F(u); }
NET_HD unsigned f2u(float f) { return NET_F2U(f); }
template <class V16>
NET_HD void lane_top16(const V16& s0, const V16& s1, const V16& s2, const V16& s3, int hi, float (&out)[16]) {
    float g0[16], g1[16], g2[16], g3[16];
#pragma unroll
    for (int r = 0; r < 16; ++r) {
        const unsigned nb = (unsigned)((r & 3) + 8 * (r >> 2));
        g0[r] = u2f((f2u(s0[r]) & 0xFFFFFF80u) | nb); g1[r] = u2f((f2u(s1[r]) & 0xFFFFFF80u) | (nb + 32u));
        g2[r] = u2f((f2u(s2[r]) & 0xFFFFFF80u) | (nb + 64u)); g3[r] = u2f((f2u(s3[r]) & 0xFFFFFF80u) | (nb + 96u));
    }
    top16_of_64(g0, g1, g2, g3);
    const unsigned h4 = (unsigned)hi << 2;
#pragma unroll
    for (int i = 0; i < 16; ++i) out[i] = u2f(f2u(g0[i]) | h4);
}
constexpr int cand_slot(int a, int b) { int n = 0; for (int x = 0; x < 16; ++x) for (int y = 0; y < 16; ++y) { if (x == a && y == b) return n; if ((x + 1) * (y + 1) <= 16) ++n; } return n; }
NET_HD void cand_top16(const float (&s1)[16], const float (&s2)[16], float (&c)[16]) {
    float g0[16], g1[16], g2[16], g3[16];
#pragma unroll
    for (int i = 0; i < 16; ++i) { g0[i] = -3.0e38f; g1[i] = -3.0e38f; g2[i] = -3.0e38f; g3[i] = -3.0e38f; }
#pragma unroll
    for (int a = 0; a < 16; ++a) {
#pragma unroll
        for (int b = 0; b < 16; ++b) {
            if ((a + 1) * (b + 1) <= 16) {
                const int sl = cand_slot(a, b);
                const float v = u2f((f2u(s1[a] + s2[b]) & 0xFFFFFF00u) | (unsigned)(a * 16 + b));
                if (sl < 16) g0[sl & 15] = v; else if (sl < 32) g1[sl & 15] = v; else if (sl < 48) g2[sl & 15] = v; else g3[sl & 15] = v;
            }
        }
    }
    top16_of_64(g0, g1, g2, g3);
#pragma unroll
    for (int i = 0; i < 16; ++i) c[i] = g0[i];
}

__device__ __forceinline__ void phase_route(const Params& P, int l, char* lds) {
    const bf16* XN = (const bf16*)(P.ws + WS_XN);
    const bf16* Wc = (const bf16*)(P.ws + WS_WPQ) + (size_t)l * 2048 * LDW;
    int* EXPp = (int*)(P.ws + WS_EXP);
    float* GATEp = (float*)(P.ws + WS_GATE);
    const int tid = tidx(), lane = tid & 63, w = tid >> 6, r32 = lane & 31, hi = lane >> 5;
    for (int u = blockIdx.x; u < (T / 128) * PH; u += gridDim.x) {
        const int tm = u >> 3, h = u & 7;
        float L0[16], L1[16];
        {
            f32x16 acc[4]; float ssd[4];
            gemm_kloop<1, false>(Wc + (size_t)((h * 2 + 0) * 128) * LDW, LDW, XN + (size_t)(tm * 128) * LDX, LDX, D / 64, acc, ssd, lds, tid);
            lane_top16(acc[0], acc[1], acc[2], acc[3], hi, L0);
            float o[16];
#pragma unroll
            for (int i = 0; i < 16; ++i) o[i] = __shfl_xor(L0[i], 32, 64);
            merge16_desc(L0, o);
        }
        {
            f32x16 acc[4]; float ssd[4];
            gemm_kloop<1, false>(Wc + (size_t)((h * 2 + 1) * 128) * LDW, LDW, XN + (size_t)(tm * 128) * LDX, LDX, D / 64, acc, ssd, lds, tid);
            lane_top16(acc[0], acc[1], acc[2], acc[3], hi, L1);
            float o[16];
#pragma unroll
            for (int i = 0; i < 16; ++i) o[i] = __shfl_xor(L1[i], 32, 64);
            merge16_desc(L1, o);
        }
        float c[16];
        cand_top16(L0, L1, c);
        __syncthreads();
        unsigned char* my = (unsigned char*)lds + tid * 32;
        {
            uint4 a, b;
#define PK4(L, i) ((__float_as_uint(L[i]) & 127u) | ((__float_as_uint(L[i + 1]) & 127u) << 8) | ((__float_as_uint(L[i + 2]) & 127u) << 16) | ((__float_as_uint(L[i + 3]) & 127u) << 24))
            a.x = PK4(L0, 0); a.y = PK4(L0, 4); a.z = PK4(L0, 8); a.w = PK4(L0, 12);
            b.x = PK4(L1, 0); b.y = PK4(L1, 4); b.z = PK4(L1, 8); b.w = PK4(L1, 12);
#undef PK4
            *(uint4*)my = a; *(uint4*)(my + 16) = b;
        }
        int ev[16]; float gv[16]; float den = 0.f;
#pragma unroll
        for (int k = 0; k < 16; ++k) {
            const unsigned ci = __float_as_uint(c[k]) & 255u;
            const int n1 = my[ci >> 4], n2 = my[16 + (ci & 15)];
            ev[k] = n1 * NKEY + n2;
            gv[k] = __expf(c[k] - c[0]); den += gv[k];
        }
        const float iden = 1.f / den;
        if (hi == 0) {
            const int t = tm * 128 + w * 32 + r32;
            uint4* ep = (uint4*)(EXPp + (size_t)t * HK + h * 16);
            float4* gp = (float4*)(GATEp + (size_t)t * HK + h * 16);
#pragma unroll
            for (int q = 0; q < 4; ++q) {
                ep[q] = make_uint4((unsigned)ev[4 * q], (unsigned)ev[4 * q + 1], (unsigned)ev[4 * q + 2], (unsigned)ev[4 * q + 3]);
                gp[q] = make_float4(gv[4 * q] * iden, gv[4 * q + 1] * iden, gv[4 * q + 2] * iden, gv[4 * q + 3] * iden);
            }
        }
        __syncthreads();
    }
}

__device__ __forceinline__ float red16(float (&p)[16], int lane) {
#pragma unroll
    for (int i = 0; i < 8; ++i) { const bool up = lane & 32; const float send = up ? p[i] : p[i + 8], keep = up ? p[i + 8] : p[i]; p[i] = keep + __shfl_xor(send, 32, 64); }
#pragma unroll
    for (int i = 0; i < 4; ++i) { const bool up = lane & 16; const float send = up ? p[i] : p[i + 4], keep = up ? p[i + 4] : p[i]; p[i] = keep + __shfl_xor(send, 16, 64); }
#pragma unroll
    for (int i = 0; i < 2; ++i) { const bool up = lane & 8; const float send = up ? p[i] : p[i + 2], keep = up ? p[i + 2] : p[i]; p[i] = keep + __shfl_xor(send, 8, 64); }
    { const bool up = lane & 4; const float send = up ? p[0] : p[1], keep = up ? p[1] : p[0]; p[0] = keep + __shfl_xor(send, 4, 64); }
    float r = p[0];
    r += __shfl_xor(r, 2, 64); r += __shfl_xor(r, 1, 64);
    return r;
}

__device__ __forceinline__ void phase_gather(const Params& P, int l) {
    const bf16* XN = (const bf16*)(P.ws + WS_XN);
    bf16* XNw = (bf16*)(P.ws + WS_XN);
    const int* EXPp = (const int*)(P.ws + WS_EXP);
    const float* GATEp = (const float*)(P.ws + WS_GATE);
    const unsigned char* U = P.ws + WS_TABU + (size_t)l * NEXP * TAB_ROWB;
    const unsigned char* V = P.ws + WS_TABV + (size_t)l * NEXP * TAB_ROWB;
    const float* SU = (const float*)(P.ws + WS_TSCU) + (size_t)l * NEXP;
    const float* SV = (const float*)(P.ws + WS_TSCV) + (size_t)l * NEXP;
    const int lane = tidx() & 63;
    for (int t = gwave(); t < T; t += nwave()) {
        const int e_lo = EXPp[(size_t)t * HK + lane], e_hi = EXPp[(size_t)t * HK + 64 + lane];
#if TAB_FP8
        float xf[16];
        {
            const uint4 a = ((const uint4*)(XN + (size_t)t * D))[lane * 2], b = ((const uint4*)(XN + (size_t)t * D))[lane * 2 + 1];
            xf[0] = bflo(a.x); xf[1] = bfhi(a.x); xf[2] = bflo(a.y); xf[3] = bfhi(a.y); xf[4] = bflo(a.z); xf[5] = bfhi(a.z); xf[6] = bflo(a.w); xf[7] = bfhi(a.w);
            xf[8] = bflo(b.x); xf[9] = bfhi(b.x); xf[10] = bflo(b.y); xf[11] = bfhi(b.y); xf[12] = bflo(b.z); xf[13] = bfhi(b.z); xf[14] = bflo(b.w); xf[15] = bfhi(b.w);
        }
#else
        const uint4 xa = ((const uint4*)(XN + (size_t)t * D))[lane], xb = ((const uint4*)(XN + (size_t)t * D))[64 + lane];
#endif
        float acc[16];
#pragma unroll
        for (int i = 0; i < 16; ++i) acc[i] = 0.f;
        for (int c = 0; c < 8; ++c) {
            const int esel = (c < 4) ? e_lo : e_hi;
            const int kb = (c & 3) * 16;
            float part[16];
#pragma unroll
            for (int hb = 0; hb < 2; ++hb) {
#if TAB_FP8
                uint4 r[8];
#pragma unroll
                for (int i = 0; i < 8; ++i) { const int e = __builtin_amdgcn_readlane(esel, kb + hb * 8 + i); r[i] = *(const uint4*)(U + (size_t)e * 1024 + lane * 16); }
#pragma unroll
                for (int i = 0; i < 8; ++i) {
                    float d0 = 0.f, d1 = 0.f;
                    const unsigned w[4] = {r[i].x, r[i].y, r[i].z, r[i].w};
#pragma unroll
                    for (int q = 0; q < 4; ++q) {
                        const auto lo = __builtin_amdgcn_cvt_pk_f32_fp8((int)w[q], false); const auto hh = __builtin_amdgcn_cvt_pk_f32_fp8((int)w[q], true);
                        d0 = fmaf(xf[4 * q], lo[0], d0); d1 = fmaf(xf[4 * q + 1], lo[1], d1); d0 = fmaf(xf[4 * q + 2], hh[0], d0); d1 = fmaf(xf[4 * q + 3], hh[1], d1);
                    }
                    part[hb * 8 + i] = d0 + d1;
                }
#else
                uint4 r0[8], r1[8];
#pragma unroll
                for (int i = 0; i < 8; ++i) { const int e = __builtin_amdgcn_readlane(esel, kb + hb * 8 + i); const unsigned char* rp = U + (size_t)e * 2048 + lane * 16; r0[i] = *(const uint4*)(rp); r1[i] = *(const uint4*)(rp + 1024); }
#pragma unroll
                for (int i = 0; i < 8; ++i) {
                    float d0 = 0.f, d1 = 0.f;
                    d0 = dot2bf(xa.x, r0[i].x, d0); d1 = dot2bf(xa.y, r0[i].y, d1); d0 = dot2bf(xa.z, r0[i].z, d0); d1 = dot2bf(xa.w, r0[i].w, d1);
                    d0 = dot2bf(xb.x, r1[i].x, d0); d1 = dot2bf(xb.y, r1[i].y, d1); d0 = dot2bf(xb.z, r1[i].z, d0); d1 = dot2bf(xb.w, r1[i].w, d1);
                    part[hb * 8 + i] = d0 + d1;
                }
#endif
            }
            float dsum = red16(part, lane);
            const int kk = c * 16 + (lane >> 2);
            const int eme = __shfl(esel, kb + (lane >> 2), 64);
            float wv = GATEp[(size_t)t * HK + kk];
#if TAB_FP8
            dsum *= SU[eme];
            wv *= SV[eme];
#endif
            wv *= gelu_exact(dsum);
#pragma unroll
            for (int hb = 0; hb < 2; ++hb) {
#if TAB_FP8
                uint4 r[8];
#pragma unroll
                for (int i = 0; i < 8; ++i) { const int e = __builtin_amdgcn_readlane(esel, kb + hb * 8 + i); r[i] = *(const uint4*)(V + (size_t)e * 1024 + lane * 16); }
#pragma unroll
                for (int i = 0; i < 8; ++i) {
                    const float w = __int_as_float(__builtin_amdgcn_readlane(__float_as_int(wv), (hb * 8 + i) * 4));
                    const unsigned ww[4] = {r[i].x, r[i].y, r[i].z, r[i].w};
#pragma unroll
                    for (int q = 0; q < 4; ++q) {
                        const auto lo = __builtin_amdgcn_cvt_pk_f32_fp8((int)ww[q], false); const auto hh = __builtin_amdgcn_cvt_pk_f32_fp8((int)ww[q], true);
                        acc[4 * q] = fmaf(w, lo[0], acc[4 * q]); acc[4 * q + 1] = fmaf(w, lo[1], acc[4 * q + 1]); acc[4 * q + 2] = fmaf(w, hh[0], acc[4 * q + 2]); acc[4 * q + 3] = fmaf(w, hh[1], acc[4 * q + 3]);
                    }
                }
#else
                uint4 r0[8], r1[8];
#pragma unroll
                for (int i = 0; i < 8; ++i) { const int e = __builtin_amdgcn_readlane(esel, kb + hb * 8 + i); const unsigned char* rp = V + (size_t)e * 2048 + lane * 16; r0[i] = *(const uint4*)(rp); r1[i] = *(const uint4*)(rp + 1024); }
#pragma unroll
                for (int i = 0; i < 8; ++i) {
                    const float w = __int_as_float(__builtin_amdgcn_readlane(__float_as_int(wv), (hb * 8 + i) * 4));
                    acc[0] = fmaf(w, bflo(r0[i].x), acc[0]); acc[1] = fmaf(w, bfhi(r0[i].x), acc[1]); acc[2] = fmaf(w, bflo(r0[i].y), acc[2]); acc[3] = fmaf(w, bfhi(r0[i].y), acc[3]);
                    acc[4] = fmaf(w, bflo(r0[i].z), acc[4]); acc[5] = fmaf(w, bfhi(r0[i].z), acc[5]); acc[6] = fmaf(w, bflo(r0[i].w), acc[6]); acc[7] = fmaf(w, bfhi(r0[i].w), acc[7]);
                    acc[8] = fmaf(w, bflo(r1[i].x), acc[8]); acc[9] = fmaf(w, bfhi(r1[i].x), acc[9]); acc[10] = fmaf(w, bflo(r1[i].y), acc[10]); acc[11] = fmaf(w, bfhi(r1[i].y), acc[11]);
                    acc[12] = fmaf(w, bflo(r1[i].z), acc[12]); acc[13] = fmaf(w, bfhi(r1[i].z), acc[13]); acc[14] = fmaf(w, bflo(r1[i].w), acc[14]); acc[15] = fmaf(w, bfhi(r1[i].w), acc[15]);
                }
#endif
            }
        }
        float* hrow = P.out + (size_t)t * D;
#if TAB_FP8
        const int c0 = lane * 16, c1 = lane * 16 + 8;
#else
        const int c0 = lane * 8, c1 = 512 + lane * 8;
#endif
        float4 h0 = *(const float4*)(hrow + c0), h1 = *(const float4*)(hrow + c0 + 4), h2 = *(const float4*)(hrow + c1), h3 = *(const float4*)(hrow + c1 + 4);
        h0.x += acc[0]; h0.y += acc[1]; h0.z += acc[2]; h0.w += acc[3]; h1.x += acc[4]; h1.y += acc[5]; h1.z += acc[6]; h1.w += acc[7];
        h2.x += acc[8]; h2.y += acc[9]; h2.z += acc[10]; h2.w += acc[11]; h3.x += acc[12]; h3.y += acc[13]; h3.z += acc[14]; h3.w += acc[15];
        float ss = h0.x * h0.x + h0.y * h0.y + h0.z * h0.z + h0.w * h0.w + h1.x * h1.x + h1.y * h1.y + h1.z * h1.z + h1.w * h1.w
                 + h2.x * h2.x + h2.y * h2.y + h2.z * h2.z + h2.w * h2.w + h3.x * h3.x + h3.y * h3.y + h3.z * h3.z + h3.w * h3.w;
        ss = wave_sum(ss);
        const float rn = rsqrtf(ss * (1.f / D) + EPS);
        if (l == DEPTH - 1) {
            const float* g = P.norm_final;
            const float4 g0 = *(const float4*)(g + c0), g1 = *(const float4*)(g + c0 + 4), g2 = *(const float4*)(g + c1), g3 = *(const float4*)(g + c1 + 4);
            *(float4*)(hrow + c0) = make_float4(h0.x * rn * g0.x, h0.y * rn * g0.y, h0.z * rn * g0.z, h0.w * rn * g0.w);
            *(float4*)(hrow + c0 + 4) = make_float4(h1.x * rn * g1.x, h1.y * rn * g1.y, h1.z * rn * g1.z, h1.w * rn * g1.w);
            *(float4*)(hrow + c1) = make_float4(h2.x * rn * g2.x, h2.y * rn * g2.y, h2.z * rn * g2.z, h2.w * rn * g2.w);
            *(float4*)(hrow + c1 + 4) = make_float4(h3.x * rn * g3.x, h3.y * rn * g3.y, h3.z * rn * g3.z, h3.w * rn * g3.w);
        } else {
            *(float4*)(hrow + c0) = h0; *(float4*)(hrow + c0 + 4) = h1; *(float4*)(hrow + c1) = h2; *(float4*)(hrow + c1 + 4) = h3;
            const float* g = P.norm_mix + (l + 1) * D;
            const float4 g0 = *(const float4*)(g + c0), g1 = *(const float4*)(g + c0 + 4), g2 = *(const float4*)(g + c1), g3 = *(const float4*)(g + c1 + 4);
            uint4 o0, o1;
            o0.x = pack2(h0.x * rn * g0.x, h0.y * rn * g0.y); o0.y = pack2(h0.z * rn * g0.z, h0.w * rn * g0.w); o0.z = pack2(h1.x * rn * g1.x, h1.y * rn * g1.y); o0.w = pack2(h1.z * rn * g1.z, h1.w * rn * g1.w);
            o1.x = pack2(h2.x * rn * g2.x, h2.y * rn * g2.y); o1.y = pack2(h2.z * rn * g2.z, h2.w * rn * g2.w); o1.z = pack2(h3.x * rn * g3.x, h3.y * rn * g3.y); o1.w = pack2(h3.z * rn * g3.z, h3.w * rn * g3.w);
            *(uint4*)(XNw + (size_t)t * D + c0) = o0; *(uint4*)(XNw + (size_t)t * D + c1) = o1;
        }
    }
}


constexpr size_t WS_PART = WS_PROJ;
static_assert((size_t)8 * T * HK * 4 <= WS_K - WS_PROJ, "PART alias");
constexpr int XI_X = 0, XI_RANK = 1, XI_J = 2, XI_NX = 3, XI_NLOC = 4;
constexpr int CTL_CENSUS = 4096;
constexpr int CTL_BYTES = (CTL_CENSUS + 16) * 4;

__device__ __forceinline__ float dot16_fp8(const float (&xf)[16], const uint4& r) {
    float d0 = 0.f, d1 = 0.f;
    const unsigned w[4] = {r.x, r.y, r.z, r.w};
#pragma unroll
    for (int q = 0; q < 4; ++q) {
        const auto lo = __builtin_amdgcn_cvt_pk_f32_fp8((int)w[q], false); const auto hh = __builtin_amdgcn_cvt_pk_f32_fp8((int)w[q], true);
        d0 = fmaf(xf[4 * q], lo[0], d0); d1 = fmaf(xf[4 * q + 1], lo[1], d1); d0 = fmaf(xf[4 * q + 2], hh[0], d0); d1 = fmaf(xf[4 * q + 3], hh[1], d1);
    }
    return d0 + d1;
}
template <int M1, int M2, int M3>
__device__ __forceinline__ void red16x3(float (&p)[16], int lane) {
#pragma unroll
    for (int i = 0; i < 8; ++i) { const bool up = lane & M1; const float send = up ? p[i] : p[i + 8], keep = up ? p[i + 8] : p[i]; p[i] = keep + __shfl_xor(send, M1, 64); }
#pragma unroll
    for (int i = 0; i < 4; ++i) { const bool up = lane & M2; const float send = up ? p[i] : p[i + 4], keep = up ? p[i + 4] : p[i]; p[i] = keep + __shfl_xor(send, M2, 64); }
#pragma unroll
    for (int i = 0; i < 2; ++i) { const bool up = lane & M3; const float send = up ? p[i] : p[i + 2], keep = up ? p[i + 2] : p[i]; p[i] = keep + __shfl_xor(send, M3, 64); }
}
__device__ __forceinline__ void phase_gu(const Params& P, int l, const volatile int* xi) {
    const bf16* XN = (const bf16*)(P.ws + WS_XN);
    const int* EXPp = (const int*)(P.ws + WS_EXP);
    float* PART = (float*)(P.ws + WS_PART);
    const int tid = tidx(), lane = tid & 63, w = tid >> 6, g = lane >> 3, c = lane & 7;
    int xo_ = 0; asm volatile("" : "+v"(xo_));
    const int j = xi[xo_ + XI_J], nx = xi[xo_ + XI_NX], nloc = xi[xo_ + XI_NLOC], rank = xi[xo_ + XI_RANK];
    const int t0 = rank * 4 + w, st = nloc * 4;
    const int n = (t0 < T) ? (T - t0 + st - 1) / st : 0;
    const int i0 = 8 * (c & 1) + 4 * ((c >> 1) & 1) + 2 * ((c >> 2) & 1);
    for (int sl = j; sl < 8 && n > 0; sl += nx) {
        const unsigned char* Us = P.ws + WS_TABU + ((size_t)(l * 8 + sl) * NEXP) * 128 + c * 16;
        float* part = PART + (size_t)sl * T * HK;
        const bf16* xs = XN + sl * 128 + c * 16;
#define GU_TK(k) (t0 + (((k) < n) ? (k) : (n - 1)) * st)
#define GU_LOADE(S, t) do { S##lo = EXPp[(size_t)(t) * HK + lane]; S##hi = EXPp[(size_t)(t) * HK + 64 + lane]; } while (0)
#define GU_LOADX(S, t) do { S##a = *(const uint4*)(xs + (size_t)(t) * LDX); S##b = *(const uint4*)(xs + (size_t)(t) * LDX + 8); } while (0)
#define GU_ISSUE(R, S) do { _Pragma("unroll") for (int i = 0; i < 16; ++i) { \
            const int e = __builtin_amdgcn_ds_bpermute((((8 * i) & 63) + g) << 2, (i < 8) ? S##lo : S##hi); R[i] = *(const uint4*)(Us + (size_t)e * 128); } } while (0)
#define GU_FINISH(R, S, t) do { \
            float xf[16]; \
            xf[0] = bflo(S##a.x); xf[1] = bfhi(S##a.x); xf[2] = bflo(S##a.y); xf[3] = bfhi(S##a.y); xf[4] = bflo(S##a.z); xf[5] = bfhi(S##a.z); xf[6] = bflo(S##a.w); xf[7] = bfhi(S##a.w); \
            xf[8] = bflo(S##b.x); xf[9] = bfhi(S##b.x); xf[10] = bflo(S##b.y); xf[11] = bfhi(S##b.y); xf[12] = bflo(S##b.z); xf[13] = bfhi(S##b.z); xf[14] = bflo(S##b.w); xf[15] = bfhi(S##b.w); \
            float p[16]; \
            _Pragma("unroll") for (int i = 0; i < 16; ++i) { p[i] = dot16_fp8(xf, R[i]); __builtin_amdgcn_sched_barrier(0); } \
            red16x3<1, 2, 4>(p, lane); \
            part[(size_t)(t) * HK + 8 * i0 + g] = p[0]; part[(size_t)(t) * HK + 8 * (i0 + 1) + g] = p[1]; } while (0)
        int eAlo, eAhi, eBlo, eBhi; uint4 xAa, xAb, xBa, xBb; uint4 rA[16], rB[16];
        GU_LOADE(eA, GU_TK(0)); GU_LOADX(xA, GU_TK(0)); GU_LOADE(eB, GU_TK(1));
        GU_ISSUE(rA, eA);
        for (int k = 0; k < n; k += 2) {
            GU_LOADX(xB, GU_TK(k + 1)); GU_ISSUE(rB, eB); GU_LOADE(eA, GU_TK(k + 2));
            GU_FINISH(rA, xA, GU_TK(k));
            GU_LOADX(xA, GU_TK(k + 2)); GU_ISSUE(rA, eA); GU_LOADE(eB, GU_TK(k + 3));
            GU_FINISH(rB, xB, GU_TK(k + 1));
        }
#undef GU_TK
#undef GU_LOADE
#undef GU_LOADX
#undef GU_ISSUE
#undef GU_FINISH
    }
}
__device__ __forceinline__ void phase_gw(const Params& P, int l) {
    const int* EXPp = (const int*)(P.ws + WS_EXP);
    float* GATEp = (float*)(P.ws + WS_GATE);
    const float* PART = (const float*)(P.ws + WS_PART);
    const float* SU = (const float*)(P.ws + WS_TSCU) + (size_t)l * NEXP;
    const float* SV = (const float*)(P.ws + WS_TSCV) + (size_t)l * NEXP;
    for (size_t i = gtid(); i < (size_t)T * HK; i += gnth()) {
        float s = 0.f;
#pragma unroll
        for (int x = 0; x < 8; ++x) s += PART[(size_t)x * T * HK + i];
        const int e = EXPp[i];
        GATEp[i] = GATEp[i] * gelu_exact(s * SU[e]) * SV[e];
    }
}
__device__ __forceinline__ void phase_gv(const Params& P, int l, const volatile int* xi) {
    const int* EXPp = (const int*)(P.ws + WS_EXP);
    const float* WGT = (const float*)(P.ws + WS_GATE);
    const int tid = tidx(), lane = tid & 63, w = tid >> 6, g = lane >> 3, c = lane & 7;
    int xo_ = 0; asm volatile("" : "+v"(xo_));
    const int j = xi[xo_ + XI_J], nx = xi[xo_ + XI_NX], nloc = xi[xo_ + XI_NLOC], rank = xi[xo_ + XI_RANK];
    const int t0 = rank * 4 + w, st = nloc * 4;
    const int n = (t0 < T) ? (T - t0 + st - 1) / st : 0;
    const int j0 = 8 * (g & 1) + 4 * ((g >> 1) & 1) + 2 * ((g >> 2) & 1);
    for (int sl = j; sl < 8 && n > 0; sl += nx) {
        const unsigned char* Vs = P.ws + WS_TABV + ((size_t)(l * 8 + sl) * NEXP) * 128 + c * 16;
        float* hcol = P.out + sl * 128 + c * 16 + j0;
#define GV_TK(k) (t0 + (((k) < n) ? (k) : (n - 1)) * st)
#define GV_LOADE(S, t) do { S##el = EXPp[(size_t)(t) * HK + lane]; S##eh = EXPp[(size_t)(t) * HK + 64 + lane]; \
            S##wl = __float_as_int(WGT[(size_t)(t) * HK + lane]); S##wh = __float_as_int(WGT[(size_t)(t) * HK + 64 + lane]); } while (0)
#define GV_ISSUE(R, W, ESEL, WSEL) do { _Pragma("unroll") for (int i = 0; i < 8; ++i) { const int src = (8 * i + g) << 2; \
            const int e = __builtin_amdgcn_ds_bpermute(src, ESEL); W[i] = __int_as_float(__builtin_amdgcn_ds_bpermute(src, WSEL)); R[i] = *(const uint4*)(Vs + (size_t)e * 128); } } while (0)
#define GV_FINISH(R, W) do { _Pragma("unroll") for (int i = 0; i < 8; ++i) { const unsigned ww[4] = {R[i].x, R[i].y, R[i].z, R[i].w}; \
            _Pragma("unroll") for (int q = 0; q < 4; ++q) { \
                const auto lo = __builtin_amdgcn_cvt_pk_f32_fp8((int)ww[q], false); const auto hh = __builtin_amdgcn_cvt_pk_f32_fp8((int)ww[q], true); \
                acc[4 * q] = fmaf(W[i], lo[0], acc[4 * q]); acc[4 * q + 1] = fmaf(W[i], lo[1], acc[4 * q + 1]); acc[4 * q + 2] = fmaf(W[i], hh[0], acc[4 * q + 2]); acc[4 * q + 3] = fmaf(W[i], hh[1], acc[4 * q + 3]); } __builtin_amdgcn_sched_barrier(0); } } while (0)
        int Cel, Ceh, Cwl, Cwh, Nel, Neh, Nwl, Nwh, Fel, Feh, Fwl, Fwh;
        uint4 r0[8], r1[8]; float wk0[8], wk1[8];
        GV_LOADE(C, GV_TK(0)); GV_LOADE(N, GV_TK(1));
        GV_ISSUE(r0, wk0, Cel, Cwl);
        for (int k = 0; k < n; ++k) {
            const int t = GV_TK(k);
            GV_ISSUE(r1, wk1, Ceh, Cwh);
            float2* hp = (float2*)(hcol + (size_t)t * D);
            const float2 hv = *hp;
            GV_LOADE(F, GV_TK(k + 2));
            float acc[16];
#pragma unroll
            for (int q = 0; q < 16; ++q) acc[q] = 0.f;
            GV_FINISH(r0, wk0);
            GV_ISSUE(r0, wk0, Nel, Nwl);
            GV_FINISH(r1, wk1);
            red16x3<8, 16, 32>(acc, lane);
            *hp = make_float2(hv.x + acc[0], hv.y + acc[1]);
            Cel = Nel; Ceh = Neh; Cwl = Nwl; Cwh = Nwh; Nel = Fel; Neh = Feh; Nwl = Fwl; Nwh = Fwh;
        }
#undef GV_TK
#undef GV_LOADE
#undef GV_ISSUE
#undef GV_FINISH
    }
}
__device__ __forceinline__ void phase_gnorm(const Params& P, int l) {
    const int lane = tidx() & 63;
    bf16* XNw = (bf16*)(P.ws + WS_XN);
    for (int t = gwave(); t < T; t += nwave()) {
        float4* hr = (float4*)(P.out + (size_t)t * D);
        float4 v[4]; float ss = 0.f;
#pragma unroll
        for (int q = 0; q < 4; ++q) { v[q] = hr[q * 64 + lane]; ss += v[q].x * v[q].x + v[q].y * v[q].y + v[q].z * v[q].z + v[q].w * v[q].w; }
        ss = wave_sum(ss);
        const float rn = rsqrtf(ss * (1.f / D) + EPS);
        const float4* g = (const float4*)((l == DEPTH - 1) ? P.norm_final : (P.norm_mix + (l + 1) * D));
#pragma unroll
        for (int q = 0; q < 4; ++q) {
            const float4 gg = g[q * 64 + lane];
            const float4 o = make_float4(v[q].x * rn * gg.x, v[q].y * rn * gg.y, v[q].z * rn * gg.z, v[q].w * rn * gg.w);
            if (l == DEPTH - 1) hr[q * 64 + lane] = o;
            else { uint2 u; u.x = pack2(o.x, o.y); u.y = pack2(o.z, o.w); ((uint2*)(XNw + (size_t)t * LDX))[q * 64 + lane] = u; }
        }
    }
}

#define XB_TMO      128
#define XB_XCNT(j)  (256  + 64 * (j))
#define XB_XSUB(j)  (1280 + 64 * (j))
#define XB_XGEN(j)  (2304 + 64 * (j))
#define XB_TOP      3328
#define XB_TOPGEN   3392
#define XCD_BAR_WORDS 3456
#define XB_SPIN_CAP (1u << 22)
#define LAS __attribute__((address_space(3)))
__device__ __forceinline__ unsigned xb_ld(unsigned* p)              { return __hip_atomic_load(p, __ATOMIC_RELAXED, __HIP_MEMORY_SCOPE_AGENT); }
__device__ __forceinline__ unsigned xb_add(unsigned* p, unsigned v) { return __hip_atomic_fetch_add(p, v, __ATOMIC_RELAXED, __HIP_MEMORY_SCOPE_AGENT); }
__device__ __forceinline__ unsigned xb_xcc_id() { return (unsigned)__builtin_amdgcn_s_getreg((3 << 11) | 20) & 0xFu; }
#define XB_SPIN(cond, bar) do { unsigned _sp = 0; while (cond) { __builtin_amdgcn_s_sleep(1); \
    if ((++_sp & 255u) == 0u) { if (xb_ld(&(bar)[XB_TMO])) break; if (_sp > XB_SPIN_CAP) { atomicAdd(&(bar)[XB_TMO], 1u); break; } } } } while (0)
struct XcdBarrier { unsigned* bar; unsigned x; volatile LAS unsigned* st; };
__device__ __forceinline__ XcdBarrier xcd_barrier_post(unsigned* bar, volatile LAS unsigned* st) {
    XcdBarrier b; b.bar = bar; b.x = xb_xcc_id(); b.st = st;
    if (__builtin_amdgcn_workitem_id_x() == 0) (void)xb_add(&bar[XB_XCNT(b.x)], 1u);
    return b;
}
__device__ __forceinline__ void xcd_barrier_complete(unsigned* bar, unsigned x, unsigned& nloc, unsigned& nx) {
    const unsigned G = gridDim.x * gridDim.y * gridDim.z;
    unsigned sum, cnt, mine, sp = 0u;
    for (;;) {
        sum = 0u; cnt = 0u; mine = 0u;
#pragma unroll
        for (unsigned j = 0; j < 16; ++j) { const unsigned c = xb_ld(&bar[XB_XCNT(j)]); sum += c; cnt += (c > 0u) ? 1u : 0u; mine = (j == x) ? c : mine; }
        if (sum == G) break;
        __builtin_amdgcn_s_sleep(1);
        if ((++sp & 255u) == 0u) { if (xb_ld(&bar[XB_TMO])) break; if (sp > XB_SPIN_CAP) { atomicAdd(&bar[XB_TMO], 1u); break; } }
    }
    nloc = mine > 0u ? mine : 1u; nx = cnt > 0u ? cnt : 1u;
}
__device__ __forceinline__ void xcd_barrier(const XcdBarrier& b) {
    asm volatile("s_waitcnt vmcnt(0)" ::: "memory");
    __syncthreads();
    if (__builtin_amdgcn_workitem_id_x() == 0) {
        unsigned* bar = b.bar;
        __builtin_amdgcn_s_waitcnt(0);
        unsigned nloc = b.st[0], nx = b.st[1];
        if (nloc == 0u) { xcd_barrier_complete(bar, b.x, nloc, nx); b.st[0] = nloc; b.st[1] = nx; }
        const unsigned old = xb_add(&bar[XB_XSUB(b.x)], 1u);
        const unsigned gen = old / nloc;
        if (old + 1u == (gen + 1u) * nloc) {
            __builtin_amdgcn_fence(__ATOMIC_RELEASE, "agent");
            asm volatile("s_waitcnt vmcnt(0)" ::: "memory");
            const unsigned og = xb_add(&bar[XB_TOP], 1u);
            const unsigned tg = og / nx;
            if (og + 1u == (tg + 1u) * nx) xb_add(&bar[XB_TOPGEN], 1u);
            else XB_SPIN(xb_ld(&bar[XB_TOPGEN]) == tg, bar);
            __builtin_amdgcn_fence(__ATOMIC_ACQUIRE, "agent");
            xb_add(&bar[XB_XGEN(b.x)], 1u);
            asm volatile("s_waitcnt vmcnt(0)" ::: "memory");
        } else {
            XB_SPIN(xb_ld(&bar[XB_XGEN(b.x)]) == gen, bar);
            __builtin_amdgcn_fence(__ATOMIC_ACQUIRE, "agent");
            asm volatile("s_waitcnt vmcnt(0)" ::: "memory");
        }
    }
    __syncthreads();
}

constexpr float QSCALE = 0.10206207261596575f * 1.4426950408889634f;

__device__ __forceinline__ void phase_gemm1(const Params& P, int l, char* lds) {
    unsigned char* ws = P.ws;
    const bf16* XN = (const bf16*)(ws + WS_XN);
    bf16* PROJ = (bf16*)(ws + WS_PROJ);
    bf16* Kb = (bf16*)(ws + WS_K);
    const float* rope = (const float*)(ws + WS_ROPE);
    const bf16* W = (const bf16*)(ws + WS_WIN) + (size_t)l * DINP * LDW;
    gemm_t<false>(W, LDW, DINP, XN, LDX, T, D, C_KR / 128, [&](int n0, int t0, const f32x16& acc, int r32, int hi, float) {
        const int t = t0 + r32;
        if (n0 < C_KR) {
            bf16* pr = PROJ + (size_t)t * DINP + n0 + 4 * hi;
#pragma unroll
            for (int g = 0; g < 4; ++g) { uint2 o; o.x = cvtpk(acc[4 * g], acc[4 * g + 1]); o.y = cvtpk(acc[4 * g + 2], acc[4 * g + 3]); *(uint2*)(pr + 8 * g) = o; }
        } else if (n0 == C_KR) {
            const int b = t / S, s = t % S;
            uint2 o1[2], o2[2];
#pragma unroll
            for (int g = 0; g < 2; ++g) {
                const float4 cs0 = *(const float4*)(rope + ((size_t)s * 16 + 8 * g + 4 * hi) * 2), cs1 = *(const float4*)(rope + ((size_t)s * 16 + 8 * g + 4 * hi) * 2 + 4);
                const float x10 = acc[4 * g], x11 = acc[4 * g + 1], x12 = acc[4 * g + 2], x13 = acc[4 * g + 3];
                const float x20 = acc[8 + 4 * g], x21 = acc[8 + 4 * g + 1], x22 = acc[8 + 4 * g + 2], x23 = acc[8 + 4 * g + 3];
                o1[g].x = cvtpk(x10 * cs0.x - x20 * cs0.y, x11 * cs0.z - x21 * cs0.w); o1[g].y = cvtpk(x12 * cs1.x - x22 * cs1.y, x13 * cs1.z - x23 * cs1.w);
                o2[g].x = cvtpk(x20 * cs0.x + x10 * cs0.y, x21 * cs0.z + x11 * cs0.w); o2[g].y = cvtpk(x22 * cs1.x + x12 * cs1.y, x23 * cs1.z + x13 * cs1.w);
            }
#pragma unroll
            for (int h = 0; h < NH; ++h) {
                bf16* kr = Kb + ((size_t)(b * NH + h) * S + s) * DQK + 64 + 4 * hi;
                *(uint2*)(kr) = o1[0]; *(uint2*)(kr + 8) = o1[1]; *(uint2*)(kr + 16) = o2[0]; *(uint2*)(kr + 24) = o2[1];
            }
        }
    }, [&](int t, int n, const float4& v) {
        uint2 o; o.x = cvtpk(v.x, v.y); o.y = cvtpk(v.z, v.w);
        *(uint2*)(PROJ + (size_t)t * DINP + n) = o;
    }, lds);
}
__device__ __forceinline__ void phase_gemm2(const Params& P, int l, char* lds) {
    unsigned char* ws = P.ws;
    const bf16* PROJ = (const bf16*)(ws + WS_PROJ);
    const float* rope = (const float*)(ws + WS_ROPE);
    {
        const bf16* W = (const bf16*)(ws + WS_WUQ) + (size_t)l * 768 * QR;
        bf16* Qb = (bf16*)(ws + WS_Q);
        gemm_t<true>(W, QR, 768, PROJ + C_CQ, DINP, T, QR, 0, [&](int n0, int t0, const f32x16& acc, int r32, int hi, float ssq) {
            const int t = t0 + r32, b = t / S, s = t % S;
            const int h = n0 / DQK, d0 = n0 % DQK;
            const float sc = rsqrtf(ssq * (1.f / QR) + EPS) * QSCALE;
            bf16* qb = Qb + ((size_t)(b * NH + h) * S + s) * DQK + d0 + 4 * hi;
            if (d0 == 64) {
#pragma unroll
                for (int g = 0; g < 2; ++g) {
                    const float4 cs0 = *(const float4*)(rope + ((size_t)s * 16 + 8 * g + 4 * hi) * 2), cs1 = *(const float4*)(rope + ((size_t)s * 16 + 8 * g + 4 * hi) * 2 + 4);
                    const float x10 = acc[4 * g] * sc, x11 = acc[4 * g + 1] * sc, x12 = acc[4 * g + 2] * sc, x13 = acc[4 * g + 3] * sc;
                    const float x20 = acc[8 + 4 * g] * sc, x21 = acc[8 + 4 * g + 1] * sc, x22 = acc[8 + 4 * g + 2] * sc, x23 = acc[8 + 4 * g + 3] * sc;
                    uint2 o1, o2;
                    o1.x = cvtpk(x10 * cs0.x - x20 * cs0.y, x11 * cs0.z - x21 * cs0.w); o1.y = cvtpk(x12 * cs1.x - x22 * cs1.y, x13 * cs1.z - x23 * cs1.w);
                    o2.x = cvtpk(x20 * cs0.x + x10 * cs0.y, x21 * cs0.z + x11 * cs0.w); o2.y = cvtpk(x22 * cs1.x + x12 * cs1.y, x23 * cs1.z + x13 * cs1.w);
                    *(uint2*)(qb + 8 * g) = o1; *(uint2*)(qb + 16 + 8 * g) = o2;
                }
            } else {
#pragma unroll
                for (int g = 0; g < 4; ++g) { uint2 o; o.x = cvtpk(acc[4 * g] * sc, acc[4 * g + 1] * sc); o.y = cvtpk(acc[4 * g + 2] * sc, acc[4 * g + 3] * sc); *(uint2*)(qb + 8 * g) = o; }
            }
        }, [](int, int, const float4&) {}, lds);
    }
    {
        const bf16* W = (const bf16*)(ws + WS_WUKV) + (size_t)l * 1024 * KVR;
        bf16* Kb = (bf16*)(ws + WS_K); bf16* Vb = (bf16*)(ws + WS_V);
        gemm_t<true>(W, KVR, 1024, PROJ + C_CKV, DINP, T, KVR, 0, [&](int n0, int t0, const f32x16& acc, int r32, int hi, float ssq) {
            const int t = t0 + r32, b = t / S, s = t % S;
            const float sc = rsqrtf(ssq * (1.f / KVR) + EPS);
            bf16* dst;
            if (n0 < 512) dst = Kb + ((size_t)(b * NH + (n0 >> 6)) * S + s) * DQK + (n0 & 63) + 4 * hi;
            else          dst = Vb + ((size_t)(b * NH + ((n0 - 512) >> 6)) * S + s) * DV + (n0 & 63) + 4 * hi;
#pragma unroll
            for (int g = 0; g < 4; ++g) { uint2 o; o.x = cvtpk(acc[4 * g] * sc, acc[4 * g + 1] * sc); o.y = cvtpk(acc[4 * g + 2] * sc, acc[4 * g + 3] * sc); *(uint2*)(dst + 8 * g) = o; }
        }, [](int, int, const float4&) {}, lds);
    }
}
__device__ __forceinline__ void phase_gemm3(const Params& P, int l, char* lds) {
    unsigned char* ws = P.ws;
    const bf16* Yb = (const bf16*)(ws + WS_XN);
    const bf16* W = (const bf16*)(ws + WS_WOUT) + (size_t)l * D * LDW;
    const float* hin = (l == 0) ? P.x : P.out;
    float* out = P.out;
    gemm_t<false>(W, LDW, D, Yb, LDX, T, D, D / 128, [](int, int, const f32x16&, int, int, float) {}, [&](int t, int n, const float4& v) {
        const size_t idx = (size_t)t * D + n;
        const float4 hv = *(const float4*)(hin + idx);
        *(float4*)(out + idx) = make_float4(hv.x + v.x, hv.y + v.y, hv.z + v.z, hv.w + v.w);
    }, lds);
}

#define GSYNC() do { XcdBarrier xb_; { __attribute__((address_space(1))) char* gp_ = (__attribute__((address_space(1))) char*)(char*)(P.ws + WS_CTL); asm volatile("" : "+s"(gp_)); xb_.bar = (unsigned*)(char*)gp_; } \
    xb_.x = xb_xcc_id(); xb_.st = (volatile LAS unsigned*)&xb_words; xcd_barrier(xb_); } while (0)
#define PHASE(stmt) { const Params Q = launder(P); stmt; }
__global__ void __launch_bounds__(NTHREADS, 2) k_all(Params P) {
    __shared__ __attribute__((aligned(16))) char sm[LDS_TOTAL];
    __shared__ uint4 xb_words;
    cg::grid_group grid = cg::this_grid();
    if (__builtin_amdgcn_workitem_id_x() == 0) xb_words = make_uint4(0u, 0u, 0u, 0u);
    __syncthreads();
    (void)xcd_barrier_post((unsigned*)(P.ws + WS_CTL), (volatile LAS unsigned*)&xb_words);
    __shared__ int xinfo[8];
    if (__builtin_amdgcn_workitem_id_x() == 0) {
        const unsigned x = xb_xcc_id();
        xinfo[XI_X] = (int)x; xinfo[XI_RANK] = (int)xb_add((unsigned*)(P.ws + WS_CTL) + CTL_CENSUS + x, 1u);
    }
    PHASE(phase_prep(Q, sm));
    PHASE(phase_norm(Q.x, Q.norm_mix, (bf16*)(Q.ws + WS_XN)));
    grid.sync();
    if (__builtin_amdgcn_workitem_id_x() == 0) {
        unsigned* cen = (unsigned*)(P.ws + WS_CTL) + CTL_CENSUS;
        const int x = xinfo[XI_X]; int nx = 0, jj = 0;
        for (int q = 0; q < 16; ++q) { const unsigned cq = xb_ld(cen + q); if (cq) { if (q < x) ++jj; ++nx; } }
        xinfo[XI_J] = jj; xinfo[XI_NX] = nx; xinfo[XI_NLOC] = (int)xb_ld(cen + x);
    }
    __syncthreads();
    for (int l = 0; l < DEPTH; ++l) {
        PHASE(phase_gemm1(Q, l, sm));
#if PROBE_DUP & 2
        PHASE(phase_gemm1(Q, l, sm));
#endif
        GSYNC();
        PHASE(phase_mixlocal(Q, l, sm));
#if PROBE_DUP & 256
        PHASE(phase_mixlocal(Q, l, sm));
#endif
        PHASE(phase_gemm2(Q, l, sm));
        GSYNC();
        PHASE(phase_attn(Q, sm));
        GSYNC();
        PHASE(phase_gemm3(Q, l, sm));
#if PROBE_DUP & 16
        if (l == 0) PHASE(phase_gemm3(Q, l, sm));
#endif
        GSYNC();
        PHASE(phase_norm(Q.out, Q.norm_ffn + l * D, (bf16*)(Q.ws + WS_XN)));
        GSYNC();
        PHASE(phase_route(Q, l, sm));
        GSYNC();
        PHASE(phase_gu(Q, l, xinfo));
        GSYNC();
        PHASE(phase_gw(Q, l));
        GSYNC();
        PHASE(phase_gv(Q, l, xinfo));
        GSYNC();
        PHASE(phase_gnorm(Q, l));
        GSYNC();
    }
}

extern "C" void kernel_launch(void* const* d_in, const int* in_sizes, int n_in, void* d_out, int out_size, void* d_ws, size_t ws_size, hipStream_t stream) {
    static int grid = 0;
    if (grid == 0) {
        if (n_in != 18 || out_size != T * D || ws_size < WS_END) { fprintf(stderr, "kernel_launch: bad sizes n_in %d out %d ws %zu need %zu\n", n_in, out_size, ws_size, (size_t)WS_END); grid = -1; return; }
        int dev = 0, cus = 0, per_cu = 0;
        (void)hipGetDevice(&dev);
        (void)hipDeviceGetAttribute(&cus, hipDeviceAttributeMultiprocessorCount, dev);
        (void)hipOccupancyMaxActiveBlocksPerMultiprocessor(&per_cu, (const void*)k_all, NTHREADS, 0);
        if (per_cu > 2) per_cu = 2;
        if (per_cu < 1) { fprintf(stderr, "kernel_launch: occupancy query says %d\n", per_cu); grid = -1; return; }
        grid = cus * per_cu;
    }
    if (grid < 0) return;
    Params p{};
    p.x = (const float*)d_in[0]; p.norm_mix = (const float*)d_in[1]; p.w_in = (const float*)d_in[2]; p.conv_w = (const float*)d_in[3];
    p.pool_w = (const float*)d_in[4]; p.pool_scale = (const float*)d_in[5]; p.q_norm = (const float*)d_in[6]; p.w_uq = (const float*)d_in[7];
    p.kv_norm = (const float*)d_in[8]; p.w_uk = (const float*)d_in[9]; p.w_uv = (const float*)d_in[10]; p.w_out = (const float*)d_in[11];
    p.norm_ffn = (const float*)d_in[12]; p.peer_wq = (const float*)d_in[13]; p.peer_subkeys = (const float*)d_in[14]; p.peer_u = (const float*)d_in[15];
    p.peer_v = (const float*)d_in[16]; p.norm_final = (const float*)d_in[17];
    p.out = (float*)d_out; p.ws = (unsigned char*)d_ws;
    if (hipMemsetAsync((char*)d_ws + WS_CTL, 0, CTL_BYTES, stream) != hipSuccess) { fprintf(stderr, "kernel_launch: memset failed\n"); return; }
    void* args[] = {&p};
    hipError_t e = hipLaunchCooperativeKernel((const void*)k_all, dim3(grid), dim3(NTHREADS), args, 0, stream);
    if (e != hipSuccess) fprintf(stderr, "cooperative launch failed: %s (grid %d)\n", hipGetErrorString(e), grid);
}
```

```cpp
#include <hip/hip_runtime.h>
#include <hip/hip_cooperative_groups.h>
#include <cstdio>
#include <cstdint>
namespace cg = cooperative_groups;

#ifndef TAB_FP8
#define TAB_FP8 1
#endif
#ifndef PROBE_DUP
#define PROBE_DUP 0
#endif

constexpr int NB = 4, S = 8192, T = NB * S, D = 1024, DEPTH = 2;
constexpr int DIN = 1696, DINP = 1792;
constexpr int C_BG = 0, C_CG = 256, C_HC = 512, C_HP = 768, C_CQ = 1024, C_CKV = 1408, C_KR = 1664;
constexpr int QR = 384, KVR = 256, NH = 8, DQK = 96, DV = 64;
constexpr int PH = 8, NKEY = 128, NEXP = NKEY * NKEY, TOPK = 16, HK = PH * TOPK;
constexpr float EPS = 1e-6f;
constexpr int LDX = 1088;
constexpr int LDW = 1088;

typedef unsigned short bf16;

constexpr size_t WS_CTL   = 0;
constexpr size_t WS_ROPE  = 64 * 1024;
constexpr size_t WS_WIN   = WS_ROPE + (size_t)S * 16 * 2 * 4;
constexpr size_t WS_WUQ   = WS_WIN + (size_t)DEPTH * DINP * LDW * 2;
constexpr size_t WS_WUKV  = WS_WUQ + (size_t)DEPTH * 768 * QR * 2;
constexpr size_t WS_WOUT  = WS_WUKV + (size_t)DEPTH * 1024 * KVR * 2;
constexpr size_t WS_WPQ   = WS_WOUT + (size_t)DEPTH * D * LDW * 2;
constexpr size_t WS_XN    = ((WS_WPQ + (size_t)DEPTH * 2048 * LDW * 2 + 4095) / 4096) * 4096;
constexpr size_t WS_PROJ  = WS_XN + (size_t)T * LDX * 2;
constexpr size_t WS_Q     = WS_PROJ + (size_t)T * DINP * 2;
constexpr size_t WS_K     = WS_Q + (size_t)T * NH * DQK * 2;
constexpr size_t WS_V     = WS_K + (size_t)T * NH * DQK * 2;
constexpr size_t WS_EXP   = WS_V + (size_t)T * NH * DV * 2;
constexpr size_t WS_GATE  = WS_EXP + (size_t)T * HK * 4;
constexpr size_t TAB_ROWB = TAB_FP8 ? 1024 : 2048;
constexpr size_t WS_TABU  = WS_GATE + (size_t)T * HK * 4;
constexpr size_t WS_TABV  = WS_TABU + (size_t)DEPTH * NEXP * TAB_ROWB;
constexpr size_t WS_TSCU  = WS_TABV + (size_t)DEPTH * NEXP * TAB_ROWB;
constexpr size_t WS_TSCV  = WS_TSCU + (size_t)DEPTH * NEXP * 4;
constexpr size_t WS_XQ    = WS_TSCV + (size_t)DEPTH * NEXP * 4;
constexpr size_t WS_XS    = WS_XQ + (size_t)T * D;
constexpr size_t WS_END   = WS_XS + (size_t)T * 4;
static_assert(WS_END <= (size_t)512 * 1024 * 1024, "workspace budget");

struct Params {
    const float* x; const float* norm_mix; const float* w_in; const float* conv_w; const float* pool_w; const float* pool_scale;
    const float* q_norm; const float* w_uq; const float* kv_norm; const float* w_uk; const float* w_uv; const float* w_out;
    const float* norm_ffn; const float* peer_wq; const float* peer_subkeys; const float* peer_u; const float* peer_v; const float* norm_final;
    float* out; unsigned char* ws;
};

__device__ __forceinline__ bf16 f2bf(float f) { unsigned u = __float_as_uint(f); u += 0x7fffu + ((u >> 16) & 1u); return (bf16)(u >> 16); }
__device__ __forceinline__ float bf2f(bf16 h) { return __uint_as_float(((unsigned)h) << 16); }
__device__ __forceinline__ float bflo(unsigned u) { return __uint_as_float(u << 16); }
__device__ __forceinline__ float bfhi(unsigned u) { return __uint_as_float(u & 0xffff0000u); }
__device__ __forceinline__ unsigned pack2(float a, float b) { return (unsigned)f2bf(a) | ((unsigned)f2bf(b) << 16); }
__device__ __forceinline__ float wave_sum(float v) {
#pragma unroll
    for (int m = 32; m >= 1; m >>= 1) v += __shfl_xor(v, m, 64);
    return v;
}
__device__ __forceinline__ float gelu_exact(float x) { return 0.5f * x * (1.f + erff(x * 0.70710678118654752f)); }

#define NTHREADS 256
__device__ __forceinline__ int tidx() { int t = (int)__builtin_amdgcn_workitem_id_x(); asm volatile("" : "+v"(t)); return t; }
__device__ __forceinline__ int gwave() { return blockIdx.x * (NTHREADS / 64) + (tidx() >> 6); }
__device__ __forceinline__ int nwave() { return gridDim.x * (NTHREADS / 64); }
__device__ __forceinline__ size_t gtid() { return (size_t)blockIdx.x * NTHREADS + tidx(); }
__device__ __forceinline__ size_t gnth() { return (size_t)gridDim.x * NTHREADS; }


__device__ __forceinline__ Params launder(const Params& P) {
    typedef __attribute__((address_space(1))) char* gp_t;
    gp_t g[20] = {(gp_t)(char*)P.x, (gp_t)(char*)P.norm_mix, (gp_t)(char*)P.w_in, (gp_t)(char*)P.conv_w, (gp_t)(char*)P.pool_w, (gp_t)(char*)P.pool_scale, (gp_t)(char*)P.q_norm, (gp_t)(char*)P.w_uq,
                  (gp_t)(char*)P.kv_norm, (gp_t)(char*)P.w_uk, (gp_t)(char*)P.w_uv, (gp_t)(char*)P.w_out, (gp_t)(char*)P.norm_ffn, (gp_t)(char*)P.peer_wq, (gp_t)(char*)P.peer_subkeys,
                  (gp_t)(char*)P.peer_u, (gp_t)(char*)P.peer_v, (gp_t)(char*)P.norm_final, (gp_t)(char*)P.out, (gp_t)(char*)P.ws};
    asm volatile("" : "+s"(g[0]), "+s"(g[1]), "+s"(g[2]), "+s"(g[3]), "+s"(g[4]), "+s"(g[5]), "+s"(g[6]), "+s"(g[7]), "+s"(g[8]), "+s"(g[9]));
    asm volatile("" : "+s"(g[10]), "+s"(g[11]), "+s"(g[12]), "+s"(g[13]), "+s"(g[14]), "+s"(g[15]), "+s"(g[16]), "+s"(g[17]), "+s"(g[18]), "+s"(g[19]));
    Params Q;
    Q.x = (const float*)(char*)g[0]; Q.norm_mix = (const float*)(char*)g[1]; Q.w_in = (const float*)(char*)g[2]; Q.conv_w = (const float*)(char*)g[3]; Q.pool_w = (const float*)(char*)g[4];
    Q.pool_scale = (const float*)(char*)g[5]; Q.q_norm = (const float*)(char*)g[6]; Q.w_uq = (const float*)(char*)g[7]; Q.kv_norm = (const float*)(char*)g[8]; Q.w_uk = (const float*)(char*)g[9];
    Q.w_uv = (const float*)(char*)g[10]; Q.w_out = (const float*)(char*)g[11]; Q.norm_ffn = (const float*)(char*)g[12]; Q.peer_wq = (const float*)(char*)g[13]; Q.peer_subkeys = (const float*)(char*)g[14];
    Q.peer_u = (const float*)(char*)g[15]; Q.peer_v = (const float*)(char*)g[16]; Q.norm_final = (const float*)(char*)g[17]; Q.out = (float*)(char*)g[18]; Q.ws = (unsigned char*)(char*)g[19];
    return Q;
}

typedef __attribute__((ext_vector_type(8))) short bf16x8;
typedef __attribute__((ext_vector_type(16))) float f32x16;
typedef __attribute__((ext_vector_type(2))) __bf16 bf2_t;
#define MFMA32(a, b, c) __builtin_amdgcn_mfma_f32_32x32x16_bf16(a, b, c, 0, 0, 0)
__device__ __forceinline__ int crow(int r, int hi) { return (r & 3) + 8 * (r >> 2) + 4 * hi; }
__device__ __forceinline__ float dot2bf(unsigned a, unsigned b, float c) { return __builtin_amdgcn_fdot2_f32_bf16(__builtin_bit_cast(bf2_t, a), __builtin_bit_cast(bf2_t, b), c, false); }
__device__ __forceinline__ unsigned cvtpk(float lo, float hi) { unsigned r; asm("v_cvt_pk_bf16_f32 %0, %1, %2" : "=v"(r) : "v"(lo), "v"(hi)); return r; }
constexpr int G_OPB = 128 * 128;
constexpr int G_BUF = 2 * G_OPB;
constexpr int GEMM_LDS = 2 * G_BUF;
constexpr int LDS_TOTAL = GEMM_LDS + 8192;

template <int WT, bool ROWSS>
__device__ __forceinline__ void gemm_kloop(const bf16* __restrict__ Ag0, int lda, const bf16* __restrict__ Bg0, int ldb, int nk, f32x16 (&acc)[4], float (&ss)[4], char* lds, int tid) {
    const int lane = tid & 63, w = __builtin_amdgcn_readfirstlane(tid >> 6), r32 = lane & 31, hi = lane >> 5;
    const int srow = 8 * w + (lane >> 3);
    const int sch = (lane & 7) ^ ((srow >> 1) & 7);
    const bf16* Ag = Ag0 + (size_t)srow * lda + sch * 8;
    const bf16* Bg = Bg0 + (size_t)srow * ldb + sch * 8;
#pragma unroll
    for (int i = 0; i < 4; ++i)
#pragma unroll
        for (int r = 0; r < 16; ++r) acc[i][r] = 0.f;
    ss[0] = 0.f; ss[1] = 0.f; ss[2] = 0.f; ss[3] = 0.f;
    typedef __attribute__((address_space(3))) unsigned* ldsp_t;
    typedef const __attribute__((address_space(1))) unsigned* glbp_t;
#define G_DMA(buf, kofs) do { char* d_ = lds + (buf) * G_BUF + (8 * w) * 128; \
    _Pragma("unroll") for (int i = 0; i < 4; ++i) { \
        __builtin_amdgcn_global_load_lds((glbp_t)(const void*)(Ag + (size_t)(32 * i) * lda + (kofs)), (ldsp_t)(void*)(d_ + i * 4096), 16, 0, 0); \
        __builtin_amdgcn_global_load_lds((glbp_t)(const void*)(Bg + (size_t)(32 * i) * ldb + (kofs)), (ldsp_t)(void*)(d_ + G_OPB + i * 4096), 16, 0, 0); } } while (0)
    const int xr = (r32 >> 1) & 7;
    const int o0 = ((0 + hi) ^ xr) << 4, o1 = ((2 + hi) ^ xr) << 4, o2 = ((4 + hi) ^ xr) << 4, o3 = ((6 + hi) ^ xr) << 4;
#define G_SS(s_, r_) do { union { bf16x8 v; uint4 u; } c_; c_.v = r_; s_ = dot2bf(c_.u.x, c_.u.x, s_); s_ = dot2bf(c_.u.y, c_.u.y, s_); s_ = dot2bf(c_.u.z, c_.u.z, s_); s_ = dot2bf(c_.u.w, c_.u.w, s_); } while (0)
#define G_STEP(pa, pb, off) do { \
    if (WT == 0) { \
        const bf16x8 a0 = *(const bf16x8*)(pa + off), a1 = *(const bf16x8*)(pa + 32 * 128 + off); \
        const bf16x8 b0 = *(const bf16x8*)(pb + off), b1 = *(const bf16x8*)(pb + 32 * 128 + off); \
        if (ROWSS) { G_SS(ss[0], b0); G_SS(ss[1], b1); } \
        acc[0] = MFMA32(a0, b0, acc[0]); acc[1] = MFMA32(a0, b1, acc[1]); \
        acc[2] = MFMA32(a1, b0, acc[2]); acc[3] = MFMA32(a1, b1, acc[3]); \
    } else { \
        const bf16x8 b0 = *(const bf16x8*)(pb + off); \
        const bf16x8 a0 = *(const bf16x8*)(pa + off), a1 = *(const bf16x8*)(pa + 32 * 128 + off); \
        const bf16x8 a2 = *(const bf16x8*)(pa + 64 * 128 + off), a3 = *(const bf16x8*)(pa + 96 * 128 + off); \
        acc[0] = MFMA32(a0, b0, acc[0]); acc[1] = MFMA32(a1, b0, acc[1]); \
        acc[2] = MFMA32(a2, b0, acc[2]); acc[3] = MFMA32(a3, b0, acc[3]); \
    } } while (0)
    const int arow = (WT == 0) ? ((w >> 1) * 64 + r32) : r32;
    const int brow = (WT == 0) ? ((w & 1) * 64 + r32) : (w * 32 + r32);
    G_DMA(0, 0);
    for (int kt = 0; kt < nk; ++kt) {
        __syncthreads();
        if (kt + 1 < nk) G_DMA((kt + 1) & 1, (kt + 1) * 64);
        const char* pa = lds + (kt & 1) * G_BUF + arow * 128;
        const char* pb = lds + (kt & 1) * G_BUF + G_OPB + brow * 128;
        G_STEP(pa, pb, o0); G_STEP(pa, pb, o1); G_STEP(pa, pb, o2); G_STEP(pa, pb, o3);
    }
    if (ROWSS) { ss[0] += __shfl_xor(ss[0], 32, 64); ss[1] += __shfl_xor(ss[1], 32, 64); }
#undef G_DMA
#undef G_SS
#undef G_STEP
}

constexpr int ST_P = 68;
static_assert(4 * 64 * ST_P * 4 <= LDS_TOTAL, "staging LDS");
template <bool ROWSS, class EPI, class EPIROW>
__device__ __forceinline__ void gemm_t(const bf16* __restrict__ Wt, int ldw, int N, const bf16* __restrict__ X, int ldx, int M, int K, int tn_direct, EPI epi, EPIROW epirow, char* lds) {
    const int tid = tidx(), lane = tid & 63, w = tid >> 6, r32 = lane & 31, hi = lane >> 5;
    const int tilesN = N / 128, tilesM = M / 128, nk = K / 64;
    for (int tile = blockIdx.x; tile < tilesM * tilesN; tile += gridDim.x) {
        const int tm = tile / tilesN, tn = tile % tilesN;
        f32x16 acc[4]; float ss[4];
        gemm_kloop<0, ROWSS>(Wt + (size_t)(tn * 128) * ldw, ldw, X + (size_t)(tm * 128) * ldx, ldx, nk, acc, ss, lds, tid);
        if (tn < tn_direct) {
            __syncthreads();
            float* st = (float*)lds + w * (64 * ST_P);
#pragma unroll
            for (int i = 0; i < 2; ++i)
#pragma unroll
                for (int j = 0; j < 2; ++j)
#pragma unroll
                    for (int g = 0; g < 4; ++g)
                        *(float4*)(st + (32 * j + r32) * ST_P + 32 * i + 8 * g + 4 * hi) = make_float4(acc[i * 2 + j][4 * g], acc[i * 2 + j][4 * g + 1], acc[i * 2 + j][4 * g + 2], acc[i * 2 + j][4 * g + 3]);
            const int rr = lane >> 4, ch = lane & 15;
#pragma unroll 4
            for (int it = 0; it < 16; ++it) {
                const int row = it * 4 + rr;
                const float4 v = *(const float4*)(st + row * ST_P + ch * 4);
                epirow(tm * 128 + (w & 1) * 64 + row, tn * 128 + (w >> 1) * 64 + ch * 4, v);
            }
        } else {
#pragma unroll
            for (int i = 0; i < 2; ++i)
#pragma unroll
                for (int j = 0; j < 2; ++j) {
                    const int tl = (w & 1) * 64 + j * 32;
                    epi(tn * 128 + (w >> 1) * 64 + i * 32, tm * 128 + tl, acc[i * 2 + j], r32, hi, ss[j]);
                }
        }
        __syncthreads();
    }
}

__device__ __forceinline__ void transpose_tiled(const float* __restrict__ W, bf16* __restrict__ Wt, int K, int N, int Npad, int ldk, const float* __restrict__ gain, char* lds) {
    float (*tl)[65] = (float (*)[65])lds;
    const int tid = tidx(), a = tid & 63, q = tid >> 6;
    const int tK = K / 64, tN = Npad / 64;
    for (int tile = blockIdx.x; tile < tK * tN; tile += gridDim.x) {
        const int k0 = (tile / tN) * 64, n0 = (tile % tN) * 64;
#pragma unroll 4
        for (int i = 0; i < 16; ++i) {
            const int k = k0 + q * 16 + i, n = n0 + a;
            float v = (n < N) ? W[(size_t)k * N + n] : 0.f;
            if (gain) v *= gain[k];
            tl[q * 16 + i][a] = v;
        }
        __syncthreads();
#pragma unroll 4
        for (int i = 0; i < 16; ++i) { const int nl = q * 16 + i; Wt[(size_t)(n0 + nl) * ldk + k0 + a] = f2bf(tl[a][nl]); }
        __syncthreads();
    }
}

__device__ __forceinline__ void quant_row(const float4 (&v)[4], unsigned char* __restrict__ dst, float* __restrict__ scl, int r, int lane) {
    float am = 0.f;
#pragma unroll
    for (int j = 0; j < 4; ++j) am = fmaxf(am, fmaxf(fmaxf(fabsf(v[j].x), fabsf(v[j].y)), fmaxf(fabsf(v[j].z), fabsf(v[j].w))));
#pragma unroll
    for (int m = 32; m >= 1; m >>= 1) am = fmaxf(am, __shfl_xor(am, m, 64));
    const float sc = (am > 0.f) ? am * (1.f / 448.f) : 1.f;
    const float is = 1.f / sc;
    uint4 o;
    { int w = 0; w = __builtin_amdgcn_cvt_pk_fp8_f32(v[0].x * is, v[0].y * is, w, false); w = __builtin_amdgcn_cvt_pk_fp8_f32(v[0].z * is, v[0].w * is, w, true); o.x = (unsigned)w; }
    { int w = 0; w = __builtin_amdgcn_cvt_pk_fp8_f32(v[1].x * is, v[1].y * is, w, false); w = __builtin_amdgcn_cvt_pk_fp8_f32(v[1].z * is, v[1].w * is, w, true); o.y = (unsigned)w; }
    { int w = 0; w = __builtin_amdgcn_cvt_pk_fp8_f32(v[2].x * is, v[2].y * is, w, false); w = __builtin_amdgcn_cvt_pk_fp8_f32(v[2].z * is, v[2].w * is, w, true); o.z = (unsigned)w; }
    { int w = 0; w = __builtin_amdgcn_cvt_pk_fp8_f32(v[3].x * is, v[3].y * is, w, false); w = __builtin_amdgcn_cvt_pk_fp8_f32(v[3].z * is, v[3].w * is, w, true); o.w = (unsigned)w; }
    { const int lay = r / NEXP, e = r % NEXP; *(uint4*)(dst + (((size_t)(lay * 8 + (lane >> 3)) * NEXP + e) * 128) + (lane & 7) * 16) = o; }
    if (lane == 0) scl[r] = sc;
}
__device__ __forceinline__ unsigned pack_i8x4(float a, float b, float c, float d) {
    const int ia = __float2int_rn(a), ib = __float2int_rn(b), ic = __float2int_rn(c), id = __float2int_rn(d);
    return (unsigned)(ia & 255) | ((unsigned)(ib & 255) << 8) | ((unsigned)(ic & 255) << 16) | ((unsigned)(id & 255) << 24);
}
__device__ __forceinline__ void quant_row_i8(const float4 (&v)[4], unsigned char* __restrict__ dst, float* __restrict__ scl, int r, int lane) {
    float am = 0.f;
#pragma unroll
    for (int j = 0; j < 4; ++j) am = fmaxf(am, fmaxf(fmaxf(fabsf(v[j].x), fabsf(v[j].y)), fmaxf(fabsf(v[j].z), fabsf(v[j].w))));
#pragma unroll
    for (int m = 32; m >= 1; m >>= 1) am = fmaxf(am, __shfl_xor(am, m, 64));
    const float sc = (am > 0.f) ? am * (1.f / 127.f) : 1.f;
    const float is = 1.f / sc;
    uint4 o;
    o.x = pack_i8x4(v[0].x * is, v[0].y * is, v[0].z * is, v[0].w * is); o.y = pack_i8x4(v[1].x * is, v[1].y * is, v[1].z * is, v[1].w * is);
    o.z = pack_i8x4(v[2].x * is, v[2].y * is, v[2].z * is, v[2].w * is); o.w = pack_i8x4(v[3].x * is, v[3].y * is, v[3].z * is, v[3].w * is);
    { const int lay = r / NEXP, e = r % NEXP; *(uint4*)(dst + (((size_t)(lay * 8 + (lane >> 3)) * NEXP + e) * 128) + (lane & 7) * 16) = o; }
    if (lane == 0) scl[r] = sc;
}
template <bool I8>
__device__ __forceinline__ void convert_table(const float* __restrict__ src, unsigned char* __restrict__ dst, float* __restrict__ scl, int rows) {
    static_assert(TAB_FP8, "fp8 tables");
    const int lane = tidx() & 63;
    const int nw = nwave();
    for (int r = gwave(); r < rows; r += 2 * nw) {
        const int r2 = r + nw;
        float4 v0[4], v1[4];
        const float4* s0 = (const float4*)(src + (size_t)r * D);
        const float4* s1 = (const float4*)(src + (size_t)(r2 < rows ? r2 : r) * D);
#pragma unroll
        for (int j = 0; j < 4; ++j) { v0[j] = s0[lane * 4 + j]; v1[j] = s1[lane * 4 + j]; }
        if (I8) { quant_row_i8(v0, dst, scl, r, lane); if (r2 < rows) quant_row_i8(v1, dst, scl, r2, lane); }
        else { quant_row(v0, dst, scl, r, lane); if (r2 < rows) quant_row(v1, dst, scl, r2, lane); }
    }
}
__device__ __forceinline__ void phase_prep(const Params& P, char* lds) {
    unsigned char* ws = P.ws;
    for (int l = 0; l < DEPTH; ++l) {
        transpose_tiled(P.w_in + (size_t)l * D * DIN, (bf16*)(ws + WS_WIN) + (size_t)l * DINP * LDW, D, DIN, DINP, LDW, nullptr, lds);
        transpose_tiled(P.w_uq + (size_t)l * QR * 768, (bf16*)(ws + WS_WUQ) + (size_t)l * 768 * QR, QR, 768, 768, QR, P.q_norm + l * QR, lds);
        transpose_tiled(P.w_uk + (size_t)l * KVR * 512, (bf16*)(ws + WS_WUKV) + (size_t)l * 1024 * KVR, KVR, 512, 512, KVR, P.kv_norm + l * KVR, lds);
        transpose_tiled(P.w_uv + (size_t)l * KVR * 512, (bf16*)(ws + WS_WUKV) + (size_t)l * 1024 * KVR + (size_t)512 * KVR, KVR, 512, 512, KVR, P.kv_norm + l * KVR, lds);
        transpose_tiled(P.w_out + (size_t)l * D * D, (bf16*)(ws + WS_WOUT) + (size_t)l * D * LDW, D, D, D, LDW, nullptr, lds);
    }
    {
        bf16* Wc = (bf16*)(ws + WS_WPQ);
        float (*As)[68] = (float (*)[68])lds;
        float (*Bs)[68] = (float (*)[68])(lds + 16 * 68 * 4);
        const int tid = tidx(), tx = tid & 15, ty = tid >> 4;
        const int lr = tid >> 2, ld4 = (tid & 3) * 4;
        for (int tile = blockIdx.x; tile < (DEPTH * 2048 / 64) * (D / 64); tile += gridDim.x) {
            const int row0 = (tile >> 4) * 64, k0 = (tile & 15) * 64;
            const int l = row0 >> 11, hp = (row0 >> 7) & 15, n0 = row0 & 127;
            const float* skp = P.peer_subkeys + (((size_t)l * 2 + (hp & 1)) * NKEY + n0 + lr) * 128 + ld4;
            const float* wqp = P.peer_wq + ((size_t)l * D + k0 + lr) * 2048 + hp * 128 + ld4;
            float acc[4][4];
#pragma unroll
            for (int i = 0; i < 4; ++i)
#pragma unroll
                for (int j = 0; j < 4; ++j) acc[i][j] = 0.f;
            for (int d0 = 0; d0 < 128; d0 += 16) {
                const float4 av = *(const float4*)(skp + d0), bv = *(const float4*)(wqp + d0);
                As[ld4 + 0][lr] = av.x; As[ld4 + 1][lr] = av.y; As[ld4 + 2][lr] = av.z; As[ld4 + 3][lr] = av.w;
                Bs[ld4 + 0][lr] = bv.x; Bs[ld4 + 1][lr] = bv.y; Bs[ld4 + 2][lr] = bv.z; Bs[ld4 + 3][lr] = bv.w;
                __syncthreads();
#pragma unroll
                for (int kk = 0; kk < 16; ++kk) {
                    const float4 a4 = *(const float4*)&As[kk][ty * 4], b4 = *(const float4*)&Bs[kk][tx * 4];
                    const float aa[4] = {a4.x, a4.y, a4.z, a4.w}, bb[4] = {b4.x, b4.y, b4.z, b4.w};
#pragma unroll
                    for (int i = 0; i < 4; ++i)
#pragma unroll
                        for (int j = 0; j < 4; ++j) acc[i][j] = fmaf(aa[i], bb[j], acc[i][j]);
                }
                __syncthreads();
            }
#pragma unroll
            for (int i = 0; i < 4; ++i) {
                uint2 o; o.x = pack2(acc[i][0], acc[i][1]); o.y = pack2(acc[i][2], acc[i][3]);
                *(uint2*)(Wc + (size_t)(row0 + ty * 4 + i) * LDW + k0 + tx * 4) = o;
            }
        }
    }
    convert_table<true>(P.peer_u, ws + WS_TABU, (float*)(ws + WS_TSCU), DEPTH * NEXP);
    convert_table<false>(P.peer_v, ws + WS_TABV, (float*)(ws + WS_TSCV), DEPTH * NEXP);
    float* rope = (float*)(ws + WS_ROPE);
    for (size_t i = gtid(); i < (size_t)S * 16; i += gnth()) {
        const int s = (int)(i >> 4), f = (int)(i & 15);
        const double inv = pow(10000.0, -(double)f / 16.0);
        const double ang = (double)s * inv;
        rope[2 * i] = (float)cos(ang); rope[2 * i + 1] = (float)sin(ang);
    }
}

__device__ __forceinline__ void phase_norm(const float* __restrict__ h, const float* __restrict__ g, bf16* __restrict__ xn) {
    const int lane = tidx() & 63;
    for (int t = gwave(); t < T; t += nwave()) {
        const float4* hr = (const float4*)(h + (size_t)t * D);
        float4 v[4]; float ss = 0.f;
#pragma unroll
        for (int j = 0; j < 4; ++j) { v[j] = hr[j * 64 + lane]; ss += v[j].x * v[j].x + v[j].y * v[j].y + v[j].z * v[j].z + v[j].w * v[j].w; }
        ss = wave_sum(ss);
        const float r = rsqrtf(ss * (1.f / D) + EPS);
#pragma unroll
        for (int j = 0; j < 4; ++j) {
            const float4 gg = ((const float4*)g)[j * 64 + lane];
            uint2 o; o.x = pack2(v[j].x * r * gg.x, v[j].y * r * gg.y); o.y = pack2(v[j].z * r * gg.z, v[j].w * r * gg.w);
            ((uint2*)(xn + (size_t)t * LDX))[j * 64 + lane] = o;
        }
    }
}

__device__ __forceinline__ void phase_norm_q(const Params& P, int l) {
    const int lane = tidx() & 63;
    const float* g = P.norm_ffn + l * D;
    bf16* xn = (bf16*)(P.ws + WS_XN);
    unsigned* xq = (unsigned*)(P.ws + WS_XQ);
    float* xsc = (float*)(P.ws + WS_XS);
    for (int t = gwave(); t < T; t += nwave()) {
        const float4* hr = (const float4*)(P.out + (size_t)t * D);
        float4 v[4]; float ss = 0.f;
#pragma unroll
        for (int j = 0; j < 4; ++j) { v[j] = hr[j * 64 + lane]; ss += v[j].x * v[j].x + v[j].y * v[j].y + v[j].z * v[j].z + v[j].w * v[j].w; }
        ss = wave_sum(ss);
        const float r = rsqrtf(ss * (1.f / D) + EPS);
        float am = 0.f;
#pragma unroll
        for (int j = 0; j < 4; ++j) {
            const float4 gg = ((const float4*)g)[j * 64 + lane];
            v[j].x *= r * gg.x; v[j].y *= r * gg.y; v[j].z *= r * gg.z; v[j].w *= r * gg.w;
            am = fmaxf(am, fmaxf(fmaxf(fabsf(v[j].x), fabsf(v[j].y)), fmaxf(fabsf(v[j].z), fabsf(v[j].w))));
            uint2 o; o.x = pack2(v[j].x, v[j].y); o.y = pack2(v[j].z, v[j].w);
            ((uint2*)(xn + (size_t)t * LDX))[j * 64 + lane] = o;
        }
#pragma unroll
        for (int m = 32; m >= 1; m >>= 1) am = fmaxf(am, __shfl_xor(am, m, 64));
        const float sc = (am > 0.f) ? am * (1.f / 127.f) : 1.f, is = 1.f / sc;
#pragma unroll
        for (int j = 0; j < 4; ++j) xq[(size_t)t * (D / 4) + j * 64 + lane] = pack_i8x4(v[j].x * is, v[j].y * is, v[j].z * is, v[j].w * is);
        if (lane == 0) xsc[t] = sc;
    }
}

__device__ __forceinline__ void phase_mixlocal(const Params& P, int l, char* lds) {
    const bf16* proj = (const bf16*)(P.ws + WS_PROJ);
    bf16* Y = (bf16*)(P.ws + WS_XN);
    const int tid = tidx();
    {
        const float* cw = P.conv_w + (size_t)l * 3 * 256;
        for (size_t i = gtid(); i < (size_t)T * 32; i += gnth()) {
            const int t = (int)(i >> 5), c0 = (int)(i & 31) * 8, s = t & (S - 1);
            const bf16* pr = proj + (size_t)t * DINP;
            float acc[8];
#pragma unroll
            for (int e = 0; e < 8; ++e) acc[e] = 0.f;
#pragma unroll
            for (int j = 0; j < 3; ++j) {
                if (s - 2 + j >= 0) {
                    const bf16* pp = pr - (size_t)(2 - j) * DINP;
                    const uint4 g = *(const uint4*)(pp + C_CG + c0), hc = *(const uint4*)(pp + C_HC + c0);
                    const float4 w0 = *(const float4*)(cw + j * 256 + c0), w1 = *(const float4*)(cw + j * 256 + c0 + 4);
                    acc[0] = fmaf(w0.x, bflo(g.x) * bflo(hc.x), acc[0]); acc[1] = fmaf(w0.y, bfhi(g.x) * bfhi(hc.x), acc[1]);
                    acc[2] = fmaf(w0.z, bflo(g.y) * bflo(hc.y), acc[2]); acc[3] = fmaf(w0.w, bfhi(g.y) * bfhi(hc.y), acc[3]);
                    acc[4] = fmaf(w1.x, bflo(g.z) * bflo(hc.z), acc[4]); acc[5] = fmaf(w1.y, bfhi(g.z) * bfhi(hc.z), acc[5]);
                    acc[6] = fmaf(w1.z, bflo(g.w) * bflo(hc.w), acc[6]); acc[7] = fmaf(w1.w, bfhi(g.w) * bfhi(hc.w), acc[7]);
                }
            }
            const uint4 bg = *(const uint4*)(pr + C_BG + c0);
            uint4 o;
            o.x = pack2(bflo(bg.x) * acc[0], bfhi(bg.x) * acc[1]); o.y = pack2(bflo(bg.y) * acc[2], bfhi(bg.y) * acc[3]);
            o.z = pack2(bflo(bg.z) * acc[4], bfhi(bg.z) * acc[5]); o.w = pack2(bflo(bg.w) * acc[6], bfhi(bg.w) * acc[7]);
            *(uint4*)(Y + (size_t)t * LDX + c0) = o;
        }
    }
    {
        float (*pl)[68] = (float (*)[68])lds;
        const float* pw = P.pool_w + (size_t)l * 4 * 64 * 64;
        const float* psc = P.pool_scale + l * 256;
        const int a = tid & 63, q = tid >> 6;
        for (int tile = blockIdx.x; tile < (T / 64) * 4; tile += gridDim.x) {
            const int g = tile & 3, t0 = (tile >> 2) * 64;
            const int w = 2 << g;
            {
                const bf16* col = proj + C_HP + g * 64 + a;
                const int tf = t0 + q * 16, sf = tf & (S - 1);
                float sum = 0.f;
                for (int d = 1; d < w; ++d) if (sf - d >= 0) sum += bf2f(col[(size_t)(tf - d) * DINP]);
#pragma unroll 4
                for (int i = 0; i < 16; ++i) {
                    const int s = sf + i;
                    const float xv = bf2f(col[(size_t)(tf + i) * DINP]);
                    sum += xv;
                    const int cnt = (s + 1 < w) ? (s + 1) : w;
                    pl[q * 16 + i][a] = sum / (float)cnt - xv;
                    if (s - w + 1 >= 0) sum -= bf2f(col[(size_t)(tf + i - w + 1) * DINP]);
                }
            }
            __syncthreads();
            {
                float pc[64];
#pragma unroll
                for (int c = 0; c < 64; ++c) pc[c] = pw[(g * 64 + c) * 64 + a];
                const float sc = psc[g * 64 + a];
#pragma unroll 2
                for (int i = 0; i < 16; ++i) {
                    const float4* row = (const float4*)&pl[q * 16 + i][0];
                    float m0 = 0.f, m1 = 0.f;
#pragma unroll
                    for (int c4 = 0; c4 < 16; ++c4) { const float4 v = row[c4]; m0 = fmaf(v.x, pc[4 * c4], m0); m1 = fmaf(v.y, pc[4 * c4 + 1], m1); m0 = fmaf(v.z, pc[4 * c4 + 2], m0); m1 = fmaf(v.w, pc[4 * c4 + 3], m1); }
                    Y[(size_t)(t0 + q * 16 + i) * LDX + 256 + g * 64 + a] = f2bf((m0 + m1) * sc);
                }
            }
            __syncthreads();
        }
    }
}

typedef short v4i16_t __attribute__((ext_vector_type(4)));
typedef __attribute__((address_space(3))) v4i16_t* lds_v4p;
__device__ __forceinline__ v4i16_t vtr(const char* p) { return __builtin_amdgcn_ds_read_tr16_b64_v4i16((lds_v4p)p); }
constexpr int A_KP = 208, A_VP = 192;
constexpr int A_KB = 64 * A_KP, A_VB = 64 * A_VP, A_BUF = A_KB + A_VB, ATTN_LDS = 2 * A_BUF;
static_assert(ATTN_LDS <= GEMM_LDS, "attention LDS");

__device__ __forceinline__ void attn_unit(const bf16* __restrict__ Qb, const bf16* __restrict__ Kb, const bf16* __restrict__ Vb, bf16* __restrict__ Y, int bh, int qblk, char* lds) {
    const int tid = tidx(), lane = tid & 63, w = tid >> 6, r32 = lane & 31, hi = lane >> 5;
    const int q0 = qblk * 128, qw0 = q0 + w * 32;
    const int NT = 2 * qblk + 2;
    bf16x8 qf[6];
    {
        const bf16* qp = Qb + ((size_t)bh * S + qw0 + r32) * DQK + hi * 8;
#pragma unroll
        for (int ks = 0; ks < 6; ++ks) qf[ks] = *(const bf16x8*)(qp + ks * 16);
    }
    f32x16 o0, o1;
#pragma unroll
    for (int r = 0; r < 16; ++r) { o0[r] = 0.f; o1[r] = 0.f; }
    float m = -1e30f, lsum = 0.f;
    const char* Kg = (const char*)(Kb + (size_t)bh * S * DQK) + tid * 16;
    const char* Vg = (const char*)(Vb + (size_t)bh * S * DV) + tid * 16;
    const int kl0 = (tid / 12) * A_KP + (tid % 12) * 16, kl1 = ((tid + 256) / 12) * A_KP + ((tid + 256) % 12) * 16, kl2 = ((tid + 512) / 12) * A_KP + ((tid + 512) % 12) * 16;
    const int vl0 = (tid >> 3) * A_VP + (tid & 7) * 16, vl1 = vl0 + 32 * A_VP;
    uint4 pk0, pk1, pk2, pv0, pv1, qk0, qk1, qk2, qv0, qv1;
#define A_LOAD(S, t) do { const char* kg = Kg + (size_t)(t) * (64 * 192); const char* vg = Vg + (size_t)(t) * (64 * 128); \
        S##k0 = *(const uint4*)(kg); S##k1 = *(const uint4*)(kg + 4096); S##k2 = *(const uint4*)(kg + 8192); S##v0 = *(const uint4*)(vg); S##v1 = *(const uint4*)(vg + 4096); } while (0)
#define A_STORE(S, bK, bV) do { *(uint4*)(bK + kl0) = S##k0; *(uint4*)(bK + kl1) = S##k1; *(uint4*)(bK + kl2) = S##k2; *(uint4*)(bV + vl0) = S##v0; *(uint4*)(bV + vl1) = S##v1; } while (0)
#define A_PV(pf, kofs) do { \
            { const v4i16_t lo = vtr(pv + (kofs) * A_VP), hh = vtr(pv + ((kofs) + 8) * A_VP); const bf16x8 vf = {lo[0], lo[1], lo[2], lo[3], hh[0], hh[1], hh[2], hh[3]}; o0 = MFMA32(vf, pf.v, o0); } \
            { const v4i16_t lo = vtr(pv + (kofs) * A_VP + 64), hh = vtr(pv + ((kofs) + 8) * A_VP + 64); const bf16x8 vf = {lo[0], lo[1], lo[2], lo[3], hh[0], hh[1], hh[2], hh[3]}; o1 = MFMA32(vf, pf.v, o1); } } while (0)
    const int pvo = (4 * hi + ((lane & 15) >> 2)) * A_VP + (16 * ((lane >> 4) & 1) + 4 * (lane & 3)) * 2;
    A_LOAD(p, 0); A_LOAD(q, 1);
    for (int t2 = 0; t2 < NT; t2 += 2) {
#pragma unroll
        for (int half = 0; half < 2; ++half) {
            const int t = t2 + half;
            char* bK = lds + half * A_BUF; char* bV = bK + A_KB;
            if (half == 0) A_STORE(p, bK, bV); else A_STORE(q, bK, bV);
            __syncthreads();
            { const int tn = (t + 2 < NT) ? (t + 2) : (NT - 2 + half); if (half == 0) A_LOAD(p, tn); else A_LOAD(q, tn); }
        const int kt0 = t * 64;
        if (kt0 <= qw0) {
            f32x16 s0, s1;
#pragma unroll
            for (int r = 0; r < 16; ++r) { s0[r] = 0.f; s1[r] = 0.f; }
            const char* pk = bK + r32 * A_KP + hi * 16;
#pragma unroll
            for (int ks = 0; ks < 6; ++ks) {
                const bf16x8 a0 = *(const bf16x8*)(pk + ks * 32), a1 = *(const bf16x8*)(pk + 32 * A_KP + ks * 32);
                s0 = MFMA32(a0, qf[ks], s0); s1 = MFMA32(a1, qf[ks], s1);
            }
            if (kt0 + 63 > qw0) {
                const int qrow = qw0 + r32;
#pragma unroll
                for (int r = 0; r < 16; ++r) { const int key = kt0 + crow(r, hi); if (key > qrow) s0[r] = -INFINITY; if (key + 32 > qrow) s1[r] = -INFINITY; }
            }
            float mx = fmaxf(s0[0], s1[0]);
#pragma unroll
            for (int r = 1; r < 16; ++r) mx = fmaxf(mx, fmaxf(s0[r], s1[r]));
            mx = fmaxf(mx, __shfl_xor(mx, 32, 64));
            const float mn = fmaxf(m, mx);
            const float alpha = __builtin_amdgcn_exp2f(m - mn);
            m = mn;
            float ps = 0.f;
#pragma unroll
            for (int r = 0; r < 16; ++r) { s0[r] = __builtin_amdgcn_exp2f(s0[r] - mn); s1[r] = __builtin_amdgcn_exp2f(s1[r] - mn); ps += s0[r] + s1[r]; }
            lsum = lsum * alpha + ps;
#pragma unroll
            for (int r = 0; r < 16; ++r) { o0[r] *= alpha; o1[r] *= alpha; }
            union { unsigned u[4]; bf16x8 v; } p00, p01, p10, p11;
#pragma unroll
            for (int j = 0; j < 4; ++j) { p00.u[j] = cvtpk(s0[2 * j], s0[2 * j + 1]); p01.u[j] = cvtpk(s0[8 + 2 * j], s0[9 + 2 * j]); p10.u[j] = cvtpk(s1[2 * j], s1[2 * j + 1]); p11.u[j] = cvtpk(s1[8 + 2 * j], s1[9 + 2 * j]); }
            const char* pv = bV + pvo;
            A_PV(p00, 0); A_PV(p01, 16); A_PV(p10, 32); A_PV(p11, 48);
        }
        }
    }
    lsum += __shfl_xor(lsum, 32, 64);
    const float inv = 1.f / lsum;
    const int b = bh >> 3, h = bh & 7;
    bf16* yo = Y + (size_t)(b * S + qw0 + r32) * LDX + 512 + h * 64 + 4 * hi;
#pragma unroll
    for (int g = 0; g < 4; ++g) {
        uint2 a, c;
        a.x = cvtpk(o0[4 * g] * inv, o0[4 * g + 1] * inv); a.y = cvtpk(o0[4 * g + 2] * inv, o0[4 * g + 3] * inv);
        c.x = cvtpk(o1[4 * g] * inv, o1[4 * g + 1] * inv); c.y = cvtpk(o1[4 * g + 2] * inv, o1[4 * g + 3] * inv);
        *(uint2*)(yo + 8 * g) = a; *(uint2*)(yo + 32 + 8 * g) = c;
    }
    __syncthreads();
}
__device__ __forceinline__ void phase_attn(const Params& P, char* lds) {
    const bf16* Qb = (const bf16*)(P.ws + WS_Q);
    const bf16* Kb = (const bf16*)(P.ws + WS_K);
    const bf16* Vb = (const bf16*)(P.ws + WS_V);
    bf16* Y = (bf16*)(P.ws + WS_XN);
    for (int u = blockIdx.x; u < NB * NH * (S / 128); u += gridDim.x) {
        const int bh = u & 31, v = u >> 5;
        const int qblk = (v < 16) ? (63 - v) : (v < 32) ? (v - 16) : (v < 48) ? (79 - v) : (v - 32);
        attn_unit(Qb, Kb, Vb, Y, bh, qblk, lds);
    }
}

#define NET_HD __device__ __forceinline__
#define NET_U2F(u) __uint_as_float(u)
#define NET_F2U(f) __float_as_uint(f)
#define CE_DESC(a, b) do { const float hi__ = fmaxf(a, b), lo__ = fminf(a, b); a = hi__; b = lo__; } while (0)
NET_HD void sort16_desc(float (&v)[16]) {
#pragma unroll
    for (int k = 2; k <= 16; k <<= 1) {
#pragma unroll
        for (int j = k >> 1; j > 0; j >>= 1) {
#pragma unroll
            for (int i = 0; i < 16; ++i) {
                const int l = i ^ j;
                if (l > i) { if ((i & k) == 0) CE_DESC(v[i], v[l]); else CE_DESC(v[l], v[i]); }
            }
        }
    }
}
NET_HD void merge16_desc(float (&a)[16], const float (&b)[16]) {
#pragma unroll
    for (int i = 0; i < 16; ++i) a[i] = fmaxf(a[i], b[15 - i]);
#pragma unroll
    for (int j = 8; j > 0; j >>= 1) {
#pragma unroll
        for (int i = 0; i < 16; ++i) { const int l = i ^ j; if (l > i) CE_DESC(a[i], a[l]); }
    }
}
NET_HD void top16_of_64(float (&g0)[16], float (&g1)[16], float (&g2)[16], float (&g3)[16]) {
    sort16_desc(g0); sort16_desc(g1); sort16_desc(g2); sort16_desc(g3);
    merge16_desc(g0, g1); merge16_desc(g2, g3); merge16_desc(g0, g2);
}
NET_HD float u2f(unsigned u) { return NET_U2F(u); }
NET_HD unsigned f2u(float f) { return NET_F2U(f); }
template <class V16>
NET_HD void lane_top16(const V16& s0, const V16& s1, const V16& s2, const V16& s3, int hi, float (&out)[16]) {
    float g0[16], g1[16], g2[16], g3[16];
#pragma unroll
    for (int r = 0; r < 16; ++r) {
        const unsigned nb = (unsigned)((r & 3) + 8 * (r >> 2));
        g0[r] = u2f((f2u(s0[r]) & 0xFFFFFF80u) | nb); g1[r] = u2f((f2u(s1[r]) & 0xFFFFFF80u) | (nb + 32u));
        g2[r] = u2f((f2u(s2[r]) & 0xFFFFFF80u) | (nb + 64u)); g3[r] = u2f((f2u(s3[r]) & 0xFFFFFF80u) | (nb + 96u));
    }
    top16_of_64(g0, g1, g2, g3);
    const unsigned h4 = (unsigned)hi << 2;
#pragma unroll
    for (int i = 0; i < 16; ++i) out[i] = u2f(f2u(g0[i]) | h4);
}
constexpr int cand_slot(int a, int b) { int n = 0; for (int x = 0; x < 16; ++x) for (int y = 0; y < 16; ++y) { if (x == a && y == b) return n; if ((x + 1) * (y + 1) <= 16) ++n; } return n; }
NET_HD void cand_top16(const float (&s1)[16], const float (&s2)[16], float (&c)[16]) {
    float g0[16], g1[16], g2[16], g3[16];
#pragma unroll
    for (int i = 0; i < 16; ++i) { g0[i] = -3.0e38f; g1[i] = -3.0e38f; g2[i] = -3.0e38f; g3[i] = -3.0e38f; }
#pragma unroll
    for (int a = 0; a < 16; ++a) {
#pragma unroll
        for (int b = 0; b < 16; ++b) {
            if ((a + 1) * (b + 1) <= 16) {
                const int sl = cand_slot(a, b);
                const float v = u2f((f2u(s1[a] + s2[b]) & 0xFFFFFF00u) | (unsigned)(a * 16 + b));
                if (sl < 16) g0[sl & 15] = v; else if (sl < 32) g1[sl & 15] = v; else if (sl < 48) g2[sl & 15] = v; else g3[sl & 15] = v;
            }
        }
    }
    top16_of_64(g0, g1, g2, g3);
#pragma unroll
    for (int i = 0; i < 16; ++i) c[i] = g0[i];
}

__device__ __forceinline__ void phase_route(const Params& P, int l, char* lds) {
    const bf16* XN = (const bf16*)(P.ws + WS_XN);
    const bf16* Wc = (const bf16*)(P.ws + WS_WPQ) + (size_t)l * 2048 * LDW;
    int* EXPp = (int*)(P.ws + WS_EXP);
    float* GATEp = (float*)(P.ws + WS_GATE);
    const int tid = tidx(), lane = tid & 63, w = tid >> 6, r32 = lane & 31, hi = lane >> 5;
    for (int u = blockIdx.x; u < (T / 128) * PH; u += gridDim.x) {
        const int tm = u >> 3, h = u & 7;
        float L0[16], L1[16];
        {
            f32x16 acc[4]; float ssd[4];
            gemm_kloop<1, false>(Wc + (size_t)((h * 2 + 0) * 128) * LDW, LDW, XN + (size_t)(tm * 128) * LDX, LDX, D / 64, acc, ssd, lds, tid);
            lane_top16(acc[0], acc[1], acc[2], acc[3], hi, L0);
            float o[16];
#pragma unroll
            for (int i = 0; i < 16; ++i) o[i] = __shfl_xor(L0[i], 32, 64);
            merge16_desc(L0, o);
        }
        {
            f32x16 acc[4]; float ssd[4];
            gemm_kloop<1, false>(Wc + (size_t)((h * 2 + 1) * 128) * LDW, LDW, XN + (size_t)(tm * 128) * LDX, LDX, D / 64, acc, ssd, lds, tid);
            lane_top16(acc[0], acc[1], acc[2], acc[3], hi, L1);
            float o[16];
#pragma unroll
            for (int i = 0; i < 16; ++i) o[i] = __shfl_xor(L1[i], 32, 64);
            merge16_desc(L1, o);
        }
        float c[16];
        cand_top16(L0, L1, c);
        __syncthreads();
        unsigned char* my = (unsigned char*)lds + tid * 32;
        {
            uint4 a, b;
#define PK4(L, i) ((__float_as_uint(L[i]) & 127u) | ((__float_as_uint(L[i + 1]) & 127u) << 8) | ((__float_as_uint(L[i + 2]) & 127u) << 16) | ((__float_as_uint(L[i + 3]) & 127u) << 24))
            a.x = PK4(L0, 0); a.y = PK4(L0, 4); a.z = PK4(L0, 8); a.w = PK4(L0, 12);
            b.x = PK4(L1, 0); b.y = PK4(L1, 4); b.z = PK4(L1, 8); b.w = PK4(L1, 12);
#undef PK4
            *(uint4*)my = a; *(uint4*)(my + 16) = b;
        }
        int ev[16]; float gv[16]; float den = 0.f;
#pragma unroll
        for (int k = 0; k < 16; ++k) {
            const unsigned ci = __float_as_uint(c[k]) & 255u;
            const int n1 = my[ci >> 4], n2 = my[16 + (ci & 15)];
            ev[k] = n1 * NKEY + n2;
            gv[k] = __expf(c[k] - c[0]); den += gv[k];
        }
        const float iden = 1.f / den;
        if (hi == 0) {
            const int t = tm * 128 + w * 32 + r32;
            uint4* ep = (uint4*)(EXPp + (size_t)t * HK + h * 16);
            float4* gp = (float4*)(GATEp + (size_t)t * HK + h * 16);
#pragma unroll
            for (int q = 0; q < 4; ++q) {
                ep[q] = make_uint4((unsigned)ev[4 * q], (unsigned)ev[4 * q + 1], (unsigned)ev[4 * q + 2], (unsigned)ev[4 * q + 3]);
                gp[q] = make_float4(gv[4 * q] * iden, gv[4 * q + 1] * iden, gv[4 * q + 2] * iden, gv[4 * q + 3] * iden);
            }
        }
        __syncthreads();
    }
}

__device__ __forceinline__ float red16(float (&p)[16], int lane) {
#pragma unroll
    for (int i = 0; i < 8; ++i) { const bool up = lane & 32; const float send = up ? p[i] : p[i + 8], keep = up ? p[i + 8] : p[i]; p[i] = keep + __shfl_xor(send, 32, 64); }
#pragma unroll
    for (int i = 0; i < 4; ++i) { const bool up = lane & 16; const float send = up ? p[i] : p[i + 4], keep = up ? p[i + 4] : p[i]; p[i] = keep + __shfl_xor(send, 16, 64); }
#pragma unroll
    for (int i = 0; i < 2; ++i) { const bool up = lane & 8; const float send = up ? p[i] : p[i + 2], keep = up ? p[i + 2] : p[i]; p[i] = keep + __shfl_xor(send, 8, 64); }
    { const bool up = lane & 4; const float send = up ? p[0] : p[1], keep = up ? p[1] : p[0]; p[0] = keep + __shfl_xor(send, 4, 64); }
    float r = p[0];
    r += __shfl_xor(r, 2, 64); r += __shfl_xor(r, 1, 64);
    return r;
}

__device__ __forceinline__ void phase_gather(const Params& P, int l) {
    const bf16* XN = (const bf16*)(P.ws + WS_XN);
    bf16* XNw = (bf16*)(P.ws + WS_XN);
    const int* EXPp = (const int*)(P.ws + WS_EXP);
    const float* GATEp = (const float*)(P.ws + WS_GATE);
    const unsigned char* U = P.ws + WS_TABU + (size_t)l * NEXP * TAB_ROWB;
    const unsigned char* V = P.ws + WS_TABV + (size_t)l * NEXP * TAB_ROWB;
    const float* SU = (const float*)(P.ws + WS_TSCU) + (size_t)l * NEXP;
    const float* SV = (const float*)(P.ws + WS_TSCV) + (size_t)l * NEXP;
    const int lane = tidx() & 63;
    for (int t = gwave(); t < T; t += nwave()) {
        const int e_lo = EXPp[(size_t)t * HK + lane], e_hi = EXPp[(size_t)t * HK + 64 + lane];
#if TAB_FP8
        float xf[16];
        {
            const uint4 a = ((const uint4*)(XN + (size_t)t * D))[lane * 2], b = ((const uint4*)(XN + (size_t)t * D))[lane * 2 + 1];
            xf[0] = bflo(a.x); xf[1] = bfhi(a.x); xf[2] = bflo(a.y); xf[3] = bfhi(a.y); xf[4] = bflo(a.z); xf[5] = bfhi(a.z); xf[6] = bflo(a.w); xf[7] = bfhi(a.w);
            xf[8] = bflo(b.x); xf[9] = bfhi(b.x); xf[10] = bflo(b.y); xf[11] = bfhi(b.y); xf[12] = bflo(b.z); xf[13] = bfhi(b.z); xf[14] = bflo(b.w); xf[15] = bfhi(b.w);
        }
#else
        const uint4 xa = ((const uint4*)(XN + (size_t)t * D))[lane], xb = ((const uint4*)(XN + (size_t)t * D))[64 + lane];
#endif
        float acc[16];
#pragma unroll
        for (int i = 0; i < 16; ++i) acc[i] = 0.f;
        for (int c = 0; c < 8; ++c) {
            const int esel = (c < 4) ? e_lo : e_hi;
            const int kb = (c & 3) * 16;
            float part[16];
#pragma unroll
            for (int hb = 0; hb < 2; ++hb) {
#if TAB_FP8
                uint4 r[8];
#pragma unroll
                for (int i = 0; i < 8; ++i) { const int e = __builtin_amdgcn_readlane(esel, kb + hb * 8 + i); r[i] = *(const uint4*)(U + (size_t)e * 1024 + lane * 16); }
#pragma unroll
                for (int i = 0; i < 8; ++i) {
                    float d0 = 0.f, d1 = 0.f;
                    const unsigned w[4] = {r[i].x, r[i].y, r[i].z, r[i].w};
#pragma unroll
                    for (int q = 0; q < 4; ++q) {
                        const auto lo = __builtin_amdgcn_cvt_pk_f32_fp8((int)w[q], false); const auto hh = __builtin_amdgcn_cvt_pk_f32_fp8((int)w[q], true);
                        d0 = fmaf(xf[4 * q], lo[0], d0); d1 = fmaf(xf[4 * q + 1], lo[1], d1); d0 = fmaf(xf[4 * q + 2], hh[0], d0); d1 = fmaf(xf[4 * q + 3], hh[1], d1);
                    }
                    part[hb * 8 + i] = d0 + d1;
                }
#else
                uint4 r0[8], r1[8];
#pragma unroll
                for (int i = 0; i < 8; ++i) { const int e = __builtin_amdgcn_readlane(esel, kb + hb * 8 + i); const unsigned char* rp = U + (size_t)e * 2048 + lane * 16; r0[i] = *(const uint4*)(rp); r1[i] = *(const uint4*)(rp + 1024); }
#pragma unroll
                for (int i = 0; i < 8; ++i) {
                    float d0 = 0.f, d1 = 0.f;
                    d0 = dot2bf(xa.x, r0[i].x, d0); d1 = dot2bf(xa.y, r0[i].y, d1); d0 = dot2bf(xa.z, r0[i].z, d0); d1 = dot2bf(xa.w, r0[i].w, d1);
                    d0 = dot2bf(xb.x, r1[i].x, d0); d1 = dot2bf(xb.y, r1[i].y, d1); d0 = dot2bf(xb.z, r1[i].z, d0); d1 = dot2bf(xb.w, r1[i].w, d1);
                    part[hb * 8 + i] = d0 + d1;
                }
#endif
            }
            float dsum = red16(part, lane);
            const int kk = c * 16 + (lane >> 2);
            const int eme = __shfl(esel, kb + (lane >> 2), 64);
            float wv = GATEp[(size_t)t * HK + kk];
#if TAB_FP8
            dsum *= SU[eme];
            wv *= SV[eme];
#endif
            wv *= gelu_exact(dsum);
#pragma unroll
            for (int hb = 0; hb < 2; ++hb) {
#if TAB_FP8
                uint4 r[8];
#pragma unroll
                for (int i = 0; i < 8; ++i) { const int e = __builtin_amdgcn_readlane(esel, kb + hb * 8 + i); r[i] = *(const uint4*)(V + (size_t)e * 1024 + lane * 16); }
#pragma unroll
                for (int i = 0; i < 8; ++i) {
                    const float w = __int_as_float(__builtin_amdgcn_readlane(__float_as_int(wv), (hb * 8 + i) * 4));
                    const unsigned ww[4] = {r[i].x, r[i].y, r[i].z, r[i].w};
#pragma unroll
                    for (int q = 0; q < 4; ++q) {
                        const auto lo = __builtin_amdgcn_cvt_pk_f32_fp8((int)ww[q], false); const auto hh = __builtin_amdgcn_cvt_pk_f32_fp8((int)ww[q], true);
                        acc[4 * q] = fmaf(w, lo[0], acc[4 * q]); acc[4 * q + 1] = fmaf(w, lo[1], acc[4 * q + 1]); acc[4 * q + 2] = fmaf(w, hh[0], acc[4 * q + 2]); acc[4 * q + 3] = fmaf(w, hh[1], acc[4 * q + 3]);
                    }
                }
#else
                uint4 r0[8], r1[8];
#pragma unroll
                for (int i = 0; i < 8; ++i) { const int e = __builtin_amdgcn_readlane(esel, kb + hb * 8 + i); const unsigned char* rp = V + (size_t)e * 2048 + lane * 16; r0[i] = *(const uint4*)(rp); r1[i] = *(const uint4*)(rp + 1024); }
#pragma unroll
                for (int i = 0; i < 8; ++i) {
                    const float w = __int_as_float(__builtin_amdgcn_readlane(__float_as_int(wv), (hb * 8 + i) * 4));
                    acc[0] = fmaf(w, bflo(r0[i].x), acc[0]); acc[1] = fmaf(w, bfhi(r0[i].x), acc[1]); acc[2] = fmaf(w, bflo(r0[i].y), acc[2]); acc[3] = fmaf(w, bfhi(r0[i].y), acc[3]);
                    acc[4] = fmaf(w, bflo(r0[i].z), acc[4]); acc[5] = fmaf(w, bfhi(r0[i].z), acc[5]); acc[6] = fmaf(w, bflo(r0[i].w), acc[6]); acc[7] = fmaf(w, bfhi(r0[i].w), acc[7]);
                    acc[8] = fmaf(w, bflo(r1[i].x), acc[8]); acc[9] = fmaf(w, bfhi(r1[i].x), acc[9]); acc[10] = fmaf(w, bflo(r1[i].y), acc[10]); acc[11] = fmaf(w, bfhi(r1[i].y), acc[11]);
                    acc[12] = fmaf(w, bflo(r1[i].z), acc[12]); acc[13] = fmaf(w, bfhi(r1[i].z), acc[13]); acc[14] = fmaf(w, bflo(r1[i].w), acc[14]); acc[15] = fmaf(w, bfhi(r1[i].w), acc[15]);
                }
#endif
            }
        }
        float* hrow = P.out + (size_t)t * D;
#if TAB_FP8
        const int c0 = lane * 16, c1 = lane * 16 + 8;
#else
        const int c0 = lane * 8, c1 = 512 + lane * 8;
#endif
        float4 h0 = *(const float4*)(hrow + c0), h1 = *(const float4*)(hrow + c0 + 4), h2 = *(const float4*)(hrow + c1), h3 = *(const float4*)(hrow + c1 + 4);
        h0.x += acc[0]; h0.y += acc[1]; h0.z += acc[2]; h0.w += acc[3]; h1.x += acc[4]; h1.y += acc[5]; h1.z += acc[6]; h1.w += acc[7];
        h2.x += acc[8]; h2.y += acc[9]; h2.z += acc[10]; h2.w += acc[11]; h3.x += acc[12]; h3.y += acc[13]; h3.z += acc[14]; h3.w += acc[15];
        float ss = h0.x * h0.x + h0.y * h0.y + h0.z * h0.z + h0.w * h0.w + h1.x * h1.x + h1.y * h1.y + h1.z * h1.z + h1.w * h1.w
                 + h2.x * h2.x + h2.y * h2.y + h2.z * h2.z + h2.w * h2.w + h3.x * h3.x + h3.y * h3.y + h3.z * h3.z + h3.w * h3.w;
        ss = wave_sum(ss);
        const float rn = rsqrtf(ss * (1.f / D) + EPS);
        if (l == DEPTH - 1) {
            const float* g = P.norm_final;
            const float4 g0 = *(const float4*)(g + c0), g1 = *(const float4*)(g + c0 + 4), g2 = *(const float4*)(g + c1), g3 = *(const float4*)(g + c1 + 4);
            *(float4*)(hrow + c0) = make_float4(h0.x * rn * g0.x, h0.y * rn * g0.y, h0.z * rn * g0.z, h0.w * rn * g0.w);
            *(float4*)(hrow + c0 + 4) = make_float4(h1.x * rn * g1.x, h1.y * rn * g1.y, h1.z * rn * g1.z, h1.w * rn * g1.w);
            *(float4*)(hrow + c1) = make_float4(h2.x * rn * g2.x, h2.y * rn * g2.y, h2.z * rn * g2.z, h2.w * rn * g2.w);
            *(float4*)(hrow + c1 + 4) = make_float4(h3.x * rn * g3.x, h3.y * rn * g3.y, h3.z * rn * g3.z, h3.w * rn * g3.w);
        } else {
            *(float4*)(hrow + c0) = h0; *(float4*)(hrow + c0 + 4) = h1; *(float4*)(hrow + c1) = h2; *(float4*)(hrow + c1 + 4) = h3;
            const float* g = P.norm_mix + (l + 1) * D;
            const float4 g0 = *(const float4*)(g + c0), g1 = *(const float4*)(g + c0 + 4), g2 = *(const float4*)(g + c1), g3 = *(const float4*)(g + c1 + 4);
            uint4 o0, o1;
            o0.x = pack2(h0.x * rn * g0.x, h0.y * rn * g0.y); o0.y = pack2(h0.z * rn * g0.z, h0.w * rn * g0.w); o0.z = pack2(h1.x * rn * g1.x, h1.y * rn * g1.y); o0.w = pack2(h1.z * rn * g1.z, h1.w * rn * g1.w);
            o1.x = pack2(h2.x * rn * g2.x, h2.y * rn * g2.y); o1.y = pack2(h2.z * rn * g2.z, h2.w * rn * g2.w); o1.z = pack2(h3.x * rn * g3.x, h3.y * rn * g3.y); o1.w = pack2(h3.z * rn * g3.z, h3.w * rn * g3.w);
            *(uint4*)(XNw + (size_t)t * D + c0) = o0; *(uint4*)(XNw + (size_t)t * D + c1) = o1;
        }
    }
}


constexpr size_t WS_PART = WS_PROJ;
static_assert((size_t)8 * T * HK * 4 <= WS_K - WS_PROJ, "PART alias");
constexpr int XI_X = 0, XI_RANK = 1, XI_J = 2, XI_NX = 3, XI_NLOC = 4;
constexpr int CTL_CENSUS = 4096;
constexpr int CTL_BYTES = (CTL_CENSUS + 16) * 4;

__device__ __forceinline__ float dot16_fp8(const float (&xf)[16], const uint4& r) {
    float d0 = 0.f, d1 = 0.f;
    const unsigned w[4] = {r.x, r.y, r.z, r.w};
#pragma unroll
    for (int q = 0; q < 4; ++q) {
        const auto lo = __builtin_amdgcn_cvt_pk_f32_fp8((int)w[q], false); const auto hh = __builtin_amdgcn_cvt_pk_f32_fp8((int)w[q], true);
        d0 = fmaf(xf[4 * q], lo[0], d0); d1 = fmaf(xf[4 * q + 1], lo[1], d1); d0 = fmaf(xf[4 * q + 2], hh[0], d0); d1 = fmaf(xf[4 * q + 3], hh[1], d1);
    }
    return d0 + d1;
}
template <int M1, int M2, int M3, class TT>
__device__ __forceinline__ void red16x3(TT (&p)[16], int lane) {
#pragma unroll
    for (int i = 0; i < 8; ++i) { const bool up = lane & M1; const TT send = up ? p[i] : p[i + 8], keep = up ? p[i + 8] : p[i]; p[i] = keep + __shfl_xor(send, M1, 64); }
#pragma unroll
    for (int i = 0; i < 4; ++i) { const bool up = lane & M2; const TT send = up ? p[i] : p[i + 4], keep = up ? p[i + 4] : p[i]; p[i] = keep + __shfl_xor(send, M2, 64); }
#pragma unroll
    for (int i = 0; i < 2; ++i) { const bool up = lane & M3; const TT send = up ? p[i] : p[i + 2], keep = up ? p[i + 2] : p[i]; p[i] = keep + __shfl_xor(send, M3, 64); }
}
__device__ __forceinline__ void phase_gu(const Params& P, int l, const volatile int* xi) {
    const unsigned char* XQ = P.ws + WS_XQ;
    const float* XSc = (const float*)(P.ws + WS_XS);
    const int* EXPp = (const int*)(P.ws + WS_EXP);
    float* PART = (float*)(P.ws + WS_PART);
    const int tid = tidx(), lane = tid & 63, w = tid >> 6, g = lane >> 3, c = lane & 7;
    int xo_ = 0; asm volatile("" : "+v"(xo_));
    const int j = xi[xo_ + XI_J], nx = xi[xo_ + XI_NX], nloc = xi[xo_ + XI_NLOC], rank = xi[xo_ + XI_RANK];
    const int t0 = rank * 4 + w, st = nloc * 4;
    const int n = (t0 < T) ? (T - t0 + st - 1) / st : 0;
    const int i0 = 8 * (c & 1) + 4 * ((c >> 1) & 1) + 2 * ((c >> 2) & 1);
    for (int sl = j; sl < 8 && n > 0; sl += nx) {
        const unsigned char* Us = P.ws + WS_TABU + ((size_t)(l * 8 + sl) * NEXP) * 128 + c * 16;
        float* part = PART + (size_t)sl * T * HK;
        const unsigned char* xs = XQ + sl * 128 + c * 16;
#define GU_TK(k) (t0 + (((k) < n) ? (k) : (n - 1)) * st)
#define GU_LOADE(S, t) do { S##lo = EXPp[(size_t)(t) * HK + lane]; S##hi = EXPp[(size_t)(t) * HK + 64 + lane]; } while (0)
#define GU_LOADX(S, t) do { S##a = *(const uint4*)(xs + (size_t)(t) * D); S##s = XSc[t]; } while (0)
#define GU_ISSUE(R, S) do { _Pragma("unroll") for (int i = 0; i < 16; ++i) { \
            const int e = __builtin_amdgcn_ds_bpermute((((8 * i) & 63) + g) << 2, (i < 8) ? S##lo : S##hi); R[i] = *(const uint4*)(Us + (size_t)e * 128); } } while (0)
#define GU_FINISH(R, S, t) do { \
            int p[16]; \
            _Pragma("unroll") for (int i = 0; i < 16; ++i) { int d_ = __builtin_amdgcn_sdot4((int)S##a.x, (int)R[i].x, 0, false); d_ = __builtin_amdgcn_sdot4((int)S##a.y, (int)R[i].y, d_, false); \
                d_ = __builtin_amdgcn_sdot4((int)S##a.z, (int)R[i].z, d_, false); p[i] = __builtin_amdgcn_sdot4((int)S##a.w, (int)R[i].w, d_, false); } \
            red16x3<1, 2, 4, int>(p, lane); \
            part[(size_t)(t) * HK + 8 * i0 + g] = (float)p[0] * S##s; part[(size_t)(t) * HK + 8 * (i0 + 1) + g] = (float)p[1] * S##s; } while (0)
        int eAlo, eAhi, eBlo, eBhi; uint4 xAa, xBa; float xAs, xBs; uint4 rA[16], rB[16];
        GU_LOADE(eA, GU_TK(0)); GU_LOADX(xA, GU_TK(0)); GU_LOADE(eB, GU_TK(1));
        GU_ISSUE(rA, eA);
        for (int k = 0; k < n; k += 2) {
            GU_LOADX(xB, GU_TK(k + 1)); GU_ISSUE(rB, eB); GU_LOADE(eA, GU_TK(k + 2));
            GU_FINISH(rA, xA, GU_TK(k));
            GU_LOADX(xA, GU_TK(k + 2)); GU_ISSUE(rA, eA); GU_LOADE(eB, GU_TK(k + 3));
            GU_FINISH(rB, xB, GU_TK(k + 1));
        }
#undef GU_TK
#undef GU_LOADE
#undef GU_LOADX
#undef GU_ISSUE
#undef GU_FINISH
    }
}
__device__ __forceinline__ void phase_gw(const Params& P, int l) {
    const int* EXPp = (const int*)(P.ws + WS_EXP);
    float* GATEp = (float*)(P.ws + WS_GATE);
    const float* PART = (const float*)(P.ws + WS_PART);
    const float* SU = (const float*)(P.ws + WS_TSCU) + (size_t)l * NEXP;
    const float* SV = (const float*)(P.ws + WS_TSCV) + (size_t)l * NEXP;
    for (size_t i = gtid(); i < (size_t)T * HK; i += gnth()) {
        float s = 0.f;
#pragma unroll
        for (int x = 0; x < 8; ++x) s += PART[(size_t)x * T * HK + i];
        const int e = EXPp[i];
        GATEp[i] = GATEp[i] * gelu_exact(s * SU[e]) * SV[e];
    }
}
__device__ __forceinline__ void phase_gv(const Params& P, int l, const volatile int* xi) {
    const int* EXPp = (const int*)(P.ws + WS_EXP);
    const float* WGT = (const float*)(P.ws + WS_GATE);
    const int tid = tidx(), lane = tid & 63, w = tid >> 6, g = lane >> 3, c = lane & 7;
    int xo_ = 0; asm volatile("" : "+v"(xo_));
    const int j = xi[xo_ + XI_J], nx = xi[xo_ + XI_NX], nloc = xi[xo_ + XI_NLOC], rank = xi[xo_ + XI_RANK];
    const int t0 = rank * 4 + w, st = nloc * 4;
    const int n = (t0 < T) ? (T - t0 + st - 1) / st : 0;
    const int j0 = 8 * (g & 1) + 4 * ((g >> 1) & 1) + 2 * ((g >> 2) & 1);
    for (int sl = j; sl < 8 && n > 0; sl += nx) {
        const unsigned char* Vs = P.ws + WS_TABV + ((size_t)(l * 8 + sl) * NEXP) * 128 + c * 16;
        float* hcol = P.out + sl * 128 + c * 16 + j0;
#define GV_TK(k) (t0 + (((k) < n) ? (k) : (n - 1)) * st)
#define GV_LOADE(S, t) do { S##el = EXPp[(size_t)(t) * HK + lane]; S##eh = EXPp[(size_t)(t) * HK + 64 + lane]; \
            S##wl = __float_as_int(WGT[(size_t)(t) * HK + lane]); S##wh = __float_as_int(WGT[(size_t)(t) * HK + 64 + lane]); } while (0)
#define GV_ISSUE(R, W, ESEL, WSEL) do { _Pragma("unroll") for (int i = 0; i < 8; ++i) { const int src = (8 * i + g) << 2; \
            const int e = __builtin_amdgcn_ds_bpermute(src, ESEL); W[i] = __int_as_float(__builtin_amdgcn_ds_bpermute(src, WSEL)); R[i] = *(const uint4*)(Vs + (size_t)e * 128); } } while (0)
#define GV_FINISH(R, W) do { _Pragma("unroll") for (int i = 0; i < 8; ++i) { const unsigned ww[4] = {R[i].x, R[i].y, R[i].z, R[i].w}; \
            _Pragma("unroll") for (int q = 0; q < 4; ++q) { \
                const auto lo = __builtin_amdgcn_cvt_pk_f32_fp8((int)ww[q], false); const auto hh = __builtin_amdgcn_cvt_pk_f32_fp8((int)ww[q], true); \
                acc[4 * q] = fmaf(W[i], lo[0], acc[4 * q]); acc[4 * q + 1] = fmaf(W[i], lo[1], acc[4 * q + 1]); acc[4 * q + 2] = fmaf(W[i], hh[0], acc[4 * q + 2]); acc[4 * q + 3] = fmaf(W[i], hh[1], acc[4 * q + 3]); } __builtin_amdgcn_sched_barrier(0); } } while (0)
        int Cel, Ceh, Cwl, Cwh, Nel, Neh, Nwl, Nwh, Fel, Feh, Fwl, Fwh;
        uint4 r0[8], r1[8]; float wk0[8], wk1[8];
        GV_LOADE(C, GV_TK(0)); GV_LOADE(N, GV_TK(1));
        GV_ISSUE(r0, wk0, Cel, Cwl);
        for (int k = 0; k < n; ++k) {
            const int t = GV_TK(k);
            GV_ISSUE(r1, wk1, Ceh, Cwh);
            float2* hp = (float2*)(hcol + (size_t)t * D);
            const float2 hv = *hp;
            GV_LOADE(F, GV_TK(k + 2));
            float acc[16];
#pragma unroll
            for (int q = 0; q < 16; ++q) acc[q] = 0.f;
            GV_FINISH(r0, wk0);
            GV_ISSUE(r0, wk0, Nel, Nwl);
            GV_FINISH(r1, wk1);
            red16x3<8, 16, 32, float>(acc, lane);
            *hp = make_float2(hv.x + acc[0], hv.y + acc[1]);
            Cel = Nel; Ceh = Neh; Cwl = Nwl; Cwh = Nwh; Nel = Fel; Neh = Feh; Nwl = Fwl; Nwh = Fwh;
        }
#undef GV_TK
#undef GV_LOADE
#undef GV_ISSUE
#undef GV_FINISH
    }
}
__device__ __forceinline__ void phase_gnorm(const Params& P, int l) {
    const int lane = tidx() & 63;
    bf16* XNw = (bf16*)(P.ws + WS_XN);
    for (int t = gwave(); t < T; t += nwave()) {
        float4* hr = (float4*)(P.out + (size_t)t * D);
        float4 v[4]; float ss = 0.f;
#pragma unroll
        for (int q = 0; q < 4; ++q) { v[q] = hr[q * 64 + lane]; ss += v[q].x * v[q].x + v[q].y * v[q].y + v[q].z * v[q].z + v[q].w * v[q].w; }
        ss = wave_sum(ss);
        const float rn = rsqrtf(ss * (1.f / D) + EPS);
        const float4* g = (const float4*)((l == DEPTH - 1) ? P.norm_final : (P.norm_mix + (l + 1) * D));
#pragma unroll
        for (int q = 0; q < 4; ++q) {
            const float4 gg = g[q * 64 + lane];
            const float4 o = make_float4(v[q].x * rn * gg.x, v[q].y * rn * gg.y, v[q].z * rn * gg.z, v[q].w * rn * gg.w);
            if (l == DEPTH - 1) hr[q * 64 + lane] = o;
            else { uint2 u; u.x = pack2(o.x, o.y); u.y = pack2(o.z, o.w); ((uint2*)(XNw + (size_t)t * LDX))[q * 64 + lane] = u; }
        }
    }
}

#define XB_TMO      128
#define XB_XCNT(j)  (256  + 64 * (j))
#define XB_XSUB(j)  (1280 + 64 * (j))
#define XB_XGEN(j)  (2304 + 64 * (j))
#define XB_TOP      3328
#define XB_TOPGEN   3392
#define XCD_BAR_WORDS 3456
#define XB_SPIN_CAP (1u << 22)
#define LAS __attribute__((address_space(3)))
__device__ __forceinline__ unsigned xb_ld(unsigned* p)              { return __hip_atomic_load(p, __ATOMIC_RELAXED, __HIP_MEMORY_SCOPE_AGENT); }
__device__ __forceinline__ unsigned xb_add(unsigned* p, unsigned v) { return __hip_atomic_fetch_add(p, v, __ATOMIC_RELAXED, __HIP_MEMORY_SCOPE_AGENT); }
__device__ __forceinline__ unsigned xb_xcc_id() { return (unsigned)__builtin_amdgcn_s_getreg((3 << 11) | 20) & 0xFu; }
#define XB_SPIN(cond, bar) do { unsigned _sp = 0; while (cond) { __builtin_amdgcn_s_sleep(1); \
    if ((++_sp & 255u) == 0u) { if (xb_ld(&(bar)[XB_TMO])) break; if (_sp > XB_SPIN_CAP) { atomicAdd(&(bar)[XB_TMO], 1u); break; } } } } while (0)
struct XcdBarrier { unsigned* bar; unsigned x; volatile LAS unsigned* st; };
__device__ __forceinline__ XcdBarrier xcd_barrier_post(unsigned* bar, volatile LAS unsigned* st) {
    XcdBarrier b; b.bar = bar; b.x = xb_xcc_id(); b.st = st;
    if (__builtin_amdgcn_workitem_id_x() == 0) (void)xb_add(&bar[XB_XCNT(b.x)], 1u);
    return b;
}
__device__ __forceinline__ void xcd_barrier_complete(unsigned* bar, unsigned x, unsigned& nloc, unsigned& nx) {
    const unsigned G = gridDim.x * gridDim.y * gridDim.z;
    unsigned sum, cnt, mine, sp = 0u;
    for (;;) {
        sum = 0u; cnt = 0u; mine = 0u;
#pragma unroll
        for (unsigned j = 0; j < 16; ++j) { const unsigned c = xb_ld(&bar[XB_XCNT(j)]); sum += c; cnt += (c > 0u) ? 1u : 0u; mine = (j == x) ? c : mine; }
        if (sum == G) break;
        __builtin_amdgcn_s_sleep(1);
        if ((++sp & 255u) == 0u) { if (xb_ld(&bar[XB_TMO])) break; if (sp > XB_SPIN_CAP) { atomicAdd(&bar[XB_TMO], 1u); break; } }
    }
    nloc = mine > 0u ? mine : 1u; nx = cnt > 0u ? cnt : 1u;
}
__device__ __forceinline__ void xcd_barrier(const XcdBarrier& b) {
    asm volatile("s_waitcnt vmcnt(0)" ::: "memory");
    __syncthreads();
    if (__builtin_amdgcn_workitem_id_x() == 0) {
        unsigned* bar = b.bar;
        __builtin_amdgcn_s_waitcnt(0);
        unsigned nloc = b.st[0], nx = b.st[1];
        if (nloc == 0u) { xcd_barrier_complete(bar, b.x, nloc, nx); b.st[0] = nloc; b.st[1] = nx; }
        const unsigned old = xb_add(&bar[XB_XSUB(b.x)], 1u);
        const unsigned gen = old / nloc;
        if (old + 1u == (gen + 1u) * nloc) {
            __builtin_amdgcn_fence(__ATOMIC_RELEASE, "agent");
            asm volatile("s_waitcnt vmcnt(0)" ::: "memory");
            const unsigned og = xb_add(&bar[XB_TOP], 1u);
            const unsigned tg = og / nx;
            if (og + 1u == (tg + 1u) * nx) xb_add(&bar[XB_TOPGEN], 1u);
            else XB_SPIN(xb_ld(&bar[XB_TOPGEN]) == tg, bar);
            __builtin_amdgcn_fence(__ATOMIC_ACQUIRE, "agent");
            xb_add(&bar[XB_XGEN(b.x)], 1u);
            asm volatile("s_waitcnt vmcnt(0)" ::: "memory");
        } else {
            XB_SPIN(xb_ld(&bar[XB_XGEN(b.x)]) == gen, bar);
            __builtin_amdgcn_fence(__ATOMIC_ACQUIRE, "agent");
            asm volatile("s_waitcnt vmcnt(0)" ::: "memory");
        }
    }
    __syncthreads();
}

constexpr float QSCALE = 0.10206207261596575f * 1.4426950408889634f;

__device__ __forceinline__ void phase_gemm1(const Params& P, int l, char* lds) {
    unsigned char* ws = P.ws;
    const bf16* XN = (const bf16*)(ws + WS_XN);
    bf16* PROJ = (bf16*)(ws + WS_PROJ);
    bf16* Kb = (bf16*)(ws + WS_K);
    const float* rope = (const float*)(ws + WS_ROPE);
    const bf16* W = (const bf16*)(ws + WS_WIN) + (size_t)l * DINP * LDW;
    gemm_t<false>(W, LDW, DINP, XN, LDX, T, D, C_KR / 128, [&](int n0, int t0, const f32x16& acc, int r32, int hi, float) {
        const int t = t0 + r32;
        if (n0 < C_KR) {
            bf16* pr = PROJ + (size_t)t * DINP + n0 + 4 * hi;
#pragma unroll
            for (int g = 0; g < 4; ++g) { uint2 o; o.x = cvtpk(acc[4 * g], acc[4 * g + 1]); o.y = cvtpk(acc[4 * g + 2], acc[4 * g + 3]); *(uint2*)(pr + 8 * g) = o; }
        } else if (n0 == C_KR) {
            const int b = t / S, s = t % S;
            uint2 o1[2], o2[2];
#pragma unroll
            for (int g = 0; g < 2; ++g) {
                const float4 cs0 = *(const float4*)(rope + ((size_t)s * 16 + 8 * g + 4 * hi) * 2), cs1 = *(const float4*)(rope + ((size_t)s * 16 + 8 * g + 4 * hi) * 2 + 4);
                const float x10 = acc[4 * g], x11 = acc[4 * g + 1], x12 = acc[4 * g + 2], x13 = acc[4 * g + 3];
                const float x20 = acc[8 + 4 * g], x21 = acc[8 + 4 * g + 1], x22 = acc[8 + 4 * g + 2], x23 = acc[8 + 4 * g + 3];
                o1[g].x = cvtpk(x10 * cs0.x - x20 * cs0.y, x11 * cs0.z - x21 * cs0.w); o1[g].y = cvtpk(x12 * cs1.x - x22 * cs1.y, x13 * cs1.z - x23 * cs1.w);
                o2[g].x = cvtpk(x20 * cs0.x + x10 * cs0.y, x21 * cs0.z + x11 * cs0.w); o2[g].y = cvtpk(x22 * cs1.x + x12 * cs1.y, x23 * cs1.z + x13 * cs1.w);
            }
#pragma unroll
            for (int h = 0; h < NH; ++h) {
                bf16* kr = Kb + ((size_t)(b * NH + h) * S + s) * DQK + 64 + 4 * hi;
                *(uint2*)(kr) = o1[0]; *(uint2*)(kr + 8) = o1[1]; *(uint2*)(kr + 16) = o2[0]; *(uint2*)(kr + 24) = o2[1];
            }
        }
    }, [&](int t, int n, const float4& v) {
        uint2 o; o.x = cvtpk(v.x, v.y); o.y = cvtpk(v.z, v.w);
        *(uint2*)(PROJ + (size_t)t * DINP + n) = o;
    }, lds);
}
__device__ __forceinline__ void phase_gemm2(const Params& P, int l, char* lds) {
    unsigned char* ws = P.ws;
    const bf16* PROJ = (const bf16*)(ws + WS_PROJ);
    const float* rope = (const float*)(ws + WS_ROPE);
    {
        const bf16* W = (const bf16*)(ws + WS_WUQ) + (size_t)l * 768 * QR;
        bf16* Qb = (bf16*)(ws + WS_Q);
        gemm_t<true>(W, QR, 768, PROJ + C_CQ, DINP, T, QR, 0, [&](int n0, int t0, const f32x16& acc, int r32, int hi, float ssq) {
            const int t = t0 + r32, b = t / S, s = t % S;
            const int h = n0 / DQK, d0 = n0 % DQK;
            const float sc = rsqrtf(ssq * (1.f / QR) + EPS) * QSCALE;
            bf16* qb = Qb + ((size_t)(b * NH + h) * S + s) * DQK + d0 + 4 * hi;
            if (d0 == 64) {
#pragma unroll
                for (int g = 0; g < 2; ++g) {
                    const float4 cs0 = *(const float4*)(rope + ((size_t)s * 16 + 8 * g + 4 * hi) * 2), cs1 = *(const float4*)(rope + ((size_t)s * 16 + 8 * g + 4 * hi) * 2 + 4);
                    const float x10 = acc[4 * g] * sc, x11 = acc[4 * g + 1] * sc, x12 = acc[4 * g + 2] * sc, x13 = acc[4 * g + 3] * sc;
                    const float x20 = acc[8 + 4 * g] * sc, x21 = acc[8 + 4 * g + 1] * sc, x22 = acc[8 + 4 * g + 2] * sc, x23 = acc[8 + 4 * g + 3] * sc;
                    uint2 o1, o2;
                    o1.x = cvtpk(x10 * cs0.x - x20 * cs0.y, x11 * cs0.z - x21 * cs0.w); o1.y = cvtpk(x12 * cs1.x - x22 * cs1.y, x13 * cs1.z - x23 * cs1.w);
                    o2.x = cvtpk(x20 * cs0.x + x10 * cs0.y, x21 * cs0.z + x11 * cs0.w); o2.y = cvtpk(x22 * cs1.x + x12 * cs1.y, x23 * cs1.z + x13 * cs1.w);
                    *(uint2*)(qb + 8 * g) = o1; *(uint2*)(qb + 16 + 8 * g) = o2;
                }
            } else {
#pragma unroll
                for (int g = 0; g < 4; ++g) { uint2 o; o.x = cvtpk(acc[4 * g] * sc, acc[4 * g + 1] * sc); o.y = cvtpk(acc[4 * g + 2] * sc, acc[4 * g + 3] * sc); *(uint2*)(qb + 8 * g) = o; }
            }
        }, [](int, int, const float4&) {}, lds);
    }
    {
        const bf16* W = (const bf16*)(ws + WS_WUKV) + (size_t)l * 1024 * KVR;
        bf16* Kb = (bf16*)(ws + WS_K); bf16* Vb = (bf16*)(ws + WS_V);
        gemm_t<true>(W, KVR, 1024, PROJ + C_CKV, DINP, T, KVR, 0, [&](int n0, int t0, const f32x16& acc, int r32, int hi, float ssq) {
            const int t = t0 + r32, b = t / S, s = t % S;
            const float sc = rsqrtf(ssq * (1.f / KVR) + EPS);
            bf16* dst;
            if (n0 < 512) dst = Kb + ((size_t)(b * NH + (n0 >> 6)) * S + s) * DQK + (n0 & 63) + 4 * hi;
            else          dst = Vb + ((size_t)(b * NH + ((n0 - 512) >> 6)) * S + s) * DV + (n0 & 63) + 4 * hi;
#pragma unroll
            for (int g = 0; g < 4; ++g) { uint2 o; o.x = cvtpk(acc[4 * g] * sc, acc[4 * g + 1] * sc); o.y = cvtpk(acc[4 * g + 2] * sc, acc[4 * g + 3] * sc); *(uint2*)(dst + 8 * g) = o; }
        }, [](int, int, const float4&) {}, lds);
    }
}
__device__ __forceinline__ void phase_gemm3(const Params& P, int l, char* lds) {
    unsigned char* ws = P.ws;
    const bf16* Yb = (const bf16*)(ws + WS_XN);
    const bf16* W = (const bf16*)(ws + WS_WOUT) + (size_t)l * D * LDW;
    const float* hin = (l == 0) ? P.x : P.out;
    float* out = P.out;
    gemm_t<false>(W, LDW, D, Yb, LDX, T, D, D / 128, [](int, int, const f32x16&, int, int, float) {}, [&](int t, int n, const float4& v) {
        const size_t idx = (size_t)t * D + n;
        const float4 hv = *(const float4*)(hin + idx);
        *(float4*)(out + idx) = make_float4(hv.x + v.x, hv.y + v.y, hv.z + v.z, hv.w + v.w);
    }, lds);
}

#define GSYNC() do { XcdBarrier xb_; { __attribute__((address_space(1))) char* gp_ = (__attribute__((address_space(1))) char*)(char*)(P.ws + WS_CTL); asm volatile("" : "+s"(gp_)); xb_.bar = (unsigned*)(char*)gp_; } \
    xb_.x = xb_xcc_id(); xb_.st = (volatile LAS unsigned*)&xb_words; xcd_barrier(xb_); } while (0)
#define PHASE(stmt) { const Params Q = launder(P); stmt; }
__global__ void __launch_bounds__(NTHREADS, 2) k_all(Params P) {
    __shared__ __attribute__((aligned(16))) char sm[LDS_TOTAL];
    __shared__ uint4 xb_words;
    cg::grid_group grid = cg::this_grid();
    if (__builtin_amdgcn_workitem_id_x() == 0) xb_words = make_uint4(0u, 0u, 0u, 0u);
    __syncthreads();
    (void)xcd_barrier_post((unsigned*)(P.ws + WS_CTL), (volatile LAS unsigned*)&xb_words);
    __shared__ int xinfo[8];
    if (__builtin_amdgcn_workitem_id_x() == 0) {
        const unsigned x = xb_xcc_id();
        xinfo[XI_X] = (int)x; xinfo[XI_RANK] = (int)xb_add((unsigned*)(P.ws + WS_CTL) + CTL_CENSUS + x, 1u);
    }
    PHASE(phase_prep(Q, sm));
    PHASE(phase_norm(Q.x, Q.norm_mix, (bf16*)(Q.ws + WS_XN)));
    grid.sync();
    if (__builtin_amdgcn_workitem_id_x() == 0) {
        unsigned* cen = (unsigned*)(P.ws + WS_CTL) + CTL_CENSUS;
        const int x = xinfo[XI_X]; int nx = 0, jj = 0;
        for (int q = 0; q < 16; ++q) { const unsigned cq = xb_ld(cen + q); if (cq) { if (q < x) ++jj; ++nx; } }
        xinfo[XI_J] = jj; xinfo[XI_NX] = nx; xinfo[XI_NLOC] = (int)xb_ld(cen + x);
    }
    __syncthreads();
    for (int l = 0; l < DEPTH; ++l) {
        PHASE(phase_gemm1(Q, l, sm));
#if PROBE_DUP & 2
        PHASE(phase_gemm1(Q, l, sm));
#endif
        GSYNC();
        PHASE(phase_mixlocal(Q, l, sm));
#if PROBE_DUP & 256
        PHASE(phase_mixlocal(Q, l, sm));
#endif
        PHASE(phase_gemm2(Q, l, sm));
        GSYNC();
        PHASE(phase_attn(Q, sm));
        GSYNC();
        PHASE(phase_gemm3(Q, l, sm));
#if PROBE_DUP & 16
        if (l == 0) PHASE(phase_gemm3(Q, l, sm));
#endif
        GSYNC();
        PHASE(phase_norm_q(Q, l));
        GSYNC();
        PHASE(phase_route(Q, l, sm));
        GSYNC();
        PHASE(phase_gu(Q, l, xinfo));
        GSYNC();
        PHASE(phase_gw(Q, l));
        GSYNC();
        PHASE(phase_gv(Q, l, xinfo));
        GSYNC();
        PHASE(phase_gnorm(Q, l));
        GSYNC();
    }
}

extern "C" void kernel_launch(void* const* d_in, const int* in_sizes, int n_in, void* d_out, int out_size, void* d_ws, size_t ws_size, hipStream_t stream) {
    static int grid = 0;
    if (grid == 0) {
        if (n_in != 18 || out_size != T * D || ws_size < WS_END) { fprintf(stderr, "kernel_launch: bad sizes n_in %d out %d ws %zu need %zu\n", n_in, out_size, ws_size, (size_t)WS_END); grid = -1; return; }
        int dev = 0, cus = 0, per_cu = 0;
        (void)hipGetDevice(&dev);
        (void)hipDeviceGetAttribute(&cus, hipDeviceAttributeMultiprocessorCount, dev);
        (void)hipOccupancyMaxActiveBlocksPerMultiprocessor(&per_cu, (const void*)k_all, NTHREADS, 0);
        if (per_cu > 2) per_cu = 2;
        if (per_cu < 1) { fprintf(stderr, "kernel_launch: occupancy query says %d\n", per_cu); grid = -1; return; }
        grid = cus * per_cu;
    }
    if (grid < 0) return;
    Params p{};
    p.x = (const float*)d_in[0]; p.norm_mix = (const float*)d_in[1]; p.w_in = (const float*)d_in[2]; p.conv_w = (const float*)d_in[3];
    p.pool_w = (const float*)d_in[4]; p.pool_scale = (const float*)d_in[5]; p.q_norm = (const float*)d_in[6]; p.w_uq = (const float*)d_in[7];
    p.kv_norm = (const float*)d_in[8]; p.w_uk = (const float*)d_in[9]; p.w_uv = (const float*)d_in[10]; p.w_out = (const float*)d_in[11];
    p.norm_ffn = (const float*)d_in[12]; p.peer_wq = (const float*)d_in[13]; p.peer_subkeys = (const float*)d_in[14]; p.peer_u = (const float*)d_in[15];
    p.peer_v = (const float*)d_in[16]; p.norm_final = (const float*)d_in[17];
    p.out = (float*)d_out; p.ws = (unsigned char*)d_ws;
    if (hipMemsetAsync((char*)d_ws + WS_CTL, 0, CTL_BYTES, stream) != hipSuccess) { fprintf(stderr, "kernel_launch: memset failed\n"); return; }
    void* args[] = {&p};
    hipError_t e = hipLaunchCooperativeKernel((const void*)k_all, dim3(grid), dim3(NTHREADS), args, 0, stream);
    if (e != hipSuccess) fprintf(stderr, "cooperative launch failed: %s (grid %d)\n", hipGetErrorString(e), grid);
}
```

```cpp
#include <hip/hip_runtime.h>
#include <hip/hip_cooperative_groups.h>
#include <cstdio>
#include <cstdint>
namespace cg = cooperative_groups;

#ifndef TAB_FP8
#define TAB_FP8 1
#endif
#ifndef PROBE_DUP
#define PROBE_DUP 0
#endif

constexpr int NB = 4, S = 8192, T = NB * S, D = 1024, DEPTH = 2;
constexpr int DIN = 1696, DINP = 1792;
constexpr int C_BG = 0, C_CG = 256, C_HC = 512, C_HP = 768, C_CQ = 1024, C_CKV = 1408, C_KR = 1664;
constexpr int QR = 384, KVR = 256, NH = 8, DQK = 96, DV = 64;
constexpr int PH = 8, NKEY = 128, NEXP = NKEY * NKEY, TOPK = 16, HK = PH * TOPK;
constexpr float EPS = 1e-6f;
constexpr int LDX = 1088;
constexpr int LDW = 1088;

typedef unsigned short bf16;

constexpr size_t WS_CTL   = 0;
constexpr size_t WS_ROPE  = 64 * 1024;
constexpr size_t WS_WIN   = WS_ROPE + (size_t)S * 16 * 2 * 4;
constexpr size_t WS_WUQ   = WS_WIN + (size_t)DEPTH * DINP * LDW * 2;
constexpr size_t WS_WUKV  = WS_WUQ + (size_t)DEPTH * 768 * QR * 2;
constexpr size_t WS_WOUT  = WS_WUKV + (size_t)DEPTH * 1024 * KVR * 2;
constexpr size_t WS_WPQ   = WS_WOUT + (size_t)DEPTH * D * LDW * 2;
constexpr size_t WS_XN    = ((WS_WPQ + (size_t)DEPTH * 2048 * LDW * 2 + 4095) / 4096) * 4096;
constexpr size_t WS_PROJ  = WS_XN + (size_t)T * LDX * 2;
constexpr size_t WS_Q     = WS_PROJ + (size_t)T * DINP * 2;
constexpr size_t WS_K     = WS_Q + (size_t)T * NH * DQK * 2;
constexpr size_t WS_V     = WS_K + (size_t)T * NH * DQK * 2;
constexpr size_t WS_EXP   = WS_V + (size_t)T * NH * DV * 2;
constexpr size_t WS_GATE  = WS_EXP + (size_t)T * HK * 4;
constexpr size_t TAB_ROWB = TAB_FP8 ? 1024 : 2048;
constexpr size_t WS_TABU  = WS_GATE + (size_t)T * HK * 4;
constexpr size_t WS_TABV  = WS_TABU + (size_t)DEPTH * NEXP * TAB_ROWB;
constexpr size_t WS_TSCU  = WS_TABV + (size_t)DEPTH * NEXP * TAB_ROWB;
constexpr size_t WS_TSCV  = WS_TSCU + (size_t)DEPTH * NEXP * 4;
constexpr size_t WS_XQ    = WS_TSCV + (size_t)DEPTH * NEXP * 4;
constexpr size_t WS_XS    = WS_XQ + (size_t)T * D;
constexpr size_t WS_END   = WS_XS + (size_t)T * 4;
static_assert(WS_END <= (size_t)512 * 1024 * 1024, "workspace budget");

struct Params {
    const float* x; const float* norm_mix; const float* w_in; const float* conv_w; const float* pool_w; const float* pool_scale;
    const float* q_norm; const float* w_uq; const float* kv_norm; const float* w_uk; const float* w_uv; const float* w_out;
    const float* norm_ffn; const float* peer_wq; const float* peer_subkeys; const float* peer_u; const float* peer_v; const float* norm_final;
    float* out; unsigned char* ws;
};

__device__ __forceinline__ bf16 f2bf(float f) { unsigned u = __float_as_uint(f); u += 0x7fffu + ((u >> 16) & 1u); return (bf16)(u >> 16); }
__device__ __forceinline__ float bf2f(bf16 h) { return __uint_as_float(((unsigned)h) << 16); }
__device__ __forceinline__ float bflo(unsigned u) { return __uint_as_float(u << 16); }
__device__ __forceinline__ float bfhi(unsigned u) { return __uint_as_float(u & 0xffff0000u); }
__device__ __forceinline__ unsigned pack2(float a, float b) { return (unsigned)f2bf(a) | ((unsigned)f2bf(b) << 16); }
__device__ __forceinline__ float wave_sum(float v) {
#pragma unroll
    for (int m = 32; m >= 1; m >>= 1) v += __shfl_xor(v, m, 64);
    return v;
}
__device__ __forceinline__ float gelu_exact(float x) { return 0.5f * x * (1.f + erff(x * 0.70710678118654752f)); }

#define NTHREADS 256
__device__ __forceinline__ int tidx() { int t = (int)__builtin_amdgcn_workitem_id_x(); asm volatile("" : "+v"(t)); return t; }
__device__ __forceinline__ int gwave() { return blockIdx.x * (NTHREADS / 64) + (tidx() >> 6); }
__device__ __forceinline__ int nwave() { return gridDim.x * (NTHREADS / 64); }
__device__ __forceinline__ size_t gtid() { return (size_t)blockIdx.x * NTHREADS + tidx(); }
__device__ __forceinline__ size_t gnth() { return (size_t)gridDim.x * NTHREADS; }


__device__ __forceinline__ Params launder(const Params& P) {
    typedef __attribute__((address_space(1))) char* gp_t;
    gp_t g[20] = {(gp_t)(char*)P.x, (gp_t)(char*)P.norm_mix, (gp_t)(char*)P.w_in, (gp_t)(char*)P.conv_w, (gp_t)(char*)P.pool_w, (gp_t)(char*)P.pool_scale, (gp_t)(char*)P.q_norm, (gp_t)(char*)P.w_uq,
                  (gp_t)(char*)P.kv_norm, (gp_t)(char*)P.w_uk, (gp_t)(char*)P.w_uv, (gp_t)(char*)P.w_out, (gp_t)(char*)P.norm_ffn, (gp_t)(char*)P.peer_wq, (gp_t)(char*)P.peer_subkeys,
                  (gp_t)(char*)P.peer_u, (gp_t)(char*)P.peer_v, (gp_t)(char*)P.norm_final, (gp_t)(char*)P.out, (gp_t)(char*)P.ws};
    asm volatile("" : "+s"(g[0]), "+s"(g[1]), "+s"(g[2]), "+s"(g[3]), "+s"(g[4]), "+s"(g[5]), "+s"(g[6]), "+s"(g[7]), "+s"(g[8]), "+s"(g[9]));
    asm volatile("" : "+s"(g[10]), "+s"(g[11]), "+s"(g[12]), "+s"(g[13]), "+s"(g[14]), "+s"(g[15]), "+s"(g[16]), "+s"(g[17]), "+s"(g[18]), "+s"(g[19]));
    Params Q;
    Q.x = (const float*)(char*)g[0]; Q.norm_mix = (const float*)(char*)g[1]; Q.w_in = (const float*)(char*)g[2]; Q.conv_w = (const float*)(char*)g[3]; Q.pool_w = (const float*)(char*)g[4];
    Q.pool_scale = (const float*)(char*)g[5]; Q.q_norm = (const float*)(char*)g[6]; Q.w_uq = (const float*)(char*)g[7]; Q.kv_norm = (const float*)(char*)g[8]; Q.w_uk = (const float*)(char*)g[9];
    Q.w_uv = (const float*)(char*)g[10]; Q.w_out = (const float*)(char*)g[11]; Q.norm_ffn = (const float*)(char*)g[12]; Q.peer_wq = (const float*)(char*)g[13]; Q.peer_subkeys = (const float*)(char*)g[14];
    Q.peer_u = (const float*)(char*)g[15]; Q.peer_v = (const float*)(char*)g[16]; Q.norm_final = (const float*)(char*)g[17]; Q.out = (float*)(char*)g[18]; Q.ws = (unsigned char*)(char*)g[19];
    return Q;
}

typedef __attribute__((ext_vector_type(8))) short bf16x8;
typedef __attribute__((ext_vector_type(16))) float f32x16;
typedef __attribute__((ext_vector_type(2))) __bf16 bf2_t;
#define MFMA32(a, b, c) __builtin_amdgcn_mfma_f32_32x32x16_bf16(a, b, c, 0, 0, 0)
__device__ __forceinline__ int crow(int r, int hi) { return (r & 3) + 8 * (r >> 2) + 4 * hi; }
__device__ __forceinline__ float dot2bf(unsigned a, unsigned b, float c) { return __builtin_amdgcn_fdot2_f32_bf16(__builtin_bit_cast(bf2_t, a), __builtin_bit_cast(bf2_t, b), c, false); }
__device__ __forceinline__ unsigned cvtpk(float lo, float hi) { unsigned r; asm("v_cvt_pk_bf16_f32 %0, %1, %2" : "=v"(r) : "v"(lo), "v"(hi)); return r; }
constexpr int G_OPB = 128 * 128;
constexpr int G_BUF = 2 * G_OPB;
constexpr int GEMM_LDS = 2 * G_BUF;
constexpr int LDS_TOTAL = GEMM_LDS + 8192;

template <int WT, bool ROWSS>
__device__ __forceinline__ void gemm_kloop(const bf16* __restrict__ Ag0, int lda, const bf16* __restrict__ Bg0, int ldb, int nk, f32x16 (&acc)[4], float (&ss)[4], char* lds, int tid) {
    const int lane = tid & 63, w = __builtin_amdgcn_readfirstlane(tid >> 6), r32 = lane & 31, hi = lane >> 5;
    const int srow = 8 * w + (lane >> 3);
    const int sch = (lane & 7) ^ ((srow >> 1) & 7);
    const bf16* Ag = Ag0 + (size_t)srow * lda + sch * 8;
    const bf16* Bg = Bg0 + (size_t)srow * ldb + sch * 8;
#pragma unroll
    for (int i = 0; i < 4; ++i)
#pragma unroll
        for (int r = 0; r < 16; ++r) acc[i][r] = 0.f;
    ss[0] = 0.f; ss[1] = 0.f; ss[2] = 0.f; ss[3] = 0.f;
    typedef __attribute__((address_space(3))) unsigned* ldsp_t;
    typedef const __attribute__((address_space(1))) unsigned* glbp_t;
#define G_DMA(buf, kofs) do { char* d_ = lds + (buf) * G_BUF + (8 * w) * 128; \
    _Pragma("unroll") for (int i = 0; i < 4; ++i) { \
        __builtin_amdgcn_global_load_lds((glbp_t)(const void*)(Ag + (size_t)(32 * i) * lda + (kofs)), (ldsp_t)(void*)(d_ + i * 4096), 16, 0, 0); \
        __builtin_amdgcn_global_load_lds((glbp_t)(const void*)(Bg + (size_t)(32 * i) * ldb + (kofs)), (ldsp_t)(void*)(d_ + G_OPB + i * 4096), 16, 0, 0); } } while (0)
    const int xr = (r32 >> 1) & 7;
    const int o0 = ((0 + hi) ^ xr) << 4, o1 = ((2 + hi) ^ xr) << 4, o2 = ((4 + hi) ^ xr) << 4, o3 = ((6 + hi) ^ xr) << 4;
#define G_SS(s_, r_) do { union { bf16x8 v; uint4 u; } c_; c_.v = r_; s_ = dot2bf(c_.u.x, c_.u.x, s_); s_ = dot2bf(c_.u.y, c_.u.y, s_); s_ = dot2bf(c_.u.z, c_.u.z, s_); s_ = dot2bf(c_.u.w, c_.u.w, s_); } while (0)
#define G_STEP(pa, pb, off) do { \
    if (WT == 0) { \
        const bf16x8 a0 = *(const bf16x8*)(pa + off), a1 = *(const bf16x8*)(pa + 32 * 128 + off); \
        const bf16x8 b0 = *(const bf16x8*)(pb + off), b1 = *(const bf16x8*)(pb + 32 * 128 + off); \
        if (ROWSS) { G_SS(ss[0], b0); G_SS(ss[1], b1); } \
        acc[0] = MFMA32(a0, b0, acc[0]); acc[1] = MFMA32(a0, b1, acc[1]); \
        acc[2] = MFMA32(a1, b0, acc[2]); acc[3] = MFMA32(a1, b1, acc[3]); \
    } else { \
        const bf16x8 b0 = *(const bf16x8*)(pb + off); \
        const bf16x8 a0 = *(const bf16x8*)(pa + off), a1 = *(const bf16x8*)(pa + 32 * 128 + off); \
        const bf16x8 a2 = *(const bf16x8*)(pa + 64 * 128 + off), a3 = *(const bf16x8*)(pa + 96 * 128 + off); \
        acc[0] = MFMA32(a0, b0, acc[0]); acc[1] = MFMA32(a1, b0, acc[1]); \
        acc[2] = MFMA32(a2, b0, acc[2]); acc[3] = MFMA32(a3, b0, acc[3]); \
    } } while (0)
    const int arow = (WT == 0) ? ((w >> 1) * 64 + r32) : r32;
    const int brow = (WT == 0) ? ((w & 1) * 64 + r32) : (w * 32 + r32);
    G_DMA(0, 0);
    for (int kt = 0; kt < nk; ++kt) {
        __syncthreads();
        if (kt + 1 < nk) G_DMA((kt + 1) & 1, (kt + 1) * 64);
        const char* pa = lds + (kt & 1) * G_BUF + arow * 128;
        const char* pb = lds + (kt & 1) * G_BUF + G_OPB + brow * 128;
        G_STEP(pa, pb, o0); G_STEP(pa, pb, o1); G_STEP(pa, pb, o2); G_STEP(pa, pb, o3);
    }
    if (ROWSS) { ss[0] += __shfl_xor(ss[0], 32, 64); ss[1] += __shfl_xor(ss[1], 32, 64); }
#undef G_DMA
#undef G_SS
#undef G_STEP
}

constexpr int ST_P = 68;
static_assert(4 * 64 * ST_P * 4 <= LDS_TOTAL, "staging LDS");
template <bool ROWSS, class EPI, class EPIROW, class RSC>
__device__ __forceinline__ void gemm_t(const bf16* __restrict__ Wt, int ldw, int N, const bf16* __restrict__ X, int ldx, int M, int K, int tn_direct, EPI epi, EPIROW epirow, RSC rowscale, char* lds) {
    const int tid = tidx(), lane = tid & 63, w = tid >> 6, r32 = lane & 31, hi = lane >> 5;
    const int tilesN = N / 128, tilesM = M / 128, nk = K / 64;
    for (int tile = blockIdx.x; tile < tilesM * tilesN; tile += gridDim.x) {
        const int tm = tile / tilesN, tn = tile % tilesN;
        f32x16 acc[4]; float ss[4];
        gemm_kloop<0, ROWSS>(Wt + (size_t)(tn * 128) * ldw, ldw, X + (size_t)(tm * 128) * ldx, ldx, nk, acc, ss, lds, tid);
        if (tn < tn_direct) {
            __syncthreads();
            float* st = (float*)lds + w * (64 * ST_P);
            const float m0_ = rowscale(ss[0]), m1_ = rowscale(ss[1]);
#pragma unroll
            for (int i = 0; i < 2; ++i)
#pragma unroll
                for (int j = 0; j < 2; ++j)
#pragma unroll
                    for (int g = 0; g < 4; ++g) {
                        const float mj = j ? m1_ : m0_;
                        *(float4*)(st + (32 * j + r32) * ST_P + 32 * i + 8 * g + 4 * hi) = make_float4(acc[i * 2 + j][4 * g] * mj, acc[i * 2 + j][4 * g + 1] * mj, acc[i * 2 + j][4 * g + 2] * mj, acc[i * 2 + j][4 * g + 3] * mj);
                    }
            const int rr = lane >> 4, ch = lane & 15;
#pragma unroll 4
            for (int it = 0; it < 16; ++it) {
                const int row = it * 4 + rr;
                const float4 v = *(const float4*)(st + row * ST_P + ch * 4);
                epirow(tm * 128 + (w & 1) * 64 + row, tn * 128 + (w >> 1) * 64 + ch * 4, v);
            }
        } else {
#pragma unroll
            for (int i = 0; i < 2; ++i)
#pragma unroll
                for (int j = 0; j < 2; ++j) {
                    const int tl = (w & 1) * 64 + j * 32;
                    epi(tn * 128 + (w >> 1) * 64 + i * 32, tm * 128 + tl, acc[i * 2 + j], r32, hi, ss[j]);
                }
        }
        __syncthreads();
    }
}

__device__ __forceinline__ void transpose_tiled(const float* __restrict__ W, bf16* __restrict__ Wt, int K, int N, int Npad, int ldk, const float* __restrict__ gain, char* lds) {
    float (*tl)[65] = (float (*)[65])lds;
    const int tid = tidx(), a = tid & 63, q = tid >> 6;
    const int tK = K / 64, tN = Npad / 64;
    for (int tile = blockIdx.x; tile < tK * tN; tile += gridDim.x) {
        const int k0 = (tile / tN) * 64, n0 = (tile % tN) * 64;
#pragma unroll 4
        for (int i = 0; i < 16; ++i) {
            const int k = k0 + q * 16 + i, n = n0 + a;
            float v = (n < N) ? W[(size_t)k * N + n] : 0.f;
            if (gain) v *= gain[k];
            tl[q * 16 + i][a] = v;
        }
        __syncthreads();
#pragma unroll 4
        for (int i = 0; i < 16; ++i) { const int nl = q * 16 + i; Wt[(size_t)(n0 + nl) * ldk + k0 + a] = f2bf(tl[a][nl]); }
        __syncthreads();
    }
}

__device__ __forceinline__ void quant_row(const float4 (&v)[4], unsigned char* __restrict__ dst, float* __restrict__ scl, int r, int lane) {
    float am = 0.f;
#pragma unroll
    for (int j = 0; j < 4; ++j) am = fmaxf(am, fmaxf(fmaxf(fabsf(v[j].x), fabsf(v[j].y)), fmaxf(fabsf(v[j].z), fabsf(v[j].w))));
#pragma unroll
    for (int m = 32; m >= 1; m >>= 1) am = fmaxf(am, __shfl_xor(am, m, 64));
    const float sc = (am > 0.f) ? am * (1.f / 448.f) : 1.f;
    const float is = 1.f / sc;
    uint4 o;
    { int w = 0; w = __builtin_amdgcn_cvt_pk_fp8_f32(v[0].x * is, v[0].y * is, w, false); w = __builtin_amdgcn_cvt_pk_fp8_f32(v[0].z * is, v[0].w * is, w, true); o.x = (unsigned)w; }
    { int w = 0; w = __builtin_amdgcn_cvt_pk_fp8_f32(v[1].x * is, v[1].y * is, w, false); w = __builtin_amdgcn_cvt_pk_fp8_f32(v[1].z * is, v[1].w * is, w, true); o.y = (unsigned)w; }
    { int w = 0; w = __builtin_amdgcn_cvt_pk_fp8_f32(v[2].x * is, v[2].y * is, w, false); w = __builtin_amdgcn_cvt_pk_fp8_f32(v[2].z * is, v[2].w * is, w, true); o.z = (unsigned)w; }
    { int w = 0; w = __builtin_amdgcn_cvt_pk_fp8_f32(v[3].x * is, v[3].y * is, w, false); w = __builtin_amdgcn_cvt_pk_fp8_f32(v[3].z * is, v[3].w * is, w, true); o.w = (unsigned)w; }
    { const int lay = r / NEXP, e = r % NEXP; *(uint4*)(dst + (((size_t)(lay * 8 + (lane >> 3)) * NEXP + e) * 128) + (lane & 7) * 16) = o; }
    if (lane == 0) scl[r] = sc;
}
__device__ __forceinline__ unsigned pack_i8x4(float a, float b, float c, float d) {
    const int ia = __float2int_rn(a), ib = __float2int_rn(b), ic = __float2int_rn(c), id = __float2int_rn(d);
    return (unsigned)(ia & 255) | ((unsigned)(ib & 255) << 8) | ((unsigned)(ic & 255) << 16) | ((unsigned)(id & 255) << 24);
}
__device__ __forceinline__ void quant_row_i8(const float4 (&v)[4], unsigned char* __restrict__ dst, float* __restrict__ scl, int r, int lane) {
    float am = 0.f;
#pragma unroll
    for (int j = 0; j < 4; ++j) am = fmaxf(am, fmaxf(fmaxf(fabsf(v[j].x), fabsf(v[j].y)), fmaxf(fabsf(v[j].z), fabsf(v[j].w))));
#pragma unroll
    for (int m = 32; m >= 1; m >>= 1) am = fmaxf(am, __shfl_xor(am, m, 64));
    const float sc = (am > 0.f) ? am * (1.f / 127.f) : 1.f;
    const float is = 1.f / sc;
    uint4 o;
    o.x = pack_i8x4(v[0].x * is, v[0].y * is, v[0].z * is, v[0].w * is); o.y = pack_i8x4(v[1].x * is, v[1].y * is, v[1].z * is, v[1].w * is);
    o.z = pack_i8x4(v[2].x * is, v[2].y * is, v[2].z * is, v[2].w * is); o.w = pack_i8x4(v[3].x * is, v[3].y * is, v[3].z * is, v[3].w * is);
    { const int lay = r / NEXP, e = r % NEXP; *(uint4*)(dst + (((size_t)(lay * 8 + (lane >> 3)) * NEXP + e) * 128) + (lane & 7) * 16) = o; }
    if (lane == 0) scl[r] = sc;
}
template <bool I8>
__device__ __forceinline__ void convert_table(const float* __restrict__ src, unsigned char* __restrict__ dst, float* __restrict__ scl, int rows) {
    static_assert(TAB_FP8, "fp8 tables");
    const int lane = tidx() & 63;
    const int nw = nwave();
    for (int r = gwave(); r < rows; r += 2 * nw) {
        const int r2 = r + nw;
        float4 v0[4], v1[4];
        const float4* s0 = (const float4*)(src + (size_t)r * D);
        const float4* s1 = (const float4*)(src + (size_t)(r2 < rows ? r2 : r) * D);
#pragma unroll
        for (int j = 0; j < 4; ++j) { v0[j] = s0[lane * 4 + j]; v1[j] = s1[lane * 4 + j]; }
        if (I8) { quant_row_i8(v0, dst, scl, r, lane); if (r2 < rows) quant_row_i8(v1, dst, scl, r2, lane); }
        else { quant_row(v0, dst, scl, r, lane); if (r2 < rows) quant_row(v1, dst, scl, r2, lane); }
    }
}
__device__ __forceinline__ void phase_prep(const Params& P, char* lds) {
    unsigned char* ws = P.ws;
    for (int l = 0; l < DEPTH; ++l) {
        transpose_tiled(P.w_in + (size_t)l * D * DIN, (bf16*)(ws + WS_WIN) + (size_t)l * DINP * LDW, D, DIN, DINP, LDW, nullptr, lds);
        transpose_tiled(P.w_uq + (size_t)l * QR * 768, (bf16*)(ws + WS_WUQ) + (size_t)l * 768 * QR, QR, 768, 768, QR, P.q_norm + l * QR, lds);
        transpose_tiled(P.w_uk + (size_t)l * KVR * 512, (bf16*)(ws + WS_WUKV) + (size_t)l * 1024 * KVR, KVR, 512, 512, KVR, P.kv_norm + l * KVR, lds);
        transpose_tiled(P.w_uv + (size_t)l * KVR * 512, (bf16*)(ws + WS_WUKV) + (size_t)l * 1024 * KVR + (size_t)512 * KVR, KVR, 512, 512, KVR, P.kv_norm + l * KVR, lds);
        transpose_tiled(P.w_out + (size_t)l * D * D, (bf16*)(ws + WS_WOUT) + (size_t)l * D * LDW, D, D, D, LDW, nullptr, lds);
    }
    {
        bf16* Wc = (bf16*)(ws + WS_WPQ);
        float (*As)[68] = (float (*)[68])lds;
        float (*Bs)[68] = (float (*)[68])(lds + 16 * 68 * 4);
        const int tid = tidx(), tx = tid & 15, ty = tid >> 4;
        const int lr = tid >> 2, ld4 = (tid & 3) * 4;
        for (int tile = blockIdx.x; tile < (DEPTH * 2048 / 64) * (D / 64); tile += gridDim.x) {
            const int row0 = (tile >> 4) * 64, k0 = (tile & 15) * 64;
            const int l = row0 >> 11, hp = (row0 >> 7) & 15, n0 = row0 & 127;
            const float* skp = P.peer_subkeys + (((size_t)l * 2 + (hp & 1)) * NKEY + n0 + lr) * 128 + ld4;
            const float* wqp = P.peer_wq + ((size_t)l * D + k0 + lr) * 2048 + hp * 128 + ld4;
            float acc[4][4];
#pragma unroll
            for (int i = 0; i < 4; ++i)
#pragma unroll
                for (int j = 0; j < 4; ++j) acc[i][j] = 0.f;
            for (int d0 = 0; d0 < 128; d0 += 16) {
                const float4 av = *(const float4*)(skp + d0), bv = *(const float4*)(wqp + d0);
                As[ld4 + 0][lr] = av.x; As[ld4 + 1][lr] = av.y; As[ld4 + 2][lr] = av.z; As[ld4 + 3][lr] = av.w;
                Bs[ld4 + 0][lr] = bv.x; Bs[ld4 + 1][lr] = bv.y; Bs[ld4 + 2][lr] = bv.z; Bs[ld4 + 3][lr] = bv.w;
                __syncthreads();
#pragma unroll
                for (int kk = 0; kk < 16; ++kk) {
                    const float4 a4 = *(const float4*)&As[kk][ty * 4], b4 = *(const float4*)&Bs[kk][tx * 4];
                    const float aa[4] = {a4.x, a4.y, a4.z, a4.w}, bb[4] = {b4.x, b4.y, b4.z, b4.w};
#pragma unroll
                    for (int i = 0; i < 4; ++i)
#pragma unroll
                        for (int j = 0; j < 4; ++j) acc[i][j] = fmaf(aa[i], bb[j], acc[i][j]);
                }
                __syncthreads();
            }
#pragma unroll
            for (int i = 0; i < 4; ++i) {
                uint2 o; o.x = pack2(acc[i][0], acc[i][1]); o.y = pack2(acc[i][2], acc[i][3]);
                *(uint2*)(Wc + (size_t)(row0 + ty * 4 + i) * LDW + k0 + tx * 4) = o;
            }
        }
    }
    convert_table<true>(P.peer_u, ws + WS_TABU, (float*)(ws + WS_TSCU), DEPTH * NEXP);
    convert_table<false>(P.peer_v, ws + WS_TABV, (float*)(ws + WS_TSCV), DEPTH * NEXP);
    float* rope = (float*)(ws + WS_ROPE);
    for (size_t i = gtid(); i < (size_t)S * 16; i += gnth()) {
        const int s = (int)(i >> 4), f = (int)(i & 15);
        const double inv = pow(10000.0, -(double)f / 16.0);
        const double ang = (double)s * inv;
        rope[2 * i] = (float)cos(ang); rope[2 * i + 1] = (float)sin(ang);
    }
}

__device__ __forceinline__ void phase_norm(const float* __restrict__ h, const float* __restrict__ g, bf16* __restrict__ xn) {
    const int lane = tidx() & 63;
    for (int t = gwave(); t < T; t += nwave()) {
        const float4* hr = (const float4*)(h + (size_t)t * D);
        float4 v[4]; float ss = 0.f;
#pragma unroll
        for (int j = 0; j < 4; ++j) { v[j] = hr[j * 64 + lane]; ss += v[j].x * v[j].x + v[j].y * v[j].y + v[j].z * v[j].z + v[j].w * v[j].w; }
        ss = wave_sum(ss);
        const float r = rsqrtf(ss * (1.f / D) + EPS);
#pragma unroll
        for (int j = 0; j < 4; ++j) {
            const float4 gg = ((const float4*)g)[j * 64 + lane];
            uint2 o; o.x = pack2(v[j].x * r * gg.x, v[j].y * r * gg.y); o.y = pack2(v[j].z * r * gg.z, v[j].w * r * gg.w);
            ((uint2*)(xn + (size_t)t * LDX))[j * 64 + lane] = o;
        }
    }
}

__device__ __forceinline__ void phase_norm_q(const Params& P, int l) {
    const int lane = tidx() & 63;
    const float* g = P.norm_ffn + l * D;
    bf16* xn = (bf16*)(P.ws + WS_XN);
    unsigned* xq = (unsigned*)(P.ws + WS_XQ);
    float* xsc = (float*)(P.ws + WS_XS);
    for (int t = gwave(); t < T; t += nwave()) {
        const float4* hr = (const float4*)(P.out + (size_t)t * D);
        float4 v[4]; float ss = 0.f;
#pragma unroll
        for (int j = 0; j < 4; ++j) { v[j] = hr[j * 64 + lane]; ss += v[j].x * v[j].x + v[j].y * v[j].y + v[j].z * v[j].z + v[j].w * v[j].w; }
        ss = wave_sum(ss);
        const float r = rsqrtf(ss * (1.f / D) + EPS);
        float am = 0.f;
#pragma unroll
        for (int j = 0; j < 4; ++j) {
            const float4 gg = ((const float4*)g)[j * 64 + lane];
            v[j].x *= r * gg.x; v[j].y *= r * gg.y; v[j].z *= r * gg.z; v[j].w *= r * gg.w;
            am = fmaxf(am, fmaxf(fmaxf(fabsf(v[j].x), fabsf(v[j].y)), fmaxf(fabsf(v[j].z), fabsf(v[j].w))));
            uint2 o; o.x = pack2(v[j].x, v[j].y); o.y = pack2(v[j].z, v[j].w);
            ((uint2*)(xn + (size_t)t * LDX))[j * 64 + lane] = o;
        }
#pragma unroll
        for (int m = 32; m >= 1; m >>= 1) am = fmaxf(am, __shfl_xor(am, m, 64));
        const float sc = (am > 0.f) ? am * (1.f / 127.f) : 1.f, is = 1.f / sc;
#pragma unroll
        for (int j = 0; j < 4; ++j) xq[(size_t)t * (D / 4) + j * 64 + lane] = pack_i8x4(v[j].x * is, v[j].y * is, v[j].z * is, v[j].w * is);
        if (lane == 0) xsc[t] = sc;
    }
}

__device__ __forceinline__ void phase_mixlocal(const Params& P, int l, char* lds) {
    const bf16* proj = (const bf16*)(P.ws + WS_PROJ);
    bf16* Y = (bf16*)(P.ws + WS_XN);
    const int tid = tidx();
    {
        const float* cw = P.conv_w + (size_t)l * 3 * 256;
        for (size_t i = gtid(); i < (size_t)T * 32; i += gnth()) {
            const int t = (int)(i >> 5), c0 = (int)(i & 31) * 8, s = t & (S - 1);
            const bf16* pr = proj + (size_t)t * DINP;
            float acc[8];
#pragma unroll
            for (int e = 0; e < 8; ++e) acc[e] = 0.f;
#pragma unroll
            for (int j = 0; j < 3; ++j) {
                if (s - 2 + j >= 0) {
                    const bf16* pp = pr - (size_t)(2 - j) * DINP;
                    const uint4 g = *(const uint4*)(pp + C_CG + c0), hc = *(const uint4*)(pp + C_HC + c0);
                    const float4 w0 = *(const float4*)(cw + j * 256 + c0), w1 = *(const float4*)(cw + j * 256 + c0 + 4);
                    acc[0] = fmaf(w0.x, bflo(g.x) * bflo(hc.x), acc[0]); acc[1] = fmaf(w0.y, bfhi(g.x) * bfhi(hc.x), acc[1]);
                    acc[2] = fmaf(w0.z, bflo(g.y) * bflo(hc.y), acc[2]); acc[3] = fmaf(w0.w, bfhi(g.y) * bfhi(hc.y), acc[3]);
                    acc[4] = fmaf(w1.x, bflo(g.z) * bflo(hc.z), acc[4]); acc[5] = fmaf(w1.y, bfhi(g.z) * bfhi(hc.z), acc[5]);
                    acc[6] = fmaf(w1.z, bflo(g.w) * bflo(hc.w), acc[6]); acc[7] = fmaf(w1.w, bfhi(g.w) * bfhi(hc.w), acc[7]);
                }
            }
            const uint4 bg = *(const uint4*)(pr + C_BG + c0);
            uint4 o;
            o.x = pack2(bflo(bg.x) * acc[0], bfhi(bg.x) * acc[1]); o.y = pack2(bflo(bg.y) * acc[2], bfhi(bg.y) * acc[3]);
            o.z = pack2(bflo(bg.z) * acc[4], bfhi(bg.z) * acc[5]); o.w = pack2(bflo(bg.w) * acc[6], bfhi(bg.w) * acc[7]);
            *(uint4*)(Y + (size_t)t * LDX + c0) = o;
        }
    }
    {
        float (*pl)[68] = (float (*)[68])lds;
        const float* pw = P.pool_w + (size_t)l * 4 * 64 * 64;
        const float* psc = P.pool_scale + l * 256;
        const int a = tid & 63, q = tid >> 6;
        for (int tile = blockIdx.x; tile < (T / 64) * 4; tile += gridDim.x) {
            const int g = tile & 3, t0 = (tile >> 2) * 64;
            const int w = 2 << g;
            {
                const bf16* col = proj + C_HP + g * 64 + a;
                const int tf = t0 + q * 16, sf = tf & (S - 1);
                float sum = 0.f;
                for (int d = 1; d < w; ++d) if (sf - d >= 0) sum += bf2f(col[(size_t)(tf - d) * DINP]);
#pragma unroll 4
                for (int i = 0; i < 16; ++i) {
                    const int s = sf + i;
                    const float xv = bf2f(col[(size_t)(tf + i) * DINP]);
                    sum += xv;
                    const int cnt = (s + 1 < w) ? (s + 1) : w;
                    pl[q * 16 + i][a] = sum / (float)cnt - xv;
                    if (s - w + 1 >= 0) sum -= bf2f(col[(size_t)(tf + i - w + 1) * DINP]);
                }
            }
            __syncthreads();
            {
                float pc[64];
#pragma unroll
                for (int c = 0; c < 64; ++c) pc[c] = pw[(g * 64 + c) * 64 + a];
                const float sc = psc[g * 64 + a];
#pragma unroll 2
                for (int i = 0; i < 16; ++i) {
                    const float4* row = (const float4*)&pl[q * 16 + i][0];
                    float m0 = 0.f, m1 = 0.f;
#pragma unroll
                    for (int c4 = 0; c4 < 16; ++c4) { const float4 v = row[c4]; m0 = fmaf(v.x, pc[4 * c4], m0); m1 = fmaf(v.y, pc[4 * c4 + 1], m1); m0 = fmaf(v.z, pc[4 * c4 + 2], m0); m1 = fmaf(v.w, pc[4 * c4 + 3], m1); }
                    Y[(size_t)(t0 + q * 16 + i) * LDX + 256 + g * 64 + a] = f2bf((m0 + m1) * sc);
                }
            }
            __syncthreads();
        }
    }
}

typedef short v4i16_t __attribute__((ext_vector_type(4)));
typedef __attribute__((address_space(3))) v4i16_t* lds_v4p;
__device__ __forceinline__ v4i16_t vtr(const char* p) { return __builtin_amdgcn_ds_read_tr16_b64_v4i16((lds_v4p)p); }
constexpr int A_KP = 208, A_VP = 192;
constexpr int A_KB = 64 * A_KP, A_VB = 64 * A_VP, A_BUF = A_KB + A_VB, ATTN_LDS = 2 * A_BUF;
static_assert(ATTN_LDS <= GEMM_LDS, "attention LDS");

__device__ __forceinline__ void attn_unit(const bf16* __restrict__ Qb, const bf16* __restrict__ Kb, const bf16* __restrict__ Vb, bf16* __restrict__ Y, int bh, int qblk, char* lds) {
    const int tid = tidx(), lane = tid & 63, w = tid >> 6, r32 = lane & 31, hi = lane >> 5;
    const int q0 = qblk * 128, qw0 = q0 + w * 32;
    const int NT = 2 * qblk + 2;
    bf16x8 qf[6];
    {
        const bf16* qp = Qb + ((size_t)bh * S + qw0 + r32) * DQK + hi * 8;
#pragma unroll
        for (int ks = 0; ks < 6; ++ks) qf[ks] = *(const bf16x8*)(qp + ks * 16);
    }
    f32x16 o0, o1;
#pragma unroll
    for (int r = 0; r < 16; ++r) { o0[r] = 0.f; o1[r] = 0.f; }
    float m = -1e30f, lsum = 0.f;
    const char* Kg = (const char*)(Kb + (size_t)bh * S * DQK) + tid * 16;
    const char* Vg = (const char*)(Vb + (size_t)bh * S * DV) + tid * 16;
    const int kl0 = (tid / 12) * A_KP + (tid % 12) * 16, kl1 = ((tid + 256) / 12) * A_KP + ((tid + 256) % 12) * 16, kl2 = ((tid + 512) / 12) * A_KP + ((tid + 512) % 12) * 16;
    const int vl0 = (tid >> 3) * A_VP + (tid & 7) * 16, vl1 = vl0 + 32 * A_VP;
    uint4 pk0, pk1, pk2, pv0, pv1, qk0, qk1, qk2, qv0, qv1;
#define A_LOAD(S, t) do { const char* kg = Kg + (size_t)(t) * (64 * 192); const char* vg = Vg + (size_t)(t) * (64 * 128); \
        S##k0 = *(const uint4*)(kg); S##k1 = *(const uint4*)(kg + 4096); S##k2 = *(const uint4*)(kg + 8192); S##v0 = *(const uint4*)(vg); S##v1 = *(const uint4*)(vg + 4096); } while (0)
#define A_STORE(S, bK, bV) do { *(uint4*)(bK + kl0) = S##k0; *(uint4*)(bK + kl1) = S##k1; *(uint4*)(bK + kl2) = S##k2; *(uint4*)(bV + vl0) = S##v0; *(uint4*)(bV + vl1) = S##v1; } while (0)
#define A_PV(pf, kofs) do { \
            { const v4i16_t lo = vtr(pv + (kofs) * A_VP), hh = vtr(pv + ((kofs) + 8) * A_VP); const bf16x8 vf = {lo[0], lo[1], lo[2], lo[3], hh[0], hh[1], hh[2], hh[3]}; o0 = MFMA32(vf, pf.v, o0); } \
            { const v4i16_t lo = vtr(pv + (kofs) * A_VP + 64), hh = vtr(pv + ((kofs) + 8) * A_VP + 64); const bf16x8 vf = {lo[0], lo[1], lo[2], lo[3], hh[0], hh[1], hh[2], hh[3]}; o1 = MFMA32(vf, pf.v, o1); } } while (0)
    const int pvo = (4 * hi + ((lane & 15) >> 2)) * A_VP + (16 * ((lane >> 4) & 1) + 4 * (lane & 3)) * 2;
    A_LOAD(p, 0); A_LOAD(q, 1);
    for (int t2 = 0; t2 < NT; t2 += 2) {
#pragma unroll
        for (int half = 0; half < 2; ++half) {
            const int t = t2 + half;
            char* bK = lds + half * A_BUF; char* bV = bK + A_KB;
            if (half == 0) A_STORE(p, bK, bV); else A_STORE(q, bK, bV);
            __syncthreads();
            { const int tn = (t + 2 < NT) ? (t + 2) : (NT - 2 + half); if (half == 0) A_LOAD(p, tn); else A_LOAD(q, tn); }
        const int kt0 = t * 64;
        if (kt0 <= qw0) {
            f32x16 s0, s1;
#pragma unroll
            for (int r = 0; r < 16; ++r) { s0[r] = 0.f; s1[r] = 0.f; }
            const char* pk = bK + r32 * A_KP + hi * 16;
#pragma unroll
            for (int ks = 0; ks < 6; ++ks) {
                const bf16x8 a0 = *(const bf16x8*)(pk + ks * 32), a1 = *(const bf16x8*)(pk + 32 * A_KP + ks * 32);
                s0 = MFMA32(a0, qf[ks], s0); s1 = MFMA32(a1, qf[ks], s1);
            }
            if (kt0 + 63 > qw0) {
                const int qrow = qw0 + r32;
#pragma unroll
                for (int r = 0; r < 16; ++r) { const int key = kt0 + crow(r, hi); if (key > qrow) s0[r] = -INFINITY; if (key + 32 > qrow) s1[r] = -INFINITY; }
            }
            float mx = fmaxf(s0[0], s1[0]);
#pragma unroll
            for (int r = 1; r < 16; ++r) mx = fmaxf(mx, fmaxf(s0[r], s1[r]));
            mx = fmaxf(mx, __shfl_xor(mx, 32, 64));
            const float mn = fmaxf(m, mx);
            const float alpha = __builtin_amdgcn_exp2f(m - mn);
            m = mn;
            float ps = 0.f;
#pragma unroll
            for (int r = 0; r < 16; ++r) { s0[r] = __builtin_amdgcn_exp2f(s0[r] - mn); s1[r] = __builtin_amdgcn_exp2f(s1[r] - mn); ps += s0[r] + s1[r]; }
            lsum = lsum * alpha + ps;
#pragma unroll
            for (int r = 0; r < 16; ++r) { o0[r] *= alpha; o1[r] *= alpha; }
            union { unsigned u[4]; bf16x8 v; } p00, p01, p10, p11;
#pragma unroll
            for (int j = 0; j < 4; ++j) { p00.u[j] = cvtpk(s0[2 * j], s0[2 * j + 1]); p01.u[j] = cvtpk(s0[8 + 2 * j], s0[9 + 2 * j]); p10.u[j] = cvtpk(s1[2 * j], s1[2 * j + 1]); p11.u[j] = cvtpk(s1[8 + 2 * j], s1[9 + 2 * j]); }
            const char* pv = bV + pvo;
            A_PV(p00, 0); A_PV(p01, 16); A_PV(p10, 32); A_PV(p11, 48);
        }
        }
    }
    lsum += __shfl_xor(lsum, 32, 64);
    const float inv = 1.f / lsum;
    const int b = bh >> 3, h = bh & 7;
    bf16* yo = Y + (size_t)(b * S + qw0 + r32) * LDX + 512 + h * 64 + 4 * hi;
#pragma unroll
    for (int g = 0; g < 4; ++g) {
        uint2 a, c;
        a.x = cvtpk(o0[4 * g] * inv, o0[4 * g + 1] * inv); a.y = cvtpk(o0[4 * g + 2] * inv, o0[4 * g + 3] * inv);
        c.x = cvtpk(o1[4 * g] * inv, o1[4 * g + 1] * inv); c.y = cvtpk(o1[4 * g + 2] * inv, o1[4 * g + 3] * inv);
        *(uint2*)(yo + 8 * g) = a; *(uint2*)(yo + 32 + 8 * g) = c;
    }
    __syncthreads();
}
__device__ __forceinline__ void phase_attn(const Params& P, char* lds) {
    const bf16* Qb = (const bf16*)(P.ws + WS_Q);
    const bf16* Kb = (const bf16*)(P.ws + WS_K);
    const bf16* Vb = (const bf16*)(P.ws + WS_V);
    bf16* Y = (bf16*)(P.ws + WS_XN);
    for (int u = blockIdx.x; u < NB * NH * (S / 128); u += gridDim.x) {
        const int bh = u & 31, v = u >> 5;
        const int qblk = (v < 16) ? (63 - v) : (v < 32) ? (v - 16) : (v < 48) ? (79 - v) : (v - 32);
        attn_unit(Qb, Kb, Vb, Y, bh, qblk, lds);
    }
}

#define NET_HD __device__ __forceinline__
#define NET_U2F(u) __uint_as_float(u)
#define NET_F2U(f) __float_as_uint(f)
#define CE_DESC(a, b) do { const float hi__ = fmaxf(a, b), lo__ = fminf(a, b); a = hi__; b = lo__; } while (0)
NET_HD void sort16_desc(float (&v)[16]) {
#pragma unroll
    for (int k = 2; k <= 16; k <<= 1) {
#pragma unroll
        for (int j = k >> 1; j > 0; j >>= 1) {
#pragma unroll
            for (int i = 0; i < 16; ++i) {
                const int l = i ^ j;
                if (l > i) { if ((i & k) == 0) CE_DESC(v[i], v[l]); else CE_DESC(v[l], v[i]); }
            }
        }
    }
}
NET_HD void merge16_desc(float (&a)[16], const float (&b)[16]) {
#pragma unroll
    for (int i = 0; i < 16; ++i) a[i] = fmaxf(a[i], b[15 - i]);
#pragma unroll
    for (int j = 8; j > 0; j >>= 1) {
#pragma unroll
        for (int i = 0; i < 16; ++i) { const int l = i ^ j; if (l > i) CE_DESC(a[i], a[l]); }
    }
}
NET_HD void top16_of_64(float (&g0)[16], float (&g1)[16], float (&g2)[16], float (&g3)[16]) {
    sort16_desc(g0); sort16_desc(g1); sort16_desc(g2); sort16_desc(g3);
    merge16_desc(g0, g1); merge16_desc(g2, g3); merge16_desc(g0, g2);
}
NET_HD float u2f(unsigned u) { return NET_U2F(u); }
NET_HD unsigned f2u(float f) { return NET_F2U(f); }
template <class V16>
NET_HD void lane_top16(const V16& s0, const V16& s1, const V16& s2, const V16& s3, int hi, float (&out)[16]) {
    float g0[16], g1[16], g2[16], g3[16];
#pragma unroll
    for (int r = 0; r < 16; ++r) {
        const unsigned nb = (unsigned)((r & 3) + 8 * (r >> 2));
        g0[r] = u2f((f2u(s0[r]) & 0xFFFFFF80u) | nb); g1[r] = u2f((f2u(s1[r]) & 0xFFFFFF80u) | (nb + 32u));
        g2[r] = u2f((f2u(s2[r]) & 0xFFFFFF80u) | (nb + 64u)); g3[r] = u2f((f2u(s3[r]) & 0xFFFFFF80u) | (nb + 96u));
    }
    top16_of_64(g0, g1, g2, g3);
    const unsigned h4 = (unsigned)hi << 2;
#pragma unroll
    for (int i = 0; i < 16; ++i) out[i] = u2f(f2u(g0[i]) | h4);
}
constexpr int cand_slot(int a, int b) { int n = 0; for (int x = 0; x < 16; ++x) for (int y = 0; y < 16; ++y) { if (x == a && y == b) return n; if ((x + 1) * (y + 1) <= 16) ++n; } return n; }
NET_HD void cand_top16(const float (&s1)[16], const float (&s2)[16], float (&c)[16]) {
    float g0[16], g1[16], g2[16], g3[16];
#pragma unroll
    for (int i = 0; i < 16; ++i) { g0[i] = -3.0e38f; g1[i] = -3.0e38f; g2[i] = -3.0e38f; g3[i] = -3.0e38f; }
#pragma unroll
    for (int a = 0; a < 16; ++a) {
#pragma unroll
        for (int b = 0; b < 16; ++b) {
            if ((a + 1) * (b + 1) <= 16) {
                const int sl = cand_slot(a, b);
                const float v = u2f((f2u(s1[a] + s2[b]) & 0xFFFFFF00u) | (unsigned)(a * 16 + b));
                if (sl < 16) g0[sl & 15] = v; else if (sl < 32) g1[sl & 15] = v; else if (sl < 48) g2[sl & 15] = v; else g3[sl & 15] = v;
            }
        }
    }
    top16_of_64(g0, g1, g2, g3);
#pragma unroll
    for (int i = 0; i < 16; ++i) c[i] = g0[i];
}

__device__ __forceinline__ void phase_route(const Params& P, int l, char* lds) {
    const bf16* XN = (const bf16*)(P.ws + WS_XN);
    const bf16* Wc = (const bf16*)(P.ws + WS_WPQ) + (size_t)l * 2048 * LDW;
    int* EXPp = (int*)(P.ws + WS_EXP);
    float* GATEp = (float*)(P.ws + WS_GATE);
    const int tid = tidx(), lane = tid & 63, w = tid >> 6, r32 = lane & 31, hi = lane >> 5;
    for (int u = blockIdx.x; u < (T / 128) * PH; u += gridDim.x) {
        const int tm = u >> 3, h = u & 7;
        float L0[16], L1[16];
        {
            f32x16 acc[4]; float ssd[4];
            gemm_kloop<1, false>(Wc + (size_t)((h * 2 + 0) * 128) * LDW, LDW, XN + (size_t)(tm * 128) * LDX, LDX, D / 64, acc, ssd, lds, tid);
            lane_top16(acc[0], acc[1], acc[2], acc[3], hi, L0);
            float o[16];
#pragma unroll
            for (int i = 0; i < 16; ++i) o[i] = __shfl_xor(L0[i], 32, 64);
            merge16_desc(L0, o);
        }
        {
            f32x16 acc[4]; float ssd[4];
            gemm_kloop<1, false>(Wc + (size_t)((h * 2 + 1) * 128) * LDW, LDW, XN + (size_t)(tm * 128) * LDX, LDX, D / 64, acc, ssd, lds, tid);
            lane_top16(acc[0], acc[1], acc[2], acc[3], hi, L1);
            float o[16];
#pragma unroll
            for (int i = 0; i < 16; ++i) o[i] = __shfl_xor(L1[i], 32, 64);
            merge16_desc(L1, o);
        }
        float c[16];
        cand_top16(L0, L1, c);
        __syncthreads();
        unsigned char* my = (unsigned char*)lds + tid * 32;
        {
            uint4 a, b;
#define PK4(L, i) ((__float_as_uint(L[i]) & 127u) | ((__float_as_uint(L[i + 1]) & 127u) << 8) | ((__float_as_uint(L[i + 2]) & 127u) << 16) | ((__float_as_uint(L[i + 3]) & 127u) << 24))
            a.x = PK4(L0, 0); a.y = PK4(L0, 4); a.z = PK4(L0, 8); a.w = PK4(L0, 12);
            b.x = PK4(L1, 0); b.y = PK4(L1, 4); b.z = PK4(L1, 8); b.w = PK4(L1, 12);
#undef PK4
            *(uint4*)my = a; *(uint4*)(my + 16) = b;
        }
        int ev[16]; float gv[16]; float den = 0.f;
#pragma unroll
        for (int k = 0; k < 16; ++k) {
            const unsigned ci = __float_as_uint(c[k]) & 255u;
            const int n1 = my[ci >> 4], n2 = my[16 + (ci & 15)];
            ev[k] = n1 * NKEY + n2;
            gv[k] = __expf(c[k] - c[0]); den += gv[k];
        }
        const float iden = 1.f / den;
        if (hi == 0) {
            const int t = tm * 128 + w * 32 + r32;
            uint4* ep = (uint4*)(EXPp + (size_t)t * HK + h * 16);
            float4* gp = (float4*)(GATEp + (size_t)t * HK + h * 16);
#pragma unroll
            for (int q = 0; q < 4; ++q) {
                ep[q] = make_uint4((unsigned)ev[4 * q], (unsigned)ev[4 * q + 1], (unsigned)ev[4 * q + 2], (unsigned)ev[4 * q + 3]);
                gp[q] = make_float4(gv[4 * q] * iden, gv[4 * q + 1] * iden, gv[4 * q + 2] * iden, gv[4 * q + 3] * iden);
            }
        }
        __syncthreads();
    }
}

__device__ __forceinline__ float red16(float (&p)[16], int lane) {
#pragma unroll
    for (int i = 0; i < 8; ++i) { const bool up = lane & 32; const float send = up ? p[i] : p[i + 8], keep = up ? p[i + 8] : p[i]; p[i] = keep + __shfl_xor(send, 32, 64); }
#pragma unroll
    for (int i = 0; i < 4; ++i) { const bool up = lane & 16; const float send = up ? p[i] : p[i + 4], keep = up ? p[i + 4] : p[i]; p[i] = keep + __shfl_xor(send, 16, 64); }
#pragma unroll
    for (int i = 0; i < 2; ++i) { const bool up = lane & 8; const float send = up ? p[i] : p[i + 2], keep = up ? p[i + 2] : p[i]; p[i] = keep + __shfl_xor(send, 8, 64); }
    { const bool up = lane & 4; const float send = up ? p[0] : p[1], keep = up ? p[1] : p[0]; p[0] = keep + __shfl_xor(send, 4, 64); }
    float r = p[0];
    r += __shfl_xor(r, 2, 64); r += __shfl_xor(r, 1, 64);
    return r;
}

__device__ __forceinline__ void phase_gather(const Params& P, int l) {
    const bf16* XN = (const bf16*)(P.ws + WS_XN);
    bf16* XNw = (bf16*)(P.ws + WS_XN);
    const int* EXPp = (const int*)(P.ws + WS_EXP);
    const float* GATEp = (const float*)(P.ws + WS_GATE);
    const unsigned char* U = P.ws + WS_TABU + (size_t)l * NEXP * TAB_ROWB;
    const unsigned char* V = P.ws + WS_TABV + (size_t)l * NEXP * TAB_ROWB;
    const float* SU = (const float*)(P.ws + WS_TSCU) + (size_t)l * NEXP;
    const float* SV = (const float*)(P.ws + WS_TSCV) + (size_t)l * NEXP;
    const int lane = tidx() & 63;
    for (int t = gwave(); t < T; t += nwave()) {
        const int e_lo = EXPp[(size_t)t * HK + lane], e_hi = EXPp[(size_t)t * HK + 64 + lane];
#if TAB_FP8
        float xf[16];
        {
            const uint4 a = ((const uint4*)(XN + (size_t)t * D))[lane * 2], b = ((const uint4*)(XN + (size_t)t * D))[lane * 2 + 1];
            xf[0] = bflo(a.x); xf[1] = bfhi(a.x); xf[2] = bflo(a.y); xf[3] = bfhi(a.y); xf[4] = bflo(a.z); xf[5] = bfhi(a.z); xf[6] = bflo(a.w); xf[7] = bfhi(a.w);
            xf[8] = bflo(b.x); xf[9] = bfhi(b.x); xf[10] = bflo(b.y); xf[11] = bfhi(b.y); xf[12] = bflo(b.z); xf[13] = bfhi(b.z); xf[14] = bflo(b.w); xf[15] = bfhi(b.w);
        }
#else
        const uint4 xa = ((const uint4*)(XN + (size_t)t * D))[lane], xb = ((const uint4*)(XN + (size_t)t * D))[64 + lane];
#endif
        float acc[16];
#pragma unroll
        for (int i = 0; i < 16; ++i) acc[i] = 0.f;
        for (int c = 0; c < 8; ++c) {
            const int esel = (c < 4) ? e_lo : e_hi;
            const int kb = (c & 3) * 16;
            float part[16];
#pragma unroll
            for (int hb = 0; hb < 2; ++hb) {
#if TAB_FP8
                uint4 r[8];
#pragma unroll
                for (int i = 0; i < 8; ++i) { const int e = __builtin_amdgcn_readlane(esel, kb + hb * 8 + i); r[i] = *(const uint4*)(U + (size_t)e * 1024 + lane * 16); }
#pragma unroll
                for (int i = 0; i < 8; ++i) {
                    float d0 = 0.f, d1 = 0.f;
                    const unsigned w[4] = {r[i].x, r[i].y, r[i].z, r[i].w};
#pragma unroll
                    for (int q = 0; q < 4; ++q) {
                        const auto lo = __builtin_amdgcn_cvt_pk_f32_fp8((int)w[q], false); const auto hh = __builtin_amdgcn_cvt_pk_f32_fp8((int)w[q], true);
                        d0 = fmaf(xf[4 * q], lo[0], d0); d1 = fmaf(xf[4 * q + 1], lo[1], d1); d0 = fmaf(xf[4 * q + 2], hh[0], d0); d1 = fmaf(xf[4 * q + 3], hh[1], d1);
                    }
                    part[hb * 8 + i] = d0 + d1;
                }
#else
                uint4 r0[8], r1[8];
#pragma unroll
                for (int i = 0; i < 8; ++i) { const int e = __builtin_amdgcn_readlane(esel, kb + hb * 8 + i); const unsigned char* rp = U + (size_t)e * 2048 + lane * 16; r0[i] = *(const uint4*)(rp); r1[i] = *(const uint4*)(rp + 1024); }
#pragma unroll
                for (int i = 0; i < 8; ++i) {
                    float d0 = 0.f, d1 = 0.f;
                    d0 = dot2bf(xa.x, r0[i].x, d0); d1 = dot2bf(xa.y, r0[i].y, d1); d0 = dot2bf(xa.z, r0[i].z, d0); d1 = dot2bf(xa.w, r0[i].w, d1);
                    d0 = dot2bf(xb.x, r1[i].x, d0); d1 = dot2bf(xb.y, r1[i].y, d1); d0 = dot2bf(xb.z, r1[i].z, d0); d1 = dot2bf(xb.w, r1[i].w, d1);
                    part[hb * 8 + i] = d0 + d1;
                }
#endif
            }
            float dsum = red16(part, lane);
            const int kk = c * 16 + (lane >> 2);
            const int eme = __shfl(esel, kb + (lane >> 2), 64);
            float wv = GATEp[(size_t)t * HK + kk];
#if TAB_FP8
            dsum *= SU[eme];
            wv *= SV[eme];
#endif
            wv *= gelu_exact(dsum);
#pragma unroll
            for (int hb = 0; hb < 2; ++hb) {
#if TAB_FP8
                uint4 r[8];
#pragma unroll
                for (int i = 0; i < 8; ++i) { const int e = __builtin_amdgcn_readlane(esel, kb + hb * 8 + i); r[i] = *(const uint4*)(V + (size_t)e * 1024 + lane * 16); }
#pragma unroll
                for (int i = 0; i < 8; ++i) {
                    const float w = __int_as_float(__builtin_amdgcn_readlane(__float_as_int(wv), (hb * 8 + i) * 4));
                    const unsigned ww[4] = {r[i].x, r[i].y, r[i].z, r[i].w};
#pragma unroll
                    for (int q = 0; q < 4; ++q) {
                        const auto lo = __builtin_amdgcn_cvt_pk_f32_fp8((int)ww[q], false); const auto hh = __builtin_amdgcn_cvt_pk_f32_fp8((int)ww[q], true);
                        acc[4 * q] = fmaf(w, lo[0], acc[4 * q]); acc[4 * q + 1] = fmaf(w, lo[1], acc[4 * q + 1]); acc[4 * q + 2] = fmaf(w, hh[0], acc[4 * q + 2]); acc[4 * q + 3] = fmaf(w, hh[1], acc[4 * q + 3]);
                    }
                }
#else
                uint4 r0[8], r1[8];
#pragma unroll
                for (int i = 0; i < 8; ++i) { const int e = __builtin_amdgcn_readlane(esel, kb + hb * 8 + i); const unsigned char* rp = V + (size_t)e * 2048 + lane * 16; r0[i] = *(const uint4*)(rp); r1[i] = *(const uint4*)(rp + 1024); }
#pragma unroll
                for (int i = 0; i < 8; ++i) {
                    const float w = __int_as_float(__builtin_amdgcn_readlane(__float_as_int(wv), (hb * 8 + i) * 4));
                    acc[0] = fmaf(w, bflo(r0[i].x), acc[0]); acc[1] = fmaf(w, bfhi(r0[i].x), acc[1]); acc[2] = fmaf(w, bflo(r0[i].y), acc[2]); acc[3] = fmaf(w, bfhi(r0[i].y), acc[3]);
                    acc[4] = fmaf(w, bflo(r0[i].z), acc[4]); acc[5] = fmaf(w, bfhi(r0[i].z), acc[5]); acc[6] = fmaf(w, bflo(r0[i].w), acc[6]); acc[7] = fmaf(w, bfhi(r0[i].w), acc[7]);
                    acc[8] = fmaf(w, bflo(r1[i].x), acc[8]); acc[9] = fmaf(w, bfhi(r1[i].x), acc[9]); acc[10] = fmaf(w, bflo(r1[i].y), acc[10]); acc[11] = fmaf(w, bfhi(r1[i].y), acc[11]);
                    acc[12] = fmaf(w, bflo(r1[i].z), acc[12]); acc[13] = fmaf(w, bfhi(r1[i].z), acc[13]); acc[14] = fmaf(w, bflo(r1[i].w), acc[14]); acc[15] = fmaf(w, bfhi(r1[i].w), acc[15]);
                }
#endif
            }
        }
        float* hrow = P.out + (size_t)t * D;
#if TAB_FP8
        const int c0 = lane * 16, c1 = lane * 16 + 8;
#else
        const int c0 = lane * 8, c1 = 512 + lane * 8;
#endif
        float4 h0 = *(const float4*)(hrow + c0), h1 = *(const float4*)(hrow + c0 + 4), h2 = *(const float4*)(hrow + c1), h3 = *(const float4*)(hrow + c1 + 4);
        h0.x += acc[0]; h0.y += acc[1]; h0.z += acc[2]; h0.w += acc[3]; h1.x += acc[4]; h1.y += acc[5]; h1.z += acc[6]; h1.w += acc[7];
        h2.x += acc[8]; h2.y += acc[9]; h2.z += acc[10]; h2.w += acc[11]; h3.x += acc[12]; h3.y += acc[13]; h3.z += acc[14]; h3.w += acc[15];
        float ss = h0.x * h0.x + h0.y * h0.y + h0.z * h0.z + h0.w * h0.w + h1.x * h1.x + h1.y * h1.y + h1.z * h1.z + h1.w * h1.w
                 + h2.x * h2.x + h2.y * h2.y + h2.z * h2.z + h2.w * h2.w + h3.x * h3.x + h3.y * h3.y + h3.z * h3.z + h3.w * h3.w;
        ss = wave_sum(ss);
        const float rn = rsqrtf(ss * (1.f / D) + EPS);
        if (l == DEPTH - 1) {
            const float* g = P.norm_final;
            const float4 g0 = *(const float4*)(g + c0), g1 = *(const float4*)(g + c0 + 4), g2 = *(const float4*)(g + c1), g3 = *(const float4*)(g + c1 + 4);
            *(float4*)(hrow + c0) = make_float4(h0.x * rn * g0.x, h0.y * rn * g0.y, h0.z * rn * g0.z, h0.w * rn * g0.w);
            *(float4*)(hrow + c0 + 4) = make_float4(h1.x * rn * g1.x, h1.y * rn * g1.y, h1.z * rn * g1.z, h1.w * rn * g1.w);
            *(float4*)(hrow + c1) = make_float4(h2.x * rn * g2.x, h2.y * rn * g2.y, h2.z * rn * g2.z, h2.w * rn * g2.w);
            *(float4*)(hrow + c1 + 4) = make_float4(h3.x * rn * g3.x, h3.y * rn * g3.y, h3.z * rn * g3.z, h3.w * rn * g3.w);
        } else {
            *(float4*)(hrow + c0) = h0; *(float4*)(hrow + c0 + 4) = h1; *(float4*)(hrow + c1) = h2; *(float4*)(hrow + c1 + 4) = h3;
            const float* g = P.norm_mix + (l + 1) * D;
            const float4 g0 = *(const float4*)(g + c0), g1 = *(const float4*)(g + c0 + 4), g2 = *(const float4*)(g + c1), g3 = *(const float4*)(g + c1 + 4);
            uint4 o0, o1;
            o0.x = pack2(h0.x * rn * g0.x, h0.y * rn * g0.y); o0.y = pack2(h0.z * rn * g0.z, h0.w * rn * g0.w); o0.z = pack2(h1.x * rn * g1.x, h1.y * rn * g1.y); o0.w = pack2(h1.z * rn * g1.z, h1.w * rn * g1.w);
            o1.x = pack2(h2.x * rn * g2.x, h2.y * rn * g2.y); o1.y = pack2(h2.z * rn * g2.z, h2.w * rn * g2.w); o1.z = pack2(h3.x * rn * g3.x, h3.y * rn * g3.y); o1.w = pack2(h3.z * rn * g3.z, h3.w * rn * g3.w);
            *(uint4*)(XNw + (size_t)t * D + c0) = o0; *(uint4*)(XNw + (size_t)t * D + c1) = o1;
        }
    }
}


constexpr size_t WS_PART = WS_PROJ;
static_assert((size_t)8 * T * HK * 4 <= WS_K - WS_PROJ, "PART alias");
constexpr int XI_X = 0, XI_RANK = 1, XI_J = 2, XI_NX = 3, XI_NLOC = 4;
constexpr int CTL_CENSUS = 4096;
constexpr int CTL_BYTES = (CTL_CENSUS + 16) * 4;

__device__ __forceinline__ float dot16_fp8(const float (&xf)[16], const uint4& r) {
    float d0 = 0.f, d1 = 0.f;
    const unsigned w[4] = {r.x, r.y, r.z, r.w};
#pragma unroll
    for (int q = 0; q < 4; ++q) {
        const auto lo = __builtin_amdgcn_cvt_pk_f32_fp8((int)w[q], false); const auto hh = __builtin_amdgcn_cvt_pk_f32_fp8((int)w[q], true);
        d0 = fmaf(xf[4 * q], lo[0], d0); d1 = fmaf(xf[4 * q + 1], lo[1], d1); d0 = fmaf(xf[4 * q + 2], hh[0], d0); d1 = fmaf(xf[4 * q + 3], hh[1], d1);
    }
    return d0 + d1;
}
template <int M1, int M2, int M3, class TT>
__device__ __forceinline__ void red16x3(TT (&p)[16], int lane) {
#pragma unroll
    for (int i = 0; i < 8; ++i) { const bool up = lane & M1; const TT send = up ? p[i] : p[i + 8], keep = up ? p[i + 8] : p[i]; p[i] = keep + __shfl_xor(send, M1, 64); }
#pragma unroll
    for (int i = 0; i < 4; ++i) { const bool up = lane & M2; const TT send = up ? p[i] : p[i + 4], keep = up ? p[i + 4] : p[i]; p[i] = keep + __shfl_xor(send, M2, 64); }
#pragma unroll
    for (int i = 0; i < 2; ++i) { const bool up = lane & M3; const TT send = up ? p[i] : p[i + 2], keep = up ? p[i + 2] : p[i]; p[i] = keep + __shfl_xor(send, M3, 64); }
}
__device__ __forceinline__ void phase_gu(const Params& P, int l, const volatile int* xi) {
    const unsigned char* XQ = P.ws + WS_XQ;
    const float* XSc = (const float*)(P.ws + WS_XS);
    const int* EXPp = (const int*)(P.ws + WS_EXP);
    float* PART = (float*)(P.ws + WS_PART);
    const int tid = tidx(), lane = tid & 63, w = tid >> 6, g = lane >> 3, c = lane & 7;
    int xo_ = 0; asm volatile("" : "+v"(xo_));
    const int j = __builtin_amdgcn_readfirstlane(xi[xo_ + XI_J]), nx = __builtin_amdgcn_readfirstlane(xi[xo_ + XI_NX]), nloc = __builtin_amdgcn_readfirstlane(xi[xo_ + XI_NLOC]), rank = __builtin_amdgcn_readfirstlane(xi[xo_ + XI_RANK]);
    const int t0 = rank * 4 + w, st = nloc * 4;
    const int n = (t0 < T) ? (T - t0 + st - 1) / st : 0;
    const int i0 = 8 * (c & 1) + 4 * ((c >> 1) & 1) + 2 * ((c >> 2) & 1);
    for (int sl = j; sl < 8 && n > 0; sl += nx) {
        const unsigned char* Us = P.ws + WS_TABU + ((size_t)(l * 8 + sl) * NEXP) * 128;
        const unsigned co = (unsigned)c << 4;
        float* part = PART + (size_t)sl * T * HK;
        const unsigned char* xs = XQ + sl * 128 + c * 16;
#define GU_TK(k) (t0 + (((k) < n) ? (k) : (n - 1)) * st)
#define GU_LOADE(S, t) do { S##lo = EXPp[(size_t)(t) * HK + lane]; S##hi = EXPp[(size_t)(t) * HK + 64 + lane]; } while (0)
#define GU_LOADX(S, t) do { S##a = *(const uint4*)(xs + (size_t)(t) * D); S##s = XSc[t]; } while (0)
#define GU_ISSUE(R, S) do { _Pragma("unroll") for (int i = 0; i < 16; ++i) { \
            const int e = __builtin_amdgcn_ds_bpermute((((8 * i) & 63) + g) << 2, (i < 8) ? S##lo : S##hi); R[i] = *(const uint4*)(Us + (((unsigned)e << 7) | co)); } } while (0)
#define GU_FINISH(R, S, t) do { \
            int p[16]; \
            _Pragma("unroll") for (int i = 0; i < 16; ++i) { int d_ = __builtin_amdgcn_sdot4((int)S##a.x, (int)R[i].x, 0, false); d_ = __builtin_amdgcn_sdot4((int)S##a.y, (int)R[i].y, d_, false); \
                d_ = __builtin_amdgcn_sdot4((int)S##a.z, (int)R[i].z, d_, false); p[i] = __builtin_amdgcn_sdot4((int)S##a.w, (int)R[i].w, d_, false); } \
            red16x3<1, 2, 4, int>(p, lane); \
            part[(size_t)(t) * HK + 8 * i0 + g] = (float)p[0] * S##s; part[(size_t)(t) * HK + 8 * (i0 + 1) + g] = (float)p[1] * S##s; } while (0)
        int eAlo, eAhi, eBlo, eBhi; uint4 xAa, xBa; float xAs, xBs; uint4 rA[16], rB[16];
        GU_LOADE(eA, GU_TK(0)); GU_LOADX(xA, GU_TK(0)); GU_LOADE(eB, GU_TK(1));
        GU_ISSUE(rA, eA);
        for (int k = 0; k < n; k += 2) {
            GU_LOADX(xB, GU_TK(k + 1)); GU_ISSUE(rB, eB); GU_LOADE(eA, GU_TK(k + 2));
            GU_FINISH(rA, xA, GU_TK(k));
            GU_LOADX(xA, GU_TK(k + 2)); GU_ISSUE(rA, eA); GU_LOADE(eB, GU_TK(k + 3));
            GU_FINISH(rB, xB, GU_TK(k + 1));
        }
#undef GU_TK
#undef GU_LOADE
#undef GU_LOADX
#undef GU_ISSUE
#undef GU_FINISH
    }
}
__device__ __forceinline__ void phase_gw(const Params& P, int l) {
    const int* EXPp = (const int*)(P.ws + WS_EXP);
    float* GATEp = (float*)(P.ws + WS_GATE);
    const float* PART = (const float*)(P.ws + WS_PART);
    const float* SU = (const float*)(P.ws + WS_TSCU) + (size_t)l * NEXP;
    const float* SV = (const float*)(P.ws + WS_TSCV) + (size_t)l * NEXP;
    for (size_t i = gtid(); i < (size_t)T * HK; i += gnth()) {
        float s = 0.f;
#pragma unroll
        for (int x = 0; x < 8; ++x) s += PART[(size_t)x * T * HK + i];
        const int e = EXPp[i];
        GATEp[i] = GATEp[i] * gelu_exact(s * SU[e]) * SV[e];
    }
}
__device__ __forceinline__ void phase_gv(const Params& P, int l, const volatile int* xi) {
    const int* EXPp = (const int*)(P.ws + WS_EXP);
    const float* WGT = (const float*)(P.ws + WS_GATE);
    const int tid = tidx(), lane = tid & 63, w = tid >> 6, g = lane >> 3, c = lane & 7;
    int xo_ = 0; asm volatile("" : "+v"(xo_));
    const int j = __builtin_amdgcn_readfirstlane(xi[xo_ + XI_J]), nx = __builtin_amdgcn_readfirstlane(xi[xo_ + XI_NX]), nloc = __builtin_amdgcn_readfirstlane(xi[xo_ + XI_NLOC]), rank = __builtin_amdgcn_readfirstlane(xi[xo_ + XI_RANK]);
    const int t0 = rank * 4 + w, st = nloc * 4;
    const int n = (t0 < T) ? (T - t0 + st - 1) / st : 0;
    const int j0 = 8 * (g & 1) + 4 * ((g >> 1) & 1) + 2 * ((g >> 2) & 1);
    for (int sl = j; sl < 8 && n > 0; sl += nx) {
        const unsigned char* Vs = P.ws + WS_TABV + ((size_t)(l * 8 + sl) * NEXP) * 128;
        const unsigned co = (unsigned)c << 4;
        float* hcol = P.out + sl * 128 + c * 16 + j0;
#define GV_TK(k) (t0 + (((k) < n) ? (k) : (n - 1)) * st)
#define GV_LOADE(S, t) do { S##el = EXPp[(size_t)(t) * HK + lane]; S##eh = EXPp[(size_t)(t) * HK + 64 + lane]; \
            S##wl = __float_as_int(WGT[(size_t)(t) * HK + lane]); S##wh = __float_as_int(WGT[(size_t)(t) * HK + 64 + lane]); } while (0)
#define GV_ISSUE(R, W, ESEL, WSEL) do { _Pragma("unroll") for (int i = 0; i < 8; ++i) { const int src = (8 * i + g) << 2; \
            const int e = __builtin_amdgcn_ds_bpermute(src, ESEL); W[i] = __int_as_float(__builtin_amdgcn_ds_bpermute(src, WSEL)); R[i] = *(const uint4*)(Vs + (((unsigned)e << 7) | co)); } } while (0)
#define GV_FINISH(R, W) do { _Pragma("unroll") for (int i = 0; i < 8; ++i) { const unsigned ww[4] = {R[i].x, R[i].y, R[i].z, R[i].w}; \
            _Pragma("unroll") for (int q = 0; q < 4; ++q) { \
                const auto lo = __builtin_amdgcn_cvt_pk_f32_fp8((int)ww[q], false); const auto hh = __builtin_amdgcn_cvt_pk_f32_fp8((int)ww[q], true); \
                acc[4 * q] = fmaf(W[i], lo[0], acc[4 * q]); acc[4 * q + 1] = fmaf(W[i], lo[1], acc[4 * q + 1]); acc[4 * q + 2] = fmaf(W[i], hh[0], acc[4 * q + 2]); acc[4 * q + 3] = fmaf(W[i], hh[1], acc[4 * q + 3]); } __builtin_amdgcn_sched_barrier(0); } } while (0)
        int Cel, Ceh, Cwl, Cwh, Nel, Neh, Nwl, Nwh, Fel, Feh, Fwl, Fwh;
        uint4 r0[8], r1[8]; float wk0[8], wk1[8];
        GV_LOADE(C, GV_TK(0)); GV_LOADE(N, GV_TK(1));
        GV_ISSUE(r0, wk0, Cel, Cwl);
        for (int k = 0; k < n; ++k) {
            const int t = GV_TK(k);
            GV_ISSUE(r1, wk1, Ceh, Cwh);
            float2* hp = (float2*)(hcol + (size_t)t * D);
            const float2 hv = *hp;
            GV_LOADE(F, GV_TK(k + 2));
            float acc[16];
#pragma unroll
            for (int q = 0; q < 16; ++q) acc[q] = 0.f;
            GV_FINISH(r0, wk0);
            GV_ISSUE(r0, wk0, Nel, Nwl);
            GV_FINISH(r1, wk1);
            red16x3<8, 16, 32, float>(acc, lane);
            *hp = make_float2(hv.x + acc[0], hv.y + acc[1]);
            Cel = Nel; Ceh = Neh; Cwl = Nwl; Cwh = Nwh; Nel = Fel; Neh = Feh; Nwl = Fwl; Nwh = Fwh;
        }
#undef GV_TK
#undef GV_LOADE
#undef GV_ISSUE
#undef GV_FINISH
    }
}
__device__ __forceinline__ void phase_gnorm(const Params& P, int l) {
    const int lane = tidx() & 63;
    bf16* XNw = (bf16*)(P.ws + WS_XN);
    for (int t = gwave(); t < T; t += nwave()) {
        float4* hr = (float4*)(P.out + (size_t)t * D);
        float4 v[4]; float ss = 0.f;
#pragma unroll
        for (int q = 0; q < 4; ++q) { v[q] = hr[q * 64 + lane]; ss += v[q].x * v[q].x + v[q].y * v[q].y + v[q].z * v[q].z + v[q].w * v[q].w; }
        ss = wave_sum(ss);
        const float rn = rsqrtf(ss * (1.f / D) + EPS);
        const float4* g = (const float4*)((l == DEPTH - 1) ? P.norm_final : (P.norm_mix + (l + 1) * D));
#pragma unroll
        for (int q = 0; q < 4; ++q) {
            const float4 gg = g[q * 64 + lane];
            const float4 o = make_float4(v[q].x * rn * gg.x, v[q].y * rn * gg.y, v[q].z * rn * gg.z, v[q].w * rn * gg.w);
            if (l == DEPTH - 1) hr[q * 64 + lane] = o;
            else { uint2 u; u.x = pack2(o.x, o.y); u.y = pack2(o.z, o.w); ((uint2*)(XNw + (size_t)t * LDX))[q * 64 + lane] = u; }
        }
    }
}

#define XB_TMO      128
#define XB_XCNT(j)  (256  + 64 * (j))
#define XB_XSUB(j)  (1280 + 64 * (j))
#define XB_XGEN(j)  (2304 + 64 * (j))
#define XB_TOP      3328
#define XB_TOPGEN   3392
#define XCD_BAR_WORDS 3456
#define XB_SPIN_CAP (1u << 22)
#define LAS __attribute__((address_space(3)))
__device__ __forceinline__ unsigned xb_ld(unsigned* p)              { return __hip_atomic_load(p, __ATOMIC_RELAXED, __HIP_MEMORY_SCOPE_AGENT); }
__device__ __forceinline__ unsigned xb_add(unsigned* p, unsigned v) { return __hip_atomic_fetch_add(p, v, __ATOMIC_RELAXED, __HIP_MEMORY_SCOPE_AGENT); }
__device__ __forceinline__ unsigned xb_xcc_id() { return (unsigned)__builtin_amdgcn_s_getreg((3 << 11) | 20) & 0xFu; }
#define XB_SPIN(cond, bar) do { unsigned _sp = 0; while (cond) { __builtin_amdgcn_s_sleep(1); \
    if ((++_sp & 255u) == 0u) { if (xb_ld(&(bar)[XB_TMO])) break; if (_sp > XB_SPIN_CAP) { atomicAdd(&(bar)[XB_TMO], 1u); break; } } } } while (0)
struct XcdBarrier { unsigned* bar; unsigned x; volatile LAS unsigned* st; };
__device__ __forceinline__ XcdBarrier xcd_barrier_post(unsigned* bar, volatile LAS unsigned* st) {
    XcdBarrier b; b.bar = bar; b.x = xb_xcc_id(); b.st = st;
    if (__builtin_amdgcn_workitem_id_x() == 0) (void)xb_add(&bar[XB_XCNT(b.x)], 1u);
    return b;
}
__device__ __forceinline__ void xcd_barrier_complete(unsigned* bar, unsigned x, unsigned& nloc, unsigned& nx) {
    const unsigned G = gridDim.x * gridDim.y * gridDim.z;
    unsigned sum, cnt, mine, sp = 0u;
    for (;;) {
        sum = 0u; cnt = 0u; mine = 0u;
#pragma unroll
        for (unsigned j = 0; j < 16; ++j) { const unsigned c = xb_ld(&bar[XB_XCNT(j)]); sum += c; cnt += (c > 0u) ? 1u : 0u; mine = (j == x) ? c : mine; }
        if (sum == G) break;
        __builtin_amdgcn_s_sleep(1);
        if ((++sp & 255u) == 0u) { if (xb_ld(&bar[XB_TMO])) break; if (sp > XB_SPIN_CAP) { atomicAdd(&bar[XB_TMO], 1u); break; } }
    }
    nloc = mine > 0u ? mine : 1u; nx = cnt > 0u ? cnt : 1u;
}
__device__ __forceinline__ void xcd_barrier(const XcdBarrier& b) {
    asm volatile("s_waitcnt vmcnt(0)" ::: "memory");
    __syncthreads();
    if (__builtin_amdgcn_workitem_id_x() == 0) {
        unsigned* bar = b.bar;
        __builtin_amdgcn_s_waitcnt(0);
        unsigned nloc = b.st[0], nx = b.st[1];
        if (nloc == 0u) { xcd_barrier_complete(bar, b.x, nloc, nx); b.st[0] = nloc; b.st[1] = nx; }
        const unsigned old = xb_add(&bar[XB_XSUB(b.x)], 1u);
        const unsigned gen = old / nloc;
        if (old + 1u == (gen + 1u) * nloc) {
            __builtin_amdgcn_fence(__ATOMIC_RELEASE, "agent");
            asm volatile("s_waitcnt vmcnt(0)" ::: "memory");
            const unsigned og = xb_add(&bar[XB_TOP], 1u);
            const unsigned tg = og / nx;
            if (og + 1u == (tg + 1u) * nx) xb_add(&bar[XB_TOPGEN], 1u);
            else XB_SPIN(xb_ld(&bar[XB_TOPGEN]) == tg, bar);
            __builtin_amdgcn_fence(__ATOMIC_ACQUIRE, "agent");
            xb_add(&bar[XB_XGEN(b.x)], 1u);
            asm volatile("s_waitcnt vmcnt(0)" ::: "memory");
        } else {
            XB_SPIN(xb_ld(&bar[XB_XGEN(b.x)]) == gen, bar);
            __builtin_amdgcn_fence(__ATOMIC_ACQUIRE, "agent");
            asm volatile("s_waitcnt vmcnt(0)" ::: "memory");
        }
    }
    __syncthreads();
}

constexpr float QSCALE = 0.10206207261596575f * 1.4426950408889634f;

__device__ __forceinline__ void phase_gemm1(const Params& P, int l, char* lds) {
    unsigned char* ws = P.ws;
    const bf16* XN = (const bf16*)(ws + WS_XN);
    bf16* PROJ = (bf16*)(ws + WS_PROJ);
    bf16* Kb = (bf16*)(ws + WS_K);
    const float* rope = (const float*)(ws + WS_ROPE);
    const bf16* W = (const bf16*)(ws + WS_WIN) + (size_t)l * DINP * LDW;
    gemm_t<false>(W, LDW, DINP, XN, LDX, T, D, C_KR / 128, [&](int n0, int t0, const f32x16& acc, int r32, int hi, float) {
        const int t = t0 + r32;
        if (n0 < C_KR) {
            bf16* pr = PROJ + (size_t)t * DINP + n0 + 4 * hi;
#pragma unroll
            for (int g = 0; g < 4; ++g) { uint2 o; o.x = cvtpk(acc[4 * g], acc[4 * g + 1]); o.y = cvtpk(acc[4 * g + 2], acc[4 * g + 3]); *(uint2*)(pr + 8 * g) = o; }
        } else if (n0 == C_KR) {
            const int b = t / S, s = t % S;
            uint2 o1[2], o2[2];
#pragma unroll
            for (int g = 0; g < 2; ++g) {
                const float4 cs0 = *(const float4*)(rope + ((size_t)s * 16 + 8 * g + 4 * hi) * 2), cs1 = *(const float4*)(rope + ((size_t)s * 16 + 8 * g + 4 * hi) * 2 + 4);
                const float x10 = acc[4 * g], x11 = acc[4 * g + 1], x12 = acc[4 * g + 2], x13 = acc[4 * g + 3];
                const float x20 = acc[8 + 4 * g], x21 = acc[8 + 4 * g + 1], x22 = acc[8 + 4 * g + 2], x23 = acc[8 + 4 * g + 3];
                o1[g].x = cvtpk(x10 * cs0.x - x20 * cs0.y, x11 * cs0.z - x21 * cs0.w); o1[g].y = cvtpk(x12 * cs1.x - x22 * cs1.y, x13 * cs1.z - x23 * cs1.w);
                o2[g].x = cvtpk(x20 * cs0.x + x10 * cs0.y, x21 * cs0.z + x11 * cs0.w); o2[g].y = cvtpk(x22 * cs1.x + x12 * cs1.y, x23 * cs1.z + x13 * cs1.w);
            }
#pragma unroll
            for (int h = 0; h < NH; ++h) {
                bf16* kr = Kb + ((size_t)(b * NH + h) * S + s) * DQK + 64 + 4 * hi;
                *(uint2*)(kr) = o1[0]; *(uint2*)(kr + 8) = o1[1]; *(uint2*)(kr + 16) = o2[0]; *(uint2*)(kr + 24) = o2[1];
            }
        }
    }, [&](int t, int n, const float4& v) {
        uint2 o; o.x = cvtpk(v.x, v.y); o.y = cvtpk(v.z, v.w);
        *(uint2*)(PROJ + (size_t)t * DINP + n) = o;
    }, [](float) { return 1.f; }, lds);
}
__device__ __forceinline__ void phase_gemm2(const Params& P, int l, char* lds) {
    unsigned char* ws = P.ws;
    const bf16* PROJ = (const bf16*)(ws + WS_PROJ);
    const float* rope = (const float*)(ws + WS_ROPE);
    const int lane = tidx() & 63;
    {
        const bf16* W = (const bf16*)(ws + WS_WUQ) + (size_t)l * 768 * QR;
        bf16* Qb = (bf16*)(ws + WS_Q);
        gemm_t<true>(W, QR, 768, PROJ + C_CQ, DINP, T, QR, 768 / 128, [](int, int, const f32x16&, int, int, float) {},
            [&](int t, int n, const float4& v) {
                const int b = t / S, s = t % S, h = n / DQK, d = n % DQK;
                float4 o = v;
                const float4 up = make_float4(__shfl(v.x, lane + 4, 64), __shfl(v.y, lane + 4, 64), __shfl(v.z, lane + 4, 64), __shfl(v.w, lane + 4, 64));
                const float4 dn = make_float4(__shfl(v.x, lane - 4, 64), __shfl(v.y, lane - 4, 64), __shfl(v.z, lane - 4, 64), __shfl(v.w, lane - 4, 64));
                if (d >= 64) {
                    const bool first = d < 80;
                    const int f = first ? (d - 64) : (d - 80);
                    const float4 cs0 = *(const float4*)(rope + ((size_t)s * 16 + f) * 2), cs1 = *(const float4*)(rope + ((size_t)s * 16 + f) * 2 + 4);
                    if (first) o = make_float4(v.x * cs0.x - up.x * cs0.y, v.y * cs0.z - up.y * cs0.w, v.z * cs1.x - up.z * cs1.y, v.w * cs1.z - up.w * cs1.w);
                    else       o = make_float4(v.x * cs0.x + dn.x * cs0.y, v.y * cs0.z + dn.y * cs0.w, v.z * cs1.x + dn.z * cs1.y, v.w * cs1.z + dn.w * cs1.w);
                }
                uint2 u; u.x = cvtpk(o.x, o.y); u.y = cvtpk(o.z, o.w);
                *(uint2*)(Qb + ((size_t)(b * NH + h) * S + s) * DQK + d) = u;
            }, [](float ssq) { return rsqrtf(ssq * (1.f / QR) + EPS) * QSCALE; }, lds);
    }
    {
        const bf16* W = (const bf16*)(ws + WS_WUKV) + (size_t)l * 1024 * KVR;
        bf16* Kb = (bf16*)(ws + WS_K); bf16* Vb = (bf16*)(ws + WS_V);
        gemm_t<true>(W, KVR, 1024, PROJ + C_CKV, DINP, T, KVR, 1024 / 128, [](int, int, const f32x16&, int, int, float) {},
            [&](int t, int n, const float4& v) {
                const int b = t / S, s = t % S;
                uint2 u; u.x = cvtpk(v.x, v.y); u.y = cvtpk(v.z, v.w);
                if (n < 512) *(uint2*)(Kb + ((size_t)(b * NH + (n >> 6)) * S + s) * DQK + (n & 63)) = u;
                else         *(uint2*)(Vb + ((size_t)(b * NH + ((n - 512) >> 6)) * S + s) * DV + (n & 63)) = u;
            }, [](float ssq) { return rsqrtf(ssq * (1.f / KVR) + EPS); }, lds);
    }
}
__device__ __forceinline__ void phase_gemm3(const Params& P, int l, char* lds) {
    unsigned char* ws = P.ws;
    const bf16* Yb = (const bf16*)(ws + WS_XN);
    const bf16* W = (const bf16*)(ws + WS_WOUT) + (size_t)l * D * LDW;
    const float* hin = (l == 0) ? P.x : P.out;
    float* out = P.out;
    gemm_t<false>(W, LDW, D, Yb, LDX, T, D, D / 128, [](int, int, const f32x16&, int, int, float) {}, [&](int t, int n, const float4& v) {
        const size_t idx = (size_t)t * D + n;
        const float4 hv = *(const float4*)(hin + idx);
        *(float4*)(out + idx) = make_float4(hv.x + v.x, hv.y + v.y, hv.z + v.z, hv.w + v.w);
    }, [](float) { return 1.f; }, lds);
}

#define GSYNC() do { XcdBarrier xb_; { __attribute__((address_space(1))) char* gp_ = (__attribute__((address_space(1))) char*)(char*)(P.ws + WS_CTL); asm volatile("" : "+s"(gp_)); xb_.bar = (unsigned*)(char*)gp_; } \
    xb_.x = xb_xcc_id(); xb_.st = (volatile LAS unsigned*)&xb_words; xcd_barrier(xb_); } while (0)
#define PHASE(stmt) { const Params Q = launder(P); stmt; }
__global__ void __launch_bounds__(NTHREADS, 2) k_all(Params P) {
    __shared__ __attribute__((aligned(16))) char sm[LDS_TOTAL];
    __shared__ uint4 xb_words;
    cg::grid_group grid = cg::this_grid();
    if (__builtin_amdgcn_workitem_id_x() == 0) xb_words = make_uint4(0u, 0u, 0u, 0u);
    __syncthreads();
    (void)xcd_barrier_post((unsigned*)(P.ws + WS_CTL), (volatile LAS unsigned*)&xb_words);
    __shared__ int xinfo[8];
    if (__builtin_amdgcn_workitem_id_x() == 0) {
        const unsigned x = xb_xcc_id();
        xinfo[XI_X] = (int)x; xinfo[XI_RANK] = (int)xb_add((unsigned*)(P.ws + WS_CTL) + CTL_CENSUS + x, 1u);
    }
    PHASE(phase_prep(Q, sm));
    PHASE(phase_norm(Q.x, Q.norm_mix, (bf16*)(Q.ws + WS_XN)));
    if (P.ws == nullptr) grid.sync();
    GSYNC();
    if (__builtin_amdgcn_workitem_id_x() == 0) {
        unsigned* cen = (unsigned*)(P.ws + WS_CTL) + CTL_CENSUS;
        const int x = xinfo[XI_X]; int nx = 0, jj = 0;
        for (int q = 0; q < 16; ++q) { const unsigned cq = xb_ld(cen + q); if (cq) { if (q < x) ++jj; ++nx; } }
        xinfo[XI_J] = jj; xinfo[XI_NX] = nx; xinfo[XI_NLOC] = (int)xb_ld(cen + x);
    }
    __syncthreads();
    for (int l = 0; l < DEPTH; ++l) {
        PHASE(phase_gemm1(Q, l, sm));
#if PROBE_DUP & 2
        PHASE(phase_gemm1(Q, l, sm));
#endif
        GSYNC();
        PHASE(phase_mixlocal(Q, l, sm));
#if PROBE_DUP & 256
        PHASE(phase_mixlocal(Q, l, sm));
#endif
        PHASE(phase_gemm2(Q, l, sm));
        GSYNC();
        PHASE(phase_attn(Q, sm));
        GSYNC();
        PHASE(phase_gemm3(Q, l, sm));
#if PROBE_DUP & 16
        if (l == 0) PHASE(phase_gemm3(Q, l, sm));
#endif
        GSYNC();
        PHASE(phase_norm_q(Q, l));
        GSYNC();
        PHASE(phase_route(Q, l, sm));
        GSYNC();
        PHASE(phase_gu(Q, l, xinfo));
        GSYNC();
        PHASE(phase_gw(Q, l));
        GSYNC();
        PHASE(phase_gv(Q, l, xinfo));
        GSYNC();
        PHASE(phase_gnorm(Q, l));
        GSYNC();
    }
}

extern "C" void kernel_launch(void* const* d_in, const int* in_sizes, int n_in, void* d_out, int out_size, void* d_ws, size_t ws_size, hipStream_t stream) {
    static int grid = 0;
    if (grid == 0) {
        if (n_in != 18 || out_size != T * D || ws_size < WS_END) { fprintf(stderr, "kernel_launch: bad sizes n_in %d out %d ws %zu need %zu\n", n_in, out_size, ws_size, (size_t)WS_END); grid = -1; return; }
        int dev = 0, cus = 0, per_cu = 0;
        (void)hipGetDevice(&dev);
        (void)hipDeviceGetAttribute(&cus, hipDeviceAttributeMultiprocessorCount, dev);
        (void)hipOccupancyMaxActiveBlocksPerMultiprocessor(&per_cu, (const void*)k_all, NTHREADS, 0);
        if (per_cu > 2) per_cu = 2;
        if (per_cu < 1) { fprintf(stderr, "kernel_launch: occupancy query says %d\n", per_cu); grid = -1; return; }
        grid = cus * per_cu;
    }
    if (grid < 0) return;
    Params p{};
    p.x = (const float*)d_in[0]; p.norm_mix = (const float*)d_in[1]; p.w_in = (const float*)d_in[2]; p.conv_w = (const float*)d_in[3];
    p.pool_w = (const float*)d_in[4]; p.pool_scale = (const float*)d_in[5]; p.q_norm = (const float*)d_in[6]; p.w_uq = (const float*)d_in[7];
    p.kv_norm = (const float*)d_in[8]; p.w_uk = (const float*)d_in[9]; p.w_uv = (const float*)d_in[10]; p.w_out = (const float*)d_in[11];
    p.norm_ffn = (const float*)d_in[12]; p.peer_wq = (const float*)d_in[13]; p.peer_subkeys = (const float*)d_in[14]; p.peer_u = (const float*)d_in[15];
    p.peer_v = (const float*)d_in[16]; p.norm_final = (const float*)d_in[17];
    p.out = (float*)d_out; p.ws = (unsigned char*)d_ws;
    if (hipMemsetAsync((char*)d_ws + WS_CTL, 0, CTL_BYTES, stream) != hipSuccess) { fprintf(stderr, "kernel_launch: memset failed\n"); return; }
    void* args[] = {&p};
    hipError_t e = hipLaunchCooperativeKernel((const void*)k_all, dim3(grid), dim3(NTHREADS), args, 0, stream);
    if (e != hipSuccess) fprintf(stderr, "cooperative launch failed: %s (grid %d)\n", hipGetErrorString(e), grid);
}
```

```cpp
#include <hip/hip_runtime.h>
#include <hip/hip_cooperative_groups.h>
#include <cstdio>
#include <cstdint>
namespace cg = cooperative_groups;

#ifndef TAB_FP8
#define TAB_FP8 1
#endif
#ifndef PROBE_DUP
#define PROBE_DUP 0
#endif

constexpr int NB = 4, S = 8192, T = NB * S, D = 1024, DEPTH = 2;
constexpr int DIN = 1696, DINP = 1792;
constexpr int C_BG = 0, C_CG = 256, C_HC = 512, C_HP = 768, C_CQ = 1024, C_CKV = 1408, C_KR = 1664;
constexpr int QR = 384, KVR = 256, NH = 8, DQK = 96, DV = 64;
constexpr int PH = 8, NKEY = 128, NEXP = NKEY * NKEY, TOPK = 16, HK = PH * TOPK;
constexpr float EPS = 1e-6f;
constexpr int LDX = 1088;
constexpr int LDW = 1088;

typedef unsigned short bf16;

constexpr size_t WS_CTL   = 0;
constexpr size_t WS_ROPE  = 64 * 1024;
constexpr size_t WS_WIN   = WS_ROPE + (size_t)S * 16 * 2 * 4;
constexpr size_t WS_WUQ   = WS_WIN + (size_t)DEPTH * DINP * LDW * 2;
constexpr size_t WS_WUKV  = WS_WUQ + (size_t)DEPTH * 768 * QR * 2;
constexpr size_t WS_WOUT  = WS_WUKV + (size_t)DEPTH * 1024 * KVR * 2;
constexpr size_t WS_WPQ   = WS_WOUT + (size_t)DEPTH * D * LDW * 2;
constexpr size_t WS_XN    = ((WS_WPQ + (size_t)DEPTH * 2048 * LDW * 2 + 4095) / 4096) * 4096;
constexpr size_t WS_PROJ  = WS_XN + (size_t)T * LDX * 2;
constexpr size_t WS_Q     = WS_PROJ + (size_t)T * DINP * 2;
constexpr size_t WS_K     = WS_Q + (size_t)T * NH * DQK * 2;
constexpr size_t WS_V     = WS_K + (size_t)T * NH * DQK * 2;
constexpr size_t WS_EXP   = WS_V + (size_t)T * NH * DV * 2;
constexpr size_t WS_GATE  = WS_EXP + (size_t)T * HK * 4;
constexpr size_t TAB_ROWB = TAB_FP8 ? 1024 : 2048;
constexpr size_t WS_TABU  = WS_GATE + (size_t)T * HK * 4;
constexpr size_t WS_TABV  = WS_TABU + (size_t)DEPTH * NEXP * TAB_ROWB;
constexpr size_t WS_TSCU  = WS_TABV + (size_t)DEPTH * NEXP * TAB_ROWB;
constexpr size_t WS_TSCV  = WS_TSCU + (size_t)DEPTH * NEXP * 4;
constexpr size_t WS_XQ    = WS_TSCV + (size_t)DEPTH * NEXP * 4;
constexpr size_t WS_XS    = WS_XQ + (size_t)T * D;
constexpr size_t WS_WQ8   = WS_XS + (size_t)T * 4;
constexpr size_t WS_WSC   = WS_WQ8 + (size_t)T * HK;
constexpr size_t WS_END   = WS_WSC + (size_t)T * 4;
static_assert(WS_END <= (size_t)512 * 1024 * 1024, "workspace budget");

struct Params {
    const float* x; const float* norm_mix; const float* w_in; const float* conv_w; const float* pool_w; const float* pool_scale;
    const float* q_norm; const float* w_uq; const float* kv_norm; const float* w_uk; const float* w_uv; const float* w_out;
    const float* norm_ffn; const float* peer_wq; const float* peer_subkeys; const float* peer_u; const float* peer_v; const float* norm_final;
    float* out; unsigned char* ws;
};

__device__ __forceinline__ bf16 f2bf(float f) { unsigned u = __float_as_uint(f); u += 0x7fffu + ((u >> 16) & 1u); return (bf16)(u >> 16); }
__device__ __forceinline__ float bf2f(bf16 h) { return __uint_as_float(((unsigned)h) << 16); }
__device__ __forceinline__ float bflo(unsigned u) { return __uint_as_float(u << 16); }
__device__ __forceinline__ float bfhi(unsigned u) { return __uint_as_float(u & 0xffff0000u); }
__device__ __forceinline__ unsigned pack2(float a, float b) { return (unsigned)f2bf(a) | ((unsigned)f2bf(b) << 16); }
__device__ __forceinline__ float wave_sum(float v) {
#pragma unroll
    for (int m = 32; m >= 1; m >>= 1) v += __shfl_xor(v, m, 64);
    return v;
}
__device__ __forceinline__ float gelu_exact(float x) { return 0.5f * x * (1.f + erff(x * 0.70710678118654752f)); }

#define NTHREADS 256
__device__ __forceinline__ int tidx() { int t = (int)__builtin_amdgcn_workitem_id_x(); asm volatile("" : "+v"(t)); return t; }
__device__ __forceinline__ int gwave() { return blockIdx.x * (NTHREADS / 64) + (tidx() >> 6); }
__device__ __forceinline__ int nwave() { return gridDim.x * (NTHREADS / 64); }
__device__ __forceinline__ size_t gtid() { return (size_t)blockIdx.x * NTHREADS + tidx(); }
__device__ __forceinline__ size_t gnth() { return (size_t)gridDim.x * NTHREADS; }


__device__ __forceinline__ Params launder(const Params& P) {
    typedef __attribute__((address_space(1))) char* gp_t;
    gp_t g[20] = {(gp_t)(char*)P.x, (gp_t)(char*)P.norm_mix, (gp_t)(char*)P.w_in, (gp_t)(char*)P.conv_w, (gp_t)(char*)P.pool_w, (gp_t)(char*)P.pool_scale, (gp_t)(char*)P.q_norm, (gp_t)(char*)P.w_uq,
                  (gp_t)(char*)P.kv_norm, (gp_t)(char*)P.w_uk, (gp_t)(char*)P.w_uv, (gp_t)(char*)P.w_out, (gp_t)(char*)P.norm_ffn, (gp_t)(char*)P.peer_wq, (gp_t)(char*)P.peer_subkeys,
                  (gp_t)(char*)P.peer_u, (gp_t)(char*)P.peer_v, (gp_t)(char*)P.norm_final, (gp_t)(char*)P.out, (gp_t)(char*)P.ws};
    asm volatile("" : "+s"(g[0]), "+s"(g[1]), "+s"(g[2]), "+s"(g[3]), "+s"(g[4]), "+s"(g[5]), "+s"(g[6]), "+s"(g[7]), "+s"(g[8]), "+s"(g[9]));
    asm volatile("" : "+s"(g[10]), "+s"(g[11]), "+s"(g[12]), "+s"(g[13]), "+s"(g[14]), "+s"(g[15]), "+s"(g[16]), "+s"(g[17]), "+s"(g[18]), "+s"(g[19]));
    Params Q;
    Q.x = (const float*)(char*)g[0]; Q.norm_mix = (const float*)(char*)g[1]; Q.w_in = (const float*)(char*)g[2]; Q.conv_w = (const float*)(char*)g[3]; Q.pool_w = (const float*)(char*)g[4];
    Q.pool_scale = (const float*)(char*)g[5]; Q.q_norm = (const float*)(char*)g[6]; Q.w_uq = (const float*)(char*)g[7]; Q.kv_norm = (const float*)(char*)g[8]; Q.w_uk = (const float*)(char*)g[9];
    Q.w_uv = (const float*)(char*)g[10]; Q.w_out = (const float*)(char*)g[11]; Q.norm_ffn = (const float*)(char*)g[12]; Q.peer_wq = (const float*)(char*)g[13]; Q.peer_subkeys = (const float*)(char*)g[14];
    Q.peer_u = (const float*)(char*)g[15]; Q.peer_v = (const float*)(char*)g[16]; Q.norm_final = (const float*)(char*)g[17]; Q.out = (float*)(char*)g[18]; Q.ws = (unsigned char*)(char*)g[19];
    return Q;
}

typedef __attribute__((ext_vector_type(8))) short bf16x8;
typedef __attribute__((ext_vector_type(16))) float f32x16;
typedef __attribute__((ext_vector_type(2))) __bf16 bf2_t;
#define MFMA32(a, b, c) __builtin_amdgcn_mfma_f32_32x32x16_bf16(a, b, c, 0, 0, 0)
__device__ __forceinline__ int crow(int r, int hi) { return (r & 3) + 8 * (r >> 2) + 4 * hi; }
__device__ __forceinline__ float dot2bf(unsigned a, unsigned b, float c) { return __builtin_amdgcn_fdot2_f32_bf16(__builtin_bit_cast(bf2_t, a), __builtin_bit_cast(bf2_t, b), c, false); }
__device__ __forceinline__ unsigned cvtpk(float lo, float hi) { unsigned r; asm("v_cvt_pk_bf16_f32 %0, %1, %2" : "=v"(r) : "v"(lo), "v"(hi)); return r; }
constexpr int G_OPB = 128 * 128;
constexpr int G_BUF = 2 * G_OPB;
constexpr int GEMM_LDS = 2 * G_BUF;
constexpr int LDS_TOTAL = GEMM_LDS + 8192;

template <int WT, bool ROWSS>
__device__ __forceinline__ void gemm_kloop(const bf16* __restrict__ Ag0, int lda, const bf16* __restrict__ Bg0, int ldb, int nk, f32x16 (&acc)[4], float (&ss)[4], char* lds, int tid) {
    const int lane = tid & 63, w = __builtin_amdgcn_readfirstlane(tid >> 6), r32 = lane & 31, hi = lane >> 5;
    const int srow = 8 * w + (lane >> 3);
    const int sch = (lane & 7) ^ ((srow >> 1) & 7);
    const bf16* Ag = Ag0 + (size_t)srow * lda + sch * 8;
    const bf16* Bg = Bg0 + (size_t)srow * ldb + sch * 8;
#pragma unroll
    for (int i = 0; i < 4; ++i)
#pragma unroll
        for (int r = 0; r < 16; ++r) acc[i][r] = 0.f;
    ss[0] = 0.f; ss[1] = 0.f; ss[2] = 0.f; ss[3] = 0.f;
    typedef __attribute__((address_space(3))) unsigned* ldsp_t;
    typedef const __attribute__((address_space(1))) unsigned* glbp_t;
#define G_DMA(buf, kofs) do { char* d_ = lds + (buf) * G_BUF + (8 * w) * 128; \
    _Pragma("unroll") for (int i = 0; i < 4; ++i) { \
        __builtin_amdgcn_global_load_lds((glbp_t)(const void*)(Ag + (size_t)(32 * i) * lda + (kofs)), (ldsp_t)(void*)(d_ + i * 4096), 16, 0, 0); \
        __builtin_amdgcn_global_load_lds((glbp_t)(const void*)(Bg + (size_t)(32 * i) * ldb + (kofs)), (ldsp_t)(void*)(d_ + G_OPB + i * 4096), 16, 0, 0); } } while (0)
    const int xr = (r32 >> 1) & 7;
    const int o0 = ((0 + hi) ^ xr) << 4, o1 = ((2 + hi) ^ xr) << 4, o2 = ((4 + hi) ^ xr) << 4, o3 = ((6 + hi) ^ xr) << 4;
#define G_SS(s_, r_) do { union { bf16x8 v; uint4 u; } c_; c_.v = r_; s_ = dot2bf(c_.u.x, c_.u.x, s_); s_ = dot2bf(c_.u.y, c_.u.y, s_); s_ = dot2bf(c_.u.z, c_.u.z, s_); s_ = dot2bf(c_.u.w, c_.u.w, s_); } while (0)
#define G_STEP(pa, pb, off) do { \
    if (WT == 0) { \
        const bf16x8 a0 = *(const bf16x8*)(pa + off), a1 = *(const bf16x8*)(pa + 32 * 128 + off); \
        const bf16x8 b0 = *(const bf16x8*)(pb + off), b1 = *(const bf16x8*)(pb + 32 * 128 + off); \
        if (ROWSS) { G_SS(ss[0], b0); G_SS(ss[1], b1); } \
        acc[0] = MFMA32(a0, b0, acc[0]); acc[1] = MFMA32(a0, b1, acc[1]); \
        acc[2] = MFMA32(a1, b0, acc[2]); acc[3] = MFMA32(a1, b1, acc[3]); \
    } else { \
        const bf16x8 b0 = *(const bf16x8*)(pb + off); \
        const bf16x8 a0 = *(const bf16x8*)(pa + off), a1 = *(const bf16x8*)(pa + 32 * 128 + off); \
        const bf16x8 a2 = *(const bf16x8*)(pa + 64 * 128 + off), a3 = *(const bf16x8*)(pa + 96 * 128 + off); \
        acc[0] = MFMA32(a0, b0, acc[0]); acc[1] = MFMA32(a1, b0, acc[1]); \
        acc[2] = MFMA32(a2, b0, acc[2]); acc[3] = MFMA32(a3, b0, acc[3]); \
    } } while (0)
    const int arow = (WT == 0) ? ((w >> 1) * 64 + r32) : r32;
    const int brow = (WT == 0) ? ((w & 1) * 64 + r32) : (w * 32 + r32);
    G_DMA(0, 0);
    for (int kt = 0; kt < nk; ++kt) {
        __syncthreads();
        if (kt + 1 < nk) G_DMA((kt + 1) & 1, (kt + 1) * 64);
        const char* pa = lds + (kt & 1) * G_BUF + arow * 128;
        const char* pb = lds + (kt & 1) * G_BUF + G_OPB + brow * 128;
        G_STEP(pa, pb, o0); G_STEP(pa, pb, o1); G_STEP(pa, pb, o2); G_STEP(pa, pb, o3);
    }
    if (ROWSS) { ss[0] += __shfl_xor(ss[0], 32, 64); ss[1] += __shfl_xor(ss[1], 32, 64); }
#undef G_DMA
#undef G_SS
#undef G_STEP
}

constexpr int ST_P = 68;
static_assert(4 * 64 * ST_P * 4 <= LDS_TOTAL, "staging LDS");
template <bool ROWSS, class EPI, class EPIROW, class RSC>
__device__ __forceinline__ void gemm_t(const bf16* __restrict__ Wt, int ldw, int N, const bf16* __restrict__ X, int ldx, int M, int K, int tn_direct, EPI epi, EPIROW epirow, RSC rowscale, char* lds) {
    const int tid = tidx(), lane = tid & 63, w = tid >> 6, r32 = lane & 31, hi = lane >> 5;
    const int tilesN = N / 128, tilesM = M / 128, nk = K / 64;
    for (int tile = blockIdx.x; tile < tilesM * tilesN; tile += gridDim.x) {
        const int tm = tile / tilesN, tn = tile % tilesN;
        f32x16 acc[4]; float ss[4];
        gemm_kloop<0, ROWSS>(Wt + (size_t)(tn * 128) * ldw, ldw, X + (size_t)(tm * 128) * ldx, ldx, nk, acc, ss, lds, tid);
        if (tn < tn_direct) {
            __syncthreads();
            float* st = (float*)lds + w * (64 * ST_P);
            const float m0_ = rowscale(ss[0]), m1_ = rowscale(ss[1]);
#pragma unroll
            for (int i = 0; i < 2; ++i)
#pragma unroll
                for (int j = 0; j < 2; ++j)
#pragma unroll
                    for (int g = 0; g < 4; ++g) {
                        const float mj = j ? m1_ : m0_;
                        *(float4*)(st + (32 * j + r32) * ST_P + 32 * i + 8 * g + 4 * hi) = make_float4(acc[i * 2 + j][4 * g] * mj, acc[i * 2 + j][4 * g + 1] * mj, acc[i * 2 + j][4 * g + 2] * mj, acc[i * 2 + j][4 * g + 3] * mj);
                    }
            const int rr = lane >> 4, ch = lane & 15;
#pragma unroll 4
            for (int it = 0; it < 16; ++it) {
                const int row = it * 4 + rr;
                const float4 v = *(const float4*)(st + row * ST_P + ch * 4);
                epirow(tm * 128 + (w & 1) * 64 + row, tn * 128 + (w >> 1) * 64 + ch * 4, v);
            }
        } else {
#pragma unroll
            for (int i = 0; i < 2; ++i)
#pragma unroll
                for (int j = 0; j < 2; ++j) {
                    const int tl = (w & 1) * 64 + j * 32;
                    epi(tn * 128 + (w >> 1) * 64 + i * 32, tm * 128 + tl, acc[i * 2 + j], r32, hi, ss[j]);
                }
        }
        __syncthreads();
    }
}

__device__ __forceinline__ void transpose_tiled(const float* __restrict__ W, bf16* __restrict__ Wt, int K, int N, int Npad, int ldk, const float* __restrict__ gain, char* lds) {
    float (*tl)[65] = (float (*)[65])lds;
    const int tid = tidx(), a = tid & 63, q = tid >> 6;
    const int tK = K / 64, tN = Npad / 64;
    for (int tile = blockIdx.x; tile < tK * tN; tile += gridDim.x) {
        const int k0 = (tile / tN) * 64, n0 = (tile % tN) * 64;
#pragma unroll 4
        for (int i = 0; i < 16; ++i) {
            const int k = k0 + q * 16 + i, n = n0 + a;
            float v = (n < N) ? W[(size_t)k * N + n] : 0.f;
            if (gain) v *= gain[k];
            tl[q * 16 + i][a] = v;
        }
        __syncthreads();
#pragma unroll 4
        for (int i = 0; i < 16; ++i) { const int nl = q * 16 + i; Wt[(size_t)(n0 + nl) * ldk + k0 + a] = f2bf(tl[a][nl]); }
        __syncthreads();
    }
}

__device__ __forceinline__ void quant_row(const float4 (&v)[4], unsigned char* __restrict__ dst, float* __restrict__ scl, int r, int lane) {
    float am = 0.f;
#pragma unroll
    for (int j = 0; j < 4; ++j) am = fmaxf(am, fmaxf(fmaxf(fabsf(v[j].x), fabsf(v[j].y)), fmaxf(fabsf(v[j].z), fabsf(v[j].w))));
#pragma unroll
    for (int m = 32; m >= 1; m >>= 1) am = fmaxf(am, __shfl_xor(am, m, 64));
    const float sc = (am > 0.f) ? am * (1.f / 448.f) : 1.f;
    const float is = 1.f / sc;
    uint4 o;
    { int w = 0; w = __builtin_amdgcn_cvt_pk_fp8_f32(v[0].x * is, v[0].y * is, w, false); w = __builtin_amdgcn_cvt_pk_fp8_f32(v[0].z * is, v[0].w * is, w, true); o.x = (unsigned)w; }
    { int w = 0; w = __builtin_amdgcn_cvt_pk_fp8_f32(v[1].x * is, v[1].y * is, w, false); w = __builtin_amdgcn_cvt_pk_fp8_f32(v[1].z * is, v[1].w * is, w, true); o.y = (unsigned)w; }
    { int w = 0; w = __builtin_amdgcn_cvt_pk_fp8_f32(v[2].x * is, v[2].y * is, w, false); w = __builtin_amdgcn_cvt_pk_fp8_f32(v[2].z * is, v[2].w * is, w, true); o.z = (unsigned)w; }
    { int w = 0; w = __builtin_amdgcn_cvt_pk_fp8_f32(v[3].x * is, v[3].y * is, w, false); w = __builtin_amdgcn_cvt_pk_fp8_f32(v[3].z * is, v[3].w * is, w, true); o.w = (unsigned)w; }
    { const int lay = r / NEXP, e = r % NEXP; *(uint4*)(dst + (((size_t)(lay * 8 + (lane >> 3)) * NEXP + e) * 128) + (lane & 7) * 16) = o; }
    if (lane == 0) scl[r] = sc;
}
__device__ __forceinline__ unsigned pack_i8x4(float a, float b, float c, float d) {
    const int ia = __float2int_rn(a), ib = __float2int_rn(b), ic = __float2int_rn(c), id = __float2int_rn(d);
    return (unsigned)(ia & 255) | ((unsigned)(ib & 255) << 8) | ((unsigned)(ic & 255) << 16) | ((unsigned)(id & 255) << 24);
}
__device__ __forceinline__ void quant_row_i8(const float4 (&v)[4], unsigned char* __restrict__ dst, float* __restrict__ scl, int r, int lane) {
    float am = 0.f;
#pragma unroll
    for (int j = 0; j < 4; ++j) am = fmaxf(am, fmaxf(fmaxf(fabsf(v[j].x), fabsf(v[j].y)), fmaxf(fabsf(v[j].z), fabsf(v[j].w))));
#pragma unroll
    for (int m = 32; m >= 1; m >>= 1) am = fmaxf(am, __shfl_xor(am, m, 64));
    const float sc = (am > 0.f) ? am * (1.f / 127.f) : 1.f;
    const float is = 1.f / sc;
    uint4 o;
    o.x = pack_i8x4(v[0].x * is, v[0].y * is, v[0].z * is, v[0].w * is); o.y = pack_i8x4(v[1].x * is, v[1].y * is, v[1].z * is, v[1].w * is);
    o.z = pack_i8x4(v[2].x * is, v[2].y * is, v[2].z * is, v[2].w * is); o.w = pack_i8x4(v[3].x * is, v[3].y * is, v[3].z * is, v[3].w * is);
    { const int lay = r / NEXP, e = r % NEXP; *(uint4*)(dst + (((size_t)(lay * 8 + (lane >> 3)) * NEXP + e) * 128) + (lane & 7) * 16) = o; }
    if (lane == 0) scl[r] = sc;
}
template <bool I8>
__device__ __forceinline__ void convert_table(const float* __restrict__ src, unsigned char* __restrict__ dst, float* __restrict__ scl, int rows) {
    static_assert(TAB_FP8, "fp8 tables");
    const int lane = tidx() & 63;
    const int nw = nwave();
    for (int r = gwave(); r < rows; r += 2 * nw) {
        const int r2 = r + nw;
        float4 v0[4], v1[4];
        const float4* s0 = (const float4*)(src + (size_t)r * D);
        const float4* s1 = (const float4*)(src + (size_t)(r2 < rows ? r2 : r) * D);
#pragma unroll
        for (int j = 0; j < 4; ++j) { v0[j] = s0[lane * 4 + j]; v1[j] = s1[lane * 4 + j]; }
        if (I8) { quant_row_i8(v0, dst, scl, r, lane); if (r2 < rows) quant_row_i8(v1, dst, scl, r2, lane); }
        else { quant_row(v0, dst, scl, r, lane); if (r2 < rows) quant_row(v1, dst, scl, r2, lane); }
    }
}
__device__ __forceinline__ void phase_prep(const Params& P, char* lds) {
    unsigned char* ws = P.ws;
    for (int l = 0; l < DEPTH; ++l) {
        transpose_tiled(P.w_in + (size_t)l * D * DIN, (bf16*)(ws + WS_WIN) + (size_t)l * DINP * LDW, D, DIN, DINP, LDW, nullptr, lds);
        transpose_tiled(P.w_uq + (size_t)l * QR * 768, (bf16*)(ws + WS_WUQ) + (size_t)l * 768 * QR, QR, 768, 768, QR, P.q_norm + l * QR, lds);
        transpose_tiled(P.w_uk + (size_t)l * KVR * 512, (bf16*)(ws + WS_WUKV) + (size_t)l * 1024 * KVR, KVR, 512, 512, KVR, P.kv_norm + l * KVR, lds);
        transpose_tiled(P.w_uv + (size_t)l * KVR * 512, (bf16*)(ws + WS_WUKV) + (size_t)l * 1024 * KVR + (size_t)512 * KVR, KVR, 512, 512, KVR, P.kv_norm + l * KVR, lds);
        transpose_tiled(P.w_out + (size_t)l * D * D, (bf16*)(ws + WS_WOUT) + (size_t)l * D * LDW, D, D, D, LDW, nullptr, lds);
    }
    {
        bf16* Wc = (bf16*)(ws + WS_WPQ);
        float (*As)[68] = (float (*)[68])lds;
        float (*Bs)[68] = (float (*)[68])(lds + 16 * 68 * 4);
        const int tid = tidx(), tx = tid & 15, ty = tid >> 4;
        const int lr = tid >> 2, ld4 = (tid & 3) * 4;
        for (int tile = blockIdx.x; tile < (DEPTH * 2048 / 64) * (D / 64); tile += gridDim.x) {
            const int row0 = (tile >> 4) * 64, k0 = (tile & 15) * 64;
            const int l = row0 >> 11, hp = (row0 >> 7) & 15, n0 = row0 & 127;
            const float* skp = P.peer_subkeys + (((size_t)l * 2 + (hp & 1)) * NKEY + n0 + lr) * 128 + ld4;
            const float* wqp = P.peer_wq + ((size_t)l * D + k0 + lr) * 2048 + hp * 128 + ld4;
            float acc[4][4];
#pragma unroll
            for (int i = 0; i < 4; ++i)
#pragma unroll
                for (int j = 0; j < 4; ++j) acc[i][j] = 0.f;
            for (int d0 = 0; d0 < 128; d0 += 16) {
                const float4 av = *(const float4*)(skp + d0), bv = *(const float4*)(wqp + d0);
                As[ld4 + 0][lr] = av.x; As[ld4 + 1][lr] = av.y; As[ld4 + 2][lr] = av.z; As[ld4 + 3][lr] = av.w;
                Bs[ld4 + 0][lr] = bv.x; Bs[ld4 + 1][lr] = bv.y; Bs[ld4 + 2][lr] = bv.z; Bs[ld4 + 3][lr] = bv.w;
                __syncthreads();
#pragma unroll
                for (int kk = 0; kk < 16; ++kk) {
                    const float4 a4 = *(const float4*)&As[kk][ty * 4], b4 = *(const float4*)&Bs[kk][tx * 4];
                    const float aa[4] = {a4.x, a4.y, a4.z, a4.w}, bb[4] = {b4.x, b4.y, b4.z, b4.w};
#pragma unroll
                    for (int i = 0; i < 4; ++i)
#pragma unroll
                        for (int j = 0; j < 4; ++j) acc[i][j] = fmaf(aa[i], bb[j], acc[i][j]);
                }
                __syncthreads();
            }
#pragma unroll
            for (int i = 0; i < 4; ++i) {
                uint2 o; o.x = pack2(acc[i][0], acc[i][1]); o.y = pack2(acc[i][2], acc[i][3]);
                *(uint2*)(Wc + (size_t)(row0 + ty * 4 + i) * LDW + k0 + tx * 4) = o;
            }
        }
    }
    convert_table<true>(P.peer_u, ws + WS_TABU, (float*)(ws + WS_TSCU), DEPTH * NEXP);
    convert_table<false>(P.peer_v, ws + WS_TABV, (float*)(ws + WS_TSCV), DEPTH * NEXP);
    float* rope = (float*)(ws + WS_ROPE);
    for (size_t i = gtid(); i < (size_t)S * 16; i += gnth()) {
        const int s = (int)(i >> 4), f = (int)(i & 15);
        const double inv = pow(10000.0, -(double)f / 16.0);
        const double ang = (double)s * inv;
        rope[2 * i] = (float)cos(ang); rope[2 * i + 1] = (float)sin(ang);
    }
}

__device__ __forceinline__ void phase_norm(const float* __restrict__ h, const float* __restrict__ g, bf16* __restrict__ xn) {
    const int lane = tidx() & 63;
    for (int t = gwave(); t < T; t += nwave()) {
        const float4* hr = (const float4*)(h + (size_t)t * D);
        float4 v[4]; float ss = 0.f;
#pragma unroll
        for (int j = 0; j < 4; ++j) { v[j] = hr[j * 64 + lane]; ss += v[j].x * v[j].x + v[j].y * v[j].y + v[j].z * v[j].z + v[j].w * v[j].w; }
        ss = wave_sum(ss);
        const float r = rsqrtf(ss * (1.f / D) + EPS);
#pragma unroll
        for (int j = 0; j < 4; ++j) {
            const float4 gg = ((const float4*)g)[j * 64 + lane];
            uint2 o; o.x = pack2(v[j].x * r * gg.x, v[j].y * r * gg.y); o.y = pack2(v[j].z * r * gg.z, v[j].w * r * gg.w);
            ((uint2*)(xn + (size_t)t * LDX))[j * 64 + lane] = o;
        }
    }
}

__device__ __forceinline__ void phase_norm_q(const Params& P, int l) {
    const int lane = tidx() & 63;
    const float* g = P.norm_ffn + l * D;
    bf16* xn = (bf16*)(P.ws + WS_XN);
    unsigned* xq = (unsigned*)(P.ws + WS_XQ);
    float* xsc = (float*)(P.ws + WS_XS);
    for (int t = gwave(); t < T; t += nwave()) {
        const float4* hr = (const float4*)(P.out + (size_t)t * D);
        float4 v[4]; float ss = 0.f;
#pragma unroll
        for (int j = 0; j < 4; ++j) { v[j] = hr[j * 64 + lane]; ss += v[j].x * v[j].x + v[j].y * v[j].y + v[j].z * v[j].z + v[j].w * v[j].w; }
        ss = wave_sum(ss);
        const float r = rsqrtf(ss * (1.f / D) + EPS);
        float am = 0.f;
#pragma unroll
        for (int j = 0; j < 4; ++j) {
            const float4 gg = ((const float4*)g)[j * 64 + lane];
            v[j].x *= r * gg.x; v[j].y *= r * gg.y; v[j].z *= r * gg.z; v[j].w *= r * gg.w;
            am = fmaxf(am, fmaxf(fmaxf(fabsf(v[j].x), fabsf(v[j].y)), fmaxf(fabsf(v[j].z), fabsf(v[j].w))));
            uint2 o; o.x = pack2(v[j].x, v[j].y); o.y = pack2(v[j].z, v[j].w);
            ((uint2*)(xn + (size_t)t * LDX))[j * 64 + lane] = o;
        }
#pragma unroll
        for (int m = 32; m >= 1; m >>= 1) am = fmaxf(am, __shfl_xor(am, m, 64));
        const float sc = (am > 0.f) ? am * (1.f / 127.f) : 1.f, is = 1.f / sc;
#pragma unroll
        for (int j = 0; j < 4; ++j) xq[(size_t)t * (D / 4) + j * 64 + lane] = pack_i8x4(v[j].x * is, v[j].y * is, v[j].z * is, v[j].w * is);
        if (lane == 0) xsc[t] = sc;
    }
}

__device__ __forceinline__ void phase_mixlocal(const Params& P, int l, char* lds) {
    const bf16* proj = (const bf16*)(P.ws + WS_PROJ);
    bf16* Y = (bf16*)(P.ws + WS_XN);
    const int tid = tidx();
    {
        const float* cw = P.conv_w + (size_t)l * 3 * 256;
        for (size_t i = gtid(); i < (size_t)T * 32; i += gnth()) {
            const int t = (int)(i >> 5), c0 = (int)(i & 31) * 8, s = t & (S - 1);
            const bf16* pr = proj + (size_t)t * DINP;
            float acc[8];
#pragma unroll
            for (int e = 0; e < 8; ++e) acc[e] = 0.f;
#pragma unroll
            for (int j = 0; j < 3; ++j) {
                if (s - 2 + j >= 0) {
                    const bf16* pp = pr - (size_t)(2 - j) * DINP;
                    const uint4 g = *(const uint4*)(pp + C_CG + c0), hc = *(const uint4*)(pp + C_HC + c0);
                    const float4 w0 = *(const float4*)(cw + j * 256 + c0), w1 = *(const float4*)(cw + j * 256 + c0 + 4);
                    acc[0] = fmaf(w0.x, bflo(g.x) * bflo(hc.x), acc[0]); acc[1] = fmaf(w0.y, bfhi(g.x) * bfhi(hc.x), acc[1]);
                    acc[2] = fmaf(w0.z, bflo(g.y) * bflo(hc.y), acc[2]); acc[3] = fmaf(w0.w, bfhi(g.y) * bfhi(hc.y), acc[3]);
                    acc[4] = fmaf(w1.x, bflo(g.z) * bflo(hc.z), acc[4]); acc[5] = fmaf(w1.y, bfhi(g.z) * bfhi(hc.z), acc[5]);
                    acc[6] = fmaf(w1.z, bflo(g.w) * bflo(hc.w), acc[6]); acc[7] = fmaf(w1.w, bfhi(g.w) * bfhi(hc.w), acc[7]);
                }
            }
            const uint4 bg = *(const uint4*)(pr + C_BG + c0);
            uint4 o;
            o.x = pack2(bflo(bg.x) * acc[0], bfhi(bg.x) * acc[1]); o.y = pack2(bflo(bg.y) * acc[2], bfhi(bg.y) * acc[3]);
            o.z = pack2(bflo(bg.z) * acc[4], bfhi(bg.z) * acc[5]); o.w = pack2(bflo(bg.w) * acc[6], bfhi(bg.w) * acc[7]);
            *(uint4*)(Y + (size_t)t * LDX + c0) = o;
        }
    }
    {
        float (*pl)[68] = (float (*)[68])lds;
        const float* pw = P.pool_w + (size_t)l * 4 * 64 * 64;
        const float* psc = P.pool_scale + l * 256;
        const int a = tid & 63, q = tid >> 6;
        for (int tile = blockIdx.x; tile < (T / 64) * 4; tile += gridDim.x) {
            const int g = tile & 3, t0 = (tile >> 2) * 64;
            const int w = 2 << g;
            {
                const bf16* col = proj + C_HP + g * 64 + a;
                const int tf = t0 + q * 16, sf = tf & (S - 1);
                float sum = 0.f;
                for (int d = 1; d < w; ++d) if (sf - d >= 0) sum += bf2f(col[(size_t)(tf - d) * DINP]);
#pragma unroll 4
                for (int i = 0; i < 16; ++i) {
                    const int s = sf + i;
                    const float xv = bf2f(col[(size_t)(tf + i) * DINP]);
                    sum += xv;
                    const int cnt = (s + 1 < w) ? (s + 1) : w;
                    pl[q * 16 + i][a] = sum / (float)cnt - xv;
                    if (s - w + 1 >= 0) sum -= bf2f(col[(size_t)(tf + i - w + 1) * DINP]);
                }
            }
            __syncthreads();
            {
                float pc[64];
#pragma unroll
                for (int c = 0; c < 64; ++c) pc[c] = pw[(g * 64 + c) * 64 + a];
                const float sc = psc[g * 64 + a];
#pragma unroll 2
                for (int i = 0; i < 16; ++i) {
                    const float4* row = (const float4*)&pl[q * 16 + i][0];
                    float m0 = 0.f, m1 = 0.f;
#pragma unroll
                    for (int c4 = 0; c4 < 16; ++c4) { const float4 v = row[c4]; m0 = fmaf(v.x, pc[4 * c4], m0); m1 = fmaf(v.y, pc[4 * c4 + 1], m1); m0 = fmaf(v.z, pc[4 * c4 + 2], m0); m1 = fmaf(v.w, pc[4 * c4 + 3], m1); }
                    Y[(size_t)(t0 + q * 16 + i) * LDX + 256 + g * 64 + a] = f2bf((m0 + m1) * sc);
                }
            }
            __syncthreads();
        }
    }
}

typedef short v4i16_t __attribute__((ext_vector_type(4)));
typedef __attribute__((address_space(3))) v4i16_t* lds_v4p;
__device__ __forceinline__ v4i16_t vtr(const char* p) { return __builtin_amdgcn_ds_read_tr16_b64_v4i16((lds_v4p)p); }
constexpr int A_KP = 208, A_VP = 192;
constexpr int A_KB = 64 * A_KP, A_VB = 64 * A_VP, A_BUF = A_KB + A_VB, ATTN_LDS = 2 * A_BUF;
static_assert(ATTN_LDS <= GEMM_LDS, "attention LDS");

__device__ __forceinline__ void attn_unit(const bf16* __restrict__ Qb, const bf16* __restrict__ Kb, const bf16* __restrict__ Vb, bf16* __restrict__ Y, int bh, int qblk, char* lds) {
    const int tid = tidx(), lane = tid & 63, w = tid >> 6, r32 = lane & 31, hi = lane >> 5;
    const int q0 = qblk * 128, qw0 = q0 + w * 32;
    const int NT = 2 * qblk + 2;
    bf16x8 qf[6];
    {
        const bf16* qp = Qb + ((size_t)bh * S + qw0 + r32) * DQK + hi * 8;
#pragma unroll
        for (int ks = 0; ks < 6; ++ks) qf[ks] = *(const bf16x8*)(qp + ks * 16);
    }
    f32x16 o0, o1;
#pragma unroll
    for (int r = 0; r < 16; ++r) { o0[r] = 0.f; o1[r] = 0.f; }
    float m = -1e30f, lsum = 0.f;
    const char* Kg = (const char*)(Kb + (size_t)bh * S * DQK) + tid * 16;
    const char* Vg = (const char*)(Vb + (size_t)bh * S * DV) + tid * 16;
    const int kl0 = (tid / 12) * A_KP + (tid % 12) * 16, kl1 = ((tid + 256) / 12) * A_KP + ((tid + 256) % 12) * 16, kl2 = ((tid + 512) / 12) * A_KP + ((tid + 512) % 12) * 16;
    const int vl0 = (tid >> 3) * A_VP + (tid & 7) * 16, vl1 = vl0 + 32 * A_VP;
    uint4 pk0, pk1, pk2, pv0, pv1, qk0, qk1, qk2, qv0, qv1;
#define A_LOAD(S, t) do { const char* kg = Kg + (size_t)(t) * (64 * 192); const char* vg = Vg + (size_t)(t) * (64 * 128); \
        S##k0 = *(const uint4*)(kg); S##k1 = *(const uint4*)(kg + 4096); S##k2 = *(const uint4*)(kg + 8192); S##v0 = *(const uint4*)(vg); S##v1 = *(const uint4*)(vg + 4096); } while (0)
#define A_STORE(S, bK, bV) do { *(uint4*)(bK + kl0) = S##k0; *(uint4*)(bK + kl1) = S##k1; *(uint4*)(bK + kl2) = S##k2; *(uint4*)(bV + vl0) = S##v0; *(uint4*)(bV + vl1) = S##v1; } while (0)
#define A_PV(pf, kofs) do { \
            { const v4i16_t lo = vtr(pv + (kofs) * A_VP), hh = vtr(pv + ((kofs) + 8) * A_VP); const bf16x8 vf = {lo[0], lo[1], lo[2], lo[3], hh[0], hh[1], hh[2], hh[3]}; o0 = MFMA32(vf, pf.v, o0); } \
            { const v4i16_t lo = vtr(pv + (kofs) * A_VP + 64), hh = vtr(pv + ((kofs) + 8) * A_VP + 64); const bf16x8 vf = {lo[0], lo[1], lo[2], lo[3], hh[0], hh[1], hh[2], hh[3]}; o1 = MFMA32(vf, pf.v, o1); } } while (0)
    const int pvo = (4 * hi + ((lane & 15) >> 2)) * A_VP + (16 * ((lane >> 4) & 1) + 4 * (lane & 3)) * 2;
    A_LOAD(p, 0); A_LOAD(q, 1);
    for (int t2 = 0; t2 < NT; t2 += 2) {
#pragma unroll
        for (int half = 0; half < 2; ++half) {
            const int t = t2 + half;
            char* bK = lds + half * A_BUF; char* bV = bK + A_KB;
            if (half == 0) A_STORE(p, bK, bV); else A_STORE(q, bK, bV);
            __syncthreads();
            { const int tn = (t + 2 < NT) ? (t + 2) : (NT - 2 + half); if (half == 0) A_LOAD(p, tn); else A_LOAD(q, tn); }
        const int kt0 = t * 64;
        if (kt0 <= qw0) {
            f32x16 s0, s1;
#pragma unroll
            for (int r = 0; r < 16; ++r) { s0[r] = 0.f; s1[r] = 0.f; }
            const char* pk = bK + r32 * A_KP + hi * 16;
#pragma unroll
            for (int ks = 0; ks < 6; ++ks) {
                const bf16x8 a0 = *(const bf16x8*)(pk + ks * 32), a1 = *(const bf16x8*)(pk + 32 * A_KP + ks * 32);
                s0 = MFMA32(a0, qf[ks], s0); s1 = MFMA32(a1, qf[ks], s1);
            }
            if (kt0 + 63 > qw0) {
                const int qrow = qw0 + r32;
#pragma unroll
                for (int r = 0; r < 16; ++r) { const int key = kt0 + crow(r, hi); if (key > qrow) s0[r] = -INFINITY; if (key + 32 > qrow) s1[r] = -INFINITY; }
            }
            float mx = fmaxf(s0[0], s1[0]);
#pragma unroll
            for (int r = 1; r < 16; ++r) mx = fmaxf(mx, fmaxf(s0[r], s1[r]));
            mx = fmaxf(mx, __shfl_xor(mx, 32, 64));
            const float mn = fmaxf(m, mx), m_prev = m;
            const float alpha = __builtin_amdgcn_exp2f(m - mn);
            m = mn;
            float ps = 0.f;
#pragma unroll
            for (int r = 0; r < 16; ++r) { s0[r] = __builtin_amdgcn_exp2f(s0[r] - mn); s1[r] = __builtin_amdgcn_exp2f(s1[r] - mn); ps += s0[r] + s1[r]; }
            if (__builtin_amdgcn_ballot_w64(mn > m_prev) != 0ull) {
                lsum *= alpha;
#pragma unroll
                for (int r = 0; r < 16; ++r) { o0[r] *= alpha; o1[r] *= alpha; }
            }
            lsum += ps;
            union { unsigned u[4]; bf16x8 v; } p00, p01, p10, p11;
#pragma unroll
            for (int j = 0; j < 4; ++j) { p00.u[j] = cvtpk(s0[2 * j], s0[2 * j + 1]); p01.u[j] = cvtpk(s0[8 + 2 * j], s0[9 + 2 * j]); p10.u[j] = cvtpk(s1[2 * j], s1[2 * j + 1]); p11.u[j] = cvtpk(s1[8 + 2 * j], s1[9 + 2 * j]); }
            const char* pv = bV + pvo;
            A_PV(p00, 0); A_PV(p01, 16); A_PV(p10, 32); A_PV(p11, 48);
        }
        }
    }
    lsum += __shfl_xor(lsum, 32, 64);
    const float inv = 1.f / lsum;
    const int b = bh >> 3, h = bh & 7;
    bf16* yo = Y + (size_t)(b * S + qw0 + r32) * LDX + 512 + h * 64 + 4 * hi;
#pragma unroll
    for (int g = 0; g < 4; ++g) {
        uint2 a, c;
        a.x = cvtpk(o0[4 * g] * inv, o0[4 * g + 1] * inv); a.y = cvtpk(o0[4 * g + 2] * inv, o0[4 * g + 3] * inv);
        c.x = cvtpk(o1[4 * g] * inv, o1[4 * g + 1] * inv); c.y = cvtpk(o1[4 * g + 2] * inv, o1[4 * g + 3] * inv);
        *(uint2*)(yo + 8 * g) = a; *(uint2*)(yo + 32 + 8 * g) = c;
    }
    __syncthreads();
}
__device__ __forceinline__ void phase_attn(const Params& P, char* lds) {
    const bf16* Qb = (const bf16*)(P.ws + WS_Q);
    const bf16* Kb = (const bf16*)(P.ws + WS_K);
    const bf16* Vb = (const bf16*)(P.ws + WS_V);
    bf16* Y = (bf16*)(P.ws + WS_XN);
    for (int u = blockIdx.x; u < NB * NH * (S / 128); u += gridDim.x) {
        const int bh = u & 31, v = u >> 5;
        const int qblk = (v < 16) ? (63 - v) : (v < 32) ? (v - 16) : (v < 48) ? (79 - v) : (v - 32);
        attn_unit(Qb, Kb, Vb, Y, bh, qblk, lds);
    }
}

#define NET_HD __device__ __forceinline__
#define NET_U2F(u) __uint_as_float(u)
#define NET_F2U(f) __float_as_uint(f)
#define CE_DESC(a, b) do { const float hi__ = fmaxf(a, b), lo__ = fminf(a, b); a = hi__; b = lo__; } while (0)
NET_HD void sort16_desc(float (&v)[16]) {
#pragma unroll
    for (int k = 2; k <= 16; k <<= 1) {
#pragma unroll
        for (int j = k >> 1; j > 0; j >>= 1) {
#pragma unroll
            for (int i = 0; i < 16; ++i) {
                const int l = i ^ j;
                if (l > i) { if ((i & k) == 0) CE_DESC(v[i], v[l]); else CE_DESC(v[l], v[i]); }
            }
        }
    }
}
NET_HD void merge16_desc(float (&a)[16], const float (&b)[16]) {
#pragma unroll
    for (int i = 0; i < 16; ++i) a[i] = fmaxf(a[i], b[15 - i]);
#pragma unroll
    for (int j = 8; j > 0; j >>= 1) {
#pragma unroll
        for (int i = 0; i < 16; ++i) { const int l = i ^ j; if (l > i) CE_DESC(a[i], a[l]); }
    }
}
NET_HD void top16_of_64(float (&g0)[16], float (&g1)[16], float (&g2)[16], float (&g3)[16]) {
    sort16_desc(g0); sort16_desc(g1); sort16_desc(g2); sort16_desc(g3);
    merge16_desc(g0, g1); merge16_desc(g2, g3); merge16_desc(g0, g2);
}
NET_HD float u2f(unsigned u) { return NET_U2F(u); }
NET_HD unsigned f2u(float f) { return NET_F2U(f); }
template <class V16>
NET_HD void lane_top16(const V16& s0, const V16& s1, const V16& s2, const V16& s3, int hi, float (&out)[16]) {
    float g0[16], g1[16], g2[16], g3[16];
#pragma unroll
    for (int r = 0; r < 16; ++r) {
        const unsigned nb = (unsigned)((r & 3) + 8 * (r >> 2));
        g0[r] = u2f((f2u(s0[r]) & 0xFFFFFF80u) | nb); g1[r] = u2f((f2u(s1[r]) & 0xFFFFFF80u) | (nb + 32u));
        g2[r] = u2f((f2u(s2[r]) & 0xFFFFFF80u) | (nb + 64u)); g3[r] = u2f((f2u(s3[r]) & 0xFFFFFF80u) | (nb + 96u));
    }
    top16_of_64(g0, g1, g2, g3);
    const unsigned h4 = (unsigned)hi << 2;
#pragma unroll
    for (int i = 0; i < 16; ++i) out[i] = u2f(f2u(g0[i]) | h4);
}
constexpr int cand_slot(int a, int b) { int n = 0; for (int x = 0; x < 16; ++x) for (int y = 0; y < 16; ++y) { if (x == a && y == b) return n; if ((x + 1) * (y + 1) <= 16) ++n; } return n; }
NET_HD void cand_top16(const float (&s1)[16], const float (&s2)[16], float (&c)[16]) {
    float g0[16], g1[16], g2[16], g3[16];
#pragma unroll
    for (int i = 0; i < 16; ++i) { g0[i] = -3.0e38f; g1[i] = -3.0e38f; g2[i] = -3.0e38f; g3[i] = -3.0e38f; }
#pragma unroll
    for (int a = 0; a < 16; ++a) {
#pragma unroll
        for (int b = 0; b < 16; ++b) {
            if ((a + 1) * (b + 1) <= 16) {
                const int sl = cand_slot(a, b);
                const float v = u2f((f2u(s1[a] + s2[b]) & 0xFFFFFF00u) | (unsigned)(a * 16 + b));
                if (sl < 16) g0[sl & 15] = v; else if (sl < 32) g1[sl & 15] = v; else if (sl < 48) g2[sl & 15] = v; else g3[sl & 15] = v;
            }
        }
    }
    top16_of_64(g0, g1, g2, g3);
#pragma unroll
    for (int i = 0; i < 16; ++i) c[i] = g0[i];
}

__device__ __forceinline__ void phase_route(const Params& P, int l, char* lds) {
    const bf16* XN = (const bf16*)(P.ws + WS_XN);
    const bf16* Wc = (const bf16*)(P.ws + WS_WPQ) + (size_t)l * 2048 * LDW;
    int* EXPp = (int*)(P.ws + WS_EXP);
    float* GATEp = (float*)(P.ws + WS_GATE);
    const int tid = tidx(), lane = tid & 63, w = tid >> 6, r32 = lane & 31, hi = lane >> 5;
    for (int u = blockIdx.x; u < (T / 128) * PH; u += gridDim.x) {
        const int tm = u >> 3, h = u & 7;
        float L0[16], L1[16];
        {
            f32x16 acc[4]; float ssd[4];
            gemm_kloop<1, false>(Wc + (size_t)((h * 2 + 0) * 128) * LDW, LDW, XN + (size_t)(tm * 128) * LDX, LDX, D / 64, acc, ssd, lds, tid);
            lane_top16(acc[0], acc[1], acc[2], acc[3], hi, L0);
            float o[16];
#pragma unroll
            for (int i = 0; i < 16; ++i) o[i] = __shfl_xor(L0[i], 32, 64);
            merge16_desc(L0, o);
        }
        {
            f32x16 acc[4]; float ssd[4];
            gemm_kloop<1, false>(Wc + (size_t)((h * 2 + 1) * 128) * LDW, LDW, XN + (size_t)(tm * 128) * LDX, LDX, D / 64, acc, ssd, lds, tid);
            lane_top16(acc[0], acc[1], acc[2], acc[3], hi, L1);
            float o[16];
#pragma unroll
            for (int i = 0; i < 16; ++i) o[i] = __shfl_xor(L1[i], 32, 64);
            merge16_desc(L1, o);
        }
        float c[16];
        cand_top16(L0, L1, c);
        __syncthreads();
        unsigned char* my = (unsigned char*)lds + tid * 32;
        {
            uint4 a, b;
#define PK4(L, i) ((__float_as_uint(L[i]) & 127u) | ((__float_as_uint(L[i + 1]) & 127u) << 8) | ((__float_as_uint(L[i + 2]) & 127u) << 16) | ((__float_as_uint(L[i + 3]) & 127u) << 24))
            a.x = PK4(L0, 0); a.y = PK4(L0, 4); a.z = PK4(L0, 8); a.w = PK4(L0, 12);
            b.x = PK4(L1, 0); b.y = PK4(L1, 4); b.z = PK4(L1, 8); b.w = PK4(L1, 12);
#undef PK4
            *(uint4*)my = a; *(uint4*)(my + 16) = b;
        }
        int ev[16]; float gv[16]; float den = 0.f;
#pragma unroll
        for (int k = 0; k < 16; ++k) {
            const unsigned ci = __float_as_uint(c[k]) & 255u;
            const int n1 = my[ci >> 4], n2 = my[16 + (ci & 15)];
            ev[k] = n1 * NKEY + n2;
            gv[k] = __expf(c[k] - c[0]); den += gv[k];
        }
        const float iden = 1.f / den;
        if (hi == 0) {
            const int t = tm * 128 + w * 32 + r32;
            uint4* ep = (uint4*)(EXPp + (size_t)t * HK + h * 16);
            float4* gp = (float4*)(GATEp + (size_t)t * HK + h * 16);
#pragma unroll
            for (int q = 0; q < 4; ++q) {
                ep[q] = make_uint4((unsigned)ev[4 * q], (unsigned)ev[4 * q + 1], (unsigned)ev[4 * q + 2], (unsigned)ev[4 * q + 3]);
                gp[q] = make_float4(gv[4 * q] * iden, gv[4 * q + 1] * iden, gv[4 * q + 2] * iden, gv[4 * q + 3] * iden);
            }
        }
        __syncthreads();
    }
}

__device__ __forceinline__ float red16(float (&p)[16], int lane) {
#pragma unroll
    for (int i = 0; i < 8; ++i) { const bool up = lane & 32; const float send = up ? p[i] : p[i + 8], keep = up ? p[i + 8] : p[i]; p[i] = keep + __shfl_xor(send, 32, 64); }
#pragma unroll
    for (int i = 0; i < 4; ++i) { const bool up = lane & 16; const float send = up ? p[i] : p[i + 4], keep = up ? p[i + 4] : p[i]; p[i] = keep + __shfl_xor(send, 16, 64); }
#pragma unroll
    for (int i = 0; i < 2; ++i) { const bool up = lane & 8; const float send = up ? p[i] : p[i + 2], keep = up ? p[i + 2] : p[i]; p[i] = keep + __shfl_xor(send, 8, 64); }
    { const bool up = lane & 4; const float send = up ? p[0] : p[1], keep = up ? p[1] : p[0]; p[0] = keep + __shfl_xor(send, 4, 64); }
    float r = p[0];
    r += __shfl_xor(r, 2, 64); r += __shfl_xor(r, 1, 64);
    return r;
}

__device__ __forceinline__ void phase_gather(const Params& P, int l) {
    const bf16* XN = (const bf16*)(P.ws + WS_XN);
    bf16* XNw = (bf16*)(P.ws + WS_XN);
    const int* EXPp = (const int*)(P.ws + WS_EXP);
    const float* GATEp = (const float*)(P.ws + WS_GATE);
    const unsigned char* U = P.ws + WS_TABU + (size_t)l * NEXP * TAB_ROWB;
    const unsigned char* V = P.ws + WS_TABV + (size_t)l * NEXP * TAB_ROWB;
    const float* SU = (const float*)(P.ws + WS_TSCU) + (size_t)l * NEXP;
    const float* SV = (const float*)(P.ws + WS_TSCV) + (size_t)l * NEXP;
    const int lane = tidx() & 63;
    for (int t = gwave(); t < T; t += nwave()) {
        const int e_lo = EXPp[(size_t)t * HK + lane], e_hi = EXPp[(size_t)t * HK + 64 + lane];
#if TAB_FP8
        float xf[16];
        {
            const uint4 a = ((const uint4*)(XN + (size_t)t * D))[lane * 2], b = ((const uint4*)(XN + (size_t)t * D))[lane * 2 + 1];
            xf[0] = bflo(a.x); xf[1] = bfhi(a.x); xf[2] = bflo(a.y); xf[3] = bfhi(a.y); xf[4] = bflo(a.z); xf[5] = bfhi(a.z); xf[6] = bflo(a.w); xf[7] = bfhi(a.w);
            xf[8] = bflo(b.x); xf[9] = bfhi(b.x); xf[10] = bflo(b.y); xf[11] = bfhi(b.y); xf[12] = bflo(b.z); xf[13] = bfhi(b.z); xf[14] = bflo(b.w); xf[15] = bfhi(b.w);
        }
#else
        const uint4 xa = ((const uint4*)(XN + (size_t)t * D))[lane], xb = ((const uint4*)(XN + (size_t)t * D))[64 + lane];
#endif
        float acc[16];
#pragma unroll
        for (int i = 0; i < 16; ++i) acc[i] = 0.f;
        for (int c = 0; c < 8; ++c) {
            const int esel = (c < 4) ? e_lo : e_hi;
            const int kb = (c & 3) * 16;
            float part[16];
#pragma unroll
            for (int hb = 0; hb < 2; ++hb) {
#if TAB_FP8
                uint4 r[8];
#pragma unroll
                for (int i = 0; i < 8; ++i) { const int e = __builtin_amdgcn_readlane(esel, kb + hb * 8 + i); r[i] = *(const uint4*)(U + (size_t)e * 1024 + lane * 16); }
#pragma unroll
                for (int i = 0; i < 8; ++i) {
                    float d0 = 0.f, d1 = 0.f;
                    const unsigned w[4] = {r[i].x, r[i].y, r[i].z, r[i].w};
#pragma unroll
                    for (int q = 0; q < 4; ++q) {
                        const auto lo = __builtin_amdgcn_cvt_pk_f32_fp8((int)w[q], false); const auto hh = __builtin_amdgcn_cvt_pk_f32_fp8((int)w[q], true);
                        d0 = fmaf(xf[4 * q], lo[0], d0); d1 = fmaf(xf[4 * q + 1], lo[1], d1); d0 = fmaf(xf[4 * q + 2], hh[0], d0); d1 = fmaf(xf[4 * q + 3], hh[1], d1);
                    }
                    part[hb * 8 + i] = d0 + d1;
                }
#else
                uint4 r0[8], r1[8];
#pragma unroll
                for (int i = 0; i < 8; ++i) { const int e = __builtin_amdgcn_readlane(esel, kb + hb * 8 + i); const unsigned char* rp = U + (size_t)e * 2048 + lane * 16; r0[i] = *(const uint4*)(rp); r1[i] = *(const uint4*)(rp + 1024); }
#pragma unroll
                for (int i = 0; i < 8; ++i) {
                    float d0 = 0.f, d1 = 0.f;
                    d0 = dot2bf(xa.x, r0[i].x, d0); d1 = dot2bf(xa.y, r0[i].y, d1); d0 = dot2bf(xa.z, r0[i].z, d0); d1 = dot2bf(xa.w, r0[i].w, d1);
                    d0 = dot2bf(xb.x, r1[i].x, d0); d1 = dot2bf(xb.y, r1[i].y, d1); d0 = dot2bf(xb.z, r1[i].z, d0); d1 = dot2bf(xb.w, r1[i].w, d1);
                    part[hb * 8 + i] = d0 + d1;
                }
#endif
            }
            float dsum = red16(part, lane);
            const int kk = c * 16 + (lane >> 2);
            const int eme = __shfl(esel, kb + (lane >> 2), 64);
            float wv = GATEp[(size_t)t * HK + kk];
#if TAB_FP8
            dsum *= SU[eme];
            wv *= SV[eme];
#endif
            wv *= gelu_exact(dsum);
#pragma unroll
            for (int hb = 0; hb < 2; ++hb) {
#if TAB_FP8
                uint4 r[8];
#pragma unroll
                for (int i = 0; i < 8; ++i) { const int e = __builtin_amdgcn_readlane(esel, kb + hb * 8 + i); r[i] = *(const uint4*)(V + (size_t)e * 1024 + lane * 16); }
#pragma unroll
                for (int i = 0; i < 8; ++i) {
                    const float w = __int_as_float(__builtin_amdgcn_readlane(__float_as_int(wv), (hb * 8 + i) * 4));
                    const unsigned ww[4] = {r[i].x, r[i].y, r[i].z, r[i].w};
#pragma unroll
                    for (int q = 0; q < 4; ++q) {
                        const auto lo = __builtin_amdgcn_cvt_pk_f32_fp8((int)ww[q], false); const auto hh = __builtin_amdgcn_cvt_pk_f32_fp8((int)ww[q], true);
                        acc[4 * q] = fmaf(w, lo[0], acc[4 * q]); acc[4 * q + 1] = fmaf(w, lo[1], acc[4 * q + 1]); acc[4 * q + 2] = fmaf(w, hh[0], acc[4 * q + 2]); acc[4 * q + 3] = fmaf(w, hh[1], acc[4 * q + 3]);
                    }
                }
#else
                uint4 r0[8], r1[8];
#pragma unroll
                for (int i = 0; i < 8; ++i) { const int e = __builtin_amdgcn_readlane(esel, kb + hb * 8 + i); const unsigned char* rp = V + (size_t)e * 2048 + lane * 16; r0[i] = *(const uint4*)(rp); r1[i] = *(const uint4*)(rp + 1024); }
#pragma unroll
                for (int i = 0; i < 8; ++i) {
                    const float w = __int_as_float(__builtin_amdgcn_readlane(__float_as_int(wv), (hb * 8 + i) * 4));
                    acc[0] = fmaf(w, bflo(r0[i].x), acc[0]); acc[1] = fmaf(w, bfhi(r0[i].x), acc[1]); acc[2] = fmaf(w, bflo(r0[i].y), acc[2]); acc[3] = fmaf(w, bfhi(r0[i].y), acc[3]);
                    acc[4] = fmaf(w, bflo(r0[i].z), acc[4]); acc[5] = fmaf(w, bfhi(r0[i].z), acc[5]); acc[6] = fmaf(w, bflo(r0[i].w), acc[6]); acc[7] = fmaf(w, bfhi(r0[i].w), acc[7]);
                    acc[8] = fmaf(w, bflo(r1[i].x), acc[8]); acc[9] = fmaf(w, bfhi(r1[i].x), acc[9]); acc[10] = fmaf(w, bflo(r1[i].y), acc[10]); acc[11] = fmaf(w, bfhi(r1[i].y), acc[11]);
                    acc[12] = fmaf(w, bflo(r1[i].z), acc[12]); acc[13] = fmaf(w, bfhi(r1[i].z), acc[13]); acc[14] = fmaf(w, bflo(r1[i].w), acc[14]); acc[15] = fmaf(w, bfhi(r1[i].w), acc[15]);
                }
#endif
            }
        }
        float* hrow = P.out + (size_t)t * D;
#if TAB_FP8
        const int c0 = lane * 16, c1 = lane * 16 + 8;
#else
        const int c0 = lane * 8, c1 = 512 + lane * 8;
#endif
        float4 h0 = *(const float4*)(hrow + c0), h1 = *(const float4*)(hrow + c0 + 4), h2 = *(const float4*)(hrow + c1), h3 = *(const float4*)(hrow + c1 + 4);
        h0.x += acc[0]; h0.y += acc[1]; h0.z += acc[2]; h0.w += acc[3]; h1.x += acc[4]; h1.y += acc[5]; h1.z += acc[6]; h1.w += acc[7];
        h2.x += acc[8]; h2.y += acc[9]; h2.z += acc[10]; h2.w += acc[11]; h3.x += acc[12]; h3.y += acc[13]; h3.z += acc[14]; h3.w += acc[15];
        float ss = h0.x * h0.x + h0.y * h0.y + h0.z * h0.z + h0.w * h0.w + h1.x * h1.x + h1.y * h1.y + h1.z * h1.z + h1.w * h1.w
                 + h2.x * h2.x + h2.y * h2.y + h2.z * h2.z + h2.w * h2.w + h3.x * h3.x + h3.y * h3.y + h3.z * h3.z + h3.w * h3.w;
        ss = wave_sum(ss);
        const float rn = rsqrtf(ss * (1.f / D) + EPS);
        if (l == DEPTH - 1) {
            const float* g = P.norm_final;
            const float4 g0 = *(const float4*)(g + c0), g1 = *(const float4*)(g + c0 + 4), g2 = *(const float4*)(g + c1), g3 = *(const float4*)(g + c1 + 4);
            *(float4*)(hrow + c0) = make_float4(h0.x * rn * g0.x, h0.y * rn * g0.y, h0.z * rn * g0.z, h0.w * rn * g0.w);
            *(float4*)(hrow + c0 + 4) = make_float4(h1.x * rn * g1.x, h1.y * rn * g1.y, h1.z * rn * g1.z, h1.w * rn * g1.w);
            *(float4*)(hrow + c1) = make_float4(h2.x * rn * g2.x, h2.y * rn * g2.y, h2.z * rn * g2.z, h2.w * rn * g2.w);
            *(float4*)(hrow + c1 + 4) = make_float4(h3.x * rn * g3.x, h3.y * rn * g3.y, h3.z * rn * g3.z, h3.w * rn * g3.w);
        } else {
            *(float4*)(hrow + c0) = h0; *(float4*)(hrow + c0 + 4) = h1; *(float4*)(hrow + c1) = h2; *(float4*)(hrow + c1 + 4) = h3;
            const float* g = P.norm_mix + (l + 1) * D;
            const float4 g0 = *(const float4*)(g + c0), g1 = *(const float4*)(g + c0 + 4), g2 = *(const float4*)(g + c1), g3 = *(const float4*)(g + c1 + 4);
            uint4 o0, o1;
            o0.x = pack2(h0.x * rn * g0.x, h0.y * rn * g0.y); o0.y = pack2(h0.z * rn * g0.z, h0.w * rn * g0.w); o0.z = pack2(h1.x * rn * g1.x, h1.y * rn * g1.y); o0.w = pack2(h1.z * rn * g1.z, h1.w * rn * g1.w);
            o1.x = pack2(h2.x * rn * g2.x, h2.y * rn * g2.y); o1.y = pack2(h2.z * rn * g2.z, h2.w * rn * g2.w); o1.z = pack2(h3.x * rn * g3.x, h3.y * rn * g3.y); o1.w = pack2(h3.z * rn * g3.z, h3.w * rn * g3.w);
            *(uint4*)(XNw + (size_t)t * D + c0) = o0; *(uint4*)(XNw + (size_t)t * D + c1) = o1;
        }
    }
}


constexpr size_t WS_PART = WS_PROJ;
static_assert((size_t)8 * T * HK * 4 <= WS_K - WS_PROJ, "PART alias");
constexpr int XI_X = 0, XI_RANK = 1, XI_J = 2, XI_NX = 3, XI_NLOC = 4;
constexpr int CTL_CENSUS = 4096;
constexpr int CTL_BYTES = (CTL_CENSUS + 16) * 4;

__device__ __forceinline__ float dot16_fp8(const float (&xf)[16], const uint4& r) {
    float d0 = 0.f, d1 = 0.f;
    const unsigned w[4] = {r.x, r.y, r.z, r.w};
#pragma unroll
    for (int q = 0; q < 4; ++q) {
        const auto lo = __builtin_amdgcn_cvt_pk_f32_fp8((int)w[q], false); const auto hh = __builtin_amdgcn_cvt_pk_f32_fp8((int)w[q], true);
        d0 = fmaf(xf[4 * q], lo[0], d0); d1 = fmaf(xf[4 * q + 1], lo[1], d1); d0 = fmaf(xf[4 * q + 2], hh[0], d0); d1 = fmaf(xf[4 * q + 3], hh[1], d1);
    }
    return d0 + d1;
}
template <int M1, int M2, int M3, class TT>
__device__ __forceinline__ void red16x3(TT (&p)[16], int lane) {
#pragma unroll
    for (int i = 0; i < 8; ++i) { const bool up = lane & M1; const TT send = up ? p[i] : p[i + 8], keep = up ? p[i + 8] : p[i]; p[i] = keep + __shfl_xor(send, M1, 64); }
#pragma unroll
    for (int i = 0; i < 4; ++i) { const bool up = lane & M2; const TT send = up ? p[i] : p[i + 4], keep = up ? p[i + 4] : p[i]; p[i] = keep + __shfl_xor(send, M2, 64); }
#pragma unroll
    for (int i = 0; i < 2; ++i) { const bool up = lane & M3; const TT send = up ? p[i] : p[i + 2], keep = up ? p[i + 2] : p[i]; p[i] = keep + __shfl_xor(send, M3, 64); }
}
__device__ __forceinline__ void phase_gu(const Params& P, int l, const volatile int* xi) {
    const unsigned char* XQ = P.ws + WS_XQ;
    const float* XSc = (const float*)(P.ws + WS_XS);
    const int* EXPp = (const int*)(P.ws + WS_EXP);
    float* PART = (float*)(P.ws + WS_PART);
    const int tid = tidx(), lane = tid & 63, w = tid >> 6, g = lane >> 3, c = lane & 7;
    int xo_ = 0; asm volatile("" : "+v"(xo_));
    const int j = __builtin_amdgcn_readfirstlane(xi[xo_ + XI_J]), nx = __builtin_amdgcn_readfirstlane(xi[xo_ + XI_NX]), nloc = __builtin_amdgcn_readfirstlane(xi[xo_ + XI_NLOC]), rank = __builtin_amdgcn_readfirstlane(xi[xo_ + XI_RANK]);
    const int t0 = rank * 4 + w, st = nloc * 4;
    const int n = (t0 < T) ? (T - t0 + st - 1) / st : 0;
    const int i0 = 8 * (c & 1) + 4 * ((c >> 1) & 1) + 2 * ((c >> 2) & 1);
    for (int sl = j; sl < 8 && n > 0; sl += nx) {
        const unsigned char* Us = P.ws + WS_TABU + ((size_t)(l * 8 + sl) * NEXP) * 128;
        const unsigned co = (unsigned)c << 4;
        float* part = PART + (size_t)sl * T * HK;
        const unsigned char* xs = XQ + sl * 128 + c * 16;
#define GU_TK(k) (t0 + (((k) < n) ? (k) : (n - 1)) * st)
#define GU_LOADE(S, t) do { S##lo = EXPp[(size_t)(t) * HK + lane]; S##hi = EXPp[(size_t)(t) * HK + 64 + lane]; } while (0)
#define GU_LOADX(S, t) do { S##a = *(const uint4*)(xs + (size_t)(t) * D); S##s = XSc[t]; } while (0)
#define GU_ISSUE(R, S) do { _Pragma("unroll") for (int i = 0; i < 16; ++i) { \
            const int e = __builtin_amdgcn_ds_bpermute((((8 * i) & 63) + g) << 2, (i < 8) ? S##lo : S##hi); R[i] = *(const uint4*)(Us + (((unsigned)e << 7) | co)); } } while (0)
#define GU_FINISH(R, S, t) do { \
            int p[16]; \
            _Pragma("unroll") for (int i = 0; i < 16; ++i) { int d_ = __builtin_amdgcn_sdot4((int)S##a.x, (int)R[i].x, 0, false); d_ = __builtin_amdgcn_sdot4((int)S##a.y, (int)R[i].y, d_, false); \
                d_ = __builtin_amdgcn_sdot4((int)S##a.z, (int)R[i].z, d_, false); p[i] = __builtin_amdgcn_sdot4((int)S##a.w, (int)R[i].w, d_, false); } \
            red16x3<1, 2, 4, int>(p, lane); \
            part[(size_t)(t) * HK + 8 * i0 + g] = (float)p[0] * S##s; part[(size_t)(t) * HK + 8 * (i0 + 1) + g] = (float)p[1] * S##s; } while (0)
        int eAlo, eAhi, eBlo, eBhi; uint4 xAa, xBa; float xAs, xBs; uint4 rA[16], rB[16];
        GU_LOADE(eA, GU_TK(0)); GU_LOADX(xA, GU_TK(0)); GU_LOADE(eB, GU_TK(1));
        GU_ISSUE(rA, eA);
        for (int k = 0; k < n; k += 2) {
            GU_LOADX(xB, GU_TK(k + 1)); GU_ISSUE(rB, eB); GU_LOADE(eA, GU_TK(k + 2));
            GU_FINISH(rA, xA, GU_TK(k));
            GU_LOADX(xA, GU_TK(k + 2)); GU_ISSUE(rA, eA); GU_LOADE(eB, GU_TK(k + 3));
            GU_FINISH(rB, xB, GU_TK(k + 1));
        }
#undef GU_TK
#undef GU_LOADE
#undef GU_LOADX
#undef GU_ISSUE
#undef GU_FINISH
    }
}
__device__ __forceinline__ void phase_gw(const Params& P, int l) {
    const int* EXPp = (const int*)(P.ws + WS_EXP);
    const float* GATEp = (const float*)(P.ws + WS_GATE);
    const float* PART = (const float*)(P.ws + WS_PART);
    const float* SU = (const float*)(P.ws + WS_TSCU) + (size_t)l * NEXP;
    const float* SV = (const float*)(P.ws + WS_TSCV) + (size_t)l * NEXP;
    unsigned char* WQ = P.ws + WS_WQ8;
    float* WSC = (float*)(P.ws + WS_WSC);
    const int lane = tidx() & 63;
    for (int tb = gwave() * 4; tb < T; tb += nwave() * 4) {
        float wv[4][2];
#pragma unroll
        for (int q = 0; q < 4; ++q)
#pragma unroll
            for (int hk = 0; hk < 2; ++hk) {
                const size_t i = (size_t)(tb + q) * HK + hk * 64 + lane;
                float s = 0.f;
#pragma unroll
                for (int x = 0; x < 8; ++x) s += PART[(size_t)x * T * HK + i];
                const int e = EXPp[i];
                wv[q][hk] = GATEp[i] * gelu_exact(s * SU[e]) * SV[e];
            }
#pragma unroll
        for (int q = 0; q < 4; ++q) {
            float am = fmaxf(fabsf(wv[q][0]), fabsf(wv[q][1]));
#pragma unroll
            for (int m = 32; m >= 1; m >>= 1) am = fmaxf(am, __shfl_xor(am, m, 64));
            const float sc = (am > 0.f) ? am * (1.f / 448.f) : 1.f, is = 1.f / sc;
            const int pk = __builtin_amdgcn_cvt_pk_fp8_f32(wv[q][0] * is, wv[q][1] * is, 0, false);
            WQ[(size_t)(tb + q) * HK + lane] = (unsigned char)(pk & 255);
            WQ[(size_t)(tb + q) * HK + 64 + lane] = (unsigned char)((pk >> 8) & 255);
            if (lane == 0) WSC[tb + q] = sc;
        }
    }
}
typedef int v2i_t __attribute__((ext_vector_type(2)));
typedef unsigned u32x4_t __attribute__((ext_vector_type(4)));
typedef __attribute__((ext_vector_type(4))) float f32x4;
constexpr int GV_PIECE = 1024 + 16;
constexpr int GV_TILE = 16 * GV_PIECE;
static_assert(4 * GV_TILE + 4 * 512 <= LDS_TOTAL, "gv LDS");
__device__ __forceinline__ void phase_gv(const Params& P, int l, const volatile int* xi, char* lds) {
    const int* EXPp = (const int*)(P.ws + WS_EXP);
    const unsigned char* WQ = P.ws + WS_WQ8;
    const float* WSC = (const float*)(P.ws + WS_WSC);
    const int tid = tidx(), lane = tid & 63, w = __builtin_amdgcn_readfirstlane(tid >> 6), g = lane >> 3, pos = lane & 7;
    int xo_ = 0; asm volatile("" : "+v"(xo_));
    const int j = __builtin_amdgcn_readfirstlane(xi[xo_ + XI_J]), nx = __builtin_amdgcn_readfirstlane(xi[xo_ + XI_NX]), nloc = __builtin_amdgcn_readfirstlane(xi[xo_ + XI_NLOC]), rank = __builtin_amdgcn_readfirstlane(xi[xo_ + XI_RANK]);
    const int t0 = rank * 4 + w, st = nloc * 4;
    const int n = (t0 < T) ? (T - t0 + st - 1) / st : 0;
    char* tile = lds + w * GV_TILE;
    float* strip = (float*)(lds + 4 * GV_TILE) + w * 128;
    typedef __attribute__((address_space(3))) v2i_t* ldsv2_t;
    const unsigned co = (unsigned)(pos ^ g) << 4;
    const int rr = (lane & 15) >> 1, kq = lane >> 4;
    const int rdo = kq * GV_PIECE + rr * 128 + (lane & 1) * 8;
    const bool row0 = (lane & 15) == 0;
    __syncthreads();
    for (int sl = j; sl < 8 && n > 0; sl += nx) {
        const unsigned char* Vs = P.ws + WS_TABV + ((size_t)(l * 8 + sl) * NEXP) * 128;
        float* hrow = P.out + sl * 128 + 2 * lane;
#define GV_TK(k) (t0 + (((k) < n) ? (k) : (n - 1)) * st)
#define GV_LOADE(S, t) do { S##el = EXPp[(size_t)(t) * HK + lane]; S##eh = EXPp[(size_t)(t) * HK + 64 + lane]; } while (0)
#define GV_ISSUE(R, S) do { _Pragma("unroll") for (int i = 0; i < 16; ++i) { \
            const int e = __builtin_amdgcn_ds_bpermute((((8 * i) & 63) + g) << 2, (i < 8) ? S##el : S##eh); R[i] = *(const u32x4_t*)(Vs + (((unsigned)e << 7) | co)); } } while (0)
#define GV_LOADT(S, kk) do { const int t_ = GV_TK(kk); \
            S##a0 = 0; S##a1 = 0; S##a2 = 0; S##a3 = 0; \
            if (row0) { const long* wp = (const long*)(WQ + (size_t)t_ * HK + kq * 8); S##a0 = wp[0]; S##a1 = wp[4]; S##a2 = wp[8]; S##a3 = wp[12]; } \
            S##ws = ((kk) < n) ? WSC[t_] : 0.f; \
            S##hv = *(const float2*)(hrow + (size_t)t_ * D); } while (0)
#define GV_TOKEN(R, S, kk) do { \
            const int t = GV_TK(kk); \
            _Pragma("unroll") for (int i = 0; i < 16; ++i) *(u32x4_t*)(tile + i * GV_PIECE + lane * 16) = R[i]; \
            f32x4 acc[8]; \
            _Pragma("unroll") for (int nt = 0; nt < 8; ++nt) acc[nt] = (f32x4){0.f, 0.f, 0.f, 0.f}; \
            _Pragma("unroll") for (int s4 = 0; s4 < 4; ++s4) { \
                const long av = (s4 == 0) ? S##a0 : (s4 == 1) ? S##a1 : (s4 == 2) ? S##a2 : S##a3; \
                _Pragma("unroll") for (int nt = 0; nt < 8; ++nt) { \
                    const v2i_t bv = __builtin_amdgcn_ds_read_tr8_b64_v2i32((ldsv2_t)(void*)(tile + (4 * s4) * GV_PIECE + rdo + ((nt ^ rr) << 4))); \
                    acc[nt] = __builtin_amdgcn_mfma_f32_16x16x32_fp8_fp8(av, __builtin_bit_cast(long, bv), acc[nt], 0, 0, 0); } } \
            if (lane < 16) { _Pragma("unroll") for (int nt = 0; nt < 8; ++nt) strip[16 * nt + lane] = acc[nt][0]; }        \
            { const float2 o2 = *(const float2*)(strip + 2 * lane); \
              if ((kk) < n) *(float2*)(hrow + (size_t)t * D) = make_float2(S##hv.x + S##ws * o2.x, S##hv.y + S##ws * o2.y); } } while (0)
        int Ael, Aeh, Bel, Beh; u32x4_t rA[16], rB[16];
        long Pa0, Pa1, Pa2, Pa3, Qa0, Qa1, Qa2, Qa3; float Pws, Qws; float2 Phv, Qhv;
        GV_LOADE(A, GV_TK(0)); GV_LOADE(B, GV_TK(1));
        GV_ISSUE(rA, A); GV_LOADT(P, 0);
        for (int k = 0; k < n; k += 2) {
            GV_ISSUE(rB, B); GV_LOADE(A, GV_TK(k + 2)); GV_LOADT(Q, k + 1);
            GV_TOKEN(rA, P, k);
            GV_ISSUE(rA, A); GV_LOADE(B, GV_TK(k + 3)); GV_LOADT(P, k + 2);
            GV_TOKEN(rB, Q, k + 1);
        }
#undef GV_TK
#undef GV_LOADE
#undef GV_ISSUE
#undef GV_LOADT
#undef GV_TOKEN
    }
    __syncthreads();
}
__device__ __forceinline__ void phase_gnorm(const Params& P, int l) {
    const int lane = tidx() & 63;
    bf16* XNw = (bf16*)(P.ws + WS_XN);
    for (int t = gwave(); t < T; t += nwave()) {
        float4* hr = (float4*)(P.out + (size_t)t * D);
        float4 v[4]; float ss = 0.f;
#pragma unroll
        for (int q = 0; q < 4; ++q) { v[q] = hr[q * 64 + lane]; ss += v[q].x * v[q].x + v[q].y * v[q].y + v[q].z * v[q].z + v[q].w * v[q].w; }
        ss = wave_sum(ss);
        const float rn = rsqrtf(ss * (1.f / D) + EPS);
        const float4* g = (const float4*)((l == DEPTH - 1) ? P.norm_final : (P.norm_mix + (l + 1) * D));
#pragma unroll
        for (int q = 0; q < 4; ++q) {
            const float4 gg = g[q * 64 + lane];
            const float4 o = make_float4(v[q].x * rn * gg.x, v[q].y * rn * gg.y, v[q].z * rn * gg.z, v[q].w * rn * gg.w);
            if (l == DEPTH - 1) hr[q * 64 + lane] = o;
            else { uint2 u; u.x = pack2(o.x, o.y); u.y = pack2(o.z, o.w); ((uint2*)(XNw + (size_t)t * LDX))[q * 64 + lane] = u; }
        }
    }
}

#define XB_TMO      128
#define XB_XCNT(j)  (256  + 64 * (j))
#define XB_XSUB(j)  (1280 + 64 * (j))
#define XB_XGEN(j)  (2304 + 64 * (j))
#define XB_TOP      3328
#define XB_TOPGEN   3392
#define XCD_BAR_WORDS 3456
#define XB_SPIN_CAP (1u << 22)
#define LAS __attribute__((address_space(3)))
__device__ __forceinline__ unsigned xb_ld(unsigned* p)              { return __hip_atomic_load(p, __ATOMIC_RELAXED, __HIP_MEMORY_SCOPE_AGENT); }
__device__ __forceinline__ unsigned xb_add(unsigned* p, unsigned v) { return __hip_atomic_fetch_add(p, v, __ATOMIC_RELAXED, __HIP_MEMORY_SCOPE_AGENT); }
__device__ __forceinline__ unsigned xb_xcc_id() { return (unsigned)__builtin_amdgcn_s_getreg((3 << 11) | 20) & 0xFu; }
#define XB_SPIN(cond, bar) do { unsigned _sp = 0; while (cond) { __builtin_amdgcn_s_sleep(1); \
    if ((++_sp & 255u) == 0u) { if (xb_ld(&(bar)[XB_TMO])) break; if (_sp > XB_SPIN_CAP) { atomicAdd(&(bar)[XB_TMO], 1u); break; } } } } while (0)
struct XcdBarrier { unsigned* bar; unsigned x; volatile LAS unsigned* st; };
__device__ __forceinline__ XcdBarrier xcd_barrier_post(unsigned* bar, volatile LAS unsigned* st) {
    XcdBarrier b; b.bar = bar; b.x = xb_xcc_id(); b.st = st;
    if (__builtin_amdgcn_workitem_id_x() == 0) (void)xb_add(&bar[XB_XCNT(b.x)], 1u);
    return b;
}
__device__ __forceinline__ void xcd_barrier_complete(unsigned* bar, unsigned x, unsigned& nloc, unsigned& nx) {
    const unsigned G = gridDim.x * gridDim.y * gridDim.z;
    unsigned sum, cnt, mine, sp = 0u;
    for (;;) {
        sum = 0u; cnt = 0u; mine = 0u;
#pragma unroll
        for (unsigned j = 0; j < 16; ++j) { const unsigned c = xb_ld(&bar[XB_XCNT(j)]); sum += c; cnt += (c > 0u) ? 1u : 0u; mine = (j == x) ? c : mine; }
        if (sum == G) break;
        __builtin_amdgcn_s_sleep(1);
        if ((++sp & 255u) == 0u) { if (xb_ld(&bar[XB_TMO])) break; if (sp > XB_SPIN_CAP) { atomicAdd(&bar[XB_TMO], 1u); break; } }
    }
    nloc = mine > 0u ? mine : 1u; nx = cnt > 0u ? cnt : 1u;
}
__device__ __forceinline__ void xcd_barrier(const XcdBarrier& b) {
    asm volatile("s_waitcnt vmcnt(0)" ::: "memory");
    __syncthreads();
    if (__builtin_amdgcn_workitem_id_x() == 0) {
        unsigned* bar = b.bar;
        __builtin_amdgcn_s_waitcnt(0);
        unsigned nloc = b.st[0], nx = b.st[1];
        if (nloc == 0u) { xcd_barrier_complete(bar, b.x, nloc, nx); b.st[0] = nloc; b.st[1] = nx; }
        const unsigned old = xb_add(&bar[XB_XSUB(b.x)], 1u);
        const unsigned gen = old / nloc;
        if (old + 1u == (gen + 1u) * nloc) {
            __builtin_amdgcn_fence(__ATOMIC_RELEASE, "agent");
            asm volatile("s_waitcnt vmcnt(0)" ::: "memory");
            const unsigned og = xb_add(&bar[XB_TOP], 1u);
            const unsigned tg = og / nx;
            if (og + 1u == (tg + 1u) * nx) xb_add(&bar[XB_TOPGEN], 1u);
            else XB_SPIN(xb_ld(&bar[XB_TOPGEN]) == tg, bar);
            __builtin_amdgcn_fence(__ATOMIC_ACQUIRE, "agent");
            xb_add(&bar[XB_XGEN(b.x)], 1u);
            asm volatile("s_waitcnt vmcnt(0)" ::: "memory");
        } else {
            XB_SPIN(xb_ld(&bar[XB_XGEN(b.x)]) == gen, bar);
            __builtin_amdgcn_fence(__ATOMIC_ACQUIRE, "agent");
            asm volatile("s_waitcnt vmcnt(0)" ::: "memory");
        }
    }
    __syncthreads();
}

constexpr float QSCALE = 0.10206207261596575f * 1.4426950408889634f;

__device__ __forceinline__ void phase_gemm1(const Params& P, int l, char* lds) {
    unsigned char* ws = P.ws;
    const bf16* XN = (const bf16*)(ws + WS_XN);
    bf16* PROJ = (bf16*)(ws + WS_PROJ);
    bf16* Kb = (bf16*)(ws + WS_K);
    const float* rope = (const float*)(ws + WS_ROPE);
    const bf16* W = (const bf16*)(ws + WS_WIN) + (size_t)l * DINP * LDW;
    gemm_t<false>(W, LDW, DINP, XN, LDX, T, D, C_KR / 128, [&](int n0, int t0, const f32x16& acc, int r32, int hi, float) {
        const int t = t0 + r32;
        if (n0 < C_KR) {
            bf16* pr = PROJ + (size_t)t * DINP + n0 + 4 * hi;
#pragma unroll
            for (int g = 0; g < 4; ++g) { uint2 o; o.x = cvtpk(acc[4 * g], acc[4 * g + 1]); o.y = cvtpk(acc[4 * g + 2], acc[4 * g + 3]); *(uint2*)(pr + 8 * g) = o; }
        } else if (n0 == C_KR) {
            const int b = t / S, s = t % S;
            uint2 o1[2], o2[2];
#pragma unroll
            for (int g = 0; g < 2; ++g) {
                const float4 cs0 = *(const float4*)(rope + ((size_t)s * 16 + 8 * g + 4 * hi) * 2), cs1 = *(const float4*)(rope + ((size_t)s * 16 + 8 * g + 4 * hi) * 2 + 4);
                const float x10 = acc[4 * g], x11 = acc[4 * g + 1], x12 = acc[4 * g + 2], x13 = acc[4 * g + 3];
                const float x20 = acc[8 + 4 * g], x21 = acc[8 + 4 * g + 1], x22 = acc[8 + 4 * g + 2], x23 = acc[8 + 4 * g + 3];
                o1[g].x = cvtpk(x10 * cs0.x - x20 * cs0.y, x11 * cs0.z - x21 * cs0.w); o1[g].y = cvtpk(x12 * cs1.x - x22 * cs1.y, x13 * cs1.z - x23 * cs1.w);
                o2[g].x = cvtpk(x20 * cs0.x + x10 * cs0.y, x21 * cs0.z + x11 * cs0.w); o2[g].y = cvtpk(x22 * cs1.x + x12 * cs1.y, x23 * cs1.z + x13 * cs1.w);
            }
#pragma unroll
            for (int h = 0; h < NH; ++h) {
                bf16* kr = Kb + ((size_t)(b * NH + h) * S + s) * DQK + 64 + 4 * hi;
                *(uint2*)(kr) = o1[0]; *(uint2*)(kr + 8) = o1[1]; *(uint2*)(kr + 16) = o2[0]; *(uint2*)(kr + 24) = o2[1];
            }
        }
    }, [&](int t, int n, const float4& v) {
        uint2 o; o.x = cvtpk(v.x, v.y); o.y = cvtpk(v.z, v.w);
        *(uint2*)(PROJ + (size_t)t * DINP + n) = o;
    }, [](float) { return 1.f; }, lds);
}
__device__ __forceinline__ void phase_gemm2(const Params& P, int l, char* lds) {
    unsigned char* ws = P.ws;
    const bf16* PROJ = (const bf16*)(ws + WS_PROJ);
    const float* rope = (const float*)(ws + WS_ROPE);
    const int lane = tidx() & 63;
    {
        const bf16* W = (const bf16*)(ws + WS_WUQ) + (size_t)l * 768 * QR;
        bf16* Qb = (bf16*)(ws + WS_Q);
        gemm_t<true>(W, QR, 768, PROJ + C_CQ, DINP, T, QR, 768 / 128, [](int, int, const f32x16&, int, int, float) {},
            [&](int t, int n, const float4& v) {
                const int b = t / S, s = t % S, h = n / DQK, d = n % DQK;
                float4 o = v;
                const float4 up = make_float4(__shfl(v.x, lane + 4, 64), __shfl(v.y, lane + 4, 64), __shfl(v.z, lane + 4, 64), __shfl(v.w, lane + 4, 64));
                const float4 dn = make_float4(__shfl(v.x, lane - 4, 64), __shfl(v.y, lane - 4, 64), __shfl(v.z, lane - 4, 64), __shfl(v.w, lane - 4, 64));
                if (d >= 64) {
                    const bool first = d < 80;
                    const int f = first ? (d - 64) : (d - 80);
                    const float4 cs0 = *(const float4*)(rope + ((size_t)s * 16 + f) * 2), cs1 = *(const float4*)(rope + ((size_t)s * 16 + f) * 2 + 4);
                    if (first) o = make_float4(v.x * cs0.x - up.x * cs0.y, v.y * cs0.z - up.y * cs0.w, v.z * cs1.x - up.z * cs1.y, v.w * cs1.z - up.w * cs1.w);
                    else       o = make_float4(v.x * cs0.x + dn.x * cs0.y, v.y * cs0.z + dn.y * cs0.w, v.z * cs1.x + dn.z * cs1.y, v.w * cs1.z + dn.w * cs1.w);
                }
                uint2 u; u.x = cvtpk(o.x, o.y); u.y = cvtpk(o.z, o.w);
                *(uint2*)(Qb + ((size_t)(b * NH + h) * S + s) * DQK + d) = u;
            }, [](float ssq) { return rsqrtf(ssq * (1.f / QR) + EPS) * QSCALE; }, lds);
    }
    {
        const bf16* W = (const bf16*)(ws + WS_WUKV) + (size_t)l * 1024 * KVR;
        bf16* Kb = (bf16*)(ws + WS_K); bf16* Vb = (bf16*)(ws + WS_V);
        gemm_t<true>(W, KVR, 1024, PROJ + C_CKV, DINP, T, KVR, 1024 / 128, [](int, int, const f32x16&, int, int, float) {},
            [&](int t, int n, const float4& v) {
                const int b = t / S, s = t % S;
                uint2 u; u.x = cvtpk(v.x, v.y); u.y = cvtpk(v.z, v.w);
                if (n < 512) *(uint2*)(Kb + ((size_t)(b * NH + (n >> 6)) * S + s) * DQK + (n & 63)) = u;
                else         *(uint2*)(Vb + ((size_t)(b * NH + ((n - 512) >> 6)) * S + s) * DV + (n & 63)) = u;
            }, [](float ssq) { return rsqrtf(ssq * (1.f / KVR) + EPS); }, lds);
    }
}
__device__ __forceinline__ void phase_gemm3(const Params& P, int l, char* lds) {
    unsigned char* ws = P.ws;
    const bf16* Yb = (const bf16*)(ws + WS_XN);
    const bf16* W = (const bf16*)(ws + WS_WOUT) + (size_t)l * D * LDW;
    const float* hin = (l == 0) ? P.x : P.out;
    float* out = P.out;
    gemm_t<false>(W, LDW, D, Yb, LDX, T, D, D / 128, [](int, int, const f32x16&, int, int, float) {}, [&](int t, int n, const float4& v) {
        const size_t idx = (size_t)t * D + n;
        const float4 hv = *(const float4*)(hin + idx);
        *(float4*)(out + idx) = make_float4(hv.x + v.x, hv.y + v.y, hv.z + v.z, hv.w + v.w);
    }, [](float) { return 1.f; }, lds);
}

#define GSYNC() do { XcdBarrier xb_; { __attribute__((address_space(1))) char* gp_ = (__attribute__((address_space(1))) char*)(char*)(P.ws + WS_CTL); asm volatile("" : "+s"(gp_)); xb_.bar = (unsigned*)(char*)gp_; } \
    xb_.x = xb_xcc_id(); xb_.st = (volatile LAS unsigned*)&xb_words; xcd_barrier(xb_); } while (0)
#define PHASE(stmt) { const Params Q = launder(P); stmt; }
__global__ void __launch_bounds__(NTHREADS, 2) k_all(Params P) {
    __shared__ __attribute__((aligned(16))) char sm[LDS_TOTAL];
    __shared__ uint4 xb_words;
    cg::grid_group grid = cg::this_grid();
    if (__builtin_amdgcn_workitem_id_x() == 0) xb_words = make_uint4(0u, 0u, 0u, 0u);
    __syncthreads();
    (void)xcd_barrier_post((unsigned*)(P.ws + WS_CTL), (volatile LAS unsigned*)&xb_words);
    __shared__ int xinfo[8];
    if (__builtin_amdgcn_workitem_id_x() == 0) {
        const unsigned x = xb_xcc_id();
        xinfo[XI_X] = (int)x; xinfo[XI_RANK] = (int)xb_add((unsigned*)(P.ws + WS_CTL) + CTL_CENSUS + x, 1u);
    }
    PHASE(phase_prep(Q, sm));
    PHASE(phase_norm(Q.x, Q.norm_mix, (bf16*)(Q.ws + WS_XN)));
    if (P.ws == nullptr) grid.sync();
    GSYNC();
    if (__builtin_amdgcn_workitem_id_x() == 0) {
        unsigned* cen = (unsigned*)(P.ws + WS_CTL) + CTL_CENSUS;
        const int x = xinfo[XI_X]; int nx = 0, jj = 0;
        for (int q = 0; q < 16; ++q) { const unsigned cq = xb_ld(cen + q); if (cq) { if (q < x) ++jj; ++nx; } }
        xinfo[XI_J] = jj; xinfo[XI_NX] = nx; xinfo[XI_NLOC] = (int)xb_ld(cen + x);
    }
    __syncthreads();
    for (int l = 0; l < DEPTH; ++l) {
        PHASE(phase_gemm1(Q, l, sm));
#if PROBE_DUP & 2
        PHASE(phase_gemm1(Q, l, sm));
#endif
        GSYNC();
        PHASE(phase_mixlocal(Q, l, sm));
#if PROBE_DUP & 256
        PHASE(phase_mixlocal(Q, l, sm));
#endif
        PHASE(phase_gemm2(Q, l, sm));
        GSYNC();
        PHASE(phase_attn(Q, sm));
        GSYNC();
        PHASE(phase_gemm3(Q, l, sm));
#if PROBE_DUP & 16
        if (l == 0) PHASE(phase_gemm3(Q, l, sm));
#endif
        GSYNC();
        PHASE(phase_norm_q(Q, l));
        GSYNC();
        PHASE(phase_route(Q, l, sm));
        GSYNC();
        PHASE(phase_gu(Q, l, xinfo));
        GSYNC();
        PHASE(phase_gw(Q, l));
        GSYNC();
        PHASE(phase_gv(Q, l, xinfo, sm));
        GSYNC();
        PHASE(phase_gnorm(Q, l));
        GSYNC();
    }
}

extern "C" void kernel_launch(void* const* d_in, const int* in_sizes, int n_in, void* d_out, int out_size, void* d_ws, size_t ws_size, hipStream_t stream) {
    static int grid = 0;
    if (grid == 0) {
        if (n_in != 18 || out_size != T * D || ws_size < WS_END) { fprintf(stderr, "kernel_launch: bad sizes n_in %d out %d ws %zu need %zu\n", n_in, out_size, ws_size, (size_t)WS_END); grid = -1; return; }
        int dev = 0, cus = 0, per_cu = 0;
        (void)hipGetDevice(&dev);
        (void)hipDeviceGetAttribute(&cus, hipDeviceAttributeMultiprocessorCount, dev);
        (void)hipOccupancyMaxActiveBlocksPerMultiprocessor(&per_cu, (const void*)k_all, NTHREADS, 0);
        if (per_cu > 2) per_cu = 2;
        if (per_cu < 1) { fprintf(stderr, "kernel_launch: occupancy query says %d\n", per_cu); grid = -1; return; }
        grid = cus * per_cu;
    }
    if (grid < 0) return;
    Params p{};
    p.x = (const float*)d_in[0]; p.norm_mix = (const float*)d_in[1]; p.w_in = (const float*)d_in[2]; p.conv_w = (const float*)d_in[3];
    p.pool_w = (const float*)d_in[4]; p.pool_scale = (const float*)d_in[5]; p.q_norm = (const float*)d_in[6]; p.w_uq = (const float*)d_in[7];
    p.kv_norm = (const float*)d_in[8]; p.w_uk = (const float*)d_in[9]; p.w_uv = (const float*)d_in[10]; p.w_out = (const float*)d_in[11];
    p.norm_ffn = (const float*)d_in[12]; p.peer_wq = (const float*)d_in[13]; p.peer_subkeys = (const float*)d_in[14]; p.peer_u = (const float*)d_in[15];
    p.peer_v = (const float*)d_in[16]; p.norm_final = (const float*)d_in[17];
    p.out = (float*)d_out; p.ws = (unsigned char*)d_ws;
    if (hipMemsetAsync((char*)d_ws + WS_CTL, 0, CTL_BYTES, stream) != hipSuccess) { fprintf(stderr, "kernel_launch: memset failed\n"); return; }
    void* args[] = {&p};
    hipError_t e = hipLaunchCooperativeKernel((const void*)k_all, dim3(grid), dim3(NTHREADS), args, 0, stream);
    if (e != hipSuccess) fprintf(stderr, "cooperative launch failed: %s (grid %d)\n", hipGetErrorString(e), grid);
}
```

```cpp
#include <hip/hip_runtime.h>
#include <hip/hip_cooperative_groups.h>
#include <cstdio>
#include <cstdint>
namespace cg = cooperative_groups;

#ifndef TAB_FP8
#define TAB_FP8 1
#endif
#ifndef PROBE_DUP
#define PROBE_DUP 0
#endif

constexpr int NB = 4, S = 8192, T = NB * S, D = 1024, DEPTH = 2;
constexpr int DIN = 1696, DINP = 1792;
constexpr int C_BG = 0, C_CG = 256, C_HC = 512, C_HP = 768, C_CQ = 1024, C_CKV = 1408, C_KR = 1664;
constexpr int QR = 384, KVR = 256, NH = 8, DQK = 96, DV = 64;
constexpr int PH = 8, NKEY = 128, NEXP = NKEY * NKEY, TOPK = 16, HK = PH * TOPK;
constexpr float EPS = 1e-6f;
constexpr int LDX = 1088;
constexpr int LDW = 1088;

typedef unsigned short bf16;

constexpr size_t WS_CTL   = 0;
constexpr size_t WS_ROPE  = 64 * 1024;
constexpr size_t WS_WIN   = WS_ROPE + (size_t)S * 16 * 2 * 4;
constexpr size_t WS_WUQ   = WS_WIN + (size_t)DEPTH * DINP * LDW * 2;
constexpr size_t WS_WUKV  = WS_WUQ + (size_t)DEPTH * 768 * QR * 2;
constexpr size_t WS_WOUT  = WS_WUKV + (size_t)DEPTH * 1024 * KVR * 2;
constexpr size_t WS_WPQ   = WS_WOUT + (size_t)DEPTH * D * LDW * 2;
constexpr size_t WS_XN    = ((WS_WPQ + (size_t)DEPTH * 2048 * LDW * 2 + 4095) / 4096) * 4096;
constexpr size_t WS_PROJ  = WS_XN + (size_t)T * LDX * 2;
constexpr size_t WS_Q     = WS_PROJ + (size_t)T * DINP * 2;
constexpr size_t WS_K     = WS_Q + (size_t)T * NH * DQK * 2;
constexpr size_t WS_V     = WS_K + (size_t)T * NH * DQK * 2;
constexpr size_t WS_EXP   = WS_V + (size_t)T * NH * DV * 2;
constexpr size_t WS_GATE  = WS_EXP + (size_t)T * HK * 4;
constexpr size_t TAB_ROWB = TAB_FP8 ? 1024 : 2048;
constexpr size_t WS_TABU  = WS_GATE + (size_t)T * HK * 4;
constexpr size_t WS_TABV  = WS_TABU + (size_t)DEPTH * NEXP * TAB_ROWB;
constexpr size_t WS_TSCU  = WS_TABV + (size_t)DEPTH * NEXP * TAB_ROWB;
constexpr size_t WS_TSCV  = WS_TSCU + (size_t)DEPTH * NEXP * 4;
constexpr size_t WS_XQ    = WS_TSCV + (size_t)DEPTH * NEXP * 4;
constexpr size_t WS_XS    = WS_XQ + (size_t)T * D;
constexpr size_t WS_WQ8   = WS_XS + (size_t)T * 4;
constexpr size_t WS_WSC   = WS_WQ8 + (size_t)T * HK;
constexpr size_t WS_END   = WS_WSC + (size_t)T * 4;
static_assert(WS_END <= (size_t)512 * 1024 * 1024, "workspace budget");

struct Params {
    const float* x; const float* norm_mix; const float* w_in; const float* conv_w; const float* pool_w; const float* pool_scale;
    const float* q_norm; const float* w_uq; const float* kv_norm; const float* w_uk; const float* w_uv; const float* w_out;
    const float* norm_ffn; const float* peer_wq; const float* peer_subkeys; const float* peer_u; const float* peer_v; const float* norm_final;
    float* out; unsigned char* ws;
};

__device__ __forceinline__ bf16 f2bf(float f) { unsigned u = __float_as_uint(f); u += 0x7fffu + ((u >> 16) & 1u); return (bf16)(u >> 16); }
__device__ __forceinline__ float bf2f(bf16 h) { return __uint_as_float(((unsigned)h) << 16); }
__device__ __forceinline__ float bflo(unsigned u) { return __uint_as_float(u << 16); }
__device__ __forceinline__ float bfhi(unsigned u) { return __uint_as_float(u & 0xffff0000u); }
__device__ __forceinline__ unsigned pack2(float a, float b) { return (unsigned)f2bf(a) | ((unsigned)f2bf(b) << 16); }
__device__ __forceinline__ float wave_sum(float v) {
#pragma unroll
    for (int m = 32; m >= 1; m >>= 1) v += __shfl_xor(v, m, 64);
    return v;
}
__device__ __forceinline__ float gelu_exact(float x) { return 0.5f * x * (1.f + erff(x * 0.70710678118654752f)); }

#define NTHREADS 256
__device__ __forceinline__ int tidx() { int t = (int)__builtin_amdgcn_workitem_id_x(); asm volatile("" : "+v"(t)); return t; }
__device__ __forceinline__ int gwave() { return blockIdx.x * (NTHREADS / 64) + (tidx() >> 6); }
__device__ __forceinline__ int nwave() { return gridDim.x * (NTHREADS / 64); }
__device__ __forceinline__ size_t gtid() { return (size_t)blockIdx.x * NTHREADS + tidx(); }
__device__ __forceinline__ size_t gnth() { return (size_t)gridDim.x * NTHREADS; }


__device__ __forceinline__ Params launder(const Params& P) {
    typedef __attribute__((address_space(1))) char* gp_t;
    gp_t g[20] = {(gp_t)(char*)P.x, (gp_t)(char*)P.norm_mix, (gp_t)(char*)P.w_in, (gp_t)(char*)P.conv_w, (gp_t)(char*)P.pool_w, (gp_t)(char*)P.pool_scale, (gp_t)(char*)P.q_norm, (gp_t)(char*)P.w_uq,
                  (gp_t)(char*)P.kv_norm, (gp_t)(char*)P.w_uk, (gp_t)(char*)P.w_uv, (gp_t)(char*)P.w_out, (gp_t)(char*)P.norm_ffn, (gp_t)(char*)P.peer_wq, (gp_t)(char*)P.peer_subkeys,
                  (gp_t)(char*)P.peer_u, (gp_t)(char*)P.peer_v, (gp_t)(char*)P.norm_final, (gp_t)(char*)P.out, (gp_t)(char*)P.ws};
    asm volatile("" : "+s"(g[0]), "+s"(g[1]), "+s"(g[2]), "+s"(g[3]), "+s"(g[4]), "+s"(g[5]), "+s"(g[6]), "+s"(g[7]), "+s"(g[8]), "+s"(g[9]));
    asm volatile("" : "+s"(g[10]), "+s"(g[11]), "+s"(g[12]), "+s"(g[13]), "+s"(g[14]), "+s"(g[15]), "+s"(g[16]), "+s"(g[17]), "+s"(g[18]), "+s"(g[19]));
    Params Q;
    Q.x = (const float*)(char*)g[0]; Q.norm_mix = (const float*)(char*)g[1]; Q.w_in = (const float*)(char*)g[2]; Q.conv_w = (const float*)(char*)g[3]; Q.pool_w = (const float*)(char*)g[4];
    Q.pool_scale = (const float*)(char*)g[5]; Q.q_norm = (const float*)(char*)g[6]; Q.w_uq = (const float*)(char*)g[7]; Q.kv_norm = (const float*)(char*)g[8]; Q.w_uk = (const float*)(char*)g[9];
    Q.w_uv = (const float*)(char*)g[10]; Q.w_out = (const float*)(char*)g[11]; Q.norm_ffn = (const float*)(char*)g[12]; Q.peer_wq = (const float*)(char*)g[13]; Q.peer_subkeys = (const float*)(char*)g[14];
    Q.peer_u = (const float*)(char*)g[15]; Q.peer_v = (const float*)(char*)g[16]; Q.norm_final = (const float*)(char*)g[17]; Q.out = (float*)(char*)g[18]; Q.ws = (unsigned char*)(char*)g[19];
    return Q;
}

typedef __attribute__((ext_vector_type(8))) short bf16x8;
typedef __attribute__((ext_vector_type(16))) float f32x16;
typedef __attribute__((ext_vector_type(2))) __bf16 bf2_t;
#define MFMA32(a, b, c) __builtin_amdgcn_mfma_f32_32x32x16_bf16(a, b, c, 0, 0, 0)
__device__ __forceinline__ int crow(int r, int hi) { return (r & 3) + 8 * (r >> 2) + 4 * hi; }
__device__ __forceinline__ float dot2bf(unsigned a, unsigned b, float c) { return __builtin_amdgcn_fdot2_f32_bf16(__builtin_bit_cast(bf2_t, a), __builtin_bit_cast(bf2_t, b), c, false); }
__device__ __forceinline__ unsigned cvtpk(float lo, float hi) { unsigned r; asm("v_cvt_pk_bf16_f32 %0, %1, %2" : "=v"(r) : "v"(lo), "v"(hi)); return r; }
constexpr int G_OPB = 128 * 128;
constexpr int G_BUF = 2 * G_OPB;
constexpr int GEMM_LDS = 2 * G_BUF;
constexpr int LDS_TOTAL = GEMM_LDS + 8192;

template <int WT, bool ROWSS>
__device__ __forceinline__ void gemm_kloop(const bf16* __restrict__ Ag0, int lda, const bf16* __restrict__ Bg0, int ldb, int nk, f32x16 (&acc)[4], float (&ss)[4], char* lds, int tid) {
    const int lane = tid & 63, w = __builtin_amdgcn_readfirstlane(tid >> 6), r32 = lane & 31, hi = lane >> 5;
    const int srow = 8 * w + (lane >> 3);
    const int sch = (lane & 7) ^ ((srow >> 1) & 7);
    const bf16* Ag = Ag0 + (size_t)srow * lda + sch * 8;
    const bf16* Bg = Bg0 + (size_t)srow * ldb + sch * 8;
#pragma unroll
    for (int i = 0; i < 4; ++i)
#pragma unroll
        for (int r = 0; r < 16; ++r) acc[i][r] = 0.f;
    ss[0] = 0.f; ss[1] = 0.f; ss[2] = 0.f; ss[3] = 0.f;
    typedef __attribute__((address_space(3))) unsigned* ldsp_t;
    typedef const __attribute__((address_space(1))) unsigned* glbp_t;
#define G_DMA(buf, kofs) do { char* d_ = lds + (buf) * G_BUF + (8 * w) * 128; \
    _Pragma("unroll") for (int i = 0; i < 4; ++i) { \
        __builtin_amdgcn_global_load_lds((glbp_t)(const void*)(Ag + (size_t)(32 * i) * lda + (kofs)), (ldsp_t)(void*)(d_ + i * 4096), 16, 0, 0); \
        __builtin_amdgcn_global_load_lds((glbp_t)(const void*)(Bg + (size_t)(32 * i) * ldb + (kofs)), (ldsp_t)(void*)(d_ + G_OPB + i * 4096), 16, 0, 0); } } while (0)
    const int xr = (r32 >> 1) & 7;
    const int o0 = ((0 + hi) ^ xr) << 4, o1 = ((2 + hi) ^ xr) << 4, o2 = ((4 + hi) ^ xr) << 4, o3 = ((6 + hi) ^ xr) << 4;
#define G_SS(s_, r_) do { union { bf16x8 v; uint4 u; } c_; c_.v = r_; s_ = dot2bf(c_.u.x, c_.u.x, s_); s_ = dot2bf(c_.u.y, c_.u.y, s_); s_ = dot2bf(c_.u.z, c_.u.z, s_); s_ = dot2bf(c_.u.w, c_.u.w, s_); } while (0)
#define G_STEP(pa, pb, off) do { \
    if (WT == 0) { \
        const bf16x8 a0 = *(const bf16x8*)(pa + off), a1 = *(const bf16x8*)(pa + 32 * 128 + off); \
        const bf16x8 b0 = *(const bf16x8*)(pb + off), b1 = *(const bf16x8*)(pb + 32 * 128 + off); \
        if (ROWSS) { G_SS(ss[0], b0); G_SS(ss[1], b1); } \
        acc[0] = MFMA32(a0, b0, acc[0]); acc[1] = MFMA32(a0, b1, acc[1]); \
        acc[2] = MFMA32(a1, b0, acc[2]); acc[3] = MFMA32(a1, b1, acc[3]); \
    } else { \
        const bf16x8 b0 = *(const bf16x8*)(pb + off); \
        const bf16x8 a0 = *(const bf16x8*)(pa + off), a1 = *(const bf16x8*)(pa + 32 * 128 + off); \
        const bf16x8 a2 = *(const bf16x8*)(pa + 64 * 128 + off), a3 = *(const bf16x8*)(pa + 96 * 128 + off); \
        acc[0] = MFMA32(a0, b0, acc[0]); acc[1] = MFMA32(a1, b0, acc[1]); \
        acc[2] = MFMA32(a2, b0, acc[2]); acc[3] = MFMA32(a3, b0, acc[3]); \
    } } while (0)
    const int arow = (WT == 0) ? ((w >> 1) * 64 + r32) : r32;
    const int brow = (WT == 0) ? ((w & 1) * 64 + r32) : (w * 32 + r32);
    G_DMA(0, 0);
    for (int kt = 0; kt < nk; ++kt) {
        __syncthreads();
        if (kt + 1 < nk) G_DMA((kt + 1) & 1, (kt + 1) * 64);
        const char* pa = lds + (kt & 1) * G_BUF + arow * 128;
        const char* pb = lds + (kt & 1) * G_BUF + G_OPB + brow * 128;
        G_STEP(pa, pb, o0); G_STEP(pa, pb, o1); G_STEP(pa, pb, o2); G_STEP(pa, pb, o3);
    }
    if (ROWSS) { ss[0] += __shfl_xor(ss[0], 32, 64); ss[1] += __shfl_xor(ss[1], 32, 64); }
#undef G_DMA
#undef G_SS
#undef G_STEP
}

constexpr int ST_P = 68;
static_assert(4 * 64 * ST_P * 4 <= LDS_TOTAL, "staging LDS");
template <bool ROWSS, class EPI, class EPIROW, class RSC>
__device__ __forceinline__ void gemm_t(const bf16* __restrict__ Wt, int ldw, int N, const bf16* __restrict__ X, int ldx, int M, int K, int tn_direct, EPI epi, EPIROW epirow, RSC rowscale, char* lds) {
    const int tid = tidx(), lane = tid & 63, w = tid >> 6, r32 = lane & 31, hi = lane >> 5;
    const int tilesN = N / 128, tilesM = M / 128, nk = K / 64;
    for (int tile = blockIdx.x; tile < tilesM * tilesN; tile += gridDim.x) {
        const int tm = tile / tilesN, tn = tile % tilesN;
        f32x16 acc[4]; float ss[4];
        gemm_kloop<0, ROWSS>(Wt + (size_t)(tn * 128) * ldw, ldw, X + (size_t)(tm * 128) * ldx, ldx, nk, acc, ss, lds, tid);
        if (tn < tn_direct) {
            __syncthreads();
            float* st = (float*)lds + w * (64 * ST_P);
            const float m0_ = rowscale(ss[0]), m1_ = rowscale(ss[1]);
#pragma unroll
            for (int i = 0; i < 2; ++i)
#pragma unroll
                for (int j = 0; j < 2; ++j)
#pragma unroll
                    for (int g = 0; g < 4; ++g) {
                        const float mj = j ? m1_ : m0_;
                        *(float4*)(st + (32 * j + r32) * ST_P + 32 * i + 8 * g + 4 * hi) = make_float4(acc[i * 2 + j][4 * g] * mj, acc[i * 2 + j][4 * g + 1] * mj, acc[i * 2 + j][4 * g + 2] * mj, acc[i * 2 + j][4 * g + 3] * mj);
                    }
            const int rr = lane >> 4, ch = lane & 15;
#pragma unroll 4
            for (int it = 0; it < 16; ++it) {
                const int row = it * 4 + rr;
                const float4 v = *(const float4*)(st + row * ST_P + ch * 4);
                epirow(tm * 128 + (w & 1) * 64 + row, tn * 128 + (w >> 1) * 64 + ch * 4, v);
            }
        } else {
#pragma unroll
            for (int i = 0; i < 2; ++i)
#pragma unroll
                for (int j = 0; j < 2; ++j) {
                    const int tl = (w & 1) * 64 + j * 32;
                    epi(tn * 128 + (w >> 1) * 64 + i * 32, tm * 128 + tl, acc[i * 2 + j], r32, hi, ss[j]);
                }
        }
        __syncthreads();
    }
}

__device__ __forceinline__ void transpose_tiled(const float* __restrict__ W, bf16* __restrict__ Wt, int K, int N, int Npad, int ldk, const float* __restrict__ gain, char* lds) {
    float (*tl)[65] = (float (*)[65])lds;
    const int tid = tidx(), a = tid & 63, q = tid >> 6;
    const int tK = K / 64, tN = Npad / 64;
    for (int tile = blockIdx.x; tile < tK * tN; tile += gridDim.x) {
        const int k0 = (tile / tN) * 64, n0 = (tile % tN) * 64;
#pragma unroll 4
        for (int i = 0; i < 16; ++i) {
            const int k = k0 + q * 16 + i, n = n0 + a;
            float v = (n < N) ? W[(size_t)k * N + n] : 0.f;
            if (gain) v *= gain[k];
            tl[q * 16 + i][a] = v;
        }
        __syncthreads();
#pragma unroll 4
        for (int i = 0; i < 16; ++i) { const int nl = q * 16 + i; Wt[(size_t)(n0 + nl) * ldk + k0 + a] = f2bf(tl[a][nl]); }
        __syncthreads();
    }
}

__device__ __forceinline__ void quant_row(const float4 (&v)[4], unsigned char* __restrict__ dst, float* __restrict__ scl, int r, int lane) {
    float am = 0.f;
#pragma unroll
    for (int j = 0; j < 4; ++j) am = fmaxf(am, fmaxf(fmaxf(fabsf(v[j].x), fabsf(v[j].y)), fmaxf(fabsf(v[j].z), fabsf(v[j].w))));
#pragma unroll
    for (int m = 32; m >= 1; m >>= 1) am = fmaxf(am, __shfl_xor(am, m, 64));
    const float sc = (am > 0.f) ? am * (1.f / 448.f) : 1.f;
    const float is = 1.f / sc;
    uint4 o;
    { int w = 0; w = __builtin_amdgcn_cvt_pk_fp8_f32(v[0].x * is, v[0].y * is, w, false); w = __builtin_amdgcn_cvt_pk_fp8_f32(v[0].z * is, v[0].w * is, w, true); o.x = (unsigned)w; }
    { int w = 0; w = __builtin_amdgcn_cvt_pk_fp8_f32(v[1].x * is, v[1].y * is, w, false); w = __builtin_amdgcn_cvt_pk_fp8_f32(v[1].z * is, v[1].w * is, w, true); o.y = (unsigned)w; }
    { int w = 0; w = __builtin_amdgcn_cvt_pk_fp8_f32(v[2].x * is, v[2].y * is, w, false); w = __builtin_amdgcn_cvt_pk_fp8_f32(v[2].z * is, v[2].w * is, w, true); o.z = (unsigned)w; }
    { int w = 0; w = __builtin_amdgcn_cvt_pk_fp8_f32(v[3].x * is, v[3].y * is, w, false); w = __builtin_amdgcn_cvt_pk_fp8_f32(v[3].z * is, v[3].w * is, w, true); o.w = (unsigned)w; }
    { const int lay = r / NEXP, e = r % NEXP; *(uint4*)(dst + (((size_t)(lay * 8 + (lane >> 3)) * NEXP + e) * 128) + (lane & 7) * 16) = o; }
    if (lane == 0) scl[r] = sc;
}
__device__ __forceinline__ unsigned pack_i8x4(float a, float b, float c, float d) {
    const int ia = __float2int_rn(a), ib = __float2int_rn(b), ic = __float2int_rn(c), id = __float2int_rn(d);
    return (unsigned)(ia & 255) | ((unsigned)(ib & 255) << 8) | ((unsigned)(ic & 255) << 16) | ((unsigned)(id & 255) << 24);
}
__device__ __forceinline__ void quant_row_i8(const float4 (&v)[4], unsigned char* __restrict__ dst, float* __restrict__ scl, int r, int lane) {
    float am = 0.f;
#pragma unroll
    for (int j = 0; j < 4; ++j) am = fmaxf(am, fmaxf(fmaxf(fabsf(v[j].x), fabsf(v[j].y)), fmaxf(fabsf(v[j].z), fabsf(v[j].w))));
#pragma unroll
    for (int m = 32; m >= 1; m >>= 1) am = fmaxf(am, __shfl_xor(am, m, 64));
    const float sc = (am > 0.f) ? am * (1.f / 127.f) : 1.f;
    const float is = 1.f / sc;
    uint4 o;
    o.x = pack_i8x4(v[0].x * is, v[0].y * is, v[0].z * is, v[0].w * is); o.y = pack_i8x4(v[1].x * is, v[1].y * is, v[1].z * is, v[1].w * is);
    o.z = pack_i8x4(v[2].x * is, v[2].y * is, v[2].z * is, v[2].w * is); o.w = pack_i8x4(v[3].x * is, v[3].y * is, v[3].z * is, v[3].w * is);
    { const int lay = r / NEXP, e = r % NEXP; *(uint4*)(dst + (((size_t)(lay * 8 + (lane >> 3)) * NEXP + e) * 128) + (lane & 7) * 16) = o; }
    if (lane == 0) scl[r] = sc;
}
template <bool I8>
__device__ __forceinline__ void convert_table(const float* __restrict__ src, unsigned char* __restrict__ dst, float* __restrict__ scl, int rows) {
    static_assert(TAB_FP8, "fp8 tables");
    const int lane = tidx() & 63;
    const int nw = nwave();
    for (int r = gwave(); r < rows; r += 4 * nw) {
        float4 v[4][4]; int rr[4];
#pragma unroll
        for (int u = 0; u < 4; ++u) {
            rr[u] = (r + u * nw < rows) ? (r + u * nw) : r;
            const float4* s0 = (const float4*)(src + (size_t)rr[u] * D);
#pragma unroll
            for (int j = 0; j < 4; ++j) v[u][j] = s0[lane * 4 + j];
        }
#pragma unroll
        for (int u = 0; u < 4; ++u) {
            if (u == 0 || rr[u] != r) { if (I8) quant_row_i8(v[u], dst, scl, rr[u], lane); else quant_row(v[u], dst, scl, rr[u], lane); }
        }
    }
}
__device__ __forceinline__ void phase_prep(const Params& P, char* lds) {
    unsigned char* ws = P.ws;
    for (int l = 0; l < DEPTH; ++l) {
        transpose_tiled(P.w_in + (size_t)l * D * DIN, (bf16*)(ws + WS_WIN) + (size_t)l * DINP * LDW, D, DIN, DINP, LDW, nullptr, lds);
        transpose_tiled(P.w_uq + (size_t)l * QR * 768, (bf16*)(ws + WS_WUQ) + (size_t)l * 768 * QR, QR, 768, 768, QR, P.q_norm + l * QR, lds);
        transpose_tiled(P.w_uk + (size_t)l * KVR * 512, (bf16*)(ws + WS_WUKV) + (size_t)l * 1024 * KVR, KVR, 512, 512, KVR, P.kv_norm + l * KVR, lds);
        transpose_tiled(P.w_uv + (size_t)l * KVR * 512, (bf16*)(ws + WS_WUKV) + (size_t)l * 1024 * KVR + (size_t)512 * KVR, KVR, 512, 512, KVR, P.kv_norm + l * KVR, lds);
        transpose_tiled(P.w_out + (size_t)l * D * D, (bf16*)(ws + WS_WOUT) + (size_t)l * D * LDW, D, D, D, LDW, nullptr, lds);
    }
    {
        bf16* Wc = (bf16*)(ws + WS_WPQ);
        float (*As)[68] = (float (*)[68])lds;
        float (*Bs)[68] = (float (*)[68])(lds + 16 * 68 * 4);
        const int tid = tidx(), tx = tid & 15, ty = tid >> 4;
        const int lr = tid >> 2, ld4 = (tid & 3) * 4;
        for (int tile = blockIdx.x; tile < (DEPTH * 2048 / 64) * (D / 64); tile += gridDim.x) {
            const int row0 = (tile >> 4) * 64, k0 = (tile & 15) * 64;
            const int l = row0 >> 11, hp = (row0 >> 7) & 15, n0 = row0 & 127;
            const float* skp = P.peer_subkeys + (((size_t)l * 2 + (hp & 1)) * NKEY + n0 + lr) * 128 + ld4;
            const float* wqp = P.peer_wq + ((size_t)l * D + k0 + lr) * 2048 + hp * 128 + ld4;
            float acc[4][4];
#pragma unroll
            for (int i = 0; i < 4; ++i)
#pragma unroll
                for (int j = 0; j < 4; ++j) acc[i][j] = 0.f;
            for (int d0 = 0; d0 < 128; d0 += 16) {
                const float4 av = *(const float4*)(skp + d0), bv = *(const float4*)(wqp + d0);
                As[ld4 + 0][lr] = av.x; As[ld4 + 1][lr] = av.y; As[ld4 + 2][lr] = av.z; As[ld4 + 3][lr] = av.w;
                Bs[ld4 + 0][lr] = bv.x; Bs[ld4 + 1][lr] = bv.y; Bs[ld4 + 2][lr] = bv.z; Bs[ld4 + 3][lr] = bv.w;
                __syncthreads();
#pragma unroll
                for (int kk = 0; kk < 16; ++kk) {
                    const float4 a4 = *(const float4*)&As[kk][ty * 4], b4 = *(const float4*)&Bs[kk][tx * 4];
                    const float aa[4] = {a4.x, a4.y, a4.z, a4.w}, bb[4] = {b4.x, b4.y, b4.z, b4.w};
#pragma unroll
                    for (int i = 0; i < 4; ++i)
#pragma unroll
                        for (int j = 0; j < 4; ++j) acc[i][j] = fmaf(aa[i], bb[j], acc[i][j]);
                }
                __syncthreads();
            }
#pragma unroll
            for (int i = 0; i < 4; ++i) {
                uint2 o; o.x = pack2(acc[i][0], acc[i][1]); o.y = pack2(acc[i][2], acc[i][3]);
                *(uint2*)(Wc + (size_t)(row0 + ty * 4 + i) * LDW + k0 + tx * 4) = o;
            }
        }
    }
    convert_table<true>(P.peer_u, ws + WS_TABU, (float*)(ws + WS_TSCU), DEPTH * NEXP);
    convert_table<false>(P.peer_v, ws + WS_TABV, (float*)(ws + WS_TSCV), DEPTH * NEXP);
    float* rope = (float*)(ws + WS_ROPE);
    for (size_t i = gtid(); i < (size_t)S * 16; i += gnth()) {
        const int s = (int)(i >> 4), f = (int)(i & 15);
        const double inv = pow(10000.0, -(double)f / 16.0);
        const double ang = (double)s * inv;
        rope[2 * i] = (float)cos(ang); rope[2 * i + 1] = (float)sin(ang);
    }
}

__device__ __forceinline__ void phase_norm(const float* __restrict__ h, const float* __restrict__ g, bf16* __restrict__ xn) {
    const int lane = tidx() & 63, nw = nwave();
    for (int t = gwave(); t < T; t += 2 * nw) {
        const int t2 = (t + nw < T) ? (t + nw) : t;
        float4 v[2][4];
#pragma unroll
        for (int j = 0; j < 4; ++j) { v[0][j] = ((const float4*)(h + (size_t)t * D))[j * 64 + lane]; v[1][j] = ((const float4*)(h + (size_t)t2 * D))[j * 64 + lane]; }
#pragma unroll
        for (int u = 0; u < 2; ++u) {
            float ss = 0.f;
#pragma unroll
            for (int j = 0; j < 4; ++j) ss += v[u][j].x * v[u][j].x + v[u][j].y * v[u][j].y + v[u][j].z * v[u][j].z + v[u][j].w * v[u][j].w;
            ss = wave_sum(ss);
            const float r = rsqrtf(ss * (1.f / D) + EPS);
            const int tt = u ? t2 : t;
            if (u == 0 || t2 != t) {
#pragma unroll
                for (int j = 0; j < 4; ++j) {
                    const float4 gg = ((const float4*)g)[j * 64 + lane];
                    uint2 o; o.x = pack2(v[u][j].x * r * gg.x, v[u][j].y * r * gg.y); o.y = pack2(v[u][j].z * r * gg.z, v[u][j].w * r * gg.w);
                    ((uint2*)(xn + (size_t)tt * LDX))[j * 64 + lane] = o;
                }
            }
        }
    }
}

__device__ __forceinline__ void phase_norm_q(const Params& P, int l) {
    const int lane = tidx() & 63, nw = nwave();
    const float* g = P.norm_ffn + l * D;
    bf16* xn = (bf16*)(P.ws + WS_XN);
    unsigned* xq = (unsigned*)(P.ws + WS_XQ);
    float* xsc = (float*)(P.ws + WS_XS);
    for (int t = gwave(); t < T; t += 2 * nw) {
        const int t2 = (t + nw < T) ? (t + nw) : t;
        float4 v[2][4];
#pragma unroll
        for (int j = 0; j < 4; ++j) { v[0][j] = ((const float4*)(P.out + (size_t)t * D))[j * 64 + lane]; v[1][j] = ((const float4*)(P.out + (size_t)t2 * D))[j * 64 + lane]; }
#pragma unroll
        for (int u = 0; u < 2; ++u) {
            float ss = 0.f;
#pragma unroll
            for (int j = 0; j < 4; ++j) ss += v[u][j].x * v[u][j].x + v[u][j].y * v[u][j].y + v[u][j].z * v[u][j].z + v[u][j].w * v[u][j].w;
            ss = wave_sum(ss);
            const float r = rsqrtf(ss * (1.f / D) + EPS);
            const int tt = u ? t2 : t;
            if (u == 0 || t2 != t) {
                float am = 0.f;
#pragma unroll
                for (int j = 0; j < 4; ++j) {
                    const float4 gg = ((const float4*)g)[j * 64 + lane];
                    v[u][j].x *= r * gg.x; v[u][j].y *= r * gg.y; v[u][j].z *= r * gg.z; v[u][j].w *= r * gg.w;
                    am = fmaxf(am, fmaxf(fmaxf(fabsf(v[u][j].x), fabsf(v[u][j].y)), fmaxf(fabsf(v[u][j].z), fabsf(v[u][j].w))));
                    uint2 o; o.x = pack2(v[u][j].x, v[u][j].y); o.y = pack2(v[u][j].z, v[u][j].w);
                    ((uint2*)(xn + (size_t)tt * LDX))[j * 64 + lane] = o;
                }
#pragma unroll
                for (int m = 32; m >= 1; m >>= 1) am = fmaxf(am, __shfl_xor(am, m, 64));
                const float sc = (am > 0.f) ? am * (1.f / 127.f) : 1.f, is = 1.f / sc;
#pragma unroll
                for (int j = 0; j < 4; ++j) xq[(size_t)tt * (D / 4) + j * 64 + lane] = pack_i8x4(v[u][j].x * is, v[u][j].y * is, v[u][j].z * is, v[u][j].w * is);
                if (lane == 0) xsc[tt] = sc;
            }
        }
    }
}

__device__ __forceinline__ void phase_mixlocal(const Params& P, int l, char* lds) {
    const bf16* proj = (const bf16*)(P.ws + WS_PROJ);
    bf16* Y = (bf16*)(P.ws + WS_XN);
    const int tid = tidx();
    {
        const float* cw = P.conv_w + (size_t)l * 3 * 256;
        for (size_t i = gtid(); i < (size_t)T * 32; i += gnth()) {
            const int t = (int)(i >> 5), c0 = (int)(i & 31) * 8, s = t & (S - 1);
            const bf16* pr = proj + (size_t)t * DINP;
            float acc[8];
#pragma unroll
            for (int e = 0; e < 8; ++e) acc[e] = 0.f;
#pragma unroll
            for (int j = 0; j < 3; ++j) {
                if (s - 2 + j >= 0) {
                    const bf16* pp = pr - (size_t)(2 - j) * DINP;
                    const uint4 g = *(const uint4*)(pp + C_CG + c0), hc = *(const uint4*)(pp + C_HC + c0);
                    const float4 w0 = *(const float4*)(cw + j * 256 + c0), w1 = *(const float4*)(cw + j * 256 + c0 + 4);
                    acc[0] = fmaf(w0.x, bflo(g.x) * bflo(hc.x), acc[0]); acc[1] = fmaf(w0.y, bfhi(g.x) * bfhi(hc.x), acc[1]);
                    acc[2] = fmaf(w0.z, bflo(g.y) * bflo(hc.y), acc[2]); acc[3] = fmaf(w0.w, bfhi(g.y) * bfhi(hc.y), acc[3]);
                    acc[4] = fmaf(w1.x, bflo(g.z) * bflo(hc.z), acc[4]); acc[5] = fmaf(w1.y, bfhi(g.z) * bfhi(hc.z), acc[5]);
                    acc[6] = fmaf(w1.z, bflo(g.w) * bflo(hc.w), acc[6]); acc[7] = fmaf(w1.w, bfhi(g.w) * bfhi(hc.w), acc[7]);
                }
            }
            const uint4 bg = *(const uint4*)(pr + C_BG + c0);
            uint4 o;
            o.x = pack2(bflo(bg.x) * acc[0], bfhi(bg.x) * acc[1]); o.y = pack2(bflo(bg.y) * acc[2], bfhi(bg.y) * acc[3]);
            o.z = pack2(bflo(bg.z) * acc[4], bfhi(bg.z) * acc[5]); o.w = pack2(bflo(bg.w) * acc[6], bfhi(bg.w) * acc[7]);
            *(uint4*)(Y + (size_t)t * LDX + c0) = o;
        }
    }
    {
        float (*pl)[68] = (float (*)[68])lds;
        const float* pw = P.pool_w + (size_t)l * 4 * 64 * 64;
        const float* psc = P.pool_scale + l * 256;
        const int a = tid & 63, q = tid >> 6;
        for (int tile = blockIdx.x; tile < (T / 64) * 4; tile += gridDim.x) {
            const int g = tile & 3, t0 = (tile >> 2) * 64;
            const int w = 2 << g;
            {
                const bf16* col = proj + C_HP + g * 64 + a;
                const int tf = t0 + q * 16, sf = tf & (S - 1);
                float xr[31];
#pragma unroll
                for (int d = 1; d <= 15; ++d) xr[15 - d] = (d < w && sf - d >= 0) ? bf2f(col[(size_t)(tf - d) * DINP]) : 0.f;
#pragma unroll
                for (int i = 0; i < 16; ++i) xr[15 + i] = bf2f(col[(size_t)(tf + i) * DINP]);
                float sum = 0.f;
#pragma unroll
                for (int d = 1; d <= 15; ++d) sum += xr[15 - d];
#pragma unroll
                for (int i = 0; i < 16; ++i) {
                    const int s = sf + i;
                    sum += xr[15 + i];
                    const int cnt = (s + 1 < w) ? (s + 1) : w;
                    pl[q * 16 + i][a] = sum / (float)cnt - xr[15 + i];
                    const int o = 15 + i + 1;
                    const float old = (g == 0) ? xr[o - 2] : (g == 1) ? xr[o - 4] : (g == 2) ? xr[o - 8] : xr[o - 16];
                    sum -= old;
                }
            }
            __syncthreads();
            {
                float pc[64];
#pragma unroll
                for (int c = 0; c < 64; ++c) pc[c] = pw[(g * 64 + c) * 64 + a];
                const float sc = psc[g * 64 + a];
#pragma unroll 2
                for (int i = 0; i < 16; ++i) {
                    const float4* row = (const float4*)&pl[q * 16 + i][0];
                    float m0 = 0.f, m1 = 0.f;
#pragma unroll
                    for (int c4 = 0; c4 < 16; ++c4) { const float4 v = row[c4]; m0 = fmaf(v.x, pc[4 * c4], m0); m1 = fmaf(v.y, pc[4 * c4 + 1], m1); m0 = fmaf(v.z, pc[4 * c4 + 2], m0); m1 = fmaf(v.w, pc[4 * c4 + 3], m1); }
                    Y[(size_t)(t0 + q * 16 + i) * LDX + 256 + g * 64 + a] = f2bf((m0 + m1) * sc);
                }
            }
            __syncthreads();
        }
    }
}

typedef short v4i16_t __attribute__((ext_vector_type(4)));
typedef __attribute__((address_space(3))) v4i16_t* lds_v4p;
__device__ __forceinline__ v4i16_t vtr(const char* p) { return __builtin_amdgcn_ds_read_tr16_b64_v4i16((lds_v4p)p); }
constexpr int A_KP = 208, A_VP = 192;
constexpr int A_KB = 64 * A_KP, A_VB = 64 * A_VP, A_BUF = A_KB + A_VB, ATTN_LDS = 2 * A_BUF;
static_assert(ATTN_LDS <= GEMM_LDS, "attention LDS");

__device__ __forceinline__ void attn_unit(const bf16* __restrict__ Qb, const bf16* __restrict__ Kb, const bf16* __restrict__ Vb, bf16* __restrict__ Y, int bh, int qblk, char* lds) {
    const int tid = tidx(), lane = tid & 63, w = tid >> 6, r32 = lane & 31, hi = lane >> 5;
    const int q0 = qblk * 128, qw0 = q0 + w * 32;
    const int NT = 2 * qblk + 2;
    bf16x8 qf[6];
    {
        const bf16* qp = Qb + ((size_t)bh * S + qw0 + r32) * DQK + hi * 8;
#pragma unroll
        for (int ks = 0; ks < 6; ++ks) qf[ks] = *(const bf16x8*)(qp + ks * 16);
    }
    f32x16 o0, o1;
#pragma unroll
    for (int r = 0; r < 16; ++r) { o0[r] = 0.f; o1[r] = 0.f; }
    float m = -1e30f, lsum = 0.f;
    const char* Kg = (const char*)(Kb + (size_t)bh * S * DQK) + tid * 16;
    const char* Vg = (const char*)(Vb + (size_t)bh * S * DV) + tid * 16;
    const int kl0 = (tid / 12) * A_KP + (tid % 12) * 16, kl1 = ((tid + 256) / 12) * A_KP + ((tid + 256) % 12) * 16, kl2 = ((tid + 512) / 12) * A_KP + ((tid + 512) % 12) * 16;
    const int vl0 = (tid >> 3) * A_VP + (tid & 7) * 16, vl1 = vl0 + 32 * A_VP;
    uint4 pk0, pk1, pk2, pv0, pv1, qk0, qk1, qk2, qv0, qv1;
#define A_LOAD(S, t) do { const char* kg = Kg + (size_t)(t) * (64 * 192); const char* vg = Vg + (size_t)(t) * (64 * 128); \
        S##k0 = *(const uint4*)(kg); S##k1 = *(const uint4*)(kg + 4096); S##k2 = *(const uint4*)(kg + 8192); S##v0 = *(const uint4*)(vg); S##v1 = *(const uint4*)(vg + 4096); } while (0)
#define A_STORE(S, bK, bV) do { *(uint4*)(bK + kl0) = S##k0; *(uint4*)(bK + kl1) = S##k1; *(uint4*)(bK + kl2) = S##k2; *(uint4*)(bV + vl0) = S##v0; *(uint4*)(bV + vl1) = S##v1; } while (0)
#define A_PV(pf, kofs) do { \
            { const v4i16_t lo = vtr(pv + (kofs) * A_VP), hh = vtr(pv + ((kofs) + 8) * A_VP); const bf16x8 vf = {lo[0], lo[1], lo[2], lo[3], hh[0], hh[1], hh[2], hh[3]}; o0 = MFMA32(vf, pf.v, o0); } \
            { const v4i16_t lo = vtr(pv + (kofs) * A_VP + 64), hh = vtr(pv + ((kofs) + 8) * A_VP + 64); const bf16x8 vf = {lo[0], lo[1], lo[2], lo[3], hh[0], hh[1], hh[2], hh[3]}; o1 = MFMA32(vf, pf.v, o1); } } while (0)
    const int pvo = (4 * hi + ((lane & 15) >> 2)) * A_VP + (16 * ((lane >> 4) & 1) + 4 * (lane & 3)) * 2;
    A_LOAD(p, 0); A_LOAD(q, 1);
    for (int t2 = 0; t2 < NT; t2 += 2) {
#pragma unroll
        for (int half = 0; half < 2; ++half) {
            const int t = t2 + half;
            char* bK = lds + half * A_BUF; char* bV = bK + A_KB;
            if (half == 0) A_STORE(p, bK, bV); else A_STORE(q, bK, bV);
            __syncthreads();
            { const int tn = (t + 2 < NT) ? (t + 2) : (NT - 2 + half); if (half == 0) A_LOAD(p, tn); else A_LOAD(q, tn); }
        const int kt0 = t * 64;
        if (kt0 <= qw0) {
            f32x16 s0, s1;
#pragma unroll
            for (int r = 0; r < 16; ++r) { s0[r] = 0.f; s1[r] = 0.f; }
            const char* pk = bK + r32 * A_KP + hi * 16;
#pragma unroll
            for (int ks = 0; ks < 6; ++ks) {
                const bf16x8 a0 = *(const bf16x8*)(pk + ks * 32), a1 = *(const bf16x8*)(pk + 32 * A_KP + ks * 32);
                s0 = MFMA32(a0, qf[ks], s0); s1 = MFMA32(a1, qf[ks], s1);
            }
            if (kt0 + 63 > qw0) {
                const int qrow = qw0 + r32;
#pragma unroll
                for (int r = 0; r < 16; ++r) { const int key = kt0 + crow(r, hi); if (key > qrow) s0[r] = -INFINITY; if (key + 32 > qrow) s1[r] = -INFINITY; }
            }
            float mx = fmaxf(s0[0], s1[0]);
#pragma unroll
            for (int r = 1; r < 16; ++r) mx = fmaxf(mx, fmaxf(s0[r], s1[r]));
            mx = fmaxf(mx, __shfl_xor(mx, 32, 64));
            const float mn = fmaxf(m, mx), m_prev = m;
            const float alpha = __builtin_amdgcn_exp2f(m - mn);
            m = mn;
            float ps = 0.f;
#pragma unroll
            for (int r = 0; r < 16; ++r) { s0[r] = __builtin_amdgcn_exp2f(s0[r] - mn); s1[r] = __builtin_amdgcn_exp2f(s1[r] - mn); ps += s0[r] + s1[r]; }
            if (__builtin_amdgcn_ballot_w64(mn > m_prev) != 0ull) {
                lsum *= alpha;
#pragma unroll
                for (int r = 0; r < 16; ++r) { o0[r] *= alpha; o1[r] *= alpha; }
            }
            lsum += ps;
            union { unsigned u[4]; bf16x8 v; } p00, p01, p10, p11;
#pragma unroll
            for (int j = 0; j < 4; ++j) { p00.u[j] = cvtpk(s0[2 * j], s0[2 * j + 1]); p01.u[j] = cvtpk(s0[8 + 2 * j], s0[9 + 2 * j]); p10.u[j] = cvtpk(s1[2 * j], s1[2 * j + 1]); p11.u[j] = cvtpk(s1[8 + 2 * j], s1[9 + 2 * j]); }
            const char* pv = bV + pvo;
            A_PV(p00, 0); A_PV(p01, 16); A_PV(p10, 32); A_PV(p11, 48);
        }
        }
    }
    lsum += __shfl_xor(lsum, 32, 64);
    const float inv = 1.f / lsum;
    const int b = bh >> 3, h = bh & 7;
    bf16* yo = Y + (size_t)(b * S + qw0 + r32) * LDX + 512 + h * 64 + 4 * hi;
#pragma unroll
    for (int g = 0; g < 4; ++g) {
        uint2 a, c;
        a.x = cvtpk(o0[4 * g] * inv, o0[4 * g + 1] * inv); a.y = cvtpk(o0[4 * g + 2] * inv, o0[4 * g + 3] * inv);
        c.x = cvtpk(o1[4 * g] * inv, o1[4 * g + 1] * inv); c.y = cvtpk(o1[4 * g + 2] * inv, o1[4 * g + 3] * inv);
        *(uint2*)(yo + 8 * g) = a; *(uint2*)(yo + 32 + 8 * g) = c;
    }
    __syncthreads();
}
__device__ __forceinline__ void phase_attn(const Params& P, char* lds) {
    const bf16* Qb = (const bf16*)(P.ws + WS_Q);
    const bf16* Kb = (const bf16*)(P.ws + WS_K);
    const bf16* Vb = (const bf16*)(P.ws + WS_V);
    bf16* Y = (bf16*)(P.ws + WS_XN);
    for (int u = blockIdx.x; u < NB * NH * (S / 128); u += gridDim.x) {
        const int bh = u & 31, v = u >> 5;
        const int qblk = (v < 16) ? (63 - v) : (v < 32) ? (v - 16) : (v < 48) ? (79 - v) : (v - 32);
        attn_unit(Qb, Kb, Vb, Y, bh, qblk, lds);
    }
}

#define NET_HD __device__ __forceinline__
#define NET_U2F(u) __uint_as_float(u)
#define NET_F2U(f) __float_as_uint(f)
#define CE_DESC(a, b) do { const float hi__ = fmaxf(a, b), lo__ = fminf(a, b); a = hi__; b = lo__; } while (0)
NET_HD void sort16_desc(float (&v)[16]) {
#pragma unroll
    for (int k = 2; k <= 16; k <<= 1) {
#pragma unroll
        for (int j = k >> 1; j > 0; j >>= 1) {
#pragma unroll
            for (int i = 0; i < 16; ++i) {
                const int l = i ^ j;
                if (l > i) { if ((i & k) == 0) CE_DESC(v[i], v[l]); else CE_DESC(v[l], v[i]); }
            }
        }
    }
}
NET_HD void merge16_desc(float (&a)[16], const float (&b)[16]) {
#pragma unroll
    for (int i = 0; i < 16; ++i) a[i] = fmaxf(a[i], b[15 - i]);
#pragma unroll
    for (int j = 8; j > 0; j >>= 1) {
#pragma unroll
        for (int i = 0; i < 16; ++i) { const int l = i ^ j; if (l > i) CE_DESC(a[i], a[l]); }
    }
}
NET_HD void top16_of_64(float (&g0)[16], float (&g1)[16], float (&g2)[16], float (&g3)[16]) {
    sort16_desc(g0); sort16_desc(g1); sort16_desc(g2); sort16_desc(g3);
    merge16_desc(g0, g1); merge16_desc(g2, g3); merge16_desc(g0, g2);
}
NET_HD float u2f(unsigned u) { return NET_U2F(u); }
NET_HD unsigned f2u(float f) { return NET_F2U(f); }
template <class V16>
NET_HD void lane_top16(const V16& s0, const V16& s1, const V16& s2, const V16& s3, int hi, float (&out)[16]) {
    float g0[16], g1[16], g2[16], g3[16];
#pragma unroll
    for (int r = 0; r < 16; ++r) {
        const unsigned nb = (unsigned)((r & 3) + 8 * (r >> 2));
        g0[r] = u2f((f2u(s0[r]) & 0xFFFFFF80u) | nb); g1[r] = u2f((f2u(s1[r]) & 0xFFFFFF80u) | (nb + 32u));
        g2[r] = u2f((f2u(s2[r]) & 0xFFFFFF80u) | (nb + 64u)); g3[r] = u2f((f2u(s3[r]) & 0xFFFFFF80u) | (nb + 96u));
    }
    top16_of_64(g0, g1, g2, g3);
    const unsigned h4 = (unsigned)hi << 2;
#pragma unroll
    for (int i = 0; i < 16; ++i) out[i] = u2f(f2u(g0[i]) | h4);
}
constexpr int cand_slot(int a, int b) { int n = 0; for (int x = 0; x < 16; ++x) for (int y = 0; y < 16; ++y) { if (x == a && y == b) return n; if ((x + 1) * (y + 1) <= 16) ++n; } return n; }
NET_HD void cand_top16(const float (&s1)[16], const float (&s2)[16], float (&c)[16]) {
    float g0[16], g1[16], g2[16], g3[16];
#pragma unroll
    for (int i = 0; i < 16; ++i) { g0[i] = -3.0e38f; g1[i] = -3.0e38f; g2[i] = -3.0e38f; g3[i] = -3.0e38f; }
#pragma unroll
    for (int a = 0; a < 16; ++a) {
#pragma unroll
        for (int b = 0; b < 16; ++b) {
            if ((a + 1) * (b + 1) <= 16) {
                const int sl = cand_slot(a, b);
                const float v = u2f((f2u(s1[a] + s2[b]) & 0xFFFFFF00u) | (unsigned)(a * 16 + b));
                if (sl < 16) g0[sl & 15] = v; else if (sl < 32) g1[sl & 15] = v; else if (sl < 48) g2[sl & 15] = v; else g3[sl & 15] = v;
            }
        }
    }
    top16_of_64(g0, g1, g2, g3);
#pragma unroll
    for (int i = 0; i < 16; ++i) c[i] = g0[i];
}

__device__ __forceinline__ void phase_route(const Params& P, int l, char* lds) {
    const bf16* XN = (const bf16*)(P.ws + WS_XN);
    const bf16* Wc = (const bf16*)(P.ws + WS_WPQ) + (size_t)l * 2048 * LDW;
    int* EXPp = (int*)(P.ws + WS_EXP);
    float* GATEp = (float*)(P.ws + WS_GATE);
    const int tid = tidx(), lane = tid & 63, w = tid >> 6, r32 = lane & 31, hi = lane >> 5;
    for (int u = blockIdx.x; u < (T / 128) * PH; u += gridDim.x) {
        const int tm = u >> 3, h = u & 7;
        float L0[16], L1[16];
        {
            f32x16 acc[4]; float ssd[4];
            gemm_kloop<1, false>(Wc + (size_t)((h * 2 + 0) * 128) * LDW, LDW, XN + (size_t)(tm * 128) * LDX, LDX, D / 64, acc, ssd, lds, tid);
            lane_top16(acc[0], acc[1], acc[2], acc[3], hi, L0);
            float o[16];
#pragma unroll
            for (int i = 0; i < 16; ++i) o[i] = __shfl_xor(L0[i], 32, 64);
            merge16_desc(L0, o);
        }
        {
            f32x16 acc[4]; float ssd[4];
            gemm_kloop<1, false>(Wc + (size_t)((h * 2 + 1) * 128) * LDW, LDW, XN + (size_t)(tm * 128) * LDX, LDX, D / 64, acc, ssd, lds, tid);
            lane_top16(acc[0], acc[1], acc[2], acc[3], hi, L1);
            float o[16];
#pragma unroll
            for (int i = 0; i < 16; ++i) o[i] = __shfl_xor(L1[i], 32, 64);
            merge16_desc(L1, o);
        }
        float c[16];
        cand_top16(L0, L1, c);
        __syncthreads();
        unsigned char* my = (unsigned char*)lds + tid * 32;
        {
            uint4 a, b;
#define PK4(L, i) ((__float_as_uint(L[i]) & 127u) | ((__float_as_uint(L[i + 1]) & 127u) << 8) | ((__float_as_uint(L[i + 2]) & 127u) << 16) | ((__float_as_uint(L[i + 3]) & 127u) << 24))
            a.x = PK4(L0, 0); a.y = PK4(L0, 4); a.z = PK4(L0, 8); a.w = PK4(L0, 12);
            b.x = PK4(L1, 0); b.y = PK4(L1, 4); b.z = PK4(L1, 8); b.w = PK4(L1, 12);
#undef PK4
            *(uint4*)my = a; *(uint4*)(my + 16) = b;
        }
        int ev[16]; float gv[16]; float den = 0.f;
#pragma unroll
        for (int k = 0; k < 16; ++k) {
            const unsigned ci = __float_as_uint(c[k]) & 255u;
            const int n1 = my[ci >> 4], n2 = my[16 + (ci & 15)];
            ev[k] = n1 * NKEY + n2;
            gv[k] = __expf(c[k] - c[0]); den += gv[k];
        }
        const float iden = 1.f / den;
        if (hi == 0) {
            const int t = tm * 128 + w * 32 + r32;
            uint4* ep = (uint4*)(EXPp + (size_t)t * HK + h * 16);
            float4* gp = (float4*)(GATEp + (size_t)t * HK + h * 16);
#pragma unroll
            for (int q = 0; q < 4; ++q) {
                ep[q] = make_uint4((unsigned)ev[4 * q], (unsigned)ev[4 * q + 1], (unsigned)ev[4 * q + 2], (unsigned)ev[4 * q + 3]);
                gp[q] = make_float4(gv[4 * q] * iden, gv[4 * q + 1] * iden, gv[4 * q + 2] * iden, gv[4 * q + 3] * iden);
            }
        }
        __syncthreads();
    }
}

__device__ __forceinline__ float red16(float (&p)[16], int lane) {
#pragma unroll
    for (int i = 0; i < 8; ++i) { const bool up = lane & 32; const float send = up ? p[i] : p[i + 8], keep = up ? p[i + 8] : p[i]; p[i] = keep + __shfl_xor(send, 32, 64); }
#pragma unroll
    for (int i = 0; i < 4; ++i) { const bool up = lane & 16; const float send = up ? p[i] : p[i + 4], keep = up ? p[i + 4] : p[i]; p[i] = keep + __shfl_xor(send, 16, 64); }
#pragma unroll
    for (int i = 0; i < 2; ++i) { const bool up = lane & 8; const float send = up ? p[i] : p[i + 2], keep = up ? p[i + 2] : p[i]; p[i] = keep + __shfl_xor(send, 8, 64); }
    { const bool up = lane & 4; const float send = up ? p[0] : p[1], keep = up ? p[1] : p[0]; p[0] = keep + __shfl_xor(send, 4, 64); }
    float r = p[0];
    r += __shfl_xor(r, 2, 64); r += __shfl_xor(r, 1, 64);
    return r;
}

__device__ __forceinline__ void phase_gather(const Params& P, int l) {
    const bf16* XN = (const bf16*)(P.ws + WS_XN);
    bf16* XNw = (bf16*)(P.ws + WS_XN);
    const int* EXPp = (const int*)(P.ws + WS_EXP);
    const float* GATEp = (const float*)(P.ws + WS_GATE);
    const unsigned char* U = P.ws + WS_TABU + (size_t)l * NEXP * TAB_ROWB;
    const unsigned char* V = P.ws + WS_TABV + (size_t)l * NEXP * TAB_ROWB;
    const float* SU = (const float*)(P.ws + WS_TSCU) + (size_t)l * NEXP;
    const float* SV = (const float*)(P.ws + WS_TSCV) + (size_t)l * NEXP;
    const int lane = tidx() & 63;
    for (int t = gwave(); t < T; t += nwave()) {
        const int e_lo = EXPp[(size_t)t * HK + lane], e_hi = EXPp[(size_t)t * HK + 64 + lane];
#if TAB_FP8
        float xf[16];
        {
            const uint4 a = ((const uint4*)(XN + (size_t)t * D))[lane * 2], b = ((const uint4*)(XN + (size_t)t * D))[lane * 2 + 1];
            xf[0] = bflo(a.x); xf[1] = bfhi(a.x); xf[2] = bflo(a.y); xf[3] = bfhi(a.y); xf[4] = bflo(a.z); xf[5] = bfhi(a.z); xf[6] = bflo(a.w); xf[7] = bfhi(a.w);
            xf[8] = bflo(b.x); xf[9] = bfhi(b.x); xf[10] = bflo(b.y); xf[11] = bfhi(b.y); xf[12] = bflo(b.z); xf[13] = bfhi(b.z); xf[14] = bflo(b.w); xf[15] = bfhi(b.w);
        }
#else
        const uint4 xa = ((const uint4*)(XN + (size_t)t * D))[lane], xb = ((const uint4*)(XN + (size_t)t * D))[64 + lane];
#endif
        float acc[16];
#pragma unroll
        for (int i = 0; i < 16; ++i) acc[i] = 0.f;
        for (int c = 0; c < 8; ++c) {
            const int esel = (c < 4) ? e_lo : e_hi;
            const int kb = (c & 3) * 16;
            float part[16];
#pragma unroll
            for (int hb = 0; hb < 2; ++hb) {
#if TAB_FP8
                uint4 r[8];
#pragma unroll
                for (int i = 0; i < 8; ++i) { const int e = __builtin_amdgcn_readlane(esel, kb + hb * 8 + i); r[i] = *(const uint4*)(U + (size_t)e * 1024 + lane * 16); }
#pragma unroll
                for (int i = 0; i < 8; ++i) {
                    float d0 = 0.f, d1 = 0.f;
                    const unsigned w[4] = {r[i].x, r[i].y, r[i].z, r[i].w};
#pragma unroll
                    for (int q = 0; q < 4; ++q) {
                        const auto lo = __builtin_amdgcn_cvt_pk_f32_fp8((int)w[q], false); const auto hh = __builtin_amdgcn_cvt_pk_f32_fp8((int)w[q], true);
                        d0 = fmaf(xf[4 * q], lo[0], d0); d1 = fmaf(xf[4 * q + 1], lo[1], d1); d0 = fmaf(xf[4 * q + 2], hh[0], d0); d1 = fmaf(xf[4 * q + 3], hh[1], d1);
                    }
                    part[hb * 8 + i] = d0 + d1;
                }
#else
                uint4 r0[8], r1[8];
#pragma unroll
                for (int i = 0; i < 8; ++i) { const int e = __builtin_amdgcn_readlane(esel, kb + hb * 8 + i); const unsigned char* rp = U + (size_t)e * 2048 + lane * 16; r0[i] = *(const uint4*)(rp); r1[i] = *(const uint4*)(rp + 1024); }
#pragma unroll
                for (int i = 0; i < 8; ++i) {
                    float d0 = 0.f, d1 = 0.f;
                    d0 = dot2bf(xa.x, r0[i].x, d0); d1 = dot2bf(xa.y, r0[i].y, d1); d0 = dot2bf(xa.z, r0[i].z, d0); d1 = dot2bf(xa.w, r0[i].w, d1);
                    d0 = dot2bf(xb.x, r1[i].x, d0); d1 = dot2bf(xb.y, r1[i].y, d1); d0 = dot2bf(xb.z, r1[i].z, d0); d1 = dot2bf(xb.w, r1[i].w, d1);
                    part[hb * 8 + i] = d0 + d1;
                }
#endif
            }
            float dsum = red16(part, lane);
            const int kk = c * 16 + (lane >> 2);
            const int eme = __shfl(esel, kb + (lane >> 2), 64);
            float wv = GATEp[(size_t)t * HK + kk];
#if TAB_FP8
            dsum *= SU[eme];
            wv *= SV[eme];
#endif
            wv *= gelu_exact(dsum);
#pragma unroll
            for (int hb = 0; hb < 2; ++hb) {
#if TAB_FP8
                uint4 r[8];
#pragma unroll
                for (int i = 0; i < 8; ++i) { const int e = __builtin_amdgcn_readlane(esel, kb + hb * 8 + i); r[i] = *(const uint4*)(V + (size_t)e * 1024 + lane * 16); }
#pragma unroll
                for (int i = 0; i < 8; ++i) {
                    const float w = __int_as_float(__builtin_amdgcn_readlane(__float_as_int(wv), (hb * 8 + i) * 4));
                    const unsigned ww[4] = {r[i].x, r[i].y, r[i].z, r[i].w};
#pragma unroll
                    for (int q = 0; q < 4; ++q) {
                        const auto lo = __builtin_amdgcn_cvt_pk_f32_fp8((int)ww[q], false); const auto hh = __builtin_amdgcn_cvt_pk_f32_fp8((int)ww[q], true);
                        acc[4 * q] = fmaf(w, lo[0], acc[4 * q]); acc[4 * q + 1] = fmaf(w, lo[1], acc[4 * q + 1]); acc[4 * q + 2] = fmaf(w, hh[0], acc[4 * q + 2]); acc[4 * q + 3] = fmaf(w, hh[1], acc[4 * q + 3]);
                    }
                }
#else
                uint4 r0[8], r1[8];
#pragma unroll
                for (int i = 0; i < 8; ++i) { const int e = __builtin_amdgcn_readlane(esel, kb + hb * 8 + i); const unsigned char* rp = V + (size_t)e * 2048 + lane * 16; r0[i] = *(const uint4*)(rp); r1[i] = *(const uint4*)(rp + 1024); }
#pragma unroll
                for (int i = 0; i < 8; ++i) {
                    const float w = __int_as_float(__builtin_amdgcn_readlane(__float_as_int(wv), (hb * 8 + i) * 4));
                    acc[0] = fmaf(w, bflo(r0[i].x), acc[0]); acc[1] = fmaf(w, bfhi(r0[i].x), acc[1]); acc[2] = fmaf(w, bflo(r0[i].y), acc[2]); acc[3] = fmaf(w, bfhi(r0[i].y), acc[3]);
                    acc[4] = fmaf(w, bflo(r0[i].z), acc[4]); acc[5] = fmaf(w, bfhi(r0[i].z), acc[5]); acc[6] = fmaf(w, bflo(r0[i].w), acc[6]); acc[7] = fmaf(w, bfhi(r0[i].w), acc[7]);
                    acc[8] = fmaf(w, bflo(r1[i].x), acc[8]); acc[9] = fmaf(w, bfhi(r1[i].x), acc[9]); acc[10] = fmaf(w, bflo(r1[i].y), acc[10]); acc[11] = fmaf(w, bfhi(r1[i].y), acc[11]);
                    acc[12] = fmaf(w, bflo(r1[i].z), acc[12]); acc[13] = fmaf(w, bfhi(r1[i].z), acc[13]); acc[14] = fmaf(w, bflo(r1[i].w), acc[14]); acc[15] = fmaf(w, bfhi(r1[i].w), acc[15]);
                }
#endif
            }
        }
        float* hrow = P.out + (size_t)t * D;
#if TAB_FP8
        const int c0 = lane * 16, c1 = lane * 16 + 8;
#else
        const int c0 = lane * 8, c1 = 512 + lane * 8;
#endif
        float4 h0 = *(const float4*)(hrow + c0), h1 = *(const float4*)(hrow + c0 + 4), h2 = *(const float4*)(hrow + c1), h3 = *(const float4*)(hrow + c1 + 4);
        h0.x += acc[0]; h0.y += acc[1]; h0.z += acc[2]; h0.w += acc[3]; h1.x += acc[4]; h1.y += acc[5]; h1.z += acc[6]; h1.w += acc[7];
        h2.x += acc[8]; h2.y += acc[9]; h2.z += acc[10]; h2.w += acc[11]; h3.x += acc[12]; h3.y += acc[13]; h3.z += acc[14]; h3.w += acc[15];
        float ss = h0.x * h0.x + h0.y * h0.y + h0.z * h0.z + h0.w * h0.w + h1.x * h1.x + h1.y * h1.y + h1.z * h1.z + h1.w * h1.w
                 + h2.x * h2.x + h2.y * h2.y + h2.z * h2.z + h2.w * h2.w + h3.x * h3.x + h3.y * h3.y + h3.z * h3.z + h3.w * h3.w;
        ss = wave_sum(ss);
        const float rn = rsqrtf(ss * (1.f / D) + EPS);
        if (l == DEPTH - 1) {
            const float* g = P.norm_final;
            const float4 g0 = *(const float4*)(g + c0), g1 = *(const float4*)(g + c0 + 4), g2 = *(const float4*)(g + c1), g3 = *(const float4*)(g + c1 + 4);
            *(float4*)(hrow + c0) = make_float4(h0.x * rn * g0.x, h0.y * rn * g0.y, h0.z * rn * g0.z, h0.w * rn * g0.w);
            *(float4*)(hrow + c0 + 4) = make_float4(h1.x * rn * g1.x, h1.y * rn * g1.y, h1.z * rn * g1.z, h1.w * rn * g1.w);
            *(float4*)(hrow + c1) = make_float4(h2.x * rn * g2.x, h2.y * rn * g2.y, h2.z * rn * g2.z, h2.w * rn * g2.w);
            *(float4*)(hrow + c1 + 4) = make_float4(h3.x * rn * g3.x, h3.y * rn * g3.y, h3.z * rn * g3.z, h3.w * rn * g3.w);
        } else {
            *(float4*)(hrow + c0) = h0; *(float4*)(hrow + c0 + 4) = h1; *(float4*)(hrow + c1) = h2; *(float4*)(hrow + c1 + 4) = h3;
            const float* g = P.norm_mix + (l + 1) * D;
            const float4 g0 = *(const float4*)(g + c0), g1 = *(const float4*)(g + c0 + 4), g2 = *(const float4*)(g + c1), g3 = *(const float4*)(g + c1 + 4);
            uint4 o0, o1;
            o0.x = pack2(h0.x * rn * g0.x, h0.y * rn * g0.y); o0.y = pack2(h0.z * rn * g0.z, h0.w * rn * g0.w); o0.z = pack2(h1.x * rn * g1.x, h1.y * rn * g1.y); o0.w = pack2(h1.z * rn * g1.z, h1.w * rn * g1.w);
            o1.x = pack2(h2.x * rn * g2.x, h2.y * rn * g2.y); o1.y = pack2(h2.z * rn * g2.z, h2.w * rn * g2.w); o1.z = pack2(h3.x * rn * g3.x, h3.y * rn * g3.y); o1.w = pack2(h3.z * rn * g3.z, h3.w * rn * g3.w);
            *(uint4*)(XNw + (size_t)t * D + c0) = o0; *(uint4*)(XNw + (size_t)t * D + c1) = o1;
        }
    }
}


constexpr size_t WS_PART = WS_PROJ;
static_assert((size_t)8 * T * HK * 4 <= WS_K - WS_PROJ, "PART alias");
constexpr int XI_X = 0, XI_RANK = 1, XI_J = 2, XI_NX = 3, XI_NLOC = 4;
constexpr int CTL_CENSUS = 4096;
constexpr int CTL_BYTES = (CTL_CENSUS + 16) * 4;

__device__ __forceinline__ float dot16_fp8(const float (&xf)[16], const uint4& r) {
    float d0 = 0.f, d1 = 0.f;
    const unsigned w[4] = {r.x, r.y, r.z, r.w};
#pragma unroll
    for (int q = 0; q < 4; ++q) {
        const auto lo = __builtin_amdgcn_cvt_pk_f32_fp8((int)w[q], false); const auto hh = __builtin_amdgcn_cvt_pk_f32_fp8((int)w[q], true);
        d0 = fmaf(xf[4 * q], lo[0], d0); d1 = fmaf(xf[4 * q + 1], lo[1], d1); d0 = fmaf(xf[4 * q + 2], hh[0], d0); d1 = fmaf(xf[4 * q + 3], hh[1], d1);
    }
    return d0 + d1;
}
template <int M1, int M2, int M3, class TT>
__device__ __forceinline__ void red16x3(TT (&p)[16], int lane) {
#pragma unroll
    for (int i = 0; i < 8; ++i) { const bool up = lane & M1; const TT send = up ? p[i] : p[i + 8], keep = up ? p[i + 8] : p[i]; p[i] = keep + __shfl_xor(send, M1, 64); }
#pragma unroll
    for (int i = 0; i < 4; ++i) { const bool up = lane & M2; const TT send = up ? p[i] : p[i + 4], keep = up ? p[i + 4] : p[i]; p[i] = keep + __shfl_xor(send, M2, 64); }
#pragma unroll
    for (int i = 0; i < 2; ++i) { const bool up = lane & M3; const TT send = up ? p[i] : p[i + 2], keep = up ? p[i + 2] : p[i]; p[i] = keep + __shfl_xor(send, M3, 64); }
}
__device__ __forceinline__ void phase_gu(const Params& P, int l, const volatile int* xi) {
    const unsigned char* XQ = P.ws + WS_XQ;
    const float* XSc = (const float*)(P.ws + WS_XS);
    const int* EXPp = (const int*)(P.ws + WS_EXP);
    float* PART = (float*)(P.ws + WS_PART);
    const int tid = tidx(), lane = tid & 63, w = tid >> 6, g = lane >> 3, c = lane & 7;
    int xo_ = 0; asm volatile("" : "+v"(xo_));
    const int j = __builtin_amdgcn_readfirstlane(xi[xo_ + XI_J]), nx = __builtin_amdgcn_readfirstlane(xi[xo_ + XI_NX]), nloc = __builtin_amdgcn_readfirstlane(xi[xo_ + XI_NLOC]), rank = __builtin_amdgcn_readfirstlane(xi[xo_ + XI_RANK]);
    const int t0 = rank * 4 + w, st = nloc * 4;
    const int n = (t0 < T) ? (T - t0 + st - 1) / st : 0;
    const int i0 = 8 * (c & 1) + 4 * ((c >> 1) & 1) + 2 * ((c >> 2) & 1);
    for (int sl = j; sl < 8 && n > 0; sl += nx) {
        const unsigned char* Us = P.ws + WS_TABU + ((size_t)(l * 8 + sl) * NEXP) * 128;
        const unsigned co = (unsigned)c << 4;
        float* part = PART + (size_t)sl * T * HK;
        const unsigned char* xs = XQ + sl * 128 + c * 16;
#define GU_TK(k) (t0 + (((k) < n) ? (k) : (n - 1)) * st)
#define GU_LOADE(S, t) do { S##lo = EXPp[(size_t)(t) * HK + lane]; S##hi = EXPp[(size_t)(t) * HK + 64 + lane]; } while (0)
#define GU_LOADX(S, t) do { S##a = *(const uint4*)(xs + (size_t)(t) * D); S##s = XSc[t]; } while (0)
#define GU_ISSUE(R, S) do { _Pragma("unroll") for (int i = 0; i < 16; ++i) { \
            const int e = __builtin_amdgcn_ds_bpermute((((8 * i) & 63) + g) << 2, (i < 8) ? S##lo : S##hi); R[i] = *(const uint4*)(Us + (((unsigned)e << 7) | co)); } } while (0)
#define GU_FINISH(R, S, t) do { \
            int p[16]; \
            _Pragma("unroll") for (int i = 0; i < 16; ++i) { int d_ = __builtin_amdgcn_sdot4((int)S##a.x, (int)R[i].x, 0, false); d_ = __builtin_amdgcn_sdot4((int)S##a.y, (int)R[i].y, d_, false); \
                d_ = __builtin_amdgcn_sdot4((int)S##a.z, (int)R[i].z, d_, false); p[i] = __builtin_amdgcn_sdot4((int)S##a.w, (int)R[i].w, d_, false); } \
            red16x3<1, 2, 4, int>(p, lane); \
            part[(size_t)(t) * HK + 8 * i0 + g] = (float)p[0] * S##s; part[(size_t)(t) * HK + 8 * (i0 + 1) + g] = (float)p[1] * S##s; } while (0)
        int eAlo, eAhi, eBlo, eBhi; uint4 xAa, xBa; float xAs, xBs; uint4 rA[16], rB[16];
        GU_LOADE(eA, GU_TK(0)); GU_LOADX(xA, GU_TK(0)); GU_LOADE(eB, GU_TK(1));
        GU_ISSUE(rA, eA);
        for (int k = 0; k < n; k += 2) {
            GU_LOADX(xB, GU_TK(k + 1)); GU_ISSUE(rB, eB); GU_LOADE(eA, GU_TK(k + 2));
            GU_FINISH(rA, xA, GU_TK(k));
            GU_LOADX(xA, GU_TK(k + 2)); GU_ISSUE(rA, eA); GU_LOADE(eB, GU_TK(k + 3));
            GU_FINISH(rB, xB, GU_TK(k + 1));
        }
#undef GU_TK
#undef GU_LOADE
#undef GU_LOADX
#undef GU_ISSUE
#undef GU_FINISH
    }
}
__device__ __forceinline__ void phase_gw(const Params& P, int l) {
    const int* EXPp = (const int*)(P.ws + WS_EXP);
    const float* GATEp = (const float*)(P.ws + WS_GATE);
    const float* PART = (const float*)(P.ws + WS_PART);
    const float* SU = (const float*)(P.ws + WS_TSCU) + (size_t)l * NEXP;
    const float* SV = (const float*)(P.ws + WS_TSCV) + (size_t)l * NEXP;
    unsigned char* WQ = P.ws + WS_WQ8;
    float* WSC = (float*)(P.ws + WS_WSC);
    const int lane = tidx() & 63;
    for (int tb = gwave() * 4; tb < T; tb += nwave() * 4) {
        float wv[4][2];
#pragma unroll
        for (int q = 0; q < 4; ++q)
#pragma unroll
            for (int hk = 0; hk < 2; ++hk) {
                const size_t i = (size_t)(tb + q) * HK + hk * 64 + lane;
                float s = 0.f;
#pragma unroll
                for (int x = 0; x < 8; ++x) s += PART[(size_t)x * T * HK + i];
                const int e = EXPp[i];
                wv[q][hk] = GATEp[i] * gelu_exact(s * SU[e]) * SV[e];
            }
#pragma unroll
        for (int q = 0; q < 4; ++q) {
            float am = fmaxf(fabsf(wv[q][0]), fabsf(wv[q][1]));
#pragma unroll
            for (int m = 32; m >= 1; m >>= 1) am = fmaxf(am, __shfl_xor(am, m, 64));
            const float sc = (am > 0.f) ? am * (1.f / 448.f) : 1.f, is = 1.f / sc;
            const int pk = __builtin_amdgcn_cvt_pk_fp8_f32(wv[q][0] * is, wv[q][1] * is, 0, false);
            WQ[(size_t)(tb + q) * HK + lane] = (unsigned char)(pk & 255);
            WQ[(size_t)(tb + q) * HK + 64 + lane] = (unsigned char)((pk >> 8) & 255);
            if (lane == 0) WSC[tb + q] = sc;
        }
    }
}
typedef int v2i_t __attribute__((ext_vector_type(2)));
typedef unsigned u32x4_t __attribute__((ext_vector_type(4)));
typedef __attribute__((ext_vector_type(4))) float f32x4;
constexpr int GV_PIECE = 1024 + 16;
constexpr int GV_TILE = 16 * GV_PIECE;
static_assert(4 * GV_TILE + 4 * 512 <= LDS_TOTAL, "gv LDS");
__device__ __forceinline__ void phase_gv(const Params& P, int l, const volatile int* xi, char* lds) {
    const int* EXPp = (const int*)(P.ws + WS_EXP);
    const unsigned char* WQ = P.ws + WS_WQ8;
    const float* WSC = (const float*)(P.ws + WS_WSC);
    const int tid = tidx(), lane = tid & 63, w = __builtin_amdgcn_readfirstlane(tid >> 6), g = lane >> 3, pos = lane & 7;
    int xo_ = 0; asm volatile("" : "+v"(xo_));
    const int j = __builtin_amdgcn_readfirstlane(xi[xo_ + XI_J]), nx = __builtin_amdgcn_readfirstlane(xi[xo_ + XI_NX]), nloc = __builtin_amdgcn_readfirstlane(xi[xo_ + XI_NLOC]), rank = __builtin_amdgcn_readfirstlane(xi[xo_ + XI_RANK]);
    const int t0 = rank * 4 + w, st = nloc * 4;
    const int n = (t0 < T) ? (T - t0 + st - 1) / st : 0;
    char* tile = lds + w * GV_TILE;
    float* strip = (float*)(lds + 4 * GV_TILE) + w * 128;
    typedef __attribute__((address_space(3))) v2i_t* ldsv2_t;
    const unsigned co = (unsigned)(pos ^ g) << 4;
    const int rr = (lane & 15) >> 1, kq = lane >> 4;
    const int rdo = kq * GV_PIECE + rr * 128 + (lane & 1) * 8;
    const bool row0 = (lane & 15) == 0;
    __syncthreads();
    for (int sl = j; sl < 8 && n > 0; sl += nx) {
        const unsigned char* Vs = P.ws + WS_TABV + ((size_t)(l * 8 + sl) * NEXP) * 128;
        float* hrow = P.out + sl * 128 + 2 * lane;
#define GV_TK(k) (t0 + (((k) < n) ? (k) : (n - 1)) * st)
#define GV_LOADE(S, t) do { S##el = EXPp[(size_t)(t) * HK + lane]; S##eh = EXPp[(size_t)(t) * HK + 64 + lane]; } while (0)
#define GV_ISSUE(R, S) do { _Pragma("unroll") for (int i = 0; i < 16; ++i) { \
            const int e = __builtin_amdgcn_ds_bpermute((((8 * i) & 63) + g) << 2, (i < 8) ? S##el : S##eh); R[i] = *(const u32x4_t*)(Vs + (((unsigned)e << 7) | co)); } } while (0)
#define GV_LOADT(S, kk) do { const int t_ = GV_TK(kk); \
            S##a0 = 0; S##a1 = 0; S##a2 = 0; S##a3 = 0; \
            if (row0) { const long* wp = (const long*)(WQ + (size_t)t_ * HK + kq * 8); S##a0 = wp[0]; S##a1 = wp[4]; S##a2 = wp[8]; S##a3 = wp[12]; } \
            S##ws = ((kk) < n) ? WSC[t_] : 0.f; \
            S##hv = *(const float2*)(hrow + (size_t)t_ * D); } while (0)
#define GV_TOKEN(R, S, kk) do { \
            const int t = GV_TK(kk); \
            _Pragma("unroll") for (int i = 0; i < 16; ++i) *(u32x4_t*)(tile + i * GV_PIECE + lane * 16) = R[i]; \
            f32x4 acc[8]; \
            _Pragma("unroll") for (int nt = 0; nt < 8; ++nt) acc[nt] = (f32x4){0.f, 0.f, 0.f, 0.f}; \
            _Pragma("unroll") for (int s4 = 0; s4 < 4; ++s4) { \
                const long av = (s4 == 0) ? S##a0 : (s4 == 1) ? S##a1 : (s4 == 2) ? S##a2 : S##a3; \
                _Pragma("unroll") for (int nt = 0; nt < 8; ++nt) { \
                    const v2i_t bv = __builtin_amdgcn_ds_read_tr8_b64_v2i32((ldsv2_t)(void*)(tile + (4 * s4) * GV_PIECE + rdo + ((nt ^ rr) << 4))); \
                    acc[nt] = __builtin_amdgcn_mfma_f32_16x16x32_fp8_fp8(av, __builtin_bit_cast(long, bv), acc[nt], 0, 0, 0); } } \
            if (lane < 16) { _Pragma("unroll") for (int nt = 0; nt < 8; ++nt) strip[16 * nt + lane] = acc[nt][0]; }        \
            { const float2 o2 = *(const float2*)(strip + 2 * lane); \
              if ((kk) < n) *(float2*)(hrow + (size_t)t * D) = make_float2(S##hv.x + S##ws * o2.x, S##hv.y + S##ws * o2.y); } } while (0)
        int Ael, Aeh, Bel, Beh; u32x4_t rA[16], rB[16];
        long Pa0, Pa1, Pa2, Pa3, Qa0, Qa1, Qa2, Qa3; float Pws, Qws; float2 Phv, Qhv;
        GV_LOADE(A, GV_TK(0)); GV_LOADE(B, GV_TK(1));
        GV_ISSUE(rA, A); GV_LOADT(P, 0);
        for (int k = 0; k < n; k += 2) {
            GV_ISSUE(rB, B); GV_LOADE(A, GV_TK(k + 2)); GV_LOADT(Q, k + 1);
            GV_TOKEN(rA, P, k);
            GV_ISSUE(rA, A); GV_LOADE(B, GV_TK(k + 3)); GV_LOADT(P, k + 2);
            GV_TOKEN(rB, Q, k + 1);
        }
#undef GV_TK
#undef GV_LOADE
#undef GV_ISSUE
#undef GV_LOADT
#undef GV_TOKEN
    }
    __syncthreads();
}
__device__ __forceinline__ void phase_gnorm(const Params& P, int l) {
    const int lane = tidx() & 63, nw = nwave();
    bf16* XNw = (bf16*)(P.ws + WS_XN);
    const float4* g = (const float4*)((l == DEPTH - 1) ? P.norm_final : (P.norm_mix + (l + 1) * D));
    for (int t = gwave(); t < T; t += 2 * nw) {
        const int t2 = (t + nw < T) ? (t + nw) : t;
        float4 v[2][4];
#pragma unroll
        for (int q = 0; q < 4; ++q) { v[0][q] = ((const float4*)(P.out + (size_t)t * D))[q * 64 + lane]; v[1][q] = ((const float4*)(P.out + (size_t)t2 * D))[q * 64 + lane]; }
#pragma unroll
        for (int u = 0; u < 2; ++u) {
            float ss = 0.f;
#pragma unroll
            for (int q = 0; q < 4; ++q) ss += v[u][q].x * v[u][q].x + v[u][q].y * v[u][q].y + v[u][q].z * v[u][q].z + v[u][q].w * v[u][q].w;
            ss = wave_sum(ss);
            const float rn = rsqrtf(ss * (1.f / D) + EPS);
            const int tt = u ? t2 : t;
            if (u == 0 || t2 != t) {
                float4* hr = (float4*)(P.out + (size_t)tt * D);
#pragma unroll
                for (int q = 0; q < 4; ++q) {
                    const float4 gg = g[q * 64 + lane];
                    const float4 o = make_float4(v[u][q].x * rn * gg.x, v[u][q].y * rn * gg.y, v[u][q].z * rn * gg.z, v[u][q].w * rn * gg.w);
                    if (l == DEPTH - 1) hr[q * 64 + lane] = o;
                    else { uint2 uu; uu.x = pack2(o.x, o.y); uu.y = pack2(o.z, o.w); ((uint2*)(XNw + (size_t)tt * LDX))[q * 64 + lane] = uu; }
                }
            }
        }
    }
}

#define XB_TMO      128
#define XB_XCNT(j)  (256  + 64 * (j))
#define XB_XSUB(j)  (1280 + 64 * (j))
#define XB_XGEN(j)  (2304 + 64 * (j))
#define XB_TOP      3328
#define XB_TOPGEN   3392
#define XCD_BAR_WORDS 3456
#define XB_SPIN_CAP (1u << 22)
#define LAS __attribute__((address_space(3)))
__device__ __forceinline__ unsigned xb_ld(unsigned* p)              { return __hip_atomic_load(p, __ATOMIC_RELAXED, __HIP_MEMORY_SCOPE_AGENT); }
__device__ __forceinline__ unsigned xb_add(unsigned* p, unsigned v) { return __hip_atomic_fetch_add(p, v, __ATOMIC_RELAXED, __HIP_MEMORY_SCOPE_AGENT); }
__device__ __forceinline__ unsigned xb_xcc_id() { return (unsigned)__builtin_amdgcn_s_getreg((3 << 11) | 20) & 0xFu; }
#define XB_SPIN(cond, bar) do { unsigned _sp = 0; while (cond) { __builtin_amdgcn_s_sleep(1); \
    if ((++_sp & 255u) == 0u) { if (xb_ld(&(bar)[XB_TMO])) break; if (_sp > XB_SPIN_CAP) { atomicAdd(&(bar)[XB_TMO], 1u); break; } } } } while (0)
struct XcdBarrier { unsigned* bar; unsigned x; volatile LAS unsigned* st; };
__device__ __forceinline__ XcdBarrier xcd_barrier_post(unsigned* bar, volatile LAS unsigned* st) {
    XcdBarrier b; b.bar = bar; b.x = xb_xcc_id(); b.st = st;
    if (__builtin_amdgcn_workitem_id_x() == 0) (void)xb_add(&bar[XB_XCNT(b.x)], 1u);
    return b;
}
__device__ __forceinline__ void xcd_barrier_complete(unsigned* bar, unsigned x, unsigned& nloc, unsigned& nx) {
    const unsigned G = gridDim.x * gridDim.y * gridDim.z;
    unsigned sum, cnt, mine, sp = 0u;
    for (;;) {
        sum = 0u; cnt = 0u; mine = 0u;
#pragma unroll
        for (unsigned j = 0; j < 16; ++j) { const unsigned c = xb_ld(&bar[XB_XCNT(j)]); sum += c; cnt += (c > 0u) ? 1u : 0u; mine = (j == x) ? c : mine; }
        if (sum == G) break;
        __builtin_amdgcn_s_sleep(1);
        if ((++sp & 255u) == 0u) { if (xb_ld(&bar[XB_TMO])) break; if (sp > XB_SPIN_CAP) { atomicAdd(&bar[XB_TMO], 1u); break; } }
    }
    nloc = mine > 0u ? mine : 1u; nx = cnt > 0u ? cnt : 1u;
}
__device__ __forceinline__ void xcd_barrier(const XcdBarrier& b) {
    asm volatile("s_waitcnt vmcnt(0)" ::: "memory");
    __syncthreads();
    if (__builtin_amdgcn_workitem_id_x() == 0) {
        unsigned* bar = b.bar;
        __builtin_amdgcn_s_waitcnt(0);
        unsigned nloc = b.st[0], nx = b.st[1];
        if (nloc == 0u) { xcd_barrier_complete(bar, b.x, nloc, nx); b.st[0] = nloc; b.st[1] = nx; }
        const unsigned old = xb_add(&bar[XB_XSUB(b.x)], 1u);
        const unsigned gen = old / nloc;
        if (old + 1u == (gen + 1u) * nloc) {
            __builtin_amdgcn_fence(__ATOMIC_RELEASE, "agent");
            asm volatile("s_waitcnt vmcnt(0)" ::: "memory");
            const unsigned og = xb_add(&bar[XB_TOP], 1u);
            const unsigned tg = og / nx;
            if (og + 1u == (tg + 1u) * nx) xb_add(&bar[XB_TOPGEN], 1u);
            else XB_SPIN(xb_ld(&bar[XB_TOPGEN]) == tg, bar);
            __builtin_amdgcn_fence(__ATOMIC_ACQUIRE, "agent");
            xb_add(&bar[XB_XGEN(b.x)], 1u);
            asm volatile("s_waitcnt vmcnt(0)" ::: "memory");
        } else {
            XB_SPIN(xb_ld(&bar[XB_XGEN(b.x)]) == gen, bar);
            __builtin_amdgcn_fence(__ATOMIC_ACQUIRE, "agent");
            asm volatile("s_waitcnt vmcnt(0)" ::: "memory");
        }
    }
    __syncthreads();
}

constexpr float QSCALE = 0.10206207261596575f * 1.4426950408889634f;

__device__ __forceinline__ void phase_gemm1(const Params& P, int l, char* lds) {
    unsigned char* ws = P.ws;
    const bf16* XN = (const bf16*)(ws + WS_XN);
    bf16* PROJ = (bf16*)(ws + WS_PROJ);
    bf16* Kb = (bf16*)(ws + WS_K);
    const float* rope = (const float*)(ws + WS_ROPE);
    const bf16* W = (const bf16*)(ws + WS_WIN) + (size_t)l * DINP * LDW;
    gemm_t<false>(W, LDW, DINP, XN, LDX, T, D, C_KR / 128, [&](int n0, int t0, const f32x16& acc, int r32, int hi, float) {
        const int t = t0 + r32;
        if (n0 < C_KR) {
            bf16* pr = PROJ + (size_t)t * DINP + n0 + 4 * hi;
#pragma unroll
            for (int g = 0; g < 4; ++g) { uint2 o; o.x = cvtpk(acc[4 * g], acc[4 * g + 1]); o.y = cvtpk(acc[4 * g + 2], acc[4 * g + 3]); *(uint2*)(pr + 8 * g) = o; }
        } else if (n0 == C_KR) {
            const int b = t / S, s = t % S;
            uint2 o1[2], o2[2];
#pragma unroll
            for (int g = 0; g < 2; ++g) {
                const float4 cs0 = *(const float4*)(rope + ((size_t)s * 16 + 8 * g + 4 * hi) * 2), cs1 = *(const float4*)(rope + ((size_t)s * 16 + 8 * g + 4 * hi) * 2 + 4);
                const float x10 = acc[4 * g], x11 = acc[4 * g + 1], x12 = acc[4 * g + 2], x13 = acc[4 * g + 3];
                const float x20 = acc[8 + 4 * g], x21 = acc[8 + 4 * g + 1], x22 = acc[8 + 4 * g + 2], x23 = acc[8 + 4 * g + 3];
                o1[g].x = cvtpk(x10 * cs0.x - x20 * cs0.y, x11 * cs0.z - x21 * cs0.w); o1[g].y = cvtpk(x12 * cs1.x - x22 * cs1.y, x13 * cs1.z - x23 * cs1.w);
                o2[g].x = cvtpk(x20 * cs0.x + x10 * cs0.y, x21 * cs0.z + x11 * cs0.w); o2[g].y = cvtpk(x22 * cs1.x + x12 * cs1.y, x23 * cs1.z + x13 * cs1.w);
            }
#pragma unroll
            for (int h = 0; h < NH; ++h) {
                bf16* kr = Kb + ((size_t)(b * NH + h) * S + s) * DQK + 64 + 4 * hi;
                *(uint2*)(kr) = o1[0]; *(uint2*)(kr + 8) = o1[1]; *(uint2*)(kr + 16) = o2[0]; *(uint2*)(kr + 24) = o2[1];
            }
        }
    }, [&](int t, int n, const float4& v) {
        uint2 o; o.x = cvtpk(v.x, v.y); o.y = cvtpk(v.z, v.w);
        *(uint2*)(PROJ + (size_t)t * DINP + n) = o;
    }, [](float) { return 1.f; }, lds);
}
__device__ __forceinline__ void phase_gemm2(const Params& P, int l, char* lds) {
    unsigned char* ws = P.ws;
    const bf16* PROJ = (const bf16*)(ws + WS_PROJ);
    const float* rope = (const float*)(ws + WS_ROPE);
    const int lane = tidx() & 63;
    {
        const bf16* W = (const bf16*)(ws + WS_WUQ) + (size_t)l * 768 * QR;
        bf16* Qb = (bf16*)(ws + WS_Q);
        gemm_t<true>(W, QR, 768, PROJ + C_CQ, DINP, T, QR, 768 / 128, [](int, int, const f32x16&, int, int, float) {},
            [&](int t, int n, const float4& v) {
                const int b = t / S, s = t % S, h = n / DQK, d = n % DQK;
                float4 o = v;
                const float4 up = make_float4(__shfl(v.x, lane + 4, 64), __shfl(v.y, lane + 4, 64), __shfl(v.z, lane + 4, 64), __shfl(v.w, lane + 4, 64));
                const float4 dn = make_float4(__shfl(v.x, lane - 4, 64), __shfl(v.y, lane - 4, 64), __shfl(v.z, lane - 4, 64), __shfl(v.w, lane - 4, 64));
                if (d >= 64) {
                    const bool first = d < 80;
                    const int f = first ? (d - 64) : (d - 80);
                    const float4 cs0 = *(const float4*)(rope + ((size_t)s * 16 + f) * 2), cs1 = *(const float4*)(rope + ((size_t)s * 16 + f) * 2 + 4);
                    if (first) o = make_float4(v.x * cs0.x - up.x * cs0.y, v.y * cs0.z - up.y * cs0.w, v.z * cs1.x - up.z * cs1.y, v.w * cs1.z - up.w * cs1.w);
                    else       o = make_float4(v.x * cs0.x + dn.x * cs0.y, v.y * cs0.z + dn.y * cs0.w, v.z * cs1.x + dn.z * cs1.y, v.w * cs1.z + dn.w * cs1.w);
                }
                uint2 u; u.x = cvtpk(o.x, o.y); u.y = cvtpk(o.z, o.w);
                *(uint2*)(Qb + ((size_t)(b * NH + h) * S + s) * DQK + d) = u;
            }, [](float ssq) { return rsqrtf(ssq * (1.f / QR) + EPS) * QSCALE; }, lds);
    }
    {
        const bf16* W = (const bf16*)(ws + WS_WUKV) + (size_t)l * 1024 * KVR;
        bf16* Kb = (bf16*)(ws + WS_K); bf16* Vb = (bf16*)(ws + WS_V);
        gemm_t<true>(W, KVR, 1024, PROJ + C_CKV, DINP, T, KVR, 1024 / 128, [](int, int, const f32x16&, int, int, float) {},
            [&](int t, int n, const float4& v) {
                const int b = t / S, s = t % S;
                uint2 u; u.x = cvtpk(v.x, v.y); u.y = cvtpk(v.z, v.w);
                if (n < 512) *(uint2*)(Kb + ((size_t)(b * NH + (n >> 6)) * S + s) * DQK + (n & 63)) = u;
                else         *(uint2*)(Vb + ((size_t)(b * NH + ((n - 512) >> 6)) * S + s) * DV + (n & 63)) = u;
            }, [](float ssq) { return rsqrtf(ssq * (1.f / KVR) + EPS); }, lds);
    }
}
__device__ __forceinline__ void phase_gemm3(const Params& P, int l, char* lds) {
    unsigned char* ws = P.ws;
    const bf16* Yb = (const bf16*)(ws + WS_XN);
    const bf16* W = (const bf16*)(ws + WS_WOUT) + (size_t)l * D * LDW;
    const float* hin = (l == 0) ? P.x : P.out;
    float* out = P.out;
    gemm_t<false>(W, LDW, D, Yb, LDX, T, D, D / 128, [](int, int, const f32x16&, int, int, float) {}, [&](int t, int n, const float4& v) {
        const size_t idx = (size_t)t * D + n;
        const float4 hv = *(const float4*)(hin + idx);
        *(float4*)(out + idx) = make_float4(hv.x + v.x, hv.y + v.y, hv.z + v.z, hv.w + v.w);
    }, [](float) { return 1.f; }, lds);
}

#define GSYNC() do { XcdBarrier xb_; { __attribute__((address_space(1))) char* gp_ = (__attribute__((address_space(1))) char*)(char*)(P.ws + WS_CTL); asm volatile("" : "+s"(gp_)); xb_.bar = (unsigned*)(char*)gp_; } \
    xb_.x = xb_xcc_id(); xb_.st = (volatile LAS unsigned*)&xb_words; xcd_barrier(xb_); } while (0)
#define PHASE(stmt) { const Params Q = launder(P); stmt; }
__global__ void __launch_bounds__(NTHREADS, 2) k_all(Params P) {
    __shared__ __attribute__((aligned(16))) char sm[LDS_TOTAL];
    __shared__ uint4 xb_words;
    cg::grid_group grid = cg::this_grid();
    if (__builtin_amdgcn_workitem_id_x() == 0) xb_words = make_uint4(0u, 0u, 0u, 0u);
    __syncthreads();
    (void)xcd_barrier_post((unsigned*)(P.ws + WS_CTL), (volatile LAS unsigned*)&xb_words);
    __shared__ int xinfo[8];
    if (__builtin_amdgcn_workitem_id_x() == 0) {
        const unsigned x = xb_xcc_id();
        xinfo[XI_X] = (int)x; xinfo[XI_RANK] = (int)xb_add((unsigned*)(P.ws + WS_CTL) + CTL_CENSUS + x, 1u);
    }
    PHASE(phase_prep(Q, sm));
    PHASE(phase_norm(Q.x, Q.norm_mix, (bf16*)(Q.ws + WS_XN)));
    if (P.ws == nullptr) grid.sync();
    GSYNC();
    if (__builtin_amdgcn_workitem_id_x() == 0) {
        unsigned* cen = (unsigned*)(P.ws + WS_CTL) + CTL_CENSUS;
        const int x = xinfo[XI_X]; int nx = 0, jj = 0;
        for (int q = 0; q < 16; ++q) { const unsigned cq = xb_ld(cen + q); if (cq) { if (q < x) ++jj; ++nx; } }
        xinfo[XI_J] = jj; xinfo[XI_NX] = nx; xinfo[XI_NLOC] = (int)xb_ld(cen + x);
    }
    __syncthreads();
    for (int l = 0; l < DEPTH; ++l) {
        PHASE(phase_gemm1(Q, l, sm));
#if PROBE_DUP & 2
        PHASE(phase_gemm1(Q, l, sm));
#endif
        GSYNC();
        PHASE(phase_mixlocal(Q, l, sm));
#if PROBE_DUP & 256
        PHASE(phase_mixlocal(Q, l, sm));
#endif
        PHASE(phase_gemm2(Q, l, sm));
        GSYNC();
        PHASE(phase_attn(Q, sm));
        GSYNC();
        PHASE(phase_gemm3(Q, l, sm));
#if PROBE_DUP & 16
        if (l == 0) PHASE(phase_gemm3(Q, l, sm));
#endif
        GSYNC();
        PHASE(phase_norm_q(Q, l));
        GSYNC();
        PHASE(phase_route(Q, l, sm));
        GSYNC();
        PHASE(phase_gu(Q, l, xinfo));
        GSYNC();
        PHASE(phase_gw(Q, l));
        GSYNC();
        PHASE(phase_gv(Q, l, xinfo, sm));
        GSYNC();
        PHASE(phase_gnorm(Q, l));
        GSYNC();
    }
}

extern "C" void kernel_launch(void* const* d_in, const int* in_sizes, int n_in, void* d_out, int out_size, void* d_ws, size_t ws_size, hipStream_t stream) {
    static int grid = 0;
    if (grid == 0) {
        if (n_in != 18 || out_size != T * D || ws_size < WS_END) { fprintf(stderr, "kernel_launch: bad sizes n_in %d out %d ws %zu need %zu\n", n_in, out_size, ws_size, (size_t)WS_END); grid = -1; return; }
        int dev = 0, cus = 0, per_cu = 0;
        (void)hipGetDevice(&dev);
        (void)hipDeviceGetAttribute(&cus, hipDeviceAttributeMultiprocessorCount, dev);
        (void)hipOccupancyMaxActiveBlocksPerMultiprocessor(&per_cu, (const void*)k_all, NTHREADS, 0);
        if (per_cu > 2) per_cu = 2;
        if (per_cu < 1) { fprintf(stderr, "kernel_launch: occupancy query says %d\n", per_cu); grid = -1; return; }
        grid = cus * per_cu;
    }
    if (grid < 0) return;
    Params p{};
    p.x = (const float*)d_in[0]; p.norm_mix = (const float*)d_in[1]; p.w_in = (const float*)d_in[2]; p.conv_w = (const float*)d_in[3];
    p.pool_w = (const float*)d_in[4]; p.pool_scale = (const float*)d_in[5]; p.q_norm = (const float*)d_in[6]; p.w_uq = (const float*)d_in[7];
    p.kv_norm = (const float*)d_in[8]; p.w_uk = (const float*)d_in[9]; p.w_uv = (const float*)d_in[10]; p.w_out = (const float*)d_in[11];
    p.norm_ffn = (const float*)d_in[12]; p.peer_wq = (const float*)d_in[13]; p.peer_subkeys = (const float*)d_in[14]; p.peer_u = (const float*)d_in[15];
    p.peer_v = (const float*)d_in[16]; p.norm_final = (const float*)d_in[17];
    p.out = (float*)d_out; p.ws = (unsigned char*)d_ws;
    if (hipMemsetAsync((char*)d_ws + WS_CTL, 0, CTL_BYTES, stream) != hipSuccess) { fprintf(stderr, "kernel_launch: memset failed\n"); return; }
    void* args[] = {&p};
    hipError_t e = hipLaunchCooperativeKernel((const void*)k_all, dim3(grid), dim3(NTHREADS), args, 0, stream);
    if (e != hipSuccess) fprintf(stderr, "cooperative launch failed: %s (grid %d)\n", hipGetErrorString(e), grid);
}
```

```cpp
#include <hip/hip_runtime.h>
#include <hip/hip_cooperative_groups.h>
#include <cstdio>
#include <cstdint>
namespace cg = cooperative_groups;

#ifndef TAB_FP8
#define TAB_FP8 1
#endif
#ifndef PROBE_DUP
#define PROBE_DUP 0
#endif

constexpr int NB = 4, S = 8192, T = NB * S, D = 1024, DEPTH = 2;
constexpr int DIN = 1696, DINP = 1792;
constexpr int C_BG = 0, C_CG = 256, C_HC = 512, C_HP = 768, C_CQ = 1024, C_CKV = 1408, C_KR = 1664;
constexpr int QR = 384, KVR = 256, NH = 8, DQK = 96, DV = 64;
constexpr int PH = 8, NKEY = 128, NEXP = NKEY * NKEY, TOPK = 16, HK = PH * TOPK;
constexpr float EPS = 1e-6f;
constexpr int LDX = 1088;
constexpr int LDW = 1088;

typedef unsigned short bf16;

constexpr size_t WS_CTL   = 0;
constexpr size_t WS_ROPE  = 64 * 1024;
constexpr size_t WS_WIN   = WS_ROPE + (size_t)S * 16 * 2 * 4;
constexpr size_t WS_WUQ   = WS_WIN + (size_t)DEPTH * DINP * LDW * 2;
constexpr size_t WS_WUKV  = WS_WUQ + (size_t)DEPTH * 768 * QR * 2;
constexpr size_t WS_WOUT  = WS_WUKV + (size_t)DEPTH * 1024 * KVR * 2;
constexpr size_t WS_WPQ   = WS_WOUT + (size_t)DEPTH * D * LDW * 2;
constexpr size_t WS_XN    = ((WS_WPQ + (size_t)DEPTH * 2048 * LDW * 2 + 4095) / 4096) * 4096;
constexpr size_t WS_PROJ  = WS_XN + (size_t)T * LDX * 2;
constexpr size_t WS_Q     = WS_PROJ + (size_t)T * DINP * 2;
constexpr size_t WS_K     = WS_Q + (size_t)T * NH * DQK * 2;
constexpr size_t WS_V     = WS_K + (size_t)T * NH * DQK * 2;
constexpr size_t WS_EXP   = WS_V + (size_t)T * NH * DV * 2;
constexpr size_t WS_GATE  = WS_EXP + (size_t)T * HK * 4;
constexpr size_t TAB_ROWB = TAB_FP8 ? 1024 : 2048;
constexpr size_t WS_TABU  = WS_GATE + (size_t)T * HK * 4;
constexpr size_t WS_TABV  = WS_TABU + (size_t)DEPTH * NEXP * TAB_ROWB;
constexpr size_t WS_TSCU  = WS_TABV + (size_t)DEPTH * NEXP * TAB_ROWB;
constexpr size_t WS_TSCV  = WS_TSCU + (size_t)DEPTH * NEXP * 4;
constexpr size_t WS_XQ    = WS_TSCV + (size_t)DEPTH * NEXP * 4;
constexpr size_t WS_XS    = WS_XQ + (size_t)T * D;
constexpr size_t WS_WQ8   = WS_XS + (size_t)T * 4;
constexpr size_t WS_WSC   = WS_WQ8 + (size_t)T * HK;
constexpr size_t WS_END   = WS_WSC + (size_t)T * 4;
static_assert(WS_END <= (size_t)512 * 1024 * 1024, "workspace budget");

struct Params {
    const float* x; const float* norm_mix; const float* w_in; const float* conv_w; const float* pool_w; const float* pool_scale;
    const float* q_norm; const float* w_uq; const float* kv_norm; const float* w_uk; const float* w_uv; const float* w_out;
    const float* norm_ffn; const float* peer_wq; const float* peer_subkeys; const float* peer_u; const float* peer_v; const float* norm_final;
    float* out; unsigned char* ws;
};

__device__ __forceinline__ bf16 f2bf(float f) { unsigned u = __float_as_uint(f); u += 0x7fffu + ((u >> 16) & 1u); return (bf16)(u >> 16); }
__device__ __forceinline__ float bf2f(bf16 h) { return __uint_as_float(((unsigned)h) << 16); }
__device__ __forceinline__ float bflo(unsigned u) { return __uint_as_float(u << 16); }
__device__ __forceinline__ float bfhi(unsigned u) { return __uint_as_float(u & 0xffff0000u); }
__device__ __forceinline__ unsigned pack2(float a, float b) { return (unsigned)f2bf(a) | ((unsigned)f2bf(b) << 16); }
__device__ __forceinline__ float wave_sum(float v) {
#pragma unroll
    for (int m = 32; m >= 1; m >>= 1) v += __shfl_xor(v, m, 64);
    return v;
}
__device__ __forceinline__ float gelu_exact(float x) { return 0.5f * x * (1.f + erff(x * 0.70710678118654752f)); }

#define NTHREADS 256
__device__ __forceinline__ int tidx() { int t = (int)__builtin_amdgcn_workitem_id_x(); asm volatile("" : "+v"(t)); return t; }
__device__ __forceinline__ int gwave() { return blockIdx.x * (NTHREADS / 64) + (tidx() >> 6); }
__device__ __forceinline__ int nwave() { return gridDim.x * (NTHREADS / 64); }
__device__ __forceinline__ size_t gtid() { return (size_t)blockIdx.x * NTHREADS + tidx(); }
__device__ __forceinline__ size_t gnth() { return (size_t)gridDim.x * NTHREADS; }


__device__ __forceinline__ Params launder(const Params& P) {
    typedef __attribute__((address_space(1))) char* gp_t;
    gp_t g[20] = {(gp_t)(char*)P.x, (gp_t)(char*)P.norm_mix, (gp_t)(char*)P.w_in, (gp_t)(char*)P.conv_w, (gp_t)(char*)P.pool_w, (gp_t)(char*)P.pool_scale, (gp_t)(char*)P.q_norm, (gp_t)(char*)P.w_uq,
                  (gp_t)(char*)P.kv_norm, (gp_t)(char*)P.w_uk, (gp_t)(char*)P.w_uv, (gp_t)(char*)P.w_out, (gp_t)(char*)P.norm_ffn, (gp_t)(char*)P.peer_wq, (gp_t)(char*)P.peer_subkeys,
                  (gp_t)(char*)P.peer_u, (gp_t)(char*)P.peer_v, (gp_t)(char*)P.norm_final, (gp_t)(char*)P.out, (gp_t)(char*)P.ws};
    asm volatile("" : "+s"(g[0]), "+s"(g[1]), "+s"(g[2]), "+s"(g[3]), "+s"(g[4]), "+s"(g[5]), "+s"(g[6]), "+s"(g[7]), "+s"(g[8]), "+s"(g[9]));
    asm volatile("" : "+s"(g[10]), "+s"(g[11]), "+s"(g[12]), "+s"(g[13]), "+s"(g[14]), "+s"(g[15]), "+s"(g[16]), "+s"(g[17]), "+s"(g[18]), "+s"(g[19]));
    Params Q;
    Q.x = (const float*)(char*)g[0]; Q.norm_mix = (const float*)(char*)g[1]; Q.w_in = (const float*)(char*)g[2]; Q.conv_w = (const float*)(char*)g[3]; Q.pool_w = (const float*)(char*)g[4];
    Q.pool_scale = (const float*)(char*)g[5]; Q.q_norm = (const float*)(char*)g[6]; Q.w_uq = (const float*)(char*)g[7]; Q.kv_norm = (const float*)(char*)g[8]; Q.w_uk = (const float*)(char*)g[9];
    Q.w_uv = (const float*)(char*)g[10]; Q.w_out = (const float*)(char*)g[11]; Q.norm_ffn = (const float*)(char*)g[12]; Q.peer_wq = (const float*)(char*)g[13]; Q.peer_subkeys = (const float*)(char*)g[14];
    Q.peer_u = (const float*)(char*)g[15]; Q.peer_v = (const float*)(char*)g[16]; Q.norm_final = (const float*)(char*)g[17]; Q.out = (float*)(char*)g[18]; Q.ws = (unsigned char*)(char*)g[19];
    return Q;
}

typedef __attribute__((ext_vector_type(8))) short bf16x8;
typedef __attribute__((ext_vector_type(16))) float f32x16;
typedef __attribute__((ext_vector_type(2))) __bf16 bf2_t;
#define MFMA32(a, b, c) __builtin_amdgcn_mfma_f32_32x32x16_bf16(a, b, c, 0, 0, 0)
__device__ __forceinline__ int crow(int r, int hi) { return (r & 3) + 8 * (r >> 2) + 4 * hi; }
__device__ __forceinline__ float dot2bf(unsigned a, unsigned b, float c) { return __builtin_amdgcn_fdot2_f32_bf16(__builtin_bit_cast(bf2_t, a), __builtin_bit_cast(bf2_t, b), c, false); }
__device__ __forceinline__ unsigned cvtpk(float lo, float hi) { unsigned r; asm("v_cvt_pk_bf16_f32 %0, %1, %2" : "=v"(r) : "v"(lo), "v"(hi)); return r; }
constexpr int G_OPB = 128 * 128;
constexpr int G_BUF = 2 * G_OPB;
constexpr int GEMM_LDS = 2 * G_BUF;
constexpr int LDS_TOTAL = GEMM_LDS + 8192;

template <int WT, bool ROWSS>
__device__ __forceinline__ void gemm_kloop(const bf16* __restrict__ Ag0, int lda, const bf16* __restrict__ Bg0, int ldb, int nk, f32x16 (&acc)[4], float (&ss)[4], char* lds, int tid) {
    const int lane = tid & 63, w = __builtin_amdgcn_readfirstlane(tid >> 6), r32 = lane & 31, hi = lane >> 5;
    const int srow = 8 * w + (lane >> 3);
    const int sch = (lane & 7) ^ ((srow >> 1) & 7);
    const bf16* Ag = Ag0 + (size_t)srow * lda + sch * 8;
    const bf16* Bg = Bg0 + (size_t)srow * ldb + sch * 8;
#pragma unroll
    for (int i = 0; i < 4; ++i)
#pragma unroll
        for (int r = 0; r < 16; ++r) acc[i][r] = 0.f;
    ss[0] = 0.f; ss[1] = 0.f; ss[2] = 0.f; ss[3] = 0.f;
    typedef __attribute__((address_space(3))) unsigned* ldsp_t;
    typedef const __attribute__((address_space(1))) unsigned* glbp_t;
#define G_DMA(buf, kofs) do { char* d_ = lds + (buf) * G_BUF + (8 * w) * 128; \
    _Pragma("unroll") for (int i = 0; i < 4; ++i) { \
        __builtin_amdgcn_global_load_lds((glbp_t)(const void*)(Ag + (size_t)(32 * i) * lda + (kofs)), (ldsp_t)(void*)(d_ + i * 4096), 16, 0, 0); \
        __builtin_amdgcn_global_load_lds((glbp_t)(const void*)(Bg + (size_t)(32 * i) * ldb + (kofs)), (ldsp_t)(void*)(d_ + G_OPB + i * 4096), 16, 0, 0); } } while (0)
    const int xr = (r32 >> 1) & 7;
    const int o0 = ((0 + hi) ^ xr) << 4, o1 = ((2 + hi) ^ xr) << 4, o2 = ((4 + hi) ^ xr) << 4, o3 = ((6 + hi) ^ xr) << 4;
#define G_SS(s_, r_) do { union { bf16x8 v; uint4 u; } c_; c_.v = r_; s_ = dot2bf(c_.u.x, c_.u.x, s_); s_ = dot2bf(c_.u.y, c_.u.y, s_); s_ = dot2bf(c_.u.z, c_.u.z, s_); s_ = dot2bf(c_.u.w, c_.u.w, s_); } while (0)
#define G_STEP(pa, pb, off) do { \
    if (WT == 0) { \
        const bf16x8 a0 = *(const bf16x8*)(pa + off), a1 = *(const bf16x8*)(pa + 32 * 128 + off); \
        const bf16x8 b0 = *(const bf16x8*)(pb + off), b1 = *(const bf16x8*)(pb + 32 * 128 + off); \
        if (ROWSS) { G_SS(ss[0], b0); G_SS(ss[1], b1); } \
        acc[0] = MFMA32(a0, b0, acc[0]); acc[1] = MFMA32(a0, b1, acc[1]); \
        acc[2] = MFMA32(a1, b0, acc[2]); acc[3] = MFMA32(a1, b1, acc[3]); \
    } else { \
        const bf16x8 b0 = *(const bf16x8*)(pb + off); \
        const bf16x8 a0 = *(const bf16x8*)(pa + off), a1 = *(const bf16x8*)(pa + 32 * 128 + off); \
        const bf16x8 a2 = *(const bf16x8*)(pa + 64 * 128 + off), a3 = *(const bf16x8*)(pa + 96 * 128 + off); \
        acc[0] = MFMA32(a0, b0, acc[0]); acc[1] = MFMA32(a1, b0, acc[1]); \
        acc[2] = MFMA32(a2, b0, acc[2]); acc[3] = MFMA32(a3, b0, acc[3]); \
    } } while (0)
    const int arow = (WT == 0) ? ((w >> 1) * 64 + r32) : r32;
    const int brow = (WT == 0) ? ((w & 1) * 64 + r32) : (w * 32 + r32);
    G_DMA(0, 0);
    for (int kt = 0; kt < nk; ++kt) {
        __syncthreads();
        if (kt + 1 < nk) G_DMA((kt + 1) & 1, (kt + 1) * 64);
        const char* pa = lds + (kt & 1) * G_BUF + arow * 128;
        const char* pb = lds + (kt & 1) * G_BUF + G_OPB + brow * 128;
        G_STEP(pa, pb, o0); G_STEP(pa, pb, o1); G_STEP(pa, pb, o2); G_STEP(pa, pb, o3);
    }
    if (ROWSS) { ss[0] += __shfl_xor(ss[0], 32, 64); ss[1] += __shfl_xor(ss[1], 32, 64); }
#undef G_DMA
#undef G_SS
#undef G_STEP
}

__device__ __forceinline__ void tile_range(int ntiles, int& lo, int& hi) {
    const int G = gridDim.x, b = blockIdx.x;
    const int vb = ((G & 7) == 0) ? ((b & 7) * (G >> 3) + (b >> 3)) : b;
    const int per = (ntiles + G - 1) / G;
    lo = vb * per; hi = lo + per; if (hi > ntiles) hi = ntiles;
}
constexpr int ST_P = 68;
static_assert(4 * 64 * ST_P * 4 <= LDS_TOTAL, "staging LDS");
template <bool ROWSS, class EPI, class EPIROW, class RSC>
__device__ __forceinline__ void gemm_t(const bf16* __restrict__ Wt, int ldw, int N, const bf16* __restrict__ X, int ldx, int M, int K, int tn_direct, EPI epi, EPIROW epirow, RSC rowscale, char* lds) {
    const int tid = tidx(), lane = tid & 63, w = tid >> 6, r32 = lane & 31, hi = lane >> 5;
    const int tilesN = N / 128, tilesM = M / 128, nk = K / 64;
    int tlo, thi; tile_range(tilesM * tilesN, tlo, thi);
    for (int tile = tlo; tile < thi; ++tile) {
        const int tm = tile / tilesN, tn = tile % tilesN;
        f32x16 acc[4]; float ss[4];
        gemm_kloop<0, ROWSS>(Wt + (size_t)(tn * 128) * ldw, ldw, X + (size_t)(tm * 128) * ldx, ldx, nk, acc, ss, lds, tid);
        if (tn < tn_direct) {
            __syncthreads();
            float* st = (float*)lds + w * (64 * ST_P);
            const float m0_ = rowscale(ss[0]), m1_ = rowscale(ss[1]);
#pragma unroll
            for (int i = 0; i < 2; ++i)
#pragma unroll
                for (int j = 0; j < 2; ++j)
#pragma unroll
                    for (int g = 0; g < 4; ++g) {
                        const float mj = j ? m1_ : m0_;
                        *(float4*)(st + (32 * j + r32) * ST_P + 32 * i + 8 * g + 4 * hi) = make_float4(acc[i * 2 + j][4 * g] * mj, acc[i * 2 + j][4 * g + 1] * mj, acc[i * 2 + j][4 * g + 2] * mj, acc[i * 2 + j][4 * g + 3] * mj);
                    }
            const int rr = lane >> 4, ch = lane & 15;
#pragma unroll 4
            for (int it = 0; it < 16; ++it) {
                const int row = it * 4 + rr;
                const float4 v = *(const float4*)(st + row * ST_P + ch * 4);
                epirow(tm * 128 + (w & 1) * 64 + row, tn * 128 + (w >> 1) * 64 + ch * 4, v);
            }
        } else {
#pragma unroll
            for (int i = 0; i < 2; ++i)
#pragma unroll
                for (int j = 0; j < 2; ++j) {
                    const int tl = (w & 1) * 64 + j * 32;
                    epi(tn * 128 + (w >> 1) * 64 + i * 32, tm * 128 + tl, acc[i * 2 + j], r32, hi, ss[j]);
                }
        }
        __syncthreads();
    }
}

__device__ __forceinline__ void transpose_tiled(const float* __restrict__ W, bf16* __restrict__ Wt, int K, int N, int Npad, int ldk, const float* __restrict__ gain, char* lds) {
    float (*tl)[65] = (float (*)[65])lds;
    const int tid = tidx(), a = tid & 63, q = tid >> 6;
    const int tK = K / 64, tN = Npad / 64;
    for (int tile = blockIdx.x; tile < tK * tN; tile += gridDim.x) {
        const int k0 = (tile / tN) * 64, n0 = (tile % tN) * 64;
#pragma unroll 4
        for (int i = 0; i < 16; ++i) {
            const int k = k0 + q * 16 + i, n = n0 + a;
            float v = (n < N) ? W[(size_t)k * N + n] : 0.f;
            if (gain) v *= gain[k];
            tl[q * 16 + i][a] = v;
        }
        __syncthreads();
#pragma unroll 4
        for (int i = 0; i < 16; ++i) { const int nl = q * 16 + i; Wt[(size_t)(n0 + nl) * ldk + k0 + a] = f2bf(tl[a][nl]); }
        __syncthreads();
    }
}

__device__ __forceinline__ void quant_row(const float4 (&v)[4], unsigned char* __restrict__ dst, float* __restrict__ scl, int r, int lane) {
    float am = 0.f;
#pragma unroll
    for (int j = 0; j < 4; ++j) am = fmaxf(am, fmaxf(fmaxf(fabsf(v[j].x), fabsf(v[j].y)), fmaxf(fabsf(v[j].z), fabsf(v[j].w))));
#pragma unroll
    for (int m = 32; m >= 1; m >>= 1) am = fmaxf(am, __shfl_xor(am, m, 64));
    const float sc = (am > 0.f) ? am * (1.f / 448.f) : 1.f;
    const float is = 1.f / sc;
    uint4 o;
    { int w = 0; w = __builtin_amdgcn_cvt_pk_fp8_f32(v[0].x * is, v[0].y * is, w, false); w = __builtin_amdgcn_cvt_pk_fp8_f32(v[0].z * is, v[0].w * is, w, true); o.x = (unsigned)w; }
    { int w = 0; w = __builtin_amdgcn_cvt_pk_fp8_f32(v[1].x * is, v[1].y * is, w, false); w = __builtin_amdgcn_cvt_pk_fp8_f32(v[1].z * is, v[1].w * is, w, true); o.y = (unsigned)w; }
    { int w = 0; w = __builtin_amdgcn_cvt_pk_fp8_f32(v[2].x * is, v[2].y * is, w, false); w = __builtin_amdgcn_cvt_pk_fp8_f32(v[2].z * is, v[2].w * is, w, true); o.z = (unsigned)w; }
    { int w = 0; w = __builtin_amdgcn_cvt_pk_fp8_f32(v[3].x * is, v[3].y * is, w, false); w = __builtin_amdgcn_cvt_pk_fp8_f32(v[3].z * is, v[3].w * is, w, true); o.w = (unsigned)w; }
    { const int lay = r / NEXP, e = r % NEXP; *(uint4*)(dst + (((size_t)(lay * 8 + (lane >> 3)) * NEXP + e) * 128) + (lane & 7) * 16) = o; }
    if (lane == 0) scl[r] = sc;
}
__device__ __forceinline__ unsigned pack_i8x4(float a, float b, float c, float d) {
    const int ia = __float2int_rn(a), ib = __float2int_rn(b), ic = __float2int_rn(c), id = __float2int_rn(d);
    return (unsigned)(ia & 255) | ((unsigned)(ib & 255) << 8) | ((unsigned)(ic & 255) << 16) | ((unsigned)(id & 255) << 24);
}
__device__ __forceinline__ void quant_row_i8(const float4 (&v)[4], unsigned char* __restrict__ dst, float* __restrict__ scl, int r, int lane) {
    float am = 0.f;
#pragma unroll
    for (int j = 0; j < 4; ++j) am = fmaxf(am, fmaxf(fmaxf(fabsf(v[j].x), fabsf(v[j].y)), fmaxf(fabsf(v[j].z), fabsf(v[j].w))));
#pragma unroll
    for (int m = 32; m >= 1; m >>= 1) am = fmaxf(am, __shfl_xor(am, m, 64));
    const float sc = (am > 0.f) ? am * (1.f / 127.f) : 1.f;
    const float is = 1.f / sc;
    uint4 o;
    o.x = pack_i8x4(v[0].x * is, v[0].y * is, v[0].z * is, v[0].w * is); o.y = pack_i8x4(v[1].x * is, v[1].y * is, v[1].z * is, v[1].w * is);
    o.z = pack_i8x4(v[2].x * is, v[2].y * is, v[2].z * is, v[2].w * is); o.w = pack_i8x4(v[3].x * is, v[3].y * is, v[3].z * is, v[3].w * is);
    { const int lay = r / NEXP, e = r % NEXP; *(uint4*)(dst + (((size_t)(lay * 8 + (lane >> 3)) * NEXP + e) * 128) + (lane & 7) * 16) = o; }
    if (lane == 0) scl[r] = sc;
}
template <bool I8>
__device__ __forceinline__ void convert_table(const float* __restrict__ src, unsigned char* __restrict__ dst, float* __restrict__ scl, int rows) {
    static_assert(TAB_FP8, "fp8 tables");
    const int lane = tidx() & 63;
    const int nw = nwave();
    for (int r = gwave(); r < rows; r += 4 * nw) {
        float4 v[4][4]; int rr[4];
#pragma unroll
        for (int u = 0; u < 4; ++u) {
            rr[u] = (r + u * nw < rows) ? (r + u * nw) : r;
            const float4* s0 = (const float4*)(src + (size_t)rr[u] * D);
#pragma unroll
            for (int j = 0; j < 4; ++j) v[u][j] = s0[lane * 4 + j];
        }
#pragma unroll
        for (int u = 0; u < 4; ++u) {
            if (u == 0 || rr[u] != r) { if (I8) quant_row_i8(v[u], dst, scl, rr[u], lane); else quant_row(v[u], dst, scl, rr[u], lane); }
        }
    }
}
__device__ __forceinline__ void phase_prep(const Params& P, char* lds) {
    unsigned char* ws = P.ws;
    for (int l = 0; l < DEPTH; ++l) {
        transpose_tiled(P.w_in + (size_t)l * D * DIN, (bf16*)(ws + WS_WIN) + (size_t)l * DINP * LDW, D, DIN, DINP, LDW, nullptr, lds);
        transpose_tiled(P.w_uq + (size_t)l * QR * 768, (bf16*)(ws + WS_WUQ) + (size_t)l * 768 * QR, QR, 768, 768, QR, P.q_norm + l * QR, lds);
        transpose_tiled(P.w_uk + (size_t)l * KVR * 512, (bf16*)(ws + WS_WUKV) + (size_t)l * 1024 * KVR, KVR, 512, 512, KVR, P.kv_norm + l * KVR, lds);
        transpose_tiled(P.w_uv + (size_t)l * KVR * 512, (bf16*)(ws + WS_WUKV) + (size_t)l * 1024 * KVR + (size_t)512 * KVR, KVR, 512, 512, KVR, P.kv_norm + l * KVR, lds);
        transpose_tiled(P.w_out + (size_t)l * D * D, (bf16*)(ws + WS_WOUT) + (size_t)l * D * LDW, D, D, D, LDW, nullptr, lds);
    }
    {
        bf16* Wc = (bf16*)(ws + WS_WPQ);
        float (*As)[68] = (float (*)[68])lds;
        float (*Bs)[68] = (float (*)[68])(lds + 16 * 68 * 4);
        const int tid = tidx(), tx = tid & 15, ty = tid >> 4;
        const int lr = tid >> 2, ld4 = (tid & 3) * 4;
        for (int tile = blockIdx.x; tile < (DEPTH * 2048 / 64) * (D / 64); tile += gridDim.x) {
            const int row0 = (tile >> 4) * 64, k0 = (tile & 15) * 64;
            const int l = row0 >> 11, hp = (row0 >> 7) & 15, n0 = row0 & 127;
            const float* skp = P.peer_subkeys + (((size_t)l * 2 + (hp & 1)) * NKEY + n0 + lr) * 128 + ld4;
            const float* wqp = P.peer_wq + ((size_t)l * D + k0 + lr) * 2048 + hp * 128 + ld4;
            float acc[4][4];
#pragma unroll
            for (int i = 0; i < 4; ++i)
#pragma unroll
                for (int j = 0; j < 4; ++j) acc[i][j] = 0.f;
            for (int d0 = 0; d0 < 128; d0 += 16) {
                const float4 av = *(const float4*)(skp + d0), bv = *(const float4*)(wqp + d0);
                As[ld4 + 0][lr] = av.x; As[ld4 + 1][lr] = av.y; As[ld4 + 2][lr] = av.z; As[ld4 + 3][lr] = av.w;
                Bs[ld4 + 0][lr] = bv.x; Bs[ld4 + 1][lr] = bv.y; Bs[ld4 + 2][lr] = bv.z; Bs[ld4 + 3][lr] = bv.w;
                __syncthreads();
#pragma unroll
                for (int kk = 0; kk < 16; ++kk) {
                    const float4 a4 = *(const float4*)&As[kk][ty * 4], b4 = *(const float4*)&Bs[kk][tx * 4];
                    const float aa[4] = {a4.x, a4.y, a4.z, a4.w}, bb[4] = {b4.x, b4.y, b4.z, b4.w};
#pragma unroll
                    for (int i = 0; i < 4; ++i)
#pragma unroll
                        for (int j = 0; j < 4; ++j) acc[i][j] = fmaf(aa[i], bb[j], acc[i][j]);
                }
                __syncthreads();
            }
#pragma unroll
            for (int i = 0; i < 4; ++i) {
                uint2 o; o.x = pack2(acc[i][0], acc[i][1]); o.y = pack2(acc[i][2], acc[i][3]);
                *(uint2*)(Wc + (size_t)(row0 + ty * 4 + i) * LDW + k0 + tx * 4) = o;
            }
        }
    }
    convert_table<true>(P.peer_u, ws + WS_TABU, (float*)(ws + WS_TSCU), DEPTH * NEXP);
    convert_table<false>(P.peer_v, ws + WS_TABV, (float*)(ws + WS_TSCV), DEPTH * NEXP);
    float* rope = (float*)(ws + WS_ROPE);
    for (size_t i = gtid(); i < (size_t)S * 16; i += gnth()) {
        const int s = (int)(i >> 4), f = (int)(i & 15);
        const double inv = pow(10000.0, -(double)f / 16.0);
        const double ang = (double)s * inv;
        rope[2 * i] = (float)cos(ang); rope[2 * i + 1] = (float)sin(ang);
    }
}

__device__ __forceinline__ void phase_norm(const float* __restrict__ h, const float* __restrict__ g, bf16* __restrict__ xn) {
    const int lane = tidx() & 63, nw = nwave();
    for (int t = gwave(); t < T; t += 2 * nw) {
        const int t2 = (t + nw < T) ? (t + nw) : t;
        float4 v[2][4];
#pragma unroll
        for (int j = 0; j < 4; ++j) { v[0][j] = ((const float4*)(h + (size_t)t * D))[j * 64 + lane]; v[1][j] = ((const float4*)(h + (size_t)t2 * D))[j * 64 + lane]; }
#pragma unroll
        for (int u = 0; u < 2; ++u) {
            float ss = 0.f;
#pragma unroll
            for (int j = 0; j < 4; ++j) ss += v[u][j].x * v[u][j].x + v[u][j].y * v[u][j].y + v[u][j].z * v[u][j].z + v[u][j].w * v[u][j].w;
            ss = wave_sum(ss);
            const float r = rsqrtf(ss * (1.f / D) + EPS);
            const int tt = u ? t2 : t;
            if (u == 0 || t2 != t) {
#pragma unroll
                for (int j = 0; j < 4; ++j) {
                    const float4 gg = ((const float4*)g)[j * 64 + lane];
                    uint2 o; o.x = pack2(v[u][j].x * r * gg.x, v[u][j].y * r * gg.y); o.y = pack2(v[u][j].z * r * gg.z, v[u][j].w * r * gg.w);
                    ((uint2*)(xn + (size_t)tt * LDX))[j * 64 + lane] = o;
                }
            }
        }
    }
}

__device__ __forceinline__ void phase_norm_q(const Params& P, int l) {
    const int lane = tidx() & 63, nw = nwave();
    const float* g = P.norm_ffn + l * D;
    bf16* xn = (bf16*)(P.ws + WS_XN);
    unsigned* xq = (unsigned*)(P.ws + WS_XQ);
    float* xsc = (float*)(P.ws + WS_XS);
    for (int t = gwave(); t < T; t += 2 * nw) {
        const int t2 = (t + nw < T) ? (t + nw) : t;
        float4 v[2][4];
#pragma unroll
        for (int j = 0; j < 4; ++j) { v[0][j] = ((const float4*)(P.out + (size_t)t * D))[j * 64 + lane]; v[1][j] = ((const float4*)(P.out + (size_t)t2 * D))[j * 64 + lane]; }
#pragma unroll
        for (int u = 0; u < 2; ++u) {
            float ss = 0.f;
#pragma unroll
            for (int j = 0; j < 4; ++j) ss += v[u][j].x * v[u][j].x + v[u][j].y * v[u][j].y + v[u][j].z * v[u][j].z + v[u][j].w * v[u][j].w;
            ss = wave_sum(ss);
            const float r = rsqrtf(ss * (1.f / D) + EPS);
            const int tt = u ? t2 : t;
            if (u == 0 || t2 != t) {
                float am = 0.f;
#pragma unroll
                for (int j = 0; j < 4; ++j) {
                    const float4 gg = ((const float4*)g)[j * 64 + lane];
                    v[u][j].x *= r * gg.x; v[u][j].y *= r * gg.y; v[u][j].z *= r * gg.z; v[u][j].w *= r * gg.w;
                    am = fmaxf(am, fmaxf(fmaxf(fabsf(v[u][j].x), fabsf(v[u][j].y)), fmaxf(fabsf(v[u][j].z), fabsf(v[u][j].w))));
                    uint2 o; o.x = pack2(v[u][j].x, v[u][j].y); o.y = pack2(v[u][j].z, v[u][j].w);
                    ((uint2*)(xn + (size_t)tt * LDX))[j * 64 + lane] = o;
                }
#pragma unroll
                for (int m = 32; m >= 1; m >>= 1) am = fmaxf(am, __shfl_xor(am, m, 64));
                const float sc = (am > 0.f) ? am * (1.f / 127.f) : 1.f, is = 1.f / sc;
#pragma unroll
                for (int j = 0; j < 4; ++j) xq[(size_t)tt * (D / 4) + j * 64 + lane] = pack_i8x4(v[u][j].x * is, v[u][j].y * is, v[u][j].z * is, v[u][j].w * is);
                if (lane == 0) xsc[tt] = sc;
            }
        }
    }
}

__device__ __forceinline__ void phase_mixlocal(const Params& P, int l, char* lds) {
    const bf16* proj = (const bf16*)(P.ws + WS_PROJ);
    bf16* Y = (bf16*)(P.ws + WS_XN);
    const int tid = tidx();
    {
        const float* cw = P.conv_w + (size_t)l * 3 * 256;
        for (size_t i = gtid(); i < (size_t)T * 32; i += gnth()) {
            const int t = (int)(i >> 5), c0 = (int)(i & 31) * 8, s = t & (S - 1);
            const bf16* pr = proj + (size_t)t * DINP;
            float acc[8];
#pragma unroll
            for (int e = 0; e < 8; ++e) acc[e] = 0.f;
#pragma unroll
            for (int j = 0; j < 3; ++j) {
                if (s - 2 + j >= 0) {
                    const bf16* pp = pr - (size_t)(2 - j) * DINP;
                    const uint4 g = *(const uint4*)(pp + C_CG + c0), hc = *(const uint4*)(pp + C_HC + c0);
                    const float4 w0 = *(const float4*)(cw + j * 256 + c0), w1 = *(const float4*)(cw + j * 256 + c0 + 4);
                    acc[0] = fmaf(w0.x, bflo(g.x) * bflo(hc.x), acc[0]); acc[1] = fmaf(w0.y, bfhi(g.x) * bfhi(hc.x), acc[1]);
                    acc[2] = fmaf(w0.z, bflo(g.y) * bflo(hc.y), acc[2]); acc[3] = fmaf(w0.w, bfhi(g.y) * bfhi(hc.y), acc[3]);
                    acc[4] = fmaf(w1.x, bflo(g.z) * bflo(hc.z), acc[4]); acc[5] = fmaf(w1.y, bfhi(g.z) * bfhi(hc.z), acc[5]);
                    acc[6] = fmaf(w1.z, bflo(g.w) * bflo(hc.w), acc[6]); acc[7] = fmaf(w1.w, bfhi(g.w) * bfhi(hc.w), acc[7]);
                }
            }
            const uint4 bg = *(const uint4*)(pr + C_BG + c0);
            uint4 o;
            o.x = pack2(bflo(bg.x) * acc[0], bfhi(bg.x) * acc[1]); o.y = pack2(bflo(bg.y) * acc[2], bfhi(bg.y) * acc[3]);
            o.z = pack2(bflo(bg.z) * acc[4], bfhi(bg.z) * acc[5]); o.w = pack2(bflo(bg.w) * acc[6], bfhi(bg.w) * acc[7]);
            *(uint4*)(Y + (size_t)t * LDX + c0) = o;
        }
    }
    {
        float (*pl)[68] = (float (*)[68])lds;
        const float* pw = P.pool_w + (size_t)l * 4 * 64 * 64;
        const float* psc = P.pool_scale + l * 256;
        const int a = tid & 63, q = tid >> 6;
        for (int tile = blockIdx.x; tile < (T / 64) * 4; tile += gridDim.x) {
            const int g = tile & 3, t0 = (tile >> 2) * 64;
            const int w = 2 << g;
            {
                const bf16* col = proj + C_HP + g * 64 + a;
                const int tf = t0 + q * 16, sf = tf & (S - 1);
                float xr[31];
#pragma unroll
                for (int d = 1; d <= 15; ++d) xr[15 - d] = (d < w && sf - d >= 0) ? bf2f(col[(size_t)(tf - d) * DINP]) : 0.f;
#pragma unroll
                for (int i = 0; i < 16; ++i) xr[15 + i] = bf2f(col[(size_t)(tf + i) * DINP]);
                float sum = 0.f;
#pragma unroll
                for (int d = 1; d <= 15; ++d) sum += xr[15 - d];
#pragma unroll
                for (int i = 0; i < 16; ++i) {
                    const int s = sf + i;
                    sum += xr[15 + i];
                    const int cnt = (s + 1 < w) ? (s + 1) : w;
                    pl[q * 16 + i][a] = sum / (float)cnt - xr[15 + i];
                    const int o = 15 + i + 1;
                    const float old = (g == 0) ? xr[o - 2] : (g == 1) ? xr[o - 4] : (g == 2) ? xr[o - 8] : xr[o - 16];
                    sum -= old;
                }
            }
            __syncthreads();
            {
                float pc[64];
#pragma unroll
                for (int c = 0; c < 64; ++c) pc[c] = pw[(g * 64 + c) * 64 + a];
                const float sc = psc[g * 64 + a];
#pragma unroll 2
                for (int i = 0; i < 16; ++i) {
                    const float4* row = (const float4*)&pl[q * 16 + i][0];
                    float m0 = 0.f, m1 = 0.f;
#pragma unroll
                    for (int c4 = 0; c4 < 16; ++c4) { const float4 v = row[c4]; m0 = fmaf(v.x, pc[4 * c4], m0); m1 = fmaf(v.y, pc[4 * c4 + 1], m1); m0 = fmaf(v.z, pc[4 * c4 + 2], m0); m1 = fmaf(v.w, pc[4 * c4 + 3], m1); }
                    Y[(size_t)(t0 + q * 16 + i) * LDX + 256 + g * 64 + a] = f2bf((m0 + m1) * sc);
                }
            }
            __syncthreads();
        }
    }
}

typedef short v4i16_t __attribute__((ext_vector_type(4)));
typedef __attribute__((address_space(3))) v4i16_t* lds_v4p;
__device__ __forceinline__ v4i16_t vtr(const char* p) { return __builtin_amdgcn_ds_read_tr16_b64_v4i16((lds_v4p)p); }
constexpr int A_KP = 208, A_VP = 192;
constexpr int A_KB = 64 * A_KP, A_VB = 64 * A_VP, A_BUF = A_KB + A_VB, ATTN_LDS = 2 * A_BUF;
static_assert(ATTN_LDS <= GEMM_LDS, "attention LDS");

__device__ __forceinline__ void attn_unit(const bf16* __restrict__ Qb, const bf16* __restrict__ Kb, const bf16* __restrict__ Vb, bf16* __restrict__ Y, int bh, int qblk, char* lds) {
    const int tid = tidx(), lane = tid & 63, w = tid >> 6, r32 = lane & 31, hi = lane >> 5;
    const int q0 = qblk * 128, qw0 = q0 + w * 32;
    const int NT = 2 * qblk + 2;
    bf16x8 qf[6];
    {
        const bf16* qp = Qb + ((size_t)bh * S + qw0 + r32) * DQK + hi * 8;
#pragma unroll
        for (int ks = 0; ks < 6; ++ks) qf[ks] = *(const bf16x8*)(qp + ks * 16);
    }
    f32x16 o0, o1;
#pragma unroll
    for (int r = 0; r < 16; ++r) { o0[r] = 0.f; o1[r] = 0.f; }
    float m = -1e30f, lsum = 0.f;
    const char* Kg = (const char*)(Kb + (size_t)bh * S * DQK) + tid * 16;
    const char* Vg = (const char*)(Vb + (size_t)bh * S * DV) + tid * 16;
    const int kl0 = (tid / 12) * A_KP + (tid % 12) * 16, kl1 = ((tid + 256) / 12) * A_KP + ((tid + 256) % 12) * 16, kl2 = ((tid + 512) / 12) * A_KP + ((tid + 512) % 12) * 16;
    const int vl0 = (tid >> 3) * A_VP + (tid & 7) * 16, vl1 = vl0 + 32 * A_VP;
    uint4 pk0, pk1, pk2, pv0, pv1, qk0, qk1, qk2, qv0, qv1;
#define A_LOAD(S, t) do { const char* kg = Kg + (size_t)(t) * (64 * 192); const char* vg = Vg + (size_t)(t) * (64 * 128); \
        S##k0 = *(const uint4*)(kg); S##k1 = *(const uint4*)(kg + 4096); S##k2 = *(const uint4*)(kg + 8192); S##v0 = *(const uint4*)(vg); S##v1 = *(const uint4*)(vg + 4096); } while (0)
#define A_STORE(S, bK, bV) do { *(uint4*)(bK + kl0) = S##k0; *(uint4*)(bK + kl1) = S##k1; *(uint4*)(bK + kl2) = S##k2; *(uint4*)(bV + vl0) = S##v0; *(uint4*)(bV + vl1) = S##v1; } while (0)
#define A_PV(pf, kofs) do { \
            { const v4i16_t lo = vtr(pv + (kofs) * A_VP), hh = vtr(pv + ((kofs) + 8) * A_VP); const bf16x8 vf = {lo[0], lo[1], lo[2], lo[3], hh[0], hh[1], hh[2], hh[3]}; o0 = MFMA32(vf, pf.v, o0); } \
            { const v4i16_t lo = vtr(pv + (kofs) * A_VP + 64), hh = vtr(pv + ((kofs) + 8) * A_VP + 64); const bf16x8 vf = {lo[0], lo[1], lo[2], lo[3], hh[0], hh[1], hh[2], hh[3]}; o1 = MFMA32(vf, pf.v, o1); } } while (0)
    const int pvo = (4 * hi + ((lane & 15) >> 2)) * A_VP + (16 * ((lane >> 4) & 1) + 4 * (lane & 3)) * 2;
    A_LOAD(p, 0); A_LOAD(q, 1);
    for (int t2 = 0; t2 < NT; t2 += 2) {
#pragma unroll
        for (int half = 0; half < 2; ++half) {
            const int t = t2 + half;
            char* bK = lds + half * A_BUF; char* bV = bK + A_KB;
            if (half == 0) A_STORE(p, bK, bV); else A_STORE(q, bK, bV);
            __syncthreads();
            { const int tn = (t + 2 < NT) ? (t + 2) : (NT - 2 + half); if (half == 0) A_LOAD(p, tn); else A_LOAD(q, tn); }
        const int kt0 = t * 64;
        if (kt0 <= qw0) {
            f32x16 s0, s1;
#pragma unroll
            for (int r = 0; r < 16; ++r) { s0[r] = 0.f; s1[r] = 0.f; }
            const char* pk = bK + r32 * A_KP + hi * 16;
#pragma unroll
            for (int ks = 0; ks < 6; ++ks) {
                const bf16x8 a0 = *(const bf16x8*)(pk + ks * 32), a1 = *(const bf16x8*)(pk + 32 * A_KP + ks * 32);
                s0 = MFMA32(a0, qf[ks], s0); s1 = MFMA32(a1, qf[ks], s1);
            }
            if (kt0 + 63 > qw0) {
                const int qrow = qw0 + r32;
#pragma unroll
                for (int r = 0; r < 16; ++r) { const int key = kt0 + crow(r, hi); if (key > qrow) s0[r] = -INFINITY; if (key + 32 > qrow) s1[r] = -INFINITY; }
            }
            float mx = fmaxf(s0[0], s1[0]);
#pragma unroll
            for (int r = 1; r < 16; ++r) mx = fmaxf(mx, fmaxf(s0[r], s1[r]));
            mx = fmaxf(mx, __shfl_xor(mx, 32, 64));
            const float mn = fmaxf(m, mx), m_prev = m;
            const float alpha = __builtin_amdgcn_exp2f(m - mn);
            m = mn;
            float ps = 0.f;
#pragma unroll
            for (int r = 0; r < 16; ++r) { s0[r] = __builtin_amdgcn_exp2f(s0[r] - mn); s1[r] = __builtin_amdgcn_exp2f(s1[r] - mn); ps += s0[r] + s1[r]; }
            if (__builtin_amdgcn_ballot_w64(mn > m_prev) != 0ull) {
                lsum *= alpha;
#pragma unroll
                for (int r = 0; r < 16; ++r) { o0[r] *= alpha; o1[r] *= alpha; }
            }
            lsum += ps;
            union { unsigned u[4]; bf16x8 v; } p00, p01, p10, p11;
#pragma unroll
            for (int j = 0; j < 4; ++j) { p00.u[j] = cvtpk(s0[2 * j], s0[2 * j + 1]); p01.u[j] = cvtpk(s0[8 + 2 * j], s0[9 + 2 * j]); p10.u[j] = cvtpk(s1[2 * j], s1[2 * j + 1]); p11.u[j] = cvtpk(s1[8 + 2 * j], s1[9 + 2 * j]); }
            const char* pv = bV + pvo;
            A_PV(p00, 0); A_PV(p01, 16); A_PV(p10, 32); A_PV(p11, 48);
        }
        }
    }
    lsum += __shfl_xor(lsum, 32, 64);
    const float inv = 1.f / lsum;
    const int b = bh >> 3, h = bh & 7;
    bf16* yo = Y + (size_t)(b * S + qw0 + r32) * LDX + 512 + h * 64 + 4 * hi;
#pragma unroll
    for (int g = 0; g < 4; ++g) {
        uint2 a, c;
        a.x = cvtpk(o0[4 * g] * inv, o0[4 * g + 1] * inv); a.y = cvtpk(o0[4 * g + 2] * inv, o0[4 * g + 3] * inv);
        c.x = cvtpk(o1[4 * g] * inv, o1[4 * g + 1] * inv); c.y = cvtpk(o1[4 * g + 2] * inv, o1[4 * g + 3] * inv);
        *(uint2*)(yo + 8 * g) = a; *(uint2*)(yo + 32 + 8 * g) = c;
    }
    __syncthreads();
}
__device__ __forceinline__ void phase_attn(const Params& P, char* lds) {
    const bf16* Qb = (const bf16*)(P.ws + WS_Q);
    const bf16* Kb = (const bf16*)(P.ws + WS_K);
    const bf16* Vb = (const bf16*)(P.ws + WS_V);
    bf16* Y = (bf16*)(P.ws + WS_XN);
    for (int u = blockIdx.x; u < NB * NH * (S / 128); u += gridDim.x) {
        const int bh = u & 31, v = u >> 5;
        const int qblk = (v < 16) ? (63 - v) : (v < 32) ? (v - 16) : (v < 48) ? (79 - v) : (v - 32);
        attn_unit(Qb, Kb, Vb, Y, bh, qblk, lds);
    }
}

#define NET_HD __device__ __forceinline__
#define NET_U2F(u) __uint_as_float(u)
#define NET_F2U(f) __float_as_uint(f)
#define CE_DESC(a, b) do { const float hi__ = fmaxf(a, b), lo__ = fminf(a, b); a = hi__; b = lo__; } while (0)
NET_HD void sort16_desc(float (&v)[16]) {
#define CE2(a, b) CE_DESC(v[a], v[b])
    CE2(0,13); CE2(1,12); CE2(2,15); CE2(3,14); CE2(4,8); CE2(5,6); CE2(7,11); CE2(9,10);
    CE2(0,5); CE2(1,7); CE2(2,9); CE2(3,4); CE2(6,13); CE2(8,14); CE2(10,15); CE2(11,12);
    CE2(0,1); CE2(2,3); CE2(4,5); CE2(6,8); CE2(7,9); CE2(10,11); CE2(12,13); CE2(14,15);
    CE2(0,2); CE2(1,3); CE2(4,10); CE2(5,11); CE2(6,7); CE2(8,9); CE2(12,14); CE2(13,15);
    CE2(1,2); CE2(3,12); CE2(4,6); CE2(5,7); CE2(8,10); CE2(9,11); CE2(13,14);
    CE2(1,4); CE2(2,6); CE2(5,8); CE2(7,10); CE2(9,13); CE2(11,14);
    CE2(2,4); CE2(3,6); CE2(9,12); CE2(11,13);
    CE2(3,5); CE2(6,8); CE2(7,9); CE2(10,12);
    CE2(3,4); CE2(5,6); CE2(7,8); CE2(9,10); CE2(11,12);
    CE2(6,7); CE2(8,9);
#undef CE2
}
NET_HD void merge16_desc(float (&a)[16], const float (&b)[16]) {
#pragma unroll
    for (int i = 0; i < 16; ++i) a[i] = fmaxf(a[i], b[15 - i]);
#pragma unroll
    for (int j = 8; j > 0; j >>= 1) {
#pragma unroll
        for (int i = 0; i < 16; ++i) { const int l = i ^ j; if (l > i) CE_DESC(a[i], a[l]); }
    }
}
NET_HD void top16_of_64(float (&g0)[16], float (&g1)[16], float (&g2)[16], float (&g3)[16]) {
    sort16_desc(g0); sort16_desc(g1); sort16_desc(g2); sort16_desc(g3);
    merge16_desc(g0, g1); merge16_desc(g2, g3); merge16_desc(g0, g2);
}
NET_HD float u2f(unsigned u) { return NET_U2F(u); }
NET_HD unsigned f2u(float f) { return NET_F2U(f); }
template <class V16>
NET_HD void lane_top16(const V16& s0, const V16& s1, const V16& s2, const V16& s3, int hi, float (&out)[16]) {
    float g0[16], g1[16], g2[16], g3[16];
#pragma unroll
    for (int r = 0; r < 16; ++r) {
        const unsigned nb = (unsigned)((r & 3) + 8 * (r >> 2));
        g0[r] = u2f((f2u(s0[r]) & 0xFFFFFF80u) | nb); g1[r] = u2f((f2u(s1[r]) & 0xFFFFFF80u) | (nb + 32u));
        g2[r] = u2f((f2u(s2[r]) & 0xFFFFFF80u) | (nb + 64u)); g3[r] = u2f((f2u(s3[r]) & 0xFFFFFF80u) | (nb + 96u));
    }
    top16_of_64(g0, g1, g2, g3);
    const unsigned h4 = (unsigned)hi << 2;
#pragma unroll
    for (int i = 0; i < 16; ++i) out[i] = u2f(f2u(g0[i]) | h4);
}
constexpr int cand_slot(int a, int b) { int n = 0; for (int x = 0; x < 16; ++x) for (int y = 0; y < 16; ++y) { if (x == a && y == b) return n; if ((x + 1) * (y + 1) <= 16) ++n; } return n; }
NET_HD void cand_top16(const float (&s1)[16], const float (&s2)[16], float (&c)[16]) {
    float g0[16], g1[16], g2[16], g3[16];
#pragma unroll
    for (int i = 0; i < 16; ++i) { g0[i] = -3.0e38f; g1[i] = -3.0e38f; g2[i] = -3.0e38f; g3[i] = -3.0e38f; }
#pragma unroll
    for (int a = 0; a < 16; ++a) {
#pragma unroll
        for (int b = 0; b < 16; ++b) {
            if ((a + 1) * (b + 1) <= 16) {
                const int sl = cand_slot(a, b);
                const float v = u2f((f2u(s1[a] + s2[b]) & 0xFFFFFF00u) | (unsigned)(a * 16 + b));
                if (sl < 16) g0[sl & 15] = v; else if (sl < 32) g1[sl & 15] = v; else if (sl < 48) g2[sl & 15] = v; else g3[sl & 15] = v;
            }
        }
    }
    top16_of_64(g0, g1, g2, g3);
#pragma unroll
    for (int i = 0; i < 16; ++i) c[i] = g0[i];
}

__device__ __forceinline__ void phase_route(const Params& P, int l, char* lds) {
    const bf16* XN = (const bf16*)(P.ws + WS_XN);
    const bf16* Wc = (const bf16*)(P.ws + WS_WPQ) + (size_t)l * 2048 * LDW;
    int* EXPp = (int*)(P.ws + WS_EXP);
    float* GATEp = (float*)(P.ws + WS_GATE);
    const int tid = tidx(), lane = tid & 63, w = tid >> 6, r32 = lane & 31, hi = lane >> 5;
    int tlo, thi; tile_range((T / 128) * PH, tlo, thi);
    for (int u = tlo; u < thi; ++u) {
        const int tm = u >> 3, h = u & 7;
        float L0[16], L1[16];
        {
            f32x16 acc[4]; float ssd[4];
            gemm_kloop<1, false>(Wc + (size_t)((h * 2 + 0) * 128) * LDW, LDW, XN + (size_t)(tm * 128) * LDX, LDX, D / 64, acc, ssd, lds, tid);
            lane_top16(acc[0], acc[1], acc[2], acc[3], hi, L0);
            float o[16];
#pragma unroll
            for (int i = 0; i < 16; ++i) o[i] = __shfl_xor(L0[i], 32, 64);
            merge16_desc(L0, o);
        }
        {
            f32x16 acc[4]; float ssd[4];
            gemm_kloop<1, false>(Wc + (size_t)((h * 2 + 1) * 128) * LDW, LDW, XN + (size_t)(tm * 128) * LDX, LDX, D / 64, acc, ssd, lds, tid);
            lane_top16(acc[0], acc[1], acc[2], acc[3], hi, L1);
            float o[16];
#pragma unroll
            for (int i = 0; i < 16; ++i) o[i] = __shfl_xor(L1[i], 32, 64);
            merge16_desc(L1, o);
        }
        float c[16];
        cand_top16(L0, L1, c);
        __syncthreads();
        unsigned char* my = (unsigned char*)lds + tid * 32;
        {
            uint4 a, b;
#define PK4(L, i) ((__float_as_uint(L[i]) & 127u) | ((__float_as_uint(L[i + 1]) & 127u) << 8) | ((__float_as_uint(L[i + 2]) & 127u) << 16) | ((__float_as_uint(L[i + 3]) & 127u) << 24))
            a.x = PK4(L0, 0); a.y = PK4(L0, 4); a.z = PK4(L0, 8); a.w = PK4(L0, 12);
            b.x = PK4(L1, 0); b.y = PK4(L1, 4); b.z = PK4(L1, 8); b.w = PK4(L1, 12);
#undef PK4
            *(uint4*)my = a; *(uint4*)(my + 16) = b;
        }
        int ev[16]; float gv[16]; float den = 0.f;
#pragma unroll
        for (int k = 0; k < 16; ++k) {
            const unsigned ci = __float_as_uint(c[k]) & 255u;
            const int n1 = my[ci >> 4], n2 = my[16 + (ci & 15)];
            ev[k] = n1 * NKEY + n2;
            gv[k] = __expf(c[k] - c[0]); den += gv[k];
        }
        const float iden = 1.f / den;
        if (hi == 0) {
            const int t = tm * 128 + w * 32 + r32;
            uint4* ep = (uint4*)(EXPp + (size_t)t * HK + h * 16);
            float4* gp = (float4*)(GATEp + (size_t)t * HK + h * 16);
#pragma unroll
            for (int q = 0; q < 4; ++q) {
                ep[q] = make_uint4((unsigned)ev[4 * q], (unsigned)ev[4 * q + 1], (unsigned)ev[4 * q + 2], (unsigned)ev[4 * q + 3]);
                gp[q] = make_float4(gv[4 * q] * iden, gv[4 * q + 1] * iden, gv[4 * q + 2] * iden, gv[4 * q + 3] * iden);
            }
        }
        __syncthreads();
    }
}

__device__ __forceinline__ float red16(float (&p)[16], int lane) {
#pragma unroll
    for (int i = 0; i < 8; ++i) { const bool up = lane & 32; const float send = up ? p[i] : p[i + 8], keep = up ? p[i + 8] : p[i]; p[i] = keep + __shfl_xor(send, 32, 64); }
#pragma unroll
    for (int i = 0; i < 4; ++i) { const bool up = lane & 16; const float send = up ? p[i] : p[i + 4], keep = up ? p[i + 4] : p[i]; p[i] = keep + __shfl_xor(send, 16, 64); }
#pragma unroll
    for (int i = 0; i < 2; ++i) { const bool up = lane & 8; const float send = up ? p[i] : p[i + 2], keep = up ? p[i + 2] : p[i]; p[i] = keep + __shfl_xor(send, 8, 64); }
    { const bool up = lane & 4; const float send = up ? p[0] : p[1], keep = up ? p[1] : p[0]; p[0] = keep + __shfl_xor(send, 4, 64); }
    float r = p[0];
    r += __shfl_xor(r, 2, 64); r += __shfl_xor(r, 1, 64);
    return r;
}

__device__ __forceinline__ void phase_gather(const Params& P, int l) {
    const bf16* XN = (const bf16*)(P.ws + WS_XN);
    bf16* XNw = (bf16*)(P.ws + WS_XN);
    const int* EXPp = (const int*)(P.ws + WS_EXP);
    const float* GATEp = (const float*)(P.ws + WS_GATE);
    const unsigned char* U = P.ws + WS_TABU + (size_t)l * NEXP * TAB_ROWB;
    const unsigned char* V = P.ws + WS_TABV + (size_t)l * NEXP * TAB_ROWB;
    const float* SU = (const float*)(P.ws + WS_TSCU) + (size_t)l * NEXP;
    const float* SV = (const float*)(P.ws + WS_TSCV) + (size_t)l * NEXP;
    const int lane = tidx() & 63;
    for (int t = gwave(); t < T; t += nwave()) {
        const int e_lo = EXPp[(size_t)t * HK + lane], e_hi = EXPp[(size_t)t * HK + 64 + lane];
#if TAB_FP8
        float xf[16];
        {
            const uint4 a = ((const uint4*)(XN + (size_t)t * D))[lane * 2], b = ((const uint4*)(XN + (size_t)t * D))[lane * 2 + 1];
            xf[0] = bflo(a.x); xf[1] = bfhi(a.x); xf[2] = bflo(a.y); xf[3] = bfhi(a.y); xf[4] = bflo(a.z); xf[5] = bfhi(a.z); xf[6] = bflo(a.w); xf[7] = bfhi(a.w);
            xf[8] = bflo(b.x); xf[9] = bfhi(b.x); xf[10] = bflo(b.y); xf[11] = bfhi(b.y); xf[12] = bflo(b.z); xf[13] = bfhi(b.z); xf[14] = bflo(b.w); xf[15] = bfhi(b.w);
        }
#else
        const uint4 xa = ((const uint4*)(XN + (size_t)t * D))[lane], xb = ((const uint4*)(XN + (size_t)t * D))[64 + lane];
#endif
        float acc[16];
#pragma unroll
        for (int i = 0; i < 16; ++i) acc[i] = 0.f;
        for (int c = 0; c < 8; ++c) {
            const int esel = (c < 4) ? e_lo : e_hi;
            const int kb = (c & 3) * 16;
            float part[16];
#pragma unroll
            for (int hb = 0; hb < 2; ++hb) {
#if TAB_FP8
                uint4 r[8];
#pragma unroll
                for (int i = 0; i < 8; ++i) { const int e = __builtin_amdgcn_readlane(esel, kb + hb * 8 + i); r[i] = *(const uint4*)(U + (size_t)e * 1024 + lane * 16); }
#pragma unroll
                for (int i = 0; i < 8; ++i) {
                    float d0 = 0.f, d1 = 0.f;
                    const unsigned w[4] = {r[i].x, r[i].y, r[i].z, r[i].w};
#pragma unroll
                    for (int q = 0; q < 4; ++q) {
                        const auto lo = __builtin_amdgcn_cvt_pk_f32_fp8((int)w[q], false); const auto hh = __builtin_amdgcn_cvt_pk_f32_fp8((int)w[q], true);
                        d0 = fmaf(xf[4 * q], lo[0], d0); d1 = fmaf(xf[4 * q + 1], lo[1], d1); d0 = fmaf(xf[4 * q + 2], hh[0], d0); d1 = fmaf(xf[4 * q + 3], hh[1], d1);
                    }
                    part[hb * 8 + i] = d0 + d1;
                }
#else
                uint4 r0[8], r1[8];
#pragma unroll
                for (int i = 0; i < 8; ++i) { const int e = __builtin_amdgcn_readlane(esel, kb + hb * 8 + i); const unsigned char* rp = U + (size_t)e * 2048 + lane * 16; r0[i] = *(const uint4*)(rp); r1[i] = *(const uint4*)(rp + 1024); }
#pragma unroll
                for (int i = 0; i < 8; ++i) {
                    float d0 = 0.f, d1 = 0.f;
                    d0 = dot2bf(xa.x, r0[i].x, d0); d1 = dot2bf(xa.y, r0[i].y, d1); d0 = dot2bf(xa.z, r0[i].z, d0); d1 = dot2bf(xa.w, r0[i].w, d1);
                    d0 = dot2bf(xb.x, r1[i].x, d0); d1 = dot2bf(xb.y, r1[i].y, d1); d0 = dot2bf(xb.z, r1[i].z, d0); d1 = dot2bf(xb.w, r1[i].w, d1);
                    part[hb * 8 + i] = d0 + d1;
                }
#endif
            }
            float dsum = red16(part, lane);
            const int kk = c * 16 + (lane >> 2);
            const int eme = __shfl(esel, kb + (lane >> 2), 64);
            float wv = GATEp[(size_t)t * HK + kk];
#if TAB_FP8
            dsum *= SU[eme];
            wv *= SV[eme];
#endif
            wv *= gelu_exact(dsum);
#pragma unroll
            for (int hb = 0; hb < 2; ++hb) {
#if TAB_FP8
                uint4 r[8];
#pragma unroll
                for (int i = 0; i < 8; ++i) { const int e = __builtin_amdgcn_readlane(esel, kb + hb * 8 + i); r[i] = *(const uint4*)(V + (size_t)e * 1024 + lane * 16); }
#pragma unroll
                for (int i = 0; i < 8; ++i) {
                    const float w = __int_as_float(__builtin_amdgcn_readlane(__float_as_int(wv), (hb * 8 + i) * 4));
                    const unsigned ww[4] = {r[i].x, r[i].y, r[i].z, r[i].w};
#pragma unroll
                    for (int q = 0; q < 4; ++q) {
                        const auto lo = __builtin_amdgcn_cvt_pk_f32_fp8((int)ww[q], false); const auto hh = __builtin_amdgcn_cvt_pk_f32_fp8((int)ww[q], true);
                        acc[4 * q] = fmaf(w, lo[0], acc[4 * q]); acc[4 * q + 1] = fmaf(w, lo[1], acc[4 * q + 1]); acc[4 * q + 2] = fmaf(w, hh[0], acc[4 * q + 2]); acc[4 * q + 3] = fmaf(w, hh[1], acc[4 * q + 3]);
                    }
                }
#else
                uint4 r0[8], r1[8];
#pragma unroll
                for (int i = 0; i < 8; ++i) { const int e = __builtin_amdgcn_readlane(esel, kb + hb * 8 + i); const unsigned char* rp = V + (size_t)e * 2048 + lane * 16; r0[i] = *(const uint4*)(rp); r1[i] = *(const uint4*)(rp + 1024); }
#pragma unroll
                for (int i = 0; i < 8; ++i) {
                    const float w = __int_as_float(__builtin_amdgcn_readlane(__float_as_int(wv), (hb * 8 + i) * 4));
                    acc[0] = fmaf(w, bflo(r0[i].x), acc[0]); acc[1] = fmaf(w, bfhi(r0[i].x), acc[1]); acc[2] = fmaf(w, bflo(r0[i].y), acc[2]); acc[3] = fmaf(w, bfhi(r0[i].y), acc[3]);
                    acc[4] = fmaf(w, bflo(r0[i].z), acc[4]); acc[5] = fmaf(w, bfhi(r0[i].z), acc[5]); acc[6] = fmaf(w, bflo(r0[i].w), acc[6]); acc[7] = fmaf(w, bfhi(r0[i].w), acc[7]);
                    acc[8] = fmaf(w, bflo(r1[i].x), acc[8]); acc[9] = fmaf(w, bfhi(r1[i].x), acc[9]); acc[10] = fmaf(w, bflo(r1[i].y), acc[10]); acc[11] = fmaf(w, bfhi(r1[i].y), acc[11]);
                    acc[12] = fmaf(w, bflo(r1[i].z), acc[12]); acc[13] = fmaf(w, bfhi(r1[i].z), acc[13]); acc[14] = fmaf(w, bflo(r1[i].w), acc[14]); acc[15] = fmaf(w, bfhi(r1[i].w), acc[15]);
                }
#endif
            }
        }
        float* hrow = P.out + (size_t)t * D;
#if TAB_FP8
        const int c0 = lane * 16, c1 = lane * 16 + 8;
#else
        const int c0 = lane * 8, c1 = 512 + lane * 8;
#endif
        float4 h0 = *(const float4*)(hrow + c0), h1 = *(const float4*)(hrow + c0 + 4), h2 = *(const float4*)(hrow + c1), h3 = *(const float4*)(hrow + c1 + 4);
        h0.x += acc[0]; h0.y += acc[1]; h0.z += acc[2]; h0.w += acc[3]; h1.x += acc[4]; h1.y += acc[5]; h1.z += acc[6]; h1.w += acc[7];
        h2.x += acc[8]; h2.y += acc[9]; h2.z += acc[10]; h2.w += acc[11]; h3.x += acc[12]; h3.y += acc[13]; h3.z += acc[14]; h3.w += acc[15];
        float ss = h0.x * h0.x + h0.y * h0.y + h0.z * h0.z + h0.w * h0.w + h1.x * h1.x + h1.y * h1.y + h1.z * h1.z + h1.w * h1.w
                 + h2.x * h2.x + h2.y * h2.y + h2.z * h2.z + h2.w * h2.w + h3.x * h3.x + h3.y * h3.y + h3.z * h3.z + h3.w * h3.w;
        ss = wave_sum(ss);
        const float rn = rsqrtf(ss * (1.f / D) + EPS);
        if (l == DEPTH - 1) {
            const float* g = P.norm_final;
            const float4 g0 = *(const float4*)(g + c0), g1 = *(const float4*)(g + c0 + 4), g2 = *(const float4*)(g + c1), g3 = *(const float4*)(g + c1 + 4);
            *(float4*)(hrow + c0) = make_float4(h0.x * rn * g0.x, h0.y * rn * g0.y, h0.z * rn * g0.z, h0.w * rn * g0.w);
            *(float4*)(hrow + c0 + 4) = make_float4(h1.x * rn * g1.x, h1.y * rn * g1.y, h1.z * rn * g1.z, h1.w * rn * g1.w);
            *(float4*)(hrow + c1) = make_float4(h2.x * rn * g2.x, h2.y * rn * g2.y, h2.z * rn * g2.z, h2.w * rn * g2.w);
            *(float4*)(hrow + c1 + 4) = make_float4(h3.x * rn * g3.x, h3.y * rn * g3.y, h3.z * rn * g3.z, h3.w * rn * g3.w);
        } else {
            *(float4*)(hrow + c0) = h0; *(float4*)(hrow + c0 + 4) = h1; *(float4*)(hrow + c1) = h2; *(float4*)(hrow + c1 + 4) = h3;
            const float* g = P.norm_mix + (l + 1) * D;
            const float4 g0 = *(const float4*)(g + c0), g1 = *(const float4*)(g + c0 + 4), g2 = *(const float4*)(g + c1), g3 = *(const float4*)(g + c1 + 4);
            uint4 o0, o1;
            o0.x = pack2(h0.x * rn * g0.x, h0.y * rn * g0.y); o0.y = pack2(h0.z * rn * g0.z, h0.w * rn * g0.w); o0.z = pack2(h1.x * rn * g1.x, h1.y * rn * g1.y); o0.w = pack2(h1.z * rn * g1.z, h1.w * rn * g1.w);
            o1.x = pack2(h2.x * rn * g2.x, h2.y * rn * g2.y); o1.y = pack2(h2.z * rn * g2.z, h2.w * rn * g2.w); o1.z = pack2(h3.x * rn * g3.x, h3.y * rn * g3.y); o1.w = pack2(h3.z * rn * g3.z, h3.w * rn * g3.w);
            *(uint4*)(XNw + (size_t)t * D + c0) = o0; *(uint4*)(XNw + (size_t)t * D + c1) = o1;
        }
    }
}


constexpr size_t WS_PART = WS_PROJ;
static_assert((size_t)8 * T * HK * 4 <= WS_K - WS_PROJ, "PART alias");
constexpr int XI_X = 0, XI_RANK = 1, XI_J = 2, XI_NX = 3, XI_NLOC = 4;
constexpr int CTL_CENSUS = 4096;
constexpr int CTL_BYTES = (CTL_CENSUS + 16) * 4;

__device__ __forceinline__ float dot16_fp8(const float (&xf)[16], const uint4& r) {
    float d0 = 0.f, d1 = 0.f;
    const unsigned w[4] = {r.x, r.y, r.z, r.w};
#pragma unroll
    for (int q = 0; q < 4; ++q) {
        const auto lo = __builtin_amdgcn_cvt_pk_f32_fp8((int)w[q], false); const auto hh = __builtin_amdgcn_cvt_pk_f32_fp8((int)w[q], true);
        d0 = fmaf(xf[4 * q], lo[0], d0); d1 = fmaf(xf[4 * q + 1], lo[1], d1); d0 = fmaf(xf[4 * q + 2], hh[0], d0); d1 = fmaf(xf[4 * q + 3], hh[1], d1);
    }
    return d0 + d1;
}
template <int M1, int M2, int M3, class TT>
__device__ __forceinline__ void red16x3(TT (&p)[16], int lane) {
#pragma unroll
    for (int i = 0; i < 8; ++i) { const bool up = lane & M1; const TT send = up ? p[i] : p[i + 8], keep = up ? p[i + 8] : p[i]; p[i] = keep + __shfl_xor(send, M1, 64); }
#pragma unroll
    for (int i = 0; i < 4; ++i) { const bool up = lane & M2; const TT send = up ? p[i] : p[i + 4], keep = up ? p[i + 4] : p[i]; p[i] = keep + __shfl_xor(send, M2, 64); }
#pragma unroll
    for (int i = 0; i < 2; ++i) { const bool up = lane & M3; const TT send = up ? p[i] : p[i + 2], keep = up ? p[i + 2] : p[i]; p[i] = keep + __shfl_xor(send, M3, 64); }
}
__device__ __forceinline__ void phase_gu(const Params& P, int l, const volatile int* xi) {
    const unsigned char* XQ = P.ws + WS_XQ;
    const float* XSc = (const float*)(P.ws + WS_XS);
    const int* EXPp = (const int*)(P.ws + WS_EXP);
    float* PART = (float*)(P.ws + WS_PART);
    const int tid = tidx(), lane = tid & 63, w = tid >> 6, g = lane >> 3, c = lane & 7;
    int xo_ = 0; asm volatile("" : "+v"(xo_));
    const int j = __builtin_amdgcn_readfirstlane(xi[xo_ + XI_J]), nx = __builtin_amdgcn_readfirstlane(xi[xo_ + XI_NX]), nloc = __builtin_amdgcn_readfirstlane(xi[xo_ + XI_NLOC]), rank = __builtin_amdgcn_readfirstlane(xi[xo_ + XI_RANK]);
    const int t0 = rank * 4 + w, st = nloc * 4;
    const int n = (t0 < T) ? (T - t0 + st - 1) / st : 0;
    const int i0 = 8 * (c & 1) + 4 * ((c >> 1) & 1) + 2 * ((c >> 2) & 1);
    for (int sl = j; sl < 8 && n > 0; sl += nx) {
        const unsigned char* Us = P.ws + WS_TABU + ((size_t)(l * 8 + sl) * NEXP) * 128;
        const unsigned co = (unsigned)c << 4;
        float* part = PART + (size_t)sl * T * HK;
        const unsigned char* xs = XQ + sl * 128 + c * 16;
#define GU_TK(k) (t0 + (((k) < n) ? (k) : (n - 1)) * st)
#define GU_LOADE(S, t) do { S##lo = EXPp[(size_t)(t) * HK + lane]; S##hi = EXPp[(size_t)(t) * HK + 64 + lane]; } while (0)
#define GU_LOADX(S, t) do { S##a = *(const uint4*)(xs + (size_t)(t) * D); S##s = XSc[t]; } while (0)
#define GU_ISSUE(R, S) do { _Pragma("unroll") for (int i = 0; i < 16; ++i) { \
            const int e = __builtin_amdgcn_ds_bpermute((((8 * i) & 63) + g) << 2, (i < 8) ? S##lo : S##hi); R[i] = *(const uint4*)(Us + (((unsigned)e << 7) | co)); } } while (0)
#define GU_FINISH(R, S, t) do { \
            int p[16]; \
            _Pragma("unroll") for (int i = 0; i < 16; ++i) { int d_ = __builtin_amdgcn_sdot4((int)S##a.x, (int)R[i].x, 0, false); d_ = __builtin_amdgcn_sdot4((int)S##a.y, (int)R[i].y, d_, false); \
                d_ = __builtin_amdgcn_sdot4((int)S##a.z, (int)R[i].z, d_, false); p[i] = __builtin_amdgcn_sdot4((int)S##a.w, (int)R[i].w, d_, false); } \
            red16x3<1, 2, 4, int>(p, lane); \
            part[(size_t)(t) * HK + 8 * i0 + g] = (float)p[0] * S##s; part[(size_t)(t) * HK + 8 * (i0 + 1) + g] = (float)p[1] * S##s; } while (0)
        int eAlo, eAhi, eBlo, eBhi; uint4 xAa, xBa; float xAs, xBs; uint4 rA[16], rB[16];
        GU_LOADE(eA, GU_TK(0)); GU_LOADX(xA, GU_TK(0)); GU_LOADE(eB, GU_TK(1));
        GU_ISSUE(rA, eA);
        for (int k = 0; k < n; k += 2) {
            GU_LOADX(xB, GU_TK(k + 1)); GU_ISSUE(rB, eB); GU_LOADE(eA, GU_TK(k + 2));
            GU_FINISH(rA, xA, GU_TK(k));
            GU_LOADX(xA, GU_TK(k + 2)); GU_ISSUE(rA, eA); GU_LOADE(eB, GU_TK(k + 3));
            GU_FINISH(rB, xB, GU_TK(k + 1));
        }
#undef GU_TK
#undef GU_LOADE
#undef GU_LOADX
#undef GU_ISSUE
#undef GU_FINISH
    }
}
__device__ __forceinline__ void phase_gw(const Params& P, int l) {
    const int* EXPp = (const int*)(P.ws + WS_EXP);
    const float* GATEp = (const float*)(P.ws + WS_GATE);
    const float* PART = (const float*)(P.ws + WS_PART);
    const float* SU = (const float*)(P.ws + WS_TSCU) + (size_t)l * NEXP;
    const float* SV = (const float*)(P.ws + WS_TSCV) + (size_t)l * NEXP;
    unsigned char* WQ = P.ws + WS_WQ8;
    float* WSC = (float*)(P.ws + WS_WSC);
    const int lane = tidx() & 63;
    for (int tb = gwave() * 4; tb < T; tb += nwave() * 4) {
        float wv[4][2];
#pragma unroll
        for (int q = 0; q < 4; ++q)
#pragma unroll
            for (int hk = 0; hk < 2; ++hk) {
                const size_t i = (size_t)(tb + q) * HK + hk * 64 + lane;
                float s = 0.f;
#pragma unroll
                for (int x = 0; x < 8; ++x) s += PART[(size_t)x * T * HK + i];
                const int e = EXPp[i];
                wv[q][hk] = GATEp[i] * gelu_exact(s * SU[e]) * SV[e];
            }
#pragma unroll
        for (int q = 0; q < 4; ++q) {
            float am = fmaxf(fabsf(wv[q][0]), fabsf(wv[q][1]));
#pragma unroll
            for (int m = 32; m >= 1; m >>= 1) am = fmaxf(am, __shfl_xor(am, m, 64));
            const float sc = (am > 0.f) ? am * (1.f / 448.f) : 1.f, is = 1.f / sc;
            const int pk = __builtin_amdgcn_cvt_pk_fp8_f32(wv[q][0] * is, wv[q][1] * is, 0, false);
            WQ[(size_t)(tb + q) * HK + lane] = (unsigned char)(pk & 255);
            WQ[(size_t)(tb + q) * HK + 64 + lane] = (unsigned char)((pk >> 8) & 255);
            if (lane == 0) WSC[tb + q] = sc;
        }
    }
}
typedef int v2i_t __attribute__((ext_vector_type(2)));
typedef unsigned u32x4_t __attribute__((ext_vector_type(4)));
typedef __attribute__((ext_vector_type(4))) float f32x4;
constexpr int GV_PIECE = 1024 + 16;
constexpr int GV_TILE = 16 * GV_PIECE;
static_assert(4 * GV_TILE + 4 * 512 <= LDS_TOTAL, "gv LDS");
__device__ __forceinline__ void phase_gv(const Params& P, int l, const volatile int* xi, char* lds) {
    const int* EXPp = (const int*)(P.ws + WS_EXP);
    const unsigned char* WQ = P.ws + WS_WQ8;
    const float* WSC = (const float*)(P.ws + WS_WSC);
    const int tid = tidx(), lane = tid & 63, w = __builtin_amdgcn_readfirstlane(tid >> 6), g = lane >> 3, pos = lane & 7;
    int xo_ = 0; asm volatile("" : "+v"(xo_));
    const int j = __builtin_amdgcn_readfirstlane(xi[xo_ + XI_J]), nx = __builtin_amdgcn_readfirstlane(xi[xo_ + XI_NX]), nloc = __builtin_amdgcn_readfirstlane(xi[xo_ + XI_NLOC]), rank = __builtin_amdgcn_readfirstlane(xi[xo_ + XI_RANK]);
    const int t0 = rank * 4 + w, st = nloc * 4;
    const int n = (t0 < T) ? (T - t0 + st - 1) / st : 0;
    char* tile = lds + w * GV_TILE;
    float* strip = (float*)(lds + 4 * GV_TILE) + w * 128;
    typedef __attribute__((address_space(3))) v2i_t* ldsv2_t;
    const unsigned co = (unsigned)(pos ^ g) << 4;
    const int rr = (lane & 15) >> 1, kq = lane >> 4;
    const int rdo = kq * GV_PIECE + rr * 128 + (lane & 1) * 8;
    const bool row0 = (lane & 15) == 0;
    __syncthreads();
    for (int sl = j; sl < 8 && n > 0; sl += nx) {
        const unsigned char* Vs = P.ws + WS_TABV + ((size_t)(l * 8 + sl) * NEXP) * 128;
        float* hrow = P.out + sl * 128 + 2 * lane;
#define GV_TK(k) (t0 + (((k) < n) ? (k) : (n - 1)) * st)
#define GV_LOADE(S, t) do { S##el = EXPp[(size_t)(t) * HK + lane]; S##eh = EXPp[(size_t)(t) * HK + 64 + lane]; } while (0)
#define GV_ISSUE(R, S) do { _Pragma("unroll") for (int i = 0; i < 16; ++i) { \
            const int e = __builtin_amdgcn_ds_bpermute((((8 * i) & 63) + g) << 2, (i < 8) ? S##el : S##eh); R[i] = *(const u32x4_t*)(Vs + (((unsigned)e << 7) | co)); } } while (0)
#define GV_LOADT(S, kk) do { const int t_ = GV_TK(kk); \
            S##a0 = 0; S##a1 = 0; S##a2 = 0; S##a3 = 0; \
            if (row0) { const long* wp = (const long*)(WQ + (size_t)t_ * HK + kq * 8); S##a0 = wp[0]; S##a1 = wp[4]; S##a2 = wp[8]; S##a3 = wp[12]; } \
            S##ws = ((kk) < n) ? WSC[t_] : 0.f; \
            S##hv = *(const float2*)(hrow + (size_t)t_ * D); } while (0)
#define GV_TOKEN(R, S, kk) do { \
            const int t = GV_TK(kk); \
            _Pragma("unroll") for (int i = 0; i < 16; ++i) *(u32x4_t*)(tile + i * GV_PIECE + lane * 16) = R[i]; \
            f32x4 acc[8]; \
            _Pragma("unroll") for (int nt = 0; nt < 8; ++nt) acc[nt] = (f32x4){0.f, 0.f, 0.f, 0.f}; \
            _Pragma("unroll") for (int s4 = 0; s4 < 4; ++s4) { \
                const long av = (s4 == 0) ? S##a0 : (s4 == 1) ? S##a1 : (s4 == 2) ? S##a2 : S##a3; \
                _Pragma("unroll") for (int nt = 0; nt < 8; ++nt) { \
                    const v2i_t bv = __builtin_amdgcn_ds_read_tr8_b64_v2i32((ldsv2_t)(void*)(tile + (4 * s4) * GV_PIECE + rdo + ((nt ^ rr) << 4))); \
                    acc[nt] = __builtin_amdgcn_mfma_f32_16x16x32_fp8_fp8(av, __builtin_bit_cast(long, bv), acc[nt], 0, 0, 0); } } \
            if (lane < 16) { _Pragma("unroll") for (int nt = 0; nt < 8; ++nt) strip[16 * nt + lane] = acc[nt][0]; }        \
            { const float2 o2 = *(const float2*)(strip + 2 * lane); \
              if ((kk) < n) *(float2*)(hrow + (size_t)t * D) = make_float2(S##hv.x + S##ws * o2.x, S##hv.y + S##ws * o2.y); } } while (0)
        int Ael, Aeh, Bel, Beh; u32x4_t rA[16], rB[16];
        long Pa0, Pa1, Pa2, Pa3, Qa0, Qa1, Qa2, Qa3; float Pws, Qws; float2 Phv, Qhv;
        GV_LOADE(A, GV_TK(0)); GV_LOADE(B, GV_TK(1));
        GV_ISSUE(rA, A); GV_LOADT(P, 0);
        for (int k = 0; k < n; k += 2) {
            GV_ISSUE(rB, B); GV_LOADE(A, GV_TK(k + 2)); GV_LOADT(Q, k + 1);
            GV_TOKEN(rA, P, k);
            GV_ISSUE(rA, A); GV_LOADE(B, GV_TK(k + 3)); GV_LOADT(P, k + 2);
            GV_TOKEN(rB, Q, k + 1);
        }
#undef GV_TK
#undef GV_LOADE
#undef GV_ISSUE
#undef GV_LOADT
#undef GV_TOKEN
    }
    __syncthreads();
}
__device__ __forceinline__ void phase_gnorm(const Params& P, int l) {
    const int lane = tidx() & 63, nw = nwave();
    bf16* XNw = (bf16*)(P.ws + WS_XN);
    const float4* g = (const float4*)((l == DEPTH - 1) ? P.norm_final : (P.norm_mix + (l + 1) * D));
    for (int t = gwave(); t < T; t += 2 * nw) {
        const int t2 = (t + nw < T) ? (t + nw) : t;
        float4 v[2][4];
#pragma unroll
        for (int q = 0; q < 4; ++q) { v[0][q] = ((const float4*)(P.out + (size_t)t * D))[q * 64 + lane]; v[1][q] = ((const float4*)(P.out + (size_t)t2 * D))[q * 64 + lane]; }
#pragma unroll
        for (int u = 0; u < 2; ++u) {
            float ss = 0.f;
#pragma unroll
            for (int q = 0; q < 4; ++q) ss += v[u][q].x * v[u][q].x + v[u][q].y * v[u][q].y + v[u][q].z * v[u][q].z + v[u][q].w * v[u][q].w;
            ss = wave_sum(ss);
            const float rn = rsqrtf(ss * (1.f / D) + EPS);
            const int tt = u ? t2 : t;
            if (u == 0 || t2 != t) {
                float4* hr = (float4*)(P.out + (size_t)tt * D);
#pragma unroll
                for (int q = 0; q < 4; ++q) {
                    const float4 gg = g[q * 64 + lane];
                    const float4 o = make_float4(v[u][q].x * rn * gg.x, v[u][q].y * rn * gg.y, v[u][q].z * rn * gg.z, v[u][q].w * rn * gg.w);
                    if (l == DEPTH - 1) hr[q * 64 + lane] = o;
                    else { uint2 uu; uu.x = pack2(o.x, o.y); uu.y = pack2(o.z, o.w); ((uint2*)(XNw + (size_t)tt * LDX))[q * 64 + lane] = uu; }
                }
            }
        }
    }
}

#define XB_TMO      128
#define XB_XCNT(j)  (256  + 64 * (j))
#define XB_XSUB(j)  (1280 + 64 * (j))
#define XB_XGEN(j)  (2304 + 64 * (j))
#define XB_TOP      3328
#define XB_TOPGEN   3392
#define XCD_BAR_WORDS 3456
#define XB_SPIN_CAP (1u << 22)
#define LAS __attribute__((address_space(3)))
__device__ __forceinline__ unsigned xb_ld(unsigned* p)              { return __hip_atomic_load(p, __ATOMIC_RELAXED, __HIP_MEMORY_SCOPE_AGENT); }
__device__ __forceinline__ unsigned xb_add(unsigned* p, unsigned v) { return __hip_atomic_fetch_add(p, v, __ATOMIC_RELAXED, __HIP_MEMORY_SCOPE_AGENT); }
__device__ __forceinline__ unsigned xb_xcc_id() { return (unsigned)__builtin_amdgcn_s_getreg((3 << 11) | 20) & 0xFu; }
#define XB_SPIN(cond, bar) do { unsigned _sp = 0; while (cond) { __builtin_amdgcn_s_sleep(1); \
    if ((++_sp & 255u) == 0u) { if (xb_ld(&(bar)[XB_TMO])) break; if (_sp > XB_SPIN_CAP) { atomicAdd(&(bar)[XB_TMO], 1u); break; } } } } while (0)
struct XcdBarrier { unsigned* bar; unsigned x; volatile LAS unsigned* st; };
__device__ __forceinline__ XcdBarrier xcd_barrier_post(unsigned* bar, volatile LAS unsigned* st) {
    XcdBarrier b; b.bar = bar; b.x = xb_xcc_id(); b.st = st;
    if (__builtin_amdgcn_workitem_id_x() == 0) (void)xb_add(&bar[XB_XCNT(b.x)], 1u);
    return b;
}
__device__ __forceinline__ void xcd_barrier_complete(unsigned* bar, unsigned x, unsigned& nloc, unsigned& nx) {
    const unsigned G = gridDim.x * gridDim.y * gridDim.z;
    unsigned sum, cnt, mine, sp = 0u;
    for (;;) {
        sum = 0u; cnt = 0u; mine = 0u;
#pragma unroll
        for (unsigned j = 0; j < 16; ++j) { const unsigned c = xb_ld(&bar[XB_XCNT(j)]); sum += c; cnt += (c > 0u) ? 1u : 0u; mine = (j == x) ? c : mine; }
        if (sum == G) break;
        __builtin_amdgcn_s_sleep(1);
        if ((++sp & 255u) == 0u) { if (xb_ld(&bar[XB_TMO])) break; if (sp > XB_SPIN_CAP) { atomicAdd(&bar[XB_TMO], 1u); break; } }
    }
    nloc = mine > 0u ? mine : 1u; nx = cnt > 0u ? cnt : 1u;
}
__device__ __forceinline__ void xcd_barrier(const XcdBarrier& b) {
    asm volatile("s_waitcnt vmcnt(0)" ::: "memory");
    __syncthreads();
    if (__builtin_amdgcn_workitem_id_x() == 0) {
        unsigned* bar = b.bar;
        __builtin_amdgcn_s_waitcnt(0);
        unsigned nloc = b.st[0], nx = b.st[1];
        if (nloc == 0u) { xcd_barrier_complete(bar, b.x, nloc, nx); b.st[0] = nloc; b.st[1] = nx; }
        const unsigned old = xb_add(&bar[XB_XSUB(b.x)], 1u);
        const unsigned gen = old / nloc;
        if (old + 1u == (gen + 1u) * nloc) {
            __builtin_amdgcn_fence(__ATOMIC_RELEASE, "agent");
            asm volatile("s_waitcnt vmcnt(0)" ::: "memory");
            const unsigned og = xb_add(&bar[XB_TOP], 1u);
            const unsigned tg = og / nx;
            if (og + 1u == (tg + 1u) * nx) xb_add(&bar[XB_TOPGEN], 1u);
            else XB_SPIN(xb_ld(&bar[XB_TOPGEN]) == tg, bar);
            __builtin_amdgcn_fence(__ATOMIC_ACQUIRE, "agent");
            xb_add(&bar[XB_XGEN(b.x)], 1u);
            asm volatile("s_waitcnt vmcnt(0)" ::: "memory");
        } else {
            XB_SPIN(xb_ld(&bar[XB_XGEN(b.x)]) == gen, bar);
            __builtin_amdgcn_fence(__ATOMIC_ACQUIRE, "agent");
            asm volatile("s_waitcnt vmcnt(0)" ::: "memory");
        }
    }
    __syncthreads();
}

constexpr float QSCALE = 0.10206207261596575f * 1.4426950408889634f;

__device__ __forceinline__ void phase_gemm1(const Params& P, int l, char* lds) {
    unsigned char* ws = P.ws;
    const bf16* XN = (const bf16*)(ws + WS_XN);
    bf16* PROJ = (bf16*)(ws + WS_PROJ);
    bf16* Kb = (bf16*)(ws + WS_K);
    const float* rope = (const float*)(ws + WS_ROPE);
    const bf16* W = (const bf16*)(ws + WS_WIN) + (size_t)l * DINP * LDW;
    gemm_t<false>(W, LDW, DINP, XN, LDX, T, D, C_KR / 128, [&](int n0, int t0, const f32x16& acc, int r32, int hi, float) {
        const int t = t0 + r32;
        if (n0 < C_KR) {
            bf16* pr = PROJ + (size_t)t * DINP + n0 + 4 * hi;
#pragma unroll
            for (int g = 0; g < 4; ++g) { uint2 o; o.x = cvtpk(acc[4 * g], acc[4 * g + 1]); o.y = cvtpk(acc[4 * g + 2], acc[4 * g + 3]); *(uint2*)(pr + 8 * g) = o; }
        } else if (n0 == C_KR) {
            const int b = t / S, s = t % S;
            uint2 o1[2], o2[2];
#pragma unroll
            for (int g = 0; g < 2; ++g) {
                const float4 cs0 = *(const float4*)(rope + ((size_t)s * 16 + 8 * g + 4 * hi) * 2), cs1 = *(const float4*)(rope + ((size_t)s * 16 + 8 * g + 4 * hi) * 2 + 4);
                const float x10 = acc[4 * g], x11 = acc[4 * g + 1], x12 = acc[4 * g + 2], x13 = acc[4 * g + 3];
                const float x20 = acc[8 + 4 * g], x21 = acc[8 + 4 * g + 1], x22 = acc[8 + 4 * g + 2], x23 = acc[8 + 4 * g + 3];
                o1[g].x = cvtpk(x10 * cs0.x - x20 * cs0.y, x11 * cs0.z - x21 * cs0.w); o1[g].y = cvtpk(x12 * cs1.x - x22 * cs1.y, x13 * cs1.z - x23 * cs1.w);
                o2[g].x = cvtpk(x20 * cs0.x + x10 * cs0.y, x21 * cs0.z + x11 * cs0.w); o2[g].y = cvtpk(x22 * cs1.x + x12 * cs1.y, x23 * cs1.z + x13 * cs1.w);
            }
#pragma unroll
            for (int h = 0; h < NH; ++h) {
                bf16* kr = Kb + ((size_t)(b * NH + h) * S + s) * DQK + 64 + 4 * hi;
                *(uint2*)(kr) = o1[0]; *(uint2*)(kr + 8) = o1[1]; *(uint2*)(kr + 16) = o2[0]; *(uint2*)(kr + 24) = o2[1];
            }
        }
    }, [&](int t, int n, const float4& v) {
        uint2 o; o.x = cvtpk(v.x, v.y); o.y = cvtpk(v.z, v.w);
        *(uint2*)(PROJ + (size_t)t * DINP + n) = o;
    }, [](float) { return 1.f; }, lds);
}
__device__ __forceinline__ void phase_gemm2(const Params& P, int l, char* lds) {
    unsigned char* ws = P.ws;
    const bf16* PROJ = (const bf16*)(ws + WS_PROJ);
    const float* rope = (const float*)(ws + WS_ROPE);
    const int lane = tidx() & 63;
    {
        const bf16* W = (const bf16*)(ws + WS_WUQ) + (size_t)l * 768 * QR;
        bf16* Qb = (bf16*)(ws + WS_Q);
        gemm_t<true>(W, QR, 768, PROJ + C_CQ, DINP, T, QR, 768 / 128, [](int, int, const f32x16&, int, int, float) {},
            [&](int t, int n, const float4& v) {
                const int b = t / S, s = t % S, h = n / DQK, d = n % DQK;
                float4 o = v;
                const float4 up = make_float4(__shfl(v.x, lane + 4, 64), __shfl(v.y, lane + 4, 64), __shfl(v.z, lane + 4, 64), __shfl(v.w, lane + 4, 64));
                const float4 dn = make_float4(__shfl(v.x, lane - 4, 64), __shfl(v.y, lane - 4, 64), __shfl(v.z, lane - 4, 64), __shfl(v.w, lane - 4, 64));
                if (d >= 64) {
                    const bool first = d < 80;
                    const int f = first ? (d - 64) : (d - 80);
                    const float4 cs0 = *(const float4*)(rope + ((size_t)s * 16 + f) * 2), cs1 = *(const float4*)(rope + ((size_t)s * 16 + f) * 2 + 4);
                    if (first) o = make_float4(v.x * cs0.x - up.x * cs0.y, v.y * cs0.z - up.y * cs0.w, v.z * cs1.x - up.z * cs1.y, v.w * cs1.z - up.w * cs1.w);
                    else       o = make_float4(v.x * cs0.x + dn.x * cs0.y, v.y * cs0.z + dn.y * cs0.w, v.z * cs1.x + dn.z * cs1.y, v.w * cs1.z + dn.w * cs1.w);
                }
                uint2 u; u.x = cvtpk(o.x, o.y); u.y = cvtpk(o.z, o.w);
                *(uint2*)(Qb + ((size_t)(b * NH + h) * S + s) * DQK + d) = u;
            }, [](float ssq) { return rsqrtf(ssq * (1.f / QR) + EPS) * QSCALE; }, lds);
    }
    {
        const bf16* W = (const bf16*)(ws + WS_WUKV) + (size_t)l * 1024 * KVR;
        bf16* Kb = (bf16*)(ws + WS_K); bf16* Vb = (bf16*)(ws + WS_V);
        gemm_t<true>(W, KVR, 1024, PROJ + C_CKV, DINP, T, KVR, 1024 / 128, [](int, int, const f32x16&, int, int, float) {},
            [&](int t, int n, const float4& v) {
                const int b = t / S, s = t % S;
                uint2 u; u.x = cvtpk(v.x, v.y); u.y = cvtpk(v.z, v.w);
                if (n < 512) *(uint2*)(Kb + ((size_t)(b * NH + (n >> 6)) * S + s) * DQK + (n & 63)) = u;
                else         *(uint2*)(Vb + ((size_t)(b * NH + ((n - 512) >> 6)) * S + s) * DV + (n & 63)) = u;
            }, [](float ssq) { return rsqrtf(ssq * (1.f / KVR) + EPS); }, lds);
    }
}
__device__ __forceinline__ void phase_gemm3(const Params& P, int l, char* lds) {
    unsigned char* ws = P.ws;
    const bf16* Yb = (const bf16*)(ws + WS_XN);
    const bf16* W = (const bf16*)(ws + WS_WOUT) + (size_t)l * D * LDW;
    const float* hin = (l == 0) ? P.x : P.out;
    float* out = P.out;
    gemm_t<false>(W, LDW, D, Yb, LDX, T, D, D / 128, [](int, int, const f32x16&, int, int, float) {}, [&](int t, int n, const float4& v) {
        const size_t idx = (size_t)t * D + n;
        const float4 hv = *(const float4*)(hin + idx);
        *(float4*)(out + idx) = make_float4(hv.x + v.x, hv.y + v.y, hv.z + v.z, hv.w + v.w);
    }, [](float) { return 1.f; }, lds);
}

#define GSYNC() do { XcdBarrier xb_; { __attribute__((address_space(1))) char* gp_ = (__attribute__((address_space(1))) char*)(char*)(P.ws + WS_CTL); asm volatile("" : "+s"(gp_)); xb_.bar = (unsigned*)(char*)gp_; } \
    xb_.x = xb_xcc_id(); xb_.st = (volatile LAS unsigned*)&xb_words; xcd_barrier(xb_); } while (0)
#define PHASE(stmt) { const Params Q = launder(P); stmt; }
__global__ void __launch_bounds__(NTHREADS, 2) k_all(Params P) {
    __shared__ __attribute__((aligned(16))) char sm[LDS_TOTAL];
    __shared__ uint4 xb_words;
    cg::grid_group grid = cg::this_grid();
    if (__builtin_amdgcn_workitem_id_x() == 0) xb_words = make_uint4(0u, 0u, 0u, 0u);
    __syncthreads();
    (void)xcd_barrier_post((unsigned*)(P.ws + WS_CTL), (volatile LAS unsigned*)&xb_words);
    __shared__ int xinfo[8];
    if (__builtin_amdgcn_workitem_id_x() == 0) {
        const unsigned x = xb_xcc_id();
        xinfo[XI_X] = (int)x; xinfo[XI_RANK] = (int)xb_add((unsigned*)(P.ws + WS_CTL) + CTL_CENSUS + x, 1u);
    }
    PHASE(phase_prep(Q, sm));
    PHASE(phase_norm(Q.x, Q.norm_mix, (bf16*)(Q.ws + WS_XN)));
    if (P.ws == nullptr) grid.sync();
    GSYNC();
    if (__builtin_amdgcn_workitem_id_x() == 0) {
        unsigned* cen = (unsigned*)(P.ws + WS_CTL) + CTL_CENSUS;
        const int x = xinfo[XI_X]; int nx = 0, jj = 0;
        for (int q = 0; q < 16; ++q) { const unsigned cq = xb_ld(cen + q); if (cq) { if (q < x) ++jj; ++nx; } }
        xinfo[XI_J] = jj; xinfo[XI_NX] = nx; xinfo[XI_NLOC] = (int)xb_ld(cen + x);
    }
    __syncthreads();
    for (int l = 0; l < DEPTH; ++l) {
        PHASE(phase_gemm1(Q, l, sm));
#if PROBE_DUP & 2
        PHASE(phase_gemm1(Q, l, sm));
#endif
        GSYNC();
        PHASE(phase_mixlocal(Q, l, sm));
#if PROBE_DUP & 256
        PHASE(phase_mixlocal(Q, l, sm));
#endif
        PHASE(phase_gemm2(Q, l, sm));
        GSYNC();
        PHASE(phase_attn(Q, sm));
        GSYNC();
        PHASE(phase_gemm3(Q, l, sm));
#if PROBE_DUP & 16
        if (l == 0) PHASE(phase_gemm3(Q, l, sm));
#endif
        GSYNC();
        PHASE(phase_norm_q(Q, l));
        GSYNC();
        PHASE(phase_route(Q, l, sm));
        GSYNC();
        PHASE(phase_gu(Q, l, xinfo));
        GSYNC();
        PHASE(phase_gw(Q, l));
        GSYNC();
        PHASE(phase_gv(Q, l, xinfo, sm));
        GSYNC();
        PHASE(phase_gnorm(Q, l));
        GSYNC();
    }
}

extern "C" void kernel_launch(void* const* d_in, const int* in_sizes, int n_in, void* d_out, int out_size, void* d_ws, size_t ws_size, hipStream_t stream) {
    static int grid = 0;
    if (grid == 0) {
        if (n_in != 18 || out_size != T * D || ws_size < WS_END) { fprintf(stderr, "kernel_launch: bad sizes n_in %d out %d ws %zu need %zu\n", n_in, out_size, ws_size, (size_t)WS_END); grid = -1; return; }
        int dev = 0, cus = 0, per_cu = 0;
        (void)hipGetDevice(&dev);
        (void)hipDeviceGetAttribute(&cus, hipDeviceAttributeMultiprocessorCount, dev);
        (void)hipOccupancyMaxActiveBlocksPerMultiprocessor(&per_cu, (const void*)k_all, NTHREADS, 0);
        if (per_cu > 2) per_cu = 2;
        if (per_cu < 1) { fprintf(stderr, "kernel_launch: occupancy query says %d\n", per_cu); grid = -1; return; }
        grid = cus * per_cu;
    }
    if (grid < 0) return;
    Params p{};
    p.x = (const float*)d_in[0]; p.norm_mix = (const float*)d_in[1]; p.w_in = (const float*)d_in[2]; p.conv_w = (const float*)d_in[3];
    p.pool_w = (const float*)d_in[4]; p.pool_scale = (const float*)d_in[5]; p.q_norm = (const float*)d_in[6]; p.w_uq = (const float*)d_in[7];
    p.kv_norm = (const float*)d_in[8]; p.w_uk = (const float*)d_in[9]; p.w_uv = (const float*)d_in[10]; p.w_out = (const float*)d_in[11];
    p.norm_ffn = (const float*)d_in[12]; p.peer_wq = (const float*)d_in[13]; p.peer_subkeys = (const float*)d_in[14]; p.peer_u = (const float*)d_in[15];
    p.peer_v = (const float*)d_in[16]; p.norm_final = (const float*)d_in[17];
    p.out = (float*)d_out; p.ws = (unsigned char*)d_ws;
    if (hipMemsetAsync((char*)d_ws + WS_CTL, 0, CTL_BYTES, stream) != hipSuccess) { fprintf(stderr, "kernel_launch: memset failed\n"); return; }
    void* args[] = {&p};
    hipError_t e = hipLaunchCooperativeKernel((const void*)k_all, dim3(grid), dim3(NTHREADS), args, 0, stream);
    if (e != hipSuccess) fprintf(stderr, "cooperative launch failed: %s (grid %d)\n", hipGetErrorString(e), grid);
}
```

```cpp
#include <hip/hip_runtime.h>
#include <hip/hip_cooperative_groups.h>
#include <cstdio>
#include <cstdint>
namespace cg = cooperative_groups;

#ifndef TAB_FP8
#define TAB_FP8 1
#endif
#ifndef PROBE_DUP
#define PROBE_DUP 0
#endif

constexpr int NB = 4, S = 8192, T = NB * S, D = 1024, DEPTH = 2;
constexpr int DIN = 1696, DINP = 1792;
constexpr int C_BG = 0, C_CG = 256, C_HC = 512, C_HP = 768, C_CQ = 1024, C_CKV = 1408, C_KR = 1664;
constexpr int QR = 384, KVR = 256, NH = 8, DQK = 96, DV = 64;
constexpr int PH = 8, NKEY = 128, NEXP = NKEY * NKEY, TOPK = 16, HK = PH * TOPK;
constexpr float EPS = 1e-6f;
constexpr int LDX = 1088;
constexpr int LDW = 1088;

typedef unsigned short bf16;

constexpr size_t WS_CTL   = 0;
constexpr size_t WS_ROPE  = 64 * 1024;
constexpr size_t WS_WIN   = WS_ROPE + (size_t)S * 16 * 2 * 4;
constexpr size_t WS_WUQ   = WS_WIN + (size_t)DEPTH * DINP * LDW * 2;
constexpr size_t WS_WUKV  = WS_WUQ + (size_t)DEPTH * 768 * QR * 2;
constexpr size_t WS_WOUT  = WS_WUKV + (size_t)DEPTH * 1024 * KVR * 2;
constexpr size_t WS_WPQ   = WS_WOUT + (size_t)DEPTH * D * LDW * 2;
constexpr size_t WS_XN    = ((WS_WPQ + (size_t)DEPTH * 2048 * LDW * 2 + 4095) / 4096) * 4096;
constexpr size_t WS_PROJ  = WS_XN + (size_t)T * LDX * 2;
constexpr size_t WS_Q     = WS_PROJ + (size_t)T * DINP * 2;
constexpr size_t WS_K     = WS_Q + (size_t)T * NH * DQK * 2;
constexpr size_t WS_V     = WS_K + (size_t)T * NH * DQK * 2;
constexpr size_t WS_EXP   = WS_V + (size_t)T * NH * DV * 2;
constexpr size_t WS_GATE  = WS_EXP + (size_t)T * HK * 4;
constexpr size_t TAB_ROWB = TAB_FP8 ? 1024 : 2048;
constexpr size_t WS_TABU  = WS_GATE + (size_t)T * HK * 4;
constexpr size_t WS_TABV  = WS_TABU + (size_t)DEPTH * NEXP * TAB_ROWB;
constexpr size_t WS_TSCU  = WS_TABV + (size_t)DEPTH * NEXP * TAB_ROWB;
constexpr size_t WS_TSCV  = WS_TSCU + (size_t)DEPTH * NEXP * 4;
constexpr size_t WS_XQ    = WS_TSCV + (size_t)DEPTH * NEXP * 4;
constexpr size_t WS_XS    = WS_XQ + (size_t)T * D;
constexpr size_t WS_WQ8   = WS_XS + (size_t)T * 4;
constexpr size_t WS_WSC   = WS_WQ8 + (size_t)T * HK;
constexpr size_t WS_END   = WS_WSC + (size_t)T * 4;
static_assert(WS_END <= (size_t)512 * 1024 * 1024, "workspace budget");

struct Params {
    const float* x; const float* norm_mix; const float* w_in; const float* conv_w; const float* pool_w; const float* pool_scale;
    const float* q_norm; const float* w_uq; const float* kv_norm; const float* w_uk; const float* w_uv; const float* w_out;
    const float* norm_ffn; const float* peer_wq; const float* peer_subkeys; const float* peer_u; const float* peer_v; const float* norm_final;
    float* out; unsigned char* ws;
};

__device__ __forceinline__ bf16 f2bf(float f) { unsigned u = __float_as_uint(f); u += 0x7fffu + ((u >> 16) & 1u); return (bf16)(u >> 16); }
__device__ __forceinline__ float bf2f(bf16 h) { return __uint_as_float(((unsigned)h) << 16); }
__device__ __forceinline__ float bflo(unsigned u) { return __uint_as_float(u << 16); }
__device__ __forceinline__ float bfhi(unsigned u) { return __uint_as_float(u & 0xffff0000u); }
__device__ __forceinline__ unsigned pack2(float a, float b) { return (unsigned)f2bf(a) | ((unsigned)f2bf(b) << 16); }
__device__ __forceinline__ float wave_sum(float v) {
#pragma unroll
    for (int m = 32; m >= 1; m >>= 1) v += __shfl_xor(v, m, 64);
    return v;
}
__device__ __forceinline__ float gelu_exact(float x) { return 0.5f * x * (1.f + erff(x * 0.70710678118654752f)); }

#define NTHREADS 256
__device__ __forceinline__ int tidx() { int t = (int)__builtin_amdgcn_workitem_id_x(); asm volatile("" : "+v"(t)); return t; }
__device__ __forceinline__ int gwave() { return blockIdx.x * (NTHREADS / 64) + (tidx() >> 6); }
__device__ __forceinline__ int nwave() { return gridDim.x * (NTHREADS / 64); }
__device__ __forceinline__ size_t gtid() { return (size_t)blockIdx.x * NTHREADS + tidx(); }
__device__ __forceinline__ size_t gnth() { return (size_t)gridDim.x * NTHREADS; }


__device__ __forceinline__ Params launder(const Params& P) {
    typedef __attribute__((address_space(1))) char* gp_t;
    gp_t g[20] = {(gp_t)(char*)P.x, (gp_t)(char*)P.norm_mix, (gp_t)(char*)P.w_in, (gp_t)(char*)P.conv_w, (gp_t)(char*)P.pool_w, (gp_t)(char*)P.pool_scale, (gp_t)(char*)P.q_norm, (gp_t)(char*)P.w_uq,
                  (gp_t)(char*)P.kv_norm, (gp_t)(char*)P.w_uk, (gp_t)(char*)P.w_uv, (gp_t)(char*)P.w_out, (gp_t)(char*)P.norm_ffn, (gp_t)(char*)P.peer_wq, (gp_t)(char*)P.peer_subkeys,
                  (gp_t)(char*)P.peer_u, (gp_t)(char*)P.peer_v, (gp_t)(char*)P.norm_final, (gp_t)(char*)P.out, (gp_t)(char*)P.ws};
    asm volatile("" : "+s"(g[0]), "+s"(g[1]), "+s"(g[2]), "+s"(g[3]), "+s"(g[4]), "+s"(g[5]), "+s"(g[6]), "+s"(g[7]), "+s"(g[8]), "+s"(g[9]));
    asm volatile("" : "+s"(g[10]), "+s"(g[11]), "+s"(g[12]), "+s"(g[13]), "+s"(g[14]), "+s"(g[15]), "+s"(g[16]), "+s"(g[17]), "+s"(g[18]), "+s"(g[19]));
    Params Q;
    Q.x = (const float*)(char*)g[0]; Q.norm_mix = (const float*)(char*)g[1]; Q.w_in = (const float*)(char*)g[2]; Q.conv_w = (const float*)(char*)g[3]; Q.pool_w = (const float*)(char*)g[4];
    Q.pool_scale = (const float*)(char*)g[5]; Q.q_norm = (const float*)(char*)g[6]; Q.w_uq = (const float*)(char*)g[7]; Q.kv_norm = (const float*)(char*)g[8]; Q.w_uk = (const float*)(char*)g[9];
    Q.w_uv = (const float*)(char*)g[10]; Q.w_out = (const float*)(char*)g[11]; Q.norm_ffn = (const float*)(char*)g[12]; Q.peer_wq = (const float*)(char*)g[13]; Q.peer_subkeys = (const float*)(char*)g[14];
    Q.peer_u = (const float*)(char*)g[15]; Q.peer_v = (const float*)(char*)g[16]; Q.norm_final = (const float*)(char*)g[17]; Q.out = (float*)(char*)g[18]; Q.ws = (unsigned char*)(char*)g[19];
    return Q;
}

typedef __attribute__((ext_vector_type(8))) short bf16x8;
typedef __attribute__((ext_vector_type(16))) float f32x16;
typedef __attribute__((ext_vector_type(2))) __bf16 bf2_t;
#define MFMA32(a, b, c) __builtin_amdgcn_mfma_f32_32x32x16_bf16(a, b, c, 0, 0, 0)
__device__ __forceinline__ int crow(int r, int hi) { return (r & 3) + 8 * (r >> 2) + 4 * hi; }
__device__ __forceinline__ float dot2bf(unsigned a, unsigned b, float c) { return __builtin_amdgcn_fdot2_f32_bf16(__builtin_bit_cast(bf2_t, a), __builtin_bit_cast(bf2_t, b), c, false); }
__device__ __forceinline__ unsigned cvtpk(float lo, float hi) { unsigned r; asm("v_cvt_pk_bf16_f32 %0, %1, %2" : "=v"(r) : "v"(lo), "v"(hi)); return r; }
constexpr int G_OPB = 128 * 128;
constexpr int G_BUF = 2 * G_OPB;
constexpr int GEMM_LDS = 2 * G_BUF;
constexpr int LDS_TOTAL = GEMM_LDS + 8192;

template <int WT, bool ROWSS>
__device__ __forceinline__ void gemm_kloop(const bf16* __restrict__ Ag0, int lda, const bf16* __restrict__ Bg0, int ldb, int nk, f32x16 (&acc)[4], float (&ss)[4], char* lds, int tid) {
    const int lane = tid & 63, w = __builtin_amdgcn_readfirstlane(tid >> 6), r32 = lane & 31, hi = lane >> 5;
    const int srow = 8 * w + (lane >> 3);
    const int sch = (lane & 7) ^ ((srow >> 1) & 7);
    const bf16* Ag = Ag0 + (size_t)srow * lda + sch * 8;
    const bf16* Bg = Bg0 + (size_t)srow * ldb + sch * 8;
#pragma unroll
    for (int i = 0; i < 4; ++i)
#pragma unroll
        for (int r = 0; r < 16; ++r) acc[i][r] = 0.f;
    ss[0] = 0.f; ss[1] = 0.f; ss[2] = 0.f; ss[3] = 0.f;
    typedef __attribute__((address_space(3))) unsigned* ldsp_t;
    typedef const __attribute__((address_space(1))) unsigned* glbp_t;
#define G_DMA(buf, kofs) do { char* d_ = lds + (buf) * G_BUF + (8 * w) * 128; \
    _Pragma("unroll") for (int i = 0; i < 4; ++i) { \
        __builtin_amdgcn_global_load_lds((glbp_t)(const void*)(Ag + (size_t)(32 * i) * lda + (kofs)), (ldsp_t)(void*)(d_ + i * 4096), 16, 0, 0); \
        __builtin_amdgcn_global_load_lds((glbp_t)(const void*)(Bg + (size_t)(32 * i) * ldb + (kofs)), (ldsp_t)(void*)(d_ + G_OPB + i * 4096), 16, 0, 0); } } while (0)
    const int xr = (r32 >> 1) & 7;
    const int o0 = ((0 + hi) ^ xr) << 4, o1 = ((2 + hi) ^ xr) << 4, o2 = ((4 + hi) ^ xr) << 4, o3 = ((6 + hi) ^ xr) << 4;
#define G_SS(s_, r_) do { union { bf16x8 v; uint4 u; } c_; c_.v = r_; s_ = dot2bf(c_.u.x, c_.u.x, s_); s_ = dot2bf(c_.u.y, c_.u.y, s_); s_ = dot2bf(c_.u.z, c_.u.z, s_); s_ = dot2bf(c_.u.w, c_.u.w, s_); } while (0)
#define G_STEP(pa, pb, off) do { \
    if (WT == 0) { \
        const bf16x8 a0 = *(const bf16x8*)(pa + off), a1 = *(const bf16x8*)(pa + 32 * 128 + off); \
        const bf16x8 b0 = *(const bf16x8*)(pb + off), b1 = *(const bf16x8*)(pb + 32 * 128 + off); \
        if (ROWSS) { G_SS(ss[0], b0); G_SS(ss[1], b1); } \
        acc[0] = MFMA32(a0, b0, acc[0]); acc[1] = MFMA32(a0, b1, acc[1]); \
        acc[2] = MFMA32(a1, b0, acc[2]); acc[3] = MFMA32(a1, b1, acc[3]); \
    } else { \
        const bf16x8 b0 = *(const bf16x8*)(pb + off); \
        const bf16x8 a0 = *(const bf16x8*)(pa + off), a1 = *(const bf16x8*)(pa + 32 * 128 + off); \
        const bf16x8 a2 = *(const bf16x8*)(pa + 64 * 128 + off), a3 = *(const bf16x8*)(pa + 96 * 128 + off); \
        acc[0] = MFMA32(a0, b0, acc[0]); acc[1] = MFMA32(a1, b0, acc[1]); \
        acc[2] = MFMA32(a2, b0, acc[2]); acc[3] = MFMA32(a3, b0, acc[3]); \
    } } while (0)
    const int arow = (WT == 0) ? ((w >> 1) * 64 + r32) : r32;
    const int brow = (WT == 0) ? ((w & 1) * 64 + r32) : (w * 32 + r32);
    G_DMA(0, 0);
    for (int kt = 0; kt < nk; ++kt) {
        __syncthreads();
        if (kt + 1 < nk) G_DMA((kt + 1) & 1, (kt + 1) * 64);
        const char* pa = lds + (kt & 1) * G_BUF + arow * 128;
        const char* pb = lds + (kt & 1) * G_BUF + G_OPB + brow * 128;
        G_STEP(pa, pb, o0); G_STEP(pa, pb, o1); G_STEP(pa, pb, o2); G_STEP(pa, pb, o3);
    }
    if (ROWSS) { ss[0] += __shfl_xor(ss[0], 32, 64); ss[1] += __shfl_xor(ss[1], 32, 64); }
#undef G_DMA
#undef G_SS
#undef G_STEP
}

__device__ __forceinline__ void tile_range(int ntiles, int& lo, int& hi) {
    const int G = gridDim.x, b = blockIdx.x;
    const int vb = ((G & 7) == 0) ? ((b & 7) * (G >> 3) + (b >> 3)) : b;
    const int per = (ntiles + G - 1) / G;
    lo = vb * per; hi = lo + per; if (hi > ntiles) hi = ntiles;
}
constexpr int ST_P = 68;
static_assert(4 * 64 * ST_P * 4 <= LDS_TOTAL, "staging LDS");
template <bool ROWSS, class EPI, class EPIROW, class RSC>
__device__ __forceinline__ void gemm_t(const bf16* __restrict__ Wt, int ldw, int N, const bf16* __restrict__ X, int ldx, int M, int K, int tn_direct, EPI epi, EPIROW epirow, RSC rowscale, char* lds) {
    const int tid = tidx(), lane = tid & 63, w = tid >> 6, r32 = lane & 31, hi = lane >> 5;
    const int tilesN = N / 128, tilesM = M / 128, nk = K / 64;
    int tlo, thi; tile_range(tilesM * tilesN, tlo, thi);
    for (int tile = tlo; tile < thi; ++tile) {
        const int tm = tile / tilesN, tn = tile % tilesN;
        f32x16 acc[4]; float ss[4];
        gemm_kloop<0, ROWSS>(Wt + (size_t)(tn * 128) * ldw, ldw, X + (size_t)(tm * 128) * ldx, ldx, nk, acc, ss, lds, tid);
        if (tn < tn_direct) {
            __syncthreads();
            float* st = (float*)lds + w * (64 * ST_P);
            const float m0_ = rowscale(ss[0]), m1_ = rowscale(ss[1]);
#pragma unroll
            for (int i = 0; i < 2; ++i)
#pragma unroll
                for (int j = 0; j < 2; ++j)
#pragma unroll
                    for (int g = 0; g < 4; ++g) {
                        const float mj = j ? m1_ : m0_;
                        *(float4*)(st + (32 * j + r32) * ST_P + 32 * i + 8 * g + 4 * hi) = make_float4(acc[i * 2 + j][4 * g] * mj, acc[i * 2 + j][4 * g + 1] * mj, acc[i * 2 + j][4 * g + 2] * mj, acc[i * 2 + j][4 * g + 3] * mj);
                    }
            const int rr = lane >> 4, ch = lane & 15;
#pragma unroll 4
            for (int it = 0; it < 16; ++it) {
                const int row = it * 4 + rr;
                const float4 v = *(const float4*)(st + row * ST_P + ch * 4);
                epirow(tm * 128 + (w & 1) * 64 + row, tn * 128 + (w >> 1) * 64 + ch * 4, v);
            }
        } else {
#pragma unroll
            for (int i = 0; i < 2; ++i)
#pragma unroll
                for (int j = 0; j < 2; ++j) {
                    const int tl = (w & 1) * 64 + j * 32;
                    epi(tn * 128 + (w >> 1) * 64 + i * 32, tm * 128 + tl, acc[i * 2 + j], r32, hi, ss[j]);
                }
        }
        __syncthreads();
    }
}

__device__ __forceinline__ void transpose_tiled(const float* __restrict__ W, bf16* __restrict__ Wt, int K, int N, int Npad, int ldk, const float* __restrict__ gain, char* lds) {
    float (*tl)[65] = (float (*)[65])lds;
    const int tid = tidx(), a = tid & 63, q = tid >> 6;
    const int tK = K / 64, tN = Npad / 64;
    for (int tile = blockIdx.x; tile < tK * tN; tile += gridDim.x) {
        const int k0 = (tile / tN) * 64, n0 = (tile % tN) * 64;
#pragma unroll 4
        for (int i = 0; i < 16; ++i) {
            const int k = k0 + q * 16 + i, n = n0 + a;
            float v = (n < N) ? W[(size_t)k * N + n] : 0.f;
            if (gain) v *= gain[k];
            tl[q * 16 + i][a] = v;
        }
        __syncthreads();
#pragma unroll 4
        for (int i = 0; i < 16; ++i) { const int nl = q * 16 + i; Wt[(size_t)(n0 + nl) * ldk + k0 + a] = f2bf(tl[a][nl]); }
        __syncthreads();
    }
}

__device__ __forceinline__ void quant_row(const float4 (&v)[4], unsigned char* __restrict__ dst, float* __restrict__ scl, int r, int lane) {
    float am = 0.f;
#pragma unroll
    for (int j = 0; j < 4; ++j) am = fmaxf(am, fmaxf(fmaxf(fabsf(v[j].x), fabsf(v[j].y)), fmaxf(fabsf(v[j].z), fabsf(v[j].w))));
#pragma unroll
    for (int m = 32; m >= 1; m >>= 1) am = fmaxf(am, __shfl_xor(am, m, 64));
    const float sc = (am > 0.f) ? am * (1.f / 448.f) : 1.f;
    const float is = 1.f / sc;
    uint4 o;
    { int w = 0; w = __builtin_amdgcn_cvt_pk_fp8_f32(v[0].x * is, v[0].y * is, w, false); w = __builtin_amdgcn_cvt_pk_fp8_f32(v[0].z * is, v[0].w * is, w, true); o.x = (unsigned)w; }
    { int w = 0; w = __builtin_amdgcn_cvt_pk_fp8_f32(v[1].x * is, v[1].y * is, w, false); w = __builtin_amdgcn_cvt_pk_fp8_f32(v[1].z * is, v[1].w * is, w, true); o.y = (unsigned)w; }
    { int w = 0; w = __builtin_amdgcn_cvt_pk_fp8_f32(v[2].x * is, v[2].y * is, w, false); w = __builtin_amdgcn_cvt_pk_fp8_f32(v[2].z * is, v[2].w * is, w, true); o.z = (unsigned)w; }
    { int w = 0; w = __builtin_amdgcn_cvt_pk_fp8_f32(v[3].x * is, v[3].y * is, w, false); w = __builtin_amdgcn_cvt_pk_fp8_f32(v[3].z * is, v[3].w * is, w, true); o.w = (unsigned)w; }
    { const int lay = r / NEXP, e = r % NEXP; *(uint4*)(dst + (((size_t)(lay * 8 + (lane >> 3)) * NEXP + e) * 128) + (lane & 7) * 16) = o; }
    if (lane == 0) scl[r] = sc;
}
__device__ __forceinline__ unsigned pack_i8x4(float a, float b, float c, float d) {
    const int ia = __float2int_rn(a), ib = __float2int_rn(b), ic = __float2int_rn(c), id = __float2int_rn(d);
    return (unsigned)(ia & 255) | ((unsigned)(ib & 255) << 8) | ((unsigned)(ic & 255) << 16) | ((unsigned)(id & 255) << 24);
}
__device__ __forceinline__ void quant_row_i8(const float4 (&v)[4], unsigned char* __restrict__ dst, float* __restrict__ scl, int r, int lane) {
    float am = 0.f;
#pragma unroll
    for (int j = 0; j < 4; ++j) am = fmaxf(am, fmaxf(fmaxf(fabsf(v[j].x), fabsf(v[j].y)), fmaxf(fabsf(v[j].z), fabsf(v[j].w))));
#pragma unroll
    for (int m = 32; m >= 1; m >>= 1) am = fmaxf(am, __shfl_xor(am, m, 64));
    const float sc = (am > 0.f) ? am * (1.f / 127.f) : 1.f;
    const float is = 1.f / sc;
    uint4 o;
    o.x = pack_i8x4(v[0].x * is, v[0].y * is, v[0].z * is, v[0].w * is); o.y = pack_i8x4(v[1].x * is, v[1].y * is, v[1].z * is, v[1].w * is);
    o.z = pack_i8x4(v[2].x * is, v[2].y * is, v[2].z * is, v[2].w * is); o.w = pack_i8x4(v[3].x * is, v[3].y * is, v[3].z * is, v[3].w * is);
    { const int lay = r / NEXP, e = r % NEXP; *(uint4*)(dst + (((size_t)(lay * 8 + (lane >> 3)) * NEXP + e) * 128) + (lane & 7) * 16) = o; }
    if (lane == 0) scl[r] = sc;
}
template <bool I8>
__device__ __forceinline__ void convert_table(const float* __restrict__ src, unsigned char* __restrict__ dst, float* __restrict__ scl, int rows) {
    static_assert(TAB_FP8, "fp8 tables");
    const int lane = tidx() & 63;
    const int nw = nwave();
    for (int r = gwave(); r < rows; r += 4 * nw) {
        float4 v[4][4]; int rr[4];
#pragma unroll
        for (int u = 0; u < 4; ++u) {
            rr[u] = (r + u * nw < rows) ? (r + u * nw) : r;
            const float4* s0 = (const float4*)(src + (size_t)rr[u] * D);
#pragma unroll
            for (int j = 0; j < 4; ++j) v[u][j] = s0[lane * 4 + j];
        }
#pragma unroll
        for (int u = 0; u < 4; ++u) {
            if (u == 0 || rr[u] != r) { if (I8) quant_row_i8(v[u], dst, scl, rr[u], lane); else quant_row(v[u], dst, scl, rr[u], lane); }
        }
    }
}
__device__ __forceinline__ void phase_prep(const Params& P, char* lds) {
    unsigned char* ws = P.ws;
    for (int l = 0; l < DEPTH; ++l) {
        transpose_tiled(P.w_in + (size_t)l * D * DIN, (bf16*)(ws + WS_WIN) + (size_t)l * DINP * LDW, D, DIN, DINP, LDW, nullptr, lds);
        transpose_tiled(P.w_uq + (size_t)l * QR * 768, (bf16*)(ws + WS_WUQ) + (size_t)l * 768 * QR, QR, 768, 768, QR, P.q_norm + l * QR, lds);
        transpose_tiled(P.w_uk + (size_t)l * KVR * 512, (bf16*)(ws + WS_WUKV) + (size_t)l * 1024 * KVR, KVR, 512, 512, KVR, P.kv_norm + l * KVR, lds);
        transpose_tiled(P.w_uv + (size_t)l * KVR * 512, (bf16*)(ws + WS_WUKV) + (size_t)l * 1024 * KVR + (size_t)512 * KVR, KVR, 512, 512, KVR, P.kv_norm + l * KVR, lds);
        transpose_tiled(P.w_out + (size_t)l * D * D, (bf16*)(ws + WS_WOUT) + (size_t)l * D * LDW, D, D, D, LDW, nullptr, lds);
    }
    {
        bf16* Wc = (bf16*)(ws + WS_WPQ);
        float (*As)[68] = (float (*)[68])lds;
        float (*Bs)[68] = (float (*)[68])(lds + 16 * 68 * 4);
        const int tid = tidx(), tx = tid & 15, ty = tid >> 4;
        const int lr = tid >> 2, ld4 = (tid & 3) * 4;
        for (int tile = blockIdx.x; tile < (DEPTH * 2048 / 64) * (D / 64); tile += gridDim.x) {
            const int row0 = (tile >> 4) * 64, k0 = (tile & 15) * 64;
            const int l = row0 >> 11, hp = (row0 >> 7) & 15, n0 = row0 & 127;
            const float* skp = P.peer_subkeys + (((size_t)l * 2 + (hp & 1)) * NKEY + n0 + lr) * 128 + ld4;
            const float* wqp = P.peer_wq + ((size_t)l * D + k0 + lr) * 2048 + hp * 128 + ld4;
            float acc[4][4];
#pragma unroll
            for (int i = 0; i < 4; ++i)
#pragma unroll
                for (int j = 0; j < 4; ++j) acc[i][j] = 0.f;
            for (int d0 = 0; d0 < 128; d0 += 16) {
                const float4 av = *(const float4*)(skp + d0), bv = *(const float4*)(wqp + d0);
                As[ld4 + 0][lr] = av.x; As[ld4 + 1][lr] = av.y; As[ld4 + 2][lr] = av.z; As[ld4 + 3][lr] = av.w;
                Bs[ld4 + 0][lr] = bv.x; Bs[ld4 + 1][lr] = bv.y; Bs[ld4 + 2][lr] = bv.z; Bs[ld4 + 3][lr] = bv.w;
                __syncthreads();
#pragma unroll
                for (int kk = 0; kk < 16; ++kk) {
                    const float4 a4 = *(const float4*)&As[kk][ty * 4], b4 = *(const float4*)&Bs[kk][tx * 4];
                    const float aa[4] = {a4.x, a4.y, a4.z, a4.w}, bb[4] = {b4.x, b4.y, b4.z, b4.w};
#pragma unroll
                    for (int i = 0; i < 4; ++i)
#pragma unroll
                        for (int j = 0; j < 4; ++j) acc[i][j] = fmaf(aa[i], bb[j], acc[i][j]);
                }
                __syncthreads();
            }
#pragma unroll
            for (int i = 0; i < 4; ++i) {
                uint2 o; o.x = pack2(acc[i][0], acc[i][1]); o.y = pack2(acc[i][2], acc[i][3]);
                *(uint2*)(Wc + (size_t)(row0 + ty * 4 + i) * LDW + k0 + tx * 4) = o;
            }
        }
    }
    convert_table<true>(P.peer_u, ws + WS_TABU, (float*)(ws + WS_TSCU), DEPTH * NEXP);
    convert_table<false>(P.peer_v, ws + WS_TABV, (float*)(ws + WS_TSCV), DEPTH * NEXP);
    float* rope = (float*)(ws + WS_ROPE);
    for (size_t i = gtid(); i < (size_t)S * 16; i += gnth()) {
        const int s = (int)(i >> 4), f = (int)(i & 15);
        const double inv = pow(10000.0, -(double)f / 16.0);
        const double ang = (double)s * inv;
        rope[2 * i] = (float)cos(ang); rope[2 * i + 1] = (float)sin(ang);
    }
}

__device__ __forceinline__ void phase_norm(const float* __restrict__ h, const float* __restrict__ g, bf16* __restrict__ xn) {
    const int lane = tidx() & 63, nw = nwave();
    for (int t = gwave(); t < T; t += 2 * nw) {
        const int t2 = (t + nw < T) ? (t + nw) : t;
        float4 v[2][4];
#pragma unroll
        for (int j = 0; j < 4; ++j) { v[0][j] = ((const float4*)(h + (size_t)t * D))[j * 64 + lane]; v[1][j] = ((const float4*)(h + (size_t)t2 * D))[j * 64 + lane]; }
#pragma unroll
        for (int u = 0; u < 2; ++u) {
            float ss = 0.f;
#pragma unroll
            for (int j = 0; j < 4; ++j) ss += v[u][j].x * v[u][j].x + v[u][j].y * v[u][j].y + v[u][j].z * v[u][j].z + v[u][j].w * v[u][j].w;
            ss = wave_sum(ss);
            const float r = rsqrtf(ss * (1.f / D) + EPS);
            const int tt = u ? t2 : t;
            if (u == 0 || t2 != t) {
#pragma unroll
                for (int j = 0; j < 4; ++j) {
                    const float4 gg = ((const float4*)g)[j * 64 + lane];
                    uint2 o; o.x = pack2(v[u][j].x * r * gg.x, v[u][j].y * r * gg.y); o.y = pack2(v[u][j].z * r * gg.z, v[u][j].w * r * gg.w);
                    ((uint2*)(xn + (size_t)tt * LDX))[j * 64 + lane] = o;
                }
            }
        }
    }
}

__device__ __forceinline__ void phase_norm_q(const Params& P, int l) {
    const int lane = tidx() & 63, nw = nwave();
    const float* g = P.norm_ffn + l * D;
    bf16* xn = (bf16*)(P.ws + WS_XN);
    unsigned* xq = (unsigned*)(P.ws + WS_XQ);
    float* xsc = (float*)(P.ws + WS_XS);
    for (int t = gwave(); t < T; t += 2 * nw) {
        const int t2 = (t + nw < T) ? (t + nw) : t;
        float4 v[2][4];
#pragma unroll
        for (int j = 0; j < 4; ++j) { v[0][j] = ((const float4*)(P.out + (size_t)t * D))[j * 64 + lane]; v[1][j] = ((const float4*)(P.out + (size_t)t2 * D))[j * 64 + lane]; }
#pragma unroll
        for (int u = 0; u < 2; ++u) {
            float ss = 0.f;
#pragma unroll
            for (int j = 0; j < 4; ++j) ss += v[u][j].x * v[u][j].x + v[u][j].y * v[u][j].y + v[u][j].z * v[u][j].z + v[u][j].w * v[u][j].w;
            ss = wave_sum(ss);
            const float r = rsqrtf(ss * (1.f / D) + EPS);
            const int tt = u ? t2 : t;
            if (u == 0 || t2 != t) {
                float am = 0.f;
#pragma unroll
                for (int j = 0; j < 4; ++j) {
                    const float4 gg = ((const float4*)g)[j * 64 + lane];
                    v[u][j].x *= r * gg.x; v[u][j].y *= r * gg.y; v[u][j].z *= r * gg.z; v[u][j].w *= r * gg.w;
                    am = fmaxf(am, fmaxf(fmaxf(fabsf(v[u][j].x), fabsf(v[u][j].y)), fmaxf(fabsf(v[u][j].z), fabsf(v[u][j].w))));
                    uint2 o; o.x = pack2(v[u][j].x, v[u][j].y); o.y = pack2(v[u][j].z, v[u][j].w);
                    ((uint2*)(xn + (size_t)tt * LDX))[j * 64 + lane] = o;
                }
#pragma unroll
                for (int m = 32; m >= 1; m >>= 1) am = fmaxf(am, __shfl_xor(am, m, 64));
                const float sc = (am > 0.f) ? am * (1.f / 127.f) : 1.f, is = 1.f / sc;
#pragma unroll
                for (int j = 0; j < 4; ++j) xq[(size_t)tt * (D / 4) + j * 64 + lane] = pack_i8x4(v[u][j].x * is, v[u][j].y * is, v[u][j].z * is, v[u][j].w * is);
                if (lane == 0) xsc[tt] = sc;
            }
        }
    }
}

__device__ __forceinline__ void phase_mixlocal(const Params& P, int l, char* lds) {
    const bf16* proj = (const bf16*)(P.ws + WS_PROJ);
    bf16* Y = (bf16*)(P.ws + WS_XN);
    const int tid = tidx();
    {
        const float* cw = P.conv_w + (size_t)l * 3 * 256;
        for (size_t i = gtid(); i < (size_t)T * 32; i += gnth()) {
            const int t = (int)(i >> 5), c0 = (int)(i & 31) * 8, s = t & (S - 1);
            const bf16* pr = proj + (size_t)t * DINP;
            float acc[8];
#pragma unroll
            for (int e = 0; e < 8; ++e) acc[e] = 0.f;
#pragma unroll
            for (int j = 0; j < 3; ++j) {
                if (s - 2 + j >= 0) {
                    const bf16* pp = pr - (size_t)(2 - j) * DINP;
                    const uint4 g = *(const uint4*)(pp + C_CG + c0), hc = *(const uint4*)(pp + C_HC + c0);
                    const float4 w0 = *(const float4*)(cw + j * 256 + c0), w1 = *(const float4*)(cw + j * 256 + c0 + 4);
                    acc[0] = fmaf(w0.x, bflo(g.x) * bflo(hc.x), acc[0]); acc[1] = fmaf(w0.y, bfhi(g.x) * bfhi(hc.x), acc[1]);
                    acc[2] = fmaf(w0.z, bflo(g.y) * bflo(hc.y), acc[2]); acc[3] = fmaf(w0.w, bfhi(g.y) * bfhi(hc.y), acc[3]);
                    acc[4] = fmaf(w1.x, bflo(g.z) * bflo(hc.z), acc[4]); acc[5] = fmaf(w1.y, bfhi(g.z) * bfhi(hc.z), acc[5]);
                    acc[6] = fmaf(w1.z, bflo(g.w) * bflo(hc.w), acc[6]); acc[7] = fmaf(w1.w, bfhi(g.w) * bfhi(hc.w), acc[7]);
                }
            }
            const uint4 bg = *(const uint4*)(pr + C_BG + c0);
            uint4 o;
            o.x = pack2(bflo(bg.x) * acc[0], bfhi(bg.x) * acc[1]); o.y = pack2(bflo(bg.y) * acc[2], bfhi(bg.y) * acc[3]);
            o.z = pack2(bflo(bg.z) * acc[4], bfhi(bg.z) * acc[5]); o.w = pack2(bflo(bg.w) * acc[6], bfhi(bg.w) * acc[7]);
            *(uint4*)(Y + (size_t)t * LDX + c0) = o;
        }
    }
    {
        float (*pl)[68] = (float (*)[68])lds;
        const float* pw = P.pool_w + (size_t)l * 4 * 64 * 64;
        const float* psc = P.pool_scale + l * 256;
        const int a = tid & 63, q = tid >> 6;
        for (int tile = blockIdx.x; tile < (T / 64) * 4; tile += gridDim.x) {
            const int g = tile & 3, t0 = (tile >> 2) * 64;
            const int w = 2 << g;
            {
                const bf16* col = proj + C_HP + g * 64 + a;
                const int tf = t0 + q * 16, sf = tf & (S - 1);
                float xr[31];
#pragma unroll
                for (int d = 1; d <= 15; ++d) xr[15 - d] = (d < w && sf - d >= 0) ? bf2f(col[(size_t)(tf - d) * DINP]) : 0.f;
#pragma unroll
                for (int i = 0; i < 16; ++i) xr[15 + i] = bf2f(col[(size_t)(tf + i) * DINP]);
                float sum = 0.f;
#pragma unroll
                for (int d = 1; d <= 15; ++d) sum += xr[15 - d];
#pragma unroll
                for (int i = 0; i < 16; ++i) {
                    const int s = sf + i;
                    sum += xr[15 + i];
                    const int cnt = (s + 1 < w) ? (s + 1) : w;
                    pl[q * 16 + i][a] = sum / (float)cnt - xr[15 + i];
                    const int o = 15 + i + 1;
                    const float old = (g == 0) ? xr[o - 2] : (g == 1) ? xr[o - 4] : (g == 2) ? xr[o - 8] : xr[o - 16];
                    sum -= old;
                }
            }
            __syncthreads();
            {
                float pc[64];
#pragma unroll
                for (int c = 0; c < 64; ++c) pc[c] = pw[(g * 64 + c) * 64 + a];
                const float sc = psc[g * 64 + a];
#pragma unroll 2
                for (int i = 0; i < 16; ++i) {
                    const float4* row = (const float4*)&pl[q * 16 + i][0];
                    float m0 = 0.f, m1 = 0.f;
#pragma unroll
                    for (int c4 = 0; c4 < 16; ++c4) { const float4 v = row[c4]; m0 = fmaf(v.x, pc[4 * c4], m0); m1 = fmaf(v.y, pc[4 * c4 + 1], m1); m0 = fmaf(v.z, pc[4 * c4 + 2], m0); m1 = fmaf(v.w, pc[4 * c4 + 3], m1); }
                    Y[(size_t)(t0 + q * 16 + i) * LDX + 256 + g * 64 + a] = f2bf((m0 + m1) * sc);
                }
            }
            __syncthreads();
        }
    }
}

typedef short v4i16_t __attribute__((ext_vector_type(4)));
typedef __attribute__((address_space(3))) v4i16_t* lds_v4p;
__device__ __forceinline__ v4i16_t vtr(const char* p) { return __builtin_amdgcn_ds_read_tr16_b64_v4i16((lds_v4p)p); }
constexpr int A_KP = 208, A_VP = 192;
constexpr int A_KB = 64 * A_KP, A_VB = 64 * A_VP, A_BUF = A_KB + A_VB, ATTN_LDS = 2 * A_BUF;
static_assert(ATTN_LDS <= GEMM_LDS, "attention LDS");

__device__ __forceinline__ void attn_unit(const bf16* __restrict__ Qb, const bf16* __restrict__ Kb, const bf16* __restrict__ Vb, bf16* __restrict__ Y, int bh, int qblk, char* lds) {
    const int tid = tidx(), lane = tid & 63, w = tid >> 6, r32 = lane & 31, hi = lane >> 5;
    const int q0 = qblk * 128, qw0 = q0 + w * 32;
    const int NT = 2 * qblk + 2;
    bf16x8 qf[6];
    {
        const bf16* qp = Qb + ((size_t)bh * S + qw0 + r32) * DQK + hi * 8;
#pragma unroll
        for (int ks = 0; ks < 6; ++ks) qf[ks] = *(const bf16x8*)(qp + ks * 16);
    }
    f32x16 o0, o1;
#pragma unroll
    for (int r = 0; r < 16; ++r) { o0[r] = 0.f; o1[r] = 0.f; }
    float m = -1e30f, lsum = 0.f;
    const char* Kg = (const char*)(Kb + (size_t)bh * S * DQK) + tid * 16;
    const char* Vg = (const char*)(Vb + (size_t)bh * S * DV) + tid * 16;
    const int kl0 = (tid / 12) * A_KP + (tid % 12) * 16, kl1 = ((tid + 256) / 12) * A_KP + ((tid + 256) % 12) * 16, kl2 = ((tid + 512) / 12) * A_KP + ((tid + 512) % 12) * 16;
    const int vl0 = (tid >> 3) * A_VP + (tid & 7) * 16, vl1 = vl0 + 32 * A_VP;
    uint4 pk0, pk1, pk2, pv0, pv1, qk0, qk1, qk2, qv0, qv1;
#define A_LOAD(S, t) do { const char* kg = Kg + (size_t)(t) * (64 * 192); const char* vg = Vg + (size_t)(t) * (64 * 128); \
        S##k0 = *(const uint4*)(kg); S##k1 = *(const uint4*)(kg + 4096); S##k2 = *(const uint4*)(kg + 8192); S##v0 = *(const uint4*)(vg); S##v1 = *(const uint4*)(vg + 4096); } while (0)
#define A_STORE(S, bK, bV) do { *(uint4*)(bK + kl0) = S##k0; *(uint4*)(bK + kl1) = S##k1; *(uint4*)(bK + kl2) = S##k2; *(uint4*)(bV + vl0) = S##v0; *(uint4*)(bV + vl1) = S##v1; } while (0)
#define A_PV(pf, kofs) do { \
            { const v4i16_t lo = vtr(pv + (kofs) * A_VP), hh = vtr(pv + ((kofs) + 8) * A_VP); const bf16x8 vf = {lo[0], lo[1], lo[2], lo[3], hh[0], hh[1], hh[2], hh[3]}; o0 = MFMA32(vf, pf.v, o0); } \
            { const v4i16_t lo = vtr(pv + (kofs) * A_VP + 64), hh = vtr(pv + ((kofs) + 8) * A_VP + 64); const bf16x8 vf = {lo[0], lo[1], lo[2], lo[3], hh[0], hh[1], hh[2], hh[3]}; o1 = MFMA32(vf, pf.v, o1); } } while (0)
    const int pvo = (4 * hi + ((lane & 15) >> 2)) * A_VP + (16 * ((lane >> 4) & 1) + 4 * (lane & 3)) * 2;
    A_LOAD(p, 0); A_LOAD(q, 1);
    for (int t2 = 0; t2 < NT; t2 += 2) {
#pragma unroll
        for (int half = 0; half < 2; ++half) {
            const int t = t2 + half;
            char* bK = lds + half * A_BUF; char* bV = bK + A_KB;
            if (half == 0) A_STORE(p, bK, bV); else A_STORE(q, bK, bV);
            __syncthreads();
            { const int tn = (t + 2 < NT) ? (t + 2) : (NT - 2 + half); if (half == 0) A_LOAD(p, tn); else A_LOAD(q, tn); }
        const int kt0 = t * 64;
        if (kt0 <= qw0) {
            f32x16 s0, s1;
#pragma unroll
            for (int r = 0; r < 16; ++r) { s0[r] = 0.f; s1[r] = 0.f; }
            const char* pk = bK + r32 * A_KP + hi * 16;
#pragma unroll
            for (int ks = 0; ks < 6; ++ks) {
                const bf16x8 a0 = *(const bf16x8*)(pk + ks * 32), a1 = *(const bf16x8*)(pk + 32 * A_KP + ks * 32);
                s0 = MFMA32(a0, qf[ks], s0); s1 = MFMA32(a1, qf[ks], s1);
            }
            if (kt0 + 63 > qw0) {
                const int qrow = qw0 + r32;
#pragma unroll
                for (int r = 0; r < 16; ++r) { const int key = kt0 + crow(r, hi); if (key > qrow) s0[r] = -INFINITY; if (key + 32 > qrow) s1[r] = -INFINITY; }
            }
            float mx = fmaxf(s0[0], s1[0]);
#pragma unroll
            for (int r = 1; r < 16; ++r) mx = fmaxf(mx, fmaxf(s0[r], s1[r]));
            mx = fmaxf(mx, __shfl_xor(mx, 32, 64));
            const float mn = fmaxf(m, mx), m_prev = m;
            const float alpha = __builtin_amdgcn_exp2f(m - mn);
            m = mn;
            float ps = 0.f;
#pragma unroll
            for (int r = 0; r < 16; ++r) { s0[r] = __builtin_amdgcn_exp2f(s0[r] - mn); s1[r] = __builtin_amdgcn_exp2f(s1[r] - mn); ps += s0[r] + s1[r]; }
            if (__builtin_amdgcn_ballot_w64(mn > m_prev) != 0ull) {
                lsum *= alpha;
#pragma unroll
                for (int r = 0; r < 16; ++r) { o0[r] *= alpha; o1[r] *= alpha; }
            }
            lsum += ps;
            union { unsigned u[4]; bf16x8 v; } p00, p01, p10, p11;
#pragma unroll
            for (int j = 0; j < 4; ++j) { p00.u[j] = cvtpk(s0[2 * j], s0[2 * j + 1]); p01.u[j] = cvtpk(s0[8 + 2 * j], s0[9 + 2 * j]); p10.u[j] = cvtpk(s1[2 * j], s1[2 * j + 1]); p11.u[j] = cvtpk(s1[8 + 2 * j], s1[9 + 2 * j]); }
            const char* pv = bV + pvo;
            A_PV(p00, 0); A_PV(p01, 16); A_PV(p10, 32); A_PV(p11, 48);
        }
        }
    }
    lsum += __shfl_xor(lsum, 32, 64);
    const float inv = 1.f / lsum;
    const int b = bh >> 3, h = bh & 7;
    bf16* yo = Y + (size_t)(b * S + qw0 + r32) * LDX + 512 + h * 64 + 4 * hi;
#pragma unroll
    for (int g = 0; g < 4; ++g) {
        uint2 a, c;
        a.x = cvtpk(o0[4 * g] * inv, o0[4 * g + 1] * inv); a.y = cvtpk(o0[4 * g + 2] * inv, o0[4 * g + 3] * inv);
        c.x = cvtpk(o1[4 * g] * inv, o1[4 * g + 1] * inv); c.y = cvtpk(o1[4 * g + 2] * inv, o1[4 * g + 3] * inv);
        *(uint2*)(yo + 8 * g) = a; *(uint2*)(yo + 32 + 8 * g) = c;
    }
    __syncthreads();
}
__device__ __forceinline__ void phase_attn(const Params& P, char* lds) {
    const bf16* Qb = (const bf16*)(P.ws + WS_Q);
    const bf16* Kb = (const bf16*)(P.ws + WS_K);
    const bf16* Vb = (const bf16*)(P.ws + WS_V);
    bf16* Y = (bf16*)(P.ws + WS_XN);
    for (int u = blockIdx.x; u < NB * NH * (S / 128); u += gridDim.x) {
        const int bh = u & 31, v = u >> 5;
        const int qblk = (v < 16) ? (63 - v) : (v < 32) ? (v - 16) : (v < 48) ? (79 - v) : (v - 32);
        attn_unit(Qb, Kb, Vb, Y, bh, qblk, lds);
    }
}

#define NET_HD __device__ __forceinline__
#define NET_U2F(u) __uint_as_float(u)
#define NET_F2U(f) __float_as_uint(f)
#define CE_DESC(a, b) do { const float hi__ = fmaxf(a, b), lo__ = fminf(a, b); a = hi__; b = lo__; } while (0)
NET_HD void sort16_desc(float (&v)[16]) {
#define CE2(a, b) CE_DESC(v[a], v[b])
    CE2(0,13); CE2(1,12); CE2(2,15); CE2(3,14); CE2(4,8); CE2(5,6); CE2(7,11); CE2(9,10);
    CE2(0,5); CE2(1,7); CE2(2,9); CE2(3,4); CE2(6,13); CE2(8,14); CE2(10,15); CE2(11,12);
    CE2(0,1); CE2(2,3); CE2(4,5); CE2(6,8); CE2(7,9); CE2(10,11); CE2(12,13); CE2(14,15);
    CE2(0,2); CE2(1,3); CE2(4,10); CE2(5,11); CE2(6,7); CE2(8,9); CE2(12,14); CE2(13,15);
    CE2(1,2); CE2(3,12); CE2(4,6); CE2(5,7); CE2(8,10); CE2(9,11); CE2(13,14);
    CE2(1,4); CE2(2,6); CE2(5,8); CE2(7,10); CE2(9,13); CE2(11,14);
    CE2(2,4); CE2(3,6); CE2(9,12); CE2(11,13);
    CE2(3,5); CE2(6,8); CE2(7,9); CE2(10,12);
    CE2(3,4); CE2(5,6); CE2(7,8); CE2(9,10); CE2(11,12);
    CE2(6,7); CE2(8,9);
#undef CE2
}
NET_HD void merge16_desc(float (&a)[16], const float (&b)[16]) {
#pragma unroll
    for (int i = 0; i < 16; ++i) a[i] = fmaxf(a[i], b[15 - i]);
#pragma unroll
    for (int j = 8; j > 0; j >>= 1) {
#pragma unroll
        for (int i = 0; i < 16; ++i) { const int l = i ^ j; if (l > i) CE_DESC(a[i], a[l]); }
    }
}
NET_HD void top16_of_64(float (&g0)[16], float (&g1)[16], float (&g2)[16], float (&g3)[16]) {
    sort16_desc(g0); sort16_desc(g1); sort16_desc(g2); sort16_desc(g3);
    merge16_desc(g0, g1); merge16_desc(g2, g3); merge16_desc(g0, g2);
}
NET_HD float u2f(unsigned u) { return NET_U2F(u); }
NET_HD unsigned f2u(float f) { return NET_F2U(f); }
template <class V16>
NET_HD void lane_top16(const V16& s0, const V16& s1, const V16& s2, const V16& s3, int hi, float (&out)[16]) {
    float g0[16], g1[16], g2[16], g3[16];
#pragma unroll
    for (int r = 0; r < 16; ++r) {
        const unsigned nb = (unsigned)((r & 3) + 8 * (r >> 2));
        g0[r] = u2f((f2u(s0[r]) & 0xFFFFFF80u) | nb); g1[r] = u2f((f2u(s1[r]) & 0xFFFFFF80u) | (nb + 32u));
        g2[r] = u2f((f2u(s2[r]) & 0xFFFFFF80u) | (nb + 64u)); g3[r] = u2f((f2u(s3[r]) & 0xFFFFFF80u) | (nb + 96u));
    }
    top16_of_64(g0, g1, g2, g3);
    const unsigned h4 = (unsigned)hi << 2;
#pragma unroll
    for (int i = 0; i < 16; ++i) out[i] = u2f(f2u(g0[i]) | h4);
}
constexpr int cand_slot(int a, int b) { int n = 0; for (int x = 0; x < 16; ++x) for (int y = 0; y < 16; ++y) { if (x == a && y == b) return n; if ((x + 1) * (y + 1) <= 16) ++n; } return n; }
NET_HD void cand_top16(const float (&s1)[16], const float (&s2)[16], float (&c)[16]) {
    float g0[16], g1[16], g2[16], g3[16];
#pragma unroll
    for (int i = 0; i < 16; ++i) { g0[i] = -3.0e38f; g1[i] = -3.0e38f; g2[i] = -3.0e38f; g3[i] = -3.0e38f; }
#pragma unroll
    for (int a = 0; a < 16; ++a) {
#pragma unroll
        for (int b = 0; b < 16; ++b) {
            if ((a + 1) * (b + 1) <= 16) {
                const int sl = cand_slot(a, b);
                const float v = u2f((f2u(s1[a] + s2[b]) & 0xFFFFFF00u) | (unsigned)(a * 16 + b));
                if (sl < 16) g0[sl & 15] = v; else if (sl < 32) g1[sl & 15] = v; else if (sl < 48) g2[sl & 15] = v; else g3[sl & 15] = v;
            }
        }
    }
    top16_of_64(g0, g1, g2, g3);
#pragma unroll
    for (int i = 0; i < 16; ++i) c[i] = g0[i];
}

__device__ __forceinline__ void phase_route(const Params& P, int l, char* lds) {
    const bf16* XN = (const bf16*)(P.ws + WS_XN);
    const bf16* Wc = (const bf16*)(P.ws + WS_WPQ) + (size_t)l * 2048 * LDW;
    int* EXPp = (int*)(P.ws + WS_EXP);
    float* GATEp = (float*)(P.ws + WS_GATE);
    const int tid = tidx(), lane = tid & 63, w = tid >> 6, r32 = lane & 31, hi = lane >> 5;
    int tlo, thi; tile_range((T / 128) * PH, tlo, thi);
    for (int u = tlo; u < thi; ++u) {
        const int tm = u >> 3, h = u & 7;
        float L0[16], L1[16];
        {
            f32x16 acc[4]; float ssd[4];
            gemm_kloop<1, false>(Wc + (size_t)((h * 2 + 0) * 128) * LDW, LDW, XN + (size_t)(tm * 128) * LDX, LDX, D / 64, acc, ssd, lds, tid);
            lane_top16(acc[0], acc[1], acc[2], acc[3], hi, L0);
            float o[16];
#pragma unroll
            for (int i = 0; i < 16; ++i) o[i] = __shfl_xor(L0[i], 32, 64);
            merge16_desc(L0, o);
        }
        {
            f32x16 acc[4]; float ssd[4];
            gemm_kloop<1, false>(Wc + (size_t)((h * 2 + 1) * 128) * LDW, LDW, XN + (size_t)(tm * 128) * LDX, LDX, D / 64, acc, ssd, lds, tid);
            lane_top16(acc[0], acc[1], acc[2], acc[3], hi, L1);
            float o[16];
#pragma unroll
            for (int i = 0; i < 16; ++i) o[i] = __shfl_xor(L1[i], 32, 64);
            merge16_desc(L1, o);
        }
        float c[16];
        cand_top16(L0, L1, c);
        __syncthreads();
        unsigned char* my = (unsigned char*)lds + tid * 32;
        {
            uint4 a, b;
#define PK4(L, i) ((__float_as_uint(L[i]) & 127u) | ((__float_as_uint(L[i + 1]) & 127u) << 8) | ((__float_as_uint(L[i + 2]) & 127u) << 16) | ((__float_as_uint(L[i + 3]) & 127u) << 24))
            a.x = PK4(L0, 0); a.y = PK4(L0, 4); a.z = PK4(L0, 8); a.w = PK4(L0, 12);
            b.x = PK4(L1, 0); b.y = PK4(L1, 4); b.z = PK4(L1, 8); b.w = PK4(L1, 12);
#undef PK4
            *(uint4*)my = a; *(uint4*)(my + 16) = b;
        }
        int ev[16]; float gv[16]; float den = 0.f;
#pragma unroll
        for (int k = 0; k < 16; ++k) {
            const unsigned ci = __float_as_uint(c[k]) & 255u;
            const int n1 = my[ci >> 4], n2 = my[16 + (ci & 15)];
            ev[k] = n1 * NKEY + n2;
            gv[k] = __expf(c[k] - c[0]); den += gv[k];
        }
        const float iden = 1.f / den;
        if (hi == 0) {
            const int t = tm * 128 + w * 32 + r32;
            uint4* ep = (uint4*)(EXPp + (size_t)t * HK + h * 16);
            float4* gp = (float4*)(GATEp + (size_t)t * HK + h * 16);
#pragma unroll
            for (int q = 0; q < 4; ++q) {
                ep[q] = make_uint4((unsigned)ev[4 * q], (unsigned)ev[4 * q + 1], (unsigned)ev[4 * q + 2], (unsigned)ev[4 * q + 3]);
                gp[q] = make_float4(gv[4 * q] * iden, gv[4 * q + 1] * iden, gv[4 * q + 2] * iden, gv[4 * q + 3] * iden);
            }
        }
        __syncthreads();
    }
}

constexpr size_t WS_PART = WS_PROJ;
static_assert((size_t)8 * T * HK * 4 <= WS_K - WS_PROJ, "PART alias");
constexpr int XI_X = 0, XI_RANK = 1, XI_J = 2, XI_NX = 3, XI_NLOC = 4;
constexpr int CTL_CENSUS = 4096;
constexpr int CTL_BYTES = (CTL_CENSUS + 16) * 4;

template <int M1, int M2, int M3, class TT>
__device__ __forceinline__ void red16x3(TT (&p)[16], int lane) {
#pragma unroll
    for (int i = 0; i < 8; ++i) { const bool up = lane & M1; const TT send = up ? p[i] : p[i + 8], keep = up ? p[i + 8] : p[i]; p[i] = keep + __shfl_xor(send, M1, 64); }
#pragma unroll
    for (int i = 0; i < 4; ++i) { const bool up = lane & M2; const TT send = up ? p[i] : p[i + 4], keep = up ? p[i + 4] : p[i]; p[i] = keep + __shfl_xor(send, M2, 64); }
#pragma unroll
    for (int i = 0; i < 2; ++i) { const bool up = lane & M3; const TT send = up ? p[i] : p[i + 2], keep = up ? p[i + 2] : p[i]; p[i] = keep + __shfl_xor(send, M3, 64); }
}
__device__ __forceinline__ void phase_gu(const Params& P, int l, const volatile int* xi) {
    const unsigned char* XQ = P.ws + WS_XQ;
    const float* XSc = (const float*)(P.ws + WS_XS);
    const int* EXPp = (const int*)(P.ws + WS_EXP);
    float* PART = (float*)(P.ws + WS_PART);
    const int tid = tidx(), lane = tid & 63, w = tid >> 6, g = lane >> 3, c = lane & 7;
    int xo_ = 0; asm volatile("" : "+v"(xo_));
    const int j = __builtin_amdgcn_readfirstlane(xi[xo_ + XI_J]), nx = __builtin_amdgcn_readfirstlane(xi[xo_ + XI_NX]), nloc = __builtin_amdgcn_readfirstlane(xi[xo_ + XI_NLOC]), rank = __builtin_amdgcn_readfirstlane(xi[xo_ + XI_RANK]);
    const int t0 = rank * 4 + w, st = nloc * 4;
    const int n = (t0 < T) ? (T - t0 + st - 1) / st : 0;
    const int i0 = 8 * (c & 1) + 4 * ((c >> 1) & 1) + 2 * ((c >> 2) & 1);
    for (int sl = j; sl < 8 && n > 0; sl += nx) {
        const unsigned char* Us = P.ws + WS_TABU + ((size_t)(l * 8 + sl) * NEXP) * 128;
        const unsigned co = (unsigned)c << 4;
        float* part = PART + (size_t)sl * T * HK;
        const unsigned char* xs = XQ + sl * 128 + c * 16;
#define GU_TK(k) (t0 + (((k) < n) ? (k) : (n - 1)) * st)
#define GU_LOADE(S, t) do { S##lo = EXPp[(size_t)(t) * HK + lane]; S##hi = EXPp[(size_t)(t) * HK + 64 + lane]; } while (0)
#define GU_LOADX(S, t) do { S##a = *(const uint4*)(xs + (size_t)(t) * D); S##s = XSc[t]; } while (0)
#define GU_ISSUE(R, S) do { _Pragma("unroll") for (int i = 0; i < 16; ++i) { \
            const int e = __builtin_amdgcn_ds_bpermute((((8 * i) & 63) + g) << 2, (i < 8) ? S##lo : S##hi); R[i] = *(const uint4*)(Us + (((unsigned)e << 7) | co)); } } while (0)
#define GU_FINISH(R, S, t) do { \
            int p[16]; \
            _Pragma("unroll") for (int i = 0; i < 16; ++i) { int d_ = __builtin_amdgcn_sdot4((int)S##a.x, (int)R[i].x, 0, false); d_ = __builtin_amdgcn_sdot4((int)S##a.y, (int)R[i].y, d_, false); \
                d_ = __builtin_amdgcn_sdot4((int)S##a.z, (int)R[i].z, d_, false); p[i] = __builtin_amdgcn_sdot4((int)S##a.w, (int)R[i].w, d_, false); } \
            red16x3<1, 2, 4, int>(p, lane); \
            part[(size_t)(t) * HK + 8 * i0 + g] = (float)p[0] * S##s; part[(size_t)(t) * HK + 8 * (i0 + 1) + g] = (float)p[1] * S##s; } while (0)
        int eAlo, eAhi, eBlo, eBhi; uint4 xAa, xBa; float xAs, xBs; uint4 rA[16], rB[16];
        GU_LOADE(eA, GU_TK(0)); GU_LOADX(xA, GU_TK(0)); GU_LOADE(eB, GU_TK(1));
        GU_ISSUE(rA, eA);
        for (int k = 0; k < n; k += 2) {
            GU_LOADX(xB, GU_TK(k + 1)); GU_ISSUE(rB, eB); GU_LOADE(eA, GU_TK(k + 2));
            GU_FINISH(rA, xA, GU_TK(k));
            GU_LOADX(xA, GU_TK(k + 2)); GU_ISSUE(rA, eA); GU_LOADE(eB, GU_TK(k + 3));
            GU_FINISH(rB, xB, GU_TK(k + 1));
        }
#undef GU_TK
#undef GU_LOADE
#undef GU_LOADX
#undef GU_ISSUE
#undef GU_FINISH
    }
}
__device__ __forceinline__ void phase_gw(const Params& P, int l) {
    const int* EXPp = (const int*)(P.ws + WS_EXP);
    const float* GATEp = (const float*)(P.ws + WS_GATE);
    const float* PART = (const float*)(P.ws + WS_PART);
    const float* SU = (const float*)(P.ws + WS_TSCU) + (size_t)l * NEXP;
    const float* SV = (const float*)(P.ws + WS_TSCV) + (size_t)l * NEXP;
    unsigned char* WQ = P.ws + WS_WQ8;
    float* WSC = (float*)(P.ws + WS_WSC);
    const int lane = tidx() & 63;
    for (int tb = gwave() * 4; tb < T; tb += nwave() * 4) {
        float wv[4][2];
#pragma unroll
        for (int q = 0; q < 4; ++q)
#pragma unroll
            for (int hk = 0; hk < 2; ++hk) {
                const size_t i = (size_t)(tb + q) * HK + hk * 64 + lane;
                float s = 0.f;
#pragma unroll
                for (int x = 0; x < 8; ++x) s += PART[(size_t)x * T * HK + i];
                const int e = EXPp[i];
                wv[q][hk] = GATEp[i] * gelu_exact(s * SU[e]) * SV[e];
            }
#pragma unroll
        for (int q = 0; q < 4; ++q) {
            float am = fmaxf(fabsf(wv[q][0]), fabsf(wv[q][1]));
#pragma unroll
            for (int m = 32; m >= 1; m >>= 1) am = fmaxf(am, __shfl_xor(am, m, 64));
            const float sc = (am > 0.f) ? am * (1.f / 448.f) : 1.f, is = 1.f / sc;
            const int pk = __builtin_amdgcn_cvt_pk_fp8_f32(wv[q][0] * is, wv[q][1] * is, 0, false);
            WQ[(size_t)(tb + q) * HK + lane] = (unsigned char)(pk & 255);
            WQ[(size_t)(tb + q) * HK + 64 + lane] = (unsigned char)((pk >> 8) & 255);
            if (lane == 0) WSC[tb + q] = sc;
        }
    }
}
typedef int v2i_t __attribute__((ext_vector_type(2)));
typedef unsigned u32x4_t __attribute__((ext_vector_type(4)));
typedef __attribute__((ext_vector_type(4))) float f32x4;
constexpr int GV_PIECE = 1024 + 16;
constexpr int GV_TILE = 16 * GV_PIECE;
static_assert(4 * GV_TILE + 4 * 512 <= LDS_TOTAL, "gv LDS");
__device__ __forceinline__ void phase_gv(const Params& P, int l, const volatile int* xi, char* lds) {
    const int* EXPp = (const int*)(P.ws + WS_EXP);
    const unsigned char* WQ = P.ws + WS_WQ8;
    const float* WSC = (const float*)(P.ws + WS_WSC);
    const int tid = tidx(), lane = tid & 63, w = __builtin_amdgcn_readfirstlane(tid >> 6), g = lane >> 3, pos = lane & 7;
    int xo_ = 0; asm volatile("" : "+v"(xo_));
    const int j = __builtin_amdgcn_readfirstlane(xi[xo_ + XI_J]), nx = __builtin_amdgcn_readfirstlane(xi[xo_ + XI_NX]), nloc = __builtin_amdgcn_readfirstlane(xi[xo_ + XI_NLOC]), rank = __builtin_amdgcn_readfirstlane(xi[xo_ + XI_RANK]);
    const int t0 = rank * 4 + w, st = nloc * 4;
    const int n = (t0 < T) ? (T - t0 + st - 1) / st : 0;
    char* tile = lds + w * GV_TILE;
    float* strip = (float*)(lds + 4 * GV_TILE) + w * 128;
    typedef __attribute__((address_space(3))) v2i_t* ldsv2_t;
    const unsigned co = (unsigned)(pos ^ g) << 4;
    const int rr = (lane & 15) >> 1, kq = lane >> 4;
    const int rdo = kq * GV_PIECE + rr * 128 + (lane & 1) * 8;
    const bool row0 = (lane & 15) == 0;
    __syncthreads();
    for (int sl = j; sl < 8 && n > 0; sl += nx) {
        const unsigned char* Vs = P.ws + WS_TABV + ((size_t)(l * 8 + sl) * NEXP) * 128;
        float* hrow = P.out + sl * 128 + 2 * lane;
#define GV_TK(k) (t0 + (((k) < n) ? (k) : (n - 1)) * st)
#define GV_LOADE(S, t) do { S##el = EXPp[(size_t)(t) * HK + lane]; S##eh = EXPp[(size_t)(t) * HK + 64 + lane]; } while (0)
#define GV_ISSUE(R, S) do { _Pragma("unroll") for (int i = 0; i < 16; ++i) { \
            const int e = __builtin_amdgcn_ds_bpermute((((8 * i) & 63) + g) << 2, (i < 8) ? S##el : S##eh); R[i] = *(const u32x4_t*)(Vs + (((unsigned)e << 7) | co)); } } while (0)
#define GV_LOADT(S, kk) do { const int t_ = GV_TK(kk); \
            S##a0 = 0; S##a1 = 0; S##a2 = 0; S##a3 = 0; \
            if (row0) { const long* wp = (const long*)(WQ + (size_t)t_ * HK + kq * 8); S##a0 = wp[0]; S##a1 = wp[4]; S##a2 = wp[8]; S##a3 = wp[12]; } \
            S##ws = ((kk) < n) ? WSC[t_] : 0.f; \
            S##hv = *(const float2*)(hrow + (size_t)t_ * D); } while (0)
#define GV_TOKEN(R, S, kk) do { \
            const int t = GV_TK(kk); \
            _Pragma("unroll") for (int i = 0; i < 16; ++i) *(u32x4_t*)(tile + i * GV_PIECE + lane * 16) = R[i]; \
            f32x4 acc[8]; \
            _Pragma("unroll") for (int nt = 0; nt < 8; ++nt) acc[nt] = (f32x4){0.f, 0.f, 0.f, 0.f}; \
            _Pragma("unroll") for (int s4 = 0; s4 < 4; ++s4) { \
                const long av = (s4 == 0) ? S##a0 : (s4 == 1) ? S##a1 : (s4 == 2) ? S##a2 : S##a3; \
                _Pragma("unroll") for (int nt = 0; nt < 8; ++nt) { \
                    const v2i_t bv = __builtin_amdgcn_ds_read_tr8_b64_v2i32((ldsv2_t)(void*)(tile + (4 * s4) * GV_PIECE + rdo + ((nt ^ rr) << 4))); \
                    acc[nt] = __builtin_amdgcn_mfma_f32_16x16x32_fp8_fp8(av, __builtin_bit_cast(long, bv), acc[nt], 0, 0, 0); } } \
            if (lane < 16) { _Pragma("unroll") for (int nt = 0; nt < 8; ++nt) strip[16 * nt + lane] = acc[nt][0]; }        \
            { const float2 o2 = *(const float2*)(strip + 2 * lane); \
              if ((kk) < n) *(float2*)(hrow + (size_t)t * D) = make_float2(S##hv.x + S##ws * o2.x, S##hv.y + S##ws * o2.y); } } while (0)
        int Ael, Aeh, Bel, Beh; u32x4_t rA[16], rB[16];
        long Pa0, Pa1, Pa2, Pa3, Qa0, Qa1, Qa2, Qa3; float Pws, Qws; float2 Phv, Qhv;
        GV_LOADE(A, GV_TK(0)); GV_LOADE(B, GV_TK(1));
        GV_ISSUE(rA, A); GV_LOADT(P, 0);
        for (int k = 0; k < n; k += 2) {
            GV_ISSUE(rB, B); GV_LOADE(A, GV_TK(k + 2)); GV_LOADT(Q, k + 1);
            GV_TOKEN(rA, P, k);
            GV_ISSUE(rA, A); GV_LOADE(B, GV_TK(k + 3)); GV_LOADT(P, k + 2);
            GV_TOKEN(rB, Q, k + 1);
        }
#undef GV_TK
#undef GV_LOADE
#undef GV_ISSUE
#undef GV_LOADT
#undef GV_TOKEN
    }
    __syncthreads();
}
__device__ __forceinline__ void phase_gnorm(const Params& P, int l) {
    const int lane = tidx() & 63, nw = nwave();
    bf16* XNw = (bf16*)(P.ws + WS_XN);
    const float4* g = (const float4*)((l == DEPTH - 1) ? P.norm_final : (P.norm_mix + (l + 1) * D));
    for (int t = gwave(); t < T; t += 2 * nw) {
        const int t2 = (t + nw < T) ? (t + nw) : t;
        float4 v[2][4];
#pragma unroll
        for (int q = 0; q < 4; ++q) { v[0][q] = ((const float4*)(P.out + (size_t)t * D))[q * 64 + lane]; v[1][q] = ((const float4*)(P.out + (size_t)t2 * D))[q * 64 + lane]; }
#pragma unroll
        for (int u = 0; u < 2; ++u) {
            float ss = 0.f;
#pragma unroll
            for (int q = 0; q < 4; ++q) ss += v[u][q].x * v[u][q].x + v[u][q].y * v[u][q].y + v[u][q].z * v[u][q].z + v[u][q].w * v[u][q].w;
            ss = wave_sum(ss);
            const float rn = rsqrtf(ss * (1.f / D) + EPS);
            const int tt = u ? t2 : t;
            if (u == 0 || t2 != t) {
                float4* hr = (float4*)(P.out + (size_t)tt * D);
#pragma unroll
                for (int q = 0; q < 4; ++q) {
                    const float4 gg = g[q * 64 + lane];
                    const float4 o = make_float4(v[u][q].x * rn * gg.x, v[u][q].y * rn * gg.y, v[u][q].z * rn * gg.z, v[u][q].w * rn * gg.w);
                    if (l == DEPTH - 1) hr[q * 64 + lane] = o;
                    else { uint2 uu; uu.x = pack2(o.x, o.y); uu.y = pack2(o.z, o.w); ((uint2*)(XNw + (size_t)tt * LDX))[q * 64 + lane] = uu; }
                }
            }
        }
    }
}

#define XB_TMO      128
#define XB_XCNT(j)  (256  + 64 * (j))
#define XB_XSUB(j)  (1280 + 64 * (j))
#define XB_XGEN(j)  (2304 + 64 * (j))
#define XB_TOP      3328
#define XB_TOPGEN   3392
#define XCD_BAR_WORDS 3456
#define XB_SPIN_CAP (1u << 22)
#define LAS __attribute__((address_space(3)))
__device__ __forceinline__ unsigned xb_ld(unsigned* p)              { return __hip_atomic_load(p, __ATOMIC_RELAXED, __HIP_MEMORY_SCOPE_AGENT); }
__device__ __forceinline__ unsigned xb_add(unsigned* p, unsigned v) { return __hip_atomic_fetch_add(p, v, __ATOMIC_RELAXED, __HIP_MEMORY_SCOPE_AGENT); }
__device__ __forceinline__ unsigned xb_xcc_id() { return (unsigned)__builtin_amdgcn_s_getreg((3 << 11) | 20) & 0xFu; }
#define XB_SPIN(cond, bar) do { unsigned _sp = 0; while (cond) { __builtin_amdgcn_s_sleep(1); \
    if ((++_sp & 255u) == 0u) { if (xb_ld(&(bar)[XB_TMO])) break; if (_sp > XB_SPIN_CAP) { atomicAdd(&(bar)[XB_TMO], 1u); break; } } } } while (0)
struct XcdBarrier { unsigned* bar; unsigned x; volatile LAS unsigned* st; };
__device__ __forceinline__ XcdBarrier xcd_barrier_post(unsigned* bar, volatile LAS unsigned* st) {
    XcdBarrier b; b.bar = bar; b.x = xb_xcc_id(); b.st = st;
    if (__builtin_amdgcn_workitem_id_x() == 0) (void)xb_add(&bar[XB_XCNT(b.x)], 1u);
    return b;
}
__device__ __forceinline__ void xcd_barrier_complete(unsigned* bar, unsigned x, unsigned& nloc, unsigned& nx) {
    const unsigned G = gridDim.x * gridDim.y * gridDim.z;
    unsigned sum, cnt, mine, sp = 0u;
    for (;;) {
        sum = 0u; cnt = 0u; mine = 0u;
#pragma unroll
        for (unsigned j = 0; j < 16; ++j) { const unsigned c = xb_ld(&bar[XB_XCNT(j)]); sum += c; cnt += (c > 0u) ? 1u : 0u; mine = (j == x) ? c : mine; }
        if (sum == G) break;
        __builtin_amdgcn_s_sleep(1);
        if ((++sp & 255u) == 0u) { if (xb_ld(&bar[XB_TMO])) break; if (sp > XB_SPIN_CAP) { atomicAdd(&bar[XB_TMO], 1u); break; } }
    }
    nloc = mine > 0u ? mine : 1u; nx = cnt > 0u ? cnt : 1u;
}
__device__ __forceinline__ void xcd_barrier(const XcdBarrier& b) {
    asm volatile("s_waitcnt vmcnt(0)" ::: "memory");
    __syncthreads();
    if (__builtin_amdgcn_workitem_id_x() == 0) {
        unsigned* bar = b.bar;
        __builtin_amdgcn_s_waitcnt(0);
        unsigned nloc = b.st[0], nx = b.st[1];
        if (nloc == 0u) { xcd_barrier_complete(bar, b.x, nloc, nx); b.st[0] = nloc; b.st[1] = nx; }
        const unsigned old = xb_add(&bar[XB_XSUB(b.x)], 1u);
        const unsigned gen = old / nloc;
        if (old + 1u == (gen + 1u) * nloc) {
            __builtin_amdgcn_fence(__ATOMIC_RELEASE, "agent");
            asm volatile("s_waitcnt vmcnt(0)" ::: "memory");
            const unsigned og = xb_add(&bar[XB_TOP], 1u);
            const unsigned tg = og / nx;
            if (og + 1u == (tg + 1u) * nx) xb_add(&bar[XB_TOPGEN], 1u);
            else XB_SPIN(xb_ld(&bar[XB_TOPGEN]) == tg, bar);
            __builtin_amdgcn_fence(__ATOMIC_ACQUIRE, "agent");
            xb_add(&bar[XB_XGEN(b.x)], 1u);
            asm volatile("s_waitcnt vmcnt(0)" ::: "memory");
        } else {
            XB_SPIN(xb_ld(&bar[XB_XGEN(b.x)]) == gen, bar);
            __builtin_amdgcn_fence(__ATOMIC_ACQUIRE, "agent");
            asm volatile("s_waitcnt vmcnt(0)" ::: "memory");
        }
    }
    __syncthreads();
}

constexpr float QSCALE = 0.10206207261596575f * 1.4426950408889634f;

__device__ __forceinline__ void phase_gemm1(const Params& P, int l, char* lds) {
    unsigned char* ws = P.ws;
    const bf16* XN = (const bf16*)(ws + WS_XN);
    bf16* PROJ = (bf16*)(ws + WS_PROJ);
    bf16* Kb = (bf16*)(ws + WS_K);
    const float* rope = (const float*)(ws + WS_ROPE);
    const bf16* W = (const bf16*)(ws + WS_WIN) + (size_t)l * DINP * LDW;
    gemm_t<false>(W, LDW, DINP, XN, LDX, T, D, C_KR / 128, [&](int n0, int t0, const f32x16& acc, int r32, int hi, float) {
        const int t = t0 + r32;
        if (n0 < C_KR) {
            bf16* pr = PROJ + (size_t)t * DINP + n0 + 4 * hi;
#pragma unroll
            for (int g = 0; g < 4; ++g) { uint2 o; o.x = cvtpk(acc[4 * g], acc[4 * g + 1]); o.y = cvtpk(acc[4 * g + 2], acc[4 * g + 3]); *(uint2*)(pr + 8 * g) = o; }
        } else if (n0 == C_KR) {
            const int b = t / S, s = t % S;
            uint2 o1[2], o2[2];
#pragma unroll
            for (int g = 0; g < 2; ++g) {
                const float4 cs0 = *(const float4*)(rope + ((size_t)s * 16 + 8 * g + 4 * hi) * 2), cs1 = *(const float4*)(rope + ((size_t)s * 16 + 8 * g + 4 * hi) * 2 + 4);
                const float x10 = acc[4 * g], x11 = acc[4 * g + 1], x12 = acc[4 * g + 2], x13 = acc[4 * g + 3];
                const float x20 = acc[8 + 4 * g], x21 = acc[8 + 4 * g + 1], x22 = acc[8 + 4 * g + 2], x23 = acc[8 + 4 * g + 3];
                o1[g].x = cvtpk(x10 * cs0.x - x20 * cs0.y, x11 * cs0.z - x21 * cs0.w); o1[g].y = cvtpk(x12 * cs1.x - x22 * cs1.y, x13 * cs1.z - x23 * cs1.w);
                o2[g].x = cvtpk(x20 * cs0.x + x10 * cs0.y, x21 * cs0.z + x11 * cs0.w); o2[g].y = cvtpk(x22 * cs1.x + x12 * cs1.y, x23 * cs1.z + x13 * cs1.w);
            }
#pragma unroll
            for (int h = 0; h < NH; ++h) {
                bf16* kr = Kb + ((size_t)(b * NH + h) * S + s) * DQK + 64 + 4 * hi;
                *(uint2*)(kr) = o1[0]; *(uint2*)(kr + 8) = o1[1]; *(uint2*)(kr + 16) = o2[0]; *(uint2*)(kr + 24) = o2[1];
            }
        }
    }, [&](int t, int n, const float4& v) {
        uint2 o; o.x = cvtpk(v.x, v.y); o.y = cvtpk(v.z, v.w);
        *(uint2*)(PROJ + (size_t)t * DINP + n) = o;
    }, [](float) { return 1.f; }, lds);
}
__device__ __forceinline__ void phase_gemm2(const Params& P, int l, char* lds) {
    unsigned char* ws = P.ws;
    const bf16* PROJ = (const bf16*)(ws + WS_PROJ);
    const float* rope = (const float*)(ws + WS_ROPE);
    const int lane = tidx() & 63;
    {
        const bf16* W = (const bf16*)(ws + WS_WUQ) + (size_t)l * 768 * QR;
        bf16* Qb = (bf16*)(ws + WS_Q);
        gemm_t<true>(W, QR, 768, PROJ + C_CQ, DINP, T, QR, 768 / 128, [](int, int, const f32x16&, int, int, float) {},
            [&](int t, int n, const float4& v) {
                const int b = t / S, s = t % S, h = n / DQK, d = n % DQK;
                float4 o = v;
                const float4 up = make_float4(__shfl(v.x, lane + 4, 64), __shfl(v.y, lane + 4, 64), __shfl(v.z, lane + 4, 64), __shfl(v.w, lane + 4, 64));
                const float4 dn = make_float4(__shfl(v.x, lane - 4, 64), __shfl(v.y, lane - 4, 64), __shfl(v.z, lane - 4, 64), __shfl(v.w, lane - 4, 64));
                if (d >= 64) {
                    const bool first = d < 80;
                    const int f = first ? (d - 64) : (d - 80);
                    const float4 cs0 = *(const float4*)(rope + ((size_t)s * 16 + f) * 2), cs1 = *(const float4*)(rope + ((size_t)s * 16 + f) * 2 + 4);
                    if (first) o = make_float4(v.x * cs0.x - up.x * cs0.y, v.y * cs0.z - up.y * cs0.w, v.z * cs1.x - up.z * cs1.y, v.w * cs1.z - up.w * cs1.w);
                    else       o = make_float4(v.x * cs0.x + dn.x * cs0.y, v.y * cs0.z + dn.y * cs0.w, v.z * cs1.x + dn.z * cs1.y, v.w * cs1.z + dn.w * cs1.w);
                }
                uint2 u; u.x = cvtpk(o.x, o.y); u.y = cvtpk(o.z, o.w);
                *(uint2*)(Qb + ((size_t)(b * NH + h) * S + s) * DQK + d) = u;
            }, [](float ssq) { return rsqrtf(ssq * (1.f / QR) + EPS) * QSCALE; }, lds);
    }
    {
        const bf16* W = (const bf16*)(ws + WS_WUKV) + (size_t)l * 1024 * KVR;
        bf16* Kb = (bf16*)(ws + WS_K); bf16* Vb = (bf16*)(ws + WS_V);
        gemm_t<true>(W, KVR, 1024, PROJ + C_CKV, DINP, T, KVR, 1024 / 128, [](int, int, const f32x16&, int, int, float) {},
            [&](int t, int n, const float4& v) {
                const int b = t / S, s = t % S;
                uint2 u; u.x = cvtpk(v.x, v.y); u.y = cvtpk(v.z, v.w);
                if (n < 512) *(uint2*)(Kb + ((size_t)(b * NH + (n >> 6)) * S + s) * DQK + (n & 63)) = u;
                else         *(uint2*)(Vb + ((size_t)(b * NH + ((n - 512) >> 6)) * S + s) * DV + (n & 63)) = u;
            }, [](float ssq) { return rsqrtf(ssq * (1.f / KVR) + EPS); }, lds);
    }
}
__device__ __forceinline__ void phase_gemm3(const Params& P, int l, char* lds) {
    unsigned char* ws = P.ws;
    const bf16* Yb = (const bf16*)(ws + WS_XN);
    const bf16* W = (const bf16*)(ws + WS_WOUT) + (size_t)l * D * LDW;
    const float* hin = (l == 0) ? P.x : P.out;
    float* out = P.out;
    const int tid = tidx(), lane = tid & 63, w = tid >> 6, r32 = lane & 31, hi = lane >> 5;
    const int rr = lane >> 4, ch = lane & 15;
    int tlo, thi; tile_range((T / 128) * (D / 128), tlo, thi);
    for (int tile = tlo; tile < thi; ++tile) {
        const int tm = tile / (D / 128), tn = tile % (D / 128);
        const size_t base = (size_t)(tm * 128 + (w & 1) * 64 + rr) * D + tn * 128 + (w >> 1) * 64 + ch * 4;
        float4 hv[16];
#pragma unroll
        for (int it = 0; it < 16; ++it) hv[it] = *(const float4*)(hin + base + (size_t)(it * 4) * D);
        f32x16 acc[4]; float ss[4];
        gemm_kloop<0, false>(W + (size_t)(tn * 128) * LDW, LDW, Yb + (size_t)(tm * 128) * LDX, LDX, D / 64, acc, ss, lds, tid);
        __syncthreads();
        float* st = (float*)lds + w * (64 * ST_P);
#pragma unroll
        for (int i = 0; i < 2; ++i)
#pragma unroll
            for (int j = 0; j < 2; ++j)
#pragma unroll
                for (int g = 0; g < 4; ++g)
                    *(float4*)(st + (32 * j + r32) * ST_P + 32 * i + 8 * g + 4 * hi) = make_float4(acc[i * 2 + j][4 * g], acc[i * 2 + j][4 * g + 1], acc[i * 2 + j][4 * g + 2], acc[i * 2 + j][4 * g + 3]);
#pragma unroll
        for (int it = 0; it < 16; ++it) {
            const float4 v = *(const float4*)(st + (it * 4 + rr) * ST_P + ch * 4);
            *(float4*)(out + base + (size_t)(it * 4) * D) = make_float4(hv[it].x + v.x, hv[it].y + v.y, hv[it].z + v.z, hv[it].w + v.w);
        }
        __syncthreads();
    }
}

#define GSYNC() do { XcdBarrier xb_; { __attribute__((address_space(1))) char* gp_ = (__attribute__((address_space(1))) char*)(char*)(P.ws + WS_CTL); asm volatile("" : "+s"(gp_)); xb_.bar = (unsigned*)(char*)gp_; } \
    xb_.x = xb_xcc_id(); xb_.st = (volatile LAS unsigned*)&xb_words; xcd_barrier(xb_); } while (0)
#define PHASE(stmt) { const Params Q = launder(P); stmt; }
__global__ void __launch_bounds__(NTHREADS, 2) k_all(Params P) {
    __shared__ __attribute__((aligned(16))) char sm[LDS_TOTAL];
    __shared__ uint4 xb_words;
    cg::grid_group grid = cg::this_grid();
    if (__builtin_amdgcn_workitem_id_x() == 0) xb_words = make_uint4(0u, 0u, 0u, 0u);
    __syncthreads();
    (void)xcd_barrier_post((unsigned*)(P.ws + WS_CTL), (volatile LAS unsigned*)&xb_words);
    __shared__ int xinfo[8];
    if (__builtin_amdgcn_workitem_id_x() == 0) {
        const unsigned x = xb_xcc_id();
        xinfo[XI_X] = (int)x; xinfo[XI_RANK] = (int)xb_add((unsigned*)(P.ws + WS_CTL) + CTL_CENSUS + x, 1u);
    }
    PHASE(phase_prep(Q, sm));
    PHASE(phase_norm(Q.x, Q.norm_mix, (bf16*)(Q.ws + WS_XN)));
    if (P.ws == nullptr) grid.sync();
    GSYNC();
    if (__builtin_amdgcn_workitem_id_x() == 0) {
        unsigned* cen = (unsigned*)(P.ws + WS_CTL) + CTL_CENSUS;
        const int x = xinfo[XI_X]; int nx = 0, jj = 0;
        for (int q = 0; q < 16; ++q) { const unsigned cq = xb_ld(cen + q); if (cq) { if (q < x) ++jj; ++nx; } }
        xinfo[XI_J] = jj; xinfo[XI_NX] = nx; xinfo[XI_NLOC] = (int)xb_ld(cen + x);
    }
    __syncthreads();
    for (int l = 0; l < DEPTH; ++l) {
        PHASE(phase_gemm1(Q, l, sm));
#if PROBE_DUP & 2
        PHASE(phase_gemm1(Q, l, sm));
#endif
        GSYNC();
        PHASE(phase_mixlocal(Q, l, sm));
#if PROBE_DUP & 256
        PHASE(phase_mixlocal(Q, l, sm));
#endif
        PHASE(phase_gemm2(Q, l, sm));
        GSYNC();
        PHASE(phase_attn(Q, sm));
        GSYNC();
        PHASE(phase_gemm3(Q, l, sm));
#if PROBE_DUP & 16
        if (l == 0) PHASE(phase_gemm3(Q, l, sm));
#endif
        GSYNC();
        PHASE(phase_norm_q(Q, l));
        GSYNC();
        PHASE(phase_route(Q, l, sm));
        GSYNC();
        PHASE(phase_gu(Q, l, xinfo));
        GSYNC();
        PHASE(phase_gw(Q, l));
        GSYNC();
        PHASE(phase_gv(Q, l, xinfo, sm));
        GSYNC();
        PHASE(phase_gnorm(Q, l));
        GSYNC();
    }
}

extern "C" void kernel_launch(void* const* d_in, const int* in_sizes, int n_in, void* d_out, int out_size, void* d_ws, size_t ws_size, hipStream_t stream) {
    static int grid = 0;
    if (grid == 0) {
        if (n_in != 18 || out_size != T * D || ws_size < WS_END) { fprintf(stderr, "kernel_launch: bad sizes n_in %d out %d ws %zu need %zu\n", n_in, out_size, ws_size, (size_t)WS_END); grid = -1; return; }
        int dev = 0, cus = 0, per_cu = 0;
        (void)hipGetDevice(&dev);
        (void)hipDeviceGetAttribute(&cus, hipDeviceAttributeMultiprocessorCount, dev);
        (void)hipOccupancyMaxActiveBlocksPerMultiprocessor(&per_cu, (const void*)k_all, NTHREADS, 0);
        if (per_cu > 2) per_cu = 2;
        if (per_cu < 1) { fprintf(stderr, "kernel_launch: occupancy query says %d\n", per_cu); grid = -1; return; }
        grid = cus * per_cu;
    }
    if (grid < 0) return;
    Params p{};
    p.x = (const float*)d_in[0]; p.norm_mix = (const float*)d_in[1]; p.w_in = (const float*)d_in[2]; p.conv_w = (const float*)d_in[3];
    p.pool_w = (const float*)d_in[4]; p.pool_scale = (const float*)d_in[5]; p.q_norm = (const float*)d_in[6]; p.w_uq = (const float*)d_in[7];
    p.kv_norm = (const float*)d_in[8]; p.w_uk = (const float*)d_in[9]; p.w_uv = (const float*)d_in[10]; p.w_out = (const float*)d_in[11];
    p.norm_ffn = (const float*)d_in[12]; p.peer_wq = (const float*)d_in[13]; p.peer_subkeys = (const float*)d_in[14]; p.peer_u = (const float*)d_in[15];
    p.peer_v = (const float*)d_in[16]; p.norm_final = (const float*)d_in[17];
    p.out = (float*)d_out; p.ws = (unsigned char*)d_ws;
    if (hipMemsetAsync((char*)d_ws + WS_CTL, 0, CTL_BYTES, stream) != hipSuccess) { fprintf(stderr, "kernel_launch: memset failed\n"); return; }
    void* args[] = {&p};
    hipError_t e = hipLaunchCooperativeKernel((const void*)k_all, dim3(grid), dim3(NTHREADS), args, 0, stream);
    if (e != hipSuccess) fprintf(stderr, "cooperative launch failed: %s (grid %d)\n", hipGetErrorString(e), grid);
}
```

```cpp
#include <hip/hip_runtime.h>
#include <hip/hip_cooperative_groups.h>
#include <cstdio>
#include <cstdint>
namespace cg = cooperative_groups;

#ifndef TAB_FP8
#define TAB_FP8 1
#endif
#ifndef PROBE_DUP
#define PROBE_DUP 0
#endif

constexpr int NB = 4, S = 8192, T = NB * S, D = 1024, DEPTH = 2;
constexpr int DIN = 1696, DINP = 1792;
constexpr int C_BG = 0, C_CG = 256, C_HC = 512, C_HP = 768, C_CQ = 1024, C_CKV = 1408, C_KR = 1664;
constexpr int QR = 384, KVR = 256, NH = 8, DQK = 96, DV = 64;
constexpr int PH = 8, NKEY = 128, NEXP = NKEY * NKEY, TOPK = 16, HK = PH * TOPK;
constexpr float EPS = 1e-6f;
constexpr int LDX = 1088;
constexpr int LDW = 1088;

typedef unsigned short bf16;

constexpr size_t WS_CTL   = 0;
constexpr size_t WS_ROPE  = 64 * 1024;
constexpr size_t WS_WIN   = WS_ROPE + (size_t)S * 16 * 2 * 4;
constexpr size_t WS_WUQ   = WS_WIN + (size_t)DEPTH * DINP * LDW * 2;
constexpr size_t WS_WUKV  = WS_WUQ + (size_t)DEPTH * 768 * QR * 2;
constexpr size_t WS_WOUT  = WS_WUKV + (size_t)DEPTH * 1024 * KVR * 2;
constexpr size_t WS_WPQ   = WS_WOUT + (size_t)DEPTH * D * LDW * 2;
constexpr size_t WS_XN    = ((WS_WPQ + (size_t)DEPTH * 2048 * LDW * 2 + 4095) / 4096) * 4096;
constexpr size_t WS_PROJ  = WS_XN + (size_t)T * LDX * 2;
constexpr size_t WS_Q     = WS_PROJ + (size_t)T * DINP * 2;
constexpr size_t WS_K     = WS_Q + (size_t)T * NH * DQK * 2;
constexpr size_t WS_V     = WS_K + (size_t)T * NH * DQK * 2;
constexpr size_t WS_EXP   = WS_V + (size_t)T * NH * DV * 2;
constexpr size_t WS_GATE  = WS_EXP + (size_t)T * HK * 4;
constexpr size_t TAB_ROWB = TAB_FP8 ? 1024 : 2048;
constexpr size_t WS_TABU  = WS_GATE + (size_t)T * HK * 4;
constexpr size_t WS_TABV  = WS_TABU + (size_t)DEPTH * NEXP * TAB_ROWB;
constexpr size_t WS_TSCU  = WS_TABV + (size_t)DEPTH * NEXP * TAB_ROWB;
constexpr size_t WS_TSCV  = WS_TSCU + (size_t)DEPTH * NEXP * 4;
constexpr size_t WS_XQ    = WS_TSCV + (size_t)DEPTH * NEXP * 4;
constexpr size_t WS_XS    = WS_XQ + (size_t)T * D;
constexpr size_t WS_WQ8   = WS_XS + (size_t)T * 4;
constexpr size_t WS_WSC   = WS_WQ8 + (size_t)T * HK;
constexpr size_t WS_END   = WS_WSC + (size_t)T * 4;
static_assert(WS_END <= (size_t)512 * 1024 * 1024, "workspace budget");

struct Params {
    const float* x; const float* norm_mix; const float* w_in; const float* conv_w; const float* pool_w; const float* pool_scale;
    const float* q_norm; const float* w_uq; const float* kv_norm; const float* w_uk; const float* w_uv; const float* w_out;
    const float* norm_ffn; const float* peer_wq; const float* peer_subkeys; const float* peer_u; const float* peer_v; const float* norm_final;
    float* out; unsigned char* ws;
};

__device__ __forceinline__ bf16 f2bf(float f) { unsigned u = __float_as_uint(f); u += 0x7fffu + ((u >> 16) & 1u); return (bf16)(u >> 16); }
__device__ __forceinline__ float bf2f(bf16 h) { return __uint_as_float(((unsigned)h) << 16); }
__device__ __forceinline__ float bflo(unsigned u) { return __uint_as_float(u << 16); }
__device__ __forceinline__ float bfhi(unsigned u) { return __uint_as_float(u & 0xffff0000u); }
__device__ __forceinline__ unsigned pack2(float a, float b) { return (unsigned)f2bf(a) | ((unsigned)f2bf(b) << 16); }
__device__ __forceinline__ float wave_sum(float v) {
#pragma unroll
    for (int m = 32; m >= 1; m >>= 1) v += __shfl_xor(v, m, 64);
    return v;
}
__device__ __forceinline__ float gelu_exact(float x) { return 0.5f * x * (1.f + erff(x * 0.70710678118654752f)); }

#define NTHREADS 256
__device__ __forceinline__ int tidx() { int t = (int)__builtin_amdgcn_workitem_id_x(); asm volatile("" : "+v"(t)); return t; }
__device__ __forceinline__ int gwave() { return blockIdx.x * (NTHREADS / 64) + (tidx() >> 6); }
__device__ __forceinline__ int nwave() { return gridDim.x * (NTHREADS / 64); }
__device__ __forceinline__ size_t gtid() { return (size_t)blockIdx.x * NTHREADS + tidx(); }
__device__ __forceinline__ size_t gnth() { return (size_t)gridDim.x * NTHREADS; }


__device__ __forceinline__ Params launder(const Params& P) {
    typedef __attribute__((address_space(1))) char* gp_t;
    gp_t g[20] = {(gp_t)(char*)P.x, (gp_t)(char*)P.norm_mix, (gp_t)(char*)P.w_in, (gp_t)(char*)P.conv_w, (gp_t)(char*)P.pool_w, (gp_t)(char*)P.pool_scale, (gp_t)(char*)P.q_norm, (gp_t)(char*)P.w_uq,
                  (gp_t)(char*)P.kv_norm, (gp_t)(char*)P.w_uk, (gp_t)(char*)P.w_uv, (gp_t)(char*)P.w_out, (gp_t)(char*)P.norm_ffn, (gp_t)(char*)P.peer_wq, (gp_t)(char*)P.peer_subkeys,
                  (gp_t)(char*)P.peer_u, (gp_t)(char*)P.peer_v, (gp_t)(char*)P.norm_final, (gp_t)(char*)P.out, (gp_t)(char*)P.ws};
    asm volatile("" : "+s"(g[0]), "+s"(g[1]), "+s"(g[2]), "+s"(g[3]), "+s"(g[4]), "+s"(g[5]), "+s"(g[6]), "+s"(g[7]), "+s"(g[8]), "+s"(g[9]));
    asm volatile("" : "+s"(g[10]), "+s"(g[11]), "+s"(g[12]), "+s"(g[13]), "+s"(g[14]), "+s"(g[15]), "+s"(g[16]), "+s"(g[17]), "+s"(g[18]), "+s"(g[19]));
    Params Q;
    Q.x = (const float*)(char*)g[0]; Q.norm_mix = (const float*)(char*)g[1]; Q.w_in = (const float*)(char*)g[2]; Q.conv_w = (const float*)(char*)g[3]; Q.pool_w = (const float*)(char*)g[4];
    Q.pool_scale = (const float*)(char*)g[5]; Q.q_norm = (const float*)(char*)g[6]; Q.w_uq = (const float*)(char*)g[7]; Q.kv_norm = (const float*)(char*)g[8]; Q.w_uk = (const float*)(char*)g[9];
    Q.w_uv = (const float*)(char*)g[10]; Q.w_out = (const float*)(char*)g[11]; Q.norm_ffn = (const float*)(char*)g[12]; Q.peer_wq = (const float*)(char*)g[13]; Q.peer_subkeys = (const float*)(char*)g[14];
    Q.peer_u = (const float*)(char*)g[15]; Q.peer_v = (const float*)(char*)g[16]; Q.norm_final = (const float*)(char*)g[17]; Q.out = (float*)(char*)g[18]; Q.ws = (unsigned char*)(char*)g[19];
    return Q;
}

typedef __attribute__((ext_vector_type(8))) short bf16x8;
typedef __attribute__((ext_vector_type(16))) float f32x16;
typedef __attribute__((ext_vector_type(2))) __bf16 bf2_t;
#define MFMA32(a, b, c) __builtin_amdgcn_mfma_f32_32x32x16_bf16(a, b, c, 0, 0, 0)
__device__ __forceinline__ int crow(int r, int hi) { return (r & 3) + 8 * (r >> 2) + 4 * hi; }
__device__ __forceinline__ float dot2bf(unsigned a, unsigned b, float c) { return __builtin_amdgcn_fdot2_f32_bf16(__builtin_bit_cast(bf2_t, a), __builtin_bit_cast(bf2_t, b), c, false); }
__device__ __forceinline__ unsigned cvtpk(float lo, float hi) { unsigned r; asm("v_cvt_pk_bf16_f32 %0, %1, %2" : "=v"(r) : "v"(lo), "v"(hi)); return r; }
constexpr int G_OPB = 128 * 128;
constexpr int G_BUF = 2 * G_OPB;
constexpr int GEMM_LDS = 2 * G_BUF;
constexpr int LDS_TOTAL = GEMM_LDS + 8192;

template <int WT, bool ROWSS>
__device__ __forceinline__ void gemm_kloop(const bf16* __restrict__ Ag0, int lda, const bf16* __restrict__ Bg0, int ldb, int nk, f32x16 (&acc)[4], float (&ss)[4], char* lds, int tid) {
    const int lane = tid & 63, w = __builtin_amdgcn_readfirstlane(tid >> 6), r32 = lane & 31, hi = lane >> 5;
    const int srow = 8 * w + (lane >> 3);
    const int sch = (lane & 7) ^ ((srow >> 1) & 7);
    const bf16* Ag = Ag0 + (size_t)srow * lda + sch * 8;
    const bf16* Bg = Bg0 + (size_t)srow * ldb + sch * 8;
#pragma unroll
    for (int i = 0; i < 4; ++i)
#pragma unroll
        for (int r = 0; r < 16; ++r) acc[i][r] = 0.f;
    ss[0] = 0.f; ss[1] = 0.f; ss[2] = 0.f; ss[3] = 0.f;
    typedef __attribute__((address_space(3))) unsigned* ldsp_t;
    typedef const __attribute__((address_space(1))) unsigned* glbp_t;
#define G_DMA(buf, kofs) do { char* d_ = lds + (buf) * G_BUF + (8 * w) * 128; \
    _Pragma("unroll") for (int i = 0; i < 4; ++i) { \
        __builtin_amdgcn_global_load_lds((glbp_t)(const void*)(Ag + (size_t)(32 * i) * lda + (kofs)), (ldsp_t)(void*)(d_ + i * 4096), 16, 0, 0); \
        __builtin_amdgcn_global_load_lds((glbp_t)(const void*)(Bg + (size_t)(32 * i) * ldb + (kofs)), (ldsp_t)(void*)(d_ + G_OPB + i * 4096), 16, 0, 0); } } while (0)
    const int xr = (r32 >> 1) & 7;
    const int o0 = ((0 + hi) ^ xr) << 4, o1 = ((2 + hi) ^ xr) << 4, o2 = ((4 + hi) ^ xr) << 4, o3 = ((6 + hi) ^ xr) << 4;
#define G_SS(s_, r_) do { union { bf16x8 v; uint4 u; } c_; c_.v = r_; s_ = dot2bf(c_.u.x, c_.u.x, s_); s_ = dot2bf(c_.u.y, c_.u.y, s_); s_ = dot2bf(c_.u.z, c_.u.z, s_); s_ = dot2bf(c_.u.w, c_.u.w, s_); } while (0)
#define G_STEP(pa, pb, off) do { \
    if (WT == 0) { \
        const bf16x8 a0 = *(const bf16x8*)(pa + off), a1 = *(const bf16x8*)(pa + 32 * 128 + off); \
        const bf16x8 b0 = *(const bf16x8*)(pb + off), b1 = *(const bf16x8*)(pb + 32 * 128 + off); \
        if (ROWSS) { G_SS(ss[0], b0); G_SS(ss[1], b1); } \
        acc[0] = MFMA32(a0, b0, acc[0]); acc[1] = MFMA32(a0, b1, acc[1]); \
        acc[2] = MFMA32(a1, b0, acc[2]); acc[3] = MFMA32(a1, b1, acc[3]); \
    } else { \
        const bf16x8 b0 = *(const bf16x8*)(pb + off); \
        const bf16x8 a0 = *(const bf16x8*)(pa + off), a1 = *(const bf16x8*)(pa + 32 * 128 + off); \
        const bf16x8 a2 = *(const bf16x8*)(pa + 64 * 128 + off), a3 = *(const bf16x8*)(pa + 96 * 128 + off); \
        acc[0] = MFMA32(a0, b0, acc[0]); acc[1] = MFMA32(a1, b0, acc[1]); \
        acc[2] = MFMA32(a2, b0, acc[2]); acc[3] = MFMA32(a3, b0, acc[3]); \
    } } while (0)
    const int arow = (WT == 0) ? ((w >> 1) * 64 + r32) : r32;
    const int brow = (WT == 0) ? ((w & 1) * 64 + r32) : (w * 32 + r32);
    G_DMA(0, 0);
    for (int kt = 0; kt < nk; ++kt) {
        __syncthreads();
        if (kt + 1 < nk) G_DMA((kt + 1) & 1, (kt + 1) * 64);
        const char* pa = lds + (kt & 1) * G_BUF + arow * 128;
        const char* pb = lds + (kt & 1) * G_BUF + G_OPB + brow * 128;
        if (WT == 0) {
#define G_RD(off, A0, A1, B0, B1) do { A0 = *(const bf16x8*)(pa + off); A1 = *(const bf16x8*)(pa + 32 * 128 + off); B0 = *(const bf16x8*)(pb + off); B1 = *(const bf16x8*)(pb + 32 * 128 + off); } while (0)
#define G_MM(A0, A1, B0, B1) do { if (ROWSS) { G_SS(ss[0], B0); G_SS(ss[1], B1); } \
            acc[0] = MFMA32(A0, B0, acc[0]); acc[1] = MFMA32(A0, B1, acc[1]); acc[2] = MFMA32(A1, B0, acc[2]); acc[3] = MFMA32(A1, B1, acc[3]); } while (0)
            bf16x8 xa0, xa1, xb0, xb1, ya0, ya1, yb0, yb1;
            G_RD(o0, xa0, xa1, xb0, xb1);
            G_RD(o1, ya0, ya1, yb0, yb1); __builtin_amdgcn_sched_barrier(0);
            G_MM(xa0, xa1, xb0, xb1); G_RD(o2, xa0, xa1, xb0, xb1); __builtin_amdgcn_sched_barrier(0);
            G_MM(ya0, ya1, yb0, yb1); G_RD(o3, ya0, ya1, yb0, yb1); __builtin_amdgcn_sched_barrier(0);
            G_MM(xa0, xa1, xb0, xb1);
            G_MM(ya0, ya1, yb0, yb1);
#undef G_RD
#undef G_MM
        } else {
            G_STEP(pa, pb, o0); G_STEP(pa, pb, o1); G_STEP(pa, pb, o2); G_STEP(pa, pb, o3);
        }
    }
    if (ROWSS) { ss[0] += __shfl_xor(ss[0], 32, 64); ss[1] += __shfl_xor(ss[1], 32, 64); }
#undef G_DMA
#undef G_SS
#undef G_STEP
}

__device__ __forceinline__ void tile_range(int ntiles, int& lo, int& hi) {
    const int G = gridDim.x, b = blockIdx.x;
    const int vb = ((G & 7) == 0) ? ((b & 7) * (G >> 3) + (b >> 3)) : b;
    const int per = (ntiles + G - 1) / G;
    lo = vb * per; hi = lo + per; if (hi > ntiles) hi = ntiles;
}
constexpr int ST_P = 68;
static_assert(4 * 64 * ST_P * 4 <= LDS_TOTAL, "staging LDS");
template <bool ROWSS, class EPI, class EPIROW, class RSC>
__device__ __forceinline__ void gemm_t(const bf16* __restrict__ Wt, int ldw, int N, const bf16* __restrict__ X, int ldx, int M, int K, int tn_direct, EPI epi, EPIROW epirow, RSC rowscale, char* lds) {
    const int tid = tidx(), lane = tid & 63, w = tid >> 6, r32 = lane & 31, hi = lane >> 5;
    const int tilesN = N / 128, tilesM = M / 128, nk = K / 64;
    int tlo, thi; tile_range(tilesM * tilesN, tlo, thi);
    for (int tile = tlo; tile < thi; ++tile) {
        const int tm = tile / tilesN, tn = tile % tilesN;
        f32x16 acc[4]; float ss[4];
        gemm_kloop<0, ROWSS>(Wt + (size_t)(tn * 128) * ldw, ldw, X + (size_t)(tm * 128) * ldx, ldx, nk, acc, ss, lds, tid);
        if (tn < tn_direct) {
            __syncthreads();
            float* st = (float*)lds + w * (64 * ST_P);
            const float m0_ = rowscale(ss[0]), m1_ = rowscale(ss[1]);
#pragma unroll
            for (int i = 0; i < 2; ++i)
#pragma unroll
                for (int j = 0; j < 2; ++j)
#pragma unroll
                    for (int g = 0; g < 4; ++g) {
                        const float mj = j ? m1_ : m0_;
                        *(float4*)(st + (32 * j + r32) * ST_P + 32 * i + 8 * g + 4 * hi) = make_float4(acc[i * 2 + j][4 * g] * mj, acc[i * 2 + j][4 * g + 1] * mj, acc[i * 2 + j][4 * g + 2] * mj, acc[i * 2 + j][4 * g + 3] * mj);
                    }
            const int rr = lane >> 4, ch = lane & 15;
#pragma unroll 4
            for (int it = 0; it < 16; ++it) {
                const int row = it * 4 + rr;
                const float4 v = *(const float4*)(st + row * ST_P + ch * 4);
                epirow(tm * 128 + (w & 1) * 64 + row, tn * 128 + (w >> 1) * 64 + ch * 4, v);
            }
        } else {
#pragma unroll
            for (int i = 0; i < 2; ++i)
#pragma unroll
                for (int j = 0; j < 2; ++j) {
                    const int tl = (w & 1) * 64 + j * 32;
                    epi(tn * 128 + (w >> 1) * 64 + i * 32, tm * 128 + tl, acc[i * 2 + j], r32, hi, ss[j]);
                }
        }
        __syncthreads();
    }
}

__device__ __forceinline__ void transpose_tiled(const float* __restrict__ W, bf16* __restrict__ Wt, int K, int N, int Npad, int ldk, const float* __restrict__ gain, char* lds) {
    float (*tl)[65] = (float (*)[65])lds;
    const int tid = tidx(), a = tid & 63, q = tid >> 6;
    const int tK = K / 64, tN = Npad / 64;
    for (int tile = blockIdx.x; tile < tK * tN; tile += gridDim.x) {
        const int k0 = (tile / tN) * 64, n0 = (tile % tN) * 64;
#pragma unroll 4
        for (int i = 0; i < 16; ++i) {
            const int k = k0 + q * 16 + i, n = n0 + a;
            float v = (n < N) ? W[(size_t)k * N + n] : 0.f;
            if (gain) v *= gain[k];
            tl[q * 16 + i][a] = v;
        }
        __syncthreads();
#pragma unroll 4
        for (int i = 0; i < 16; ++i) { const int nl = q * 16 + i; Wt[(size_t)(n0 + nl) * ldk + k0 + a] = f2bf(tl[a][nl]); }
        __syncthreads();
    }
}

__device__ __forceinline__ void quant_row(const float4 (&v)[4], unsigned char* __restrict__ dst, float* __restrict__ scl, int r, int lane) {
    float am = 0.f;
#pragma unroll
    for (int j = 0; j < 4; ++j) am = fmaxf(am, fmaxf(fmaxf(fabsf(v[j].x), fabsf(v[j].y)), fmaxf(fabsf(v[j].z), fabsf(v[j].w))));
#pragma unroll
    for (int m = 32; m >= 1; m >>= 1) am = fmaxf(am, __shfl_xor(am, m, 64));
    const float sc = (am > 0.f) ? am * (1.f / 448.f) : 1.f;
    const float is = 1.f / sc;
    uint4 o;
    { int w = 0; w = __builtin_amdgcn_cvt_pk_fp8_f32(v[0].x * is, v[0].y * is, w, false); w = __builtin_amdgcn_cvt_pk_fp8_f32(v[0].z * is, v[0].w * is, w, true); o.x = (unsigned)w; }
    { int w = 0; w = __builtin_amdgcn_cvt_pk_fp8_f32(v[1].x * is, v[1].y * is, w, false); w = __builtin_amdgcn_cvt_pk_fp8_f32(v[1].z * is, v[1].w * is, w, true); o.y = (unsigned)w; }
    { int w = 0; w = __builtin_amdgcn_cvt_pk_fp8_f32(v[2].x * is, v[2].y * is, w, false); w = __builtin_amdgcn_cvt_pk_fp8_f32(v[2].z * is, v[2].w * is, w, true); o.z = (unsigned)w; }
    { int w = 0; w = __builtin_amdgcn_cvt_pk_fp8_f32(v[3].x * is, v[3].y * is, w, false); w = __builtin_amdgcn_cvt_pk_fp8_f32(v[3].z * is, v[3].w * is, w, true); o.w = (unsigned)w; }
    { const int lay = r / NEXP, e = r % NEXP; *(uint4*)(dst + (((size_t)(lay * 8 + (lane >> 3)) * NEXP + e) * 128) + (lane & 7) * 16) = o; }
    if (lane == 0) scl[r] = sc;
}
__device__ __forceinline__ unsigned pack_i8x4(float a, float b, float c, float d) {
    const int ia = __float2int_rn(a), ib = __float2int_rn(b), ic = __float2int_rn(c), id = __float2int_rn(d);
    return (unsigned)(ia & 255) | ((unsigned)(ib & 255) << 8) | ((unsigned)(ic & 255) << 16) | ((unsigned)(id & 255) << 24);
}
__device__ __forceinline__ void quant_row_i8(const float4 (&v)[4], unsigned char* __restrict__ dst, float* __restrict__ scl, int r, int lane) {
    float am = 0.f;
#pragma unroll
    for (int j = 0; j < 4; ++j) am = fmaxf(am, fmaxf(fmaxf(fabsf(v[j].x), fabsf(v[j].y)), fmaxf(fabsf(v[j].z), fabsf(v[j].w))));
#pragma unroll
    for (int m = 32; m >= 1; m >>= 1) am = fmaxf(am, __shfl_xor(am, m, 64));
    const float sc = (am > 0.f) ? am * (1.f / 127.f) : 1.f;
    const float is = 1.f / sc;
    uint4 o;
    o.x = pack_i8x4(v[0].x * is, v[0].y * is, v[0].z * is, v[0].w * is); o.y = pack_i8x4(v[1].x * is, v[1].y * is, v[1].z * is, v[1].w * is);
    o.z = pack_i8x4(v[2].x * is, v[2].y * is, v[2].z * is, v[2].w * is); o.w = pack_i8x4(v[3].x * is, v[3].y * is, v[3].z * is, v[3].w * is);
    { const int lay = r / NEXP, e = r % NEXP; *(uint4*)(dst + (((size_t)(lay * 8 + (lane >> 3)) * NEXP + e) * 128) + (lane & 7) * 16) = o; }
    if (lane == 0) scl[r] = sc;
}
template <bool I8>
__device__ __forceinline__ void convert_table(const float* __restrict__ src, unsigned char* __restrict__ dst, float* __restrict__ scl, int rows) {
    static_assert(TAB_FP8, "fp8 tables");
    const int lane = tidx() & 63;
    const int nw = nwave();
    for (int r = gwave(); r < rows; r += 4 * nw) {
        float4 v[4][4]; int rr[4];
#pragma unroll
        for (int u = 0; u < 4; ++u) {
            rr[u] = (r + u * nw < rows) ? (r + u * nw) : r;
            const float4* s0 = (const float4*)(src + (size_t)rr[u] * D);
#pragma unroll
            for (int j = 0; j < 4; ++j) v[u][j] = s0[lane * 4 + j];
        }
#pragma unroll
        for (int u = 0; u < 4; ++u) {
            if (u == 0 || rr[u] != r) { if (I8) quant_row_i8(v[u], dst, scl, rr[u], lane); else quant_row(v[u], dst, scl, rr[u], lane); }
        }
    }
}
__device__ __forceinline__ void phase_prep(const Params& P, char* lds) {
    unsigned char* ws = P.ws;
    for (int l = 0; l < DEPTH; ++l) {
        transpose_tiled(P.w_in + (size_t)l * D * DIN, (bf16*)(ws + WS_WIN) + (size_t)l * DINP * LDW, D, DIN, DINP, LDW, nullptr, lds);
        transpose_tiled(P.w_uq + (size_t)l * QR * 768, (bf16*)(ws + WS_WUQ) + (size_t)l * 768 * QR, QR, 768, 768, QR, P.q_norm + l * QR, lds);
        transpose_tiled(P.w_uk + (size_t)l * KVR * 512, (bf16*)(ws + WS_WUKV) + (size_t)l * 1024 * KVR, KVR, 512, 512, KVR, P.kv_norm + l * KVR, lds);
        transpose_tiled(P.w_uv + (size_t)l * KVR * 512, (bf16*)(ws + WS_WUKV) + (size_t)l * 1024 * KVR + (size_t)512 * KVR, KVR, 512, 512, KVR, P.kv_norm + l * KVR, lds);
        transpose_tiled(P.w_out + (size_t)l * D * D, (bf16*)(ws + WS_WOUT) + (size_t)l * D * LDW, D, D, D, LDW, nullptr, lds);
    }
    {
        bf16* Wc = (bf16*)(ws + WS_WPQ);
        float (*As)[68] = (float (*)[68])lds;
        float (*Bs)[68] = (float (*)[68])(lds + 16 * 68 * 4);
        const int tid = tidx(), tx = tid & 15, ty = tid >> 4;
        const int lr = tid >> 2, ld4 = (tid & 3) * 4;
        for (int tile = blockIdx.x; tile < (DEPTH * 2048 / 64) * (D / 64); tile += gridDim.x) {
            const int row0 = (tile >> 4) * 64, k0 = (tile & 15) * 64;
            const int l = row0 >> 11, hp = (row0 >> 7) & 15, n0 = row0 & 127;
            const float* skp = P.peer_subkeys + (((size_t)l * 2 + (hp & 1)) * NKEY + n0 + lr) * 128 + ld4;
            const float* wqp = P.peer_wq + ((size_t)l * D + k0 + lr) * 2048 + hp * 128 + ld4;
            float acc[4][4];
#pragma unroll
            for (int i = 0; i < 4; ++i)
#pragma unroll
                for (int j = 0; j < 4; ++j) acc[i][j] = 0.f;
            for (int d0 = 0; d0 < 128; d0 += 16) {
                const float4 av = *(const float4*)(skp + d0), bv = *(const float4*)(wqp + d0);
                As[ld4 + 0][lr] = av.x; As[ld4 + 1][lr] = av.y; As[ld4 + 2][lr] = av.z; As[ld4 + 3][lr] = av.w;
                Bs[ld4 + 0][lr] = bv.x; Bs[ld4 + 1][lr] = bv.y; Bs[ld4 + 2][lr] = bv.z; Bs[ld4 + 3][lr] = bv.w;
                __syncthreads();
#pragma unroll
                for (int kk = 0; kk < 16; ++kk) {
                    const float4 a4 = *(const float4*)&As[kk][ty * 4], b4 = *(const float4*)&Bs[kk][tx * 4];
                    const float aa[4] = {a4.x, a4.y, a4.z, a4.w}, bb[4] = {b4.x, b4.y, b4.z, b4.w};
#pragma unroll
                    for (int i = 0; i < 4; ++i)
#pragma unroll
                        for (int j = 0; j < 4; ++j) acc[i][j] = fmaf(aa[i], bb[j], acc[i][j]);
                }
                __syncthreads();
            }
#pragma unroll
            for (int i = 0; i < 4; ++i) {
                uint2 o; o.x = pack2(acc[i][0], acc[i][1]); o.y = pack2(acc[i][2], acc[i][3]);
                *(uint2*)(Wc + (size_t)(row0 + ty * 4 + i) * LDW + k0 + tx * 4) = o;
            }
        }
    }
    convert_table<true>(P.peer_u, ws + WS_TABU, (float*)(ws + WS_TSCU), DEPTH * NEXP);
    convert_table<false>(P.peer_v, ws + WS_TABV, (float*)(ws + WS_TSCV), DEPTH * NEXP);
    float* rope = (float*)(ws + WS_ROPE);
    for (size_t i = gtid(); i < (size_t)S * 16; i += gnth()) {
        const int s = (int)(i >> 4), f = (int)(i & 15);
        const double inv = pow(10000.0, -(double)f / 16.0);
        const double ang = (double)s * inv;
        rope[2 * i] = (float)cos(ang); rope[2 * i + 1] = (float)sin(ang);
    }
}

__device__ __forceinline__ void phase_norm(const float* __restrict__ h, const float* __restrict__ g, bf16* __restrict__ xn) {
    const int lane = tidx() & 63, nw = nwave();
    for (int t = gwave(); t < T; t += 2 * nw) {
        const int t2 = (t + nw < T) ? (t + nw) : t;
        float4 v[2][4];
#pragma unroll
        for (int j = 0; j < 4; ++j) { v[0][j] = ((const float4*)(h + (size_t)t * D))[j * 64 + lane]; v[1][j] = ((const float4*)(h + (size_t)t2 * D))[j * 64 + lane]; }
#pragma unroll
        for (int u = 0; u < 2; ++u) {
            float ss = 0.f;
#pragma unroll
            for (int j = 0; j < 4; ++j) ss += v[u][j].x * v[u][j].x + v[u][j].y * v[u][j].y + v[u][j].z * v[u][j].z + v[u][j].w * v[u][j].w;
            ss = wave_sum(ss);
            const float r = rsqrtf(ss * (1.f / D) + EPS);
            const int tt = u ? t2 : t;
            if (u == 0 || t2 != t) {
#pragma unroll
                for (int j = 0; j < 4; ++j) {
                    const float4 gg = ((const float4*)g)[j * 64 + lane];
                    uint2 o; o.x = pack2(v[u][j].x * r * gg.x, v[u][j].y * r * gg.y); o.y = pack2(v[u][j].z * r * gg.z, v[u][j].w * r * gg.w);
                    ((uint2*)(xn + (size_t)tt * LDX))[j * 64 + lane] = o;
                }
            }
        }
    }
}

__device__ __forceinline__ void phase_norm_q(const Params& P, int l) {
    const int lane = tidx() & 63, nw = nwave();
    const float* g = P.norm_ffn + l * D;
    bf16* xn = (bf16*)(P.ws + WS_XN);
    unsigned* xq = (unsigned*)(P.ws + WS_XQ);
    float* xsc = (float*)(P.ws + WS_XS);
    for (int t = gwave(); t < T; t += 2 * nw) {
        const int t2 = (t + nw < T) ? (t + nw) : t;
        float4 v[2][4];
#pragma unroll
        for (int j = 0; j < 4; ++j) { v[0][j] = ((const float4*)(P.out + (size_t)t * D))[j * 64 + lane]; v[1][j] = ((const float4*)(P.out + (size_t)t2 * D))[j * 64 + lane]; }
#pragma unroll
        for (int u = 0; u < 2; ++u) {
            float ss = 0.f;
#pragma unroll
            for (int j = 0; j < 4; ++j) ss += v[u][j].x * v[u][j].x + v[u][j].y * v[u][j].y + v[u][j].z * v[u][j].z + v[u][j].w * v[u][j].w;
            ss = wave_sum(ss);
            const float r = rsqrtf(ss * (1.f / D) + EPS);
            const int tt = u ? t2 : t;
            if (u == 0 || t2 != t) {
                float am = 0.f;
#pragma unroll
                for (int j = 0; j < 4; ++j) {
                    const float4 gg = ((const float4*)g)[j * 64 + lane];
                    v[u][j].x *= r * gg.x; v[u][j].y *= r * gg.y; v[u][j].z *= r * gg.z; v[u][j].w *= r * gg.w;
                    am = fmaxf(am, fmaxf(fmaxf(fabsf(v[u][j].x), fabsf(v[u][j].y)), fmaxf(fabsf(v[u][j].z), fabsf(v[u][j].w))));
                    uint2 o; o.x = pack2(v[u][j].x, v[u][j].y); o.y = pack2(v[u][j].z, v[u][j].w);
                    ((uint2*)(xn + (size_t)tt * LDX))[j * 64 + lane] = o;
                }
#pragma unroll
                for (int m = 32; m >= 1; m >>= 1) am = fmaxf(am, __shfl_xor(am, m, 64));
                const float sc = (am > 0.f) ? am * (1.f / 127.f) : 1.f, is = 1.f / sc;
#pragma unroll
                for (int j = 0; j < 4; ++j) xq[(size_t)tt * (D / 4) + j * 64 + lane] = pack_i8x4(v[u][j].x * is, v[u][j].y * is, v[u][j].z * is, v[u][j].w * is);
                if (lane == 0) xsc[tt] = sc;
            }
        }
    }
}

__device__ __forceinline__ void phase_mixlocal(const Params& P, int l, char* lds) {
    const bf16* proj = (const bf16*)(P.ws + WS_PROJ);
    bf16* Y = (bf16*)(P.ws + WS_XN);
    const int tid = tidx();
    {
        const float* cw = P.conv_w + (size_t)l * 3 * 256;
        for (size_t i = gtid(); i < (size_t)T * 32; i += gnth()) {
            const int t = (int)(i >> 5), c0 = (int)(i & 31) * 8, s = t & (S - 1);
            const bf16* pr = proj + (size_t)t * DINP;
            float acc[8];
#pragma unroll
            for (int e = 0; e < 8; ++e) acc[e] = 0.f;
#pragma unroll
            for (int j = 0; j < 3; ++j) {
                if (s - 2 + j >= 0) {
                    const bf16* pp = pr - (size_t)(2 - j) * DINP;
                    const uint4 g = *(const uint4*)(pp + C_CG + c0), hc = *(const uint4*)(pp + C_HC + c0);
                    const float4 w0 = *(const float4*)(cw + j * 256 + c0), w1 = *(const float4*)(cw + j * 256 + c0 + 4);
                    acc[0] = fmaf(w0.x, bflo(g.x) * bflo(hc.x), acc[0]); acc[1] = fmaf(w0.y, bfhi(g.x) * bfhi(hc.x), acc[1]);
                    acc[2] = fmaf(w0.z, bflo(g.y) * bflo(hc.y), acc[2]); acc[3] = fmaf(w0.w, bfhi(g.y) * bfhi(hc.y), acc[3]);
                    acc[4] = fmaf(w1.x, bflo(g.z) * bflo(hc.z), acc[4]); acc[5] = fmaf(w1.y, bfhi(g.z) * bfhi(hc.z), acc[5]);
                    acc[6] = fmaf(w1.z, bflo(g.w) * bflo(hc.w), acc[6]); acc[7] = fmaf(w1.w, bfhi(g.w) * bfhi(hc.w), acc[7]);
                }
            }
            const uint4 bg = *(const uint4*)(pr + C_BG + c0);
            uint4 o;
            o.x = pack2(bflo(bg.x) * acc[0], bfhi(bg.x) * acc[1]); o.y = pack2(bflo(bg.y) * acc[2], bfhi(bg.y) * acc[3]);
            o.z = pack2(bflo(bg.z) * acc[4], bfhi(bg.z) * acc[5]); o.w = pack2(bflo(bg.w) * acc[6], bfhi(bg.w) * acc[7]);
            *(uint4*)(Y + (size_t)t * LDX + c0) = o;
        }
    }
    {
        float (*pl)[68] = (float (*)[68])lds;
        const float* pw = P.pool_w + (size_t)l * 4 * 64 * 64;
        const float* psc = P.pool_scale + l * 256;
        const int a = tid & 63, q = tid >> 6;
        for (int tile = blockIdx.x; tile < (T / 64) * 4; tile += gridDim.x) {
            const int g = tile & 3, t0 = (tile >> 2) * 64;
            const int w = 2 << g;
            {
                const bf16* col = proj + C_HP + g * 64 + a;
                const int tf = t0 + q * 16, sf = tf & (S - 1);
                float xr[31];
#pragma unroll
                for (int d = 1; d <= 15; ++d) xr[15 - d] = (d < w && sf - d >= 0) ? bf2f(col[(size_t)(tf - d) * DINP]) : 0.f;
#pragma unroll
                for (int i = 0; i < 16; ++i) xr[15 + i] = bf2f(col[(size_t)(tf + i) * DINP]);
                float sum = 0.f;
#pragma unroll
                for (int d = 1; d <= 15; ++d) sum += xr[15 - d];
#pragma unroll
                for (int i = 0; i < 16; ++i) {
                    const int s = sf + i;
                    sum += xr[15 + i];
                    const int cnt = (s + 1 < w) ? (s + 1) : w;
                    pl[q * 16 + i][a] = sum / (float)cnt - xr[15 + i];
                    const int o = 15 + i + 1;
                    const float old = (g == 0) ? xr[o - 2] : (g == 1) ? xr[o - 4] : (g == 2) ? xr[o - 8] : xr[o - 16];
                    sum -= old;
                }
            }
            __syncthreads();
            {
                float pc[64];
#pragma unroll
                for (int c = 0; c < 64; ++c) pc[c] = pw[(g * 64 + c) * 64 + a];
                const float sc = psc[g * 64 + a];
#pragma unroll 2
                for (int i = 0; i < 16; ++i) {
                    const float4* row = (const float4*)&pl[q * 16 + i][0];
                    float m0 = 0.f, m1 = 0.f;
#pragma unroll
                    for (int c4 = 0; c4 < 16; ++c4) { const float4 v = row[c4]; m0 = fmaf(v.x, pc[4 * c4], m0); m1 = fmaf(v.y, pc[4 * c4 + 1], m1); m0 = fmaf(v.z, pc[4 * c4 + 2], m0); m1 = fmaf(v.w, pc[4 * c4 + 3], m1); }
                    Y[(size_t)(t0 + q * 16 + i) * LDX + 256 + g * 64 + a] = f2bf((m0 + m1) * sc);
                }
            }
            __syncthreads();
        }
    }
}

typedef short v4i16_t __attribute__((ext_vector_type(4)));
typedef __attribute__((address_space(3))) v4i16_t* lds_v4p;
__device__ __forceinline__ v4i16_t vtr(const char* p) { return __builtin_amdgcn_ds_read_tr16_b64_v4i16((lds_v4p)p); }
constexpr int A_KP = 208, A_VP = 192;
constexpr int A_KB = 64 * A_KP, A_VB = 64 * A_VP, A_BUF = A_KB + A_VB, ATTN_LDS = 2 * A_BUF;
static_assert(ATTN_LDS <= GEMM_LDS, "attention LDS");

__device__ __forceinline__ void attn_unit(const bf16* __restrict__ Qb, const bf16* __restrict__ Kb, const bf16* __restrict__ Vb, bf16* __restrict__ Y, int bh, int qblk, char* lds) {
    const int tid = tidx(), lane = tid & 63, w = tid >> 6, r32 = lane & 31, hi = lane >> 5;
    const int q0 = qblk * 128, qw0 = q0 + w * 32;
    const int NT = 2 * qblk + 2;
    bf16x8 qf[6];
    {
        const bf16* qp = Qb + ((size_t)bh * S + qw0 + r32) * DQK + hi * 8;
#pragma unroll
        for (int ks = 0; ks < 6; ++ks) qf[ks] = *(const bf16x8*)(qp + ks * 16);
    }
    f32x16 o0, o1;
#pragma unroll
    for (int r = 0; r < 16; ++r) { o0[r] = 0.f; o1[r] = 0.f; }
    float m = -1e30f, lsum = 0.f;
    const char* Kg = (const char*)(Kb + (size_t)bh * S * DQK) + tid * 16;
    const char* Vg = (const char*)(Vb + (size_t)bh * S * DV) + tid * 16;
    const int kl0 = (tid / 12) * A_KP + (tid % 12) * 16, kl1 = ((tid + 256) / 12) * A_KP + ((tid + 256) % 12) * 16, kl2 = ((tid + 512) / 12) * A_KP + ((tid + 512) % 12) * 16;
    const int vl0 = (tid >> 3) * A_VP + (tid & 7) * 16, vl1 = vl0 + 32 * A_VP;
    uint4 pk0, pk1, pk2, pv0, pv1, qk0, qk1, qk2, qv0, qv1;
#define A_LOAD(S, t) do { const char* kg = Kg + (size_t)(t) * (64 * 192); const char* vg = Vg + (size_t)(t) * (64 * 128); \
        S##k0 = *(const uint4*)(kg); S##k1 = *(const uint4*)(kg + 4096); S##k2 = *(const uint4*)(kg + 8192); S##v0 = *(const uint4*)(vg); S##v1 = *(const uint4*)(vg + 4096); } while (0)
#define A_STORE(S, bK, bV) do { *(uint4*)(bK + kl0) = S##k0; *(uint4*)(bK + kl1) = S##k1; *(uint4*)(bK + kl2) = S##k2; *(uint4*)(bV + vl0) = S##v0; *(uint4*)(bV + vl1) = S##v1; } while (0)
#define A_PV(pf, kofs) do { \
            { const v4i16_t lo = vtr(pv + (kofs) * A_VP), hh = vtr(pv + ((kofs) + 8) * A_VP); const bf16x8 vf = {lo[0], lo[1], lo[2], lo[3], hh[0], hh[1], hh[2], hh[3]}; o0 = MFMA32(vf, pf.v, o0); } \
            { const v4i16_t lo = vtr(pv + (kofs) * A_VP + 64), hh = vtr(pv + ((kofs) + 8) * A_VP + 64); const bf16x8 vf = {lo[0], lo[1], lo[2], lo[3], hh[0], hh[1], hh[2], hh[3]}; o1 = MFMA32(vf, pf.v, o1); } } while (0)
    const int pvo = (4 * hi + ((lane & 15) >> 2)) * A_VP + (16 * ((lane >> 4) & 1) + 4 * (lane & 3)) * 2;
    A_LOAD(p, 0); A_LOAD(q, 1);
    for (int t2 = 0; t2 < NT; t2 += 2) {
#pragma unroll
        for (int half = 0; half < 2; ++half) {
            const int t = t2 + half;
            char* bK = lds + half * A_BUF; char* bV = bK + A_KB;
            if (half == 0) A_STORE(p, bK, bV); else A_STORE(q, bK, bV);
            __syncthreads();
            { const int tn = (t + 2 < NT) ? (t + 2) : (NT - 2 + half); if (half == 0) A_LOAD(p, tn); else A_LOAD(q, tn); }
        const int kt0 = t * 64;
        if (kt0 <= qw0) {
            f32x16 s0, s1;
#pragma unroll
            for (int r = 0; r < 16; ++r) { s0[r] = 0.f; s1[r] = 0.f; }
            const char* pk = bK + r32 * A_KP + hi * 16;
#pragma unroll
            for (int ks = 0; ks < 6; ++ks) {
                const bf16x8 a0 = *(const bf16x8*)(pk + ks * 32), a1 = *(const bf16x8*)(pk + 32 * A_KP + ks * 32);
                s0 = MFMA32(a0, qf[ks], s0); s1 = MFMA32(a1, qf[ks], s1);
            }
            if (kt0 + 63 > qw0) {
                const int qrow = qw0 + r32;
#pragma unroll
                for (int r = 0; r < 16; ++r) { const int key = kt0 + crow(r, hi); if (key > qrow) s0[r] = -INFINITY; if (key + 32 > qrow) s1[r] = -INFINITY; }
            }
            float mx = fmaxf(s0[0], s1[0]);
#pragma unroll
            for (int r = 1; r < 16; ++r) mx = fmaxf(mx, fmaxf(s0[r], s1[r]));
            mx = fmaxf(mx, __shfl_xor(mx, 32, 64));
            const float mn = fmaxf(m, mx), m_prev = m;
            const float alpha = __builtin_amdgcn_exp2f(m - mn);
            m = mn;
            float ps = 0.f;
#pragma unroll
            for (int r = 0; r < 16; ++r) { s0[r] = __builtin_amdgcn_exp2f(s0[r] - mn); s1[r] = __builtin_amdgcn_exp2f(s1[r] - mn); ps += s0[r] + s1[r]; }
            if (__builtin_amdgcn_ballot_w64(mn > m_prev) != 0ull) {
                lsum *= alpha;
#pragma unroll
                for (int r = 0; r < 16; ++r) { o0[r] *= alpha; o1[r] *= alpha; }
            }
            lsum += ps;
            union { unsigned u[4]; bf16x8 v; } p00, p01, p10, p11;
#pragma unroll
            for (int j = 0; j < 4; ++j) { p00.u[j] = cvtpk(s0[2 * j], s0[2 * j + 1]); p01.u[j] = cvtpk(s0[8 + 2 * j], s0[9 + 2 * j]); p10.u[j] = cvtpk(s1[2 * j], s1[2 * j + 1]); p11.u[j] = cvtpk(s1[8 + 2 * j], s1[9 + 2 * j]); }
            const char* pv = bV + pvo;
            A_PV(p00, 0); A_PV(p01, 16); A_PV(p10, 32); A_PV(p11, 48);
        }
        }
    }
    lsum += __shfl_xor(lsum, 32, 64);
    const float inv = 1.f / lsum;
    const int b = bh >> 3, h = bh & 7;
    bf16* yo = Y + (size_t)(b * S + qw0 + r32) * LDX + 512 + h * 64 + 4 * hi;
#pragma unroll
    for (int g = 0; g < 4; ++g) {
        uint2 a, c;
        a.x = cvtpk(o0[4 * g] * inv, o0[4 * g + 1] * inv); a.y = cvtpk(o0[4 * g + 2] * inv, o0[4 * g + 3] * inv);
        c.x = cvtpk(o1[4 * g] * inv, o1[4 * g + 1] * inv); c.y = cvtpk(o1[4 * g + 2] * inv, o1[4 * g + 3] * inv);
        *(uint2*)(yo + 8 * g) = a; *(uint2*)(yo + 32 + 8 * g) = c;
    }
    __syncthreads();
}
__device__ __forceinline__ void phase_attn(const Params& P, char* lds) {
    const bf16* Qb = (const bf16*)(P.ws + WS_Q);
    const bf16* Kb = (const bf16*)(P.ws + WS_K);
    const bf16* Vb = (const bf16*)(P.ws + WS_V);
    bf16* Y = (bf16*)(P.ws + WS_XN);
    for (int u = blockIdx.x; u < NB * NH * (S / 128); u += gridDim.x) {
        const int bh = u & 31, v = u >> 5;
        const int qblk = (v < 16) ? (63 - v) : (v < 32) ? (v - 16) : (v < 48) ? (79 - v) : (v - 32);
        attn_unit(Qb, Kb, Vb, Y, bh, qblk, lds);
    }
}

#define NET_HD __device__ __forceinline__
#define NET_U2F(u) __uint_as_float(u)
#define NET_F2U(f) __float_as_uint(f)
#define CE_DESC(a, b) do { const float hi__ = fmaxf(a, b), lo__ = fminf(a, b); a = hi__; b = lo__; } while (0)
NET_HD void sort16_desc(float (&v)[16]) {
#define CE2(a, b) CE_DESC(v[a], v[b])
    CE2(0,13); CE2(1,12); CE2(2,15); CE2(3,14); CE2(4,8); CE2(5,6); CE2(7,11); CE2(9,10);
    CE2(0,5); CE2(1,7); CE2(2,9); CE2(3,4); CE2(6,13); CE2(8,14); CE2(10,15); CE2(11,12);
    CE2(0,1); CE2(2,3); CE2(4,5); CE2(6,8); CE2(7,9); CE2(10,11); CE2(12,13); CE2(14,15);
    CE2(0,2); CE2(1,3); CE2(4,10); CE2(5,11); CE2(6,7); CE2(8,9); CE2(12,14); CE2(13,15);
    CE2(1,2); CE2(3,12); CE2(4,6); CE2(5,7); CE2(8,10); CE2(9,11); CE2(13,14);
    CE2(1,4); CE2(2,6); CE2(5,8); CE2(7,10); CE2(9,13); CE2(11,14);
    CE2(2,4); CE2(3,6); CE2(9,12); CE2(11,13);
    CE2(3,5); CE2(6,8); CE2(7,9); CE2(10,12);
    CE2(3,4); CE2(5,6); CE2(7,8); CE2(9,10); CE2(11,12);
    CE2(6,7); CE2(8,9);
#undef CE2
}
NET_HD void merge16_desc(float (&a)[16], const float (&b)[16]) {
#pragma unroll
    for (int i = 0; i < 16; ++i) a[i] = fmaxf(a[i], b[15 - i]);
#pragma unroll
    for (int j = 8; j > 0; j >>= 1) {
#pragma unroll
        for (int i = 0; i < 16; ++i) { const int l = i ^ j; if (l > i) CE_DESC(a[i], a[l]); }
    }
}
NET_HD void top16_of_64(float (&g0)[16], float (&g1)[16], float (&g2)[16], float (&g3)[16]) {
    sort16_desc(g0); sort16_desc(g1); sort16_desc(g2); sort16_desc(g3);
    merge16_desc(g0, g1); merge16_desc(g2, g3); merge16_desc(g0, g2);
}
NET_HD float u2f(unsigned u) { return NET_U2F(u); }
NET_HD unsigned f2u(float f) { return NET_F2U(f); }
template <class V16>
NET_HD void lane_top16(const V16& s0, const V16& s1, const V16& s2, const V16& s3, int hi, float (&out)[16]) {
    float g0[16], g1[16], g2[16], g3[16];
#pragma unroll
    for (int r = 0; r < 16; ++r) {
        const unsigned nb = (unsigned)((r & 3) + 8 * (r >> 2));
        g0[r] = u2f((f2u(s0[r]) & 0xFFFFFF80u) | nb); g1[r] = u2f((f2u(s1[r]) & 0xFFFFFF80u) | (nb + 32u));
        g2[r] = u2f((f2u(s2[r]) & 0xFFFFFF80u) | (nb + 64u)); g3[r] = u2f((f2u(s3[r]) & 0xFFFFFF80u) | (nb + 96u));
    }
    top16_of_64(g0, g1, g2, g3);
    const unsigned h4 = (unsigned)hi << 2;
#pragma unroll
    for (int i = 0; i < 16; ++i) out[i] = u2f(f2u(g0[i]) | h4);
}
constexpr int cand_slot(int a, int b) { int n = 0; for (int x = 0; x < 16; ++x) for (int y = 0; y < 16; ++y) { if (x == a && y == b) return n; if ((x + 1) * (y + 1) <= 16) ++n; } return n; }
NET_HD void cand_top16(const float (&s1)[16], const float (&s2)[16], float (&c)[16]) {
    float g0[16], g1[16], g2[16], g3[16];
#pragma unroll
    for (int i = 0; i < 16; ++i) { g0[i] = -3.0e38f; g1[i] = -3.0e38f; g2[i] = -3.0e38f; g3[i] = -3.0e38f; }
#pragma unroll
    for (int a = 0; a < 16; ++a) {
#pragma unroll
        for (int b = 0; b < 16; ++b) {
            if ((a + 1) * (b + 1) <= 16) {
                const int sl = cand_slot(a, b);
                const float v = u2f((f2u(s1[a] + s2[b]) & 0xFFFFFF00u) | (unsigned)(a * 16 + b));
                if (sl < 16) g0[sl & 15] = v; else if (sl < 32) g1[sl & 15] = v; else if (sl < 48) g2[sl & 15] = v; else g3[sl & 15] = v;
            }
        }
    }
    top16_of_64(g0, g1, g2, g3);
#pragma unroll
    for (int i = 0; i < 16; ++i) c[i] = g0[i];
}

__device__ __forceinline__ void phase_route(const Params& P, int l, char* lds) {
    const bf16* XN = (const bf16*)(P.ws + WS_XN);
    const bf16* Wc = (const bf16*)(P.ws + WS_WPQ) + (size_t)l * 2048 * LDW;
    int* EXPp = (int*)(P.ws + WS_EXP);
    float* GATEp = (float*)(P.ws + WS_GATE);
    const int tid = tidx(), lane = tid & 63, w = tid >> 6, r32 = lane & 31, hi = lane >> 5;
    int tlo, thi; tile_range((T / 128) * PH, tlo, thi);
    for (int u = tlo; u < thi; ++u) {
        const int tm = u >> 3, h = u & 7;
        float L0[16], L1[16];
        {
            f32x16 acc[4]; float ssd[4];
            gemm_kloop<1, false>(Wc + (size_t)((h * 2 + 0) * 128) * LDW, LDW, XN + (size_t)(tm * 128) * LDX, LDX, D / 64, acc, ssd, lds, tid);
            lane_top16(acc[0], acc[1], acc[2], acc[3], hi, L0);
            float o[16];
#pragma unroll
            for (int i = 0; i < 16; ++i) o[i] = __shfl_xor(L0[i], 32, 64);
            merge16_desc(L0, o);
        }
        {
            f32x16 acc[4]; float ssd[4];
            gemm_kloop<1, false>(Wc + (size_t)((h * 2 + 1) * 128) * LDW, LDW, XN + (size_t)(tm * 128) * LDX, LDX, D / 64, acc, ssd, lds, tid);
            lane_top16(acc[0], acc[1], acc[2], acc[3], hi, L1);
            float o[16];
#pragma unroll
            for (int i = 0; i < 16; ++i) o[i] = __shfl_xor(L1[i], 32, 64);
            merge16_desc(L1, o);
        }
        float c[16];
        cand_top16(L0, L1, c);
        __syncthreads();
        unsigned char* my = (unsigned char*)lds + tid * 32;
        {
            uint4 a, b;
#define PK4(L, i) ((__float_as_uint(L[i]) & 127u) | ((__float_as_uint(L[i + 1]) & 127u) << 8) | ((__float_as_uint(L[i + 2]) & 127u) << 16) | ((__float_as_uint(L[i + 3]) & 127u) << 24))
            a.x = PK4(L0, 0); a.y = PK4(L0, 4); a.z = PK4(L0, 8); a.w = PK4(L0, 12);
            b.x = PK4(L1, 0); b.y = PK4(L1, 4); b.z = PK4(L1, 8); b.w = PK4(L1, 12);
#undef PK4
            *(uint4*)my = a; *(uint4*)(my + 16) = b;
        }
        int ev[16]; float gv[16]; float den = 0.f;
#pragma unroll
        for (int k = 0; k < 16; ++k) {
            const unsigned ci = __float_as_uint(c[k]) & 255u;
            const int n1 = my[ci >> 4], n2 = my[16 + (ci & 15)];
            ev[k] = n1 * NKEY + n2;
            gv[k] = __expf(c[k] - c[0]); den += gv[k];
        }
        const float iden = 1.f / den;
        if (hi == 0) {
            const int t = tm * 128 + w * 32 + r32;
            uint4* ep = (uint4*)(EXPp + (size_t)t * HK + h * 16);
            float4* gp = (float4*)(GATEp + (size_t)t * HK + h * 16);
#pragma unroll
            for (int q = 0; q < 4; ++q) {
                ep[q] = make_uint4((unsigned)ev[4 * q], (unsigned)ev[4 * q + 1], (unsigned)ev[4 * q + 2], (unsigned)ev[4 * q + 3]);
                gp[q] = make_float4(gv[4 * q] * iden, gv[4 * q + 1] * iden, gv[4 * q + 2] * iden, gv[4 * q + 3] * iden);
            }
        }
        __syncthreads();
    }
}

constexpr size_t WS_PART = WS_PROJ;
static_assert((size_t)8 * T * HK * 4 <= WS_K - WS_PROJ, "PART alias");
constexpr int XI_X = 0, XI_RANK = 1, XI_J = 2, XI_NX = 3, XI_NLOC = 4;
constexpr int CTL_CENSUS = 4096;
constexpr int CTL_BYTES = (CTL_CENSUS + 16) * 4;

template <int M1, int M2, int M3, class TT>
__device__ __forceinline__ void red16x3(TT (&p)[16], int lane) {
#pragma unroll
    for (int i = 0; i < 8; ++i) { const bool up = lane & M1; const TT send = up ? p[i] : p[i + 8], keep = up ? p[i + 8] : p[i]; p[i] = keep + __shfl_xor(send, M1, 64); }
#pragma unroll
    for (int i = 0; i < 4; ++i) { const bool up = lane & M2; const TT send = up ? p[i] : p[i + 4], keep = up ? p[i + 4] : p[i]; p[i] = keep + __shfl_xor(send, M2, 64); }
#pragma unroll
    for (int i = 0; i < 2; ++i) { const bool up = lane & M3; const TT send = up ? p[i] : p[i + 2], keep = up ? p[i + 2] : p[i]; p[i] = keep + __shfl_xor(send, M3, 64); }
}
__device__ __forceinline__ void phase_gu(const Params& P, int l, const volatile int* xi) {
    const unsigned char* XQ = P.ws + WS_XQ;
    const float* XSc = (const float*)(P.ws + WS_XS);
    const int* EXPp = (const int*)(P.ws + WS_EXP);
    float* PART = (float*)(P.ws + WS_PART);
    const int tid = tidx(), lane = tid & 63, w = tid >> 6, g = lane >> 3, c = lane & 7;
    int xo_ = 0; asm volatile("" : "+v"(xo_));
    const int j = __builtin_amdgcn_readfirstlane(xi[xo_ + XI_J]), nx = __builtin_amdgcn_readfirstlane(xi[xo_ + XI_NX]), nloc = __builtin_amdgcn_readfirstlane(xi[xo_ + XI_NLOC]), rank = __builtin_amdgcn_readfirstlane(xi[xo_ + XI_RANK]);
    const int t0 = rank * 4 + w, st = nloc * 4;
    const int n = (t0 < T) ? (T - t0 + st - 1) / st : 0;
    const int i0 = 8 * (c & 1) + 4 * ((c >> 1) & 1) + 2 * ((c >> 2) & 1);
    for (int sl = j; sl < 8 && n > 0; sl += nx) {
        const unsigned char* Us = P.ws + WS_TABU + ((size_t)(l * 8 + sl) * NEXP) * 128;
        const unsigned co = (unsigned)c << 4;
        float* part = PART + (size_t)sl * T * HK;
        const unsigned char* xs = XQ + sl * 128 + c * 16;
#define GU_TK(k) (t0 + (((k) < n) ? (k) : (n - 1)) * st)
#define GU_LOADE(S, t) do { S##lo = EXPp[(size_t)(t) * HK + lane]; S##hi = EXPp[(size_t)(t) * HK + 64 + lane]; } while (0)
#define GU_LOADX(S, t) do { S##a = *(const uint4*)(xs + (size_t)(t) * D); S##s = XSc[t]; } while (0)
#define GU_ISSUE(R, S) do { _Pragma("unroll") for (int i = 0; i < 16; ++i) { \
            const int e = __builtin_amdgcn_ds_bpermute((((8 * i) & 63) + g) << 2, (i < 8) ? S##lo : S##hi); R[i] = *(const uint4*)(Us + (((unsigned)e << 7) | co)); } } while (0)
#define GU_FINISH(R, S, t) do { \
            int p[16]; \
            _Pragma("unroll") for (int i = 0; i < 16; ++i) { int d_ = __builtin_amdgcn_sdot4((int)S##a.x, (int)R[i].x, 0, false); d_ = __builtin_amdgcn_sdot4((int)S##a.y, (int)R[i].y, d_, false); \
                d_ = __builtin_amdgcn_sdot4((int)S##a.z, (int)R[i].z, d_, false); p[i] = __builtin_amdgcn_sdot4((int)S##a.w, (int)R[i].w, d_, false); } \
            red16x3<1, 2, 4, int>(p, lane); \
            part[(size_t)(t) * HK + 8 * i0 + g] = (float)p[0] * S##s; part[(size_t)(t) * HK + 8 * (i0 + 1) + g] = (float)p[1] * S##s; } while (0)
        int eAlo, eAhi, eBlo, eBhi; uint4 xAa, xBa; float xAs, xBs; uint4 rA[16], rB[16];
        GU_LOADE(eA, GU_TK(0)); GU_LOADX(xA, GU_TK(0)); GU_LOADE(eB, GU_TK(1));
        GU_ISSUE(rA, eA);
        for (int k = 0; k < n; k += 2) {
            GU_LOADX(xB, GU_TK(k + 1)); GU_ISSUE(rB, eB); GU_LOADE(eA, GU_TK(k + 2));
            GU_FINISH(rA, xA, GU_TK(k));
            GU_LOADX(xA, GU_TK(k + 2)); GU_ISSUE(rA, eA); GU_LOADE(eB, GU_TK(k + 3));
            GU_FINISH(rB, xB, GU_TK(k + 1));
        }
#undef GU_TK
#undef GU_LOADE
#undef GU_LOADX
#undef GU_ISSUE
#undef GU_FINISH
    }
}
__device__ __forceinline__ void phase_gw(const Params& P, int l) {
    const int* EXPp = (const int*)(P.ws + WS_EXP);
    const float* GATEp = (const float*)(P.ws + WS_GATE);
    const float* PART = (const float*)(P.ws + WS_PART);
    const float* SU = (const float*)(P.ws + WS_TSCU) + (size_t)l * NEXP;
    const float* SV = (const float*)(P.ws + WS_TSCV) + (size_t)l * NEXP;
    unsigned char* WQ = P.ws + WS_WQ8;
    float* WSC = (float*)(P.ws + WS_WSC);
    const int lane = tidx() & 63;
    for (int tb = gwave() * 4; tb < T; tb += nwave() * 4) {
        float wv[4][2];
#pragma unroll
        for (int q = 0; q < 4; ++q)
#pragma unroll
            for (int hk = 0; hk < 2; ++hk) {
                const size_t i = (size_t)(tb + q) * HK + hk * 64 + lane;
                float s = 0.f;
#pragma unroll
                for (int x = 0; x < 8; ++x) s += PART[(size_t)x * T * HK + i];
                const int e = EXPp[i];
                wv[q][hk] = GATEp[i] * gelu_exact(s * SU[e]) * SV[e];
            }
#pragma unroll
        for (int q = 0; q < 4; ++q) {
            float am = fmaxf(fabsf(wv[q][0]), fabsf(wv[q][1]));
#pragma unroll
            for (int m = 32; m >= 1; m >>= 1) am = fmaxf(am, __shfl_xor(am, m, 64));
            const float sc = (am > 0.f) ? am * (1.f / 448.f) : 1.f, is = 1.f / sc;
            const int pk = __builtin_amdgcn_cvt_pk_fp8_f32(wv[q][0] * is, wv[q][1] * is, 0, false);
            WQ[(size_t)(tb + q) * HK + lane] = (unsigned char)(pk & 255);
            WQ[(size_t)(tb + q) * HK + 64 + lane] = (unsigned char)((pk >> 8) & 255);
            if (lane == 0) WSC[tb + q] = sc;
        }
    }
}
typedef int v2i_t __attribute__((ext_vector_type(2)));
typedef unsigned u32x4_t __attribute__((ext_vector_type(4)));
typedef __attribute__((ext_vector_type(4))) float f32x4;
constexpr int GV_PIECE = 1024 + 16;
constexpr int GV_TILE = 16 * GV_PIECE;
static_assert(4 * GV_TILE + 4 * 512 <= LDS_TOTAL, "gv LDS");
__device__ __forceinline__ void phase_gv(const Params& P, int l, const volatile int* xi, char* lds) {
    const int* EXPp = (const int*)(P.ws + WS_EXP);
    const unsigned char* WQ = P.ws + WS_WQ8;
    const float* WSC = (const float*)(P.ws + WS_WSC);
    const int tid = tidx(), lane = tid & 63, w = __builtin_amdgcn_readfirstlane(tid >> 6), g = lane >> 3, pos = lane & 7;
    int xo_ = 0; asm volatile("" : "+v"(xo_));
    const int j = __builtin_amdgcn_readfirstlane(xi[xo_ + XI_J]), nx = __builtin_amdgcn_readfirstlane(xi[xo_ + XI_NX]), nloc = __builtin_amdgcn_readfirstlane(xi[xo_ + XI_NLOC]), rank = __builtin_amdgcn_readfirstlane(xi[xo_ + XI_RANK]);
    const int t0 = rank * 4 + w, st = nloc * 4;
    const int n = (t0 < T) ? (T - t0 + st - 1) / st : 0;
    char* tile = lds + w * GV_TILE;
    float* strip = (float*)(lds + 4 * GV_TILE) + w * 128;
    typedef __attribute__((address_space(3))) v2i_t* ldsv2_t;
    const unsigned co = (unsigned)(pos ^ g) << 4;
    const int rr = (lane & 15) >> 1, kq = lane >> 4;
    const int rdo = kq * GV_PIECE + rr * 128 + (lane & 1) * 8;
    const bool row0 = (lane & 15) == 0;
    __syncthreads();
    for (int sl = j; sl < 8 && n > 0; sl += nx) {
        const unsigned char* Vs = P.ws + WS_TABV + ((size_t)(l * 8 + sl) * NEXP) * 128;
        float* hrow = P.out + sl * 128 + 2 * lane;
#define GV_TK(k) (t0 + (((k) < n) ? (k) : (n - 1)) * st)
#define GV_LOADE(S, t) do { S##el = EXPp[(size_t)(t) * HK + lane]; S##eh = EXPp[(size_t)(t) * HK + 64 + lane]; } while (0)
#define GV_ISSUE(R, S) do { _Pragma("unroll") for (int i = 0; i < 16; ++i) { \
            const int e = __builtin_amdgcn_ds_bpermute((((8 * i) & 63) + g) << 2, (i < 8) ? S##el : S##eh); R[i] = *(const u32x4_t*)(Vs + (((unsigned)e << 7) | co)); } } while (0)
#define GV_LOADT(S, kk) do { const int t_ = GV_TK(kk); \
            S##a0 = 0; S##a1 = 0; S##a2 = 0; S##a3 = 0; \
            if (row0) { const long* wp = (const long*)(WQ + (size_t)t_ * HK + kq * 8); S##a0 = wp[0]; S##a1 = wp[4]; S##a2 = wp[8]; S##a3 = wp[12]; } \
            S##ws = ((kk) < n) ? WSC[t_] : 0.f; \
            S##hv = *(const float2*)(hrow + (size_t)t_ * D); } while (0)
#define GV_TOKEN(R, S, kk) do { \
            const int t = GV_TK(kk); \
            _Pragma("unroll") for (int i = 0; i < 16; ++i) *(u32x4_t*)(tile + i * GV_PIECE + lane * 16) = R[i]; \
            f32x4 acc[8]; \
            _Pragma("unroll") for (int nt = 0; nt < 8; ++nt) acc[nt] = (f32x4){0.f, 0.f, 0.f, 0.f}; \
            _Pragma("unroll") for (int s4 = 0; s4 < 4; ++s4) { \
                const long av = (s4 == 0) ? S##a0 : (s4 == 1) ? S##a1 : (s4 == 2) ? S##a2 : S##a3; \
                _Pragma("unroll") for (int nt = 0; nt < 8; ++nt) { \
                    const v2i_t bv = __builtin_amdgcn_ds_read_tr8_b64_v2i32((ldsv2_t)(void*)(tile + (4 * s4) * GV_PIECE + rdo + ((nt ^ rr) << 4))); \
                    acc[nt] = __builtin_amdgcn_mfma_f32_16x16x32_fp8_fp8(av, __builtin_bit_cast(long, bv), acc[nt], 0, 0, 0); } } \
            if (lane < 16) { _Pragma("unroll") for (int nt = 0; nt < 8; ++nt) strip[16 * nt + lane] = acc[nt][0]; }        \
            { const float2 o2 = *(const float2*)(strip + 2 * lane); \
              if ((kk) < n) *(float2*)(hrow + (size_t)t * D) = make_float2(S##hv.x + S##ws * o2.x, S##hv.y + S##ws * o2.y); } } while (0)
        int Ael, Aeh, Bel, Beh; u32x4_t rA[16], rB[16];
        long Pa0, Pa1, Pa2, Pa3, Qa0, Qa1, Qa2, Qa3; float Pws, Qws; float2 Phv, Qhv;
        GV_LOADE(A, GV_TK(0)); GV_LOADE(B, GV_TK(1));
        GV_ISSUE(rA, A); GV_LOADT(P, 0);
        for (int k = 0; k < n; k += 2) {
            GV_ISSUE(rB, B); GV_LOADE(A, GV_TK(k + 2)); GV_LOADT(Q, k + 1);
            GV_TOKEN(rA, P, k);
            GV_ISSUE(rA, A); GV_LOADE(B, GV_TK(k + 3)); GV_LOADT(P, k + 2);
            GV_TOKEN(rB, Q, k + 1);
        }
#undef GV_TK
#undef GV_LOADE
#undef GV_ISSUE
#undef GV_LOADT
#undef GV_TOKEN
    }
    __syncthreads();
}
__device__ __forceinline__ void phase_gnorm(const Params& P, int l) {
    const int lane = tidx() & 63, nw = nwave();
    bf16* XNw = (bf16*)(P.ws + WS_XN);
    const float4* g = (const float4*)((l == DEPTH - 1) ? P.norm_final : (P.norm_mix + (l + 1) * D));
    for (int t = gwave(); t < T; t += 2 * nw) {
        const int t2 = (t + nw < T) ? (t + nw) : t;
        float4 v[2][4];
#pragma unroll
        for (int q = 0; q < 4; ++q) { v[0][q] = ((const float4*)(P.out + (size_t)t * D))[q * 64 + lane]; v[1][q] = ((const float4*)(P.out + (size_t)t2 * D))[q * 64 + lane]; }
#pragma unroll
        for (int u = 0; u < 2; ++u) {
            float ss = 0.f;
#pragma unroll
            for (int q = 0; q < 4; ++q) ss += v[u][q].x * v[u][q].x + v[u][q].y * v[u][q].y + v[u][q].z * v[u][q].z + v[u][q].w * v[u][q].w;
            ss = wave_sum(ss);
            const float rn = rsqrtf(ss * (1.f / D) + EPS);
            const int tt = u ? t2 : t;
            if (u == 0 || t2 != t) {
                float4* hr = (float4*)(P.out + (size_t)tt * D);
#pragma unroll
                for (int q = 0; q < 4; ++q) {
                    const float4 gg = g[q * 64 + lane];
                    const float4 o = make_float4(v[u][q].x * rn * gg.x, v[u][q].y * rn * gg.y, v[u][q].z * rn * gg.z, v[u][q].w * rn * gg.w);
                    if (l == DEPTH - 1) hr[q * 64 + lane] = o;
                    else { uint2 uu; uu.x = pack2(o.x, o.y); uu.y = pack2(o.z, o.w); ((uint2*)(XNw + (size_t)tt * LDX))[q * 64 + lane] = uu; }
                }
            }
        }
    }
}

#define XB_TMO      128
#define XB_XCNT(j)  (256  + 64 * (j))
#define XB_XSUB(j)  (1280 + 64 * (j))
#define XB_XGEN(j)  (2304 + 64 * (j))
#define XB_TOP      3328
#define XB_TOPGEN   3392
#define XCD_BAR_WORDS 3456
#define XB_SPIN_CAP (1u << 22)
#define LAS __attribute__((address_space(3)))
__device__ __forceinline__ unsigned xb_ld(unsigned* p)              { return __hip_atomic_load(p, __ATOMIC_RELAXED, __HIP_MEMORY_SCOPE_AGENT); }
__device__ __forceinline__ unsigned xb_add(unsigned* p, unsigned v) { return __hip_atomic_fetch_add(p, v, __ATOMIC_RELAXED, __HIP_MEMORY_SCOPE_AGENT); }
__device__ __forceinline__ unsigned xb_xcc_id() { return (unsigned)__builtin_amdgcn_s_getreg((3 << 11) | 20) & 0xFu; }
#define XB_SPIN(cond, bar) do { unsigned _sp = 0; while (cond) { __builtin_amdgcn_s_sleep(1); \
    if ((++_sp & 255u) == 0u) { if (xb_ld(&(bar)[XB_TMO])) break; if (_sp > XB_SPIN_CAP) { atomicAdd(&(bar)[XB_TMO], 1u); break; } } } } while (0)
struct XcdBarrier { unsigned* bar; unsigned x; volatile LAS unsigned* st; };
__device__ __forceinline__ XcdBarrier xcd_barrier_post(unsigned* bar, volatile LAS unsigned* st) {
    XcdBarrier b; b.bar = bar; b.x = xb_xcc_id(); b.st = st;
    if (__builtin_amdgcn_workitem_id_x() == 0) (void)xb_add(&bar[XB_XCNT(b.x)], 1u);
    return b;
}
__device__ __forceinline__ void xcd_barrier_complete(unsigned* bar, unsigned x, unsigned& nloc, unsigned& nx) {
    const unsigned G = gridDim.x * gridDim.y * gridDim.z;
    unsigned sum, cnt, mine, sp = 0u;
    for (;;) {
        sum = 0u; cnt = 0u; mine = 0u;
#pragma unroll
        for (unsigned j = 0; j < 16; ++j) { const unsigned c = xb_ld(&bar[XB_XCNT(j)]); sum += c; cnt += (c > 0u) ? 1u : 0u; mine = (j == x) ? c : mine; }
        if (sum == G) break;
        __builtin_amdgcn_s_sleep(1);
        if ((++sp & 255u) == 0u) { if (xb_ld(&bar[XB_TMO])) break; if (sp > XB_SPIN_CAP) { atomicAdd(&bar[XB_TMO], 1u); break; } }
    }
    nloc = mine > 0u ? mine : 1u; nx = cnt > 0u ? cnt : 1u;
}
__device__ __forceinline__ void xcd_barrier(const XcdBarrier& b) {
    asm volatile("s_waitcnt vmcnt(0)" ::: "memory");
    __syncthreads();
    if (__builtin_amdgcn_workitem_id_x() == 0) {
        unsigned* bar = b.bar;
        __builtin_amdgcn_s_waitcnt(0);
        unsigned nloc = b.st[0], nx = b.st[1];
        if (nloc == 0u) { xcd_barrier_complete(bar, b.x, nloc, nx); b.st[0] = nloc; b.st[1] = nx; }
        const unsigned old = xb_add(&bar[XB_XSUB(b.x)], 1u);
        const unsigned gen = old / nloc;
        if (old + 1u == (gen + 1u) * nloc) {
            __builtin_amdgcn_fence(__ATOMIC_RELEASE, "agent");
            asm volatile("s_waitcnt vmcnt(0)" ::: "memory");
            const unsigned og = xb_add(&bar[XB_TOP], 1u);
            const unsigned tg = og / nx;
            if (og + 1u == (tg + 1u) * nx) xb_add(&bar[XB_TOPGEN], 1u);
            else XB_SPIN(xb_ld(&bar[XB_TOPGEN]) == tg, bar);
            __builtin_amdgcn_fence(__ATOMIC_ACQUIRE, "agent");
            xb_add(&bar[XB_XGEN(b.x)], 1u);
            asm volatile("s_waitcnt vmcnt(0)" ::: "memory");
        } else {
            XB_SPIN(xb_ld(&bar[XB_XGEN(b.x)]) == gen, bar);
            __builtin_amdgcn_fence(__ATOMIC_ACQUIRE, "agent");
            asm volatile("s_waitcnt vmcnt(0)" ::: "memory");
        }
    }
    __syncthreads();
}

constexpr float QSCALE = 0.10206207261596575f * 1.4426950408889634f;

__device__ __forceinline__ void phase_gemm1(const Params& P, int l, char* lds) {
    unsigned char* ws = P.ws;
    const bf16* XN = (const bf16*)(ws + WS_XN);
    bf16* PROJ = (bf16*)(ws + WS_PROJ);
    bf16* Kb = (bf16*)(ws + WS_K);
    const float* rope = (const float*)(ws + WS_ROPE);
    const bf16* W = (const bf16*)(ws + WS_WIN) + (size_t)l * DINP * LDW;
    gemm_t<false>(W, LDW, DINP, XN, LDX, T, D, C_KR / 128, [&](int n0, int t0, const f32x16& acc, int r32, int hi, float) {
        const int t = t0 + r32;
        if (n0 < C_KR) {
            bf16* pr = PROJ + (size_t)t * DINP + n0 + 4 * hi;
#pragma unroll
            for (int g = 0; g < 4; ++g) { uint2 o; o.x = cvtpk(acc[4 * g], acc[4 * g + 1]); o.y = cvtpk(acc[4 * g + 2], acc[4 * g + 3]); *(uint2*)(pr + 8 * g) = o; }
        } else if (n0 == C_KR) {
            const int b = t / S, s = t % S;
            uint2 o1[2], o2[2];
#pragma unroll
            for (int g = 0; g < 2; ++g) {
                const float4 cs0 = *(const float4*)(rope + ((size_t)s * 16 + 8 * g + 4 * hi) * 2), cs1 = *(const float4*)(rope + ((size_t)s * 16 + 8 * g + 4 * hi) * 2 + 4);
                const float x10 = acc[4 * g], x11 = acc[4 * g + 1], x12 = acc[4 * g + 2], x13 = acc[4 * g + 3];
                const float x20 = acc[8 + 4 * g], x21 = acc[8 + 4 * g + 1], x22 = acc[8 + 4 * g + 2], x23 = acc[8 + 4 * g + 3];
                o1[g].x = cvtpk(x10 * cs0.x - x20 * cs0.y, x11 * cs0.z - x21 * cs0.w); o1[g].y = cvtpk(x12 * cs1.x - x22 * cs1.y, x13 * cs1.z - x23 * cs1.w);
                o2[g].x = cvtpk(x20 * cs0.x + x10 * cs0.y, x21 * cs0.z + x11 * cs0.w); o2[g].y = cvtpk(x22 * cs1.x + x12 * cs1.y, x23 * cs1.z + x13 * cs1.w);
            }
#pragma unroll
            for (int h = 0; h < NH; ++h) {
                bf16* kr = Kb + ((size_t)(b * NH + h) * S + s) * DQK + 64 + 4 * hi;
                *(uint2*)(kr) = o1[0]; *(uint2*)(kr + 8) = o1[1]; *(uint2*)(kr + 16) = o2[0]; *(uint2*)(kr + 24) = o2[1];
            }
        }
    }, [&](int t, int n, const float4& v) {
        uint2 o; o.x = cvtpk(v.x, v.y); o.y = cvtpk(v.z, v.w);
        *(uint2*)(PROJ + (size_t)t * DINP + n) = o;
    }, [](float) { return 1.f; }, lds);
}
__device__ __forceinline__ void phase_gemm2(const Params& P, int l, char* lds) {
    unsigned char* ws = P.ws;
    const bf16* PROJ = (const bf16*)(ws + WS_PROJ);
    const float* rope = (const float*)(ws + WS_ROPE);
    const int lane = tidx() & 63;
    {
        const bf16* W = (const bf16*)(ws + WS_WUQ) + (size_t)l * 768 * QR;
        bf16* Qb = (bf16*)(ws + WS_Q);
        gemm_t<true>(W, QR, 768, PROJ + C_CQ, DINP, T, QR, 768 / 128, [](int, int, const f32x16&, int, int, float) {},
            [&](int t, int n, const float4& v) {
                const int b = t / S, s = t % S, h = n / DQK, d = n % DQK;
                float4 o = v;
                const float4 up = make_float4(__shfl(v.x, lane + 4, 64), __shfl(v.y, lane + 4, 64), __shfl(v.z, lane + 4, 64), __shfl(v.w, lane + 4, 64));
                const float4 dn = make_float4(__shfl(v.x, lane - 4, 64), __shfl(v.y, lane - 4, 64), __shfl(v.z, lane - 4, 64), __shfl(v.w, lane - 4, 64));
                if (d >= 64) {
                    const bool first = d < 80;
                    const int f = first ? (d - 64) : (d - 80);
                    const float4 cs0 = *(const float4*)(rope + ((size_t)s * 16 + f) * 2), cs1 = *(const float4*)(rope + ((size_t)s * 16 + f) * 2 + 4);
                    if (first) o = make_float4(v.x * cs0.x - up.x * cs0.y, v.y * cs0.z - up.y * cs0.w, v.z * cs1.x - up.z * cs1.y, v.w * cs1.z - up.w * cs1.w);
                    else       o = make_float4(v.x * cs0.x + dn.x * cs0.y, v.y * cs0.z + dn.y * cs0.w, v.z * cs1.x + dn.z * cs1.y, v.w * cs1.z + dn.w * cs1.w);
                }
                uint2 u; u.x = cvtpk(o.x, o.y); u.y = cvtpk(o.z, o.w);
                *(uint2*)(Qb + ((size_t)(b * NH + h) * S + s) * DQK + d) = u;
            }, [](float ssq) { return rsqrtf(ssq * (1.f / QR) + EPS) * QSCALE; }, lds);
    }
    {
        const bf16* W = (const bf16*)(ws + WS_WUKV) + (size_t)l * 1024 * KVR;
        bf16* Kb = (bf16*)(ws + WS_K); bf16* Vb = (bf16*)(ws + WS_V);
        gemm_t<true>(W, KVR, 1024, PROJ + C_CKV, DINP, T, KVR, 1024 / 128, [](int, int, const f32x16&, int, int, float) {},
            [&](int t, int n, const float4& v) {
                const int b = t / S, s = t % S;
                uint2 u; u.x = cvtpk(v.x, v.y); u.y = cvtpk(v.z, v.w);
                if (n < 512) *(uint2*)(Kb + ((size_t)(b * NH + (n >> 6)) * S + s) * DQK + (n & 63)) = u;
                else         *(uint2*)(Vb + ((size_t)(b * NH + ((n - 512) >> 6)) * S + s) * DV + (n & 63)) = u;
            }, [](float ssq) { return rsqrtf(ssq * (1.f / KVR) + EPS); }, lds);
    }
}
__device__ __forceinline__ void phase_gemm3(const Params& P, int l, char* lds) {
    unsigned char* ws = P.ws;
    const bf16* Yb = (const bf16*)(ws + WS_XN);
    const bf16* W = (const bf16*)(ws + WS_WOUT) + (size_t)l * D * LDW;
    const float* hin = (l == 0) ? P.x : P.out;
    float* out = P.out;
    gemm_t<false>(W, LDW, D, Yb, LDX, T, D, D / 128, [](int, int, const f32x16&, int, int, float) {}, [&](int t, int n, const float4& v) {
        const size_t idx = (size_t)t * D + n;
        const float4 hv = *(const float4*)(hin + idx);
        *(float4*)(out + idx) = make_float4(hv.x + v.x, hv.y + v.y, hv.z + v.z, hv.w + v.w);
    }, [](float) { return 1.f; }, lds);
}

#define GSYNC() do { XcdBarrier xb_; { __attribute__((address_space(1))) char* gp_ = (__attribute__((address_space(1))) char*)(char*)(P.ws + WS_CTL); asm volatile("" : "+s"(gp_)); xb_.bar = (unsigned*)(char*)gp_; } \
    xb_.x = xb_xcc_id(); xb_.st = (volatile LAS unsigned*)&xb_words; xcd_barrier(xb_); } while (0)
#define PHASE(stmt) { const Params Q = launder(P); stmt; }
__global__ void __launch_bounds__(NTHREADS, 2) k_all(Params P) {
    __shared__ __attribute__((aligned(16))) char sm[LDS_TOTAL];
    __shared__ uint4 xb_words;
    cg::grid_group grid = cg::this_grid();
    if (__builtin_amdgcn_workitem_id_x() == 0) xb_words = make_uint4(0u, 0u, 0u, 0u);
    __syncthreads();
    (void)xcd_barrier_post((unsigned*)(P.ws + WS_CTL), (volatile LAS unsigned*)&xb_words);
    __shared__ int xinfo[8];
    if (__builtin_amdgcn_workitem_id_x() == 0) {
        const unsigned x = xb_xcc_id();
        xinfo[XI_X] = (int)x; xinfo[XI_RANK] = (int)xb_add((unsigned*)(P.ws + WS_CTL) + CTL_CENSUS + x, 1u);
    }
    PHASE(phase_prep(Q, sm));
    PHASE(phase_norm(Q.x, Q.norm_mix, (bf16*)(Q.ws + WS_XN)));
    if (P.ws == nullptr) grid.sync();
    GSYNC();
    if (__builtin_amdgcn_workitem_id_x() == 0) {
        unsigned* cen = (unsigned*)(P.ws + WS_CTL) + CTL_CENSUS;
        const int x = xinfo[XI_X]; int nx = 0, jj = 0;
        for (int q = 0; q < 16; ++q) { const unsigned cq = xb_ld(cen + q); if (cq) { if (q < x) ++jj; ++nx; } }
        xinfo[XI_J] = jj; xinfo[XI_NX] = nx; xinfo[XI_NLOC] = (int)xb_ld(cen + x);
    }
    __syncthreads();
    for (int l = 0; l < DEPTH; ++l) {
        PHASE(phase_gemm1(Q, l, sm));
#if PROBE_DUP & 2
        PHASE(phase_gemm1(Q, l, sm));
#endif
        GSYNC();
        PHASE(phase_mixlocal(Q, l, sm));
#if PROBE_DUP & 256
        PHASE(phase_mixlocal(Q, l, sm));
#endif
        PHASE(phase_gemm2(Q, l, sm));
        GSYNC();
        PHASE(phase_attn(Q, sm));
        GSYNC();
        PHASE(phase_gemm3(Q, l, sm));
#if PROBE_DUP & 16
        if (l == 0) PHASE(phase_gemm3(Q, l, sm));
#endif
        GSYNC();
        PHASE(phase_norm_q(Q, l));
        GSYNC();
        PHASE(phase_route(Q, l, sm));
        GSYNC();
        PHASE(phase_gu(Q, l, xinfo));
        GSYNC();
        PHASE(phase_gw(Q, l));
        GSYNC();
        PHASE(phase_gv(Q, l, xinfo, sm));
        GSYNC();
        PHASE(phase_gnorm(Q, l));
        GSYNC();
    }
}

extern "C" void kernel_launch(void* const* d_in, const int* in_sizes, int n_in, void* d_out, int out_size, void* d_ws, size_t ws_size, hipStream_t stream) {
    static int grid = 0;
    if (grid == 0) {
        if (n_in != 18 || out_size != T * D || ws_size < WS_END) { fprintf(stderr, "kernel_launch: bad sizes n_in %d out %d ws %zu need %zu\n", n_in, out_size, ws_size, (size_t)WS_END); grid = -1; return; }
        int dev = 0, cus = 0, per_cu = 0;
        (void)hipGetDevice(&dev);
        (void)hipDeviceGetAttribute(&cus, hipDeviceAttributeMultiprocessorCount, dev);
        (void)hipOccupancyMaxActiveBlocksPerMultiprocessor(&per_cu, (const void*)k_all, NTHREADS, 0);
        if (per_cu > 2) per_cu = 2;
        if (per_cu < 1) { fprintf(stderr, "kernel_launch: occupancy query says %d\n", per_cu); grid = -1; return; }
        grid = cus * per_cu;
    }
    if (grid < 0) return;
    Params p{};
    p.x = (const float*)d_in[0]; p.norm_mix = (const float*)d_in[1]; p.w_in = (const float*)d_in[2]; p.conv_w = (const float*)d_in[3];
    p.pool_w = (const float*)d_in[4]; p.pool_scale = (const float*)d_in[5]; p.q_norm = (const float*)d_in[6]; p.w_uq = (const float*)d_in[7];
    p.kv_norm = (const float*)d_in[8]; p.w_uk = (const float*)d_in[9]; p.w_uv = (const float*)d_in[10]; p.w_out = (const float*)d_in[11];
    p.norm_ffn = (const float*)d_in[12]; p.peer_wq = (const float*)d_in[13]; p.peer_subkeys = (const float*)d_in[14]; p.peer_u = (const float*)d_in[15];
    p.peer_v = (const float*)d_in[16]; p.norm_final = (const float*)d_in[17];
    p.out = (float*)d_out; p.ws = (unsigned char*)d_ws;
    if (hipMemsetAsync((char*)d_ws + WS_CTL, 0, CTL_BYTES, stream) != hipSuccess) { fprintf(stderr, "kernel_launch: memset failed\n"); return; }
    void* args[] = {&p};
    hipError_t e = hipLaunchCooperativeKernel((const void*)k_all, dim3(grid), dim3(NTHREADS), args, 0, stream);
    if (e != hipSuccess) fprintf(stderr, "cooperative launch failed: %s (grid %d)\n", hipGetErrorString(e), grid);
}
```

```cpp
#include <hip/hip_runtime.h>
#include <hip/hip_cooperative_groups.h>
#include <cstdio>
#include <cstdint>
namespace cg = cooperative_groups;

#ifndef TAB_FP8
#define TAB_FP8 1
#endif
#ifndef PROBE_DUP
#define PROBE_DUP 0
#endif

constexpr int NB = 4, S = 8192, T = NB * S, D = 1024, DEPTH = 2;
constexpr int DIN = 1696, DINP = 1792;
constexpr int C_BG = 0, C_CG = 256, C_HC = 512, C_HP = 768, C_CQ = 1024, C_CKV = 1408, C_KR = 1664;
constexpr int QR = 384, KVR = 256, NH = 8, DQK = 96, DV = 64;
constexpr int PH = 8, NKEY = 128, NEXP = NKEY * NKEY, TOPK = 16, HK = PH * TOPK;
constexpr float EPS = 1e-6f;
constexpr int LDX = 1088;
constexpr int LDW = 1088;

typedef unsigned short bf16;

constexpr size_t WS_CTL   = 0;
constexpr size_t WS_ROPE  = 64 * 1024;
constexpr size_t WS_WIN   = WS_ROPE + (size_t)S * 16 * 2 * 4;
constexpr size_t WS_WUQ   = WS_WIN + (size_t)DEPTH * DINP * LDW * 2;
constexpr size_t WS_WUKV  = WS_WUQ + (size_t)DEPTH * 768 * QR * 2;
constexpr size_t WS_WOUT  = WS_WUKV + (size_t)DEPTH * 1024 * KVR * 2;
constexpr size_t WS_WPQ   = WS_WOUT + (size_t)DEPTH * D * LDW * 2;
constexpr size_t WS_XN    = ((WS_WPQ + (size_t)DEPTH * 2048 * LDW * 2 + 4095) / 4096) * 4096;
constexpr size_t WS_PROJ  = WS_XN + (size_t)T * LDX * 2;
constexpr size_t WS_Q     = WS_PROJ + (size_t)T * DINP * 2;
constexpr size_t WS_K     = WS_Q + (size_t)T * NH * DQK * 2;
constexpr size_t WS_V     = WS_K + (size_t)T * NH * DQK * 2;
constexpr size_t WS_EXP   = WS_V + (size_t)T * NH * DV * 2;
constexpr size_t WS_GATE  = WS_EXP + (size_t)T * HK * 4;
constexpr size_t TAB_ROWB = TAB_FP8 ? 1024 : 2048;
constexpr size_t WS_TABU  = WS_GATE + (size_t)T * HK * 4;
constexpr size_t WS_TABV  = WS_TABU + (size_t)DEPTH * NEXP * TAB_ROWB;
constexpr size_t WS_TSCU  = WS_TABV + (size_t)DEPTH * NEXP * TAB_ROWB;
constexpr size_t WS_TSCV  = WS_TSCU + (size_t)DEPTH * NEXP * 4;
constexpr size_t WS_XQ    = WS_TSCV + (size_t)DEPTH * NEXP * 4;
constexpr size_t WS_XS    = WS_XQ + (size_t)T * D;
constexpr size_t WS_WQ8   = WS_XS + (size_t)T * 4;
constexpr size_t WS_WSC   = WS_WQ8 + (size_t)T * HK;
constexpr size_t WS_END   = WS_WSC + (size_t)T * 4;
static_assert(WS_END <= (size_t)512 * 1024 * 1024, "workspace budget");

struct Params {
    const float* x; const float* norm_mix; const float* w_in; const float* conv_w; const float* pool_w; const float* pool_scale;
    const float* q_norm; const float* w_uq; const float* kv_norm; const float* w_uk; const float* w_uv; const float* w_out;
    const float* norm_ffn; const float* peer_wq; const float* peer_subkeys; const float* peer_u; const float* peer_v; const float* norm_final;
    float* out; unsigned char* ws;
};

__device__ __forceinline__ bf16 f2bf(float f) { unsigned u = __float_as_uint(f); u += 0x7fffu + ((u >> 16) & 1u); return (bf16)(u >> 16); }
__device__ __forceinline__ float bf2f(bf16 h) { return __uint_as_float(((unsigned)h) << 16); }
__device__ __forceinline__ float bflo(unsigned u) { return __uint_as_float(u << 16); }
__device__ __forceinline__ float bfhi(unsigned u) { return __uint_as_float(u & 0xffff0000u); }
__device__ __forceinline__ unsigned pack2(float a, float b) { return (unsigned)f2bf(a) | ((unsigned)f2bf(b) << 16); }
__device__ __forceinline__ float wave_sum(float v) {
#pragma unroll
    for (int m = 32; m >= 1; m >>= 1) v += __shfl_xor(v, m, 64);
    return v;
}
__device__ __forceinline__ float gelu_exact(float x) { return 0.5f * x * (1.f + erff(x * 0.70710678118654752f)); }

#define NTHREADS 256
__device__ __forceinline__ int tidx() { int t = (int)__builtin_amdgcn_workitem_id_x(); asm volatile("" : "+v"(t)); return t; }
__device__ __forceinline__ int gwave() { return blockIdx.x * (NTHREADS / 64) + (tidx() >> 6); }
__device__ __forceinline__ int nwave() { return gridDim.x * (NTHREADS / 64); }
__device__ __forceinline__ size_t gtid() { return (size_t)blockIdx.x * NTHREADS + tidx(); }
__device__ __forceinline__ size_t gnth() { return (size_t)gridDim.x * NTHREADS; }


__device__ __forceinline__ Params launder(const Params& P) {
    typedef __attribute__((address_space(1))) char* gp_t;
    gp_t g[20] = {(gp_t)(char*)P.x, (gp_t)(char*)P.norm_mix, (gp_t)(char*)P.w_in, (gp_t)(char*)P.conv_w, (gp_t)(char*)P.pool_w, (gp_t)(char*)P.pool_scale, (gp_t)(char*)P.q_norm, (gp_t)(char*)P.w_uq,
                  (gp_t)(char*)P.kv_norm, (gp_t)(char*)P.w_uk, (gp_t)(char*)P.w_uv, (gp_t)(char*)P.w_out, (gp_t)(char*)P.norm_ffn, (gp_t)(char*)P.peer_wq, (gp_t)(char*)P.peer_subkeys,
                  (gp_t)(char*)P.peer_u, (gp_t)(char*)P.peer_v, (gp_t)(char*)P.norm_final, (gp_t)(char*)P.out, (gp_t)(char*)P.ws};
    asm volatile("" : "+s"(g[0]), "+s"(g[1]), "+s"(g[2]), "+s"(g[3]), "+s"(g[4]), "+s"(g[5]), "+s"(g[6]), "+s"(g[7]), "+s"(g[8]), "+s"(g[9]));
    asm volatile("" : "+s"(g[10]), "+s"(g[11]), "+s"(g[12]), "+s"(g[13]), "+s"(g[14]), "+s"(g[15]), "+s"(g[16]), "+s"(g[17]), "+s"(g[18]), "+s"(g[19]));
    Params Q;
    Q.x = (const float*)(char*)g[0]; Q.norm_mix = (const float*)(char*)g[1]; Q.w_in = (const float*)(char*)g[2]; Q.conv_w = (const float*)(char*)g[3]; Q.pool_w = (const float*)(char*)g[4];
    Q.pool_scale = (const float*)(char*)g[5]; Q.q_norm = (const float*)(char*)g[6]; Q.w_uq = (const float*)(char*)g[7]; Q.kv_norm = (const float*)(char*)g[8]; Q.w_uk = (const float*)(char*)g[9];
    Q.w_uv = (const float*)(char*)g[10]; Q.w_out = (const float*)(char*)g[11]; Q.norm_ffn = (const float*)(char*)g[12]; Q.peer_wq = (const float*)(char*)g[13]; Q.peer_subkeys = (const float*)(char*)g[14];
    Q.peer_u = (const float*)(char*)g[15]; Q.peer_v = (const float*)(char*)g[16]; Q.norm_final = (const float*)(char*)g[17]; Q.out = (float*)(char*)g[18]; Q.ws = (unsigned char*)(char*)g[19];
    return Q;
}

typedef __attribute__((ext_vector_type(8))) short bf16x8;
typedef __attribute__((ext_vector_type(16))) float f32x16;
typedef __attribute__((ext_vector_type(2))) __bf16 bf2_t;
#define MFMA32(a, b, c) __builtin_amdgcn_mfma_f32_32x32x16_bf16(a, b, c, 0, 0, 0)
__device__ __forceinline__ int crow(int r, int hi) { return (r & 3) + 8 * (r >> 2) + 4 * hi; }
__device__ __forceinline__ float dot2bf(unsigned a, unsigned b, float c) { return __builtin_amdgcn_fdot2_f32_bf16(__builtin_bit_cast(bf2_t, a), __builtin_bit_cast(bf2_t, b), c, false); }
__device__ __forceinline__ unsigned cvtpk(float lo, float hi) { unsigned r; asm("v_cvt_pk_bf16_f32 %0, %1, %2" : "=v"(r) : "v"(lo), "v"(hi)); return r; }
constexpr int G_OPB = 128 * 128;
constexpr int G_BUF = 2 * G_OPB;
constexpr int GEMM_LDS = 2 * G_BUF;
constexpr int LDS_TOTAL = GEMM_LDS + 8192;

template <int WT, bool ROWSS>
__device__ __forceinline__ void gemm_kloop(const bf16* __restrict__ Ag0, int lda, const bf16* __restrict__ Bg0, int ldb, int nk, f32x16 (&acc)[4], float (&ss)[4], char* lds, int tid) {
    const int lane = tid & 63, w = __builtin_amdgcn_readfirstlane(tid >> 6), r32 = lane & 31, hi = lane >> 5;
    const int srow = 8 * w + (lane >> 3);
    const int sch = (lane & 7) ^ ((srow >> 1) & 7);
    const bf16* Ag = Ag0 + (size_t)srow * lda + sch * 8;
    const bf16* Bg = Bg0 + (size_t)srow * ldb + sch * 8;
#pragma unroll
    for (int i = 0; i < 4; ++i)
#pragma unroll
        for (int r = 0; r < 16; ++r) acc[i][r] = 0.f;
    ss[0] = 0.f; ss[1] = 0.f; ss[2] = 0.f; ss[3] = 0.f;
    typedef __attribute__((address_space(3))) unsigned* ldsp_t;
    typedef const __attribute__((address_space(1))) unsigned* glbp_t;
#define G_DMA(buf, kofs) do { char* d_ = lds + (buf) * G_BUF + (8 * w) * 128; \
    _Pragma("unroll") for (int i = 0; i < 4; ++i) { \
        __builtin_amdgcn_global_load_lds((glbp_t)(const void*)(Ag + (size_t)(32 * i) * lda + (kofs)), (ldsp_t)(void*)(d_ + i * 4096), 16, 0, 0); \
        __builtin_amdgcn_global_load_lds((glbp_t)(const void*)(Bg + (size_t)(32 * i) * ldb + (kofs)), (ldsp_t)(void*)(d_ + G_OPB + i * 4096), 16, 0, 0); } } while (0)
    const int xr = (r32 >> 1) & 7;
    const int o0 = ((0 + hi) ^ xr) << 4, o1 = ((2 + hi) ^ xr) << 4, o2 = ((4 + hi) ^ xr) << 4, o3 = ((6 + hi) ^ xr) << 4;
#define G_SS(s_, r_) do { union { bf16x8 v; uint4 u; } c_; c_.v = r_; s_ = dot2bf(c_.u.x, c_.u.x, s_); s_ = dot2bf(c_.u.y, c_.u.y, s_); s_ = dot2bf(c_.u.z, c_.u.z, s_); s_ = dot2bf(c_.u.w, c_.u.w, s_); } while (0)
#define G_STEP(pa, pb, off) do { \
    if (WT == 0) { \
        const bf16x8 a0 = *(const bf16x8*)(pa + off), a1 = *(const bf16x8*)(pa + 32 * 128 + off); \
        const bf16x8 b0 = *(const bf16x8*)(pb + off), b1 = *(const bf16x8*)(pb + 32 * 128 + off); \
        if (ROWSS) { G_SS(ss[0], b0); G_SS(ss[1], b1); } \
        acc[0] = MFMA32(a0, b0, acc[0]); acc[1] = MFMA32(a0, b1, acc[1]); \
        acc[2] = MFMA32(a1, b0, acc[2]); acc[3] = MFMA32(a1, b1, acc[3]); \
    } else { \
        const bf16x8 b0 = *(const bf16x8*)(pb + off); \
        const bf16x8 a0 = *(const bf16x8*)(pa + off), a1 = *(const bf16x8*)(pa + 32 * 128 + off); \
        const bf16x8 a2 = *(const bf16x8*)(pa + 64 * 128 + off), a3 = *(const bf16x8*)(pa + 96 * 128 + off); \
        acc[0] = MFMA32(a0, b0, acc[0]); acc[1] = MFMA32(a1, b0, acc[1]); \
        acc[2] = MFMA32(a2, b0, acc[2]); acc[3] = MFMA32(a3, b0, acc[3]); \
    } } while (0)
    const int arow = (WT == 0) ? ((w >> 1) * 64 + r32) : r32;
    const int brow = (WT == 0) ? ((w & 1) * 64 + r32) : (w * 32 + r32);
    G_DMA(0, 0);
    for (int kt = 0; kt < nk; ++kt) {
        __syncthreads();
        if (kt + 1 < nk) G_DMA((kt + 1) & 1, (kt + 1) * 64);
        const char* pa = lds + (kt & 1) * G_BUF + arow * 128;
        const char* pb = lds + (kt & 1) * G_BUF + G_OPB + brow * 128;
        if (WT == 0) {
#define G_RD(off, A0, A1, B0, B1) do { A0 = *(const bf16x8*)(pa + off); A1 = *(const bf16x8*)(pa + 32 * 128 + off); B0 = *(const bf16x8*)(pb + off); B1 = *(const bf16x8*)(pb + 32 * 128 + off); } while (0)
#define G_MM(A0, A1, B0, B1) do { if (ROWSS) { G_SS(ss[0], B0); G_SS(ss[1], B1); } \
            acc[0] = MFMA32(A0, B0, acc[0]); acc[1] = MFMA32(A0, B1, acc[1]); acc[2] = MFMA32(A1, B0, acc[2]); acc[3] = MFMA32(A1, B1, acc[3]); } while (0)
            bf16x8 xa0, xa1, xb0, xb1, ya0, ya1, yb0, yb1;
            G_RD(o0, xa0, xa1, xb0, xb1);
            G_RD(o1, ya0, ya1, yb0, yb1); __builtin_amdgcn_sched_barrier(0);
            G_MM(xa0, xa1, xb0, xb1); G_RD(o2, xa0, xa1, xb0, xb1); __builtin_amdgcn_sched_barrier(0);
            G_MM(ya0, ya1, yb0, yb1); G_RD(o3, ya0, ya1, yb0, yb1); __builtin_amdgcn_sched_barrier(0);
            G_MM(xa0, xa1, xb0, xb1);
            G_MM(ya0, ya1, yb0, yb1);
#undef G_RD
#undef G_MM
        } else {
            G_STEP(pa, pb, o0); G_STEP(pa, pb, o1); G_STEP(pa, pb, o2); G_STEP(pa, pb, o3);
        }
    }
    if (ROWSS) { ss[0] += __shfl_xor(ss[0], 32, 64); ss[1] += __shfl_xor(ss[1], 32, 64); }
#undef G_DMA
#undef G_SS
#undef G_STEP
}

__device__ __forceinline__ void tile_range(int ntiles, int& lo, int& hi) {
    const int G = gridDim.x, b = blockIdx.x;
    const int vb = ((G & 7) == 0) ? ((b & 7) * (G >> 3) + (b >> 3)) : b;
    const int per = (ntiles + G - 1) / G;
    lo = vb * per; hi = lo + per; if (hi > ntiles) hi = ntiles;
}
constexpr int ST_P = 68;
static_assert(4 * 64 * ST_P * 4 <= LDS_TOTAL, "staging LDS");
template <bool ROWSS, class EPI, class EPIROW, class RSC>
__device__ __forceinline__ void gemm_t(const bf16* __restrict__ Wt, int ldw, int N, const bf16* __restrict__ X, int ldx, int M, int K, int tn_direct, EPI epi, EPIROW epirow, RSC rowscale, char* lds) {
    const int tid = tidx(), lane = tid & 63, w = tid >> 6, r32 = lane & 31, hi = lane >> 5;
    const int tilesN = N / 128, tilesM = M / 128, nk = K / 64;
    int tlo, thi; tile_range(tilesM * tilesN, tlo, thi);
    for (int tile = tlo; tile < thi; ++tile) {
        const int tm = tile / tilesN, tn = tile % tilesN;
        f32x16 acc[4]; float ss[4];
        gemm_kloop<0, ROWSS>(Wt + (size_t)(tn * 128) * ldw, ldw, X + (size_t)(tm * 128) * ldx, ldx, nk, acc, ss, lds, tid);
        if (tn < tn_direct) {
            __syncthreads();
            float* st = (float*)lds + w * (64 * ST_P);
            const float m0_ = rowscale(ss[0]), m1_ = rowscale(ss[1]);
#pragma unroll
            for (int i = 0; i < 2; ++i)
#pragma unroll
                for (int j = 0; j < 2; ++j)
#pragma unroll
                    for (int g = 0; g < 4; ++g) {
                        const float mj = j ? m1_ : m0_;
                        *(float4*)(st + (32 * j + r32) * ST_P + 32 * i + 8 * g + 4 * hi) = make_float4(acc[i * 2 + j][4 * g] * mj, acc[i * 2 + j][4 * g + 1] * mj, acc[i * 2 + j][4 * g + 2] * mj, acc[i * 2 + j][4 * g + 3] * mj);
                    }
            const int rr = lane >> 4, ch = lane & 15;
#pragma unroll 4
            for (int it = 0; it < 16; ++it) {
                const int row = it * 4 + rr;
                const float4 v = *(const float4*)(st + row * ST_P + ch * 4);
                epirow(tm * 128 + (w & 1) * 64 + row, tn * 128 + (w >> 1) * 64 + ch * 4, v);
            }
        } else {
#pragma unroll
            for (int i = 0; i < 2; ++i)
#pragma unroll
                for (int j = 0; j < 2; ++j) {
                    const int tl = (w & 1) * 64 + j * 32;
                    epi(tn * 128 + (w >> 1) * 64 + i * 32, tm * 128 + tl, acc[i * 2 + j], r32, hi, ss[j]);
                }
        }
        __syncthreads();
    }
}

__device__ __forceinline__ void transpose_tiled(const float* __restrict__ W, bf16* __restrict__ Wt, int K, int N, int Npad, int ldk, const float* __restrict__ gain, char* lds) {
    float (*tl)[65] = (float (*)[65])lds;
    const int tid = tidx(), a = tid & 63, q = tid >> 6;
    const int tK = K / 64, tN = Npad / 64;
    for (int tile = blockIdx.x; tile < tK * tN; tile += gridDim.x) {
        const int k0 = (tile / tN) * 64, n0 = (tile % tN) * 64;
#pragma unroll 4
        for (int i = 0; i < 16; ++i) {
            const int k = k0 + q * 16 + i, n = n0 + a;
            float v = (n < N) ? W[(size_t)k * N + n] : 0.f;
            if (gain) v *= gain[k];
            tl[q * 16 + i][a] = v;
        }
        __syncthreads();
#pragma unroll 4
        for (int i = 0; i < 16; ++i) { const int nl = q * 16 + i; Wt[(size_t)(n0 + nl) * ldk + k0 + a] = f2bf(tl[a][nl]); }
        __syncthreads();
    }
}

__device__ __forceinline__ void quant_row(const float4 (&v)[4], unsigned char* __restrict__ dst, float* __restrict__ scl, int r, int lane) {
    float am = 0.f;
#pragma unroll
    for (int j = 0; j < 4; ++j) am = fmaxf(am, fmaxf(fmaxf(fabsf(v[j].x), fabsf(v[j].y)), fmaxf(fabsf(v[j].z), fabsf(v[j].w))));
#pragma unroll
    for (int m = 32; m >= 1; m >>= 1) am = fmaxf(am, __shfl_xor(am, m, 64));
    const float sc = (am > 0.f) ? am * (1.f / 448.f) : 1.f;
    const float is = 1.f / sc;
    uint4 o;
    { int w = 0; w = __builtin_amdgcn_cvt_pk_fp8_f32(v[0].x * is, v[0].y * is, w, false); w = __builtin_amdgcn_cvt_pk_fp8_f32(v[0].z * is, v[0].w * is, w, true); o.x = (unsigned)w; }
    { int w = 0; w = __builtin_amdgcn_cvt_pk_fp8_f32(v[1].x * is, v[1].y * is, w, false); w = __builtin_amdgcn_cvt_pk_fp8_f32(v[1].z * is, v[1].w * is, w, true); o.y = (unsigned)w; }
    { int w = 0; w = __builtin_amdgcn_cvt_pk_fp8_f32(v[2].x * is, v[2].y * is, w, false); w = __builtin_amdgcn_cvt_pk_fp8_f32(v[2].z * is, v[2].w * is, w, true); o.z = (unsigned)w; }
    { int w = 0; w = __builtin_amdgcn_cvt_pk_fp8_f32(v[3].x * is, v[3].y * is, w, false); w = __builtin_amdgcn_cvt_pk_fp8_f32(v[3].z * is, v[3].w * is, w, true); o.w = (unsigned)w; }
    { const int lay = r / NEXP, e = r % NEXP; *(uint4*)(dst + (((size_t)(lay * 8 + (lane >> 3)) * NEXP + e) * 128) + (lane & 7) * 16) = o; }
    if (lane == 0) scl[r] = sc;
}
__device__ __forceinline__ unsigned pack_i8x4(float a, float b, float c, float d) {
    const int ia = __float2int_rn(a), ib = __float2int_rn(b), ic = __float2int_rn(c), id = __float2int_rn(d);
    return (unsigned)(ia & 255) | ((unsigned)(ib & 255) << 8) | ((unsigned)(ic & 255) << 16) | ((unsigned)(id & 255) << 24);
}
__device__ __forceinline__ void quant_row_i8(const float4 (&v)[4], unsigned char* __restrict__ dst, float* __restrict__ scl, int r, int lane) {
    float am = 0.f;
#pragma unroll
    for (int j = 0; j < 4; ++j) am = fmaxf(am, fmaxf(fmaxf(fabsf(v[j].x), fabsf(v[j].y)), fmaxf(fabsf(v[j].z), fabsf(v[j].w))));
#pragma unroll
    for (int m = 32; m >= 1; m >>= 1) am = fmaxf(am, __shfl_xor(am, m, 64));
    const float sc = (am > 0.f) ? am * (1.f / 127.f) : 1.f;
    const float is = 1.f / sc;
    uint4 o;
    o.x = pack_i8x4(v[0].x * is, v[0].y * is, v[0].z * is, v[0].w * is); o.y = pack_i8x4(v[1].x * is, v[1].y * is, v[1].z * is, v[1].w * is);
    o.z = pack_i8x4(v[2].x * is, v[2].y * is, v[2].z * is, v[2].w * is); o.w = pack_i8x4(v[3].x * is, v[3].y * is, v[3].z * is, v[3].w * is);
    { const int lay = r / NEXP, e = r % NEXP; *(uint4*)(dst + (((size_t)(lay * 8 + (lane >> 3)) * NEXP + e) * 128) + (lane & 7) * 16) = o; }
    if (lane == 0) scl[r] = sc;
}
template <bool I8>
__device__ __forceinline__ void convert_table(const float* __restrict__ src, unsigned char* __restrict__ dst, float* __restrict__ scl, int rows) {
    static_assert(TAB_FP8, "fp8 tables");
    const int lane = tidx() & 63;
    const int nw = nwave();
    for (int r = gwave(); r < rows; r += 4 * nw) {
        float4 v[4][4]; int rr[4];
#pragma unroll
        for (int u = 0; u < 4; ++u) {
            rr[u] = (r + u * nw < rows) ? (r + u * nw) : r;
            const float4* s0 = (const float4*)(src + (size_t)rr[u] * D);
#pragma unroll
            for (int j = 0; j < 4; ++j) v[u][j] = s0[lane * 4 + j];
        }
#pragma unroll
        for (int u = 0; u < 4; ++u) {
            if (u == 0 || rr[u] != r) { if (I8) quant_row_i8(v[u], dst, scl, rr[u], lane); else quant_row(v[u], dst, scl, rr[u], lane); }
        }
    }
}
__device__ __forceinline__ void phase_prep(const Params& P, char* lds) {
    unsigned char* ws = P.ws;
    for (int l = 0; l < DEPTH; ++l) {
        transpose_tiled(P.w_in + (size_t)l * D * DIN, (bf16*)(ws + WS_WIN) + (size_t)l * DINP * LDW, D, DIN, DINP, LDW, nullptr, lds);
        transpose_tiled(P.w_uq + (size_t)l * QR * 768, (bf16*)(ws + WS_WUQ) + (size_t)l * 768 * QR, QR, 768, 768, QR, P.q_norm + l * QR, lds);
        transpose_tiled(P.w_uk + (size_t)l * KVR * 512, (bf16*)(ws + WS_WUKV) + (size_t)l * 1024 * KVR, KVR, 512, 512, KVR, P.kv_norm + l * KVR, lds);
        transpose_tiled(P.w_uv + (size_t)l * KVR * 512, (bf16*)(ws + WS_WUKV) + (size_t)l * 1024 * KVR + (size_t)512 * KVR, KVR, 512, 512, KVR, P.kv_norm + l * KVR, lds);
        transpose_tiled(P.w_out + (size_t)l * D * D, (bf16*)(ws + WS_WOUT) + (size_t)l * D * LDW, D, D, D, LDW, nullptr, lds);
    }
    {
        bf16* Wc = (bf16*)(ws + WS_WPQ);
        float (*As)[68] = (float (*)[68])lds;
        float (*Bs)[68] = (float (*)[68])(lds + 16 * 68 * 4);
        const int tid = tidx(), tx = tid & 15, ty = tid >> 4;
        const int lr = tid >> 2, ld4 = (tid & 3) * 4;
        for (int tile = blockIdx.x; tile < (DEPTH * 2048 / 64) * (D / 64); tile += gridDim.x) {
            const int row0 = (tile >> 4) * 64, k0 = (tile & 15) * 64;
            const int l = row0 >> 11, hp = (row0 >> 7) & 15, n0 = row0 & 127;
            const float* skp = P.peer_subkeys + (((size_t)l * 2 + (hp & 1)) * NKEY + n0 + lr) * 128 + ld4;
            const float* wqp = P.peer_wq + ((size_t)l * D + k0 + lr) * 2048 + hp * 128 + ld4;
            float acc[4][4];
#pragma unroll
            for (int i = 0; i < 4; ++i)
#pragma unroll
                for (int j = 0; j < 4; ++j) acc[i][j] = 0.f;
            for (int d0 = 0; d0 < 128; d0 += 16) {
                const float4 av = *(const float4*)(skp + d0), bv = *(const float4*)(wqp + d0);
                As[ld4 + 0][lr] = av.x; As[ld4 + 1][lr] = av.y; As[ld4 + 2][lr] = av.z; As[ld4 + 3][lr] = av.w;
                Bs[ld4 + 0][lr] = bv.x; Bs[ld4 + 1][lr] = bv.y; Bs[ld4 + 2][lr] = bv.z; Bs[ld4 + 3][lr] = bv.w;
                __syncthreads();
#pragma unroll
                for (int kk = 0; kk < 16; ++kk) {
                    const float4 a4 = *(const float4*)&As[kk][ty * 4], b4 = *(const float4*)&Bs[kk][tx * 4];
                    const float aa[4] = {a4.x, a4.y, a4.z, a4.w}, bb[4] = {b4.x, b4.y, b4.z, b4.w};
#pragma unroll
                    for (int i = 0; i < 4; ++i)
#pragma unroll
                        for (int j = 0; j < 4; ++j) acc[i][j] = fmaf(aa[i], bb[j], acc[i][j]);
                }
                __syncthreads();
            }
#pragma unroll
            for (int i = 0; i < 4; ++i) {
                uint2 o; o.x = pack2(acc[i][0], acc[i][1]); o.y = pack2(acc[i][2], acc[i][3]);
                *(uint2*)(Wc + (size_t)(row0 + ty * 4 + i) * LDW + k0 + tx * 4) = o;
            }
        }
    }
    float* rope = (float*)(ws + WS_ROPE);
    for (size_t i = gtid(); i < (size_t)S * 16; i += gnth()) {
        const int s = (int)(i >> 4), f = (int)(i & 15);
        const double inv = pow(10000.0, -(double)f / 16.0);
        const double ang = (double)s * inv;
        rope[2 * i] = (float)cos(ang); rope[2 * i + 1] = (float)sin(ang);
    }
}

__device__ __forceinline__ void phase_tables(const Params& P) {
    convert_table<true>(P.peer_u, P.ws + WS_TABU, (float*)(P.ws + WS_TSCU), DEPTH * NEXP);
    convert_table<false>(P.peer_v, P.ws + WS_TABV, (float*)(P.ws + WS_TSCV), DEPTH * NEXP);
}

__device__ __forceinline__ void phase_norm(const float* __restrict__ h, const float* __restrict__ g, bf16* __restrict__ xn) {
    const int lane = tidx() & 63, nw = nwave();
    for (int t = gwave(); t < T; t += 2 * nw) {
        const int t2 = (t + nw < T) ? (t + nw) : t;
        float4 v[2][4];
#pragma unroll
        for (int j = 0; j < 4; ++j) { v[0][j] = ((const float4*)(h + (size_t)t * D))[j * 64 + lane]; v[1][j] = ((const float4*)(h + (size_t)t2 * D))[j * 64 + lane]; }
#pragma unroll
        for (int u = 0; u < 2; ++u) {
            float ss = 0.f;
#pragma unroll
            for (int j = 0; j < 4; ++j) ss += v[u][j].x * v[u][j].x + v[u][j].y * v[u][j].y + v[u][j].z * v[u][j].z + v[u][j].w * v[u][j].w;
            ss = wave_sum(ss);
            const float r = rsqrtf(ss * (1.f / D) + EPS);
            const int tt = u ? t2 : t;
            if (u == 0 || t2 != t) {
#pragma unroll
                for (int j = 0; j < 4; ++j) {
                    const float4 gg = ((const float4*)g)[j * 64 + lane];
                    uint2 o; o.x = pack2(v[u][j].x * r * gg.x, v[u][j].y * r * gg.y); o.y = pack2(v[u][j].z * r * gg.z, v[u][j].w * r * gg.w);
                    ((uint2*)(xn + (size_t)tt * LDX))[j * 64 + lane] = o;
                }
            }
        }
    }
}

__device__ __forceinline__ void phase_norm_q(const Params& P, int l) {
    const int lane = tidx() & 63, nw = nwave();
    const float* g = P.norm_ffn + l * D;
    bf16* xn = (bf16*)(P.ws + WS_XN);
    unsigned* xq = (unsigned*)(P.ws + WS_XQ);
    float* xsc = (float*)(P.ws + WS_XS);
    for (int t = gwave(); t < T; t += 2 * nw) {
        const int t2 = (t + nw < T) ? (t + nw) : t;
        float4 v[2][4];
#pragma unroll
        for (int j = 0; j < 4; ++j) { v[0][j] = ((const float4*)(P.out + (size_t)t * D))[j * 64 + lane]; v[1][j] = ((const float4*)(P.out + (size_t)t2 * D))[j * 64 + lane]; }
#pragma unroll
        for (int u = 0; u < 2; ++u) {
            float ss = 0.f;
#pragma unroll
            for (int j = 0; j < 4; ++j) ss += v[u][j].x * v[u][j].x + v[u][j].y * v[u][j].y + v[u][j].z * v[u][j].z + v[u][j].w * v[u][j].w;
            ss = wave_sum(ss);
            const float r = rsqrtf(ss * (1.f / D) + EPS);
            const int tt = u ? t2 : t;
            if (u == 0 || t2 != t) {
                float am = 0.f;
#pragma unroll
                for (int j = 0; j < 4; ++j) {
                    const float4 gg = ((const float4*)g)[j * 64 + lane];
                    v[u][j].x *= r * gg.x; v[u][j].y *= r * gg.y; v[u][j].z *= r * gg.z; v[u][j].w *= r * gg.w;
                    am = fmaxf(am, fmaxf(fmaxf(fabsf(v[u][j].x), fabsf(v[u][j].y)), fmaxf(fabsf(v[u][j].z), fabsf(v[u][j].w))));
                    uint2 o; o.x = pack2(v[u][j].x, v[u][j].y); o.y = pack2(v[u][j].z, v[u][j].w);
                    ((uint2*)(xn + (size_t)tt * LDX))[j * 64 + lane] = o;
                }
#pragma unroll
                for (int m = 32; m >= 1; m >>= 1) am = fmaxf(am, __shfl_xor(am, m, 64));
                const float sc = (am > 0.f) ? am * (1.f / 127.f) : 1.f, is = 1.f / sc;
#pragma unroll
                for (int j = 0; j < 4; ++j) xq[(size_t)tt * (D / 4) + j * 64 + lane] = pack_i8x4(v[u][j].x * is, v[u][j].y * is, v[u][j].z * is, v[u][j].w * is);
                if (lane == 0) xsc[tt] = sc;
            }
        }
    }
}

__device__ __forceinline__ void phase_mixlocal(const Params& P, int l, char* lds) {
    const bf16* proj = (const bf16*)(P.ws + WS_PROJ);
    bf16* Y = (bf16*)(P.ws + WS_XN);
    const int tid = tidx();
    {
        const float* cw = P.conv_w + (size_t)l * 3 * 256;
        for (size_t i = gtid(); i < (size_t)T * 32; i += gnth()) {
            const int t = (int)(i >> 5), c0 = (int)(i & 31) * 8, s = t & (S - 1);
            const bf16* pr = proj + (size_t)t * DINP;
            float acc[8];
#pragma unroll
            for (int e = 0; e < 8; ++e) acc[e] = 0.f;
#pragma unroll
            for (int j = 0; j < 3; ++j) {
                if (s - 2 + j >= 0) {
                    const bf16* pp = pr - (size_t)(2 - j) * DINP;
                    const uint4 g = *(const uint4*)(pp + C_CG + c0), hc = *(const uint4*)(pp + C_HC + c0);
                    const float4 w0 = *(const float4*)(cw + j * 256 + c0), w1 = *(const float4*)(cw + j * 256 + c0 + 4);
                    acc[0] = fmaf(w0.x, bflo(g.x) * bflo(hc.x), acc[0]); acc[1] = fmaf(w0.y, bfhi(g.x) * bfhi(hc.x), acc[1]);
                    acc[2] = fmaf(w0.z, bflo(g.y) * bflo(hc.y), acc[2]); acc[3] = fmaf(w0.w, bfhi(g.y) * bfhi(hc.y), acc[3]);
                    acc[4] = fmaf(w1.x, bflo(g.z) * bflo(hc.z), acc[4]); acc[5] = fmaf(w1.y, bfhi(g.z) * bfhi(hc.z), acc[5]);
                    acc[6] = fmaf(w1.z, bflo(g.w) * bflo(hc.w), acc[6]); acc[7] = fmaf(w1.w, bfhi(g.w) * bfhi(hc.w), acc[7]);
                }
            }
            const uint4 bg = *(const uint4*)(pr + C_BG + c0);
            uint4 o;
            o.x = pack2(bflo(bg.x) * acc[0], bfhi(bg.x) * acc[1]); o.y = pack2(bflo(bg.y) * acc[2], bfhi(bg.y) * acc[3]);
            o.z = pack2(bflo(bg.z) * acc[4], bfhi(bg.z) * acc[5]); o.w = pack2(bflo(bg.w) * acc[6], bfhi(bg.w) * acc[7]);
            *(uint4*)(Y + (size_t)t * LDX + c0) = o;
        }
    }
    {
        float (*pl)[68] = (float (*)[68])lds;
        const float* pw = P.pool_w + (size_t)l * 4 * 64 * 64;
        const float* psc = P.pool_scale + l * 256;
        const int a = tid & 63, q = tid >> 6;
        for (int tile = blockIdx.x; tile < (T / 64) * 4; tile += gridDim.x) {
            const int g = tile & 3, t0 = (tile >> 2) * 64;
            const int w = 2 << g;
            {
                const bf16* col = proj + C_HP + g * 64 + a;
                const int tf = t0 + q * 16, sf = tf & (S - 1);
                float xr[31];
#pragma unroll
                for (int d = 1; d <= 15; ++d) xr[15 - d] = (d < w && sf - d >= 0) ? bf2f(col[(size_t)(tf - d) * DINP]) : 0.f;
#pragma unroll
                for (int i = 0; i < 16; ++i) xr[15 + i] = bf2f(col[(size_t)(tf + i) * DINP]);
                float sum = 0.f;
#pragma unroll
                for (int d = 1; d <= 15; ++d) sum += xr[15 - d];
#pragma unroll
                for (int i = 0; i < 16; ++i) {
                    const int s = sf + i;
                    sum += xr[15 + i];
                    const int cnt = (s + 1 < w) ? (s + 1) : w;
                    pl[q * 16 + i][a] = sum / (float)cnt - xr[15 + i];
                    const int o = 15 + i + 1;
                    const float old = (g == 0) ? xr[o - 2] : (g == 1) ? xr[o - 4] : (g == 2) ? xr[o - 8] : xr[o - 16];
                    sum -= old;
                }
            }
            __syncthreads();
            {
                float pc[64];
#pragma unroll
                for (int c = 0; c < 64; ++c) pc[c] = pw[(g * 64 + c) * 64 + a];
                const float sc = psc[g * 64 + a];
#pragma unroll 2
                for (int i = 0; i < 16; ++i) {
                    const float4* row = (const float4*)&pl[q * 16 + i][0];
                    float m0 = 0.f, m1 = 0.f;
#pragma unroll
                    for (int c4 = 0; c4 < 16; ++c4) { const float4 v = row[c4]; m0 = fmaf(v.x, pc[4 * c4], m0); m1 = fmaf(v.y, pc[4 * c4 + 1], m1); m0 = fmaf(v.z, pc[4 * c4 + 2], m0); m1 = fmaf(v.w, pc[4 * c4 + 3], m1); }
                    Y[(size_t)(t0 + q * 16 + i) * LDX + 256 + g * 64 + a] = f2bf((m0 + m1) * sc);
                }
            }
            __syncthreads();
        }
    }
}

typedef short v4i16_t __attribute__((ext_vector_type(4)));
typedef __attribute__((address_space(3))) v4i16_t* lds_v4p;
__device__ __forceinline__ v4i16_t vtr(const char* p) { return __builtin_amdgcn_ds_read_tr16_b64_v4i16((lds_v4p)p); }
constexpr int A_KP = 208, A_VP = 192;
constexpr int A_KB = 64 * A_KP, A_VB = 64 * A_VP, A_BUF = A_KB + A_VB, ATTN_LDS = 2 * A_BUF;
static_assert(ATTN_LDS <= GEMM_LDS, "attention LDS");

__device__ __forceinline__ void attn_unit(const bf16* __restrict__ Qb, const bf16* __restrict__ Kb, const bf16* __restrict__ Vb, bf16* __restrict__ Y, int bh, int qblk, char* lds) {
    const int tid = tidx(), lane = tid & 63, w = tid >> 6, r32 = lane & 31, hi = lane >> 5;
    const int q0 = qblk * 128, qw0 = q0 + w * 32;
    const int NT = 2 * qblk + 2;
    bf16x8 qf[6];
    {
        const bf16* qp = Qb + ((size_t)bh * S + qw0 + r32) * DQK + hi * 8;
#pragma unroll
        for (int ks = 0; ks < 6; ++ks) qf[ks] = *(const bf16x8*)(qp + ks * 16);
    }
    f32x16 o0, o1;
#pragma unroll
    for (int r = 0; r < 16; ++r) { o0[r] = 0.f; o1[r] = 0.f; }
    float m = -1e30f, lsum = 0.f;
    const char* Kg = (const char*)(Kb + (size_t)bh * S * DQK) + tid * 16;
    const char* Vg = (const char*)(Vb + (size_t)bh * S * DV) + tid * 16;
    const int kl0 = (tid / 12) * A_KP + (tid % 12) * 16, kl1 = ((tid + 256) / 12) * A_KP + ((tid + 256) % 12) * 16, kl2 = ((tid + 512) / 12) * A_KP + ((tid + 512) % 12) * 16;
    const int vl0 = (tid >> 3) * A_VP + (tid & 7) * 16, vl1 = vl0 + 32 * A_VP;
    uint4 pk0, pk1, pk2, pv0, pv1, qk0, qk1, qk2, qv0, qv1;
#define A_LOAD(S, t) do { const char* kg = Kg + (size_t)(t) * (64 * 192); const char* vg = Vg + (size_t)(t) * (64 * 128); \
        S##k0 = *(const uint4*)(kg); S##k1 = *(const uint4*)(kg + 4096); S##k2 = *(const uint4*)(kg + 8192); S##v0 = *(const uint4*)(vg); S##v1 = *(const uint4*)(vg + 4096); } while (0)
#define A_STORE(S, bK, bV) do { *(uint4*)(bK + kl0) = S##k0; *(uint4*)(bK + kl1) = S##k1; *(uint4*)(bK + kl2) = S##k2; *(uint4*)(bV + vl0) = S##v0; *(uint4*)(bV + vl1) = S##v1; } while (0)
#define A_PV(pf, kofs) do { \
            { const v4i16_t lo = vtr(pv + (kofs) * A_VP), hh = vtr(pv + ((kofs) + 8) * A_VP); const bf16x8 vf = {lo[0], lo[1], lo[2], lo[3], hh[0], hh[1], hh[2], hh[3]}; o0 = MFMA32(vf, pf.v, o0); } \
            { const v4i16_t lo = vtr(pv + (kofs) * A_VP + 64), hh = vtr(pv + ((kofs) + 8) * A_VP + 64); const bf16x8 vf = {lo[0], lo[1], lo[2], lo[3], hh[0], hh[1], hh[2], hh[3]}; o1 = MFMA32(vf, pf.v, o1); } } while (0)
    const int pvo = (4 * hi + ((lane & 15) >> 2)) * A_VP + (16 * ((lane >> 4) & 1) + 4 * (lane & 3)) * 2;
    A_LOAD(p, 0); A_LOAD(q, 1);
    for (int t2 = 0; t2 < NT; t2 += 2) {
#pragma unroll
        for (int half = 0; half < 2; ++half) {
            const int t = t2 + half;
            char* bK = lds + half * A_BUF; char* bV = bK + A_KB;
            if (half == 0) A_STORE(p, bK, bV); else A_STORE(q, bK, bV);
            __syncthreads();
            { const int tn = (t + 2 < NT) ? (t + 2) : (NT - 2 + half); if (half == 0) A_LOAD(p, tn); else A_LOAD(q, tn); }
        const int kt0 = t * 64;
        if (kt0 <= qw0) {
            f32x16 s0, s1;
#pragma unroll
            for (int r = 0; r < 16; ++r) { s0[r] = 0.f; s1[r] = 0.f; }
            const char* pk = bK + r32 * A_KP + hi * 16;
#pragma unroll
            for (int ks = 0; ks < 6; ++ks) {
                const bf16x8 a0 = *(const bf16x8*)(pk + ks * 32), a1 = *(const bf16x8*)(pk + 32 * A_KP + ks * 32);
                s0 = MFMA32(a0, qf[ks], s0); s1 = MFMA32(a1, qf[ks], s1);
            }
            if (kt0 + 63 > qw0) {
                const int qrow = qw0 + r32;
#pragma unroll
                for (int r = 0; r < 16; ++r) { const int key = kt0 + crow(r, hi); if (key > qrow) s0[r] = -INFINITY; if (key + 32 > qrow) s1[r] = -INFINITY; }
            }
            float mx = fmaxf(s0[0], s1[0]);
#pragma unroll
            for (int r = 1; r < 16; ++r) mx = fmaxf(mx, fmaxf(s0[r], s1[r]));
            mx = fmaxf(mx, __shfl_xor(mx, 32, 64));
            const float mn = fmaxf(m, mx), m_prev = m;
            const float alpha = __builtin_amdgcn_exp2f(m - mn);
            m = mn;
            float ps = 0.f;
#pragma unroll
            for (int r = 0; r < 16; ++r) { s0[r] = __builtin_amdgcn_exp2f(s0[r] - mn); s1[r] = __builtin_amdgcn_exp2f(s1[r] - mn); ps += s0[r] + s1[r]; }
            if (__builtin_amdgcn_ballot_w64(mn > m_prev) != 0ull) {
                lsum *= alpha;
#pragma unroll
                for (int r = 0; r < 16; ++r) { o0[r] *= alpha; o1[r] *= alpha; }
            }
            lsum += ps;
            union { unsigned u[4]; bf16x8 v; } p00, p01, p10, p11;
#pragma unroll
            for (int j = 0; j < 4; ++j) { p00.u[j] = cvtpk(s0[2 * j], s0[2 * j + 1]); p01.u[j] = cvtpk(s0[8 + 2 * j], s0[9 + 2 * j]); p10.u[j] = cvtpk(s1[2 * j], s1[2 * j + 1]); p11.u[j] = cvtpk(s1[8 + 2 * j], s1[9 + 2 * j]); }
            const char* pv = bV + pvo;
            A_PV(p00, 0); A_PV(p01, 16); A_PV(p10, 32); A_PV(p11, 48);
        }
        }
    }
    lsum += __shfl_xor(lsum, 32, 64);
    const float inv = 1.f / lsum;
    const int b = bh >> 3, h = bh & 7;
    bf16* yo = Y + (size_t)(b * S + qw0 + r32) * LDX + 512 + h * 64 + 4 * hi;
#pragma unroll
    for (int g = 0; g < 4; ++g) {
        uint2 a, c;
        a.x = cvtpk(o0[4 * g] * inv, o0[4 * g + 1] * inv); a.y = cvtpk(o0[4 * g + 2] * inv, o0[4 * g + 3] * inv);
        c.x = cvtpk(o1[4 * g] * inv, o1[4 * g + 1] * inv); c.y = cvtpk(o1[4 * g + 2] * inv, o1[4 * g + 3] * inv);
        *(uint2*)(yo + 8 * g) = a; *(uint2*)(yo + 32 + 8 * g) = c;
    }
    __syncthreads();
}
__device__ __forceinline__ void phase_attn(const Params& P, char* lds) {
    const bf16* Qb = (const bf16*)(P.ws + WS_Q);
    const bf16* Kb = (const bf16*)(P.ws + WS_K);
    const bf16* Vb = (const bf16*)(P.ws + WS_V);
    bf16* Y = (bf16*)(P.ws + WS_XN);
    for (int u = blockIdx.x; u < NB * NH * (S / 128); u += gridDim.x) {
        const int bh = u & 31, v = u >> 5;
        const int qblk = (v < 16) ? (63 - v) : (v < 32) ? (v - 16) : (v < 48) ? (79 - v) : (v - 32);
        attn_unit(Qb, Kb, Vb, Y, bh, qblk, lds);
    }
}

#define NET_HD __device__ __forceinline__
#define NET_U2F(u) __uint_as_float(u)
#define NET_F2U(f) __float_as_uint(f)
#define CE_DESC(a, b) do { const float hi__ = fmaxf(a, b), lo__ = fminf(a, b); a = hi__; b = lo__; } while (0)
NET_HD void sort16_desc(float (&v)[16]) {
#define CE2(a, b) CE_DESC(v[a], v[b])
    CE2(0,13); CE2(1,12); CE2(2,15); CE2(3,14); CE2(4,8); CE2(5,6); CE2(7,11); CE2(9,10);
    CE2(0,5); CE2(1,7); CE2(2,9); CE2(3,4); CE2(6,13); CE2(8,14); CE2(10,15); CE2(11,12);
    CE2(0,1); CE2(2,3); CE2(4,5); CE2(6,8); CE2(7,9); CE2(10,11); CE2(12,13); CE2(14,15);
    CE2(0,2); CE2(1,3); CE2(4,10); CE2(5,11); CE2(6,7); CE2(8,9); CE2(12,14); CE2(13,15);
    CE2(1,2); CE2(3,12); CE2(4,6); CE2(5,7); CE2(8,10); CE2(9,11); CE2(13,14);
    CE2(1,4); CE2(2,6); CE2(5,8); CE2(7,10); CE2(9,13); CE2(11,14);
    CE2(2,4); CE2(3,6); CE2(9,12); CE2(11,13);
    CE2(3,5); CE2(6,8); CE2(7,9); CE2(10,12);
    CE2(3,4); CE2(5,6); CE2(7,8); CE2(9,10); CE2(11,12);
    CE2(6,7); CE2(8,9);
#undef CE2
}
NET_HD void merge16_desc(float (&a)[16], const float (&b)[16]) {
#pragma unroll
    for (int i = 0; i < 16; ++i) a[i] = fmaxf(a[i], b[15 - i]);
#pragma unroll
    for (int j = 8; j > 0; j >>= 1) {
#pragma unroll
        for (int i = 0; i < 16; ++i) { const int l = i ^ j; if (l > i) CE_DESC(a[i], a[l]); }
    }
}
NET_HD void top16_of_64(float (&g0)[16], float (&g1)[16], float (&g2)[16], float (&g3)[16]) {
    sort16_desc(g0); sort16_desc(g1); sort16_desc(g2); sort16_desc(g3);
    merge16_desc(g0, g1); merge16_desc(g2, g3); merge16_desc(g0, g2);
}
NET_HD float u2f(unsigned u) { return NET_U2F(u); }
NET_HD unsigned f2u(float f) { return NET_F2U(f); }
template <class V16>
NET_HD void lane_top16(const V16& s0, const V16& s1, const V16& s2, const V16& s3, int hi, float (&out)[16]) {
    float g0[16], g1[16], g2[16], g3[16];
#pragma unroll
    for (int r = 0; r < 16; ++r) {
        const unsigned nb = (unsigned)((r & 3) + 8 * (r >> 2));
        g0[r] = u2f((f2u(s0[r]) & 0xFFFFFF80u) | nb); g1[r] = u2f((f2u(s1[r]) & 0xFFFFFF80u) | (nb + 32u));
        g2[r] = u2f((f2u(s2[r]) & 0xFFFFFF80u) | (nb + 64u)); g3[r] = u2f((f2u(s3[r]) & 0xFFFFFF80u) | (nb + 96u));
    }
    top16_of_64(g0, g1, g2, g3);
    const unsigned h4 = (unsigned)hi << 2;
#pragma unroll
    for (int i = 0; i < 16; ++i) out[i] = u2f(f2u(g0[i]) | h4);
}
constexpr int cand_slot(int a, int b) { int n = 0; for (int x = 0; x < 16; ++x) for (int y = 0; y < 16; ++y) { if (x == a && y == b) return n; if ((x + 1) * (y + 1) <= 16) ++n; } return n; }
NET_HD void cand_top16(const float (&s1)[16], const float (&s2)[16], float (&c)[16]) {
    float g0[16], g1[16], g2[16], g3[16];
#pragma unroll
    for (int i = 0; i < 16; ++i) { g0[i] = -3.0e38f; g1[i] = -3.0e38f; g2[i] = -3.0e38f; g3[i] = -3.0e38f; }
#pragma unroll
    for (int a = 0; a < 16; ++a) {
#pragma unroll
        for (int b = 0; b < 16; ++b) {
            if ((a + 1) * (b + 1) <= 16) {
                const int sl = cand_slot(a, b);
                const float v = u2f((f2u(s1[a] + s2[b]) & 0xFFFFFF00u) | (unsigned)(a * 16 + b));
                if (sl < 16) g0[sl & 15] = v; else if (sl < 32) g1[sl & 15] = v; else if (sl < 48) g2[sl & 15] = v; else g3[sl & 15] = v;
            }
        }
    }
    top16_of_64(g0, g1, g2, g3);
#pragma unroll
    for (int i = 0; i < 16; ++i) c[i] = g0[i];
}

__device__ __forceinline__ void phase_route(const Params& P, int l, char* lds) {
    const bf16* XN = (const bf16*)(P.ws + WS_XN);
    const bf16* Wc = (const bf16*)(P.ws + WS_WPQ) + (size_t)l * 2048 * LDW;
    int* EXPp = (int*)(P.ws + WS_EXP);
    float* GATEp = (float*)(P.ws + WS_GATE);
    const int tid = tidx(), lane = tid & 63, w = tid >> 6, r32 = lane & 31, hi = lane >> 5;
    int tlo, thi; tile_range((T / 128) * PH, tlo, thi);
    for (int u = tlo; u < thi; ++u) {
        const int tm = u >> 3, h = u & 7;
        float L0[16], L1[16];
        {
            f32x16 acc[4]; float ssd[4];
            gemm_kloop<1, false>(Wc + (size_t)((h * 2 + 0) * 128) * LDW, LDW, XN + (size_t)(tm * 128) * LDX, LDX, D / 64, acc, ssd, lds, tid);
            lane_top16(acc[0], acc[1], acc[2], acc[3], hi, L0);
            float o[16];
#pragma unroll
            for (int i = 0; i < 16; ++i) o[i] = __shfl_xor(L0[i], 32, 64);
            merge16_desc(L0, o);
        }
        {
            f32x16 acc[4]; float ssd[4];
            gemm_kloop<1, false>(Wc + (size_t)((h * 2 + 1) * 128) * LDW, LDW, XN + (size_t)(tm * 128) * LDX, LDX, D / 64, acc, ssd, lds, tid);
            lane_top16(acc[0], acc[1], acc[2], acc[3], hi, L1);
            float o[16];
#pragma unroll
            for (int i = 0; i < 16; ++i) o[i] = __shfl_xor(L1[i], 32, 64);
            merge16_desc(L1, o);
        }
        float c[16];
        cand_top16(L0, L1, c);
        __syncthreads();
        unsigned char* my = (unsigned char*)lds + tid * 32;
        {
            uint4 a, b;
#define PK4(L, i) ((__float_as_uint(L[i]) & 127u) | ((__float_as_uint(L[i + 1]) & 127u) << 8) | ((__float_as_uint(L[i + 2]) & 127u) << 16) | ((__float_as_uint(L[i + 3]) & 127u) << 24))
            a.x = PK4(L0, 0); a.y = PK4(L0, 4); a.z = PK4(L0, 8); a.w = PK4(L0, 12);
            b.x = PK4(L1, 0); b.y = PK4(L1, 4); b.z = PK4(L1, 8); b.w = PK4(L1, 12);
#undef PK4
            *(uint4*)my = a; *(uint4*)(my + 16) = b;
        }
        int ev[16]; float gv[16]; float den = 0.f;
#pragma unroll
        for (int k = 0; k < 16; ++k) {
            const unsigned ci = __float_as_uint(c[k]) & 255u;
            const int n1 = my[ci >> 4], n2 = my[16 + (ci & 15)];
            ev[k] = n1 * NKEY + n2;
            gv[k] = __expf(c[k] - c[0]); den += gv[k];
        }
        const float iden = 1.f / den;
        if (hi == 0) {
            const int t = tm * 128 + w * 32 + r32;
            uint4* ep = (uint4*)(EXPp + (size_t)t * HK + h * 16);
            float4* gp = (float4*)(GATEp + (size_t)t * HK + h * 16);
#pragma unroll
            for (int q = 0; q < 4; ++q) {
                ep[q] = make_uint4((unsigned)ev[4 * q], (unsigned)ev[4 * q + 1], (unsigned)ev[4 * q + 2], (unsigned)ev[4 * q + 3]);
                gp[q] = make_float4(gv[4 * q] * iden, gv[4 * q + 1] * iden, gv[4 * q + 2] * iden, gv[4 * q + 3] * iden);
            }
        }
        __syncthreads();
    }
}

constexpr size_t WS_PART = WS_PROJ;
static_assert((size_t)8 * T * HK * 4 <= WS_K - WS_PROJ, "PART alias");
constexpr int XI_X = 0, XI_RANK = 1, XI_J = 2, XI_NX = 3, XI_NLOC = 4;
constexpr int CTL_CENSUS = 4096;
constexpr int CTL_BYTES = (CTL_CENSUS + 16) * 4;

template <int M1, int M2, int M3, class TT>
__device__ __forceinline__ void red16x3(TT (&p)[16], int lane) {
#pragma unroll
    for (int i = 0; i < 8; ++i) { const bool up = lane & M1; const TT send = up ? p[i] : p[i + 8], keep = up ? p[i + 8] : p[i]; p[i] = keep + __shfl_xor(send, M1, 64); }
#pragma unroll
    for (int i = 0; i < 4; ++i) { const bool up = lane & M2; const TT send = up ? p[i] : p[i + 4], keep = up ? p[i + 4] : p[i]; p[i] = keep + __shfl_xor(send, M2, 64); }
#pragma unroll
    for (int i = 0; i < 2; ++i) { const bool up = lane & M3; const TT send = up ? p[i] : p[i + 2], keep = up ? p[i + 2] : p[i]; p[i] = keep + __shfl_xor(send, M3, 64); }
}
__device__ __forceinline__ void phase_gu(const Params& P, int l, const volatile int* xi) {
    const unsigned char* XQ = P.ws + WS_XQ;
    const float* XSc = (const float*)(P.ws + WS_XS);
    const int* EXPp = (const int*)(P.ws + WS_EXP);
    float* PART = (float*)(P.ws + WS_PART);
    const int tid = tidx(), lane = tid & 63, w = tid >> 6, g = lane >> 3, c = lane & 7;
    int xo_ = 0; asm volatile("" : "+v"(xo_));
    const int j = __builtin_amdgcn_readfirstlane(xi[xo_ + XI_J]), nx = __builtin_amdgcn_readfirstlane(xi[xo_ + XI_NX]), nloc = __builtin_amdgcn_readfirstlane(xi[xo_ + XI_NLOC]), rank = __builtin_amdgcn_readfirstlane(xi[xo_ + XI_RANK]);
    const int t0 = rank * 4 + w, st = nloc * 4;
    const int n = (t0 < T) ? (T - t0 + st - 1) / st : 0;
    const int i0 = 8 * (c & 1) + 4 * ((c >> 1) & 1) + 2 * ((c >> 2) & 1);
    for (int sl = j; sl < 8 && n > 0; sl += nx) {
        const unsigned char* Us = P.ws + WS_TABU + ((size_t)(l * 8 + sl) * NEXP) * 128;
        const unsigned co = (unsigned)c << 4;
        float* part = PART + (size_t)sl * T * HK;
        const unsigned char* xs = XQ + sl * 128 + c * 16;
#define GU_TK(k) (t0 + (((k) < n) ? (k) : (n - 1)) * st)
#define GU_LOADE(S, t) do { S##lo = EXPp[(size_t)(t) * HK + lane]; S##hi = EXPp[(size_t)(t) * HK + 64 + lane]; } while (0)
#define GU_LOADX(S, t) do { S##a = *(const uint4*)(xs + (size_t)(t) * D); S##s = XSc[t]; } while (0)
#define GU_ISSUE(R, S) do { _Pragma("unroll") for (int i = 0; i < 16; ++i) { \
            const int e = __builtin_amdgcn_ds_bpermute((((8 * i) & 63) + g) << 2, (i < 8) ? S##lo : S##hi); R[i] = *(const uint4*)(Us + (((unsigned)e << 7) | co)); } } while (0)
#define GU_FINISH(R, S, t) do { \
            int p[16]; \
            _Pragma("unroll") for (int i = 0; i < 16; ++i) { int d_ = __builtin_amdgcn_sdot4((int)S##a.x, (int)R[i].x, 0, false); d_ = __builtin_amdgcn_sdot4((int)S##a.y, (int)R[i].y, d_, false); \
                d_ = __builtin_amdgcn_sdot4((int)S##a.z, (int)R[i].z, d_, false); p[i] = __builtin_amdgcn_sdot4((int)S##a.w, (int)R[i].w, d_, false); } \
            red16x3<1, 2, 4, int>(p, lane); \
            part[(size_t)(t) * HK + 8 * i0 + g] = (float)p[0] * S##s; part[(size_t)(t) * HK + 8 * (i0 + 1) + g] = (float)p[1] * S##s; } while (0)
        int eAlo, eAhi, eBlo, eBhi; uint4 xAa, xBa; float xAs, xBs; uint4 rA[16], rB[16];
        GU_LOADE(eA, GU_TK(0)); GU_LOADX(xA, GU_TK(0)); GU_LOADE(eB, GU_TK(1));
        GU_ISSUE(rA, eA);
        for (int k = 0; k < n; k += 2) {
            GU_LOADX(xB, GU_TK(k + 1)); GU_ISSUE(rB, eB); GU_LOADE(eA, GU_TK(k + 2));
            GU_FINISH(rA, xA, GU_TK(k));
            GU_LOADX(xA, GU_TK(k + 2)); GU_ISSUE(rA, eA); GU_LOADE(eB, GU_TK(k + 3));
            GU_FINISH(rB, xB, GU_TK(k + 1));
        }
#undef GU_TK
#undef GU_LOADE
#undef GU_LOADX
#undef GU_ISSUE
#undef GU_FINISH
    }
}
__device__ __forceinline__ void phase_gw(const Params& P, int l) {
    const int* EXPp = (const int*)(P.ws + WS_EXP);
    const float* GATEp = (const float*)(P.ws + WS_GATE);
    const float* PART = (const float*)(P.ws + WS_PART);
    const float* SU = (const float*)(P.ws + WS_TSCU) + (size_t)l * NEXP;
    const float* SV = (const float*)(P.ws + WS_TSCV) + (size_t)l * NEXP;
    unsigned char* WQ = P.ws + WS_WQ8;
    float* WSC = (float*)(P.ws + WS_WSC);
    const int lane = tidx() & 63;
    for (int tb = gwave() * 4; tb < T; tb += nwave() * 4) {
        float wv[4][2];
#pragma unroll
        for (int q = 0; q < 4; ++q)
#pragma unroll
            for (int hk = 0; hk < 2; ++hk) {
                const size_t i = (size_t)(tb + q) * HK + hk * 64 + lane;
                float s = 0.f;
#pragma unroll
                for (int x = 0; x < 8; ++x) s += PART[(size_t)x * T * HK + i];
                const int e = EXPp[i];
                wv[q][hk] = GATEp[i] * gelu_exact(s * SU[e]) * SV[e];
            }
#pragma unroll
        for (int q = 0; q < 4; ++q) {
            float am = fmaxf(fabsf(wv[q][0]), fabsf(wv[q][1]));
#pragma unroll
            for (int m = 32; m >= 1; m >>= 1) am = fmaxf(am, __shfl_xor(am, m, 64));
            const float sc = (am > 0.f) ? am * (1.f / 448.f) : 1.f, is = 1.f / sc;
            const int pk = __builtin_amdgcn_cvt_pk_fp8_f32(wv[q][0] * is, wv[q][1] * is, 0, false);
            WQ[(size_t)(tb + q) * HK + lane] = (unsigned char)(pk & 255);
            WQ[(size_t)(tb + q) * HK + 64 + lane] = (unsigned char)((pk >> 8) & 255);
            if (lane == 0) WSC[tb + q] = sc;
        }
    }
}
typedef int v2i_t __attribute__((ext_vector_type(2)));
typedef unsigned u32x4_t __attribute__((ext_vector_type(4)));
typedef __attribute__((ext_vector_type(4))) float f32x4;
constexpr int GV_PIECE = 1024 + 16;
constexpr int GV_TILE = 16 * GV_PIECE;
static_assert(4 * GV_TILE + 4 * 512 <= LDS_TOTAL, "gv LDS");
__device__ __forceinline__ void phase_gv(const Params& P, int l, const volatile int* xi, char* lds) {
    const int* EXPp = (const int*)(P.ws + WS_EXP);
    const unsigned char* WQ = P.ws + WS_WQ8;
    const float* WSC = (const float*)(P.ws + WS_WSC);
    const int tid = tidx(), lane = tid & 63, w = __builtin_amdgcn_readfirstlane(tid >> 6), g = lane >> 3, pos = lane & 7;
    int xo_ = 0; asm volatile("" : "+v"(xo_));
    const int j = __builtin_amdgcn_readfirstlane(xi[xo_ + XI_J]), nx = __builtin_amdgcn_readfirstlane(xi[xo_ + XI_NX]), nloc = __builtin_amdgcn_readfirstlane(xi[xo_ + XI_NLOC]), rank = __builtin_amdgcn_readfirstlane(xi[xo_ + XI_RANK]);
    const int t0 = rank * 4 + w, st = nloc * 4;
    const int n = (t0 < T) ? (T - t0 + st - 1) / st : 0;
    char* tile = lds + w * GV_TILE;
    float* strip = (float*)(lds + 4 * GV_TILE) + w * 128;
    typedef __attribute__((address_space(3))) v2i_t* ldsv2_t;
    const unsigned co = (unsigned)(pos ^ g) << 4;
    const int rr = (lane & 15) >> 1, kq = lane >> 4;
    const int rdo = kq * GV_PIECE + rr * 128 + (lane & 1) * 8;
    const bool row0 = (lane & 15) == 0;
    __syncthreads();
    for (int sl = j; sl < 8 && n > 0; sl += nx) {
        const unsigned char* Vs = P.ws + WS_TABV + ((size_t)(l * 8 + sl) * NEXP) * 128;
        float* hrow = P.out + sl * 128 + 2 * lane;
#define GV_TK(k) (t0 + (((k) < n) ? (k) : (n - 1)) * st)
#define GV_LOADE(S, t) do { S##el = EXPp[(size_t)(t) * HK + lane]; S##eh = EXPp[(size_t)(t) * HK + 64 + lane]; } while (0)
#define GV_ISSUE(R, S) do { _Pragma("unroll") for (int i = 0; i < 16; ++i) { \
            const int e = __builtin_amdgcn_ds_bpermute((((8 * i) & 63) + g) << 2, (i < 8) ? S##el : S##eh); R[i] = *(const u32x4_t*)(Vs + (((unsigned)e << 7) | co)); } } while (0)
#define GV_LOADT(S, kk) do { const int t_ = GV_TK(kk); \
            S##a0 = 0; S##a1 = 0; S##a2 = 0; S##a3 = 0; \
            if (row0) { const long* wp = (const long*)(WQ + (size_t)t_ * HK + kq * 8); S##a0 = wp[0]; S##a1 = wp[4]; S##a2 = wp[8]; S##a3 = wp[12]; } \
            S##ws = ((kk) < n) ? WSC[t_] : 0.f; \
            S##hv = *(const float2*)(hrow + (size_t)t_ * D); } while (0)
#define GV_TOKEN(R, S, kk) do { \
            const int t = GV_TK(kk); \
            _Pragma("unroll") for (int i = 0; i < 16; ++i) *(u32x4_t*)(tile + i * GV_PIECE + lane * 16) = R[i]; \
            f32x4 acc[8]; \
            _Pragma("unroll") for (int nt = 0; nt < 8; ++nt) acc[nt] = (f32x4){0.f, 0.f, 0.f, 0.f}; \
            _Pragma("unroll") for (int s4 = 0; s4 < 4; ++s4) { \
                const long av = (s4 == 0) ? S##a0 : (s4 == 1) ? S##a1 : (s4 == 2) ? S##a2 : S##a3; \
                _Pragma("unroll") for (int nt = 0; nt < 8; ++nt) { \
                    const v2i_t bv = __builtin_amdgcn_ds_read_tr8_b64_v2i32((ldsv2_t)(void*)(tile + (4 * s4) * GV_PIECE + rdo + ((nt ^ rr) << 4))); \
                    acc[nt] = __builtin_amdgcn_mfma_f32_16x16x32_fp8_fp8(av, __builtin_bit_cast(long, bv), acc[nt], 0, 0, 0); } } \
            if (lane < 16) { _Pragma("unroll") for (int nt = 0; nt < 8; ++nt) strip[16 * nt + lane] = acc[nt][0]; }        \
            { const float2 o2 = *(const float2*)(strip + 2 * lane); \
              if ((kk) < n) *(float2*)(hrow + (size_t)t * D) = make_float2(S##hv.x + S##ws * o2.x, S##hv.y + S##ws * o2.y); } } while (0)
        int Ael, Aeh, Bel, Beh; u32x4_t rA[16], rB[16];
        long Pa0, Pa1, Pa2, Pa3, Qa0, Qa1, Qa2, Qa3; float Pws, Qws; float2 Phv, Qhv;
        GV_LOADE(A, GV_TK(0)); GV_LOADE(B, GV_TK(1));
        GV_ISSUE(rA, A); GV_LOADT(P, 0);
        for (int k = 0; k < n; k += 2) {
            GV_ISSUE(rB, B); GV_LOADE(A, GV_TK(k + 2)); GV_LOADT(Q, k + 1);
            GV_TOKEN(rA, P, k);
            GV_ISSUE(rA, A); GV_LOADE(B, GV_TK(k + 3)); GV_LOADT(P, k + 2);
            GV_TOKEN(rB, Q, k + 1);
        }
#undef GV_TK
#undef GV_LOADE
#undef GV_ISSUE
#undef GV_LOADT
#undef GV_TOKEN
    }
    __syncthreads();
}
__device__ __forceinline__ void phase_gnorm(const Params& P, int l) {
    const int lane = tidx() & 63, nw = nwave();
    bf16* XNw = (bf16*)(P.ws + WS_XN);
    const float4* g = (const float4*)((l == DEPTH - 1) ? P.norm_final : (P.norm_mix + (l + 1) * D));
    for (int t = gwave(); t < T; t += 2 * nw) {
        const int t2 = (t + nw < T) ? (t + nw) : t;
        float4 v[2][4];
#pragma unroll
        for (int q = 0; q < 4; ++q) { v[0][q] = ((const float4*)(P.out + (size_t)t * D))[q * 64 + lane]; v[1][q] = ((const float4*)(P.out + (size_t)t2 * D))[q * 64 + lane]; }
#pragma unroll
        for (int u = 0; u < 2; ++u) {
            float ss = 0.f;
#pragma unroll
            for (int q = 0; q < 4; ++q) ss += v[u][q].x * v[u][q].x + v[u][q].y * v[u][q].y + v[u][q].z * v[u][q].z + v[u][q].w * v[u][q].w;
            ss = wave_sum(ss);
            const float rn = rsqrtf(ss * (1.f / D) + EPS);
            const int tt = u ? t2 : t;
            if (u == 0 || t2 != t) {
                float4* hr = (float4*)(P.out + (size_t)tt * D);
#pragma unroll
                for (int q = 0; q < 4; ++q) {
                    const float4 gg = g[q * 64 + lane];
                    const float4 o = make_float4(v[u][q].x * rn * gg.x, v[u][q].y * rn * gg.y, v[u][q].z * rn * gg.z, v[u][q].w * rn * gg.w);
                    if (l == DEPTH - 1) hr[q * 64 + lane] = o;
                    else { uint2 uu; uu.x = pack2(o.x, o.y); uu.y = pack2(o.z, o.w); ((uint2*)(XNw + (size_t)tt * LDX))[q * 64 + lane] = uu; }
                }
            }
        }
    }
}

#define XB_TMO      128
#define XB_XCNT(j)  (256  + 64 * (j))
#define XB_XSUB(j)  (1280 + 64 * (j))
#define XB_XGEN(j)  (2304 + 64 * (j))
#define XB_TOP      3328
#define XB_TOPGEN   3392
#define XCD_BAR_WORDS 3456
#define XB_SPIN_CAP (1u << 22)
#define LAS __attribute__((address_space(3)))
__device__ __forceinline__ unsigned xb_ld(unsigned* p)              { return __hip_atomic_load(p, __ATOMIC_RELAXED, __HIP_MEMORY_SCOPE_AGENT); }
__device__ __forceinline__ unsigned xb_add(unsigned* p, unsigned v) { return __hip_atomic_fetch_add(p, v, __ATOMIC_RELAXED, __HIP_MEMORY_SCOPE_AGENT); }
__device__ __forceinline__ unsigned xb_xcc_id() { return (unsigned)__builtin_amdgcn_s_getreg((3 << 11) | 20) & 0xFu; }
#define XB_SPIN(cond, bar) do { unsigned _sp = 0; while (cond) { __builtin_amdgcn_s_sleep(1); \
    if ((++_sp & 255u) == 0u) { if (xb_ld(&(bar)[XB_TMO])) break; if (_sp > XB_SPIN_CAP) { atomicAdd(&(bar)[XB_TMO], 1u); break; } } } } while (0)
struct XcdBarrier { unsigned* bar; unsigned x; volatile LAS unsigned* st; };
__device__ __forceinline__ XcdBarrier xcd_barrier_post(unsigned* bar, volatile LAS unsigned* st) {
    XcdBarrier b; b.bar = bar; b.x = xb_xcc_id(); b.st = st;
    if (__builtin_amdgcn_workitem_id_x() == 0) (void)xb_add(&bar[XB_XCNT(b.x)], 1u);
    return b;
}
__device__ __forceinline__ void xcd_barrier_complete(unsigned* bar, unsigned x, unsigned& nloc, unsigned& nx) {
    const unsigned G = gridDim.x * gridDim.y * gridDim.z;
    unsigned sum, cnt, mine, sp = 0u;
    for (;;) {
        sum = 0u; cnt = 0u; mine = 0u;
#pragma unroll
        for (unsigned j = 0; j < 16; ++j) { const unsigned c = xb_ld(&bar[XB_XCNT(j)]); sum += c; cnt += (c > 0u) ? 1u : 0u; mine = (j == x) ? c : mine; }
        if (sum == G) break;
        __builtin_amdgcn_s_sleep(1);
        if ((++sp & 255u) == 0u) { if (xb_ld(&bar[XB_TMO])) break; if (sp > XB_SPIN_CAP) { atomicAdd(&bar[XB_TMO], 1u); break; } }
    }
    nloc = mine > 0u ? mine : 1u; nx = cnt > 0u ? cnt : 1u;
}
__device__ __forceinline__ void xcd_barrier(const XcdBarrier& b) {
    asm volatile("s_waitcnt vmcnt(0)" ::: "memory");
    __syncthreads();
    if (__builtin_amdgcn_workitem_id_x() == 0) {
        unsigned* bar = b.bar;
        __builtin_amdgcn_s_waitcnt(0);
        unsigned nloc = b.st[0], nx = b.st[1];
        if (nloc == 0u) { xcd_barrier_complete(bar, b.x, nloc, nx); b.st[0] = nloc; b.st[1] = nx; }
        const unsigned old = xb_add(&bar[XB_XSUB(b.x)], 1u);
        const unsigned gen = old / nloc;
        if (old + 1u == (gen + 1u) * nloc) {
            __builtin_amdgcn_fence(__ATOMIC_RELEASE, "agent");
            asm volatile("s_waitcnt vmcnt(0)" ::: "memory");
            const unsigned og = xb_add(&bar[XB_TOP], 1u);
            const unsigned tg = og / nx;
            if (og + 1u == (tg + 1u) * nx) xb_add(&bar[XB_TOPGEN], 1u);
            else XB_SPIN(xb_ld(&bar[XB_TOPGEN]) == tg, bar);
            __builtin_amdgcn_fence(__ATOMIC_ACQUIRE, "agent");
            xb_add(&bar[XB_XGEN(b.x)], 1u);
            asm volatile("s_waitcnt vmcnt(0)" ::: "memory");
        } else {
            XB_SPIN(xb_ld(&bar[XB_XGEN(b.x)]) == gen, bar);
            __builtin_amdgcn_fence(__ATOMIC_ACQUIRE, "agent");
            asm volatile("s_waitcnt vmcnt(0)" ::: "memory");
        }
    }
    __syncthreads();
}

constexpr float QSCALE = 0.10206207261596575f * 1.4426950408889634f;

__device__ __forceinline__ void phase_gemm1(const Params& P, int l, char* lds) {
    unsigned char* ws = P.ws;
    const bf16* XN = (const bf16*)(ws + WS_XN);
    bf16* PROJ = (bf16*)(ws + WS_PROJ);
    bf16* Kb = (bf16*)(ws + WS_K);
    const float* rope = (const float*)(ws + WS_ROPE);
    const bf16* W = (const bf16*)(ws + WS_WIN) + (size_t)l * DINP * LDW;
    gemm_t<false>(W, LDW, DINP, XN, LDX, T, D, C_KR / 128, [&](int n0, int t0, const f32x16& acc, int r32, int hi, float) {
        const int t = t0 + r32;
        if (n0 < C_KR) {
            bf16* pr = PROJ + (size_t)t * DINP + n0 + 4 * hi;
#pragma unroll
            for (int g = 0; g < 4; ++g) { uint2 o; o.x = cvtpk(acc[4 * g], acc[4 * g + 1]); o.y = cvtpk(acc[4 * g + 2], acc[4 * g + 3]); *(uint2*)(pr + 8 * g) = o; }
        } else if (n0 == C_KR) {
            const int b = t / S, s = t % S;
            uint2 o1[2], o2[2];
#pragma unroll
            for (int g = 0; g < 2; ++g) {
                const float4 cs0 = *(const float4*)(rope + ((size_t)s * 16 + 8 * g + 4 * hi) * 2), cs1 = *(const float4*)(rope + ((size_t)s * 16 + 8 * g + 4 * hi) * 2 + 4);
                const float x10 = acc[4 * g], x11 = acc[4 * g + 1], x12 = acc[4 * g + 2], x13 = acc[4 * g + 3];
                const float x20 = acc[8 + 4 * g], x21 = acc[8 + 4 * g + 1], x22 = acc[8 + 4 * g + 2], x23 = acc[8 + 4 * g + 3];
                o1[g].x = cvtpk(x10 * cs0.x - x20 * cs0.y, x11 * cs0.z - x21 * cs0.w); o1[g].y = cvtpk(x12 * cs1.x - x22 * cs1.y, x13 * cs1.z - x23 * cs1.w);
                o2[g].x = cvtpk(x20 * cs0.x + x10 * cs0.y, x21 * cs0.z + x11 * cs0.w); o2[g].y = cvtpk(x22 * cs1.x + x12 * cs1.y, x23 * cs1.z + x13 * cs1.w);
            }
#pragma unroll
            for (int h = 0; h < NH; ++h) {
                bf16* kr = Kb + ((size_t)(b * NH + h) * S + s) * DQK + 64 + 4 * hi;
                *(uint2*)(kr) = o1[0]; *(uint2*)(kr + 8) = o1[1]; *(uint2*)(kr + 16) = o2[0]; *(uint2*)(kr + 24) = o2[1];
            }
        }
    }, [&](int t, int n, const float4& v) {
        uint2 o; o.x = cvtpk(v.x, v.y); o.y = cvtpk(v.z, v.w);
        *(uint2*)(PROJ + (size_t)t * DINP + n) = o;
    }, [](float) { return 1.f; }, lds);
}
__device__ __forceinline__ void phase_gemm2(const Params& P, int l, char* lds) {
    unsigned char* ws = P.ws;
    const bf16* PROJ = (const bf16*)(ws + WS_PROJ);
    const float* rope = (const float*)(ws + WS_ROPE);
    const int lane = tidx() & 63;
    {
        const bf16* W = (const bf16*)(ws + WS_WUQ) + (size_t)l * 768 * QR;
        bf16* Qb = (bf16*)(ws + WS_Q);
        gemm_t<true>(W, QR, 768, PROJ + C_CQ, DINP, T, QR, 768 / 128, [](int, int, const f32x16&, int, int, float) {},
            [&](int t, int n, const float4& v) {
                const int b = t / S, s = t % S, h = n / DQK, d = n % DQK;
                float4 o = v;
                const float4 up = make_float4(__shfl(v.x, lane + 4, 64), __shfl(v.y, lane + 4, 64), __shfl(v.z, lane + 4, 64), __shfl(v.w, lane + 4, 64));
                const float4 dn = make_float4(__shfl(v.x, lane - 4, 64), __shfl(v.y, lane - 4, 64), __shfl(v.z, lane - 4, 64), __shfl(v.w, lane - 4, 64));
                if (d >= 64) {
                    const bool first = d < 80;
                    const int f = first ? (d - 64) : (d - 80);
                    const float4 cs0 = *(const float4*)(rope + ((size_t)s * 16 + f) * 2), cs1 = *(const float4*)(rope + ((size_t)s * 16 + f) * 2 + 4);
                    if (first) o = make_float4(v.x * cs0.x - up.x * cs0.y, v.y * cs0.z - up.y * cs0.w, v.z * cs1.x - up.z * cs1.y, v.w * cs1.z - up.w * cs1.w);
                    else       o = make_float4(v.x * cs0.x + dn.x * cs0.y, v.y * cs0.z + dn.y * cs0.w, v.z * cs1.x + dn.z * cs1.y, v.w * cs1.z + dn.w * cs1.w);
                }
                uint2 u; u.x = cvtpk(o.x, o.y); u.y = cvtpk(o.z, o.w);
                *(uint2*)(Qb + ((size_t)(b * NH + h) * S + s) * DQK + d) = u;
            }, [](float ssq) { return rsqrtf(ssq * (1.f / QR) + EPS) * QSCALE; }, lds);
    }
    {
        const bf16* W = (const bf16*)(ws + WS_WUKV) + (size_t)l * 1024 * KVR;
        bf16* Kb = (bf16*)(ws + WS_K); bf16* Vb = (bf16*)(ws + WS_V);
        gemm_t<true>(W, KVR, 1024, PROJ + C_CKV, DINP, T, KVR, 1024 / 128, [](int, int, const f32x16&, int, int, float) {},
            [&](int t, int n, const float4& v) {
                const int b = t / S, s = t % S;
                uint2 u; u.x = cvtpk(v.x, v.y); u.y = cvtpk(v.z, v.w);
                if (n < 512) *(uint2*)(Kb + ((size_t)(b * NH + (n >> 6)) * S + s) * DQK + (n & 63)) = u;
                else         *(uint2*)(Vb + ((size_t)(b * NH + ((n - 512) >> 6)) * S + s) * DV + (n & 63)) = u;
            }, [](float ssq) { return rsqrtf(ssq * (1.f / KVR) + EPS); }, lds);
    }
}
__device__ __forceinline__ void phase_gemm3(const Params& P, int l, char* lds) {
    unsigned char* ws = P.ws;
    const bf16* Yb = (const bf16*)(ws + WS_XN);
    const bf16* W = (const bf16*)(ws + WS_WOUT) + (size_t)l * D * LDW;
    const float* hin = (l == 0) ? P.x : P.out;
    float* out = P.out;
    gemm_t<false>(W, LDW, D, Yb, LDX, T, D, D / 128, [](int, int, const f32x16&, int, int, float) {}, [&](int t, int n, const float4& v) {
        const size_t idx = (size_t)t * D + n;
        const float4 hv = *(const float4*)(hin + idx);
        *(float4*)(out + idx) = make_float4(hv.x + v.x, hv.y + v.y, hv.z + v.z, hv.w + v.w);
    }, [](float) { return 1.f; }, lds);
}

#define GSYNC() do { XcdBarrier xb_; { __attribute__((address_space(1))) char* gp_ = (__attribute__((address_space(1))) char*)(char*)(P.ws + WS_CTL); asm volatile("" : "+s"(gp_)); xb_.bar = (unsigned*)(char*)gp_; } \
    xb_.x = xb_xcc_id(); xb_.st = (volatile LAS unsigned*)&xb_words; xcd_barrier(xb_); } while (0)
#define PHASE(stmt) { const Params Q = launder(P); stmt; }
__global__ void __launch_bounds__(NTHREADS, 2) k_all(Params P) {
    __shared__ __attribute__((aligned(16))) char sm[LDS_TOTAL];
    __shared__ uint4 xb_words;
    cg::grid_group grid = cg::this_grid();
    if (__builtin_amdgcn_workitem_id_x() == 0) xb_words = make_uint4(0u, 0u, 0u, 0u);
    __syncthreads();
    (void)xcd_barrier_post((unsigned*)(P.ws + WS_CTL), (volatile LAS unsigned*)&xb_words);
    __shared__ int xinfo[8];
    if (__builtin_amdgcn_workitem_id_x() == 0) {
        const unsigned x = xb_xcc_id();
        xinfo[XI_X] = (int)x; xinfo[XI_RANK] = (int)xb_add((unsigned*)(P.ws + WS_CTL) + CTL_CENSUS + x, 1u);
    }
    PHASE(phase_prep(Q, sm));
    PHASE(phase_norm(Q.x, Q.norm_mix, (bf16*)(Q.ws + WS_XN)));
    if (P.ws == nullptr) grid.sync();
    GSYNC();
    if (__builtin_amdgcn_workitem_id_x() == 0) {
        unsigned* cen = (unsigned*)(P.ws + WS_CTL) + CTL_CENSUS;
        const int x = xinfo[XI_X]; int nx = 0, jj = 0;
        for (int q = 0; q < 16; ++q) { const unsigned cq = xb_ld(cen + q); if (cq) { if (q < x) ++jj; ++nx; } }
        xinfo[XI_J] = jj; xinfo[XI_NX] = nx; xinfo[XI_NLOC] = (int)xb_ld(cen + x);
    }
    __syncthreads();
    for (int l = 0; l < DEPTH; ++l) {
        PHASE(phase_gemm1(Q, l, sm));
#if PROBE_DUP & 2
        PHASE(phase_gemm1(Q, l, sm));
#endif
        GSYNC();
        PHASE(phase_mixlocal(Q, l, sm));
#if PROBE_DUP & 256
        PHASE(phase_mixlocal(Q, l, sm));
#endif
        PHASE(phase_gemm2(Q, l, sm));
        GSYNC();
        if (l == 0 && blockIdx.x >= (gridDim.x >> 1)) PHASE(phase_tables(Q));
        PHASE(phase_attn(Q, sm));
        if (l == 0 && blockIdx.x < (gridDim.x >> 1)) PHASE(phase_tables(Q));
        GSYNC();
        PHASE(phase_gemm3(Q, l, sm));
#if PROBE_DUP & 16
        if (l == 0) PHASE(phase_gemm3(Q, l, sm));
#endif
        GSYNC();
        PHASE(phase_norm_q(Q, l));
        GSYNC();
        PHASE(phase_route(Q, l, sm));
        GSYNC();
        PHASE(phase_gu(Q, l, xinfo));
        GSYNC();
        PHASE(phase_gw(Q, l));
        GSYNC();
        PHASE(phase_gv(Q, l, xinfo, sm));
        GSYNC();
        PHASE(phase_gnorm(Q, l));
        GSYNC();
    }
}

extern "C" void kernel_launch(void* const* d_in, const int* in_sizes, int n_in, void* d_out, int out_size, void* d_ws, size_t ws_size, hipStream_t stream) {
    static int grid = 0;
    if (grid == 0) {
        if (n_in != 18 || out_size != T * D || ws_size < WS_END) { fprintf(stderr, "kernel_launch: bad sizes n_in %d out %d ws %zu need %zu\n", n_in, out_size, ws_size, (size_t)WS_END); grid = -1; return; }
        int dev = 0, cus = 0, per_cu = 0;
        (void)hipGetDevice(&dev);
        (void)hipDeviceGetAttribute(&cus, hipDeviceAttributeMultiprocessorCount, dev);
        (void)hipOccupancyMaxActiveBlocksPerMultiprocessor(&per_cu, (const void*)k_all, NTHREADS, 0);
        if (per_cu > 2) per_cu = 2;
        if (per_cu < 1) { fprintf(stderr, "kernel_launch: occupancy query says %d\n", per_cu); grid = -1; return; }
        grid = cus * per_cu;
    }
    if (grid < 0) return;
    Params p{};
    p.x = (const float*)d_in[0]; p.norm_mix = (const float*)d_in[1]; p.w_in = (const float*)d_in[2]; p.conv_w = (const float*)d_in[3];
    p.pool_w = (const float*)d_in[4]; p.pool_scale = (const float*)d_in[5]; p.q_norm = (const float*)d_in[6]; p.w_uq = (const float*)d_in[7];
    p.kv_norm = (const float*)d_in[8]; p.w_uk = (const float*)d_in[9]; p.w_uv = (const float*)d_in[10]; p.w_out = (const float*)d_in[11];
    p.norm_ffn = (const float*)d_in[12]; p.peer_wq = (const float*)d_in[13]; p.peer_subkeys = (const float*)d_in[14]; p.peer_u = (const float*)d_in[15];
    p.peer_v = (const float*)d_in[16]; p.norm_final = (const float*)d_in[17];
    p.out = (float*)d_out; p.ws = (unsigned char*)d_ws;
    if (hipMemsetAsync((char*)d_ws + WS_CTL, 0, CTL_BYTES, stream) != hipSuccess) { fprintf(stderr, "kernel_launch: memset failed\n"); return; }
    void* args[] = {&p};
    hipError_t e = hipLaunchCooperativeKernel((const void*)k_all, dim3(grid), dim3(NTHREADS), args, 0, stream);
    if (e != hipSuccess) fprintf(stderr, "cooperative launch failed: %s (grid %d)\n", hipGetErrorString(e), grid);
}
```

```cpp
#include <hip/hip_runtime.h>
#include <hip/hip_cooperative_groups.h>
#include <cstdio>
#include <cstdint>
namespace cg = cooperative_groups;

#ifndef TAB_FP8
#define TAB_FP8 1
#endif
#ifndef PROBE_DUP
#define PROBE_DUP 0
#endif

constexpr int NB = 4, S = 8192, T = NB * S, D = 1024, DEPTH = 2;
constexpr int DIN = 1696, DINP = 1792;
constexpr int C_BG = 0, C_CG = 256, C_HC = 512, C_HP = 768, C_CQ = 1024, C_CKV = 1408, C_KR = 1664;
constexpr int QR = 384, KVR = 256, NH = 8, DQK = 96, DV = 64;
constexpr int PH = 8, NKEY = 128, NEXP = NKEY * NKEY, TOPK = 16, HK = PH * TOPK;
constexpr float EPS = 1e-6f;
constexpr int LDX = 1088;
constexpr int LDW = 1088;

typedef unsigned short bf16;

constexpr size_t WS_CTL   = 0;
constexpr size_t WS_ROPE  = 64 * 1024;
constexpr size_t WS_WIN   = WS_ROPE + (size_t)S * 16 * 2 * 4;
constexpr size_t WS_WUQ   = WS_WIN + (size_t)DEPTH * DINP * LDW * 2;
constexpr size_t WS_WUKV  = WS_WUQ + (size_t)DEPTH * 768 * QR * 2;
constexpr size_t WS_WOUT  = WS_WUKV + (size_t)DEPTH * 1024 * KVR * 2;
constexpr size_t WS_WPQ   = WS_WOUT + (size_t)DEPTH * D * LDW * 2;
constexpr size_t WS_XN    = ((WS_WPQ + (size_t)DEPTH * 2048 * LDW * 2 + 4095) / 4096) * 4096;
constexpr size_t WS_PROJ  = WS_XN + (size_t)T * LDX * 2;
constexpr size_t WS_Q     = WS_PROJ + (size_t)T * DINP * 2;
constexpr size_t WS_K     = WS_Q + (size_t)T * NH * DQK * 2;
constexpr size_t WS_V     = WS_K + (size_t)T * NH * DQK * 2;
constexpr size_t WS_EXP   = WS_V + (size_t)T * NH * DV * 2;
constexpr size_t WS_GATE  = WS_EXP + (size_t)T * HK * 4;
constexpr size_t TAB_ROWB = TAB_FP8 ? 1024 : 2048;
constexpr size_t WS_TABU  = WS_GATE + (size_t)T * HK * 4;
constexpr size_t WS_TABV  = WS_TABU + (size_t)DEPTH * NEXP * TAB_ROWB;
constexpr size_t WS_TSCU  = WS_TABV + (size_t)DEPTH * NEXP * TAB_ROWB;
constexpr size_t WS_TSCV  = WS_TSCU + (size_t)DEPTH * NEXP * 4;
constexpr size_t WS_XQ    = WS_TSCV + (size_t)DEPTH * NEXP * 4;
constexpr size_t WS_XS    = WS_XQ + (size_t)T * D;
constexpr size_t WS_WQ8   = WS_XS + (size_t)T * 4;
constexpr size_t WS_WSC   = WS_WQ8 + (size_t)T * HK;
constexpr size_t WS_END   = WS_WSC + (size_t)T * 4;
static_assert(WS_END <= (size_t)512 * 1024 * 1024, "workspace budget");

struct Params {
    const float* x; const float* norm_mix; const float* w_in; const float* conv_w; const float* pool_w; const float* pool_scale;
    const float* q_norm; const float* w_uq; const float* kv_norm; const float* w_uk; const float* w_uv; const float* w_out;
    const float* norm_ffn; const float* peer_wq; const float* peer_subkeys; const float* peer_u; const float* peer_v; const float* norm_final;
    float* out; unsigned char* ws;
};

__device__ __forceinline__ bf16 f2bf(float f) { unsigned u = __float_as_uint(f); u += 0x7fffu + ((u >> 16) & 1u); return (bf16)(u >> 16); }
__device__ __forceinline__ float bf2f(bf16 h) { return __uint_as_float(((unsigned)h) << 16); }
__device__ __forceinline__ float bflo(unsigned u) { return __uint_as_float(u << 16); }
__device__ __forceinline__ float bfhi(unsigned u) { return __uint_as_float(u & 0xffff0000u); }
__device__ __forceinline__ unsigned pack2(float a, float b) { return (unsigned)f2bf(a) | ((unsigned)f2bf(b) << 16); }
__device__ __forceinline__ float wave_sum(float v) {
#pragma unroll
    for (int m = 32; m >= 1; m >>= 1) v += __shfl_xor(v, m, 64);
    return v;
}
__device__ __forceinline__ float gelu_exact(float x) { return 0.5f * x * (1.f + erff(x * 0.70710678118654752f)); }

#define NTHREADS 256
__device__ __forceinline__ int tidx() { int t = (int)__builtin_amdgcn_workitem_id_x(); asm volatile("" : "+v"(t)); return t; }
__device__ __forceinline__ int gwave() { return blockIdx.x * (NTHREADS / 64) + (tidx() >> 6); }
__device__ __forceinline__ int nwave() { return gridDim.x * (NTHREADS / 64); }
__device__ __forceinline__ size_t gtid() { return (size_t)blockIdx.x * NTHREADS + tidx(); }
__device__ __forceinline__ size_t gnth() { return (size_t)gridDim.x * NTHREADS; }


__device__ __forceinline__ Params launder(const Params& P) {
    typedef __attribute__((address_space(1))) char* gp_t;
    gp_t g[20] = {(gp_t)(char*)P.x, (gp_t)(char*)P.norm_mix, (gp_t)(char*)P.w_in, (gp_t)(char*)P.conv_w, (gp_t)(char*)P.pool_w, (gp_t)(char*)P.pool_scale, (gp_t)(char*)P.q_norm, (gp_t)(char*)P.w_uq,
                  (gp_t)(char*)P.kv_norm, (gp_t)(char*)P.w_uk, (gp_t)(char*)P.w_uv, (gp_t)(char*)P.w_out, (gp_t)(char*)P.norm_ffn, (gp_t)(char*)P.peer_wq, (gp_t)(char*)P.peer_subkeys,
                  (gp_t)(char*)P.peer_u, (gp_t)(char*)P.peer_v, (gp_t)(char*)P.norm_final, (gp_t)(char*)P.out, (gp_t)(char*)P.ws};
    asm volatile("" : "+s"(g[0]), "+s"(g[1]), "+s"(g[2]), "+s"(g[3]), "+s"(g[4]), "+s"(g[5]), "+s"(g[6]), "+s"(g[7]), "+s"(g[8]), "+s"(g[9]));
    asm volatile("" : "+s"(g[10]), "+s"(g[11]), "+s"(g[12]), "+s"(g[13]), "+s"(g[14]), "+s"(g[15]), "+s"(g[16]), "+s"(g[17]), "+s"(g[18]), "+s"(g[19]));
    Params Q;
    Q.x = (const float*)(char*)g[0]; Q.norm_mix = (const float*)(char*)g[1]; Q.w_in = (const float*)(char*)g[2]; Q.conv_w = (const float*)(char*)g[3]; Q.pool_w = (const float*)(char*)g[4];
    Q.pool_scale = (const float*)(char*)g[5]; Q.q_norm = (const float*)(char*)g[6]; Q.w_uq = (const float*)(char*)g[7]; Q.kv_norm = (const float*)(char*)g[8]; Q.w_uk = (const float*)(char*)g[9];
    Q.w_uv = (const float*)(char*)g[10]; Q.w_out = (const float*)(char*)g[11]; Q.norm_ffn = (const float*)(char*)g[12]; Q.peer_wq = (const float*)(char*)g[13]; Q.peer_subkeys = (const float*)(char*)g[14];
    Q.peer_u = (const float*)(char*)g[15]; Q.peer_v = (const float*)(char*)g[16]; Q.norm_final = (const float*)(char*)g[17]; Q.out = (float*)(char*)g[18]; Q.ws = (unsigned char*)(char*)g[19];
    return Q;
}

typedef __attribute__((ext_vector_type(8))) short bf16x8;
typedef __attribute__((ext_vector_type(16))) float f32x16;
typedef __attribute__((ext_vector_type(2))) __bf16 bf2_t;
#define MFMA32(a, b, c) __builtin_amdgcn_mfma_f32_32x32x16_bf16(a, b, c, 0, 0, 0)
__device__ __forceinline__ int crow(int r, int hi) { return (r & 3) + 8 * (r >> 2) + 4 * hi; }
__device__ __forceinline__ float dot2bf(unsigned a, unsigned b, float c) { return __builtin_amdgcn_fdot2_f32_bf16(__builtin_bit_cast(bf2_t, a), __builtin_bit_cast(bf2_t, b), c, false); }
__device__ __forceinline__ unsigned cvtpk(float lo, float hi) { unsigned r; asm("v_cvt_pk_bf16_f32 %0, %1, %2" : "=v"(r) : "v"(lo), "v"(hi)); return r; }
constexpr int G_OPB = 128 * 128;
constexpr int G_BUF = 2 * G_OPB;
constexpr int GEMM_LDS = 2 * G_BUF;
constexpr int LDS_TOTAL = GEMM_LDS + 8192;

template <int WT, bool ROWSS>
__device__ __forceinline__ void gemm_kloop(const bf16* __restrict__ Ag0, int lda, const bf16* __restrict__ Bg0, int ldb, int nk, f32x16 (&acc)[4], float (&ss)[4], char* lds, int tid) {
    const int lane = tid & 63, w = __builtin_amdgcn_readfirstlane(tid >> 6), r32 = lane & 31, hi = lane >> 5;
    const int srow = 8 * w + (lane >> 3);
    const int sch = (lane & 7) ^ ((srow >> 1) & 7);
    const bf16* Ag = Ag0 + (size_t)srow * lda + sch * 8;
    const bf16* Bg = Bg0 + (size_t)srow * ldb + sch * 8;
#pragma unroll
    for (int i = 0; i < 4; ++i)
#pragma unroll
        for (int r = 0; r < 16; ++r) acc[i][r] = 0.f;
    ss[0] = 0.f; ss[1] = 0.f; ss[2] = 0.f; ss[3] = 0.f;
    typedef __attribute__((address_space(3))) unsigned* ldsp_t;
    typedef const __attribute__((address_space(1))) unsigned* glbp_t;
#define G_DMA(buf, kofs) do { char* d_ = lds + (buf) * G_BUF + (8 * w) * 128; \
    _Pragma("unroll") for (int i = 0; i < 4; ++i) { \
        __builtin_amdgcn_global_load_lds((glbp_t)(const void*)(Ag + (size_t)(32 * i) * lda + (kofs)), (ldsp_t)(void*)(d_ + i * 4096), 16, 0, 0); \
        __builtin_amdgcn_global_load_lds((glbp_t)(const void*)(Bg + (size_t)(32 * i) * ldb + (kofs)), (ldsp_t)(void*)(d_ + G_OPB + i * 4096), 16, 0, 0); } } while (0)
    const int xr = (r32 >> 1) & 7;
    const int o0 = ((0 + hi) ^ xr) << 4, o1 = ((2 + hi) ^ xr) << 4, o2 = ((4 + hi) ^ xr) << 4, o3 = ((6 + hi) ^ xr) << 4;
#define G_SS(s_, r_) do { union { bf16x8 v; uint4 u; } c_; c_.v = r_; s_ = dot2bf(c_.u.x, c_.u.x, s_); s_ = dot2bf(c_.u.y, c_.u.y, s_); s_ = dot2bf(c_.u.z, c_.u.z, s_); s_ = dot2bf(c_.u.w, c_.u.w, s_); } while (0)
#define G_STEP(pa, pb, off) do { \
    if (WT == 0) { \
        const bf16x8 a0 = *(const bf16x8*)(pa + off), a1 = *(const bf16x8*)(pa + 32 * 128 + off); \
        const bf16x8 b0 = *(const bf16x8*)(pb + off), b1 = *(const bf16x8*)(pb + 32 * 128 + off); \
        if (ROWSS) { G_SS(ss[0], b0); G_SS(ss[1], b1); } \
        acc[0] = MFMA32(a0, b0, acc[0]); acc[1] = MFMA32(a0, b1, acc[1]); \
        acc[2] = MFMA32(a1, b0, acc[2]); acc[3] = MFMA32(a1, b1, acc[3]); \
    } else { \
        const bf16x8 b0 = *(const bf16x8*)(pb + off); \
        const bf16x8 a0 = *(const bf16x8*)(pa + off), a1 = *(const bf16x8*)(pa + 32 * 128 + off); \
        const bf16x8 a2 = *(const bf16x8*)(pa + 64 * 128 + off), a3 = *(const bf16x8*)(pa + 96 * 128 + off); \
        acc[0] = MFMA32(a0, b0, acc[0]); acc[1] = MFMA32(a1, b0, acc[1]); \
        acc[2] = MFMA32(a2, b0, acc[2]); acc[3] = MFMA32(a3, b0, acc[3]); \
    } } while (0)
    const int arow = (WT == 0) ? ((w >> 1) * 64 + r32) : r32;
    const int brow = (WT == 0) ? ((w & 1) * 64 + r32) : (w * 32 + r32);
    G_DMA(0, 0);
    for (int kt = 0; kt < nk; ++kt) {
        __syncthreads();
        if (kt + 1 < nk) G_DMA((kt + 1) & 1, (kt + 1) * 64);
        const char* pa = lds + (kt & 1) * G_BUF + arow * 128;
        const char* pb = lds + (kt & 1) * G_BUF + G_OPB + brow * 128;
        if (WT == 0) {
#define G_RD(off, A0, A1, B0, B1) do { A0 = *(const bf16x8*)(pa + off); A1 = *(const bf16x8*)(pa + 32 * 128 + off); B0 = *(const bf16x8*)(pb + off); B1 = *(const bf16x8*)(pb + 32 * 128 + off); } while (0)
#define G_MM(A0, A1, B0, B1) do { if (ROWSS) { G_SS(ss[0], B0); G_SS(ss[1], B1); } \
            acc[0] = MFMA32(A0, B0, acc[0]); acc[1] = MFMA32(A0, B1, acc[1]); acc[2] = MFMA32(A1, B0, acc[2]); acc[3] = MFMA32(A1, B1, acc[3]); } while (0)
            bf16x8 xa0, xa1, xb0, xb1, ya0, ya1, yb0, yb1;
            __builtin_amdgcn_s_setprio(1);
            G_RD(o0, xa0, xa1, xb0, xb1);
            G_RD(o1, ya0, ya1, yb0, yb1); __builtin_amdgcn_sched_barrier(0);
            G_MM(xa0, xa1, xb0, xb1); G_RD(o2, xa0, xa1, xb0, xb1); __builtin_amdgcn_sched_barrier(0);
            G_MM(ya0, ya1, yb0, yb1); G_RD(o3, ya0, ya1, yb0, yb1); __builtin_amdgcn_sched_barrier(0);
            G_MM(xa0, xa1, xb0, xb1);
            G_MM(ya0, ya1, yb0, yb1);
            __builtin_amdgcn_s_setprio(0);
#undef G_RD
#undef G_MM
        } else {
            __builtin_amdgcn_s_setprio(1);
            G_STEP(pa, pb, o0); G_STEP(pa, pb, o1); G_STEP(pa, pb, o2); G_STEP(pa, pb, o3);
            __builtin_amdgcn_s_setprio(0);
        }
    }
    if (ROWSS) { ss[0] += __shfl_xor(ss[0], 32, 64); ss[1] += __shfl_xor(ss[1], 32, 64); }
#undef G_DMA
#undef G_SS
#undef G_STEP
}

__device__ __forceinline__ void tile_range(int ntiles, int& lo, int& hi) {
    const int G = gridDim.x, b = blockIdx.x;
    const int vb = ((G & 7) == 0) ? ((b & 7) * (G >> 3) + (b >> 3)) : b;
    const int per = (ntiles + G - 1) / G;
    lo = vb * per; hi = lo + per; if (hi > ntiles) hi = ntiles;
}
constexpr int ST_P = 68;
static_assert(4 * 64 * ST_P * 4 <= LDS_TOTAL, "staging LDS");
template <bool ROWSS, class EPI, class EPIROW, class RSC>
__device__ __forceinline__ void gemm_t(const bf16* __restrict__ Wt, int ldw, int N, const bf16* __restrict__ X, int ldx, int M, int K, int tn_direct, EPI epi, EPIROW epirow, RSC rowscale, char* lds) {
    const int tid = tidx(), lane = tid & 63, w = tid >> 6, r32 = lane & 31, hi = lane >> 5;
    const int tilesN = N / 128, tilesM = M / 128, nk = K / 64;
    int tlo, thi; tile_range(tilesM * tilesN, tlo, thi);
    for (int tile = tlo; tile < thi; ++tile) {
        const int tm = tile / tilesN, tn = tile % tilesN;
        f32x16 acc[4]; float ss[4];
        gemm_kloop<0, ROWSS>(Wt + (size_t)(tn * 128) * ldw, ldw, X + (size_t)(tm * 128) * ldx, ldx, nk, acc, ss, lds, tid);
        if (tn < tn_direct) {
            __syncthreads();
            float* st = (float*)lds + w * (64 * ST_P);
            const float m0_ = rowscale(ss[0]), m1_ = rowscale(ss[1]);
#pragma unroll
            for (int i = 0; i < 2; ++i)
#pragma unroll
                for (int j = 0; j < 2; ++j)
#pragma unroll
                    for (int g = 0; g < 4; ++g) {
                        const float mj = j ? m1_ : m0_;
                        *(float4*)(st + (32 * j + r32) * ST_P + 32 * i + 8 * g + 4 * hi) = make_float4(acc[i * 2 + j][4 * g] * mj, acc[i * 2 + j][4 * g + 1] * mj, acc[i * 2 + j][4 * g + 2] * mj, acc[i * 2 + j][4 * g + 3] * mj);
                    }
            const int rr = lane >> 4, ch = lane & 15;
#pragma unroll 4
            for (int it = 0; it < 16; ++it) {
                const int row = it * 4 + rr;
                const float4 v = *(const float4*)(st + row * ST_P + ch * 4);
                epirow(tm * 128 + (w & 1) * 64 + row, tn * 128 + (w >> 1) * 64 + ch * 4, v);
            }
        } else {
#pragma unroll
            for (int i = 0; i < 2; ++i)
#pragma unroll
                for (int j = 0; j < 2; ++j) {
                    const int tl = (w & 1) * 64 + j * 32;
                    epi(tn * 128 + (w >> 1) * 64 + i * 32, tm * 128 + tl, acc[i * 2 + j], r32, hi, ss[j]);
                }
        }
        __syncthreads();
    }
}

__device__ __forceinline__ void transpose_tiled(const float* __restrict__ W, bf16* __restrict__ Wt, int K, int N, int Npad, int ldk, const float* __restrict__ gain, char* lds) {
    float (*tl)[65] = (float (*)[65])lds;
    const int tid = tidx(), a = tid & 63, q = tid >> 6;
    const int tK = K / 64, tN = Npad / 64;
    for (int tile = blockIdx.x; tile < tK * tN; tile += gridDim.x) {
        const int k0 = (tile / tN) * 64, n0 = (tile % tN) * 64;
#pragma unroll 4
        for (int i = 0; i < 16; ++i) {
            const int k = k0 + q * 16 + i, n = n0 + a;
            float v = (n < N) ? W[(size_t)k * N + n] : 0.f;
            if (gain) v *= gain[k];
            tl[q * 16 + i][a] = v;
        }
        __syncthreads();
#pragma unroll 4
        for (int i = 0; i < 16; ++i) { const int nl = q * 16 + i; Wt[(size_t)(n0 + nl) * ldk + k0 + a] = f2bf(tl[a][nl]); }
        __syncthreads();
    }
}

__device__ __forceinline__ void quant_row(const float4 (&v)[4], unsigned char* __restrict__ dst, float* __restrict__ scl, int r, int lane) {
    float am = 0.f;
#pragma unroll
    for (int j = 0; j < 4; ++j) am = fmaxf(am, fmaxf(fmaxf(fabsf(v[j].x), fabsf(v[j].y)), fmaxf(fabsf(v[j].z), fabsf(v[j].w))));
#pragma unroll
    for (int m = 32; m >= 1; m >>= 1) am = fmaxf(am, __shfl_xor(am, m, 64));
    const float sc = (am > 0.f) ? am * (1.f / 448.f) : 1.f;
    const float is = 1.f / sc;
    uint4 o;
    { int w = 0; w = __builtin_amdgcn_cvt_pk_fp8_f32(v[0].x * is, v[0].y * is, w, false); w = __builtin_amdgcn_cvt_pk_fp8_f32(v[0].z * is, v[0].w * is, w, true); o.x = (unsigned)w; }
    { int w = 0; w = __builtin_amdgcn_cvt_pk_fp8_f32(v[1].x * is, v[1].y * is, w, false); w = __builtin_amdgcn_cvt_pk_fp8_f32(v[1].z * is, v[1].w * is, w, true); o.y = (unsigned)w; }
    { int w = 0; w = __builtin_amdgcn_cvt_pk_fp8_f32(v[2].x * is, v[2].y * is, w, false); w = __builtin_amdgcn_cvt_pk_fp8_f32(v[2].z * is, v[2].w * is, w, true); o.z = (unsigned)w; }
    { int w = 0; w = __builtin_amdgcn_cvt_pk_fp8_f32(v[3].x * is, v[3].y * is, w, false); w = __builtin_amdgcn_cvt_pk_fp8_f32(v[3].z * is, v[3].w * is, w, true); o.w = (unsigned)w; }
    { const int lay = r / NEXP, e = r % NEXP; *(uint4*)(dst + (((size_t)(lay * 8 + (lane >> 3)) * NEXP + e) * 128) + (lane & 7) * 16) = o; }
    if (lane == 0) scl[r] = sc;
}
__device__ __forceinline__ unsigned pack_i8x4(float a, float b, float c, float d) {
    const int ia = __float2int_rn(a), ib = __float2int_rn(b), ic = __float2int_rn(c), id = __float2int_rn(d);
    return (unsigned)(ia & 255) | ((unsigned)(ib & 255) << 8) | ((unsigned)(ic & 255) << 16) | ((unsigned)(id & 255) << 24);
}
__device__ __forceinline__ void quant_row_i8(const float4 (&v)[4], unsigned char* __restrict__ dst, float* __restrict__ scl, int r, int lane) {
    float am = 0.f;
#pragma unroll
    for (int j = 0; j < 4; ++j) am = fmaxf(am, fmaxf(fmaxf(fabsf(v[j].x), fabsf(v[j].y)), fmaxf(fabsf(v[j].z), fabsf(v[j].w))));
#pragma unroll
    for (int m = 32; m >= 1; m >>= 1) am = fmaxf(am, __shfl_xor(am, m, 64));
    const float sc = (am > 0.f) ? am * (1.f / 127.f) : 1.f;
    const float is = 1.f / sc;
    uint4 o;
    o.x = pack_i8x4(v[0].x * is, v[0].y * is, v[0].z * is, v[0].w * is); o.y = pack_i8x4(v[1].x * is, v[1].y * is, v[1].z * is, v[1].w * is);
    o.z = pack_i8x4(v[2].x * is, v[2].y * is, v[2].z * is, v[2].w * is); o.w = pack_i8x4(v[3].x * is, v[3].y * is, v[3].z * is, v[3].w * is);
    { const int lay = r / NEXP, e = r % NEXP; *(uint4*)(dst + (((size_t)(lay * 8 + (lane >> 3)) * NEXP + e) * 128) + (lane & 7) * 16) = o; }
    if (lane == 0) scl[r] = sc;
}
template <bool I8>
__device__ __forceinline__ void convert_table(const float* __restrict__ src, unsigned char* __restrict__ dst, float* __restrict__ scl, int rows) {
    static_assert(TAB_FP8, "fp8 tables");
    const int lane = tidx() & 63;
    const int nw = nwave();
    for (int r = gwave(); r < rows; r += 4 * nw) {
        float4 v[4][4]; int rr[4];
#pragma unroll
        for (int u = 0; u < 4; ++u) {
            rr[u] = (r + u * nw < rows) ? (r + u * nw) : r;
            const float4* s0 = (const float4*)(src + (size_t)rr[u] * D);
#pragma unroll
            for (int j = 0; j < 4; ++j) v[u][j] = s0[lane * 4 + j];
        }
#pragma unroll
        for (int u = 0; u < 4; ++u) {
            if (u == 0 || rr[u] != r) { if (I8) quant_row_i8(v[u], dst, scl, rr[u], lane); else quant_row(v[u], dst, scl, rr[u], lane); }
        }
    }
}
__device__ __forceinline__ void phase_prep(const Params& P, char* lds) {
    unsigned char* ws = P.ws;
    for (int l = 0; l < DEPTH; ++l) {
        transpose_tiled(P.w_in + (size_t)l * D * DIN, (bf16*)(ws + WS_WIN) + (size_t)l * DINP * LDW, D, DIN, DINP, LDW, nullptr, lds);
        transpose_tiled(P.w_uq + (size_t)l * QR * 768, (bf16*)(ws + WS_WUQ) + (size_t)l * 768 * QR, QR, 768, 768, QR, P.q_norm + l * QR, lds);
        transpose_tiled(P.w_uk + (size_t)l * KVR * 512, (bf16*)(ws + WS_WUKV) + (size_t)l * 1024 * KVR, KVR, 512, 512, KVR, P.kv_norm + l * KVR, lds);
        transpose_tiled(P.w_uv + (size_t)l * KVR * 512, (bf16*)(ws + WS_WUKV) + (size_t)l * 1024 * KVR + (size_t)512 * KVR, KVR, 512, 512, KVR, P.kv_norm + l * KVR, lds);
        transpose_tiled(P.w_out + (size_t)l * D * D, (bf16*)(ws + WS_WOUT) + (size_t)l * D * LDW, D, D, D, LDW, nullptr, lds);
    }
    {
        bf16* Wc = (bf16*)(ws + WS_WPQ);
        float (*As)[68] = (float (*)[68])lds;
        float (*Bs)[68] = (float (*)[68])(lds + 16 * 68 * 4);
        const int tid = tidx(), tx = tid & 15, ty = tid >> 4;
        const int lr = tid >> 2, ld4 = (tid & 3) * 4;
        for (int tile = blockIdx.x; tile < (DEPTH * 2048 / 64) * (D / 64); tile += gridDim.x) {
            const int row0 = (tile >> 4) * 64, k0 = (tile & 15) * 64;
            const int l = row0 >> 11, hp = (row0 >> 7) & 15, n0 = row0 & 127;
            const float* skp = P.peer_subkeys + (((size_t)l * 2 + (hp & 1)) * NKEY + n0 + lr) * 128 + ld4;
            const float* wqp = P.peer_wq + ((size_t)l * D + k0 + lr) * 2048 + hp * 128 + ld4;
            float acc[4][4];
#pragma unroll
            for (int i = 0; i < 4; ++i)
#pragma unroll
                for (int j = 0; j < 4; ++j) acc[i][j] = 0.f;
            for (int d0 = 0; d0 < 128; d0 += 16) {
                const float4 av = *(const float4*)(skp + d0), bv = *(const float4*)(wqp + d0);
                As[ld4 + 0][lr] = av.x; As[ld4 + 1][lr] = av.y; As[ld4 + 2][lr] = av.z; As[ld4 + 3][lr] = av.w;
                Bs[ld4 + 0][lr] = bv.x; Bs[ld4 + 1][lr] = bv.y; Bs[ld4 + 2][lr] = bv.z; Bs[ld4 + 3][lr] = bv.w;
                __syncthreads();
#pragma unroll
                for (int kk = 0; kk < 16; ++kk) {
                    const float4 a4 = *(const float4*)&As[kk][ty * 4], b4 = *(const float4*)&Bs[kk][tx * 4];
                    const float aa[4] = {a4.x, a4.y, a4.z, a4.w}, bb[4] = {b4.x, b4.y, b4.z, b4.w};
#pragma unroll
                    for (int i = 0; i < 4; ++i)
#pragma unroll
                        for (int j = 0; j < 4; ++j) acc[i][j] = fmaf(aa[i], bb[j], acc[i][j]);
                }
                __syncthreads();
            }
#pragma unroll
            for (int i = 0; i < 4; ++i) {
                uint2 o; o.x = pack2(acc[i][0], acc[i][1]); o.y = pack2(acc[i][2], acc[i][3]);
                *(uint2*)(Wc + (size_t)(row0 + ty * 4 + i) * LDW + k0 + tx * 4) = o;
            }
        }
    }
    float* rope = (float*)(ws + WS_ROPE);
    for (size_t i = gtid(); i < (size_t)S * 16; i += gnth()) {
        const int s = (int)(i >> 4), f = (int)(i & 15);
        const double inv = pow(10000.0, -(double)f / 16.0);
        const double ang = (double)s * inv;
        rope[2 * i] = (float)cos(ang); rope[2 * i + 1] = (float)sin(ang);
    }
}

__device__ __forceinline__ void phase_tables(const Params& P) {
    convert_table<true>(P.peer_u, P.ws + WS_TABU, (float*)(P.ws + WS_TSCU), DEPTH * NEXP);
    convert_table<false>(P.peer_v, P.ws + WS_TABV, (float*)(P.ws + WS_TSCV), DEPTH * NEXP);
}

__device__ __forceinline__ void phase_norm(const float* __restrict__ h, const float* __restrict__ g, bf16* __restrict__ xn) {
    const int lane = tidx() & 63, nw = nwave();
    for (int t = gwave(); t < T; t += 2 * nw) {
        const int t2 = (t + nw < T) ? (t + nw) : t;
        float4 v[2][4];
#pragma unroll
        for (int j = 0; j < 4; ++j) { v[0][j] = ((const float4*)(h + (size_t)t * D))[j * 64 + lane]; v[1][j] = ((const float4*)(h + (size_t)t2 * D))[j * 64 + lane]; }
#pragma unroll
        for (int u = 0; u < 2; ++u) {
            float ss = 0.f;
#pragma unroll
            for (int j = 0; j < 4; ++j) ss += v[u][j].x * v[u][j].x + v[u][j].y * v[u][j].y + v[u][j].z * v[u][j].z + v[u][j].w * v[u][j].w;
            ss = wave_sum(ss);
            const float r = rsqrtf(ss * (1.f / D) + EPS);
            const int tt = u ? t2 : t;
            if (u == 0 || t2 != t) {
#pragma unroll
                for (int j = 0; j < 4; ++j) {
                    const float4 gg = ((const float4*)g)[j * 64 + lane];
                    uint2 o; o.x = pack2(v[u][j].x * r * gg.x, v[u][j].y * r * gg.y); o.y = pack2(v[u][j].z * r * gg.z, v[u][j].w * r * gg.w);
                    ((uint2*)(xn + (size_t)tt * LDX))[j * 64 + lane] = o;
                }
            }
        }
    }
}

__device__ __forceinline__ void phase_norm_q(const Params& P, int l) {
    const int lane = tidx() & 63, nw = nwave();
    const float* g = P.norm_ffn + l * D;
    bf16* xn = (bf16*)(P.ws + WS_XN);
    unsigned* xq = (unsigned*)(P.ws + WS_XQ);
    float* xsc = (float*)(P.ws + WS_XS);
    for (int t = gwave(); t < T; t += 2 * nw) {
        const int t2 = (t + nw < T) ? (t + nw) : t;
        float4 v[2][4];
#pragma unroll
        for (int j = 0; j < 4; ++j) { v[0][j] = ((const float4*)(P.out + (size_t)t * D))[j * 64 + lane]; v[1][j] = ((const float4*)(P.out + (size_t)t2 * D))[j * 64 + lane]; }
#pragma unroll
        for (int u = 0; u < 2; ++u) {
            float ss = 0.f;
#pragma unroll
            for (int j = 0; j < 4; ++j) ss += v[u][j].x * v[u][j].x + v[u][j].y * v[u][j].y + v[u][j].z * v[u][j].z + v[u][j].w * v[u][j].w;
            ss = wave_sum(ss);
            const float r = rsqrtf(ss * (1.f / D) + EPS);
            const int tt = u ? t2 : t;
            if (u == 0 || t2 != t) {
                float am = 0.f;
#pragma unroll
                for (int j = 0; j < 4; ++j) {
                    const float4 gg = ((const float4*)g)[j * 64 + lane];
                    v[u][j].x *= r * gg.x; v[u][j].y *= r * gg.y; v[u][j].z *= r * gg.z; v[u][j].w *= r * gg.w;
                    am = fmaxf(am, fmaxf(fmaxf(fabsf(v[u][j].x), fabsf(v[u][j].y)), fmaxf(fabsf(v[u][j].z), fabsf(v[u][j].w))));
                    uint2 o; o.x = pack2(v[u][j].x, v[u][j].y); o.y = pack2(v[u][j].z, v[u][j].w);
                    ((uint2*)(xn + (size_t)tt * LDX))[j * 64 + lane] = o;
                }
#pragma unroll
                for (int m = 32; m >= 1; m >>= 1) am = fmaxf(am, __shfl_xor(am, m, 64));
                const float sc = (am > 0.f) ? am * (1.f / 127.f) : 1.f, is = 1.f / sc;
#pragma unroll
                for (int j = 0; j < 4; ++j) xq[(size_t)tt * (D / 4) + j * 64 + lane] = pack_i8x4(v[u][j].x * is, v[u][j].y * is, v[u][j].z * is, v[u][j].w * is);
                if (lane == 0) xsc[tt] = sc;
            }
        }
    }
}

__device__ __forceinline__ void phase_mixlocal(const Params& P, int l, char* lds) {
    const bf16* proj = (const bf16*)(P.ws + WS_PROJ);
    bf16* Y = (bf16*)(P.ws + WS_XN);
    const int tid = tidx();
    {
        const float* cw = P.conv_w + (size_t)l * 3 * 256;
        for (size_t i = gtid(); i < (size_t)T * 32; i += gnth()) {
            const int t = (int)(i >> 5), c0 = (int)(i & 31) * 8, s = t & (S - 1);
            const bf16* pr = proj + (size_t)t * DINP;
            float acc[8];
#pragma unroll
            for (int e = 0; e < 8; ++e) acc[e] = 0.f;
#pragma unroll
            for (int j = 0; j < 3; ++j) {
                if (s - 2 + j >= 0) {
                    const bf16* pp = pr - (size_t)(2 - j) * DINP;
                    const uint4 g = *(const uint4*)(pp + C_CG + c0), hc = *(const uint4*)(pp + C_HC + c0);
                    const float4 w0 = *(const float4*)(cw + j * 256 + c0), w1 = *(const float4*)(cw + j * 256 + c0 + 4);
                    acc[0] = fmaf(w0.x, bflo(g.x) * bflo(hc.x), acc[0]); acc[1] = fmaf(w0.y, bfhi(g.x) * bfhi(hc.x), acc[1]);
                    acc[2] = fmaf(w0.z, bflo(g.y) * bflo(hc.y), acc[2]); acc[3] = fmaf(w0.w, bfhi(g.y) * bfhi(hc.y), acc[3]);
                    acc[4] = fmaf(w1.x, bflo(g.z) * bflo(hc.z), acc[4]); acc[5] = fmaf(w1.y, bfhi(g.z) * bfhi(hc.z), acc[5]);
                    acc[6] = fmaf(w1.z, bflo(g.w) * bflo(hc.w), acc[6]); acc[7] = fmaf(w1.w, bfhi(g.w) * bfhi(hc.w), acc[7]);
                }
            }
            const uint4 bg = *(const uint4*)(pr + C_BG + c0);
            uint4 o;
            o.x = pack2(bflo(bg.x) * acc[0], bfhi(bg.x) * acc[1]); o.y = pack2(bflo(bg.y) * acc[2], bfhi(bg.y) * acc[3]);
            o.z = pack2(bflo(bg.z) * acc[4], bfhi(bg.z) * acc[5]); o.w = pack2(bflo(bg.w) * acc[6], bfhi(bg.w) * acc[7]);
            *(uint4*)(Y + (size_t)t * LDX + c0) = o;
        }
    }
    {
        float (*pl)[68] = (float (*)[68])lds;
        const float* pw = P.pool_w + (size_t)l * 4 * 64 * 64;
        const float* psc = P.pool_scale + l * 256;
        const int a = tid & 63, q = tid >> 6;
        for (int tile = blockIdx.x; tile < (T / 64) * 4; tile += gridDim.x) {
            const int g = tile & 3, t0 = (tile >> 2) * 64;
            const int w = 2 << g;
            {
                const bf16* col = proj + C_HP + g * 64 + a;
                const int tf = t0 + q * 16, sf = tf & (S - 1);
                float xr[31];
#pragma unroll
                for (int d = 1; d <= 15; ++d) xr[15 - d] = (d < w && sf - d >= 0) ? bf2f(col[(size_t)(tf - d) * DINP]) : 0.f;
#pragma unroll
                for (int i = 0; i < 16; ++i) xr[15 + i] = bf2f(col[(size_t)(tf + i) * DINP]);
                float sum = 0.f;
#pragma unroll
                for (int d = 1; d <= 15; ++d) sum += xr[15 - d];
#pragma unroll
                for (int i = 0; i < 16; ++i) {
                    const int s = sf + i;
                    sum += xr[15 + i];
                    const int cnt = (s + 1 < w) ? (s + 1) : w;
                    pl[q * 16 + i][a] = sum / (float)cnt - xr[15 + i];
                    const int o = 15 + i + 1;
                    const float old = (g == 0) ? xr[o - 2] : (g == 1) ? xr[o - 4] : (g == 2) ? xr[o - 8] : xr[o - 16];
                    sum -= old;
                }
            }
            __syncthreads();
            {
                float pc[64];
#pragma unroll
                for (int c = 0; c < 64; ++c) pc[c] = pw[(g * 64 + c) * 64 + a];
                const float sc = psc[g * 64 + a];
#pragma unroll 2
                for (int i = 0; i < 16; ++i) {
                    const float4* row = (const float4*)&pl[q * 16 + i][0];
                    float m0 = 0.f, m1 = 0.f;
#pragma unroll
                    for (int c4 = 0; c4 < 16; ++c4) { const float4 v = row[c4]; m0 = fmaf(v.x, pc[4 * c4], m0); m1 = fmaf(v.y, pc[4 * c4 + 1], m1); m0 = fmaf(v.z, pc[4 * c4 + 2], m0); m1 = fmaf(v.w, pc[4 * c4 + 3], m1); }
                    Y[(size_t)(t0 + q * 16 + i) * LDX + 256 + g * 64 + a] = f2bf((m0 + m1) * sc);
                }
            }
            __syncthreads();
        }
    }
}

typedef short v4i16_t __attribute__((ext_vector_type(4)));
typedef __attribute__((address_space(3))) v4i16_t* lds_v4p;
__device__ __forceinline__ v4i16_t vtr(const char* p) { return __builtin_amdgcn_ds_read_tr16_b64_v4i16((lds_v4p)p); }
constexpr int A_KP = 208, A_VP = 192;
constexpr int A_KB = 64 * A_KP, A_VB = 64 * A_VP, A_BUF = A_KB + A_VB, ATTN_LDS = 2 * A_BUF;
static_assert(ATTN_LDS <= GEMM_LDS, "attention LDS");

__device__ __forceinline__ void attn_unit(const bf16* __restrict__ Qb, const bf16* __restrict__ Kb, const bf16* __restrict__ Vb, bf16* __restrict__ Y, int bh, int qblk, char* lds) {
    const int tid = tidx(), lane = tid & 63, w = tid >> 6, r32 = lane & 31, hi = lane >> 5;
    const int q0 = qblk * 128, qw0 = q0 + w * 32;
    const int NT = 2 * qblk + 2;
    bf16x8 qf[6];
    {
        const bf16* qp = Qb + ((size_t)bh * S + qw0 + r32) * DQK + hi * 8;
#pragma unroll
        for (int ks = 0; ks < 6; ++ks) qf[ks] = *(const bf16x8*)(qp + ks * 16);
    }
    f32x16 o0, o1;
#pragma unroll
    for (int r = 0; r < 16; ++r) { o0[r] = 0.f; o1[r] = 0.f; }
    float m = -1e30f, lsum = 0.f;
    const char* Kg = (const char*)(Kb + (size_t)bh * S * DQK) + tid * 16;
    const char* Vg = (const char*)(Vb + (size_t)bh * S * DV) + tid * 16;
    const int kl0 = (tid / 12) * A_KP + (tid % 12) * 16, kl1 = ((tid + 256) / 12) * A_KP + ((tid + 256) % 12) * 16, kl2 = ((tid + 512) / 12) * A_KP + ((tid + 512) % 12) * 16;
    const int vl0 = (tid >> 3) * A_VP + (tid & 7) * 16, vl1 = vl0 + 32 * A_VP;
    uint4 pk0, pk1, pk2, pv0, pv1, qk0, qk1, qk2, qv0, qv1;
#define A_LOAD(S, t) do { const char* kg = Kg + (size_t)(t) * (64 * 192); const char* vg = Vg + (size_t)(t) * (64 * 128); \
        S##k0 = *(const uint4*)(kg); S##k1 = *(const uint4*)(kg + 4096); S##k2 = *(const uint4*)(kg + 8192); S##v0 = *(const uint4*)(vg); S##v1 = *(const uint4*)(vg + 4096); } while (0)
#define A_STORE(S, bK, bV) do { *(uint4*)(bK + kl0) = S##k0; *(uint4*)(bK + kl1) = S##k1; *(uint4*)(bK + kl2) = S##k2; *(uint4*)(bV + vl0) = S##v0; *(uint4*)(bV + vl1) = S##v1; } while (0)
#define A_PV(pf, kofs) do { \
            { const v4i16_t lo = vtr(pv + (kofs) * A_VP), hh = vtr(pv + ((kofs) + 8) * A_VP); const bf16x8 vf = {lo[0], lo[1], lo[2], lo[3], hh[0], hh[1], hh[2], hh[3]}; o0 = MFMA32(vf, pf.v, o0); } \
            { const v4i16_t lo = vtr(pv + (kofs) * A_VP + 64), hh = vtr(pv + ((kofs) + 8) * A_VP + 64); const bf16x8 vf = {lo[0], lo[1], lo[2], lo[3], hh[0], hh[1], hh[2], hh[3]}; o1 = MFMA32(vf, pf.v, o1); } } while (0)
    const int pvo = (4 * hi + ((lane & 15) >> 2)) * A_VP + (16 * ((lane >> 4) & 1) + 4 * (lane & 3)) * 2;
    A_LOAD(p, 0); A_LOAD(q, 1);
    for (int t2 = 0; t2 < NT; t2 += 2) {
#pragma unroll
        for (int half = 0; half < 2; ++half) {
            const int t = t2 + half;
            char* bK = lds + half * A_BUF; char* bV = bK + A_KB;
            if (half == 0) A_STORE(p, bK, bV); else A_STORE(q, bK, bV);
            __syncthreads();
            { const int tn = (t + 2 < NT) ? (t + 2) : (NT - 2 + half); if (half == 0) A_LOAD(p, tn); else A_LOAD(q, tn); }
        const int kt0 = t * 64;
        if (kt0 <= qw0) {
            f32x16 s0, s1;
#pragma unroll
            for (int r = 0; r < 16; ++r) { s0[r] = 0.f; s1[r] = 0.f; }
            const char* pk = bK + r32 * A_KP + hi * 16;
            __builtin_amdgcn_s_setprio(1);
#pragma unroll
            for (int ks = 0; ks < 6; ++ks) {
                const bf16x8 a0 = *(const bf16x8*)(pk + ks * 32), a1 = *(const bf16x8*)(pk + 32 * A_KP + ks * 32);
                s0 = MFMA32(a0, qf[ks], s0); s1 = MFMA32(a1, qf[ks], s1);
            }
            __builtin_amdgcn_s_setprio(0);
            if (kt0 + 63 > qw0) {
                const int qrow = qw0 + r32;
#pragma unroll
                for (int r = 0; r < 16; ++r) { const int key = kt0 + crow(r, hi); if (key > qrow) s0[r] = -INFINITY; if (key + 32 > qrow) s1[r] = -INFINITY; }
            }
            float mx = fmaxf(s0[0], s1[0]);
#pragma unroll
            for (int r = 1; r < 16; ++r) mx = fmaxf(mx, fmaxf(s0[r], s1[r]));
            mx = fmaxf(mx, __shfl_xor(mx, 32, 64));
            const float mn = fmaxf(m, mx), m_prev = m;
            const float alpha = __builtin_amdgcn_exp2f(m - mn);
            m = mn;
            float ps = 0.f;
#pragma unroll
            for (int r = 0; r < 16; ++r) { s0[r] = __builtin_amdgcn_exp2f(s0[r] - mn); s1[r] = __builtin_amdgcn_exp2f(s1[r] - mn); ps += s0[r] + s1[r]; }
            if (__builtin_amdgcn_ballot_w64(mn > m_prev) != 0ull) {
                lsum *= alpha;
#pragma unroll
                for (int r = 0; r < 16; ++r) { o0[r] *= alpha; o1[r] *= alpha; }
            }
            lsum += ps;
            union { unsigned u[4]; bf16x8 v; } p00, p01, p10, p11;
#pragma unroll
            for (int j = 0; j < 4; ++j) { p00.u[j] = cvtpk(s0[2 * j], s0[2 * j + 1]); p01.u[j] = cvtpk(s0[8 + 2 * j], s0[9 + 2 * j]); p10.u[j] = cvtpk(s1[2 * j], s1[2 * j + 1]); p11.u[j] = cvtpk(s1[8 + 2 * j], s1[9 + 2 * j]); }
            const char* pv = bV + pvo;
            __builtin_amdgcn_s_setprio(1);
            A_PV(p00, 0); A_PV(p01, 16); A_PV(p10, 32); A_PV(p11, 48);
            __builtin_amdgcn_s_setprio(0);
        }
        }
    }
    lsum += __shfl_xor(lsum, 32, 64);
    const float inv = 1.f / lsum;
    const int b = bh >> 3, h = bh & 7;
    bf16* yo = Y + (size_t)(b * S + qw0 + r32) * LDX + 512 + h * 64 + 4 * hi;
#pragma unroll
    for (int g = 0; g < 4; ++g) {
        uint2 a, c;
        a.x = cvtpk(o0[4 * g] * inv, o0[4 * g + 1] * inv); a.y = cvtpk(o0[4 * g + 2] * inv, o0[4 * g + 3] * inv);
        c.x = cvtpk(o1[4 * g] * inv, o1[4 * g + 1] * inv); c.y = cvtpk(o1[4 * g + 2] * inv, o1[4 * g + 3] * inv);
        *(uint2*)(yo + 8 * g) = a; *(uint2*)(yo + 32 + 8 * g) = c;
    }
    __syncthreads();
}
__device__ __forceinline__ void phase_attn(const Params& P, char* lds) {
    const bf16* Qb = (const bf16*)(P.ws + WS_Q);
    const bf16* Kb = (const bf16*)(P.ws + WS_K);
    const bf16* Vb = (const bf16*)(P.ws + WS_V);
    bf16* Y = (bf16*)(P.ws + WS_XN);
    for (int u = blockIdx.x; u < NB * NH * (S / 128); u += gridDim.x) {
        const int bh = u & 31, v = u >> 5;
        const int qblk = (v < 16) ? (63 - v) : (v < 32) ? (v - 16) : (v < 48) ? (79 - v) : (v - 32);
        attn_unit(Qb, Kb, Vb, Y, bh, qblk, lds);
    }
}

#define NET_HD __device__ __forceinline__
#define NET_U2F(u) __uint_as_float(u)
#define NET_F2U(f) __float_as_uint(f)
#define CE_DESC(a, b) do { const float hi__ = fmaxf(a, b), lo__ = fminf(a, b); a = hi__; b = lo__; } while (0)
NET_HD void sort16_desc(float (&v)[16]) {
#define CE2(a, b) CE_DESC(v[a], v[b])
    CE2(0,13); CE2(1,12); CE2(2,15); CE2(3,14); CE2(4,8); CE2(5,6); CE2(7,11); CE2(9,10);
    CE2(0,5); CE2(1,7); CE2(2,9); CE2(3,4); CE2(6,13); CE2(8,14); CE2(10,15); CE2(11,12);
    CE2(0,1); CE2(2,3); CE2(4,5); CE2(6,8); CE2(7,9); CE2(10,11); CE2(12,13); CE2(14,15);
    CE2(0,2); CE2(1,3); CE2(4,10); CE2(5,11); CE2(6,7); CE2(8,9); CE2(12,14); CE2(13,15);
    CE2(1,2); CE2(3,12); CE2(4,6); CE2(5,7); CE2(8,10); CE2(9,11); CE2(13,14);
    CE2(1,4); CE2(2,6); CE2(5,8); CE2(7,10); CE2(9,13); CE2(11,14);
    CE2(2,4); CE2(3,6); CE2(9,12); CE2(11,13);
    CE2(3,5); CE2(6,8); CE2(7,9); CE2(10,12);
    CE2(3,4); CE2(5,6); CE2(7,8); CE2(9,10); CE2(11,12);
    CE2(6,7); CE2(8,9);
#undef CE2
}
NET_HD void merge16_desc(float (&a)[16], const float (&b)[16]) {
#pragma unroll
    for (int i = 0; i < 16; ++i) a[i] = fmaxf(a[i], b[15 - i]);
#pragma unroll
    for (int j = 8; j > 0; j >>= 1) {
#pragma unroll
        for (int i = 0; i < 16; ++i) { const int l = i ^ j; if (l > i) CE_DESC(a[i], a[l]); }
    }
}
NET_HD void top16_of_64(float (&g0)[16], float (&g1)[16], float (&g2)[16], float (&g3)[16]) {
    sort16_desc(g0); sort16_desc(g1); sort16_desc(g2); sort16_desc(g3);
    merge16_desc(g0, g1); merge16_desc(g2, g3); merge16_desc(g0, g2);
}
NET_HD float u2f(unsigned u) { return NET_U2F(u); }
NET_HD unsigned f2u(float f) { return NET_F2U(f); }
template <class V16>
NET_HD void lane_top16(const V16& s0, const V16& s1, const V16& s2, const V16& s3, int hi, float (&out)[16]) {
    float g0[16], g1[16], g2[16], g3[16];
#pragma unroll
    for (int r = 0; r < 16; ++r) {
        const unsigned nb = (unsigned)((r & 3) + 8 * (r >> 2));
        g0[r] = u2f((f2u(s0[r]) & 0xFFFFFF80u) | nb); g1[r] = u2f((f2u(s1[r]) & 0xFFFFFF80u) | (nb + 32u));
        g2[r] = u2f((f2u(s2[r]) & 0xFFFFFF80u) | (nb + 64u)); g3[r] = u2f((f2u(s3[r]) & 0xFFFFFF80u) | (nb + 96u));
    }
    top16_of_64(g0, g1, g2, g3);
    const unsigned h4 = (unsigned)hi << 2;
#pragma unroll
    for (int i = 0; i < 16; ++i) out[i] = u2f(f2u(g0[i]) | h4);
}
constexpr int cand_slot(int a, int b) { int n = 0; for (int x = 0; x < 16; ++x) for (int y = 0; y < 16; ++y) { if (x == a && y == b) return n; if ((x + 1) * (y + 1) <= 16) ++n; } return n; }
NET_HD void cand_top16(const float (&s1)[16], const float (&s2)[16], float (&c)[16]) {
    float g0[16], g1[16], g2[16], g3[16];
#pragma unroll
    for (int i = 0; i < 16; ++i) { g0[i] = -3.0e38f; g1[i] = -3.0e38f; g2[i] = -3.0e38f; g3[i] = -3.0e38f; }
#pragma unroll
    for (int a = 0; a < 16; ++a) {
#pragma unroll
        for (int b = 0; b < 16; ++b) {
            if ((a + 1) * (b + 1) <= 16) {
                const int sl = cand_slot(a, b);
                const float v = u2f((f2u(s1[a] + s2[b]) & 0xFFFFFF00u) | (unsigned)(a * 16 + b));
                if (sl < 16) g0[sl & 15] = v; else if (sl < 32) g1[sl & 15] = v; else if (sl < 48) g2[sl & 15] = v; else g3[sl & 15] = v;
            }
        }
    }
    top16_of_64(g0, g1, g2, g3);
#pragma unroll
    for (int i = 0; i < 16; ++i) c[i] = g0[i];
}

__device__ __forceinline__ void phase_route(const Params& P, int l, char* lds) {
    const bf16* XN = (const bf16*)(P.ws + WS_XN);
    const bf16* Wc = (const bf16*)(P.ws + WS_WPQ) + (size_t)l * 2048 * LDW;
    int* EXPp = (int*)(P.ws + WS_EXP);
    float* GATEp = (float*)(P.ws + WS_GATE);
    const int tid = tidx(), lane = tid & 63, w = tid >> 6, r32 = lane & 31, hi = lane >> 5;
    int tlo, thi; tile_range((T / 128) * PH, tlo, thi);
    for (int u = tlo; u < thi; ++u) {
        const int tm = u >> 3, h = u & 7;
        float L0[16], L1[16];
        {
            f32x16 acc[4]; float ssd[4];
            gemm_kloop<1, false>(Wc + (size_t)((h * 2 + 0) * 128) * LDW, LDW, XN + (size_t)(tm * 128) * LDX, LDX, D / 64, acc, ssd, lds, tid);
            lane_top16(acc[0], acc[1], acc[2], acc[3], hi, L0);
            float o[16];
#pragma unroll
            for (int i = 0; i < 16; ++i) o[i] = __shfl_xor(L0[i], 32, 64);
            merge16_desc(L0, o);
        }
        float* park = (float*)(lds + GEMM_LDS) + (size_t)(w * 32 + r32) * 16;
        if (hi == 0) {
#pragma unroll
            for (int q = 0; q < 4; ++q) *(float4*)(park + 4 * q) = make_float4(L0[4 * q], L0[4 * q + 1], L0[4 * q + 2], L0[4 * q + 3]);
        }
        {
            f32x16 acc[4]; float ssd[4];
            gemm_kloop<1, false>(Wc + (size_t)((h * 2 + 1) * 128) * LDW, LDW, XN + (size_t)(tm * 128) * LDX, LDX, D / 64, acc, ssd, lds, tid);
            lane_top16(acc[0], acc[1], acc[2], acc[3], hi, L1);
            float o[16];
#pragma unroll
            for (int i = 0; i < 16; ++i) o[i] = __shfl_xor(L1[i], 32, 64);
            merge16_desc(L1, o);
        }
#pragma unroll
        for (int q = 0; q < 4; ++q) { const float4 v = *(const float4*)(park + 4 * q); L0[4 * q] = v.x; L0[4 * q + 1] = v.y; L0[4 * q + 2] = v.z; L0[4 * q + 3] = v.w; }
        float c[16];
        cand_top16(L0, L1, c);
        __syncthreads();
        unsigned char* my = (unsigned char*)lds + tid * 32;
        {
            uint4 a, b;
#define PK4(L, i) ((__float_as_uint(L[i]) & 127u) | ((__float_as_uint(L[i + 1]) & 127u) << 8) | ((__float_as_uint(L[i + 2]) & 127u) << 16) | ((__float_as_uint(L[i + 3]) & 127u) << 24))
            a.x = PK4(L0, 0); a.y = PK4(L0, 4); a.z = PK4(L0, 8); a.w = PK4(L0, 12);
            b.x = PK4(L1, 0); b.y = PK4(L1, 4); b.z = PK4(L1, 8); b.w = PK4(L1, 12);
#undef PK4
            *(uint4*)my = a; *(uint4*)(my + 16) = b;
        }
        int ev[16]; float gv[16]; float den = 0.f;
#pragma unroll
        for (int k = 0; k < 16; ++k) {
            const unsigned ci = __float_as_uint(c[k]) & 255u;
            const int n1 = my[ci >> 4], n2 = my[16 + (ci & 15)];
            ev[k] = n1 * NKEY + n2;
            gv[k] = __expf(c[k] - c[0]); den += gv[k];
        }
        const float iden = 1.f / den;
        if (hi == 0) {
            const int t = tm * 128 + w * 32 + r32;
            uint4* ep = (uint4*)(EXPp + (size_t)t * HK + h * 16);
            float4* gp = (float4*)(GATEp + (size_t)t * HK + h * 16);
#pragma unroll
            for (int q = 0; q < 4; ++q) {
                ep[q] = make_uint4((unsigned)ev[4 * q], (unsigned)ev[4 * q + 1], (unsigned)ev[4 * q + 2], (unsigned)ev[4 * q + 3]);
                gp[q] = make_float4(gv[4 * q] * iden, gv[4 * q + 1] * iden, gv[4 * q + 2] * iden, gv[4 * q + 3] * iden);
            }
        }
        __syncthreads();
    }
}

constexpr size_t WS_PART = WS_PROJ;
static_assert((size_t)8 * T * HK * 4 <= WS_K - WS_PROJ, "PART alias");
constexpr int XI_X = 0, XI_RANK = 1, XI_J = 2, XI_NX = 3, XI_NLOC = 4;
constexpr int CTL_CENSUS = 4096;
constexpr int CTL_BYTES = (CTL_CENSUS + 16) * 4;

template <int M1, int M2, int M3, class TT>
__device__ __forceinline__ void red16x3(TT (&p)[16], int lane) {
#pragma unroll
    for (int i = 0; i < 8; ++i) { const bool up = lane & M1; const TT send = up ? p[i] : p[i + 8], keep = up ? p[i + 8] : p[i]; p[i] = keep + __shfl_xor(send, M1, 64); }
#pragma unroll
    for (int i = 0; i < 4; ++i) { const bool up = lane & M2; const TT send = up ? p[i] : p[i + 4], keep = up ? p[i + 4] : p[i]; p[i] = keep + __shfl_xor(send, M2, 64); }
#pragma unroll
    for (int i = 0; i < 2; ++i) { const bool up = lane & M3; const TT send = up ? p[i] : p[i + 2], keep = up ? p[i + 2] : p[i]; p[i] = keep + __shfl_xor(send, M3, 64); }
}
__device__ __forceinline__ void phase_gu(const Params& P, int l, const volatile int* xi) {
    const unsigned char* XQ = P.ws + WS_XQ;
    const float* XSc = (const float*)(P.ws + WS_XS);
    const int* EXPp = (const int*)(P.ws + WS_EXP);
    float* PART = (float*)(P.ws + WS_PART);
    const int tid = tidx(), lane = tid & 63, w = tid >> 6, g = lane >> 3, c = lane & 7;
    int xo_ = 0; asm volatile("" : "+v"(xo_));
    const int j = __builtin_amdgcn_readfirstlane(xi[xo_ + XI_J]), nx = __builtin_amdgcn_readfirstlane(xi[xo_ + XI_NX]), nloc = __builtin_amdgcn_readfirstlane(xi[xo_ + XI_NLOC]), rank = __builtin_amdgcn_readfirstlane(xi[xo_ + XI_RANK]);
    const int t0 = rank * 4 + w, st = nloc * 4;
    const int n = (t0 < T) ? (T - t0 + st - 1) / st : 0;
    const int i0 = 8 * (c & 1) + 4 * ((c >> 1) & 1) + 2 * ((c >> 2) & 1);
    for (int sl = j; sl < 8 && n > 0; sl += nx) {
        const unsigned char* Us = P.ws + WS_TABU + ((size_t)(l * 8 + sl) * NEXP) * 128;
        const unsigned co = (unsigned)c << 4;
        float* part = PART + (size_t)sl * T * HK;
        const unsigned char* xs = XQ + sl * 128 + c * 16;
#define GU_TK(k) (t0 + (((k) < n) ? (k) : (n - 1)) * st)
#define GU_LOADE(S, t) do { S##lo = EXPp[(size_t)(t) * HK + lane]; S##hi = EXPp[(size_t)(t) * HK + 64 + lane]; } while (0)
#define GU_LOADX(S, t) do { S##a = *(const uint4*)(xs + (size_t)(t) * D); S##s = XSc[t]; } while (0)
#define GU_ISSUE(R, S) do { _Pragma("unroll") for (int i = 0; i < 16; ++i) { \
            const int e = __builtin_amdgcn_ds_bpermute((((8 * i) & 63) + g) << 2, (i < 8) ? S##lo : S##hi); R[i] = *(const uint4*)(Us + (((unsigned)e << 7) | co)); } } while (0)
#define GU_FINISH(R, S, t) do { \
            int p[16]; \
            _Pragma("unroll") for (int i = 0; i < 16; ++i) { int d_ = __builtin_amdgcn_sdot4((int)S##a.x, (int)R[i].x, 0, false); d_ = __builtin_amdgcn_sdot4((int)S##a.y, (int)R[i].y, d_, false); \
                d_ = __builtin_amdgcn_sdot4((int)S##a.z, (int)R[i].z, d_, false); p[i] = __builtin_amdgcn_sdot4((int)S##a.w, (int)R[i].w, d_, false); } \
            red16x3<1, 2, 4, int>(p, lane); \
            part[(size_t)(t) * HK + 8 * i0 + g] = (float)p[0] * S##s; part[(size_t)(t) * HK + 8 * (i0 + 1) + g] = (float)p[1] * S##s; } while (0)
        int eAlo, eAhi, eBlo, eBhi; uint4 xAa, xBa; float xAs, xBs; uint4 rA[16], rB[16];
        GU_LOADE(eA, GU_TK(0)); GU_LOADX(xA, GU_TK(0)); GU_LOADE(eB, GU_TK(1));
        GU_ISSUE(rA, eA);
        for (int k = 0; k < n; k += 2) {
            GU_LOADX(xB, GU_TK(k + 1)); GU_ISSUE(rB, eB); GU_LOADE(eA, GU_TK(k + 2));
            GU_FINISH(rA, xA, GU_TK(k));
            GU_LOADX(xA, GU_TK(k + 2)); GU_ISSUE(rA, eA); GU_LOADE(eB, GU_TK(k + 3));
            GU_FINISH(rB, xB, GU_TK(k + 1));
        }
#undef GU_TK
#undef GU_LOADE
#undef GU_LOADX
#undef GU_ISSUE
#undef GU_FINISH
    }
}
__device__ __forceinline__ void phase_gw(const Params& P, int l) {
    const int* EXPp = (const int*)(P.ws + WS_EXP);
    const float* GATEp = (const float*)(P.ws + WS_GATE);
    const float* PART = (const float*)(P.ws + WS_PART);
    const float* SU = (const float*)(P.ws + WS_TSCU) + (size_t)l * NEXP;
    const float* SV = (const float*)(P.ws + WS_TSCV) + (size_t)l * NEXP;
    unsigned char* WQ = P.ws + WS_WQ8;
    float* WSC = (float*)(P.ws + WS_WSC);
    const int lane = tidx() & 63;
    for (int tb = gwave() * 4; tb < T; tb += nwave() * 4) {
        float wv[4][2];
#pragma unroll
        for (int q = 0; q < 4; ++q)
#pragma unroll
            for (int hk = 0; hk < 2; ++hk) {
                const size_t i = (size_t)(tb + q) * HK + hk * 64 + lane;
                float s = 0.f;
#pragma unroll
                for (int x = 0; x < 8; ++x) s += PART[(size_t)x * T * HK + i];
                const int e = EXPp[i];
                wv[q][hk] = GATEp[i] * gelu_exact(s * SU[e]) * SV[e];
            }
#pragma unroll
        for (int q = 0; q < 4; ++q) {
            float am = fmaxf(fabsf(wv[q][0]), fabsf(wv[q][1]));
#pragma unroll
            for (int m = 32; m >= 1; m >>= 1) am = fmaxf(am, __shfl_xor(am, m, 64));
            const float sc = (am > 0.f) ? am * (1.f / 448.f) : 1.f, is = 1.f / sc;
            const int pk = __builtin_amdgcn_cvt_pk_fp8_f32(wv[q][0] * is, wv[q][1] * is, 0, false);
            WQ[(size_t)(tb + q) * HK + lane] = (unsigned char)(pk & 255);
            WQ[(size_t)(tb + q) * HK + 64 + lane] = (unsigned char)((pk >> 8) & 255);
            if (lane == 0) WSC[tb + q] = sc;
        }
    }
}
typedef int v2i_t __attribute__((ext_vector_type(2)));
typedef unsigned u32x4_t __attribute__((ext_vector_type(4)));
typedef __attribute__((ext_vector_type(4))) float f32x4;
constexpr int GV_PIECE = 1024 + 16;
constexpr int GV_TILE = 16 * GV_PIECE;
static_assert(4 * GV_TILE + 4 * 512 <= LDS_TOTAL, "gv LDS");
__device__ __forceinline__ void phase_gv(const Params& P, int l, const volatile int* xi, char* lds) {
    const int* EXPp = (const int*)(P.ws + WS_EXP);
    const unsigned char* WQ = P.ws + WS_WQ8;
    const float* WSC = (const float*)(P.ws + WS_WSC);
    const int tid = tidx(), lane = tid & 63, w = __builtin_amdgcn_readfirstlane(tid >> 6), g = lane >> 3, pos = lane & 7;
    int xo_ = 0; asm volatile("" : "+v"(xo_));
    const int j = __builtin_amdgcn_readfirstlane(xi[xo_ + XI_J]), nx = __builtin_amdgcn_readfirstlane(xi[xo_ + XI_NX]), nloc = __builtin_amdgcn_readfirstlane(xi[xo_ + XI_NLOC]), rank = __builtin_amdgcn_readfirstlane(xi[xo_ + XI_RANK]);
    const int t0 = rank * 4 + w, st = nloc * 4;
    const int n = (t0 < T) ? (T - t0 + st - 1) / st : 0;
    char* tile = lds + w * GV_TILE;
    float* strip = (float*)(lds + 4 * GV_TILE) + w * 128;
    typedef __attribute__((address_space(3))) v2i_t* ldsv2_t;
    const unsigned co = (unsigned)(pos ^ g) << 4;
    const int rr = (lane & 15) >> 1, kq = lane >> 4;
    const int rdo = kq * GV_PIECE + rr * 128 + (lane & 1) * 8;
    const bool row0 = (lane & 15) == 0;
    __syncthreads();
    for (int sl = j; sl < 8 && n > 0; sl += nx) {
        const unsigned char* Vs = P.ws + WS_TABV + ((size_t)(l * 8 + sl) * NEXP) * 128;
        float* hrow = P.out + sl * 128 + 2 * lane;
#define GV_TK(k) (t0 + (((k) < n) ? (k) : (n - 1)) * st)
#define GV_LOADE(S, t) do { S##el = EXPp[(size_t)(t) * HK + lane]; S##eh = EXPp[(size_t)(t) * HK + 64 + lane]; } while (0)
#define GV_ISSUE(R, S) do { _Pragma("unroll") for (int i = 0; i < 16; ++i) { \
            const int e = __builtin_amdgcn_ds_bpermute((((8 * i) & 63) + g) << 2, (i < 8) ? S##el : S##eh); R[i] = *(const u32x4_t*)(Vs + (((unsigned)e << 7) | co)); } } while (0)
#define GV_LOADT(S, kk) do { const int t_ = GV_TK(kk); \
            S##a0 = 0; S##a1 = 0; S##a2 = 0; S##a3 = 0; \
            if (row0) { const long* wp = (const long*)(WQ + (size_t)t_ * HK + kq * 8); S##a0 = wp[0]; S##a1 = wp[4]; S##a2 = wp[8]; S##a3 = wp[12]; } \
            S##ws = ((kk) < n) ? WSC[t_] : 0.f; \
            S##hv = *(const float2*)(hrow + (size_t)t_ * D); } while (0)
#define GV_TOKEN(R, S, kk) do { \
            const int t = GV_TK(kk); \
            _Pragma("unroll") for (int i = 0; i < 16; ++i) *(u32x4_t*)(tile + i * GV_PIECE + lane * 16) = R[i]; \
            f32x4 acc[8]; \
            _Pragma("unroll") for (int nt = 0; nt < 8; ++nt) acc[nt] = (f32x4){0.f, 0.f, 0.f, 0.f}; \
            _Pragma("unroll") for (int s4 = 0; s4 < 4; ++s4) { \
                const long av = (s4 == 0) ? S##a0 : (s4 == 1) ? S##a1 : (s4 == 2) ? S##a2 : S##a3; \
                _Pragma("unroll") for (int nt = 0; nt < 8; ++nt) { \
                    const v2i_t bv = __builtin_amdgcn_ds_read_tr8_b64_v2i32((ldsv2_t)(void*)(tile + (4 * s4) * GV_PIECE + rdo + ((nt ^ rr) << 4))); \
                    acc[nt] = __builtin_amdgcn_mfma_f32_16x16x32_fp8_fp8(av, __builtin_bit_cast(long, bv), acc[nt], 0, 0, 0); } } \
            if (lane < 16) { _Pragma("unroll") for (int nt = 0; nt < 8; ++nt) strip[16 * nt + lane] = acc[nt][0]; }        \
            { const float2 o2 = *(const float2*)(strip + 2 * lane); \
              if ((kk) < n) *(float2*)(hrow + (size_t)t * D) = make_float2(S##hv.x + S##ws * o2.x, S##hv.y + S##ws * o2.y); } } while (0)
        int Ael, Aeh, Bel, Beh; u32x4_t rA[16], rB[16];
        long Pa0, Pa1, Pa2, Pa3, Qa0, Qa1, Qa2, Qa3; float Pws, Qws; float2 Phv, Qhv;
        GV_LOADE(A, GV_TK(0)); GV_LOADE(B, GV_TK(1));
        GV_ISSUE(rA, A); GV_LOADT(P, 0);
        for (int k = 0; k < n; k += 2) {
            GV_ISSUE(rB, B); GV_LOADE(A, GV_TK(k + 2)); GV_LOADT(Q, k + 1);
            GV_TOKEN(rA, P, k);
            GV_ISSUE(rA, A); GV_LOADE(B, GV_TK(k + 3)); GV_LOADT(P, k + 2);
            GV_TOKEN(rB, Q, k + 1);
        }
#undef GV_TK
#undef GV_LOADE
#undef GV_ISSUE
#undef GV_LOADT
#undef GV_TOKEN
    }
    __syncthreads();
}
__device__ __forceinline__ void phase_gnorm(const Params& P, int l) {
    const int lane = tidx() & 63, nw = nwave();
    bf16* XNw = (bf16*)(P.ws + WS_XN);
    const float4* g = (const float4*)((l == DEPTH - 1) ? P.norm_final : (P.norm_mix + (l + 1) * D));
    for (int t = gwave(); t < T; t += 2 * nw) {
        const int t2 = (t + nw < T) ? (t + nw) : t;
        float4 v[2][4];
#pragma unroll
        for (int q = 0; q < 4; ++q) { v[0][q] = ((const float4*)(P.out + (size_t)t * D))[q * 64 + lane]; v[1][q] = ((const float4*)(P.out + (size_t)t2 * D))[q * 64 + lane]; }
#pragma unroll
        for (int u = 0; u < 2; ++u) {
            float ss = 0.f;
#pragma unroll
            for (int q = 0; q < 4; ++q) ss += v[u][q].x * v[u][q].x + v[u][q].y * v[u][q].y + v[u][q].z * v[u][q].z + v[u][q].w * v[u][q].w;
            ss = wave_sum(ss);
            const float rn = rsqrtf(ss * (1.f / D) + EPS);
            const int tt = u ? t2 : t;
            if (u == 0 || t2 != t) {
                float4* hr = (float4*)(P.out + (size_t)tt * D);
#pragma unroll
                for (int q = 0; q < 4; ++q) {
                    const float4 gg = g[q * 64 + lane];
                    const float4 o = make_float4(v[u][q].x * rn * gg.x, v[u][q].y * rn * gg.y, v[u][q].z * rn * gg.z, v[u][q].w * rn * gg.w);
                    if (l == DEPTH - 1) hr[q * 64 + lane] = o;
                    else { uint2 uu; uu.x = pack2(o.x, o.y); uu.y = pack2(o.z, o.w); ((uint2*)(XNw + (size_t)tt * LDX))[q * 64 + lane] = uu; }
                }
            }
        }
    }
}

#define XB_TMO      128
#define XB_XCNT(j)  (256  + 64 * (j))
#define XB_XSUB(j)  (1280 + 64 * (j))
#define XB_XGEN(j)  (2304 + 64 * (j))
#define XB_TOP      3328
#define XB_TOPGEN   3392
#define XCD_BAR_WORDS 3456
#define XB_SPIN_CAP (1u << 22)
#define LAS __attribute__((address_space(3)))
__device__ __forceinline__ unsigned xb_ld(unsigned* p)              { return __hip_atomic_load(p, __ATOMIC_RELAXED, __HIP_MEMORY_SCOPE_AGENT); }
__device__ __forceinline__ unsigned xb_add(unsigned* p, unsigned v) { return __hip_atomic_fetch_add(p, v, __ATOMIC_RELAXED, __HIP_MEMORY_SCOPE_AGENT); }
__device__ __forceinline__ unsigned xb_xcc_id() { return (unsigned)__builtin_amdgcn_s_getreg((3 << 11) | 20) & 0xFu; }
#define XB_SPIN(cond, bar) do { unsigned _sp = 0; while (cond) { __builtin_amdgcn_s_sleep(1); \
    if ((++_sp & 255u) == 0u) { if (xb_ld(&(bar)[XB_TMO])) break; if (_sp > XB_SPIN_CAP) { atomicAdd(&(bar)[XB_TMO], 1u); break; } } } } while (0)
struct XcdBarrier { unsigned* bar; unsigned x; volatile LAS unsigned* st; };
__device__ __forceinline__ XcdBarrier xcd_barrier_post(unsigned* bar, volatile LAS unsigned* st) {
    XcdBarrier b; b.bar = bar; b.x = xb_xcc_id(); b.st = st;
    if (__builtin_amdgcn_workitem_id_x() == 0) (void)xb_add(&bar[XB_XCNT(b.x)], 1u);
    return b;
}
__device__ __forceinline__ void xcd_barrier_complete(unsigned* bar, unsigned x, unsigned& nloc, unsigned& nx) {
    const unsigned G = gridDim.x * gridDim.y * gridDim.z;
    unsigned sum, cnt, mine, sp = 0u;
    for (;;) {
        sum = 0u; cnt = 0u; mine = 0u;
#pragma unroll
        for (unsigned j = 0; j < 16; ++j) { const unsigned c = xb_ld(&bar[XB_XCNT(j)]); sum += c; cnt += (c > 0u) ? 1u : 0u; mine = (j == x) ? c : mine; }
        if (sum == G) break;
        __builtin_amdgcn_s_sleep(1);
        if ((++sp & 255u) == 0u) { if (xb_ld(&bar[XB_TMO])) break; if (sp > XB_SPIN_CAP) { atomicAdd(&bar[XB_TMO], 1u); break; } }
    }
    nloc = mine > 0u ? mine : 1u; nx = cnt > 0u ? cnt : 1u;
}
__device__ __forceinline__ void xcd_barrier(const XcdBarrier& b) {
    asm volatile("s_waitcnt vmcnt(0)" ::: "memory");
    __syncthreads();
    if (__builtin_amdgcn_workitem_id_x() == 0) {
        unsigned* bar = b.bar;
        __builtin_amdgcn_s_waitcnt(0);
        unsigned nloc = b.st[0], nx = b.st[1];
        if (nloc == 0u) { xcd_barrier_complete(bar, b.x, nloc, nx); b.st[0] = nloc; b.st[1] = nx; }
        const unsigned old = xb_add(&bar[XB_XSUB(b.x)], 1u);
        const unsigned gen = old / nloc;
        if (old + 1u == (gen + 1u) * nloc) {
            __builtin_amdgcn_fence(__ATOMIC_RELEASE, "agent");
            asm volatile("s_waitcnt vmcnt(0)" ::: "memory");
            const unsigned og = xb_add(&bar[XB_TOP], 1u);
            const unsigned tg = og / nx;
            if (og + 1u == (tg + 1u) * nx) xb_add(&bar[XB_TOPGEN], 1u);
            else XB_SPIN(xb_ld(&bar[XB_TOPGEN]) == tg, bar);
            __builtin_amdgcn_fence(__ATOMIC_ACQUIRE, "agent");
            xb_add(&bar[XB_XGEN(b.x)], 1u);
            asm volatile("s_waitcnt vmcnt(0)" ::: "memory");
        } else {
            XB_SPIN(xb_ld(&bar[XB_XGEN(b.x)]) == gen, bar);
            __builtin_amdgcn_fence(__ATOMIC_ACQUIRE, "agent");
            asm volatile("s_waitcnt vmcnt(0)" ::: "memory");
        }
    }
    __syncthreads();
}

constexpr float QSCALE = 0.10206207261596575f * 1.4426950408889634f;

__device__ __forceinline__ void phase_gemm1(const Params& P, int l, char* lds) {
    unsigned char* ws = P.ws;
    const bf16* XN = (const bf16*)(ws + WS_XN);
    bf16* PROJ = (bf16*)(ws + WS_PROJ);
    bf16* Kb = (bf16*)(ws + WS_K);
    const float* rope = (const float*)(ws + WS_ROPE);
    const bf16* W = (const bf16*)(ws + WS_WIN) + (size_t)l * DINP * LDW;
    gemm_t<false>(W, LDW, DINP, XN, LDX, T, D, C_KR / 128, [&](int n0, int t0, const f32x16& acc, int r32, int hi, float) {
        const int t = t0 + r32;
        if (n0 < C_KR) {
            bf16* pr = PROJ + (size_t)t * DINP + n0 + 4 * hi;
#pragma unroll
            for (int g = 0; g < 4; ++g) { uint2 o; o.x = cvtpk(acc[4 * g], acc[4 * g + 1]); o.y = cvtpk(acc[4 * g + 2], acc[4 * g + 3]); *(uint2*)(pr + 8 * g) = o; }
        } else if (n0 == C_KR) {
            const int b = t / S, s = t % S;
            uint2 o1[2], o2[2];
#pragma unroll
            for (int g = 0; g < 2; ++g) {
                const float4 cs0 = *(const float4*)(rope + ((size_t)s * 16 + 8 * g + 4 * hi) * 2), cs1 = *(const float4*)(rope + ((size_t)s * 16 + 8 * g + 4 * hi) * 2 + 4);
                const float x10 = acc[4 * g], x11 = acc[4 * g + 1], x12 = acc[4 * g + 2], x13 = acc[4 * g + 3];
                const float x20 = acc[8 + 4 * g], x21 = acc[8 + 4 * g + 1], x22 = acc[8 + 4 * g + 2], x23 = acc[8 + 4 * g + 3];
                o1[g].x = cvtpk(x10 * cs0.x - x20 * cs0.y, x11 * cs0.z - x21 * cs0.w); o1[g].y = cvtpk(x12 * cs1.x - x22 * cs1.y, x13 * cs1.z - x23 * cs1.w);
                o2[g].x = cvtpk(x20 * cs0.x + x10 * cs0.y, x21 * cs0.z + x11 * cs0.w); o2[g].y = cvtpk(x22 * cs1.x + x12 * cs1.y, x23 * cs1.z + x13 * cs1.w);
            }
#pragma unroll
            for (int h = 0; h < NH; ++h) {
                bf16* kr = Kb + ((size_t)(b * NH + h) * S + s) * DQK + 64 + 4 * hi;
                *(uint2*)(kr) = o1[0]; *(uint2*)(kr + 8) = o1[1]; *(uint2*)(kr + 16) = o2[0]; *(uint2*)(kr + 24) = o2[1];
            }
        }
    }, [&](int t, int n, const float4& v) {
        uint2 o; o.x = cvtpk(v.x, v.y); o.y = cvtpk(v.z, v.w);
        *(uint2*)(PROJ + (size_t)t * DINP + n) = o;
    }, [](float) { return 1.f; }, lds);
}
__device__ __forceinline__ void phase_gemm2(const Params& P, int l, char* lds) {
    unsigned char* ws = P.ws;
    const bf16* PROJ = (const bf16*)(ws + WS_PROJ);
    const float* rope = (const float*)(ws + WS_ROPE);
    const int lane = tidx() & 63;
    {
        const bf16* W = (const bf16*)(ws + WS_WUQ) + (size_t)l * 768 * QR;
        bf16* Qb = (bf16*)(ws + WS_Q);
        gemm_t<true>(W, QR, 768, PROJ + C_CQ, DINP, T, QR, 768 / 128, [](int, int, const f32x16&, int, int, float) {},
            [&](int t, int n, const float4& v) {
                const int b = t / S, s = t % S, h = n / DQK, d = n % DQK;
                float4 o = v;
                const float4 up = make_float4(__shfl(v.x, lane + 4, 64), __shfl(v.y, lane + 4, 64), __shfl(v.z, lane + 4, 64), __shfl(v.w, lane + 4, 64));
                const float4 dn = make_float4(__shfl(v.x, lane - 4, 64), __shfl(v.y, lane - 4, 64), __shfl(v.z, lane - 4, 64), __shfl(v.w, lane - 4, 64));
                if (d >= 64) {
                    const bool first = d < 80;
                    const int f = first ? (d - 64) : (d - 80);
                    const float4 cs0 = *(const float4*)(rope + ((size_t)s * 16 + f) * 2), cs1 = *(const float4*)(rope + ((size_t)s * 16 + f) * 2 + 4);
                    if (first) o = make_float4(v.x * cs0.x - up.x * cs0.y, v.y * cs0.z - up.y * cs0.w, v.z * cs1.x - up.z * cs1.y, v.w * cs1.z - up.w * cs1.w);
                    else       o = make_float4(v.x * cs0.x + dn.x * cs0.y, v.y * cs0.z + dn.y * cs0.w, v.z * cs1.x + dn.z * cs1.y, v.w * cs1.z + dn.w * cs1.w);
                }
                uint2 u; u.x = cvtpk(o.x, o.y); u.y = cvtpk(o.z, o.w);
                *(uint2*)(Qb + ((size_t)(b * NH + h) * S + s) * DQK + d) = u;
            }, [](float ssq) { return rsqrtf(ssq * (1.f / QR) + EPS) * QSCALE; }, lds);
    }
    {
        const bf16* W = (const bf16*)(ws + WS_WUKV) + (size_t)l * 1024 * KVR;
        bf16* Kb = (bf16*)(ws + WS_K); bf16* Vb = (bf16*)(ws + WS_V);
        gemm_t<true>(W, KVR, 1024, PROJ + C_CKV, DINP, T, KVR, 1024 / 128, [](int, int, const f32x16&, int, int, float) {},
            [&](int t, int n, const float4& v) {
                const int b = t / S, s = t % S;
                uint2 u; u.x = cvtpk(v.x, v.y); u.y = cvtpk(v.z, v.w);
                if (n < 512) *(uint2*)(Kb + ((size_t)(b * NH + (n >> 6)) * S + s) * DQK + (n & 63)) = u;
                else         *(uint2*)(Vb + ((size_t)(b * NH + ((n - 512) >> 6)) * S + s) * DV + (n & 63)) = u;
            }, [](float ssq) { return rsqrtf(ssq * (1.f / KVR) + EPS); }, lds);
    }
}
__device__ __forceinline__ void phase_gemm3(const Params& P, int l, char* lds) {
    unsigned char* ws = P.ws;
    const bf16* Yb = (const bf16*)(ws + WS_XN);
    const bf16* W = (const bf16*)(ws + WS_WOUT) + (size_t)l * D * LDW;
    const float* hin = (l == 0) ? P.x : P.out;
    float* out = P.out;
    gemm_t<false>(W, LDW, D, Yb, LDX, T, D, D / 128, [](int, int, const f32x16&, int, int, float) {}, [&](int t, int n, const float4& v) {
        const size_t idx = (size_t)t * D + n;
        const float4 hv = *(const float4*)(hin + idx);
        *(float4*)(out + idx) = make_float4(hv.x + v.x, hv.y + v.y, hv.z + v.z, hv.w + v.w);
    }, [](float) { return 1.f; }, lds);
}

#define GSYNC() do { XcdBarrier xb_; { __attribute__((address_space(1))) char* gp_ = (__attribute__((address_space(1))) char*)(char*)(P.ws + WS_CTL); asm volatile("" : "+s"(gp_)); xb_.bar = (unsigned*)(char*)gp_; } \
    xb_.x = xb_xcc_id(); xb_.st = (volatile LAS unsigned*)&xb_words; xcd_barrier(xb_); } while (0)
#define PHASE(stmt) { const Params Q = launder(P); stmt; }
__global__ void __launch_bounds__(NTHREADS, 2) k_all(Params P) {
    __shared__ __attribute__((aligned(16))) char sm[LDS_TOTAL];
    __shared__ uint4 xb_words;
    cg::grid_group grid = cg::this_grid();
    if (__builtin_amdgcn_workitem_id_x() == 0) xb_words = make_uint4(0u, 0u, 0u, 0u);
    __syncthreads();
    (void)xcd_barrier_post((unsigned*)(P.ws + WS_CTL), (volatile LAS unsigned*)&xb_words);
    __shared__ int xinfo[8];
    if (__builtin_amdgcn_workitem_id_x() == 0) {
        const unsigned x = xb_xcc_id();
        xinfo[XI_X] = (int)x; xinfo[XI_RANK] = (int)xb_add((unsigned*)(P.ws + WS_CTL) + CTL_CENSUS + x, 1u);
    }
    PHASE(phase_prep(Q, sm));
    PHASE(phase_norm(Q.x, Q.norm_mix, (bf16*)(Q.ws + WS_XN)));
    if (P.ws == nullptr) grid.sync();
    GSYNC();
    if (__builtin_amdgcn_workitem_id_x() == 0) {
        unsigned* cen = (unsigned*)(P.ws + WS_CTL) + CTL_CENSUS;
        const int x = xinfo[XI_X]; int nx = 0, jj = 0;
        for (int q = 0; q < 16; ++q) { const unsigned cq = xb_ld(cen + q); if (cq) { if (q < x) ++jj; ++nx; } }
        xinfo[XI_J] = jj; xinfo[XI_NX] = nx; xinfo[XI_NLOC] = (int)xb_ld(cen + x);
    }
    __syncthreads();
    for (int l = 0; l < DEPTH; ++l) {
        PHASE(phase_gemm1(Q, l, sm));
#if PROBE_DUP & 2
        PHASE(phase_gemm1(Q, l, sm));
#endif
        GSYNC();
        PHASE(phase_mixlocal(Q, l, sm));
#if PROBE_DUP & 256
        PHASE(phase_mixlocal(Q, l, sm));
#endif
        PHASE(phase_gemm2(Q, l, sm));
        GSYNC();
        if (l == 0 && blockIdx.x >= (gridDim.x >> 1)) PHASE(phase_tables(Q));
        PHASE(phase_attn(Q, sm));
        if (l == 0 && blockIdx.x < (gridDim.x >> 1)) PHASE(phase_tables(Q));
        GSYNC();
        PHASE(phase_gemm3(Q, l, sm));
#if PROBE_DUP & 16
        if (l == 0) PHASE(phase_gemm3(Q, l, sm));
#endif
        GSYNC();
        PHASE(phase_norm_q(Q, l));
        GSYNC();
        PHASE(phase_route(Q, l, sm));
        GSYNC();
        PHASE(phase_gu(Q, l, xinfo));
        GSYNC();
        PHASE(phase_gw(Q, l));
        GSYNC();
        PHASE(phase_gv(Q, l, xinfo, sm));
        GSYNC();
        PHASE(phase_gnorm(Q, l));
        GSYNC();
    }
}

extern "C" void kernel_launch(void* const* d_in, const int* in_sizes, int n_in, void* d_out, int out_size, void* d_ws, size_t ws_size, hipStream_t stream) {
    static int grid = 0;
    if (grid == 0) {
        if (n_in != 18 || out_size != T * D || ws_size < WS_END) { fprintf(stderr, "kernel_launch: bad sizes n_in %d out %d ws %zu need %zu\n", n_in, out_size, ws_size, (size_t)WS_END); grid = -1; return; }
        int dev = 0, cus = 0, per_cu = 0;
        (void)hipGetDevice(&dev);
        (void)hipDeviceGetAttribute(&cus, hipDeviceAttributeMultiprocessorCount, dev);
        (void)hipOccupancyMaxActiveBlocksPerMultiprocessor(&per_cu, (const void*)k_all, NTHREADS, 0);
        if (per_cu > 2) per_cu = 2;
        if (per_cu < 1) { fprintf(stderr, "kernel_launch: occupancy query says %d\n", per_cu); grid = -1; return; }
        grid = cus * per_cu;
    }
    if (grid < 0) return;
    Params p{};
    p.x = (const float*)d_in[0]; p.norm_mix = (const float*)d_in[1]; p.w_in = (const float*)d_in[2]; p.conv_w = (const float*)d_in[3];
    p.pool_w = (const float*)d_in[4]; p.pool_scale = (const float*)d_in[5]; p.q_norm = (const float*)d_in[6]; p.w_uq = (const float*)d_in[7];
    p.kv_norm = (const float*)d_in[8]; p.w_uk = (const float*)d_in[9]; p.w_uv = (const float*)d_in[10]; p.w_out = (const float*)d_in[11];
    p.norm_ffn = (const float*)d_in[12]; p.peer_wq = (const float*)d_in[13]; p.peer_subkeys = (const float*)d_in[14]; p.peer_u = (const float*)d_in[15];
    p.peer_v = (const float*)d_in[16]; p.norm_final = (const float*)d_in[17];
    p.out = (float*)d_out; p.ws = (unsigned char*)d_ws;
    if (hipMemsetAsync((char*)d_ws + WS_CTL, 0, CTL_BYTES, stream) != hipSuccess) { fprintf(stderr, "kernel_launch: memset failed\n"); return; }
    void* args[] = {&p};
    hipError_t e = hipLaunchCooperativeKernel((const void*)k_all, dim3(grid), dim3(NTHREADS), args, 0, stream);
    if (e != hipSuccess) fprintf(stderr, "cooperative launch failed: %s (grid %d)\n", hipGetErrorString(e), grid);
}
```

```cpp
#include <hip/hip_runtime.h>
#include <hip/hip_cooperative_groups.h>
#include <cstdio>
#include <cstdint>
namespace cg = cooperative_groups;

#ifndef TAB_FP8
#define TAB_FP8 1
#endif
#ifndef PROBE_DUP
#define PROBE_DUP 0
#endif

constexpr int NB = 4, S = 8192, T = NB * S, D = 1024, DEPTH = 2;
constexpr int DIN = 1696, DINP = 1792;
constexpr int C_BG = 0, C_CG = 256, C_HC = 512, C_HP = 768, C_CQ = 1024, C_CKV = 1408, C_KR = 1664;
constexpr int QR = 384, KVR = 256, NH = 8, DQK = 96, DV = 64;
constexpr int PH = 8, NKEY = 128, NEXP = NKEY * NKEY, TOPK = 16, HK = PH * TOPK;
constexpr float EPS = 1e-6f;
constexpr int LDX = 1088;
constexpr int LDW = 1088;

typedef unsigned short bf16;

constexpr size_t WS_CTL   = 0;
constexpr size_t WS_ROPE  = 64 * 1024;
constexpr size_t WS_WIN   = WS_ROPE + (size_t)S * 16 * 2 * 4;
constexpr size_t WS_WUQ   = WS_WIN + (size_t)DEPTH * DINP * LDW * 2;
constexpr size_t WS_WUKV  = WS_WUQ + (size_t)DEPTH * 768 * QR * 2;
constexpr size_t WS_WOUT  = WS_WUKV + (size_t)DEPTH * 1024 * KVR * 2;
constexpr size_t WS_WPQ   = WS_WOUT + (size_t)DEPTH * D * LDW * 2;
constexpr size_t WS_XN    = ((WS_WPQ + (size_t)DEPTH * 2048 * LDW * 2 + 4095) / 4096) * 4096;
constexpr size_t WS_PROJ  = WS_XN + (size_t)T * LDX * 2;
constexpr size_t WS_Q     = WS_PROJ + (size_t)T * DINP * 2;
constexpr size_t WS_K     = WS_Q + (size_t)T * NH * DQK * 2;
constexpr size_t WS_V     = WS_K + (size_t)T * NH * DQK * 2;
constexpr size_t WS_EXP   = WS_V + (size_t)T * NH * DV * 2;
constexpr size_t WS_GATE  = WS_EXP + (size_t)T * HK * 4;
constexpr size_t TAB_ROWB = TAB_FP8 ? 1024 : 2048;
constexpr size_t WS_TABU  = WS_GATE + (size_t)T * HK * 4;
constexpr size_t WS_TABV  = WS_TABU + (size_t)DEPTH * NEXP * TAB_ROWB;
constexpr size_t WS_TSCU  = WS_TABV + (size_t)DEPTH * NEXP * TAB_ROWB;
constexpr size_t WS_TSCV  = WS_TSCU + (size_t)DEPTH * NEXP * 4;
constexpr size_t WS_XQ    = WS_TSCV + (size_t)DEPTH * NEXP * 4;
constexpr size_t WS_XS    = WS_XQ + (size_t)T * D;
constexpr size_t WS_WQ8   = WS_XS + (size_t)T * 4;
constexpr size_t WS_WSC   = WS_WQ8 + (size_t)T * HK;
constexpr size_t WS_END   = WS_WSC + (size_t)T * 4;
static_assert(WS_END <= (size_t)512 * 1024 * 1024, "workspace budget");

struct Params {
    const float* x; const float* norm_mix; const float* w_in; const float* conv_w; const float* pool_w; const float* pool_scale;
    const float* q_norm; const float* w_uq; const float* kv_norm; const float* w_uk; const float* w_uv; const float* w_out;
    const float* norm_ffn; const float* peer_wq; const float* peer_subkeys; const float* peer_u; const float* peer_v; const float* norm_final;
    float* out; unsigned char* ws;
};

__device__ __forceinline__ bf16 f2bf(float f) { unsigned u = __float_as_uint(f); u += 0x7fffu + ((u >> 16) & 1u); return (bf16)(u >> 16); }
__device__ __forceinline__ float bf2f(bf16 h) { return __uint_as_float(((unsigned)h) << 16); }
__device__ __forceinline__ float bflo(unsigned u) { return __uint_as_float(u << 16); }
__device__ __forceinline__ float bfhi(unsigned u) { return __uint_as_float(u & 0xffff0000u); }
__device__ __forceinline__ unsigned pack2(float a, float b) { return (unsigned)f2bf(a) | ((unsigned)f2bf(b) << 16); }
__device__ __forceinline__ float wave_sum(float v) {
#pragma unroll
    for (int m = 32; m >= 1; m >>= 1) v += __shfl_xor(v, m, 64);
    return v;
}
__device__ __forceinline__ float gelu_exact(float x) { return 0.5f * x * (1.f + erff(x * 0.70710678118654752f)); }

#define NTHREADS 256
__device__ __forceinline__ int tidx() { int t = (int)__builtin_amdgcn_workitem_id_x(); asm volatile("" : "+v"(t)); return t; }
__device__ __forceinline__ int gwave() { return blockIdx.x * (NTHREADS / 64) + (tidx() >> 6); }
__device__ __forceinline__ int nwave() { return gridDim.x * (NTHREADS / 64); }
__device__ __forceinline__ size_t gtid() { return (size_t)blockIdx.x * NTHREADS + tidx(); }
__device__ __forceinline__ size_t gnth() { return (size_t)gridDim.x * NTHREADS; }


__device__ __forceinline__ Params launder(const Params& P) {
    typedef __attribute__((address_space(1))) char* gp_t;
    gp_t g[20] = {(gp_t)(char*)P.x, (gp_t)(char*)P.norm_mix, (gp_t)(char*)P.w_in, (gp_t)(char*)P.conv_w, (gp_t)(char*)P.pool_w, (gp_t)(char*)P.pool_scale, (gp_t)(char*)P.q_norm, (gp_t)(char*)P.w_uq,
                  (gp_t)(char*)P.kv_norm, (gp_t)(char*)P.w_uk, (gp_t)(char*)P.w_uv, (gp_t)(char*)P.w_out, (gp_t)(char*)P.norm_ffn, (gp_t)(char*)P.peer_wq, (gp_t)(char*)P.peer_subkeys,
                  (gp_t)(char*)P.peer_u, (gp_t)(char*)P.peer_v, (gp_t)(char*)P.norm_final, (gp_t)(char*)P.out, (gp_t)(char*)P.ws};
    asm volatile("" : "+s"(g[0]), "+s"(g[1]), "+s"(g[2]), "+s"(g[3]), "+s"(g[4]), "+s"(g[5]), "+s"(g[6]), "+s"(g[7]), "+s"(g[8]), "+s"(g[9]));
    asm volatile("" : "+s"(g[10]), "+s"(g[11]), "+s"(g[12]), "+s"(g[13]), "+s"(g[14]), "+s"(g[15]), "+s"(g[16]), "+s"(g[17]), "+s"(g[18]), "+s"(g[19]));
    Params Q;
    Q.x = (const float*)(char*)g[0]; Q.norm_mix = (const float*)(char*)g[1]; Q.w_in = (const float*)(char*)g[2]; Q.conv_w = (const float*)(char*)g[3]; Q.pool_w = (const float*)(char*)g[4];
    Q.pool_scale = (const float*)(char*)g[5]; Q.q_norm = (const float*)(char*)g[6]; Q.w_uq = (const float*)(char*)g[7]; Q.kv_norm = (const float*)(char*)g[8]; Q.w_uk = (const float*)(char*)g[9];
    Q.w_uv = (const float*)(char*)g[10]; Q.w_out = (const float*)(char*)g[11]; Q.norm_ffn = (const float*)(char*)g[12]; Q.peer_wq = (const float*)(char*)g[13]; Q.peer_subkeys = (const float*)(char*)g[14];
    Q.peer_u = (const float*)(char*)g[15]; Q.peer_v = (const float*)(char*)g[16]; Q.norm_final = (const float*)(char*)g[17]; Q.out = (float*)(char*)g[18]; Q.ws = (unsigned char*)(char*)g[19];
    return Q;
}

typedef __attribute__((ext_vector_type(8))) short bf16x8;
typedef __attribute__((ext_vector_type(16))) float f32x16;
typedef __attribute__((ext_vector_type(2))) __bf16 bf2_t;
#define MFMA32(a, b, c) __builtin_amdgcn_mfma_f32_32x32x16_bf16(a, b, c, 0, 0, 0)
__device__ __forceinline__ int crow(int r, int hi) { return (r & 3) + 8 * (r >> 2) + 4 * hi; }
__device__ __forceinline__ float dot2bf(unsigned a, unsigned b, float c) { return __builtin_amdgcn_fdot2_f32_bf16(__builtin_bit_cast(bf2_t, a), __builtin_bit_cast(bf2_t, b), c, false); }
__device__ __forceinline__ unsigned cvtpk(float lo, float hi) { unsigned r; asm("v_cvt_pk_bf16_f32 %0, %1, %2" : "=v"(r) : "v"(lo), "v"(hi)); return r; }
constexpr int G_OPB = 128 * 128;
constexpr int G_BUF = 2 * G_OPB;
constexpr int GEMM_LDS = 2 * G_BUF;
constexpr int LDS_TOTAL = GEMM_LDS + 8192;

template <int WT, bool ROWSS>
__device__ __forceinline__ void gemm_kloop(const bf16* __restrict__ Ag0, int lda, const bf16* __restrict__ Bg0, int ldb, int nk, f32x16 (&acc)[4], float (&ss)[4], char* lds, int tid) {
    const int lane = tid & 63, w = __builtin_amdgcn_readfirstlane(tid >> 6), r32 = lane & 31, hi = lane >> 5;
    const int srow = 8 * w + (lane >> 3);
    const int sch = (lane & 7) ^ ((srow >> 1) & 7);
    const bf16* Ag = Ag0 + (size_t)srow * lda + sch * 8;
    const bf16* Bg = Bg0 + (size_t)srow * ldb + sch * 8;
#pragma unroll
    for (int i = 0; i < 4; ++i)
#pragma unroll
        for (int r = 0; r < 16; ++r) acc[i][r] = 0.f;
    ss[0] = 0.f; ss[1] = 0.f; ss[2] = 0.f; ss[3] = 0.f;
    typedef __attribute__((address_space(3))) unsigned* ldsp_t;
    typedef const __attribute__((address_space(1))) unsigned* glbp_t;
#define G_DMA(buf, kofs) do { char* d_ = lds + (buf) * G_BUF + (8 * w) * 128; \
    _Pragma("unroll") for (int i = 0; i < 4; ++i) { \
        __builtin_amdgcn_global_load_lds((glbp_t)(const void*)(Ag + (size_t)(32 * i) * lda + (kofs)), (ldsp_t)(void*)(d_ + i * 4096), 16, 0, 0); \
        __builtin_amdgcn_global_load_lds((glbp_t)(const void*)(Bg + (size_t)(32 * i) * ldb + (kofs)), (ldsp_t)(void*)(d_ + G_OPB + i * 4096), 16, 0, 0); } } while (0)
    const int xr = (r32 >> 1) & 7;
    const int o0 = ((0 + hi) ^ xr) << 4, o1 = ((2 + hi) ^ xr) << 4, o2 = ((4 + hi) ^ xr) << 4, o3 = ((6 + hi) ^ xr) << 4;
#define G_SS(s_, r_) do { union { bf16x8 v; uint4 u; } c_; c_.v = r_; s_ = dot2bf(c_.u.x, c_.u.x, s_); s_ = dot2bf(c_.u.y, c_.u.y, s_); s_ = dot2bf(c_.u.z, c_.u.z, s_); s_ = dot2bf(c_.u.w, c_.u.w, s_); } while (0)
#define G_STEP(pa, pb, off) do { \
    if (WT == 0) { \
        const bf16x8 a0 = *(const bf16x8*)(pa + off), a1 = *(const bf16x8*)(pa + 32 * 128 + off); \
        const bf16x8 b0 = *(const bf16x8*)(pb + off), b1 = *(const bf16x8*)(pb + 32 * 128 + off); \
        if (ROWSS) { G_SS(ss[0], b0); G_SS(ss[1], b1); } \
        acc[0] = MFMA32(a0, b0, acc[0]); acc[1] = MFMA32(a0, b1, acc[1]); \
        acc[2] = MFMA32(a1, b0, acc[2]); acc[3] = MFMA32(a1, b1, acc[3]); \
    } else { \
        const bf16x8 b0 = *(const bf16x8*)(pb + off); \
        const bf16x8 a0 = *(const bf16x8*)(pa + off), a1 = *(const bf16x8*)(pa + 32 * 128 + off); \
        const bf16x8 a2 = *(const bf16x8*)(pa + 64 * 128 + off), a3 = *(const bf16x8*)(pa + 96 * 128 + off); \
        acc[0] = MFMA32(a0, b0, acc[0]); acc[1] = MFMA32(a1, b0, acc[1]); \
        acc[2] = MFMA32(a2, b0, acc[2]); acc[3] = MFMA32(a3, b0, acc[3]); \
    } } while (0)
    const int arow = (WT == 0) ? ((w >> 1) * 64 + r32) : r32;
    const int brow = (WT == 0) ? ((w & 1) * 64 + r32) : (w * 32 + r32);
    G_DMA(0, 0);
    for (int kt = 0; kt < nk; ++kt) {
        __syncthreads();
        if (kt + 1 < nk) G_DMA((kt + 1) & 1, (kt + 1) * 64);
        const char* pa = lds + (kt & 1) * G_BUF + arow * 128;
        const char* pb = lds + (kt & 1) * G_BUF + G_OPB + brow * 128;
        if (WT == 0) {
#define G_RD(off, A0, A1, B0, B1) do { A0 = *(const bf16x8*)(pa + off); A1 = *(const bf16x8*)(pa + 32 * 128 + off); B0 = *(const bf16x8*)(pb + off); B1 = *(const bf16x8*)(pb + 32 * 128 + off); } while (0)
#define G_MM(A0, A1, B0, B1) do { if (ROWSS) { G_SS(ss[0], B0); G_SS(ss[1], B1); } \
            acc[0] = MFMA32(A0, B0, acc[0]); acc[1] = MFMA32(A0, B1, acc[1]); acc[2] = MFMA32(A1, B0, acc[2]); acc[3] = MFMA32(A1, B1, acc[3]); } while (0)
            bf16x8 xa0, xa1, xb0, xb1, ya0, ya1, yb0, yb1;
            G_RD(o0, xa0, xa1, xb0, xb1);
            G_RD(o1, ya0, ya1, yb0, yb1); __builtin_amdgcn_sched_barrier(0);
            G_MM(xa0, xa1, xb0, xb1); G_RD(o2, xa0, xa1, xb0, xb1); __builtin_amdgcn_sched_barrier(0);
            G_MM(ya0, ya1, yb0, yb1); G_RD(o3, ya0, ya1, yb0, yb1); __builtin_amdgcn_sched_barrier(0);
            G_MM(xa0, xa1, xb0, xb1);
            G_MM(ya0, ya1, yb0, yb1);
#undef G_RD
#undef G_MM
        } else {
            G_STEP(pa, pb, o0); G_STEP(pa, pb, o1); G_STEP(pa, pb, o2); G_STEP(pa, pb, o3);
        }
    }
    if (ROWSS) { ss[0] += __shfl_xor(ss[0], 32, 64); ss[1] += __shfl_xor(ss[1], 32, 64); }
#undef G_DMA
#undef G_SS
#undef G_STEP
}

__device__ __forceinline__ void tile_range(int ntiles, int& lo, int& hi) {
    const int G = gridDim.x, b = blockIdx.x;
    const int vb = ((G & 7) == 0) ? ((b & 7) * (G >> 3) + (b >> 3)) : b;
    const int per = (ntiles + G - 1) / G;
    lo = vb * per; hi = lo + per; if (hi > ntiles) hi = ntiles;
}
constexpr int ST_P = 68;
static_assert(4 * 64 * ST_P * 4 <= LDS_TOTAL, "staging LDS");
template <bool ROWSS, class EPI, class EPIROW, class RSC>
__device__ __forceinline__ void gemm_t(const bf16* __restrict__ Wt, int ldw, int N, const bf16* __restrict__ X, int ldx, int M, int K, int tn_direct, EPI epi, EPIROW epirow, RSC rowscale, char* lds) {
    const int tid = tidx(), lane = tid & 63, w = tid >> 6, r32 = lane & 31, hi = lane >> 5;
    const int tilesN = N / 128, tilesM = M / 128, nk = K / 64;
    int tlo, thi; tile_range(tilesM * tilesN, tlo, thi);
    for (int tile = tlo; tile < thi; ++tile) {
        const int tm = tile / tilesN, tn = tile % tilesN;
        f32x16 acc[4]; float ss[4];
        gemm_kloop<0, ROWSS>(Wt + (size_t)(tn * 128) * ldw, ldw, X + (size_t)(tm * 128) * ldx, ldx, nk, acc, ss, lds, tid);
        if (tn < tn_direct) {
            __syncthreads();
            float* st = (float*)lds + w * (64 * ST_P);
            const float m0_ = rowscale(ss[0]), m1_ = rowscale(ss[1]);
#pragma unroll
            for (int i = 0; i < 2; ++i)
#pragma unroll
                for (int j = 0; j < 2; ++j)
#pragma unroll
                    for (int g = 0; g < 4; ++g) {
                        const float mj = j ? m1_ : m0_;
                        *(float4*)(st + (32 * j + r32) * ST_P + 32 * i + 8 * g + 4 * hi) = make_float4(acc[i * 2 + j][4 * g] * mj, acc[i * 2 + j][4 * g + 1] * mj, acc[i * 2 + j][4 * g + 2] * mj, acc[i * 2 + j][4 * g + 3] * mj);
                    }
            const int rr = lane >> 4, ch = lane & 15;
#pragma unroll 4
            for (int it = 0; it < 16; ++it) {
                const int row = it * 4 + rr;
                const float4 v = *(const float4*)(st + row * ST_P + ch * 4);
                epirow(tm * 128 + (w & 1) * 64 + row, tn * 128 + (w >> 1) * 64 + ch * 4, v);
            }
        } else {
#pragma unroll
            for (int i = 0; i < 2; ++i)
#pragma unroll
                for (int j = 0; j < 2; ++j) {
                    const int tl = (w & 1) * 64 + j * 32;
                    epi(tn * 128 + (w >> 1) * 64 + i * 32, tm * 128 + tl, acc[i * 2 + j], r32, hi, ss[j]);
                }
        }
        __syncthreads();
    }
}

__device__ __forceinline__ void transpose_tiled(const float* __restrict__ W, bf16* __restrict__ Wt, int K, int N, int Npad, int ldk, const float* __restrict__ gain, char* lds) {
    float (*tl)[65] = (float (*)[65])lds;
    const int tid = tidx(), a = tid & 63, q = tid >> 6;
    const int tK = K / 64, tN = Npad / 64;
    for (int tile = blockIdx.x; tile < tK * tN; tile += gridDim.x) {
        const int k0 = (tile / tN) * 64, n0 = (tile % tN) * 64;
#pragma unroll 4
        for (int i = 0; i < 16; ++i) {
            const int k = k0 + q * 16 + i, n = n0 + a;
            float v = (n < N) ? W[(size_t)k * N + n] : 0.f;
            if (gain) v *= gain[k];
            tl[q * 16 + i][a] = v;
        }
        __syncthreads();
#pragma unroll 4
        for (int i = 0; i < 16; ++i) { const int nl = q * 16 + i; Wt[(size_t)(n0 + nl) * ldk + k0 + a] = f2bf(tl[a][nl]); }
        __syncthreads();
    }
}

__device__ __forceinline__ void quant_row(const float4 (&v)[4], unsigned char* __restrict__ dst, float* __restrict__ scl, int r, int lane) {
    float am = 0.f;
#pragma unroll
    for (int j = 0; j < 4; ++j) am = fmaxf(am, fmaxf(fmaxf(fabsf(v[j].x), fabsf(v[j].y)), fmaxf(fabsf(v[j].z), fabsf(v[j].w))));
#pragma unroll
    for (int m = 32; m >= 1; m >>= 1) am = fmaxf(am, __shfl_xor(am, m, 64));
    const float sc = (am > 0.f) ? am * (1.f / 448.f) : 1.f;
    const float is = 1.f / sc;
    uint4 o;
    { int w = 0; w = __builtin_amdgcn_cvt_pk_fp8_f32(v[0].x * is, v[0].y * is, w, false); w = __builtin_amdgcn_cvt_pk_fp8_f32(v[0].z * is, v[0].w * is, w, true); o.x = (unsigned)w; }
    { int w = 0; w = __builtin_amdgcn_cvt_pk_fp8_f32(v[1].x * is, v[1].y * is, w, false); w = __builtin_amdgcn_cvt_pk_fp8_f32(v[1].z * is, v[1].w * is, w, true); o.y = (unsigned)w; }
    { int w = 0; w = __builtin_amdgcn_cvt_pk_fp8_f32(v[2].x * is, v[2].y * is, w, false); w = __builtin_amdgcn_cvt_pk_fp8_f32(v[2].z * is, v[2].w * is, w, true); o.z = (unsigned)w; }
    { int w = 0; w = __builtin_amdgcn_cvt_pk_fp8_f32(v[3].x * is, v[3].y * is, w, false); w = __builtin_amdgcn_cvt_pk_fp8_f32(v[3].z * is, v[3].w * is, w, true); o.w = (unsigned)w; }
    { const int lay = r / NEXP, e = r % NEXP; *(uint4*)(dst + (((size_t)(lay * 8 + (lane >> 3)) * NEXP + e) * 128) + (lane & 7) * 16) = o; }
    if (lane == 0) scl[r] = sc;
}
__device__ __forceinline__ unsigned pack_i8x4(float a, float b, float c, float d) {
    const int ia = __float2int_rn(a), ib = __float2int_rn(b), ic = __float2int_rn(c), id = __float2int_rn(d);
    return (unsigned)(ia & 255) | ((unsigned)(ib & 255) << 8) | ((unsigned)(ic & 255) << 16) | ((unsigned)(id & 255) << 24);
}
__device__ __forceinline__ void quant_row_i8(const float4 (&v)[4], unsigned char* __restrict__ dst, float* __restrict__ scl, int r, int lane) {
    float am = 0.f;
#pragma unroll
    for (int j = 0; j < 4; ++j) am = fmaxf(am, fmaxf(fmaxf(fabsf(v[j].x), fabsf(v[j].y)), fmaxf(fabsf(v[j].z), fabsf(v[j].w))));
#pragma unroll
    for (int m = 32; m >= 1; m >>= 1) am = fmaxf(am, __shfl_xor(am, m, 64));
    const float sc = (am > 0.f) ? am * (1.f / 127.f) : 1.f;
    const float is = 1.f / sc;
    uint4 o;
    o.x = pack_i8x4(v[0].x * is, v[0].y * is, v[0].z * is, v[0].w * is); o.y = pack_i8x4(v[1].x * is, v[1].y * is, v[1].z * is, v[1].w * is);
    o.z = pack_i8x4(v[2].x * is, v[2].y * is, v[2].z * is, v[2].w * is); o.w = pack_i8x4(v[3].x * is, v[3].y * is, v[3].z * is, v[3].w * is);
    { const int lay = r / NEXP, e = r % NEXP; *(uint4*)(dst + (((size_t)(lay * 8 + (lane >> 3)) * NEXP + e) * 128) + (lane & 7) * 16) = o; }
    if (lane == 0) scl[r] = sc;
}
template <bool I8>
__device__ __forceinline__ void convert_table(const float* __restrict__ src, unsigned char* __restrict__ dst, float* __restrict__ scl, int rows) {
    static_assert(TAB_FP8, "fp8 tables");
    const int lane = tidx() & 63;
    const int nw = nwave();
    for (int r = gwave(); r < rows; r += 4 * nw) {
        float4 v[4][4]; int rr[4];
#pragma unroll
        for (int u = 0; u < 4; ++u) {
            rr[u] = (r + u * nw < rows) ? (r + u * nw) : r;
            const float4* s0 = (const float4*)(src + (size_t)rr[u] * D);
#pragma unroll
            for (int j = 0; j < 4; ++j) v[u][j] = s0[lane * 4 + j];
        }
#pragma unroll
        for (int u = 0; u < 4; ++u) {
            if (u == 0 || rr[u] != r) { if (I8) quant_row_i8(v[u], dst, scl, rr[u], lane); else quant_row(v[u], dst, scl, rr[u], lane); }
        }
    }
}
__device__ __forceinline__ void phase_prep(const Params& P, char* lds) {
    unsigned char* ws = P.ws;
    for (int l = 0; l < DEPTH; ++l) {
        transpose_tiled(P.w_in + (size_t)l * D * DIN, (bf16*)(ws + WS_WIN) + (size_t)l * DINP * LDW, D, DIN, DINP, LDW, nullptr, lds);
        transpose_tiled(P.w_uq + (size_t)l * QR * 768, (bf16*)(ws + WS_WUQ) + (size_t)l * 768 * QR, QR, 768, 768, QR, P.q_norm + l * QR, lds);
        transpose_tiled(P.w_uk + (size_t)l * KVR * 512, (bf16*)(ws + WS_WUKV) + (size_t)l * 1024 * KVR, KVR, 512, 512, KVR, P.kv_norm + l * KVR, lds);
        transpose_tiled(P.w_uv + (size_t)l * KVR * 512, (bf16*)(ws + WS_WUKV) + (size_t)l * 1024 * KVR + (size_t)512 * KVR, KVR, 512, 512, KVR, P.kv_norm + l * KVR, lds);
        transpose_tiled(P.w_out + (size_t)l * D * D, (bf16*)(ws + WS_WOUT) + (size_t)l * D * LDW, D, D, D, LDW, nullptr, lds);
    }
    {
        bf16* Wc = (bf16*)(ws + WS_WPQ);
        float (*As)[68] = (float (*)[68])lds;
        float (*Bs)[68] = (float (*)[68])(lds + 16 * 68 * 4);
        const int tid = tidx(), tx = tid & 15, ty = tid >> 4;
        const int lr = tid >> 2, ld4 = (tid & 3) * 4;
        for (int tile = blockIdx.x; tile < (DEPTH * 2048 / 64) * (D / 64); tile += gridDim.x) {
            const int row0 = (tile >> 4) * 64, k0 = (tile & 15) * 64;
            const int l = row0 >> 11, hp = (row0 >> 7) & 15, n0 = row0 & 127;
            const float* skp = P.peer_subkeys + (((size_t)l * 2 + (hp & 1)) * NKEY + n0 + lr) * 128 + ld4;
            const float* wqp = P.peer_wq + ((size_t)l * D + k0 + lr) * 2048 + hp * 128 + ld4;
            float acc[4][4];
#pragma unroll
            for (int i = 0; i < 4; ++i)
#pragma unroll
                for (int j = 0; j < 4; ++j) acc[i][j] = 0.f;
            for (int d0 = 0; d0 < 128; d0 += 16) {
                const float4 av = *(const float4*)(skp + d0), bv = *(const float4*)(wqp + d0);
                As[ld4 + 0][lr] = av.x; As[ld4 + 1][lr] = av.y; As[ld4 + 2][lr] = av.z; As[ld4 + 3][lr] = av.w;
                Bs[ld4 + 0][lr] = bv.x; Bs[ld4 + 1][lr] = bv.y; Bs[ld4 + 2][lr] = bv.z; Bs[ld4 + 3][lr] = bv.w;
                __syncthreads();
#pragma unroll
                for (int kk = 0; kk < 16; ++kk) {
                    const float4 a4 = *(const float4*)&As[kk][ty * 4], b4 = *(const float4*)&Bs[kk][tx * 4];
                    const float aa[4] = {a4.x, a4.y, a4.z, a4.w}, bb[4] = {b4.x, b4.y, b4.z, b4.w};
#pragma unroll
                    for (int i = 0; i < 4; ++i)
#pragma unroll
                        for (int j = 0; j < 4; ++j) acc[i][j] = fmaf(aa[i], bb[j], acc[i][j]);
                }
                __syncthreads();
            }
#pragma unroll
            for (int i = 0; i < 4; ++i) {
                uint2 o; o.x = pack2(acc[i][0], acc[i][1]); o.y = pack2(acc[i][2], acc[i][3]);
                *(uint2*)(Wc + (size_t)(row0 + ty * 4 + i) * LDW + k0 + tx * 4) = o;
            }
        }
    }
    float* rope = (float*)(ws + WS_ROPE);
    for (size_t i = gtid(); i < (size_t)S * 16; i += gnth()) {
        const int s = (int)(i >> 4), f = (int)(i & 15);
        const double inv = pow(10000.0, -(double)f / 16.0);
        const double ang = (double)s * inv;
        rope[2 * i] = (float)cos(ang); rope[2 * i + 1] = (float)sin(ang);
    }
}

__device__ __forceinline__ void phase_tables(const Params& P) {
    convert_table<true>(P.peer_u, P.ws + WS_TABU, (float*)(P.ws + WS_TSCU), DEPTH * NEXP);
    convert_table<false>(P.peer_v, P.ws + WS_TABV, (float*)(P.ws + WS_TSCV), DEPTH * NEXP);
}

__device__ __forceinline__ void phase_norm(const float* __restrict__ h, const float* __restrict__ g, bf16* __restrict__ xn) {
    const int lane = tidx() & 63, nw = nwave();
    for (int t = gwave(); t < T; t += 2 * nw) {
        const int t2 = (t + nw < T) ? (t + nw) : t;
        float4 v[2][4];
#pragma unroll
        for (int j = 0; j < 4; ++j) { v[0][j] = ((const float4*)(h + (size_t)t * D))[j * 64 + lane]; v[1][j] = ((const float4*)(h + (size_t)t2 * D))[j * 64 + lane]; }
#pragma unroll
        for (int u = 0; u < 2; ++u) {
            float ss = 0.f;
#pragma unroll
            for (int j = 0; j < 4; ++j) ss += v[u][j].x * v[u][j].x + v[u][j].y * v[u][j].y + v[u][j].z * v[u][j].z + v[u][j].w * v[u][j].w;
            ss = wave_sum(ss);
            const float r = rsqrtf(ss * (1.f / D) + EPS);
            const int tt = u ? t2 : t;
            if (u == 0 || t2 != t) {
#pragma unroll
                for (int j = 0; j < 4; ++j) {
                    const float4 gg = ((const float4*)g)[j * 64 + lane];
                    uint2 o; o.x = pack2(v[u][j].x * r * gg.x, v[u][j].y * r * gg.y); o.y = pack2(v[u][j].z * r * gg.z, v[u][j].w * r * gg.w);
                    ((uint2*)(xn + (size_t)tt * LDX))[j * 64 + lane] = o;
                }
            }
        }
    }
}

__device__ __forceinline__ void phase_norm_q(const Params& P, int l) {
    const int lane = tidx() & 63, nw = nwave();
    const float* g = P.norm_ffn + l * D;
    bf16* xn = (bf16*)(P.ws + WS_XN);
    unsigned* xq = (unsigned*)(P.ws + WS_XQ);
    float* xsc = (float*)(P.ws + WS_XS);
    for (int t = gwave(); t < T; t += 2 * nw) {
        const int t2 = (t + nw < T) ? (t + nw) : t;
        float4 v[2][4];
#pragma unroll
        for (int j = 0; j < 4; ++j) { v[0][j] = ((const float4*)(P.out + (size_t)t * D))[j * 64 + lane]; v[1][j] = ((const float4*)(P.out + (size_t)t2 * D))[j * 64 + lane]; }
#pragma unroll
        for (int u = 0; u < 2; ++u) {
            float ss = 0.f;
#pragma unroll
            for (int j = 0; j < 4; ++j) ss += v[u][j].x * v[u][j].x + v[u][j].y * v[u][j].y + v[u][j].z * v[u][j].z + v[u][j].w * v[u][j].w;
            ss = wave_sum(ss);
            const float r = rsqrtf(ss * (1.f / D) + EPS);
            const int tt = u ? t2 : t;
            if (u == 0 || t2 != t) {
                float am = 0.f;
#pragma unroll
                for (int j = 0; j < 4; ++j) {
                    const float4 gg = ((const float4*)g)[j * 64 + lane];
                    v[u][j].x *= r * gg.x; v[u][j].y *= r * gg.y; v[u][j].z *= r * gg.z; v[u][j].w *= r * gg.w;
                    am = fmaxf(am, fmaxf(fmaxf(fabsf(v[u][j].x), fabsf(v[u][j].y)), fmaxf(fabsf(v[u][j].z), fabsf(v[u][j].w))));
                    uint2 o; o.x = pack2(v[u][j].x, v[u][j].y); o.y = pack2(v[u][j].z, v[u][j].w);
                    ((uint2*)(xn + (size_t)tt * LDX))[j * 64 + lane] = o;
                }
#pragma unroll
                for (int m = 32; m >= 1; m >>= 1) am = fmaxf(am, __shfl_xor(am, m, 64));
                const float sc = (am > 0.f) ? am * (1.f / 127.f) : 1.f, is = 1.f / sc;
#pragma unroll
                for (int j = 0; j < 4; ++j) xq[(size_t)tt * (D / 4) + j * 64 + lane] = pack_i8x4(v[u][j].x * is, v[u][j].y * is, v[u][j].z * is, v[u][j].w * is);
                if (lane == 0) xsc[tt] = sc;
            }
        }
    }
}

__device__ __forceinline__ void phase_mixlocal(const Params& P, int l, char* lds) {
    const bf16* proj = (const bf16*)(P.ws + WS_PROJ);
    bf16* Y = (bf16*)(P.ws + WS_XN);
    const int tid = tidx();
    {
        const float* cw = P.conv_w + (size_t)l * 3 * 256;
        for (size_t i = gtid(); i < (size_t)T * 32; i += gnth()) {
            const int t = (int)(i >> 5), c0 = (int)(i & 31) * 8, s = t & (S - 1);
            const bf16* pr = proj + (size_t)t * DINP;
            float acc[8];
#pragma unroll
            for (int e = 0; e < 8; ++e) acc[e] = 0.f;
#pragma unroll
            for (int j = 0; j < 3; ++j) {
                if (s - 2 + j >= 0) {
                    const bf16* pp = pr - (size_t)(2 - j) * DINP;
                    const uint4 g = *(const uint4*)(pp + C_CG + c0), hc = *(const uint4*)(pp + C_HC + c0);
                    const float4 w0 = *(const float4*)(cw + j * 256 + c0), w1 = *(const float4*)(cw + j * 256 + c0 + 4);
                    acc[0] = fmaf(w0.x, bflo(g.x) * bflo(hc.x), acc[0]); acc[1] = fmaf(w0.y, bfhi(g.x) * bfhi(hc.x), acc[1]);
                    acc[2] = fmaf(w0.z, bflo(g.y) * bflo(hc.y), acc[2]); acc[3] = fmaf(w0.w, bfhi(g.y) * bfhi(hc.y), acc[3]);
                    acc[4] = fmaf(w1.x, bflo(g.z) * bflo(hc.z), acc[4]); acc[5] = fmaf(w1.y, bfhi(g.z) * bfhi(hc.z), acc[5]);
                    acc[6] = fmaf(w1.z, bflo(g.w) * bflo(hc.w), acc[6]); acc[7] = fmaf(w1.w, bfhi(g.w) * bfhi(hc.w), acc[7]);
                }
            }
            const uint4 bg = *(const uint4*)(pr + C_BG + c0);
            uint4 o;
            o.x = pack2(bflo(bg.x) * acc[0], bfhi(bg.x) * acc[1]); o.y = pack2(bflo(bg.y) * acc[2], bfhi(bg.y) * acc[3]);
            o.z = pack2(bflo(bg.z) * acc[4], bfhi(bg.z) * acc[5]); o.w = pack2(bflo(bg.w) * acc[6], bfhi(bg.w) * acc[7]);
            *(uint4*)(Y + (size_t)t * LDX + c0) = o;
        }
    }
    {
        float (*pl)[68] = (float (*)[68])lds;
        const float* pw = P.pool_w + (size_t)l * 4 * 64 * 64;
        const float* psc = P.pool_scale + l * 256;
        const int a = tid & 63, q = tid >> 6;
        for (int tile = blockIdx.x; tile < (T / 64) * 4; tile += gridDim.x) {
            const int g = tile & 3, t0 = (tile >> 2) * 64;
            const int w = 2 << g;
            {
                const bf16* col = proj + C_HP + g * 64 + a;
                const int tf = t0 + q * 16, sf = tf & (S - 1);
                float xr[31];
#pragma unroll
                for (int d = 1; d <= 15; ++d) xr[15 - d] = (d < w && sf - d >= 0) ? bf2f(col[(size_t)(tf - d) * DINP]) : 0.f;
#pragma unroll
                for (int i = 0; i < 16; ++i) xr[15 + i] = bf2f(col[(size_t)(tf + i) * DINP]);
                float sum = 0.f;
#pragma unroll
                for (int d = 1; d <= 15; ++d) sum += xr[15 - d];
#pragma unroll
                for (int i = 0; i < 16; ++i) {
                    const int s = sf + i;
                    sum += xr[15 + i];
                    const int cnt = (s + 1 < w) ? (s + 1) : w;
                    pl[q * 16 + i][a] = sum / (float)cnt - xr[15 + i];
                    const int o = 15 + i + 1;
                    const float old = (g == 0) ? xr[o - 2] : (g == 1) ? xr[o - 4] : (g == 2) ? xr[o - 8] : xr[o - 16];
                    sum -= old;
                }
            }
            __syncthreads();
            {
                float pc[64];
#pragma unroll
                for (int c = 0; c < 64; ++c) pc[c] = pw[(g * 64 + c) * 64 + a];
                const float sc = psc[g * 64 + a];
#pragma unroll 2
                for (int i = 0; i < 16; ++i) {
                    const float4* row = (const float4*)&pl[q * 16 + i][0];
                    float m0 = 0.f, m1 = 0.f;
#pragma unroll
                    for (int c4 = 0; c4 < 16; ++c4) { const float4 v = row[c4]; m0 = fmaf(v.x, pc[4 * c4], m0); m1 = fmaf(v.y, pc[4 * c4 + 1], m1); m0 = fmaf(v.z, pc[4 * c4 + 2], m0); m1 = fmaf(v.w, pc[4 * c4 + 3], m1); }
                    Y[(size_t)(t0 + q * 16 + i) * LDX + 256 + g * 64 + a] = f2bf((m0 + m1) * sc);
                }
            }
            __syncthreads();
        }
    }
}

typedef short v4i16_t __attribute__((ext_vector_type(4)));
typedef __attribute__((address_space(3))) v4i16_t* lds_v4p;
__device__ __forceinline__ v4i16_t vtr(const char* p) { return __builtin_amdgcn_ds_read_tr16_b64_v4i16((lds_v4p)p); }
constexpr int A_KP = 208, A_VP = 192;
constexpr int A_KB = 64 * A_KP, A_VB = 64 * A_VP, A_BUF = A_KB + A_VB, ATTN_LDS = 2 * A_BUF;
static_assert(ATTN_LDS <= GEMM_LDS, "attention LDS");

__device__ __forceinline__ void attn_unit(const bf16* __restrict__ Qb, const bf16* __restrict__ Kb, const bf16* __restrict__ Vb, bf16* __restrict__ Y, int bh, int qblk, char* lds) {
    const int tid = tidx(), lane = tid & 63, w = tid >> 6, r32 = lane & 31, hi = lane >> 5;
    const int q0 = qblk * 128, qw0 = q0 + w * 32;
    const int NT = 2 * qblk + 2;
    bf16x8 qf[6];
    {
        const bf16* qp = Qb + ((size_t)bh * S + qw0 + r32) * DQK + hi * 8;
#pragma unroll
        for (int ks = 0; ks < 6; ++ks) qf[ks] = *(const bf16x8*)(qp + ks * 16);
    }
    f32x16 o0, o1;
#pragma unroll
    for (int r = 0; r < 16; ++r) { o0[r] = 0.f; o1[r] = 0.f; }
    float m = -1e30f, lsum = 0.f;
    const char* Kg = (const char*)(Kb + (size_t)bh * S * DQK) + tid * 16;
    const char* Vg = (const char*)(Vb + (size_t)bh * S * DV) + tid * 16;
    const int kl0 = (tid / 12) * A_KP + (tid % 12) * 16, kl1 = ((tid + 256) / 12) * A_KP + ((tid + 256) % 12) * 16, kl2 = ((tid + 512) / 12) * A_KP + ((tid + 512) % 12) * 16;
    const int vl0 = (tid >> 3) * A_VP + (tid & 7) * 16, vl1 = vl0 + 32 * A_VP;
    uint4 pk0, pk1, pk2, pv0, pv1, qk0, qk1, qk2, qv0, qv1;
#define A_LOAD(S, t) do { const char* kg = Kg + (size_t)(t) * (64 * 192); const char* vg = Vg + (size_t)(t) * (64 * 128); \
        S##k0 = *(const uint4*)(kg); S##k1 = *(const uint4*)(kg + 4096); S##k2 = *(const uint4*)(kg + 8192); S##v0 = *(const uint4*)(vg); S##v1 = *(const uint4*)(vg + 4096); } while (0)
#define A_STORE(S, bK, bV) do { *(uint4*)(bK + kl0) = S##k0; *(uint4*)(bK + kl1) = S##k1; *(uint4*)(bK + kl2) = S##k2; *(uint4*)(bV + vl0) = S##v0; *(uint4*)(bV + vl1) = S##v1; } while (0)
#define A_PV(pf, kofs) do { \
            { const v4i16_t lo = vtr(pv + (kofs) * A_VP), hh = vtr(pv + ((kofs) + 8) * A_VP); const bf16x8 vf = {lo[0], lo[1], lo[2], lo[3], hh[0], hh[1], hh[2], hh[3]}; o0 = MFMA32(vf, pf.v, o0); } \
            { const v4i16_t lo = vtr(pv + (kofs) * A_VP + 64), hh = vtr(pv + ((kofs) + 8) * A_VP + 64); const bf16x8 vf = {lo[0], lo[1], lo[2], lo[3], hh[0], hh[1], hh[2], hh[3]}; o1 = MFMA32(vf, pf.v, o1); } } while (0)
    const int pvo = (4 * hi + ((lane & 15) >> 2)) * A_VP + (16 * ((lane >> 4) & 1) + 4 * (lane & 3)) * 2;
    A_LOAD(p, 0); A_LOAD(q, 1);
    for (int t2 = 0; t2 < NT; t2 += 2) {
#pragma unroll
        for (int half = 0; half < 2; ++half) {
            const int t = t2 + half;
            char* bK = lds + half * A_BUF; char* bV = bK + A_KB;
            if (half == 0) A_STORE(p, bK, bV); else A_STORE(q, bK, bV);
            __syncthreads();
            { const int tn = (t + 2 < NT) ? (t + 2) : (NT - 2 + half); if (half == 0) A_LOAD(p, tn); else A_LOAD(q, tn); }
        const int kt0 = t * 64;
        if (kt0 <= qw0) {
            f32x16 s0, s1;
#pragma unroll
            for (int r = 0; r < 16; ++r) { s0[r] = 0.f; s1[r] = 0.f; }
            const char* pk = bK + r32 * A_KP + hi * 16;
#pragma unroll
            for (int ks = 0; ks < 6; ++ks) {
                const bf16x8 a0 = *(const bf16x8*)(pk + ks * 32), a1 = *(const bf16x8*)(pk + 32 * A_KP + ks * 32);
                s0 = MFMA32(a0, qf[ks], s0); s1 = MFMA32(a1, qf[ks], s1);
            }
            if (kt0 + 63 > qw0) {
                const int qrow = qw0 + r32;
#pragma unroll
                for (int r = 0; r < 16; ++r) { const int key = kt0 + crow(r, hi); if (key > qrow) s0[r] = -INFINITY; if (key + 32 > qrow) s1[r] = -INFINITY; }
            }
            float mx = fmaxf(s0[0], s1[0]);
#pragma unroll
            for (int r = 1; r < 16; ++r) mx = fmaxf(mx, fmaxf(s0[r], s1[r]));
            mx = fmaxf(mx, __shfl_xor(mx, 32, 64));
            const float mn = fmaxf(m, mx), m_prev = m;
            const float alpha = __builtin_amdgcn_exp2f(m - mn);
            m = mn;
            float ps = 0.f;
#pragma unroll
            for (int r = 0; r < 16; ++r) { s0[r] = __builtin_amdgcn_exp2f(s0[r] - mn); s1[r] = __builtin_amdgcn_exp2f(s1[r] - mn); ps += s0[r] + s1[r]; }
            if (__builtin_amdgcn_ballot_w64(mn > m_prev) != 0ull) {
                lsum *= alpha;
#pragma unroll
                for (int r = 0; r < 16; ++r) { o0[r] *= alpha; o1[r] *= alpha; }
            }
            lsum += ps;
            union { unsigned u[4]; bf16x8 v; } p00, p01, p10, p11;
#pragma unroll
            for (int j = 0; j < 4; ++j) { p00.u[j] = cvtpk(s0[2 * j], s0[2 * j + 1]); p01.u[j] = cvtpk(s0[8 + 2 * j], s0[9 + 2 * j]); p10.u[j] = cvtpk(s1[2 * j], s1[2 * j + 1]); p11.u[j] = cvtpk(s1[8 + 2 * j], s1[9 + 2 * j]); }
            const char* pv = bV + pvo;
            A_PV(p00, 0); A_PV(p01, 16); A_PV(p10, 32); A_PV(p11, 48);
        }
        }
    }
    lsum += __shfl_xor(lsum, 32, 64);
    const float inv = 1.f / lsum;
    const int b = bh >> 3, h = bh & 7;
    bf16* yo = Y + (size_t)(b * S + qw0 + r32) * LDX + 512 + h * 64 + 4 * hi;
#pragma unroll
    for (int g = 0; g < 4; ++g) {
        uint2 a, c;
        a.x = cvtpk(o0[4 * g] * inv, o0[4 * g + 1] * inv); a.y = cvtpk(o0[4 * g + 2] * inv, o0[4 * g + 3] * inv);
        c.x = cvtpk(o1[4 * g] * inv, o1[4 * g + 1] * inv); c.y = cvtpk(o1[4 * g + 2] * inv, o1[4 * g + 3] * inv);
        *(uint2*)(yo + 8 * g) = a; *(uint2*)(yo + 32 + 8 * g) = c;
    }
    __syncthreads();
}
__device__ __forceinline__ void phase_attn(const Params& P, char* lds) {
    const bf16* Qb = (const bf16*)(P.ws + WS_Q);
    const bf16* Kb = (const bf16*)(P.ws + WS_K);
    const bf16* Vb = (const bf16*)(P.ws + WS_V);
    bf16* Y = (bf16*)(P.ws + WS_XN);
    for (int u = blockIdx.x; u < NB * NH * (S / 128); u += gridDim.x) {
        const int bh = u & 31, v = u >> 5;
        const int qblk = (v < 16) ? (63 - v) : (v < 32) ? (v - 16) : (v < 48) ? (79 - v) : (v - 32);
        attn_unit(Qb, Kb, Vb, Y, bh, qblk, lds);
    }
}

#define NET_HD __device__ __forceinline__
#define NET_U2F(u) __uint_as_float(u)
#define NET_F2U(f) __float_as_uint(f)
#define CE_DESC(a, b) do { const float hi__ = fmaxf(a, b), lo__ = fminf(a, b); a = hi__; b = lo__; } while (0)
NET_HD void sort16_desc(float (&v)[16]) {
#define CE2(a, b) CE_DESC(v[a], v[b])
    CE2(0,13); CE2(1,12); CE2(2,15); CE2(3,14); CE2(4,8); CE2(5,6); CE2(7,11); CE2(9,10);
    CE2(0,5); CE2(1,7); CE2(2,9); CE2(3,4); CE2(6,13); CE2(8,14); CE2(10,15); CE2(11,12);
    CE2(0,1); CE2(2,3); CE2(4,5); CE2(6,8); CE2(7,9); CE2(10,11); CE2(12,13); CE2(14,15);
    CE2(0,2); CE2(1,3); CE2(4,10); CE2(5,11); CE2(6,7); CE2(8,9); CE2(12,14); CE2(13,15);
    CE2(1,2); CE2(3,12); CE2(4,6); CE2(5,7); CE2(8,10); CE2(9,11); CE2(13,14);
    CE2(1,4); CE2(2,6); CE2(5,8); CE2(7,10); CE2(9,13); CE2(11,14);
    CE2(2,4); CE2(3,6); CE2(9,12); CE2(11,13);
    CE2(3,5); CE2(6,8); CE2(7,9); CE2(10,12);
    CE2(3,4); CE2(5,6); CE2(7,8); CE2(9,10); CE2(11,12);
    CE2(6,7); CE2(8,9);
#undef CE2
}
NET_HD void merge16_desc(float (&a)[16], const float (&b)[16]) {
#pragma unroll
    for (int i = 0; i < 16; ++i) a[i] = fmaxf(a[i], b[15 - i]);
#pragma unroll
    for (int j = 8; j > 0; j >>= 1) {
#pragma unroll
        for (int i = 0; i < 16; ++i) { const int l = i ^ j; if (l > i) CE_DESC(a[i], a[l]); }
    }
}
NET_HD void top16_of_64(float (&g0)[16], float (&g1)[16], float (&g2)[16], float (&g3)[16]) {
    sort16_desc(g0); sort16_desc(g1); sort16_desc(g2); sort16_desc(g3);
    merge16_desc(g0, g1); merge16_desc(g2, g3); merge16_desc(g0, g2);
}
NET_HD float u2f(unsigned u) { return NET_U2F(u); }
NET_HD unsigned f2u(float f) { return NET_F2U(f); }
template <class V16>
NET_HD void lane_top16(const V16& s0, const V16& s1, const V16& s2, const V16& s3, int hi, float (&out)[16]) {
    float g0[16], g1[16], g2[16], g3[16];
#pragma unroll
    for (int r = 0; r < 16; ++r) {
        const unsigned nb = (unsigned)((r & 3) + 8 * (r >> 2));
        g0[r] = u2f((f2u(s0[r]) & 0xFFFFFF80u) | nb); g1[r] = u2f((f2u(s1[r]) & 0xFFFFFF80u) | (nb + 32u));
        g2[r] = u2f((f2u(s2[r]) & 0xFFFFFF80u) | (nb + 64u)); g3[r] = u2f((f2u(s3[r]) & 0xFFFFFF80u) | (nb + 96u));
    }
    top16_of_64(g0, g1, g2, g3);
    const unsigned h4 = (unsigned)hi << 2;
#pragma unroll
    for (int i = 0; i < 16; ++i) out[i] = u2f(f2u(g0[i]) | h4);
}
constexpr int cand_slot(int a, int b) { int n = 0; for (int x = 0; x < 16; ++x) for (int y = 0; y < 16; ++y) { if (x == a && y == b) return n; if ((x + 1) * (y + 1) <= 16) ++n; } return n; }
NET_HD void cand_top16(const float (&s1)[16], const float (&s2)[16], float (&c)[16]) {
    float g0[16], g1[16], g2[16], g3[16];
#pragma unroll
    for (int i = 0; i < 16; ++i) { g0[i] = -3.0e38f; g1[i] = -3.0e38f; g2[i] = -3.0e38f; g3[i] = -3.0e38f; }
#pragma unroll
    for (int a = 0; a < 16; ++a) {
#pragma unroll
        for (int b = 0; b < 16; ++b) {
            if ((a + 1) * (b + 1) <= 16) {
                const int sl = cand_slot(a, b);
                const float v = u2f((f2u(s1[a] + s2[b]) & 0xFFFFFF00u) | (unsigned)(a * 16 + b));
                if (sl < 16) g0[sl & 15] = v; else if (sl < 32) g1[sl & 15] = v; else if (sl < 48) g2[sl & 15] = v; else g3[sl & 15] = v;
            }
        }
    }
    top16_of_64(g0, g1, g2, g3);
#pragma unroll
    for (int i = 0; i < 16; ++i) c[i] = g0[i];
}

__device__ __forceinline__ void phase_route(const Params& P, int l, char* lds) {
    const bf16* XN = (const bf16*)(P.ws + WS_XN);
    const bf16* Wc = (const bf16*)(P.ws + WS_WPQ) + (size_t)l * 2048 * LDW;
    int* EXPp = (int*)(P.ws + WS_EXP);
    float* GATEp = (float*)(P.ws + WS_GATE);
    const int tid = tidx(), lane = tid & 63, w = tid >> 6, r32 = lane & 31, hi = lane >> 5;
    int tlo, thi; tile_range((T / 128) * PH, tlo, thi);
    for (int u = tlo; u < thi; ++u) {
        const int tm = u >> 3, h = u & 7;
        float L0[16], L1[16];
        {
            f32x16 acc[4]; float ssd[4];
            gemm_kloop<1, false>(Wc + (size_t)((h * 2 + 0) * 128) * LDW, LDW, XN + (size_t)(tm * 128) * LDX, LDX, D / 64, acc, ssd, lds, tid);
            lane_top16(acc[0], acc[1], acc[2], acc[3], hi, L0);
            float o[16];
#pragma unroll
            for (int i = 0; i < 16; ++i) o[i] = __shfl_xor(L0[i], 32, 64);
            merge16_desc(L0, o);
        }
        float* park = (float*)(lds + GEMM_LDS) + (size_t)(w * 32 + r32) * 16;
        if (hi == 0) {
#pragma unroll
            for (int q = 0; q < 4; ++q) *(float4*)(park + 4 * q) = make_float4(L0[4 * q], L0[4 * q + 1], L0[4 * q + 2], L0[4 * q + 3]);
        }
        {
            f32x16 acc[4]; float ssd[4];
            gemm_kloop<1, false>(Wc + (size_t)((h * 2 + 1) * 128) * LDW, LDW, XN + (size_t)(tm * 128) * LDX, LDX, D / 64, acc, ssd, lds, tid);
            lane_top16(acc[0], acc[1], acc[2], acc[3], hi, L1);
            float o[16];
#pragma unroll
            for (int i = 0; i < 16; ++i) o[i] = __shfl_xor(L1[i], 32, 64);
            merge16_desc(L1, o);
        }
#pragma unroll
        for (int q = 0; q < 4; ++q) { const float4 v = *(const float4*)(park + 4 * q); L0[4 * q] = v.x; L0[4 * q + 1] = v.y; L0[4 * q + 2] = v.z; L0[4 * q + 3] = v.w; }
        float c[16];
        cand_top16(L0, L1, c);
        __syncthreads();
        unsigned char* my = (unsigned char*)lds + tid * 32;
        {
            uint4 a, b;
#define PK4(L, i) ((__float_as_uint(L[i]) & 127u) | ((__float_as_uint(L[i + 1]) & 127u) << 8) | ((__float_as_uint(L[i + 2]) & 127u) << 16) | ((__float_as_uint(L[i + 3]) & 127u) << 24))
            a.x = PK4(L0, 0); a.y = PK4(L0, 4); a.z = PK4(L0, 8); a.w = PK4(L0, 12);
            b.x = PK4(L1, 0); b.y = PK4(L1, 4); b.z = PK4(L1, 8); b.w = PK4(L1, 12);
#undef PK4
            *(uint4*)my = a; *(uint4*)(my + 16) = b;
        }
        int ev[16]; float gv[16]; float den = 0.f;
#pragma unroll
        for (int k = 0; k < 16; ++k) {
            const unsigned ci = __float_as_uint(c[k]) & 255u;
            const int n1 = my[ci >> 4], n2 = my[16 + (ci & 15)];
            ev[k] = n1 * NKEY + n2;
            gv[k] = __expf(c[k] - c[0]); den += gv[k];
        }
        const float iden = 1.f / den;
        if (hi == 0) {
            const int t = tm * 128 + w * 32 + r32;
            uint4* ep = (uint4*)(EXPp + (size_t)t * HK + h * 16);
            float4* gp = (float4*)(GATEp + (size_t)t * HK + h * 16);
#pragma unroll
            for (int q = 0; q < 4; ++q) {
                ep[q] = make_uint4((unsigned)ev[4 * q], (unsigned)ev[4 * q + 1], (unsigned)ev[4 * q + 2], (unsigned)ev[4 * q + 3]);
                gp[q] = make_float4(gv[4 * q] * iden, gv[4 * q + 1] * iden, gv[4 * q + 2] * iden, gv[4 * q + 3] * iden);
            }
        }
        __syncthreads();
    }
}

constexpr size_t WS_PART = WS_PROJ;
static_assert((size_t)8 * T * HK * 4 <= WS_K - WS_PROJ, "PART alias");
constexpr int XI_X = 0, XI_RANK = 1, XI_J = 2, XI_NX = 3, XI_NLOC = 4;
constexpr int CTL_CENSUS = 4096;
constexpr int CTL_BYTES = (CTL_CENSUS + 16) * 4;

template <int M1, int M2, int M3, class TT>
__device__ __forceinline__ void red16x3(TT (&p)[16], int lane) {
#pragma unroll
    for (int i = 0; i < 8; ++i) { const bool up = lane & M1; const TT send = up ? p[i] : p[i + 8], keep = up ? p[i + 8] : p[i]; p[i] = keep + __shfl_xor(send, M1, 64); }
#pragma unroll
    for (int i = 0; i < 4; ++i) { const bool up = lane & M2; const TT send = up ? p[i] : p[i + 4], keep = up ? p[i + 4] : p[i]; p[i] = keep + __shfl_xor(send, M2, 64); }
#pragma unroll
    for (int i = 0; i < 2; ++i) { const bool up = lane & M3; const TT send = up ? p[i] : p[i + 2], keep = up ? p[i + 2] : p[i]; p[i] = keep + __shfl_xor(send, M3, 64); }
}
__device__ __forceinline__ void phase_gu(const Params& P, int l, const volatile int* xi) {
    const unsigned char* XQ = P.ws + WS_XQ;
    const float* XSc = (const float*)(P.ws + WS_XS);
    const int* EXPp = (const int*)(P.ws + WS_EXP);
    float* PART = (float*)(P.ws + WS_PART);
    const int tid = tidx(), lane = tid & 63, w = tid >> 6, g = lane >> 3, c = lane & 7;
    int xo_ = 0; asm volatile("" : "+v"(xo_));
    const int j = __builtin_amdgcn_readfirstlane(xi[xo_ + XI_J]), nx = __builtin_amdgcn_readfirstlane(xi[xo_ + XI_NX]), nloc = __builtin_amdgcn_readfirstlane(xi[xo_ + XI_NLOC]), rank = __builtin_amdgcn_readfirstlane(xi[xo_ + XI_RANK]);
    const int t0 = rank * 4 + w, st = nloc * 4;
    const int n = (t0 < T) ? (T - t0 + st - 1) / st : 0;
    const int i0 = 8 * (c & 1) + 4 * ((c >> 1) & 1) + 2 * ((c >> 2) & 1);
    for (int sl = j; sl < 8 && n > 0; sl += nx) {
        const unsigned char* Us = P.ws + WS_TABU + ((size_t)(l * 8 + sl) * NEXP) * 128;
        const unsigned co = (unsigned)c << 4;
        float* part = PART + (size_t)sl * T * HK;
        const unsigned char* xs = XQ + sl * 128 + c * 16;
#define GU_TK(k) (t0 + (((k) < n) ? (k) : (n - 1)) * st)
#define GU_LOADE(S, t) do { S##lo = EXPp[(size_t)(t) * HK + lane]; S##hi = EXPp[(size_t)(t) * HK + 64 + lane]; } while (0)
#define GU_LOADX(S, t) do { S##a = *(const uint4*)(xs + (size_t)(t) * D); S##s = XSc[t]; } while (0)
#define GU_ISSUE(R, S) do { _Pragma("unroll") for (int i = 0; i < 16; ++i) { \
            const int e = __builtin_amdgcn_ds_bpermute((((8 * i) & 63) + g) << 2, (i < 8) ? S##lo : S##hi); R[i] = *(const uint4*)(Us + (((unsigned)e << 7) | co)); } } while (0)
#define GU_FINISH(R, S, t) do { \
            int p[16]; \
            _Pragma("unroll") for (int i = 0; i < 16; ++i) { int d_ = __builtin_amdgcn_sdot4((int)S##a.x, (int)R[i].x, 0, false); d_ = __builtin_amdgcn_sdot4((int)S##a.y, (int)R[i].y, d_, false); \
                d_ = __builtin_amdgcn_sdot4((int)S##a.z, (int)R[i].z, d_, false); p[i] = __builtin_amdgcn_sdot4((int)S##a.w, (int)R[i].w, d_, false); } \
            red16x3<1, 2, 4, int>(p, lane); \
            part[(size_t)(t) * HK + 8 * i0 + g] = (float)p[0] * S##s; part[(size_t)(t) * HK + 8 * (i0 + 1) + g] = (float)p[1] * S##s; } while (0)
        int eAlo, eAhi, eBlo, eBhi; uint4 xAa, xBa; float xAs, xBs; uint4 rA[16], rB[16];
        GU_LOADE(eA, GU_TK(0)); GU_LOADX(xA, GU_TK(0)); GU_LOADE(eB, GU_TK(1));
        GU_ISSUE(rA, eA);
        for (int k = 0; k < n; k += 2) {
            GU_LOADX(xB, GU_TK(k + 1)); GU_ISSUE(rB, eB); GU_LOADE(eA, GU_TK(k + 2));
            GU_FINISH(rA, xA, GU_TK(k));
            GU_LOADX(xA, GU_TK(k + 2)); GU_ISSUE(rA, eA); GU_LOADE(eB, GU_TK(k + 3));
            GU_FINISH(rB, xB, GU_TK(k + 1));
        }
#undef GU_TK
#undef GU_LOADE
#undef GU_LOADX
#undef GU_ISSUE
#undef GU_FINISH
    }
}
__device__ __forceinline__ void phase_gw(const Params& P, int l) {
    const int* EXPp = (const int*)(P.ws + WS_EXP);
    const float* GATEp = (const float*)(P.ws + WS_GATE);
    const float* PART = (const float*)(P.ws + WS_PART);
    const float* SU = (const float*)(P.ws + WS_TSCU) + (size_t)l * NEXP;
    const float* SV = (const float*)(P.ws + WS_TSCV) + (size_t)l * NEXP;
    unsigned char* WQ = P.ws + WS_WQ8;
    float* WSC = (float*)(P.ws + WS_WSC);
    const int lane = tidx() & 63;
    for (int tb = gwave() * 4; tb < T; tb += nwave() * 4) {
        float wv[4][2];
#pragma unroll
        for (int q = 0; q < 4; ++q)
#pragma unroll
            for (int hk = 0; hk < 2; ++hk) {
                const size_t i = (size_t)(tb + q) * HK + hk * 64 + lane;
                float s = 0.f;
#pragma unroll
                for (int x = 0; x < 8; ++x) s += PART[(size_t)x * T * HK + i];
                const int e = EXPp[i];
                wv[q][hk] = GATEp[i] * gelu_exact(s * SU[e]) * SV[e];
            }
#pragma unroll
        for (int q = 0; q < 4; ++q) {
            float am = fmaxf(fabsf(wv[q][0]), fabsf(wv[q][1]));
#pragma unroll
            for (int m = 32; m >= 1; m >>= 1) am = fmaxf(am, __shfl_xor(am, m, 64));
            const float sc = (am > 0.f) ? am * (1.f / 448.f) : 1.f, is = 1.f / sc;
            const int pk = __builtin_amdgcn_cvt_pk_fp8_f32(wv[q][0] * is, wv[q][1] * is, 0, false);
            WQ[(size_t)(tb + q) * HK + lane] = (unsigned char)(pk & 255);
            WQ[(size_t)(tb + q) * HK + 64 + lane] = (unsigned char)((pk >> 8) & 255);
            if (lane == 0) WSC[tb + q] = sc;
        }
    }
}
typedef int v2i_t __attribute__((ext_vector_type(2)));
typedef unsigned u32x4_t __attribute__((ext_vector_type(4)));
typedef __attribute__((ext_vector_type(4))) float f32x4;
constexpr int GV_PIECE = 1024 + 16;
constexpr int GV_TILE = 16 * GV_PIECE;
static_assert(4 * GV_TILE + 4 * 512 <= LDS_TOTAL, "gv LDS");
__device__ __forceinline__ void phase_gv(const Params& P, int l, const volatile int* xi, char* lds) {
    const int* EXPp = (const int*)(P.ws + WS_EXP);
    const unsigned char* WQ = P.ws + WS_WQ8;
    const float* WSC = (const float*)(P.ws + WS_WSC);
    const int tid = tidx(), lane = tid & 63, w = __builtin_amdgcn_readfirstlane(tid >> 6), g = lane >> 3, pos = lane & 7;
    int xo_ = 0; asm volatile("" : "+v"(xo_));
    const int j = __builtin_amdgcn_readfirstlane(xi[xo_ + XI_J]), nx = __builtin_amdgcn_readfirstlane(xi[xo_ + XI_NX]), nloc = __builtin_amdgcn_readfirstlane(xi[xo_ + XI_NLOC]), rank = __builtin_amdgcn_readfirstlane(xi[xo_ + XI_RANK]);
    const int t0 = rank * 4 + w, st = nloc * 4;
    const int n = (t0 < T) ? (T - t0 + st - 1) / st : 0;
    char* tile = lds + w * GV_TILE;
    float* strip = (float*)(lds + 4 * GV_TILE) + w * 128;
    typedef __attribute__((address_space(3))) v2i_t* ldsv2_t;
    const unsigned co = (unsigned)(pos ^ g) << 4;
    const int rr = (lane & 15) >> 1, kq = lane >> 4;
    const int rdo = kq * GV_PIECE + rr * 128 + (lane & 1) * 8;
    const bool row0 = (lane & 15) == 0;
    __syncthreads();
    for (int sl = j; sl < 8 && n > 0; sl += nx) {
        const unsigned char* Vs = P.ws + WS_TABV + ((size_t)(l * 8 + sl) * NEXP) * 128;
        float* hrow = P.out + sl * 128 + 2 * lane;
#define GV_TK(k) (t0 + (((k) < n) ? (k) : (n - 1)) * st)
#define GV_LOADE(S, t) do { S##el = EXPp[(size_t)(t) * HK + lane]; S##eh = EXPp[(size_t)(t) * HK + 64 + lane]; } while (0)
#define GV_ISSUE(R, S) do { _Pragma("unroll") for (int i = 0; i < 16; ++i) { \
            const int e = __builtin_amdgcn_ds_bpermute((((8 * i) & 63) + g) << 2, (i < 8) ? S##el : S##eh); R[i] = *(const u32x4_t*)(Vs + (((unsigned)e << 7) | co)); } } while (0)
#define GV_LOADT(S, kk) do { const int t_ = GV_TK(kk); \
            S##a0 = 0; S##a1 = 0; S##a2 = 0; S##a3 = 0; \
            if (row0) { const long* wp = (const long*)(WQ + (size_t)t_ * HK + kq * 8); S##a0 = wp[0]; S##a1 = wp[4]; S##a2 = wp[8]; S##a3 = wp[12]; } \
            S##ws = ((kk) < n) ? WSC[t_] : 0.f; \
            S##hv = *(const float2*)(hrow + (size_t)t_ * D); } while (0)
#define GV_TOKEN(R, S, kk) do { \
            const int t = GV_TK(kk); \
            _Pragma("unroll") for (int i = 0; i < 16; ++i) *(u32x4_t*)(tile + i * GV_PIECE + lane * 16) = R[i]; \
            f32x4 acc[8]; \
            _Pragma("unroll") for (int nt = 0; nt < 8; ++nt) acc[nt] = (f32x4){0.f, 0.f, 0.f, 0.f}; \
            _Pragma("unroll") for (int s4 = 0; s4 < 4; ++s4) { \
                const long av = (s4 == 0) ? S##a0 : (s4 == 1) ? S##a1 : (s4 == 2) ? S##a2 : S##a3; \
                _Pragma("unroll") for (int nt = 0; nt < 8; ++nt) { \
                    const v2i_t bv = __builtin_amdgcn_ds_read_tr8_b64_v2i32((ldsv2_t)(void*)(tile + (4 * s4) * GV_PIECE + rdo + ((nt ^ rr) << 4))); \
                    acc[nt] = __builtin_amdgcn_mfma_f32_16x16x32_fp8_fp8(av, __builtin_bit_cast(long, bv), acc[nt], 0, 0, 0); } } \
            if (lane < 16) { _Pragma("unroll") for (int nt = 0; nt < 8; ++nt) strip[16 * nt + lane] = acc[nt][0]; }        \
            { const float2 o2 = *(const float2*)(strip + 2 * lane); \
              if ((kk) < n) *(float2*)(hrow + (size_t)t * D) = make_float2(S##hv.x + S##ws * o2.x, S##hv.y + S##ws * o2.y); } } while (0)
        int Ael, Aeh, Bel, Beh; u32x4_t rA[16], rB[16];
        long Pa0, Pa1, Pa2, Pa3, Qa0, Qa1, Qa2, Qa3; float Pws, Qws; float2 Phv, Qhv;
        GV_LOADE(A, GV_TK(0)); GV_LOADE(B, GV_TK(1));
        GV_ISSUE(rA, A); GV_LOADT(P, 0);
        for (int k = 0; k < n; k += 2) {
            GV_ISSUE(rB, B); GV_LOADE(A, GV_TK(k + 2)); GV_LOADT(Q, k + 1);
            GV_TOKEN(rA, P, k);
            GV_ISSUE(rA, A); GV_LOADE(B, GV_TK(k + 3)); GV_LOADT(P, k + 2);
            GV_TOKEN(rB, Q, k + 1);
        }
#undef GV_TK
#undef GV_LOADE
#undef GV_ISSUE
#undef GV_LOADT
#undef GV_TOKEN
    }
    __syncthreads();
}
__device__ __forceinline__ void phase_gnorm(const Params& P, int l) {
    const int lane = tidx() & 63, nw = nwave();
    bf16* XNw = (bf16*)(P.ws + WS_XN);
    const float4* g = (const float4*)((l == DEPTH - 1) ? P.norm_final : (P.norm_mix + (l + 1) * D));
    for (int t = gwave(); t < T; t += 2 * nw) {
        const int t2 = (t + nw < T) ? (t + nw) : t;
        float4 v[2][4];
#pragma unroll
        for (int q = 0; q < 4; ++q) { v[0][q] = ((const float4*)(P.out + (size_t)t * D))[q * 64 + lane]; v[1][q] = ((const float4*)(P.out + (size_t)t2 * D))[q * 64 + lane]; }
#pragma unroll
        for (int u = 0; u < 2; ++u) {
            float ss = 0.f;
#pragma unroll
            for (int q = 0; q < 4; ++q) ss += v[u][q].x * v[u][q].x + v[u][q].y * v[u][q].y + v[u][q].z * v[u][q].z + v[u][q].w * v[u][q].w;
            ss = wave_sum(ss);
            const float rn = rsqrtf(ss * (1.f / D) + EPS);
            const int tt = u ? t2 : t;
            if (u == 0 || t2 != t) {
                float4* hr = (float4*)(P.out + (size_t)tt * D);
#pragma unroll
                for (int q = 0; q < 4; ++q) {
                    const float4 gg = g[q * 64 + lane];
                    const float4 o = make_float4(v[u][q].x * rn * gg.x, v[u][q].y * rn * gg.y, v[u][q].z * rn * gg.z, v[u][q].w * rn * gg.w);
                    if (l == DEPTH - 1) hr[q * 64 + lane] = o;
                    else { uint2 uu; uu.x = pack2(o.x, o.y); uu.y = pack2(o.z, o.w); ((uint2*)(XNw + (size_t)tt * LDX))[q * 64 + lane] = uu; }
                }
            }
        }
    }
}

#define XB_TMO      128
#define XB_XCNT(j)  (256  + 64 * (j))
#define XB_XSUB(j)  (1280 + 64 * (j))
#define XB_XGEN(j)  (2304 + 64 * (j))
#define XB_TOP      3328
#define XB_TOPGEN   3392
#define XCD_BAR_WORDS 3456
#define XB_SPIN_CAP (1u << 22)
#define LAS __attribute__((address_space(3)))
__device__ __forceinline__ unsigned xb_ld(unsigned* p)              { return __hip_atomic_load(p, __ATOMIC_RELAXED, __HIP_MEMORY_SCOPE_AGENT); }
__device__ __forceinline__ unsigned xb_add(unsigned* p, unsigned v) { return __hip_atomic_fetch_add(p, v, __ATOMIC_RELAXED, __HIP_MEMORY_SCOPE_AGENT); }
__device__ __forceinline__ unsigned xb_xcc_id() { return (unsigned)__builtin_amdgcn_s_getreg((3 << 11) | 20) & 0xFu; }
#define XB_SPIN(cond, bar) do { unsigned _sp = 0; while (cond) { __builtin_amdgcn_s_sleep(1); \
    if ((++_sp & 255u) == 0u) { if (xb_ld(&(bar)[XB_TMO])) break; if (_sp > XB_SPIN_CAP) { atomicAdd(&(bar)[XB_TMO], 1u); break; } } } } while (0)
struct XcdBarrier { unsigned* bar; unsigned x; volatile LAS unsigned* st; };
__device__ __forceinline__ XcdBarrier xcd_barrier_post(unsigned* bar, volatile LAS unsigned* st) {
    XcdBarrier b; b.bar = bar; b.x = xb_xcc_id(); b.st = st;
    if (__builtin_amdgcn_workitem_id_x() == 0) (void)xb_add(&bar[XB_XCNT(b.x)], 1u);
    return b;
}
__device__ __forceinline__ void xcd_barrier_complete(unsigned* bar, unsigned x, unsigned& nloc, unsigned& nx) {
    const unsigned G = gridDim.x * gridDim.y * gridDim.z;
    unsigned sum, cnt, mine, sp = 0u;
    for (;;) {
        sum = 0u; cnt = 0u; mine = 0u;
#pragma unroll
        for (unsigned j = 0; j < 16; ++j) { const unsigned c = xb_ld(&bar[XB_XCNT(j)]); sum += c; cnt += (c > 0u) ? 1u : 0u; mine = (j == x) ? c : mine; }
        if (sum == G) break;
        __builtin_amdgcn_s_sleep(1);
        if ((++sp & 255u) == 0u) { if (xb_ld(&bar[XB_TMO])) break; if (sp > XB_SPIN_CAP) { atomicAdd(&bar[XB_TMO], 1u); break; } }
    }
    nloc = mine > 0u ? mine : 1u; nx = cnt > 0u ? cnt : 1u;
}
__device__ __forceinline__ void xcd_barrier(const XcdBarrier& b) {
    asm volatile("s_waitcnt vmcnt(0)" ::: "memory");
    __syncthreads();
    if (__builtin_amdgcn_workitem_id_x() == 0) {
        unsigned* bar = b.bar;
        __builtin_amdgcn_s_waitcnt(0);
        unsigned nloc = b.st[0], nx = b.st[1];
        if (nloc == 0u) { xcd_barrier_complete(bar, b.x, nloc, nx); b.st[0] = nloc; b.st[1] = nx; }
        const unsigned old = xb_add(&bar[XB_XSUB(b.x)], 1u);
        const unsigned gen = old / nloc;
        if (old + 1u == (gen + 1u) * nloc) {
            __builtin_amdgcn_fence(__ATOMIC_RELEASE, "agent");
            asm volatile("s_waitcnt vmcnt(0)" ::: "memory");
            const unsigned og = xb_add(&bar[XB_TOP], 1u);
            const unsigned tg = og / nx;
            if (og + 1u == (tg + 1u) * nx) xb_add(&bar[XB_TOPGEN], 1u);
            else XB_SPIN(xb_ld(&bar[XB_TOPGEN]) == tg, bar);
            __builtin_amdgcn_fence(__ATOMIC_ACQUIRE, "agent");
            xb_add(&bar[XB_XGEN(b.x)], 1u);
            asm volatile("s_waitcnt vmcnt(0)" ::: "memory");
        } else {
            XB_SPIN(xb_ld(&bar[XB_XGEN(b.x)]) == gen, bar);
            __builtin_amdgcn_fence(__ATOMIC_ACQUIRE, "agent");
            asm volatile("s_waitcnt vmcnt(0)" ::: "memory");
        }
    }
    __syncthreads();
}

constexpr float QSCALE = 0.10206207261596575f * 1.4426950408889634f;

__device__ __forceinline__ void phase_gemm1(const Params& P, int l, char* lds) {
    unsigned char* ws = P.ws;
    const bf16* XN = (const bf16*)(ws + WS_XN);
    bf16* PROJ = (bf16*)(ws + WS_PROJ);
    bf16* Kb = (bf16*)(ws + WS_K);
    const float* rope = (const float*)(ws + WS_ROPE);
    const bf16* W = (const bf16*)(ws + WS_WIN) + (size_t)l * DINP * LDW;
    gemm_t<false>(W, LDW, DINP, XN, LDX, T, D, C_KR / 128, [&](int n0, int t0, const f32x16& acc, int r32, int hi, float) {
        const int t = t0 + r32;
        if (n0 < C_KR) {
            bf16* pr = PROJ + (size_t)t * DINP + n0 + 4 * hi;
#pragma unroll
            for (int g = 0; g < 4; ++g) { uint2 o; o.x = cvtpk(acc[4 * g], acc[4 * g + 1]); o.y = cvtpk(acc[4 * g + 2], acc[4 * g + 3]); *(uint2*)(pr + 8 * g) = o; }
        } else if (n0 == C_KR) {
            const int b = t / S, s = t % S;
            uint2 o1[2], o2[2];
#pragma unroll
            for (int g = 0; g < 2; ++g) {
                const float4 cs0 = *(const float4*)(rope + ((size_t)s * 16 + 8 * g + 4 * hi) * 2), cs1 = *(const float4*)(rope + ((size_t)s * 16 + 8 * g + 4 * hi) * 2 + 4);
                const float x10 = acc[4 * g], x11 = acc[4 * g + 1], x12 = acc[4 * g + 2], x13 = acc[4 * g + 3];
                const float x20 = acc[8 + 4 * g], x21 = acc[8 + 4 * g + 1], x22 = acc[8 + 4 * g + 2], x23 = acc[8 + 4 * g + 3];
                o1[g].x = cvtpk(x10 * cs0.x - x20 * cs0.y, x11 * cs0.z - x21 * cs0.w); o1[g].y = cvtpk(x12 * cs1.x - x22 * cs1.y, x13 * cs1.z - x23 * cs1.w);
                o2[g].x = cvtpk(x20 * cs0.x + x10 * cs0.y, x21 * cs0.z + x11 * cs0.w); o2[g].y = cvtpk(x22 * cs1.x + x12 * cs1.y, x23 * cs1.z + x13 * cs1.w);
            }
#pragma unroll
            for (int h = 0; h < NH; ++h) {
                bf16* kr = Kb + ((size_t)(b * NH + h) * S + s) * DQK + 64 + 4 * hi;
                *(uint2*)(kr) = o1[0]; *(uint2*)(kr + 8) = o1[1]; *(uint2*)(kr + 16) = o2[0]; *(uint2*)(kr + 24) = o2[1];
            }
        }
    }, [&](int t, int n, const float4& v) {
        uint2 o; o.x = cvtpk(v.x, v.y); o.y = cvtpk(v.z, v.w);
        *(uint2*)(PROJ + (size_t)t * DINP + n) = o;
    }, [](float) { return 1.f; }, lds);
}
__device__ __forceinline__ void phase_gemm2(const Params& P, int l, char* lds) {
    unsigned char* ws = P.ws;
    const bf16* PROJ = (const bf16*)(ws + WS_PROJ);
    const float* rope = (const float*)(ws + WS_ROPE);
    const int lane = tidx() & 63;
    {
        const bf16* W = (const bf16*)(ws + WS_WUQ) + (size_t)l * 768 * QR;
        bf16* Qb = (bf16*)(ws + WS_Q);
        gemm_t<true>(W, QR, 768, PROJ + C_CQ, DINP, T, QR, 768 / 128, [](int, int, const f32x16&, int, int, float) {},
            [&](int t, int n, const float4& v) {
                const int b = t / S, s = t % S, h = n / DQK, d = n % DQK;
                float4 o = v;
                const float4 up = make_float4(__shfl(v.x, lane + 4, 64), __shfl(v.y, lane + 4, 64), __shfl(v.z, lane + 4, 64), __shfl(v.w, lane + 4, 64));
                const float4 dn = make_float4(__shfl(v.x, lane - 4, 64), __shfl(v.y, lane - 4, 64), __shfl(v.z, lane - 4, 64), __shfl(v.w, lane - 4, 64));
                if (d >= 64) {
                    const bool first = d < 80;
                    const int f = first ? (d - 64) : (d - 80);
                    const float4 cs0 = *(const float4*)(rope + ((size_t)s * 16 + f) * 2), cs1 = *(const float4*)(rope + ((size_t)s * 16 + f) * 2 + 4);
                    if (first) o = make_float4(v.x * cs0.x - up.x * cs0.y, v.y * cs0.z - up.y * cs0.w, v.z * cs1.x - up.z * cs1.y, v.w * cs1.z - up.w * cs1.w);
                    else       o = make_float4(v.x * cs0.x + dn.x * cs0.y, v.y * cs0.z + dn.y * cs0.w, v.z * cs1.x + dn.z * cs1.y, v.w * cs1.z + dn.w * cs1.w);
                }
                uint2 u; u.x = cvtpk(o.x, o.y); u.y = cvtpk(o.z, o.w);
                *(uint2*)(Qb + ((size_t)(b * NH + h) * S + s) * DQK + d) = u;
            }, [](float ssq) { return rsqrtf(ssq * (1.f / QR) + EPS) * QSCALE; }, lds);
    }
    {
        const bf16* W = (const bf16*)(ws + WS_WUKV) + (size_t)l * 1024 * KVR;
        bf16* Kb = (bf16*)(ws + WS_K); bf16* Vb = (bf16*)(ws + WS_V);
        gemm_t<true>(W, KVR, 1024, PROJ + C_CKV, DINP, T, KVR, 1024 / 128, [](int, int, const f32x16&, int, int, float) {},
            [&](int t, int n, const float4& v) {
                const int b = t / S, s = t % S;
                uint2 u; u.x = cvtpk(v.x, v.y); u.y = cvtpk(v.z, v.w);
                if (n < 512) *(uint2*)(Kb + ((size_t)(b * NH + (n >> 6)) * S + s) * DQK + (n & 63)) = u;
                else         *(uint2*)(Vb + ((size_t)(b * NH + ((n - 512) >> 6)) * S + s) * DV + (n & 63)) = u;
            }, [](float ssq) { return rsqrtf(ssq * (1.f / KVR) + EPS); }, lds);
    }
}
__device__ __forceinline__ void phase_gemm3(const Params& P, int l, char* lds) {
    unsigned char* ws = P.ws;
    const bf16* Yb = (const bf16*)(ws + WS_XN);
    const bf16* W = (const bf16*)(ws + WS_WOUT) + (size_t)l * D * LDW;
    const float* hin = (l == 0) ? P.x : P.out;
    float* out = P.out;
    gemm_t<false>(W, LDW, D, Yb, LDX, T, D, D / 128, [](int, int, const f32x16&, int, int, float) {}, [&](int t, int n, const float4& v) {
        const size_t idx = (size_t)t * D + n;
        const float4 hv = *(const float4*)(hin + idx);
        *(float4*)(out + idx) = make_float4(hv.x + v.x, hv.y + v.y, hv.z + v.z, hv.w + v.w);
    }, [](float) { return 1.f; }, lds);
}

#define GSYNC() do { XcdBarrier xb_; { __attribute__((address_space(1))) char* gp_ = (__attribute__((address_space(1))) char*)(char*)(P.ws + WS_CTL); asm volatile("" : "+s"(gp_)); xb_.bar = (unsigned*)(char*)gp_; } \
    xb_.x = xb_xcc_id(); xb_.st = (volatile LAS unsigned*)&xb_words; xcd_barrier(xb_); } while (0)
#define PHASE(stmt) { const Params Q = launder(P); stmt; }
__global__ void __launch_bounds__(NTHREADS, 2) k_all(Params P) {
    __shared__ __attribute__((aligned(16))) char sm[LDS_TOTAL];
    __shared__ uint4 xb_words;
    cg::grid_group grid = cg::this_grid();
    if (__builtin_amdgcn_workitem_id_x() == 0) xb_words = make_uint4(0u, 0u, 0u, 0u);
    __syncthreads();
    (void)xcd_barrier_post((unsigned*)(P.ws + WS_CTL), (volatile LAS unsigned*)&xb_words);
    __shared__ int xinfo[8];
    if (__builtin_amdgcn_workitem_id_x() == 0) {
        const unsigned x = xb_xcc_id();
        xinfo[XI_X] = (int)x; xinfo[XI_RANK] = (int)xb_add((unsigned*)(P.ws + WS_CTL) + CTL_CENSUS + x, 1u);
    }
    PHASE(phase_prep(Q, sm));
    PHASE(phase_norm(Q.x, Q.norm_mix, (bf16*)(Q.ws + WS_XN)));
    if (P.ws == nullptr) grid.sync();
    GSYNC();
    if (__builtin_amdgcn_workitem_id_x() == 0) {
        unsigned* cen = (unsigned*)(P.ws + WS_CTL) + CTL_CENSUS;
        const int x = xinfo[XI_X]; int nx = 0, jj = 0;
        for (int q = 0; q < 16; ++q) { const unsigned cq = xb_ld(cen + q); if (cq) { if (q < x) ++jj; ++nx; } }
        xinfo[XI_J] = jj; xinfo[XI_NX] = nx; xinfo[XI_NLOC] = (int)xb_ld(cen + x);
    }
    __syncthreads();
    for (int l = 0; l < DEPTH; ++l) {
        PHASE(phase_gemm1(Q, l, sm));
#if PROBE_DUP & 2
        PHASE(phase_gemm1(Q, l, sm));
#endif
        GSYNC();
        PHASE(phase_mixlocal(Q, l, sm));
#if PROBE_DUP & 256
        PHASE(phase_mixlocal(Q, l, sm));
#endif
        PHASE(phase_gemm2(Q, l, sm));
        GSYNC();
        if (l == 0 && blockIdx.x >= (gridDim.x >> 1)) PHASE(phase_tables(Q));
        PHASE(phase_attn(Q, sm));
        if (l == 0 && blockIdx.x < (gridDim.x >> 1)) PHASE(phase_tables(Q));
        GSYNC();
        PHASE(phase_gemm3(Q, l, sm));
#if PROBE_DUP & 16
        if (l == 0) PHASE(phase_gemm3(Q, l, sm));
#endif
        GSYNC();
        PHASE(phase_norm_q(Q, l));
        GSYNC();
        PHASE(phase_route(Q, l, sm));
        GSYNC();
        PHASE(phase_gu(Q, l, xinfo));
        GSYNC();
        PHASE(phase_gw(Q, l));
        GSYNC();
        PHASE(phase_gv(Q, l, xinfo, sm));
        GSYNC();
        PHASE(phase_gnorm(Q, l));
        GSYNC();
    }
}

extern "C" void kernel_launch(void* const* d_in, const int* in_sizes, int n_in, void* d_out, int out_size, void* d_ws, size_t ws_size, hipStream_t stream) {
    static int grid = 0;
    if (grid == 0) {
        if (n_in != 18 || out_size != T * D || ws_size < WS_END) { fprintf(stderr, "kernel_launch: bad sizes n_in %d out %d ws %zu need %zu\n", n_in, out_size, ws_size, (size_t)WS_END); grid = -1; return; }
        int dev = 0, cus = 0, per_cu = 0;
        (void)hipGetDevice(&dev);
        (void)hipDeviceGetAttribute(&cus, hipDeviceAttributeMultiprocessorCount, dev);
        (void)hipOccupancyMaxActiveBlocksPerMultiprocessor(&per_cu, (const void*)k_all, NTHREADS, 0);
        if (per_cu > 2) per_cu = 2;
        if (per_cu < 1) { fprintf(stderr, "kernel_launch: occupancy query says %d\n", per_cu); grid = -1; return; }
        grid = cus * per_cu;
    }
    if (grid < 0) return;
    Params p{};
    p.x = (const float*)d_in[0]; p.norm_mix = (const float*)d_in[1]; p.w_in = (const float*)d_in[2]; p.conv_w = (const float*)d_in[3];
    p.pool_w = (const float*)d_in[4]; p.pool_scale = (const float*)d_in[5]; p.q_norm = (const float*)d_in[6]; p.w_uq = (const float*)d_in[7];
    p.kv_norm = (const float*)d_in[8]; p.w_uk = (const float*)d_in[9]; p.w_uv = (const float*)d_in[10]; p.w_out = (const float*)d_in[11];
    p.norm_ffn = (const float*)d_in[12]; p.peer_wq = (const float*)d_in[13]; p.peer_subkeys = (const float*)d_in[14]; p.peer_u = (const float*)d_in[15];
    p.peer_v = (const float*)d_in[16]; p.norm_final = (const float*)d_in[17];
    p.out = (float*)d_out; p.ws = (unsigned char*)d_ws;
    if (hipMemsetAsync((char*)d_ws + WS_CTL, 0, CTL_BYTES, stream) != hipSuccess) { fprintf(stderr, "kernel_launch: memset failed\n"); return; }
    void* args[] = {&p};
    hipError_t e = hipLaunchCooperativeKernel((const void*)k_all, dim3(grid), dim3(NTHREADS), args, 0, stream);
    if (e != hipSuccess) fprintf(stderr, "cooperative launch failed: %s (grid %d)\n", hipGetErrorString(e), grid);
}
```

```cpp
#include <hip/hip_runtime.h>
#include <hip/hip_cooperative_groups.h>
#include <cstdio>
#include <cstdint>
namespace cg = cooperative_groups;

#ifndef TAB_FP8
#define TAB_FP8 1
#endif
#ifndef PROBE_DUP
#define PROBE_DUP 0
#endif

constexpr int NB = 4, S = 8192, T = NB * S, D = 1024, DEPTH = 2;
constexpr int DIN = 1696, DINP = 1792;
constexpr int C_BG = 0, C_CG = 256, C_HC = 512, C_HP = 768, C_CQ = 1024, C_CKV = 1408, C_KR = 1664;
constexpr int QR = 384, KVR = 256, NH = 8, DQK = 96, DV = 64;
constexpr int PH = 8, NKEY = 128, NEXP = NKEY * NKEY, TOPK = 16, HK = PH * TOPK;
constexpr float EPS = 1e-6f;
constexpr int LDX = 1088;
constexpr int LDW = 1088;

typedef unsigned short bf16;

constexpr size_t WS_CTL   = 0;
constexpr size_t WS_ROPE  = 64 * 1024;
constexpr size_t WS_WIN   = WS_ROPE + (size_t)S * 16 * 2 * 4;
constexpr size_t WS_WUQ   = WS_WIN + (size_t)DEPTH * DINP * LDW * 2;
constexpr size_t WS_WUKV  = WS_WUQ + (size_t)DEPTH * 768 * QR * 2;
constexpr size_t WS_WOUT  = WS_WUKV + (size_t)DEPTH * 1024 * KVR * 2;
constexpr size_t WS_WPQ   = WS_WOUT + (size_t)DEPTH * D * LDW * 2;
constexpr size_t WS_XN    = ((WS_WPQ + (size_t)DEPTH * 2048 * LDW * 2 + 4095) / 4096) * 4096;
constexpr size_t WS_PROJ  = WS_XN + (size_t)T * LDX * 2;
constexpr size_t WS_Q     = WS_PROJ + (size_t)T * DINP * 2;
constexpr size_t WS_K     = WS_Q + (size_t)T * NH * DQK * 2;
constexpr size_t WS_V     = WS_K + (size_t)T * NH * DQK * 2;
constexpr size_t WS_EXP   = WS_V + (size_t)T * NH * DV * 2;
constexpr size_t WS_GATE  = WS_EXP + (size_t)T * HK * 4;
constexpr size_t TAB_ROWB = TAB_FP8 ? 1024 : 2048;
constexpr size_t WS_TABU  = WS_GATE + (size_t)T * HK * 4;
constexpr size_t WS_TABV  = WS_TABU + (size_t)DEPTH * NEXP * TAB_ROWB;
constexpr size_t WS_TSCU  = WS_TABV + (size_t)DEPTH * NEXP * TAB_ROWB;
constexpr size_t WS_TSCV  = WS_TSCU + (size_t)DEPTH * NEXP * 4;
constexpr size_t WS_XQ    = WS_TSCV + (size_t)DEPTH * NEXP * 4;
constexpr size_t WS_XS    = WS_XQ + (size_t)T * D;
constexpr size_t WS_WQ8   = WS_XS + (size_t)T * 4;
constexpr size_t WS_WSC   = WS_WQ8 + (size_t)T * HK;
constexpr size_t WS_END   = WS_WSC + (size_t)T * 4;
static_assert(WS_END <= (size_t)512 * 1024 * 1024, "workspace budget");

struct Params {
    const float* x; const float* norm_mix; const float* w_in; const float* conv_w; const float* pool_w; const float* pool_scale;
    const float* q_norm; const float* w_uq; const float* kv_norm; const float* w_uk; const float* w_uv; const float* w_out;
    const float* norm_ffn; const float* peer_wq; const float* peer_subkeys; const float* peer_u; const float* peer_v; const float* norm_final;
    float* out; unsigned char* ws;
};

__device__ __forceinline__ bf16 f2bf(float f) { unsigned u = __float_as_uint(f); u += 0x7fffu + ((u >> 16) & 1u); return (bf16)(u >> 16); }
__device__ __forceinline__ float bf2f(bf16 h) { return __uint_as_float(((unsigned)h) << 16); }
__device__ __forceinline__ float bflo(unsigned u) { return __uint_as_float(u << 16); }
__device__ __forceinline__ float bfhi(unsigned u) { return __uint_as_float(u & 0xffff0000u); }
__device__ __forceinline__ unsigned pack2(float a, float b) { return (unsigned)f2bf(a) | ((unsigned)f2bf(b) << 16); }
__device__ __forceinline__ float wave_sum(float v) {
#pragma unroll
    for (int m = 32; m >= 1; m >>= 1) v += __shfl_xor(v, m, 64);
    return v;
}
__device__ __forceinline__ float gelu_exact(float x) { return 0.5f * x * (1.f + erff(x * 0.70710678118654752f)); }

#define NTHREADS 512
constexpr int NW = NTHREADS / 64;
__device__ __forceinline__ int tidx() { int t = (int)__builtin_amdgcn_workitem_id_x(); asm volatile("" : "+v"(t)); return t; }
__device__ __forceinline__ int gwave() { return blockIdx.x * (NTHREADS / 64) + (tidx() >> 6); }
__device__ __forceinline__ int nwave() { return gridDim.x * (NTHREADS / 64); }
__device__ __forceinline__ size_t gtid() { return (size_t)blockIdx.x * NTHREADS + tidx(); }
__device__ __forceinline__ size_t gnth() { return (size_t)gridDim.x * NTHREADS; }


__device__ __forceinline__ Params launder(const Params& P) {
    typedef __attribute__((address_space(1))) char* gp_t;
    gp_t g[20] = {(gp_t)(char*)P.x, (gp_t)(char*)P.norm_mix, (gp_t)(char*)P.w_in, (gp_t)(char*)P.conv_w, (gp_t)(char*)P.pool_w, (gp_t)(char*)P.pool_scale, (gp_t)(char*)P.q_norm, (gp_t)(char*)P.w_uq,
                  (gp_t)(char*)P.kv_norm, (gp_t)(char*)P.w_uk, (gp_t)(char*)P.w_uv, (gp_t)(char*)P.w_out, (gp_t)(char*)P.norm_ffn, (gp_t)(char*)P.peer_wq, (gp_t)(char*)P.peer_subkeys,
                  (gp_t)(char*)P.peer_u, (gp_t)(char*)P.peer_v, (gp_t)(char*)P.norm_final, (gp_t)(char*)P.out, (gp_t)(char*)P.ws};
    asm volatile("" : "+s"(g[0]), "+s"(g[1]), "+s"(g[2]), "+s"(g[3]), "+s"(g[4]), "+s"(g[5]), "+s"(g[6]), "+s"(g[7]), "+s"(g[8]), "+s"(g[9]));
    asm volatile("" : "+s"(g[10]), "+s"(g[11]), "+s"(g[12]), "+s"(g[13]), "+s"(g[14]), "+s"(g[15]), "+s"(g[16]), "+s"(g[17]), "+s"(g[18]), "+s"(g[19]));
    Params Q;
    Q.x = (const float*)(char*)g[0]; Q.norm_mix = (const float*)(char*)g[1]; Q.w_in = (const float*)(char*)g[2]; Q.conv_w = (const float*)(char*)g[3]; Q.pool_w = (const float*)(char*)g[4];
    Q.pool_scale = (const float*)(char*)g[5]; Q.q_norm = (const float*)(char*)g[6]; Q.w_uq = (const float*)(char*)g[7]; Q.kv_norm = (const float*)(char*)g[8]; Q.w_uk = (const float*)(char*)g[9];
    Q.w_uv = (const float*)(char*)g[10]; Q.w_out = (const float*)(char*)g[11]; Q.norm_ffn = (const float*)(char*)g[12]; Q.peer_wq = (const float*)(char*)g[13]; Q.peer_subkeys = (const float*)(char*)g[14];
    Q.peer_u = (const float*)(char*)g[15]; Q.peer_v = (const float*)(char*)g[16]; Q.norm_final = (const float*)(char*)g[17]; Q.out = (float*)(char*)g[18]; Q.ws = (unsigned char*)(char*)g[19];
    return Q;
}

typedef __attribute__((ext_vector_type(8))) short bf16x8;
typedef __attribute__((ext_vector_type(16))) float f32x16;
typedef __attribute__((ext_vector_type(2))) __bf16 bf2_t;
#define MFMA32(a, b, c) __builtin_amdgcn_mfma_f32_32x32x16_bf16(a, b, c, 0, 0, 0)
__device__ __forceinline__ int crow(int r, int hi) { return (r & 3) + 8 * (r >> 2) + 4 * hi; }
__device__ __forceinline__ float dot2bf(unsigned a, unsigned b, float c) { return __builtin_amdgcn_fdot2_f32_bf16(__builtin_bit_cast(bf2_t, a), __builtin_bit_cast(bf2_t, b), c, false); }
__device__ __forceinline__ unsigned cvtpk(float lo, float hi) { unsigned r; asm("v_cvt_pk_bf16_f32 %0, %1, %2" : "=v"(r) : "v"(lo), "v"(hi)); return r; }
constexpr int LDS_TOTAL = 140 * 1024;

template <int WT, bool ROWSS>
__device__ __forceinline__ void gemm_kloop(const bf16* __restrict__ Ag0, int lda, const bf16* __restrict__ Bg0, int ldb, int nk, f32x16 (&acc)[8], float (&ss)[4], char* lds, int tid) {
    constexpr int BROWS = (WT == 0) ? 256 : 128, NPB = BROWS / 64;
    constexpr int OPA = 256 * 128, G_BUF = OPA + BROWS * 128;
    const int lane = tid & 63, w = __builtin_amdgcn_readfirstlane(tid >> 6), r32 = lane & 31, hi = lane >> 5;
    const int srow = 8 * w + (lane >> 3);
    const int sch = (lane & 7) ^ ((srow >> 1) & 7);
    const bf16* Ag = Ag0 + (size_t)srow * lda + sch * 8;
    const bf16* Bg = Bg0 + (size_t)srow * ldb + sch * 8;
#pragma unroll
    for (int i = 0; i < 8; ++i)
#pragma unroll
        for (int r = 0; r < 16; ++r) acc[i][r] = 0.f;
    ss[0] = 0.f; ss[1] = 0.f; ss[2] = 0.f; ss[3] = 0.f;
    typedef __attribute__((address_space(3))) unsigned* ldsp_t;
    typedef const __attribute__((address_space(1))) unsigned* glbp_t;
#define G_DMA(buf, kofs) do { char* d_ = lds + (buf) * G_BUF + (8 * w) * 128; \
    _Pragma("unroll") for (int i = 0; i < 4; ++i) \
        __builtin_amdgcn_global_load_lds((glbp_t)(const void*)(Ag + (size_t)(64 * i) * lda + (kofs)), (ldsp_t)(void*)(d_ + i * 8192), 16, 0, 0); \
    _Pragma("unroll") for (int i = 0; i < NPB; ++i) \
        __builtin_amdgcn_global_load_lds((glbp_t)(const void*)(Bg + (size_t)(64 * i) * ldb + (kofs)), (ldsp_t)(void*)(d_ + OPA + i * 8192), 16, 0, 0); } while (0)
    const int xr = (r32 >> 1) & 7;
    const int o0 = ((0 + hi) ^ xr) << 4, o1 = ((2 + hi) ^ xr) << 4, o2 = ((4 + hi) ^ xr) << 4, o3 = ((6 + hi) ^ xr) << 4;
#define G_SS(s_, r_) do { union { bf16x8 v; uint4 u; } c_; c_.v = r_; s_ = dot2bf(c_.u.x, c_.u.x, s_); s_ = dot2bf(c_.u.y, c_.u.y, s_); s_ = dot2bf(c_.u.z, c_.u.z, s_); s_ = dot2bf(c_.u.w, c_.u.w, s_); } while (0)
#define G_STEP(pa, pb, off) do { \
    if (WT == 0) { \
        const bf16x8 a0 = *(const bf16x8*)(pa + off), a1 = *(const bf16x8*)(pa + 32 * 128 + off); \
        const bf16x8 b0 = *(const bf16x8*)(pb + off), b1 = *(const bf16x8*)(pb + 32 * 128 + off), b2 = *(const bf16x8*)(pb + 64 * 128 + off), b3 = *(const bf16x8*)(pb + 96 * 128 + off); \
        if (ROWSS) { G_SS(ss[0], b0); G_SS(ss[1], b1); G_SS(ss[2], b2); G_SS(ss[3], b3); } \
        acc[0] = MFMA32(a0, b0, acc[0]); acc[1] = MFMA32(a0, b1, acc[1]); acc[2] = MFMA32(a0, b2, acc[2]); acc[3] = MFMA32(a0, b3, acc[3]); \
        acc[4] = MFMA32(a1, b0, acc[4]); acc[5] = MFMA32(a1, b1, acc[5]); acc[6] = MFMA32(a1, b2, acc[6]); acc[7] = MFMA32(a1, b3, acc[7]); \
    } else if (WT == 2) { \
        const bf16x8 a0 = *(const bf16x8*)(pa + off), a1 = *(const bf16x8*)(pa + 32 * 128 + off); \
        const bf16x8 b0 = *(const bf16x8*)(pb + off), b1 = *(const bf16x8*)(pb + 32 * 128 + off); \
        if (ROWSS) { G_SS(ss[0], b0); G_SS(ss[1], b1); } \
        acc[0] = MFMA32(a0, b0, acc[0]); acc[1] = MFMA32(a0, b1, acc[1]); acc[2] = MFMA32(a1, b0, acc[2]); acc[3] = MFMA32(a1, b1, acc[3]); \
    } else { \
        const bf16x8 b0 = *(const bf16x8*)(pb + off); \
        const bf16x8 a0 = *(const bf16x8*)(pa + off), a1 = *(const bf16x8*)(pa + 32 * 128 + off); \
        const bf16x8 a2 = *(const bf16x8*)(pa + 64 * 128 + off), a3 = *(const bf16x8*)(pa + 96 * 128 + off); \
        if (ROWSS) { G_SS(ss[0], b0); } \
        acc[0] = MFMA32(a0, b0, acc[0]); acc[1] = MFMA32(a1, b0, acc[1]); \
        acc[2] = MFMA32(a2, b0, acc[2]); acc[3] = MFMA32(a3, b0, acc[3]); \
    } } while (0)
    const int arow = (WT == 1) ? ((w >> 2) * 128 + r32) : ((w >> 1) * 64 + r32);
    const int brow = (WT == 0) ? ((w & 1) * 128 + r32) : (WT == 2) ? ((w & 1) * 64 + r32) : ((w & 3) * 32 + r32);
    G_DMA(0, 0);
    for (int kt = 0; kt < nk; ++kt) {
        __syncthreads();
        if (kt + 1 < nk) G_DMA((kt + 1) & 1, (kt + 1) * 64);
        const char* pa = lds + (kt & 1) * G_BUF + arow * 128;
        const char* pb = lds + (kt & 1) * G_BUF + OPA + brow * 128;
        G_STEP(pa, pb, o0); G_STEP(pa, pb, o1); G_STEP(pa, pb, o2); G_STEP(pa, pb, o3);
    }
    if (ROWSS) { ss[0] += __shfl_xor(ss[0], 32, 64); ss[1] += __shfl_xor(ss[1], 32, 64); ss[2] += __shfl_xor(ss[2], 32, 64); ss[3] += __shfl_xor(ss[3], 32, 64); }
#undef G_DMA
#undef G_SS
#undef G_STEP
}

__device__ __forceinline__ void tile_range(int ntiles, int& lo, int& hi) {
    const int G = gridDim.x, b = blockIdx.x;
    const int vb = ((G & 7) == 0) ? ((b & 7) * (G >> 3) + (b >> 3)) : b;
    const int per = (ntiles + G - 1) / G;
    lo = vb * per; hi = lo + per; if (hi > ntiles) hi = ntiles;
}
constexpr int ST_P = 68;
static_assert(NW * 64 * ST_P * 4 <= LDS_TOTAL, "staging LDS");
template <bool ROWSS, class EPI, class EPIROW, class RSC>
__device__ __forceinline__ void gemm_t(const bf16* __restrict__ Wt, int ldw, int N, const bf16* __restrict__ X, int ldx, int M, int K, int tn_direct, EPI epi, EPIROW epirow, RSC rowscale, char* lds) {
    const int tid = tidx(), lane = tid & 63, w = tid >> 6, r32 = lane & 31, hi = lane >> 5;
    const int tilesN = N / 256, tilesM = M / 256, nk = K / 64;
    int tlo, thi; tile_range(tilesM * tilesN, tlo, thi);
    for (int tile = tlo; tile < thi; ++tile) {
        const int tm = tile / tilesN, tn = tile % tilesN;
        f32x16 acc[8]; float ss[4];
        gemm_kloop<0, ROWSS>(Wt + (size_t)(tn * 256) * ldw, ldw, X + (size_t)(tm * 256) * ldx, ldx, nk, acc, ss, lds, tid);
        if (tn < tn_direct) {
            __syncthreads();
            float* st = (float*)lds + w * (64 * ST_P);
            const int rr = lane >> 4, ch = lane & 15;
#pragma unroll
            for (int half = 0; half < 2; ++half) {
                const float m0_ = rowscale(ss[2 * half]), m1_ = rowscale(ss[2 * half + 1]);
#pragma unroll
                for (int i = 0; i < 2; ++i)
#pragma unroll
                    for (int jj = 0; jj < 2; ++jj)
#pragma unroll
                        for (int g = 0; g < 4; ++g) {
                            const float mj = jj ? m1_ : m0_;
                            const f32x16& a_ = acc[i * 4 + 2 * half + jj];
                            *(float4*)(st + (32 * jj + r32) * ST_P + 32 * i + 8 * g + 4 * hi) = make_float4(a_[4 * g] * mj, a_[4 * g + 1] * mj, a_[4 * g + 2] * mj, a_[4 * g + 3] * mj);
                        }
#pragma unroll 2
                for (int it = 0; it < 16; ++it) {
                    const int row = it * 4 + rr;
                    const float4 v = *(const float4*)(st + row * ST_P + ch * 4);
                    epirow(tm * 256 + (w & 1) * 128 + half * 64 + row, tn * 256 + (w >> 1) * 64 + ch * 4, v);
                }
            }
        } else {
#pragma unroll
            for (int i = 0; i < 2; ++i)
#pragma unroll
                for (int j = 0; j < 4; ++j)
                    epi(tn * 256 + (w >> 1) * 64 + i * 32, tm * 256 + (w & 1) * 128 + j * 32, acc[i * 4 + j], r32, hi, ss[j]);
        }
        __syncthreads();
    }
}

constexpr int ST1_P = 132;
static_assert(NW * 32 * ST1_P * 4 <= LDS_TOTAL, "staging LDS (128 x 32 wave tiles)");
template <class EPIROW, class RSC>
__device__ __forceinline__ void gemm_t1(const bf16* __restrict__ Wt, int ldw, int N, const bf16* __restrict__ X, int ldx, int M, int K, EPIROW epirow, RSC rowscale, char* lds) {
    const int tid = tidx(), lane = tid & 63, w = tid >> 6, r32 = lane & 31, hi = lane >> 5;
    const int tilesN = N / 256, tilesM = M / 128, nk = K / 64;
    int tlo, thi; tile_range(tilesM * tilesN, tlo, thi);
    for (int tile = tlo; tile < thi; ++tile) {
        const int tm = tile / tilesN, tn = tile % tilesN;
        f32x16 acc[8]; float ss[4];
        gemm_kloop<1, true>(Wt + (size_t)(tn * 256) * ldw, ldw, X + (size_t)(tm * 128) * ldx, ldx, nk, acc, ss, lds, tid);
        __syncthreads();
        float* st = (float*)lds + w * (32 * ST1_P);
        const float mj = rowscale(ss[0]);
#pragma unroll
        for (int mt = 0; mt < 4; ++mt)
#pragma unroll
            for (int g = 0; g < 4; ++g)
                *(float4*)(st + r32 * ST1_P + 32 * mt + 8 * g + 4 * hi) = make_float4(acc[mt][4 * g] * mj, acc[mt][4 * g + 1] * mj, acc[mt][4 * g + 2] * mj, acc[mt][4 * g + 3] * mj);
#pragma unroll 2
        for (int it = 0; it < 16; ++it) {
            const int row = it * 2 + hi;
            const float4 v = *(const float4*)(st + row * ST1_P + r32 * 4);
            epirow(tm * 128 + (w & 3) * 32 + row, tn * 256 + (w >> 2) * 128 + r32 * 4, v);
        }
        __syncthreads();
    }
}

template <class EPIROW>
__device__ __forceinline__ void gemm_t2(const bf16* __restrict__ Wt, int ldw, int N, const bf16* __restrict__ X, int ldx, int M, int K, EPIROW epirow, char* lds) {
    const int tid = tidx(), lane = tid & 63, w = tid >> 6, r32 = lane & 31, hi = lane >> 5;
    const int tilesN = N / 256, tilesM = M / 128, nk = K / 64;
    int tlo, thi; tile_range(tilesM * tilesN, tlo, thi);
    for (int tile = tlo; tile < thi; ++tile) {
        const int tm = tile / tilesN, tn = tile % tilesN;
        f32x16 acc[8]; float ss[4];
        gemm_kloop<2, false>(Wt + (size_t)(tn * 256) * ldw, ldw, X + (size_t)(tm * 128) * ldx, ldx, nk, acc, ss, lds, tid);
        __syncthreads();
        float* st = (float*)lds + w * (64 * ST_P);
#pragma unroll
        for (int i = 0; i < 2; ++i)
#pragma unroll
            for (int j = 0; j < 2; ++j)
#pragma unroll
                for (int g = 0; g < 4; ++g)
                    *(float4*)(st + (32 * j + r32) * ST_P + 32 * i + 8 * g + 4 * hi) = make_float4(acc[i * 2 + j][4 * g], acc[i * 2 + j][4 * g + 1], acc[i * 2 + j][4 * g + 2], acc[i * 2 + j][4 * g + 3]);
        const int rr = lane >> 4, ch = lane & 15;
#pragma unroll 4
        for (int it = 0; it < 16; ++it) {
            const int row = it * 4 + rr;
            const float4 v = *(const float4*)(st + row * ST_P + ch * 4);
            epirow(tm * 128 + (w & 1) * 64 + row, tn * 256 + (w >> 1) * 64 + ch * 4, v);
        }
        __syncthreads();
    }
}

typedef __attribute__((ext_vector_type(4))) float f32x4;
constexpr int G8_HT = 128 * 64;
__device__ __forceinline__ int g8_lds_byte(int r, int c) {
    const int st = (r >> 4) * 2 + (c >> 5), rr = r & 15, cc = c & 31, ob = rr * 64 + cc * 2;
    return st * 1024 + (ob ^ (((ob >> 9) & 1) << 5));
}
__device__ __forceinline__ void g8_stage_rc(int b, int& R, int& C) {
    const int st = b / 1024, sb = b % 1024, swz = sb ^ (((sb >> 9) & 1) << 5);
    R = (st >> 1) * 16 + swz / 64; C = (st & 1) * 32 + (swz % 64) / 2;
}
__device__ __forceinline__ void gemm8_kloop(const bf16* __restrict__ A, int lda, const bf16* __restrict__ Bt, int ldb, int nt, f32x4 (&acc)[2][2][4][2], char* lds, int tid) {
    bf16* shm = (bf16*)lds;
    typedef __attribute__((address_space(3))) unsigned* ldsp_t;
    typedef const __attribute__((address_space(1))) unsigned* glbp_t;
#define SA(b, h) (shm + ((b) * 2 + (h)) * G8_HT)
#define SB(b, h) (shm + (4 + (b) * 2 + (h)) * G8_HT)
    int sr0, sc0; g8_stage_rc(tid * 16, sr0, sc0);
    const unsigned voa = (unsigned)((sr0 * lda + sc0) * 2), vob = (unsigned)((sr0 * ldb + sc0) * 2);
    const char* Ap = (const char*)A; const char* Bp = (const char*)Bt;
    const int wbase = __builtin_amdgcn_readfirstlane(tid >> 6) * 1024;
#define STAGE(P, BASE, VO, LD, br, kt) do { const char* g_ = BASE + ((size_t)(br) * LD + (kt) * 64) * 2; \
    __builtin_amdgcn_global_load_lds((glbp_t)(const void*)(g_ + VO), (ldsp_t)(void*)((char*)(P) + wbase), 16, 0, 0); \
    __builtin_amdgcn_global_load_lds((glbp_t)(const void*)(g_ + (size_t)128 * LD + VO), (ldsp_t)(void*)((char*)(P) + wbase + 8192), 16, 0, 0); } while (0)
    const int lane = tid & 63, wid = tid >> 6, wr = wid >> 2, wc = wid & 3, fr = lane & 15, fq = lane >> 4;
#define LDA(dst, b, h) _Pragma("unroll") for (int m = 0; m < 4; ++m) _Pragma("unroll") for (int k = 0; k < 2; ++k) \
    dst[m][k] = *reinterpret_cast<const bf16x8*>((char*)SA(b, h) + g8_lds_byte(wr * 64 + m * 16 + fr, k * 32 + fq * 8))
#define LDB(dst, b, h) _Pragma("unroll") for (int n = 0; n < 2; ++n) _Pragma("unroll") for (int k = 0; k < 2; ++k) \
    dst[n][k] = *reinterpret_cast<const bf16x8*>((char*)SB(b, h) + g8_lds_byte(wc * 32 + n * 16 + fr, k * 32 + fq * 8))
#define MMA(ai, bj, At_, Bt_) do { __builtin_amdgcn_s_setprio(1); \
    _Pragma("unroll") for (int m = 0; m < 4; ++m) _Pragma("unroll") for (int n = 0; n < 2; ++n) _Pragma("unroll") for (int k = 0; k < 2; ++k) \
        acc[ai][bj][m][n] = __builtin_amdgcn_mfma_f32_16x16x32_bf16(At_[m][k], Bt_[n][k], acc[ai][bj][m][n], 0, 0, 0); \
    __builtin_amdgcn_s_setprio(0); } while (0)
#define WAIT_V(n) asm volatile("s_waitcnt vmcnt(" #n ")" ::: "memory")
#define WAIT_L(n) asm volatile("s_waitcnt lgkmcnt(" #n ")" ::: "memory")
#define BAR __builtin_amdgcn_s_barrier()
#define SCHED __builtin_amdgcn_sched_barrier(0)
#pragma unroll
    for (int a = 0; a < 2; ++a)
#pragma unroll
        for (int b = 0; b < 2; ++b)
#pragma unroll
            for (int m = 0; m < 4; ++m)
#pragma unroll
                for (int n = 0; n < 2; ++n) acc[a][b][m][n] = f32x4{0.f, 0.f, 0.f, 0.f};
    bf16x8 At[4][2], B0[2][2], B1[2][2];
    STAGE(SB(0, 0), Bp, vob, ldb, 0, 0); STAGE(SA(0, 0), Ap, voa, lda, 0, 0);
    STAGE(SB(0, 1), Bp, vob, ldb, 128, 0); STAGE(SA(0, 1), Ap, voa, lda, 128, 0);
    if (wr == 1) BAR;
    WAIT_V(4); BAR;
    STAGE(SB(1, 0), Bp, vob, ldb, 0, 1); STAGE(SA(1, 0), Ap, voa, lda, 0, 1); STAGE(SB(1, 1), Bp, vob, ldb, 128, 1);
    WAIT_V(6); BAR;
    for (int t = 0; t < nt - 2; t += 2) {
        LDB(B0, 0, 0); SCHED; LDA(At, 0, 0); STAGE(SA(1, 1), Ap, voa, lda, 128, t + 1);
        WAIT_L(8); BAR; WAIT_L(0); MMA(0, 0, At, B0); BAR; SCHED;
        LDB(B1, 0, 1); STAGE(SB(0, 0), Bp, vob, ldb, 0, t + 2);
        BAR; WAIT_L(0); MMA(0, 1, At, B1); BAR;
        LDA(At, 0, 1); STAGE(SA(0, 0), Ap, voa, lda, 0, t + 2);
        BAR; WAIT_L(0); MMA(1, 0, At, B0); BAR; SCHED;
        STAGE(SB(0, 1), Bp, vob, ldb, 128, t + 2);
        WAIT_V(6); BAR; MMA(1, 1, At, B1); BAR;
        LDB(B0, 1, 0); SCHED; LDA(At, 1, 0); STAGE(SA(0, 1), Ap, voa, lda, 128, t + 2);
        WAIT_L(8); BAR; WAIT_L(0); MMA(0, 0, At, B0); BAR; SCHED;
        LDB(B1, 1, 1); STAGE(SB(1, 0), Bp, vob, ldb, 0, t + 3);
        BAR; WAIT_L(0); MMA(0, 1, At, B1); BAR;
        LDA(At, 1, 1); STAGE(SA(1, 0), Ap, voa, lda, 0, t + 3);
        BAR; WAIT_L(0); MMA(1, 0, At, B0); BAR; SCHED;
        STAGE(SB(1, 1), Bp, vob, ldb, 128, t + 3);
        WAIT_V(6); BAR; MMA(1, 1, At, B1); BAR;
    }
    { LDB(B0, 0, 0); LDA(At, 0, 0); STAGE(SA(1, 1), Ap, voa, lda, 128, nt - 1);
      BAR; WAIT_L(0); MMA(0, 0, At, B0); BAR;
      LDB(B1, 0, 1); BAR; WAIT_L(0); MMA(0, 1, At, B1); BAR;
      LDA(At, 0, 1); WAIT_V(4); BAR; WAIT_L(0); MMA(1, 0, At, B0); MMA(1, 1, At, B1); BAR; }
    { LDB(B0, 1, 0); LDA(At, 1, 0); WAIT_V(2); BAR; WAIT_L(0); MMA(0, 0, At, B0); BAR;
      LDB(B1, 1, 1); WAIT_V(0); BAR; WAIT_L(0); MMA(0, 1, At, B1); BAR;
      LDA(At, 1, 1); BAR; WAIT_L(0); MMA(1, 0, At, B0); MMA(1, 1, At, B1); BAR; }
    if (wr == 0) BAR;
#undef SA
#undef SB
#undef STAGE
#undef LDA
#undef LDB
#undef MMA
#undef WAIT_V
#undef WAIT_L
#undef BAR
#undef SCHED
}
template <class EPIROW>
__device__ __forceinline__ void gemm_t8(const bf16* __restrict__ Wt, int ldw, int N, const bf16* __restrict__ X, int ldx, int M, int K, EPIROW epirow, char* lds) {
    const int tid = tidx(), lane = tid & 63, w = tid >> 6, wr = w >> 2, wc = w & 3, fr = lane & 15, fq = lane >> 4;
    const int tilesN = N / 256, tilesM = M / 256, nt = K / 64;
    int tlo, thi; tile_range(tilesM * tilesN, tlo, thi);
    for (int tile = tlo; tile < thi; ++tile) {
        const int tm = tile / tilesN, tn = tile % tilesN;
        f32x4 acc[2][2][4][2];
        gemm8_kloop(Wt + (size_t)(tn * 256) * ldw, ldw, X + (size_t)(tm * 256) * ldx, ldx, nt, acc, lds, tid);
        __syncthreads();
        float* st = (float*)lds + w * (32 * ST_P);
        const int rr = lane >> 4, ch = lane & 15;
#pragma unroll
        for (int ai = 0; ai < 2; ++ai)
#pragma unroll
            for (int bj = 0; bj < 2; ++bj) {
#pragma unroll
                for (int m = 0; m < 4; ++m)
#pragma unroll
                    for (int n = 0; n < 2; ++n) {
                        const f32x4 a_ = acc[ai][bj][m][n];
                        *(float4*)(st + (n * 16 + fr) * ST_P + m * 16 + fq * 4) = make_float4(a_[0], a_[1], a_[2], a_[3]);
                    }
#pragma unroll 4
                for (int it = 0; it < 8; ++it) {
                    const int row = it * 4 + rr;
                    const float4 v = *(const float4*)(st + row * ST_P + ch * 4);
                    epirow(tm * 256 + bj * 128 + wc * 32 + row, tn * 256 + ai * 128 + wr * 64 + ch * 4, v);
                }
            }
        __syncthreads();
    }
}

__device__ __forceinline__ void transpose_tiled(const float* __restrict__ W, bf16* __restrict__ Wt, int K, int N, int Npad, int ldk, const float* __restrict__ gain, char* lds) {
    float (*tl)[65] = (float (*)[65])lds;
    const int tid = tidx(), a = tid & 63, q = tid >> 6;
    const int tK = K / 64, tN = Npad / 64;
    for (int tile = blockIdx.x; tile < tK * tN; tile += gridDim.x) {
        const int k0 = (tile / tN) * 64, n0 = (tile % tN) * 64;
#pragma unroll 4
        for (int i = 0; i < 64 / NW; ++i) {
            const int k = k0 + q * (64 / NW) + i, n = n0 + a;
            float v = (n < N) ? W[(size_t)k * N + n] : 0.f;
            if (gain) v *= gain[k];
            tl[q * (64 / NW) + i][a] = v;
        }
        __syncthreads();
#pragma unroll 4
        for (int i = 0; i < 64 / NW; ++i) { const int nl = q * (64 / NW) + i; Wt[(size_t)(n0 + nl) * ldk + k0 + a] = f2bf(tl[a][nl]); }
        __syncthreads();
    }
}

__device__ __forceinline__ void quant_row(const float4 (&v)[4], unsigned char* __restrict__ dst, float* __restrict__ scl, int r, int lane) {
    float am = 0.f;
#pragma unroll
    for (int j = 0; j < 4; ++j) am = fmaxf(am, fmaxf(fmaxf(fabsf(v[j].x), fabsf(v[j].y)), fmaxf(fabsf(v[j].z), fabsf(v[j].w))));
#pragma unroll
    for (int m = 32; m >= 1; m >>= 1) am = fmaxf(am, __shfl_xor(am, m, 64));
    const float sc = (am > 0.f) ? am * (1.f / 448.f) : 1.f;
    const float is = 1.f / sc;
    uint4 o;
    { int w = 0; w = __builtin_amdgcn_cvt_pk_fp8_f32(v[0].x * is, v[0].y * is, w, false); w = __builtin_amdgcn_cvt_pk_fp8_f32(v[0].z * is, v[0].w * is, w, true); o.x = (unsigned)w; }
    { int w = 0; w = __builtin_amdgcn_cvt_pk_fp8_f32(v[1].x * is, v[1].y * is, w, false); w = __builtin_amdgcn_cvt_pk_fp8_f32(v[1].z * is, v[1].w * is, w, true); o.y = (unsigned)w; }
    { int w = 0; w = __builtin_amdgcn_cvt_pk_fp8_f32(v[2].x * is, v[2].y * is, w, false); w = __builtin_amdgcn_cvt_pk_fp8_f32(v[2].z * is, v[2].w * is, w, true); o.z = (unsigned)w; }
    { int w = 0; w = __builtin_amdgcn_cvt_pk_fp8_f32(v[3].x * is, v[3].y * is, w, false); w = __builtin_amdgcn_cvt_pk_fp8_f32(v[3].z * is, v[3].w * is, w, true); o.w = (unsigned)w; }
    { const int lay = r / NEXP, e = r % NEXP; *(uint4*)(dst + (((size_t)(lay * 8 + (lane >> 3)) * NEXP + e) * 128) + (lane & 7) * 16) = o; }
    if (lane == 0) scl[r] = sc;
}
__device__ __forceinline__ unsigned pack_i8x4(float a, float b, float c, float d) {
    const int ia = __float2int_rn(a), ib = __float2int_rn(b), ic = __float2int_rn(c), id = __float2int_rn(d);
    return (unsigned)(ia & 255) | ((unsigned)(ib & 255) << 8) | ((unsigned)(ic & 255) << 16) | ((unsigned)(id & 255) << 24);
}
__device__ __forceinline__ void quant_row_i8(const float4 (&v)[4], unsigned char* __restrict__ dst, float* __restrict__ scl, int r, int lane) {
    float am = 0.f;
#pragma unroll
    for (int j = 0; j < 4; ++j) am = fmaxf(am, fmaxf(fmaxf(fabsf(v[j].x), fabsf(v[j].y)), fmaxf(fabsf(v[j].z), fabsf(v[j].w))));
#pragma unroll
    for (int m = 32; m >= 1; m >>= 1) am = fmaxf(am, __shfl_xor(am, m, 64));
    const float sc = (am > 0.f) ? am * (1.f / 127.f) : 1.f;
    const float is = 1.f / sc;
    uint4 o;
    o.x = pack_i8x4(v[0].x * is, v[0].y * is, v[0].z * is, v[0].w * is); o.y = pack_i8x4(v[1].x * is, v[1].y * is, v[1].z * is, v[1].w * is);
    o.z = pack_i8x4(v[2].x * is, v[2].y * is, v[2].z * is, v[2].w * is); o.w = pack_i8x4(v[3].x * is, v[3].y * is, v[3].z * is, v[3].w * is);
    { const int lay = r / NEXP, e = r % NEXP; *(uint4*)(dst + (((size_t)(lay * 8 + (lane >> 3)) * NEXP + e) * 128) + (lane & 7) * 16) = o; }
    if (lane == 0) scl[r] = sc;
}
template <bool I8>
__device__ __forceinline__ void convert_table(const float* __restrict__ src, unsigned char* __restrict__ dst, float* __restrict__ scl, int rows) {
    static_assert(TAB_FP8, "fp8 tables");
    const int lane = tidx() & 63;
    const int nw = nwave();
    for (int r = gwave(); r < rows; r += 4 * nw) {
        float4 v[4][4]; int rr[4];
#pragma unroll
        for (int u = 0; u < 4; ++u) {
            rr[u] = (r + u * nw < rows) ? (r + u * nw) : r;
            const float4* s0 = (const float4*)(src + (size_t)rr[u] * D);
#pragma unroll
            for (int j = 0; j < 4; ++j) v[u][j] = s0[lane * 4 + j];
        }
#pragma unroll
        for (int u = 0; u < 4; ++u) {
            if (u == 0 || rr[u] != r) { if (I8) quant_row_i8(v[u], dst, scl, rr[u], lane); else quant_row(v[u], dst, scl, rr[u], lane); }
        }
    }
}
__device__ __forceinline__ void phase_prep(const Params& P, char* lds) {
    unsigned char* ws = P.ws;
    for (int l = 0; l < DEPTH; ++l) {
        transpose_tiled(P.w_in + (size_t)l * D * DIN, (bf16*)(ws + WS_WIN) + (size_t)l * DINP * LDW, D, DIN, DINP, LDW, nullptr, lds);
        transpose_tiled(P.w_uq + (size_t)l * QR * 768, (bf16*)(ws + WS_WUQ) + (size_t)l * 768 * QR, QR, 768, 768, QR, P.q_norm + l * QR, lds);
        transpose_tiled(P.w_uk + (size_t)l * KVR * 512, (bf16*)(ws + WS_WUKV) + (size_t)l * 1024 * KVR, KVR, 512, 512, KVR, P.kv_norm + l * KVR, lds);
        transpose_tiled(P.w_uv + (size_t)l * KVR * 512, (bf16*)(ws + WS_WUKV) + (size_t)l * 1024 * KVR + (size_t)512 * KVR, KVR, 512, 512, KVR, P.kv_norm + l * KVR, lds);
        transpose_tiled(P.w_out + (size_t)l * D * D, (bf16*)(ws + WS_WOUT) + (size_t)l * D * LDW, D, D, D, LDW, nullptr, lds);
    }
    {
        bf16* Wc = (bf16*)(ws + WS_WPQ);
        float (*As)[68] = (float (*)[68])lds;
        float (*Bs)[68] = (float (*)[68])(lds + 16 * 68 * 4);
        const int tid = tidx(), tx = tid & 15, ty = (tid >> 4) & 15;
        const int lr = (tid >> 2) & 63, ld4 = (tid & 3) * 4;
        for (int tile = blockIdx.x; tile < (DEPTH * 2048 / 64) * (D / 64); tile += gridDim.x) {
            const int row0 = (tile >> 4) * 64, k0 = (tile & 15) * 64;
            const int l = row0 >> 11, hp = (row0 >> 7) & 15, n0 = row0 & 127;
            const float* skp = P.peer_subkeys + (((size_t)l * 2 + (hp & 1)) * NKEY + n0 + lr) * 128 + ld4;
            const float* wqp = P.peer_wq + ((size_t)l * D + k0 + lr) * 2048 + hp * 128 + ld4;
            float acc[4][4];
#pragma unroll
            for (int i = 0; i < 4; ++i)
#pragma unroll
                for (int j = 0; j < 4; ++j) acc[i][j] = 0.f;
            for (int d0 = 0; d0 < 128; d0 += 16) {
                if (tid < 256) {
                    const float4 av = *(const float4*)(skp + d0), bv = *(const float4*)(wqp + d0);
                    As[ld4 + 0][lr] = av.x; As[ld4 + 1][lr] = av.y; As[ld4 + 2][lr] = av.z; As[ld4 + 3][lr] = av.w;
                    Bs[ld4 + 0][lr] = bv.x; Bs[ld4 + 1][lr] = bv.y; Bs[ld4 + 2][lr] = bv.z; Bs[ld4 + 3][lr] = bv.w;
                }
                __syncthreads();
#pragma unroll
                for (int kk = 0; kk < 16; ++kk) {
                    const float4 a4 = *(const float4*)&As[kk][ty * 4], b4 = *(const float4*)&Bs[kk][tx * 4];
                    const float aa[4] = {a4.x, a4.y, a4.z, a4.w}, bb[4] = {b4.x, b4.y, b4.z, b4.w};
#pragma unroll
                    for (int i = 0; i < 4; ++i)
#pragma unroll
                        for (int j = 0; j < 4; ++j) acc[i][j] = fmaf(aa[i], bb[j], acc[i][j]);
                }
                __syncthreads();
            }
            if (tid < 256) {
#pragma unroll
                for (int i = 0; i < 4; ++i) {
                    uint2 o; o.x = pack2(acc[i][0], acc[i][1]); o.y = pack2(acc[i][2], acc[i][3]);
                    *(uint2*)(Wc + (size_t)(row0 + ty * 4 + i) * LDW + k0 + tx * 4) = o;
                }
            }
        }
    }
    convert_table<true>(P.peer_u, ws + WS_TABU, (float*)(ws + WS_TSCU), DEPTH * NEXP);
    convert_table<false>(P.peer_v, ws + WS_TABV, (float*)(ws + WS_TSCV), DEPTH * NEXP);
    float* rope = (float*)(ws + WS_ROPE);
    for (size_t i = gtid(); i < (size_t)S * 16; i += gnth()) {
        const int s = (int)(i >> 4), f = (int)(i & 15);
        const double inv = pow(10000.0, -(double)f / 16.0);
        const double ang = (double)s * inv;
        rope[2 * i] = (float)cos(ang); rope[2 * i + 1] = (float)sin(ang);
    }
}

__device__ __forceinline__ void phase_norm(const float* __restrict__ h, const float* __restrict__ g, bf16* __restrict__ xn) {
    const int lane = tidx() & 63, nw = nwave();
    for (int t = gwave(); t < T; t += 2 * nw) {
        const int t2 = (t + nw < T) ? (t + nw) : t;
        float4 v[2][4];
#pragma unroll
        for (int j = 0; j < 4; ++j) { v[0][j] = ((const float4*)(h + (size_t)t * D))[j * 64 + lane]; v[1][j] = ((const float4*)(h + (size_t)t2 * D))[j * 64 + lane]; }
#pragma unroll
        for (int u = 0; u < 2; ++u) {
            float ss = 0.f;
#pragma unroll
            for (int j = 0; j < 4; ++j) ss += v[u][j].x * v[u][j].x + v[u][j].y * v[u][j].y + v[u][j].z * v[u][j].z + v[u][j].w * v[u][j].w;
            ss = wave_sum(ss);
            const float r = rsqrtf(ss * (1.f / D) + EPS);
            const int tt = u ? t2 : t;
            if (u == 0 || t2 != t) {
#pragma unroll
                for (int j = 0; j < 4; ++j) {
                    const float4 gg = ((const float4*)g)[j * 64 + lane];
                    uint2 o; o.x = pack2(v[u][j].x * r * gg.x, v[u][j].y * r * gg.y); o.y = pack2(v[u][j].z * r * gg.z, v[u][j].w * r * gg.w);
                    ((uint2*)(xn + (size_t)tt * LDX))[j * 64 + lane] = o;
                }
            }
        }
    }
}

__device__ __forceinline__ void phase_norm_q(const Params& P, int l) {
    const int lane = tidx() & 63, nw = nwave();
    const float* g = P.norm_ffn + l * D;
    bf16* xn = (bf16*)(P.ws + WS_XN);
    unsigned* xq = (unsigned*)(P.ws + WS_XQ);
    float* xsc = (float*)(P.ws + WS_XS);
    for (int t = gwave(); t < T; t += 2 * nw) {
        const int t2 = (t + nw < T) ? (t + nw) : t;
        float4 v[2][4];
#pragma unroll
        for (int j = 0; j < 4; ++j) { v[0][j] = ((const float4*)(P.out + (size_t)t * D))[j * 64 + lane]; v[1][j] = ((const float4*)(P.out + (size_t)t2 * D))[j * 64 + lane]; }
#pragma unroll
        for (int u = 0; u < 2; ++u) {
            float ss = 0.f;
#pragma unroll
            for (int j = 0; j < 4; ++j) ss += v[u][j].x * v[u][j].x + v[u][j].y * v[u][j].y + v[u][j].z * v[u][j].z + v[u][j].w * v[u][j].w;
            ss = wave_sum(ss);
            const float r = rsqrtf(ss * (1.f / D) + EPS);
            const int tt = u ? t2 : t;
            if (u == 0 || t2 != t) {
                float am = 0.f;
#pragma unroll
                for (int j = 0; j < 4; ++j) {
                    const float4 gg = ((const float4*)g)[j * 64 + lane];
                    v[u][j].x *= r * gg.x; v[u][j].y *= r * gg.y; v[u][j].z *= r * gg.z; v[u][j].w *= r * gg.w;
                    am = fmaxf(am, fmaxf(fmaxf(fabsf(v[u][j].x), fabsf(v[u][j].y)), fmaxf(fabsf(v[u][j].z), fabsf(v[u][j].w))));
                    uint2 o; o.x = pack2(v[u][j].x, v[u][j].y); o.y = pack2(v[u][j].z, v[u][j].w);
                    ((uint2*)(xn + (size_t)tt * LDX))[j * 64 + lane] = o;
                }
#pragma unroll
                for (int m = 32; m >= 1; m >>= 1) am = fmaxf(am, __shfl_xor(am, m, 64));
                const float sc = (am > 0.f) ? am * (1.f / 127.f) : 1.f, is = 1.f / sc;
#pragma unroll
                for (int j = 0; j < 4; ++j) xq[(size_t)tt * (D / 4) + j * 64 + lane] = pack_i8x4(v[u][j].x * is, v[u][j].y * is, v[u][j].z * is, v[u][j].w * is);
                if (lane == 0) xsc[tt] = sc;
            }
        }
    }
}

__device__ __forceinline__ void phase_mixlocal(const Params& P, int l, char* lds) {
    const bf16* proj = (const bf16*)(P.ws + WS_PROJ);
    bf16* Y = (bf16*)(P.ws + WS_XN);
    const int tid = tidx();
    {
        const float* cw = P.conv_w + (size_t)l * 3 * 256;
        for (size_t i = gtid(); i < (size_t)T * 32; i += gnth()) {
            const int t = (int)(i >> 5), c0 = (int)(i & 31) * 8, s = t & (S - 1);
            const bf16* pr = proj + (size_t)t * DINP;
            float acc[8];
#pragma unroll
            for (int e = 0; e < 8; ++e) acc[e] = 0.f;
#pragma unroll
            for (int j = 0; j < 3; ++j) {
                if (s - 2 + j >= 0) {
                    const bf16* pp = pr - (size_t)(2 - j) * DINP;
                    const uint4 g = *(const uint4*)(pp + C_CG + c0), hc = *(const uint4*)(pp + C_HC + c0);
                    const float4 w0 = *(const float4*)(cw + j * 256 + c0), w1 = *(const float4*)(cw + j * 256 + c0 + 4);
                    acc[0] = fmaf(w0.x, bflo(g.x) * bflo(hc.x), acc[0]); acc[1] = fmaf(w0.y, bfhi(g.x) * bfhi(hc.x), acc[1]);
                    acc[2] = fmaf(w0.z, bflo(g.y) * bflo(hc.y), acc[2]); acc[3] = fmaf(w0.w, bfhi(g.y) * bfhi(hc.y), acc[3]);
                    acc[4] = fmaf(w1.x, bflo(g.z) * bflo(hc.z), acc[4]); acc[5] = fmaf(w1.y, bfhi(g.z) * bfhi(hc.z), acc[5]);
                    acc[6] = fmaf(w1.z, bflo(g.w) * bflo(hc.w), acc[6]); acc[7] = fmaf(w1.w, bfhi(g.w) * bfhi(hc.w), acc[7]);
                }
            }
            const uint4 bg = *(const uint4*)(pr + C_BG + c0);
            uint4 o;
            o.x = pack2(bflo(bg.x) * acc[0], bfhi(bg.x) * acc[1]); o.y = pack2(bflo(bg.y) * acc[2], bfhi(bg.y) * acc[3]);
            o.z = pack2(bflo(bg.z) * acc[4], bfhi(bg.z) * acc[5]); o.w = pack2(bflo(bg.w) * acc[6], bfhi(bg.w) * acc[7]);
            *(uint4*)(Y + (size_t)t * LDX + c0) = o;
        }
    }
    {
        float (*pl)[68] = (float (*)[68])lds;
        const float* pw = P.pool_w + (size_t)l * 4 * 64 * 64;
        const float* psc = P.pool_scale + l * 256;
        const int a = tid & 63, q = tid >> 6;
        for (int tile = blockIdx.x; tile < (T / (16 * NW)) * 4; tile += gridDim.x) {
            const int g = tile & 3, t0 = (tile >> 2) * (16 * NW);
            const int w = 2 << g;
            {
                const bf16* col = proj + C_HP + g * 64 + a;
                const int tf = t0 + q * 16, sf = tf & (S - 1);
                float xr[31];
#pragma unroll
                for (int d = 1; d <= 15; ++d) xr[15 - d] = (d < w && sf - d >= 0) ? bf2f(col[(size_t)(tf - d) * DINP]) : 0.f;
#pragma unroll
                for (int i = 0; i < 16; ++i) xr[15 + i] = bf2f(col[(size_t)(tf + i) * DINP]);
                float sum = 0.f;
#pragma unroll
                for (int d = 1; d <= 15; ++d) sum += xr[15 - d];
#pragma unroll
                for (int i = 0; i < 16; ++i) {
                    const int s = sf + i;
                    sum += xr[15 + i];
                    const int cnt = (s + 1 < w) ? (s + 1) : w;
                    pl[q * 16 + i][a] = sum / (float)cnt - xr[15 + i];
                    const int o = 15 + i + 1;
                    const float old = (g == 0) ? xr[o - 2] : (g == 1) ? xr[o - 4] : (g == 2) ? xr[o - 8] : xr[o - 16];
                    sum -= old;
                }
            }
            __syncthreads();
            {
                float pc[64];
#pragma unroll
                for (int c = 0; c < 64; ++c) pc[c] = pw[(g * 64 + c) * 64 + a];
                const float sc = psc[g * 64 + a];
#pragma unroll 2
                for (int i = 0; i < 16; ++i) {
                    const float4* row = (const float4*)&pl[q * 16 + i][0];
                    float m0 = 0.f, m1 = 0.f;
#pragma unroll
                    for (int c4 = 0; c4 < 16; ++c4) { const float4 v = row[c4]; m0 = fmaf(v.x, pc[4 * c4], m0); m1 = fmaf(v.y, pc[4 * c4 + 1], m1); m0 = fmaf(v.z, pc[4 * c4 + 2], m0); m1 = fmaf(v.w, pc[4 * c4 + 3], m1); }
                    Y[(size_t)(t0 + q * 16 + i) * LDX + 256 + g * 64 + a] = f2bf((m0 + m1) * sc);
                }
            }
            __syncthreads();
        }
    }
}

typedef short v4i16_t __attribute__((ext_vector_type(4)));
typedef __attribute__((address_space(3))) v4i16_t* lds_v4p;
__device__ __forceinline__ v4i16_t vtr(const char* p) { return __builtin_amdgcn_ds_read_tr16_b64_v4i16((lds_v4p)p); }
constexpr int A_KP = 208, A_VP = 192;
constexpr int A_KB = 64 * A_KP, A_VB = 64 * A_VP, A_BUF = A_KB + A_VB, ATTN_LDS = 2 * A_BUF;
static_assert(ATTN_LDS <= LDS_TOTAL, "attention LDS");

__device__ __forceinline__ void attn_unit(const bf16* __restrict__ Qb, const bf16* __restrict__ Kb, const bf16* __restrict__ Vb, bf16* __restrict__ Y, int bh, int qblk, char* lds) {
    const int tid = tidx(), lane = tid & 63, w = tid >> 6, r32 = lane & 31, hi = lane >> 5;
    const int q0 = qblk * (32 * NW), qw0 = q0 + w * 32;
    const int NT = (q0 + 32 * NW) / 64;
    bf16x8 qf[6];
    {
        const bf16* qp = Qb + ((size_t)bh * S + qw0 + r32) * DQK + hi * 8;
#pragma unroll
        for (int ks = 0; ks < 6; ++ks) qf[ks] = *(const bf16x8*)(qp + ks * 16);
    }
    f32x16 o0, o1;
#pragma unroll
    for (int r = 0; r < 16; ++r) { o0[r] = 0.f; o1[r] = 0.f; }
    float m = -1e30f, lsum = 0.f;
    const int t8 = tid & 255; const bool isv = tid >= 256;
    const char* Tg = isv ? (const char*)(Vb + (size_t)bh * S * DV) : (const char*)(Kb + (size_t)bh * S * DQK);
    const int Ts = isv ? (64 * 128) : (64 * 192);
    const int g0 = t8 * 16, g1 = (t8 + 256) * 16, g2 = isv ? g1 : (t8 + 512) * 16;
    const int l0 = isv ? (A_KB + (t8 >> 3) * A_VP + (t8 & 7) * 16) : ((t8 / 12) * A_KP + (t8 % 12) * 16);
    const int l1 = isv ? (l0 + 32 * A_VP) : (((t8 + 256) / 12) * A_KP + ((t8 + 256) % 12) * 16);
    const int l2 = isv ? l1 : (((t8 + 512) / 12) * A_KP + ((t8 + 512) % 12) * 16);
    uint4 pk0, pk1, pk2, qk0, qk1, qk2;
#define A_LOAD(S, t) do { const char* tg = Tg + (size_t)(t) * Ts; S##k0 = *(const uint4*)(tg + g0); S##k1 = *(const uint4*)(tg + g1); S##k2 = *(const uint4*)(tg + g2); } while (0)
#define A_STORE(S, bK, bV) do { *(uint4*)(bK + l0) = S##k0; *(uint4*)(bK + l1) = S##k1; *(uint4*)(bK + l2) = S##k2; } while (0)
#define A_PV(pf, kofs) do { \
            { const v4i16_t lo = vtr(pv + (kofs) * A_VP), hh = vtr(pv + ((kofs) + 8) * A_VP); const bf16x8 vf = {lo[0], lo[1], lo[2], lo[3], hh[0], hh[1], hh[2], hh[3]}; o0 = MFMA32(vf, pf.v, o0); } \
            { const v4i16_t lo = vtr(pv + (kofs) * A_VP + 64), hh = vtr(pv + ((kofs) + 8) * A_VP + 64); const bf16x8 vf = {lo[0], lo[1], lo[2], lo[3], hh[0], hh[1], hh[2], hh[3]}; o1 = MFMA32(vf, pf.v, o1); } } while (0)
    const int pvo = (4 * hi + ((lane & 15) >> 2)) * A_VP + (16 * ((lane >> 4) & 1) + 4 * (lane & 3)) * 2;
    A_LOAD(p, 0); A_LOAD(q, 1);
    for (int t2 = 0; t2 < NT; t2 += 2) {
#pragma unroll
        for (int half = 0; half < 2; ++half) {
            const int t = t2 + half;
            char* bK = lds + half * A_BUF; char* bV = bK + A_KB;
            if (half == 0) A_STORE(p, bK, bV); else A_STORE(q, bK, bV);
            __syncthreads();
            { const int tn = (t + 2 < NT) ? (t + 2) : (NT - 2 + half); if (half == 0) A_LOAD(p, tn); else A_LOAD(q, tn); }
        const int kt0 = t * 64;
        if (kt0 <= qw0) {
            f32x16 s0, s1;
#pragma unroll
            for (int r = 0; r < 16; ++r) { s0[r] = 0.f; s1[r] = 0.f; }
            const char* pk = bK + r32 * A_KP + hi * 16;
#pragma unroll
            for (int ks = 0; ks < 6; ++ks) {
                const bf16x8 a0 = *(const bf16x8*)(pk + ks * 32), a1 = *(const bf16x8*)(pk + 32 * A_KP + ks * 32);
                s0 = MFMA32(a0, qf[ks], s0); s1 = MFMA32(a1, qf[ks], s1);
            }
            if (kt0 + 63 > qw0) {
                const int qrow = qw0 + r32;
#pragma unroll
                for (int r = 0; r < 16; ++r) { const int key = kt0 + crow(r, hi); if (key > qrow) s0[r] = -INFINITY; if (key + 32 > qrow) s1[r] = -INFINITY; }
            }
            float mx = fmaxf(s0[0], s1[0]);
#pragma unroll
            for (int r = 1; r < 16; ++r) mx = fmaxf(mx, fmaxf(s0[r], s1[r]));
            mx = fmaxf(mx, __shfl_xor(mx, 32, 64));
            const float mn = fmaxf(m, mx), m_prev = m;
            const float alpha = __builtin_amdgcn_exp2f(m - mn);
            m = mn;
            float ps = 0.f;
#pragma unroll
            for (int r = 0; r < 16; ++r) { s0[r] = __builtin_amdgcn_exp2f(s0[r] - mn); s1[r] = __builtin_amdgcn_exp2f(s1[r] - mn); ps += s0[r] + s1[r]; }
            if (__builtin_amdgcn_ballot_w64(mn > m_prev) != 0ull) {
                lsum *= alpha;
#pragma unroll
                for (int r = 0; r < 16; ++r) { o0[r] *= alpha; o1[r] *= alpha; }
            }
            lsum += ps;
            union { unsigned u[4]; bf16x8 v; } p00, p01, p10, p11;
#pragma unroll
            for (int j = 0; j < 4; ++j) { p00.u[j] = cvtpk(s0[2 * j], s0[2 * j + 1]); p01.u[j] = cvtpk(s0[8 + 2 * j], s0[9 + 2 * j]); p10.u[j] = cvtpk(s1[2 * j], s1[2 * j + 1]); p11.u[j] = cvtpk(s1[8 + 2 * j], s1[9 + 2 * j]); }
            const char* pv = bV + pvo;
            A_PV(p00, 0); A_PV(p01, 16); A_PV(p10, 32); A_PV(p11, 48);
        }
        }
    }
    lsum += __shfl_xor(lsum, 32, 64);
    const float inv = 1.f / lsum;
    const int b = bh >> 3, h = bh & 7;
    bf16* yo = Y + (size_t)(b * S + qw0 + r32) * LDX + 512 + h * 64 + 4 * hi;
#pragma unroll
    for (int g = 0; g < 4; ++g) {
        uint2 a, c;
        a.x = cvtpk(o0[4 * g] * inv, o0[4 * g + 1] * inv); a.y = cvtpk(o0[4 * g + 2] * inv, o0[4 * g + 3] * inv);
        c.x = cvtpk(o1[4 * g] * inv, o1[4 * g + 1] * inv); c.y = cvtpk(o1[4 * g + 2] * inv, o1[4 * g + 3] * inv);
        *(uint2*)(yo + 8 * g) = a; *(uint2*)(yo + 32 + 8 * g) = c;
    }
    __syncthreads();
}
__device__ __forceinline__ void phase_attn(const Params& P, char* lds) {
    const bf16* Qb = (const bf16*)(P.ws + WS_Q);
    const bf16* Kb = (const bf16*)(P.ws + WS_K);
    const bf16* Vb = (const bf16*)(P.ws + WS_V);
    bf16* Y = (bf16*)(P.ws + WS_XN);
    for (int u = blockIdx.x; u < NB * NH * (S / 256); u += gridDim.x) {
        const int bh = u & 31, v = u >> 5;
        const int qblk = (v < 8) ? (31 - v) : (v < 16) ? (v - 8) : (v < 24) ? (39 - v) : (v - 16);
        attn_unit(Qb, Kb, Vb, Y, bh, qblk, lds);
    }
}

#define NET_HD __device__ __forceinline__
#define NET_U2F(u) __uint_as_float(u)
#define NET_F2U(f) __float_as_uint(f)
#define CE_DESC(a, b) do { const float hi__ = fmaxf(a, b), lo__ = fminf(a, b); a = hi__; b = lo__; } while (0)
NET_HD void sort16_desc(float (&v)[16]) {
#define CE2(a, b) CE_DESC(v[a], v[b])
    CE2(0,13); CE2(1,12); CE2(2,15); CE2(3,14); CE2(4,8); CE2(5,6); CE2(7,11); CE2(9,10);
    CE2(0,5); CE2(1,7); CE2(2,9); CE2(3,4); CE2(6,13); CE2(8,14); CE2(10,15); CE2(11,12);
    CE2(0,1); CE2(2,3); CE2(4,5); CE2(6,8); CE2(7,9); CE2(10,11); CE2(12,13); CE2(14,15);
    CE2(0,2); CE2(1,3); CE2(4,10); CE2(5,11); CE2(6,7); CE2(8,9); CE2(12,14); CE2(13,15);
    CE2(1,2); CE2(3,12); CE2(4,6); CE2(5,7); CE2(8,10); CE2(9,11); CE2(13,14);
    CE2(1,4); CE2(2,6); CE2(5,8); CE2(7,10); CE2(9,13); CE2(11,14);
    CE2(2,4); CE2(3,6); CE2(9,12); CE2(11,13);
    CE2(3,5); CE2(6,8); CE2(7,9); CE2(10,12);
    CE2(3,4); CE2(5,6); CE2(7,8); CE2(9,10); CE2(11,12);
    CE2(6,7); CE2(8,9);
#undef CE2
}
NET_HD void merge16_desc(float (&a)[16], const float (&b)[16]) {
#pragma unroll
    for (int i = 0; i < 16; ++i) a[i] = fmaxf(a[i], b[15 - i]);
#pragma unroll
    for (int j = 8; j > 0; j >>= 1) {
#pragma unroll
        for (int i = 0; i < 16; ++i) { const int l = i ^ j; if (l > i) CE_DESC(a[i], a[l]); }
    }
}
NET_HD void top16_of_64(float (&g0)[16], float (&g1)[16], float (&g2)[16], float (&g3)[16]) {
    sort16_desc(g0); sort16_desc(g1); sort16_desc(g2); sort16_desc(g3);
    merge16_desc(g0, g1); merge16_desc(g2, g3); merge16_desc(g0, g2);
}
NET_HD float u2f(unsigned u) { return NET_U2F(u); }
NET_HD unsigned f2u(float f) { return NET_F2U(f); }
template <class V16>
NET_HD void lane_top16(const V16& s0, const V16& s1, const V16& s2, const V16& s3, int hi, float (&out)[16]) {
    float g0[16], g1[16], g2[16], g3[16];
#pragma unroll
    for (int r = 0; r < 16; ++r) {
        const unsigned nb = (unsigned)((r & 3) + 8 * (r >> 2));
        g0[r] = u2f((f2u(s0[r]) & 0xFFFFFF80u) | nb); g1[r] = u2f((f2u(s1[r]) & 0xFFFFFF80u) | (nb + 32u));
        g2[r] = u2f((f2u(s2[r]) & 0xFFFFFF80u) | (nb + 64u)); g3[r] = u2f((f2u(s3[r]) & 0xFFFFFF80u) | (nb + 96u));
    }
    top16_of_64(g0, g1, g2, g3);
    const unsigned h4 = (unsigned)hi << 2;
#pragma unroll
    for (int i = 0; i < 16; ++i) out[i] = u2f(f2u(g0[i]) | h4);
}
constexpr int cand_slot(int a, int b) { int n = 0; for (int x = 0; x < 16; ++x) for (int y = 0; y < 16; ++y) { if (x == a && y == b) return n; if ((x + 1) * (y + 1) <= 16) ++n; } return n; }
NET_HD void cand_top16(const float (&s1)[16], const float (&s2)[16], float (&c)[16]) {
    float g0[16], g1[16], g2[16], g3[16];
#pragma unroll
    for (int i = 0; i < 16; ++i) { g0[i] = -3.0e38f; g1[i] = -3.0e38f; g2[i] = -3.0e38f; g3[i] = -3.0e38f; }
#pragma unroll
    for (int a = 0; a < 16; ++a) {
#pragma unroll
        for (int b = 0; b < 16; ++b) {
            if ((a + 1) * (b + 1) <= 16) {
                const int sl = cand_slot(a, b);
                const float v = u2f((f2u(s1[a] + s2[b]) & 0xFFFFFF00u) | (unsigned)(a * 16 + b));
                if (sl < 16) g0[sl & 15] = v; else if (sl < 32) g1[sl & 15] = v; else if (sl < 48) g2[sl & 15] = v; else g3[sl & 15] = v;
            }
        }
    }
    top16_of_64(g0, g1, g2, g3);
#pragma unroll
    for (int i = 0; i < 16; ++i) c[i] = g0[i];
}

__device__ __forceinline__ void phase_route(const Params& P, int l, char* lds) {
    const bf16* XN = (const bf16*)(P.ws + WS_XN);
    const bf16* Wc = (const bf16*)(P.ws + WS_WPQ) + (size_t)l * 2048 * LDW;
    int* EXPp = (int*)(P.ws + WS_EXP);
    float* GATEp = (float*)(P.ws + WS_GATE);
    const int tid = tidx(), lane = tid & 63, w = tid >> 6, r32 = lane & 31, hi = lane >> 5;
    const int ph = w >> 2, tg = w & 3;
    float* xch = (float*)(lds + 16384);
    int tlo, thi; tile_range((T / 128) * PH, tlo, thi);
    for (int u = tlo; u < thi; ++u) {
        const int tm = u >> 3, h = u & 7;
        float L0[16];
        {
            f32x16 acc[8]; float ssd[4];
            gemm_kloop<1, false>(Wc + (size_t)(h * 256) * LDW, LDW, XN + (size_t)(tm * 128) * LDX, LDX, D / 64, acc, ssd, lds, tid);
            lane_top16(acc[0], acc[1], acc[2], acc[3], hi, L0);
            float o[16];
#pragma unroll
            for (int i = 0; i < 16; ++i) o[i] = __shfl_xor(L0[i], 32, 64);
            merge16_desc(L0, o);
        }
        __syncthreads();
        if (ph == 1 && hi == 0) {
#pragma unroll
            for (int q = 0; q < 4; ++q) *(float4*)(xch + ((tg * 32 + r32) * 16) + 4 * q) = make_float4(L0[4 * q], L0[4 * q + 1], L0[4 * q + 2], L0[4 * q + 3]);
        }
        __syncthreads();
        if (ph == 0) {
            float L1[16];
#pragma unroll
            for (int q = 0; q < 4; ++q) { const float4 v = *(const float4*)(xch + ((tg * 32 + r32) * 16) + 4 * q); L1[4 * q] = v.x; L1[4 * q + 1] = v.y; L1[4 * q + 2] = v.z; L1[4 * q + 3] = v.w; }
            float c[16];
            cand_top16(L0, L1, c);
            unsigned char* my = (unsigned char*)lds + tid * 32;
            {
                uint4 a, b;
#define PK4(L, i) ((__float_as_uint(L[i]) & 127u) | ((__float_as_uint(L[i + 1]) & 127u) << 8) | ((__float_as_uint(L[i + 2]) & 127u) << 16) | ((__float_as_uint(L[i + 3]) & 127u) << 24))
                a.x = PK4(L0, 0); a.y = PK4(L0, 4); a.z = PK4(L0, 8); a.w = PK4(L0, 12);
                b.x = PK4(L1, 0); b.y = PK4(L1, 4); b.z = PK4(L1, 8); b.w = PK4(L1, 12);
#undef PK4
                *(uint4*)my = a; *(uint4*)(my + 16) = b;
            }
            int ev[16]; float gv[16]; float den = 0.f;
#pragma unroll
            for (int k = 0; k < 16; ++k) {
                const unsigned ci = __float_as_uint(c[k]) & 255u;
                const int n1 = my[ci >> 4], n2 = my[16 + (ci & 15)];
                ev[k] = n1 * NKEY + n2;
                gv[k] = __expf(c[k] - c[0]); den += gv[k];
            }
            const float iden = 1.f / den;
            if (hi == 0) {
                const int t = tm * 128 + tg * 32 + r32;
                uint4* ep = (uint4*)(EXPp + (size_t)t * HK + h * 16);
                float4* gp = (float4*)(GATEp + (size_t)t * HK + h * 16);
#pragma unroll
                for (int q = 0; q < 4; ++q) {
                    ep[q] = make_uint4((unsigned)ev[4 * q], (unsigned)ev[4 * q + 1], (unsigned)ev[4 * q + 2], (unsigned)ev[4 * q + 3]);
                    gp[q] = make_float4(gv[4 * q] * iden, gv[4 * q + 1] * iden, gv[4 * q + 2] * iden, gv[4 * q + 3] * iden);
                }
            }
        }
        __syncthreads();
    }
}

constexpr size_t WS_PART = WS_PROJ;
static_assert((size_t)8 * T * HK * 4 <= WS_K - WS_PROJ, "PART alias");
constexpr int XI_X = 0, XI_RANK = 1, XI_J = 2, XI_NX = 3, XI_NLOC = 4;
constexpr int CTL_CENSUS = 4096;
constexpr int CTL_BYTES = (CTL_CENSUS + 16) * 4;

template <int M1, int M2, int M3, class TT>
__device__ __forceinline__ void red16x3(TT (&p)[16], int lane) {
#pragma unroll
    for (int i = 0; i < 8; ++i) { const bool up = lane & M1; const TT send = up ? p[i] : p[i + 8], keep = up ? p[i + 8] : p[i]; p[i] = keep + __shfl_xor(send, M1, 64); }
#pragma unroll
    for (int i = 0; i < 4; ++i) { const bool up = lane & M2; const TT send = up ? p[i] : p[i + 4], keep = up ? p[i + 4] : p[i]; p[i] = keep + __shfl_xor(send, M2, 64); }
#pragma unroll
    for (int i = 0; i < 2; ++i) { const bool up = lane & M3; const TT send = up ? p[i] : p[i + 2], keep = up ? p[i + 2] : p[i]; p[i] = keep + __shfl_xor(send, M3, 64); }
}
__device__ __forceinline__ void phase_gu(const Params& P, int l, const volatile int* xi) {
    const unsigned char* XQ = P.ws + WS_XQ;
    const float* XSc = (const float*)(P.ws + WS_XS);
    const int* EXPp = (const int*)(P.ws + WS_EXP);
    float* PART = (float*)(P.ws + WS_PART);
    const int tid = tidx(), lane = tid & 63, w = tid >> 6, g = lane >> 3, c = lane & 7;
    int xo_ = 0; asm volatile("" : "+v"(xo_));
    const int j = __builtin_amdgcn_readfirstlane(xi[xo_ + XI_J]), nx = __builtin_amdgcn_readfirstlane(xi[xo_ + XI_NX]), nloc = __builtin_amdgcn_readfirstlane(xi[xo_ + XI_NLOC]), rank = __builtin_amdgcn_readfirstlane(xi[xo_ + XI_RANK]);
    const int t0 = rank * NW + w, st = nloc * NW;
    const int n = (t0 < T) ? (T - t0 + st - 1) / st : 0;
    const int i0 = 8 * (c & 1) + 4 * ((c >> 1) & 1) + 2 * ((c >> 2) & 1);
    for (int sl = j; sl < 8 && n > 0; sl += nx) {
        const unsigned char* Us = P.ws + WS_TABU + ((size_t)(l * 8 + sl) * NEXP) * 128;
        const unsigned co = (unsigned)c << 4;
        float* part = PART + (size_t)sl * T * HK;
        const unsigned char* xs = XQ + sl * 128 + c * 16;
#define GU_TK(k) (t0 + (((k) < n) ? (k) : (n - 1)) * st)
#define GU_LOADE(S, t) do { S##lo = EXPp[(size_t)(t) * HK + lane]; S##hi = EXPp[(size_t)(t) * HK + 64 + lane]; } while (0)
#define GU_LOADX(S, t) do { S##a = *(const uint4*)(xs + (size_t)(t) * D); S##s = XSc[t]; } while (0)
#define GU_ISSUE(R, S) do { _Pragma("unroll") for (int i = 0; i < 16; ++i) { \
            const int e = __builtin_amdgcn_ds_bpermute((((8 * i) & 63) + g) << 2, (i < 8) ? S##lo : S##hi); R[i] = *(const uint4*)(Us + (((unsigned)e << 7) | co)); } } while (0)
#define GU_FINISH(R, S, t) do { \
            int p[16]; \
            _Pragma("unroll") for (int i = 0; i < 16; ++i) { int d_ = __builtin_amdgcn_sdot4((int)S##a.x, (int)R[i].x, 0, false); d_ = __builtin_amdgcn_sdot4((int)S##a.y, (int)R[i].y, d_, false); \
                d_ = __builtin_amdgcn_sdot4((int)S##a.z, (int)R[i].z, d_, false); p[i] = __builtin_amdgcn_sdot4((int)S##a.w, (int)R[i].w, d_, false); } \
            red16x3<1, 2, 4, int>(p, lane); \
            part[(size_t)(t) * HK + 8 * i0 + g] = (float)p[0] * S##s; part[(size_t)(t) * HK + 8 * (i0 + 1) + g] = (float)p[1] * S##s; } while (0)
        int eAlo, eAhi, eBlo, eBhi; uint4 xAa, xBa; float xAs, xBs; uint4 rA[16], rB[16];
        GU_LOADE(eA, GU_TK(0)); GU_LOADX(xA, GU_TK(0)); GU_LOADE(eB, GU_TK(1));
        GU_ISSUE(rA, eA);
        for (int k = 0; k < n; k += 2) {
            GU_LOADX(xB, GU_TK(k + 1)); GU_ISSUE(rB, eB); GU_LOADE(eA, GU_TK(k + 2));
            GU_FINISH(rA, xA, GU_TK(k));
            GU_LOADX(xA, GU_TK(k + 2)); GU_ISSUE(rA, eA); GU_LOADE(eB, GU_TK(k + 3));
            GU_FINISH(rB, xB, GU_TK(k + 1));
        }
#undef GU_TK
#undef GU_LOADE
#undef GU_LOADX
#undef GU_ISSUE
#undef GU_FINISH
    }
}
__device__ __forceinline__ void phase_gw(const Params& P, int l) {
    const int* EXPp = (const int*)(P.ws + WS_EXP);
    const float* GATEp = (const float*)(P.ws + WS_GATE);
    const float* PART = (const float*)(P.ws + WS_PART);
    const float* SU = (const float*)(P.ws + WS_TSCU) + (size_t)l * NEXP;
    const float* SV = (const float*)(P.ws + WS_TSCV) + (size_t)l * NEXP;
    unsigned char* WQ = P.ws + WS_WQ8;
    float* WSC = (float*)(P.ws + WS_WSC);
    const int lane = tidx() & 63;
    for (int tb = gwave() * 4; tb < T; tb += nwave() * 4) {
        float wv[4][2];
#pragma unroll
        for (int q = 0; q < 4; ++q)
#pragma unroll
            for (int hk = 0; hk < 2; ++hk) {
                const size_t i = (size_t)(tb + q) * HK + hk * 64 + lane;
                float s = 0.f;
#pragma unroll
                for (int x = 0; x < 8; ++x) s += PART[(size_t)x * T * HK + i];
                const int e = EXPp[i];
                wv[q][hk] = GATEp[i] * gelu_exact(s * SU[e]) * SV[e];
            }
#pragma unroll
        for (int q = 0; q < 4; ++q) {
            float am = fmaxf(fabsf(wv[q][0]), fabsf(wv[q][1]));
#pragma unroll
            for (int m = 32; m >= 1; m >>= 1) am = fmaxf(am, __shfl_xor(am, m, 64));
            const float sc = (am > 0.f) ? am * (1.f / 448.f) : 1.f, is = 1.f / sc;
            const int pk = __builtin_amdgcn_cvt_pk_fp8_f32(wv[q][0] * is, wv[q][1] * is, 0, false);
            WQ[(size_t)(tb + q) * HK + lane] = (unsigned char)(pk & 255);
            WQ[(size_t)(tb + q) * HK + 64 + lane] = (unsigned char)((pk >> 8) & 255);
            if (lane == 0) WSC[tb + q] = sc;
        }
    }
}
typedef int v2i_t __attribute__((ext_vector_type(2)));
typedef unsigned u32x4_t __attribute__((ext_vector_type(4)));
typedef __attribute__((ext_vector_type(4))) float f32x4;
constexpr int GV_PIECE = 1024 + 16;
constexpr int GV_TILE = 16 * GV_PIECE;
static_assert(NW * GV_TILE + NW * 512 <= LDS_TOTAL, "gv LDS");
__device__ __forceinline__ void phase_gv(const Params& P, int l, const volatile int* xi, char* lds) {
    const int* EXPp = (const int*)(P.ws + WS_EXP);
    const unsigned char* WQ = P.ws + WS_WQ8;
    const float* WSC = (const float*)(P.ws + WS_WSC);
    const int tid = tidx(), lane = tid & 63, w = __builtin_amdgcn_readfirstlane(tid >> 6), g = lane >> 3, pos = lane & 7;
    int xo_ = 0; asm volatile("" : "+v"(xo_));
    const int j = __builtin_amdgcn_readfirstlane(xi[xo_ + XI_J]), nx = __builtin_amdgcn_readfirstlane(xi[xo_ + XI_NX]), nloc = __builtin_amdgcn_readfirstlane(xi[xo_ + XI_NLOC]), rank = __builtin_amdgcn_readfirstlane(xi[xo_ + XI_RANK]);
    const int t0 = rank * NW + w, st = nloc * NW;
    const int n = (t0 < T) ? (T - t0 + st - 1) / st : 0;
    char* tile = lds + w * GV_TILE;
    float* strip = (float*)(lds + NW * GV_TILE) + w * 128;
    typedef __attribute__((address_space(3))) v2i_t* ldsv2_t;
    const unsigned co = (unsigned)(pos ^ g) << 4;
    const int rr = (lane & 15) >> 1, kq = lane >> 4;
    const int rdo = kq * GV_PIECE + rr * 128 + (lane & 1) * 8;
    const bool row0 = (lane & 15) == 0;
    __syncthreads();
    for (int sl = j; sl < 8 && n > 0; sl += nx) {
        const unsigned char* Vs = P.ws + WS_TABV + ((size_t)(l * 8 + sl) * NEXP) * 128;
        float* hrow = P.out + sl * 128 + 2 * lane;
#define GV_TK(k) (t0 + (((k) < n) ? (k) : (n - 1)) * st)
#define GV_LOADE(S, t) do { S##el = EXPp[(size_t)(t) * HK + lane]; S##eh = EXPp[(size_t)(t) * HK + 64 + lane]; } while (0)
#define GV_ISSUE(R, S) do { _Pragma("unroll") for (int i = 0; i < 16; ++i) { \
            const int e = __builtin_amdgcn_ds_bpermute((((8 * i) & 63) + g) << 2, (i < 8) ? S##el : S##eh); R[i] = *(const u32x4_t*)(Vs + (((unsigned)e << 7) | co)); } } while (0)
#define GV_LOADT(S, kk) do { const int t_ = GV_TK(kk); \
            S##a0 = 0; S##a1 = 0; S##a2 = 0; S##a3 = 0; \
            if (row0) { const long* wp = (const long*)(WQ + (size_t)t_ * HK + kq * 8); S##a0 = wp[0]; S##a1 = wp[4]; S##a2 = wp[8]; S##a3 = wp[12]; } \
            S##ws = ((kk) < n) ? WSC[t_] : 0.f; \
            S##hv = *(const float2*)(hrow + (size_t)t_ * D); } while (0)
#define GV_TOKEN(R, S, kk) do { \
            const int t = GV_TK(kk); \
            _Pragma("unroll") for (int i = 0; i < 16; ++i) *(u32x4_t*)(tile + i * GV_PIECE + lane * 16) = R[i]; \
            f32x4 acc[8]; \
            _Pragma("unroll") for (int nt = 0; nt < 8; ++nt) acc[nt] = (f32x4){0.f, 0.f, 0.f, 0.f}; \
            _Pragma("unroll") for (int s4 = 0; s4 < 4; ++s4) { \
                const long av = (s4 == 0) ? S##a0 : (s4 == 1) ? S##a1 : (s4 == 2) ? S##a2 : S##a3; \
                _Pragma("unroll") for (int nt = 0; nt < 8; ++nt) { \
                    const v2i_t bv = __builtin_amdgcn_ds_read_tr8_b64_v2i32((ldsv2_t)(void*)(tile + (4 * s4) * GV_PIECE + rdo + ((nt ^ rr) << 4))); \
                    acc[nt] = __builtin_amdgcn_mfma_f32_16x16x32_fp8_fp8(av, __builtin_bit_cast(long, bv), acc[nt], 0, 0, 0); } } \
            if (lane < 16) { _Pragma("unroll") for (int nt = 0; nt < 8; ++nt) strip[16 * nt + lane] = acc[nt][0]; }        \
            { const float2 o2 = *(const float2*)(strip + 2 * lane); \
              if ((kk) < n) *(float2*)(hrow + (size_t)t * D) = make_float2(S##hv.x + S##ws * o2.x, S##hv.y + S##ws * o2.y); } } while (0)
        int Ael, Aeh, Bel, Beh; u32x4_t rA[16], rB[16];
        long Pa0, Pa1, Pa2, Pa3, Qa0, Qa1, Qa2, Qa3; float Pws, Qws; float2 Phv, Qhv;
        GV_LOADE(A, GV_TK(0)); GV_LOADE(B, GV_TK(1));
        GV_ISSUE(rA, A); GV_LOADT(P, 0);
        for (int k = 0; k < n; k += 2) {
            GV_ISSUE(rB, B); GV_LOADE(A, GV_TK(k + 2)); GV_LOADT(Q, k + 1);
            GV_TOKEN(rA, P, k);
            GV_ISSUE(rA, A); GV_LOADE(B, GV_TK(k + 3)); GV_LOADT(P, k + 2);
            GV_TOKEN(rB, Q, k + 1);
        }
#undef GV_TK
#undef GV_LOADE
#undef GV_ISSUE
#undef GV_LOADT
#undef GV_TOKEN
    }
    __syncthreads();
}
__device__ __forceinline__ void phase_gnorm(const Params& P, int l) {
    const int lane = tidx() & 63, nw = nwave();
    bf16* XNw = (bf16*)(P.ws + WS_XN);
    const float4* g = (const float4*)((l == DEPTH - 1) ? P.norm_final : (P.norm_mix + (l + 1) * D));
    for (int t = gwave(); t < T; t += 2 * nw) {
        const int t2 = (t + nw < T) ? (t + nw) : t;
        float4 v[2][4];
#pragma unroll
        for (int q = 0; q < 4; ++q) { v[0][q] = ((const float4*)(P.out + (size_t)t * D))[q * 64 + lane]; v[1][q] = ((const float4*)(P.out + (size_t)t2 * D))[q * 64 + lane]; }
#pragma unroll
        for (int u = 0; u < 2; ++u) {
            float ss = 0.f;
#pragma unroll
            for (int q = 0; q < 4; ++q) ss += v[u][q].x * v[u][q].x + v[u][q].y * v[u][q].y + v[u][q].z * v[u][q].z + v[u][q].w * v[u][q].w;
            ss = wave_sum(ss);
            const float rn = rsqrtf(ss * (1.f / D) + EPS);
            const int tt = u ? t2 : t;
            if (u == 0 || t2 != t) {
                float4* hr = (float4*)(P.out + (size_t)tt * D);
#pragma unroll
                for (int q = 0; q < 4; ++q) {
                    const float4 gg = g[q * 64 + lane];
                    const float4 o = make_float4(v[u][q].x * rn * gg.x, v[u][q].y * rn * gg.y, v[u][q].z * rn * gg.z, v[u][q].w * rn * gg.w);
                    if (l == DEPTH - 1) hr[q * 64 + lane] = o;
                    else { uint2 uu; uu.x = pack2(o.x, o.y); uu.y = pack2(o.z, o.w); ((uint2*)(XNw + (size_t)tt * LDX))[q * 64 + lane] = uu; }
                }
            }
        }
    }
}

#define XB_TMO      128
#define XB_XCNT(j)  (256  + 64 * (j))
#define XB_XSUB(j)  (1280 + 64 * (j))
#define XB_XGEN(j)  (2304 + 64 * (j))
#define XB_TOP      3328
#define XB_TOPGEN   3392
#define XCD_BAR_WORDS 3456
#define XB_SPIN_CAP (1u << 22)
#define LAS __attribute__((address_space(3)))
__device__ __forceinline__ unsigned xb_ld(unsigned* p)              { return __hip_atomic_load(p, __ATOMIC_RELAXED, __HIP_MEMORY_SCOPE_AGENT); }
__device__ __forceinline__ unsigned xb_add(unsigned* p, unsigned v) { return __hip_atomic_fetch_add(p, v, __ATOMIC_RELAXED, __HIP_MEMORY_SCOPE_AGENT); }
__device__ __forceinline__ unsigned xb_xcc_id() { return (unsigned)__builtin_amdgcn_s_getreg((3 << 11) | 20) & 0xFu; }
#define XB_SPIN(cond, bar) do { unsigned _sp = 0; while (cond) { __builtin_amdgcn_s_sleep(1); \
    if ((++_sp & 255u) == 0u) { if (xb_ld(&(bar)[XB_TMO])) break; if (_sp > XB_SPIN_CAP) { atomicAdd(&(bar)[XB_TMO], 1u); break; } } } } while (0)
struct XcdBarrier { unsigned* bar; unsigned x; volatile LAS unsigned* st; };
__device__ __forceinline__ XcdBarrier xcd_barrier_post(unsigned* bar, volatile LAS unsigned* st) {
    XcdBarrier b; b.bar = bar; b.x = xb_xcc_id(); b.st = st;
    if (__builtin_amdgcn_workitem_id_x() == 0) (void)xb_add(&bar[XB_XCNT(b.x)], 1u);
    return b;
}
__device__ __forceinline__ void xcd_barrier_complete(unsigned* bar, unsigned x, unsigned& nloc, unsigned& nx) {
    const unsigned G = gridDim.x * gridDim.y * gridDim.z;
    unsigned sum, cnt, mine, sp = 0u;
    for (;;) {
        sum = 0u; cnt = 0u; mine = 0u;
#pragma unroll
        for (unsigned j = 0; j < 16; ++j) { const unsigned c = xb_ld(&bar[XB_XCNT(j)]); sum += c; cnt += (c > 0u) ? 1u : 0u; mine = (j == x) ? c : mine; }
        if (sum == G) break;
        __builtin_amdgcn_s_sleep(1);
        if ((++sp & 255u) == 0u) { if (xb_ld(&bar[XB_TMO])) break; if (sp > XB_SPIN_CAP) { atomicAdd(&bar[XB_TMO], 1u); break; } }
    }
    nloc = mine > 0u ? mine : 1u; nx = cnt > 0u ? cnt : 1u;
}
__device__ __forceinline__ void xcd_barrier(const XcdBarrier& b) {
    asm volatile("s_waitcnt vmcnt(0)" ::: "memory");
    __syncthreads();
    if (__builtin_amdgcn_workitem_id_x() == 0) {
        unsigned* bar = b.bar;
        __builtin_amdgcn_s_waitcnt(0);
        unsigned nloc = b.st[0], nx = b.st[1];
        if (nloc == 0u) { xcd_barrier_complete(bar, b.x, nloc, nx); b.st[0] = nloc; b.st[1] = nx; }
        const unsigned old = xb_add(&bar[XB_XSUB(b.x)], 1u);
        const unsigned gen = old / nloc;
        if (old + 1u == (gen + 1u) * nloc) {
            __builtin_amdgcn_fence(__ATOMIC_RELEASE, "agent");
            asm volatile("s_waitcnt vmcnt(0)" ::: "memory");
            const unsigned og = xb_add(&bar[XB_TOP], 1u);
            const unsigned tg = og / nx;
            if (og + 1u == (tg + 1u) * nx) xb_add(&bar[XB_TOPGEN], 1u);
            else XB_SPIN(xb_ld(&bar[XB_TOPGEN]) == tg, bar);
            __builtin_amdgcn_fence(__ATOMIC_ACQUIRE, "agent");
            xb_add(&bar[XB_XGEN(b.x)], 1u);
            asm volatile("s_waitcnt vmcnt(0)" ::: "memory");
        } else {
            XB_SPIN(xb_ld(&bar[XB_XGEN(b.x)]) == gen, bar);
            __builtin_amdgcn_fence(__ATOMIC_ACQUIRE, "agent");
            asm volatile("s_waitcnt vmcnt(0)" ::: "memory");
        }
    }
    __syncthreads();
}

constexpr float QSCALE = 0.10206207261596575f * 1.4426950408889634f;

__device__ __forceinline__ void phase_gemm1(const Params& P, int l, char* lds) {
    unsigned char* ws = P.ws;
    const bf16* XN = (const bf16*)(ws + WS_XN);
    bf16* PROJ = (bf16*)(ws + WS_PROJ);
    bf16* Kb = (bf16*)(ws + WS_K);
    const float* rope = (const float*)(ws + WS_ROPE);
    const bf16* W = (const bf16*)(ws + WS_WIN) + (size_t)l * DINP * LDW;
    const int lane = tidx() & 63;
    gemm_t8(W, LDW, DINP, XN, LDX, T, D, [&](int t, int n, const float4& v) {
        const int nb = __builtin_amdgcn_readfirstlane(n);
        if (nb < C_KR) {
            uint2 o; o.x = cvtpk(v.x, v.y); o.y = cvtpk(v.z, v.w);
            *(uint2*)(PROJ + (size_t)t * DINP + n) = o;
        } else if (nb == C_KR) {
            const float4 up = make_float4(__shfl(v.x, lane + 4, 64), __shfl(v.y, lane + 4, 64), __shfl(v.z, lane + 4, 64), __shfl(v.w, lane + 4, 64));
            const float4 dn = make_float4(__shfl(v.x, lane - 4, 64), __shfl(v.y, lane - 4, 64), __shfl(v.z, lane - 4, 64), __shfl(v.w, lane - 4, 64));
            const int d = n - C_KR;
            if (d < 32) {
                const int b = t / S, s = t % S;
                const bool first = d < 16;
                const int f = first ? d : (d - 16);
                const float4 cs0 = *(const float4*)(rope + ((size_t)s * 16 + f) * 2), cs1 = *(const float4*)(rope + ((size_t)s * 16 + f) * 2 + 4);
                float4 o;
                if (first) o = make_float4(v.x * cs0.x - up.x * cs0.y, v.y * cs0.z - up.y * cs0.w, v.z * cs1.x - up.z * cs1.y, v.w * cs1.z - up.w * cs1.w);
                else       o = make_float4(v.x * cs0.x + dn.x * cs0.y, v.y * cs0.z + dn.y * cs0.w, v.z * cs1.x + dn.z * cs1.y, v.w * cs1.z + dn.w * cs1.w);
                uint2 u; u.x = cvtpk(o.x, o.y); u.y = cvtpk(o.z, o.w);
#pragma unroll
                for (int h = 0; h < NH; ++h) *(uint2*)(Kb + ((size_t)(b * NH + h) * S + s) * DQK + 64 + d) = u;
            }
        }
    }, lds);
}
__device__ __forceinline__ void phase_gemm2(const Params& P, int l, char* lds) {
    unsigned char* ws = P.ws;
    const bf16* PROJ = (const bf16*)(ws + WS_PROJ);
    const float* rope = (const float*)(ws + WS_ROPE);
    const int lane = tidx() & 63;
    {
        const bf16* W = (const bf16*)(ws + WS_WUQ) + (size_t)l * 768 * QR;
        bf16* Qb = (bf16*)(ws + WS_Q);
        gemm_t1(W, QR, 768, PROJ + C_CQ, DINP, T, QR,
            [&](int t, int n, const float4& v) {
                const int b = t / S, s = t % S, h = n / DQK, d = n % DQK;
                float4 o = v;
                const float4 up = make_float4(__shfl(v.x, lane + 4, 64), __shfl(v.y, lane + 4, 64), __shfl(v.z, lane + 4, 64), __shfl(v.w, lane + 4, 64));
                const float4 dn = make_float4(__shfl(v.x, lane - 4, 64), __shfl(v.y, lane - 4, 64), __shfl(v.z, lane - 4, 64), __shfl(v.w, lane - 4, 64));
                if (d >= 64) {
                    const bool first = d < 80;
                    const int f = first ? (d - 64) : (d - 80);
                    const float4 cs0 = *(const float4*)(rope + ((size_t)s * 16 + f) * 2), cs1 = *(const float4*)(rope + ((size_t)s * 16 + f) * 2 + 4);
                    if (first) o = make_float4(v.x * cs0.x - up.x * cs0.y, v.y * cs0.z - up.y * cs0.w, v.z * cs1.x - up.z * cs1.y, v.w * cs1.z - up.w * cs1.w);
                    else       o = make_float4(v.x * cs0.x + dn.x * cs0.y, v.y * cs0.z + dn.y * cs0.w, v.z * cs1.x + dn.z * cs1.y, v.w * cs1.z + dn.w * cs1.w);
                }
                uint2 u; u.x = cvtpk(o.x, o.y); u.y = cvtpk(o.z, o.w);
                *(uint2*)(Qb + ((size_t)(b * NH + h) * S + s) * DQK + d) = u;
            }, [](float ssq) { return rsqrtf(ssq * (1.f / QR) + EPS) * QSCALE; }, lds);
    }
    {
        const bf16* W = (const bf16*)(ws + WS_WUKV) + (size_t)l * 1024 * KVR;
        bf16* Kb = (bf16*)(ws + WS_K); bf16* Vb = (bf16*)(ws + WS_V);
        gemm_t1(W, KVR, 1024, PROJ + C_CKV, DINP, T, KVR,
            [&](int t, int n, const float4& v) {
                const int b = t / S, s = t % S;
                uint2 u; u.x = cvtpk(v.x, v.y); u.y = cvtpk(v.z, v.w);
                if (n < 512) *(uint2*)(Kb + ((size_t)(b * NH + (n >> 6)) * S + s) * DQK + (n & 63)) = u;
                else         *(uint2*)(Vb + ((size_t)(b * NH + ((n - 512) >> 6)) * S + s) * DV + (n & 63)) = u;
            }, [](float ssq) { return rsqrtf(ssq * (1.f / KVR) + EPS); }, lds);
    }
}
__device__ __forceinline__ void phase_gemm3(const Params& P, int l, char* lds) {
    unsigned char* ws = P.ws;
    const bf16* Yb = (const bf16*)(ws + WS_XN);
    const bf16* W = (const bf16*)(ws + WS_WOUT) + (size_t)l * D * LDW;
    const float* hin = (l == 0) ? P.x : P.out;
    float* out = P.out;
    gemm_t8(W, LDW, D, Yb, LDX, T, D, [&](int t, int n, const float4& v) {
        const size_t idx = (size_t)t * D + n;
        const float4 hv = *(const float4*)(hin + idx);
        *(float4*)(out + idx) = make_float4(hv.x + v.x, hv.y + v.y, hv.z + v.z, hv.w + v.w);
    }, lds);
}

#define GSYNC() do { XcdBarrier xb_; { __attribute__((address_space(1))) char* gp_ = (__attribute__((address_space(1))) char*)(char*)(P.ws + WS_CTL); asm volatile("" : "+s"(gp_)); xb_.bar = (unsigned*)(char*)gp_; } \
    xb_.x = xb_xcc_id(); xb_.st = (volatile LAS unsigned*)&xb_words; xcd_barrier(xb_); } while (0)
#define PHASE(stmt) { const Params Q = launder(P); stmt; }
__global__ void __launch_bounds__(NTHREADS, 2) k_all(Params P) {
    __shared__ __attribute__((aligned(16))) char sm[LDS_TOTAL];
    __shared__ uint4 xb_words;
    cg::grid_group grid = cg::this_grid();
    if (__builtin_amdgcn_workitem_id_x() == 0) xb_words = make_uint4(0u, 0u, 0u, 0u);
    __syncthreads();
    (void)xcd_barrier_post((unsigned*)(P.ws + WS_CTL), (volatile LAS unsigned*)&xb_words);
    __shared__ int xinfo[8];
    if (__builtin_amdgcn_workitem_id_x() == 0) {
        const unsigned x = xb_xcc_id();
        xinfo[XI_X] = (int)x; xinfo[XI_RANK] = (int)xb_add((unsigned*)(P.ws + WS_CTL) + CTL_CENSUS + x, 1u);
    }
    PHASE(phase_prep(Q, sm));
    PHASE(phase_norm(Q.x, Q.norm_mix, (bf16*)(Q.ws + WS_XN)));
    if (P.ws == nullptr) grid.sync();
    GSYNC();
    if (__builtin_amdgcn_workitem_id_x() == 0) {
        unsigned* cen = (unsigned*)(P.ws + WS_CTL) + CTL_CENSUS;
        const int x = xinfo[XI_X]; int nx = 0, jj = 0;
        for (int q = 0; q < 16; ++q) { const unsigned cq = xb_ld(cen + q); if (cq) { if (q < x) ++jj; ++nx; } }
        xinfo[XI_J] = jj; xinfo[XI_NX] = nx; xinfo[XI_NLOC] = (int)xb_ld(cen + x);
    }
    __syncthreads();
    for (int l = 0; l < DEPTH; ++l) {
        PHASE(phase_gemm1(Q, l, sm));
#if PROBE_DUP & 2
        PHASE(phase_gemm1(Q, l, sm));
#endif
        GSYNC();
        PHASE(phase_mixlocal(Q, l, sm));
#if PROBE_DUP & 256
        PHASE(phase_mixlocal(Q, l, sm));
#endif
        PHASE(phase_gemm2(Q, l, sm));
        GSYNC();
        PHASE(phase_attn(Q, sm));
        GSYNC();
        PHASE(phase_gemm3(Q, l, sm));
#if PROBE_DUP & 16
        if (l == 0) PHASE(phase_gemm3(Q, l, sm));
#endif
        GSYNC();
        PHASE(phase_norm_q(Q, l));
        GSYNC();
        PHASE(phase_route(Q, l, sm));
        GSYNC();
        PHASE(phase_gu(Q, l, xinfo));
        GSYNC();
        PHASE(phase_gw(Q, l));
        GSYNC();
        PHASE(phase_gv(Q, l, xinfo, sm));
        GSYNC();
        PHASE(phase_gnorm(Q, l));
        GSYNC();
    }
}

extern "C" void kernel_launch(void* const* d_in, const int* in_sizes, int n_in, void* d_out, int out_size, void* d_ws, size_t ws_size, hipStream_t stream) {
    static int grid = 0;
    if (grid == 0) {
        if (n_in != 18 || out_size != T * D || ws_size < WS_END) { fprintf(stderr, "kernel_launch: bad sizes n_in %d out %d ws %zu need %zu\n", n_in, out_size, ws_size, (size_t)WS_END); grid = -1; return; }
        int dev = 0, cus = 0, per_cu = 0;
        (void)hipGetDevice(&dev);
        (void)hipDeviceGetAttribute(&cus, hipDeviceAttributeMultiprocessorCount, dev);
        (void)hipOccupancyMaxActiveBlocksPerMultiprocessor(&per_cu, (const void*)k_all, NTHREADS, 0);
        if (per_cu > 1) per_cu = 1;
        if (per_cu < 1) { fprintf(stderr, "kernel_launch: occupancy query says %d\n", per_cu); grid = -1; return; }
        grid = cus * per_cu;
    }
    if (grid < 0) return;
    Params p{};
    p.x = (const float*)d_in[0]; p.norm_mix = (const float*)d_in[1]; p.w_in = (const float*)d_in[2]; p.conv_w = (const float*)d_in[3];
    p.pool_w = (const float*)d_in[4]; p.pool_scale = (const float*)d_in[5]; p.q_norm = (const float*)d_in[6]; p.w_uq = (const float*)d_in[7];
    p.kv_norm = (const float*)d_in[8]; p.w_uk = (const float*)d_in[9]; p.w_uv = (const float*)d_in[10]; p.w_out = (const float*)d_in[11];
    p.norm_ffn = (const float*)d_in[12]; p.peer_wq = (const float*)d_in[13]; p.peer_subkeys = (const float*)d_in[14]; p.peer_u = (const float*)d_in[15];
    p.peer_v = (const float*)d_in[16]; p.norm_final = (const float*)d_in[17];
    p.out = (float*)d_out; p.ws = (unsigned char*)d_ws;
    if (hipMemsetAsync((char*)d_ws + WS_CTL, 0, CTL_BYTES, stream) != hipSuccess) { fprintf(stderr, "kernel_launch: memset failed\n"); return; }
    void* args[] = {&p};
    hipError_t e = hipLaunchCooperativeKernel((const void*)k_all, dim3(grid), dim3(NTHREADS), args, 0, stream);
    if (e != hipSuccess) fprintf(stderr, "cooperative launch failed: %s (grid %d)\n", hipGetErrorString(e), grid);
}
```

```cpp
#include <hip/hip_runtime.h>
#include <hip/hip_cooperative_groups.h>
#include <cstdio>
#include <cstdint>
namespace cg = cooperative_groups;

#ifndef TAB_FP8
#define TAB_FP8 1
#endif
#ifndef PROBE_DUP
#define PROBE_DUP 0
#endif

constexpr int NB = 4, S = 8192, T = NB * S, D = 1024, DEPTH = 2;
constexpr int DIN = 1696, DINP = 1792;
constexpr int C_BG = 0, C_CG = 256, C_HC = 512, C_HP = 768, C_CQ = 1024, C_CKV = 1408, C_KR = 1664;
constexpr int QR = 384, KVR = 256, NH = 8, DQK = 96, DV = 64;
constexpr int PH = 8, NKEY = 128, NEXP = NKEY * NKEY, TOPK = 16, HK = PH * TOPK;
constexpr float EPS = 1e-6f;
constexpr int LDX = 1088;
constexpr int LDW = 1088;

typedef unsigned short bf16;

constexpr size_t WS_CTL   = 0;
constexpr size_t WS_ROPE  = 64 * 1024;
constexpr size_t WS_WIN   = WS_ROPE + (size_t)S * 16 * 2 * 4;
constexpr size_t WS_WUQ   = WS_WIN + (size_t)DEPTH * DINP * LDW * 2;
constexpr size_t WS_WUKV  = WS_WUQ + (size_t)DEPTH * 768 * QR * 2;
constexpr size_t WS_WOUT  = WS_WUKV + (size_t)DEPTH * 1024 * KVR * 2;
constexpr size_t WS_WPQ   = WS_WOUT + (size_t)DEPTH * D * LDW * 2;
constexpr size_t WS_XN    = ((WS_WPQ + (size_t)DEPTH * 2048 * LDW * 2 + 4095) / 4096) * 4096;
constexpr size_t WS_PROJ  = WS_XN + (size_t)T * LDX * 2;
constexpr size_t WS_Q     = WS_PROJ + (size_t)T * DINP * 2;
constexpr size_t WS_K     = WS_Q + (size_t)T * NH * DQK * 2;
constexpr size_t WS_V     = WS_K + (size_t)T * NH * DQK * 2;
constexpr size_t WS_EXP   = WS_V + (size_t)T * NH * DV * 2;
constexpr size_t WS_GATE  = WS_EXP + (size_t)T * HK * 4;
constexpr size_t TAB_ROWB = TAB_FP8 ? 1024 : 2048;
constexpr size_t WS_TABU  = WS_GATE + (size_t)T * HK * 4;
constexpr size_t WS_TABV  = WS_TABU + (size_t)DEPTH * NEXP * TAB_ROWB;
constexpr size_t WS_TSCU  = WS_TABV + (size_t)DEPTH * NEXP * TAB_ROWB;
constexpr size_t WS_TSCV  = WS_TSCU + (size_t)DEPTH * NEXP * 4;
constexpr size_t WS_XQ    = WS_TSCV + (size_t)DEPTH * NEXP * 4;
constexpr size_t WS_XS    = WS_XQ + (size_t)T * D;
constexpr size_t WS_WQ8   = WS_XS + (size_t)T * 4;
constexpr size_t WS_WSC   = WS_WQ8 + (size_t)T * HK;
constexpr size_t WS_SSQ   = WS_WSC + (size_t)T * 4;
constexpr size_t WS_END   = WS_SSQ + (size_t)T * 64;
static_assert(WS_END <= (size_t)512 * 1024 * 1024, "workspace budget");

struct Params {
    const float* x; const float* norm_mix; const float* w_in; const float* conv_w; const float* pool_w; const float* pool_scale;
    const float* q_norm; const float* w_uq; const float* kv_norm; const float* w_uk; const float* w_uv; const float* w_out;
    const float* norm_ffn; const float* peer_wq; const float* peer_subkeys; const float* peer_u; const float* peer_v; const float* norm_final;
    float* out; unsigned char* ws;
};

__device__ __forceinline__ bf16 f2bf(float f) { unsigned u = __float_as_uint(f); u += 0x7fffu + ((u >> 16) & 1u); return (bf16)(u >> 16); }
__device__ __forceinline__ float bf2f(bf16 h) { return __uint_as_float(((unsigned)h) << 16); }
__device__ __forceinline__ float bflo(unsigned u) { return __uint_as_float(u << 16); }
__device__ __forceinline__ float bfhi(unsigned u) { return __uint_as_float(u & 0xffff0000u); }
__device__ __forceinline__ unsigned pack2(float a, float b) { return (unsigned)f2bf(a) | ((unsigned)f2bf(b) << 16); }
__device__ __forceinline__ float wave_sum(float v) {
#pragma unroll
    for (int m = 32; m >= 1; m >>= 1) v += __shfl_xor(v, m, 64);
    return v;
}
__device__ __forceinline__ float gelu_exact(float x) { return 0.5f * x * (1.f + erff(x * 0.70710678118654752f)); }

#define NTHREADS 512
constexpr int NW = NTHREADS / 64;
__device__ __forceinline__ int tidx() { int t = (int)__builtin_amdgcn_workitem_id_x(); asm volatile("" : "+v"(t)); return t; }
__device__ __forceinline__ int gwave() { return blockIdx.x * (NTHREADS / 64) + (tidx() >> 6); }
__device__ __forceinline__ int nwave() { return gridDim.x * (NTHREADS / 64); }
__device__ __forceinline__ size_t gtid() { return (size_t)blockIdx.x * NTHREADS + tidx(); }
__device__ __forceinline__ size_t gnth() { return (size_t)gridDim.x * NTHREADS; }


__device__ __forceinline__ Params launder(const Params& P) {
    typedef __attribute__((address_space(1))) char* gp_t;
    gp_t g[20] = {(gp_t)(char*)P.x, (gp_t)(char*)P.norm_mix, (gp_t)(char*)P.w_in, (gp_t)(char*)P.conv_w, (gp_t)(char*)P.pool_w, (gp_t)(char*)P.pool_scale, (gp_t)(char*)P.q_norm, (gp_t)(char*)P.w_uq,
                  (gp_t)(char*)P.kv_norm, (gp_t)(char*)P.w_uk, (gp_t)(char*)P.w_uv, (gp_t)(char*)P.w_out, (gp_t)(char*)P.norm_ffn, (gp_t)(char*)P.peer_wq, (gp_t)(char*)P.peer_subkeys,
                  (gp_t)(char*)P.peer_u, (gp_t)(char*)P.peer_v, (gp_t)(char*)P.norm_final, (gp_t)(char*)P.out, (gp_t)(char*)P.ws};
    asm volatile("" : "+s"(g[0]), "+s"(g[1]), "+s"(g[2]), "+s"(g[3]), "+s"(g[4]), "+s"(g[5]), "+s"(g[6]), "+s"(g[7]), "+s"(g[8]), "+s"(g[9]));
    asm volatile("" : "+s"(g[10]), "+s"(g[11]), "+s"(g[12]), "+s"(g[13]), "+s"(g[14]), "+s"(g[15]), "+s"(g[16]), "+s"(g[17]), "+s"(g[18]), "+s"(g[19]));
    Params Q;
    Q.x = (const float*)(char*)g[0]; Q.norm_mix = (const float*)(char*)g[1]; Q.w_in = (const float*)(char*)g[2]; Q.conv_w = (const float*)(char*)g[3]; Q.pool_w = (const float*)(char*)g[4];
    Q.pool_scale = (const float*)(char*)g[5]; Q.q_norm = (const float*)(char*)g[6]; Q.w_uq = (const float*)(char*)g[7]; Q.kv_norm = (const float*)(char*)g[8]; Q.w_uk = (const float*)(char*)g[9];
    Q.w_uv = (const float*)(char*)g[10]; Q.w_out = (const float*)(char*)g[11]; Q.norm_ffn = (const float*)(char*)g[12]; Q.peer_wq = (const float*)(char*)g[13]; Q.peer_subkeys = (const float*)(char*)g[14];
    Q.peer_u = (const float*)(char*)g[15]; Q.peer_v = (const float*)(char*)g[16]; Q.norm_final = (const float*)(char*)g[17]; Q.out = (float*)(char*)g[18]; Q.ws = (unsigned char*)(char*)g[19];
    return Q;
}

typedef __attribute__((ext_vector_type(8))) short bf16x8;
typedef __attribute__((ext_vector_type(16))) float f32x16;
typedef __attribute__((ext_vector_type(2))) __bf16 bf2_t;
#define MFMA32(a, b, c) __builtin_amdgcn_mfma_f32_32x32x16_bf16(a, b, c, 0, 0, 0)
__device__ __forceinline__ int crow(int r, int hi) { return (r & 3) + 8 * (r >> 2) + 4 * hi; }
__device__ __forceinline__ float dot2bf(unsigned a, unsigned b, float c) { return __builtin_amdgcn_fdot2_f32_bf16(__builtin_bit_cast(bf2_t, a), __builtin_bit_cast(bf2_t, b), c, false); }
__device__ __forceinline__ unsigned cvtpk(float lo, float hi) { unsigned r; asm("v_cvt_pk_bf16_f32 %0, %1, %2" : "=v"(r) : "v"(lo), "v"(hi)); return r; }
constexpr int LDS_TOTAL = 140 * 1024;

template <int WT, bool ROWSS>
__device__ __forceinline__ void gemm_kloop(const bf16* __restrict__ Ag0, int lda, const bf16* __restrict__ Bg0, int ldb, int nk, f32x16 (&acc)[8], float (&ss)[4], char* lds, int tid) {
    constexpr int BROWS = (WT == 0) ? 256 : 128, NPB = BROWS / 64;
    constexpr int OPA = 256 * 128, G_BUF = OPA + BROWS * 128;
    const int lane = tid & 63, w = __builtin_amdgcn_readfirstlane(tid >> 6), r32 = lane & 31, hi = lane >> 5;
    const int srow = 8 * w + (lane >> 3);
    const int sch = (lane & 7) ^ ((srow >> 1) & 7);
    const bf16* Ag = Ag0 + (size_t)srow * lda + sch * 8;
    const bf16* Bg = Bg0 + (size_t)srow * ldb + sch * 8;
#pragma unroll
    for (int i = 0; i < 8; ++i)
#pragma unroll
        for (int r = 0; r < 16; ++r) acc[i][r] = 0.f;
    ss[0] = 0.f; ss[1] = 0.f; ss[2] = 0.f; ss[3] = 0.f;
    typedef __attribute__((address_space(3))) unsigned* ldsp_t;
    typedef const __attribute__((address_space(1))) unsigned* glbp_t;
#define G_DMA(buf, kofs) do { char* d_ = lds + (buf) * G_BUF + (8 * w) * 128; \
    _Pragma("unroll") for (int i = 0; i < 4; ++i) \
        __builtin_amdgcn_global_load_lds((glbp_t)(const void*)(Ag + (size_t)(64 * i) * lda + (kofs)), (ldsp_t)(void*)(d_ + i * 8192), 16, 0, 0); \
    _Pragma("unroll") for (int i = 0; i < NPB; ++i) \
        __builtin_amdgcn_global_load_lds((glbp_t)(const void*)(Bg + (size_t)(64 * i) * ldb + (kofs)), (ldsp_t)(void*)(d_ + OPA + i * 8192), 16, 0, 0); } while (0)
    const int xr = (r32 >> 1) & 7;
    const int o0 = ((0 + hi) ^ xr) << 4, o1 = ((2 + hi) ^ xr) << 4, o2 = ((4 + hi) ^ xr) << 4, o3 = ((6 + hi) ^ xr) << 4;
#define G_SS(s_, r_) do { union { bf16x8 v; uint4 u; } c_; c_.v = r_; s_ = dot2bf(c_.u.x, c_.u.x, s_); s_ = dot2bf(c_.u.y, c_.u.y, s_); s_ = dot2bf(c_.u.z, c_.u.z, s_); s_ = dot2bf(c_.u.w, c_.u.w, s_); } while (0)
#define G_STEP(pa, pb, off) do { \
    if (WT == 0) { \
        const bf16x8 a0 = *(const bf16x8*)(pa + off), a1 = *(const bf16x8*)(pa + 32 * 128 + off); \
        const bf16x8 b0 = *(const bf16x8*)(pb + off), b1 = *(const bf16x8*)(pb + 32 * 128 + off), b2 = *(const bf16x8*)(pb + 64 * 128 + off), b3 = *(const bf16x8*)(pb + 96 * 128 + off); \
        if (ROWSS) { G_SS(ss[0], b0); G_SS(ss[1], b1); G_SS(ss[2], b2); G_SS(ss[3], b3); } \
        acc[0] = MFMA32(a0, b0, acc[0]); acc[1] = MFMA32(a0, b1, acc[1]); acc[2] = MFMA32(a0, b2, acc[2]); acc[3] = MFMA32(a0, b3, acc[3]); \
        acc[4] = MFMA32(a1, b0, acc[4]); acc[5] = MFMA32(a1, b1, acc[5]); acc[6] = MFMA32(a1, b2, acc[6]); acc[7] = MFMA32(a1, b3, acc[7]); \
    } else if (WT == 2) { \
        const bf16x8 a0 = *(const bf16x8*)(pa + off), a1 = *(const bf16x8*)(pa + 32 * 128 + off); \
        const bf16x8 b0 = *(const bf16x8*)(pb + off), b1 = *(const bf16x8*)(pb + 32 * 128 + off); \
        if (ROWSS) { G_SS(ss[0], b0); G_SS(ss[1], b1); } \
        acc[0] = MFMA32(a0, b0, acc[0]); acc[1] = MFMA32(a0, b1, acc[1]); acc[2] = MFMA32(a1, b0, acc[2]); acc[3] = MFMA32(a1, b1, acc[3]); \
    } else { \
        const bf16x8 b0 = *(const bf16x8*)(pb + off); \
        const bf16x8 a0 = *(const bf16x8*)(pa + off), a1 = *(const bf16x8*)(pa + 32 * 128 + off); \
        const bf16x8 a2 = *(const bf16x8*)(pa + 64 * 128 + off), a3 = *(const bf16x8*)(pa + 96 * 128 + off); \
        if (ROWSS) { G_SS(ss[0], b0); } \
        acc[0] = MFMA32(a0, b0, acc[0]); acc[1] = MFMA32(a1, b0, acc[1]); \
        acc[2] = MFMA32(a2, b0, acc[2]); acc[3] = MFMA32(a3, b0, acc[3]); \
    } } while (0)
    const int arow = (WT == 1) ? ((w >> 2) * 128 + r32) : ((w >> 1) * 64 + r32);
    const int brow = (WT == 0) ? ((w & 1) * 128 + r32) : (WT == 2) ? ((w & 1) * 64 + r32) : ((w & 3) * 32 + r32);
    G_DMA(0, 0);
    for (int kt = 0; kt < nk; ++kt) {
        __syncthreads();
        if (kt + 1 < nk) G_DMA((kt + 1) & 1, (kt + 1) * 64);
        const char* pa = lds + (kt & 1) * G_BUF + arow * 128;
        const char* pb = lds + (kt & 1) * G_BUF + OPA + brow * 128;
        G_STEP(pa, pb, o0); G_STEP(pa, pb, o1); G_STEP(pa, pb, o2); G_STEP(pa, pb, o3);
    }
    if (ROWSS) { ss[0] += __shfl_xor(ss[0], 32, 64); ss[1] += __shfl_xor(ss[1], 32, 64); ss[2] += __shfl_xor(ss[2], 32, 64); ss[3] += __shfl_xor(ss[3], 32, 64); }
#undef G_DMA
#undef G_SS
#undef G_STEP
}

__device__ __forceinline__ void tile_range(int ntiles, int& lo, int& hi) {
    const int G = gridDim.x, b = blockIdx.x;
    const int vb = ((G & 7) == 0) ? ((b & 7) * (G >> 3) + (b >> 3)) : b;
    const int per = (ntiles + G - 1) / G;
    lo = vb * per; hi = lo + per; if (hi > ntiles) hi = ntiles;
}
constexpr int ST_P = 68;
static_assert(NW * 64 * ST_P * 4 <= LDS_TOTAL, "staging LDS");
template <bool ROWSS, class EPI, class EPIROW, class RSC>
__device__ __forceinline__ void gemm_t(const bf16* __restrict__ Wt, int ldw, int N, const bf16* __restrict__ X, int ldx, int M, int K, int tn_direct, EPI epi, EPIROW epirow, RSC rowscale, char* lds) {
    const int tid = tidx(), lane = tid & 63, w = tid >> 6, r32 = lane & 31, hi = lane >> 5;
    const int tilesN = N / 256, tilesM = M / 256, nk = K / 64;
    int tlo, thi; tile_range(tilesM * tilesN, tlo, thi);
    for (int tile = tlo; tile < thi; ++tile) {
        const int tm = tile / tilesN, tn = tile % tilesN;
        f32x16 acc[8]; float ss[4];
        gemm_kloop<0, ROWSS>(Wt + (size_t)(tn * 256) * ldw, ldw, X + (size_t)(tm * 256) * ldx, ldx, nk, acc, ss, lds, tid);
        if (tn < tn_direct) {
            __syncthreads();
            float* st = (float*)lds + w * (64 * ST_P);
            const int rr = lane >> 4, ch = lane & 15;
#pragma unroll
            for (int half = 0; half < 2; ++half) {
                const float m0_ = rowscale(ss[2 * half]), m1_ = rowscale(ss[2 * half + 1]);
#pragma unroll
                for (int i = 0; i < 2; ++i)
#pragma unroll
                    for (int jj = 0; jj < 2; ++jj)
#pragma unroll
                        for (int g = 0; g < 4; ++g) {
                            const float mj = jj ? m1_ : m0_;
                            const f32x16& a_ = acc[i * 4 + 2 * half + jj];
                            *(float4*)(st + (32 * jj + r32) * ST_P + 32 * i + 8 * g + 4 * hi) = make_float4(a_[4 * g] * mj, a_[4 * g + 1] * mj, a_[4 * g + 2] * mj, a_[4 * g + 3] * mj);
                        }
#pragma unroll 2
                for (int it = 0; it < 16; ++it) {
                    const int row = it * 4 + rr;
                    const float4 v = *(const float4*)(st + row * ST_P + ch * 4);
                    epirow(tm * 256 + (w & 1) * 128 + half * 64 + row, tn * 256 + (w >> 1) * 64 + ch * 4, v);
                }
            }
        } else {
#pragma unroll
            for (int i = 0; i < 2; ++i)
#pragma unroll
                for (int j = 0; j < 4; ++j)
                    epi(tn * 256 + (w >> 1) * 64 + i * 32, tm * 256 + (w & 1) * 128 + j * 32, acc[i * 4 + j], r32, hi, ss[j]);
        }
        __syncthreads();
    }
}

constexpr int ST1_P = 132;
static_assert(NW * 32 * ST1_P * 4 <= LDS_TOTAL, "staging LDS (128 x 32 wave tiles)");
template <class EPIROW, class RSC>
__device__ __forceinline__ void gemm_t1(const bf16* __restrict__ Wt, int ldw, int N, const bf16* __restrict__ X, int ldx, int M, int K, EPIROW epirow, RSC rowscale, char* lds) {
    const int tid = tidx(), lane = tid & 63, w = tid >> 6, r32 = lane & 31, hi = lane >> 5;
    const int tilesN = N / 256, tilesM = M / 128, nk = K / 64;
    int tlo, thi; tile_range(tilesM * tilesN, tlo, thi);
    for (int tile = tlo; tile < thi; ++tile) {
        const int tm = tile / tilesN, tn = tile % tilesN;
        f32x16 acc[8]; float ss[4];
        gemm_kloop<1, true>(Wt + (size_t)(tn * 256) * ldw, ldw, X + (size_t)(tm * 128) * ldx, ldx, nk, acc, ss, lds, tid);
        __syncthreads();
        float* st = (float*)lds + w * (32 * ST1_P);
        const float mj = rowscale(ss[0]);
#pragma unroll
        for (int mt = 0; mt < 4; ++mt)
#pragma unroll
            for (int g = 0; g < 4; ++g)
                *(float4*)(st + r32 * ST1_P + 32 * mt + 8 * g + 4 * hi) = make_float4(acc[mt][4 * g] * mj, acc[mt][4 * g + 1] * mj, acc[mt][4 * g + 2] * mj, acc[mt][4 * g + 3] * mj);
#pragma unroll 2
        for (int it = 0; it < 16; ++it) {
            const int row = it * 2 + hi;
            const float4 v = *(const float4*)(st + row * ST1_P + r32 * 4);
            epirow(tm * 128 + (w & 3) * 32 + row, tn * 256 + (w >> 2) * 128 + r32 * 4, v);
        }
        __syncthreads();
    }
}

template <class EPIROW>
__device__ __forceinline__ void gemm_t2(const bf16* __restrict__ Wt, int ldw, int N, const bf16* __restrict__ X, int ldx, int M, int K, EPIROW epirow, char* lds) {
    const int tid = tidx(), lane = tid & 63, w = tid >> 6, r32 = lane & 31, hi = lane >> 5;
    const int tilesN = N / 256, tilesM = M / 128, nk = K / 64;
    int tlo, thi; tile_range(tilesM * tilesN, tlo, thi);
    for (int tile = tlo; tile < thi; ++tile) {
        const int tm = tile / tilesN, tn = tile % tilesN;
        f32x16 acc[8]; float ss[4];
        gemm_kloop<2, false>(Wt + (size_t)(tn * 256) * ldw, ldw, X + (size_t)(tm * 128) * ldx, ldx, nk, acc, ss, lds, tid);
        __syncthreads();
        float* st = (float*)lds + w * (64 * ST_P);
#pragma unroll
        for (int i = 0; i < 2; ++i)
#pragma unroll
            for (int j = 0; j < 2; ++j)
#pragma unroll
                for (int g = 0; g < 4; ++g)
                    *(float4*)(st + (32 * j + r32) * ST_P + 32 * i + 8 * g + 4 * hi) = make_float4(acc[i * 2 + j][4 * g], acc[i * 2 + j][4 * g + 1], acc[i * 2 + j][4 * g + 2], acc[i * 2 + j][4 * g + 3]);
        const int rr = lane >> 4, ch = lane & 15;
#pragma unroll 4
        for (int it = 0; it < 16; ++it) {
            const int row = it * 4 + rr;
            const float4 v = *(const float4*)(st + row * ST_P + ch * 4);
            epirow(tm * 128 + (w & 1) * 64 + row, tn * 256 + (w >> 1) * 64 + ch * 4, v);
        }
        __syncthreads();
    }
}

typedef __attribute__((ext_vector_type(4))) float f32x4;
constexpr int G8_HT = 128 * 64;
__device__ __forceinline__ int g8_lds_byte(int r, int c) {
    const int st = (r >> 4) * 2 + (c >> 5), rr = r & 15, cc = c & 31, ob = rr * 64 + cc * 2;
    return st * 1024 + (ob ^ (((ob >> 9) & 1) << 5));
}
__device__ __forceinline__ void g8_stage_rc(int b, int& R, int& C) {
    const int st = b / 1024, sb = b % 1024, swz = sb ^ (((sb >> 9) & 1) << 5);
    R = (st >> 1) * 16 + swz / 64; C = (st & 1) * 32 + (swz % 64) / 2;
}
__device__ __forceinline__ float ssq8(const bf16x8& v, float s) {
    union { bf16x8 v; uint4 u; } c_; c_.v = v;
    s = dot2bf(c_.u.x, c_.u.x, s); s = dot2bf(c_.u.y, c_.u.y, s); s = dot2bf(c_.u.z, c_.u.z, s); return dot2bf(c_.u.w, c_.u.w, s);
}
template <bool ROWSS, bool APERM = false>
__device__ __forceinline__ void gemm8_kloop(const bf16* __restrict__ A, int lda, const bf16* __restrict__ Bt, int ldb, int nt, f32x4 (&acc)[2][2][4][2], float (&ss)[2][2], char* lds, int tid) {
    bf16* shm = (bf16*)lds;
    typedef __attribute__((address_space(3))) unsigned* ldsp_t;
    typedef const __attribute__((address_space(1))) unsigned* glbp_t;
#define SA(b, h) (shm + ((b) * 2 + (h)) * G8_HT)
#define SB(b, h) (shm + (4 + (b) * 2 + (h)) * G8_HT)
    int sr0, sc0; g8_stage_rc(tid * 16, sr0, sc0);
    const unsigned voa = (unsigned)((sr0 * lda + sc0) * 2), vob = (unsigned)((sr0 * ldb + sc0) * 2);
    const char* Ap = (const char*)A; const char* Bp = (const char*)Bt;
    const int wbase = __builtin_amdgcn_readfirstlane(tid >> 6) * 1024;
#define STAGE_(P, BASE, VO, LD, br, r2, kt) do { const char* g_ = BASE + ((size_t)(br) * LD + (kt) * 64) * 2; \
    __builtin_amdgcn_global_load_lds((glbp_t)(const void*)(g_ + VO), (ldsp_t)(void*)((char*)(P) + wbase), 16, 0, 0); \
    __builtin_amdgcn_global_load_lds((glbp_t)(const void*)(g_ + (size_t)(2 * (r2)) * LD + VO), (ldsp_t)(void*)((char*)(P) + wbase + 8192), 16, 0, 0); } while (0)
#define STAGEA(b, h, kt) STAGE_(SA(b, h), Ap, voa, lda, (APERM ? (h) * 64 : (h) * 128), (APERM ? 128 : 64), kt)
#define STAGEB(b, h, kt) STAGE_(SB(b, h), Bp, vob, ldb, (h) * 128, 64, kt)
    const int lane = tid & 63, wid = tid >> 6, wr = wid >> 2, wc = wid & 3, fr = lane & 15, fq = lane >> 4;
    int abase, bbase;
    { const int ob = fr * 64 + fq * 16, lp = ob ^ (((ob >> 9) & 1) << 5);
      abase = lp + wr * 8192; bbase = lp + wc * 4096 + 4 * G8_HT * 2;
      asm volatile("" : "+v"(abase), "+v"(bbase)); }
#define LDA(dst, b, h) _Pragma("unroll") for (int m = 0; m < 4; ++m) _Pragma("unroll") for (int k = 0; k < 2; ++k) \
    dst[m][k] = *reinterpret_cast<const bf16x8*>(lds + abase + (((b) * 2 + (h)) * G8_HT * 2 + m * 2048 + k * 1024))
#define LDB(dst, b, h) _Pragma("unroll") for (int n = 0; n < 2; ++n) _Pragma("unroll") for (int k = 0; k < 2; ++k) \
    dst[n][k] = *reinterpret_cast<const bf16x8*>(lds + bbase + (((b) * 2 + (h)) * G8_HT * 2 + n * 2048 + k * 1024))
#define MMA(ai, bj, At_, Bt_) do { __builtin_amdgcn_s_setprio(1); \
    _Pragma("unroll") for (int m = 0; m < 4; ++m) _Pragma("unroll") for (int n = 0; n < 2; ++n) _Pragma("unroll") for (int k = 0; k < 2; ++k) \
        acc[ai][bj][m][n] = __builtin_amdgcn_mfma_f32_16x16x32_bf16(At_[m][k], Bt_[n][k], acc[ai][bj][m][n], 0, 0, 0); \
    __builtin_amdgcn_s_setprio(0); } while (0)
#define SSQ(bj, Bt_) do { if (ROWSS) { _Pragma("unroll") for (int n = 0; n < 2; ++n) { ss[bj][n] = ssq8(Bt_[n][0], ss[bj][n]); ss[bj][n] = ssq8(Bt_[n][1], ss[bj][n]); } } } while (0)
#define WAIT_V(n) asm volatile("s_waitcnt vmcnt(" #n ")" ::: "memory")
#define WAIT_L(n) asm volatile("s_waitcnt lgkmcnt(" #n ")" ::: "memory")
#define BAR __builtin_amdgcn_s_barrier()
#define SCHED __builtin_amdgcn_sched_barrier(0)
#pragma unroll
    for (int a = 0; a < 2; ++a)
#pragma unroll
        for (int b = 0; b < 2; ++b)
#pragma unroll
            for (int m = 0; m < 4; ++m)
#pragma unroll
                for (int n = 0; n < 2; ++n) acc[a][b][m][n] = f32x4{0.f, 0.f, 0.f, 0.f};
    ss[0][0] = 0.f; ss[0][1] = 0.f; ss[1][0] = 0.f; ss[1][1] = 0.f;
    bf16x8 At[4][2], B0[2][2], B1[2][2];
    STAGEB(0, 0, 0); STAGEA(0, 0, 0);
    STAGEB(0, 1, 0); STAGEA(0, 1, 0);
    if (wr == 1) BAR;
    WAIT_V(4); BAR;
    STAGEB(1, 0, 1); STAGEA(1, 0, 1); STAGEB(1, 1, 1);
    WAIT_V(6); BAR;
    for (int t = 0; t < nt - 2; t += 2) {
        LDB(B0, 0, 0); SCHED; LDA(At, 0, 0); STAGEA(1, 1, t + 1);
        WAIT_L(8); BAR; WAIT_L(0); MMA(0, 0, At, B0); SSQ(0, B0); BAR; SCHED;
        LDB(B1, 0, 1); STAGEB(0, 0, t + 2);
        BAR; WAIT_L(0); MMA(0, 1, At, B1); SSQ(1, B1); BAR;
        LDA(At, 0, 1); STAGEA(0, 0, t + 2);
        BAR; WAIT_L(0); MMA(1, 0, At, B0); BAR; SCHED;
        STAGEB(0, 1, t + 2);
        WAIT_V(6); BAR; MMA(1, 1, At, B1); BAR;
        LDB(B0, 1, 0); SCHED; LDA(At, 1, 0); STAGEA(0, 1, t + 2);
        WAIT_L(8); BAR; WAIT_L(0); MMA(0, 0, At, B0); SSQ(0, B0); BAR; SCHED;
        LDB(B1, 1, 1); STAGEB(1, 0, t + 3);
        BAR; WAIT_L(0); MMA(0, 1, At, B1); SSQ(1, B1); BAR;
        LDA(At, 1, 1); STAGEA(1, 0, t + 3);
        BAR; WAIT_L(0); MMA(1, 0, At, B0); BAR; SCHED;
        STAGEB(1, 1, t + 3);
        WAIT_V(6); BAR; MMA(1, 1, At, B1); BAR;
    }
    { LDB(B0, 0, 0); LDA(At, 0, 0); STAGEA(1, 1, nt - 1);
      BAR; WAIT_L(0); MMA(0, 0, At, B0); SSQ(0, B0); BAR;
      LDB(B1, 0, 1); BAR; WAIT_L(0); MMA(0, 1, At, B1); SSQ(1, B1); BAR;
      LDA(At, 0, 1); WAIT_V(4); BAR; WAIT_L(0); MMA(1, 0, At, B0); MMA(1, 1, At, B1); BAR; }
    { LDB(B0, 1, 0); LDA(At, 1, 0); WAIT_V(2); BAR; WAIT_L(0); MMA(0, 0, At, B0); SSQ(0, B0); BAR;
      LDB(B1, 1, 1); WAIT_V(0); BAR; WAIT_L(0); MMA(0, 1, At, B1); SSQ(1, B1); BAR;
      LDA(At, 1, 1); BAR; WAIT_L(0); MMA(1, 0, At, B0); MMA(1, 1, At, B1); BAR; }
    if (wr == 0) BAR;
    if (ROWSS) {
#pragma unroll
        for (int b = 0; b < 2; ++b)
#pragma unroll
            for (int n = 0; n < 2; ++n) { ss[b][n] += __shfl_xor(ss[b][n], 16, 64); ss[b][n] += __shfl_xor(ss[b][n], 32, 64); }
    }
#undef SSQ
#undef SA
#undef SB
#undef STAGE_
#undef STAGEA
#undef STAGEB
#undef LDA
#undef LDB
#undef MMA
#undef WAIT_V
#undef WAIT_L
#undef BAR
#undef SCHED
}
template <bool SCALE, class EPIROW, class RSC>
__device__ __forceinline__ void gemm_t8(const bf16* __restrict__ Wt, int ldw, int N, const bf16* __restrict__ X, int ldx, int K, int tlo, int thi, EPIROW epirow, RSC rowscale, char* lds) {
    const int tid = tidx();
    const int tilesN = N / 256; int nt = K / 64;
    asm volatile("" : "+s"(nt));
    for (int tile = tlo; tile < thi; ++tile) {
        const int tm = tile / tilesN, tn = tile % tilesN;
        f32x4 acc[2][2][4][2]; float ss[2][2];
        gemm8_kloop<false>(Wt + (size_t)(tn * 256) * ldw, ldw, X + (size_t)(tm * 256) * ldx, ldx, nt, acc, ss, lds, tid);
        __syncthreads();
        const int te = tidx();
        const int le = te & 63, w = te >> 6, wr = w >> 2, wc = w & 3, fr = le & 15, fq = le >> 4;
        float* st = (float*)lds + w * (32 * ST_P);
        const int rr = le >> 4, ch = le & 15;
#pragma unroll
        for (int ai = 0; ai < 2; ++ai)
#pragma unroll
            for (int bj = 0; bj < 2; ++bj) {
#pragma unroll
                for (int n = 0; n < 2; ++n) {
                    const float mj = SCALE ? rowscale(tm * 256 + bj * 128 + wc * 32 + n * 16 + fr) : 1.f;
#pragma unroll
                    for (int m = 0; m < 4; ++m) {
                        const f32x4 a_ = acc[ai][bj][m][n];
                        *(float4*)(st + (n * 16 + fr) * ST_P + m * 16 + fq * 4) = SCALE ? make_float4(a_[0] * mj, a_[1] * mj, a_[2] * mj, a_[3] * mj) : make_float4(a_[0], a_[1], a_[2], a_[3]);
                    }
                }
#pragma unroll 2
                for (int it = 0; it < 8; ++it) {
                    const int row = it * 4 + rr;
                    const float4 v = *(const float4*)(st + row * ST_P + ch * 4);
                    epirow(tm * 256 + bj * 128 + wc * 32 + row, tn * 256 + ai * 128 + wr * 64 + ch * 4, v);
                }
            }
        __syncthreads();
    }
}

__device__ __forceinline__ void transpose_tiled(const float* __restrict__ W, bf16* __restrict__ Wt, int K, int N, int Npad, int ldk, const float* __restrict__ gain, char* lds) {
    float (*tl)[65] = (float (*)[65])lds;
    const int tid = tidx(), a = tid & 63, q = tid >> 6;
    const int tK = K / 64, tN = Npad / 64;
    for (int tile = blockIdx.x; tile < tK * tN; tile += gridDim.x) {
        const int k0 = (tile / tN) * 64, n0 = (tile % tN) * 64;
#pragma unroll 4
        for (int i = 0; i < 64 / NW; ++i) {
            const int k = k0 + q * (64 / NW) + i, n = n0 + a;
            float v = (n < N) ? W[(size_t)k * N + n] : 0.f;
            if (gain) v *= gain[k];
            tl[q * (64 / NW) + i][a] = v;
        }
        __syncthreads();
#pragma unroll 4
        for (int i = 0; i < 64 / NW; ++i) { const int nl = q * (64 / NW) + i; Wt[(size_t)(n0 + nl) * ldk + k0 + a] = f2bf(tl[a][nl]); }
        __syncthreads();
    }
}

__device__ __forceinline__ void quant_row(const float4 (&v)[4], unsigned char* __restrict__ dst, float* __restrict__ scl, int r, int lane) {
    float am = 0.f;
#pragma unroll
    for (int j = 0; j < 4; ++j) am = fmaxf(am, fmaxf(fmaxf(fabsf(v[j].x), fabsf(v[j].y)), fmaxf(fabsf(v[j].z), fabsf(v[j].w))));
#pragma unroll
    for (int m = 32; m >= 1; m >>= 1) am = fmaxf(am, __shfl_xor(am, m, 64));
    const float sc = (am > 0.f) ? am * (1.f / 448.f) : 1.f;
    const float is = 1.f / sc;
    uint4 o;
    { int w = 0; w = __builtin_amdgcn_cvt_pk_fp8_f32(v[0].x * is, v[0].y * is, w, false); w = __builtin_amdgcn_cvt_pk_fp8_f32(v[0].z * is, v[0].w * is, w, true); o.x = (unsigned)w; }
    { int w = 0; w = __builtin_amdgcn_cvt_pk_fp8_f32(v[1].x * is, v[1].y * is, w, false); w = __builtin_amdgcn_cvt_pk_fp8_f32(v[1].z * is, v[1].w * is, w, true); o.y = (unsigned)w; }
    { int w = 0; w = __builtin_amdgcn_cvt_pk_fp8_f32(v[2].x * is, v[2].y * is, w, false); w = __builtin_amdgcn_cvt_pk_fp8_f32(v[2].z * is, v[2].w * is, w, true); o.z = (unsigned)w; }
    { int w = 0; w = __builtin_amdgcn_cvt_pk_fp8_f32(v[3].x * is, v[3].y * is, w, false); w = __builtin_amdgcn_cvt_pk_fp8_f32(v[3].z * is, v[3].w * is, w, true); o.w = (unsigned)w; }
    { const int lay = r / NEXP, e = r % NEXP; *(uint4*)(dst + (((size_t)(lay * 8 + (lane >> 3)) * NEXP + e) * 128) + (lane & 7) * 16) = o; }
    if (lane == 0) scl[r] = sc;
}
__device__ __forceinline__ unsigned pack_i8x4(float a, float b, float c, float d) {
    const int ia = __float2int_rn(a), ib = __float2int_rn(b), ic = __float2int_rn(c), id = __float2int_rn(d);
    return (unsigned)(ia & 255) | ((unsigned)(ib & 255) << 8) | ((unsigned)(ic & 255) << 16) | ((unsigned)(id & 255) << 24);
}
__device__ __forceinline__ void quant_row_i8(const float4 (&v)[4], unsigned char* __restrict__ dst, float* __restrict__ scl, int r, int lane) {
    float am = 0.f;
#pragma unroll
    for (int j = 0; j < 4; ++j) am = fmaxf(am, fmaxf(fmaxf(fabsf(v[j].x), fabsf(v[j].y)), fmaxf(fabsf(v[j].z), fabsf(v[j].w))));
#pragma unroll
    for (int m = 32; m >= 1; m >>= 1) am = fmaxf(am, __shfl_xor(am, m, 64));
    const float sc = (am > 0.f) ? am * (1.f / 127.f) : 1.f;
    const float is = 1.f / sc;
    uint4 o;
    o.x = pack_i8x4(v[0].x * is, v[0].y * is, v[0].z * is, v[0].w * is); o.y = pack_i8x4(v[1].x * is, v[1].y * is, v[1].z * is, v[1].w * is);
    o.z = pack_i8x4(v[2].x * is, v[2].y * is, v[2].z * is, v[2].w * is); o.w = pack_i8x4(v[3].x * is, v[3].y * is, v[3].z * is, v[3].w * is);
    { const int lay = r / NEXP, e = r % NEXP; *(uint4*)(dst + (((size_t)(lay * 8 + (lane >> 3)) * NEXP + e) * 128) + (lane & 7) * 16) = o; }
    if (lane == 0) scl[r] = sc;
}
template <bool I8>
__device__ __forceinline__ void convert_table(const float* __restrict__ src, unsigned char* __restrict__ dst, float* __restrict__ scl, int rows) {
    static_assert(TAB_FP8, "fp8 tables");
    const int lane = tidx() & 63;
    const int nw = nwave();
    for (int r = gwave(); r < rows; r += 4 * nw) {
        float4 v[4][4]; int rr[4];
#pragma unroll
        for (int u = 0; u < 4; ++u) {
            rr[u] = (r + u * nw < rows) ? (r + u * nw) : r;
            const float4* s0 = (const float4*)(src + (size_t)rr[u] * D);
#pragma unroll
            for (int j = 0; j < 4; ++j) v[u][j] = s0[lane * 4 + j];
        }
#pragma unroll
        for (int u = 0; u < 4; ++u) {
            if (u == 0 || rr[u] != r) { if (I8) quant_row_i8(v[u], dst, scl, rr[u], lane); else quant_row(v[u], dst, scl, rr[u], lane); }
        }
    }
}
__device__ __forceinline__ void phase_prep(const Params& P, char* lds) {
    unsigned char* ws = P.ws;
    for (int l = 0; l < DEPTH; ++l) {
        transpose_tiled(P.w_in + (size_t)l * D * DIN, (bf16*)(ws + WS_WIN) + (size_t)l * DINP * LDW, D, DIN, DINP, LDW, nullptr, lds);
        transpose_tiled(P.w_uq + (size_t)l * QR * 768, (bf16*)(ws + WS_WUQ) + (size_t)l * 768 * QR, QR, 768, 768, QR, P.q_norm + l * QR, lds);
        transpose_tiled(P.w_uk + (size_t)l * KVR * 512, (bf16*)(ws + WS_WUKV) + (size_t)l * 1024 * KVR, KVR, 512, 512, KVR, P.kv_norm + l * KVR, lds);
        transpose_tiled(P.w_uv + (size_t)l * KVR * 512, (bf16*)(ws + WS_WUKV) + (size_t)l * 1024 * KVR + (size_t)512 * KVR, KVR, 512, 512, KVR, P.kv_norm + l * KVR, lds);
        transpose_tiled(P.w_out + (size_t)l * D * D, (bf16*)(ws + WS_WOUT) + (size_t)l * D * LDW, D, D, D, LDW, nullptr, lds);
    }
    {
        bf16* Wc = (bf16*)(ws + WS_WPQ);
        float (*As)[68] = (float (*)[68])lds;
        float (*Bs)[68] = (float (*)[68])(lds + 16 * 68 * 4);
        const int tid = tidx(), tx = tid & 15, ty = (tid >> 4) & 15;
        const int lr = (tid >> 2) & 63, ld4 = (tid & 3) * 4;
        for (int tile = blockIdx.x; tile < (DEPTH * 2048 / 64) * (D / 64); tile += gridDim.x) {
            const int row0 = (tile >> 4) * 64, k0 = (tile & 15) * 64;
            const int l = row0 >> 11, hp = (row0 >> 7) & 15, n0 = row0 & 127;
            const float* skp = P.peer_subkeys + (((size_t)l * 2 + (hp & 1)) * NKEY + n0 + lr) * 128 + ld4;
            const float* wqp = P.peer_wq + ((size_t)l * D + k0 + lr) * 2048 + hp * 128 + ld4;
            float acc[4][4];
#pragma unroll
            for (int i = 0; i < 4; ++i)
#pragma unroll
                for (int j = 0; j < 4; ++j) acc[i][j] = 0.f;
            for (int d0 = 0; d0 < 128; d0 += 16) {
                if (tid < 256) {
                    const float4 av = *(const float4*)(skp + d0), bv = *(const float4*)(wqp + d0);
                    As[ld4 + 0][lr] = av.x; As[ld4 + 1][lr] = av.y; As[ld4 + 2][lr] = av.z; As[ld4 + 3][lr] = av.w;
                    Bs[ld4 + 0][lr] = bv.x; Bs[ld4 + 1][lr] = bv.y; Bs[ld4 + 2][lr] = bv.z; Bs[ld4 + 3][lr] = bv.w;
                }
                __syncthreads();
#pragma unroll
                for (int kk = 0; kk < 16; ++kk) {
                    const float4 a4 = *(const float4*)&As[kk][ty * 4], b4 = *(const float4*)&Bs[kk][tx * 4];
                    const float aa[4] = {a4.x, a4.y, a4.z, a4.w}, bb[4] = {b4.x, b4.y, b4.z, b4.w};
#pragma unroll
                    for (int i = 0; i < 4; ++i)
#pragma unroll
                        for (int j = 0; j < 4; ++j) acc[i][j] = fmaf(aa[i], bb[j], acc[i][j]);
                }
                __syncthreads();
            }
            if (tid < 256) {
#pragma unroll
                for (int i = 0; i < 4; ++i) {
                    uint2 o; o.x = pack2(acc[i][0], acc[i][1]); o.y = pack2(acc[i][2], acc[i][3]);
                    *(uint2*)(Wc + (size_t)(row0 + ty * 4 + i) * LDW + k0 + tx * 4) = o;
                }
            }
        }
    }
    convert_table<true>(P.peer_u, ws + WS_TABU, (float*)(ws + WS_TSCU), DEPTH * NEXP);
    convert_table<false>(P.peer_v, ws + WS_TABV, (float*)(ws + WS_TSCV), DEPTH * NEXP);
    float* rope = (float*)(ws + WS_ROPE);
    for (size_t i = gtid(); i < (size_t)S * 16; i += gnth()) {
        const int s = (int)(i >> 4), f = (int)(i & 15);
        const double inv = pow(10000.0, -(double)f / 16.0);
        const double ang = (double)s * inv;
        rope[2 * i] = (float)cos(ang); rope[2 * i + 1] = (float)sin(ang);
    }
}

__device__ __forceinline__ void phase_norm(const float* __restrict__ h, const float* __restrict__ g, bf16* __restrict__ xn) {
    const int lane = tidx() & 63, nw = nwave();
    for (int t = gwave(); t < T; t += 2 * nw) {
        const int t2 = (t + nw < T) ? (t + nw) : t;
        float4 v[2][4];
#pragma unroll
        for (int j = 0; j < 4; ++j) { v[0][j] = ((const float4*)(h + (size_t)t * D))[j * 64 + lane]; v[1][j] = ((const float4*)(h + (size_t)t2 * D))[j * 64 + lane]; }
#pragma unroll
        for (int u = 0; u < 2; ++u) {
            float ss = 0.f;
#pragma unroll
            for (int j = 0; j < 4; ++j) ss += v[u][j].x * v[u][j].x + v[u][j].y * v[u][j].y + v[u][j].z * v[u][j].z + v[u][j].w * v[u][j].w;
            ss = wave_sum(ss);
            const float r = rsqrtf(ss * (1.f / D) + EPS);
            const int tt = u ? t2 : t;
            if (u == 0 || t2 != t) {
#pragma unroll
                for (int j = 0; j < 4; ++j) {
                    const float4 gg = ((const float4*)g)[j * 64 + lane];
                    uint2 o; o.x = pack2(v[u][j].x * r * gg.x, v[u][j].y * r * gg.y); o.y = pack2(v[u][j].z * r * gg.z, v[u][j].w * r * gg.w);
                    ((uint2*)(xn + (size_t)tt * LDX))[j * 64 + lane] = o;
                }
            }
        }
    }
}

__device__ __forceinline__ void phase_norm_q(const Params& P, int l) {
    const int lane = tidx() & 63, nw = nwave();
    const float* g = P.norm_ffn + l * D;
    bf16* xn = (bf16*)(P.ws + WS_XN);
    unsigned* xq = (unsigned*)(P.ws + WS_XQ);
    float* xsc = (float*)(P.ws + WS_XS);
    for (int t = gwave(); t < T; t += 2 * nw) {
        const int t2 = (t + nw < T) ? (t + nw) : t;
        float4 v[2][4];
#pragma unroll
        for (int j = 0; j < 4; ++j) { v[0][j] = ((const float4*)(P.out + (size_t)t * D))[j * 64 + lane]; v[1][j] = ((const float4*)(P.out + (size_t)t2 * D))[j * 64 + lane]; }
#pragma unroll
        for (int u = 0; u < 2; ++u) {
            float ss = 0.f;
#pragma unroll
            for (int j = 0; j < 4; ++j) ss += v[u][j].x * v[u][j].x + v[u][j].y * v[u][j].y + v[u][j].z * v[u][j].z + v[u][j].w * v[u][j].w;
            ss = wave_sum(ss);
            const float r = rsqrtf(ss * (1.f / D) + EPS);
            const int tt = u ? t2 : t;
            if (u == 0 || t2 != t) {
                float am = 0.f;
#pragma unroll
                for (int j = 0; j < 4; ++j) {
                    const float4 gg = ((const float4*)g)[j * 64 + lane];
                    v[u][j].x *= r * gg.x; v[u][j].y *= r * gg.y; v[u][j].z *= r * gg.z; v[u][j].w *= r * gg.w;
                    am = fmaxf(am, fmaxf(fmaxf(fabsf(v[u][j].x), fabsf(v[u][j].y)), fmaxf(fabsf(v[u][j].z), fabsf(v[u][j].w))));
                    uint2 o; o.x = pack2(v[u][j].x, v[u][j].y); o.y = pack2(v[u][j].z, v[u][j].w);
                    ((uint2*)(xn + (size_t)tt * LDX))[j * 64 + lane] = o;
                }
#pragma unroll
                for (int m = 32; m >= 1; m >>= 1) am = fmaxf(am, __shfl_xor(am, m, 64));
                const float sc = (am > 0.f) ? am * (1.f / 127.f) : 1.f, is = 1.f / sc;
#pragma unroll
                for (int j = 0; j < 4; ++j) xq[(size_t)tt * (D / 4) + j * 64 + lane] = pack_i8x4(v[u][j].x * is, v[u][j].y * is, v[u][j].z * is, v[u][j].w * is);
                if (lane == 0) xsc[tt] = sc;
            }
        }
    }
}

__device__ __forceinline__ void phase_mixlocal(const Params& P, int l, char* lds) {
    const bf16* proj = (const bf16*)(P.ws + WS_PROJ);
    bf16* Y = (bf16*)(P.ws + WS_XN);
    const int tid = tidx();
    {
        const float* cw = P.conv_w + (size_t)l * 3 * 256;
        for (size_t i = gtid(); i < (size_t)T * 32; i += gnth()) {
            const int t = (int)(i >> 5), c0 = (int)(i & 31) * 8, s = t & (S - 1);
            const bf16* pr = proj + (size_t)t * DINP;
            float acc[8];
#pragma unroll
            for (int e = 0; e < 8; ++e) acc[e] = 0.f;
#pragma unroll
            for (int j = 0; j < 3; ++j) {
                if (s - 2 + j >= 0) {
                    const bf16* pp = pr - (size_t)(2 - j) * DINP;
                    const uint4 g = *(const uint4*)(pp + C_CG + c0), hc = *(const uint4*)(pp + C_HC + c0);
                    const float4 w0 = *(const float4*)(cw + j * 256 + c0), w1 = *(const float4*)(cw + j * 256 + c0 + 4);
                    acc[0] = fmaf(w0.x, bflo(g.x) * bflo(hc.x), acc[0]); acc[1] = fmaf(w0.y, bfhi(g.x) * bfhi(hc.x), acc[1]);
                    acc[2] = fmaf(w0.z, bflo(g.y) * bflo(hc.y), acc[2]); acc[3] = fmaf(w0.w, bfhi(g.y) * bfhi(hc.y), acc[3]);
                    acc[4] = fmaf(w1.x, bflo(g.z) * bflo(hc.z), acc[4]); acc[5] = fmaf(w1.y, bfhi(g.z) * bfhi(hc.z), acc[5]);
                    acc[6] = fmaf(w1.z, bflo(g.w) * bflo(hc.w), acc[6]); acc[7] = fmaf(w1.w, bfhi(g.w) * bfhi(hc.w), acc[7]);
                }
            }
            const uint4 bg = *(const uint4*)(pr + C_BG + c0);
            uint4 o;
            o.x = pack2(bflo(bg.x) * acc[0], bfhi(bg.x) * acc[1]); o.y = pack2(bflo(bg.y) * acc[2], bfhi(bg.y) * acc[3]);
            o.z = pack2(bflo(bg.z) * acc[4], bfhi(bg.z) * acc[5]); o.w = pack2(bflo(bg.w) * acc[6], bfhi(bg.w) * acc[7]);
            *(uint4*)(Y + (size_t)t * LDX + c0) = o;
        }
    }
    {
        float (*pl)[68] = (float (*)[68])lds;
        const float* pw = P.pool_w + (size_t)l * 4 * 64 * 64;
        const float* psc = P.pool_scale + l * 256;
        const int a = tid & 63, q = tid >> 6;
        for (int tile = blockIdx.x; tile < (T / (16 * NW)) * 4; tile += gridDim.x) {
            const int g = tile & 3, t0 = (tile >> 2) * (16 * NW);
            const int w = 2 << g;
            {
                const bf16* col = proj + C_HP + g * 64 + a;
                const int tf = t0 + q * 16, sf = tf & (S - 1);
                float xr[31];
#pragma unroll
                for (int d = 1; d <= 15; ++d) xr[15 - d] = (d < w && sf - d >= 0) ? bf2f(col[(size_t)(tf - d) * DINP]) : 0.f;
#pragma unroll
                for (int i = 0; i < 16; ++i) xr[15 + i] = bf2f(col[(size_t)(tf + i) * DINP]);
                float sum = 0.f;
#pragma unroll
                for (int d = 1; d <= 15; ++d) sum += xr[15 - d];
#pragma unroll
                for (int i = 0; i < 16; ++i) {
                    const int s = sf + i;
                    sum += xr[15 + i];
                    const int cnt = (s + 1 < w) ? (s + 1) : w;
                    pl[q * 16 + i][a] = sum / (float)cnt - xr[15 + i];
                    const int o = 15 + i + 1;
                    const float old = (g == 0) ? xr[o - 2] : (g == 1) ? xr[o - 4] : (g == 2) ? xr[o - 8] : xr[o - 16];
                    sum -= old;
                }
            }
            __syncthreads();
            {
                float pc[64];
#pragma unroll
                for (int c = 0; c < 64; ++c) pc[c] = pw[(g * 64 + c) * 64 + a];
                const float sc = psc[g * 64 + a];
#pragma unroll 2
                for (int i = 0; i < 16; ++i) {
                    const float4* row = (const float4*)&pl[q * 16 + i][0];
                    float m0 = 0.f, m1 = 0.f;
#pragma unroll
                    for (int c4 = 0; c4 < 16; ++c4) { const float4 v = row[c4]; m0 = fmaf(v.x, pc[4 * c4], m0); m1 = fmaf(v.y, pc[4 * c4 + 1], m1); m0 = fmaf(v.z, pc[4 * c4 + 2], m0); m1 = fmaf(v.w, pc[4 * c4 + 3], m1); }
                    Y[(size_t)(t0 + q * 16 + i) * LDX + 256 + g * 64 + a] = f2bf((m0 + m1) * sc);
                }
            }
            __syncthreads();
        }
    }
}

typedef short v4i16_t __attribute__((ext_vector_type(4)));
typedef __attribute__((address_space(3))) v4i16_t* lds_v4p;
__device__ __forceinline__ v4i16_t vtr(const char* p) { return __builtin_amdgcn_ds_read_tr16_b64_v4i16((lds_v4p)p); }
constexpr int A_KP = 208, A_VP = 192;
constexpr int A_KB = 64 * A_KP, A_VB = 64 * A_VP, A_BUF = A_KB + A_VB, ATTN_LDS = 2 * A_BUF;
static_assert(ATTN_LDS <= LDS_TOTAL, "attention LDS");

__device__ __forceinline__ void attn_unit(const bf16* __restrict__ Qb, const bf16* __restrict__ Kb, const bf16* __restrict__ Vb, bf16* __restrict__ Y, int bh, int qblk, char* lds) {
    const int tid = tidx(), lane = tid & 63, w = tid >> 6, r32 = lane & 31, hi = lane >> 5;
    const int q0 = qblk * (32 * NW), qw0 = q0 + w * 32;
    const int NT = (q0 + 32 * NW) / 64;
    bf16x8 qf[6];
    {
        const bf16* qp = Qb + ((size_t)bh * S + qw0 + r32) * DQK + hi * 8;
#pragma unroll
        for (int ks = 0; ks < 6; ++ks) qf[ks] = *(const bf16x8*)(qp + ks * 16);
    }
    f32x16 o0, o1;
#pragma unroll
    for (int r = 0; r < 16; ++r) { o0[r] = 0.f; o1[r] = 0.f; }
    float m = -1e30f, lsum = 0.f;
    const int t8 = tid & 255; const bool isv = tid >= 256;
    const char* Tg = isv ? (const char*)(Vb + (size_t)bh * S * DV) : (const char*)(Kb + (size_t)bh * S * DQK);
    const int Ts = isv ? (64 * 128) : (64 * 192);
    const int g0 = t8 * 16, g1 = (t8 + 256) * 16, g2 = isv ? g1 : (t8 + 512) * 16;
    const int l0 = isv ? (A_KB + (t8 >> 3) * A_VP + (t8 & 7) * 16) : ((t8 / 12) * A_KP + (t8 % 12) * 16);
    const int l1 = isv ? (l0 + 32 * A_VP) : (((t8 + 256) / 12) * A_KP + ((t8 + 256) % 12) * 16);
    const int l2 = isv ? l1 : (((t8 + 512) / 12) * A_KP + ((t8 + 512) % 12) * 16);
    uint4 pk0, pk1, pk2, qk0, qk1, qk2;
#define A_LOAD(S, t) do { const char* tg = Tg + (size_t)(t) * Ts; S##k0 = *(const uint4*)(tg + g0); S##k1 = *(const uint4*)(tg + g1); S##k2 = *(const uint4*)(tg + g2); } while (0)
#define A_STORE(S, bK, bV) do { *(uint4*)(bK + l0) = S##k0; *(uint4*)(bK + l1) = S##k1; *(uint4*)(bK + l2) = S##k2; } while (0)
#define A_PV(pf, kofs) do { \
            { const v4i16_t lo = vtr(pv + (kofs) * A_VP), hh = vtr(pv + ((kofs) + 8) * A_VP); const bf16x8 vf = {lo[0], lo[1], lo[2], lo[3], hh[0], hh[1], hh[2], hh[3]}; o0 = MFMA32(vf, pf.v, o0); } \
            { const v4i16_t lo = vtr(pv + (kofs) * A_VP + 64), hh = vtr(pv + ((kofs) + 8) * A_VP + 64); const bf16x8 vf = {lo[0], lo[1], lo[2], lo[3], hh[0], hh[1], hh[2], hh[3]}; o1 = MFMA32(vf, pf.v, o1); } } while (0)
    const int pvo = (4 * hi + ((lane & 15) >> 2)) * A_VP + (16 * ((lane >> 4) & 1) + 4 * (lane & 3)) * 2;
    A_LOAD(p, 0); A_LOAD(q, 1);
    for (int t2 = 0; t2 < NT; t2 += 2) {
#pragma unroll
        for (int half = 0; half < 2; ++half) {
            const int t = t2 + half;
            char* bK = lds + half * A_BUF; char* bV = bK + A_KB;
            if (half == 0) A_STORE(p, bK, bV); else A_STORE(q, bK, bV);
            __syncthreads();
            { const int tn = (t + 2 < NT) ? (t + 2) : (NT - 2 + half); if (half == 0) A_LOAD(p, tn); else A_LOAD(q, tn); }
        const int kt0 = t * 64;
        if (kt0 <= qw0) {
            f32x16 s0, s1;
#pragma unroll
            for (int r = 0; r < 16; ++r) { s0[r] = 0.f; s1[r] = 0.f; }
            const char* pk = bK + r32 * A_KP + hi * 16;
#pragma unroll
            for (int ks = 0; ks < 6; ++ks) {
                const bf16x8 a0 = *(const bf16x8*)(pk + ks * 32), a1 = *(const bf16x8*)(pk + 32 * A_KP + ks * 32);
                s0 = MFMA32(a0, qf[ks], s0); s1 = MFMA32(a1, qf[ks], s1);
            }
            if (kt0 + 63 > qw0) {
                const int qrow = qw0 + r32;
#pragma unroll
                for (int r = 0; r < 16; ++r) { const int key = kt0 + crow(r, hi); if (key > qrow) s0[r] = -INFINITY; if (key + 32 > qrow) s1[r] = -INFINITY; }
            }
            float mx = fmaxf(s0[0], s1[0]);
#pragma unroll
            for (int r = 1; r < 16; ++r) mx = fmaxf(mx, fmaxf(s0[r], s1[r]));
            mx = fmaxf(mx, __shfl_xor(mx, 32, 64));
            const float mn = fmaxf(m, mx), m_prev = m;
            const float alpha = __builtin_amdgcn_exp2f(m - mn);
            m = mn;
            float ps = 0.f;
#pragma unroll
            for (int r = 0; r < 16; ++r) { s0[r] = __builtin_amdgcn_exp2f(s0[r] - mn); s1[r] = __builtin_amdgcn_exp2f(s1[r] - mn); ps += s0[r] + s1[r]; }
            if (__builtin_amdgcn_ballot_w64(mn > m_prev) != 0ull) {
                lsum *= alpha;
#pragma unroll
                for (int r = 0; r < 16; ++r) { o0[r] *= alpha; o1[r] *= alpha; }
            }
            lsum += ps;
            union { unsigned u[4]; bf16x8 v; } p00, p01, p10, p11;
#pragma unroll
            for (int j = 0; j < 4; ++j) { p00.u[j] = cvtpk(s0[2 * j], s0[2 * j + 1]); p01.u[j] = cvtpk(s0[8 + 2 * j], s0[9 + 2 * j]); p10.u[j] = cvtpk(s1[2 * j], s1[2 * j + 1]); p11.u[j] = cvtpk(s1[8 + 2 * j], s1[9 + 2 * j]); }
            const char* pv = bV + pvo;
            A_PV(p00, 0); A_PV(p01, 16); A_PV(p10, 32); A_PV(p11, 48);
        }
        }
    }
    lsum += __shfl_xor(lsum, 32, 64);
    const float inv = 1.f / lsum;
    const int b = bh >> 3, h = bh & 7;
    bf16* yo = Y + (size_t)(b * S + qw0 + r32) * LDX + 512 + h * 64 + 4 * hi;
#pragma unroll
    for (int g = 0; g < 4; ++g) {
        uint2 a, c;
        a.x = cvtpk(o0[4 * g] * inv, o0[4 * g + 1] * inv); a.y = cvtpk(o0[4 * g + 2] * inv, o0[4 * g + 3] * inv);
        c.x = cvtpk(o1[4 * g] * inv, o1[4 * g + 1] * inv); c.y = cvtpk(o1[4 * g + 2] * inv, o1[4 * g + 3] * inv);
        *(uint2*)(yo + 8 * g) = a; *(uint2*)(yo + 32 + 8 * g) = c;
    }
    __syncthreads();
}
__device__ __forceinline__ void phase_attn(const Params& P, char* lds) {
    const bf16* Qb = (const bf16*)(P.ws + WS_Q);
    const bf16* Kb = (const bf16*)(P.ws + WS_K);
    const bf16* Vb = (const bf16*)(P.ws + WS_V);
    bf16* Y = (bf16*)(P.ws + WS_XN);
    for (int u = blockIdx.x; u < NB * NH * (S / 256); u += gridDim.x) {
        const int bh = u & 31, v = u >> 5;
        const int qblk = (v < 8) ? (31 - v) : (v < 16) ? (v - 8) : (v < 24) ? (39 - v) : (v - 16);
        attn_unit(Qb, Kb, Vb, Y, bh, qblk, lds);
    }
}

#define NET_HD __device__ __forceinline__
#define NET_U2F(u) __uint_as_float(u)
#define NET_F2U(f) __float_as_uint(f)
#define CE_DESC(a, b) do { const float hi__ = fmaxf(a, b), lo__ = fminf(a, b); a = hi__; b = lo__; } while (0)
NET_HD void sort16_desc(float (&v)[16]) {
#define CE2(a, b) CE_DESC(v[a], v[b])
    CE2(0,13); CE2(1,12); CE2(2,15); CE2(3,14); CE2(4,8); CE2(5,6); CE2(7,11); CE2(9,10);
    CE2(0,5); CE2(1,7); CE2(2,9); CE2(3,4); CE2(6,13); CE2(8,14); CE2(10,15); CE2(11,12);
    CE2(0,1); CE2(2,3); CE2(4,5); CE2(6,8); CE2(7,9); CE2(10,11); CE2(12,13); CE2(14,15);
    CE2(0,2); CE2(1,3); CE2(4,10); CE2(5,11); CE2(6,7); CE2(8,9); CE2(12,14); CE2(13,15);
    CE2(1,2); CE2(3,12); CE2(4,6); CE2(5,7); CE2(8,10); CE2(9,11); CE2(13,14);
    CE2(1,4); CE2(2,6); CE2(5,8); CE2(7,10); CE2(9,13); CE2(11,14);
    CE2(2,4); CE2(3,6); CE2(9,12); CE2(11,13);
    CE2(3,5); CE2(6,8); CE2(7,9); CE2(10,12);
    CE2(3,4); CE2(5,6); CE2(7,8); CE2(9,10); CE2(11,12);
    CE2(6,7); CE2(8,9);
#undef CE2
}
NET_HD void merge16_desc(float (&a)[16], const float (&b)[16]) {
#pragma unroll
    for (int i = 0; i < 16; ++i) a[i] = fmaxf(a[i], b[15 - i]);
#pragma unroll
    for (int j = 8; j > 0; j >>= 1) {
#pragma unroll
        for (int i = 0; i < 16; ++i) { const int l = i ^ j; if (l > i) CE_DESC(a[i], a[l]); }
    }
}
NET_HD void top16_of_64(float (&g0)[16], float (&g1)[16], float (&g2)[16], float (&g3)[16]) {
    sort16_desc(g0); sort16_desc(g1); sort16_desc(g2); sort16_desc(g3);
    merge16_desc(g0, g1); merge16_desc(g2, g3); merge16_desc(g0, g2);
}
NET_HD float u2f(unsigned u) { return NET_U2F(u); }
NET_HD unsigned f2u(float f) { return NET_F2U(f); }
template <class V16>
NET_HD void lane_top16(const V16& s0, const V16& s1, const V16& s2, const V16& s3, int hi, float (&out)[16]) {
    float g0[16], g1[16], g2[16], g3[16];
#pragma unroll
    for (int r = 0; r < 16; ++r) {
        const unsigned nb = (unsigned)((r & 3) + 8 * (r >> 2));
        g0[r] = u2f((f2u(s0[r]) & 0xFFFFFF80u) | nb); g1[r] = u2f((f2u(s1[r]) & 0xFFFFFF80u) | (nb + 32u));
        g2[r] = u2f((f2u(s2[r]) & 0xFFFFFF80u) | (nb + 64u)); g3[r] = u2f((f2u(s3[r]) & 0xFFFFFF80u) | (nb + 96u));
    }
    top16_of_64(g0, g1, g2, g3);
    const unsigned h4 = (unsigned)hi << 2;
#pragma unroll
    for (int i = 0; i < 16; ++i) out[i] = u2f(f2u(g0[i]) | h4);
}
constexpr int cand_slot(int a, int b) { int n = 0; for (int x = 0; x < 16; ++x) for (int y = 0; y < 16; ++y) { if (x == a && y == b) return n; if ((x + 1) * (y + 1) <= 16) ++n; } return n; }
NET_HD void cand_top16(const float (&s1)[16], const float (&s2)[16], float (&c)[16]) {
    float g0[16], g1[16], g2[16], g3[16];
#pragma unroll
    for (int i = 0; i < 16; ++i) { g0[i] = -3.0e38f; g1[i] = -3.0e38f; g2[i] = -3.0e38f; g3[i] = -3.0e38f; }
#pragma unroll
    for (int a = 0; a < 16; ++a) {
#pragma unroll
        for (int b = 0; b < 16; ++b) {
            if ((a + 1) * (b + 1) <= 16) {
                const int sl = cand_slot(a, b);
                const float v = u2f((f2u(s1[a] + s2[b]) & 0xFFFFFF00u) | (unsigned)(a * 16 + b));
                if (sl < 16) g0[sl & 15] = v; else if (sl < 32) g1[sl & 15] = v; else if (sl < 48) g2[sl & 15] = v; else g3[sl & 15] = v;
            }
        }
    }
    top16_of_64(g0, g1, g2, g3);
#pragma unroll
    for (int i = 0; i < 16; ++i) c[i] = g0[i];
}

__device__ __forceinline__ void phase_route(const Params& P, int l, char* lds) {
    const bf16* XN = (const bf16*)(P.ws + WS_XN);
    const bf16* Wc = (const bf16*)(P.ws + WS_WPQ) + (size_t)l * 2048 * LDW;
    int* EXPp = (int*)(P.ws + WS_EXP);
    float* GATEp = (float*)(P.ws + WS_GATE);
    const int tid = tidx();
    float* xch = (float*)(lds + 16384);
    int tlo, thi; tile_range((T / 256) * PH, tlo, thi);
    int nt = D / 64; asm volatile("" : "+s"(nt));
    for (int u = tlo; u < thi; ++u) {
        const int tm = u >> 3, h = u & 7;
        float Lk[16];
        {
            f32x4 acc[2][2][4][2]; float ssd[2][2];
            gemm8_kloop<false, true>(Wc + (size_t)(h * 256) * LDW, LDW, XN + (size_t)(tm * 256) * LDX, LDX, nt, acc, ssd, lds, tid);
            const int te = tidx(), fq = (te >> 4) & 3;
            const unsigned fqb = (unsigned)fq << 2;
#pragma unroll
            for (int i = 0; i < 16; ++i) Lk[i] = 0.f;
#pragma unroll
            for (int bj = 0; bj < 2; ++bj)
#pragma unroll
                for (int n = 0; n < 2; ++n) {
                    float g0[16], g1[16];
#pragma unroll
                    for (int m = 0; m < 4; ++m)
#pragma unroll
                        for (int j = 0; j < 4; ++j) {
                            const unsigned kb = (unsigned)(m * 16 + j) | fqb;
                            g0[m * 4 + j] = u2f((f2u(acc[0][bj][m][n][j]) & 0xFFFFFF80u) | kb);
                            g1[m * 4 + j] = u2f((f2u(acc[1][bj][m][n][j]) & 0xFFFFFF80u) | (kb + 64u));
                        }
                    sort16_desc(g0); sort16_desc(g1); merge16_desc(g0, g1);
                    float o[16];
#pragma unroll
                    for (int i = 0; i < 16; ++i) o[i] = __shfl_xor(g0[i], 16, 64);
                    merge16_desc(g0, o);
#pragma unroll
                    for (int i = 0; i < 16; ++i) o[i] = __shfl_xor(g0[i], 32, 64);
                    merge16_desc(g0, o);
                    const bool mine = fq == bj * 2 + n;
#pragma unroll
                    for (int i = 0; i < 16; ++i) Lk[i] = mine ? g0[i] : Lk[i];
                }
        }
        __syncthreads();
        const int te = tidx(), lane = te & 63, w = te >> 6, wr = w >> 2, wc = w & 3, fr = lane & 15, fq = lane >> 4;
        if (wr == 1) {
#pragma unroll
            for (int q = 0; q < 4; ++q) *(float4*)(xch + ((wc * 64 + lane) * 16) + 4 * q) = make_float4(Lk[4 * q], Lk[4 * q + 1], Lk[4 * q + 2], Lk[4 * q + 3]);
        }
        __syncthreads();
        if (wr == 0) {
            float L1[16];
#pragma unroll
            for (int q = 0; q < 4; ++q) { const float4 v = *(const float4*)(xch + ((wc * 64 + lane) * 16) + 4 * q); L1[4 * q] = v.x; L1[4 * q + 1] = v.y; L1[4 * q + 2] = v.z; L1[4 * q + 3] = v.w; }
            float c[16];
            cand_top16(Lk, L1, c);
            unsigned char* my = (unsigned char*)lds + te * 32;
            {
                uint4 a, b;
#define PK4(L, i) ((__float_as_uint(L[i]) & 127u) | ((__float_as_uint(L[i + 1]) & 127u) << 8) | ((__float_as_uint(L[i + 2]) & 127u) << 16) | ((__float_as_uint(L[i + 3]) & 127u) << 24))
                a.x = PK4(Lk, 0); a.y = PK4(Lk, 4); a.z = PK4(Lk, 8); a.w = PK4(Lk, 12);
                b.x = PK4(L1, 0); b.y = PK4(L1, 4); b.z = PK4(L1, 8); b.w = PK4(L1, 12);
#undef PK4
                *(uint4*)my = a; *(uint4*)(my + 16) = b;
            }
            int ev[16]; float gv[16]; float den = 0.f;
#pragma unroll
            for (int k = 0; k < 16; ++k) {
                const unsigned ci = __float_as_uint(c[k]) & 255u;
                const int n1 = my[ci >> 4], n2 = my[16 + (ci & 15)];
                ev[k] = n1 * NKEY + n2;
                gv[k] = __expf(c[k] - c[0]); den += gv[k];
            }
            const float iden = 1.f / den;
            const int t = tm * 256 + (fq >> 1) * 128 + wc * 32 + (fq & 1) * 16 + fr;
            uint4* ep = (uint4*)(EXPp + (size_t)t * HK + h * 16);
            float4* gp = (float4*)(GATEp + (size_t)t * HK + h * 16);
#pragma unroll
            for (int q = 0; q < 4; ++q) {
                ep[q] = make_uint4((unsigned)ev[4 * q], (unsigned)ev[4 * q + 1], (unsigned)ev[4 * q + 2], (unsigned)ev[4 * q + 3]);
                gp[q] = make_float4(gv[4 * q] * iden, gv[4 * q + 1] * iden, gv[4 * q + 2] * iden, gv[4 * q + 3] * iden);
            }
        }
        __syncthreads();
    }
}

constexpr size_t WS_PART = WS_PROJ;
static_assert((size_t)8 * T * HK * 4 <= WS_K - WS_PROJ, "PART alias");
constexpr int XI_X = 0, XI_RANK = 1, XI_J = 2, XI_NX = 3, XI_NLOC = 4;
constexpr int CTL_CENSUS = 4096;
constexpr int CTL_BYTES = (CTL_CENSUS + 16) * 4;

template <int M1, int M2, int M3, class TT>
__device__ __forceinline__ void red16x3(TT (&p)[16], int lane) {
#pragma unroll
    for (int i = 0; i < 8; ++i) { const bool up = lane & M1; const TT send = up ? p[i] : p[i + 8], keep = up ? p[i + 8] : p[i]; p[i] = keep + __shfl_xor(send, M1, 64); }
#pragma unroll
    for (int i = 0; i < 4; ++i) { const bool up = lane & M2; const TT send = up ? p[i] : p[i + 4], keep = up ? p[i + 4] : p[i]; p[i] = keep + __shfl_xor(send, M2, 64); }
#pragma unroll
    for (int i = 0; i < 2; ++i) { const bool up = lane & M3; const TT send = up ? p[i] : p[i + 2], keep = up ? p[i + 2] : p[i]; p[i] = keep + __shfl_xor(send, M3, 64); }
}
__device__ __forceinline__ void phase_gu(const Params& P, int l, const volatile int* xi) {
    const unsigned char* XQ = P.ws + WS_XQ;
    const float* XSc = (const float*)(P.ws + WS_XS);
    const int* EXPp = (const int*)(P.ws + WS_EXP);
    float* PART = (float*)(P.ws + WS_PART);
    const int tid = tidx(), lane = tid & 63, w = tid >> 6, g = lane >> 3, c = lane & 7;
    int xo_ = 0; asm volatile("" : "+v"(xo_));
    const int j = __builtin_amdgcn_readfirstlane(xi[xo_ + XI_J]), nx = __builtin_amdgcn_readfirstlane(xi[xo_ + XI_NX]), nloc = __builtin_amdgcn_readfirstlane(xi[xo_ + XI_NLOC]), rank = __builtin_amdgcn_readfirstlane(xi[xo_ + XI_RANK]);
    const int t0 = rank * NW + w, st = nloc * NW;
    const int n = (t0 < T) ? (T - t0 + st - 1) / st : 0;
    const int i0 = 8 * (c & 1) + 4 * ((c >> 1) & 1) + 2 * ((c >> 2) & 1);
    for (int sl = j; sl < 8 && n > 0; sl += nx) {
        const unsigned char* Us = P.ws + WS_TABU + ((size_t)(l * 8 + sl) * NEXP) * 128;
        const unsigned co = (unsigned)c << 4;
        float* part = PART + (size_t)sl * T * HK;
        const unsigned char* xs = XQ + sl * 128 + c * 16;
#define GU_TK(k) (t0 + (((k) < n) ? (k) : (n - 1)) * st)
#define GU_LOADE(S, t) do { S##lo = EXPp[(size_t)(t) * HK + lane]; S##hi = EXPp[(size_t)(t) * HK + 64 + lane]; } while (0)
#define GU_LOADX(S, t) do { S##a = *(const uint4*)(xs + (size_t)(t) * D); S##s = XSc[t]; } while (0)
#define GU_ISSUE(R, S) do { _Pragma("unroll") for (int i = 0; i < 16; ++i) { \
            const int e = __builtin_amdgcn_ds_bpermute((((8 * i) & 63) + g) << 2, (i < 8) ? S##lo : S##hi); R[i] = *(const uint4*)(Us + (((unsigned)e << 7) | co)); } } while (0)
#define GU_FINISH(R, S, t) do { \
            int p[16]; \
            _Pragma("unroll") for (int i = 0; i < 16; ++i) { int d_ = __builtin_amdgcn_sdot4((int)S##a.x, (int)R[i].x, 0, false); d_ = __builtin_amdgcn_sdot4((int)S##a.y, (int)R[i].y, d_, false); \
                d_ = __builtin_amdgcn_sdot4((int)S##a.z, (int)R[i].z, d_, false); p[i] = __builtin_amdgcn_sdot4((int)S##a.w, (int)R[i].w, d_, false); } \
            red16x3<1, 2, 4, int>(p, lane); \
            part[(size_t)(t) * HK + 8 * i0 + g] = (float)p[0] * S##s; part[(size_t)(t) * HK + 8 * (i0 + 1) + g] = (float)p[1] * S##s; } while (0)
        int eAlo, eAhi, eBlo, eBhi; uint4 xAa, xBa; float xAs, xBs; uint4 rA[16], rB[16];
        GU_LOADE(eA, GU_TK(0)); GU_LOADX(xA, GU_TK(0)); GU_LOADE(eB, GU_TK(1));
        GU_ISSUE(rA, eA);
        for (int k = 0; k < n; k += 2) {
            GU_LOADX(xB, GU_TK(k + 1)); GU_ISSUE(rB, eB); GU_LOADE(eA, GU_TK(k + 2));
            GU_FINISH(rA, xA, GU_TK(k));
            GU_LOADX(xA, GU_TK(k + 2)); GU_ISSUE(rA, eA); GU_LOADE(eB, GU_TK(k + 3));
            GU_FINISH(rB, xB, GU_TK(k + 1));
        }
#undef GU_TK
#undef GU_LOADE
#undef GU_LOADX
#undef GU_ISSUE
#undef GU_FINISH
    }
}
__device__ __forceinline__ void phase_gw(const Params& P, int l) {
    const int* EXPp = (const int*)(P.ws + WS_EXP);
    const float* GATEp = (const float*)(P.ws + WS_GATE);
    const float* PART = (const float*)(P.ws + WS_PART);
    const float* SU = (const float*)(P.ws + WS_TSCU) + (size_t)l * NEXP;
    const float* SV = (const float*)(P.ws + WS_TSCV) + (size_t)l * NEXP;
    unsigned char* WQ = P.ws + WS_WQ8;
    float* WSC = (float*)(P.ws + WS_WSC);
    const int lane = tidx() & 63;
    for (int tb = gwave() * 4; tb < T; tb += nwave() * 4) {
        float wv[4][2];
#pragma unroll
        for (int q = 0; q < 4; ++q)
#pragma unroll
            for (int hk = 0; hk < 2; ++hk) {
                const size_t i = (size_t)(tb + q) * HK + hk * 64 + lane;
                float s = 0.f;
#pragma unroll
                for (int x = 0; x < 8; ++x) s += PART[(size_t)x * T * HK + i];
                const int e = EXPp[i];
                wv[q][hk] = GATEp[i] * gelu_exact(s * SU[e]) * SV[e];
            }
#pragma unroll
        for (int q = 0; q < 4; ++q) {
            float am = fmaxf(fabsf(wv[q][0]), fabsf(wv[q][1]));
#pragma unroll
            for (int m = 32; m >= 1; m >>= 1) am = fmaxf(am, __shfl_xor(am, m, 64));
            const float sc = (am > 0.f) ? am * (1.f / 448.f) : 1.f, is = 1.f / sc;
            const int pk = __builtin_amdgcn_cvt_pk_fp8_f32(wv[q][0] * is, wv[q][1] * is, 0, false);
            WQ[(size_t)(tb + q) * HK + lane] = (unsigned char)(pk & 255);
            WQ[(size_t)(tb + q) * HK + 64 + lane] = (unsigned char)((pk >> 8) & 255);
            if (lane == 0) WSC[tb + q] = sc;
        }
    }
}
typedef int v2i_t __attribute__((ext_vector_type(2)));
typedef unsigned u32x4_t __attribute__((ext_vector_type(4)));
typedef __attribute__((ext_vector_type(4))) float f32x4;
constexpr int GV_PIECE = 1024 + 16;
constexpr int GV_TILE = 16 * GV_PIECE;
static_assert(NW * GV_TILE + NW * 512 <= LDS_TOTAL, "gv LDS");
__device__ __forceinline__ void phase_gv(const Params& P, int l, const volatile int* xi, char* lds) {
    const int* EXPp = (const int*)(P.ws + WS_EXP);
    const unsigned char* WQ = P.ws + WS_WQ8;
    const float* WSC = (const float*)(P.ws + WS_WSC);
    const int tid = tidx(), lane = tid & 63, w = __builtin_amdgcn_readfirstlane(tid >> 6), g = lane >> 3, pos = lane & 7;
    int xo_ = 0; asm volatile("" : "+v"(xo_));
    const int j = __builtin_amdgcn_readfirstlane(xi[xo_ + XI_J]), nx = __builtin_amdgcn_readfirstlane(xi[xo_ + XI_NX]), nloc = __builtin_amdgcn_readfirstlane(xi[xo_ + XI_NLOC]), rank = __builtin_amdgcn_readfirstlane(xi[xo_ + XI_RANK]);
    const int t0 = rank * NW + w, st = nloc * NW;
    const int n = (t0 < T) ? (T - t0 + st - 1) / st : 0;
    char* tile = lds + w * GV_TILE;
    float* strip = (float*)(lds + NW * GV_TILE) + w * 128;
    typedef __attribute__((address_space(3))) v2i_t* ldsv2_t;
    const unsigned co = (unsigned)(pos ^ g) << 4;
    const int rr = (lane & 15) >> 1, kq = lane >> 4;
    const int rdo = kq * GV_PIECE + rr * 128 + (lane & 1) * 8;
    const bool row0 = (lane & 15) == 0;
    __syncthreads();
    for (int sl = j; sl < 8 && n > 0; sl += nx) {
        const unsigned char* Vs = P.ws + WS_TABV + ((size_t)(l * 8 + sl) * NEXP) * 128;
        float* hrow = P.out + sl * 128 + 2 * lane;
#define GV_TK(k) (t0 + (((k) < n) ? (k) : (n - 1)) * st)
#define GV_LOADE(S, t) do { S##el = EXPp[(size_t)(t) * HK + lane]; S##eh = EXPp[(size_t)(t) * HK + 64 + lane]; } while (0)
#define GV_ISSUE(R, S) do { _Pragma("unroll") for (int i = 0; i < 16; ++i) { \
            const int e = __builtin_amdgcn_ds_bpermute((((8 * i) & 63) + g) << 2, (i < 8) ? S##el : S##eh); R[i] = *(const u32x4_t*)(Vs + (((unsigned)e << 7) | co)); } } while (0)
#define GV_LOADT(S, kk) do { const int t_ = GV_TK(kk); \
            S##a0 = 0; S##a1 = 0; S##a2 = 0; S##a3 = 0; \
            if (row0) { const long* wp = (const long*)(WQ + (size_t)t_ * HK + kq * 8); S##a0 = wp[0]; S##a1 = wp[4]; S##a2 = wp[8]; S##a3 = wp[12]; } \
            S##ws = ((kk) < n) ? WSC[t_] : 0.f; \
            S##hv = *(const float2*)(hrow + (size_t)t_ * D); } while (0)
#define GV_TOKEN(R, S, kk) do { \
            const int t = GV_TK(kk); \
            _Pragma("unroll") for (int i = 0; i < 16; ++i) *(u32x4_t*)(tile + i * GV_PIECE + lane * 16) = R[i]; \
            f32x4 acc[8]; \
            _Pragma("unroll") for (int nt = 0; nt < 8; ++nt) acc[nt] = (f32x4){0.f, 0.f, 0.f, 0.f}; \
            _Pragma("unroll") for (int s4 = 0; s4 < 4; ++s4) { \
                const long av = (s4 == 0) ? S##a0 : (s4 == 1) ? S##a1 : (s4 == 2) ? S##a2 : S##a3; \
                _Pragma("unroll") for (int nt = 0; nt < 8; ++nt) { \
                    const v2i_t bv = __builtin_amdgcn_ds_read_tr8_b64_v2i32((ldsv2_t)(void*)(tile + (4 * s4) * GV_PIECE + rdo + ((nt ^ rr) << 4))); \
                    acc[nt] = __builtin_amdgcn_mfma_f32_16x16x32_fp8_fp8(av, __builtin_bit_cast(long, bv), acc[nt], 0, 0, 0); } } \
            if (lane < 16) { _Pragma("unroll") for (int nt = 0; nt < 8; ++nt) strip[16 * nt + lane] = acc[nt][0]; }        \
            { const float2 o2 = *(const float2*)(strip + 2 * lane); \
              if ((kk) < n) *(float2*)(hrow + (size_t)t * D) = make_float2(S##hv.x + S##ws * o2.x, S##hv.y + S##ws * o2.y); } } while (0)
        int Ael, Aeh, Bel, Beh; u32x4_t rA[16], rB[16];
        long Pa0, Pa1, Pa2, Pa3, Qa0, Qa1, Qa2, Qa3; float Pws, Qws; float2 Phv, Qhv;
        GV_LOADE(A, GV_TK(0)); GV_LOADE(B, GV_TK(1));
        GV_ISSUE(rA, A); GV_LOADT(P, 0);
        for (int k = 0; k < n; k += 2) {
            GV_ISSUE(rB, B); GV_LOADE(A, GV_TK(k + 2)); GV_LOADT(Q, k + 1);
            GV_TOKEN(rA, P, k);
            GV_ISSUE(rA, A); GV_LOADE(B, GV_TK(k + 3)); GV_LOADT(P, k + 2);
            GV_TOKEN(rB, Q, k + 1);
        }
#undef GV_TK
#undef GV_LOADE
#undef GV_ISSUE
#undef GV_LOADT
#undef GV_TOKEN
    }
    __syncthreads();
}
__device__ __forceinline__ void phase_gnorm(const Params& P, int l) {
    const int lane = tidx() & 63, nw = nwave();
    bf16* XNw = (bf16*)(P.ws + WS_XN);
    const float4* g = (const float4*)((l == DEPTH - 1) ? P.norm_final : (P.norm_mix + (l + 1) * D));
    for (int t = gwave(); t < T; t += 2 * nw) {
        const int t2 = (t + nw < T) ? (t + nw) : t;
        float4 v[2][4];
#pragma unroll
        for (int q = 0; q < 4; ++q) { v[0][q] = ((const float4*)(P.out + (size_t)t * D))[q * 64 + lane]; v[1][q] = ((const float4*)(P.out + (size_t)t2 * D))[q * 64 + lane]; }
#pragma unroll
        for (int u = 0; u < 2; ++u) {
            float ss = 0.f;
#pragma unroll
            for (int q = 0; q < 4; ++q) ss += v[u][q].x * v[u][q].x + v[u][q].y * v[u][q].y + v[u][q].z * v[u][q].z + v[u][q].w * v[u][q].w;
            ss = wave_sum(ss);
            const float rn = rsqrtf(ss * (1.f / D) + EPS);
            const int tt = u ? t2 : t;
            if (u == 0 || t2 != t) {
                float4* hr = (float4*)(P.out + (size_t)tt * D);
#pragma unroll
                for (int q = 0; q < 4; ++q) {
                    const float4 gg = g[q * 64 + lane];
                    const float4 o = make_float4(v[u][q].x * rn * gg.x, v[u][q].y * rn * gg.y, v[u][q].z * rn * gg.z, v[u][q].w * rn * gg.w);
                    if (l == DEPTH - 1) hr[q * 64 + lane] = o;
                    else { uint2 uu; uu.x = pack2(o.x, o.y); uu.y = pack2(o.z, o.w); ((uint2*)(XNw + (size_t)tt * LDX))[q * 64 + lane] = uu; }
                }
            }
        }
    }
}

#define XB_TMO      128
#define XB_XCNT(j)  (256  + 64 * (j))
#define XB_XSUB(j)  (1280 + 64 * (j))
#define XB_XGEN(j)  (2304 + 64 * (j))
#define XB_TOP      3328
#define XB_TOPGEN   3392
#define XCD_BAR_WORDS 3456
#define XB_SPIN_CAP (1u << 22)
#define LAS __attribute__((address_space(3)))
__device__ __forceinline__ unsigned xb_ld(unsigned* p)              { return __hip_atomic_load(p, __ATOMIC_RELAXED, __HIP_MEMORY_SCOPE_AGENT); }
__device__ __forceinline__ unsigned xb_add(unsigned* p, unsigned v) { return __hip_atomic_fetch_add(p, v, __ATOMIC_RELAXED, __HIP_MEMORY_SCOPE_AGENT); }
__device__ __forceinline__ unsigned xb_xcc_id() { return (unsigned)__builtin_amdgcn_s_getreg((3 << 11) | 20) & 0xFu; }
#define XB_SPIN(cond, bar) do { unsigned _sp = 0; while (cond) { __builtin_amdgcn_s_sleep(1); \
    if ((++_sp & 255u) == 0u) { if (xb_ld(&(bar)[XB_TMO])) break; if (_sp > XB_SPIN_CAP) { atomicAdd(&(bar)[XB_TMO], 1u); break; } } } } while (0)
struct XcdBarrier { unsigned* bar; unsigned x; volatile LAS unsigned* st; };
__device__ __forceinline__ XcdBarrier xcd_barrier_post(unsigned* bar, volatile LAS unsigned* st) {
    XcdBarrier b; b.bar = bar; b.x = xb_xcc_id(); b.st = st;
    if (__builtin_amdgcn_workitem_id_x() == 0) (void)xb_add(&bar[XB_XCNT(b.x)], 1u);
    return b;
}
__device__ __forceinline__ void xcd_barrier_complete(unsigned* bar, unsigned x, unsigned& nloc, unsigned& nx) {
    const unsigned G = gridDim.x * gridDim.y * gridDim.z;
    unsigned sum, cnt, mine, sp = 0u;
    for (;;) {
        sum = 0u; cnt = 0u; mine = 0u;
#pragma unroll
        for (unsigned j = 0; j < 16; ++j) { const unsigned c = xb_ld(&bar[XB_XCNT(j)]); sum += c; cnt += (c > 0u) ? 1u : 0u; mine = (j == x) ? c : mine; }
        if (sum == G) break;
        __builtin_amdgcn_s_sleep(1);
        if ((++sp & 255u) == 0u) { if (xb_ld(&bar[XB_TMO])) break; if (sp > XB_SPIN_CAP) { atomicAdd(&bar[XB_TMO], 1u); break; } }
    }
    nloc = mine > 0u ? mine : 1u; nx = cnt > 0u ? cnt : 1u;
}
__device__ __forceinline__ void xcd_barrier(const XcdBarrier& b) {
    asm volatile("s_waitcnt vmcnt(0)" ::: "memory");
    __syncthreads();
    if (__builtin_amdgcn_workitem_id_x() == 0) {
        unsigned* bar = b.bar;
        __builtin_amdgcn_s_waitcnt(0);
        unsigned nloc = b.st[0], nx = b.st[1];
        if (nloc == 0u) { xcd_barrier_complete(bar, b.x, nloc, nx); b.st[0] = nloc; b.st[1] = nx; }
        const unsigned old = xb_add(&bar[XB_XSUB(b.x)], 1u);
        const unsigned gen = old / nloc;
        if (old + 1u == (gen + 1u) * nloc) {
            __builtin_amdgcn_fence(__ATOMIC_RELEASE, "agent");
            asm volatile("s_waitcnt vmcnt(0)" ::: "memory");
            const unsigned og = xb_add(&bar[XB_TOP], 1u);
            const unsigned tg = og / nx;
            if (og + 1u == (tg + 1u) * nx) xb_add(&bar[XB_TOPGEN], 1u);
            else XB_SPIN(xb_ld(&bar[XB_TOPGEN]) == tg, bar);
            __builtin_amdgcn_fence(__ATOMIC_ACQUIRE, "agent");
            xb_add(&bar[XB_XGEN(b.x)], 1u);
            asm volatile("s_waitcnt vmcnt(0)" ::: "memory");
        } else {
            XB_SPIN(xb_ld(&bar[XB_XGEN(b.x)]) == gen, bar);
            __builtin_amdgcn_fence(__ATOMIC_ACQUIRE, "agent");
            asm volatile("s_waitcnt vmcnt(0)" ::: "memory");
        }
    }
    __syncthreads();
}

constexpr float QSCALE = 0.10206207261596575f * 1.4426950408889634f;

__device__ __forceinline__ void phase_gemm1(const Params& P, int l, char* lds) {
    unsigned char* ws = P.ws;
    const bf16* XN = (const bf16*)(ws + WS_XN);
    bf16* PROJ = (bf16*)(ws + WS_PROJ);
    bf16* Kb = (bf16*)(ws + WS_K);
    const float* rope = (const float*)(ws + WS_ROPE);
    const bf16* W = (const bf16*)(ws + WS_WIN) + (size_t)l * DINP * LDW;
    float* SSQ = (float*)(ws + WS_SSQ);
    const int lane = tidx() & 63;
    int tlo, thi; tile_range((T / 256) * (DINP / 256), tlo, thi);
    gemm_t8<false>(W, LDW, DINP, XN, LDX, D, tlo, thi, [&](int t, int n, const float4& v) {
        const int nb = __builtin_amdgcn_readfirstlane(n);
        if (nb < C_KR) {
            uint2 o; o.x = cvtpk(v.x, v.y); o.y = cvtpk(v.z, v.w);
            *(uint2*)(PROJ + (size_t)t * DINP + n) = o;
            if (nb >= C_CQ) {
                float q = v.x * v.x + v.y * v.y + v.z * v.z + v.w * v.w;
                q += __shfl_xor(q, 1, 64); q += __shfl_xor(q, 2, 64); q += __shfl_xor(q, 4, 64); q += __shfl_xor(q, 8, 64);
                if (n == nb) SSQ[(size_t)t * 16 + ((nb - C_CQ) >> 6)] = q;
            }
        } else if (nb == C_KR) {
            const float4 up = make_float4(__shfl(v.x, lane + 4, 64), __shfl(v.y, lane + 4, 64), __shfl(v.z, lane + 4, 64), __shfl(v.w, lane + 4, 64));
            const float4 dn = make_float4(__shfl(v.x, lane - 4, 64), __shfl(v.y, lane - 4, 64), __shfl(v.z, lane - 4, 64), __shfl(v.w, lane - 4, 64));
            const int d = n - C_KR;
            if (d < 32) {
                const int b = t / S, s = t % S;
                const bool first = d < 16;
                const int f = first ? d : (d - 16);
                const float4 cs0 = *(const float4*)(rope + ((size_t)s * 16 + f) * 2), cs1 = *(const float4*)(rope + ((size_t)s * 16 + f) * 2 + 4);
                float4 o;
                if (first) o = make_float4(v.x * cs0.x - up.x * cs0.y, v.y * cs0.z - up.y * cs0.w, v.z * cs1.x - up.z * cs1.y, v.w * cs1.z - up.w * cs1.w);
                else       o = make_float4(v.x * cs0.x + dn.x * cs0.y, v.y * cs0.z + dn.y * cs0.w, v.z * cs1.x + dn.z * cs1.y, v.w * cs1.z + dn.w * cs1.w);
                uint2 u; u.x = cvtpk(o.x, o.y); u.y = cvtpk(o.z, o.w);
#pragma unroll
                for (int h = 0; h < NH; ++h) *(uint2*)(Kb + ((size_t)(b * NH + h) * S + s) * DQK + 64 + d) = u;
            }
        }
    }, [](int) { return 1.f; }, lds);
}
__device__ __forceinline__ void phase_gemm2(const Params& P, int l, char* lds) {
    unsigned char* ws = P.ws;
    const bf16* PROJ = (const bf16*)(ws + WS_PROJ);
    const float* rope = (const float*)(ws + WS_ROPE);
    const float* SSQ = (const float*)(ws + WS_SSQ);
    const int G = gridDim.x, bid = blockIdx.x;
    const int vb = ((G & 7) == 0) ? ((bid & 7) * (G >> 3) + (bid >> 3)) : bid;
    int qlo, qhi, klo, khi;
    if ((G & 1) == 0) {
        const int Gh = G >> 1, pq = (384 + Gh - 1) / Gh, pk = (512 + Gh - 1) / Gh;
        if (vb < Gh) { qlo = vb * pq; qhi = qlo + pq; if (qhi > 384) qhi = 384; if (qlo > 384) qlo = 384; klo = 0; khi = 0; }
        else { klo = (vb - Gh) * pk; khi = klo + pk; if (khi > 512) khi = 512; if (klo > 512) klo = 512; qlo = 0; qhi = 0; }
    } else { tile_range(384, qlo, qhi); tile_range(512, klo, khi); }
    {
        const bf16* W = (const bf16*)(ws + WS_WUQ) + (size_t)l * 768 * QR;
        bf16* Qb = (bf16*)(ws + WS_Q);
        gemm_t8<true>(W, QR, 768, PROJ + C_CQ, DINP, QR, qlo, qhi,
            [&](int t, int n, const float4& v) {
                const int b = t / S, s = t % S, h = n / DQK, d = n % DQK;
                float4 o = v;
                const int lane = tidx() & 63;
                const float4 up = make_float4(__shfl(v.x, lane + 4, 64), __shfl(v.y, lane + 4, 64), __shfl(v.z, lane + 4, 64), __shfl(v.w, lane + 4, 64));
                const float4 dn = make_float4(__shfl(v.x, lane - 4, 64), __shfl(v.y, lane - 4, 64), __shfl(v.z, lane - 4, 64), __shfl(v.w, lane - 4, 64));
                if (d >= 64) {
                    const bool first = d < 80;
                    const int f = first ? (d - 64) : (d - 80);
                    const float4 cs0 = *(const float4*)(rope + ((size_t)s * 16 + f) * 2), cs1 = *(const float4*)(rope + ((size_t)s * 16 + f) * 2 + 4);
                    if (first) o = make_float4(v.x * cs0.x - up.x * cs0.y, v.y * cs0.z - up.y * cs0.w, v.z * cs1.x - up.z * cs1.y, v.w * cs1.z - up.w * cs1.w);
                    else       o = make_float4(v.x * cs0.x + dn.x * cs0.y, v.y * cs0.z + dn.y * cs0.w, v.z * cs1.x + dn.z * cs1.y, v.w * cs1.z + dn.w * cs1.w);
                }
                uint2 u; u.x = cvtpk(o.x, o.y); u.y = cvtpk(o.z, o.w);
                *(uint2*)(Qb + ((size_t)(b * NH + h) * S + s) * DQK + d) = u;
            }, [&](int t) { const float4 a = *(const float4*)(SSQ + (size_t)t * 16); const float2 b = *(const float2*)(SSQ + (size_t)t * 16 + 4);
                            return rsqrtf(((a.x + a.y) + (a.z + a.w) + (b.x + b.y)) * (1.f / QR) + EPS) * QSCALE; }, lds);
    }
    {
        const bf16* W = (const bf16*)(ws + WS_WUKV) + (size_t)l * 1024 * KVR;
        bf16* Kb = (bf16*)(ws + WS_K); bf16* Vb = (bf16*)(ws + WS_V);
        gemm_t8<true>(W, KVR, 1024, PROJ + C_CKV, DINP, KVR, klo, khi,
            [&](int t, int n, const float4& v) {
                const int b = t / S, s = t % S;
                uint2 u; u.x = cvtpk(v.x, v.y); u.y = cvtpk(v.z, v.w);
                if (n < 512) *(uint2*)(Kb + ((size_t)(b * NH + (n >> 6)) * S + s) * DQK + (n & 63)) = u;
                else         *(uint2*)(Vb + ((size_t)(b * NH + ((n - 512) >> 6)) * S + s) * DV + (n & 63)) = u;
            }, [&](int t) { const float2 a = *(const float2*)(SSQ + (size_t)t * 16 + 6); const float2 b = *(const float2*)(SSQ + (size_t)t * 16 + 8);
                            return rsqrtf(((a.x + a.y) + (b.x + b.y)) * (1.f / KVR) + EPS); }, lds);
    }
}
__device__ __forceinline__ void phase_gemm3(const Params& P, int l, char* lds) {
    unsigned char* ws = P.ws;
    const bf16* Yb = (const bf16*)(ws + WS_XN);
    const bf16* W = (const bf16*)(ws + WS_WOUT) + (size_t)l * D * LDW;
    const float* hin = (l == 0) ? P.x : P.out;
    float* out = P.out;
    int tlo, thi; tile_range((T / 256) * (D / 256), tlo, thi);
    gemm_t8<false>(W, LDW, D, Yb, LDX, D, tlo, thi, [&](int t, int n, const float4& v) {
        const size_t idx = (size_t)t * D + n;
        const float4 hv = *(const float4*)(hin + idx);
        *(float4*)(out + idx) = make_float4(hv.x + v.x, hv.y + v.y, hv.z + v.z, hv.w + v.w);
    }, [](int) { return 1.f; }, lds);
}

#define GSYNC() do { XcdBarrier xb_; { __attribute__((address_space(1))) char* gp_ = (__attribute__((address_space(1))) char*)(char*)(P.ws + WS_CTL); asm volatile("" : "+s"(gp_)); xb_.bar = (unsigned*)(char*)gp_; } \
    xb_.x = xb_xcc_id(); xb_.st = (volatile LAS unsigned*)&xb_words; xcd_barrier(xb_); } while (0)
#define PHASE(stmt) { const Params Q = launder(P); stmt; }
__global__ void __launch_bounds__(NTHREADS, 2) k_all(Params P) {
    __shared__ __attribute__((aligned(16))) char sm[LDS_TOTAL];
    __shared__ uint4 xb_words;
    cg::grid_group grid = cg::this_grid();
    if (__builtin_amdgcn_workitem_id_x() == 0) xb_words = make_uint4(0u, 0u, 0u, 0u);
    __syncthreads();
    (void)xcd_barrier_post((unsigned*)(P.ws + WS_CTL), (volatile LAS unsigned*)&xb_words);
    __shared__ int xinfo[8];
    if (__builtin_amdgcn_workitem_id_x() == 0) {
        const unsigned x = xb_xcc_id();
        xinfo[XI_X] = (int)x; xinfo[XI_RANK] = (int)xb_add((unsigned*)(P.ws + WS_CTL) + CTL_CENSUS + x, 1u);
    }
    PHASE(phase_prep(Q, sm));
    PHASE(phase_norm(Q.x, Q.norm_mix, (bf16*)(Q.ws + WS_XN)));
    if (P.ws == nullptr) grid.sync();
    GSYNC();
    if (__builtin_amdgcn_workitem_id_x() == 0) {
        unsigned* cen = (unsigned*)(P.ws + WS_CTL) + CTL_CENSUS;
        const int x = xinfo[XI_X]; int nx = 0, jj = 0;
        for (int q = 0; q < 16; ++q) { const unsigned cq = xb_ld(cen + q); if (cq) { if (q < x) ++jj; ++nx; } }
        xinfo[XI_J] = jj; xinfo[XI_NX] = nx; xinfo[XI_NLOC] = (int)xb_ld(cen + x);
    }
    __syncthreads();
    for (int l = 0; l < DEPTH; ++l) {
        PHASE(phase_gemm1(Q, l, sm));
#if PROBE_DUP & 2
        PHASE(phase_gemm1(Q, l, sm));
#endif
        GSYNC();
        PHASE(phase_mixlocal(Q, l, sm));
#if PROBE_DUP & 256
        PHASE(phase_mixlocal(Q, l, sm));
#endif
        PHASE(phase_gemm2(Q, l, sm));
#if PROBE_DUP & 4
        PHASE(phase_gemm2(Q, l, sm));
#endif
        GSYNC();
        PHASE(phase_attn(Q, sm));
        GSYNC();
        PHASE(phase_gemm3(Q, l, sm));
#if PROBE_DUP & 16
        if (l == 0) PHASE(phase_gemm3(Q, l, sm));
#endif
        GSYNC();
        PHASE(phase_norm_q(Q, l));
        GSYNC();
        PHASE(phase_route(Q, l, sm));
        GSYNC();
        PHASE(phase_gu(Q, l, xinfo));
        GSYNC();
        PHASE(phase_gw(Q, l));
        GSYNC();
        PHASE(phase_gv(Q, l, xinfo, sm));
        GSYNC();
        PHASE(phase_gnorm(Q, l));
        GSYNC();
    }
}

extern "C" void kernel_launch(void* const* d_in, const int* in_sizes, int n_in, void* d_out, int out_size, void* d_ws, size_t ws_size, hipStream_t stream) {
    static int grid = 0;
    if (grid == 0) {
        if (n_in != 18 || out_size != T * D || ws_size < WS_END) { fprintf(stderr, "kernel_launch: bad sizes n_in %d out %d ws %zu need %zu\n", n_in, out_size, ws_size, (size_t)WS_END); grid = -1; return; }
        int dev = 0, cus = 0, per_cu = 0;
        (void)hipGetDevice(&dev);
        (void)hipDeviceGetAttribute(&cus, hipDeviceAttributeMultiprocessorCount, dev);
        (void)hipOccupancyMaxActiveBlocksPerMultiprocessor(&per_cu, (const void*)k_all, NTHREADS, 0);
        if (per_cu > 1) per_cu = 1;
        if (per_cu < 1) { fprintf(stderr, "kernel_launch: occupancy query says %d\n", per_cu); grid = -1; return; }
        grid = cus * per_cu;
    }
    if (grid < 0) return;
    Params p{};
    p.x = (const float*)d_in[0]; p.norm_mix = (const float*)d_in[1]; p.w_in = (const float*)d_in[2]; p.conv_w = (const float*)d_in[3];
    p.pool_w = (const float*)d_in[4]; p.pool_scale = (const float*)d_in[5]; p.q_norm = (const float*)d_in[6]; p.w_uq = (const float*)d_in[7];
    p.kv_norm = (const float*)d_in[8]; p.w_uk = (const float*)d_in[9]; p.w_uv = (const float*)d_in[10]; p.w_out = (const float*)d_in[11];
    p.norm_ffn = (const float*)d_in[12]; p.peer_wq = (const float*)d_in[13]; p.peer_subkeys = (const float*)d_in[14]; p.peer_u = (const float*)d_in[15];
    p.peer_v = (const float*)d_in[16]; p.norm_final = (const float*)d_in[17];
    p.out = (float*)d_out; p.ws = (unsigned char*)d_ws;
    if (hipMemsetAsync((char*)d_ws + WS_CTL, 0, CTL_BYTES, stream) != hipSuccess) { fprintf(stderr, "kernel_launch: memset failed\n"); return; }
    void* args[] = {&p};
    hipError_t e = hipLaunchCooperativeKernel((const void*)k_all, dim3(grid), dim3(NTHREADS), args, 0, stream);
    if (e != hipSuccess) fprintf(stderr, "cooperative launch failed: %s (grid %d)\n", hipGetErrorString(e), grid);
}
```

```cpp
#include <hip/hip_runtime.h>
#include <hip/hip_cooperative_groups.h>
#include <cstdio>
#include <cstdint>
namespace cg = cooperative_groups;

#ifndef TAB_FP8
#define TAB_FP8 1
#endif
#ifndef PROBE_DUP
#define PROBE_DUP 0
#endif

constexpr int NB = 4, S = 8192, T = NB * S, D = 1024, DEPTH = 2;
constexpr int DIN = 1696, DINP = 1792;
constexpr int C_BG = 0, C_CG = 256, C_HC = 512, C_HP = 768, C_CQ = 1024, C_CKV = 1408, C_KR = 1664;
constexpr int QR = 384, KVR = 256, NH = 8, DQK = 96, DV = 64;
constexpr int PH = 8, NKEY = 128, NEXP = NKEY * NKEY, TOPK = 16, HK = PH * TOPK;
constexpr float EPS = 1e-6f;
constexpr int LDX = 1088;
constexpr int LDW = 1088;

typedef unsigned short bf16;

constexpr size_t WS_CTL   = 0;
constexpr size_t WS_ROPE  = 64 * 1024;
constexpr size_t WS_WIN   = WS_ROPE + (size_t)S * 16 * 2 * 4;
constexpr size_t WS_WUQ   = WS_WIN + (size_t)DEPTH * DINP * LDW * 2;
constexpr size_t WS_WUKV  = WS_WUQ + (size_t)DEPTH * 768 * QR * 2;
constexpr size_t WS_WOUT  = WS_WUKV + (size_t)DEPTH * 1024 * KVR * 2;
constexpr size_t WS_WPQ   = WS_WOUT + (size_t)DEPTH * D * LDW * 2;
constexpr size_t WS_XN    = ((WS_WPQ + (size_t)DEPTH * 2048 * LDW * 2 + 4095) / 4096) * 4096;
constexpr size_t WS_PROJ  = WS_XN + (size_t)T * LDX * 2;
constexpr size_t WS_Q     = WS_PROJ + (size_t)T * DINP * 2;
constexpr size_t WS_K     = WS_Q + (size_t)T * NH * DQK * 2;
constexpr size_t WS_V     = WS_K + (size_t)T * NH * DQK * 2;
constexpr size_t WS_EXP   = WS_V + (size_t)T * NH * DV * 2;
constexpr size_t WS_GATE  = WS_EXP + (size_t)T * HK * 4;
constexpr size_t TAB_ROWB = TAB_FP8 ? 1024 : 2048;
constexpr size_t WS_TABU  = WS_GATE + (size_t)T * HK * 4;
constexpr size_t WS_TABV  = WS_TABU + (size_t)DEPTH * NEXP * TAB_ROWB;
constexpr size_t WS_TSCU  = WS_TABV + (size_t)DEPTH * NEXP * TAB_ROWB;
constexpr size_t WS_TSCV  = WS_TSCU + (size_t)DEPTH * NEXP * 4;
constexpr size_t WS_XQ    = WS_TSCV + (size_t)DEPTH * NEXP * 4;
constexpr size_t WS_XS    = WS_XQ + (size_t)T * D;
constexpr size_t WS_WQ8   = WS_XS + (size_t)T * 4;
constexpr size_t WS_WSC   = WS_WQ8 + (size_t)T * HK;
constexpr size_t WS_SSQ   = WS_WSC + (size_t)T * 4;
constexpr size_t WS_END   = WS_SSQ + (size_t)T * 64;
static_assert(WS_END <= (size_t)512 * 1024 * 1024, "workspace budget");

struct Params {
    const float* x; const float* norm_mix; const float* w_in; const float* conv_w; const float* pool_w; const float* pool_scale;
    const float* q_norm; const float* w_uq; const float* kv_norm; const float* w_uk; const float* w_uv; const float* w_out;
    const float* norm_ffn; const float* peer_wq; const float* peer_subkeys; const float* peer_u; const float* peer_v; const float* norm_final;
    float* out; unsigned char* ws;
};

__device__ __forceinline__ bf16 f2bf(float f) { unsigned u = __float_as_uint(f); u += 0x7fffu + ((u >> 16) & 1u); return (bf16)(u >> 16); }
__device__ __forceinline__ float bf2f(bf16 h) { return __uint_as_float(((unsigned)h) << 16); }
__device__ __forceinline__ float bflo(unsigned u) { return __uint_as_float(u << 16); }
__device__ __forceinline__ float bfhi(unsigned u) { return __uint_as_float(u & 0xffff0000u); }
__device__ __forceinline__ unsigned pack2(float a, float b) { return (unsigned)f2bf(a) | ((unsigned)f2bf(b) << 16); }
__device__ __forceinline__ float wave_sum(float v) {
#pragma unroll
    for (int m = 32; m >= 1; m >>= 1) v += __shfl_xor(v, m, 64);
    return v;
}
__device__ __forceinline__ float gelu_exact(float x) { return 0.5f * x * (1.f + erff(x * 0.70710678118654752f)); }

#define NTHREADS 512
constexpr int NW = NTHREADS / 64;
__device__ __forceinline__ int tidx() { int t = (int)__builtin_amdgcn_workitem_id_x(); asm volatile("" : "+v"(t)); return t; }
__device__ __forceinline__ int gwave() { return blockIdx.x * (NTHREADS / 64) + (tidx() >> 6); }
__device__ __forceinline__ int nwave() { return gridDim.x * (NTHREADS / 64); }
__device__ __forceinline__ size_t gtid() { return (size_t)blockIdx.x * NTHREADS + tidx(); }
__device__ __forceinline__ size_t gnth() { return (size_t)gridDim.x * NTHREADS; }


__device__ __forceinline__ Params launder(const Params& P) {
    typedef __attribute__((address_space(1))) char* gp_t;
    gp_t g[20] = {(gp_t)(char*)P.x, (gp_t)(char*)P.norm_mix, (gp_t)(char*)P.w_in, (gp_t)(char*)P.conv_w, (gp_t)(char*)P.pool_w, (gp_t)(char*)P.pool_scale, (gp_t)(char*)P.q_norm, (gp_t)(char*)P.w_uq,
                  (gp_t)(char*)P.kv_norm, (gp_t)(char*)P.w_uk, (gp_t)(char*)P.w_uv, (gp_t)(char*)P.w_out, (gp_t)(char*)P.norm_ffn, (gp_t)(char*)P.peer_wq, (gp_t)(char*)P.peer_subkeys,
                  (gp_t)(char*)P.peer_u, (gp_t)(char*)P.peer_v, (gp_t)(char*)P.norm_final, (gp_t)(char*)P.out, (gp_t)(char*)P.ws};
    asm volatile("" : "+s"(g[0]), "+s"(g[1]), "+s"(g[2]), "+s"(g[3]), "+s"(g[4]), "+s"(g[5]), "+s"(g[6]), "+s"(g[7]), "+s"(g[8]), "+s"(g[9]));
    asm volatile("" : "+s"(g[10]), "+s"(g[11]), "+s"(g[12]), "+s"(g[13]), "+s"(g[14]), "+s"(g[15]), "+s"(g[16]), "+s"(g[17]), "+s"(g[18]), "+s"(g[19]));
    Params Q;
    Q.x = (const float*)(char*)g[0]; Q.norm_mix = (const float*)(char*)g[1]; Q.w_in = (const float*)(char*)g[2]; Q.conv_w = (const float*)(char*)g[3]; Q.pool_w = (const float*)(char*)g[4];
    Q.pool_scale = (const float*)(char*)g[5]; Q.q_norm = (const float*)(char*)g[6]; Q.w_uq = (const float*)(char*)g[7]; Q.kv_norm = (const float*)(char*)g[8]; Q.w_uk = (const float*)(char*)g[9];
    Q.w_uv = (const float*)(char*)g[10]; Q.w_out = (const float*)(char*)g[11]; Q.norm_ffn = (const float*)(char*)g[12]; Q.peer_wq = (const float*)(char*)g[13]; Q.peer_subkeys = (const float*)(char*)g[14];
    Q.peer_u = (const float*)(char*)g[15]; Q.peer_v = (const float*)(char*)g[16]; Q.norm_final = (const float*)(char*)g[17]; Q.out = (float*)(char*)g[18]; Q.ws = (unsigned char*)(char*)g[19];
    return Q;
}

typedef __attribute__((ext_vector_type(8))) short bf16x8;
typedef __attribute__((ext_vector_type(16))) float f32x16;
typedef __attribute__((ext_vector_type(2))) __bf16 bf2_t;
#define MFMA32(a, b, c) __builtin_amdgcn_mfma_f32_32x32x16_bf16(a, b, c, 0, 0, 0)
__device__ __forceinline__ int crow(int r, int hi) { return (r & 3) + 8 * (r >> 2) + 4 * hi; }
__device__ __forceinline__ float dot2bf(unsigned a, unsigned b, float c) { return __builtin_amdgcn_fdot2_f32_bf16(__builtin_bit_cast(bf2_t, a), __builtin_bit_cast(bf2_t, b), c, false); }
__device__ __forceinline__ unsigned cvtpk(float lo, float hi) { unsigned r; asm("v_cvt_pk_bf16_f32 %0, %1, %2" : "=v"(r) : "v"(lo), "v"(hi)); return r; }
constexpr int LDS_TOTAL = 140 * 1024;

template <int WT, bool ROWSS>
__device__ __forceinline__ void gemm_kloop(const bf16* __restrict__ Ag0, int lda, const bf16* __restrict__ Bg0, int ldb, int nk, f32x16 (&acc)[8], float (&ss)[4], char* lds, int tid) {
    constexpr int BROWS = (WT == 0) ? 256 : 128, NPB = BROWS / 64;
    constexpr int OPA = 256 * 128, G_BUF = OPA + BROWS * 128;
    const int lane = tid & 63, w = __builtin_amdgcn_readfirstlane(tid >> 6), r32 = lane & 31, hi = lane >> 5;
    const int srow = 8 * w + (lane >> 3);
    const int sch = (lane & 7) ^ ((srow >> 1) & 7);
    const bf16* Ag = Ag0 + (size_t)srow * lda + sch * 8;
    const bf16* Bg = Bg0 + (size_t)srow * ldb + sch * 8;
#pragma unroll
    for (int i = 0; i < 8; ++i)
#pragma unroll
        for (int r = 0; r < 16; ++r) acc[i][r] = 0.f;
    ss[0] = 0.f; ss[1] = 0.f; ss[2] = 0.f; ss[3] = 0.f;
    typedef __attribute__((address_space(3))) unsigned* ldsp_t;
    typedef const __attribute__((address_space(1))) unsigned* glbp_t;
#define G_DMA(buf, kofs) do { char* d_ = lds + (buf) * G_BUF + (8 * w) * 128; \
    _Pragma("unroll") for (int i = 0; i < 4; ++i) \
        __builtin_amdgcn_global_load_lds((glbp_t)(const void*)(Ag + (size_t)(64 * i) * lda + (kofs)), (ldsp_t)(void*)(d_ + i * 8192), 16, 0, 0); \
    _Pragma("unroll") for (int i = 0; i < NPB; ++i) \
        __builtin_amdgcn_global_load_lds((glbp_t)(const void*)(Bg + (size_t)(64 * i) * ldb + (kofs)), (ldsp_t)(void*)(d_ + OPA + i * 8192), 16, 0, 0); } while (0)
    const int xr = (r32 >> 1) & 7;
    const int o0 = ((0 + hi) ^ xr) << 4, o1 = ((2 + hi) ^ xr) << 4, o2 = ((4 + hi) ^ xr) << 4, o3 = ((6 + hi) ^ xr) << 4;
#define G_SS(s_, r_) do { union { bf16x8 v; uint4 u; } c_; c_.v = r_; s_ = dot2bf(c_.u.x, c_.u.x, s_); s_ = dot2bf(c_.u.y, c_.u.y, s_); s_ = dot2bf(c_.u.z, c_.u.z, s_); s_ = dot2bf(c_.u.w, c_.u.w, s_); } while (0)
#define G_STEP(pa, pb, off) do { \
    if (WT == 0) { \
        const bf16x8 a0 = *(const bf16x8*)(pa + off), a1 = *(const bf16x8*)(pa + 32 * 128 + off); \
        const bf16x8 b0 = *(const bf16x8*)(pb + off), b1 = *(const bf16x8*)(pb + 32 * 128 + off), b2 = *(const bf16x8*)(pb + 64 * 128 + off), b3 = *(const bf16x8*)(pb + 96 * 128 + off); \
        if (ROWSS) { G_SS(ss[0], b0); G_SS(ss[1], b1); G_SS(ss[2], b2); G_SS(ss[3], b3); } \
        acc[0] = MFMA32(a0, b0, acc[0]); acc[1] = MFMA32(a0, b1, acc[1]); acc[2] = MFMA32(a0, b2, acc[2]); acc[3] = MFMA32(a0, b3, acc[3]); \
        acc[4] = MFMA32(a1, b0, acc[4]); acc[5] = MFMA32(a1, b1, acc[5]); acc[6] = MFMA32(a1, b2, acc[6]); acc[7] = MFMA32(a1, b3, acc[7]); \
    } else if (WT == 2) { \
        const bf16x8 a0 = *(const bf16x8*)(pa + off), a1 = *(const bf16x8*)(pa + 32 * 128 + off); \
        const bf16x8 b0 = *(const bf16x8*)(pb + off), b1 = *(const bf16x8*)(pb + 32 * 128 + off); \
        if (ROWSS) { G_SS(ss[0], b0); G_SS(ss[1], b1); } \
        acc[0] = MFMA32(a0, b0, acc[0]); acc[1] = MFMA32(a0, b1, acc[1]); acc[2] = MFMA32(a1, b0, acc[2]); acc[3] = MFMA32(a1, b1, acc[3]); \
    } else { \
        const bf16x8 b0 = *(const bf16x8*)(pb + off); \
        const bf16x8 a0 = *(const bf16x8*)(pa + off), a1 = *(const bf16x8*)(pa + 32 * 128 + off); \
        const bf16x8 a2 = *(const bf16x8*)(pa + 64 * 128 + off), a3 = *(const bf16x8*)(pa + 96 * 128 + off); \
        if (ROWSS) { G_SS(ss[0], b0); } \
        acc[0] = MFMA32(a0, b0, acc[0]); acc[1] = MFMA32(a1, b0, acc[1]); \
        acc[2] = MFMA32(a2, b0, acc[2]); acc[3] = MFMA32(a3, b0, acc[3]); \
    } } while (0)
    const int arow = (WT == 1) ? ((w >> 2) * 128 + r32) : ((w >> 1) * 64 + r32);
    const int brow = (WT == 0) ? ((w & 1) * 128 + r32) : (WT == 2) ? ((w & 1) * 64 + r32) : ((w & 3) * 32 + r32);
    G_DMA(0, 0);
    for (int kt = 0; kt < nk; ++kt) {
        __syncthreads();
        if (kt + 1 < nk) G_DMA((kt + 1) & 1, (kt + 1) * 64);
        const char* pa = lds + (kt & 1) * G_BUF + arow * 128;
        const char* pb = lds + (kt & 1) * G_BUF + OPA + brow * 128;
        G_STEP(pa, pb, o0); G_STEP(pa, pb, o1); G_STEP(pa, pb, o2); G_STEP(pa, pb, o3);
    }
    if (ROWSS) { ss[0] += __shfl_xor(ss[0], 32, 64); ss[1] += __shfl_xor(ss[1], 32, 64); ss[2] += __shfl_xor(ss[2], 32, 64); ss[3] += __shfl_xor(ss[3], 32, 64); }
#undef G_DMA
#undef G_SS
#undef G_STEP
}

__device__ __forceinline__ void tile_range(int ntiles, int& lo, int& hi) {
    const int G = gridDim.x, b = blockIdx.x;
    const int vb = ((G & 7) == 0) ? ((b & 7) * (G >> 3) + (b >> 3)) : b;
    const int per = (ntiles + G - 1) / G;
    lo = vb * per; hi = lo + per; if (hi > ntiles) hi = ntiles;
}
constexpr int ST_P = 68;
static_assert(NW * 64 * ST_P * 4 <= LDS_TOTAL, "staging LDS");
template <bool ROWSS, class EPI, class EPIROW, class RSC>
__device__ __forceinline__ void gemm_t(const bf16* __restrict__ Wt, int ldw, int N, const bf16* __restrict__ X, int ldx, int M, int K, int tn_direct, EPI epi, EPIROW epirow, RSC rowscale, char* lds) {
    const int tid = tidx(), lane = tid & 63, w = tid >> 6, r32 = lane & 31, hi = lane >> 5;
    const int tilesN = N / 256, tilesM = M / 256, nk = K / 64;
    int tlo, thi; tile_range(tilesM * tilesN, tlo, thi);
    for (int tile = tlo; tile < thi; ++tile) {
        const int tm = tile / tilesN, tn = tile % tilesN;
        f32x16 acc[8]; float ss[4];
        gemm_kloop<0, ROWSS>(Wt + (size_t)(tn * 256) * ldw, ldw, X + (size_t)(tm * 256) * ldx, ldx, nk, acc, ss, lds, tid);
        if (tn < tn_direct) {
            __syncthreads();
            float* st = (float*)lds + w * (64 * ST_P);
            const int rr = lane >> 4, ch = lane & 15;
#pragma unroll
            for (int half = 0; half < 2; ++half) {
                const float m0_ = rowscale(ss[2 * half]), m1_ = rowscale(ss[2 * half + 1]);
#pragma unroll
                for (int i = 0; i < 2; ++i)
#pragma unroll
                    for (int jj = 0; jj < 2; ++jj)
#pragma unroll
                        for (int g = 0; g < 4; ++g) {
                            const float mj = jj ? m1_ : m0_;
                            const f32x16& a_ = acc[i * 4 + 2 * half + jj];
                            *(float4*)(st + (32 * jj + r32) * ST_P + 32 * i + 8 * g + 4 * hi) = make_float4(a_[4 * g] * mj, a_[4 * g + 1] * mj, a_[4 * g + 2] * mj, a_[4 * g + 3] * mj);
                        }
#pragma unroll 2
                for (int it = 0; it < 16; ++it) {
                    const int row = it * 4 + rr;
                    const float4 v = *(const float4*)(st + row * ST_P + ch * 4);
                    epirow(tm * 256 + (w & 1) * 128 + half * 64 + row, tn * 256 + (w >> 1) * 64 + ch * 4, v);
                }
            }
        } else {
#pragma unroll
            for (int i = 0; i < 2; ++i)
#pragma unroll
                for (int j = 0; j < 4; ++j)
                    epi(tn * 256 + (w >> 1) * 64 + i * 32, tm * 256 + (w & 1) * 128 + j * 32, acc[i * 4 + j], r32, hi, ss[j]);
        }
        __syncthreads();
    }
}

constexpr int ST1_P = 132;
static_assert(NW * 32 * ST1_P * 4 <= LDS_TOTAL, "staging LDS (128 x 32 wave tiles)");
template <class EPIROW, class RSC>
__device__ __forceinline__ void gemm_t1(const bf16* __restrict__ Wt, int ldw, int N, const bf16* __restrict__ X, int ldx, int M, int K, EPIROW epirow, RSC rowscale, char* lds) {
    const int tid = tidx(), lane = tid & 63, w = tid >> 6, r32 = lane & 31, hi = lane >> 5;
    const int tilesN = N / 256, tilesM = M / 128, nk = K / 64;
    int tlo, thi; tile_range(tilesM * tilesN, tlo, thi);
    for (int tile = tlo; tile < thi; ++tile) {
        const int tm = tile / tilesN, tn = tile % tilesN;
        f32x16 acc[8]; float ss[4];
        gemm_kloop<1, true>(Wt + (size_t)(tn * 256) * ldw, ldw, X + (size_t)(tm * 128) * ldx, ldx, nk, acc, ss, lds, tid);
        __syncthreads();
        float* st = (float*)lds + w * (32 * ST1_P);
        const float mj = rowscale(ss[0]);
#pragma unroll
        for (int mt = 0; mt < 4; ++mt)
#pragma unroll
            for (int g = 0; g < 4; ++g)
                *(float4*)(st + r32 * ST1_P + 32 * mt + 8 * g + 4 * hi) = make_float4(acc[mt][4 * g] * mj, acc[mt][4 * g + 1] * mj, acc[mt][4 * g + 2] * mj, acc[mt][4 * g + 3] * mj);
#pragma unroll 2
        for (int it = 0; it < 16; ++it) {
            const int row = it * 2 + hi;
            const float4 v = *(const float4*)(st + row * ST1_P + r32 * 4);
            epirow(tm * 128 + (w & 3) * 32 + row, tn * 256 + (w >> 2) * 128 + r32 * 4, v);
        }
        __syncthreads();
    }
}

template <class EPIROW>
__device__ __forceinline__ void gemm_t2(const bf16* __restrict__ Wt, int ldw, int N, const bf16* __restrict__ X, int ldx, int M, int K, EPIROW epirow, char* lds) {
    const int tid = tidx(), lane = tid & 63, w = tid >> 6, r32 = lane & 31, hi = lane >> 5;
    const int tilesN = N / 256, tilesM = M / 128, nk = K / 64;
    int tlo, thi; tile_range(tilesM * tilesN, tlo, thi);
    for (int tile = tlo; tile < thi; ++tile) {
        const int tm = tile / tilesN, tn = tile % tilesN;
        f32x16 acc[8]; float ss[4];
        gemm_kloop<2, false>(Wt + (size_t)(tn * 256) * ldw, ldw, X + (size_t)(tm * 128) * ldx, ldx, nk, acc, ss, lds, tid);
        __syncthreads();
        float* st = (float*)lds + w * (64 * ST_P);
#pragma unroll
        for (int i = 0; i < 2; ++i)
#pragma unroll
            for (int j = 0; j < 2; ++j)
#pragma unroll
                for (int g = 0; g < 4; ++g)
                    *(float4*)(st + (32 * j + r32) * ST_P + 32 * i + 8 * g + 4 * hi) = make_float4(acc[i * 2 + j][4 * g], acc[i * 2 + j][4 * g + 1], acc[i * 2 + j][4 * g + 2], acc[i * 2 + j][4 * g + 3]);
        const int rr = lane >> 4, ch = lane & 15;
#pragma unroll 4
        for (int it = 0; it < 16; ++it) {
            const int row = it * 4 + rr;
            const float4 v = *(const float4*)(st + row * ST_P + ch * 4);
            epirow(tm * 128 + (w & 1) * 64 + row, tn * 256 + (w >> 1) * 64 + ch * 4, v);
        }
        __syncthreads();
    }
}

typedef __attribute__((ext_vector_type(4))) float f32x4;
constexpr int G8_HT = 128 * 64;
__device__ __forceinline__ int g8_lds_byte(int r, int c) {
    const int st = (r >> 4) * 2 + (c >> 5), rr = r & 15, cc = c & 31, ob = rr * 64 + cc * 2;
    return st * 1024 + (ob ^ (((ob >> 9) & 1) << 5));
}
__device__ __forceinline__ void g8_stage_rc(int b, int& R, int& C) {
    const int st = b / 1024, sb = b % 1024, swz = sb ^ (((sb >> 9) & 1) << 5);
    R = (st >> 1) * 16 + swz / 64; C = (st & 1) * 32 + (swz % 64) / 2;
}
__device__ __forceinline__ float ssq8(const bf16x8& v, float s) {
    union { bf16x8 v; uint4 u; } c_; c_.v = v;
    s = dot2bf(c_.u.x, c_.u.x, s); s = dot2bf(c_.u.y, c_.u.y, s); s = dot2bf(c_.u.z, c_.u.z, s); return dot2bf(c_.u.w, c_.u.w, s);
}
template <bool ROWSS, bool APERM = false>
__device__ __forceinline__ void gemm8_kloop(const bf16* __restrict__ A, int lda, const bf16* __restrict__ Bt, int ldb, int nt, f32x4 (&acc)[2][2][4][2], float (&ss)[2][2], char* lds, int tid) {
    bf16* shm = (bf16*)lds;
    typedef __attribute__((address_space(3))) unsigned* ldsp_t;
    typedef const __attribute__((address_space(1))) unsigned* glbp_t;
#define SA(b, h) (shm + ((b) * 2 + (h)) * G8_HT)
#define SB(b, h) (shm + (4 + (b) * 2 + (h)) * G8_HT)
    int sr0, sc0; g8_stage_rc(tid * 16, sr0, sc0);
    const unsigned voa = (unsigned)((sr0 * lda + sc0) * 2), vob = (unsigned)((sr0 * ldb + sc0) * 2);
    const char* Ap = (const char*)A; const char* Bp = (const char*)Bt;
    const int wbase = __builtin_amdgcn_readfirstlane(tid >> 6) * 1024;
#define STAGE_(P, BASE, VO, LD, br, r2, kt) do { const char* g_ = BASE + ((size_t)(br) * LD + (kt) * 64) * 2; \
    __builtin_amdgcn_global_load_lds((glbp_t)(const void*)(g_ + VO), (ldsp_t)(void*)((char*)(P) + wbase), 16, 0, 0); \
    __builtin_amdgcn_global_load_lds((glbp_t)(const void*)(g_ + (size_t)(2 * (r2)) * LD + VO), (ldsp_t)(void*)((char*)(P) + wbase + 8192), 16, 0, 0); } while (0)
#define STAGEA(b, h, kt) STAGE_(SA(b, h), Ap, voa, lda, (APERM ? (h) * 64 : (h) * 128), (APERM ? 128 : 64), kt)
#define STAGEB(b, h, kt) STAGE_(SB(b, h), Bp, vob, ldb, (h) * 128, 64, kt)
    const int lane = tid & 63, wid = tid >> 6, wr = wid >> 2, wc = wid & 3, fr = lane & 15, fq = lane >> 4;
    int abase, bbase;
    { const int ob = fr * 64 + fq * 16, lp = ob ^ (((ob >> 9) & 1) << 5);
      abase = lp + wr * 8192; bbase = lp + wc * 4096 + 4 * G8_HT * 2;
      asm volatile("" : "+v"(abase), "+v"(bbase)); }
#define LDA(dst, b, h) _Pragma("unroll") for (int m = 0; m < 4; ++m) _Pragma("unroll") for (int k = 0; k < 2; ++k) \
    dst[m][k] = *reinterpret_cast<const bf16x8*>(lds + abase + (((b) * 2 + (h)) * G8_HT * 2 + m * 2048 + k * 1024))
#define LDB(dst, b, h) _Pragma("unroll") for (int n = 0; n < 2; ++n) _Pragma("unroll") for (int k = 0; k < 2; ++k) \
    dst[n][k] = *reinterpret_cast<const bf16x8*>(lds + bbase + (((b) * 2 + (h)) * G8_HT * 2 + n * 2048 + k * 1024))
#define MMA(ai, bj, At_, Bt_) do { __builtin_amdgcn_s_setprio(1); \
    _Pragma("unroll") for (int m = 0; m < 4; ++m) _Pragma("unroll") for (int n = 0; n < 2; ++n) _Pragma("unroll") for (int k = 0; k < 2; ++k) \
        acc[ai][bj][m][n] = __builtin_amdgcn_mfma_f32_16x16x32_bf16(At_[m][k], Bt_[n][k], acc[ai][bj][m][n], 0, 0, 0); \
    __builtin_amdgcn_s_setprio(0); } while (0)
#define SSQ(bj, Bt_) do { if (ROWSS) { _Pragma("unroll") for (int n = 0; n < 2; ++n) { ss[bj][n] = ssq8(Bt_[n][0], ss[bj][n]); ss[bj][n] = ssq8(Bt_[n][1], ss[bj][n]); } } } while (0)
#define WAIT_V(n) asm volatile("s_waitcnt vmcnt(" #n ")" ::: "memory")
#define WAIT_L(n) asm volatile("s_waitcnt lgkmcnt(" #n ")" ::: "memory")
#define BAR __builtin_amdgcn_s_barrier()
#define SCHED __builtin_amdgcn_sched_barrier(0)
#pragma unroll
    for (int a = 0; a < 2; ++a)
#pragma unroll
        for (int b = 0; b < 2; ++b)
#pragma unroll
            for (int m = 0; m < 4; ++m)
#pragma unroll
                for (int n = 0; n < 2; ++n) acc[a][b][m][n] = f32x4{0.f, 0.f, 0.f, 0.f};
    ss[0][0] = 0.f; ss[0][1] = 0.f; ss[1][0] = 0.f; ss[1][1] = 0.f;
    bf16x8 At[4][2], B0[2][2], B1[2][2];
    STAGEB(0, 0, 0); STAGEA(0, 0, 0);
    STAGEB(0, 1, 0); STAGEA(0, 1, 0);
    if (wr == 1) BAR;
    WAIT_V(4); BAR;
    STAGEB(1, 0, 1); STAGEA(1, 0, 1); STAGEB(1, 1, 1);
    WAIT_V(6); BAR;
    for (int t = 0; t < nt - 2; t += 2) {
        LDB(B0, 0, 0); SCHED; LDA(At, 0, 0); STAGEA(1, 1, t + 1);
        WAIT_L(8); BAR; WAIT_L(0); MMA(0, 0, At, B0); SSQ(0, B0); BAR; SCHED;
        LDB(B1, 0, 1); STAGEB(0, 0, t + 2);
        BAR; WAIT_L(0); MMA(0, 1, At, B1); SSQ(1, B1); BAR;
        LDA(At, 0, 1); STAGEA(0, 0, t + 2);
        BAR; WAIT_L(0); MMA(1, 0, At, B0); BAR; SCHED;
        STAGEB(0, 1, t + 2);
        WAIT_V(6); BAR; MMA(1, 1, At, B1); BAR;
        LDB(B0, 1, 0); SCHED; LDA(At, 1, 0); STAGEA(0, 1, t + 2);
        WAIT_L(8); BAR; WAIT_L(0); MMA(0, 0, At, B0); SSQ(0, B0); BAR; SCHED;
        LDB(B1, 1, 1); STAGEB(1, 0, t + 3);
        BAR; WAIT_L(0); MMA(0, 1, At, B1); SSQ(1, B1); BAR;
        LDA(At, 1, 1); STAGEA(1, 0, t + 3);
        BAR; WAIT_L(0); MMA(1, 0, At, B0); BAR; SCHED;
        STAGEB(1, 1, t + 3);
        WAIT_V(6); BAR; MMA(1, 1, At, B1); BAR;
    }
    { LDB(B0, 0, 0); LDA(At, 0, 0); STAGEA(1, 1, nt - 1);
      BAR; WAIT_L(0); MMA(0, 0, At, B0); SSQ(0, B0); BAR;
      LDB(B1, 0, 1); BAR; WAIT_L(0); MMA(0, 1, At, B1); SSQ(1, B1); BAR;
      LDA(At, 0, 1); WAIT_V(4); BAR; WAIT_L(0); MMA(1, 0, At, B0); MMA(1, 1, At, B1); BAR; }
    { LDB(B0, 1, 0); LDA(At, 1, 0); WAIT_V(2); BAR; WAIT_L(0); MMA(0, 0, At, B0); SSQ(0, B0); BAR;
      LDB(B1, 1, 1); WAIT_V(0); BAR; WAIT_L(0); MMA(0, 1, At, B1); SSQ(1, B1); BAR;
      LDA(At, 1, 1); BAR; WAIT_L(0); MMA(1, 0, At, B0); MMA(1, 1, At, B1); BAR; }
    if (wr == 0) BAR;
    if (ROWSS) {
#pragma unroll
        for (int b = 0; b < 2; ++b)
#pragma unroll
            for (int n = 0; n < 2; ++n) { ss[b][n] += __shfl_xor(ss[b][n], 16, 64); ss[b][n] += __shfl_xor(ss[b][n], 32, 64); }
    }
#undef SSQ
#undef SA
#undef SB
#undef STAGE_
#undef STAGEA
#undef STAGEB
#undef LDA
#undef LDB
#undef MMA
#undef WAIT_V
#undef WAIT_L
#undef BAR
#undef SCHED
}
__device__ __forceinline__ void tile_rounds(int ntiles, int& lo, int& hi, int& step) {
    const int G = gridDim.x, b = blockIdx.x;
    if ((G & 7) == 0) { const int per = (ntiles + 7) >> 3, x = b & 7; lo = x * per + (b >> 3); hi = (x + 1) * per; if (hi > ntiles) hi = ntiles; step = G >> 3; }
    else { lo = b; hi = ntiles; step = G; }
}
template <bool SCALE, class EPIROW, class RSC>
__device__ __forceinline__ void gemm_t8(const bf16* __restrict__ Wt, int ldw, int N, const bf16* __restrict__ X, int ldx, int K, int tlo, int thi, int tstep, EPIROW epirow, RSC rowscale, char* lds) {
    const int tid = tidx();
    const int tilesN = N / 256; int nt = K / 64;
    asm volatile("" : "+s"(nt));
    for (int tile = tlo; tile < thi; tile += tstep) {
        const int tm = tile / tilesN, tn = tile % tilesN;
        f32x4 acc[2][2][4][2]; float ss[2][2];
        gemm8_kloop<false>(Wt + (size_t)(tn * 256) * ldw, ldw, X + (size_t)(tm * 256) * ldx, ldx, nt, acc, ss, lds, tid);
        __syncthreads();
        const int te = tidx();
        const int le = te & 63, w = te >> 6, wr = w >> 2, wc = w & 3, fr = le & 15, fq = le >> 4;
        float* st = (float*)lds + w * (32 * ST_P);
        const int rr = le >> 4, ch = le & 15;
#pragma unroll
        for (int ai = 0; ai < 2; ++ai)
#pragma unroll
            for (int bj = 0; bj < 2; ++bj) {
#pragma unroll
                for (int n = 0; n < 2; ++n) {
                    const float mj = SCALE ? rowscale(tm * 256 + bj * 128 + wc * 32 + n * 16 + fr) : 1.f;
#pragma unroll
                    for (int m = 0; m < 4; ++m) {
                        const f32x4 a_ = acc[ai][bj][m][n];
                        *(float4*)(st + (n * 16 + fr) * ST_P + m * 16 + fq * 4) = SCALE ? make_float4(a_[0] * mj, a_[1] * mj, a_[2] * mj, a_[3] * mj) : make_float4(a_[0], a_[1], a_[2], a_[3]);
                    }
                }
#pragma unroll 2
                for (int it = 0; it < 8; ++it) {
                    const int row = it * 4 + rr;
                    const float4 v = *(const float4*)(st + row * ST_P + ch * 4);
                    epirow(tm * 256 + bj * 128 + wc * 32 + row, tn * 256 + ai * 128 + wr * 64 + ch * 4, v);
                }
            }
        __syncthreads();
    }
}

__device__ __forceinline__ void transpose_tiled(const float* __restrict__ W, bf16* __restrict__ Wt, int K, int N, int Npad, int ldk, const float* __restrict__ gain, char* lds) {
    float (*tl)[65] = (float (*)[65])lds;
    const int tid = tidx(), a = tid & 63, q = tid >> 6;
    const int tK = K / 64, tN = Npad / 64;
    for (int tile = blockIdx.x; tile < tK * tN; tile += gridDim.x) {
        const int k0 = (tile / tN) * 64, n0 = (tile % tN) * 64;
#pragma unroll 4
        for (int i = 0; i < 64 / NW; ++i) {
            const int k = k0 + q * (64 / NW) + i, n = n0 + a;
            float v = (n < N) ? W[(size_t)k * N + n] : 0.f;
            if (gain) v *= gain[k];
            tl[q * (64 / NW) + i][a] = v;
        }
        __syncthreads();
#pragma unroll 4
        for (int i = 0; i < 64 / NW; ++i) { const int nl = q * (64 / NW) + i; Wt[(size_t)(n0 + nl) * ldk + k0 + a] = f2bf(tl[a][nl]); }
        __syncthreads();
    }
}

__device__ __forceinline__ void quant_row(const float4 (&v)[4], unsigned char* __restrict__ dst, float* __restrict__ scl, int r, int lane) {
    float am = 0.f;
#pragma unroll
    for (int j = 0; j < 4; ++j) am = fmaxf(am, fmaxf(fmaxf(fabsf(v[j].x), fabsf(v[j].y)), fmaxf(fabsf(v[j].z), fabsf(v[j].w))));
#pragma unroll
    for (int m = 32; m >= 1; m >>= 1) am = fmaxf(am, __shfl_xor(am, m, 64));
    const float sc = (am > 0.f) ? am * (1.f / 448.f) : 1.f;
    const float is = 1.f / sc;
    uint4 o;
    { int w = 0; w = __builtin_amdgcn_cvt_pk_fp8_f32(v[0].x * is, v[0].y * is, w, false); w = __builtin_amdgcn_cvt_pk_fp8_f32(v[0].z * is, v[0].w * is, w, true); o.x = (unsigned)w; }
    { int w = 0; w = __builtin_amdgcn_cvt_pk_fp8_f32(v[1].x * is, v[1].y * is, w, false); w = __builtin_amdgcn_cvt_pk_fp8_f32(v[1].z * is, v[1].w * is, w, true); o.y = (unsigned)w; }
    { int w = 0; w = __builtin_amdgcn_cvt_pk_fp8_f32(v[2].x * is, v[2].y * is, w, false); w = __builtin_amdgcn_cvt_pk_fp8_f32(v[2].z * is, v[2].w * is, w, true); o.z = (unsigned)w; }
    { int w = 0; w = __builtin_amdgcn_cvt_pk_fp8_f32(v[3].x * is, v[3].y * is, w, false); w = __builtin_amdgcn_cvt_pk_fp8_f32(v[3].z * is, v[3].w * is, w, true); o.w = (unsigned)w; }
    { const int lay = r / NEXP, e = r % NEXP; *(uint4*)(dst + (((size_t)(lay * 8 + (lane >> 3)) * NEXP + e) * 128) + (lane & 7) * 16) = o; }
    if (lane == 0) scl[r] = sc;
}
__device__ __forceinline__ unsigned pack_i8x4(float a, float b, float c, float d) {
    const int ia = __float2int_rn(a), ib = __float2int_rn(b), ic = __float2int_rn(c), id = __float2int_rn(d);
    return (unsigned)(ia & 255) | ((unsigned)(ib & 255) << 8) | ((unsigned)(ic & 255) << 16) | ((unsigned)(id & 255) << 24);
}
__device__ __forceinline__ void quant_row_i8(const float4 (&v)[4], unsigned char* __restrict__ dst, float* __restrict__ scl, int r, int lane) {
    float am = 0.f;
#pragma unroll
    for (int j = 0; j < 4; ++j) am = fmaxf(am, fmaxf(fmaxf(fabsf(v[j].x), fabsf(v[j].y)), fmaxf(fabsf(v[j].z), fabsf(v[j].w))));
#pragma unroll
    for (int m = 32; m >= 1; m >>= 1) am = fmaxf(am, __shfl_xor(am, m, 64));
    const float sc = (am > 0.f) ? am * (1.f / 127.f) : 1.f;
    const float is = 1.f / sc;
    uint4 o;
    o.x = pack_i8x4(v[0].x * is, v[0].y * is, v[0].z * is, v[0].w * is); o.y = pack_i8x4(v[1].x * is, v[1].y * is, v[1].z * is, v[1].w * is);
    o.z = pack_i8x4(v[2].x * is, v[2].y * is, v[2].z * is, v[2].w * is); o.w = pack_i8x4(v[3].x * is, v[3].y * is, v[3].z * is, v[3].w * is);
    { const int lay = r / NEXP, e = r % NEXP; *(uint4*)(dst + (((size_t)(lay * 8 + (lane >> 3)) * NEXP + e) * 128) + (lane & 7) * 16) = o; }
    if (lane == 0) scl[r] = sc;
}
template <bool I8>
__device__ __forceinline__ void convert_table(const float* __restrict__ src, unsigned char* __restrict__ dst, float* __restrict__ scl, int rows) {
    static_assert(TAB_FP8, "fp8 tables");
    const int lane = tidx() & 63;
    const int nw = nwave();
    for (int r = gwave(); r < rows; r += 4 * nw) {
        float4 v[4][4]; int rr[4];
#pragma unroll
        for (int u = 0; u < 4; ++u) {
            rr[u] = (r + u * nw < rows) ? (r + u * nw) : r;
            const float4* s0 = (const float4*)(src + (size_t)rr[u] * D);
#pragma unroll
            for (int j = 0; j < 4; ++j) v[u][j] = s0[lane * 4 + j];
        }
#pragma unroll
        for (int u = 0; u < 4; ++u) {
            if (u == 0 || rr[u] != r) { if (I8) quant_row_i8(v[u], dst, scl, rr[u], lane); else quant_row(v[u], dst, scl, rr[u], lane); }
        }
    }
}
__device__ __forceinline__ void phase_prep(const Params& P, char* lds) {
    unsigned char* ws = P.ws;
    for (int l = 0; l < DEPTH; ++l) {
        transpose_tiled(P.w_in + (size_t)l * D * DIN, (bf16*)(ws + WS_WIN) + (size_t)l * DINP * LDW, D, DIN, DINP, LDW, nullptr, lds);
        transpose_tiled(P.w_uq + (size_t)l * QR * 768, (bf16*)(ws + WS_WUQ) + (size_t)l * 768 * QR, QR, 768, 768, QR, P.q_norm + l * QR, lds);
        transpose_tiled(P.w_uk + (size_t)l * KVR * 512, (bf16*)(ws + WS_WUKV) + (size_t)l * 1024 * KVR, KVR, 512, 512, KVR, P.kv_norm + l * KVR, lds);
        transpose_tiled(P.w_uv + (size_t)l * KVR * 512, (bf16*)(ws + WS_WUKV) + (size_t)l * 1024 * KVR + (size_t)512 * KVR, KVR, 512, 512, KVR, P.kv_norm + l * KVR, lds);
        transpose_tiled(P.w_out + (size_t)l * D * D, (bf16*)(ws + WS_WOUT) + (size_t)l * D * LDW, D, D, D, LDW, nullptr, lds);
    }
    {
        bf16* Wc = (bf16*)(ws + WS_WPQ);
        float (*As)[68] = (float (*)[68])lds;
        float (*Bs)[68] = (float (*)[68])(lds + 16 * 68 * 4);
        const int tid = tidx(), tx = tid & 15, ty = (tid >> 4) & 15;
        const int lr = (tid >> 2) & 63, ld4 = (tid & 3) * 4;
        for (int tile = blockIdx.x; tile < (DEPTH * 2048 / 64) * (D / 64); tile += gridDim.x) {
            const int row0 = (tile >> 4) * 64, k0 = (tile & 15) * 64;
            const int l = row0 >> 11, hp = (row0 >> 7) & 15, n0 = row0 & 127;
            const float* skp = P.peer_subkeys + (((size_t)l * 2 + (hp & 1)) * NKEY + n0 + lr) * 128 + ld4;
            const float* wqp = P.peer_wq + ((size_t)l * D + k0 + lr) * 2048 + hp * 128 + ld4;
            float acc[4][4];
#pragma unroll
            for (int i = 0; i < 4; ++i)
#pragma unroll
                for (int j = 0; j < 4; ++j) acc[i][j] = 0.f;
            for (int d0 = 0; d0 < 128; d0 += 16) {
                if (tid < 256) {
                    const float4 av = *(const float4*)(skp + d0), bv = *(const float4*)(wqp + d0);
                    As[ld4 + 0][lr] = av.x; As[ld4 + 1][lr] = av.y; As[ld4 + 2][lr] = av.z; As[ld4 + 3][lr] = av.w;
                    Bs[ld4 + 0][lr] = bv.x; Bs[ld4 + 1][lr] = bv.y; Bs[ld4 + 2][lr] = bv.z; Bs[ld4 + 3][lr] = bv.w;
                }
                __syncthreads();
#pragma unroll
                for (int kk = 0; kk < 16; ++kk) {
                    const float4 a4 = *(const float4*)&As[kk][ty * 4], b4 = *(const float4*)&Bs[kk][tx * 4];
                    const float aa[4] = {a4.x, a4.y, a4.z, a4.w}, bb[4] = {b4.x, b4.y, b4.z, b4.w};
#pragma unroll
                    for (int i = 0; i < 4; ++i)
#pragma unroll
                        for (int j = 0; j < 4; ++j) acc[i][j] = fmaf(aa[i], bb[j], acc[i][j]);
                }
                __syncthreads();
            }
            if (tid < 256) {
#pragma unroll
                for (int i = 0; i < 4; ++i) {
                    uint2 o; o.x = pack2(acc[i][0], acc[i][1]); o.y = pack2(acc[i][2], acc[i][3]);
                    *(uint2*)(Wc + (size_t)(row0 + ty * 4 + i) * LDW + k0 + tx * 4) = o;
                }
            }
        }
    }
    convert_table<true>(P.peer_u, ws + WS_TABU, (float*)(ws + WS_TSCU), DEPTH * NEXP);
    convert_table<false>(P.peer_v, ws + WS_TABV, (float*)(ws + WS_TSCV), DEPTH * NEXP);
    float* rope = (float*)(ws + WS_ROPE);
    for (size_t i = gtid(); i < (size_t)S * 16; i += gnth()) {
        const int s = (int)(i >> 4), f = (int)(i & 15);
        const double inv = pow(10000.0, -(double)f / 16.0);
        const double ang = (double)s * inv;
        rope[2 * i] = (float)cos(ang); rope[2 * i + 1] = (float)sin(ang);
    }
}

__device__ __forceinline__ void phase_norm(const float* __restrict__ h, const float* __restrict__ g, bf16* __restrict__ xn) {
    const int lane = tidx() & 63, nw = nwave();
    for (int t = gwave(); t < T; t += 2 * nw) {
        const int t2 = (t + nw < T) ? (t + nw) : t;
        float4 v[2][4];
#pragma unroll
        for (int j = 0; j < 4; ++j) { v[0][j] = ((const float4*)(h + (size_t)t * D))[j * 64 + lane]; v[1][j] = ((const float4*)(h + (size_t)t2 * D))[j * 64 + lane]; }
#pragma unroll
        for (int u = 0; u < 2; ++u) {
            float ss = 0.f;
#pragma unroll
            for (int j = 0; j < 4; ++j) ss += v[u][j].x * v[u][j].x + v[u][j].y * v[u][j].y + v[u][j].z * v[u][j].z + v[u][j].w * v[u][j].w;
            ss = wave_sum(ss);
            const float r = rsqrtf(ss * (1.f / D) + EPS);
            const int tt = u ? t2 : t;
            if (u == 0 || t2 != t) {
#pragma unroll
                for (int j = 0; j < 4; ++j) {
                    const float4 gg = ((const float4*)g)[j * 64 + lane];
                    uint2 o; o.x = pack2(v[u][j].x * r * gg.x, v[u][j].y * r * gg.y); o.y = pack2(v[u][j].z * r * gg.z, v[u][j].w * r * gg.w);
                    ((uint2*)(xn + (size_t)tt * LDX))[j * 64 + lane] = o;
                }
            }
        }
    }
}

__device__ __forceinline__ void phase_norm_q(const Params& P, int l) {
    const int lane = tidx() & 63, nw = nwave();
    const float* g = P.norm_ffn + l * D;
    bf16* xn = (bf16*)(P.ws + WS_XN);
    unsigned* xq = (unsigned*)(P.ws + WS_XQ);
    float* xsc = (float*)(P.ws + WS_XS);
    for (int t = gwave(); t < T; t += 2 * nw) {
        const int t2 = (t + nw < T) ? (t + nw) : t;
        float4 v[2][4];
#pragma unroll
        for (int j = 0; j < 4; ++j) { v[0][j] = ((const float4*)(P.out + (size_t)t * D))[j * 64 + lane]; v[1][j] = ((const float4*)(P.out + (size_t)t2 * D))[j * 64 + lane]; }
#pragma unroll
        for (int u = 0; u < 2; ++u) {
            float ss = 0.f;
#pragma unroll
            for (int j = 0; j < 4; ++j) ss += v[u][j].x * v[u][j].x + v[u][j].y * v[u][j].y + v[u][j].z * v[u][j].z + v[u][j].w * v[u][j].w;
            ss = wave_sum(ss);
            const float r = rsqrtf(ss * (1.f / D) + EPS);
            const int tt = u ? t2 : t;
            if (u == 0 || t2 != t) {
                float am = 0.f;
#pragma unroll
                for (int j = 0; j < 4; ++j) {
                    const float4 gg = ((const float4*)g)[j * 64 + lane];
                    v[u][j].x *= r * gg.x; v[u][j].y *= r * gg.y; v[u][j].z *= r * gg.z; v[u][j].w *= r * gg.w;
                    am = fmaxf(am, fmaxf(fmaxf(fabsf(v[u][j].x), fabsf(v[u][j].y)), fmaxf(fabsf(v[u][j].z), fabsf(v[u][j].w))));
                    uint2 o; o.x = pack2(v[u][j].x, v[u][j].y); o.y = pack2(v[u][j].z, v[u][j].w);
                    ((uint2*)(xn + (size_t)tt * LDX))[j * 64 + lane] = o;
                }
#pragma unroll
                for (int m = 32; m >= 1; m >>= 1) am = fmaxf(am, __shfl_xor(am, m, 64));
                const float sc = (am > 0.f) ? am * (1.f / 127.f) : 1.f, is = 1.f / sc;
#pragma unroll
                for (int j = 0; j < 4; ++j) xq[(size_t)tt * (D / 4) + j * 64 + lane] = pack_i8x4(v[u][j].x * is, v[u][j].y * is, v[u][j].z * is, v[u][j].w * is);
                if (lane == 0) xsc[tt] = sc;
            }
        }
    }
}

__device__ __forceinline__ void phase_mixlocal(const Params& P, int l, char* lds) {
    const bf16* proj = (const bf16*)(P.ws + WS_PROJ);
    bf16* Y = (bf16*)(P.ws + WS_XN);
    const int tid = tidx();
    {
        const float* cw = P.conv_w + (size_t)l * 3 * 256;
        for (size_t i = gtid(); i < (size_t)T * 32; i += gnth()) {
            const int t = (int)(i >> 5), c0 = (int)(i & 31) * 8, s = t & (S - 1);
            const bf16* pr = proj + (size_t)t * DINP;
            float acc[8];
#pragma unroll
            for (int e = 0; e < 8; ++e) acc[e] = 0.f;
#pragma unroll
            for (int j = 0; j < 3; ++j) {
                if (s - 2 + j >= 0) {
                    const bf16* pp = pr - (size_t)(2 - j) * DINP;
                    const uint4 g = *(const uint4*)(pp + C_CG + c0), hc = *(const uint4*)(pp + C_HC + c0);
                    const float4 w0 = *(const float4*)(cw + j * 256 + c0), w1 = *(const float4*)(cw + j * 256 + c0 + 4);
                    acc[0] = fmaf(w0.x, bflo(g.x) * bflo(hc.x), acc[0]); acc[1] = fmaf(w0.y, bfhi(g.x) * bfhi(hc.x), acc[1]);
                    acc[2] = fmaf(w0.z, bflo(g.y) * bflo(hc.y), acc[2]); acc[3] = fmaf(w0.w, bfhi(g.y) * bfhi(hc.y), acc[3]);
                    acc[4] = fmaf(w1.x, bflo(g.z) * bflo(hc.z), acc[4]); acc[5] = fmaf(w1.y, bfhi(g.z) * bfhi(hc.z), acc[5]);
                    acc[6] = fmaf(w1.z, bflo(g.w) * bflo(hc.w), acc[6]); acc[7] = fmaf(w1.w, bfhi(g.w) * bfhi(hc.w), acc[7]);
                }
            }
            const uint4 bg = *(const uint4*)(pr + C_BG + c0);
            uint4 o;
            o.x = pack2(bflo(bg.x) * acc[0], bfhi(bg.x) * acc[1]); o.y = pack2(bflo(bg.y) * acc[2], bfhi(bg.y) * acc[3]);
            o.z = pack2(bflo(bg.z) * acc[4], bfhi(bg.z) * acc[5]); o.w = pack2(bflo(bg.w) * acc[6], bfhi(bg.w) * acc[7]);
            *(uint4*)(Y + (size_t)t * LDX + c0) = o;
        }
    }
    {
        float (*pl)[68] = (float (*)[68])lds;
        const float* pw = P.pool_w + (size_t)l * 4 * 64 * 64;
        const float* psc = P.pool_scale + l * 256;
        const int a = tid & 63, q = tid >> 6;
        for (int tile = blockIdx.x; tile < (T / (16 * NW)) * 4; tile += gridDim.x) {
            const int g = tile & 3, t0 = (tile >> 2) * (16 * NW);
            const int w = 2 << g;
            {
                const bf16* col = proj + C_HP + g * 64 + a;
                const int tf = t0 + q * 16, sf = tf & (S - 1);
                float xr[31];
#pragma unroll
                for (int d = 1; d <= 15; ++d) xr[15 - d] = (d < w && sf - d >= 0) ? bf2f(col[(size_t)(tf - d) * DINP]) : 0.f;
#pragma unroll
                for (int i = 0; i < 16; ++i) xr[15 + i] = bf2f(col[(size_t)(tf + i) * DINP]);
                float sum = 0.f;
#pragma unroll
                for (int d = 1; d <= 15; ++d) sum += xr[15 - d];
#pragma unroll
                for (int i = 0; i < 16; ++i) {
                    const int s = sf + i;
                    sum += xr[15 + i];
                    const int cnt = (s + 1 < w) ? (s + 1) : w;
                    pl[q * 16 + i][a] = sum / (float)cnt - xr[15 + i];
                    const int o = 15 + i + 1;
                    const float old = (g == 0) ? xr[o - 2] : (g == 1) ? xr[o - 4] : (g == 2) ? xr[o - 8] : xr[o - 16];
                    sum -= old;
                }
            }
            __syncthreads();
            {
                float pc[64];
#pragma unroll
                for (int c = 0; c < 64; ++c) pc[c] = pw[(g * 64 + c) * 64 + a];
                const float sc = psc[g * 64 + a];
#pragma unroll 2
                for (int i = 0; i < 16; ++i) {
                    const float4* row = (const float4*)&pl[q * 16 + i][0];
                    float m0 = 0.f, m1 = 0.f;
#pragma unroll
                    for (int c4 = 0; c4 < 16; ++c4) { const float4 v = row[c4]; m0 = fmaf(v.x, pc[4 * c4], m0); m1 = fmaf(v.y, pc[4 * c4 + 1], m1); m0 = fmaf(v.z, pc[4 * c4 + 2], m0); m1 = fmaf(v.w, pc[4 * c4 + 3], m1); }
                    Y[(size_t)(t0 + q * 16 + i) * LDX + 256 + g * 64 + a] = f2bf((m0 + m1) * sc);
                }
            }
            __syncthreads();
        }
    }
}

typedef short v4i16_t __attribute__((ext_vector_type(4)));
typedef __attribute__((address_space(3))) v4i16_t* lds_v4p;
__device__ __forceinline__ v4i16_t vtr(const char* p) { return __builtin_amdgcn_ds_read_tr16_b64_v4i16((lds_v4p)p); }
constexpr int A_KP = 208, A_VP = 192;
constexpr int A_KB = 64 * A_KP, A_VB = 64 * A_VP, A_BUF = A_KB + A_VB, ATTN_LDS = 2 * A_BUF;
static_assert(ATTN_LDS <= LDS_TOTAL, "attention LDS");

__device__ __forceinline__ void attn_unit(const bf16* __restrict__ Qb, const bf16* __restrict__ Kb, const bf16* __restrict__ Vb, bf16* __restrict__ Y, int bh, int qblk, char* lds) {
    const int tid = tidx(), lane = tid & 63, w = tid >> 6, r32 = lane & 31, hi = lane >> 5;
    const int q0 = qblk * (32 * NW), qw0 = q0 + w * 32;
    const int NT = (q0 + 32 * NW) / 64;
    bf16x8 qf[6];
    {
        const bf16* qp = Qb + ((size_t)bh * S + qw0 + r32) * DQK + hi * 8;
#pragma unroll
        for (int ks = 0; ks < 6; ++ks) qf[ks] = *(const bf16x8*)(qp + ks * 16);
    }
    f32x16 o0, o1;
#pragma unroll
    for (int r = 0; r < 16; ++r) { o0[r] = 0.f; o1[r] = 0.f; }
    float m = -1e30f, lsum = 0.f;
    const int t8 = tid & 255; const bool isv = tid >= 256;
    const char* Tg = isv ? (const char*)(Vb + (size_t)bh * S * DV) : (const char*)(Kb + (size_t)bh * S * DQK);
    const int Ts = isv ? (64 * 128) : (64 * 192);
    const int g0 = t8 * 16, g1 = (t8 + 256) * 16, g2 = isv ? g1 : (t8 + 512) * 16;
    const int l0 = isv ? (A_KB + (t8 >> 3) * A_VP + (t8 & 7) * 16) : ((t8 / 12) * A_KP + (t8 % 12) * 16);
    const int l1 = isv ? (l0 + 32 * A_VP) : (((t8 + 256) / 12) * A_KP + ((t8 + 256) % 12) * 16);
    const int l2 = isv ? l1 : (((t8 + 512) / 12) * A_KP + ((t8 + 512) % 12) * 16);
    uint4 pk0, pk1, pk2, qk0, qk1, qk2;
#define A_LOAD(S, t) do { const char* tg = Tg + (size_t)(t) * Ts; S##k0 = *(const uint4*)(tg + g0); S##k1 = *(const uint4*)(tg + g1); S##k2 = *(const uint4*)(tg + g2); } while (0)
#define A_STORE(S, bK, bV) do { *(uint4*)(bK + l0) = S##k0; *(uint4*)(bK + l1) = S##k1; *(uint4*)(bK + l2) = S##k2; } while (0)
#define A_PV(pf, kofs) do { \
            { const v4i16_t lo = vtr(pv + (kofs) * A_VP), hh = vtr(pv + ((kofs) + 8) * A_VP); const bf16x8 vf = {lo[0], lo[1], lo[2], lo[3], hh[0], hh[1], hh[2], hh[3]}; o0 = MFMA32(vf, pf.v, o0); } \
            { const v4i16_t lo = vtr(pv + (kofs) * A_VP + 64), hh = vtr(pv + ((kofs) + 8) * A_VP + 64); const bf16x8 vf = {lo[0], lo[1], lo[2], lo[3], hh[0], hh[1], hh[2], hh[3]}; o1 = MFMA32(vf, pf.v, o1); } } while (0)
    const int pvo = (4 * hi + ((lane & 15) >> 2)) * A_VP + (16 * ((lane >> 4) & 1) + 4 * (lane & 3)) * 2;
    A_LOAD(p, 0); A_LOAD(q, 1);
    for (int t2 = 0; t2 < NT; t2 += 2) {
#pragma unroll
        for (int half = 0; half < 2; ++half) {
            const int t = t2 + half;
            char* bK = lds + half * A_BUF; char* bV = bK + A_KB;
            if (half == 0) A_STORE(p, bK, bV); else A_STORE(q, bK, bV);
            __syncthreads();
            { const int tn = (t + 2 < NT) ? (t + 2) : (NT - 2 + half); if (half == 0) A_LOAD(p, tn); else A_LOAD(q, tn); }
        const int kt0 = t * 64;
        if (kt0 <= qw0) {
            f32x16 s0, s1;
#pragma unroll
            for (int r = 0; r < 16; ++r) { s0[r] = 0.f; s1[r] = 0.f; }
            const char* pk = bK + r32 * A_KP + hi * 16;
#pragma unroll
            for (int ks = 0; ks < 6; ++ks) {
                const bf16x8 a0 = *(const bf16x8*)(pk + ks * 32), a1 = *(const bf16x8*)(pk + 32 * A_KP + ks * 32);
                s0 = MFMA32(a0, qf[ks], s0); s1 = MFMA32(a1, qf[ks], s1);
            }
            if (kt0 + 63 > qw0) {
                const int qrow = qw0 + r32;
#pragma unroll
                for (int r = 0; r < 16; ++r) { const int key = kt0 + crow(r, hi); if (key > qrow) s0[r] = -INFINITY; if (key + 32 > qrow) s1[r] = -INFINITY; }
            }
            float mx = fmaxf(s0[0], s1[0]);
#pragma unroll
            for (int r = 1; r < 16; ++r) mx = fmaxf(mx, fmaxf(s0[r], s1[r]));
            mx = fmaxf(mx, __shfl_xor(mx, 32, 64));
            const float mn = fmaxf(m, mx), m_prev = m;
            const float alpha = __builtin_amdgcn_exp2f(m - mn);
            m = mn;
            float ps = 0.f;
#pragma unroll
            for (int r = 0; r < 16; ++r) { s0[r] = __builtin_amdgcn_exp2f(s0[r] - mn); s1[r] = __builtin_amdgcn_exp2f(s1[r] - mn); ps += s0[r] + s1[r]; }
            if (__builtin_amdgcn_ballot_w64(mn > m_prev) != 0ull) {
                lsum *= alpha;
#pragma unroll
                for (int r = 0; r < 16; ++r) { o0[r] *= alpha; o1[r] *= alpha; }
            }
            lsum += ps;
            union { unsigned u[4]; bf16x8 v; } p00, p01, p10, p11;
#pragma unroll
            for (int j = 0; j < 4; ++j) { p00.u[j] = cvtpk(s0[2 * j], s0[2 * j + 1]); p01.u[j] = cvtpk(s0[8 + 2 * j], s0[9 + 2 * j]); p10.u[j] = cvtpk(s1[2 * j], s1[2 * j + 1]); p11.u[j] = cvtpk(s1[8 + 2 * j], s1[9 + 2 * j]); }
            const char* pv = bV + pvo;
            A_PV(p00, 0); A_PV(p01, 16); A_PV(p10, 32); A_PV(p11, 48);
        }
        }
    }
    lsum += __shfl_xor(lsum, 32, 64);
    const float inv = 1.f / lsum;
    const int b = bh >> 3, h = bh & 7;
    bf16* yo = Y + (size_t)(b * S + qw0 + r32) * LDX + 512 + h * 64 + 4 * hi;
#pragma unroll
    for (int g = 0; g < 4; ++g) {
        uint2 a, c;
        a.x = cvtpk(o0[4 * g] * inv, o0[4 * g + 1] * inv); a.y = cvtpk(o0[4 * g + 2] * inv, o0[4 * g + 3] * inv);
        c.x = cvtpk(o1[4 * g] * inv, o1[4 * g + 1] * inv); c.y = cvtpk(o1[4 * g + 2] * inv, o1[4 * g + 3] * inv);
        *(uint2*)(yo + 8 * g) = a; *(uint2*)(yo + 32 + 8 * g) = c;
    }
    __syncthreads();
}
__device__ __forceinline__ void phase_attn(const Params& P, char* lds) {
    const bf16* Qb = (const bf16*)(P.ws + WS_Q);
    const bf16* Kb = (const bf16*)(P.ws + WS_K);
    const bf16* Vb = (const bf16*)(P.ws + WS_V);
    bf16* Y = (bf16*)(P.ws + WS_XN);
    for (int u = blockIdx.x; u < NB * NH * (S / 256); u += gridDim.x) {
        const int bh = u & 31, v = u >> 5;
        const int qblk = (v < 8) ? (31 - v) : (v < 16) ? (v - 8) : (v < 24) ? (39 - v) : (v - 16);
        attn_unit(Qb, Kb, Vb, Y, bh, qblk, lds);
    }
}

#define NET_HD __device__ __forceinline__
#define NET_U2F(u) __uint_as_float(u)
#define NET_F2U(f) __float_as_uint(f)
#define CE_DESC(a, b) do { const float hi__ = fmaxf(a, b), lo__ = fminf(a, b); a = hi__; b = lo__; } while (0)
NET_HD void sort16_desc(float (&v)[16]) {
#define CE2(a, b) CE_DESC(v[a], v[b])
    CE2(0,13); CE2(1,12); CE2(2,15); CE2(3,14); CE2(4,8); CE2(5,6); CE2(7,11); CE2(9,10);
    CE2(0,5); CE2(1,7); CE2(2,9); CE2(3,4); CE2(6,13); CE2(8,14); CE2(10,15); CE2(11,12);
    CE2(0,1); CE2(2,3); CE2(4,5); CE2(6,8); CE2(7,9); CE2(10,11); CE2(12,13); CE2(14,15);
    CE2(0,2); CE2(1,3); CE2(4,10); CE2(5,11); CE2(6,7); CE2(8,9); CE2(12,14); CE2(13,15);
    CE2(1,2); CE2(3,12); CE2(4,6); CE2(5,7); CE2(8,10); CE2(9,11); CE2(13,14);
    CE2(1,4); CE2(2,6); CE2(5,8); CE2(7,10); CE2(9,13); CE2(11,14);
    CE2(2,4); CE2(3,6); CE2(9,12); CE2(11,13);
    CE2(3,5); CE2(6,8); CE2(7,9); CE2(10,12);
    CE2(3,4); CE2(5,6); CE2(7,8); CE2(9,10); CE2(11,12);
    CE2(6,7); CE2(8,9);
#undef CE2
}
NET_HD void merge16_desc(float (&a)[16], const float (&b)[16]) {
#pragma unroll
    for (int i = 0; i < 16; ++i) a[i] = fmaxf(a[i], b[15 - i]);
#pragma unroll
    for (int j = 8; j > 0; j >>= 1) {
#pragma unroll
        for (int i = 0; i < 16; ++i) { const int l = i ^ j; if (l > i) CE_DESC(a[i], a[l]); }
    }
}
NET_HD void top16_of_64(float (&g0)[16], float (&g1)[16], float (&g2)[16], float (&g3)[16]) {
    sort16_desc(g0); sort16_desc(g1); sort16_desc(g2); sort16_desc(g3);
    merge16_desc(g0, g1); merge16_desc(g2, g3); merge16_desc(g0, g2);
}
NET_HD float u2f(unsigned u) { return NET_U2F(u); }
NET_HD unsigned f2u(float f) { return NET_F2U(f); }
template <class V16>
NET_HD void lane_top16(const V16& s0, const V16& s1, const V16& s2, const V16& s3, int hi, float (&out)[16]) {
    float g0[16], g1[16], g2[16], g3[16];
#pragma unroll
    for (int r = 0; r < 16; ++r) {
        const unsigned nb = (unsigned)((r & 3) + 8 * (r >> 2));
        g0[r] = u2f((f2u(s0[r]) & 0xFFFFFF80u) | nb); g1[r] = u2f((f2u(s1[r]) & 0xFFFFFF80u) | (nb + 32u));
        g2[r] = u2f((f2u(s2[r]) & 0xFFFFFF80u) | (nb + 64u)); g3[r] = u2f((f2u(s3[r]) & 0xFFFFFF80u) | (nb + 96u));
    }
    top16_of_64(g0, g1, g2, g3);
    const unsigned h4 = (unsigned)hi << 2;
#pragma unroll
    for (int i = 0; i < 16; ++i) out[i] = u2f(f2u(g0[i]) | h4);
}
constexpr int cand_slot(int a, int b) { int n = 0; for (int x = 0; x < 16; ++x) for (int y = 0; y < 16; ++y) { if (x == a && y == b) return n; if ((x + 1) * (y + 1) <= 16) ++n; } return n; }
NET_HD void cand_top16(const float (&s1)[16], const float (&s2)[16], float (&c)[16]) {
    float g0[16], g1[16], g2[16], g3[16];
#pragma unroll
    for (int i = 0; i < 16; ++i) { g0[i] = -3.0e38f; g1[i] = -3.0e38f; g2[i] = -3.0e38f; g3[i] = -3.0e38f; }
#pragma unroll
    for (int a = 0; a < 16; ++a) {
#pragma unroll
        for (int b = 0; b < 16; ++b) {
            if ((a + 1) * (b + 1) <= 16) {
                const int sl = cand_slot(a, b);
                const float v = u2f((f2u(s1[a] + s2[b]) & 0xFFFFFF00u) | (unsigned)(a * 16 + b));
                if (sl < 16) g0[sl & 15] = v; else if (sl < 32) g1[sl & 15] = v; else if (sl < 48) g2[sl & 15] = v; else g3[sl & 15] = v;
            }
        }
    }
    top16_of_64(g0, g1, g2, g3);
#pragma unroll
    for (int i = 0; i < 16; ++i) c[i] = g0[i];
}

__device__ __forceinline__ void phase_route(const Params& P, int l, char* lds) {
    const bf16* XN = (const bf16*)(P.ws + WS_XN);
    const bf16* Wc = (const bf16*)(P.ws + WS_WPQ) + (size_t)l * 2048 * LDW;
    int* EXPp = (int*)(P.ws + WS_EXP);
    float* GATEp = (float*)(P.ws + WS_GATE);
    const int tid = tidx();
    float* xch = (float*)(lds + 16384);
    int tlo, thi, tst; tile_rounds((T / 256) * PH, tlo, thi, tst);
    int nt = D / 64; asm volatile("" : "+s"(nt));
    for (int u = tlo; u < thi; u += tst) {
        const int tm = u >> 3, h = u & 7;
        float Lk[16];
        {
            f32x4 acc[2][2][4][2]; float ssd[2][2];
            gemm8_kloop<false, true>(Wc + (size_t)(h * 256) * LDW, LDW, XN + (size_t)(tm * 256) * LDX, LDX, nt, acc, ssd, lds, tid);
            const int te = tidx(), fq = (te >> 4) & 3;
            const unsigned fqb = (unsigned)fq << 2;
#pragma unroll
            for (int i = 0; i < 16; ++i) Lk[i] = 0.f;
#pragma unroll
            for (int bj = 0; bj < 2; ++bj)
#pragma unroll
                for (int n = 0; n < 2; ++n) {
                    float g0[16], g1[16];
#pragma unroll
                    for (int m = 0; m < 4; ++m)
#pragma unroll
                        for (int j = 0; j < 4; ++j) {
                            const unsigned kb = (unsigned)(m * 16 + j) | fqb;
                            g0[m * 4 + j] = u2f((f2u(acc[0][bj][m][n][j]) & 0xFFFFFF80u) | kb);
                            g1[m * 4 + j] = u2f((f2u(acc[1][bj][m][n][j]) & 0xFFFFFF80u) | (kb + 64u));
                        }
                    sort16_desc(g0); sort16_desc(g1); merge16_desc(g0, g1);
                    float o[16];
#pragma unroll
                    for (int i = 0; i < 16; ++i) o[i] = __shfl_xor(g0[i], 16, 64);
                    merge16_desc(g0, o);
#pragma unroll
                    for (int i = 0; i < 16; ++i) o[i] = __shfl_xor(g0[i], 32, 64);
                    merge16_desc(g0, o);
                    const bool mine = fq == bj * 2 + n;
#pragma unroll
                    for (int i = 0; i < 16; ++i) Lk[i] = mine ? g0[i] : Lk[i];
                }
        }
        __syncthreads();
        const int te = tidx(), lane = te & 63, w = te >> 6, wr = w >> 2, wc = w & 3, fr = lane & 15, fq = lane >> 4;
        if (wr == 1) {
#pragma unroll
            for (int q = 0; q < 4; ++q) *(float4*)(xch + ((wc * 64 + lane) * 16) + 4 * q) = make_float4(Lk[4 * q], Lk[4 * q + 1], Lk[4 * q + 2], Lk[4 * q + 3]);
        }
        __syncthreads();
        if (wr == 0) {
            float L1[16];
#pragma unroll
            for (int q = 0; q < 4; ++q) { const float4 v = *(const float4*)(xch + ((wc * 64 + lane) * 16) + 4 * q); L1[4 * q] = v.x; L1[4 * q + 1] = v.y; L1[4 * q + 2] = v.z; L1[4 * q + 3] = v.w; }
            float c[16];
            cand_top16(Lk, L1, c);
            unsigned char* my = (unsigned char*)lds + te * 32;
            {
                uint4 a, b;
#define PK4(L, i) ((__float_as_uint(L[i]) & 127u) | ((__float_as_uint(L[i + 1]) & 127u) << 8) | ((__float_as_uint(L[i + 2]) & 127u) << 16) | ((__float_as_uint(L[i + 3]) & 127u) << 24))
                a.x = PK4(Lk, 0); a.y = PK4(Lk, 4); a.z = PK4(Lk, 8); a.w = PK4(Lk, 12);
                b.x = PK4(L1, 0); b.y = PK4(L1, 4); b.z = PK4(L1, 8); b.w = PK4(L1, 12);
#undef PK4
                *(uint4*)my = a; *(uint4*)(my + 16) = b;
            }
            int ev[16]; float gv[16]; float den = 0.f;
#pragma unroll
            for (int k = 0; k < 16; ++k) {
                const unsigned ci = __float_as_uint(c[k]) & 255u;
                const int n1 = my[ci >> 4], n2 = my[16 + (ci & 15)];
                ev[k] = n1 * NKEY + n2;
                gv[k] = __expf(c[k] - c[0]); den += gv[k];
            }
            const float iden = 1.f / den;
            const int t = tm * 256 + (fq >> 1) * 128 + wc * 32 + (fq & 1) * 16 + fr;
            uint4* ep = (uint4*)(EXPp + (size_t)t * HK + h * 16);
            float4* gp = (float4*)(GATEp + (size_t)t * HK + h * 16);
#pragma unroll
            for (int q = 0; q < 4; ++q) {
                ep[q] = make_uint4((unsigned)ev[4 * q], (unsigned)ev[4 * q + 1], (unsigned)ev[4 * q + 2], (unsigned)ev[4 * q + 3]);
                gp[q] = make_float4(gv[4 * q] * iden, gv[4 * q + 1] * iden, gv[4 * q + 2] * iden, gv[4 * q + 3] * iden);
            }
        }
        __syncthreads();
    }
}

constexpr size_t WS_PART = WS_PROJ;
static_assert((size_t)8 * T * HK * 4 <= WS_K - WS_PROJ, "PART alias");
constexpr int XI_X = 0, XI_RANK = 1, XI_J = 2, XI_NX = 3, XI_NLOC = 4;
constexpr int CTL_CENSUS = 4096;
constexpr int CTL_BYTES = (CTL_CENSUS + 16) * 4;

template <int M1, int M2, int M3, class TT>
__device__ __forceinline__ void red16x3(TT (&p)[16], int lane) {
#pragma unroll
    for (int i = 0; i < 8; ++i) { const bool up = lane & M1; const TT send = up ? p[i] : p[i + 8], keep = up ? p[i + 8] : p[i]; p[i] = keep + __shfl_xor(send, M1, 64); }
#pragma unroll
    for (int i = 0; i < 4; ++i) { const bool up = lane & M2; const TT send = up ? p[i] : p[i + 4], keep = up ? p[i + 4] : p[i]; p[i] = keep + __shfl_xor(send, M2, 64); }
#pragma unroll
    for (int i = 0; i < 2; ++i) { const bool up = lane & M3; const TT send = up ? p[i] : p[i + 2], keep = up ? p[i + 2] : p[i]; p[i] = keep + __shfl_xor(send, M3, 64); }
}
__device__ __forceinline__ void phase_gu(const Params& P, int l, const volatile int* xi) {
    const unsigned char* XQ = P.ws + WS_XQ;
    const float* XSc = (const float*)(P.ws + WS_XS);
    const int* EXPp = (const int*)(P.ws + WS_EXP);
    float* PART = (float*)(P.ws + WS_PART);
    const int tid = tidx(), lane = tid & 63, w = tid >> 6, g = lane >> 3, c = lane & 7;
    int xo_ = 0; asm volatile("" : "+v"(xo_));
    const int j = __builtin_amdgcn_readfirstlane(xi[xo_ + XI_J]), nx = __builtin_amdgcn_readfirstlane(xi[xo_ + XI_NX]), nloc = __builtin_amdgcn_readfirstlane(xi[xo_ + XI_NLOC]), rank = __builtin_amdgcn_readfirstlane(xi[xo_ + XI_RANK]);
    const int t0 = rank * NW + w, st = nloc * NW;
    const int n = (t0 < T) ? (T - t0 + st - 1) / st : 0;
    const int i0 = 8 * (c & 1) + 4 * ((c >> 1) & 1) + 2 * ((c >> 2) & 1);
    for (int sl = j; sl < 8 && n > 0; sl += nx) {
        const unsigned char* Us = P.ws + WS_TABU + ((size_t)(l * 8 + sl) * NEXP) * 128;
        const unsigned co = (unsigned)c << 4;
        float* part = PART + (size_t)sl * T * HK;
        const unsigned char* xs = XQ + sl * 128 + c * 16;
#define GU_TK(k) (t0 + (((k) < n) ? (k) : (n - 1)) * st)
#define GU_LOADE(S, t) do { S##lo = EXPp[(size_t)(t) * HK + lane]; S##hi = EXPp[(size_t)(t) * HK + 64 + lane]; } while (0)
#define GU_LOADX(S, t) do { S##a = *(const uint4*)(xs + (size_t)(t) * D); S##s = XSc[t]; } while (0)
#define GU_ISSUE(R, S) do { _Pragma("unroll") for (int i = 0; i < 16; ++i) { \
            const int e = __builtin_amdgcn_ds_bpermute((((8 * i) & 63) + g) << 2, (i < 8) ? S##lo : S##hi); R[i] = *(const uint4*)(Us + (((unsigned)e << 7) | co)); } } while (0)
#define GU_FINISH(R, S, t) do { \
            int p[16]; \
            _Pragma("unroll") for (int i = 0; i < 16; ++i) { int d_ = __builtin_amdgcn_sdot4((int)S##a.x, (int)R[i].x, 0, false); d_ = __builtin_amdgcn_sdot4((int)S##a.y, (int)R[i].y, d_, false); \
                d_ = __builtin_amdgcn_sdot4((int)S##a.z, (int)R[i].z, d_, false); p[i] = __builtin_amdgcn_sdot4((int)S##a.w, (int)R[i].w, d_, false); } \
            red16x3<1, 2, 4, int>(p, lane); \
            part[(size_t)(t) * HK + 8 * i0 + g] = (float)p[0] * S##s; part[(size_t)(t) * HK + 8 * (i0 + 1) + g] = (float)p[1] * S##s; } while (0)
        int eAlo, eAhi, eBlo, eBhi; uint4 xAa, xBa; float xAs, xBs; uint4 rA[16], rB[16];
        GU_LOADE(eA, GU_TK(0)); GU_LOADX(xA, GU_TK(0)); GU_LOADE(eB, GU_TK(1));
        GU_ISSUE(rA, eA);
        for (int k = 0; k < n; k += 2) {
            GU_LOADX(xB, GU_TK(k + 1)); GU_ISSUE(rB, eB); GU_LOADE(eA, GU_TK(k + 2));
            GU_FINISH(rA, xA, GU_TK(k));
            GU_LOADX(xA, GU_TK(k + 2)); GU_ISSUE(rA, eA); GU_LOADE(eB, GU_TK(k + 3));
            GU_FINISH(rB, xB, GU_TK(k + 1));
        }
#undef GU_TK
#undef GU_LOADE
#undef GU_LOADX
#undef GU_ISSUE
#undef GU_FINISH
    }
}
__device__ __forceinline__ void phase_gw(const Params& P, int l) {
    const int* EXPp = (const int*)(P.ws + WS_EXP);
    const float* GATEp = (const float*)(P.ws + WS_GATE);
    const float* PART = (const float*)(P.ws + WS_PART);
    const float* SU = (const float*)(P.ws + WS_TSCU) + (size_t)l * NEXP;
    const float* SV = (const float*)(P.ws + WS_TSCV) + (size_t)l * NEXP;
    unsigned char* WQ = P.ws + WS_WQ8;
    float* WSC = (float*)(P.ws + WS_WSC);
    const int lane = tidx() & 63;
    for (int tb = gwave() * 4; tb < T; tb += nwave() * 4) {
        float wv[4][2];
#pragma unroll
        for (int q = 0; q < 4; ++q)
#pragma unroll
            for (int hk = 0; hk < 2; ++hk) {
                const size_t i = (size_t)(tb + q) * HK + hk * 64 + lane;
                float s = 0.f;
#pragma unroll
                for (int x = 0; x < 8; ++x) s += PART[(size_t)x * T * HK + i];
                const int e = EXPp[i];
                wv[q][hk] = GATEp[i] * gelu_exact(s * SU[e]) * SV[e];
            }
#pragma unroll
        for (int q = 0; q < 4; ++q) {
            float am = fmaxf(fabsf(wv[q][0]), fabsf(wv[q][1]));
#pragma unroll
            for (int m = 32; m >= 1; m >>= 1) am = fmaxf(am, __shfl_xor(am, m, 64));
            const float sc = (am > 0.f) ? am * (1.f / 448.f) : 1.f, is = 1.f / sc;
            const int pk = __builtin_amdgcn_cvt_pk_fp8_f32(wv[q][0] * is, wv[q][1] * is, 0, false);
            WQ[(size_t)(tb + q) * HK + lane] = (unsigned char)(pk & 255);
            WQ[(size_t)(tb + q) * HK + 64 + lane] = (unsigned char)((pk >> 8) & 255);
            if (lane == 0) WSC[tb + q] = sc;
        }
    }
}
typedef int v2i_t __attribute__((ext_vector_type(2)));
typedef unsigned u32x4_t __attribute__((ext_vector_type(4)));
typedef __attribute__((ext_vector_type(4))) float f32x4;
constexpr int GV_PIECE = 1024 + 16;
constexpr int GV_TILE = 16 * GV_PIECE;
static_assert(NW * GV_TILE + NW * 512 <= LDS_TOTAL, "gv LDS");
__device__ __forceinline__ void phase_gv(const Params& P, int l, const volatile int* xi, char* lds) {
    const int* EXPp = (const int*)(P.ws + WS_EXP);
    const unsigned char* WQ = P.ws + WS_WQ8;
    const float* WSC = (const float*)(P.ws + WS_WSC);
    const int tid = tidx(), lane = tid & 63, w = __builtin_amdgcn_readfirstlane(tid >> 6), g = lane >> 3, pos = lane & 7;
    int xo_ = 0; asm volatile("" : "+v"(xo_));
    const int j = __builtin_amdgcn_readfirstlane(xi[xo_ + XI_J]), nx = __builtin_amdgcn_readfirstlane(xi[xo_ + XI_NX]), nloc = __builtin_amdgcn_readfirstlane(xi[xo_ + XI_NLOC]), rank = __builtin_amdgcn_readfirstlane(xi[xo_ + XI_RANK]);
    const int t0 = rank * NW + w, st = nloc * NW;
    const int n = (t0 < T) ? (T - t0 + st - 1) / st : 0;
    char* tile = lds + w * GV_TILE;
    float* strip = (float*)(lds + NW * GV_TILE) + w * 128;
    typedef __attribute__((address_space(3))) v2i_t* ldsv2_t;
    const unsigned co = (unsigned)(pos ^ g) << 4;
    const int rr = (lane & 15) >> 1, kq = lane >> 4;
    const int rdo = kq * GV_PIECE + rr * 128 + (lane & 1) * 8;
    const bool row0 = (lane & 15) == 0;
    __syncthreads();
    for (int sl = j; sl < 8 && n > 0; sl += nx) {
        const unsigned char* Vs = P.ws + WS_TABV + ((size_t)(l * 8 + sl) * NEXP) * 128;
        float* hrow = P.out + sl * 128 + 2 * lane;
#define GV_TK(k) (t0 + (((k) < n) ? (k) : (n - 1)) * st)
#define GV_LOADE(S, t) do { S##el = EXPp[(size_t)(t) * HK + lane]; S##eh = EXPp[(size_t)(t) * HK + 64 + lane]; } while (0)
#define GV_ISSUE(R, S) do { _Pragma("unroll") for (int i = 0; i < 16; ++i) { \
            const int e = __builtin_amdgcn_ds_bpermute((((8 * i) & 63) + g) << 2, (i < 8) ? S##el : S##eh); R[i] = *(const u32x4_t*)(Vs + (((unsigned)e << 7) | co)); } } while (0)
#define GV_LOADT(S, kk) do { const int t_ = GV_TK(kk); \
            S##a0 = 0; S##a1 = 0; S##a2 = 0; S##a3 = 0; \
            if (row0) { const long* wp = (const long*)(WQ + (size_t)t_ * HK + kq * 8); S##a0 = wp[0]; S##a1 = wp[4]; S##a2 = wp[8]; S##a3 = wp[12]; } \
            S##ws = ((kk) < n) ? WSC[t_] : 0.f; \
            S##hv = *(const float2*)(hrow + (size_t)t_ * D); } while (0)
#define GV_TOKEN(R, S, kk) do { \
            const int t = GV_TK(kk); \
            _Pragma("unroll") for (int i = 0; i < 16; ++i) *(u32x4_t*)(tile + i * GV_PIECE + lane * 16) = R[i]; \
            f32x4 acc[8]; \
            _Pragma("unroll") for (int nt = 0; nt < 8; ++nt) acc[nt] = (f32x4){0.f, 0.f, 0.f, 0.f}; \
            _Pragma("unroll") for (int s4 = 0; s4 < 4; ++s4) { \
                const long av = (s4 == 0) ? S##a0 : (s4 == 1) ? S##a1 : (s4 == 2) ? S##a2 : S##a3; \
                _Pragma("unroll") for (int nt = 0; nt < 8; ++nt) { \
                    const v2i_t bv = __builtin_amdgcn_ds_read_tr8_b64_v2i32((ldsv2_t)(void*)(tile + (4 * s4) * GV_PIECE + rdo + ((nt ^ rr) << 4))); \
                    acc[nt] = __builtin_amdgcn_mfma_f32_16x16x32_fp8_fp8(av, __builtin_bit_cast(long, bv), acc[nt], 0, 0, 0); } } \
            if (lane < 16) { _Pragma("unroll") for (int nt = 0; nt < 8; ++nt) strip[16 * nt + lane] = acc[nt][0]; }        \
            { const float2 o2 = *(const float2*)(strip + 2 * lane); \
              if ((kk) < n) *(float2*)(hrow + (size_t)t * D) = make_float2(S##hv.x + S##ws * o2.x, S##hv.y + S##ws * o2.y); } } while (0)
        int Ael, Aeh, Bel, Beh; u32x4_t rA[16], rB[16];
        long Pa0, Pa1, Pa2, Pa3, Qa0, Qa1, Qa2, Qa3; float Pws, Qws; float2 Phv, Qhv;
        GV_LOADE(A, GV_TK(0)); GV_LOADE(B, GV_TK(1));
        GV_ISSUE(rA, A); GV_LOADT(P, 0);
        for (int k = 0; k < n; k += 2) {
            GV_ISSUE(rB, B); GV_LOADE(A, GV_TK(k + 2)); GV_LOADT(Q, k + 1);
            GV_TOKEN(rA, P, k);
            GV_ISSUE(rA, A); GV_LOADE(B, GV_TK(k + 3)); GV_LOADT(P, k + 2);
            GV_TOKEN(rB, Q, k + 1);
        }
#undef GV_TK
#undef GV_LOADE
#undef GV_ISSUE
#undef GV_LOADT
#undef GV_TOKEN
    }
    __syncthreads();
}
__device__ __forceinline__ void phase_gnorm(const Params& P, int l) {
    const int lane = tidx() & 63, nw = nwave();
    bf16* XNw = (bf16*)(P.ws + WS_XN);
    const float4* g = (const float4*)((l == DEPTH - 1) ? P.norm_final : (P.norm_mix + (l + 1) * D));
    for (int t = gwave(); t < T; t += 2 * nw) {
        const int t2 = (t + nw < T) ? (t + nw) : t;
        float4 v[2][4];
#pragma unroll
        for (int q = 0; q < 4; ++q) { v[0][q] = ((const float4*)(P.out + (size_t)t * D))[q * 64 + lane]; v[1][q] = ((const float4*)(P.out + (size_t)t2 * D))[q * 64 + lane]; }
#pragma unroll
        for (int u = 0; u < 2; ++u) {
            float ss = 0.f;
#pragma unroll
            for (int q = 0; q < 4; ++q) ss += v[u][q].x * v[u][q].x + v[u][q].y * v[u][q].y + v[u][q].z * v[u][q].z + v[u][q].w * v[u][q].w;
            ss = wave_sum(ss);
            const float rn = rsqrtf(ss * (1.f / D) + EPS);
            const int tt = u ? t2 : t;
            if (u == 0 || t2 != t) {
                float4* hr = (float4*)(P.out + (size_t)tt * D);
#pragma unroll
                for (int q = 0; q < 4; ++q) {
                    const float4 gg = g[q * 64 + lane];
                    const float4 o = make_float4(v[u][q].x * rn * gg.x, v[u][q].y * rn * gg.y, v[u][q].z * rn * gg.z, v[u][q].w * rn * gg.w);
                    if (l == DEPTH - 1) hr[q * 64 + lane] = o;
                    else { uint2 uu; uu.x = pack2(o.x, o.y); uu.y = pack2(o.z, o.w); ((uint2*)(XNw + (size_t)tt * LDX))[q * 64 + lane] = uu; }
                }
            }
        }
    }
}

#define XB_TMO      128
#define XB_XCNT(j)  (256  + 64 * (j))
#define XB_XSUB(j)  (1280 + 64 * (j))
#define XB_XGEN(j)  (2304 + 64 * (j))
#define XB_TOP      3328
#define XB_TOPGEN   3392
#define XCD_BAR_WORDS 3456
#define XB_SPIN_CAP (1u << 22)
#define LAS __attribute__((address_space(3)))
__device__ __forceinline__ unsigned xb_ld(unsigned* p)              { return __hip_atomic_load(p, __ATOMIC_RELAXED, __HIP_MEMORY_SCOPE_AGENT); }
__device__ __forceinline__ unsigned xb_add(unsigned* p, unsigned v) { return __hip_atomic_fetch_add(p, v, __ATOMIC_RELAXED, __HIP_MEMORY_SCOPE_AGENT); }
__device__ __forceinline__ unsigned xb_xcc_id() { return (unsigned)__builtin_amdgcn_s_getreg((3 << 11) | 20) & 0xFu; }
#define XB_SPIN(cond, bar) do { unsigned _sp = 0; while (cond) { __builtin_amdgcn_s_sleep(1); \
    if ((++_sp & 255u) == 0u) { if (xb_ld(&(bar)[XB_TMO])) break; if (_sp > XB_SPIN_CAP) { atomicAdd(&(bar)[XB_TMO], 1u); break; } } } } while (0)
struct XcdBarrier { unsigned* bar; unsigned x; volatile LAS unsigned* st; };
__device__ __forceinline__ XcdBarrier xcd_barrier_post(unsigned* bar, volatile LAS unsigned* st) {
    XcdBarrier b; b.bar = bar; b.x = xb_xcc_id(); b.st = st;
    if (__builtin_amdgcn_workitem_id_x() == 0) (void)xb_add(&bar[XB_XCNT(b.x)], 1u);
    return b;
}
__device__ __forceinline__ void xcd_barrier_complete(unsigned* bar, unsigned x, unsigned& nloc, unsigned& nx) {
    const unsigned G = gridDim.x * gridDim.y * gridDim.z;
    unsigned sum, cnt, mine, sp = 0u;
    for (;;) {
        sum = 0u; cnt = 0u; mine = 0u;
#pragma unroll
        for (unsigned j = 0; j < 16; ++j) { const unsigned c = xb_ld(&bar[XB_XCNT(j)]); sum += c; cnt += (c > 0u) ? 1u : 0u; mine = (j == x) ? c : mine; }
        if (sum == G) break;
        __builtin_amdgcn_s_sleep(1);
        if ((++sp & 255u) == 0u) { if (xb_ld(&bar[XB_TMO])) break; if (sp > XB_SPIN_CAP) { atomicAdd(&bar[XB_TMO], 1u); break; } }
    }
    nloc = mine > 0u ? mine : 1u; nx = cnt > 0u ? cnt : 1u;
}
__device__ __forceinline__ void xcd_barrier(const XcdBarrier& b) {
    asm volatile("s_waitcnt vmcnt(0)" ::: "memory");
    __syncthreads();
    if (__builtin_amdgcn_workitem_id_x() == 0) {
        unsigned* bar = b.bar;
        __builtin_amdgcn_s_waitcnt(0);
        unsigned nloc = b.st[0], nx = b.st[1];
        if (nloc == 0u) { xcd_barrier_complete(bar, b.x, nloc, nx); b.st[0] = nloc; b.st[1] = nx; }
        const unsigned old = xb_add(&bar[XB_XSUB(b.x)], 1u);
        const unsigned gen = old / nloc;
        if (old + 1u == (gen + 1u) * nloc) {
            __builtin_amdgcn_fence(__ATOMIC_RELEASE, "agent");
            asm volatile("s_waitcnt vmcnt(0)" ::: "memory");
            const unsigned og = xb_add(&bar[XB_TOP], 1u);
            const unsigned tg = og / nx;
            if (og + 1u == (tg + 1u) * nx) xb_add(&bar[XB_TOPGEN], 1u);
            else XB_SPIN(xb_ld(&bar[XB_TOPGEN]) == tg, bar);
            __builtin_amdgcn_fence(__ATOMIC_ACQUIRE, "agent");
            xb_add(&bar[XB_XGEN(b.x)], 1u);
            asm volatile("s_waitcnt vmcnt(0)" ::: "memory");
        } else {
            XB_SPIN(xb_ld(&bar[XB_XGEN(b.x)]) == gen, bar);
            __builtin_amdgcn_fence(__ATOMIC_ACQUIRE, "agent");
            asm volatile("s_waitcnt vmcnt(0)" ::: "memory");
        }
    }
    __syncthreads();
}

constexpr float QSCALE = 0.10206207261596575f * 1.4426950408889634f;

__device__ __forceinline__ void phase_gemm1(const Params& P, int l, char* lds) {
    unsigned char* ws = P.ws;
    const bf16* XN = (const bf16*)(ws + WS_XN);
    bf16* PROJ = (bf16*)(ws + WS_PROJ);
    bf16* Kb = (bf16*)(ws + WS_K);
    const float* rope = (const float*)(ws + WS_ROPE);
    const bf16* W = (const bf16*)(ws + WS_WIN) + (size_t)l * DINP * LDW;
    float* SSQ = (float*)(ws + WS_SSQ);
    const int lane = tidx() & 63;
    int tlo, thi, tst; tile_rounds((T / 256) * (DINP / 256), tlo, thi, tst);
    gemm_t8<false>(W, LDW, DINP, XN, LDX, D, tlo, thi, tst, [&](int t, int n, const float4& v) {
        const int nb = __builtin_amdgcn_readfirstlane(n);
        if (nb < C_KR) {
            uint2 o; o.x = cvtpk(v.x, v.y); o.y = cvtpk(v.z, v.w);
            *(uint2*)(PROJ + (size_t)t * DINP + n) = o;
            if (nb >= C_CQ) {
                float q = v.x * v.x + v.y * v.y + v.z * v.z + v.w * v.w;
                q += __shfl_xor(q, 1, 64); q += __shfl_xor(q, 2, 64); q += __shfl_xor(q, 4, 64); q += __shfl_xor(q, 8, 64);
                if (n == nb) SSQ[(size_t)t * 16 + ((nb - C_CQ) >> 6)] = q;
            }
        } else if (nb == C_KR) {
            const float4 up = make_float4(__shfl(v.x, lane + 4, 64), __shfl(v.y, lane + 4, 64), __shfl(v.z, lane + 4, 64), __shfl(v.w, lane + 4, 64));
            const float4 dn = make_float4(__shfl(v.x, lane - 4, 64), __shfl(v.y, lane - 4, 64), __shfl(v.z, lane - 4, 64), __shfl(v.w, lane - 4, 64));
            const int d = n - C_KR;
            if (d < 32) {
                const int b = t / S, s = t % S;
                const bool first = d < 16;
                const int f = first ? d : (d - 16);
                const float4 cs0 = *(const float4*)(rope + ((size_t)s * 16 + f) * 2), cs1 = *(const float4*)(rope + ((size_t)s * 16 + f) * 2 + 4);
                float4 o;
                if (first) o = make_float4(v.x * cs0.x - up.x * cs0.y, v.y * cs0.z - up.y * cs0.w, v.z * cs1.x - up.z * cs1.y, v.w * cs1.z - up.w * cs1.w);
                else       o = make_float4(v.x * cs0.x + dn.x * cs0.y, v.y * cs0.z + dn.y * cs0.w, v.z * cs1.x + dn.z * cs1.y, v.w * cs1.z + dn.w * cs1.w);
                uint2 u; u.x = cvtpk(o.x, o.y); u.y = cvtpk(o.z, o.w);
#pragma unroll
                for (int h = 0; h < NH; ++h) *(uint2*)(Kb + ((size_t)(b * NH + h) * S + s) * DQK + 64 + d) = u;
            }
        }
    }, [](int) { return 1.f; }, lds);
}
__device__ __forceinline__ void phase_gemm2(const Params& P, int l, char* lds) {
    unsigned char* ws = P.ws;
    const bf16* PROJ = (const bf16*)(ws + WS_PROJ);
    const float* rope = (const float*)(ws + WS_ROPE);
    const float* SSQ = (const float*)(ws + WS_SSQ);
    const int G = gridDim.x, bid = blockIdx.x;
    const int vb = ((G & 7) == 0) ? ((bid & 7) * (G >> 3) + (bid >> 3)) : bid;
    int qlo, qhi, klo, khi;
    if ((G & 1) == 0) {
        const int Gh = G >> 1, pq = (384 + Gh - 1) / Gh, pk = (512 + Gh - 1) / Gh;
        if (vb < Gh) { qlo = vb * pq; qhi = qlo + pq; if (qhi > 384) qhi = 384; if (qlo > 384) qlo = 384; klo = 0; khi = 0; }
        else { klo = (vb - Gh) * pk; khi = klo + pk; if (khi > 512) khi = 512; if (klo > 512) klo = 512; qlo = 0; qhi = 0; }
    } else { tile_range(384, qlo, qhi); tile_range(512, klo, khi); }
    {
        const bf16* W = (const bf16*)(ws + WS_WUQ) + (size_t)l * 768 * QR;
        bf16* Qb = (bf16*)(ws + WS_Q);
        gemm_t8<true>(W, QR, 768, PROJ + C_CQ, DINP, QR, qlo, qhi, 1,
            [&](int t, int n, const float4& v) {
                const int b = t / S, s = t % S, h = n / DQK, d = n % DQK;
                float4 o = v;
                const int lane = tidx() & 63;
                const float4 up = make_float4(__shfl(v.x, lane + 4, 64), __shfl(v.y, lane + 4, 64), __shfl(v.z, lane + 4, 64), __shfl(v.w, lane + 4, 64));
                const float4 dn = make_float4(__shfl(v.x, lane - 4, 64), __shfl(v.y, lane - 4, 64), __shfl(v.z, lane - 4, 64), __shfl(v.w, lane - 4, 64));
                if (d >= 64) {
                    const bool first = d < 80;
                    const int f = first ? (d - 64) : (d - 80);
                    const float4 cs0 = *(const float4*)(rope + ((size_t)s * 16 + f) * 2), cs1 = *(const float4*)(rope + ((size_t)s * 16 + f) * 2 + 4);
                    if (first) o = make_float4(v.x * cs0.x - up.x * cs0.y, v.y * cs0.z - up.y * cs0.w, v.z * cs1.x - up.z * cs1.y, v.w * cs1.z - up.w * cs1.w);
                    else       o = make_float4(v.x * cs0.x + dn.x * cs0.y, v.y * cs0.z + dn.y * cs0.w, v.z * cs1.x + dn.z * cs1.y, v.w * cs1.z + dn.w * cs1.w);
                }
                uint2 u; u.x = cvtpk(o.x, o.y); u.y = cvtpk(o.z, o.w);
                *(uint2*)(Qb + ((size_t)(b * NH + h) * S + s) * DQK + d) = u;
            }, [&](int t) { const float4 a = *(const float4*)(SSQ + (size_t)t * 16); const float2 b = *(const float2*)(SSQ + (size_t)t * 16 + 4);
                            return rsqrtf(((a.x + a.y) + (a.z + a.w) + (b.x + b.y)) * (1.f / QR) + EPS) * QSCALE; }, lds);
    }
    {
        const bf16* W = (const bf16*)(ws + WS_WUKV) + (size_t)l * 1024 * KVR;
        bf16* Kb = (bf16*)(ws + WS_K); bf16* Vb = (bf16*)(ws + WS_V);
        gemm_t8<true>(W, KVR, 1024, PROJ + C_CKV, DINP, KVR, klo, khi, 1,
            [&](int t, int n, const float4& v) {
                const int b = t / S, s = t % S;
                uint2 u; u.x = cvtpk(v.x, v.y); u.y = cvtpk(v.z, v.w);
                if (n < 512) *(uint2*)(Kb + ((size_t)(b * NH + (n >> 6)) * S + s) * DQK + (n & 63)) = u;
                else         *(uint2*)(Vb + ((size_t)(b * NH + ((n - 512) >> 6)) * S + s) * DV + (n & 63)) = u;
            }, [&](int t) { const float2 a = *(const float2*)(SSQ + (size_t)t * 16 + 6); const float2 b = *(const float2*)(SSQ + (size_t)t * 16 + 8);
                            return rsqrtf(((a.x + a.y) + (b.x + b.y)) * (1.f / KVR) + EPS); }, lds);
    }
}
__device__ __forceinline__ void phase_gemm3(const Params& P, int l, char* lds) {
    unsigned char* ws = P.ws;
    const bf16* Yb = (const bf16*)(ws + WS_XN);
    const bf16* W = (const bf16*)(ws + WS_WOUT) + (size_t)l * D * LDW;
    const float* hin = (l == 0) ? P.x : P.out;
    float* out = P.out;
    int tlo, thi, tst; tile_rounds((T / 256) * (D / 256), tlo, thi, tst);
    gemm_t8<false>(W, LDW, D, Yb, LDX, D, tlo, thi, tst, [&](int t, int n, const float4& v) {
        const size_t idx = (size_t)t * D + n;
        const float4 hv = *(const float4*)(hin + idx);
        *(float4*)(out + idx) = make_float4(hv.x + v.x, hv.y + v.y, hv.z + v.z, hv.w + v.w);
    }, [](int) { return 1.f; }, lds);
}

#define GSYNC() do { XcdBarrier xb_; { __attribute__((address_space(1))) char* gp_ = (__attribute__((address_space(1))) char*)(char*)(P.ws + WS_CTL); asm volatile("" : "+s"(gp_)); xb_.bar = (unsigned*)(char*)gp_; } \
    xb_.x = xb_xcc_id(); xb_.st = (volatile LAS unsigned*)&xb_words; xcd_barrier(xb_); } while (0)
#define PHASE(stmt) { const Params Q = launder(P); stmt; }
__global__ void __launch_bounds__(NTHREADS, 2) k_all(Params P) {
    __shared__ __attribute__((aligned(16))) char sm[LDS_TOTAL];
    __shared__ uint4 xb_words;
    cg::grid_group grid = cg::this_grid();
    if (__builtin_amdgcn_workitem_id_x() == 0) xb_words = make_uint4(0u, 0u, 0u, 0u);
    __syncthreads();
    (void)xcd_barrier_post((unsigned*)(P.ws + WS_CTL), (volatile LAS unsigned*)&xb_words);
    __shared__ int xinfo[8];
    if (__builtin_amdgcn_workitem_id_x() == 0) {
        const unsigned x = xb_xcc_id();
        xinfo[XI_X] = (int)x; xinfo[XI_RANK] = (int)xb_add((unsigned*)(P.ws + WS_CTL) + CTL_CENSUS + x, 1u);
    }
    PHASE(phase_prep(Q, sm));
    PHASE(phase_norm(Q.x, Q.norm_mix, (bf16*)(Q.ws + WS_XN)));
    if (P.ws == nullptr) grid.sync();
    GSYNC();
    if (__builtin_amdgcn_workitem_id_x() == 0) {
        unsigned* cen = (unsigned*)(P.ws + WS_CTL) + CTL_CENSUS;
        const int x = xinfo[XI_X]; int nx = 0, jj = 0;
        for (int q = 0; q < 16; ++q) { const unsigned cq = xb_ld(cen + q); if (cq) { if (q < x) ++jj; ++nx; } }
        xinfo[XI_J] = jj; xinfo[XI_NX] = nx; xinfo[XI_NLOC] = (int)xb_ld(cen + x);
    }
    __syncthreads();
    for (int l = 0; l < DEPTH; ++l) {
        PHASE(phase_gemm1(Q, l, sm));
#if PROBE_DUP & 2
        PHASE(phase_gemm1(Q, l, sm));
#endif
        GSYNC();
        PHASE(phase_mixlocal(Q, l, sm));
#if PROBE_DUP & 256
        PHASE(phase_mixlocal(Q, l, sm));
#endif
        PHASE(phase_gemm2(Q, l, sm));
#if PROBE_DUP & 4
        PHASE(phase_gemm2(Q, l, sm));
#endif
        GSYNC();
        PHASE(phase_attn(Q, sm));
        GSYNC();
        PHASE(phase_gemm3(Q, l, sm));
#if PROBE_DUP & 16
        if (l == 0) PHASE(phase_gemm3(Q, l, sm));
#endif
        GSYNC();
        PHASE(phase_norm_q(Q, l));
        GSYNC();
        PHASE(phase_route(Q, l, sm));
        GSYNC();
        PHASE(phase_gu(Q, l, xinfo));
        GSYNC();
        PHASE(phase_gw(Q, l));
        GSYNC();
        PHASE(phase_gv(Q, l, xinfo, sm));
        GSYNC();
        PHASE(phase_gnorm(Q, l));
        GSYNC();
    }
}

extern "C" void kernel_launch(void* const* d_in, const int* in_sizes, int n_in, void* d_out, int out_size, void* d_ws, size_t ws_size, hipStream_t stream) {
    static int grid = 0;
    if (grid == 0) {
        if (n_in != 18 || out_size != T * D || ws_size < WS_END) { fprintf(stderr, "kernel_launch: bad sizes n_in %d out %d ws %zu need %zu\n", n_in, out_size, ws_size, (size_t)WS_END); grid = -1; return; }
        int dev = 0, cus = 0, per_cu = 0;
        (void)hipGetDevice(&dev);
        (void)hipDeviceGetAttribute(&cus, hipDeviceAttributeMultiprocessorCount, dev);
        (void)hipOccupancyMaxActiveBlocksPerMultiprocessor(&per_cu, (const void*)k_all, NTHREADS, 0);
        if (per_cu > 1) per_cu = 1;
        if (per_cu < 1) { fprintf(stderr, "kernel_launch: occupancy query says %d\n", per_cu); grid = -1; return; }
        grid = cus * per_cu;
    }
    if (grid < 0) return;
    Params p{};
    p.x = (const float*)d_in[0]; p.norm_mix = (const float*)d_in[1]; p.w_in = (const float*)d_in[2]; p.conv_w = (const float*)d_in[3];
    p.pool_w = (const float*)d_in[4]; p.pool_scale = (const float*)d_in[5]; p.q_norm = (const float*)d_in[6]; p.w_uq = (const float*)d_in[7];
    p.kv_norm = (const float*)d_in[8]; p.w_uk = (const float*)d_in[9]; p.w_uv = (const float*)d_in[10]; p.w_out = (const float*)d_in[11];
    p.norm_ffn = (const float*)d_in[12]; p.peer_wq = (const float*)d_in[13]; p.peer_subkeys = (const float*)d_in[14]; p.peer_u = (const float*)d_in[15];
    p.peer_v = (const float*)d_in[16]; p.norm_final = (const float*)d_in[17];
    p.out = (float*)d_out; p.ws = (unsigned char*)d_ws;
    if (hipMemsetAsync((char*)d_ws + WS_CTL, 0, CTL_BYTES, stream) != hipSuccess) { fprintf(stderr, "kernel_launch: memset failed\n"); return; }
    void* args[] = {&p};
    hipError_t e = hipLaunchCooperativeKernel((const void*)k_all, dim3(grid), dim3(NTHREADS), args, 0, stream);
    if (e != hipSuccess) fprintf(stderr, "cooperative launch failed: %s (grid %d)\n", hipGetErrorString(e), grid);
}
```

```cpp
#include <hip/hip_runtime.h>
#include <hip/hip_cooperative_groups.h>
#include <cstdio>
#include <cstdint>
namespace cg = cooperative_groups;

#ifndef TAB_FP8
#define TAB_FP8 1
#endif
#ifndef PROBE_DUP
#define PROBE_DUP 0
#endif

constexpr int NB = 4, S = 8192, T = NB * S, D = 1024, DEPTH = 2;
constexpr int DIN = 1696, DINP = 1792;
constexpr int C_BG = 0, C_CG = 256, C_HC = 512, C_HP = 768, C_CQ = 1024, C_CKV = 1408, C_KR = 1664;
constexpr int QR = 384, KVR = 256, NH = 8, DQK = 96, DV = 64;
constexpr int PH = 8, NKEY = 128, NEXP = NKEY * NKEY, TOPK = 16, HK = PH * TOPK;
constexpr float EPS = 1e-6f;
constexpr int LDX = 1088;
constexpr int LDW = 1088;

typedef unsigned short bf16;
constexpr int HP = 2 * D;

constexpr size_t WS_CTL   = 0;
constexpr size_t WS_ROPE  = 64 * 1024;
constexpr size_t WS_WIN   = WS_ROPE + (size_t)S * 16 * 2 * 4;
constexpr size_t WS_WUQ   = WS_WIN + (size_t)DEPTH * DINP * LDW * 2;
constexpr size_t WS_WUKV  = WS_WUQ + (size_t)DEPTH * 768 * QR * 2;
constexpr size_t WS_WOUT  = WS_WUKV + (size_t)DEPTH * 1024 * KVR * 2;
constexpr size_t WS_WPQ   = WS_WOUT + (size_t)DEPTH * D * LDW * 2;
constexpr size_t WS_XN    = ((WS_WPQ + (size_t)DEPTH * 2048 * LDW * 2 + 4095) / 4096) * 4096;
constexpr size_t WS_PROJ  = WS_XN + (size_t)T * LDX * 2;
constexpr size_t WS_Q     = WS_PROJ + (size_t)T * DINP * 2;
constexpr size_t WS_K     = WS_Q + (size_t)T * NH * DQK * 2;
constexpr size_t WS_V     = WS_K + (size_t)T * NH * DQK * 2;
constexpr size_t WS_EXP   = WS_V + (size_t)T * NH * DV * 2;
constexpr size_t WS_GATE  = WS_EXP + (size_t)T * HK * 4;
constexpr size_t TAB_ROWB = TAB_FP8 ? 1024 : 2048;
constexpr size_t WS_TABU  = WS_GATE + (size_t)T * HK * 4;
constexpr size_t WS_TABV  = WS_TABU + (size_t)DEPTH * NEXP * TAB_ROWB;
constexpr size_t WS_TSCU  = WS_TABV + (size_t)DEPTH * NEXP * TAB_ROWB;
constexpr size_t WS_TSCV  = WS_TSCU + (size_t)DEPTH * NEXP * 4;
constexpr size_t WS_XQ    = WS_TSCV + (size_t)DEPTH * NEXP * 4;
constexpr size_t WS_XS    = WS_XQ + (size_t)T * D;
constexpr size_t WS_WQ8   = WS_XS + (size_t)T * 4;
constexpr size_t WS_WSC   = WS_WQ8 + (size_t)T * HK;
constexpr size_t WS_SSQ   = WS_WSC + (size_t)T * 4;
constexpr size_t WS_END   = WS_SSQ + (size_t)T * 64;
static_assert(WS_END <= (size_t)512 * 1024 * 1024, "workspace budget");

struct Params {
    const float* x; const float* norm_mix; const float* w_in; const float* conv_w; const float* pool_w; const float* pool_scale;
    const float* q_norm; const float* w_uq; const float* kv_norm; const float* w_uk; const float* w_uv; const float* w_out;
    const float* norm_ffn; const float* peer_wq; const float* peer_subkeys; const float* peer_u; const float* peer_v; const float* norm_final;
    float* out; unsigned char* ws;
};

__device__ __forceinline__ bf16 f2bf(float f) { unsigned u = __float_as_uint(f); u += 0x7fffu + ((u >> 16) & 1u); return (bf16)(u >> 16); }
__device__ __forceinline__ float bf2f(bf16 h) { return __uint_as_float(((unsigned)h) << 16); }
__device__ __forceinline__ float bflo(unsigned u) { return __uint_as_float(u << 16); }
__device__ __forceinline__ float bfhi(unsigned u) { return __uint_as_float(u & 0xffff0000u); }
__device__ __forceinline__ unsigned pack2(float a, float b) { return (unsigned)f2bf(a) | ((unsigned)f2bf(b) << 16); }
__device__ __forceinline__ float wave_sum(float v) {
#pragma unroll
    for (int m = 32; m >= 1; m >>= 1) v += __shfl_xor(v, m, 64);
    return v;
}
__device__ __forceinline__ float gelu_exact(float x) { return 0.5f * x * (1.f + erff(x * 0.70710678118654752f)); }

#define NTHREADS 512
constexpr int NW = NTHREADS / 64;
__device__ __forceinline__ int tidx() { int t = (int)__builtin_amdgcn_workitem_id_x(); asm volatile("" : "+v"(t)); return t; }
__device__ __forceinline__ int gwave() { return blockIdx.x * (NTHREADS / 64) + (tidx() >> 6); }
__device__ __forceinline__ int nwave() { return gridDim.x * (NTHREADS / 64); }
__device__ __forceinline__ size_t gtid() { return (size_t)blockIdx.x * NTHREADS + tidx(); }
__device__ __forceinline__ size_t gnth() { return (size_t)gridDim.x * NTHREADS; }


__device__ __forceinline__ Params launder(const Params& P) {
    typedef __attribute__((address_space(1))) char* gp_t;
    gp_t g[20] = {(gp_t)(char*)P.x, (gp_t)(char*)P.norm_mix, (gp_t)(char*)P.w_in, (gp_t)(char*)P.conv_w, (gp_t)(char*)P.pool_w, (gp_t)(char*)P.pool_scale, (gp_t)(char*)P.q_norm, (gp_t)(char*)P.w_uq,
                  (gp_t)(char*)P.kv_norm, (gp_t)(char*)P.w_uk, (gp_t)(char*)P.w_uv, (gp_t)(char*)P.w_out, (gp_t)(char*)P.norm_ffn, (gp_t)(char*)P.peer_wq, (gp_t)(char*)P.peer_subkeys,
                  (gp_t)(char*)P.peer_u, (gp_t)(char*)P.peer_v, (gp_t)(char*)P.norm_final, (gp_t)(char*)P.out, (gp_t)(char*)P.ws};
    asm volatile("" : "+s"(g[0]), "+s"(g[1]), "+s"(g[2]), "+s"(g[3]), "+s"(g[4]), "+s"(g[5]), "+s"(g[6]), "+s"(g[7]), "+s"(g[8]), "+s"(g[9]));
    asm volatile("" : "+s"(g[10]), "+s"(g[11]), "+s"(g[12]), "+s"(g[13]), "+s"(g[14]), "+s"(g[15]), "+s"(g[16]), "+s"(g[17]), "+s"(g[18]), "+s"(g[19]));
    Params Q;
    Q.x = (const float*)(char*)g[0]; Q.norm_mix = (const float*)(char*)g[1]; Q.w_in = (const float*)(char*)g[2]; Q.conv_w = (const float*)(char*)g[3]; Q.pool_w = (const float*)(char*)g[4];
    Q.pool_scale = (const float*)(char*)g[5]; Q.q_norm = (const float*)(char*)g[6]; Q.w_uq = (const float*)(char*)g[7]; Q.kv_norm = (const float*)(char*)g[8]; Q.w_uk = (const float*)(char*)g[9];
    Q.w_uv = (const float*)(char*)g[10]; Q.w_out = (const float*)(char*)g[11]; Q.norm_ffn = (const float*)(char*)g[12]; Q.peer_wq = (const float*)(char*)g[13]; Q.peer_subkeys = (const float*)(char*)g[14];
    Q.peer_u = (const float*)(char*)g[15]; Q.peer_v = (const float*)(char*)g[16]; Q.norm_final = (const float*)(char*)g[17]; Q.out = (float*)(char*)g[18]; Q.ws = (unsigned char*)(char*)g[19];
    return Q;
}

typedef __attribute__((ext_vector_type(8))) short bf16x8;
typedef __attribute__((ext_vector_type(16))) float f32x16;
typedef __attribute__((ext_vector_type(2))) __bf16 bf2_t;
#define MFMA32(a, b, c) __builtin_amdgcn_mfma_f32_32x32x16_bf16(a, b, c, 0, 0, 0)
__device__ __forceinline__ int crow(int r, int hi) { return (r & 3) + 8 * (r >> 2) + 4 * hi; }
__device__ __forceinline__ float dot2bf(unsigned a, unsigned b, float c) { return __builtin_amdgcn_fdot2_f32_bf16(__builtin_bit_cast(bf2_t, a), __builtin_bit_cast(bf2_t, b), c, false); }
__device__ __forceinline__ unsigned cvtpk(float lo, float hi) { unsigned r; asm("v_cvt_pk_bf16_f32 %0, %1, %2" : "=v"(r) : "v"(lo), "v"(hi)); return r; }
constexpr int LDS_TOTAL = 140 * 1024;

template <int WT, bool ROWSS>
__device__ __forceinline__ void gemm_kloop(const bf16* __restrict__ Ag0, int lda, const bf16* __restrict__ Bg0, int ldb, int nk, f32x16 (&acc)[8], float (&ss)[4], char* lds, int tid) {
    constexpr int BROWS = (WT == 0) ? 256 : 128, NPB = BROWS / 64;
    constexpr int OPA = 256 * 128, G_BUF = OPA + BROWS * 128;
    const int lane = tid & 63, w = __builtin_amdgcn_readfirstlane(tid >> 6), r32 = lane & 31, hi = lane >> 5;
    const int srow = 8 * w + (lane >> 3);
    const int sch = (lane & 7) ^ ((srow >> 1) & 7);
    const bf16* Ag = Ag0 + (size_t)srow * lda + sch * 8;
    const bf16* Bg = Bg0 + (size_t)srow * ldb + sch * 8;
#pragma unroll
    for (int i = 0; i < 8; ++i)
#pragma unroll
        for (int r = 0; r < 16; ++r) acc[i][r] = 0.f;
    ss[0] = 0.f; ss[1] = 0.f; ss[2] = 0.f; ss[3] = 0.f;
    typedef __attribute__((address_space(3))) unsigned* ldsp_t;
    typedef const __attribute__((address_space(1))) unsigned* glbp_t;
#define G_DMA(buf, kofs) do { char* d_ = lds + (buf) * G_BUF + (8 * w) * 128; \
    _Pragma("unroll") for (int i = 0; i < 4; ++i) \
        __builtin_amdgcn_global_load_lds((glbp_t)(const void*)(Ag + (size_t)(64 * i) * lda + (kofs)), (ldsp_t)(void*)(d_ + i * 8192), 16, 0, 0); \
    _Pragma("unroll") for (int i = 0; i < NPB; ++i) \
        __builtin_amdgcn_global_load_lds((glbp_t)(const void*)(Bg + (size_t)(64 * i) * ldb + (kofs)), (ldsp_t)(void*)(d_ + OPA + i * 8192), 16, 0, 0); } while (0)
    const int xr = (r32 >> 1) & 7;
    const int o0 = ((0 + hi) ^ xr) << 4, o1 = ((2 + hi) ^ xr) << 4, o2 = ((4 + hi) ^ xr) << 4, o3 = ((6 + hi) ^ xr) << 4;
#define G_SS(s_, r_) do { union { bf16x8 v; uint4 u; } c_; c_.v = r_; s_ = dot2bf(c_.u.x, c_.u.x, s_); s_ = dot2bf(c_.u.y, c_.u.y, s_); s_ = dot2bf(c_.u.z, c_.u.z, s_); s_ = dot2bf(c_.u.w, c_.u.w, s_); } while (0)
#define G_STEP(pa, pb, off) do { \
    if (WT == 0) { \
        const bf16x8 a0 = *(const bf16x8*)(pa + off), a1 = *(const bf16x8*)(pa + 32 * 128 + off); \
        const bf16x8 b0 = *(const bf16x8*)(pb + off), b1 = *(const bf16x8*)(pb + 32 * 128 + off), b2 = *(const bf16x8*)(pb + 64 * 128 + off), b3 = *(const bf16x8*)(pb + 96 * 128 + off); \
        if (ROWSS) { G_SS(ss[0], b0); G_SS(ss[1], b1); G_SS(ss[2], b2); G_SS(ss[3], b3); } \
        acc[0] = MFMA32(a0, b0, acc[0]); acc[1] = MFMA32(a0, b1, acc[1]); acc[2] = MFMA32(a0, b2, acc[2]); acc[3] = MFMA32(a0, b3, acc[3]); \
        acc[4] = MFMA32(a1, b0, acc[4]); acc[5] = MFMA32(a1, b1, acc[5]); acc[6] = MFMA32(a1, b2, acc[6]); acc[7] = MFMA32(a1, b3, acc[7]); \
    } else if (WT == 2) { \
        const bf16x8 a0 = *(const bf16x8*)(pa + off), a1 = *(const bf16x8*)(pa + 32 * 128 + off); \
        const bf16x8 b0 = *(const bf16x8*)(pb + off), b1 = *(const bf16x8*)(pb + 32 * 128 + off); \
        if (ROWSS) { G_SS(ss[0], b0); G_SS(ss[1], b1); } \
        acc[0] = MFMA32(a0, b0, acc[0]); acc[1] = MFMA32(a0, b1, acc[1]); acc[2] = MFMA32(a1, b0, acc[2]); acc[3] = MFMA32(a1, b1, acc[3]); \
    } else { \
        const bf16x8 b0 = *(const bf16x8*)(pb + off); \
        const bf16x8 a0 = *(const bf16x8*)(pa + off), a1 = *(const bf16x8*)(pa + 32 * 128 + off); \
        const bf16x8 a2 = *(const bf16x8*)(pa + 64 * 128 + off), a3 = *(const bf16x8*)(pa + 96 * 128 + off); \
        if (ROWSS) { G_SS(ss[0], b0); } \
        acc[0] = MFMA32(a0, b0, acc[0]); acc[1] = MFMA32(a1, b0, acc[1]); \
        acc[2] = MFMA32(a2, b0, acc[2]); acc[3] = MFMA32(a3, b0, acc[3]); \
    } } while (0)
    const int arow = (WT == 1) ? ((w >> 2) * 128 + r32) : ((w >> 1) * 64 + r32);
    const int brow = (WT == 0) ? ((w & 1) * 128 + r32) : (WT == 2) ? ((w & 1) * 64 + r32) : ((w & 3) * 32 + r32);
    G_DMA(0, 0);
    for (int kt = 0; kt < nk; ++kt) {
        __syncthreads();
        if (kt + 1 < nk) G_DMA((kt + 1) & 1, (kt + 1) * 64);
        const char* pa = lds + (kt & 1) * G_BUF + arow * 128;
        const char* pb = lds + (kt & 1) * G_BUF + OPA + brow * 128;
        G_STEP(pa, pb, o0); G_STEP(pa, pb, o1); G_STEP(pa, pb, o2); G_STEP(pa, pb, o3);
    }
    if (ROWSS) { ss[0] += __shfl_xor(ss[0], 32, 64); ss[1] += __shfl_xor(ss[1], 32, 64); ss[2] += __shfl_xor(ss[2], 32, 64); ss[3] += __shfl_xor(ss[3], 32, 64); }
#undef G_DMA
#undef G_SS
#undef G_STEP
}

__device__ __forceinline__ void tile_range(int ntiles, int& lo, int& hi) {
    const int G = gridDim.x, b = blockIdx.x;
    const int vb = ((G & 7) == 0) ? ((b & 7) * (G >> 3) + (b >> 3)) : b;
    const int per = (ntiles + G - 1) / G;
    lo = vb * per; hi = lo + per; if (hi > ntiles) hi = ntiles;
}
constexpr int ST_P = 68;
static_assert(NW * 64 * ST_P * 4 <= LDS_TOTAL, "staging LDS");
template <bool ROWSS, class EPI, class EPIROW, class RSC>
__device__ __forceinline__ void gemm_t(const bf16* __restrict__ Wt, int ldw, int N, const bf16* __restrict__ X, int ldx, int M, int K, int tn_direct, EPI epi, EPIROW epirow, RSC rowscale, char* lds) {
    const int tid = tidx(), lane = tid & 63, w = tid >> 6, r32 = lane & 31, hi = lane >> 5;
    const int tilesN = N / 256, tilesM = M / 256, nk = K / 64;
    int tlo, thi; tile_range(tilesM * tilesN, tlo, thi);
    for (int tile = tlo; tile < thi; ++tile) {
        const int tm = tile / tilesN, tn = tile % tilesN;
        f32x16 acc[8]; float ss[4];
        gemm_kloop<0, ROWSS>(Wt + (size_t)(tn * 256) * ldw, ldw, X + (size_t)(tm * 256) * ldx, ldx, nk, acc, ss, lds, tid);
        if (tn < tn_direct) {
            __syncthreads();
            float* st = (float*)lds + w * (64 * ST_P);
            const int rr = lane >> 4, ch = lane & 15;
#pragma unroll
            for (int half = 0; half < 2; ++half) {
                const float m0_ = rowscale(ss[2 * half]), m1_ = rowscale(ss[2 * half + 1]);
#pragma unroll
                for (int i = 0; i < 2; ++i)
#pragma unroll
                    for (int jj = 0; jj < 2; ++jj)
#pragma unroll
                        for (int g = 0; g < 4; ++g) {
                            const float mj = jj ? m1_ : m0_;
                            const f32x16& a_ = acc[i * 4 + 2 * half + jj];
                            *(float4*)(st + (32 * jj + r32) * ST_P + 32 * i + 8 * g + 4 * hi) = make_float4(a_[4 * g] * mj, a_[4 * g + 1] * mj, a_[4 * g + 2] * mj, a_[4 * g + 3] * mj);
                        }
#pragma unroll 2
                for (int it = 0; it < 16; ++it) {
                    const int row = it * 4 + rr;
                    const float4 v = *(const float4*)(st + row * ST_P + ch * 4);
                    epirow(tm * 256 + (w & 1) * 128 + half * 64 + row, tn * 256 + (w >> 1) * 64 + ch * 4, v);
                }
            }
        } else {
#pragma unroll
            for (int i = 0; i < 2; ++i)
#pragma unroll
                for (int j = 0; j < 4; ++j)
                    epi(tn * 256 + (w >> 1) * 64 + i * 32, tm * 256 + (w & 1) * 128 + j * 32, acc[i * 4 + j], r32, hi, ss[j]);
        }
        __syncthreads();
    }
}

constexpr int ST1_P = 132;
static_assert(NW * 32 * ST1_P * 4 <= LDS_TOTAL, "staging LDS (128 x 32 wave tiles)");
template <class EPIROW, class RSC>
__device__ __forceinline__ void gemm_t1(const bf16* __restrict__ Wt, int ldw, int N, const bf16* __restrict__ X, int ldx, int M, int K, EPIROW epirow, RSC rowscale, char* lds) {
    const int tid = tidx(), lane = tid & 63, w = tid >> 6, r32 = lane & 31, hi = lane >> 5;
    const int tilesN = N / 256, tilesM = M / 128, nk = K / 64;
    int tlo, thi; tile_range(tilesM * tilesN, tlo, thi);
    for (int tile = tlo; tile < thi; ++tile) {
        const int tm = tile / tilesN, tn = tile % tilesN;
        f32x16 acc[8]; float ss[4];
        gemm_kloop<1, true>(Wt + (size_t)(tn * 256) * ldw, ldw, X + (size_t)(tm * 128) * ldx, ldx, nk, acc, ss, lds, tid);
        __syncthreads();
        float* st = (float*)lds + w * (32 * ST1_P);
        const float mj = rowscale(ss[0]);
#pragma unroll
        for (int mt = 0; mt < 4; ++mt)
#pragma unroll
            for (int g = 0; g < 4; ++g)
                *(float4*)(st + r32 * ST1_P + 32 * mt + 8 * g + 4 * hi) = make_float4(acc[mt][4 * g] * mj, acc[mt][4 * g + 1] * mj, acc[mt][4 * g + 2] * mj, acc[mt][4 * g + 3] * mj);
#pragma unroll 2
        for (int it = 0; it < 16; ++it) {
            const int row = it * 2 + hi;
            const float4 v = *(const float4*)(st + row * ST1_P + r32 * 4);
            epirow(tm * 128 + (w & 3) * 32 + row, tn * 256 + (w >> 2) * 128 + r32 * 4, v);
        }
        __syncthreads();
    }
}

template <class EPIROW>
__device__ __forceinline__ void gemm_t2(const bf16* __restrict__ Wt, int ldw, int N, const bf16* __restrict__ X, int ldx, int M, int K, EPIROW epirow, char* lds) {
    const int tid = tidx(), lane = tid & 63, w = tid >> 6, r32 = lane & 31, hi = lane >> 5;
    const int tilesN = N / 256, tilesM = M / 128, nk = K / 64;
    int tlo, thi; tile_range(tilesM * tilesN, tlo, thi);
    for (int tile = tlo; tile < thi; ++tile) {
        const int tm = tile / tilesN, tn = tile % tilesN;
        f32x16 acc[8]; float ss[4];
        gemm_kloop<2, false>(Wt + (size_t)(tn * 256) * ldw, ldw, X + (size_t)(tm * 128) * ldx, ldx, nk, acc, ss, lds, tid);
        __syncthreads();
        float* st = (float*)lds + w * (64 * ST_P);
#pragma unroll
        for (int i = 0; i < 2; ++i)
#pragma unroll
            for (int j = 0; j < 2; ++j)
#pragma unroll
                for (int g = 0; g < 4; ++g)
                    *(float4*)(st + (32 * j + r32) * ST_P + 32 * i + 8 * g + 4 * hi) = make_float4(acc[i * 2 + j][4 * g], acc[i * 2 + j][4 * g + 1], acc[i * 2 + j][4 * g + 2], acc[i * 2 + j][4 * g + 3]);
        const int rr = lane >> 4, ch = lane & 15;
#pragma unroll 4
        for (int it = 0; it < 16; ++it) {
            const int row = it * 4 + rr;
            const float4 v = *(const float4*)(st + row * ST_P + ch * 4);
            epirow(tm * 128 + (w & 1) * 64 + row, tn * 256 + (w >> 1) * 64 + ch * 4, v);
        }
        __syncthreads();
    }
}

typedef __attribute__((ext_vector_type(4))) float f32x4;
constexpr int G8_HT = 128 * 64;
__device__ __forceinline__ int g8_lds_byte(int r, int c) {
    const int st = (r >> 4) * 2 + (c >> 5), rr = r & 15, cc = c & 31, ob = rr * 64 + cc * 2;
    return st * 1024 + (ob ^ (((ob >> 9) & 1) << 5));
}
__device__ __forceinline__ void g8_stage_rc(int b, int& R, int& C) {
    const int st = b / 1024, sb = b % 1024, swz = sb ^ (((sb >> 9) & 1) << 5);
    R = (st >> 1) * 16 + swz / 64; C = (st & 1) * 32 + (swz % 64) / 2;
}
__device__ __forceinline__ float ssq8(const bf16x8& v, float s) {
    union { bf16x8 v; uint4 u; } c_; c_.v = v;
    s = dot2bf(c_.u.x, c_.u.x, s); s = dot2bf(c_.u.y, c_.u.y, s); s = dot2bf(c_.u.z, c_.u.z, s); return dot2bf(c_.u.w, c_.u.w, s);
}
template <bool ROWSS, bool APERM = false>
__device__ __forceinline__ void gemm8_kloop(const bf16* __restrict__ A, int lda, const bf16* __restrict__ Bt, int ldb, int nt, f32x4 (&acc)[2][2][4][2], float (&ss)[2][2], char* lds, int tid) {
    bf16* shm = (bf16*)lds;
    typedef __attribute__((address_space(3))) unsigned* ldsp_t;
    typedef const __attribute__((address_space(1))) unsigned* glbp_t;
#define SA(b, h) (shm + ((b) * 2 + (h)) * G8_HT)
#define SB(b, h) (shm + (4 + (b) * 2 + (h)) * G8_HT)
    int sr0, sc0; g8_stage_rc(tid * 16, sr0, sc0);
    const unsigned voa = (unsigned)((sr0 * lda + sc0) * 2), vob = (unsigned)((sr0 * ldb + sc0) * 2);
    const char* Ap = (const char*)A; const char* Bp = (const char*)Bt;
    const int wbase = __builtin_amdgcn_readfirstlane(tid >> 6) * 1024;
#define STAGE_(P, BASE, VO, LD, br, r2, kt) do { const char* g_ = BASE + ((size_t)(br) * LD + (kt) * 64) * 2; \
    __builtin_amdgcn_global_load_lds((glbp_t)(const void*)(g_ + VO), (ldsp_t)(void*)((char*)(P) + wbase), 16, 0, 0); \
    __builtin_amdgcn_global_load_lds((glbp_t)(const void*)(g_ + (size_t)(2 * (r2)) * LD + VO), (ldsp_t)(void*)((char*)(P) + wbase + 8192), 16, 0, 0); } while (0)
#define STAGEA(b, h, kt) STAGE_(SA(b, h), Ap, voa, lda, (APERM ? (h) * 64 : (h) * 128), (APERM ? 128 : 64), kt)
#define STAGEB(b, h, kt) STAGE_(SB(b, h), Bp, vob, ldb, (h) * 128, 64, kt)
    const int lane = tid & 63, wid = tid >> 6, wr = wid >> 2, wc = wid & 3, fr = lane & 15, fq = lane >> 4;
    int abase, bbase;
    { const int ob = fr * 64 + fq * 16, lp = ob ^ (((ob >> 9) & 1) << 5);
      abase = lp + wr * 8192; bbase = lp + wc * 4096 + 4 * G8_HT * 2;
      asm volatile("" : "+v"(abase), "+v"(bbase)); }
#define LDA(dst, b, h) _Pragma("unroll") for (int m = 0; m < 4; ++m) _Pragma("unroll") for (int k = 0; k < 2; ++k) \
    dst[m][k] = *reinterpret_cast<const bf16x8*>(lds + abase + (((b) * 2 + (h)) * G8_HT * 2 + m * 2048 + k * 1024))
#define LDB(dst, b, h) _Pragma("unroll") for (int n = 0; n < 2; ++n) _Pragma("unroll") for (int k = 0; k < 2; ++k) \
    dst[n][k] = *reinterpret_cast<const bf16x8*>(lds + bbase + (((b) * 2 + (h)) * G8_HT * 2 + n * 2048 + k * 1024))
#define MMA(ai, bj, At_, Bt_) do { __builtin_amdgcn_s_setprio(1); \
    _Pragma("unroll") for (int m = 0; m < 4; ++m) _Pragma("unroll") for (int n = 0; n < 2; ++n) _Pragma("unroll") for (int k = 0; k < 2; ++k) \
        acc[ai][bj][m][n] = __builtin_amdgcn_mfma_f32_16x16x32_bf16(At_[m][k], Bt_[n][k], acc[ai][bj][m][n], 0, 0, 0); \
    __builtin_amdgcn_s_setprio(0); } while (0)
#define SSQ(bj, Bt_) do { if (ROWSS) { _Pragma("unroll") for (int n = 0; n < 2; ++n) { ss[bj][n] = ssq8(Bt_[n][0], ss[bj][n]); ss[bj][n] = ssq8(Bt_[n][1], ss[bj][n]); } } } while (0)
#define WAIT_V(n) asm volatile("s_waitcnt vmcnt(" #n ")" ::: "memory")
#define WAIT_L(n) asm volatile("s_waitcnt lgkmcnt(" #n ")" ::: "memory")
#define BAR __builtin_amdgcn_s_barrier()
#define SCHED __builtin_amdgcn_sched_barrier(0)
#pragma unroll
    for (int a = 0; a < 2; ++a)
#pragma unroll
        for (int b = 0; b < 2; ++b)
#pragma unroll
            for (int m = 0; m < 4; ++m)
#pragma unroll
                for (int n = 0; n < 2; ++n) acc[a][b][m][n] = f32x4{0.f, 0.f, 0.f, 0.f};
    ss[0][0] = 0.f; ss[0][1] = 0.f; ss[1][0] = 0.f; ss[1][1] = 0.f;
    bf16x8 At[4][2], B0[2][2], B1[2][2];
    STAGEB(0, 0, 0); STAGEA(0, 0, 0);
    STAGEB(0, 1, 0); STAGEA(0, 1, 0);
    if (wr == 1) BAR;
    WAIT_V(4); BAR;
    STAGEB(1, 0, 1); STAGEA(1, 0, 1); STAGEB(1, 1, 1);
    WAIT_V(6); BAR;
    for (int t = 0; t < nt - 2; t += 2) {
        LDB(B0, 0, 0); SCHED; LDA(At, 0, 0); STAGEA(1, 1, t + 1);
        WAIT_L(8); BAR; WAIT_L(0); MMA(0, 0, At, B0); SSQ(0, B0); BAR; SCHED;
        LDB(B1, 0, 1); STAGEB(0, 0, t + 2);
        BAR; WAIT_L(0); MMA(0, 1, At, B1); SSQ(1, B1); BAR;
        LDA(At, 0, 1); STAGEA(0, 0, t + 2);
        BAR; WAIT_L(0); MMA(1, 0, At, B0); BAR; SCHED;
        STAGEB(0, 1, t + 2);
        WAIT_V(6); BAR; MMA(1, 1, At, B1); BAR;
        LDB(B0, 1, 0); SCHED; LDA(At, 1, 0); STAGEA(0, 1, t + 2);
        WAIT_L(8); BAR; WAIT_L(0); MMA(0, 0, At, B0); SSQ(0, B0); BAR; SCHED;
        LDB(B1, 1, 1); STAGEB(1, 0, t + 3);
        BAR; WAIT_L(0); MMA(0, 1, At, B1); SSQ(1, B1); BAR;
        LDA(At, 1, 1); STAGEA(1, 0, t + 3);
        BAR; WAIT_L(0); MMA(1, 0, At, B0); BAR; SCHED;
        STAGEB(1, 1, t + 3);
        WAIT_V(6); BAR; MMA(1, 1, At, B1); BAR;
    }
    { LDB(B0, 0, 0); LDA(At, 0, 0); STAGEA(1, 1, nt - 1);
      BAR; WAIT_L(0); MMA(0, 0, At, B0); SSQ(0, B0); BAR;
      LDB(B1, 0, 1); BAR; WAIT_L(0); MMA(0, 1, At, B1); SSQ(1, B1); BAR;
      LDA(At, 0, 1); WAIT_V(4); BAR; WAIT_L(0); MMA(1, 0, At, B0); MMA(1, 1, At, B1); BAR; }
    { LDB(B0, 1, 0); LDA(At, 1, 0); WAIT_V(2); BAR; WAIT_L(0); MMA(0, 0, At, B0); SSQ(0, B0); BAR;
      LDB(B1, 1, 1); WAIT_V(0); BAR; WAIT_L(0); MMA(0, 1, At, B1); SSQ(1, B1); BAR;
      LDA(At, 1, 1); BAR; WAIT_L(0); MMA(1, 0, At, B0); MMA(1, 1, At, B1); BAR; }
    if (wr == 0) BAR;
    if (ROWSS) {
#pragma unroll
        for (int b = 0; b < 2; ++b)
#pragma unroll
            for (int n = 0; n < 2; ++n) { ss[b][n] += __shfl_xor(ss[b][n], 16, 64); ss[b][n] += __shfl_xor(ss[b][n], 32, 64); }
    }
#undef SSQ
#undef SA
#undef SB
#undef STAGE_
#undef STAGEA
#undef STAGEB
#undef LDA
#undef LDB
#undef MMA
#undef WAIT_V
#undef WAIT_L
#undef BAR
#undef SCHED
}
__device__ __forceinline__ void tile_rounds(int ntiles, int& lo, int& hi, int& step) {
    const int G = gridDim.x, b = blockIdx.x;
    if ((G & 7) == 0) { const int per = (ntiles + 7) >> 3, x = b & 7; lo = x * per + (b >> 3); hi = (x + 1) * per; if (hi > ntiles) hi = ntiles; step = G >> 3; }
    else { lo = b; hi = ntiles; step = G; }
}
template <bool SCALE, bool PRE, class EPIROW, class RSC, class PREF>
__device__ __forceinline__ void gemm_t8(const bf16* __restrict__ Wt, int ldw, int N, const bf16* __restrict__ X, int ldx, int K, int tlo, int thi, int tstep, EPIROW epirow, RSC rowscale, PREF pre, char* lds) {
    const int tid = tidx();
    const int tilesN = N / 256; int nt = K / 64;
    asm volatile("" : "+s"(nt));
    for (int tile = tlo; tile < thi; tile += tstep) {
        const int tm = tile / tilesN, tn = tile % tilesN;
        f32x4 acc[2][2][4][2]; float ss[2][2];
        gemm8_kloop<false>(Wt + (size_t)(tn * 256) * ldw, ldw, X + (size_t)(tm * 256) * ldx, ldx, nt, acc, ss, lds, tid);
        __syncthreads();
        const int te = tidx();
        const int le = te & 63, w = te >> 6, wr = w >> 2, wc = w & 3, fr = le & 15, fq = le >> 4;
        float* st = (float*)lds + w * (32 * ST_P);
        const int rr = le >> 4, ch = le & 15;
        const int tb = tm * 256 + wc * 32 + rr, nb = tn * 256 + wr * 64 + ch * 4;
#pragma unroll
        for (int ai = 0; ai < 2; ++ai)
#pragma unroll
            for (int bj = 0; bj < 2; ++bj) {
                float4 pv[8];
                if (PRE) {
#pragma unroll
                    for (int it = 0; it < 8; ++it) pv[it] = pre(tb + bj * 128 + it * 4, nb + ai * 128);
                }
#pragma unroll
                for (int n = 0; n < 2; ++n) {
                    const float mj = SCALE ? rowscale(tm * 256 + bj * 128 + wc * 32 + n * 16 + fr) : 1.f;
#pragma unroll
                    for (int m = 0; m < 4; ++m) {
                        const f32x4 a_ = acc[ai][bj][m][n];
                        *(float4*)(st + (n * 16 + fr) * ST_P + m * 16 + fq * 4) = SCALE ? make_float4(a_[0] * mj, a_[1] * mj, a_[2] * mj, a_[3] * mj) : make_float4(a_[0], a_[1], a_[2], a_[3]);
                    }
                }
                if (PRE) {
#pragma unroll
                    for (int it = 0; it < 8; ++it) {
                        const float4 v = *(const float4*)(st + (it * 4 + rr) * ST_P + ch * 4);
                        epirow(tb + bj * 128 + it * 4, nb + ai * 128, v, pv[it]);
                    }
                } else {
#pragma unroll 2
                    for (int it = 0; it < 8; ++it) {
                        const float4 v = *(const float4*)(st + (it * 4 + rr) * ST_P + ch * 4);
                        epirow(tb + bj * 128 + it * 4, nb + ai * 128, v, make_float4(0.f, 0.f, 0.f, 0.f));
                    }
                }
            }
        __syncthreads();
    }
}

__device__ __forceinline__ void transpose_tiled(const float* __restrict__ W, bf16* __restrict__ Wt, int K, int N, int Npad, int ldk, const float* __restrict__ gain, char* lds) {
    float (*tl)[65] = (float (*)[65])lds;
    const int tid = tidx(), a = tid & 63, q = tid >> 6;
    const int tK = K / 64, tN = Npad / 64;
    for (int tile = blockIdx.x; tile < tK * tN; tile += gridDim.x) {
        const int k0 = (tile / tN) * 64, n0 = (tile % tN) * 64;
#pragma unroll 4
        for (int i = 0; i < 64 / NW; ++i) {
            const int k = k0 + q * (64 / NW) + i, n = n0 + a;
            float v = (n < N) ? W[(size_t)k * N + n] : 0.f;
            if (gain) v *= gain[k];
            tl[q * (64 / NW) + i][a] = v;
        }
        __syncthreads();
#pragma unroll 4
        for (int i = 0; i < 64 / NW; ++i) { const int nl = q * (64 / NW) + i; Wt[(size_t)(n0 + nl) * ldk + k0 + a] = f2bf(tl[a][nl]); }
        __syncthreads();
    }
}

__device__ __forceinline__ void quant_row(const float4 (&v)[4], unsigned char* __restrict__ dst, float* __restrict__ scl, int r, int lane) {
    float am = 0.f;
#pragma unroll
    for (int j = 0; j < 4; ++j) am = fmaxf(am, fmaxf(fmaxf(fabsf(v[j].x), fabsf(v[j].y)), fmaxf(fabsf(v[j].z), fabsf(v[j].w))));
#pragma unroll
    for (int m = 32; m >= 1; m >>= 1) am = fmaxf(am, __shfl_xor(am, m, 64));
    const float sc = (am > 0.f) ? am * (1.f / 448.f) : 1.f;
    const float is = 1.f / sc;
    uint4 o;
    { int w = 0; w = __builtin_amdgcn_cvt_pk_fp8_f32(v[0].x * is, v[0].y * is, w, false); w = __builtin_amdgcn_cvt_pk_fp8_f32(v[0].z * is, v[0].w * is, w, true); o.x = (unsigned)w; }
    { int w = 0; w = __builtin_amdgcn_cvt_pk_fp8_f32(v[1].x * is, v[1].y * is, w, false); w = __builtin_amdgcn_cvt_pk_fp8_f32(v[1].z * is, v[1].w * is, w, true); o.y = (unsigned)w; }
    { int w = 0; w = __builtin_amdgcn_cvt_pk_fp8_f32(v[2].x * is, v[2].y * is, w, false); w = __builtin_amdgcn_cvt_pk_fp8_f32(v[2].z * is, v[2].w * is, w, true); o.z = (unsigned)w; }
    { int w = 0; w = __builtin_amdgcn_cvt_pk_fp8_f32(v[3].x * is, v[3].y * is, w, false); w = __builtin_amdgcn_cvt_pk_fp8_f32(v[3].z * is, v[3].w * is, w, true); o.w = (unsigned)w; }
    { const int lay = r / NEXP, e = r % NEXP; *(uint4*)(dst + (((size_t)(lay * 8 + (lane >> 3)) * NEXP + e) * 128) + (lane & 7) * 16) = o; }
    if (lane == 0) scl[r] = sc;
}
__device__ __forceinline__ unsigned pack_i8x4(float a, float b, float c, float d) {
    const int ia = __float2int_rn(a), ib = __float2int_rn(b), ic = __float2int_rn(c), id = __float2int_rn(d);
    return (unsigned)(ia & 255) | ((unsigned)(ib & 255) << 8) | ((unsigned)(ic & 255) << 16) | ((unsigned)(id & 255) << 24);
}
__device__ __forceinline__ void quant_row_i8(const float4 (&v)[4], unsigned char* __restrict__ dst, float* __restrict__ scl, int r, int lane) {
    float am = 0.f;
#pragma unroll
    for (int j = 0; j < 4; ++j) am = fmaxf(am, fmaxf(fmaxf(fabsf(v[j].x), fabsf(v[j].y)), fmaxf(fabsf(v[j].z), fabsf(v[j].w))));
#pragma unroll
    for (int m = 32; m >= 1; m >>= 1) am = fmaxf(am, __shfl_xor(am, m, 64));
    const float sc = (am > 0.f) ? am * (1.f / 127.f) : 1.f;
    const float is = 1.f / sc;
    uint4 o;
    o.x = pack_i8x4(v[0].x * is, v[0].y * is, v[0].z * is, v[0].w * is); o.y = pack_i8x4(v[1].x * is, v[1].y * is, v[1].z * is, v[1].w * is);
    o.z = pack_i8x4(v[2].x * is, v[2].y * is, v[2].z * is, v[2].w * is); o.w = pack_i8x4(v[3].x * is, v[3].y * is, v[3].z * is, v[3].w * is);
    { const int lay = r / NEXP, e = r % NEXP; *(uint4*)(dst + (((size_t)(lay * 8 + (lane >> 3)) * NEXP + e) * 128) + (lane & 7) * 16) = o; }
    if (lane == 0) scl[r] = sc;
}
template <bool I8>
__device__ __forceinline__ void convert_table(const float* __restrict__ src, unsigned char* __restrict__ dst, float* __restrict__ scl, int rows) {
    static_assert(TAB_FP8, "fp8 tables");
    const int lane = tidx() & 63;
    const int nw = nwave();
    for (int r = gwave(); r < rows; r += 4 * nw) {
        float4 v[4][4]; int rr[4];
#pragma unroll
        for (int u = 0; u < 4; ++u) {
            rr[u] = (r + u * nw < rows) ? (r + u * nw) : r;
            const float4* s0 = (const float4*)(src + (size_t)rr[u] * D);
#pragma unroll
            for (int j = 0; j < 4; ++j) v[u][j] = s0[lane * 4 + j];
        }
#pragma unroll
        for (int u = 0; u < 4; ++u) {
            if (u == 0 || rr[u] != r) { if (I8) quant_row_i8(v[u], dst, scl, rr[u], lane); else quant_row(v[u], dst, scl, rr[u], lane); }
        }
    }
}
__device__ __forceinline__ void phase_prep(const Params& P, char* lds) {
    unsigned char* ws = P.ws;
    for (int l = 0; l < DEPTH; ++l) {
        transpose_tiled(P.w_in + (size_t)l * D * DIN, (bf16*)(ws + WS_WIN) + (size_t)l * DINP * LDW, D, DIN, DINP, LDW, nullptr, lds);
        transpose_tiled(P.w_uq + (size_t)l * QR * 768, (bf16*)(ws + WS_WUQ) + (size_t)l * 768 * QR, QR, 768, 768, QR, P.q_norm + l * QR, lds);
        transpose_tiled(P.w_uk + (size_t)l * KVR * 512, (bf16*)(ws + WS_WUKV) + (size_t)l * 1024 * KVR, KVR, 512, 512, KVR, P.kv_norm + l * KVR, lds);
        transpose_tiled(P.w_uv + (size_t)l * KVR * 512, (bf16*)(ws + WS_WUKV) + (size_t)l * 1024 * KVR + (size_t)512 * KVR, KVR, 512, 512, KVR, P.kv_norm + l * KVR, lds);
        transpose_tiled(P.w_out + (size_t)l * D * D, (bf16*)(ws + WS_WOUT) + (size_t)l * D * LDW, D, D, D, LDW, nullptr, lds);
    }
    {
        bf16* Wc = (bf16*)(ws + WS_WPQ);
        float (*As)[68] = (float (*)[68])lds;
        float (*Bs)[68] = (float (*)[68])(lds + 16 * 68 * 4);
        const int tid = tidx(), tx = tid & 15, ty = (tid >> 4) & 15;
        const int lr = (tid >> 2) & 63, ld4 = (tid & 3) * 4;
        for (int tile = blockIdx.x; tile < (DEPTH * 2048 / 64) * (D / 64); tile += gridDim.x) {
            const int row0 = (tile >> 4) * 64, k0 = (tile & 15) * 64;
            const int l = row0 >> 11, hp = (row0 >> 7) & 15, n0 = row0 & 127;
            const float* skp = P.peer_subkeys + (((size_t)l * 2 + (hp & 1)) * NKEY + n0 + lr) * 128 + ld4;
            const float* wqp = P.peer_wq + ((size_t)l * D + k0 + lr) * 2048 + hp * 128 + ld4;
            float acc[4][4];
#pragma unroll
            for (int i = 0; i < 4; ++i)
#pragma unroll
                for (int j = 0; j < 4; ++j) acc[i][j] = 0.f;
            for (int d0 = 0; d0 < 128; d0 += 16) {
                if (tid < 256) {
                    const float4 av = *(const float4*)(skp + d0), bv = *(const float4*)(wqp + d0);
                    As[ld4 + 0][lr] = av.x; As[ld4 + 1][lr] = av.y; As[ld4 + 2][lr] = av.z; As[ld4 + 3][lr] = av.w;
                    Bs[ld4 + 0][lr] = bv.x; Bs[ld4 + 1][lr] = bv.y; Bs[ld4 + 2][lr] = bv.z; Bs[ld4 + 3][lr] = bv.w;
                }
                __syncthreads();
#pragma unroll
                for (int kk = 0; kk < 16; ++kk) {
                    const float4 a4 = *(const float4*)&As[kk][ty * 4], b4 = *(const float4*)&Bs[kk][tx * 4];
                    const float aa[4] = {a4.x, a4.y, a4.z, a4.w}, bb[4] = {b4.x, b4.y, b4.z, b4.w};
#pragma unroll
                    for (int i = 0; i < 4; ++i)
#pragma unroll
                        for (int j = 0; j < 4; ++j) acc[i][j] = fmaf(aa[i], bb[j], acc[i][j]);
                }
                __syncthreads();
            }
            if (tid < 256) {
#pragma unroll
                for (int i = 0; i < 4; ++i) {
                    uint2 o; o.x = pack2(acc[i][0], acc[i][1]); o.y = pack2(acc[i][2], acc[i][3]);
                    *(uint2*)(Wc + (size_t)(row0 + ty * 4 + i) * LDW + k0 + tx * 4) = o;
                }
            }
        }
    }
    convert_table<true>(P.peer_u, ws + WS_TABU, (float*)(ws + WS_TSCU), DEPTH * NEXP);
    convert_table<false>(P.peer_v, ws + WS_TABV, (float*)(ws + WS_TSCV), DEPTH * NEXP);
    float* rope = (float*)(ws + WS_ROPE);
    for (size_t i = gtid(); i < (size_t)S * 16; i += gnth()) {
        const int s = (int)(i >> 4), f = (int)(i & 15);
        const double inv = pow(10000.0, -(double)f / 16.0);
        const double ang = (double)s * inv;
        rope[2 * i] = (float)cos(ang); rope[2 * i + 1] = (float)sin(ang);
    }
}

__device__ __forceinline__ void phase_norm(const float* __restrict__ h, const float* __restrict__ g, bf16* __restrict__ xn) {
    const int lane = tidx() & 63, nw = nwave();
    for (int t = gwave(); t < T; t += 2 * nw) {
        const int t2 = (t + nw < T) ? (t + nw) : t;
        float4 v[2][4];
#pragma unroll
        for (int j = 0; j < 4; ++j) { v[0][j] = ((const float4*)(h + (size_t)t * D))[j * 64 + lane]; v[1][j] = ((const float4*)(h + (size_t)t2 * D))[j * 64 + lane]; }
#pragma unroll
        for (int u = 0; u < 2; ++u) {
            float ss = 0.f;
#pragma unroll
            for (int j = 0; j < 4; ++j) ss += v[u][j].x * v[u][j].x + v[u][j].y * v[u][j].y + v[u][j].z * v[u][j].z + v[u][j].w * v[u][j].w;
            ss = wave_sum(ss);
            const float r = rsqrtf(ss * (1.f / D) + EPS);
            const int tt = u ? t2 : t;
            if (u == 0 || t2 != t) {
#pragma unroll
                for (int j = 0; j < 4; ++j) {
                    const float4 gg = ((const float4*)g)[j * 64 + lane];
                    uint2 o; o.x = pack2(v[u][j].x * r * gg.x, v[u][j].y * r * gg.y); o.y = pack2(v[u][j].z * r * gg.z, v[u][j].w * r * gg.w);
                    ((uint2*)(xn + (size_t)tt * LDX))[j * 64 + lane] = o;
                }
            }
        }
    }
}

__device__ __forceinline__ void phase_norm_q(const Params& P, int l) {
    const int lane = tidx() & 63, nw = nwave();
    const float* g = P.norm_ffn + l * D;
    bf16* xn = (bf16*)(P.ws + WS_XN);
    unsigned* xq = (unsigned*)(P.ws + WS_XQ);
    float* xsc = (float*)(P.ws + WS_XS);
    bf16* Hb = (bf16*)P.out;
    const bf16* yo = (const bf16*)(P.ws + WS_PROJ);
    for (int t = gwave(); t < T; t += 2 * nw) {
        const int t2 = (t + nw < T) ? (t + nw) : t;
        float4 v[2][4];
#pragma unroll
        for (int j = 0; j < 4; ++j) {
            if (l == 0) { v[0][j] = ((const float4*)(P.x + (size_t)t * D))[j * 64 + lane]; v[1][j] = ((const float4*)(P.x + (size_t)t2 * D))[j * 64 + lane]; }
            else {
                const uint2 a = ((const uint2*)(Hb + (size_t)t * HP))[j * 64 + lane], b = ((const uint2*)(Hb + (size_t)t2 * HP))[j * 64 + lane];
                v[0][j] = make_float4(bflo(a.x), bfhi(a.x), bflo(a.y), bfhi(a.y)); v[1][j] = make_float4(bflo(b.x), bfhi(b.x), bflo(b.y), bfhi(b.y));
            }
        }
        {
            uint2 y[2][4];
#pragma unroll
            for (int j = 0; j < 4; ++j) { y[0][j] = ((const uint2*)(yo + (size_t)t * D))[j * 64 + lane]; y[1][j] = ((const uint2*)(yo + (size_t)t2 * D))[j * 64 + lane]; }
#pragma unroll
            for (int u = 0; u < 2; ++u)
#pragma unroll
                for (int j = 0; j < 4; ++j) { v[u][j].x += bflo(y[u][j].x); v[u][j].y += bfhi(y[u][j].x); v[u][j].z += bflo(y[u][j].y); v[u][j].w += bfhi(y[u][j].y); }
#pragma unroll
            for (int j = 0; j < 4; ++j) {
                uint2 a, b; a.x = pack2(v[0][j].x, v[0][j].y); a.y = pack2(v[0][j].z, v[0][j].w); b.x = pack2(v[1][j].x, v[1][j].y); b.y = pack2(v[1][j].z, v[1][j].w);
                ((uint2*)(Hb + (size_t)t * HP))[j * 64 + lane] = a; if (t2 != t) ((uint2*)(Hb + (size_t)t2 * HP))[j * 64 + lane] = b;
            }
        }
#pragma unroll
        for (int u = 0; u < 2; ++u) {
            float ss = 0.f;
#pragma unroll
            for (int j = 0; j < 4; ++j) ss += v[u][j].x * v[u][j].x + v[u][j].y * v[u][j].y + v[u][j].z * v[u][j].z + v[u][j].w * v[u][j].w;
            ss = wave_sum(ss);
            const float r = rsqrtf(ss * (1.f / D) + EPS);
            const int tt = u ? t2 : t;
            if (u == 0 || t2 != t) {
                float am = 0.f;
#pragma unroll
                for (int j = 0; j < 4; ++j) {
                    const float4 gg = ((const float4*)g)[j * 64 + lane];
                    v[u][j].x *= r * gg.x; v[u][j].y *= r * gg.y; v[u][j].z *= r * gg.z; v[u][j].w *= r * gg.w;
                    am = fmaxf(am, fmaxf(fmaxf(fabsf(v[u][j].x), fabsf(v[u][j].y)), fmaxf(fabsf(v[u][j].z), fabsf(v[u][j].w))));
                    uint2 o; o.x = pack2(v[u][j].x, v[u][j].y); o.y = pack2(v[u][j].z, v[u][j].w);
                    ((uint2*)(xn + (size_t)tt * LDX))[j * 64 + lane] = o;
                }
#pragma unroll
                for (int m = 32; m >= 1; m >>= 1) am = fmaxf(am, __shfl_xor(am, m, 64));
                const float sc = (am > 0.f) ? am * (1.f / 127.f) : 1.f, is = 1.f / sc;
#pragma unroll
                for (int j = 0; j < 4; ++j) xq[(size_t)tt * (D / 4) + j * 64 + lane] = pack_i8x4(v[u][j].x * is, v[u][j].y * is, v[u][j].z * is, v[u][j].w * is);
                if (lane == 0) xsc[tt] = sc;
            }
        }
    }
}

__device__ __forceinline__ void phase_mixlocal(const Params& P, int l, char* lds) {
    const bf16* proj = (const bf16*)(P.ws + WS_PROJ);
    bf16* Y = (bf16*)(P.ws + WS_XN);
    const int tid = tidx();
    {
        const float* cw = P.conv_w + (size_t)l * 3 * 256;
        for (size_t i = gtid(); i < (size_t)T * 32; i += gnth()) {
            const int t = (int)(i >> 5), c0 = (int)(i & 31) * 8, s = t & (S - 1);
            const bf16* pr = proj + (size_t)t * DINP;
            float acc[8];
#pragma unroll
            for (int e = 0; e < 8; ++e) acc[e] = 0.f;
#pragma unroll
            for (int j = 0; j < 3; ++j) {
                if (s - 2 + j >= 0) {
                    const bf16* pp = pr - (size_t)(2 - j) * DINP;
                    const uint4 g = *(const uint4*)(pp + C_CG + c0), hc = *(const uint4*)(pp + C_HC + c0);
                    const float4 w0 = *(const float4*)(cw + j * 256 + c0), w1 = *(const float4*)(cw + j * 256 + c0 + 4);
                    acc[0] = fmaf(w0.x, bflo(g.x) * bflo(hc.x), acc[0]); acc[1] = fmaf(w0.y, bfhi(g.x) * bfhi(hc.x), acc[1]);
                    acc[2] = fmaf(w0.z, bflo(g.y) * bflo(hc.y), acc[2]); acc[3] = fmaf(w0.w, bfhi(g.y) * bfhi(hc.y), acc[3]);
                    acc[4] = fmaf(w1.x, bflo(g.z) * bflo(hc.z), acc[4]); acc[5] = fmaf(w1.y, bfhi(g.z) * bfhi(hc.z), acc[5]);
                    acc[6] = fmaf(w1.z, bflo(g.w) * bflo(hc.w), acc[6]); acc[7] = fmaf(w1.w, bfhi(g.w) * bfhi(hc.w), acc[7]);
                }
            }
            const uint4 bg = *(const uint4*)(pr + C_BG + c0);
            uint4 o;
            o.x = pack2(bflo(bg.x) * acc[0], bfhi(bg.x) * acc[1]); o.y = pack2(bflo(bg.y) * acc[2], bfhi(bg.y) * acc[3]);
            o.z = pack2(bflo(bg.z) * acc[4], bfhi(bg.z) * acc[5]); o.w = pack2(bflo(bg.w) * acc[6], bfhi(bg.w) * acc[7]);
            *(uint4*)(Y + (size_t)t * LDX + c0) = o;
        }
    }
    {
        float (*pl)[68] = (float (*)[68])lds;
        const float* pw = P.pool_w + (size_t)l * 4 * 64 * 64;
        const float* psc = P.pool_scale + l * 256;
        const int a = tid & 63, q = tid >> 6;
        for (int tile = blockIdx.x; tile < (T / (16 * NW)) * 4; tile += gridDim.x) {
            const int g = tile & 3, t0 = (tile >> 2) * (16 * NW);
            const int w = 2 << g;
            {
                const bf16* col = proj + C_HP + g * 64 + a;
                const int tf = t0 + q * 16, sf = tf & (S - 1);
                float xr[31];
#pragma unroll
                for (int d = 1; d <= 15; ++d) xr[15 - d] = (d < w && sf - d >= 0) ? bf2f(col[(size_t)(tf - d) * DINP]) : 0.f;
#pragma unroll
                for (int i = 0; i < 16; ++i) xr[15 + i] = bf2f(col[(size_t)(tf + i) * DINP]);
                float sum = 0.f;
#pragma unroll
                for (int d = 1; d <= 15; ++d) sum += xr[15 - d];
#pragma unroll
                for (int i = 0; i < 16; ++i) {
                    const int s = sf + i;
                    sum += xr[15 + i];
                    const int cnt = (s + 1 < w) ? (s + 1) : w;
                    pl[q * 16 + i][a] = sum / (float)cnt - xr[15 + i];
                    const int o = 15 + i + 1;
                    const float old = (g == 0) ? xr[o - 2] : (g == 1) ? xr[o - 4] : (g == 2) ? xr[o - 8] : xr[o - 16];
                    sum -= old;
                }
            }
            __syncthreads();
            {
                float pc[64];
#pragma unroll
                for (int c = 0; c < 64; ++c) pc[c] = pw[(g * 64 + c) * 64 + a];
                const float sc = psc[g * 64 + a];
#pragma unroll 2
                for (int i = 0; i < 16; ++i) {
                    const float4* row = (const float4*)&pl[q * 16 + i][0];
                    float m0 = 0.f, m1 = 0.f;
#pragma unroll
                    for (int c4 = 0; c4 < 16; ++c4) { const float4 v = row[c4]; m0 = fmaf(v.x, pc[4 * c4], m0); m1 = fmaf(v.y, pc[4 * c4 + 1], m1); m0 = fmaf(v.z, pc[4 * c4 + 2], m0); m1 = fmaf(v.w, pc[4 * c4 + 3], m1); }
                    Y[(size_t)(t0 + q * 16 + i) * LDX + 256 + g * 64 + a] = f2bf((m0 + m1) * sc);
                }
            }
            __syncthreads();
        }
    }
}

typedef short v4i16_t __attribute__((ext_vector_type(4)));
typedef __attribute__((address_space(3))) v4i16_t* lds_v4p;
__device__ __forceinline__ v4i16_t vtr(const char* p) { return __builtin_amdgcn_ds_read_tr16_b64_v4i16((lds_v4p)p); }
constexpr int A_KP = 208, A_VP = 192;
constexpr int A_KB = 64 * A_KP, A_VB = 64 * A_VP, A_BUF = A_KB + A_VB, ATTN_LDS = 3 * A_BUF;
static_assert(ATTN_LDS <= LDS_TOTAL, "attention LDS");

__device__ __forceinline__ void attn_unit(const bf16* __restrict__ Qb, const bf16* __restrict__ Kb, const bf16* __restrict__ Vb, bf16* __restrict__ Y, int bh, int qblk, char* lds) {
    const int tid = tidx(), lane = tid & 63, w = tid >> 6, r32 = lane & 31, hi = lane >> 5;
    const int q0 = qblk * (32 * NW), qw0 = q0 + w * 32;
    const int NT = (q0 + 32 * NW) / 64;
    bf16x8 qf[6];
    {
        const bf16* qp = Qb + ((size_t)bh * S + qw0 + r32) * DQK + hi * 8;
#pragma unroll
        for (int ks = 0; ks < 6; ++ks) qf[ks] = *(const bf16x8*)(qp + ks * 16);
    }
    f32x16 o0, o1;
#pragma unroll
    for (int r = 0; r < 16; ++r) { o0[r] = 0.f; o1[r] = 0.f; }
    float m = -1e30f, lsum = 0.f;
    const int t8 = tid & 255; const bool isv = tid >= 256;
    const char* Tg = isv ? (const char*)(Vb + (size_t)bh * S * DV) : (const char*)(Kb + (size_t)bh * S * DQK);
    const int Ts = isv ? (64 * 128) : (64 * 192);
    const int g0 = t8 * 16, g1 = (t8 + 256) * 16, g2 = isv ? g1 : (t8 + 512) * 16;
    const int l0 = isv ? (A_KB + (t8 >> 3) * A_VP + (t8 & 7) * 16) : ((t8 / 12) * A_KP + (t8 % 12) * 16);
    const int l1 = isv ? (l0 + 32 * A_VP) : (((t8 + 256) / 12) * A_KP + ((t8 + 256) % 12) * 16);
    const int l2 = isv ? l1 : (((t8 + 512) / 12) * A_KP + ((t8 + 512) % 12) * 16);
    uint4 pk0, pk1, pk2, qk0, qk1, qk2;
#define A_LOAD(S, t) do { const char* tg = Tg + (size_t)(t) * Ts; S##k0 = *(const uint4*)(tg + g0); S##k1 = *(const uint4*)(tg + g1); S##k2 = *(const uint4*)(tg + g2); } while (0)
#define A_STORE(S, bK, bV) do { *(uint4*)(bK + l0) = S##k0; *(uint4*)(bK + l1) = S##k1; *(uint4*)(bK + l2) = S##k2; } while (0)
#define A_PV(pf, kofs) do { \
            { const v4i16_t lo = vtr(pv + (kofs) * A_VP), hh = vtr(pv + ((kofs) + 8) * A_VP); const bf16x8 vf = {lo[0], lo[1], lo[2], lo[3], hh[0], hh[1], hh[2], hh[3]}; o0 = MFMA32(vf, pf.v, o0); } \
            { const v4i16_t lo = vtr(pv + (kofs) * A_VP + 64), hh = vtr(pv + ((kofs) + 8) * A_VP + 64); const bf16x8 vf = {lo[0], lo[1], lo[2], lo[3], hh[0], hh[1], hh[2], hh[3]}; o1 = MFMA32(vf, pf.v, o1); } } while (0)
    const int pvo = (4 * hi + ((lane & 15) >> 2)) * A_VP + (16 * ((lane >> 4) & 1) + 4 * (lane & 3)) * 2;
#define A_QK(S0, S1, bK_, kt0_) do { \
        _Pragma("unroll") for (int r = 0; r < 16; ++r) { S0[r] = 0.f; S1[r] = 0.f; } \
        const char* pk = (bK_) + r32 * A_KP + hi * 16; \
        _Pragma("unroll") for (int ks = 0; ks < 6; ++ks) { \
            const bf16x8 a0 = *(const bf16x8*)(pk + ks * 32), a1 = *(const bf16x8*)(pk + 32 * A_KP + ks * 32); \
            S0 = MFMA32(a0, qf[ks], S0); S1 = MFMA32(a1, qf[ks], S1); } \
        if ((kt0_) + 63 > qw0) {                                      \
            const int qrow = qw0 + r32; \
            _Pragma("unroll") for (int r = 0; r < 16; ++r) { const int key = (kt0_) + crow(r, hi); if (key > qrow) S0[r] = -INFINITY; if (key + 32 > qrow) S1[r] = -INFINITY; } } } while (0)
#define A_SOFTPV(s0, s1, bV_) do { \
            float mx = fmaxf(s0[0], s1[0]); \
            _Pragma("unroll") for (int r = 1; r < 16; ++r) mx = fmaxf(mx, fmaxf(s0[r], s1[r])); \
            mx = fmaxf(mx, __shfl_xor(mx, 32, 64)); \
            const float mn = fmaxf(m, mx), m_prev = m; \
            const float alpha = __builtin_amdgcn_exp2f(m - mn); \
            m = mn; \
            float ps = 0.f; \
            _Pragma("unroll") for (int r = 0; r < 16; ++r) { s0[r] = __builtin_amdgcn_exp2f(s0[r] - mn); s1[r] = __builtin_amdgcn_exp2f(s1[r] - mn); ps += s0[r] + s1[r]; } \
            if (__builtin_amdgcn_ballot_w64(mn > m_prev) != 0ull) {     \
                lsum *= alpha; \
                _Pragma("unroll") for (int r = 0; r < 16; ++r) { o0[r] *= alpha; o1[r] *= alpha; } } \
            lsum += ps; \
            union { unsigned u[4]; bf16x8 v; } p00, p01, p10, p11; \
            _Pragma("unroll") for (int j = 0; j < 4; ++j) { p00.u[j] = cvtpk(s0[2 * j], s0[2 * j + 1]); p01.u[j] = cvtpk(s0[8 + 2 * j], s0[9 + 2 * j]); p10.u[j] = cvtpk(s1[2 * j], s1[2 * j + 1]); p11.u[j] = cvtpk(s1[8 + 2 * j], s1[9 + 2 * j]); } \
            const char* pv = (bV_) + pvo; \
            A_PV(p00, 0); A_PV(p01, 16); A_PV(p10, 32); A_PV(p11, 48); } while (0)
#define A_STEP(C0, C1, N0, N1, SET, t) do { \
        if ((t) + 1 < NT) { \
            char* bKn = lds + so_next; \
            A_STORE(SET, bKn, bKn + A_KB); \
            __syncthreads(); \
            { const int tn = ((t) + 3 < NT) ? ((t) + 3) : (NT - 1); A_LOAD(SET, tn); } \
            if (((t) + 1) * 64 <= qw0) A_QK(N0, N1, bKn, ((t) + 1) * 64); \
        } \
        if ((t) * 64 <= qw0) A_SOFTPV(C0, C1, lds + so_cur + A_KB); \
        so_cur = so_next; so_next = (so_next == 2 * A_BUF) ? 0 : so_next + A_BUF; } while (0)
    int so_cur = 0, so_next = A_BUF;
    A_LOAD(p, 0); A_LOAD(q, 1);
    A_STORE(p, lds, lds + A_KB);
    __syncthreads();
    A_LOAD(p, 2);
    f32x16 sa0, sa1, sb0, sb1;
    A_QK(sa0, sa1, lds, 0);
    for (int t2 = 0; t2 < NT; t2 += 2) {
        A_STEP(sa0, sa1, sb0, sb1, q, t2);
        A_STEP(sb0, sb1, sa0, sa1, p, t2 + 1);
    }
#undef A_QK
#undef A_SOFTPV
#undef A_STEP
    lsum += __shfl_xor(lsum, 32, 64);
    const float inv = 1.f / lsum;
    const int b = bh >> 3, h = bh & 7;
    bf16* yo = Y + (size_t)(b * S + qw0 + r32) * LDX + 512 + h * 64 + 4 * hi;
#pragma unroll
    for (int g = 0; g < 4; ++g) {
        uint2 a, c;
        a.x = cvtpk(o0[4 * g] * inv, o0[4 * g + 1] * inv); a.y = cvtpk(o0[4 * g + 2] * inv, o0[4 * g + 3] * inv);
        c.x = cvtpk(o1[4 * g] * inv, o1[4 * g + 1] * inv); c.y = cvtpk(o1[4 * g + 2] * inv, o1[4 * g + 3] * inv);
        *(uint2*)(yo + 8 * g) = a; *(uint2*)(yo + 32 + 8 * g) = c;
    }
    __syncthreads();
}
__device__ __forceinline__ void phase_attn(const Params& P, char* lds) {
    const bf16* Qb = (const bf16*)(P.ws + WS_Q);
    const bf16* Kb = (const bf16*)(P.ws + WS_K);
    const bf16* Vb = (const bf16*)(P.ws + WS_V);
    bf16* Y = (bf16*)(P.ws + WS_XN);
    for (int u = blockIdx.x; u < NB * NH * (S / 256); u += gridDim.x) {
        const int bh = u & 31, v = u >> 5;
        const int qblk = (v < 8) ? (31 - v) : (v < 16) ? (v - 8) : (v < 24) ? (39 - v) : (v - 16);
        attn_unit(Qb, Kb, Vb, Y, bh, qblk, lds);
    }
}

#define NET_HD __device__ __forceinline__
#define NET_U2F(u) __uint_as_float(u)
#define NET_F2U(f) __float_as_uint(f)
#define CE_DESC(a, b) do { const float hi__ = fmaxf(a, b), lo__ = fminf(a, b); a = hi__; b = lo__; } while (0)
NET_HD void sort16_desc(float (&v)[16]) {
#define CE2(a, b) CE_DESC(v[a], v[b])
    CE2(0,13); CE2(1,12); CE2(2,15); CE2(3,14); CE2(4,8); CE2(5,6); CE2(7,11); CE2(9,10);
    CE2(0,5); CE2(1,7); CE2(2,9); CE2(3,4); CE2(6,13); CE2(8,14); CE2(10,15); CE2(11,12);
    CE2(0,1); CE2(2,3); CE2(4,5); CE2(6,8); CE2(7,9); CE2(10,11); CE2(12,13); CE2(14,15);
    CE2(0,2); CE2(1,3); CE2(4,10); CE2(5,11); CE2(6,7); CE2(8,9); CE2(12,14); CE2(13,15);
    CE2(1,2); CE2(3,12); CE2(4,6); CE2(5,7); CE2(8,10); CE2(9,11); CE2(13,14);
    CE2(1,4); CE2(2,6); CE2(5,8); CE2(7,10); CE2(9,13); CE2(11,14);
    CE2(2,4); CE2(3,6); CE2(9,12); CE2(11,13);
    CE2(3,5); CE2(6,8); CE2(7,9); CE2(10,12);
    CE2(3,4); CE2(5,6); CE2(7,8); CE2(9,10); CE2(11,12);
    CE2(6,7); CE2(8,9);
#undef CE2
}
NET_HD void merge16_desc(float (&a)[16], const float (&b)[16]) {
#pragma unroll
    for (int i = 0; i < 16; ++i) a[i] = fmaxf(a[i], b[15 - i]);
#pragma unroll
    for (int j = 8; j > 0; j >>= 1) {
#pragma unroll
        for (int i = 0; i < 16; ++i) { const int l = i ^ j; if (l > i) CE_DESC(a[i], a[l]); }
    }
}
NET_HD void top16_of_64(float (&g0)[16], float (&g1)[16], float (&g2)[16], float (&g3)[16]) {
    sort16_desc(g0); sort16_desc(g1); sort16_desc(g2); sort16_desc(g3);
    merge16_desc(g0, g1); merge16_desc(g2, g3); merge16_desc(g0, g2);
}
NET_HD float u2f(unsigned u) { return NET_U2F(u); }
NET_HD unsigned f2u(float f) { return NET_F2U(f); }
template <class V16>
NET_HD void lane_top16(const V16& s0, const V16& s1, const V16& s2, const V16& s3, int hi, float (&out)[16]) {
    float g0[16], g1[16], g2[16], g3[16];
#pragma unroll
    for (int r = 0; r < 16; ++r) {
        const unsigned nb = (unsigned)((r & 3) + 8 * (r >> 2));
        g0[r] = u2f((f2u(s0[r]) & 0xFFFFFF80u) | nb); g1[r] = u2f((f2u(s1[r]) & 0xFFFFFF80u) | (nb + 32u));
        g2[r] = u2f((f2u(s2[r]) & 0xFFFFFF80u) | (nb + 64u)); g3[r] = u2f((f2u(s3[r]) & 0xFFFFFF80u) | (nb + 96u));
    }
    top16_of_64(g0, g1, g2, g3);
    const unsigned h4 = (unsigned)hi << 2;
#pragma unroll
    for (int i = 0; i < 16; ++i) out[i] = u2f(f2u(g0[i]) | h4);
}
constexpr int cand_slot(int a, int b) { int n = 0; for (int x = 0; x < 16; ++x) for (int y = 0; y < 16; ++y) { if (x == a && y == b) return n; if ((x + 1) * (y + 1) <= 16) ++n; } return n; }
NET_HD void cand_top16(const float (&s1)[16], const float (&s2)[16], float (&c)[16]) {
    float g0[16], g1[16], g2[16], g3[16];
#pragma unroll
    for (int i = 0; i < 16; ++i) { g0[i] = -3.0e38f; g1[i] = -3.0e38f; g2[i] = -3.0e38f; g3[i] = -3.0e38f; }
#pragma unroll
    for (int a = 0; a < 16; ++a) {
#pragma unroll
        for (int b = 0; b < 16; ++b) {
            if ((a + 1) * (b + 1) <= 16) {
                const int sl = cand_slot(a, b);
                const float v = u2f((f2u(s1[a] + s2[b]) & 0xFFFFFF00u) | (unsigned)(a * 16 + b));
                if (sl < 16) g0[sl & 15] = v; else if (sl < 32) g1[sl & 15] = v; else if (sl < 48) g2[sl & 15] = v; else g3[sl & 15] = v;
            }
        }
    }
    top16_of_64(g0, g1, g2, g3);
#pragma unroll
    for (int i = 0; i < 16; ++i) c[i] = g0[i];
}

__device__ __forceinline__ void phase_route(const Params& P, int l, char* lds) {
    const bf16* XN = (const bf16*)(P.ws + WS_XN);
    const bf16* Wc = (const bf16*)(P.ws + WS_WPQ) + (size_t)l * 2048 * LDW;
    int* EXPp = (int*)(P.ws + WS_EXP);
    float* GATEp = (float*)(P.ws + WS_GATE);
    const int tid = tidx();
    float* xch = (float*)(lds + 16384);
    int tlo, thi, tst; tile_rounds((T / 256) * PH, tlo, thi, tst);
    int nt = D / 64; asm volatile("" : "+s"(nt));
    for (int u = tlo; u < thi; u += tst) {
        const int tm = u >> 3, h = u & 7;
        float Lk[16];
        {
            f32x4 acc[2][2][4][2]; float ssd[2][2];
            gemm8_kloop<false, true>(Wc + (size_t)(h * 256) * LDW, LDW, XN + (size_t)(tm * 256) * LDX, LDX, nt, acc, ssd, lds, tid);
            const int te = tidx(), fq = (te >> 4) & 3;
            const unsigned fqb = (unsigned)fq << 2;
#pragma unroll
            for (int i = 0; i < 16; ++i) Lk[i] = 0.f;
#pragma unroll
            for (int bj = 0; bj < 2; ++bj)
#pragma unroll
                for (int n = 0; n < 2; ++n) {
                    float g0[16], g1[16];
#pragma unroll
                    for (int m = 0; m < 4; ++m)
#pragma unroll
                        for (int j = 0; j < 4; ++j) {
                            const unsigned kb = (unsigned)(m * 16 + j) | fqb;
                            g0[m * 4 + j] = u2f((f2u(acc[0][bj][m][n][j]) & 0xFFFFFF80u) | kb);
                            g1[m * 4 + j] = u2f((f2u(acc[1][bj][m][n][j]) & 0xFFFFFF80u) | (kb + 64u));
                        }
                    sort16_desc(g0); sort16_desc(g1); merge16_desc(g0, g1);
                    float o[16];
#pragma unroll
                    for (int i = 0; i < 16; ++i) o[i] = __shfl_xor(g0[i], 16, 64);
                    merge16_desc(g0, o);
#pragma unroll
                    for (int i = 0; i < 16; ++i) o[i] = __shfl_xor(g0[i], 32, 64);
                    merge16_desc(g0, o);
                    const bool mine = fq == bj * 2 + n;
#pragma unroll
                    for (int i = 0; i < 16; ++i) Lk[i] = mine ? g0[i] : Lk[i];
                }
        }
        __syncthreads();
        const int te = tidx(), lane = te & 63, w = te >> 6, wr = w >> 2, wc = w & 3, fr = lane & 15, fq = lane >> 4;
        if (wr == 1) {
#pragma unroll
            for (int q = 0; q < 4; ++q) *(float4*)(xch + ((wc * 64 + lane) * 16) + 4 * q) = make_float4(Lk[4 * q], Lk[4 * q + 1], Lk[4 * q + 2], Lk[4 * q + 3]);
        }
        __syncthreads();
        if (wr == 0) {
            float L1[16];
#pragma unroll
            for (int q = 0; q < 4; ++q) { const float4 v = *(const float4*)(xch + ((wc * 64 + lane) * 16) + 4 * q); L1[4 * q] = v.x; L1[4 * q + 1] = v.y; L1[4 * q + 2] = v.z; L1[4 * q + 3] = v.w; }
            float c[16];
            cand_top16(Lk, L1, c);
            unsigned char* my = (unsigned char*)lds + te * 32;
            {
                uint4 a, b;
#define PK4(L, i) ((__float_as_uint(L[i]) & 127u) | ((__float_as_uint(L[i + 1]) & 127u) << 8) | ((__float_as_uint(L[i + 2]) & 127u) << 16) | ((__float_as_uint(L[i + 3]) & 127u) << 24))
                a.x = PK4(Lk, 0); a.y = PK4(Lk, 4); a.z = PK4(Lk, 8); a.w = PK4(Lk, 12);
                b.x = PK4(L1, 0); b.y = PK4(L1, 4); b.z = PK4(L1, 8); b.w = PK4(L1, 12);
#undef PK4
                *(uint4*)my = a; *(uint4*)(my + 16) = b;
            }
            int ev[16]; float gv[16]; float den = 0.f;
#pragma unroll
            for (int k = 0; k < 16; ++k) {
                const unsigned ci = __float_as_uint(c[k]) & 255u;
                const int n1 = my[ci >> 4], n2 = my[16 + (ci & 15)];
                ev[k] = n1 * NKEY + n2;
                gv[k] = __expf(c[k] - c[0]); den += gv[k];
            }
            const float iden = 1.f / den;
            const int t = tm * 256 + (fq >> 1) * 128 + wc * 32 + (fq & 1) * 16 + fr;
            uint4* ep = (uint4*)(EXPp + (size_t)t * HK + h * 16);
            float4* gp = (float4*)(GATEp + (size_t)t * HK + h * 16);
#pragma unroll
            for (int q = 0; q < 4; ++q) {
                ep[q] = make_uint4((unsigned)ev[4 * q], (unsigned)ev[4 * q + 1], (unsigned)ev[4 * q + 2], (unsigned)ev[4 * q + 3]);
                gp[q] = make_float4(gv[4 * q] * iden, gv[4 * q + 1] * iden, gv[4 * q + 2] * iden, gv[4 * q + 3] * iden);
            }
        }
        __syncthreads();
    }
}

constexpr size_t WS_PART = WS_PROJ;
static_assert((size_t)8 * T * HK * 4 <= WS_K - WS_PROJ, "PART alias");
constexpr int XI_X = 0, XI_RANK = 1, XI_J = 2, XI_NX = 3, XI_NLOC = 4;
constexpr int CTL_CENSUS = 4096;
constexpr int CTL_BYTES = (CTL_CENSUS + 16) * 4;

template <int M1, int M2, int M3, class TT>
__device__ __forceinline__ void red16x3(TT (&p)[16], int lane) {
#pragma unroll
    for (int i = 0; i < 8; ++i) { const bool up = lane & M1; const TT send = up ? p[i] : p[i + 8], keep = up ? p[i + 8] : p[i]; p[i] = keep + __shfl_xor(send, M1, 64); }
#pragma unroll
    for (int i = 0; i < 4; ++i) { const bool up = lane & M2; const TT send = up ? p[i] : p[i + 4], keep = up ? p[i + 4] : p[i]; p[i] = keep + __shfl_xor(send, M2, 64); }
#pragma unroll
    for (int i = 0; i < 2; ++i) { const bool up = lane & M3; const TT send = up ? p[i] : p[i + 2], keep = up ? p[i + 2] : p[i]; p[i] = keep + __shfl_xor(send, M3, 64); }
}
__device__ __forceinline__ void phase_gu(const Params& P, int l, const volatile int* xi) {
    const unsigned char* XQ = P.ws + WS_XQ;
    const float* XSc = (const float*)(P.ws + WS_XS);
    const int* EXPp = (const int*)(P.ws + WS_EXP);
    float* PART = (float*)(P.ws + WS_PART);
    const int tid = tidx(), lane = tid & 63, w = tid >> 6, g = lane >> 3, c = lane & 7;
    int xo_ = 0; asm volatile("" : "+v"(xo_));
    const int j = __builtin_amdgcn_readfirstlane(xi[xo_ + XI_J]), nx = __builtin_amdgcn_readfirstlane(xi[xo_ + XI_NX]), nloc = __builtin_amdgcn_readfirstlane(xi[xo_ + XI_NLOC]), rank = __builtin_amdgcn_readfirstlane(xi[xo_ + XI_RANK]);
    const int t0 = rank * NW + w, st = nloc * NW;
    const int n = (t0 < T) ? (T - t0 + st - 1) / st : 0;
    const int i0 = 8 * (c & 1) + 4 * ((c >> 1) & 1) + 2 * ((c >> 2) & 1);
    for (int sl = j; sl < 8 && n > 0; sl += nx) {
        const unsigned char* Us = P.ws + WS_TABU + ((size_t)(l * 8 + sl) * NEXP) * 128;
        const unsigned co = (unsigned)c << 4;
        float* part = PART + (size_t)sl * T * HK;
        const unsigned char* xs = XQ + sl * 128 + c * 16;
#define GU_TK(k) (t0 + (((k) < n) ? (k) : (n - 1)) * st)
#define GU_LOADE(S, t) do { S##lo = EXPp[(size_t)(t) * HK + lane]; S##hi = EXPp[(size_t)(t) * HK + 64 + lane]; } while (0)
#define GU_LOADX(S, t) do { S##a = *(const uint4*)(xs + (size_t)(t) * D); S##s = XSc[t]; } while (0)
#define GU_ISSUE(R, S) do { _Pragma("unroll") for (int i = 0; i < 16; ++i) { \
            const int e = __builtin_amdgcn_ds_bpermute((((8 * i) & 63) + g) << 2, (i < 8) ? S##lo : S##hi); R[i] = *(const uint4*)(Us + (((unsigned)e << 7) | co)); } } while (0)
#define GU_FINISH(R, S, t) do { \
            int p[16]; \
            _Pragma("unroll") for (int i = 0; i < 16; ++i) { int d_ = __builtin_amdgcn_sdot4((int)S##a.x, (int)R[i].x, 0, false); d_ = __builtin_amdgcn_sdot4((int)S##a.y, (int)R[i].y, d_, false); \
                d_ = __builtin_amdgcn_sdot4((int)S##a.z, (int)R[i].z, d_, false); p[i] = __builtin_amdgcn_sdot4((int)S##a.w, (int)R[i].w, d_, false); } \
            red16x3<1, 2, 4, int>(p, lane); \
            part[(size_t)(t) * HK + 8 * i0 + g] = (float)p[0] * S##s; part[(size_t)(t) * HK + 8 * (i0 + 1) + g] = (float)p[1] * S##s; } while (0)
        int eAlo, eAhi, eBlo, eBhi; uint4 xAa, xBa; float xAs, xBs; uint4 rA[16], rB[16];
        GU_LOADE(eA, GU_TK(0)); GU_LOADX(xA, GU_TK(0)); GU_LOADE(eB, GU_TK(1));
        GU_ISSUE(rA, eA);
        for (int k = 0; k < n; k += 2) {
            GU_LOADX(xB, GU_TK(k + 1)); GU_ISSUE(rB, eB); GU_LOADE(eA, GU_TK(k + 2));
            GU_FINISH(rA, xA, GU_TK(k));
            GU_LOADX(xA, GU_TK(k + 2)); GU_ISSUE(rA, eA); GU_LOADE(eB, GU_TK(k + 3));
            GU_FINISH(rB, xB, GU_TK(k + 1));
        }
#undef GU_TK
#undef GU_LOADE
#undef GU_LOADX
#undef GU_ISSUE
#undef GU_FINISH
    }
}
__device__ __forceinline__ void phase_gw(const Params& P, int l) {
    const int* EXPp = (const int*)(P.ws + WS_EXP);
    const float* GATEp = (const float*)(P.ws + WS_GATE);
    const float* PART = (const float*)(P.ws + WS_PART);
    const float* SU = (const float*)(P.ws + WS_TSCU) + (size_t)l * NEXP;
    const float* SV = (const float*)(P.ws + WS_TSCV) + (size_t)l * NEXP;
    unsigned char* WQ = P.ws + WS_WQ8;
    float* WSC = (float*)(P.ws + WS_WSC);
    const int lane = tidx() & 63;
    for (int tb = gwave() * 4; tb < T; tb += nwave() * 4) {
        float wv[4][2];
#pragma unroll
        for (int q = 0; q < 4; ++q)
#pragma unroll
            for (int hk = 0; hk < 2; ++hk) {
                const size_t i = (size_t)(tb + q) * HK + hk * 64 + lane;
                float s = 0.f;
#pragma unroll
                for (int x = 0; x < 8; ++x) s += PART[(size_t)x * T * HK + i];
                const int e = EXPp[i];
                wv[q][hk] = GATEp[i] * gelu_exact(s * SU[e]) * SV[e];
            }
#pragma unroll
        for (int q = 0; q < 4; ++q) {
            float am = fmaxf(fabsf(wv[q][0]), fabsf(wv[q][1]));
#pragma unroll
            for (int m = 32; m >= 1; m >>= 1) am = fmaxf(am, __shfl_xor(am, m, 64));
            const float sc = (am > 0.f) ? am * (1.f / 448.f) : 1.f, is = 1.f / sc;
            const int pk = __builtin_amdgcn_cvt_pk_fp8_f32(wv[q][0] * is, wv[q][1] * is, 0, false);
            WQ[(size_t)(tb + q) * HK + lane] = (unsigned char)(pk & 255);
            WQ[(size_t)(tb + q) * HK + 64 + lane] = (unsigned char)((pk >> 8) & 255);
            if (lane == 0) WSC[tb + q] = sc;
        }
    }
}
typedef int v2i_t __attribute__((ext_vector_type(2)));
typedef unsigned u32x4_t __attribute__((ext_vector_type(4)));
typedef __attribute__((ext_vector_type(4))) float f32x4;
constexpr int GV_PIECE = 1024 + 16;
constexpr int GV_TILE = 16 * GV_PIECE;
static_assert(NW * GV_TILE + NW * 512 <= LDS_TOTAL, "gv LDS");
__device__ __forceinline__ void phase_gv(const Params& P, int l, const volatile int* xi, char* lds) {
    const int* EXPp = (const int*)(P.ws + WS_EXP);
    const unsigned char* WQ = P.ws + WS_WQ8;
    const float* WSC = (const float*)(P.ws + WS_WSC);
    const int tid = tidx(), lane = tid & 63, w = __builtin_amdgcn_readfirstlane(tid >> 6), g = lane >> 3, pos = lane & 7;
    int xo_ = 0; asm volatile("" : "+v"(xo_));
    const int j = __builtin_amdgcn_readfirstlane(xi[xo_ + XI_J]), nx = __builtin_amdgcn_readfirstlane(xi[xo_ + XI_NX]), nloc = __builtin_amdgcn_readfirstlane(xi[xo_ + XI_NLOC]), rank = __builtin_amdgcn_readfirstlane(xi[xo_ + XI_RANK]);
    const int t0 = rank * NW + w, st = nloc * NW;
    const int n = (t0 < T) ? (T - t0 + st - 1) / st : 0;
    char* tile = lds + w * GV_TILE;
    float* strip = (float*)(lds + NW * GV_TILE) + w * 128;
    typedef __attribute__((address_space(3))) v2i_t* ldsv2_t;
    const unsigned co = (unsigned)(pos ^ g) << 4;
    const int rr = (lane & 15) >> 1, kq = lane >> 4;
    const int rdo = kq * GV_PIECE + rr * 128 + (lane & 1) * 8;
    const bool row0 = (lane & 15) == 0;
    __syncthreads();
    for (int sl = j; sl < 8 && n > 0; sl += nx) {
        const unsigned char* Vs = P.ws + WS_TABV + ((size_t)(l * 8 + sl) * NEXP) * 128;
        const char* hrow = (const char*)P.out + sl * 256 + 4 * lane;
#define GV_TK(k) (t0 + (((k) < n) ? (k) : (n - 1)) * st)
#define GV_LOADE(S, t) do { S##el = EXPp[(size_t)(t) * HK + lane]; S##eh = EXPp[(size_t)(t) * HK + 64 + lane]; } while (0)
#define GV_ISSUE(R, S) do { _Pragma("unroll") for (int i = 0; i < 16; ++i) { \
            const int e = __builtin_amdgcn_ds_bpermute((((8 * i) & 63) + g) << 2, (i < 8) ? S##el : S##eh); R[i] = *(const u32x4_t*)(Vs + (((unsigned)e << 7) | co)); } } while (0)
#define GV_LOADT(S, kk) do { const int t_ = GV_TK(kk); \
            S##a0 = 0; S##a1 = 0; S##a2 = 0; S##a3 = 0; \
            if (row0) { const long* wp = (const long*)(WQ + (size_t)t_ * HK + kq * 8); S##a0 = wp[0]; S##a1 = wp[4]; S##a2 = wp[8]; S##a3 = wp[12]; } \
            S##ws = ((kk) < n) ? WSC[t_] : 0.f; \
            S##hv = *(const unsigned*)(hrow + (size_t)t_ * (HP * 2)); } while (0)
#define GV_TOKEN(R, S, kk) do { \
            const int t = GV_TK(kk); \
            _Pragma("unroll") for (int i = 0; i < 16; ++i) *(u32x4_t*)(tile + i * GV_PIECE + lane * 16) = R[i]; \
            f32x4 acc[8]; \
            _Pragma("unroll") for (int nt = 0; nt < 8; ++nt) acc[nt] = (f32x4){0.f, 0.f, 0.f, 0.f}; \
            _Pragma("unroll") for (int s4 = 0; s4 < 4; ++s4) { \
                const long av = (s4 == 0) ? S##a0 : (s4 == 1) ? S##a1 : (s4 == 2) ? S##a2 : S##a3; \
                _Pragma("unroll") for (int nt = 0; nt < 8; ++nt) { \
                    const v2i_t bv = __builtin_amdgcn_ds_read_tr8_b64_v2i32((ldsv2_t)(void*)(tile + (4 * s4) * GV_PIECE + rdo + ((nt ^ rr) << 4))); \
                    acc[nt] = __builtin_amdgcn_mfma_f32_16x16x32_fp8_fp8(av, __builtin_bit_cast(long, bv), acc[nt], 0, 0, 0); } } \
            if (lane < 16) { _Pragma("unroll") for (int nt = 0; nt < 8; ++nt) strip[16 * nt + lane] = acc[nt][0]; }        \
            { const float2 o2 = *(const float2*)(strip + 2 * lane); \
              if ((kk) < n) *(unsigned*)(hrow + (size_t)t * (HP * 2)) = pack2(bflo(S##hv) + S##ws * o2.x, bfhi(S##hv) + S##ws * o2.y); } } while (0)
        int Ael, Aeh, Bel, Beh; u32x4_t rA[16], rB[16];
        long Pa0, Pa1, Pa2, Pa3, Qa0, Qa1, Qa2, Qa3; float Pws, Qws; unsigned Phv, Qhv;
        GV_LOADE(A, GV_TK(0)); GV_LOADE(B, GV_TK(1));
        GV_ISSUE(rA, A); GV_LOADT(P, 0);
        for (int k = 0; k < n; k += 2) {
            GV_ISSUE(rB, B); GV_LOADE(A, GV_TK(k + 2)); GV_LOADT(Q, k + 1);
            GV_TOKEN(rA, P, k);
            GV_ISSUE(rA, A); GV_LOADE(B, GV_TK(k + 3)); GV_LOADT(P, k + 2);
            GV_TOKEN(rB, Q, k + 1);
        }
#undef GV_TK
#undef GV_LOADE
#undef GV_ISSUE
#undef GV_LOADT
#undef GV_TOKEN
    }
    __syncthreads();
}
__device__ __forceinline__ void phase_gnorm(const Params& P, int l) {
    const int lane = tidx() & 63, nw = nwave();
    bf16* XNw = (bf16*)(P.ws + WS_XN);
    const bf16* Hb = (const bf16*)P.out;
    const float4* g = (const float4*)((l == DEPTH - 1) ? P.norm_final : (P.norm_mix + (l + 1) * D));
    for (int t = gwave(); t < T; t += 2 * nw) {
        const int t2 = (t + nw < T) ? (t + nw) : t;
        float4 v[2][4];
#pragma unroll
        for (int q = 0; q < 4; ++q) {
            const uint2 a = ((const uint2*)(Hb + (size_t)t * HP))[q * 64 + lane], b = ((const uint2*)(Hb + (size_t)t2 * HP))[q * 64 + lane];
            v[0][q] = make_float4(bflo(a.x), bfhi(a.x), bflo(a.y), bfhi(a.y)); v[1][q] = make_float4(bflo(b.x), bfhi(b.x), bflo(b.y), bfhi(b.y));
        }
#pragma unroll
        for (int u = 0; u < 2; ++u) {
            float ss = 0.f;
#pragma unroll
            for (int q = 0; q < 4; ++q) ss += v[u][q].x * v[u][q].x + v[u][q].y * v[u][q].y + v[u][q].z * v[u][q].z + v[u][q].w * v[u][q].w;
            ss = wave_sum(ss);
            const float rn = rsqrtf(ss * (1.f / D) + EPS);
            const int tt = u ? t2 : t;
            if (u == 0 || t2 != t) {
                float4* hr = (float4*)(P.out + (size_t)tt * D);
#pragma unroll
                for (int q = 0; q < 4; ++q) {
                    const float4 gg = g[q * 64 + lane];
                    const float4 o = make_float4(v[u][q].x * rn * gg.x, v[u][q].y * rn * gg.y, v[u][q].z * rn * gg.z, v[u][q].w * rn * gg.w);
                    if (l == DEPTH - 1) hr[q * 64 + lane] = o;
                    else { uint2 uu; uu.x = pack2(o.x, o.y); uu.y = pack2(o.z, o.w); ((uint2*)(XNw + (size_t)tt * LDX))[q * 64 + lane] = uu; }
                }
            }
        }
    }
}

#define XB_TMO      128
#define XB_XCNT(j)  (256  + 64 * (j))
#define XB_XSUB(j)  (1280 + 64 * (j))
#define XB_XGEN(j)  (2304 + 64 * (j))
#define XB_TOP      3328
#define XB_TOPGEN   3392
#define XCD_BAR_WORDS 3456
#define XB_SPIN_CAP (1u << 22)
#define LAS __attribute__((address_space(3)))
__device__ __forceinline__ unsigned xb_ld(unsigned* p)              { return __hip_atomic_load(p, __ATOMIC_RELAXED, __HIP_MEMORY_SCOPE_AGENT); }
__device__ __forceinline__ unsigned xb_add(unsigned* p, unsigned v) { return __hip_atomic_fetch_add(p, v, __ATOMIC_RELAXED, __HIP_MEMORY_SCOPE_AGENT); }
__device__ __forceinline__ unsigned xb_xcc_id() { return (unsigned)__builtin_amdgcn_s_getreg((3 << 11) | 20) & 0xFu; }
#define XB_SPIN(cond, bar) do { unsigned _sp = 0; while (cond) { __builtin_amdgcn_s_sleep(1); \
    if ((++_sp & 255u) == 0u) { if (xb_ld(&(bar)[XB_TMO])) break; if (_sp > XB_SPIN_CAP) { atomicAdd(&(bar)[XB_TMO], 1u); break; } } } } while (0)
struct XcdBarrier { unsigned* bar; unsigned x; volatile LAS unsigned* st; };
__device__ __forceinline__ XcdBarrier xcd_barrier_post(unsigned* bar, volatile LAS unsigned* st) {
    XcdBarrier b; b.bar = bar; b.x = xb_xcc_id(); b.st = st;
    if (__builtin_amdgcn_workitem_id_x() == 0) (void)xb_add(&bar[XB_XCNT(b.x)], 1u);
    return b;
}
__device__ __forceinline__ void xcd_barrier_complete(unsigned* bar, unsigned x, unsigned& nloc, unsigned& nx) {
    const unsigned G = gridDim.x * gridDim.y * gridDim.z;
    unsigned sum, cnt, mine, sp = 0u;
    for (;;) {
        sum = 0u; cnt = 0u; mine = 0u;
#pragma unroll
        for (unsigned j = 0; j < 16; ++j) { const unsigned c = xb_ld(&bar[XB_XCNT(j)]); sum += c; cnt += (c > 0u) ? 1u : 0u; mine = (j == x) ? c : mine; }
        if (sum == G) break;
        __builtin_amdgcn_s_sleep(1);
        if ((++sp & 255u) == 0u) { if (xb_ld(&bar[XB_TMO])) break; if (sp > XB_SPIN_CAP) { atomicAdd(&bar[XB_TMO], 1u); break; } }
    }
    nloc = mine > 0u ? mine : 1u; nx = cnt > 0u ? cnt : 1u;
}
__device__ __forceinline__ void xcd_barrier(const XcdBarrier& b) {
    asm volatile("s_waitcnt vmcnt(0)" ::: "memory");
    __syncthreads();
    if (__builtin_amdgcn_workitem_id_x() == 0) {
        unsigned* bar = b.bar;
        __builtin_amdgcn_s_waitcnt(0);
        unsigned nloc = b.st[0], nx = b.st[1];
        if (nloc == 0u) { xcd_barrier_complete(bar, b.x, nloc, nx); b.st[0] = nloc; b.st[1] = nx; }
        const unsigned old = xb_add(&bar[XB_XSUB(b.x)], 1u);
        const unsigned gen = old / nloc;
        if (old + 1u == (gen + 1u) * nloc) {
            __builtin_amdgcn_fence(__ATOMIC_RELEASE, "agent");
            asm volatile("s_waitcnt vmcnt(0)" ::: "memory");
            const unsigned og = xb_add(&bar[XB_TOP], 1u);
            const unsigned tg = og / nx;
            if (og + 1u == (tg + 1u) * nx) xb_add(&bar[XB_TOPGEN], 1u);
            else XB_SPIN(xb_ld(&bar[XB_TOPGEN]) == tg, bar);
            __builtin_amdgcn_fence(__ATOMIC_ACQUIRE, "agent");
            xb_add(&bar[XB_XGEN(b.x)], 1u);
            asm volatile("s_waitcnt vmcnt(0)" ::: "memory");
        } else {
            XB_SPIN(xb_ld(&bar[XB_XGEN(b.x)]) == gen, bar);
            __builtin_amdgcn_fence(__ATOMIC_ACQUIRE, "agent");
            asm volatile("s_waitcnt vmcnt(0)" ::: "memory");
        }
    }
    __syncthreads();
}

constexpr float QSCALE = 0.10206207261596575f * 1.4426950408889634f;

__device__ __forceinline__ void phase_gemm1(const Params& P, int l, char* lds) {
    unsigned char* ws = P.ws;
    const bf16* XN = (const bf16*)(ws + WS_XN);
    bf16* PROJ = (bf16*)(ws + WS_PROJ);
    bf16* Kb = (bf16*)(ws + WS_K);
    const float* rope = (const float*)(ws + WS_ROPE);
    const bf16* W = (const bf16*)(ws + WS_WIN) + (size_t)l * DINP * LDW;
    float* SSQ = (float*)(ws + WS_SSQ);
    const int lane = tidx() & 63;
    int tlo, thi, tst; tile_rounds((T / 256) * (DINP / 256), tlo, thi, tst);
    gemm_t8<false, false>(W, LDW, DINP, XN, LDX, D, tlo, thi, tst, [&](int t, int n, const float4& v, const float4&) {
        const int nb = __builtin_amdgcn_readfirstlane(n);
        if (nb < C_KR) {
            uint2 o; o.x = cvtpk(v.x, v.y); o.y = cvtpk(v.z, v.w);
            *(uint2*)(PROJ + (size_t)t * DINP + n) = o;
            if (nb >= C_CQ) {
                float q = v.x * v.x + v.y * v.y + v.z * v.z + v.w * v.w;
                q += __shfl_xor(q, 1, 64); q += __shfl_xor(q, 2, 64); q += __shfl_xor(q, 4, 64); q += __shfl_xor(q, 8, 64);
                if (n == nb) SSQ[(size_t)t * 16 + ((nb - C_CQ) >> 6)] = q;
            }
        } else if (nb == C_KR) {
            const float4 up = make_float4(__shfl(v.x, lane + 4, 64), __shfl(v.y, lane + 4, 64), __shfl(v.z, lane + 4, 64), __shfl(v.w, lane + 4, 64));
            const float4 dn = make_float4(__shfl(v.x, lane - 4, 64), __shfl(v.y, lane - 4, 64), __shfl(v.z, lane - 4, 64), __shfl(v.w, lane - 4, 64));
            const int d = n - C_KR;
            if (d < 32) {
                const int b = t / S, s = t % S;
                const bool first = d < 16;
                const int f = first ? d : (d - 16);
                const float4 cs0 = *(const float4*)(rope + ((size_t)s * 16 + f) * 2), cs1 = *(const float4*)(rope + ((size_t)s * 16 + f) * 2 + 4);
                float4 o;
                if (first) o = make_float4(v.x * cs0.x - up.x * cs0.y, v.y * cs0.z - up.y * cs0.w, v.z * cs1.x - up.z * cs1.y, v.w * cs1.z - up.w * cs1.w);
                else       o = make_float4(v.x * cs0.x + dn.x * cs0.y, v.y * cs0.z + dn.y * cs0.w, v.z * cs1.x + dn.z * cs1.y, v.w * cs1.z + dn.w * cs1.w);
                uint2 u; u.x = cvtpk(o.x, o.y); u.y = cvtpk(o.z, o.w);
#pragma unroll
                for (int h = 0; h < NH; ++h) *(uint2*)(Kb + ((size_t)(b * NH + h) * S + s) * DQK + 64 + d) = u;
            }
        }
    }, [](int) { return 1.f; }, [](int, int) { return make_float4(0.f, 0.f, 0.f, 0.f); }, lds);
}
__device__ __forceinline__ void phase_gemm2(const Params& P, int l, char* lds) {
    unsigned char* ws = P.ws;
    const bf16* PROJ = (const bf16*)(ws + WS_PROJ);
    const float* rope = (const float*)(ws + WS_ROPE);
    const float* SSQ = (const float*)(ws + WS_SSQ);
    const int G = gridDim.x, bid = blockIdx.x;
    const int vb = ((G & 7) == 0) ? ((bid & 7) * (G >> 3) + (bid >> 3)) : bid;
    int qlo, qhi, klo, khi;
    if ((G & 1) == 0) {
        const int Gh = G >> 1, pq = (384 + Gh - 1) / Gh, pk = (512 + Gh - 1) / Gh;
        if (vb < Gh) { qlo = vb * pq; qhi = qlo + pq; if (qhi > 384) qhi = 384; if (qlo > 384) qlo = 384; klo = 0; khi = 0; }
        else { klo = (vb - Gh) * pk; khi = klo + pk; if (khi > 512) khi = 512; if (klo > 512) klo = 512; qlo = 0; qhi = 0; }
    } else { tile_range(384, qlo, qhi); tile_range(512, klo, khi); }
    {
        const bf16* W = (const bf16*)(ws + WS_WUQ) + (size_t)l * 768 * QR;
        bf16* Qb = (bf16*)(ws + WS_Q);
        gemm_t8<true, false>(W, QR, 768, PROJ + C_CQ, DINP, QR, qlo, qhi, 1,
            [&](int t, int n, const float4& v, const float4&) {
                const int b = t / S, s = t % S, h = n / DQK, d = n % DQK;
                float4 o = v;
                const int lane = tidx() & 63;
                const float4 up = make_float4(__shfl(v.x, lane + 4, 64), __shfl(v.y, lane + 4, 64), __shfl(v.z, lane + 4, 64), __shfl(v.w, lane + 4, 64));
                const float4 dn = make_float4(__shfl(v.x, lane - 4, 64), __shfl(v.y, lane - 4, 64), __shfl(v.z, lane - 4, 64), __shfl(v.w, lane - 4, 64));
                if (d >= 64) {
                    const bool first = d < 80;
                    const int f = first ? (d - 64) : (d - 80);
                    const float4 cs0 = *(const float4*)(rope + ((size_t)s * 16 + f) * 2), cs1 = *(const float4*)(rope + ((size_t)s * 16 + f) * 2 + 4);
                    if (first) o = make_float4(v.x * cs0.x - up.x * cs0.y, v.y * cs0.z - up.y * cs0.w, v.z * cs1.x - up.z * cs1.y, v.w * cs1.z - up.w * cs1.w);
                    else       o = make_float4(v.x * cs0.x + dn.x * cs0.y, v.y * cs0.z + dn.y * cs0.w, v.z * cs1.x + dn.z * cs1.y, v.w * cs1.z + dn.w * cs1.w);
                }
                uint2 u; u.x = cvtpk(o.x, o.y); u.y = cvtpk(o.z, o.w);
                *(uint2*)(Qb + ((size_t)(b * NH + h) * S + s) * DQK + d) = u;
            }, [&](int t) { const float4 a = *(const float4*)(SSQ + (size_t)t * 16); const float2 b = *(const float2*)(SSQ + (size_t)t * 16 + 4);
                            return rsqrtf(((a.x + a.y) + (a.z + a.w) + (b.x + b.y)) * (1.f / QR) + EPS) * QSCALE; }, [](int, int) { return make_float4(0.f, 0.f, 0.f, 0.f); }, lds);
    }
    {
        const bf16* W = (const bf16*)(ws + WS_WUKV) + (size_t)l * 1024 * KVR;
        bf16* Kb = (bf16*)(ws + WS_K); bf16* Vb = (bf16*)(ws + WS_V);
        gemm_t8<true, false>(W, KVR, 1024, PROJ + C_CKV, DINP, KVR, klo, khi, 1,
            [&](int t, int n, const float4& v, const float4&) {
                const int b = t / S, s = t % S;
                uint2 u; u.x = cvtpk(v.x, v.y); u.y = cvtpk(v.z, v.w);
                if (n < 512) *(uint2*)(Kb + ((size_t)(b * NH + (n >> 6)) * S + s) * DQK + (n & 63)) = u;
                else         *(uint2*)(Vb + ((size_t)(b * NH + ((n - 512) >> 6)) * S + s) * DV + (n & 63)) = u;
            }, [&](int t) { const float2 a = *(const float2*)(SSQ + (size_t)t * 16 + 6); const float2 b = *(const float2*)(SSQ + (size_t)t * 16 + 8);
                            return rsqrtf(((a.x + a.y) + (b.x + b.y)) * (1.f / KVR) + EPS); }, [](int, int) { return make_float4(0.f, 0.f, 0.f, 0.f); }, lds);
    }
}
constexpr size_t WS_YO = WS_PROJ;
__device__ __forceinline__ void phase_gemm3(const Params& P, int l, char* lds) {
    unsigned char* ws = P.ws;
    const bf16* Yb = (const bf16*)(ws + WS_XN);
    const bf16* W = (const bf16*)(ws + WS_WOUT) + (size_t)l * D * LDW;
    bf16* YO = (bf16*)(ws + WS_YO);
    int tlo, thi, tst; tile_rounds((T / 256) * (D / 256), tlo, thi, tst);
    gemm_t8<false, false>(W, LDW, D, Yb, LDX, D, tlo, thi, tst, [&](int t, int n, const float4& v, const float4&) {
        uint2 o; o.x = cvtpk(v.x, v.y); o.y = cvtpk(v.z, v.w);
        *(uint2*)(YO + (size_t)t * D + n) = o;
    }, [](int) { return 1.f; }, [](int, int) { return make_float4(0.f, 0.f, 0.f, 0.f); }, lds);
}

#define GSYNC() do { XcdBarrier xb_; { __attribute__((address_space(1))) char* gp_ = (__attribute__((address_space(1))) char*)(char*)(P.ws + WS_CTL); asm volatile("" : "+s"(gp_)); xb_.bar = (unsigned*)(char*)gp_; } \
    xb_.x = xb_xcc_id(); xb_.st = (volatile LAS unsigned*)&xb_words; xcd_barrier(xb_); } while (0)
#define PHASE(stmt) { const Params Q = launder(P); stmt; }
__global__ void __launch_bounds__(NTHREADS, 2) k_all(Params P) {
    __shared__ __attribute__((aligned(16))) char sm[LDS_TOTAL];
    __shared__ uint4 xb_words;
    cg::grid_group grid = cg::this_grid();
    if (__builtin_amdgcn_workitem_id_x() == 0) xb_words = make_uint4(0u, 0u, 0u, 0u);
    __syncthreads();
    (void)xcd_barrier_post((unsigned*)(P.ws + WS_CTL), (volatile LAS unsigned*)&xb_words);
    __shared__ int xinfo[8];
    if (__builtin_amdgcn_workitem_id_x() == 0) {
        const unsigned x = xb_xcc_id();
        xinfo[XI_X] = (int)x; xinfo[XI_RANK] = (int)xb_add((unsigned*)(P.ws + WS_CTL) + CTL_CENSUS + x, 1u);
    }
    PHASE(phase_prep(Q, sm));
    PHASE(phase_norm(Q.x, Q.norm_mix, (bf16*)(Q.ws + WS_XN)));
    if (P.ws == nullptr) grid.sync();
    GSYNC();
    if (__builtin_amdgcn_workitem_id_x() == 0) {
        unsigned* cen = (unsigned*)(P.ws + WS_CTL) + CTL_CENSUS;
        const int x = xinfo[XI_X]; int nx = 0, jj = 0;
        for (int q = 0; q < 16; ++q) { const unsigned cq = xb_ld(cen + q); if (cq) { if (q < x) ++jj; ++nx; } }
        xinfo[XI_J] = jj; xinfo[XI_NX] = nx; xinfo[XI_NLOC] = (int)xb_ld(cen + x);
    }
    __syncthreads();
    for (int l = 0; l < DEPTH; ++l) {
        PHASE(phase_gemm1(Q, l, sm));
#if PROBE_DUP & 2
        PHASE(phase_gemm1(Q, l, sm));
#endif
        GSYNC();
        PHASE(phase_mixlocal(Q, l, sm));
#if PROBE_DUP & 256
        PHASE(phase_mixlocal(Q, l, sm));
#endif
        PHASE(phase_gemm2(Q, l, sm));
#if PROBE_DUP & 4
        PHASE(phase_gemm2(Q, l, sm));
#endif
        GSYNC();
        PHASE(phase_attn(Q, sm));
#if PROBE_DUP & 8
        PHASE(phase_attn(Q, sm));
#endif
        GSYNC();
        PHASE(phase_gemm3(Q, l, sm));
#if PROBE_DUP & 16
        if (l == 0) PHASE(phase_gemm3(Q, l, sm));
#endif
        GSYNC();
        PHASE(phase_norm_q(Q, l));
#if PROBE_DUP & 512
        PHASE(phase_norm_q(Q, l));
#endif
        GSYNC();
        PHASE(phase_route(Q, l, sm));
#if PROBE_DUP & 32
        PHASE(phase_route(Q, l, sm));
#endif
        GSYNC();
        PHASE(phase_gu(Q, l, xinfo));
#if PROBE_DUP & 64
        PHASE(phase_gu(Q, l, xinfo));
#endif
        GSYNC();
        PHASE(phase_gw(Q, l));
#if PROBE_DUP & 128
        PHASE(phase_gw(Q, l));
#endif
        GSYNC();
        PHASE(phase_gv(Q, l, xinfo, sm));
        GSYNC();
        PHASE(phase_gnorm(Q, l));
        GSYNC();
    }
}

extern "C" void kernel_launch(void* const* d_in, const int* in_sizes, int n_in, void* d_out, int out_size, void* d_ws, size_t ws_size, hipStream_t stream) {
    static int grid = 0;
    if (grid == 0) {
        if (n_in != 18 || out_size != T * D || ws_size < WS_END) { fprintf(stderr, "kernel_launch: bad sizes n_in %d out %d ws %zu need %zu\n", n_in, out_size, ws_size, (size_t)WS_END); grid = -1; return; }
        int dev = 0, cus = 0, per_cu = 0;
        (void)hipGetDevice(&dev);
        (void)hipDeviceGetAttribute(&cus, hipDeviceAttributeMultiprocessorCount, dev);
        (void)hipOccupancyMaxActiveBlocksPerMultiprocessor(&per_cu, (const void*)k_all, NTHREADS, 0);
        if (per_cu > 1) per_cu = 1;
        if (per_cu < 1) { fprintf(stderr, "kernel_launch: occupancy query says %d\n", per_cu); grid = -1; return; }
        grid = cus * per_cu;
    }
    if (grid < 0) return;
    Params p{};
    p.x = (const float*)d_in[0]; p.norm_mix = (const float*)d_in[1]; p.w_in = (const float*)d_in[2]; p.conv_w = (const float*)d_in[3];
    p.pool_w = (const float*)d_in[4]; p.pool_scale = (const float*)d_in[5]; p.q_norm = (const float*)d_in[6]; p.w_uq = (const float*)d_in[7];
    p.kv_norm = (const float*)d_in[8]; p.w_uk = (const float*)d_in[9]; p.w_uv = (const float*)d_in[10]; p.w_out = (const float*)d_in[11];
    p.norm_ffn = (const float*)d_in[12]; p.peer_wq = (const float*)d_in[13]; p.peer_subkeys = (const float*)d_in[14]; p.peer_u = (const float*)d_in[15];
    p.peer_v = (const float*)d_in[16]; p.norm_final = (const float*)d_in[17];
    p.out = (float*)d_out; p.ws = (unsigned char*)d_ws;
    if (hipMemsetAsync((char*)d_ws + WS_CTL, 0, CTL_BYTES, stream) != hipSuccess) { fprintf(stderr, "kernel_launch: memset failed\n"); return; }
    void* args[] = {&p};
    hipError_t e = hipLaunchCooperativeKernel((const void*)k_all, dim3(grid), dim3(NTHREADS), args, 0, stream);
    if (e != hipSuccess) fprintf(stderr, "cooperative launch failed: %s (grid %d)\n", hipGetErrorString(e), grid);
}
```

```cpp
#include <hip/hip_runtime.h>
#include <hip/hip_cooperative_groups.h>
#include <cstdio>
#include <cstdint>
namespace cg = cooperative_groups;

#ifndef TAB_FP8
#define TAB_FP8 1
#endif
#ifndef PROBE_DUP
#define PROBE_DUP 0
#endif

constexpr int NB = 4, S = 8192, T = NB * S, D = 1024, DEPTH = 2;
constexpr int DIN = 1696, DINP = 1792;
constexpr int C_BG = 0, C_CG = 256, C_HC = 512, C_HP = 768, C_CQ = 1024, C_CKV = 1408, C_KR = 1664;
constexpr int QR = 384, KVR = 256, NH = 8, DQK = 96, DV = 64;
constexpr int PH = 8, NKEY = 128, NEXP = NKEY * NKEY, TOPK = 16, HK = PH * TOPK;
constexpr float EPS = 1e-6f;
constexpr int LDX = 1088;
constexpr int LDW = 1088;

typedef unsigned short bf16;
constexpr int HP = 2 * D;

constexpr size_t WS_CTL   = 0;
constexpr size_t WS_ROPE  = 64 * 1024;
constexpr size_t WS_WIN   = WS_ROPE + (size_t)S * 16 * 2 * 4;
constexpr size_t WS_WUQ   = WS_WIN + (size_t)DEPTH * DINP * LDW * 2;
constexpr size_t WS_WUKV  = WS_WUQ + (size_t)DEPTH * 768 * QR * 2;
constexpr size_t WS_WOUT  = WS_WUKV + (size_t)DEPTH * 1024 * KVR * 2;
constexpr size_t WS_WPQ   = WS_WOUT + (size_t)DEPTH * D * LDW * 2;
constexpr size_t WS_XN    = ((WS_WPQ + (size_t)DEPTH * 2048 * LDW * 2 + 4095) / 4096) * 4096;
constexpr size_t WS_PROJ  = WS_XN + (size_t)T * LDX * 2;
constexpr size_t WS_Q     = WS_PROJ + (size_t)T * DINP * 2;
constexpr size_t WS_K     = WS_Q + (size_t)T * NH * DQK * 2;
constexpr size_t WS_V     = WS_K + (size_t)T * NH * DQK * 2;
constexpr size_t WS_EXP   = WS_V + (size_t)T * NH * DV * 2;
constexpr size_t WS_GATE  = WS_EXP + (size_t)T * HK * 4;
constexpr size_t TAB_ROWB = TAB_FP8 ? 1024 : 2048;
constexpr size_t WS_TABU  = WS_GATE + (size_t)T * HK * 4;
constexpr size_t WS_TABV  = WS_TABU + (size_t)DEPTH * NEXP * TAB_ROWB;
constexpr size_t WS_TSCU  = WS_TABV + (size_t)DEPTH * NEXP * TAB_ROWB;
constexpr size_t WS_TSCV  = WS_TSCU + (size_t)DEPTH * NEXP * 4;
constexpr size_t WS_XQ    = WS_TSCV + (size_t)DEPTH * NEXP * 4;
constexpr int XQP = 1088;
constexpr size_t WS_XS    = WS_XQ + (size_t)T * XQP;
constexpr size_t WS_WQ8   = WS_XS + (size_t)T * 4;
constexpr size_t WS_WSC   = WS_WQ8 + (size_t)T * HK;
constexpr size_t WS_SSQ   = WS_WSC + (size_t)T * 4;
constexpr size_t WS_WC8   = WS_SSQ + (size_t)T * 64;
constexpr size_t WS_WCS   = WS_WC8 + (size_t)DEPTH * 2048 * XQP;
constexpr size_t WS_END   = WS_WCS + (size_t)DEPTH * 2048 * 4;
static_assert(WS_END <= (size_t)512 * 1024 * 1024, "workspace budget");

struct Params {
    const float* x; const float* norm_mix; const float* w_in; const float* conv_w; const float* pool_w; const float* pool_scale;
    const float* q_norm; const float* w_uq; const float* kv_norm; const float* w_uk; const float* w_uv; const float* w_out;
    const float* norm_ffn; const float* peer_wq; const float* peer_subkeys; const float* peer_u; const float* peer_v; const float* norm_final;
    float* out; unsigned char* ws;
};

__device__ __forceinline__ bf16 f2bf(float f) { unsigned u = __float_as_uint(f); u += 0x7fffu + ((u >> 16) & 1u); return (bf16)(u >> 16); }
__device__ __forceinline__ float bf2f(bf16 h) { return __uint_as_float(((unsigned)h) << 16); }
__device__ __forceinline__ float bflo(unsigned u) { return __uint_as_float(u << 16); }
__device__ __forceinline__ float bfhi(unsigned u) { return __uint_as_float(u & 0xffff0000u); }
__device__ __forceinline__ unsigned pack2(float a, float b) { return (unsigned)f2bf(a) | ((unsigned)f2bf(b) << 16); }
__device__ __forceinline__ float wave_sum(float v) {
#pragma unroll
    for (int m = 32; m >= 1; m >>= 1) v += __shfl_xor(v, m, 64);
    return v;
}
__device__ __forceinline__ float gelu_exact(float x) { return 0.5f * x * (1.f + erff(x * 0.70710678118654752f)); }

#define NTHREADS 512
constexpr int NW = NTHREADS / 64;
__device__ __forceinline__ int tidx() { int t = (int)__builtin_amdgcn_workitem_id_x(); asm volatile("" : "+v"(t)); return t; }
__device__ __forceinline__ int gwave() { return blockIdx.x * (NTHREADS / 64) + (tidx() >> 6); }
__device__ __forceinline__ int nwave() { return gridDim.x * (NTHREADS / 64); }
__device__ __forceinline__ size_t gtid() { return (size_t)blockIdx.x * NTHREADS + tidx(); }
__device__ __forceinline__ size_t gnth() { return (size_t)gridDim.x * NTHREADS; }


__device__ __forceinline__ Params launder(const Params& P) {
    typedef __attribute__((address_space(1))) char* gp_t;
    gp_t g[20] = {(gp_t)(char*)P.x, (gp_t)(char*)P.norm_mix, (gp_t)(char*)P.w_in, (gp_t)(char*)P.conv_w, (gp_t)(char*)P.pool_w, (gp_t)(char*)P.pool_scale, (gp_t)(char*)P.q_norm, (gp_t)(char*)P.w_uq,
                  (gp_t)(char*)P.kv_norm, (gp_t)(char*)P.w_uk, (gp_t)(char*)P.w_uv, (gp_t)(char*)P.w_out, (gp_t)(char*)P.norm_ffn, (gp_t)(char*)P.peer_wq, (gp_t)(char*)P.peer_subkeys,
                  (gp_t)(char*)P.peer_u, (gp_t)(char*)P.peer_v, (gp_t)(char*)P.norm_final, (gp_t)(char*)P.out, (gp_t)(char*)P.ws};
    asm volatile("" : "+s"(g[0]), "+s"(g[1]), "+s"(g[2]), "+s"(g[3]), "+s"(g[4]), "+s"(g[5]), "+s"(g[6]), "+s"(g[7]), "+s"(g[8]), "+s"(g[9]));
    asm volatile("" : "+s"(g[10]), "+s"(g[11]), "+s"(g[12]), "+s"(g[13]), "+s"(g[14]), "+s"(g[15]), "+s"(g[16]), "+s"(g[17]), "+s"(g[18]), "+s"(g[19]));
    Params Q;
    Q.x = (const float*)(char*)g[0]; Q.norm_mix = (const float*)(char*)g[1]; Q.w_in = (const float*)(char*)g[2]; Q.conv_w = (const float*)(char*)g[3]; Q.pool_w = (const float*)(char*)g[4];
    Q.pool_scale = (const float*)(char*)g[5]; Q.q_norm = (const float*)(char*)g[6]; Q.w_uq = (const float*)(char*)g[7]; Q.kv_norm = (const float*)(char*)g[8]; Q.w_uk = (const float*)(char*)g[9];
    Q.w_uv = (const float*)(char*)g[10]; Q.w_out = (const float*)(char*)g[11]; Q.norm_ffn = (const float*)(char*)g[12]; Q.peer_wq = (const float*)(char*)g[13]; Q.peer_subkeys = (const float*)(char*)g[14];
    Q.peer_u = (const float*)(char*)g[15]; Q.peer_v = (const float*)(char*)g[16]; Q.norm_final = (const float*)(char*)g[17]; Q.out = (float*)(char*)g[18]; Q.ws = (unsigned char*)(char*)g[19];
    return Q;
}

typedef __attribute__((ext_vector_type(8))) short bf16x8;
typedef __attribute__((ext_vector_type(16))) float f32x16;
typedef __attribute__((ext_vector_type(2))) __bf16 bf2_t;
#define MFMA32(a, b, c) __builtin_amdgcn_mfma_f32_32x32x16_bf16(a, b, c, 0, 0, 0)
__device__ __forceinline__ int crow(int r, int hi) { return (r & 3) + 8 * (r >> 2) + 4 * hi; }
__device__ __forceinline__ float dot2bf(unsigned a, unsigned b, float c) { return __builtin_amdgcn_fdot2_f32_bf16(__builtin_bit_cast(bf2_t, a), __builtin_bit_cast(bf2_t, b), c, false); }
__device__ __forceinline__ unsigned cvtpk(float lo, float hi) { unsigned r; asm("v_cvt_pk_bf16_f32 %0, %1, %2" : "=v"(r) : "v"(lo), "v"(hi)); return r; }
constexpr int LDS_TOTAL = 140 * 1024;

template <int WT, bool ROWSS>
__device__ __forceinline__ void gemm_kloop(const bf16* __restrict__ Ag0, int lda, const bf16* __restrict__ Bg0, int ldb, int nk, f32x16 (&acc)[8], float (&ss)[4], char* lds, int tid) {
    constexpr int BROWS = (WT == 0) ? 256 : 128, NPB = BROWS / 64;
    constexpr int OPA = 256 * 128, G_BUF = OPA + BROWS * 128;
    const int lane = tid & 63, w = __builtin_amdgcn_readfirstlane(tid >> 6), r32 = lane & 31, hi = lane >> 5;
    const int srow = 8 * w + (lane >> 3);
    const int sch = (lane & 7) ^ ((srow >> 1) & 7);
    const bf16* Ag = Ag0 + (size_t)srow * lda + sch * 8;
    const bf16* Bg = Bg0 + (size_t)srow * ldb + sch * 8;
#pragma unroll
    for (int i = 0; i < 8; ++i)
#pragma unroll
        for (int r = 0; r < 16; ++r) acc[i][r] = 0.f;
    ss[0] = 0.f; ss[1] = 0.f; ss[2] = 0.f; ss[3] = 0.f;
    typedef __attribute__((address_space(3))) unsigned* ldsp_t;
    typedef const __attribute__((address_space(1))) unsigned* glbp_t;
#define G_DMA(buf, kofs) do { char* d_ = lds + (buf) * G_BUF + (8 * w) * 128; \
    _Pragma("unroll") for (int i = 0; i < 4; ++i) \
        __builtin_amdgcn_global_load_lds((glbp_t)(const void*)(Ag + (size_t)(64 * i) * lda + (kofs)), (ldsp_t)(void*)(d_ + i * 8192), 16, 0, 0); \
    _Pragma("unroll") for (int i = 0; i < NPB; ++i) \
        __builtin_amdgcn_global_load_lds((glbp_t)(const void*)(Bg + (size_t)(64 * i) * ldb + (kofs)), (ldsp_t)(void*)(d_ + OPA + i * 8192), 16, 0, 0); } while (0)
    const int xr = (r32 >> 1) & 7;
    const int o0 = ((0 + hi) ^ xr) << 4, o1 = ((2 + hi) ^ xr) << 4, o2 = ((4 + hi) ^ xr) << 4, o3 = ((6 + hi) ^ xr) << 4;
#define G_SS(s_, r_) do { union { bf16x8 v; uint4 u; } c_; c_.v = r_; s_ = dot2bf(c_.u.x, c_.u.x, s_); s_ = dot2bf(c_.u.y, c_.u.y, s_); s_ = dot2bf(c_.u.z, c_.u.z, s_); s_ = dot2bf(c_.u.w, c_.u.w, s_); } while (0)
#define G_STEP(pa, pb, off) do { \
    if (WT == 0) { \
        const bf16x8 a0 = *(const bf16x8*)(pa + off), a1 = *(const bf16x8*)(pa + 32 * 128 + off); \
        const bf16x8 b0 = *(const bf16x8*)(pb + off), b1 = *(const bf16x8*)(pb + 32 * 128 + off), b2 = *(const bf16x8*)(pb + 64 * 128 + off), b3 = *(const bf16x8*)(pb + 96 * 128 + off); \
        if (ROWSS) { G_SS(ss[0], b0); G_SS(ss[1], b1); G_SS(ss[2], b2); G_SS(ss[3], b3); } \
        acc[0] = MFMA32(a0, b0, acc[0]); acc[1] = MFMA32(a0, b1, acc[1]); acc[2] = MFMA32(a0, b2, acc[2]); acc[3] = MFMA32(a0, b3, acc[3]); \
        acc[4] = MFMA32(a1, b0, acc[4]); acc[5] = MFMA32(a1, b1, acc[5]); acc[6] = MFMA32(a1, b2, acc[6]); acc[7] = MFMA32(a1, b3, acc[7]); \
    } else if (WT == 2) { \
        const bf16x8 a0 = *(const bf16x8*)(pa + off), a1 = *(const bf16x8*)(pa + 32 * 128 + off); \
        const bf16x8 b0 = *(const bf16x8*)(pb + off), b1 = *(const bf16x8*)(pb + 32 * 128 + off); \
        if (ROWSS) { G_SS(ss[0], b0); G_SS(ss[1], b1); } \
        acc[0] = MFMA32(a0, b0, acc[0]); acc[1] = MFMA32(a0, b1, acc[1]); acc[2] = MFMA32(a1, b0, acc[2]); acc[3] = MFMA32(a1, b1, acc[3]); \
    } else { \
        const bf16x8 b0 = *(const bf16x8*)(pb + off); \
        const bf16x8 a0 = *(const bf16x8*)(pa + off), a1 = *(const bf16x8*)(pa + 32 * 128 + off); \
        const bf16x8 a2 = *(const bf16x8*)(pa + 64 * 128 + off), a3 = *(const bf16x8*)(pa + 96 * 128 + off); \
        if (ROWSS) { G_SS(ss[0], b0); } \
        acc[0] = MFMA32(a0, b0, acc[0]); acc[1] = MFMA32(a1, b0, acc[1]); \
        acc[2] = MFMA32(a2, b0, acc[2]); acc[3] = MFMA32(a3, b0, acc[3]); \
    } } while (0)
    const int arow = (WT == 1) ? ((w >> 2) * 128 + r32) : ((w >> 1) * 64 + r32);
    const int brow = (WT == 0) ? ((w & 1) * 128 + r32) : (WT == 2) ? ((w & 1) * 64 + r32) : ((w & 3) * 32 + r32);
    G_DMA(0, 0);
    for (int kt = 0; kt < nk; ++kt) {
        __syncthreads();
        if (kt + 1 < nk) G_DMA((kt + 1) & 1, (kt + 1) * 64);
        const char* pa = lds + (kt & 1) * G_BUF + arow * 128;
        const char* pb = lds + (kt & 1) * G_BUF + OPA + brow * 128;
        G_STEP(pa, pb, o0); G_STEP(pa, pb, o1); G_STEP(pa, pb, o2); G_STEP(pa, pb, o3);
    }
    if (ROWSS) { ss[0] += __shfl_xor(ss[0], 32, 64); ss[1] += __shfl_xor(ss[1], 32, 64); ss[2] += __shfl_xor(ss[2], 32, 64); ss[3] += __shfl_xor(ss[3], 32, 64); }
#undef G_DMA
#undef G_SS
#undef G_STEP
}

__device__ __forceinline__ void tile_range(int ntiles, int& lo, int& hi) {
    const int G = gridDim.x, b = blockIdx.x;
    const int vb = ((G & 7) == 0) ? ((b & 7) * (G >> 3) + (b >> 3)) : b;
    const int per = (ntiles + G - 1) / G;
    lo = vb * per; hi = lo + per; if (hi > ntiles) hi = ntiles;
}
constexpr int ST_P = 68;
static_assert(NW * 64 * ST_P * 4 <= LDS_TOTAL, "staging LDS");
template <bool ROWSS, class EPI, class EPIROW, class RSC>
__device__ __forceinline__ void gemm_t(const bf16* __restrict__ Wt, int ldw, int N, const bf16* __restrict__ X, int ldx, int M, int K, int tn_direct, EPI epi, EPIROW epirow, RSC rowscale, char* lds) {
    const int tid = tidx(), lane = tid & 63, w = tid >> 6, r32 = lane & 31, hi = lane >> 5;
    const int tilesN = N / 256, tilesM = M / 256, nk = K / 64;
    int tlo, thi; tile_range(tilesM * tilesN, tlo, thi);
    for (int tile = tlo; tile < thi; ++tile) {
        const int tm = tile / tilesN, tn = tile % tilesN;
        f32x16 acc[8]; float ss[4];
        gemm_kloop<0, ROWSS>(Wt + (size_t)(tn * 256) * ldw, ldw, X + (size_t)(tm * 256) * ldx, ldx, nk, acc, ss, lds, tid);
        if (tn < tn_direct) {
            __syncthreads();
            float* st = (float*)lds + w * (64 * ST_P);
            const int rr = lane >> 4, ch = lane & 15;
#pragma unroll
            for (int half = 0; half < 2; ++half) {
                const float m0_ = rowscale(ss[2 * half]), m1_ = rowscale(ss[2 * half + 1]);
#pragma unroll
                for (int i = 0; i < 2; ++i)
#pragma unroll
                    for (int jj = 0; jj < 2; ++jj)
#pragma unroll
                        for (int g = 0; g < 4; ++g) {
                            const float mj = jj ? m1_ : m0_;
                            const f32x16& a_ = acc[i * 4 + 2 * half + jj];
                            *(float4*)(st + (32 * jj + r32) * ST_P + 32 * i + 8 * g + 4 * hi) = make_float4(a_[4 * g] * mj, a_[4 * g + 1] * mj, a_[4 * g + 2] * mj, a_[4 * g + 3] * mj);
                        }
#pragma unroll 2
                for (int it = 0; it < 16; ++it) {
                    const int row = it * 4 + rr;
                    const float4 v = *(const float4*)(st + row * ST_P + ch * 4);
                    epirow(tm * 256 + (w & 1) * 128 + half * 64 + row, tn * 256 + (w >> 1) * 64 + ch * 4, v);
                }
            }
        } else {
#pragma unroll
            for (int i = 0; i < 2; ++i)
#pragma unroll
                for (int j = 0; j < 4; ++j)
                    epi(tn * 256 + (w >> 1) * 64 + i * 32, tm * 256 + (w & 1) * 128 + j * 32, acc[i * 4 + j], r32, hi, ss[j]);
        }
        __syncthreads();
    }
}

constexpr int ST1_P = 132;
static_assert(NW * 32 * ST1_P * 4 <= LDS_TOTAL, "staging LDS (128 x 32 wave tiles)");
template <class EPIROW, class RSC>
__device__ __forceinline__ void gemm_t1(const bf16* __restrict__ Wt, int ldw, int N, const bf16* __restrict__ X, int ldx, int M, int K, EPIROW epirow, RSC rowscale, char* lds) {
    const int tid = tidx(), lane = tid & 63, w = tid >> 6, r32 = lane & 31, hi = lane >> 5;
    const int tilesN = N / 256, tilesM = M / 128, nk = K / 64;
    int tlo, thi; tile_range(tilesM * tilesN, tlo, thi);
    for (int tile = tlo; tile < thi; ++tile) {
        const int tm = tile / tilesN, tn = tile % tilesN;
        f32x16 acc[8]; float ss[4];
        gemm_kloop<1, true>(Wt + (size_t)(tn * 256) * ldw, ldw, X + (size_t)(tm * 128) * ldx, ldx, nk, acc, ss, lds, tid);
        __syncthreads();
        float* st = (float*)lds + w * (32 * ST1_P);
        const float mj = rowscale(ss[0]);
#pragma unroll
        for (int mt = 0; mt < 4; ++mt)
#pragma unroll
            for (int g = 0; g < 4; ++g)
                *(float4*)(st + r32 * ST1_P + 32 * mt + 8 * g + 4 * hi) = make_float4(acc[mt][4 * g] * mj, acc[mt][4 * g + 1] * mj, acc[mt][4 * g + 2] * mj, acc[mt][4 * g + 3] * mj);
#pragma unroll 2
        for (int it = 0; it < 16; ++it) {
            const int row = it * 2 + hi;
            const float4 v = *(const float4*)(st + row * ST1_P + r32 * 4);
            epirow(tm * 128 + (w & 3) * 32 + row, tn * 256 + (w >> 2) * 128 + r32 * 4, v);
        }
        __syncthreads();
    }
}

template <class EPIROW>
__device__ __forceinline__ void gemm_t2(const bf16* __restrict__ Wt, int ldw, int N, const bf16* __restrict__ X, int ldx, int M, int K, EPIROW epirow, char* lds) {
    const int tid = tidx(), lane = tid & 63, w = tid >> 6, r32 = lane & 31, hi = lane >> 5;
    const int tilesN = N / 256, tilesM = M / 128, nk = K / 64;
    int tlo, thi; tile_range(tilesM * tilesN, tlo, thi);
    for (int tile = tlo; tile < thi; ++tile) {
        const int tm = tile / tilesN, tn = tile % tilesN;
        f32x16 acc[8]; float ss[4];
        gemm_kloop<2, false>(Wt + (size_t)(tn * 256) * ldw, ldw, X + (size_t)(tm * 128) * ldx, ldx, nk, acc, ss, lds, tid);
        __syncthreads();
        float* st = (float*)lds + w * (64 * ST_P);
#pragma unroll
        for (int i = 0; i < 2; ++i)
#pragma unroll
            for (int j = 0; j < 2; ++j)
#pragma unroll
                for (int g = 0; g < 4; ++g)
                    *(float4*)(st + (32 * j + r32) * ST_P + 32 * i + 8 * g + 4 * hi) = make_float4(acc[i * 2 + j][4 * g], acc[i * 2 + j][4 * g + 1], acc[i * 2 + j][4 * g + 2], acc[i * 2 + j][4 * g + 3]);
        const int rr = lane >> 4, ch = lane & 15;
#pragma unroll 4
        for (int it = 0; it < 16; ++it) {
            const int row = it * 4 + rr;
            const float4 v = *(const float4*)(st + row * ST_P + ch * 4);
            epirow(tm * 128 + (w & 1) * 64 + row, tn * 256 + (w >> 1) * 64 + ch * 4, v);
        }
        __syncthreads();
    }
}

typedef __attribute__((ext_vector_type(4))) float f32x4;
constexpr int G8_HT = 128 * 64;
__device__ __forceinline__ int g8_lds_byte(int r, int c) {
    const int st = (r >> 4) * 2 + (c >> 5), rr = r & 15, cc = c & 31, ob = rr * 64 + cc * 2;
    return st * 1024 + (ob ^ (((ob >> 9) & 1) << 5));
}
__device__ __forceinline__ void g8_stage_rc(int b, int& R, int& C) {
    const int st = b / 1024, sb = b % 1024, swz = sb ^ (((sb >> 9) & 1) << 5);
    R = (st >> 1) * 16 + swz / 64; C = (st & 1) * 32 + (swz % 64) / 2;
}
__device__ __forceinline__ float ssq8(const bf16x8& v, float s) {
    union { bf16x8 v; uint4 u; } c_; c_.v = v;
    s = dot2bf(c_.u.x, c_.u.x, s); s = dot2bf(c_.u.y, c_.u.y, s); s = dot2bf(c_.u.z, c_.u.z, s); return dot2bf(c_.u.w, c_.u.w, s);
}
typedef __attribute__((ext_vector_type(4))) int i32x4;
__device__ __forceinline__ f32x4 mma8(const bf16x8& a, const bf16x8& b, const f32x4& c) { return __builtin_amdgcn_mfma_f32_16x16x32_bf16(a, b, c, 0, 0, 0); }
__device__ __forceinline__ i32x4 mma8(const bf16x8& a, const bf16x8& b, const i32x4& c) { return __builtin_amdgcn_mfma_i32_16x16x64_i8(__builtin_bit_cast(i32x4, a), __builtin_bit_cast(i32x4, b), c, 0, 0, 0); }
template <bool ROWSS, bool APERM = false, class ACC = f32x4>
__device__ __forceinline__ void gemm8_kloop(const bf16* __restrict__ A, int lda, const bf16* __restrict__ Bt, int ldb, int nt, ACC (&acc)[2][2][4][2], float (&ss)[2][2], char* lds, int tid) {
    bf16* shm = (bf16*)lds;
    typedef __attribute__((address_space(3))) unsigned* ldsp_t;
    typedef const __attribute__((address_space(1))) unsigned* glbp_t;
#define SA(b, h) (shm + ((b) * 2 + (h)) * G8_HT)
#define SB(b, h) (shm + (4 + (b) * 2 + (h)) * G8_HT)
    int sr0, sc0; g8_stage_rc(tid * 16, sr0, sc0);
    const unsigned voa = (unsigned)((sr0 * lda + sc0) * 2), vob = (unsigned)((sr0 * ldb + sc0) * 2);
    const char* Ap = (const char*)A; const char* Bp = (const char*)Bt;
    const int wbase = __builtin_amdgcn_readfirstlane(tid >> 6) * 1024;
#define STAGE_(P, BASE, VO, LD, br, r2, kt) do { const char* g_ = BASE + ((size_t)(br) * LD + (kt) * 64) * 2; \
    __builtin_amdgcn_global_load_lds((glbp_t)(const void*)(g_ + VO), (ldsp_t)(void*)((char*)(P) + wbase), 16, 0, 0); \
    __builtin_amdgcn_global_load_lds((glbp_t)(const void*)(g_ + (size_t)(2 * (r2)) * LD + VO), (ldsp_t)(void*)((char*)(P) + wbase + 8192), 16, 0, 0); } while (0)
#define STAGEA(b, h, kt) STAGE_(SA(b, h), Ap, voa, lda, (APERM ? (h) * 64 : (h) * 128), (APERM ? 128 : 64), kt)
#define STAGEB(b, h, kt) STAGE_(SB(b, h), Bp, vob, ldb, (h) * 128, 64, kt)
    const int lane = tid & 63, wid = tid >> 6, wr = wid >> 2, wc = wid & 3, fr = lane & 15, fq = lane >> 4;
    int abase, bbase;
    { const int ob = fr * 64 + fq * 16, lp = ob ^ (((ob >> 9) & 1) << 5);
      abase = lp + wr * 8192; bbase = lp + wc * 4096 + 4 * G8_HT * 2;
      asm volatile("" : "+v"(abase), "+v"(bbase)); }
#define LDA(dst, b, h) _Pragma("unroll") for (int m = 0; m < 4; ++m) _Pragma("unroll") for (int k = 0; k < 2; ++k) \
    dst[m][k] = *reinterpret_cast<const bf16x8*>(lds + abase + (((b) * 2 + (h)) * G8_HT * 2 + m * 2048 + k * 1024))
#define LDB(dst, b, h) _Pragma("unroll") for (int n = 0; n < 2; ++n) _Pragma("unroll") for (int k = 0; k < 2; ++k) \
    dst[n][k] = *reinterpret_cast<const bf16x8*>(lds + bbase + (((b) * 2 + (h)) * G8_HT * 2 + n * 2048 + k * 1024))
#define MMA(ai, bj, At_, Bt_) do { __builtin_amdgcn_s_setprio(1); \
    _Pragma("unroll") for (int m = 0; m < 4; ++m) _Pragma("unroll") for (int n = 0; n < 2; ++n) _Pragma("unroll") for (int k = 0; k < 2; ++k) \
        acc[ai][bj][m][n] = mma8(At_[m][k], Bt_[n][k], acc[ai][bj][m][n]); \
    __builtin_amdgcn_s_setprio(0); } while (0)
#define SSQ(bj, Bt_) do { if (ROWSS) { _Pragma("unroll") for (int n = 0; n < 2; ++n) { ss[bj][n] = ssq8(Bt_[n][0], ss[bj][n]); ss[bj][n] = ssq8(Bt_[n][1], ss[bj][n]); } } } while (0)
#define WAIT_V(n) asm volatile("s_waitcnt vmcnt(" #n ")" ::: "memory")
#define WAIT_L(n) asm volatile("s_waitcnt lgkmcnt(" #n ")" ::: "memory")
#define BAR __builtin_amdgcn_s_barrier()
#define SCHED __builtin_amdgcn_sched_barrier(0)
#pragma unroll
    for (int a = 0; a < 2; ++a)
#pragma unroll
        for (int b = 0; b < 2; ++b)
#pragma unroll
            for (int m = 0; m < 4; ++m)
#pragma unroll
                for (int n = 0; n < 2; ++n) acc[a][b][m][n] = ACC{0, 0, 0, 0};
    ss[0][0] = 0.f; ss[0][1] = 0.f; ss[1][0] = 0.f; ss[1][1] = 0.f;
    bf16x8 At[4][2], B0[2][2], B1[2][2];
    STAGEB(0, 0, 0); STAGEA(0, 0, 0);
    STAGEB(0, 1, 0); STAGEA(0, 1, 0);
    if (wr == 1) BAR;
    WAIT_V(4); BAR;
    STAGEB(1, 0, 1); STAGEA(1, 0, 1); STAGEB(1, 1, 1);
    WAIT_V(6); BAR;
    for (int t = 0; t < nt - 2; t += 2) {
        LDB(B0, 0, 0); SCHED; LDA(At, 0, 0); STAGEA(1, 1, t + 1);
        WAIT_L(8); BAR; WAIT_L(0); MMA(0, 0, At, B0); SSQ(0, B0); BAR; SCHED;
        LDB(B1, 0, 1); STAGEB(0, 0, t + 2);
        BAR; WAIT_L(0); MMA(0, 1, At, B1); SSQ(1, B1); BAR;
        LDA(At, 0, 1); STAGEA(0, 0, t + 2);
        BAR; WAIT_L(0); MMA(1, 0, At, B0); BAR; SCHED;
        STAGEB(0, 1, t + 2);
        WAIT_V(6); BAR; MMA(1, 1, At, B1); BAR;
        LDB(B0, 1, 0); SCHED; LDA(At, 1, 0); STAGEA(0, 1, t + 2);
        WAIT_L(8); BAR; WAIT_L(0); MMA(0, 0, At, B0); SSQ(0, B0); BAR; SCHED;
        LDB(B1, 1, 1); STAGEB(1, 0, t + 3);
        BAR; WAIT_L(0); MMA(0, 1, At, B1); SSQ(1, B1); BAR;
        LDA(At, 1, 1); STAGEA(1, 0, t + 3);
        BAR; WAIT_L(0); MMA(1, 0, At, B0); BAR; SCHED;
        STAGEB(1, 1, t + 3);
        WAIT_V(6); BAR; MMA(1, 1, At, B1); BAR;
    }
    { LDB(B0, 0, 0); LDA(At, 0, 0); STAGEA(1, 1, nt - 1);
      BAR; WAIT_L(0); MMA(0, 0, At, B0); SSQ(0, B0); BAR;
      LDB(B1, 0, 1); BAR; WAIT_L(0); MMA(0, 1, At, B1); SSQ(1, B1); BAR;
      LDA(At, 0, 1); WAIT_V(4); BAR; WAIT_L(0); MMA(1, 0, At, B0); MMA(1, 1, At, B1); BAR; }
    { LDB(B0, 1, 0); LDA(At, 1, 0); WAIT_V(2); BAR; WAIT_L(0); MMA(0, 0, At, B0); SSQ(0, B0); BAR;
      LDB(B1, 1, 1); WAIT_V(0); BAR; WAIT_L(0); MMA(0, 1, At, B1); SSQ(1, B1); BAR;
      LDA(At, 1, 1); BAR; WAIT_L(0); MMA(1, 0, At, B0); MMA(1, 1, At, B1); BAR; }
    if (wr == 0) BAR;
    if (ROWSS) {
#pragma unroll
        for (int b = 0; b < 2; ++b)
#pragma unroll
            for (int n = 0; n < 2; ++n) { ss[b][n] += __shfl_xor(ss[b][n], 16, 64); ss[b][n] += __shfl_xor(ss[b][n], 32, 64); }
    }
#undef SSQ
#undef SA
#undef SB
#undef STAGE_
#undef STAGEA
#undef STAGEB
#undef LDA
#undef LDB
#undef MMA
#undef WAIT_V
#undef WAIT_L
#undef BAR
#undef SCHED
}
__device__ __forceinline__ void tile_rounds(int ntiles, int& lo, int& hi, int& step) {
    const int G = gridDim.x, b = blockIdx.x;
    if ((G & 7) == 0) { const int per = (ntiles + 7) >> 3, x = b & 7; lo = x * per + (b >> 3); hi = (x + 1) * per; if (hi > ntiles) hi = ntiles; step = G >> 3; }
    else { lo = b; hi = ntiles; step = G; }
}
template <bool SCALE, bool PRE, class EPIROW, class RSC, class PREF>
__device__ __forceinline__ void gemm_t8(const bf16* __restrict__ Wt, int ldw, int N, const bf16* __restrict__ X, int ldx, int K, int tlo, int thi, int tstep, EPIROW epirow, RSC rowscale, PREF pre, char* lds) {
    const int tid = tidx();
    const int tilesN = N / 256; int nt = K / 64;
    asm volatile("" : "+s"(nt));
    for (int tile = tlo; tile < thi; tile += tstep) {
        const int tm = tile / tilesN, tn = tile % tilesN;
        f32x4 acc[2][2][4][2]; float ss[2][2];
        gemm8_kloop<false>(Wt + (size_t)(tn * 256) * ldw, ldw, X + (size_t)(tm * 256) * ldx, ldx, nt, acc, ss, lds, tid);
        __syncthreads();
        const int te = tidx();
        const int le = te & 63, w = te >> 6, wr = w >> 2, wc = w & 3, fr = le & 15, fq = le >> 4;
        float* st = (float*)lds + w * (32 * ST_P);
        const int rr = le >> 4, ch = le & 15;
        const int tb = tm * 256 + wc * 32 + rr, nb = tn * 256 + wr * 64 + ch * 4;
#pragma unroll
        for (int ai = 0; ai < 2; ++ai)
#pragma unroll
            for (int bj = 0; bj < 2; ++bj) {
                float4 pv[8];
                if (PRE) {
#pragma unroll
                    for (int it = 0; it < 8; ++it) pv[it] = pre(tb + bj * 128 + it * 4, nb + ai * 128);
                }
#pragma unroll
                for (int n = 0; n < 2; ++n) {
                    const float mj = SCALE ? rowscale(tm * 256 + bj * 128 + wc * 32 + n * 16 + fr) : 1.f;
#pragma unroll
                    for (int m = 0; m < 4; ++m) {
                        const f32x4 a_ = acc[ai][bj][m][n];
                        *(float4*)(st + (n * 16 + fr) * ST_P + m * 16 + fq * 4) = SCALE ? make_float4(a_[0] * mj, a_[1] * mj, a_[2] * mj, a_[3] * mj) : make_float4(a_[0], a_[1], a_[2], a_[3]);
                    }
                }
                if (PRE) {
#pragma unroll
                    for (int it = 0; it < 8; ++it) {
                        const float4 v = *(const float4*)(st + (it * 4 + rr) * ST_P + ch * 4);
                        epirow(tb + bj * 128 + it * 4, nb + ai * 128, v, pv[it]);
                    }
                } else {
#pragma unroll 2
                    for (int it = 0; it < 8; ++it) {
                        const float4 v = *(const float4*)(st + (it * 4 + rr) * ST_P + ch * 4);
                        epirow(tb + bj * 128 + it * 4, nb + ai * 128, v, make_float4(0.f, 0.f, 0.f, 0.f));
                    }
                }
            }
        __syncthreads();
    }
}

__device__ __forceinline__ void transpose_tiled(const float* __restrict__ W, bf16* __restrict__ Wt, int K, int N, int Npad, int ldk, const float* __restrict__ gain, char* lds) {
    float (*tl)[65] = (float (*)[65])lds;
    const int tid = tidx(), a = tid & 63, q = tid >> 6;
    const int tK = K / 64, tN = Npad / 64;
    for (int tile = blockIdx.x; tile < tK * tN; tile += gridDim.x) {
        const int k0 = (tile / tN) * 64, n0 = (tile % tN) * 64;
#pragma unroll 4
        for (int i = 0; i < 64 / NW; ++i) {
            const int k = k0 + q * (64 / NW) + i, n = n0 + a;
            float v = (n < N) ? W[(size_t)k * N + n] : 0.f;
            if (gain) v *= gain[k];
            tl[q * (64 / NW) + i][a] = v;
        }
        __syncthreads();
#pragma unroll 4
        for (int i = 0; i < 64 / NW; ++i) { const int nl = q * (64 / NW) + i; Wt[(size_t)(n0 + nl) * ldk + k0 + a] = f2bf(tl[a][nl]); }
        __syncthreads();
    }
}

__device__ __forceinline__ void quant_row(const float4 (&v)[4], unsigned char* __restrict__ dst, float* __restrict__ scl, int r, int lane) {
    float am = 0.f;
#pragma unroll
    for (int j = 0; j < 4; ++j) am = fmaxf(am, fmaxf(fmaxf(fabsf(v[j].x), fabsf(v[j].y)), fmaxf(fabsf(v[j].z), fabsf(v[j].w))));
#pragma unroll
    for (int m = 32; m >= 1; m >>= 1) am = fmaxf(am, __shfl_xor(am, m, 64));
    const float sc = (am > 0.f) ? am * (1.f / 448.f) : 1.f;
    const float is = 1.f / sc;
    uint4 o;
    { int w = 0; w = __builtin_amdgcn_cvt_pk_fp8_f32(v[0].x * is, v[0].y * is, w, false); w = __builtin_amdgcn_cvt_pk_fp8_f32(v[0].z * is, v[0].w * is, w, true); o.x = (unsigned)w; }
    { int w = 0; w = __builtin_amdgcn_cvt_pk_fp8_f32(v[1].x * is, v[1].y * is, w, false); w = __builtin_amdgcn_cvt_pk_fp8_f32(v[1].z * is, v[1].w * is, w, true); o.y = (unsigned)w; }
    { int w = 0; w = __builtin_amdgcn_cvt_pk_fp8_f32(v[2].x * is, v[2].y * is, w, false); w = __builtin_amdgcn_cvt_pk_fp8_f32(v[2].z * is, v[2].w * is, w, true); o.z = (unsigned)w; }
    { int w = 0; w = __builtin_amdgcn_cvt_pk_fp8_f32(v[3].x * is, v[3].y * is, w, false); w = __builtin_amdgcn_cvt_pk_fp8_f32(v[3].z * is, v[3].w * is, w, true); o.w = (unsigned)w; }
    { const int lay = r / NEXP, e = r % NEXP; *(uint4*)(dst + (((size_t)(lay * 8 + (lane >> 3)) * NEXP + e) * 128) + (lane & 7) * 16) = o; }
    if (lane == 0) scl[r] = sc;
}
__device__ __forceinline__ unsigned pack_i8x4(float a, float b, float c, float d) {
    const int ia = __float2int_rn(a), ib = __float2int_rn(b), ic = __float2int_rn(c), id = __float2int_rn(d);
    return (unsigned)(ia & 255) | ((unsigned)(ib & 255) << 8) | ((unsigned)(ic & 255) << 16) | ((unsigned)(id & 255) << 24);
}
__device__ __forceinline__ void quant_row_i8(const float4 (&v)[4], unsigned char* __restrict__ dst, float* __restrict__ scl, int r, int lane) {
    float am = 0.f;
#pragma unroll
    for (int j = 0; j < 4; ++j) am = fmaxf(am, fmaxf(fmaxf(fabsf(v[j].x), fabsf(v[j].y)), fmaxf(fabsf(v[j].z), fabsf(v[j].w))));
#pragma unroll
    for (int m = 32; m >= 1; m >>= 1) am = fmaxf(am, __shfl_xor(am, m, 64));
    const float sc = (am > 0.f) ? am * (1.f / 127.f) : 1.f;
    const float is = 1.f / sc;
    uint4 o;
    o.x = pack_i8x4(v[0].x * is, v[0].y * is, v[0].z * is, v[0].w * is); o.y = pack_i8x4(v[1].x * is, v[1].y * is, v[1].z * is, v[1].w * is);
    o.z = pack_i8x4(v[2].x * is, v[2].y * is, v[2].z * is, v[2].w * is); o.w = pack_i8x4(v[3].x * is, v[3].y * is, v[3].z * is, v[3].w * is);
    { const int lay = r / NEXP, e = r % NEXP; *(uint4*)(dst + (((size_t)(lay * 8 + (lane >> 3)) * NEXP + e) * 128) + (lane & 7) * 16) = o; }
    if (lane == 0) scl[r] = sc;
}
template <bool I8>
__device__ __forceinline__ void convert_table(const float* __restrict__ src, unsigned char* __restrict__ dst, float* __restrict__ scl, int rows) {
    static_assert(TAB_FP8, "fp8 tables");
    const int lane = tidx() & 63;
    const int nw = nwave();
    for (int r = gwave(); r < rows; r += 4 * nw) {
        float4 v[4][4]; int rr[4];
#pragma unroll
        for (int u = 0; u < 4; ++u) {
            rr[u] = (r + u * nw < rows) ? (r + u * nw) : r;
            const float4* s0 = (const float4*)(src + (size_t)rr[u] * D);
#pragma unroll
            for (int j = 0; j < 4; ++j) v[u][j] = s0[lane * 4 + j];
        }
#pragma unroll
        for (int u = 0; u < 4; ++u) {
            if (u == 0 || rr[u] != r) { if (I8) quant_row_i8(v[u], dst, scl, rr[u], lane); else quant_row(v[u], dst, scl, rr[u], lane); }
        }
    }
}
__device__ __forceinline__ void phase_prep(const Params& P, char* lds) {
    unsigned char* ws = P.ws;
    for (int l = 0; l < DEPTH; ++l) {
        transpose_tiled(P.w_in + (size_t)l * D * DIN, (bf16*)(ws + WS_WIN) + (size_t)l * DINP * LDW, D, DIN, DINP, LDW, nullptr, lds);
        transpose_tiled(P.w_uq + (size_t)l * QR * 768, (bf16*)(ws + WS_WUQ) + (size_t)l * 768 * QR, QR, 768, 768, QR, P.q_norm + l * QR, lds);
        transpose_tiled(P.w_uk + (size_t)l * KVR * 512, (bf16*)(ws + WS_WUKV) + (size_t)l * 1024 * KVR, KVR, 512, 512, KVR, P.kv_norm + l * KVR, lds);
        transpose_tiled(P.w_uv + (size_t)l * KVR * 512, (bf16*)(ws + WS_WUKV) + (size_t)l * 1024 * KVR + (size_t)512 * KVR, KVR, 512, 512, KVR, P.kv_norm + l * KVR, lds);
        transpose_tiled(P.w_out + (size_t)l * D * D, (bf16*)(ws + WS_WOUT) + (size_t)l * D * LDW, D, D, D, LDW, nullptr, lds);
    }
    {
        bf16* Wc = (bf16*)(ws + WS_WPQ);
        float (*As)[68] = (float (*)[68])lds;
        float (*Bs)[68] = (float (*)[68])(lds + 16 * 68 * 4);
        const int tid = tidx(), tx = tid & 15, ty = (tid >> 4) & 15;
        const int lr = (tid >> 2) & 63, ld4 = (tid & 3) * 4;
        for (int tile = blockIdx.x; tile < (DEPTH * 2048 / 64) * (D / 64); tile += gridDim.x) {
            const int row0 = (tile >> 4) * 64, k0 = (tile & 15) * 64;
            const int l = row0 >> 11, hp = (row0 >> 7) & 15, n0 = row0 & 127;
            const float* skp = P.peer_subkeys + (((size_t)l * 2 + (hp & 1)) * NKEY + n0 + lr) * 128 + ld4;
            const float* wqp = P.peer_wq + ((size_t)l * D + k0 + lr) * 2048 + hp * 128 + ld4;
            float acc[4][4];
#pragma unroll
            for (int i = 0; i < 4; ++i)
#pragma unroll
                for (int j = 0; j < 4; ++j) acc[i][j] = 0.f;
            for (int d0 = 0; d0 < 128; d0 += 16) {
                if (tid < 256) {
                    const float4 av = *(const float4*)(skp + d0), bv = *(const float4*)(wqp + d0);
                    As[ld4 + 0][lr] = av.x; As[ld4 + 1][lr] = av.y; As[ld4 + 2][lr] = av.z; As[ld4 + 3][lr] = av.w;
                    Bs[ld4 + 0][lr] = bv.x; Bs[ld4 + 1][lr] = bv.y; Bs[ld4 + 2][lr] = bv.z; Bs[ld4 + 3][lr] = bv.w;
                }
                __syncthreads();
#pragma unroll
                for (int kk = 0; kk < 16; ++kk) {
                    const float4 a4 = *(const float4*)&As[kk][ty * 4], b4 = *(const float4*)&Bs[kk][tx * 4];
                    const float aa[4] = {a4.x, a4.y, a4.z, a4.w}, bb[4] = {b4.x, b4.y, b4.z, b4.w};
#pragma unroll
                    for (int i = 0; i < 4; ++i)
#pragma unroll
                        for (int j = 0; j < 4; ++j) acc[i][j] = fmaf(aa[i], bb[j], acc[i][j]);
                }
                __syncthreads();
            }
            if (tid < 256) {
#pragma unroll
                for (int i = 0; i < 4; ++i) {
                    uint2 o; o.x = pack2(acc[i][0], acc[i][1]); o.y = pack2(acc[i][2], acc[i][3]);
                    *(uint2*)(Wc + (size_t)(row0 + ty * 4 + i) * LDW + k0 + tx * 4) = o;
                }
            }
        }
    }
    convert_table<true>(P.peer_u, ws + WS_TABU, (float*)(ws + WS_TSCU), DEPTH * NEXP);
    convert_table<false>(P.peer_v, ws + WS_TABV, (float*)(ws + WS_TSCV), DEPTH * NEXP);
    float* rope = (float*)(ws + WS_ROPE);
    for (size_t i = gtid(); i < (size_t)S * 16; i += gnth()) {
        const int s = (int)(i >> 4), f = (int)(i & 15);
        const double inv = pow(10000.0, -(double)f / 16.0);
        const double ang = (double)s * inv;
        rope[2 * i] = (float)cos(ang); rope[2 * i + 1] = (float)sin(ang);
    }
}

__device__ __forceinline__ void phase_norm(const float* __restrict__ h, const float* __restrict__ g, bf16* __restrict__ xn) {
    const int lane = tidx() & 63, nw = nwave();
    for (int t = gwave(); t < T; t += 2 * nw) {
        const int t2 = (t + nw < T) ? (t + nw) : t;
        float4 v[2][4];
#pragma unroll
        for (int j = 0; j < 4; ++j) { v[0][j] = ((const float4*)(h + (size_t)t * D))[j * 64 + lane]; v[1][j] = ((const float4*)(h + (size_t)t2 * D))[j * 64 + lane]; }
#pragma unroll
        for (int u = 0; u < 2; ++u) {
            float ss = 0.f;
#pragma unroll
            for (int j = 0; j < 4; ++j) ss += v[u][j].x * v[u][j].x + v[u][j].y * v[u][j].y + v[u][j].z * v[u][j].z + v[u][j].w * v[u][j].w;
            ss = wave_sum(ss);
            const float r = rsqrtf(ss * (1.f / D) + EPS);
            const int tt = u ? t2 : t;
            if (u == 0 || t2 != t) {
#pragma unroll
                for (int j = 0; j < 4; ++j) {
                    const float4 gg = ((const float4*)g)[j * 64 + lane];
                    uint2 o; o.x = pack2(v[u][j].x * r * gg.x, v[u][j].y * r * gg.y); o.y = pack2(v[u][j].z * r * gg.z, v[u][j].w * r * gg.w);
                    ((uint2*)(xn + (size_t)tt * LDX))[j * 64 + lane] = o;
                }
            }
        }
    }
}

__device__ __forceinline__ void phase_norm_q(const Params& P, int l) {
    const int lane = tidx() & 63, nw = nwave();
    const float* g = P.norm_ffn + l * D;
    bf16* xn = (bf16*)(P.ws + WS_XN);
    unsigned* xq = (unsigned*)(P.ws + WS_XQ);
    float* xsc = (float*)(P.ws + WS_XS);
    bf16* Hb = (bf16*)P.out;
    const bf16* yo = (const bf16*)(P.ws + WS_PROJ);
    for (int t = gwave(); t < T; t += 2 * nw) {
        const int t2 = (t + nw < T) ? (t + nw) : t;
        float4 v[2][4];
#pragma unroll
        for (int j = 0; j < 4; ++j) {
            if (l == 0) { v[0][j] = ((const float4*)(P.x + (size_t)t * D))[j * 64 + lane]; v[1][j] = ((const float4*)(P.x + (size_t)t2 * D))[j * 64 + lane]; }
            else {
                const uint2 a = ((const uint2*)(Hb + (size_t)t * HP))[j * 64 + lane], b = ((const uint2*)(Hb + (size_t)t2 * HP))[j * 64 + lane];
                v[0][j] = make_float4(bflo(a.x), bfhi(a.x), bflo(a.y), bfhi(a.y)); v[1][j] = make_float4(bflo(b.x), bfhi(b.x), bflo(b.y), bfhi(b.y));
            }
        }
        {
            uint2 y[2][4];
#pragma unroll
            for (int j = 0; j < 4; ++j) { y[0][j] = ((const uint2*)(yo + (size_t)t * D))[j * 64 + lane]; y[1][j] = ((const uint2*)(yo + (size_t)t2 * D))[j * 64 + lane]; }
#pragma unroll
            for (int u = 0; u < 2; ++u)
#pragma unroll
                for (int j = 0; j < 4; ++j) { v[u][j].x += bflo(y[u][j].x); v[u][j].y += bfhi(y[u][j].x); v[u][j].z += bflo(y[u][j].y); v[u][j].w += bfhi(y[u][j].y); }
#pragma unroll
            for (int j = 0; j < 4; ++j) {
                uint2 a, b; a.x = pack2(v[0][j].x, v[0][j].y); a.y = pack2(v[0][j].z, v[0][j].w); b.x = pack2(v[1][j].x, v[1][j].y); b.y = pack2(v[1][j].z, v[1][j].w);
                ((uint2*)(Hb + (size_t)t * HP))[j * 64 + lane] = a; if (t2 != t) ((uint2*)(Hb + (size_t)t2 * HP))[j * 64 + lane] = b;
            }
        }
#pragma unroll
        for (int u = 0; u < 2; ++u) {
            float ss = 0.f;
#pragma unroll
            for (int j = 0; j < 4; ++j) ss += v[u][j].x * v[u][j].x + v[u][j].y * v[u][j].y + v[u][j].z * v[u][j].z + v[u][j].w * v[u][j].w;
            ss = wave_sum(ss);
            const float r = rsqrtf(ss * (1.f / D) + EPS);
            const int tt = u ? t2 : t;
            if (u == 0 || t2 != t) {
                float am = 0.f;
#pragma unroll
                for (int j = 0; j < 4; ++j) {
                    const float4 gg = ((const float4*)g)[j * 64 + lane];
                    v[u][j].x *= r * gg.x; v[u][j].y *= r * gg.y; v[u][j].z *= r * gg.z; v[u][j].w *= r * gg.w;
                    am = fmaxf(am, fmaxf(fmaxf(fabsf(v[u][j].x), fabsf(v[u][j].y)), fmaxf(fabsf(v[u][j].z), fabsf(v[u][j].w))));
                    uint2 o; o.x = pack2(v[u][j].x, v[u][j].y); o.y = pack2(v[u][j].z, v[u][j].w);
                    ((uint2*)(xn + (size_t)tt * LDX))[j * 64 + lane] = o;
                }
#pragma unroll
                for (int m = 32; m >= 1; m >>= 1) am = fmaxf(am, __shfl_xor(am, m, 64));
                const float sc = (am > 0.f) ? am * (1.f / 127.f) : 1.f, is = 1.f / sc;
#pragma unroll
                for (int j = 0; j < 4; ++j) xq[(size_t)tt * (XQP / 4) + j * 64 + lane] = pack_i8x4(v[u][j].x * is, v[u][j].y * is, v[u][j].z * is, v[u][j].w * is);
                if (lane == 0) xsc[tt] = sc;
            }
        }
    }
}

__device__ __forceinline__ void phase_mixlocal(const Params& P, int l, char* lds) {
    const bf16* proj = (const bf16*)(P.ws + WS_PROJ);
    bf16* Y = (bf16*)(P.ws + WS_XN);
    const int tid = tidx();
    {
        const float* cw = P.conv_w + (size_t)l * 3 * 256;
        for (size_t i = gtid(); i < (size_t)T * 32; i += gnth()) {
            const int t = (int)(i >> 5), c0 = (int)(i & 31) * 8, s = t & (S - 1);
            const bf16* pr = proj + (size_t)t * DINP;
            float acc[8];
#pragma unroll
            for (int e = 0; e < 8; ++e) acc[e] = 0.f;
#pragma unroll
            for (int j = 0; j < 3; ++j) {
                if (s - 2 + j >= 0) {
                    const bf16* pp = pr - (size_t)(2 - j) * DINP;
                    const uint4 g = *(const uint4*)(pp + C_CG + c0), hc = *(const uint4*)(pp + C_HC + c0);
                    const float4 w0 = *(const float4*)(cw + j * 256 + c0), w1 = *(const float4*)(cw + j * 256 + c0 + 4);
                    acc[0] = fmaf(w0.x, bflo(g.x) * bflo(hc.x), acc[0]); acc[1] = fmaf(w0.y, bfhi(g.x) * bfhi(hc.x), acc[1]);
                    acc[2] = fmaf(w0.z, bflo(g.y) * bflo(hc.y), acc[2]); acc[3] = fmaf(w0.w, bfhi(g.y) * bfhi(hc.y), acc[3]);
                    acc[4] = fmaf(w1.x, bflo(g.z) * bflo(hc.z), acc[4]); acc[5] = fmaf(w1.y, bfhi(g.z) * bfhi(hc.z), acc[5]);
                    acc[6] = fmaf(w1.z, bflo(g.w) * bflo(hc.w), acc[6]); acc[7] = fmaf(w1.w, bfhi(g.w) * bfhi(hc.w), acc[7]);
                }
            }
            const uint4 bg = *(const uint4*)(pr + C_BG + c0);
            uint4 o;
            o.x = pack2(bflo(bg.x) * acc[0], bfhi(bg.x) * acc[1]); o.y = pack2(bflo(bg.y) * acc[2], bfhi(bg.y) * acc[3]);
            o.z = pack2(bflo(bg.z) * acc[4], bfhi(bg.z) * acc[5]); o.w = pack2(bflo(bg.w) * acc[6], bfhi(bg.w) * acc[7]);
            *(uint4*)(Y + (size_t)t * LDX + c0) = o;
        }
    }
    {
        float (*pl)[68] = (float (*)[68])lds;
        const float* pw = P.pool_w + (size_t)l * 4 * 64 * 64;
        const float* psc = P.pool_scale + l * 256;
        const int a = tid & 63, q = tid >> 6;
        for (int tile = blockIdx.x; tile < (T / (16 * NW)) * 4; tile += gridDim.x) {
            const int g = tile & 3, t0 = (tile >> 2) * (16 * NW);
            const int w = 2 << g;
            {
                const bf16* col = proj + C_HP + g * 64 + a;
                const int tf = t0 + q * 16, sf = tf & (S - 1);
                float xr[31];
#pragma unroll
                for (int d = 1; d <= 15; ++d) xr[15 - d] = (d < w && sf - d >= 0) ? bf2f(col[(size_t)(tf - d) * DINP]) : 0.f;
#pragma unroll
                for (int i = 0; i < 16; ++i) xr[15 + i] = bf2f(col[(size_t)(tf + i) * DINP]);
                float sum = 0.f;
#pragma unroll
                for (int d = 1; d <= 15; ++d) sum += xr[15 - d];
#pragma unroll
                for (int i = 0; i < 16; ++i) {
                    const int s = sf + i;
                    sum += xr[15 + i];
                    const int cnt = (s + 1 < w) ? (s + 1) : w;
                    pl[q * 16 + i][a] = sum / (float)cnt - xr[15 + i];
                    const int o = 15 + i + 1;
                    const float old = (g == 0) ? xr[o - 2] : (g == 1) ? xr[o - 4] : (g == 2) ? xr[o - 8] : xr[o - 16];
                    sum -= old;
                }
            }
            __syncthreads();
            {
                float pc[64];
#pragma unroll
                for (int c = 0; c < 64; ++c) pc[c] = pw[(g * 64 + c) * 64 + a];
                const float sc = psc[g * 64 + a];
#pragma unroll 2
                for (int i = 0; i < 16; ++i) {
                    const float4* row = (const float4*)&pl[q * 16 + i][0];
                    float m0 = 0.f, m1 = 0.f;
#pragma unroll
                    for (int c4 = 0; c4 < 16; ++c4) { const float4 v = row[c4]; m0 = fmaf(v.x, pc[4 * c4], m0); m1 = fmaf(v.y, pc[4 * c4 + 1], m1); m0 = fmaf(v.z, pc[4 * c4 + 2], m0); m1 = fmaf(v.w, pc[4 * c4 + 3], m1); }
                    Y[(size_t)(t0 + q * 16 + i) * LDX + 256 + g * 64 + a] = f2bf((m0 + m1) * sc);
                }
            }
            __syncthreads();
        }
    }
}

typedef short v4i16_t __attribute__((ext_vector_type(4)));
typedef __attribute__((address_space(3))) v4i16_t* lds_v4p;
__device__ __forceinline__ v4i16_t vtr(const char* p) { return __builtin_amdgcn_ds_read_tr16_b64_v4i16((lds_v4p)p); }
constexpr int A_KP = 208, A_VP = 192;
constexpr int A_KB = 64 * A_KP, A_VB = 64 * A_VP, A_BUF = A_KB + A_VB, ATTN_LDS = 3 * A_BUF;
static_assert(ATTN_LDS <= LDS_TOTAL, "attention LDS");

__device__ __forceinline__ void attn_unit(const bf16* __restrict__ Qb, const bf16* __restrict__ Kb, const bf16* __restrict__ Vb, bf16* __restrict__ Y, int bh, int qblk, char* lds) {
    const int tid = tidx(), lane = tid & 63, w = tid >> 6, r32 = lane & 31, hi = lane >> 5;
    const int q0 = qblk * (32 * NW), qw0 = q0 + w * 32;
    const int NT = (q0 + 32 * NW) / 64;
    bf16x8 qf[6];
    {
        const bf16* qp = Qb + ((size_t)bh * S + qw0 + r32) * DQK + hi * 8;
#pragma unroll
        for (int ks = 0; ks < 6; ++ks) qf[ks] = *(const bf16x8*)(qp + ks * 16);
    }
    f32x16 o0, o1;
#pragma unroll
    for (int r = 0; r < 16; ++r) { o0[r] = 0.f; o1[r] = 0.f; }
    float m = -1e30f, lsum = 0.f;
    const int t8 = tid & 255; const bool isv = tid >= 256;
    const char* Tg = isv ? (const char*)(Vb + (size_t)bh * S * DV) : (const char*)(Kb + (size_t)bh * S * DQK);
    const int Ts = isv ? (64 * 128) : (64 * 192);
    const int g0 = t8 * 16, g1 = (t8 + 256) * 16, g2 = isv ? g1 : (t8 + 512) * 16;
    const int l0 = isv ? (A_KB + (t8 >> 3) * A_VP + (t8 & 7) * 16) : ((t8 / 12) * A_KP + (t8 % 12) * 16);
    const int l1 = isv ? (l0 + 32 * A_VP) : (((t8 + 256) / 12) * A_KP + ((t8 + 256) % 12) * 16);
    const int l2 = isv ? l1 : (((t8 + 512) / 12) * A_KP + ((t8 + 512) % 12) * 16);
    uint4 pk0, pk1, pk2, qk0, qk1, qk2;
#define A_LOAD(S, t) do { const char* tg = Tg + (size_t)(t) * Ts; S##k0 = *(const uint4*)(tg + g0); S##k1 = *(const uint4*)(tg + g1); S##k2 = *(const uint4*)(tg + g2); } while (0)
#define A_STORE(S, bK, bV) do { *(uint4*)(bK + l0) = S##k0; *(uint4*)(bK + l1) = S##k1; *(uint4*)(bK + l2) = S##k2; } while (0)
#define A_PV(pf, kofs) do { \
            { const v4i16_t lo = vtr(pv + (kofs) * A_VP), hh = vtr(pv + ((kofs) + 8) * A_VP); const bf16x8 vf = {lo[0], lo[1], lo[2], lo[3], hh[0], hh[1], hh[2], hh[3]}; o0 = MFMA32(vf, pf.v, o0); } \
            { const v4i16_t lo = vtr(pv + (kofs) * A_VP + 64), hh = vtr(pv + ((kofs) + 8) * A_VP + 64); const bf16x8 vf = {lo[0], lo[1], lo[2], lo[3], hh[0], hh[1], hh[2], hh[3]}; o1 = MFMA32(vf, pf.v, o1); } } while (0)
    const int pvo = (4 * hi + ((lane & 15) >> 2)) * A_VP + (16 * ((lane >> 4) & 1) + 4 * (lane & 3)) * 2;
#define A_QK(S0, S1, bK_, kt0_) do { \
        _Pragma("unroll") for (int r = 0; r < 16; ++r) { S0[r] = 0.f; S1[r] = 0.f; } \
        const char* pk = (bK_) + r32 * A_KP + hi * 16; \
        _Pragma("unroll") for (int ks = 0; ks < 6; ++ks) { \
            const bf16x8 a0 = *(const bf16x8*)(pk + ks * 32), a1 = *(const bf16x8*)(pk + 32 * A_KP + ks * 32); \
            S0 = MFMA32(a0, qf[ks], S0); S1 = MFMA32(a1, qf[ks], S1); } \
        if ((kt0_) + 63 > qw0) {                                      \
            const int qrow = qw0 + r32; \
            _Pragma("unroll") for (int r = 0; r < 16; ++r) { const int key = (kt0_) + crow(r, hi); if (key > qrow) S0[r] = -INFINITY; if (key + 32 > qrow) S1[r] = -INFINITY; } } } while (0)
#define A_SOFTPV(s0, s1, bV_) do { \
            float mx = fmaxf(s0[0], s1[0]); \
            _Pragma("unroll") for (int r = 1; r < 16; ++r) mx = fmaxf(mx, fmaxf(s0[r], s1[r])); \
            mx = fmaxf(mx, __shfl_xor(mx, 32, 64)); \
            const float mn = fmaxf(m, mx), m_prev = m; \
            const float alpha = __builtin_amdgcn_exp2f(m - mn); \
            m = mn; \
            float ps = 0.f; \
            _Pragma("unroll") for (int r = 0; r < 16; ++r) { s0[r] = __builtin_amdgcn_exp2f(s0[r] - mn); s1[r] = __builtin_amdgcn_exp2f(s1[r] - mn); ps += s0[r] + s1[r]; } \
            if (__builtin_amdgcn_ballot_w64(mn > m_prev) != 0ull) {     \
                lsum *= alpha; \
                _Pragma("unroll") for (int r = 0; r < 16; ++r) { o0[r] *= alpha; o1[r] *= alpha; } } \
            lsum += ps; \
            union { unsigned u[4]; bf16x8 v; } p00, p01, p10, p11; \
            _Pragma("unroll") for (int j = 0; j < 4; ++j) { p00.u[j] = cvtpk(s0[2 * j], s0[2 * j + 1]); p01.u[j] = cvtpk(s0[8 + 2 * j], s0[9 + 2 * j]); p10.u[j] = cvtpk(s1[2 * j], s1[2 * j + 1]); p11.u[j] = cvtpk(s1[8 + 2 * j], s1[9 + 2 * j]); } \
            const char* pv = (bV_) + pvo; \
            A_PV(p00, 0); A_PV(p01, 16); A_PV(p10, 32); A_PV(p11, 48); } while (0)
#define A_STEP(C0, C1, N0, N1, SET, t) do { \
        if ((t) + 1 < NT) { \
            char* bKn = lds + so_next; \
            A_STORE(SET, bKn, bKn + A_KB); \
            __syncthreads(); \
            { const int tn = ((t) + 3 < NT) ? ((t) + 3) : (NT - 1); A_LOAD(SET, tn); } \
            if (((t) + 1) * 64 <= qw0) A_QK(N0, N1, bKn, ((t) + 1) * 64); \
        } \
        if ((t) * 64 <= qw0) A_SOFTPV(C0, C1, lds + so_cur + A_KB); \
        so_cur = so_next; so_next = (so_next == 2 * A_BUF) ? 0 : so_next + A_BUF; } while (0)
    int so_cur = 0, so_next = A_BUF;
    A_LOAD(p, 0); A_LOAD(q, 1);
    A_STORE(p, lds, lds + A_KB);
    __syncthreads();
    A_LOAD(p, 2);
    f32x16 sa0, sa1, sb0, sb1;
    A_QK(sa0, sa1, lds, 0);
    for (int t2 = 0; t2 < NT; t2 += 2) {
        A_STEP(sa0, sa1, sb0, sb1, q, t2);
        A_STEP(sb0, sb1, sa0, sa1, p, t2 + 1);
    }
#undef A_QK
#undef A_SOFTPV
#undef A_STEP
    lsum += __shfl_xor(lsum, 32, 64);
    const float inv = 1.f / lsum;
    const int b = bh >> 3, h = bh & 7;
    bf16* yo = Y + (size_t)(b * S + qw0 + r32) * LDX + 512 + h * 64 + 4 * hi;
#pragma unroll
    for (int g = 0; g < 4; ++g) {
        uint2 a, c;
        a.x = cvtpk(o0[4 * g] * inv, o0[4 * g + 1] * inv); a.y = cvtpk(o0[4 * g + 2] * inv, o0[4 * g + 3] * inv);
        c.x = cvtpk(o1[4 * g] * inv, o1[4 * g + 1] * inv); c.y = cvtpk(o1[4 * g + 2] * inv, o1[4 * g + 3] * inv);
        *(uint2*)(yo + 8 * g) = a; *(uint2*)(yo + 32 + 8 * g) = c;
    }
    __syncthreads();
}
__device__ __forceinline__ void phase_attn(const Params& P, char* lds) {
    const bf16* Qb = (const bf16*)(P.ws + WS_Q);
    const bf16* Kb = (const bf16*)(P.ws + WS_K);
    const bf16* Vb = (const bf16*)(P.ws + WS_V);
    bf16* Y = (bf16*)(P.ws + WS_XN);
    for (int u = blockIdx.x; u < NB * NH * (S / 256); u += gridDim.x) {
        const int bh = u & 31, v = u >> 5;
        const int qblk = (v < 8) ? (31 - v) : (v < 16) ? (v - 8) : (v < 24) ? (39 - v) : (v - 16);
        attn_unit(Qb, Kb, Vb, Y, bh, qblk, lds);
    }
}

#define NET_HD __device__ __forceinline__
#define NET_U2F(u) __uint_as_float(u)
#define NET_F2U(f) __float_as_uint(f)
#define CE_DESC(a, b) do { const float hi__ = fmaxf(a, b), lo__ = fminf(a, b); a = hi__; b = lo__; } while (0)
NET_HD void sort16_desc(float (&v)[16]) {
#define CE2(a, b) CE_DESC(v[a], v[b])
    CE2(0,13); CE2(1,12); CE2(2,15); CE2(3,14); CE2(4,8); CE2(5,6); CE2(7,11); CE2(9,10);
    CE2(0,5); CE2(1,7); CE2(2,9); CE2(3,4); CE2(6,13); CE2(8,14); CE2(10,15); CE2(11,12);
    CE2(0,1); CE2(2,3); CE2(4,5); CE2(6,8); CE2(7,9); CE2(10,11); CE2(12,13); CE2(14,15);
    CE2(0,2); CE2(1,3); CE2(4,10); CE2(5,11); CE2(6,7); CE2(8,9); CE2(12,14); CE2(13,15);
    CE2(1,2); CE2(3,12); CE2(4,6); CE2(5,7); CE2(8,10); CE2(9,11); CE2(13,14);
    CE2(1,4); CE2(2,6); CE2(5,8); CE2(7,10); CE2(9,13); CE2(11,14);
    CE2(2,4); CE2(3,6); CE2(9,12); CE2(11,13);
    CE2(3,5); CE2(6,8); CE2(7,9); CE2(10,12);
    CE2(3,4); CE2(5,6); CE2(7,8); CE2(9,10); CE2(11,12);
    CE2(6,7); CE2(8,9);
#undef CE2
}
NET_HD void merge16_desc(float (&a)[16], const float (&b)[16]) {
#pragma unroll
    for (int i = 0; i < 16; ++i) a[i] = fmaxf(a[i], b[15 - i]);
#pragma unroll
    for (int j = 8; j > 0; j >>= 1) {
#pragma unroll
        for (int i = 0; i < 16; ++i) { const int l = i ^ j; if (l > i) CE_DESC(a[i], a[l]); }
    }
}
NET_HD void top16_of_64(float (&g0)[16], float (&g1)[16], float (&g2)[16], float (&g3)[16]) {
    sort16_desc(g0); sort16_desc(g1); sort16_desc(g2); sort16_desc(g3);
    merge16_desc(g0, g1); merge16_desc(g2, g3); merge16_desc(g0, g2);
}
NET_HD float u2f(unsigned u) { return NET_U2F(u); }
NET_HD unsigned f2u(float f) { return NET_F2U(f); }
template <class V16>
NET_HD void lane_top16(const V16& s0, const V16& s1, const V16& s2, const V16& s3, int hi, float (&out)[16]) {
    float g0[16], g1[16], g2[16], g3[16];
#pragma unroll
    for (int r = 0; r < 16; ++r) {
        const unsigned nb = (unsigned)((r & 3) + 8 * (r >> 2));
        g0[r] = u2f((f2u(s0[r]) & 0xFFFFFF80u) | nb); g1[r] = u2f((f2u(s1[r]) & 0xFFFFFF80u) | (nb + 32u));
        g2[r] = u2f((f2u(s2[r]) & 0xFFFFFF80u) | (nb + 64u)); g3[r] = u2f((f2u(s3[r]) & 0xFFFFFF80u) | (nb + 96u));
    }
    top16_of_64(g0, g1, g2, g3);
    const unsigned h4 = (unsigned)hi << 2;
#pragma unroll
    for (int i = 0; i < 16; ++i) out[i] = u2f(f2u(g0[i]) | h4);
}
constexpr int cand_slot(int a, int b) { int n = 0; for (int x = 0; x < 16; ++x) for (int y = 0; y < 16; ++y) { if (x == a && y == b) return n; if ((x + 1) * (y + 1) <= 16) ++n; } return n; }
NET_HD void cand_top16(const float (&s1)[16], const float (&s2)[16], float (&c)[16]) {
    float g0[16], g1[16], g2[16], g3[16];
#pragma unroll
    for (int i = 0; i < 16; ++i) { g0[i] = -3.0e38f; g1[i] = -3.0e38f; g2[i] = -3.0e38f; g3[i] = -3.0e38f; }
#pragma unroll
    for (int a = 0; a < 16; ++a) {
#pragma unroll
        for (int b = 0; b < 16; ++b) {
            if ((a + 1) * (b + 1) <= 16) {
                const int sl = cand_slot(a, b);
                const float v = u2f((f2u(s1[a] + s2[b]) & 0xFFFFFF00u) | (unsigned)(a * 16 + b));
                if (sl < 16) g0[sl & 15] = v; else if (sl < 32) g1[sl & 15] = v; else if (sl < 48) g2[sl & 15] = v; else g3[sl & 15] = v;
            }
        }
    }
    top16_of_64(g0, g1, g2, g3);
#pragma unroll
    for (int i = 0; i < 16; ++i) c[i] = g0[i];
}

__device__ __forceinline__ void phase_route(const Params& P, int l, char* lds) {
    const bf16* XQb = (const bf16*)(P.ws + WS_XQ);
    const bf16* Wc = (const bf16*)(P.ws + WS_WC8 + (size_t)l * 2048 * XQP);
    const float* WcS = (const float*)(P.ws + WS_WCS) + (size_t)l * 2048;
    const float* XSc = (const float*)(P.ws + WS_XS);
    int* EXPp = (int*)(P.ws + WS_EXP);
    float* GATEp = (float*)(P.ws + WS_GATE);
    const int tid = tidx();
    float* xch = (float*)(lds + 16384);
    int tlo, thi, tst; tile_rounds((T / 256) * PH, tlo, thi, tst);
    int nt = D / 128; asm volatile("" : "+s"(nt));
    for (int u = tlo; u < thi; u += tst) {
        const int tm = u >> 3, h = u & 7;
        float Lk[16];
        {
            i32x4 acc[2][2][4][2]; float ssd[2][2];
            gemm8_kloop<false, true, i32x4>(Wc + (size_t)(h * 256) * (XQP / 2), XQP / 2, XQb + (size_t)(tm * 256) * (XQP / 2), XQP / 2, nt, acc, ssd, lds, tid);
            const int te = tidx(), fq = (te >> 4) & 3;
            const unsigned fqb = (unsigned)fq << 2;
            float4 ks[2][4];
            { const float* kp = WcS + h * 256 + ((te >> 8) & 1) * 128 + fq * 4;
#pragma unroll
              for (int ai = 0; ai < 2; ++ai)
#pragma unroll
                  for (int m = 0; m < 4; ++m) ks[ai][m] = *(const float4*)(kp + ai * 64 + m * 16); }
#pragma unroll
            for (int i = 0; i < 16; ++i) Lk[i] = 0.f;
#pragma unroll
            for (int bj = 0; bj < 2; ++bj)
#pragma unroll
                for (int n = 0; n < 2; ++n) {
                    float g0[16], g1[16];
#pragma unroll
                    for (int m = 0; m < 4; ++m)
#pragma unroll
                        for (int j = 0; j < 4; ++j) {
                            const unsigned kb = (unsigned)(m * 16 + j) | fqb;
                            const float k0 = (j == 0) ? ks[0][m].x : (j == 1) ? ks[0][m].y : (j == 2) ? ks[0][m].z : ks[0][m].w;
                            const float k1 = (j == 0) ? ks[1][m].x : (j == 1) ? ks[1][m].y : (j == 2) ? ks[1][m].z : ks[1][m].w;
                            g0[m * 4 + j] = u2f((f2u((float)acc[0][bj][m][n][j] * k0) & 0xFFFFFF80u) | kb);
                            g1[m * 4 + j] = u2f((f2u((float)acc[1][bj][m][n][j] * k1) & 0xFFFFFF80u) | (kb + 64u));
                        }
                    sort16_desc(g0); sort16_desc(g1); merge16_desc(g0, g1);
                    float o[16];
#pragma unroll
                    for (int i = 0; i < 16; ++i) o[i] = __shfl_xor(g0[i], 16, 64);
                    merge16_desc(g0, o);
#pragma unroll
                    for (int i = 0; i < 16; ++i) o[i] = __shfl_xor(g0[i], 32, 64);
                    merge16_desc(g0, o);
                    const bool mine = fq == bj * 2 + n;
#pragma unroll
                    for (int i = 0; i < 16; ++i) Lk[i] = mine ? g0[i] : Lk[i];
                }
        }
        __syncthreads();
        const int te = tidx(), lane = te & 63, w = te >> 6, wr = w >> 2, wc = w & 3, fr = lane & 15, fq = lane >> 4;
        if (wr == 1) {
#pragma unroll
            for (int q = 0; q < 4; ++q) *(float4*)(xch + ((wc * 64 + lane) * 16) + 4 * q) = make_float4(Lk[4 * q], Lk[4 * q + 1], Lk[4 * q + 2], Lk[4 * q + 3]);
        }
        __syncthreads();
        if (wr == 0) {
            float L1[16];
#pragma unroll
            for (int q = 0; q < 4; ++q) { const float4 v = *(const float4*)(xch + ((wc * 64 + lane) * 16) + 4 * q); L1[4 * q] = v.x; L1[4 * q + 1] = v.y; L1[4 * q + 2] = v.z; L1[4 * q + 3] = v.w; }
            float c[16];
            cand_top16(Lk, L1, c);
            unsigned char* my = (unsigned char*)lds + te * 32;
            {
                uint4 a, b;
#define PK4(L, i) ((__float_as_uint(L[i]) & 127u) | ((__float_as_uint(L[i + 1]) & 127u) << 8) | ((__float_as_uint(L[i + 2]) & 127u) << 16) | ((__float_as_uint(L[i + 3]) & 127u) << 24))
                a.x = PK4(Lk, 0); a.y = PK4(Lk, 4); a.z = PK4(Lk, 8); a.w = PK4(Lk, 12);
                b.x = PK4(L1, 0); b.y = PK4(L1, 4); b.z = PK4(L1, 8); b.w = PK4(L1, 12);
#undef PK4
                *(uint4*)my = a; *(uint4*)(my + 16) = b;
            }
            const int t = tm * 256 + (fq >> 1) * 128 + wc * 32 + (fq & 1) * 16 + fr;
            const float xs_t = XSc[t];
            int ev[16]; float gv[16]; float den = 0.f;
#pragma unroll
            for (int k = 0; k < 16; ++k) {
                const unsigned ci = __float_as_uint(c[k]) & 255u;
                const int n1 = my[ci >> 4], n2 = my[16 + (ci & 15)];
                ev[k] = n1 * NKEY + n2;
                gv[k] = __expf((c[k] - c[0]) * xs_t); den += gv[k];
            }
            const float iden = 1.f / den;
            uint4* ep = (uint4*)(EXPp + (size_t)t * HK + h * 16);
            float4* gp = (float4*)(GATEp + (size_t)t * HK + h * 16);
#pragma unroll
            for (int q = 0; q < 4; ++q) {
                ep[q] = make_uint4((unsigned)ev[4 * q], (unsigned)ev[4 * q + 1], (unsigned)ev[4 * q + 2], (unsigned)ev[4 * q + 3]);
                gp[q] = make_float4(gv[4 * q] * iden, gv[4 * q + 1] * iden, gv[4 * q + 2] * iden, gv[4 * q + 3] * iden);
            }
        }
        __syncthreads();
    }
}

constexpr size_t WS_PART = WS_PROJ;
static_assert((size_t)8 * T * HK * 4 <= WS_K - WS_PROJ, "PART alias");
constexpr int XI_X = 0, XI_RANK = 1, XI_J = 2, XI_NX = 3, XI_NLOC = 4;
constexpr int CTL_CENSUS = 4096;
constexpr int CTL_BYTES = (CTL_CENSUS + 16) * 4;

template <int M1, int M2, int M3, class TT>
__device__ __forceinline__ void red16x3(TT (&p)[16], int lane) {
#pragma unroll
    for (int i = 0; i < 8; ++i) { const bool up = lane & M1; const TT send = up ? p[i] : p[i + 8], keep = up ? p[i + 8] : p[i]; p[i] = keep + __shfl_xor(send, M1, 64); }
#pragma unroll
    for (int i = 0; i < 4; ++i) { const bool up = lane & M2; const TT send = up ? p[i] : p[i + 4], keep = up ? p[i + 4] : p[i]; p[i] = keep + __shfl_xor(send, M2, 64); }
#pragma unroll
    for (int i = 0; i < 2; ++i) { const bool up = lane & M3; const TT send = up ? p[i] : p[i + 2], keep = up ? p[i + 2] : p[i]; p[i] = keep + __shfl_xor(send, M3, 64); }
}
__device__ __forceinline__ void phase_gu(const Params& P, int l, const volatile int* xi) {
    const unsigned char* XQ = P.ws + WS_XQ;
    const float* XSc = (const float*)(P.ws + WS_XS);
    const int* EXPp = (const int*)(P.ws + WS_EXP);
    float* PART = (float*)(P.ws + WS_PART);
    const int tid = tidx(), lane = tid & 63, w = tid >> 6, g = lane >> 3, c = lane & 7;
    int xo_ = 0; asm volatile("" : "+v"(xo_));
    const int j = __builtin_amdgcn_readfirstlane(xi[xo_ + XI_J]), nx = __builtin_amdgcn_readfirstlane(xi[xo_ + XI_NX]), nloc = __builtin_amdgcn_readfirstlane(xi[xo_ + XI_NLOC]), rank = __builtin_amdgcn_readfirstlane(xi[xo_ + XI_RANK]);
    const int t0 = rank * NW + w, st = nloc * NW;
    const int n = (t0 < T) ? (T - t0 + st - 1) / st : 0;
    const int i0 = 8 * (c & 1) + 4 * ((c >> 1) & 1) + 2 * ((c >> 2) & 1);
    for (int sl = j; sl < 8 && n > 0; sl += nx) {
        const unsigned char* Us = P.ws + WS_TABU + ((size_t)(l * 8 + sl) * NEXP) * 128;
        const unsigned co = (unsigned)c << 4;
        float* part = PART + (size_t)sl * T * HK;
        const unsigned char* xs = XQ + sl * 128 + c * 16;
#define GU_TK(k) (t0 + (((k) < n) ? (k) : (n - 1)) * st)
#define GU_LOADE(S, t) do { S##lo = EXPp[(size_t)(t) * HK + lane]; S##hi = EXPp[(size_t)(t) * HK + 64 + lane]; } while (0)
#define GU_LOADX(S, t) do { S##a = *(const uint4*)(xs + (size_t)(t) * XQP); S##s = XSc[t]; } while (0)
#define GU_ISSUE(R, S) do { _Pragma("unroll") for (int i = 0; i < 16; ++i) { \
            const int e = __builtin_amdgcn_ds_bpermute((((8 * i) & 63) + g) << 2, (i < 8) ? S##lo : S##hi); R[i] = *(const uint4*)(Us + (((unsigned)e << 7) | co)); } } while (0)
#define GU_FINISH(R, S, t) do { \
            int p[16]; \
            _Pragma("unroll") for (int i = 0; i < 16; ++i) { int d_ = __builtin_amdgcn_sdot4((int)S##a.x, (int)R[i].x, 0, false); d_ = __builtin_amdgcn_sdot4((int)S##a.y, (int)R[i].y, d_, false); \
                d_ = __builtin_amdgcn_sdot4((int)S##a.z, (int)R[i].z, d_, false); p[i] = __builtin_amdgcn_sdot4((int)S##a.w, (int)R[i].w, d_, false); } \
            red16x3<1, 2, 4, int>(p, lane); \
            part[(size_t)(t) * HK + 8 * i0 + g] = (float)p[0] * S##s; part[(size_t)(t) * HK + 8 * (i0 + 1) + g] = (float)p[1] * S##s; } while (0)
        int eAlo, eAhi, eBlo, eBhi; uint4 xAa, xBa; float xAs, xBs; uint4 rA[16], rB[16];
        GU_LOADE(eA, GU_TK(0)); GU_LOADX(xA, GU_TK(0)); GU_LOADE(eB, GU_TK(1));
        GU_ISSUE(rA, eA);
        for (int k = 0; k < n; k += 2) {
            GU_LOADX(xB, GU_TK(k + 1)); GU_ISSUE(rB, eB); GU_LOADE(eA, GU_TK(k + 2));
            GU_FINISH(rA, xA, GU_TK(k));
            GU_LOADX(xA, GU_TK(k + 2)); GU_ISSUE(rA, eA); GU_LOADE(eB, GU_TK(k + 3));
            GU_FINISH(rB, xB, GU_TK(k + 1));
        }
#undef GU_TK
#undef GU_LOADE
#undef GU_LOADX
#undef GU_ISSUE
#undef GU_FINISH
    }
}
__device__ __forceinline__ void phase_gw(const Params& P, int l) {
    const int* EXPp = (const int*)(P.ws + WS_EXP);
    const float* GATEp = (const float*)(P.ws + WS_GATE);
    const float* PART = (const float*)(P.ws + WS_PART);
    const float* SU = (const float*)(P.ws + WS_TSCU) + (size_t)l * NEXP;
    const float* SV = (const float*)(P.ws + WS_TSCV) + (size_t)l * NEXP;
    unsigned char* WQ = P.ws + WS_WQ8;
    float* WSC = (float*)(P.ws + WS_WSC);
    const int lane = tidx() & 63;
    for (int tb = gwave() * 4; tb < T; tb += nwave() * 4) {
        float wv[4][2];
#pragma unroll
        for (int q = 0; q < 4; ++q)
#pragma unroll
            for (int hk = 0; hk < 2; ++hk) {
                const size_t i = (size_t)(tb + q) * HK + hk * 64 + lane;
                float s = 0.f;
#pragma unroll
                for (int x = 0; x < 8; ++x) s += PART[(size_t)x * T * HK + i];
                const int e = EXPp[i];
                wv[q][hk] = GATEp[i] * gelu_exact(s * SU[e]) * SV[e];
            }
#pragma unroll
        for (int q = 0; q < 4; ++q) {
            float am = fmaxf(fabsf(wv[q][0]), fabsf(wv[q][1]));
#pragma unroll
            for (int m = 32; m >= 1; m >>= 1) am = fmaxf(am, __shfl_xor(am, m, 64));
            const float sc = (am > 0.f) ? am * (1.f / 448.f) : 1.f, is = 1.f / sc;
            const int pk = __builtin_amdgcn_cvt_pk_fp8_f32(wv[q][0] * is, wv[q][1] * is, 0, false);
            WQ[(size_t)(tb + q) * HK + lane] = (unsigned char)(pk & 255);
            WQ[(size_t)(tb + q) * HK + 64 + lane] = (unsigned char)((pk >> 8) & 255);
            if (lane == 0) WSC[tb + q] = sc;
        }
    }
}
typedef int v2i_t __attribute__((ext_vector_type(2)));
typedef unsigned u32x4_t __attribute__((ext_vector_type(4)));
typedef __attribute__((ext_vector_type(4))) float f32x4;
constexpr int GV_PIECE = 1024 + 16;
constexpr int GV_TILE = 16 * GV_PIECE;
static_assert(NW * GV_TILE + NW * 512 <= LDS_TOTAL, "gv LDS");
__device__ __forceinline__ void phase_gv(const Params& P, int l, const volatile int* xi, char* lds) {
    const int* EXPp = (const int*)(P.ws + WS_EXP);
    const unsigned char* WQ = P.ws + WS_WQ8;
    const float* WSC = (const float*)(P.ws + WS_WSC);
    const int tid = tidx(), lane = tid & 63, w = __builtin_amdgcn_readfirstlane(tid >> 6), g = lane >> 3, pos = lane & 7;
    int xo_ = 0; asm volatile("" : "+v"(xo_));
    const int j = __builtin_amdgcn_readfirstlane(xi[xo_ + XI_J]), nx = __builtin_amdgcn_readfirstlane(xi[xo_ + XI_NX]), nloc = __builtin_amdgcn_readfirstlane(xi[xo_ + XI_NLOC]), rank = __builtin_amdgcn_readfirstlane(xi[xo_ + XI_RANK]);
    const int t0 = rank * NW + w, st = nloc * NW;
    const int n = (t0 < T) ? (T - t0 + st - 1) / st : 0;
    char* tile = lds + w * GV_TILE;
    float* strip = (float*)(lds + NW * GV_TILE) + w * 128;
    typedef __attribute__((address_space(3))) v2i_t* ldsv2_t;
    const unsigned co = (unsigned)(pos ^ g) << 4;
    const int rr = (lane & 15) >> 1, kq = lane >> 4;
    const int rdo = kq * GV_PIECE + rr * 128 + (lane & 1) * 8;
    const bool row0 = (lane & 15) == 0;
    __syncthreads();
    for (int sl = j; sl < 8 && n > 0; sl += nx) {
        const unsigned char* Vs = P.ws + WS_TABV + ((size_t)(l * 8 + sl) * NEXP) * 128;
        const char* hrow = (const char*)P.out + sl * 256 + 4 * lane;
#define GV_TK(k) (t0 + (((k) < n) ? (k) : (n - 1)) * st)
#define GV_LOADE(S, t) do { S##el = EXPp[(size_t)(t) * HK + lane]; S##eh = EXPp[(size_t)(t) * HK + 64 + lane]; } while (0)
#define GV_ISSUE(R, S) do { _Pragma("unroll") for (int i = 0; i < 16; ++i) { \
            const int e = __builtin_amdgcn_ds_bpermute((((8 * i) & 63) + g) << 2, (i < 8) ? S##el : S##eh); R[i] = *(const u32x4_t*)(Vs + (((unsigned)e << 7) | co)); } } while (0)
#define GV_LOADT(S, kk) do { const int t_ = GV_TK(kk); \
            S##a0 = 0; S##a1 = 0; S##a2 = 0; S##a3 = 0; \
            if (row0) { const long* wp = (const long*)(WQ + (size_t)t_ * HK + kq * 8); S##a0 = wp[0]; S##a1 = wp[4]; S##a2 = wp[8]; S##a3 = wp[12]; } \
            S##ws = ((kk) < n) ? WSC[t_] : 0.f; \
            S##hv = *(const unsigned*)(hrow + (size_t)t_ * (HP * 2)); } while (0)
#define GV_TOKEN(R, S, kk) do { \
            const int t = GV_TK(kk); \
            _Pragma("unroll") for (int i = 0; i < 16; ++i) *(u32x4_t*)(tile + i * GV_PIECE + lane * 16) = R[i]; \
            f32x4 acc[8]; \
            _Pragma("unroll") for (int nt = 0; nt < 8; ++nt) acc[nt] = (f32x4){0.f, 0.f, 0.f, 0.f}; \
            _Pragma("unroll") for (int s4 = 0; s4 < 4; ++s4) { \
                const long av = (s4 == 0) ? S##a0 : (s4 == 1) ? S##a1 : (s4 == 2) ? S##a2 : S##a3; \
                _Pragma("unroll") for (int nt = 0; nt < 8; ++nt) { \
                    const v2i_t bv = __builtin_amdgcn_ds_read_tr8_b64_v2i32((ldsv2_t)(void*)(tile + (4 * s4) * GV_PIECE + rdo + ((nt ^ rr) << 4))); \
                    acc[nt] = __builtin_amdgcn_mfma_f32_16x16x32_fp8_fp8(av, __builtin_bit_cast(long, bv), acc[nt], 0, 0, 0); } } \
            if (lane < 16) { _Pragma("unroll") for (int nt = 0; nt < 8; ++nt) strip[16 * nt + lane] = acc[nt][0]; }        \
            { const float2 o2 = *(const float2*)(strip + 2 * lane); \
              if ((kk) < n) *(unsigned*)(hrow + (size_t)t * (HP * 2)) = pack2(bflo(S##hv) + S##ws * o2.x, bfhi(S##hv) + S##ws * o2.y); } } while (0)
        int Ael, Aeh, Bel, Beh; u32x4_t rA[16], rB[16];
        long Pa0, Pa1, Pa2, Pa3, Qa0, Qa1, Qa2, Qa3; float Pws, Qws; unsigned Phv, Qhv;
        GV_LOADE(A, GV_TK(0)); GV_LOADE(B, GV_TK(1));
        GV_ISSUE(rA, A); GV_LOADT(P, 0);
        for (int k = 0; k < n; k += 2) {
            GV_ISSUE(rB, B); GV_LOADE(A, GV_TK(k + 2)); GV_LOADT(Q, k + 1);
            GV_TOKEN(rA, P, k);
            GV_ISSUE(rA, A); GV_LOADE(B, GV_TK(k + 3)); GV_LOADT(P, k + 2);
            GV_TOKEN(rB, Q, k + 1);
        }
#undef GV_TK
#undef GV_LOADE
#undef GV_ISSUE
#undef GV_LOADT
#undef GV_TOKEN
    }
    __syncthreads();
}
__device__ __forceinline__ void phase_gnorm(const Params& P, int l) {
    const int lane = tidx() & 63, nw = nwave();
    bf16* XNw = (bf16*)(P.ws + WS_XN);
    const bf16* Hb = (const bf16*)P.out;
    const float4* g = (const float4*)((l == DEPTH - 1) ? P.norm_final : (P.norm_mix + (l + 1) * D));
    for (int t = gwave(); t < T; t += 2 * nw) {
        const int t2 = (t + nw < T) ? (t + nw) : t;
        float4 v[2][4];
#pragma unroll
        for (int q = 0; q < 4; ++q) {
            const uint2 a = ((const uint2*)(Hb + (size_t)t * HP))[q * 64 + lane], b = ((const uint2*)(Hb + (size_t)t2 * HP))[q * 64 + lane];
            v[0][q] = make_float4(bflo(a.x), bfhi(a.x), bflo(a.y), bfhi(a.y)); v[1][q] = make_float4(bflo(b.x), bfhi(b.x), bflo(b.y), bfhi(b.y));
        }
#pragma unroll
        for (int u = 0; u < 2; ++u) {
            float ss = 0.f;
#pragma unroll
            for (int q = 0; q < 4; ++q) ss += v[u][q].x * v[u][q].x + v[u][q].y * v[u][q].y + v[u][q].z * v[u][q].z + v[u][q].w * v[u][q].w;
            ss = wave_sum(ss);
            const float rn = rsqrtf(ss * (1.f / D) + EPS);
            const int tt = u ? t2 : t;
            if (u == 0 || t2 != t) {
                float4* hr = (float4*)(P.out + (size_t)tt * D);
#pragma unroll
                for (int q = 0; q < 4; ++q) {
                    const float4 gg = g[q * 64 + lane];
                    const float4 o = make_float4(v[u][q].x * rn * gg.x, v[u][q].y * rn * gg.y, v[u][q].z * rn * gg.z, v[u][q].w * rn * gg.w);
                    if (l == DEPTH - 1) hr[q * 64 + lane] = o;
                    else { uint2 uu; uu.x = pack2(o.x, o.y); uu.y = pack2(o.z, o.w); ((uint2*)(XNw + (size_t)tt * LDX))[q * 64 + lane] = uu; }
                }
            }
        }
    }
}

#define XB_TMO      128
#define XB_XCNT(j)  (256  + 64 * (j))
#define XB_XSUB(j)  (1280 + 64 * (j))
#define XB_XGEN(j)  (2304 + 64 * (j))
#define XB_TOP      3328
#define XB_TOPGEN   3392
#define XCD_BAR_WORDS 3456
#define XB_SPIN_CAP (1u << 22)
#define LAS __attribute__((address_space(3)))
__device__ __forceinline__ unsigned xb_ld(unsigned* p)              { return __hip_atomic_load(p, __ATOMIC_RELAXED, __HIP_MEMORY_SCOPE_AGENT); }
__device__ __forceinline__ unsigned xb_add(unsigned* p, unsigned v) { return __hip_atomic_fetch_add(p, v, __ATOMIC_RELAXED, __HIP_MEMORY_SCOPE_AGENT); }
__device__ __forceinline__ unsigned xb_xcc_id() { return (unsigned)__builtin_amdgcn_s_getreg((3 << 11) | 20) & 0xFu; }
#define XB_SPIN(cond, bar) do { unsigned _sp = 0; while (cond) { __builtin_amdgcn_s_sleep(1); \
    if ((++_sp & 255u) == 0u) { if (xb_ld(&(bar)[XB_TMO])) break; if (_sp > XB_SPIN_CAP) { atomicAdd(&(bar)[XB_TMO], 1u); break; } } } } while (0)
struct XcdBarrier { unsigned* bar; unsigned x; volatile LAS unsigned* st; };
__device__ __forceinline__ XcdBarrier xcd_barrier_post(unsigned* bar, volatile LAS unsigned* st) {
    XcdBarrier b; b.bar = bar; b.x = xb_xcc_id(); b.st = st;
    if (__builtin_amdgcn_workitem_id_x() == 0) (void)xb_add(&bar[XB_XCNT(b.x)], 1u);
    return b;
}
__device__ __forceinline__ void xcd_barrier_complete(unsigned* bar, unsigned x, unsigned& nloc, unsigned& nx) {
    const unsigned G = gridDim.x * gridDim.y * gridDim.z;
    unsigned sum, cnt, mine, sp = 0u;
    for (;;) {
        sum = 0u; cnt = 0u; mine = 0u;
#pragma unroll
        for (unsigned j = 0; j < 16; ++j) { const unsigned c = xb_ld(&bar[XB_XCNT(j)]); sum += c; cnt += (c > 0u) ? 1u : 0u; mine = (j == x) ? c : mine; }
        if (sum == G) break;
        __builtin_amdgcn_s_sleep(1);
        if ((++sp & 255u) == 0u) { if (xb_ld(&bar[XB_TMO])) break; if (sp > XB_SPIN_CAP) { atomicAdd(&bar[XB_TMO], 1u); break; } }
    }
    nloc = mine > 0u ? mine : 1u; nx = cnt > 0u ? cnt : 1u;
}
__device__ __forceinline__ void xcd_barrier(const XcdBarrier& b) {
    asm volatile("s_waitcnt vmcnt(0)" ::: "memory");
    __syncthreads();
    if (__builtin_amdgcn_workitem_id_x() == 0) {
        unsigned* bar = b.bar;
        __builtin_amdgcn_s_waitcnt(0);
        unsigned nloc = b.st[0], nx = b.st[1];
        if (nloc == 0u) { xcd_barrier_complete(bar, b.x, nloc, nx); b.st[0] = nloc; b.st[1] = nx; }
        const unsigned old = xb_add(&bar[XB_XSUB(b.x)], 1u);
        const unsigned gen = old / nloc;
        if (old + 1u == (gen + 1u) * nloc) {
            __builtin_amdgcn_fence(__ATOMIC_RELEASE, "agent");
            asm volatile("s_waitcnt vmcnt(0)" ::: "memory");
            const unsigned og = xb_add(&bar[XB_TOP], 1u);
            const unsigned tg = og / nx;
            if (og + 1u == (tg + 1u) * nx) xb_add(&bar[XB_TOPGEN], 1u);
            else XB_SPIN(xb_ld(&bar[XB_TOPGEN]) == tg, bar);
            __builtin_amdgcn_fence(__ATOMIC_ACQUIRE, "agent");
            xb_add(&bar[XB_XGEN(b.x)], 1u);
            asm volatile("s_waitcnt vmcnt(0)" ::: "memory");
        } else {
            XB_SPIN(xb_ld(&bar[XB_XGEN(b.x)]) == gen, bar);
            __builtin_amdgcn_fence(__ATOMIC_ACQUIRE, "agent");
            asm volatile("s_waitcnt vmcnt(0)" ::: "memory");
        }
    }
    __syncthreads();
}

constexpr float QSCALE = 0.10206207261596575f * 1.4426950408889634f;

__device__ __forceinline__ void phase_gemm1(const Params& P, int l, char* lds) {
    unsigned char* ws = P.ws;
    const bf16* XN = (const bf16*)(ws + WS_XN);
    bf16* PROJ = (bf16*)(ws + WS_PROJ);
    bf16* Kb = (bf16*)(ws + WS_K);
    const float* rope = (const float*)(ws + WS_ROPE);
    const bf16* W = (const bf16*)(ws + WS_WIN) + (size_t)l * DINP * LDW;
    float* SSQ = (float*)(ws + WS_SSQ);
    const int lane = tidx() & 63;
    if (l == 0) {
        const bf16* Wc = (const bf16*)(ws + WS_WPQ);
        unsigned char* W8 = ws + WS_WC8; float* WS8 = (float*)(ws + WS_WCS);
        for (int row = gwave(); row < DEPTH * 2048; row += nwave()) {
            const uint4 a = ((const uint4*)(Wc + (size_t)row * LDW))[lane * 2], b = ((const uint4*)(Wc + (size_t)row * LDW))[lane * 2 + 1];
            float v[16] = {bflo(a.x), bfhi(a.x), bflo(a.y), bfhi(a.y), bflo(a.z), bfhi(a.z), bflo(a.w), bfhi(a.w), bflo(b.x), bfhi(b.x), bflo(b.y), bfhi(b.y), bflo(b.z), bfhi(b.z), bflo(b.w), bfhi(b.w)};
            float am = 0.f;
#pragma unroll
            for (int i = 0; i < 16; ++i) am = fmaxf(am, fabsf(v[i]));
#pragma unroll
            for (int m = 32; m >= 1; m >>= 1) am = fmaxf(am, __shfl_xor(am, m, 64));
            const float sc = (am > 0.f) ? am * (1.f / 127.f) : 1.f, is = 1.f / sc;
            uint4 o;
            o.x = pack_i8x4(v[0] * is, v[1] * is, v[2] * is, v[3] * is); o.y = pack_i8x4(v[4] * is, v[5] * is, v[6] * is, v[7] * is);
            o.z = pack_i8x4(v[8] * is, v[9] * is, v[10] * is, v[11] * is); o.w = pack_i8x4(v[12] * is, v[13] * is, v[14] * is, v[15] * is);
            ((uint4*)(W8 + (size_t)row * XQP))[lane] = o;
            if (lane == 0) WS8[row] = sc;
        }
    }
    int tlo, thi, tst; tile_rounds((T / 256) * (DINP / 256), tlo, thi, tst);
    gemm_t8<false, false>(W, LDW, DINP, XN, LDX, D, tlo, thi, tst, [&](int t, int n, const float4& v, const float4&) {
        const int nb = __builtin_amdgcn_readfirstlane(n);
        if (nb < C_KR) {
            uint2 o; o.x = cvtpk(v.x, v.y); o.y = cvtpk(v.z, v.w);
            *(uint2*)(PROJ + (size_t)t * DINP + n) = o;
            if (nb >= C_CQ) {
                float q = v.x * v.x + v.y * v.y + v.z * v.z + v.w * v.w;
                q += __shfl_xor(q, 1, 64); q += __shfl_xor(q, 2, 64); q += __shfl_xor(q, 4, 64); q += __shfl_xor(q, 8, 64);
                if (n == nb) SSQ[(size_t)t * 16 + ((nb - C_CQ) >> 6)] = q;
            }
        } else if (nb == C_KR) {
            const float4 up = make_float4(__shfl(v.x, lane + 4, 64), __shfl(v.y, lane + 4, 64), __shfl(v.z, lane + 4, 64), __shfl(v.w, lane + 4, 64));
            const float4 dn = make_float4(__shfl(v.x, lane - 4, 64), __shfl(v.y, lane - 4, 64), __shfl(v.z, lane - 4, 64), __shfl(v.w, lane - 4, 64));
            const int d = n - C_KR;
            if (d < 32) {
                const int b = t / S, s = t % S;
                const bool first = d < 16;
                const int f = first ? d : (d - 16);
                const float4 cs0 = *(const float4*)(rope + ((size_t)s * 16 + f) * 2), cs1 = *(const float4*)(rope + ((size_t)s * 16 + f) * 2 + 4);
                float4 o;
                if (first) o = make_float4(v.x * cs0.x - up.x * cs0.y, v.y * cs0.z - up.y * cs0.w, v.z * cs1.x - up.z * cs1.y, v.w * cs1.z - up.w * cs1.w);
                else       o = make_float4(v.x * cs0.x + dn.x * cs0.y, v.y * cs0.z + dn.y * cs0.w, v.z * cs1.x + dn.z * cs1.y, v.w * cs1.z + dn.w * cs1.w);
                uint2 u; u.x = cvtpk(o.x, o.y); u.y = cvtpk(o.z, o.w);
#pragma unroll
                for (int h = 0; h < NH; ++h) *(uint2*)(Kb + ((size_t)(b * NH + h) * S + s) * DQK + 64 + d) = u;
            }
        }
    }, [](int) { return 1.f; }, [](int, int) { return make_float4(0.f, 0.f, 0.f, 0.f); }, lds);
}
__device__ __forceinline__ void phase_gemm2(const Params& P, int l, char* lds) {
    unsigned char* ws = P.ws;
    const bf16* PROJ = (const bf16*)(ws + WS_PROJ);
    const float* rope = (const float*)(ws + WS_ROPE);
    const float* SSQ = (const float*)(ws + WS_SSQ);
    const int G = gridDim.x, bid = blockIdx.x;
    const int vb = ((G & 7) == 0) ? ((bid & 7) * (G >> 3) + (bid >> 3)) : bid;
    int qlo, qhi, klo, khi;
    if ((G & 1) == 0) {
        const int Gh = G >> 1, pq = (384 + Gh - 1) / Gh, pk = (512 + Gh - 1) / Gh;
        if (vb < Gh) { qlo = vb * pq; qhi = qlo + pq; if (qhi > 384) qhi = 384; if (qlo > 384) qlo = 384; klo = 0; khi = 0; }
        else { klo = (vb - Gh) * pk; khi = klo + pk; if (khi > 512) khi = 512; if (klo > 512) klo = 512; qlo = 0; qhi = 0; }
    } else { tile_range(384, qlo, qhi); tile_range(512, klo, khi); }
    {
        const bf16* W = (const bf16*)(ws + WS_WUQ) + (size_t)l * 768 * QR;
        bf16* Qb = (bf16*)(ws + WS_Q);
        gemm_t8<true, false>(W, QR, 768, PROJ + C_CQ, DINP, QR, qlo, qhi, 1,
            [&](int t, int n, const float4& v, const float4&) {
                const int b = t / S, s = t % S, h = n / DQK, d = n % DQK;
                float4 o = v;
                const int lane = tidx() & 63;
                const float4 up = make_float4(__shfl(v.x, lane + 4, 64), __shfl(v.y, lane + 4, 64), __shfl(v.z, lane + 4, 64), __shfl(v.w, lane + 4, 64));
                const float4 dn = make_float4(__shfl(v.x, lane - 4, 64), __shfl(v.y, lane - 4, 64), __shfl(v.z, lane - 4, 64), __shfl(v.w, lane - 4, 64));
                if (d >= 64) {
                    const bool first = d < 80;
                    const int f = first ? (d - 64) : (d - 80);
                    const float4 cs0 = *(const float4*)(rope + ((size_t)s * 16 + f) * 2), cs1 = *(const float4*)(rope + ((size_t)s * 16 + f) * 2 + 4);
                    if (first) o = make_float4(v.x * cs0.x - up.x * cs0.y, v.y * cs0.z - up.y * cs0.w, v.z * cs1.x - up.z * cs1.y, v.w * cs1.z - up.w * cs1.w);
                    else       o = make_float4(v.x * cs0.x + dn.x * cs0.y, v.y * cs0.z + dn.y * cs0.w, v.z * cs1.x + dn.z * cs1.y, v.w * cs1.z + dn.w * cs1.w);
                }
                uint2 u; u.x = cvtpk(o.x, o.y); u.y = cvtpk(o.z, o.w);
                *(uint2*)(Qb + ((size_t)(b * NH + h) * S + s) * DQK + d) = u;
            }, [&](int t) { const float4 a = *(const float4*)(SSQ + (size_t)t * 16); const float2 b = *(const float2*)(SSQ + (size_t)t * 16 + 4);
                            return rsqrtf(((a.x + a.y) + (a.z + a.w) + (b.x + b.y)) * (1.f / QR) + EPS) * QSCALE; }, [](int, int) { return make_float4(0.f, 0.f, 0.f, 0.f); }, lds);
    }
    {
        const bf16* W = (const bf16*)(ws + WS_WUKV) + (size_t)l * 1024 * KVR;
        bf16* Kb = (bf16*)(ws + WS_K); bf16* Vb = (bf16*)(ws + WS_V);
        gemm_t8<true, false>(W, KVR, 1024, PROJ + C_CKV, DINP, KVR, klo, khi, 1,
            [&](int t, int n, const float4& v, const float4&) {
                const int b = t / S, s = t % S;
                uint2 u; u.x = cvtpk(v.x, v.y); u.y = cvtpk(v.z, v.w);
                if (n < 512) *(uint2*)(Kb + ((size_t)(b * NH + (n >> 6)) * S + s) * DQK + (n & 63)) = u;
                else         *(uint2*)(Vb + ((size_t)(b * NH + ((n - 512) >> 6)) * S + s) * DV + (n & 63)) = u;
            }, [&](int t) { const float2 a = *(const float2*)(SSQ + (size_t)t * 16 + 6); const float2 b = *(const float2*)(SSQ + (size_t)t * 16 + 8);
                            return rsqrtf(((a.x + a.y) + (b.x + b.y)) * (1.f / KVR) + EPS); }, [](int, int) { return make_float4(0.f, 0.f, 0.f, 0.f); }, lds);
    }
}
constexpr size_t WS_YO = WS_PROJ;
__device__ __forceinline__ void phase_gemm3(const Params& P, int l, char* lds) {
    unsigned char* ws = P.ws;
    const bf16* Yb = (const bf16*)(ws + WS_XN);
    const bf16* W = (const bf16*)(ws + WS_WOUT) + (size_t)l * D * LDW;
    bf16* YO = (bf16*)(ws + WS_YO);
    int tlo, thi, tst; tile_rounds((T / 256) * (D / 256), tlo, thi, tst);
    gemm_t8<false, false>(W, LDW, D, Yb, LDX, D, tlo, thi, tst, [&](int t, int n, const float4& v, const float4&) {
        uint2 o; o.x = cvtpk(v.x, v.y); o.y = cvtpk(v.z, v.w);
        *(uint2*)(YO + (size_t)t * D + n) = o;
    }, [](int) { return 1.f; }, [](int, int) { return make_float4(0.f, 0.f, 0.f, 0.f); }, lds);
}

#define GSYNC() do { XcdBarrier xb_; { __attribute__((address_space(1))) char* gp_ = (__attribute__((address_space(1))) char*)(char*)(P.ws + WS_CTL); asm volatile("" : "+s"(gp_)); xb_.bar = (unsigned*)(char*)gp_; } \
    xb_.x = xb_xcc_id(); xb_.st = (volatile LAS unsigned*)&xb_words; xcd_barrier(xb_); } while (0)
#define PHASE(stmt) { const Params Q = launder(P); stmt; }
__global__ void __launch_bounds__(NTHREADS, 2) k_all(Params P) {
    __shared__ __attribute__((aligned(16))) char sm[LDS_TOTAL];
    __shared__ uint4 xb_words;
    cg::grid_group grid = cg::this_grid();
    if (__builtin_amdgcn_workitem_id_x() == 0) xb_words = make_uint4(0u, 0u, 0u, 0u);
    __syncthreads();
    (void)xcd_barrier_post((unsigned*)(P.ws + WS_CTL), (volatile LAS unsigned*)&xb_words);
    __shared__ int xinfo[8];
    if (__builtin_amdgcn_workitem_id_x() == 0) {
        const unsigned x = xb_xcc_id();
        xinfo[XI_X] = (int)x; xinfo[XI_RANK] = (int)xb_add((unsigned*)(P.ws + WS_CTL) + CTL_CENSUS + x, 1u);
    }
    PHASE(phase_prep(Q, sm));
    PHASE(phase_norm(Q.x, Q.norm_mix, (bf16*)(Q.ws + WS_XN)));
    if (P.ws == nullptr) grid.sync();
    GSYNC();
    if (__builtin_amdgcn_workitem_id_x() == 0) {
        unsigned* cen = (unsigned*)(P.ws + WS_CTL) + CTL_CENSUS;
        const int x = xinfo[XI_X]; int nx = 0, jj = 0;
        for (int q = 0; q < 16; ++q) { const unsigned cq = xb_ld(cen + q); if (cq) { if (q < x) ++jj; ++nx; } }
        xinfo[XI_J] = jj; xinfo[XI_NX] = nx; xinfo[XI_NLOC] = (int)xb_ld(cen + x);
    }
    __syncthreads();
    for (int l = 0; l < DEPTH; ++l) {
        PHASE(phase_gemm1(Q, l, sm));
#if PROBE_DUP & 2
        PHASE(phase_gemm1(Q, l, sm));
#endif
        GSYNC();
        PHASE(phase_mixlocal(Q, l, sm));
#if PROBE_DUP & 256
        PHASE(phase_mixlocal(Q, l, sm));
#endif
        PHASE(phase_gemm2(Q, l, sm));
#if PROBE_DUP & 4
        PHASE(phase_gemm2(Q, l, sm));
#endif
        GSYNC();
        PHASE(phase_attn(Q, sm));
#if PROBE_DUP & 8
        PHASE(phase_attn(Q, sm));
#endif
        GSYNC();
        PHASE(phase_gemm3(Q, l, sm));
#if PROBE_DUP & 16
        if (l == 0) PHASE(phase_gemm3(Q, l, sm));
#endif
        GSYNC();
        PHASE(phase_norm_q(Q, l));
#if PROBE_DUP & 512
        PHASE(phase_norm_q(Q, l));
#endif
        GSYNC();
        PHASE(phase_route(Q, l, sm));
#if PROBE_DUP & 32
        PHASE(phase_route(Q, l, sm));
#endif
        GSYNC();
        PHASE(phase_gu(Q, l, xinfo));
#if PROBE_DUP & 64
        PHASE(phase_gu(Q, l, xinfo));
#endif
        GSYNC();
        PHASE(phase_gw(Q, l));
#if PROBE_DUP & 128
        PHASE(phase_gw(Q, l));
#endif
        GSYNC();
        PHASE(phase_gv(Q, l, xinfo, sm));
        GSYNC();
        PHASE(phase_gnorm(Q, l));
        GSYNC();
    }
}

extern "C" void kernel_launch(void* const* d_in, const int* in_sizes, int n_in, void* d_out, int out_size, void* d_ws, size_t ws_size, hipStream_t stream) {
    static int grid = 0;
    if (grid == 0) {
        if (n_in != 18 || out_size != T * D || ws_size < WS_END) { fprintf(stderr, "kernel_launch: bad sizes n_in %d out %d ws %zu need %zu\n", n_in, out_size, ws_size, (size_t)WS_END); grid = -1; return; }
        int dev = 0, cus = 0, per_cu = 0;
        (void)hipGetDevice(&dev);
        (void)hipDeviceGetAttribute(&cus, hipDeviceAttributeMultiprocessorCount, dev);
        (void)hipOccupancyMaxActiveBlocksPerMultiprocessor(&per_cu, (const void*)k_all, NTHREADS, 0);
        if (per_cu > 1) per_cu = 1;
        if (per_cu < 1) { fprintf(stderr, "kernel_launch: occupancy query says %d\n", per_cu); grid = -1; return; }
        grid = cus * per_cu;
    }
    if (grid < 0) return;
    Params p{};
    p.x = (const float*)d_in[0]; p.norm_mix = (const float*)d_in[1]; p.w_in = (const float*)d_in[2]; p.conv_w = (const float*)d_in[3];
    p.pool_w = (const float*)d_in[4]; p.pool_scale = (const float*)d_in[5]; p.q_norm = (const float*)d_in[6]; p.w_uq = (const float*)d_in[7];
    p.kv_norm = (const float*)d_in[8]; p.w_uk = (const float*)d_in[9]; p.w_uv = (const float*)d_in[10]; p.w_out = (const float*)d_in[11];
    p.norm_ffn = (const float*)d_in[12]; p.peer_wq = (const float*)d_in[13]; p.peer_subkeys = (const float*)d_in[14]; p.peer_u = (const float*)d_in[15];
    p.peer_v = (const float*)d_in[16]; p.norm_final = (const float*)d_in[17];
    p.out = (float*)d_out; p.ws = (unsigned char*)d_ws;
    if (hipMemsetAsync((char*)d_ws + WS_CTL, 0, CTL_BYTES, stream) != hipSuccess) { fprintf(stderr, "kernel_launch: memset failed\n"); return; }
    void* args[] = {&p};
    hipError_t e = hipLaunchCooperativeKernel((const void*)k_all, dim3(grid), dim3(NTHREADS), args, 0, stream);
    if (e != hipSuccess) fprintf(stderr, "cooperative launch failed: %s (grid %d)\n", hipGetErrorString(e), grid);
}
```

```cpp
#include <hip/hip_runtime.h>
#include <type_traits>
#include <hip/hip_cooperative_groups.h>
#include <cstdio>
#include <cstdint>
namespace cg = cooperative_groups;

#ifndef TAB_FP8
#define TAB_FP8 1
#endif
#ifndef PROBE_DUP
#define PROBE_DUP 0
#endif

constexpr int NB = 4, S = 8192, T = NB * S, D = 1024, DEPTH = 2;
constexpr int DIN = 1696, DINP = 1792;
constexpr int C_BG = 0, C_CG = 256, C_HC = 512, C_HP = 768, C_CQ = 1024, C_CKV = 1408, C_KR = 1664;
constexpr int QR = 384, KVR = 256, NH = 8, DQK = 96, DV = 64;
constexpr int PH = 8, NKEY = 128, NEXP = NKEY * NKEY, TOPK = 16, HK = PH * TOPK;
constexpr float EPS = 1e-6f;
constexpr int LDX = 1088;
constexpr int LDW = 1088;

typedef unsigned short bf16;
constexpr int HP = 2 * D;

constexpr size_t WS_CTL   = 0;
constexpr size_t WS_ROPE  = 64 * 1024;
constexpr size_t WS_WIN   = WS_ROPE + (size_t)S * 16 * 2 * 4;
constexpr size_t WS_WUQ   = WS_WIN + (size_t)DEPTH * DINP * LDW * 2;
constexpr size_t WS_WUKV  = WS_WUQ + (size_t)DEPTH * 768 * QR * 2;
constexpr size_t WS_WOUT  = WS_WUKV + (size_t)DEPTH * 1024 * KVR * 2;
constexpr size_t WS_WPQ   = WS_WOUT + (size_t)DEPTH * D * LDW * 2;
constexpr size_t WS_XN    = ((WS_WPQ + (size_t)DEPTH * 2048 * LDW * 2 + 4095) / 4096) * 4096;
constexpr size_t WS_PROJ  = WS_XN + (size_t)T * LDX * 2;
constexpr size_t WS_Q     = WS_PROJ + (size_t)T * DINP * 2;
constexpr size_t WS_K     = WS_Q + (size_t)T * NH * DQK * 2;
constexpr size_t WS_V     = WS_K + (size_t)T * NH * DQK * 2;
constexpr size_t WS_EXP   = WS_V + (size_t)T * NH * DV * 2;
constexpr size_t WS_GATE  = WS_EXP + (size_t)T * HK * 4;
constexpr size_t TAB_ROWB = TAB_FP8 ? 1024 : 2048;
constexpr size_t WS_TABU  = WS_GATE + (size_t)T * HK * 4;
constexpr size_t WS_TABV  = WS_TABU + (size_t)DEPTH * NEXP * TAB_ROWB;
constexpr size_t WS_TSCU  = WS_TABV + (size_t)DEPTH * NEXP * TAB_ROWB;
constexpr size_t WS_TSCV  = WS_TSCU + (size_t)DEPTH * NEXP * 4;
constexpr size_t WS_XQ    = WS_TSCV + (size_t)DEPTH * NEXP * 4;
constexpr int XQP = 1088;
constexpr size_t WS_XS    = WS_XQ + (size_t)T * XQP;
constexpr size_t WS_WQ8   = WS_XS + (size_t)T * 4;
constexpr size_t WS_WSC   = WS_WQ8 + (size_t)T * HK;
constexpr size_t WS_SSQ   = WS_WSC + (size_t)T * 4;
constexpr size_t WS_WC8   = WS_SSQ + (size_t)T * 64;
constexpr size_t WS_WCS   = WS_WC8 + (size_t)DEPTH * 2048 * XQP;
constexpr size_t WS_WI8   = WS_WCS + (size_t)DEPTH * 2048 * 4;
constexpr size_t WS_WIS   = WS_WI8 + (size_t)DEPTH * DINP * XQP;
constexpr size_t WS_END   = WS_WIS + (size_t)DEPTH * DINP * 4;
static_assert(WS_END <= (size_t)512 * 1024 * 1024, "workspace budget");

struct Params {
    const float* x; const float* norm_mix; const float* w_in; const float* conv_w; const float* pool_w; const float* pool_scale;
    const float* q_norm; const float* w_uq; const float* kv_norm; const float* w_uk; const float* w_uv; const float* w_out;
    const float* norm_ffn; const float* peer_wq; const float* peer_subkeys; const float* peer_u; const float* peer_v; const float* norm_final;
    float* out; unsigned char* ws;
};

__device__ __forceinline__ bf16 f2bf(float f) { unsigned u = __float_as_uint(f); u += 0x7fffu + ((u >> 16) & 1u); return (bf16)(u >> 16); }
__device__ __forceinline__ float bf2f(bf16 h) { return __uint_as_float(((unsigned)h) << 16); }
__device__ __forceinline__ float bflo(unsigned u) { return __uint_as_float(u << 16); }
__device__ __forceinline__ float bfhi(unsigned u) { return __uint_as_float(u & 0xffff0000u); }
__device__ __forceinline__ unsigned pack2(float a, float b) { return (unsigned)f2bf(a) | ((unsigned)f2bf(b) << 16); }
__device__ __forceinline__ float wave_sum(float v) {
#pragma unroll
    for (int m = 32; m >= 1; m >>= 1) v += __shfl_xor(v, m, 64);
    return v;
}
__device__ __forceinline__ float gelu_exact(float x) { return 0.5f * x * (1.f + erff(x * 0.70710678118654752f)); }

#define NTHREADS 512
constexpr int NW = NTHREADS / 64;
__device__ __forceinline__ int tidx() { int t = (int)__builtin_amdgcn_workitem_id_x(); asm volatile("" : "+v"(t)); return t; }
__device__ __forceinline__ int gwave() { return blockIdx.x * (NTHREADS / 64) + (tidx() >> 6); }
__device__ __forceinline__ int nwave() { return gridDim.x * (NTHREADS / 64); }
__device__ __forceinline__ size_t gtid() { return (size_t)blockIdx.x * NTHREADS + tidx(); }
__device__ __forceinline__ size_t gnth() { return (size_t)gridDim.x * NTHREADS; }


__device__ __forceinline__ Params launder(const Params& P) {
    typedef __attribute__((address_space(1))) char* gp_t;
    gp_t g[20] = {(gp_t)(char*)P.x, (gp_t)(char*)P.norm_mix, (gp_t)(char*)P.w_in, (gp_t)(char*)P.conv_w, (gp_t)(char*)P.pool_w, (gp_t)(char*)P.pool_scale, (gp_t)(char*)P.q_norm, (gp_t)(char*)P.w_uq,
                  (gp_t)(char*)P.kv_norm, (gp_t)(char*)P.w_uk, (gp_t)(char*)P.w_uv, (gp_t)(char*)P.w_out, (gp_t)(char*)P.norm_ffn, (gp_t)(char*)P.peer_wq, (gp_t)(char*)P.peer_subkeys,
                  (gp_t)(char*)P.peer_u, (gp_t)(char*)P.peer_v, (gp_t)(char*)P.norm_final, (gp_t)(char*)P.out, (gp_t)(char*)P.ws};
    asm volatile("" : "+s"(g[0]), "+s"(g[1]), "+s"(g[2]), "+s"(g[3]), "+s"(g[4]), "+s"(g[5]), "+s"(g[6]), "+s"(g[7]), "+s"(g[8]), "+s"(g[9]));
    asm volatile("" : "+s"(g[10]), "+s"(g[11]), "+s"(g[12]), "+s"(g[13]), "+s"(g[14]), "+s"(g[15]), "+s"(g[16]), "+s"(g[17]), "+s"(g[18]), "+s"(g[19]));
    Params Q;
    Q.x = (const float*)(char*)g[0]; Q.norm_mix = (const float*)(char*)g[1]; Q.w_in = (const float*)(char*)g[2]; Q.conv_w = (const float*)(char*)g[3]; Q.pool_w = (const float*)(char*)g[4];
    Q.pool_scale = (const float*)(char*)g[5]; Q.q_norm = (const float*)(char*)g[6]; Q.w_uq = (const float*)(char*)g[7]; Q.kv_norm = (const float*)(char*)g[8]; Q.w_uk = (const float*)(char*)g[9];
    Q.w_uv = (const float*)(char*)g[10]; Q.w_out = (const float*)(char*)g[11]; Q.norm_ffn = (const float*)(char*)g[12]; Q.peer_wq = (const float*)(char*)g[13]; Q.peer_subkeys = (const float*)(char*)g[14];
    Q.peer_u = (const float*)(char*)g[15]; Q.peer_v = (const float*)(char*)g[16]; Q.norm_final = (const float*)(char*)g[17]; Q.out = (float*)(char*)g[18]; Q.ws = (unsigned char*)(char*)g[19];
    return Q;
}

typedef __attribute__((ext_vector_type(8))) short bf16x8;
typedef __attribute__((ext_vector_type(16))) float f32x16;
typedef __attribute__((ext_vector_type(2))) __bf16 bf2_t;
#define MFMA32(a, b, c) __builtin_amdgcn_mfma_f32_32x32x16_bf16(a, b, c, 0, 0, 0)
__device__ __forceinline__ int crow(int r, int hi) { return (r & 3) + 8 * (r >> 2) + 4 * hi; }
__device__ __forceinline__ float dot2bf(unsigned a, unsigned b, float c) { return __builtin_amdgcn_fdot2_f32_bf16(__builtin_bit_cast(bf2_t, a), __builtin_bit_cast(bf2_t, b), c, false); }
__device__ __forceinline__ unsigned cvtpk(float lo, float hi) { unsigned r; asm("v_cvt_pk_bf16_f32 %0, %1, %2" : "=v"(r) : "v"(lo), "v"(hi)); return r; }
constexpr int LDS_TOTAL = 140 * 1024;

template <int WT, bool ROWSS>
__device__ __forceinline__ void gemm_kloop(const bf16* __restrict__ Ag0, int lda, const bf16* __restrict__ Bg0, int ldb, int nk, f32x16 (&acc)[8], float (&ss)[4], char* lds, int tid) {
    constexpr int BROWS = (WT == 0) ? 256 : 128, NPB = BROWS / 64;
    constexpr int OPA = 256 * 128, G_BUF = OPA + BROWS * 128;
    const int lane = tid & 63, w = __builtin_amdgcn_readfirstlane(tid >> 6), r32 = lane & 31, hi = lane >> 5;
    const int srow = 8 * w + (lane >> 3);
    const int sch = (lane & 7) ^ ((srow >> 1) & 7);
    const bf16* Ag = Ag0 + (size_t)srow * lda + sch * 8;
    const bf16* Bg = Bg0 + (size_t)srow * ldb + sch * 8;
#pragma unroll
    for (int i = 0; i < 8; ++i)
#pragma unroll
        for (int r = 0; r < 16; ++r) acc[i][r] = 0.f;
    ss[0] = 0.f; ss[1] = 0.f; ss[2] = 0.f; ss[3] = 0.f;
    typedef __attribute__((address_space(3))) unsigned* ldsp_t;
    typedef const __attribute__((address_space(1))) unsigned* glbp_t;
#define G_DMA(buf, kofs) do { char* d_ = lds + (buf) * G_BUF + (8 * w) * 128; \
    _Pragma("unroll") for (int i = 0; i < 4; ++i) \
        __builtin_amdgcn_global_load_lds((glbp_t)(const void*)(Ag + (size_t)(64 * i) * lda + (kofs)), (ldsp_t)(void*)(d_ + i * 8192), 16, 0, 0); \
    _Pragma("unroll") for (int i = 0; i < NPB; ++i) \
        __builtin_amdgcn_global_load_lds((glbp_t)(const void*)(Bg + (size_t)(64 * i) * ldb + (kofs)), (ldsp_t)(void*)(d_ + OPA + i * 8192), 16, 0, 0); } while (0)
    const int xr = (r32 >> 1) & 7;
    const int o0 = ((0 + hi) ^ xr) << 4, o1 = ((2 + hi) ^ xr) << 4, o2 = ((4 + hi) ^ xr) << 4, o3 = ((6 + hi) ^ xr) << 4;
#define G_SS(s_, r_) do { union { bf16x8 v; uint4 u; } c_; c_.v = r_; s_ = dot2bf(c_.u.x, c_.u.x, s_); s_ = dot2bf(c_.u.y, c_.u.y, s_); s_ = dot2bf(c_.u.z, c_.u.z, s_); s_ = dot2bf(c_.u.w, c_.u.w, s_); } while (0)
#define G_STEP(pa, pb, off) do { \
    if (WT == 0) { \
        const bf16x8 a0 = *(const bf16x8*)(pa + off), a1 = *(const bf16x8*)(pa + 32 * 128 + off); \
        const bf16x8 b0 = *(const bf16x8*)(pb + off), b1 = *(const bf16x8*)(pb + 32 * 128 + off), b2 = *(const bf16x8*)(pb + 64 * 128 + off), b3 = *(const bf16x8*)(pb + 96 * 128 + off); \
        if (ROWSS) { G_SS(ss[0], b0); G_SS(ss[1], b1); G_SS(ss[2], b2); G_SS(ss[3], b3); } \
        acc[0] = MFMA32(a0, b0, acc[0]); acc[1] = MFMA32(a0, b1, acc[1]); acc[2] = MFMA32(a0, b2, acc[2]); acc[3] = MFMA32(a0, b3, acc[3]); \
        acc[4] = MFMA32(a1, b0, acc[4]); acc[5] = MFMA32(a1, b1, acc[5]); acc[6] = MFMA32(a1, b2, acc[6]); acc[7] = MFMA32(a1, b3, acc[7]); \
    } else if (WT == 2) { \
        const bf16x8 a0 = *(const bf16x8*)(pa + off), a1 = *(const bf16x8*)(pa + 32 * 128 + off); \
        const bf16x8 b0 = *(const bf16x8*)(pb + off), b1 = *(const bf16x8*)(pb + 32 * 128 + off); \
        if (ROWSS) { G_SS(ss[0], b0); G_SS(ss[1], b1); } \
        acc[0] = MFMA32(a0, b0, acc[0]); acc[1] = MFMA32(a0, b1, acc[1]); acc[2] = MFMA32(a1, b0, acc[2]); acc[3] = MFMA32(a1, b1, acc[3]); \
    } else { \
        const bf16x8 b0 = *(const bf16x8*)(pb + off); \
        const bf16x8 a0 = *(const bf16x8*)(pa + off), a1 = *(const bf16x8*)(pa + 32 * 128 + off); \
        const bf16x8 a2 = *(const bf16x8*)(pa + 64 * 128 + off), a3 = *(const bf16x8*)(pa + 96 * 128 + off); \
        if (ROWSS) { G_SS(ss[0], b0); } \
        acc[0] = MFMA32(a0, b0, acc[0]); acc[1] = MFMA32(a1, b0, acc[1]); \
        acc[2] = MFMA32(a2, b0, acc[2]); acc[3] = MFMA32(a3, b0, acc[3]); \
    } } while (0)
    const int arow = (WT == 1) ? ((w >> 2) * 128 + r32) : ((w >> 1) * 64 + r32);
    const int brow = (WT == 0) ? ((w & 1) * 128 + r32) : (WT == 2) ? ((w & 1) * 64 + r32) : ((w & 3) * 32 + r32);
    G_DMA(0, 0);
    for (int kt = 0; kt < nk; ++kt) {
        __syncthreads();
        if (kt + 1 < nk) G_DMA((kt + 1) & 1, (kt + 1) * 64);
        const char* pa = lds + (kt & 1) * G_BUF + arow * 128;
        const char* pb = lds + (kt & 1) * G_BUF + OPA + brow * 128;
        G_STEP(pa, pb, o0); G_STEP(pa, pb, o1); G_STEP(pa, pb, o2); G_STEP(pa, pb, o3);
    }
    if (ROWSS) { ss[0] += __shfl_xor(ss[0], 32, 64); ss[1] += __shfl_xor(ss[1], 32, 64); ss[2] += __shfl_xor(ss[2], 32, 64); ss[3] += __shfl_xor(ss[3], 32, 64); }
#undef G_DMA
#undef G_SS
#undef G_STEP
}

__device__ __forceinline__ void tile_range(int ntiles, int& lo, int& hi) {
    const int G = gridDim.x, b = blockIdx.x;
    const int vb = ((G & 7) == 0) ? ((b & 7) * (G >> 3) + (b >> 3)) : b;
    const int per = (ntiles + G - 1) / G;
    lo = vb * per; hi = lo + per; if (hi > ntiles) hi = ntiles;
}
constexpr int ST_P = 68;
static_assert(NW * 64 * ST_P * 4 <= LDS_TOTAL, "staging LDS");
template <bool ROWSS, class EPI, class EPIROW, class RSC>
__device__ __forceinline__ void gemm_t(const bf16* __restrict__ Wt, int ldw, int N, const bf16* __restrict__ X, int ldx, int M, int K, int tn_direct, EPI epi, EPIROW epirow, RSC rowscale, char* lds) {
    const int tid = tidx(), lane = tid & 63, w = tid >> 6, r32 = lane & 31, hi = lane >> 5;
    const int tilesN = N / 256, tilesM = M / 256, nk = K / 64;
    int tlo, thi; tile_range(tilesM * tilesN, tlo, thi);
    for (int tile = tlo; tile < thi; ++tile) {
        const int tm = tile / tilesN, tn = tile % tilesN;
        f32x16 acc[8]; float ss[4];
        gemm_kloop<0, ROWSS>(Wt + (size_t)(tn * 256) * ldw, ldw, X + (size_t)(tm * 256) * ldx, ldx, nk, acc, ss, lds, tid);
        if (tn < tn_direct) {
            __syncthreads();
            float* st = (float*)lds + w * (64 * ST_P);
            const int rr = lane >> 4, ch = lane & 15;
#pragma unroll
            for (int half = 0; half < 2; ++half) {
                const float m0_ = rowscale(ss[2 * half]), m1_ = rowscale(ss[2 * half + 1]);
#pragma unroll
                for (int i = 0; i < 2; ++i)
#pragma unroll
                    for (int jj = 0; jj < 2; ++jj)
#pragma unroll
                        for (int g = 0; g < 4; ++g) {
                            const float mj = jj ? m1_ : m0_;
                            const f32x16& a_ = acc[i * 4 + 2 * half + jj];
                            *(float4*)(st + (32 * jj + r32) * ST_P + 32 * i + 8 * g + 4 * hi) = make_float4(a_[4 * g] * mj, a_[4 * g + 1] * mj, a_[4 * g + 2] * mj, a_[4 * g + 3] * mj);
                        }
#pragma unroll 2
                for (int it = 0; it < 16; ++it) {
                    const int row = it * 4 + rr;
                    const float4 v = *(const float4*)(st + row * ST_P + ch * 4);
                    epirow(tm * 256 + (w & 1) * 128 + half * 64 + row, tn * 256 + (w >> 1) * 64 + ch * 4, v);
                }
            }
        } else {
#pragma unroll
            for (int i = 0; i < 2; ++i)
#pragma unroll
                for (int j = 0; j < 4; ++j)
                    epi(tn * 256 + (w >> 1) * 64 + i * 32, tm * 256 + (w & 1) * 128 + j * 32, acc[i * 4 + j], r32, hi, ss[j]);
        }
        __syncthreads();
    }
}

constexpr int ST1_P = 132;
static_assert(NW * 32 * ST1_P * 4 <= LDS_TOTAL, "staging LDS (128 x 32 wave tiles)");
template <class EPIROW, class RSC>
__device__ __forceinline__ void gemm_t1(const bf16* __restrict__ Wt, int ldw, int N, const bf16* __restrict__ X, int ldx, int M, int K, EPIROW epirow, RSC rowscale, char* lds) {
    const int tid = tidx(), lane = tid & 63, w = tid >> 6, r32 = lane & 31, hi = lane >> 5;
    const int tilesN = N / 256, tilesM = M / 128, nk = K / 64;
    int tlo, thi; tile_range(tilesM * tilesN, tlo, thi);
    for (int tile = tlo; tile < thi; ++tile) {
        const int tm = tile / tilesN, tn = tile % tilesN;
        f32x16 acc[8]; float ss[4];
        gemm_kloop<1, true>(Wt + (size_t)(tn * 256) * ldw, ldw, X + (size_t)(tm * 128) * ldx, ldx, nk, acc, ss, lds, tid);
        __syncthreads();
        float* st = (float*)lds + w * (32 * ST1_P);
        const float mj = rowscale(ss[0]);
#pragma unroll
        for (int mt = 0; mt < 4; ++mt)
#pragma unroll
            for (int g = 0; g < 4; ++g)
                *(float4*)(st + r32 * ST1_P + 32 * mt + 8 * g + 4 * hi) = make_float4(acc[mt][4 * g] * mj, acc[mt][4 * g + 1] * mj, acc[mt][4 * g + 2] * mj, acc[mt][4 * g + 3] * mj);
#pragma unroll 2
        for (int it = 0; it < 16; ++it) {
            const int row = it * 2 + hi;
            const float4 v = *(const float4*)(st + row * ST1_P + r32 * 4);
            epirow(tm * 128 + (w & 3) * 32 + row, tn * 256 + (w >> 2) * 128 + r32 * 4, v);
        }
        __syncthreads();
    }
}

template <class EPIROW>
__device__ __forceinline__ void gemm_t2(const bf16* __restrict__ Wt, int ldw, int N, const bf16* __restrict__ X, int ldx, int M, int K, EPIROW epirow, char* lds) {
    const int tid = tidx(), lane = tid & 63, w = tid >> 6, r32 = lane & 31, hi = lane >> 5;
    const int tilesN = N / 256, tilesM = M / 128, nk = K / 64;
    int tlo, thi; tile_range(tilesM * tilesN, tlo, thi);
    for (int tile = tlo; tile < thi; ++tile) {
        const int tm = tile / tilesN, tn = tile % tilesN;
        f32x16 acc[8]; float ss[4];
        gemm_kloop<2, false>(Wt + (size_t)(tn * 256) * ldw, ldw, X + (size_t)(tm * 128) * ldx, ldx, nk, acc, ss, lds, tid);
        __syncthreads();
        float* st = (float*)lds + w * (64 * ST_P);
#pragma unroll
        for (int i = 0; i < 2; ++i)
#pragma unroll
            for (int j = 0; j < 2; ++j)
#pragma unroll
                for (int g = 0; g < 4; ++g)
                    *(float4*)(st + (32 * j + r32) * ST_P + 32 * i + 8 * g + 4 * hi) = make_float4(acc[i * 2 + j][4 * g], acc[i * 2 + j][4 * g + 1], acc[i * 2 + j][4 * g + 2], acc[i * 2 + j][4 * g + 3]);
        const int rr = lane >> 4, ch = lane & 15;
#pragma unroll 4
        for (int it = 0; it < 16; ++it) {
            const int row = it * 4 + rr;
            const float4 v = *(const float4*)(st + row * ST_P + ch * 4);
            epirow(tm * 128 + (w & 1) * 64 + row, tn * 256 + (w >> 1) * 64 + ch * 4, v);
        }
        __syncthreads();
    }
}

typedef __attribute__((ext_vector_type(4))) float f32x4;
constexpr int G8_HT = 128 * 64;
__device__ __forceinline__ int g8_lds_byte(int r, int c) {
    const int st = (r >> 4) * 2 + (c >> 5), rr = r & 15, cc = c & 31, ob = rr * 64 + cc * 2;
    return st * 1024 + (ob ^ (((ob >> 9) & 1) << 5));
}
__device__ __forceinline__ void g8_stage_rc(int b, int& R, int& C) {
    const int st = b / 1024, sb = b % 1024, swz = sb ^ (((sb >> 9) & 1) << 5);
    R = (st >> 1) * 16 + swz / 64; C = (st & 1) * 32 + (swz % 64) / 2;
}
__device__ __forceinline__ float ssq8(const bf16x8& v, float s) {
    union { bf16x8 v; uint4 u; } c_; c_.v = v;
    s = dot2bf(c_.u.x, c_.u.x, s); s = dot2bf(c_.u.y, c_.u.y, s); s = dot2bf(c_.u.z, c_.u.z, s); return dot2bf(c_.u.w, c_.u.w, s);
}
typedef __attribute__((ext_vector_type(4))) int i32x4;
__device__ __forceinline__ f32x4 mma8(const bf16x8& a, const bf16x8& b, const f32x4& c) { return __builtin_amdgcn_mfma_f32_16x16x32_bf16(a, b, c, 0, 0, 0); }
__device__ __forceinline__ i32x4 mma8(const bf16x8& a, const bf16x8& b, const i32x4& c) { return __builtin_amdgcn_mfma_i32_16x16x64_i8(__builtin_bit_cast(i32x4, a), __builtin_bit_cast(i32x4, b), c, 0, 0, 0); }
template <bool ROWSS, bool APERM = false, class ACC = f32x4>
__device__ __forceinline__ void gemm8_kloop(const bf16* __restrict__ A, int lda, const bf16* __restrict__ Bt, int ldb, int nt, ACC (&acc)[2][2][4][2], float (&ss)[2][2], char* lds, int tid) {
    bf16* shm = (bf16*)lds;
    typedef __attribute__((address_space(3))) unsigned* ldsp_t;
    typedef const __attribute__((address_space(1))) unsigned* glbp_t;
#define SA(b, h) (shm + ((b) * 2 + (h)) * G8_HT)
#define SB(b, h) (shm + (4 + (b) * 2 + (h)) * G8_HT)
    int sr0, sc0; g8_stage_rc(tid * 16, sr0, sc0);
    const unsigned voa = (unsigned)((sr0 * lda + sc0) * 2), vob = (unsigned)((sr0 * ldb + sc0) * 2);
    const char* Ap = (const char*)A; const char* Bp = (const char*)Bt;
    const int wbase = __builtin_amdgcn_readfirstlane(tid >> 6) * 1024;
#define STAGE_(P, BASE, VO, LD, br, r2, kt) do { const char* g_ = BASE + ((size_t)(br) * LD + (kt) * 64) * 2; \
    __builtin_amdgcn_global_load_lds((glbp_t)(const void*)(g_ + VO), (ldsp_t)(void*)((char*)(P) + wbase), 16, 0, 0); \
    __builtin_amdgcn_global_load_lds((glbp_t)(const void*)(g_ + (size_t)(2 * (r2)) * LD + VO), (ldsp_t)(void*)((char*)(P) + wbase + 8192), 16, 0, 0); } while (0)
#define STAGEA(b, h, kt) STAGE_(SA(b, h), Ap, voa, lda, (APERM ? (h) * 64 : (h) * 128), (APERM ? 128 : 64), kt)
#define STAGEB(b, h, kt) STAGE_(SB(b, h), Bp, vob, ldb, (h) * 128, 64, kt)
    const int lane = tid & 63, wid = tid >> 6, wr = wid >> 2, wc = wid & 3, fr = lane & 15, fq = lane >> 4;
    int abase, bbase;
    { const int ob = fr * 64 + fq * 16, lp = ob ^ (((ob >> 9) & 1) << 5);
      abase = lp + wr * 8192; bbase = lp + wc * 4096 + 4 * G8_HT * 2;
      asm volatile("" : "+v"(abase), "+v"(bbase)); }
#define LDA(dst, b, h) _Pragma("unroll") for (int m = 0; m < 4; ++m) _Pragma("unroll") for (int k = 0; k < 2; ++k) \
    dst[m][k] = *reinterpret_cast<const bf16x8*>(lds + abase + (((b) * 2 + (h)) * G8_HT * 2 + m * 2048 + k * 1024))
#define LDB(dst, b, h) _Pragma("unroll") for (int n = 0; n < 2; ++n) _Pragma("unroll") for (int k = 0; k < 2; ++k) \
    dst[n][k] = *reinterpret_cast<const bf16x8*>(lds + bbase + (((b) * 2 + (h)) * G8_HT * 2 + n * 2048 + k * 1024))
#define MMA(ai, bj, At_, Bt_) do { __builtin_amdgcn_s_setprio(1); \
    _Pragma("unroll") for (int m = 0; m < 4; ++m) _Pragma("unroll") for (int n = 0; n < 2; ++n) _Pragma("unroll") for (int k = 0; k < 2; ++k) \
        acc[ai][bj][m][n] = mma8(At_[m][k], Bt_[n][k], acc[ai][bj][m][n]); \
    __builtin_amdgcn_s_setprio(0); } while (0)
#define SSQ(bj, Bt_) do { if (ROWSS) { _Pragma("unroll") for (int n = 0; n < 2; ++n) { ss[bj][n] = ssq8(Bt_[n][0], ss[bj][n]); ss[bj][n] = ssq8(Bt_[n][1], ss[bj][n]); } } } while (0)
#define WAIT_V(n) asm volatile("s_waitcnt vmcnt(" #n ")" ::: "memory")
#define WAIT_L(n) asm volatile("s_waitcnt lgkmcnt(" #n ")" ::: "memory")
#define BAR __builtin_amdgcn_s_barrier()
#define SCHED __builtin_amdgcn_sched_barrier(0)
#pragma unroll
    for (int a = 0; a < 2; ++a)
#pragma unroll
        for (int b = 0; b < 2; ++b)
#pragma unroll
            for (int m = 0; m < 4; ++m)
#pragma unroll
                for (int n = 0; n < 2; ++n) acc[a][b][m][n] = ACC{0, 0, 0, 0};
    ss[0][0] = 0.f; ss[0][1] = 0.f; ss[1][0] = 0.f; ss[1][1] = 0.f;
    bf16x8 At[4][2], B0[2][2], B1[2][2];
    STAGEB(0, 0, 0); STAGEA(0, 0, 0);
    STAGEB(0, 1, 0); STAGEA(0, 1, 0);
    if (wr == 1) BAR;
    WAIT_V(4); BAR;
    STAGEB(1, 0, 1); STAGEA(1, 0, 1); STAGEB(1, 1, 1);
    WAIT_V(6); BAR;
    for (int t = 0; t < nt - 2; t += 2) {
        LDB(B0, 0, 0); SCHED; LDA(At, 0, 0); STAGEA(1, 1, t + 1);
        WAIT_L(8); BAR; WAIT_L(0); MMA(0, 0, At, B0); SSQ(0, B0); BAR; SCHED;
        LDB(B1, 0, 1); STAGEB(0, 0, t + 2);
        BAR; WAIT_L(0); MMA(0, 1, At, B1); SSQ(1, B1); BAR;
        LDA(At, 0, 1); STAGEA(0, 0, t + 2);
        BAR; WAIT_L(0); MMA(1, 0, At, B0); BAR; SCHED;
        STAGEB(0, 1, t + 2);
        WAIT_V(6); BAR; MMA(1, 1, At, B1); BAR;
        LDB(B0, 1, 0); SCHED; LDA(At, 1, 0); STAGEA(0, 1, t + 2);
        WAIT_L(8); BAR; WAIT_L(0); MMA(0, 0, At, B0); SSQ(0, B0); BAR; SCHED;
        LDB(B1, 1, 1); STAGEB(1, 0, t + 3);
        BAR; WAIT_L(0); MMA(0, 1, At, B1); SSQ(1, B1); BAR;
        LDA(At, 1, 1); STAGEA(1, 0, t + 3);
        BAR; WAIT_L(0); MMA(1, 0, At, B0); BAR; SCHED;
        STAGEB(1, 1, t + 3);
        WAIT_V(6); BAR; MMA(1, 1, At, B1); BAR;
    }
    { LDB(B0, 0, 0); LDA(At, 0, 0); STAGEA(1, 1, nt - 1);
      BAR; WAIT_L(0); MMA(0, 0, At, B0); SSQ(0, B0); BAR;
      LDB(B1, 0, 1); BAR; WAIT_L(0); MMA(0, 1, At, B1); SSQ(1, B1); BAR;
      LDA(At, 0, 1); WAIT_V(4); BAR; WAIT_L(0); MMA(1, 0, At, B0); MMA(1, 1, At, B1); BAR; }
    { LDB(B0, 1, 0); LDA(At, 1, 0); WAIT_V(2); BAR; WAIT_L(0); MMA(0, 0, At, B0); SSQ(0, B0); BAR;
      LDB(B1, 1, 1); WAIT_V(0); BAR; WAIT_L(0); MMA(0, 1, At, B1); SSQ(1, B1); BAR;
      LDA(At, 1, 1); BAR; WAIT_L(0); MMA(1, 0, At, B0); MMA(1, 1, At, B1); BAR; }
    if (wr == 0) BAR;
    if (ROWSS) {
#pragma unroll
        for (int b = 0; b < 2; ++b)
#pragma unroll
            for (int n = 0; n < 2; ++n) { ss[b][n] += __shfl_xor(ss[b][n], 16, 64); ss[b][n] += __shfl_xor(ss[b][n], 32, 64); }
    }
#undef SSQ
#undef SA
#undef SB
#undef STAGE_
#undef STAGEA
#undef STAGEB
#undef LDA
#undef LDB
#undef MMA
#undef WAIT_V
#undef WAIT_L
#undef BAR
#undef SCHED
}
__device__ __forceinline__ void tile_rounds(int ntiles, int& lo, int& hi, int& step) {
    const int G = gridDim.x, b = blockIdx.x;
    if ((G & 7) == 0) { const int per = (ntiles + 7) >> 3, x = b & 7; lo = x * per + (b >> 3); hi = (x + 1) * per; if (hi > ntiles) hi = ntiles; step = G >> 3; }
    else { lo = b; hi = ntiles; step = G; }
}
template <bool SCALE, bool PRE, bool I8, class EPIROW, class RSC, class PREF, class CSC>
__device__ __forceinline__ void gemm_t8(const bf16* __restrict__ Wt, int ldw, int N, const bf16* __restrict__ X, int ldx, int K, int tlo, int thi, int tstep, EPIROW epirow, RSC rowscale, PREF pre, CSC colscale, char* lds) {
    typedef typename std::conditional<I8, i32x4, f32x4>::type ACC;
    const int tid = tidx();
    const int tilesN = N / 256; int nt = K / 64;
    asm volatile("" : "+s"(nt));
    for (int tile = tlo; tile < thi; tile += tstep) {
        const int tm = tile / tilesN, tn = tile % tilesN;
        ACC acc[2][2][4][2]; float ss[2][2];
        gemm8_kloop<false, false, ACC>(Wt + (size_t)(tn * 256) * ldw, ldw, X + (size_t)(tm * 256) * ldx, ldx, nt, acc, ss, lds, tid);
        __syncthreads();
        const int te = tidx();
        const int le = te & 63, w = te >> 6, wr = w >> 2, wc = w & 3, fr = le & 15, fq = le >> 4;
        float* st = (float*)lds + w * (32 * ST_P);
        const int rr = le >> 4, ch = le & 15;
        const int tb = tm * 256 + wc * 32 + rr, nb = tn * 256 + wr * 64 + ch * 4;
#pragma unroll
        for (int ai = 0; ai < 2; ++ai)
#pragma unroll
            for (int bj = 0; bj < 2; ++bj) {
                float4 pv[8];
                if (PRE) {
#pragma unroll
                    for (int it = 0; it < 8; ++it) pv[it] = pre(tb + bj * 128 + it * 4, nb + ai * 128);
                }
#pragma unroll
                for (int n = 0; n < 2; ++n) {
                    const float mj = SCALE ? rowscale(tm * 256 + bj * 128 + wc * 32 + n * 16 + fr) : 1.f;
#pragma unroll
                    for (int m = 0; m < 4; ++m) {
                        const ACC a_ = acc[ai][bj][m][n];
                        if (I8) {
                            const float4 cs = colscale(tn * 256 + ai * 128 + wr * 64 + m * 16 + fq * 4);
                            *(float4*)(st + (n * 16 + fr) * ST_P + m * 16 + fq * 4) = make_float4((float)a_[0] * (mj * cs.x), (float)a_[1] * (mj * cs.y), (float)a_[2] * (mj * cs.z), (float)a_[3] * (mj * cs.w));
                        } else
                        *(float4*)(st + (n * 16 + fr) * ST_P + m * 16 + fq * 4) = SCALE ? make_float4(a_[0] * mj, a_[1] * mj, a_[2] * mj, a_[3] * mj) : make_float4(a_[0], a_[1], a_[2], a_[3]);
                    }
                }
                if (PRE) {
#pragma unroll
                    for (int it = 0; it < 8; ++it) {
                        const float4 v = *(const float4*)(st + (it * 4 + rr) * ST_P + ch * 4);
                        epirow(tb + bj * 128 + it * 4, nb + ai * 128, v, pv[it]);
                    }
                } else {
#pragma unroll 2
                    for (int it = 0; it < 8; ++it) {
                        const float4 v = *(const float4*)(st + (it * 4 + rr) * ST_P + ch * 4);
                        epirow(tb + bj * 128 + it * 4, nb + ai * 128, v, make_float4(0.f, 0.f, 0.f, 0.f));
                    }
                }
            }
        __syncthreads();
    }
}

__device__ __forceinline__ void transpose_tiled(const float* __restrict__ W, bf16* __restrict__ Wt, int K, int N, int Npad, int ldk, const float* __restrict__ gain, char* lds) {
    float (*tl)[65] = (float (*)[65])lds;
    const int tid = tidx(), a = tid & 63, q = tid >> 6;
    const int tK = K / 64, tN = Npad / 64;
    for (int tile = blockIdx.x; tile < tK * tN; tile += gridDim.x) {
        const int k0 = (tile / tN) * 64, n0 = (tile % tN) * 64;
#pragma unroll 4
        for (int i = 0; i < 64 / NW; ++i) {
            const int k = k0 + q * (64 / NW) + i, n = n0 + a;
            float v = (n < N) ? W[(size_t)k * N + n] : 0.f;
            if (gain) v *= gain[k];
            tl[q * (64 / NW) + i][a] = v;
        }
        __syncthreads();
#pragma unroll 4
        for (int i = 0; i < 64 / NW; ++i) { const int nl = q * (64 / NW) + i; Wt[(size_t)(n0 + nl) * ldk + k0 + a] = f2bf(tl[a][nl]); }
        __syncthreads();
    }
}

__device__ __forceinline__ void quant_row(const float4 (&v)[4], unsigned char* __restrict__ dst, float* __restrict__ scl, int r, int lane) {
    float am = 0.f;
#pragma unroll
    for (int j = 0; j < 4; ++j) am = fmaxf(am, fmaxf(fmaxf(fabsf(v[j].x), fabsf(v[j].y)), fmaxf(fabsf(v[j].z), fabsf(v[j].w))));
#pragma unroll
    for (int m = 32; m >= 1; m >>= 1) am = fmaxf(am, __shfl_xor(am, m, 64));
    const float sc = (am > 0.f) ? am * (1.f / 448.f) : 1.f;
    const float is = 1.f / sc;
    uint4 o;
    { int w = 0; w = __builtin_amdgcn_cvt_pk_fp8_f32(v[0].x * is, v[0].y * is, w, false); w = __builtin_amdgcn_cvt_pk_fp8_f32(v[0].z * is, v[0].w * is, w, true); o.x = (unsigned)w; }
    { int w = 0; w = __builtin_amdgcn_cvt_pk_fp8_f32(v[1].x * is, v[1].y * is, w, false); w = __builtin_amdgcn_cvt_pk_fp8_f32(v[1].z * is, v[1].w * is, w, true); o.y = (unsigned)w; }
    { int w = 0; w = __builtin_amdgcn_cvt_pk_fp8_f32(v[2].x * is, v[2].y * is, w, false); w = __builtin_amdgcn_cvt_pk_fp8_f32(v[2].z * is, v[2].w * is, w, true); o.z = (unsigned)w; }
    { int w = 0; w = __builtin_amdgcn_cvt_pk_fp8_f32(v[3].x * is, v[3].y * is, w, false); w = __builtin_amdgcn_cvt_pk_fp8_f32(v[3].z * is, v[3].w * is, w, true); o.w = (unsigned)w; }
    { const int lay = r / NEXP, e = r % NEXP; *(uint4*)(dst + (((size_t)(lay * 8 + (lane >> 3)) * NEXP + e) * 128) + (lane & 7) * 16) = o; }
    if (lane == 0) scl[r] = sc;
}
__device__ __forceinline__ unsigned pack_i8x4(float a, float b, float c, float d) {
    const int ia = __float2int_rn(a), ib = __float2int_rn(b), ic = __float2int_rn(c), id = __float2int_rn(d);
    return (unsigned)(ia & 255) | ((unsigned)(ib & 255) << 8) | ((unsigned)(ic & 255) << 16) | ((unsigned)(id & 255) << 24);
}
__device__ __forceinline__ void quant_row_i8(const float4 (&v)[4], unsigned char* __restrict__ dst, float* __restrict__ scl, int r, int lane) {
    float am = 0.f;
#pragma unroll
    for (int j = 0; j < 4; ++j) am = fmaxf(am, fmaxf(fmaxf(fabsf(v[j].x), fabsf(v[j].y)), fmaxf(fabsf(v[j].z), fabsf(v[j].w))));
#pragma unroll
    for (int m = 32; m >= 1; m >>= 1) am = fmaxf(am, __shfl_xor(am, m, 64));
    const float sc = (am > 0.f) ? am * (1.f / 127.f) : 1.f;
    const float is = 1.f / sc;
    uint4 o;
    o.x = pack_i8x4(v[0].x * is, v[0].y * is, v[0].z * is, v[0].w * is); o.y = pack_i8x4(v[1].x * is, v[1].y * is, v[1].z * is, v[1].w * is);
    o.z = pack_i8x4(v[2].x * is, v[2].y * is, v[2].z * is, v[2].w * is); o.w = pack_i8x4(v[3].x * is, v[3].y * is, v[3].z * is, v[3].w * is);
    { const int lay = r / NEXP, e = r % NEXP; *(uint4*)(dst + (((size_t)(lay * 8 + (lane >> 3)) * NEXP + e) * 128) + (lane & 7) * 16) = o; }
    if (lane == 0) scl[r] = sc;
}
template <bool I8>
__device__ __forceinline__ void convert_table(const float* __restrict__ src, unsigned char* __restrict__ dst, float* __restrict__ scl, int rows) {
    static_assert(TAB_FP8, "fp8 tables");
    const int lane = tidx() & 63;
    const int nw = nwave();
    for (int r = gwave(); r < rows; r += 4 * nw) {
        float4 v[4][4]; int rr[4];
#pragma unroll
        for (int u = 0; u < 4; ++u) {
            rr[u] = (r + u * nw < rows) ? (r + u * nw) : r;
            const float4* s0 = (const float4*)(src + (size_t)rr[u] * D);
#pragma unroll
            for (int j = 0; j < 4; ++j) v[u][j] = s0[lane * 4 + j];
        }
#pragma unroll
        for (int u = 0; u < 4; ++u) {
            if (u == 0 || rr[u] != r) { if (I8) quant_row_i8(v[u], dst, scl, rr[u], lane); else quant_row(v[u], dst, scl, rr[u], lane); }
        }
    }
}
__device__ __forceinline__ void phase_prep(const Params& P, char* lds) {
    unsigned char* ws = P.ws;
    for (int l = 0; l < DEPTH; ++l) {
        transpose_tiled(P.w_in + (size_t)l * D * DIN, (bf16*)(ws + WS_WIN) + (size_t)l * DINP * LDW, D, DIN, DINP, LDW, nullptr, lds);
        transpose_tiled(P.w_uq + (size_t)l * QR * 768, (bf16*)(ws + WS_WUQ) + (size_t)l * 768 * QR, QR, 768, 768, QR, P.q_norm + l * QR, lds);
        transpose_tiled(P.w_uk + (size_t)l * KVR * 512, (bf16*)(ws + WS_WUKV) + (size_t)l * 1024 * KVR, KVR, 512, 512, KVR, P.kv_norm + l * KVR, lds);
        transpose_tiled(P.w_uv + (size_t)l * KVR * 512, (bf16*)(ws + WS_WUKV) + (size_t)l * 1024 * KVR + (size_t)512 * KVR, KVR, 512, 512, KVR, P.kv_norm + l * KVR, lds);
        transpose_tiled(P.w_out + (size_t)l * D * D, (bf16*)(ws + WS_WOUT) + (size_t)l * D * LDW, D, D, D, LDW, nullptr, lds);
    }
    {
        bf16* Wc = (bf16*)(ws + WS_WPQ);
        float (*As)[68] = (float (*)[68])lds;
        float (*Bs)[68] = (float (*)[68])(lds + 16 * 68 * 4);
        const int tid = tidx(), tx = tid & 15, ty = (tid >> 4) & 15;
        const int lr = (tid >> 2) & 63, ld4 = (tid & 3) * 4;
        for (int tile = blockIdx.x; tile < (DEPTH * 2048 / 64) * (D / 64); tile += gridDim.x) {
            const int row0 = (tile >> 4) * 64, k0 = (tile & 15) * 64;
            const int l = row0 >> 11, hp = (row0 >> 7) & 15, n0 = row0 & 127;
            const float* skp = P.peer_subkeys + (((size_t)l * 2 + (hp & 1)) * NKEY + n0 + lr) * 128 + ld4;
            const float* wqp = P.peer_wq + ((size_t)l * D + k0 + lr) * 2048 + hp * 128 + ld4;
            float acc[4][4];
#pragma unroll
            for (int i = 0; i < 4; ++i)
#pragma unroll
                for (int j = 0; j < 4; ++j) acc[i][j] = 0.f;
            for (int d0 = 0; d0 < 128; d0 += 16) {
                if (tid < 256) {
                    const float4 av = *(const float4*)(skp + d0), bv = *(const float4*)(wqp + d0);
                    As[ld4 + 0][lr] = av.x; As[ld4 + 1][lr] = av.y; As[ld4 + 2][lr] = av.z; As[ld4 + 3][lr] = av.w;
                    Bs[ld4 + 0][lr] = bv.x; Bs[ld4 + 1][lr] = bv.y; Bs[ld4 + 2][lr] = bv.z; Bs[ld4 + 3][lr] = bv.w;
                }
                __syncthreads();
#pragma unroll
                for (int kk = 0; kk < 16; ++kk) {
                    const float4 a4 = *(const float4*)&As[kk][ty * 4], b4 = *(const float4*)&Bs[kk][tx * 4];
                    const float aa[4] = {a4.x, a4.y, a4.z, a4.w}, bb[4] = {b4.x, b4.y, b4.z, b4.w};
#pragma unroll
                    for (int i = 0; i < 4; ++i)
#pragma unroll
                        for (int j = 0; j < 4; ++j) acc[i][j] = fmaf(aa[i], bb[j], acc[i][j]);
                }
                __syncthreads();
            }
            if (tid < 256) {
#pragma unroll
                for (int i = 0; i < 4; ++i) {
                    uint2 o; o.x = pack2(acc[i][0], acc[i][1]); o.y = pack2(acc[i][2], acc[i][3]);
                    *(uint2*)(Wc + (size_t)(row0 + ty * 4 + i) * LDW + k0 + tx * 4) = o;
                }
            }
        }
    }
    convert_table<true>(P.peer_u, ws + WS_TABU, (float*)(ws + WS_TSCU), DEPTH * NEXP);
    convert_table<false>(P.peer_v, ws + WS_TABV, (float*)(ws + WS_TSCV), DEPTH * NEXP);
    float* rope = (float*)(ws + WS_ROPE);
    for (size_t i = gtid(); i < (size_t)S * 16; i += gnth()) {
        const int s = (int)(i >> 4), f = (int)(i & 15);
        const double inv = pow(10000.0, -(double)f / 16.0);
        const double ang = (double)s * inv;
        rope[2 * i] = (float)cos(ang); rope[2 * i + 1] = (float)sin(ang);
    }
}

__device__ __forceinline__ void phase_norm(const float* __restrict__ h, const float* __restrict__ g, unsigned* __restrict__ xq, float* __restrict__ xsc) {
    const int lane = tidx() & 63, nw = nwave();
    for (int t = gwave(); t < T; t += 2 * nw) {
        const int t2 = (t + nw < T) ? (t + nw) : t;
        float4 v[2][4];
#pragma unroll
        for (int j = 0; j < 4; ++j) { v[0][j] = ((const float4*)(h + (size_t)t * D))[j * 64 + lane]; v[1][j] = ((const float4*)(h + (size_t)t2 * D))[j * 64 + lane]; }
#pragma unroll
        for (int u = 0; u < 2; ++u) {
            float ss = 0.f;
#pragma unroll
            for (int j = 0; j < 4; ++j) ss += v[u][j].x * v[u][j].x + v[u][j].y * v[u][j].y + v[u][j].z * v[u][j].z + v[u][j].w * v[u][j].w;
            ss = wave_sum(ss);
            const float r = rsqrtf(ss * (1.f / D) + EPS);
            const int tt = u ? t2 : t;
            if (u == 0 || t2 != t) {
                float am = 0.f;
#pragma unroll
                for (int j = 0; j < 4; ++j) {
                    const float4 gg = ((const float4*)g)[j * 64 + lane];
                    v[u][j].x *= r * gg.x; v[u][j].y *= r * gg.y; v[u][j].z *= r * gg.z; v[u][j].w *= r * gg.w;
                    am = fmaxf(am, fmaxf(fmaxf(fabsf(v[u][j].x), fabsf(v[u][j].y)), fmaxf(fabsf(v[u][j].z), fabsf(v[u][j].w))));
                }
#pragma unroll
                for (int m = 32; m >= 1; m >>= 1) am = fmaxf(am, __shfl_xor(am, m, 64));
                const float sc = (am > 0.f) ? am * (1.f / 127.f) : 1.f, is = 1.f / sc;
#pragma unroll
                for (int j = 0; j < 4; ++j) xq[(size_t)tt * (XQP / 4) + j * 64 + lane] = pack_i8x4(v[u][j].x * is, v[u][j].y * is, v[u][j].z * is, v[u][j].w * is);
                if (lane == 0) xsc[tt] = sc;
            }
        }
    }
}
__device__ __forceinline__ void quant_wrows(const bf16* __restrict__ W, int nrows, unsigned char* __restrict__ W8, float* __restrict__ WS8) {
    const int lane = tidx() & 63;
    for (int row = gwave(); row < nrows; row += nwave()) {
        const uint4 a = ((const uint4*)(W + (size_t)row * LDW))[lane * 2], b = ((const uint4*)(W + (size_t)row * LDW))[lane * 2 + 1];
        float v[16] = {bflo(a.x), bfhi(a.x), bflo(a.y), bfhi(a.y), bflo(a.z), bfhi(a.z), bflo(a.w), bfhi(a.w), bflo(b.x), bfhi(b.x), bflo(b.y), bfhi(b.y), bflo(b.z), bfhi(b.z), bflo(b.w), bfhi(b.w)};
        float am = 0.f;
#pragma unroll
        for (int i = 0; i < 16; ++i) am = fmaxf(am, fabsf(v[i]));
#pragma unroll
        for (int m = 32; m >= 1; m >>= 1) am = fmaxf(am, __shfl_xor(am, m, 64));
        const float sc = (am > 0.f) ? am * (1.f / 127.f) : 1.f, is = 1.f / sc;
        uint4 o;
        o.x = pack_i8x4(v[0] * is, v[1] * is, v[2] * is, v[3] * is); o.y = pack_i8x4(v[4] * is, v[5] * is, v[6] * is, v[7] * is);
        o.z = pack_i8x4(v[8] * is, v[9] * is, v[10] * is, v[11] * is); o.w = pack_i8x4(v[12] * is, v[13] * is, v[14] * is, v[15] * is);
        ((uint4*)(W8 + (size_t)row * XQP))[lane] = o;
        if (lane == 0) WS8[row] = sc;
    }
}
__device__ __forceinline__ void phase_norm_q(const Params& P, int l) {
    const int lane = tidx() & 63, nw = nwave();
    const float* g = P.norm_ffn + l * D;
    unsigned* xq = (unsigned*)(P.ws + WS_XQ);
    float* xsc = (float*)(P.ws + WS_XS);
    bf16* Hb = (bf16*)P.out;
    const bf16* yo = (const bf16*)(P.ws + WS_PROJ);
    for (int t = gwave(); t < T; t += 2 * nw) {
        const int t2 = (t + nw < T) ? (t + nw) : t;
        float4 v[2][4];
#pragma unroll
        for (int j = 0; j < 4; ++j) {
            if (l == 0) { v[0][j] = ((const float4*)(P.x + (size_t)t * D))[j * 64 + lane]; v[1][j] = ((const float4*)(P.x + (size_t)t2 * D))[j * 64 + lane]; }
            else {
                const uint2 a = ((const uint2*)(Hb + (size_t)t * HP))[j * 64 + lane], b = ((const uint2*)(Hb + (size_t)t2 * HP))[j * 64 + lane];
                v[0][j] = make_float4(bflo(a.x), bfhi(a.x), bflo(a.y), bfhi(a.y)); v[1][j] = make_float4(bflo(b.x), bfhi(b.x), bflo(b.y), bfhi(b.y));
            }
        }
        {
            uint2 y[2][4];
#pragma unroll
            for (int j = 0; j < 4; ++j) { y[0][j] = ((const uint2*)(yo + (size_t)t * D))[j * 64 + lane]; y[1][j] = ((const uint2*)(yo + (size_t)t2 * D))[j * 64 + lane]; }
#pragma unroll
            for (int u = 0; u < 2; ++u)
#pragma unroll
                for (int j = 0; j < 4; ++j) { v[u][j].x += bflo(y[u][j].x); v[u][j].y += bfhi(y[u][j].x); v[u][j].z += bflo(y[u][j].y); v[u][j].w += bfhi(y[u][j].y); }
#pragma unroll
            for (int j = 0; j < 4; ++j) {
                uint2 a, b; a.x = pack2(v[0][j].x, v[0][j].y); a.y = pack2(v[0][j].z, v[0][j].w); b.x = pack2(v[1][j].x, v[1][j].y); b.y = pack2(v[1][j].z, v[1][j].w);
                ((uint2*)(Hb + (size_t)t * HP))[j * 64 + lane] = a; if (t2 != t) ((uint2*)(Hb + (size_t)t2 * HP))[j * 64 + lane] = b;
            }
        }
#pragma unroll
        for (int u = 0; u < 2; ++u) {
            float ss = 0.f;
#pragma unroll
            for (int j = 0; j < 4; ++j) ss += v[u][j].x * v[u][j].x + v[u][j].y * v[u][j].y + v[u][j].z * v[u][j].z + v[u][j].w * v[u][j].w;
            ss = wave_sum(ss);
            const float r = rsqrtf(ss * (1.f / D) + EPS);
            const int tt = u ? t2 : t;
            if (u == 0 || t2 != t) {
                float am = 0.f;
#pragma unroll
                for (int j = 0; j < 4; ++j) {
                    const float4 gg = ((const float4*)g)[j * 64 + lane];
                    v[u][j].x *= r * gg.x; v[u][j].y *= r * gg.y; v[u][j].z *= r * gg.z; v[u][j].w *= r * gg.w;
                    am = fmaxf(am, fmaxf(fmaxf(fabsf(v[u][j].x), fabsf(v[u][j].y)), fmaxf(fabsf(v[u][j].z), fabsf(v[u][j].w))));
                }
#pragma unroll
                for (int m = 32; m >= 1; m >>= 1) am = fmaxf(am, __shfl_xor(am, m, 64));
                const float sc = (am > 0.f) ? am * (1.f / 127.f) : 1.f, is = 1.f / sc;
#pragma unroll
                for (int j = 0; j < 4; ++j) xq[(size_t)tt * (XQP / 4) + j * 64 + lane] = pack_i8x4(v[u][j].x * is, v[u][j].y * is, v[u][j].z * is, v[u][j].w * is);
                if (lane == 0) xsc[tt] = sc;
            }
        }
    }
}

__device__ __forceinline__ void phase_mixlocal(const Params& P, int l, char* lds) {
    const bf16* proj = (const bf16*)(P.ws + WS_PROJ);
    bf16* Y = (bf16*)(P.ws + WS_XN);
    const int tid = tidx();
    {
        const float* cw = P.conv_w + (size_t)l * 3 * 256;
        for (size_t i = gtid(); i < (size_t)T * 32; i += gnth()) {
            const int t = (int)(i >> 5), c0 = (int)(i & 31) * 8, s = t & (S - 1);
            const bf16* pr = proj + (size_t)t * DINP;
            float acc[8];
#pragma unroll
            for (int e = 0; e < 8; ++e) acc[e] = 0.f;
#pragma unroll
            for (int j = 0; j < 3; ++j) {
                if (s - 2 + j >= 0) {
                    const bf16* pp = pr - (size_t)(2 - j) * DINP;
                    const uint4 g = *(const uint4*)(pp + C_CG + c0), hc = *(const uint4*)(pp + C_HC + c0);
                    const float4 w0 = *(const float4*)(cw + j * 256 + c0), w1 = *(const float4*)(cw + j * 256 + c0 + 4);
                    acc[0] = fmaf(w0.x, bflo(g.x) * bflo(hc.x), acc[0]); acc[1] = fmaf(w0.y, bfhi(g.x) * bfhi(hc.x), acc[1]);
                    acc[2] = fmaf(w0.z, bflo(g.y) * bflo(hc.y), acc[2]); acc[3] = fmaf(w0.w, bfhi(g.y) * bfhi(hc.y), acc[3]);
                    acc[4] = fmaf(w1.x, bflo(g.z) * bflo(hc.z), acc[4]); acc[5] = fmaf(w1.y, bfhi(g.z) * bfhi(hc.z), acc[5]);
                    acc[6] = fmaf(w1.z, bflo(g.w) * bflo(hc.w), acc[6]); acc[7] = fmaf(w1.w, bfhi(g.w) * bfhi(hc.w), acc[7]);
                }
            }
            const uint4 bg = *(const uint4*)(pr + C_BG + c0);
            uint4 o;
            o.x = pack2(bflo(bg.x) * acc[0], bfhi(bg.x) * acc[1]); o.y = pack2(bflo(bg.y) * acc[2], bfhi(bg.y) * acc[3]);
            o.z = pack2(bflo(bg.z) * acc[4], bfhi(bg.z) * acc[5]); o.w = pack2(bflo(bg.w) * acc[6], bfhi(bg.w) * acc[7]);
            *(uint4*)(Y + (size_t)t * LDX + c0) = o;
        }
    }
    {
        float (*pl)[68] = (float (*)[68])lds;
        const float* pw = P.pool_w + (size_t)l * 4 * 64 * 64;
        const float* psc = P.pool_scale + l * 256;
        const int a = tid & 63, q = tid >> 6;
        for (int tile = blockIdx.x; tile < (T / (16 * NW)) * 4; tile += gridDim.x) {
            const int g = tile & 3, t0 = (tile >> 2) * (16 * NW);
            const int w = 2 << g;
            {
                const bf16* col = proj + C_HP + g * 64 + a;
                const int tf = t0 + q * 16, sf = tf & (S - 1);
                float xr[31];
#pragma unroll
                for (int d = 1; d <= 15; ++d) xr[15 - d] = (d < w && sf - d >= 0) ? bf2f(col[(size_t)(tf - d) * DINP]) : 0.f;
#pragma unroll
                for (int i = 0; i < 16; ++i) xr[15 + i] = bf2f(col[(size_t)(tf + i) * DINP]);
                float sum = 0.f;
#pragma unroll
                for (int d = 1; d <= 15; ++d) sum += xr[15 - d];
#pragma unroll
                for (int i = 0; i < 16; ++i) {
                    const int s = sf + i;
                    sum += xr[15 + i];
                    const int cnt = (s + 1 < w) ? (s + 1) : w;
                    pl[q * 16 + i][a] = sum / (float)cnt - xr[15 + i];
                    const int o = 15 + i + 1;
                    const float old = (g == 0) ? xr[o - 2] : (g == 1) ? xr[o - 4] : (g == 2) ? xr[o - 8] : xr[o - 16];
                    sum -= old;
                }
            }
            __syncthreads();
            {
                float pc[64];
#pragma unroll
                for (int c = 0; c < 64; ++c) pc[c] = pw[(g * 64 + c) * 64 + a];
                const float sc = psc[g * 64 + a];
#pragma unroll 2
                for (int i = 0; i < 16; ++i) {
                    const float4* row = (const float4*)&pl[q * 16 + i][0];
                    float m0 = 0.f, m1 = 0.f;
#pragma unroll
                    for (int c4 = 0; c4 < 16; ++c4) { const float4 v = row[c4]; m0 = fmaf(v.x, pc[4 * c4], m0); m1 = fmaf(v.y, pc[4 * c4 + 1], m1); m0 = fmaf(v.z, pc[4 * c4 + 2], m0); m1 = fmaf(v.w, pc[4 * c4 + 3], m1); }
                    Y[(size_t)(t0 + q * 16 + i) * LDX + 256 + g * 64 + a] = f2bf((m0 + m1) * sc);
                }
            }
            __syncthreads();
        }
    }
}

typedef short v4i16_t __attribute__((ext_vector_type(4)));
typedef __attribute__((address_space(3))) v4i16_t* lds_v4p;
__device__ __forceinline__ v4i16_t vtr(const char* p) { return __builtin_amdgcn_ds_read_tr16_b64_v4i16((lds_v4p)p); }
constexpr int A_KP = 208, A_VP = 192;
constexpr int A_KB = 64 * A_KP, A_VB = 64 * A_VP, A_BUF = A_KB + A_VB, ATTN_LDS = 3 * A_BUF;
static_assert(ATTN_LDS <= LDS_TOTAL, "attention LDS");

__device__ __forceinline__ void attn_unit(const bf16* __restrict__ Qb, const bf16* __restrict__ Kb, const bf16* __restrict__ Vb, bf16* __restrict__ Y, int bh, int qblk, char* lds) {
    const int tid = tidx(), lane = tid & 63, w = tid >> 6, r32 = lane & 31, hi = lane >> 5;
    const int q0 = qblk * (32 * NW), qw0 = q0 + w * 32;
    const int NT = (q0 + 32 * NW) / 64;
    bf16x8 qf[6];
    {
        const bf16* qp = Qb + ((size_t)bh * S + qw0 + r32) * DQK + hi * 8;
#pragma unroll
        for (int ks = 0; ks < 6; ++ks) qf[ks] = *(const bf16x8*)(qp + ks * 16);
    }
    f32x16 o0, o1;
#pragma unroll
    for (int r = 0; r < 16; ++r) { o0[r] = 0.f; o1[r] = 0.f; }
    float m = -1e30f, lsum = 0.f;
    const int t8 = tid & 255; const bool isv = tid >= 256;
    const char* Tg = isv ? (const char*)(Vb + (size_t)bh * S * DV) : (const char*)(Kb + (size_t)bh * S * DQK);
    const int Ts = isv ? (64 * 128) : (64 * 192);
    const int g0 = t8 * 16, g1 = (t8 + 256) * 16, g2 = isv ? g1 : (t8 + 512) * 16;
    const int l0 = isv ? (A_KB + (t8 >> 3) * A_VP + (t8 & 7) * 16) : ((t8 / 12) * A_KP + (t8 % 12) * 16);
    const int l1 = isv ? (l0 + 32 * A_VP) : (((t8 + 256) / 12) * A_KP + ((t8 + 256) % 12) * 16);
    const int l2 = isv ? l1 : (((t8 + 512) / 12) * A_KP + ((t8 + 512) % 12) * 16);
    uint4 pk0, pk1, pk2, qk0, qk1, qk2;
#define A_LOAD(S, t) do { const char* tg = Tg + (size_t)(t) * Ts; S##k0 = *(const uint4*)(tg + g0); S##k1 = *(const uint4*)(tg + g1); S##k2 = *(const uint4*)(tg + g2); } while (0)
#define A_STORE(S, bK, bV) do { *(uint4*)(bK + l0) = S##k0; *(uint4*)(bK + l1) = S##k1; *(uint4*)(bK + l2) = S##k2; } while (0)
#define A_PV(pf, kofs) do { \
            { const v4i16_t lo = vtr(pv + (kofs) * A_VP), hh = vtr(pv + ((kofs) + 8) * A_VP); const bf16x8 vf = {lo[0], lo[1], lo[2], lo[3], hh[0], hh[1], hh[2], hh[3]}; o0 = MFMA32(vf, pf.v, o0); } \
            { const v4i16_t lo = vtr(pv + (kofs) * A_VP + 64), hh = vtr(pv + ((kofs) + 8) * A_VP + 64); const bf16x8 vf = {lo[0], lo[1], lo[2], lo[3], hh[0], hh[1], hh[2], hh[3]}; o1 = MFMA32(vf, pf.v, o1); } } while (0)
    const int pvo = (4 * hi + ((lane & 15) >> 2)) * A_VP + (16 * ((lane >> 4) & 1) + 4 * (lane & 3)) * 2;
#define A_QK(S0, S1, bK_, kt0_) do { \
        _Pragma("unroll") for (int r = 0; r < 16; ++r) { S0[r] = 0.f; S1[r] = 0.f; } \
        const char* pk = (bK_) + r32 * A_KP + hi * 16; \
        _Pragma("unroll") for (int ks = 0; ks < 6; ++ks) { \
            const bf16x8 a0 = *(const bf16x8*)(pk + ks * 32), a1 = *(const bf16x8*)(pk + 32 * A_KP + ks * 32); \
            S0 = MFMA32(a0, qf[ks], S0); S1 = MFMA32(a1, qf[ks], S1); } \
        if ((kt0_) + 63 > qw0) {                                      \
            const int qrow = qw0 + r32; \
            _Pragma("unroll") for (int r = 0; r < 16; ++r) { const int key = (kt0_) + crow(r, hi); if (key > qrow) S0[r] = -INFINITY; if (key + 32 > qrow) S1[r] = -INFINITY; } } } while (0)
#define A_SOFTPV(s0, s1, bV_) do { \
            float mx = fmaxf(s0[0], s1[0]); \
            _Pragma("unroll") for (int r = 1; r < 16; ++r) mx = fmaxf(mx, fmaxf(s0[r], s1[r])); \
            mx = fmaxf(mx, __shfl_xor(mx, 32, 64)); \
            const float mn = fmaxf(m, mx), m_prev = m; \
            const float alpha = __builtin_amdgcn_exp2f(m - mn); \
            m = mn; \
            float ps = 0.f; \
            _Pragma("unroll") for (int r = 0; r < 16; ++r) { s0[r] = __builtin_amdgcn_exp2f(s0[r] - mn); s1[r] = __builtin_amdgcn_exp2f(s1[r] - mn); ps += s0[r] + s1[r]; } \
            if (__builtin_amdgcn_ballot_w64(mn > m_prev) != 0ull) {     \
                lsum *= alpha; \
                _Pragma("unroll") for (int r = 0; r < 16; ++r) { o0[r] *= alpha; o1[r] *= alpha; } } \
            lsum += ps; \
            union { unsigned u[4]; bf16x8 v; } p00, p01, p10, p11; \
            _Pragma("unroll") for (int j = 0; j < 4; ++j) { p00.u[j] = cvtpk(s0[2 * j], s0[2 * j + 1]); p01.u[j] = cvtpk(s0[8 + 2 * j], s0[9 + 2 * j]); p10.u[j] = cvtpk(s1[2 * j], s1[2 * j + 1]); p11.u[j] = cvtpk(s1[8 + 2 * j], s1[9 + 2 * j]); } \
            const char* pv = (bV_) + pvo; \
            A_PV(p00, 0); A_PV(p01, 16); A_PV(p10, 32); A_PV(p11, 48); } while (0)
#define A_STEP(C0, C1, N0, N1, SET, t) do { \
        if ((t) + 1 < NT) { \
            char* bKn = lds + so_next; \
            A_STORE(SET, bKn, bKn + A_KB); \
            __syncthreads(); \
            { const int tn = ((t) + 3 < NT) ? ((t) + 3) : (NT - 1); A_LOAD(SET, tn); } \
            if (((t) + 1) * 64 <= qw0) A_QK(N0, N1, bKn, ((t) + 1) * 64); \
        } \
        if ((t) * 64 <= qw0) A_SOFTPV(C0, C1, lds + so_cur + A_KB); \
        so_cur = so_next; so_next = (so_next == 2 * A_BUF) ? 0 : so_next + A_BUF; } while (0)
    int so_cur = 0, so_next = A_BUF;
    A_LOAD(p, 0); A_LOAD(q, 1);
    A_STORE(p, lds, lds + A_KB);
    __syncthreads();
    A_LOAD(p, 2);
    f32x16 sa0, sa1, sb0, sb1;
    A_QK(sa0, sa1, lds, 0);
    for (int t2 = 0; t2 < NT; t2 += 2) {
        A_STEP(sa0, sa1, sb0, sb1, q, t2);
        A_STEP(sb0, sb1, sa0, sa1, p, t2 + 1);
    }
#undef A_QK
#undef A_SOFTPV
#undef A_STEP
    lsum += __shfl_xor(lsum, 32, 64);
    const float inv = 1.f / lsum;
    const int b = bh >> 3, h = bh & 7;
    bf16* yo = Y + (size_t)(b * S + qw0 + r32) * LDX + 512 + h * 64 + 4 * hi;
#pragma unroll
    for (int g = 0; g < 4; ++g) {
        uint2 a, c;
        a.x = cvtpk(o0[4 * g] * inv, o0[4 * g + 1] * inv); a.y = cvtpk(o0[4 * g + 2] * inv, o0[4 * g + 3] * inv);
        c.x = cvtpk(o1[4 * g] * inv, o1[4 * g + 1] * inv); c.y = cvtpk(o1[4 * g + 2] * inv, o1[4 * g + 3] * inv);
        *(uint2*)(yo + 8 * g) = a; *(uint2*)(yo + 32 + 8 * g) = c;
    }
    __syncthreads();
}
__device__ __forceinline__ void phase_attn(const Params& P, char* lds) {
    const bf16* Qb = (const bf16*)(P.ws + WS_Q);
    const bf16* Kb = (const bf16*)(P.ws + WS_K);
    const bf16* Vb = (const bf16*)(P.ws + WS_V);
    bf16* Y = (bf16*)(P.ws + WS_XN);
    for (int u = blockIdx.x; u < NB * NH * (S / 256); u += gridDim.x) {
        const int bh = u & 31, v = u >> 5;
        const int qblk = (v < 8) ? (31 - v) : (v < 16) ? (v - 8) : (v < 24) ? (39 - v) : (v - 16);
        attn_unit(Qb, Kb, Vb, Y, bh, qblk, lds);
    }
}

#define NET_HD __device__ __forceinline__
#define NET_U2F(u) __uint_as_float(u)
#define NET_F2U(f) __float_as_uint(f)
#define CE_DESC(a, b) do { const float hi__ = fmaxf(a, b), lo__ = fminf(a, b); a = hi__; b = lo__; } while (0)
NET_HD void sort16_desc(float (&v)[16]) {
#define CE2(a, b) CE_DESC(v[a], v[b])
    CE2(0,13); CE2(1,12); CE2(2,15); CE2(3,14); CE2(4,8); CE2(5,6); CE2(7,11); CE2(9,10);
    CE2(0,5); CE2(1,7); CE2(2,9); CE2(3,4); CE2(6,13); CE2(8,14); CE2(10,15); CE2(11,12);
    CE2(0,1); CE2(2,3); CE2(4,5); CE2(6,8); CE2(7,9); CE2(10,11); CE2(12,13); CE2(14,15);
    CE2(0,2); CE2(1,3); CE2(4,10); CE2(5,11); CE2(6,7); CE2(8,9); CE2(12,14); CE2(13,15);
    CE2(1,2); CE2(3,12); CE2(4,6); CE2(5,7); CE2(8,10); CE2(9,11); CE2(13,14);
    CE2(1,4); CE2(2,6); CE2(5,8); CE2(7,10); CE2(9,13); CE2(11,14);
    CE2(2,4); CE2(3,6); CE2(9,12); CE2(11,13);
    CE2(3,5); CE2(6,8); CE2(7,9); CE2(10,12);
    CE2(3,4); CE2(5,6); CE2(7,8); CE2(9,10); CE2(11,12);
    CE2(6,7); CE2(8,9);
#undef CE2
}
NET_HD void merge16_desc(float (&a)[16], const float (&b)[16]) {
#pragma unroll
    for (int i = 0; i < 16; ++i) a[i] = fmaxf(a[i], b[15 - i]);
#pragma unroll
    for (int j = 8; j > 0; j >>= 1) {
#pragma unroll
        for (int i = 0; i < 16; ++i) { const int l = i ^ j; if (l > i) CE_DESC(a[i], a[l]); }
    }
}
NET_HD void top16_of_64(float (&g0)[16], float (&g1)[16], float (&g2)[16], float (&g3)[16]) {
    sort16_desc(g0); sort16_desc(g1); sort16_desc(g2); sort16_desc(g3);
    merge16_desc(g0, g1); merge16_desc(g2, g3); merge16_desc(g0, g2);
}
NET_HD float u2f(unsigned u) { return NET_U2F(u); }
NET_HD unsigned f2u(float f) { return NET_F2U(f); }
template <class V16>
NET_HD void lane_top16(const V16& s0, const V16& s1, const V16& s2, const V16& s3, int hi, float (&out)[16]) {
    float g0[16], g1[16], g2[16], g3[16];
#pragma unroll
    for (int r = 0; r < 16; ++r) {
        const unsigned nb = (unsigned)((r & 3) + 8 * (r >> 2));
        g0[r] = u2f((f2u(s0[r]) & 0xFFFFFF80u) | nb); g1[r] = u2f((f2u(s1[r]) & 0xFFFFFF80u) | (nb + 32u));
        g2[r] = u2f((f2u(s2[r]) & 0xFFFFFF80u) | (nb + 64u)); g3[r] = u2f((f2u(s3[r]) & 0xFFFFFF80u) | (nb + 96u));
    }
    top16_of_64(g0, g1, g2, g3);
    const unsigned h4 = (unsigned)hi << 2;
#pragma unroll
    for (int i = 0; i < 16; ++i) out[i] = u2f(f2u(g0[i]) | h4);
}
constexpr int cand_slot(int a, int b) { int n = 0; for (int x = 0; x < 16; ++x) for (int y = 0; y < 16; ++y) { if (x == a && y == b) return n; if ((x + 1) * (y + 1) <= 16) ++n; } return n; }
NET_HD void cand_top16(const float (&s1)[16], const float (&s2)[16], float (&c)[16]) {
    float g0[16], g1[16], g2[16], g3[16];
#pragma unroll
    for (int i = 0; i < 16; ++i) { g0[i] = -3.0e38f; g1[i] = -3.0e38f; g2[i] = -3.0e38f; g3[i] = -3.0e38f; }
#pragma unroll
    for (int a = 0; a < 16; ++a) {
#pragma unroll
        for (int b = 0; b < 16; ++b) {
            if ((a + 1) * (b + 1) <= 16) {
                const int sl = cand_slot(a, b);
                const float v = u2f((f2u(s1[a] + s2[b]) & 0xFFFFFF00u) | (unsigned)(a * 16 + b));
                if (sl < 16) g0[sl & 15] = v; else if (sl < 32) g1[sl & 15] = v; else if (sl < 48) g2[sl & 15] = v; else g3[sl & 15] = v;
            }
        }
    }
    top16_of_64(g0, g1, g2, g3);
#pragma unroll
    for (int i = 0; i < 16; ++i) c[i] = g0[i];
}

__device__ __forceinline__ void phase_route(const Params& P, int l, char* lds) {
    const bf16* XQb = (const bf16*)(P.ws + WS_XQ);
    const bf16* Wc = (const bf16*)(P.ws + WS_WC8 + (size_t)l * 2048 * XQP);
    const float* WcS = (const float*)(P.ws + WS_WCS) + (size_t)l * 2048;
    const float* XSc = (const float*)(P.ws + WS_XS);
    int* EXPp = (int*)(P.ws + WS_EXP);
    float* GATEp = (float*)(P.ws + WS_GATE);
    const int tid = tidx();
    float* xch = (float*)(lds + 16384);
    int tlo, thi, tst; tile_rounds((T / 256) * PH, tlo, thi, tst);
    int nt = D / 128; asm volatile("" : "+s"(nt));
    for (int u = tlo; u < thi; u += tst) {
        const int tm = u >> 3, h = u & 7;
        float Lk[16];
        {
            i32x4 acc[2][2][4][2]; float ssd[2][2];
            gemm8_kloop<false, true, i32x4>(Wc + (size_t)(h * 256) * (XQP / 2), XQP / 2, XQb + (size_t)(tm * 256) * (XQP / 2), XQP / 2, nt, acc, ssd, lds, tid);
            const int te = tidx(), fq = (te >> 4) & 3;
            const unsigned fqb = (unsigned)fq << 2;
            float4 ks[2][4];
            { const float* kp = WcS + h * 256 + ((te >> 8) & 1) * 128 + fq * 4;
#pragma unroll
              for (int ai = 0; ai < 2; ++ai)
#pragma unroll
                  for (int m = 0; m < 4; ++m) ks[ai][m] = *(const float4*)(kp + ai * 64 + m * 16); }
#pragma unroll
            for (int i = 0; i < 16; ++i) Lk[i] = 0.f;
#pragma unroll
            for (int bj = 0; bj < 2; ++bj)
#pragma unroll
                for (int n = 0; n < 2; ++n) {
                    float g0[16], g1[16];
#pragma unroll
                    for (int m = 0; m < 4; ++m)
#pragma unroll
                        for (int j = 0; j < 4; ++j) {
                            const unsigned kb = (unsigned)(m * 16 + j) | fqb;
                            const float k0 = (j == 0) ? ks[0][m].x : (j == 1) ? ks[0][m].y : (j == 2) ? ks[0][m].z : ks[0][m].w;
                            const float k1 = (j == 0) ? ks[1][m].x : (j == 1) ? ks[1][m].y : (j == 2) ? ks[1][m].z : ks[1][m].w;
                            g0[m * 4 + j] = u2f((f2u((float)acc[0][bj][m][n][j] * k0) & 0xFFFFFF80u) | kb);
                            g1[m * 4 + j] = u2f((f2u((float)acc[1][bj][m][n][j] * k1) & 0xFFFFFF80u) | (kb + 64u));
                        }
                    sort16_desc(g0); sort16_desc(g1); merge16_desc(g0, g1);
                    float o[16];
#pragma unroll
                    for (int i = 0; i < 16; ++i) o[i] = __shfl_xor(g0[i], 16, 64);
                    merge16_desc(g0, o);
#pragma unroll
                    for (int i = 0; i < 16; ++i) o[i] = __shfl_xor(g0[i], 32, 64);
                    merge16_desc(g0, o);
                    const bool mine = fq == bj * 2 + n;
#pragma unroll
                    for (int i = 0; i < 16; ++i) Lk[i] = mine ? g0[i] : Lk[i];
                }
        }
        __syncthreads();
        const int te = tidx(), lane = te & 63, w = te >> 6, wr = w >> 2, wc = w & 3, fr = lane & 15, fq = lane >> 4;
        if (wr == 1) {
#pragma unroll
            for (int q = 0; q < 4; ++q) *(float4*)(xch + ((wc * 64 + lane) * 16) + 4 * q) = make_float4(Lk[4 * q], Lk[4 * q + 1], Lk[4 * q + 2], Lk[4 * q + 3]);
        }
        __syncthreads();
        if (wr == 0) {
            float L1[16];
#pragma unroll
            for (int q = 0; q < 4; ++q) { const float4 v = *(const float4*)(xch + ((wc * 64 + lane) * 16) + 4 * q); L1[4 * q] = v.x; L1[4 * q + 1] = v.y; L1[4 * q + 2] = v.z; L1[4 * q + 3] = v.w; }
            float c[16];
            cand_top16(Lk, L1, c);
            unsigned char* my = (unsigned char*)lds + te * 32;
            {
                uint4 a, b;
#define PK4(L, i) ((__float_as_uint(L[i]) & 127u) | ((__float_as_uint(L[i + 1]) & 127u) << 8) | ((__float_as_uint(L[i + 2]) & 127u) << 16) | ((__float_as_uint(L[i + 3]) & 127u) << 24))
                a.x = PK4(Lk, 0); a.y = PK4(Lk, 4); a.z = PK4(Lk, 8); a.w = PK4(Lk, 12);
                b.x = PK4(L1, 0); b.y = PK4(L1, 4); b.z = PK4(L1, 8); b.w = PK4(L1, 12);
#undef PK4
                *(uint4*)my = a; *(uint4*)(my + 16) = b;
            }
            const int t = tm * 256 + (fq >> 1) * 128 + wc * 32 + (fq & 1) * 16 + fr;
            const float xs_t = XSc[t];
            int ev[16]; float gv[16]; float den = 0.f;
#pragma unroll
            for (int k = 0; k < 16; ++k) {
                const unsigned ci = __float_as_uint(c[k]) & 255u;
                const int n1 = my[ci >> 4], n2 = my[16 + (ci & 15)];
                ev[k] = n1 * NKEY + n2;
                gv[k] = __expf((c[k] - c[0]) * xs_t); den += gv[k];
            }
            const float iden = 1.f / den;
            uint4* ep = (uint4*)(EXPp + (size_t)t * HK + h * 16);
            float4* gp = (float4*)(GATEp + (size_t)t * HK + h * 16);
#pragma unroll
            for (int q = 0; q < 4; ++q) {
                ep[q] = make_uint4((unsigned)ev[4 * q], (unsigned)ev[4 * q + 1], (unsigned)ev[4 * q + 2], (unsigned)ev[4 * q + 3]);
                gp[q] = make_float4(gv[4 * q] * iden, gv[4 * q + 1] * iden, gv[4 * q + 2] * iden, gv[4 * q + 3] * iden);
            }
        }
        __syncthreads();
    }
}

constexpr size_t WS_PART = WS_PROJ;
static_assert((size_t)8 * T * HK * 4 <= WS_K - WS_PROJ, "PART alias");
constexpr int XI_X = 0, XI_RANK = 1, XI_J = 2, XI_NX = 3, XI_NLOC = 4;
constexpr int CTL_CENSUS = 4096;
constexpr int CTL_BYTES = (CTL_CENSUS + 16) * 4;

template <int M1, int M2, int M3, class TT>
__device__ __forceinline__ void red16x3(TT (&p)[16], int lane) {
#pragma unroll
    for (int i = 0; i < 8; ++i) { const bool up = lane & M1; const TT send = up ? p[i] : p[i + 8], keep = up ? p[i + 8] : p[i]; p[i] = keep + __shfl_xor(send, M1, 64); }
#pragma unroll
    for (int i = 0; i < 4; ++i) { const bool up = lane & M2; const TT send = up ? p[i] : p[i + 4], keep = up ? p[i + 4] : p[i]; p[i] = keep + __shfl_xor(send, M2, 64); }
#pragma unroll
    for (int i = 0; i < 2; ++i) { const bool up = lane & M3; const TT send = up ? p[i] : p[i + 2], keep = up ? p[i + 2] : p[i]; p[i] = keep + __shfl_xor(send, M3, 64); }
}
__device__ __forceinline__ void phase_gu(const Params& P, int l, const volatile int* xi) {
    const unsigned char* XQ = P.ws + WS_XQ;
    const float* XSc = (const float*)(P.ws + WS_XS);
    const int* EXPp = (const int*)(P.ws + WS_EXP);
    float* PART = (float*)(P.ws + WS_PART);
    const int tid = tidx(), lane = tid & 63, w = tid >> 6, g = lane >> 3, c = lane & 7;
    int xo_ = 0; asm volatile("" : "+v"(xo_));
    const int j = __builtin_amdgcn_readfirstlane(xi[xo_ + XI_J]), nx = __builtin_amdgcn_readfirstlane(xi[xo_ + XI_NX]), nloc = __builtin_amdgcn_readfirstlane(xi[xo_ + XI_NLOC]), rank = __builtin_amdgcn_readfirstlane(xi[xo_ + XI_RANK]);
    const int t0 = rank * NW + w, st = nloc * NW;
    const int n = (t0 < T) ? (T - t0 + st - 1) / st : 0;
    const int i0 = 8 * (c & 1) + 4 * ((c >> 1) & 1) + 2 * ((c >> 2) & 1);
    for (int sl = j; sl < 8 && n > 0; sl += nx) {
        const unsigned char* Us = P.ws + WS_TABU + ((size_t)(l * 8 + sl) * NEXP) * 128;
        const unsigned co = (unsigned)c << 4;
        float* part = PART + (size_t)sl * T * HK;
        const unsigned char* xs = XQ + sl * 128 + c * 16;
#define GU_TK(k) (t0 + (((k) < n) ? (k) : (n - 1)) * st)
#define GU_LOADE(S, t) do { S##lo = EXPp[(size_t)(t) * HK + lane]; S##hi = EXPp[(size_t)(t) * HK + 64 + lane]; } while (0)
#define GU_LOADX(S, t) do { S##a = *(const uint4*)(xs + (size_t)(t) * XQP); S##s = XSc[t]; } while (0)
#define GU_ISSUE(R, S) do { _Pragma("unroll") for (int i = 0; i < 16; ++i) { \
            const int e = __builtin_amdgcn_ds_bpermute((((8 * i) & 63) + g) << 2, (i < 8) ? S##lo : S##hi); R[i] = *(const uint4*)(Us + (((unsigned)e << 7) | co)); } } while (0)
#define GU_FINISH(R, S, t) do { \
            int p[16]; \
            _Pragma("unroll") for (int i = 0; i < 16; ++i) { int d_ = __builtin_amdgcn_sdot4((int)S##a.x, (int)R[i].x, 0, false); d_ = __builtin_amdgcn_sdot4((int)S##a.y, (int)R[i].y, d_, false); \
                d_ = __builtin_amdgcn_sdot4((int)S##a.z, (int)R[i].z, d_, false); p[i] = __builtin_amdgcn_sdot4((int)S##a.w, (int)R[i].w, d_, false); } \
            red16x3<1, 2, 4, int>(p, lane); \
            part[(size_t)(t) * HK + 8 * i0 + g] = (float)p[0] * S##s; part[(size_t)(t) * HK + 8 * (i0 + 1) + g] = (float)p[1] * S##s; } while (0)
        int eAlo, eAhi, eBlo, eBhi; uint4 xAa, xBa; float xAs, xBs; uint4 rA[16], rB[16];
        GU_LOADE(eA, GU_TK(0)); GU_LOADX(xA, GU_TK(0)); GU_LOADE(eB, GU_TK(1));
        GU_ISSUE(rA, eA);
        for (int k = 0; k < n; k += 2) {
            GU_LOADX(xB, GU_TK(k + 1)); GU_ISSUE(rB, eB); GU_LOADE(eA, GU_TK(k + 2));
            GU_FINISH(rA, xA, GU_TK(k));
            GU_LOADX(xA, GU_TK(k + 2)); GU_ISSUE(rA, eA); GU_LOADE(eB, GU_TK(k + 3));
            GU_FINISH(rB, xB, GU_TK(k + 1));
        }
#undef GU_TK
#undef GU_LOADE
#undef GU_LOADX
#undef GU_ISSUE
#undef GU_FINISH
    }
}
__device__ __forceinline__ void phase_gw(const Params& P, int l) {
    const int* EXPp = (const int*)(P.ws + WS_EXP);
    const float* GATEp = (const float*)(P.ws + WS_GATE);
    const float* PART = (const float*)(P.ws + WS_PART);
    const float* SU = (const float*)(P.ws + WS_TSCU) + (size_t)l * NEXP;
    const float* SV = (const float*)(P.ws + WS_TSCV) + (size_t)l * NEXP;
    unsigned char* WQ = P.ws + WS_WQ8;
    float* WSC = (float*)(P.ws + WS_WSC);
    const int lane = tidx() & 63;
    for (int tb = gwave() * 4; tb < T; tb += nwave() * 4) {
        float wv[4][2];
#pragma unroll
        for (int q = 0; q < 4; ++q)
#pragma unroll
            for (int hk = 0; hk < 2; ++hk) {
                const size_t i = (size_t)(tb + q) * HK + hk * 64 + lane;
                float s = 0.f;
#pragma unroll
                for (int x = 0; x < 8; ++x) s += PART[(size_t)x * T * HK + i];
                const int e = EXPp[i];
                wv[q][hk] = GATEp[i] * gelu_exact(s * SU[e]) * SV[e];
            }
#pragma unroll
        for (int q = 0; q < 4; ++q) {
            float am = fmaxf(fabsf(wv[q][0]), fabsf(wv[q][1]));
#pragma unroll
            for (int m = 32; m >= 1; m >>= 1) am = fmaxf(am, __shfl_xor(am, m, 64));
            const float sc = (am > 0.f) ? am * (1.f / 448.f) : 1.f, is = 1.f / sc;
            const int pk = __builtin_amdgcn_cvt_pk_fp8_f32(wv[q][0] * is, wv[q][1] * is, 0, false);
            WQ[(size_t)(tb + q) * HK + lane] = (unsigned char)(pk & 255);
            WQ[(size_t)(tb + q) * HK + 64 + lane] = (unsigned char)((pk >> 8) & 255);
            if (lane == 0) WSC[tb + q] = sc;
        }
    }
}
typedef int v2i_t __attribute__((ext_vector_type(2)));
typedef unsigned u32x4_t __attribute__((ext_vector_type(4)));
typedef __attribute__((ext_vector_type(4))) float f32x4;
constexpr int GV_PIECE = 1024 + 16;
constexpr int GV_TILE = 16 * GV_PIECE;
static_assert(NW * GV_TILE + NW * 512 <= LDS_TOTAL, "gv LDS");
__device__ __forceinline__ void phase_gv(const Params& P, int l, const volatile int* xi, char* lds) {
    const int* EXPp = (const int*)(P.ws + WS_EXP);
    const unsigned char* WQ = P.ws + WS_WQ8;
    const float* WSC = (const float*)(P.ws + WS_WSC);
    const int tid = tidx(), lane = tid & 63, w = __builtin_amdgcn_readfirstlane(tid >> 6), g = lane >> 3, pos = lane & 7;
    int xo_ = 0; asm volatile("" : "+v"(xo_));
    const int j = __builtin_amdgcn_readfirstlane(xi[xo_ + XI_J]), nx = __builtin_amdgcn_readfirstlane(xi[xo_ + XI_NX]), nloc = __builtin_amdgcn_readfirstlane(xi[xo_ + XI_NLOC]), rank = __builtin_amdgcn_readfirstlane(xi[xo_ + XI_RANK]);
    const int t0 = rank * NW + w, st = nloc * NW;
    const int n = (t0 < T) ? (T - t0 + st - 1) / st : 0;
    char* tile = lds + w * GV_TILE;
    float* strip = (float*)(lds + NW * GV_TILE) + w * 128;
    typedef __attribute__((address_space(3))) v2i_t* ldsv2_t;
    const unsigned co = (unsigned)(pos ^ g) << 4;
    const int rr = (lane & 15) >> 1, kq = lane >> 4;
    const int rdo = kq * GV_PIECE + rr * 128 + (lane & 1) * 8;
    const bool row0 = (lane & 15) == 0;
    __syncthreads();
    for (int sl = j; sl < 8 && n > 0; sl += nx) {
        const unsigned char* Vs = P.ws + WS_TABV + ((size_t)(l * 8 + sl) * NEXP) * 128;
        const char* hrow = (const char*)P.out + sl * 256 + 4 * lane;
#define GV_TK(k) (t0 + (((k) < n) ? (k) : (n - 1)) * st)
#define GV_LOADE(S, t) do { S##el = EXPp[(size_t)(t) * HK + lane]; S##eh = EXPp[(size_t)(t) * HK + 64 + lane]; } while (0)
#define GV_ISSUE(R, S) do { _Pragma("unroll") for (int i = 0; i < 16; ++i) { \
            const int e = __builtin_amdgcn_ds_bpermute((((8 * i) & 63) + g) << 2, (i < 8) ? S##el : S##eh); R[i] = *(const u32x4_t*)(Vs + (((unsigned)e << 7) | co)); } } while (0)
#define GV_LOADT(S, kk) do { const int t_ = GV_TK(kk); \
            S##a0 = 0; S##a1 = 0; S##a2 = 0; S##a3 = 0; \
            if (row0) { const long* wp = (const long*)(WQ + (size_t)t_ * HK + kq * 8); S##a0 = wp[0]; S##a1 = wp[4]; S##a2 = wp[8]; S##a3 = wp[12]; } \
            S##ws = ((kk) < n) ? WSC[t_] : 0.f; \
            S##hv = *(const unsigned*)(hrow + (size_t)t_ * (HP * 2)); } while (0)
#define GV_TOKEN(R, S, kk) do { \
            const int t = GV_TK(kk); \
            _Pragma("unroll") for (int i = 0; i < 16; ++i) *(u32x4_t*)(tile + i * GV_PIECE + lane * 16) = R[i]; \
            f32x4 acc[8]; \
            _Pragma("unroll") for (int nt = 0; nt < 8; ++nt) acc[nt] = (f32x4){0.f, 0.f, 0.f, 0.f}; \
            _Pragma("unroll") for (int s4 = 0; s4 < 4; ++s4) { \
                const long av = (s4 == 0) ? S##a0 : (s4 == 1) ? S##a1 : (s4 == 2) ? S##a2 : S##a3; \
                _Pragma("unroll") for (int nt = 0; nt < 8; ++nt) { \
                    const v2i_t bv = __builtin_amdgcn_ds_read_tr8_b64_v2i32((ldsv2_t)(void*)(tile + (4 * s4) * GV_PIECE + rdo + ((nt ^ rr) << 4))); \
                    acc[nt] = __builtin_amdgcn_mfma_f32_16x16x32_fp8_fp8(av, __builtin_bit_cast(long, bv), acc[nt], 0, 0, 0); } } \
            if (lane < 16) { _Pragma("unroll") for (int nt = 0; nt < 8; ++nt) strip[16 * nt + lane] = acc[nt][0]; }        \
            { const float2 o2 = *(const float2*)(strip + 2 * lane); \
              if ((kk) < n) *(unsigned*)(hrow + (size_t)t * (HP * 2)) = pack2(bflo(S##hv) + S##ws * o2.x, bfhi(S##hv) + S##ws * o2.y); } } while (0)
        int Ael, Aeh, Bel, Beh; u32x4_t rA[16], rB[16];
        long Pa0, Pa1, Pa2, Pa3, Qa0, Qa1, Qa2, Qa3; float Pws, Qws; unsigned Phv, Qhv;
        GV_LOADE(A, GV_TK(0)); GV_LOADE(B, GV_TK(1));
        GV_ISSUE(rA, A); GV_LOADT(P, 0);
        for (int k = 0; k < n; k += 2) {
            GV_ISSUE(rB, B); GV_LOADE(A, GV_TK(k + 2)); GV_LOADT(Q, k + 1);
            GV_TOKEN(rA, P, k);
            GV_ISSUE(rA, A); GV_LOADE(B, GV_TK(k + 3)); GV_LOADT(P, k + 2);
            GV_TOKEN(rB, Q, k + 1);
        }
#undef GV_TK
#undef GV_LOADE
#undef GV_ISSUE
#undef GV_LOADT
#undef GV_TOKEN
    }
    __syncthreads();
}
__device__ __forceinline__ void phase_gnorm(const Params& P, int l) {
    const int lane = tidx() & 63, nw = nwave();
    unsigned* xq = (unsigned*)(P.ws + WS_XQ);
    float* xsc = (float*)(P.ws + WS_XS);
    const bf16* Hb = (const bf16*)P.out;
    const float4* g = (const float4*)((l == DEPTH - 1) ? P.norm_final : (P.norm_mix + (l + 1) * D));
    for (int t = gwave(); t < T; t += 2 * nw) {
        const int t2 = (t + nw < T) ? (t + nw) : t;
        float4 v[2][4];
#pragma unroll
        for (int q = 0; q < 4; ++q) {
            const uint2 a = ((const uint2*)(Hb + (size_t)t * HP))[q * 64 + lane], b = ((const uint2*)(Hb + (size_t)t2 * HP))[q * 64 + lane];
            v[0][q] = make_float4(bflo(a.x), bfhi(a.x), bflo(a.y), bfhi(a.y)); v[1][q] = make_float4(bflo(b.x), bfhi(b.x), bflo(b.y), bfhi(b.y));
        }
#pragma unroll
        for (int u = 0; u < 2; ++u) {
            float ss = 0.f;
#pragma unroll
            for (int q = 0; q < 4; ++q) ss += v[u][q].x * v[u][q].x + v[u][q].y * v[u][q].y + v[u][q].z * v[u][q].z + v[u][q].w * v[u][q].w;
            ss = wave_sum(ss);
            const float rn = rsqrtf(ss * (1.f / D) + EPS);
            const int tt = u ? t2 : t;
            if (u == 0 || t2 != t) {
                float4* hr = (float4*)(P.out + (size_t)tt * D);
                float am = 0.f;
#pragma unroll
                for (int q = 0; q < 4; ++q) {
                    const float4 gg = g[q * 64 + lane];
                    v[u][q] = make_float4(v[u][q].x * rn * gg.x, v[u][q].y * rn * gg.y, v[u][q].z * rn * gg.z, v[u][q].w * rn * gg.w);
                    am = fmaxf(am, fmaxf(fmaxf(fabsf(v[u][q].x), fabsf(v[u][q].y)), fmaxf(fabsf(v[u][q].z), fabsf(v[u][q].w))));
                    if (l == DEPTH - 1) hr[q * 64 + lane] = v[u][q];
                }
                if (l != DEPTH - 1) {
#pragma unroll
                    for (int m = 32; m >= 1; m >>= 1) am = fmaxf(am, __shfl_xor(am, m, 64));
                    const float sc = (am > 0.f) ? am * (1.f / 127.f) : 1.f, is = 1.f / sc;
#pragma unroll
                    for (int q = 0; q < 4; ++q) xq[(size_t)tt * (XQP / 4) + q * 64 + lane] = pack_i8x4(v[u][q].x * is, v[u][q].y * is, v[u][q].z * is, v[u][q].w * is);
                    if (lane == 0) xsc[tt] = sc;
                }
            }
        }
    }
}

#define XB_TMO      128
#define XB_XCNT(j)  (256  + 64 * (j))
#define XB_XSUB(j)  (1280 + 64 * (j))
#define XB_XGEN(j)  (2304 + 64 * (j))
#define XB_TOP      3328
#define XB_TOPGEN   3392
#define XCD_BAR_WORDS 3456
#define XB_SPIN_CAP (1u << 22)
#define LAS __attribute__((address_space(3)))
__device__ __forceinline__ unsigned xb_ld(unsigned* p)              { return __hip_atomic_load(p, __ATOMIC_RELAXED, __HIP_MEMORY_SCOPE_AGENT); }
__device__ __forceinline__ unsigned xb_add(unsigned* p, unsigned v) { return __hip_atomic_fetch_add(p, v, __ATOMIC_RELAXED, __HIP_MEMORY_SCOPE_AGENT); }
__device__ __forceinline__ unsigned xb_xcc_id() { return (unsigned)__builtin_amdgcn_s_getreg((3 << 11) | 20) & 0xFu; }
#define XB_SPIN(cond, bar) do { unsigned _sp = 0; while (cond) { __builtin_amdgcn_s_sleep(1); \
    if ((++_sp & 255u) == 0u) { if (xb_ld(&(bar)[XB_TMO])) break; if (_sp > XB_SPIN_CAP) { atomicAdd(&(bar)[XB_TMO], 1u); break; } } } } while (0)
struct XcdBarrier { unsigned* bar; unsigned x; volatile LAS unsigned* st; };
__device__ __forceinline__ XcdBarrier xcd_barrier_post(unsigned* bar, volatile LAS unsigned* st) {
    XcdBarrier b; b.bar = bar; b.x = xb_xcc_id(); b.st = st;
    if (__builtin_amdgcn_workitem_id_x() == 0) (void)xb_add(&bar[XB_XCNT(b.x)], 1u);
    return b;
}
__device__ __forceinline__ void xcd_barrier_complete(unsigned* bar, unsigned x, unsigned& nloc, unsigned& nx) {
    const unsigned G = gridDim.x * gridDim.y * gridDim.z;
    unsigned sum, cnt, mine, sp = 0u;
    for (;;) {
        sum = 0u; cnt = 0u; mine = 0u;
#pragma unroll
        for (unsigned j = 0; j < 16; ++j) { const unsigned c = xb_ld(&bar[XB_XCNT(j)]); sum += c; cnt += (c > 0u) ? 1u : 0u; mine = (j == x) ? c : mine; }
        if (sum == G) break;
        __builtin_amdgcn_s_sleep(1);
        if ((++sp & 255u) == 0u) { if (xb_ld(&bar[XB_TMO])) break; if (sp > XB_SPIN_CAP) { atomicAdd(&bar[XB_TMO], 1u); break; } }
    }
    nloc = mine > 0u ? mine : 1u; nx = cnt > 0u ? cnt : 1u;
}
__device__ __forceinline__ void xcd_barrier(const XcdBarrier& b) {
    asm volatile("s_waitcnt vmcnt(0)" ::: "memory");
    __syncthreads();
    if (__builtin_amdgcn_workitem_id_x() == 0) {
        unsigned* bar = b.bar;
        __builtin_amdgcn_s_waitcnt(0);
        unsigned nloc = b.st[0], nx = b.st[1];
        if (nloc == 0u) { xcd_barrier_complete(bar, b.x, nloc, nx); b.st[0] = nloc; b.st[1] = nx; }
        const unsigned old = xb_add(&bar[XB_XSUB(b.x)], 1u);
        const unsigned gen = old / nloc;
        if (old + 1u == (gen + 1u) * nloc) {
            __builtin_amdgcn_fence(__ATOMIC_RELEASE, "agent");
            asm volatile("s_waitcnt vmcnt(0)" ::: "memory");
            const unsigned og = xb_add(&bar[XB_TOP], 1u);
            const unsigned tg = og / nx;
            if (og + 1u == (tg + 1u) * nx) xb_add(&bar[XB_TOPGEN], 1u);
            else XB_SPIN(xb_ld(&bar[XB_TOPGEN]) == tg, bar);
            __builtin_amdgcn_fence(__ATOMIC_ACQUIRE, "agent");
            xb_add(&bar[XB_XGEN(b.x)], 1u);
            asm volatile("s_waitcnt vmcnt(0)" ::: "memory");
        } else {
            XB_SPIN(xb_ld(&bar[XB_XGEN(b.x)]) == gen, bar);
            __builtin_amdgcn_fence(__ATOMIC_ACQUIRE, "agent");
            asm volatile("s_waitcnt vmcnt(0)" ::: "memory");
        }
    }
    __syncthreads();
}

constexpr float QSCALE = 0.10206207261596575f * 1.4426950408889634f;

__device__ __forceinline__ void phase_gemm1(const Params& P, int l, char* lds) {
    unsigned char* ws = P.ws;
    const bf16* XN = (const bf16*)(ws + WS_XN);
    bf16* PROJ = (bf16*)(ws + WS_PROJ);
    bf16* Kb = (bf16*)(ws + WS_K);
    const float* rope = (const float*)(ws + WS_ROPE);
    const bf16* W = (const bf16*)(ws + WS_WIN) + (size_t)l * DINP * LDW;
    float* SSQ = (float*)(ws + WS_SSQ);
    const int lane = tidx() & 63;
    const bf16* W8 = (const bf16*)(ws + WS_WI8 + (size_t)l * DINP * XQP);
    const bf16* XQb = (const bf16*)(ws + WS_XQ);
    const float* XSc = (const float*)(ws + WS_XS);
    const float* WIS = (const float*)(ws + WS_WIS) + (size_t)l * DINP;
    int tlo, thi, tst; tile_rounds((T / 256) * (DINP / 256), tlo, thi, tst);
    gemm_t8<true, false, true>(W8, XQP / 2, DINP, XQb, XQP / 2, D / 2, tlo, thi, tst, [&](int t, int n, const float4& v, const float4&) {
        const int nb = __builtin_amdgcn_readfirstlane(n);
        if (nb < C_KR) {
            uint2 o; o.x = cvtpk(v.x, v.y); o.y = cvtpk(v.z, v.w);
            *(uint2*)(PROJ + (size_t)t * DINP + n) = o;
            if (nb >= C_CQ) {
                float q = v.x * v.x + v.y * v.y + v.z * v.z + v.w * v.w;
                q += __shfl_xor(q, 1, 64); q += __shfl_xor(q, 2, 64); q += __shfl_xor(q, 4, 64); q += __shfl_xor(q, 8, 64);
                if (n == nb) SSQ[(size_t)t * 16 + ((nb - C_CQ) >> 6)] = q;
            }
        } else if (nb == C_KR) {
            const float4 up = make_float4(__shfl(v.x, lane + 4, 64), __shfl(v.y, lane + 4, 64), __shfl(v.z, lane + 4, 64), __shfl(v.w, lane + 4, 64));
            const float4 dn = make_float4(__shfl(v.x, lane - 4, 64), __shfl(v.y, lane - 4, 64), __shfl(v.z, lane - 4, 64), __shfl(v.w, lane - 4, 64));
            const int d = n - C_KR;
            if (d < 32) {
                const int b = t / S, s = t % S;
                const bool first = d < 16;
                const int f = first ? d : (d - 16);
                const float4 cs0 = *(const float4*)(rope + ((size_t)s * 16 + f) * 2), cs1 = *(const float4*)(rope + ((size_t)s * 16 + f) * 2 + 4);
                float4 o;
                if (first) o = make_float4(v.x * cs0.x - up.x * cs0.y, v.y * cs0.z - up.y * cs0.w, v.z * cs1.x - up.z * cs1.y, v.w * cs1.z - up.w * cs1.w);
                else       o = make_float4(v.x * cs0.x + dn.x * cs0.y, v.y * cs0.z + dn.y * cs0.w, v.z * cs1.x + dn.z * cs1.y, v.w * cs1.z + dn.w * cs1.w);
                uint2 u; u.x = cvtpk(o.x, o.y); u.y = cvtpk(o.z, o.w);
#pragma unroll
                for (int h = 0; h < NH; ++h) *(uint2*)(Kb + ((size_t)(b * NH + h) * S + s) * DQK + 64 + d) = u;
            }
        }
    }, [&](int t) { return XSc[t]; }, [](int, int) { return make_float4(0.f, 0.f, 0.f, 0.f); }, [&](int n) { return *(const float4*)(WIS + n); }, lds);
}
__device__ __forceinline__ void phase_gemm2(const Params& P, int l, char* lds) {
    unsigned char* ws = P.ws;
    const bf16* PROJ = (const bf16*)(ws + WS_PROJ);
    const float* rope = (const float*)(ws + WS_ROPE);
    const float* SSQ = (const float*)(ws + WS_SSQ);
    const int G = gridDim.x, bid = blockIdx.x;
    const int vb = ((G & 7) == 0) ? ((bid & 7) * (G >> 3) + (bid >> 3)) : bid;
    int qlo, qhi, klo, khi;
    if ((G & 1) == 0) {
        const int Gh = G >> 1, pq = (384 + Gh - 1) / Gh, pk = (512 + Gh - 1) / Gh;
        if (vb < Gh) { qlo = vb * pq; qhi = qlo + pq; if (qhi > 384) qhi = 384; if (qlo > 384) qlo = 384; klo = 0; khi = 0; }
        else { klo = (vb - Gh) * pk; khi = klo + pk; if (khi > 512) khi = 512; if (klo > 512) klo = 512; qlo = 0; qhi = 0; }
    } else { tile_range(384, qlo, qhi); tile_range(512, klo, khi); }
    {
        const bf16* W = (const bf16*)(ws + WS_WUQ) + (size_t)l * 768 * QR;
        bf16* Qb = (bf16*)(ws + WS_Q);
        gemm_t8<true, false, false>(W, QR, 768, PROJ + C_CQ, DINP, QR, qlo, qhi, 1,
            [&](int t, int n, const float4& v, const float4&) {
                const int b = t / S, s = t % S, h = n / DQK, d = n % DQK;
                float4 o = v;
                const int lane = tidx() & 63;
                const float4 up = make_float4(__shfl(v.x, lane + 4, 64), __shfl(v.y, lane + 4, 64), __shfl(v.z, lane + 4, 64), __shfl(v.w, lane + 4, 64));
                const float4 dn = make_float4(__shfl(v.x, lane - 4, 64), __shfl(v.y, lane - 4, 64), __shfl(v.z, lane - 4, 64), __shfl(v.w, lane - 4, 64));
                if (d >= 64) {
                    const bool first = d < 80;
                    const int f = first ? (d - 64) : (d - 80);
                    const float4 cs0 = *(const float4*)(rope + ((size_t)s * 16 + f) * 2), cs1 = *(const float4*)(rope + ((size_t)s * 16 + f) * 2 + 4);
                    if (first) o = make_float4(v.x * cs0.x - up.x * cs0.y, v.y * cs0.z - up.y * cs0.w, v.z * cs1.x - up.z * cs1.y, v.w * cs1.z - up.w * cs1.w);
                    else       o = make_float4(v.x * cs0.x + dn.x * cs0.y, v.y * cs0.z + dn.y * cs0.w, v.z * cs1.x + dn.z * cs1.y, v.w * cs1.z + dn.w * cs1.w);
                }
                uint2 u; u.x = cvtpk(o.x, o.y); u.y = cvtpk(o.z, o.w);
                *(uint2*)(Qb + ((size_t)(b * NH + h) * S + s) * DQK + d) = u;
            }, [&](int t) { const float4 a = *(const float4*)(SSQ + (size_t)t * 16); const float2 b = *(const float2*)(SSQ + (size_t)t * 16 + 4);
                            return rsqrtf(((a.x + a.y) + (a.z + a.w) + (b.x + b.y)) * (1.f / QR) + EPS) * QSCALE; }, [](int, int) { return make_float4(0.f, 0.f, 0.f, 0.f); }, [](int) { return make_float4(1.f, 1.f, 1.f, 1.f); }, lds);
    }
    {
        const bf16* W = (const bf16*)(ws + WS_WUKV) + (size_t)l * 1024 * KVR;
        bf16* Kb = (bf16*)(ws + WS_K); bf16* Vb = (bf16*)(ws + WS_V);
        gemm_t8<true, false, false>(W, KVR, 1024, PROJ + C_CKV, DINP, KVR, klo, khi, 1,
            [&](int t, int n, const float4& v, const float4&) {
                const int b = t / S, s = t % S;
                uint2 u; u.x = cvtpk(v.x, v.y); u.y = cvtpk(v.z, v.w);
                if (n < 512) *(uint2*)(Kb + ((size_t)(b * NH + (n >> 6)) * S + s) * DQK + (n & 63)) = u;
                else         *(uint2*)(Vb + ((size_t)(b * NH + ((n - 512) >> 6)) * S + s) * DV + (n & 63)) = u;
            }, [&](int t) { const float2 a = *(const float2*)(SSQ + (size_t)t * 16 + 6); const float2 b = *(const float2*)(SSQ + (size_t)t * 16 + 8);
                            return rsqrtf(((a.x + a.y) + (b.x + b.y)) * (1.f / KVR) + EPS); }, [](int, int) { return make_float4(0.f, 0.f, 0.f, 0.f); }, [](int) { return make_float4(1.f, 1.f, 1.f, 1.f); }, lds);
    }
}
constexpr size_t WS_YO = WS_PROJ;
__device__ __forceinline__ void phase_gemm3(const Params& P, int l, char* lds) {
    unsigned char* ws = P.ws;
    const bf16* Yb = (const bf16*)(ws + WS_XN);
    const bf16* W = (const bf16*)(ws + WS_WOUT) + (size_t)l * D * LDW;
    bf16* YO = (bf16*)(ws + WS_YO);
    int tlo, thi, tst; tile_rounds((T / 256) * (D / 256), tlo, thi, tst);
    gemm_t8<false, false, false>(W, LDW, D, Yb, LDX, D, tlo, thi, tst, [&](int t, int n, const float4& v, const float4&) {
        uint2 o; o.x = cvtpk(v.x, v.y); o.y = cvtpk(v.z, v.w);
        *(uint2*)(YO + (size_t)t * D + n) = o;
    }, [](int) { return 1.f; }, [](int, int) { return make_float4(0.f, 0.f, 0.f, 0.f); }, [](int) { return make_float4(1.f, 1.f, 1.f, 1.f); }, lds);
}

#define GSYNC() do { XcdBarrier xb_; { __attribute__((address_space(1))) char* gp_ = (__attribute__((address_space(1))) char*)(char*)(P.ws + WS_CTL); asm volatile("" : "+s"(gp_)); xb_.bar = (unsigned*)(char*)gp_; } \
    xb_.x = xb_xcc_id(); xb_.st = (volatile LAS unsigned*)&xb_words; xcd_barrier(xb_); } while (0)
#define PHASE(stmt) { const Params Q = launder(P); stmt; }
__global__ void __launch_bounds__(NTHREADS, 2) k_all(Params P) {
    __shared__ __attribute__((aligned(16))) char sm[LDS_TOTAL];
    __shared__ uint4 xb_words;
    cg::grid_group grid = cg::this_grid();
    if (__builtin_amdgcn_workitem_id_x() == 0) xb_words = make_uint4(0u, 0u, 0u, 0u);
    __syncthreads();
    (void)xcd_barrier_post((unsigned*)(P.ws + WS_CTL), (volatile LAS unsigned*)&xb_words);
    __shared__ int xinfo[8];
    if (__builtin_amdgcn_workitem_id_x() == 0) {
        const unsigned x = xb_xcc_id();
        xinfo[XI_X] = (int)x; xinfo[XI_RANK] = (int)xb_add((unsigned*)(P.ws + WS_CTL) + CTL_CENSUS + x, 1u);
    }
    PHASE(phase_prep(Q, sm));
    if (P.ws == nullptr) grid.sync();
    GSYNC();
    PHASE(phase_norm(Q.x, Q.norm_mix, (unsigned*)(Q.ws + WS_XQ), (float*)(Q.ws + WS_XS)));
    PHASE(quant_wrows((const bf16*)(Q.ws + WS_WPQ), DEPTH * 2048, Q.ws + WS_WC8, (float*)(Q.ws + WS_WCS)));
    PHASE(quant_wrows((const bf16*)(Q.ws + WS_WIN), DEPTH * DINP, Q.ws + WS_WI8, (float*)(Q.ws + WS_WIS)));
    GSYNC();
    if (__builtin_amdgcn_workitem_id_x() == 0) {
        unsigned* cen = (unsigned*)(P.ws + WS_CTL) + CTL_CENSUS;
        const int x = xinfo[XI_X]; int nx = 0, jj = 0;
        for (int q = 0; q < 16; ++q) { const unsigned cq = xb_ld(cen + q); if (cq) { if (q < x) ++jj; ++nx; } }
        xinfo[XI_J] = jj; xinfo[XI_NX] = nx; xinfo[XI_NLOC] = (int)xb_ld(cen + x);
    }
    __syncthreads();
    for (int l = 0; l < DEPTH; ++l) {
        PHASE(phase_gemm1(Q, l, sm));
#if PROBE_DUP & 2
        PHASE(phase_gemm1(Q, l, sm));
#endif
        GSYNC();
        PHASE(phase_mixlocal(Q, l, sm));
#if PROBE_DUP & 256
        PHASE(phase_mixlocal(Q, l, sm));
#endif
        PHASE(phase_gemm2(Q, l, sm));
#if PROBE_DUP & 4
        PHASE(phase_gemm2(Q, l, sm));
#endif
        GSYNC();
        PHASE(phase_attn(Q, sm));
#if PROBE_DUP & 8
        PHASE(phase_attn(Q, sm));
#endif
        GSYNC();
        PHASE(phase_gemm3(Q, l, sm));
#if PROBE_DUP & 16
        if (l == 0) PHASE(phase_gemm3(Q, l, sm));
#endif
        GSYNC();
        PHASE(phase_norm_q(Q, l));
#if PROBE_DUP & 512
        PHASE(phase_norm_q(Q, l));
#endif
        GSYNC();
        PHASE(phase_route(Q, l, sm));
#if PROBE_DUP & 32
        PHASE(phase_route(Q, l, sm));
#endif
        GSYNC();
        PHASE(phase_gu(Q, l, xinfo));
#if PROBE_DUP & 64
        PHASE(phase_gu(Q, l, xinfo));
#endif
        GSYNC();
        PHASE(phase_gw(Q, l));
#if PROBE_DUP & 128
        PHASE(phase_gw(Q, l));
#endif
        GSYNC();
        PHASE(phase_gv(Q, l, xinfo, sm));
        GSYNC();
        PHASE(phase_gnorm(Q, l));
        GSYNC();
    }
}

extern "C" void kernel_launch(void* const* d_in, const int* in_sizes, int n_in, void* d_out, int out_size, void* d_ws, size_t ws_size, hipStream_t stream) {
    static int grid = 0;
    if (grid == 0) {
        if (n_in != 18 || out_size != T * D || ws_size < WS_END) { fprintf(stderr, "kernel_launch: bad sizes n_in %d out %d ws %zu need %zu\n", n_in, out_size, ws_size, (size_t)WS_END); grid = -1; return; }
        int dev = 0, cus = 0, per_cu = 0;
        (void)hipGetDevice(&dev);
        (void)hipDeviceGetAttribute(&cus, hipDeviceAttributeMultiprocessorCount, dev);
        (void)hipOccupancyMaxActiveBlocksPerMultiprocessor(&per_cu, (const void*)k_all, NTHREADS, 0);
        if (per_cu > 1) per_cu = 1;
        if (per_cu < 1) { fprintf(stderr, "kernel_launch: occupancy query says %d\n", per_cu); grid = -1; return; }
        grid = cus * per_cu;
    }
    if (grid < 0) return;
    Params p{};
    p.x = (const float*)d_in[0]; p.norm_mix = (const float*)d_in[1]; p.w_in = (const float*)d_in[2]; p.conv_w = (const float*)d_in[3];
    p.pool_w = (const float*)d_in[4]; p.pool_scale = (const float*)d_in[5]; p.q_norm = (const float*)d_in[6]; p.w_uq = (const float*)d_in[7];
    p.kv_norm = (const float*)d_in[8]; p.w_uk = (const float*)d_in[9]; p.w_uv = (const float*)d_in[10]; p.w_out = (const float*)d_in[11];
    p.norm_ffn = (const float*)d_in[12]; p.peer_wq = (const float*)d_in[13]; p.peer_subkeys = (const float*)d_in[14]; p.peer_u = (const float*)d_in[15];
    p.peer_v = (const float*)d_in[16]; p.norm_final = (const float*)d_in[17];
    p.out = (float*)d_out; p.ws = (unsigned char*)d_ws;
    if (hipMemsetAsync((char*)d_ws + WS_CTL, 0, CTL_BYTES, stream) != hipSuccess) { fprintf(stderr, "kernel_launch: memset failed\n"); return; }
    void* args[] = {&p};
    hipError_t e = hipLaunchCooperativeKernel((const void*)k_all, dim3(grid), dim3(NTHREADS), args, 0, stream);
    if (e != hipSuccess) fprintf(stderr, "cooperative launch failed: %s (grid %d)\n", hipGetErrorString(e), grid);
}
```

```cpp
#include <hip/hip_runtime.h>
#include <type_traits>
#include <hip/hip_cooperative_groups.h>
#include <cstdio>
#include <cstdint>
namespace cg = cooperative_groups;

#ifndef TAB_FP8
#define TAB_FP8 1
#endif
#ifndef PROBE_DUP
#define PROBE_DUP 0
#endif

constexpr int NB = 4, S = 8192, T = NB * S, D = 1024, DEPTH = 2;
constexpr int DIN = 1696, DINP = 1792;
constexpr int C_BG = 0, C_CG = 256, C_HC = 512, C_HP = 768, C_CQ = 1024, C_CKV = 1408, C_KR = 1664;
constexpr int QR = 384, KVR = 256, NH = 8, DQK = 96, DV = 64;
constexpr int PH = 8, NKEY = 128, NEXP = NKEY * NKEY, TOPK = 16, HK = PH * TOPK;
constexpr float EPS = 1e-6f;
constexpr int LDX = 1088;
constexpr int LDW = 1088;

typedef unsigned short bf16;
constexpr int HP = 2 * D;

constexpr size_t WS_CTL   = 0;
constexpr size_t WS_ROPE  = 64 * 1024;
constexpr size_t WS_WIN   = WS_ROPE + (size_t)S * 16 * 2 * 4;
constexpr size_t WS_WUQ   = WS_WIN + (size_t)DEPTH * DINP * LDW * 2;
constexpr size_t WS_WUKV  = WS_WUQ + (size_t)DEPTH * 768 * QR * 2;
constexpr size_t WS_WOUT  = WS_WUKV + (size_t)DEPTH * 1024 * KVR * 2;
constexpr size_t WS_WPQ   = WS_WOUT + (size_t)DEPTH * D * LDW * 2;
constexpr size_t WS_XN    = ((WS_WPQ + (size_t)DEPTH * 2048 * LDW * 2 + 4095) / 4096) * 4096;
constexpr size_t WS_PROJ  = WS_XN + (size_t)T * LDX * 2;
constexpr size_t WS_Q     = WS_PROJ + (size_t)T * DINP * 2;
constexpr size_t WS_K     = WS_Q + (size_t)T * NH * DQK * 2;
constexpr size_t WS_V     = WS_K + (size_t)T * NH * DQK * 2;
constexpr size_t WS_EXP   = WS_V + (size_t)T * NH * DV * 2;
constexpr size_t WS_GATE  = WS_EXP + (size_t)T * HK * 4;
constexpr size_t TAB_ROWB = TAB_FP8 ? 1024 : 2048;
constexpr size_t WS_TABU  = WS_GATE + (size_t)T * HK * 4;
constexpr size_t WS_TABV  = WS_TABU + (size_t)DEPTH * NEXP * TAB_ROWB;
constexpr size_t WS_TSCU  = WS_TABV + (size_t)DEPTH * NEXP * TAB_ROWB;
constexpr size_t WS_TSCV  = WS_TSCU + (size_t)DEPTH * NEXP * 4;
constexpr size_t WS_XQ    = WS_TSCV + (size_t)DEPTH * NEXP * 4;
constexpr int XQP = 1088;
constexpr size_t WS_XS    = WS_XQ + (size_t)T * XQP;
constexpr size_t WS_WQ8   = WS_XS + (size_t)T * 4;
constexpr size_t WS_WSC   = WS_WQ8 + (size_t)T * HK;
constexpr size_t WS_SSQ   = WS_WSC + (size_t)T * 4;
constexpr size_t WS_WC8   = WS_SSQ + (size_t)T * 64;
constexpr size_t WS_WCS   = WS_WC8 + (size_t)DEPTH * 2048 * XQP;
constexpr size_t WS_WI8   = WS_WCS + (size_t)DEPTH * 2048 * 4;
constexpr size_t WS_WIS   = WS_WI8 + (size_t)DEPTH * DINP * XQP;
constexpr size_t WS_END   = WS_WIS + (size_t)DEPTH * DINP * 4;
static_assert(WS_END <= (size_t)512 * 1024 * 1024, "workspace budget");

struct Params {
    const float* x; const float* norm_mix; const float* w_in; const float* conv_w; const float* pool_w; const float* pool_scale;
    const float* q_norm; const float* w_uq; const float* kv_norm; const float* w_uk; const float* w_uv; const float* w_out;
    const float* norm_ffn; const float* peer_wq; const float* peer_subkeys; const float* peer_u; const float* peer_v; const float* norm_final;
    float* out; unsigned char* ws;
};

__device__ __forceinline__ bf16 f2bf(float f) { unsigned u = __float_as_uint(f); u += 0x7fffu + ((u >> 16) & 1u); return (bf16)(u >> 16); }
__device__ __forceinline__ float bf2f(bf16 h) { return __uint_as_float(((unsigned)h) << 16); }
__device__ __forceinline__ float bflo(unsigned u) { return __uint_as_float(u << 16); }
__device__ __forceinline__ float bfhi(unsigned u) { return __uint_as_float(u & 0xffff0000u); }
__device__ __forceinline__ unsigned pack2(float a, float b) { return (unsigned)f2bf(a) | ((unsigned)f2bf(b) << 16); }
__device__ __forceinline__ float wave_sum(float v) {
#pragma unroll
    for (int m = 32; m >= 1; m >>= 1) v += __shfl_xor(v, m, 64);
    return v;
}
__device__ __forceinline__ float gelu_exact(float x) { return 0.5f * x * (1.f + erff(x * 0.70710678118654752f)); }

#define NTHREADS 512
constexpr int NW = NTHREADS / 64;
__device__ __forceinline__ int tidx() { int t = (int)__builtin_amdgcn_workitem_id_x(); asm volatile("" : "+v"(t)); return t; }
__device__ __forceinline__ int gwave() { return blockIdx.x * (NTHREADS / 64) + (tidx() >> 6); }
__device__ __forceinline__ int nwave() { return gridDim.x * (NTHREADS / 64); }
__device__ __forceinline__ size_t gtid() { return (size_t)blockIdx.x * NTHREADS + tidx(); }
__device__ __forceinline__ size_t gnth() { return (size_t)gridDim.x * NTHREADS; }


__device__ __forceinline__ Params launder(const Params& P) {
    typedef __attribute__((address_space(1))) char* gp_t;
    gp_t g[20] = {(gp_t)(char*)P.x, (gp_t)(char*)P.norm_mix, (gp_t)(char*)P.w_in, (gp_t)(char*)P.conv_w, (gp_t)(char*)P.pool_w, (gp_t)(char*)P.pool_scale, (gp_t)(char*)P.q_norm, (gp_t)(char*)P.w_uq,
                  (gp_t)(char*)P.kv_norm, (gp_t)(char*)P.w_uk, (gp_t)(char*)P.w_uv, (gp_t)(char*)P.w_out, (gp_t)(char*)P.norm_ffn, (gp_t)(char*)P.peer_wq, (gp_t)(char*)P.peer_subkeys,
                  (gp_t)(char*)P.peer_u, (gp_t)(char*)P.peer_v, (gp_t)(char*)P.norm_final, (gp_t)(char*)P.out, (gp_t)(char*)P.ws};
    asm volatile("" : "+s"(g[0]), "+s"(g[1]), "+s"(g[2]), "+s"(g[3]), "+s"(g[4]), "+s"(g[5]), "+s"(g[6]), "+s"(g[7]), "+s"(g[8]), "+s"(g[9]));
    asm volatile("" : "+s"(g[10]), "+s"(g[11]), "+s"(g[12]), "+s"(g[13]), "+s"(g[14]), "+s"(g[15]), "+s"(g[16]), "+s"(g[17]), "+s"(g[18]), "+s"(g[19]));
    Params Q;
    Q.x = (const float*)(char*)g[0]; Q.norm_mix = (const float*)(char*)g[1]; Q.w_in = (const float*)(char*)g[2]; Q.conv_w = (const float*)(char*)g[3]; Q.pool_w = (const float*)(char*)g[4];
    Q.pool_scale = (const float*)(char*)g[5]; Q.q_norm = (const float*)(char*)g[6]; Q.w_uq = (const float*)(char*)g[7]; Q.kv_norm = (const float*)(char*)g[8]; Q.w_uk = (const float*)(char*)g[9];
    Q.w_uv = (const float*)(char*)g[10]; Q.w_out = (const float*)(char*)g[11]; Q.norm_ffn = (const float*)(char*)g[12]; Q.peer_wq = (const float*)(char*)g[13]; Q.peer_subkeys = (const float*)(char*)g[14];
    Q.peer_u = (const float*)(char*)g[15]; Q.peer_v = (const float*)(char*)g[16]; Q.norm_final = (const float*)(char*)g[17]; Q.out = (float*)(char*)g[18]; Q.ws = (unsigned char*)(char*)g[19];
    return Q;
}

typedef __attribute__((ext_vector_type(8))) short bf16x8;
typedef __attribute__((ext_vector_type(16))) float f32x16;
typedef __attribute__((ext_vector_type(2))) __bf16 bf2_t;
#define MFMA32(a, b, c) __builtin_amdgcn_mfma_f32_32x32x16_bf16(a, b, c, 0, 0, 0)
__device__ __forceinline__ int crow(int r, int hi) { return (r & 3) + 8 * (r >> 2) + 4 * hi; }
__device__ __forceinline__ float dot2bf(unsigned a, unsigned b, float c) { return __builtin_amdgcn_fdot2_f32_bf16(__builtin_bit_cast(bf2_t, a), __builtin_bit_cast(bf2_t, b), c, false); }
__device__ __forceinline__ unsigned cvtpk(float lo, float hi) { unsigned r; asm("v_cvt_pk_bf16_f32 %0, %1, %2" : "=v"(r) : "v"(lo), "v"(hi)); return r; }
constexpr int LDS_TOTAL = 140 * 1024;

template <int WT, bool ROWSS>
__device__ __forceinline__ void gemm_kloop(const bf16* __restrict__ Ag0, int lda, const bf16* __restrict__ Bg0, int ldb, int nk, f32x16 (&acc)[8], float (&ss)[4], char* lds, int tid) {
    constexpr int BROWS = (WT == 0) ? 256 : 128, NPB = BROWS / 64;
    constexpr int OPA = 256 * 128, G_BUF = OPA + BROWS * 128;
    const int lane = tid & 63, w = __builtin_amdgcn_readfirstlane(tid >> 6), r32 = lane & 31, hi = lane >> 5;
    const int srow = 8 * w + (lane >> 3);
    const int sch = (lane & 7) ^ ((srow >> 1) & 7);
    const bf16* Ag = Ag0 + (size_t)srow * lda + sch * 8;
    const bf16* Bg = Bg0 + (size_t)srow * ldb + sch * 8;
#pragma unroll
    for (int i = 0; i < 8; ++i)
#pragma unroll
        for (int r = 0; r < 16; ++r) acc[i][r] = 0.f;
    ss[0] = 0.f; ss[1] = 0.f; ss[2] = 0.f; ss[3] = 0.f;
    typedef __attribute__((address_space(3))) unsigned* ldsp_t;
    typedef const __attribute__((address_space(1))) unsigned* glbp_t;
#define G_DMA(buf, kofs) do { char* d_ = lds + (buf) * G_BUF + (8 * w) * 128; \
    _Pragma("unroll") for (int i = 0; i < 4; ++i) \
        __builtin_amdgcn_global_load_lds((glbp_t)(const void*)(Ag + (size_t)(64 * i) * lda + (kofs)), (ldsp_t)(void*)(d_ + i * 8192), 16, 0, 0); \
    _Pragma("unroll") for (int i = 0; i < NPB; ++i) \
        __builtin_amdgcn_global_load_lds((glbp_t)(const void*)(Bg + (size_t)(64 * i) * ldb + (kofs)), (ldsp_t)(void*)(d_ + OPA + i * 8192), 16, 0, 0); } while (0)
    const int xr = (r32 >> 1) & 7;
    const int o0 = ((0 + hi) ^ xr) << 4, o1 = ((2 + hi) ^ xr) << 4, o2 = ((4 + hi) ^ xr) << 4, o3 = ((6 + hi) ^ xr) << 4;
#define G_SS(s_, r_) do { union { bf16x8 v; uint4 u; } c_; c_.v = r_; s_ = dot2bf(c_.u.x, c_.u.x, s_); s_ = dot2bf(c_.u.y, c_.u.y, s_); s_ = dot2bf(c_.u.z, c_.u.z, s_); s_ = dot2bf(c_.u.w, c_.u.w, s_); } while (0)
#define G_STEP(pa, pb, off) do { \
    if (WT == 0) { \
        const bf16x8 a0 = *(const bf16x8*)(pa + off), a1 = *(const bf16x8*)(pa + 32 * 128 + off); \
        const bf16x8 b0 = *(const bf16x8*)(pb + off), b1 = *(const bf16x8*)(pb + 32 * 128 + off), b2 = *(const bf16x8*)(pb + 64 * 128 + off), b3 = *(const bf16x8*)(pb + 96 * 128 + off); \
        if (ROWSS) { G_SS(ss[0], b0); G_SS(ss[1], b1); G_SS(ss[2], b2); G_SS(ss[3], b3); } \
        acc[0] = MFMA32(a0, b0, acc[0]); acc[1] = MFMA32(a0, b1, acc[1]); acc[2] = MFMA32(a0, b2, acc[2]); acc[3] = MFMA32(a0, b3, acc[3]); \
        acc[4] = MFMA32(a1, b0, acc[4]); acc[5] = MFMA32(a1, b1, acc[5]); acc[6] = MFMA32(a1, b2, acc[6]); acc[7] = MFMA32(a1, b3, acc[7]); \
    } else if (WT == 2) { \
        const bf16x8 a0 = *(const bf16x8*)(pa + off), a1 = *(const bf16x8*)(pa + 32 * 128 + off); \
        const bf16x8 b0 = *(const bf16x8*)(pb + off), b1 = *(const bf16x8*)(pb + 32 * 128 + off); \
        if (ROWSS) { G_SS(ss[0], b0); G_SS(ss[1], b1); } \
        acc[0] = MFMA32(a0, b0, acc[0]); acc[1] = MFMA32(a0, b1, acc[1]); acc[2] = MFMA32(a1, b0, acc[2]); acc[3] = MFMA32(a1, b1, acc[3]); \
    } else { \
        const bf16x8 b0 = *(const bf16x8*)(pb + off); \
        const bf16x8 a0 = *(const bf16x8*)(pa + off), a1 = *(const bf16x8*)(pa + 32 * 128 + off); \
        const bf16x8 a2 = *(const bf16x8*)(pa + 64 * 128 + off), a3 = *(const bf16x8*)(pa + 96 * 128 + off); \
        if (ROWSS) { G_SS(ss[0], b0); } \
        acc[0] = MFMA32(a0, b0, acc[0]); acc[1] = MFMA32(a1, b0, acc[1]); \
        acc[2] = MFMA32(a2, b0, acc[2]); acc[3] = MFMA32(a3, b0, acc[3]); \
    } } while (0)
    const int arow = (WT == 1) ? ((w >> 2) * 128 + r32) : ((w >> 1) * 64 + r32);
    const int brow = (WT == 0) ? ((w & 1) * 128 + r32) : (WT == 2) ? ((w & 1) * 64 + r32) : ((w & 3) * 32 + r32);
    G_DMA(0, 0);
    for (int kt = 0; kt < nk; ++kt) {
        __syncthreads();
        if (kt + 1 < nk) G_DMA((kt + 1) & 1, (kt + 1) * 64);
        const char* pa = lds + (kt & 1) * G_BUF + arow * 128;
        const char* pb = lds + (kt & 1) * G_BUF + OPA + brow * 128;
        G_STEP(pa, pb, o0); G_STEP(pa, pb, o1); G_STEP(pa, pb, o2); G_STEP(pa, pb, o3);
    }
    if (ROWSS) { ss[0] += __shfl_xor(ss[0], 32, 64); ss[1] += __shfl_xor(ss[1], 32, 64); ss[2] += __shfl_xor(ss[2], 32, 64); ss[3] += __shfl_xor(ss[3], 32, 64); }
#undef G_DMA
#undef G_SS
#undef G_STEP
}

__device__ __forceinline__ void tile_range(int ntiles, int& lo, int& hi) {
    const int G = gridDim.x, b = blockIdx.x;
    const int vb = ((G & 7) == 0) ? ((b & 7) * (G >> 3) + (b >> 3)) : b;
    const int per = (ntiles + G - 1) / G;
    lo = vb * per; hi = lo + per; if (hi > ntiles) hi = ntiles;
}
constexpr int ST_P = 68;
static_assert(NW * 64 * ST_P * 4 <= LDS_TOTAL, "staging LDS");
template <bool ROWSS, class EPI, class EPIROW, class RSC>
__device__ __forceinline__ void gemm_t(const bf16* __restrict__ Wt, int ldw, int N, const bf16* __restrict__ X, int ldx, int M, int K, int tn_direct, EPI epi, EPIROW epirow, RSC rowscale, char* lds) {
    const int tid = tidx(), lane = tid & 63, w = tid >> 6, r32 = lane & 31, hi = lane >> 5;
    const int tilesN = N / 256, tilesM = M / 256, nk = K / 64;
    int tlo, thi; tile_range(tilesM * tilesN, tlo, thi);
    for (int tile = tlo; tile < thi; ++tile) {
        const int tm = tile / tilesN, tn = tile % tilesN;
        f32x16 acc[8]; float ss[4];
        gemm_kloop<0, ROWSS>(Wt + (size_t)(tn * 256) * ldw, ldw, X + (size_t)(tm * 256) * ldx, ldx, nk, acc, ss, lds, tid);
        if (tn < tn_direct) {
            __syncthreads();
            float* st = (float*)lds + w * (64 * ST_P);
            const int rr = lane >> 4, ch = lane & 15;
#pragma unroll
            for (int half = 0; half < 2; ++half) {
                const float m0_ = rowscale(ss[2 * half]), m1_ = rowscale(ss[2 * half + 1]);
#pragma unroll
                for (int i = 0; i < 2; ++i)
#pragma unroll
                    for (int jj = 0; jj < 2; ++jj)
#pragma unroll
                        for (int g = 0; g < 4; ++g) {
                            const float mj = jj ? m1_ : m0_;
                            const f32x16& a_ = acc[i * 4 + 2 * half + jj];
                            *(float4*)(st + (32 * jj + r32) * ST_P + 32 * i + 8 * g + 4 * hi) = make_float4(a_[4 * g] * mj, a_[4 * g + 1] * mj, a_[4 * g + 2] * mj, a_[4 * g + 3] * mj);
                        }
#pragma unroll 2
                for (int it = 0; it < 16; ++it) {
                    const int row = it * 4 + rr;
                    const float4 v = *(const float4*)(st + row * ST_P + ch * 4);
                    epirow(tm * 256 + (w & 1) * 128 + half * 64 + row, tn * 256 + (w >> 1) * 64 + ch * 4, v);
                }
            }
        } else {
#pragma unroll
            for (int i = 0; i < 2; ++i)
#pragma unroll
                for (int j = 0; j < 4; ++j)
                    epi(tn * 256 + (w >> 1) * 64 + i * 32, tm * 256 + (w & 1) * 128 + j * 32, acc[i * 4 + j], r32, hi, ss[j]);
        }
        __syncthreads();
    }
}

constexpr int ST1_P = 132;
static_assert(NW * 32 * ST1_P * 4 <= LDS_TOTAL, "staging LDS (128 x 32 wave tiles)");
template <class EPIROW, class RSC>
__device__ __forceinline__ void gemm_t1(const bf16* __restrict__ Wt, int ldw, int N, const bf16* __restrict__ X, int ldx, int M, int K, EPIROW epirow, RSC rowscale, char* lds) {
    const int tid = tidx(), lane = tid & 63, w = tid >> 6, r32 = lane & 31, hi = lane >> 5;
    const int tilesN = N / 256, tilesM = M / 128, nk = K / 64;
    int tlo, thi; tile_range(tilesM * tilesN, tlo, thi);
    for (int tile = tlo; tile < thi; ++tile) {
        const int tm = tile / tilesN, tn = tile % tilesN;
        f32x16 acc[8]; float ss[4];
        gemm_kloop<1, true>(Wt + (size_t)(tn * 256) * ldw, ldw, X + (size_t)(tm * 128) * ldx, ldx, nk, acc, ss, lds, tid);
        __syncthreads();
        float* st = (float*)lds + w * (32 * ST1_P);
        const float mj = rowscale(ss[0]);
#pragma unroll
        for (int mt = 0; mt < 4; ++mt)
#pragma unroll
            for (int g = 0; g < 4; ++g)
                *(float4*)(st + r32 * ST1_P + 32 * mt + 8 * g + 4 * hi) = make_float4(acc[mt][4 * g] * mj, acc[mt][4 * g + 1] * mj, acc[mt][4 * g + 2] * mj, acc[mt][4 * g + 3] * mj);
#pragma unroll 2
        for (int it = 0; it < 16; ++it) {
            const int row = it * 2 + hi;
            const float4 v = *(const float4*)(st + row * ST1_P + r32 * 4);
            epirow(tm * 128 + (w & 3) * 32 + row, tn * 256 + (w >> 2) * 128 + r32 * 4, v);
        }
        __syncthreads();
    }
}

template <class EPIROW>
__device__ __forceinline__ void gemm_t2(const bf16* __restrict__ Wt, int ldw, int N, const bf16* __restrict__ X, int ldx, int M, int K, EPIROW epirow, char* lds) {
    const int tid = tidx(), lane = tid & 63, w = tid >> 6, r32 = lane & 31, hi = lane >> 5;
    const int tilesN = N / 256, tilesM = M / 128, nk = K / 64;
    int tlo, thi; tile_range(tilesM * tilesN, tlo, thi);
    for (int tile = tlo; tile < thi; ++tile) {
        const int tm = tile / tilesN, tn = tile % tilesN;
        f32x16 acc[8]; float ss[4];
        gemm_kloop<2, false>(Wt + (size_t)(tn * 256) * ldw, ldw, X + (size_t)(tm * 128) * ldx, ldx, nk, acc, ss, lds, tid);
        __syncthreads();
        float* st = (float*)lds + w * (64 * ST_P);
#pragma unroll
        for (int i = 0; i < 2; ++i)
#pragma unroll
            for (int j = 0; j < 2; ++j)
#pragma unroll
                for (int g = 0; g < 4; ++g)
                    *(float4*)(st + (32 * j + r32) * ST_P + 32 * i + 8 * g + 4 * hi) = make_float4(acc[i * 2 + j][4 * g], acc[i * 2 + j][4 * g + 1], acc[i * 2 + j][4 * g + 2], acc[i * 2 + j][4 * g + 3]);
        const int rr = lane >> 4, ch = lane & 15;
#pragma unroll 4
        for (int it = 0; it < 16; ++it) {
            const int row = it * 4 + rr;
            const float4 v = *(const float4*)(st + row * ST_P + ch * 4);
            epirow(tm * 128 + (w & 1) * 64 + row, tn * 256 + (w >> 1) * 64 + ch * 4, v);
        }
        __syncthreads();
    }
}

typedef __attribute__((ext_vector_type(4))) float f32x4;
constexpr int G8_HT = 128 * 64;
__device__ __forceinline__ int g8_lds_byte(int r, int c) {
    const int st = (r >> 4) * 2 + (c >> 5), rr = r & 15, cc = c & 31, ob = rr * 64 + cc * 2;
    return st * 1024 + (ob ^ (((ob >> 9) & 1) << 5));
}
__device__ __forceinline__ void g8_stage_rc(int b, int& R, int& C) {
    const int st = b / 1024, sb = b % 1024, swz = sb ^ (((sb >> 9) & 1) << 5);
    R = (st >> 1) * 16 + swz / 64; C = (st & 1) * 32 + (swz % 64) / 2;
}
__device__ __forceinline__ float ssq8(const bf16x8& v, float s) {
    union { bf16x8 v; uint4 u; } c_; c_.v = v;
    s = dot2bf(c_.u.x, c_.u.x, s); s = dot2bf(c_.u.y, c_.u.y, s); s = dot2bf(c_.u.z, c_.u.z, s); return dot2bf(c_.u.w, c_.u.w, s);
}
typedef __attribute__((ext_vector_type(4))) int i32x4;
__device__ __forceinline__ f32x4 mma8(const bf16x8& a, const bf16x8& b, const f32x4& c) { return __builtin_amdgcn_mfma_f32_16x16x32_bf16(a, b, c, 0, 0, 0); }
__device__ __forceinline__ i32x4 mma8(const bf16x8& a, const bf16x8& b, const i32x4& c) { return __builtin_amdgcn_mfma_i32_16x16x64_i8(__builtin_bit_cast(i32x4, a), __builtin_bit_cast(i32x4, b), c, 0, 0, 0); }
template <bool ROWSS, bool APERM = false, class ACC = f32x4>
__device__ __forceinline__ void gemm8_kloop(const bf16* __restrict__ A, int lda, const bf16* __restrict__ Bt, int ldb, int nt, ACC (&acc)[2][2][4][2], float (&ss)[2][2], char* lds, int tid) {
    bf16* shm = (bf16*)lds;
    typedef __attribute__((address_space(3))) unsigned* ldsp_t;
    typedef const __attribute__((address_space(1))) unsigned* glbp_t;
#define SA(b, h) (shm + ((b) * 2 + (h)) * G8_HT)
#define SB(b, h) (shm + (4 + (b) * 2 + (h)) * G8_HT)
    int sr0, sc0; g8_stage_rc(tid * 16, sr0, sc0);
    const unsigned voa = (unsigned)((sr0 * lda + sc0) * 2), vob = (unsigned)((sr0 * ldb + sc0) * 2);
    const char* Ap = (const char*)A; const char* Bp = (const char*)Bt;
    const int wbase = __builtin_amdgcn_readfirstlane(tid >> 6) * 1024;
#define STAGE_(P, BASE, VO, LD, br, r2, kt) do { const char* g_ = BASE + ((size_t)(br) * LD + (kt) * 64) * 2; \
    __builtin_amdgcn_global_load_lds((glbp_t)(const void*)(g_ + VO), (ldsp_t)(void*)((char*)(P) + wbase), 16, 0, 0); \
    __builtin_amdgcn_global_load_lds((glbp_t)(const void*)(g_ + (size_t)(2 * (r2)) * LD + VO), (ldsp_t)(void*)((char*)(P) + wbase + 8192), 16, 0, 0); } while (0)
#define STAGEA(b, h, kt) STAGE_(SA(b, h), Ap, voa, lda, (APERM ? (h) * 64 : (h) * 128), (APERM ? 128 : 64), kt)
#define STAGEB(b, h, kt) STAGE_(SB(b, h), Bp, vob, ldb, (h) * 128, 64, kt)
    const int lane = tid & 63, wid = tid >> 6, wr = wid >> 2, wc = wid & 3, fr = lane & 15, fq = lane >> 4;
    int abase, bbase;
    { const int ob = fr * 64 + fq * 16, lp = ob ^ (((ob >> 9) & 1) << 5);
      abase = lp + wr * 8192; bbase = lp + wc * 4096 + 4 * G8_HT * 2;
      asm volatile("" : "+v"(abase), "+v"(bbase)); }
#define LDA(dst, b, h) _Pragma("unroll") for (int m = 0; m < 4; ++m) _Pragma("unroll") for (int k = 0; k < 2; ++k) \
    dst[m][k] = *reinterpret_cast<const bf16x8*>(lds + abase + (((b) * 2 + (h)) * G8_HT * 2 + m * 2048 + k * 1024))
#define LDB(dst, b, h) _Pragma("unroll") for (int n = 0; n < 2; ++n) _Pragma("unroll") for (int k = 0; k < 2; ++k) \
    dst[n][k] = *reinterpret_cast<const bf16x8*>(lds + bbase + (((b) * 2 + (h)) * G8_HT * 2 + n * 2048 + k * 1024))
#define MMA(ai, bj, At_, Bt_) do { __builtin_amdgcn_s_setprio(1); \
    _Pragma("unroll") for (int m = 0; m < 4; ++m) _Pragma("unroll") for (int n = 0; n < 2; ++n) _Pragma("unroll") for (int k = 0; k < 2; ++k) \
        acc[ai][bj][m][n] = mma8(At_[m][k], Bt_[n][k], acc[ai][bj][m][n]); \
    __builtin_amdgcn_s_setprio(0); } while (0)
#define SSQ(bj, Bt_) do { if (ROWSS) { _Pragma("unroll") for (int n = 0; n < 2; ++n) { ss[bj][n] = ssq8(Bt_[n][0], ss[bj][n]); ss[bj][n] = ssq8(Bt_[n][1], ss[bj][n]); } } } while (0)
#define WAIT_V(n) asm volatile("s_waitcnt vmcnt(" #n ")" ::: "memory")
#define WAIT_L(n) asm volatile("s_waitcnt lgkmcnt(" #n ")" ::: "memory")
#define BAR __builtin_amdgcn_s_barrier()
#define SCHED __builtin_amdgcn_sched_barrier(0)
#pragma unroll
    for (int a = 0; a < 2; ++a)
#pragma unroll
        for (int b = 0; b < 2; ++b)
#pragma unroll
            for (int m = 0; m < 4; ++m)
#pragma unroll
                for (int n = 0; n < 2; ++n) acc[a][b][m][n] = ACC{0, 0, 0, 0};
    ss[0][0] = 0.f; ss[0][1] = 0.f; ss[1][0] = 0.f; ss[1][1] = 0.f;
    bf16x8 At[4][2], B0[2][2], B1[2][2];
    STAGEB(0, 0, 0); STAGEA(0, 0, 0);
    STAGEB(0, 1, 0); STAGEA(0, 1, 0);
    if (wr == 1) BAR;
    WAIT_V(4); BAR;
    STAGEB(1, 0, 1); STAGEA(1, 0, 1); STAGEB(1, 1, 1);
    WAIT_V(6); BAR;
    for (int t = 0; t < nt - 2; t += 2) {
        LDB(B0, 0, 0); SCHED; LDA(At, 0, 0); STAGEA(1, 1, t + 1);
        WAIT_L(8); BAR; WAIT_L(0); MMA(0, 0, At, B0); SSQ(0, B0); BAR; SCHED;
        LDB(B1, 0, 1); STAGEB(0, 0, t + 2);
        BAR; WAIT_L(0); MMA(0, 1, At, B1); SSQ(1, B1); BAR;
        LDA(At, 0, 1); STAGEA(0, 0, t + 2);
        BAR; WAIT_L(0); MMA(1, 0, At, B0); BAR; SCHED;
        STAGEB(0, 1, t + 2);
        WAIT_V(6); BAR; MMA(1, 1, At, B1); BAR;
        LDB(B0, 1, 0); SCHED; LDA(At, 1, 0); STAGEA(0, 1, t + 2);
        WAIT_L(8); BAR; WAIT_L(0); MMA(0, 0, At, B0); SSQ(0, B0); BAR; SCHED;
        LDB(B1, 1, 1); STAGEB(1, 0, t + 3);
        BAR; WAIT_L(0); MMA(0, 1, At, B1); SSQ(1, B1); BAR;
        LDA(At, 1, 1); STAGEA(1, 0, t + 3);
        BAR; WAIT_L(0); MMA(1, 0, At, B0); BAR; SCHED;
        STAGEB(1, 1, t + 3);
        WAIT_V(6); BAR; MMA(1, 1, At, B1); BAR;
    }
    { LDB(B0, 0, 0); LDA(At, 0, 0); STAGEA(1, 1, nt - 1);
      BAR; WAIT_L(0); MMA(0, 0, At, B0); SSQ(0, B0); BAR;
      LDB(B1, 0, 1); BAR; WAIT_L(0); MMA(0, 1, At, B1); SSQ(1, B1); BAR;
      LDA(At, 0, 1); WAIT_V(4); BAR; WAIT_L(0); MMA(1, 0, At, B0); MMA(1, 1, At, B1); BAR; }
    { LDB(B0, 1, 0); LDA(At, 1, 0); WAIT_V(2); BAR; WAIT_L(0); MMA(0, 0, At, B0); SSQ(0, B0); BAR;
      LDB(B1, 1, 1); WAIT_V(0); BAR; WAIT_L(0); MMA(0, 1, At, B1); SSQ(1, B1); BAR;
      LDA(At, 1, 1); BAR; WAIT_L(0); MMA(1, 0, At, B0); MMA(1, 1, At, B1); BAR; }
    if (wr == 0) BAR;
    if (ROWSS) {
#pragma unroll
        for (int b = 0; b < 2; ++b)
#pragma unroll
            for (int n = 0; n < 2; ++n) { ss[b][n] += __shfl_xor(ss[b][n], 16, 64); ss[b][n] += __shfl_xor(ss[b][n], 32, 64); }
    }
#undef SSQ
#undef SA
#undef SB
#undef STAGE_
#undef STAGEA
#undef STAGEB
#undef LDA
#undef LDB
#undef MMA
#undef WAIT_V
#undef WAIT_L
#undef BAR
#undef SCHED
}
__device__ __forceinline__ void tile_rounds(int ntiles, int& lo, int& hi, int& step) {
    const int G = gridDim.x, b = blockIdx.x;
    if ((G & 7) == 0) { const int per = (ntiles + 7) >> 3, x = b & 7; lo = x * per + (b >> 3); hi = (x + 1) * per; if (hi > ntiles) hi = ntiles; step = G >> 3; }
    else { lo = b; hi = ntiles; step = G; }
}
template <bool SCALE, bool PRE, bool I8, class EPIROW, class RSC, class PREF, class CSC>
__device__ __forceinline__ void gemm_t8(const bf16* __restrict__ Wt, int ldw, int N, const bf16* __restrict__ X, int ldx, int K, int tlo, int thi, int tstep, EPIROW epirow, RSC rowscale, PREF pre, CSC colscale, char* lds) {
    typedef typename std::conditional<I8, i32x4, f32x4>::type ACC;
    const int tid = tidx();
    const int tilesN = N / 256; int nt = K / 64;
    asm volatile("" : "+s"(nt));
    for (int tile = tlo; tile < thi; tile += tstep) {
        const int tm = tile / tilesN, tn = tile % tilesN;
        ACC acc[2][2][4][2]; float ss[2][2];
        gemm8_kloop<false, false, ACC>(Wt + (size_t)(tn * 256) * ldw, ldw, X + (size_t)(tm * 256) * ldx, ldx, nt, acc, ss, lds, tid);
        __syncthreads();
        const int te = tidx();
        const int le = te & 63, w = te >> 6, wr = w >> 2, wc = w & 3, fr = le & 15, fq = le >> 4;
        float* st = (float*)lds + w * (32 * ST_P);
        const int rr = le >> 4, ch = le & 15;
        const int tb = tm * 256 + wc * 32 + rr, nb = tn * 256 + wr * 64 + ch * 4;
#pragma unroll
        for (int ai = 0; ai < 2; ++ai)
#pragma unroll
            for (int bj = 0; bj < 2; ++bj) {
                float4 pv[8];
                if (PRE) {
#pragma unroll
                    for (int it = 0; it < 8; ++it) pv[it] = pre(tb + bj * 128 + it * 4, nb + ai * 128);
                }
#pragma unroll
                for (int n = 0; n < 2; ++n) {
                    const float mj = SCALE ? rowscale(tm * 256 + bj * 128 + wc * 32 + n * 16 + fr) : 1.f;
#pragma unroll
                    for (int m = 0; m < 4; ++m) {
                        const ACC a_ = acc[ai][bj][m][n];
                        if (I8) {
                            const float4 cs = colscale(tn * 256 + ai * 128 + wr * 64 + m * 16 + fq * 4);
                            *(float4*)(st + (n * 16 + fr) * ST_P + m * 16 + fq * 4) = make_float4((float)a_[0] * (mj * cs.x), (float)a_[1] * (mj * cs.y), (float)a_[2] * (mj * cs.z), (float)a_[3] * (mj * cs.w));
                        } else
                        *(float4*)(st + (n * 16 + fr) * ST_P + m * 16 + fq * 4) = SCALE ? make_float4(a_[0] * mj, a_[1] * mj, a_[2] * mj, a_[3] * mj) : make_float4(a_[0], a_[1], a_[2], a_[3]);
                    }
                }
                if (PRE) {
#pragma unroll
                    for (int it = 0; it < 8; ++it) {
                        const float4 v = *(const float4*)(st + (it * 4 + rr) * ST_P + ch * 4);
                        epirow(tb + bj * 128 + it * 4, nb + ai * 128, v, pv[it]);
                    }
                } else {
#pragma unroll 2
                    for (int it = 0; it < 8; ++it) {
                        const float4 v = *(const float4*)(st + (it * 4 + rr) * ST_P + ch * 4);
                        epirow(tb + bj * 128 + it * 4, nb + ai * 128, v, make_float4(0.f, 0.f, 0.f, 0.f));
                    }
                }
            }
        __syncthreads();
    }
}

__device__ __forceinline__ void transpose_tiled(const float* __restrict__ W, bf16* __restrict__ Wt, int K, int N, int Npad, int ldk, const float* __restrict__ gain, char* lds) {
    float (*tl)[65] = (float (*)[65])lds;
    const int tid = tidx(), a = tid & 63, q = tid >> 6;
    const int tK = K / 64, tN = Npad / 64;
    for (int tile = blockIdx.x; tile < tK * tN; tile += gridDim.x) {
        const int k0 = (tile / tN) * 64, n0 = (tile % tN) * 64;
#pragma unroll 4
        for (int i = 0; i < 64 / NW; ++i) {
            const int k = k0 + q * (64 / NW) + i, n = n0 + a;
            float v = (n < N) ? W[(size_t)k * N + n] : 0.f;
            if (gain) v *= gain[k];
            tl[q * (64 / NW) + i][a] = v;
        }
        __syncthreads();
#pragma unroll 4
        for (int i = 0; i < 64 / NW; ++i) { const int nl = q * (64 / NW) + i; Wt[(size_t)(n0 + nl) * ldk + k0 + a] = f2bf(tl[a][nl]); }
        __syncthreads();
    }
}

__device__ __forceinline__ void quant_row(const float4 (&v)[4], unsigned char* __restrict__ dst, float* __restrict__ scl, int r, int lane) {
    float am = 0.f;
#pragma unroll
    for (int j = 0; j < 4; ++j) am = fmaxf(am, fmaxf(fmaxf(fabsf(v[j].x), fabsf(v[j].y)), fmaxf(fabsf(v[j].z), fabsf(v[j].w))));
#pragma unroll
    for (int m = 32; m >= 1; m >>= 1) am = fmaxf(am, __shfl_xor(am, m, 64));
    const float sc = (am > 0.f) ? am * (1.f / 448.f) : 1.f;
    const float is = 1.f / sc;
    uint4 o;
    { int w = 0; w = __builtin_amdgcn_cvt_pk_fp8_f32(v[0].x * is, v[0].y * is, w, false); w = __builtin_amdgcn_cvt_pk_fp8_f32(v[0].z * is, v[0].w * is, w, true); o.x = (unsigned)w; }
    { int w = 0; w = __builtin_amdgcn_cvt_pk_fp8_f32(v[1].x * is, v[1].y * is, w, false); w = __builtin_amdgcn_cvt_pk_fp8_f32(v[1].z * is, v[1].w * is, w, true); o.y = (unsigned)w; }
    { int w = 0; w = __builtin_amdgcn_cvt_pk_fp8_f32(v[2].x * is, v[2].y * is, w, false); w = __builtin_amdgcn_cvt_pk_fp8_f32(v[2].z * is, v[2].w * is, w, true); o.z = (unsigned)w; }
    { int w = 0; w = __builtin_amdgcn_cvt_pk_fp8_f32(v[3].x * is, v[3].y * is, w, false); w = __builtin_amdgcn_cvt_pk_fp8_f32(v[3].z * is, v[3].w * is, w, true); o.w = (unsigned)w; }
    { const int lay = r / NEXP, e = r % NEXP; *(uint4*)(dst + (((size_t)(lay * 8 + (lane >> 3)) * NEXP + e) * 128) + (lane & 7) * 16) = o; }
    if (lane == 0) scl[r] = sc;
}
__device__ __forceinline__ unsigned pack_i8x4(float a, float b, float c, float d) {
    const int ia = __float2int_rn(a), ib = __float2int_rn(b), ic = __float2int_rn(c), id = __float2int_rn(d);
    return (unsigned)(ia & 255) | ((unsigned)(ib & 255) << 8) | ((unsigned)(ic & 255) << 16) | ((unsigned)(id & 255) << 24);
}
__device__ __forceinline__ void quant_row_i8(const float4 (&v)[4], unsigned char* __restrict__ dst, float* __restrict__ scl, int r, int lane) {
    float am = 0.f;
#pragma unroll
    for (int j = 0; j < 4; ++j) am = fmaxf(am, fmaxf(fmaxf(fabsf(v[j].x), fabsf(v[j].y)), fmaxf(fabsf(v[j].z), fabsf(v[j].w))));
#pragma unroll
    for (int m = 32; m >= 1; m >>= 1) am = fmaxf(am, __shfl_xor(am, m, 64));
    const float sc = (am > 0.f) ? am * (1.f / 127.f) : 1.f;
    const float is = 1.f / sc;
    uint4 o;
    o.x = pack_i8x4(v[0].x * is, v[0].y * is, v[0].z * is, v[0].w * is); o.y = pack_i8x4(v[1].x * is, v[1].y * is, v[1].z * is, v[1].w * is);
    o.z = pack_i8x4(v[2].x * is, v[2].y * is, v[2].z * is, v[2].w * is); o.w = pack_i8x4(v[3].x * is, v[3].y * is, v[3].z * is, v[3].w * is);
    { const int lay = r / NEXP, e = r % NEXP; *(uint4*)(dst + (((size_t)(lay * 8 + (lane >> 3)) * NEXP + e) * 128) + (lane & 7) * 16) = o; }
    if (lane == 0) scl[r] = sc;
}
template <bool I8>
__device__ __forceinline__ void convert_table(const float* __restrict__ src, unsigned char* __restrict__ dst, float* __restrict__ scl, int rows) {
    static_assert(TAB_FP8, "fp8 tables");
    const int lane = tidx() & 63;
    const int nw = nwave();
    for (int r = gwave(); r < rows; r += 4 * nw) {
        float4 v[4][4]; int rr[4];
#pragma unroll
        for (int u = 0; u < 4; ++u) {
            rr[u] = (r + u * nw < rows) ? (r + u * nw) : r;
            const float4* s0 = (const float4*)(src + (size_t)rr[u] * D);
#pragma unroll
            for (int j = 0; j < 4; ++j) v[u][j] = s0[lane * 4 + j];
        }
#pragma unroll
        for (int u = 0; u < 4; ++u) {
            if (u == 0 || rr[u] != r) { if (I8) quant_row_i8(v[u], dst, scl, rr[u], lane); else quant_row(v[u], dst, scl, rr[u], lane); }
        }
    }
}
__device__ __forceinline__ void phase_prep(const Params& P, char* lds) {
    unsigned char* ws = P.ws;
    for (int l = 0; l < DEPTH; ++l) {
        transpose_tiled(P.w_in + (size_t)l * D * DIN, (bf16*)(ws + WS_WIN) + (size_t)l * DINP * LDW, D, DIN, DINP, LDW, nullptr, lds);
        transpose_tiled(P.w_uq + (size_t)l * QR * 768, (bf16*)(ws + WS_WUQ) + (size_t)l * 768 * QR, QR, 768, 768, QR, P.q_norm + l * QR, lds);
        transpose_tiled(P.w_uk + (size_t)l * KVR * 512, (bf16*)(ws + WS_WUKV) + (size_t)l * 1024 * KVR, KVR, 512, 512, KVR, P.kv_norm + l * KVR, lds);
        transpose_tiled(P.w_uv + (size_t)l * KVR * 512, (bf16*)(ws + WS_WUKV) + (size_t)l * 1024 * KVR + (size_t)512 * KVR, KVR, 512, 512, KVR, P.kv_norm + l * KVR, lds);
        transpose_tiled(P.w_out + (size_t)l * D * D, (bf16*)(ws + WS_WOUT) + (size_t)l * D * LDW, D, D, D, LDW, nullptr, lds);
    }
    {
        bf16* Wc = (bf16*)(ws + WS_WPQ);
        float (*As)[68] = (float (*)[68])lds;
        float (*Bs)[68] = (float (*)[68])(lds + 16 * 68 * 4);
        const int tid = tidx(), tx = tid & 15, ty = (tid >> 4) & 15;
        const int lr = (tid >> 2) & 63, ld4 = (tid & 3) * 4;
        for (int tile = blockIdx.x; tile < (DEPTH * 2048 / 64) * (D / 64); tile += gridDim.x) {
            const int row0 = (tile >> 4) * 64, k0 = (tile & 15) * 64;
            const int l = row0 >> 11, hp = (row0 >> 7) & 15, n0 = row0 & 127;
            const float* skp = P.peer_subkeys + (((size_t)l * 2 + (hp & 1)) * NKEY + n0 + lr) * 128 + ld4;
            const float* wqp = P.peer_wq + ((size_t)l * D + k0 + lr) * 2048 + hp * 128 + ld4;
            float acc[4][4];
#pragma unroll
            for (int i = 0; i < 4; ++i)
#pragma unroll
                for (int j = 0; j < 4; ++j) acc[i][j] = 0.f;
            for (int d0 = 0; d0 < 128; d0 += 16) {
                if (tid < 256) {
                    const float4 av = *(const float4*)(skp + d0), bv = *(const float4*)(wqp + d0);
                    As[ld4 + 0][lr] = av.x; As[ld4 + 1][lr] = av.y; As[ld4 + 2][lr] = av.z; As[ld4 + 3][lr] = av.w;
                    Bs[ld4 + 0][lr] = bv.x; Bs[ld4 + 1][lr] = bv.y; Bs[ld4 + 2][lr] = bv.z; Bs[ld4 + 3][lr] = bv.w;
                }
                __syncthreads();
#pragma unroll
                for (int kk = 0; kk < 16; ++kk) {
                    const float4 a4 = *(const float4*)&As[kk][ty * 4], b4 = *(const float4*)&Bs[kk][tx * 4];
                    const float aa[4] = {a4.x, a4.y, a4.z, a4.w}, bb[4] = {b4.x, b4.y, b4.z, b4.w};
#pragma unroll
                    for (int i = 0; i < 4; ++i)
#pragma unroll
                        for (int j = 0; j < 4; ++j) acc[i][j] = fmaf(aa[i], bb[j], acc[i][j]);
                }
                __syncthreads();
            }
            if (tid < 256) {
#pragma unroll
                for (int i = 0; i < 4; ++i) {
                    uint2 o; o.x = pack2(acc[i][0], acc[i][1]); o.y = pack2(acc[i][2], acc[i][3]);
                    *(uint2*)(Wc + (size_t)(row0 + ty * 4 + i) * LDW + k0 + tx * 4) = o;
                }
            }
        }
    }
    convert_table<true>(P.peer_u, ws + WS_TABU, (float*)(ws + WS_TSCU), DEPTH * NEXP);
    convert_table<false>(P.peer_v, ws + WS_TABV, (float*)(ws + WS_TSCV), DEPTH * NEXP);
    float* rope = (float*)(ws + WS_ROPE);
    for (size_t i = gtid(); i < (size_t)S * 16; i += gnth()) {
        const int s = (int)(i >> 4), f = (int)(i & 15);
        const double inv = pow(10000.0, -(double)f / 16.0);
        const double ang = (double)s * inv;
        rope[2 * i] = (float)cos(ang); rope[2 * i + 1] = (float)sin(ang);
    }
}

__device__ __forceinline__ void phase_norm(const float* __restrict__ h, const float* __restrict__ g, unsigned* __restrict__ xq, float* __restrict__ xsc) {
    const int lane = tidx() & 63, nw = nwave();
    for (int t = gwave(); t < T; t += 2 * nw) {
        const int t2 = (t + nw < T) ? (t + nw) : t;
        float4 v[2][4];
#pragma unroll
        for (int j = 0; j < 4; ++j) { v[0][j] = ((const float4*)(h + (size_t)t * D))[j * 64 + lane]; v[1][j] = ((const float4*)(h + (size_t)t2 * D))[j * 64 + lane]; }
#pragma unroll
        for (int u = 0; u < 2; ++u) {
            float ss = 0.f;
#pragma unroll
            for (int j = 0; j < 4; ++j) ss += v[u][j].x * v[u][j].x + v[u][j].y * v[u][j].y + v[u][j].z * v[u][j].z + v[u][j].w * v[u][j].w;
            ss = wave_sum(ss);
            const float r = rsqrtf(ss * (1.f / D) + EPS);
            const int tt = u ? t2 : t;
            if (u == 0 || t2 != t) {
                float am = 0.f;
#pragma unroll
                for (int j = 0; j < 4; ++j) {
                    const float4 gg = ((const float4*)g)[j * 64 + lane];
                    v[u][j].x *= r * gg.x; v[u][j].y *= r * gg.y; v[u][j].z *= r * gg.z; v[u][j].w *= r * gg.w;
                    am = fmaxf(am, fmaxf(fmaxf(fabsf(v[u][j].x), fabsf(v[u][j].y)), fmaxf(fabsf(v[u][j].z), fabsf(v[u][j].w))));
                }
#pragma unroll
                for (int m = 32; m >= 1; m >>= 1) am = fmaxf(am, __shfl_xor(am, m, 64));
                const float sc = (am > 0.f) ? am * (1.f / 127.f) : 1.f, is = 1.f / sc;
#pragma unroll
                for (int j = 0; j < 4; ++j) xq[(size_t)tt * (XQP / 4) + j * 64 + lane] = pack_i8x4(v[u][j].x * is, v[u][j].y * is, v[u][j].z * is, v[u][j].w * is);
                if (lane == 0) xsc[tt] = sc;
            }
        }
    }
}
__device__ __forceinline__ void quant_wrows(const bf16* __restrict__ W, int nrows, unsigned char* __restrict__ W8, float* __restrict__ WS8) {
    const int lane = tidx() & 63;
    for (int row = gwave(); row < nrows; row += nwave()) {
        const uint4 a = ((const uint4*)(W + (size_t)row * LDW))[lane * 2], b = ((const uint4*)(W + (size_t)row * LDW))[lane * 2 + 1];
        float v[16] = {bflo(a.x), bfhi(a.x), bflo(a.y), bfhi(a.y), bflo(a.z), bfhi(a.z), bflo(a.w), bfhi(a.w), bflo(b.x), bfhi(b.x), bflo(b.y), bfhi(b.y), bflo(b.z), bfhi(b.z), bflo(b.w), bfhi(b.w)};
        float am = 0.f;
#pragma unroll
        for (int i = 0; i < 16; ++i) am = fmaxf(am, fabsf(v[i]));
#pragma unroll
        for (int m = 32; m >= 1; m >>= 1) am = fmaxf(am, __shfl_xor(am, m, 64));
        const float sc = (am > 0.f) ? am * (1.f / 127.f) : 1.f, is = 1.f / sc;
        uint4 o;
        o.x = pack_i8x4(v[0] * is, v[1] * is, v[2] * is, v[3] * is); o.y = pack_i8x4(v[4] * is, v[5] * is, v[6] * is, v[7] * is);
        o.z = pack_i8x4(v[8] * is, v[9] * is, v[10] * is, v[11] * is); o.w = pack_i8x4(v[12] * is, v[13] * is, v[14] * is, v[15] * is);
        ((uint4*)(W8 + (size_t)row * XQP))[lane] = o;
        if (lane == 0) WS8[row] = sc;
    }
}
__device__ __forceinline__ void phase_norm_q(const Params& P, int l) {
    const int lane = tidx() & 63, nw = nwave();
    const float* g = P.norm_ffn + l * D;
    unsigned* xq = (unsigned*)(P.ws + WS_XQ);
    float* xsc = (float*)(P.ws + WS_XS);
    bf16* Hb = (bf16*)P.out;
    const bf16* yo = (const bf16*)(P.ws + WS_PROJ);
    for (int t = gwave(); t < T; t += 2 * nw) {
        const int t2 = (t + nw < T) ? (t + nw) : t;
        float4 v[2][4];
#pragma unroll
        for (int j = 0; j < 4; ++j) {
            if (l == 0) { v[0][j] = ((const float4*)(P.x + (size_t)t * D))[j * 64 + lane]; v[1][j] = ((const float4*)(P.x + (size_t)t2 * D))[j * 64 + lane]; }
            else {
                const uint2 a = ((const uint2*)(Hb + (size_t)t * HP))[j * 64 + lane], b = ((const uint2*)(Hb + (size_t)t2 * HP))[j * 64 + lane];
                v[0][j] = make_float4(bflo(a.x), bfhi(a.x), bflo(a.y), bfhi(a.y)); v[1][j] = make_float4(bflo(b.x), bfhi(b.x), bflo(b.y), bfhi(b.y));
            }
        }
        {
            uint2 y[2][4];
#pragma unroll
            for (int j = 0; j < 4; ++j) { y[0][j] = ((const uint2*)(yo + (size_t)t * D))[j * 64 + lane]; y[1][j] = ((const uint2*)(yo + (size_t)t2 * D))[j * 64 + lane]; }
#pragma unroll
            for (int u = 0; u < 2; ++u)
#pragma unroll
                for (int j = 0; j < 4; ++j) { v[u][j].x += bflo(y[u][j].x); v[u][j].y += bfhi(y[u][j].x); v[u][j].z += bflo(y[u][j].y); v[u][j].w += bfhi(y[u][j].y); }
#pragma unroll
            for (int j = 0; j < 4; ++j) {
                uint2 a, b; a.x = pack2(v[0][j].x, v[0][j].y); a.y = pack2(v[0][j].z, v[0][j].w); b.x = pack2(v[1][j].x, v[1][j].y); b.y = pack2(v[1][j].z, v[1][j].w);
                ((uint2*)(Hb + (size_t)t * HP))[j * 64 + lane] = a; if (t2 != t) ((uint2*)(Hb + (size_t)t2 * HP))[j * 64 + lane] = b;
            }
        }
#pragma unroll
        for (int u = 0; u < 2; ++u) {
            float ss = 0.f;
#pragma unroll
            for (int j = 0; j < 4; ++j) ss += v[u][j].x * v[u][j].x + v[u][j].y * v[u][j].y + v[u][j].z * v[u][j].z + v[u][j].w * v[u][j].w;
            ss = wave_sum(ss);
            const float r = rsqrtf(ss * (1.f / D) + EPS);
            const int tt = u ? t2 : t;
            if (u == 0 || t2 != t) {
                float am = 0.f;
#pragma unroll
                for (int j = 0; j < 4; ++j) {
                    const float4 gg = ((const float4*)g)[j * 64 + lane];
                    v[u][j].x *= r * gg.x; v[u][j].y *= r * gg.y; v[u][j].z *= r * gg.z; v[u][j].w *= r * gg.w;
                    am = fmaxf(am, fmaxf(fmaxf(fabsf(v[u][j].x), fabsf(v[u][j].y)), fmaxf(fabsf(v[u][j].z), fabsf(v[u][j].w))));
                }
#pragma unroll
                for (int m = 32; m >= 1; m >>= 1) am = fmaxf(am, __shfl_xor(am, m, 64));
                const float sc = (am > 0.f) ? am * (1.f / 127.f) : 1.f, is = 1.f / sc;
#pragma unroll
                for (int j = 0; j < 4; ++j) xq[(size_t)tt * (XQP / 4) + j * 64 + lane] = pack_i8x4(v[u][j].x * is, v[u][j].y * is, v[u][j].z * is, v[u][j].w * is);
                if (lane == 0) xsc[tt] = sc;
            }
        }
    }
}

__device__ __forceinline__ void phase_mixlocal(const Params& P, int l, char* lds) {
    const bf16* proj = (const bf16*)(P.ws + WS_PROJ);
    bf16* Y = (bf16*)(P.ws + WS_XN);
    const int tid = tidx();
    {
        const float* cw = P.conv_w + (size_t)l * 3 * 256;
        for (size_t i = gtid(); i < (size_t)T * 32; i += gnth()) {
            const int t = (int)(i >> 5), c0 = (int)(i & 31) * 8, s = t & (S - 1);
            const bf16* pr = proj + (size_t)t * DINP;
            float acc[8];
#pragma unroll
            for (int e = 0; e < 8; ++e) acc[e] = 0.f;
#pragma unroll
            for (int j = 0; j < 3; ++j) {
                if (s - 2 + j >= 0) {
                    const bf16* pp = pr - (size_t)(2 - j) * DINP;
                    const uint4 g = *(const uint4*)(pp + C_CG + c0), hc = *(const uint4*)(pp + C_HC + c0);
                    const float4 w0 = *(const float4*)(cw + j * 256 + c0), w1 = *(const float4*)(cw + j * 256 + c0 + 4);
                    acc[0] = fmaf(w0.x, bflo(g.x) * bflo(hc.x), acc[0]); acc[1] = fmaf(w0.y, bfhi(g.x) * bfhi(hc.x), acc[1]);
                    acc[2] = fmaf(w0.z, bflo(g.y) * bflo(hc.y), acc[2]); acc[3] = fmaf(w0.w, bfhi(g.y) * bfhi(hc.y), acc[3]);
                    acc[4] = fmaf(w1.x, bflo(g.z) * bflo(hc.z), acc[4]); acc[5] = fmaf(w1.y, bfhi(g.z) * bfhi(hc.z), acc[5]);
                    acc[6] = fmaf(w1.z, bflo(g.w) * bflo(hc.w), acc[6]); acc[7] = fmaf(w1.w, bfhi(g.w) * bfhi(hc.w), acc[7]);
                }
            }
            const uint4 bg = *(const uint4*)(pr + C_BG + c0);
            uint4 o;
            o.x = pack2(bflo(bg.x) * acc[0], bfhi(bg.x) * acc[1]); o.y = pack2(bflo(bg.y) * acc[2], bfhi(bg.y) * acc[3]);
            o.z = pack2(bflo(bg.z) * acc[4], bfhi(bg.z) * acc[5]); o.w = pack2(bflo(bg.w) * acc[6], bfhi(bg.w) * acc[7]);
            *(uint4*)(Y + (size_t)t * LDX + c0) = o;
        }
    }
    {
        float (*pl)[68] = (float (*)[68])lds;
        const float* pw = P.pool_w + (size_t)l * 4 * 64 * 64;
        const float* psc = P.pool_scale + l * 256;
        const int a = tid & 63, q = tid >> 6;
        for (int tile = blockIdx.x; tile < (T / (16 * NW)) * 4; tile += gridDim.x) {
            const int g = tile & 3, t0 = (tile >> 2) * (16 * NW);
            const int w = 2 << g;
            {
                const bf16* col = proj + C_HP + g * 64 + a;
                const int tf = t0 + q * 16, sf = tf & (S - 1);
                float xr[31];
#pragma unroll
                for (int d = 1; d <= 15; ++d) xr[15 - d] = (d < w && sf - d >= 0) ? bf2f(col[(size_t)(tf - d) * DINP]) : 0.f;
#pragma unroll
                for (int i = 0; i < 16; ++i) xr[15 + i] = bf2f(col[(size_t)(tf + i) * DINP]);
                float sum = 0.f;
#pragma unroll
                for (int d = 1; d <= 15; ++d) sum += xr[15 - d];
#pragma unroll
                for (int i = 0; i < 16; ++i) {
                    const int s = sf + i;
                    sum += xr[15 + i];
                    const int cnt = (s + 1 < w) ? (s + 1) : w;
                    pl[q * 16 + i][a] = sum / (float)cnt - xr[15 + i];
                    const int o = 15 + i + 1;
                    const float old = (g == 0) ? xr[o - 2] : (g == 1) ? xr[o - 4] : (g == 2) ? xr[o - 8] : xr[o - 16];
                    sum -= old;
                }
            }
            __syncthreads();
            {
                float pc[64];
#pragma unroll
                for (int c = 0; c < 64; ++c) pc[c] = pw[(g * 64 + c) * 64 + a];
                const float sc = psc[g * 64 + a];
#pragma unroll 2
                for (int i = 0; i < 16; ++i) {
                    const float4* row = (const float4*)&pl[q * 16 + i][0];
                    float m0 = 0.f, m1 = 0.f;
#pragma unroll
                    for (int c4 = 0; c4 < 16; ++c4) { const float4 v = row[c4]; m0 = fmaf(v.x, pc[4 * c4], m0); m1 = fmaf(v.y, pc[4 * c4 + 1], m1); m0 = fmaf(v.z, pc[4 * c4 + 2], m0); m1 = fmaf(v.w, pc[4 * c4 + 3], m1); }
                    Y[(size_t)(t0 + q * 16 + i) * LDX + 256 + g * 64 + a] = f2bf((m0 + m1) * sc);
                }
            }
            __syncthreads();
        }
    }
}

typedef short v4i16_t __attribute__((ext_vector_type(4)));
typedef __attribute__((address_space(3))) v4i16_t* lds_v4p;
__device__ __forceinline__ v4i16_t vtr(const char* p) { return __builtin_amdgcn_ds_read_tr16_b64_v4i16((lds_v4p)p); }
constexpr int A_KP = 208, A_VP = 192;
constexpr int A_KB = 64 * A_KP, A_VB = 64 * A_VP, A_BUF = A_KB + A_VB, ATTN_LDS = 3 * A_BUF;
static_assert(ATTN_LDS <= LDS_TOTAL, "attention LDS");

__device__ __forceinline__ void attn_unit(const bf16* __restrict__ Qb, const bf16* __restrict__ Kb, const bf16* __restrict__ Vb, bf16* __restrict__ Y, int bh, int qblk, char* lds) {
    const int tid = tidx(), lane = tid & 63, w = tid >> 6, r32 = lane & 31, hi = lane >> 5;
    const int q0 = qblk * (32 * NW), qw0 = q0 + w * 32;
    const int NT = (q0 + 32 * NW) / 64;
    bf16x8 qf[6];
    {
        const bf16* qp = Qb + ((size_t)bh * S + qw0 + r32) * DQK + hi * 8;
#pragma unroll
        for (int ks = 0; ks < 6; ++ks) qf[ks] = *(const bf16x8*)(qp + ks * 16);
    }
    f32x16 o0, o1;
#pragma unroll
    for (int r = 0; r < 16; ++r) { o0[r] = 0.f; o1[r] = 0.f; }
    float m = -1e30f, lsum = 0.f;
    const int t8 = tid & 255; const bool isv = tid >= 256;
    const char* Tg = isv ? (const char*)(Vb + (size_t)bh * S * DV) : (const char*)(Kb + (size_t)bh * S * DQK);
    const int Ts = isv ? (64 * 128) : (64 * 192);
    const int g0 = t8 * 16, g1 = (t8 + 256) * 16, g2 = isv ? g1 : (t8 + 512) * 16;
    const int l0 = isv ? (A_KB + (t8 >> 3) * A_VP + (t8 & 7) * 16) : ((t8 / 12) * A_KP + (t8 % 12) * 16);
    const int l1 = isv ? (l0 + 32 * A_VP) : (((t8 + 256) / 12) * A_KP + ((t8 + 256) % 12) * 16);
    const int l2 = isv ? l1 : (((t8 + 512) / 12) * A_KP + ((t8 + 512) % 12) * 16);
    uint4 pk0, pk1, pk2, qk0, qk1, qk2;
#define A_LOAD(S, t) do { const char* tg = Tg + (size_t)(t) * Ts; S##k0 = *(const uint4*)(tg + g0); S##k1 = *(const uint4*)(tg + g1); S##k2 = *(const uint4*)(tg + g2); } while (0)
#define A_STORE(S, bK, bV) do { *(uint4*)(bK + l0) = S##k0; *(uint4*)(bK + l1) = S##k1; *(uint4*)(bK + l2) = S##k2; } while (0)
#define A_PV(pf, kofs) do { \
            { const v4i16_t lo = vtr(pv + (kofs) * A_VP), hh = vtr(pv + ((kofs) + 8) * A_VP); const bf16x8 vf = {lo[0], lo[1], lo[2], lo[3], hh[0], hh[1], hh[2], hh[3]}; o0 = MFMA32(vf, pf.v, o0); } \
            { const v4i16_t lo = vtr(pv + (kofs) * A_VP + 64), hh = vtr(pv + ((kofs) + 8) * A_VP + 64); const bf16x8 vf = {lo[0], lo[1], lo[2], lo[3], hh[0], hh[1], hh[2], hh[3]}; o1 = MFMA32(vf, pf.v, o1); } } while (0)
    const int pvo = (4 * hi + ((lane & 15) >> 2)) * A_VP + (16 * ((lane >> 4) & 1) + 4 * (lane & 3)) * 2;
#define A_QK(S0, S1, bK_, kt0_) do { \
        _Pragma("unroll") for (int r = 0; r < 16; ++r) { S0[r] = 0.f; S1[r] = 0.f; } \
        const char* pk = (bK_) + r32 * A_KP + hi * 16; \
        _Pragma("unroll") for (int ks = 0; ks < 6; ++ks) { \
            const bf16x8 a0 = *(const bf16x8*)(pk + ks * 32), a1 = *(const bf16x8*)(pk + 32 * A_KP + ks * 32); \
            S0 = MFMA32(a0, qf[ks], S0); S1 = MFMA32(a1, qf[ks], S1); } \
        if ((kt0_) + 63 > qw0) {                                      \
            const int qrow = qw0 + r32; \
            _Pragma("unroll") for (int r = 0; r < 16; ++r) { const int key = (kt0_) + crow(r, hi); if (key > qrow) S0[r] = -INFINITY; if (key + 32 > qrow) S1[r] = -INFINITY; } } } while (0)
#define A_SOFTPV(s0, s1, bV_) do { \
            float mx = fmaxf(s0[0], s1[0]); \
            _Pragma("unroll") for (int r = 1; r < 16; ++r) mx = fmaxf(mx, fmaxf(s0[r], s1[r])); \
            mx = fmaxf(mx, __shfl_xor(mx, 32, 64)); \
            const float mn = fmaxf(m, mx), m_prev = m; \
            const float alpha = __builtin_amdgcn_exp2f(m - mn); \
            m = mn; \
            float ps = 0.f; \
            _Pragma("unroll") for (int r = 0; r < 16; ++r) { s0[r] = __builtin_amdgcn_exp2f(s0[r] - mn); s1[r] = __builtin_amdgcn_exp2f(s1[r] - mn); ps += s0[r] + s1[r]; } \
            if (__builtin_amdgcn_ballot_w64(mn > m_prev) != 0ull) {     \
                lsum *= alpha; \
                _Pragma("unroll") for (int r = 0; r < 16; ++r) { o0[r] *= alpha; o1[r] *= alpha; } } \
            lsum += ps; \
            union { unsigned u[4]; bf16x8 v; } p00, p01, p10, p11; \
            _Pragma("unroll") for (int j = 0; j < 4; ++j) { p00.u[j] = cvtpk(s0[2 * j], s0[2 * j + 1]); p01.u[j] = cvtpk(s0[8 + 2 * j], s0[9 + 2 * j]); p10.u[j] = cvtpk(s1[2 * j], s1[2 * j + 1]); p11.u[j] = cvtpk(s1[8 + 2 * j], s1[9 + 2 * j]); } \
            const char* pv = (bV_) + pvo; \
            A_PV(p00, 0); A_PV(p01, 16); A_PV(p10, 32); A_PV(p11, 48); } while (0)
#define A_STEP(C0, C1, N0, N1, SET, t) do { \
        if ((t) + 1 < NT) { \
            char* bKn = lds + so_next; \
            A_STORE(SET, bKn, bKn + A_KB); \
            __syncthreads(); \
            { const int tn = ((t) + 3 < NT) ? ((t) + 3) : (NT - 1); A_LOAD(SET, tn); } \
            if (((t) + 1) * 64 <= qw0) A_QK(N0, N1, bKn, ((t) + 1) * 64); \
        } \
        if ((t) * 64 <= qw0) A_SOFTPV(C0, C1, lds + so_cur + A_KB); \
        so_cur = so_next; so_next = (so_next == 2 * A_BUF) ? 0 : so_next + A_BUF; } while (0)
    int so_cur = 0, so_next = A_BUF;
    A_LOAD(p, 0); A_LOAD(q, 1);
    A_STORE(p, lds, lds + A_KB);
    __syncthreads();
    A_LOAD(p, 2);
    f32x16 sa0, sa1, sb0, sb1;
    A_QK(sa0, sa1, lds, 0);
    for (int t2 = 0; t2 < NT; t2 += 2) {
        A_STEP(sa0, sa1, sb0, sb1, q, t2);
        A_STEP(sb0, sb1, sa0, sa1, p, t2 + 1);
    }
#undef A_QK
#undef A_SOFTPV
#undef A_STEP
    lsum += __shfl_xor(lsum, 32, 64);
    const float inv = 1.f / lsum;
    const int b = bh >> 3, h = bh & 7;
    bf16* yo = Y + (size_t)(b * S + qw0 + r32) * LDX + 512 + h * 64 + 4 * hi;
#pragma unroll
    for (int g = 0; g < 4; ++g) {
        uint2 a, c;
        a.x = cvtpk(o0[4 * g] * inv, o0[4 * g + 1] * inv); a.y = cvtpk(o0[4 * g + 2] * inv, o0[4 * g + 3] * inv);
        c.x = cvtpk(o1[4 * g] * inv, o1[4 * g + 1] * inv); c.y = cvtpk(o1[4 * g + 2] * inv, o1[4 * g + 3] * inv);
        *(uint2*)(yo + 8 * g) = a; *(uint2*)(yo + 32 + 8 * g) = c;
    }
    __syncthreads();
}
__device__ __forceinline__ void phase_attn(const Params& P, char* lds) {
    const bf16* Qb = (const bf16*)(P.ws + WS_Q);
    const bf16* Kb = (const bf16*)(P.ws + WS_K);
    const bf16* Vb = (const bf16*)(P.ws + WS_V);
    bf16* Y = (bf16*)(P.ws + WS_XN);
    for (int u = blockIdx.x; u < NB * NH * (S / 256); u += gridDim.x) {
        const int bh = u & 31, v = u >> 5;
        const int qblk = (v < 8) ? (31 - v) : (v < 16) ? (v - 8) : (v < 24) ? (39 - v) : (v - 16);
        attn_unit(Qb, Kb, Vb, Y, bh, qblk, lds);
    }
}

#define NET_HD __device__ __forceinline__
#define NET_U2F(u) __uint_as_float(u)
#define NET_F2U(f) __float_as_uint(f)
#define CE_DESC(a, b) do { const float hi__ = fmaxf(a, b), lo__ = fminf(a, b); a = hi__; b = lo__; } while (0)
NET_HD void sort16_desc(float (&v)[16]) {
#define CE2(a, b) CE_DESC(v[a], v[b])
    CE2(0,13); CE2(1,12); CE2(2,15); CE2(3,14); CE2(4,8); CE2(5,6); CE2(7,11); CE2(9,10);
    CE2(0,5); CE2(1,7); CE2(2,9); CE2(3,4); CE2(6,13); CE2(8,14); CE2(10,15); CE2(11,12);
    CE2(0,1); CE2(2,3); CE2(4,5); CE2(6,8); CE2(7,9); CE2(10,11); CE2(12,13); CE2(14,15);
    CE2(0,2); CE2(1,3); CE2(4,10); CE2(5,11); CE2(6,7); CE2(8,9); CE2(12,14); CE2(13,15);
    CE2(1,2); CE2(3,12); CE2(4,6); CE2(5,7); CE2(8,10); CE2(9,11); CE2(13,14);
    CE2(1,4); CE2(2,6); CE2(5,8); CE2(7,10); CE2(9,13); CE2(11,14);
    CE2(2,4); CE2(3,6); CE2(9,12); CE2(11,13);
    CE2(3,5); CE2(6,8); CE2(7,9); CE2(10,12);
    CE2(3,4); CE2(5,6); CE2(7,8); CE2(9,10); CE2(11,12);
    CE2(6,7); CE2(8,9);
#undef CE2
}
NET_HD void merge16_desc(float (&a)[16], const float (&b)[16]) {
#pragma unroll
    for (int i = 0; i < 16; ++i) a[i] = fmaxf(a[i], b[15 - i]);
#pragma unroll
    for (int j = 8; j > 0; j >>= 1) {
#pragma unroll
        for (int i = 0; i < 16; ++i) { const int l = i ^ j; if (l > i) CE_DESC(a[i], a[l]); }
    }
}
NET_HD void top16_of_64(float (&g0)[16], float (&g1)[16], float (&g2)[16], float (&g3)[16]) {
    sort16_desc(g0); sort16_desc(g1); sort16_desc(g2); sort16_desc(g3);
    merge16_desc(g0, g1); merge16_desc(g2, g3); merge16_desc(g0, g2);
}
NET_HD float u2f(unsigned u) { return NET_U2F(u); }
NET_HD unsigned f2u(float f) { return NET_F2U(f); }
template <class V16>
NET_HD void lane_top16(const V16& s0, const V16& s1, const V16& s2, const V16& s3, int hi, float (&out)[16]) {
    float g0[16], g1[16], g2[16], g3[16];
#pragma unroll
    for (int r = 0; r < 16; ++r) {
        const unsigned nb = (unsigned)((r & 3) + 8 * (r >> 2));
        g0[r] = u2f((f2u(s0[r]) & 0xFFFFFF80u) | nb); g1[r] = u2f((f2u(s1[r]) & 0xFFFFFF80u) | (nb + 32u));
        g2[r] = u2f((f2u(s2[r]) & 0xFFFFFF80u) | (nb + 64u)); g3[r] = u2f((f2u(s3[r]) & 0xFFFFFF80u) | (nb + 96u));
    }
    top16_of_64(g0, g1, g2, g3);
    const unsigned h4 = (unsigned)hi << 2;
#pragma unroll
    for (int i = 0; i < 16; ++i) out[i] = u2f(f2u(g0[i]) | h4);
}
constexpr int cand_slot(int a, int b) { int n = 0; for (int x = 0; x < 16; ++x) for (int y = 0; y < 16; ++y) { if (x == a && y == b) return n; if ((x + 1) * (y + 1) <= 16) ++n; } return n; }
NET_HD void cand_top16(const float (&s1)[16], const float (&s2)[16], float (&c)[16]) {
    float g0[16], g1[16], g2[16], g3[16];
#pragma unroll
    for (int i = 0; i < 16; ++i) { g0[i] = -3.0e38f; g1[i] = -3.0e38f; g2[i] = -3.0e38f; g3[i] = -3.0e38f; }
#pragma unroll
    for (int a = 0; a < 16; ++a) {
#pragma unroll
        for (int b = 0; b < 16; ++b) {
            if ((a + 1) * (b + 1) <= 16) {
                const int sl = cand_slot(a, b);
                const float v = u2f((f2u(s1[a] + s2[b]) & 0xFFFFFF00u) | (unsigned)(a * 16 + b));
                if (sl < 16) g0[sl & 15] = v; else if (sl < 32) g1[sl & 15] = v; else if (sl < 48) g2[sl & 15] = v; else g3[sl & 15] = v;
            }
        }
    }
    top16_of_64(g0, g1, g2, g3);
#pragma unroll
    for (int i = 0; i < 16; ++i) c[i] = g0[i];
}

__device__ __forceinline__ void phase_route(const Params& P, int l, char* lds) {
    const bf16* XQb = (const bf16*)(P.ws + WS_XQ);
    const bf16* Wc = (const bf16*)(P.ws + WS_WC8 + (size_t)l * 2048 * XQP);
    const float* WcS = (const float*)(P.ws + WS_WCS) + (size_t)l * 2048;
    const float* XSc = (const float*)(P.ws + WS_XS);
    int* EXPp = (int*)(P.ws + WS_EXP);
    float* GATEp = (float*)(P.ws + WS_GATE);
    const int tid = tidx();
    float* xch = (float*)(lds + 16384);
    int tlo, thi, tst; tile_rounds((T / 256) * PH, tlo, thi, tst);
    int nt = D / 128; asm volatile("" : "+s"(nt));
    for (int u = tlo; u < thi; u += tst) {
        const int tm = u >> 3, h = u & 7;
        float Lk[16];
        {
            i32x4 acc[2][2][4][2]; float ssd[2][2];
            gemm8_kloop<false, true, i32x4>(Wc + (size_t)(h * 256) * (XQP / 2), XQP / 2, XQb + (size_t)(tm * 256) * (XQP / 2), XQP / 2, nt, acc, ssd, lds, tid);
            const int te = tidx(), fq = (te >> 4) & 3;
            const unsigned fqb = (unsigned)fq << 2;
            float4 ks[2][4];
            { const float* kp = WcS + h * 256 + ((te >> 8) & 1) * 128 + fq * 4;
#pragma unroll
              for (int ai = 0; ai < 2; ++ai)
#pragma unroll
                  for (int m = 0; m < 4; ++m) ks[ai][m] = *(const float4*)(kp + ai * 64 + m * 16); }
#pragma unroll
            for (int i = 0; i < 16; ++i) Lk[i] = 0.f;
#pragma unroll
            for (int bj = 0; bj < 2; ++bj)
#pragma unroll
                for (int n = 0; n < 2; ++n) {
                    float g0[16], g1[16];
#pragma unroll
                    for (int m = 0; m < 4; ++m)
#pragma unroll
                        for (int j = 0; j < 4; ++j) {
                            const unsigned kb = (unsigned)(m * 16 + j) | fqb;
                            const float k0 = (j == 0) ? ks[0][m].x : (j == 1) ? ks[0][m].y : (j == 2) ? ks[0][m].z : ks[0][m].w;
                            const float k1 = (j == 0) ? ks[1][m].x : (j == 1) ? ks[1][m].y : (j == 2) ? ks[1][m].z : ks[1][m].w;
                            g0[m * 4 + j] = u2f((f2u((float)acc[0][bj][m][n][j] * k0) & 0xFFFFFF80u) | kb);
                            g1[m * 4 + j] = u2f((f2u((float)acc[1][bj][m][n][j] * k1) & 0xFFFFFF80u) | (kb + 64u));
                        }
                    sort16_desc(g0); sort16_desc(g1); merge16_desc(g0, g1);
                    float o[16];
#pragma unroll
                    for (int i = 0; i < 16; ++i) o[i] = __shfl_xor(g0[i], 16, 64);
                    merge16_desc(g0, o);
#pragma unroll
                    for (int i = 0; i < 16; ++i) o[i] = __shfl_xor(g0[i], 32, 64);
                    merge16_desc(g0, o);
                    const bool mine = fq == bj * 2 + n;
#pragma unroll
                    for (int i = 0; i < 16; ++i) Lk[i] = mine ? g0[i] : Lk[i];
                }
        }
        __syncthreads();
        const int te = tidx(), lane = te & 63, w = te >> 6, wr = w >> 2, wc = w & 3, fr = lane & 15, fq = lane >> 4;
        if (wr == 1) {
#pragma unroll
            for (int q = 0; q < 4; ++q) *(float4*)(xch + ((wc * 64 + lane) * 16) + 4 * q) = make_float4(Lk[4 * q], Lk[4 * q + 1], Lk[4 * q + 2], Lk[4 * q + 3]);
        }
        __syncthreads();
        if (wr == 0) {
            float L1[16];
#pragma unroll
            for (int q = 0; q < 4; ++q) { const float4 v = *(const float4*)(xch + ((wc * 64 + lane) * 16) + 4 * q); L1[4 * q] = v.x; L1[4 * q + 1] = v.y; L1[4 * q + 2] = v.z; L1[4 * q + 3] = v.w; }
            float c[16];
            cand_top16(Lk, L1, c);
            unsigned char* my = (unsigned char*)lds + te * 32;
            {
                uint4 a, b;
#define PK4(L, i) ((__float_as_uint(L[i]) & 127u) | ((__float_as_uint(L[i + 1]) & 127u) << 8) | ((__float_as_uint(L[i + 2]) & 127u) << 16) | ((__float_as_uint(L[i + 3]) & 127u) << 24))
                a.x = PK4(Lk, 0); a.y = PK4(Lk, 4); a.z = PK4(Lk, 8); a.w = PK4(Lk, 12);
                b.x = PK4(L1, 0); b.y = PK4(L1, 4); b.z = PK4(L1, 8); b.w = PK4(L1, 12);
#undef PK4
                *(uint4*)my = a; *(uint4*)(my + 16) = b;
            }
            const int t = tm * 256 + (fq >> 1) * 128 + wc * 32 + (fq & 1) * 16 + fr;
            const float xs_t = XSc[t];
            int ev[16]; float gv[16]; float den = 0.f;
#pragma unroll
            for (int k = 0; k < 16; ++k) {
                const unsigned ci = __float_as_uint(c[k]) & 255u;
                const int n1 = my[ci >> 4], n2 = my[16 + (ci & 15)];
                ev[k] = n1 * NKEY + n2;
                gv[k] = __expf((c[k] - c[0]) * xs_t); den += gv[k];
            }
            const float iden = 1.f / den;
            uint4* ep = (uint4*)(EXPp + (size_t)t * HK + h * 16);
            float4* gp = (float4*)(GATEp + (size_t)t * HK + h * 16);
#pragma unroll
            for (int q = 0; q < 4; ++q) {
                ep[q] = make_uint4((unsigned)ev[4 * q], (unsigned)ev[4 * q + 1], (unsigned)ev[4 * q + 2], (unsigned)ev[4 * q + 3]);
                gp[q] = make_float4(gv[4 * q] * iden, gv[4 * q + 1] * iden, gv[4 * q + 2] * iden, gv[4 * q + 3] * iden);
            }
        }
        __syncthreads();
    }
}

constexpr size_t WS_PART = WS_PROJ;
static_assert((size_t)8 * T * HK * 4 <= WS_K - WS_PROJ, "PART alias");
constexpr int XI_X = 0, XI_RANK = 1, XI_J = 2, XI_NX = 3, XI_NLOC = 4;
constexpr int CTL_CENSUS = 4096;
constexpr int CTL_BYTES = (CTL_CENSUS + 16) * 4;

template <int M1, int M2, int M3, class TT>
__device__ __forceinline__ void red16x3(TT (&p)[16], int lane) {
#pragma unroll
    for (int i = 0; i < 8; ++i) { const bool up = lane & M1; const TT send = up ? p[i] : p[i + 8], keep = up ? p[i + 8] : p[i]; p[i] = keep + __shfl_xor(send, M1, 64); }
#pragma unroll
    for (int i = 0; i < 4; ++i) { const bool up = lane & M2; const TT send = up ? p[i] : p[i + 4], keep = up ? p[i + 4] : p[i]; p[i] = keep + __shfl_xor(send, M2, 64); }
#pragma unroll
    for (int i = 0; i < 2; ++i) { const bool up = lane & M3; const TT send = up ? p[i] : p[i + 2], keep = up ? p[i + 2] : p[i]; p[i] = keep + __shfl_xor(send, M3, 64); }
}
__device__ __forceinline__ void phase_gu(const Params& P, int l, const volatile int* xi) {
    const unsigned char* XQ = P.ws + WS_XQ;
    const float* XSc = (const float*)(P.ws + WS_XS);
    const int* EXPp = (const int*)(P.ws + WS_EXP);
    float* PART = (float*)(P.ws + WS_PART);
    const int tid = tidx(), lane = tid & 63, w = tid >> 6, g = lane >> 3, c = lane & 7;
    int xo_ = 0; asm volatile("" : "+v"(xo_));
    const int j = __builtin_amdgcn_readfirstlane(xi[xo_ + XI_J]), nx = __builtin_amdgcn_readfirstlane(xi[xo_ + XI_NX]), nloc = __builtin_amdgcn_readfirstlane(xi[xo_ + XI_NLOC]), rank = __builtin_amdgcn_readfirstlane(xi[xo_ + XI_RANK]);
    const int t0 = rank * NW + w, st = nloc * NW;
    const int n = (t0 < T) ? (T - t0 + st - 1) / st : 0;
    const int i0 = 8 * (c & 1) + 4 * ((c >> 1) & 1) + 2 * ((c >> 2) & 1);
    for (int sl = j; sl < 8 && n > 0; sl += nx) {
        const unsigned char* Us = P.ws + WS_TABU + ((size_t)(l * 8 + sl) * NEXP) * 128;
        const unsigned co = (unsigned)c << 4;
        float* part = PART + (size_t)sl * T * HK;
        const unsigned char* xs = XQ + sl * 128 + c * 16;
#define GU_TK(k) (t0 + (((k) < n) ? (k) : (n - 1)) * st)
#define GU_LOADE(S, t) do { S##lo = EXPp[(size_t)(t) * HK + lane]; S##hi = EXPp[(size_t)(t) * HK + 64 + lane]; } while (0)
#define GU_LOADX(S, t) do { S##a = *(const uint4*)(xs + (size_t)(t) * XQP); S##s = XSc[t]; } while (0)
#define GU_ISSUE(R, S) do { _Pragma("unroll") for (int i = 0; i < 16; ++i) { \
            const int e = __builtin_amdgcn_ds_bpermute((((8 * i) & 63) + g) << 2, (i < 8) ? S##lo : S##hi); R[i] = *(const uint4*)(Us + (((unsigned)e << 7) | co)); } } while (0)
#define GU_FINISH(R, S, t) do { \
            int p[16]; \
            _Pragma("unroll") for (int i = 0; i < 16; ++i) { int d_ = __builtin_amdgcn_sdot4((int)S##a.x, (int)R[i].x, 0, false); d_ = __builtin_amdgcn_sdot4((int)S##a.y, (int)R[i].y, d_, false); \
                d_ = __builtin_amdgcn_sdot4((int)S##a.z, (int)R[i].z, d_, false); p[i] = __builtin_amdgcn_sdot4((int)S##a.w, (int)R[i].w, d_, false); } \
            red16x3<1, 2, 4, int>(p, lane); \
            part[(size_t)(t) * HK + 8 * i0 + g] = (float)p[0] * S##s; part[(size_t)(t) * HK + 8 * (i0 + 1) + g] = (float)p[1] * S##s; } while (0)
        int eAlo, eAhi, eBlo, eBhi; uint4 xAa, xBa; float xAs, xBs; uint4 rA[16], rB[16];
        GU_LOADE(eA, GU_TK(0)); GU_LOADX(xA, GU_TK(0)); GU_LOADE(eB, GU_TK(1));
        GU_ISSUE(rA, eA);
        for (int k = 0; k < n; k += 2) {
            GU_LOADX(xB, GU_TK(k + 1)); GU_ISSUE(rB, eB); GU_LOADE(eA, GU_TK(k + 2));
            GU_FINISH(rA, xA, GU_TK(k));
            GU_LOADX(xA, GU_TK(k + 2)); GU_ISSUE(rA, eA); GU_LOADE(eB, GU_TK(k + 3));
            GU_FINISH(rB, xB, GU_TK(k + 1));
        }
#undef GU_TK
#undef GU_LOADE
#undef GU_LOADX
#undef GU_ISSUE
#undef GU_FINISH
    }
}
__device__ __forceinline__ void phase_gw(const Params& P, int l) {
    const int* EXPp = (const int*)(P.ws + WS_EXP);
    const float* GATEp = (const float*)(P.ws + WS_GATE);
    const float* PART = (const float*)(P.ws + WS_PART);
    const float* SU = (const float*)(P.ws + WS_TSCU) + (size_t)l * NEXP;
    const float* SV = (const float*)(P.ws + WS_TSCV) + (size_t)l * NEXP;
    unsigned char* WQ = P.ws + WS_WQ8;
    float* WSC = (float*)(P.ws + WS_WSC);
    const int lane = tidx() & 63;
    for (int tb = gwave() * 4; tb < T; tb += nwave() * 4) {
        float wv[4][2];
#pragma unroll
        for (int q = 0; q < 4; ++q)
#pragma unroll
            for (int hk = 0; hk < 2; ++hk) {
                const size_t i = (size_t)(tb + q) * HK + hk * 64 + lane;
                float s = 0.f;
#pragma unroll
                for (int x = 0; x < 8; ++x) s += PART[(size_t)x * T * HK + i];
                const int e = EXPp[i];
                wv[q][hk] = GATEp[i] * gelu_exact(s * SU[e]) * SV[e];
            }
#pragma unroll
        for (int q = 0; q < 4; ++q) {
            float am = fmaxf(fabsf(wv[q][0]), fabsf(wv[q][1]));
#pragma unroll
            for (int m = 32; m >= 1; m >>= 1) am = fmaxf(am, __shfl_xor(am, m, 64));
            const float sc = (am > 0.f) ? am * (1.f / 448.f) : 1.f, is = 1.f / sc;
            const int pk = __builtin_amdgcn_cvt_pk_fp8_f32(wv[q][0] * is, wv[q][1] * is, 0, false);
            WQ[(size_t)(tb + q) * HK + lane] = (unsigned char)(pk & 255);
            WQ[(size_t)(tb + q) * HK + 64 + lane] = (unsigned char)((pk >> 8) & 255);
            if (lane == 0) WSC[tb + q] = sc;
        }
    }
}
typedef int v2i_t __attribute__((ext_vector_type(2)));
typedef unsigned u32x4_t __attribute__((ext_vector_type(4)));
typedef __attribute__((ext_vector_type(4))) float f32x4;
constexpr int GV_PIECE = 1024 + 16;
constexpr int GV_TILE = 16 * GV_PIECE;
static_assert(NW * GV_TILE + NW * 512 <= LDS_TOTAL, "gv LDS");
__device__ __forceinline__ void phase_gv(const Params& P, int l, const volatile int* xi, char* lds) {
    const int* EXPp = (const int*)(P.ws + WS_EXP);
    const unsigned char* WQ = P.ws + WS_WQ8;
    const float* WSC = (const float*)(P.ws + WS_WSC);
    const int tid = tidx(), lane = tid & 63, w = __builtin_amdgcn_readfirstlane(tid >> 6), g = lane >> 3, pos = lane & 7;
    int xo_ = 0; asm volatile("" : "+v"(xo_));
    const int j = __builtin_amdgcn_readfirstlane(xi[xo_ + XI_J]), nx = __builtin_amdgcn_readfirstlane(xi[xo_ + XI_NX]), nloc = __builtin_amdgcn_readfirstlane(xi[xo_ + XI_NLOC]), rank = __builtin_amdgcn_readfirstlane(xi[xo_ + XI_RANK]);
    const int t0 = rank * NW + w, st = nloc * NW;
    const int n = (t0 < T) ? (T - t0 + st - 1) / st : 0;
    char* tile = lds + w * GV_TILE;
    float* strip = (float*)(lds + NW * GV_TILE) + w * 128;
    typedef __attribute__((address_space(3))) v2i_t* ldsv2_t;
    const unsigned co = (unsigned)(pos ^ g) << 4;
    const int rr = (lane & 15) >> 1, kq = lane >> 4;
    const int rdo = kq * GV_PIECE + rr * 128 + (lane & 1) * 8;
    const bool row0 = (lane & 15) == 0;
    __syncthreads();
    for (int sl = j; sl < 8 && n > 0; sl += nx) {
        const unsigned char* Vs = P.ws + WS_TABV + ((size_t)(l * 8 + sl) * NEXP) * 128;
        const char* hrow = (const char*)P.out + sl * 256 + 4 * lane;
#define GV_TK(k) (t0 + (((k) < n) ? (k) : (n - 1)) * st)
#define GV_LOADE(S, t) do { S##el = EXPp[(size_t)(t) * HK + lane]; S##eh = EXPp[(size_t)(t) * HK + 64 + lane]; } while (0)
#define GV_ISSUE(R, S) do { _Pragma("unroll") for (int i = 0; i < 16; ++i) { \
            const int e = __builtin_amdgcn_ds_bpermute((((8 * i) & 63) + g) << 2, (i < 8) ? S##el : S##eh); R[i] = *(const u32x4_t*)(Vs + (((unsigned)e << 7) | co)); } } while (0)
#define GV_LOADT(S, kk) do { const int t_ = GV_TK(kk); \
            S##a0 = 0; S##a1 = 0; S##a2 = 0; S##a3 = 0; \
            if (row0) { const long* wp = (const long*)(WQ + (size_t)t_ * HK + kq * 8); S##a0 = wp[0]; S##a1 = wp[4]; S##a2 = wp[8]; S##a3 = wp[12]; } \
            S##ws = ((kk) < n) ? WSC[t_] : 0.f; \
            S##hv = *(const unsigned*)(hrow + (size_t)t_ * (HP * 2)); } while (0)
#define GV_TOKEN(R, S, kk) do { \
            const int t = GV_TK(kk); \
            _Pragma("unroll") for (int i = 0; i < 16; ++i) *(u32x4_t*)(tile + i * GV_PIECE + lane * 16) = R[i]; \
            f32x4 acc[8]; \
            _Pragma("unroll") for (int nt = 0; nt < 8; ++nt) acc[nt] = (f32x4){0.f, 0.f, 0.f, 0.f}; \
            _Pragma("unroll") for (int s4 = 0; s4 < 4; ++s4) { \
                const long av = (s4 == 0) ? S##a0 : (s4 == 1) ? S##a1 : (s4 == 2) ? S##a2 : S##a3; \
                _Pragma("unroll") for (int nt = 0; nt < 8; ++nt) { \
                    const v2i_t bv = __builtin_amdgcn_ds_read_tr8_b64_v2i32((ldsv2_t)(void*)(tile + (4 * s4) * GV_PIECE + rdo + ((nt ^ rr) << 4))); \
                    acc[nt] = __builtin_amdgcn_mfma_f32_16x16x32_fp8_fp8(av, __builtin_bit_cast(long, bv), acc[nt], 0, 0, 0); } } \
            if (lane < 16) { _Pragma("unroll") for (int nt = 0; nt < 8; ++nt) strip[16 * nt + lane] = acc[nt][0]; }        \
            { const float2 o2 = *(const float2*)(strip + 2 * lane); \
              if ((kk) < n) *(unsigned*)(hrow + (size_t)t * (HP * 2)) = pack2(bflo(S##hv) + S##ws * o2.x, bfhi(S##hv) + S##ws * o2.y); } } while (0)
        int Ael, Aeh, Bel, Beh; u32x4_t rA[16], rB[16];
        long Pa0, Pa1, Pa2, Pa3, Qa0, Qa1, Qa2, Qa3; float Pws, Qws; unsigned Phv, Qhv;
        GV_LOADE(A, GV_TK(0)); GV_LOADE(B, GV_TK(1));
        GV_ISSUE(rA, A); GV_LOADT(P, 0);
        for (int k = 0; k < n; k += 2) {
            GV_ISSUE(rB, B); GV_LOADE(A, GV_TK(k + 2)); GV_LOADT(Q, k + 1);
            GV_TOKEN(rA, P, k);
            GV_ISSUE(rA, A); GV_LOADE(B, GV_TK(k + 3)); GV_LOADT(P, k + 2);
            GV_TOKEN(rB, Q, k + 1);
        }
#undef GV_TK
#undef GV_LOADE
#undef GV_ISSUE
#undef GV_LOADT
#undef GV_TOKEN
    }
    __syncthreads();
}
__device__ __forceinline__ void phase_gnorm(const Params& P, int l) {
    const int lane = tidx() & 63, nw = nwave();
    unsigned* xq = (unsigned*)(P.ws + WS_XQ);
    float* xsc = (float*)(P.ws + WS_XS);
    const bf16* Hb = (const bf16*)P.out;
    const float4* g = (const float4*)((l == DEPTH - 1) ? P.norm_final : (P.norm_mix + (l + 1) * D));
    for (int t = gwave(); t < T; t += 2 * nw) {
        const int t2 = (t + nw < T) ? (t + nw) : t;
        float4 v[2][4];
#pragma unroll
        for (int q = 0; q < 4; ++q) {
            const uint2 a = ((const uint2*)(Hb + (size_t)t * HP))[q * 64 + lane], b = ((const uint2*)(Hb + (size_t)t2 * HP))[q * 64 + lane];
            v[0][q] = make_float4(bflo(a.x), bfhi(a.x), bflo(a.y), bfhi(a.y)); v[1][q] = make_float4(bflo(b.x), bfhi(b.x), bflo(b.y), bfhi(b.y));
        }
#pragma unroll
        for (int u = 0; u < 2; ++u) {
            float ss = 0.f;
#pragma unroll
            for (int q = 0; q < 4; ++q) ss += v[u][q].x * v[u][q].x + v[u][q].y * v[u][q].y + v[u][q].z * v[u][q].z + v[u][q].w * v[u][q].w;
            ss = wave_sum(ss);
            const float rn = rsqrtf(ss * (1.f / D) + EPS);
            const int tt = u ? t2 : t;
            if (u == 0 || t2 != t) {
                float4* hr = (float4*)(P.out + (size_t)tt * D);
                float am = 0.f;
#pragma unroll
                for (int q = 0; q < 4; ++q) {
                    const float4 gg = g[q * 64 + lane];
                    v[u][q] = make_float4(v[u][q].x * rn * gg.x, v[u][q].y * rn * gg.y, v[u][q].z * rn * gg.z, v[u][q].w * rn * gg.w);
                    am = fmaxf(am, fmaxf(fmaxf(fabsf(v[u][q].x), fabsf(v[u][q].y)), fmaxf(fabsf(v[u][q].z), fabsf(v[u][q].w))));
                    if (l == DEPTH - 1) hr[q * 64 + lane] = v[u][q];
                }
                if (l != DEPTH - 1) {
#pragma unroll
                    for (int m = 32; m >= 1; m >>= 1) am = fmaxf(am, __shfl_xor(am, m, 64));
                    const float sc = (am > 0.f) ? am * (1.f / 127.f) : 1.f, is = 1.f / sc;
#pragma unroll
                    for (int q = 0; q < 4; ++q) xq[(size_t)tt * (XQP / 4) + q * 64 + lane] = pack_i8x4(v[u][q].x * is, v[u][q].y * is, v[u][q].z * is, v[u][q].w * is);
                    if (lane == 0) xsc[tt] = sc;
                }
            }
        }
    }
}

#define XB_TMO      128
#define XB_XCNT(j)  (256  + 64 * (j))
#define XB_XSUB(j)  (1280 + 64 * (j))
#define XB_XGEN(j)  (2304 + 64 * (j))
#define XB_TOP      3328
#define XB_TOPGEN   3392
#define XCD_BAR_WORDS 3456
#define XB_SPIN_CAP (1u << 22)
#define LAS __attribute__((address_space(3)))
__device__ __forceinline__ unsigned xb_ld(unsigned* p)              { return __hip_atomic_load(p, __ATOMIC_RELAXED, __HIP_MEMORY_SCOPE_AGENT); }
__device__ __forceinline__ unsigned xb_add(unsigned* p, unsigned v) { return __hip_atomic_fetch_add(p, v, __ATOMIC_RELAXED, __HIP_MEMORY_SCOPE_AGENT); }
__device__ __forceinline__ unsigned xb_xcc_id() { return (unsigned)__builtin_amdgcn_s_getreg((3 << 11) | 20) & 0xFu; }
#define XB_SPIN(cond, bar) do { unsigned _sp = 0; while (cond) { __builtin_amdgcn_s_sleep(1); \
    if ((++_sp & 255u) == 0u) { if (xb_ld(&(bar)[XB_TMO])) break; if (_sp > XB_SPIN_CAP) { atomicAdd(&(bar)[XB_TMO], 1u); break; } } } } while (0)
struct XcdBarrier { unsigned* bar; unsigned x; volatile LAS unsigned* st; };
__device__ __forceinline__ XcdBarrier xcd_barrier_post(unsigned* bar, volatile LAS unsigned* st) {
    XcdBarrier b; b.bar = bar; b.x = xb_xcc_id(); b.st = st;
    if (__builtin_amdgcn_workitem_id_x() == 0) (void)xb_add(&bar[XB_XCNT(b.x)], 1u);
    return b;
}
__device__ __forceinline__ void xcd_barrier_complete(unsigned* bar, unsigned x, unsigned& nloc, unsigned& nx) {
    const unsigned G = gridDim.x * gridDim.y * gridDim.z;
    unsigned sum, cnt, mine, sp = 0u;
    for (;;) {
        sum = 0u; cnt = 0u; mine = 0u;
#pragma unroll
        for (unsigned j = 0; j < 16; ++j) { const unsigned c = xb_ld(&bar[XB_XCNT(j)]); sum += c; cnt += (c > 0u) ? 1u : 0u; mine = (j == x) ? c : mine; }
        if (sum == G) break;
        __builtin_amdgcn_s_sleep(1);
        if ((++sp & 255u) == 0u) { if (xb_ld(&bar[XB_TMO])) break; if (sp > XB_SPIN_CAP) { atomicAdd(&bar[XB_TMO], 1u); break; } }
    }
    nloc = mine > 0u ? mine : 1u; nx = cnt > 0u ? cnt : 1u;
}
__device__ __forceinline__ void xcd_barrier(const XcdBarrier& b) {
    asm volatile("s_waitcnt vmcnt(0)" ::: "memory");
    __syncthreads();
    if (__builtin_amdgcn_workitem_id_x() == 0) {
        unsigned* bar = b.bar;
        __builtin_amdgcn_s_waitcnt(0);
        unsigned nloc = b.st[0], nx = b.st[1];
        if (nloc == 0u) { xcd_barrier_complete(bar, b.x, nloc, nx); b.st[0] = nloc; b.st[1] = nx; }
        const unsigned old = xb_add(&bar[XB_XSUB(b.x)], 1u);
        const unsigned gen = old / nloc;
        if (old + 1u == (gen + 1u) * nloc) {
            __builtin_amdgcn_fence(__ATOMIC_RELEASE, "agent");
            asm volatile("s_waitcnt vmcnt(0)" ::: "memory");
            const unsigned og = xb_add(&bar[XB_TOP], 1u);
            const unsigned tg = og / nx;
            if (og + 1u == (tg + 1u) * nx) xb_add(&bar[XB_TOPGEN], 1u);
            else XB_SPIN(xb_ld(&bar[XB_TOPGEN]) == tg, bar);
            __builtin_amdgcn_fence(__ATOMIC_ACQUIRE, "agent");
            xb_add(&bar[XB_XGEN(b.x)], 1u);
            asm volatile("s_waitcnt vmcnt(0)" ::: "memory");
        } else {
            XB_SPIN(xb_ld(&bar[XB_XGEN(b.x)]) == gen, bar);
            __builtin_amdgcn_fence(__ATOMIC_ACQUIRE, "agent");
            asm volatile("s_waitcnt vmcnt(0)" ::: "memory");
        }
    }
    __syncthreads();
}

constexpr float QSCALE = 0.10206207261596575f * 1.4426950408889634f;

__device__ __forceinline__ void phase_gemm1(const Params& P, int l, char* lds) {
    unsigned char* ws = P.ws;
    const bf16* XN = (const bf16*)(ws + WS_XN);
    bf16* PROJ = (bf16*)(ws + WS_PROJ);
    bf16* Kb = (bf16*)(ws + WS_K);
    const float* rope = (const float*)(ws + WS_ROPE);
    const bf16* W = (const bf16*)(ws + WS_WIN) + (size_t)l * DINP * LDW;
    float* SSQ = (float*)(ws + WS_SSQ);
    const int lane = tidx() & 63;
    const bf16* W8 = (const bf16*)(ws + WS_WI8 + (size_t)l * DINP * XQP);
    const bf16* XQb = (const bf16*)(ws + WS_XQ);
    const float* XSc = (const float*)(ws + WS_XS);
    const float* WIS = (const float*)(ws + WS_WIS) + (size_t)l * DINP;
    int tlo, thi, tst; tile_rounds((T / 256) * (DINP / 256), tlo, thi, tst);
    gemm_t8<true, false, true>(W8, XQP / 2, DINP, XQb, XQP / 2, D / 2, tlo, thi, tst, [&](int t, int n, const float4& v, const float4&) {
        const int nb = __builtin_amdgcn_readfirstlane(n);
        if (nb < C_KR) {
            uint2 o; o.x = cvtpk(v.x, v.y); o.y = cvtpk(v.z, v.w);
            *(uint2*)(PROJ + (size_t)t * DINP + n) = o;
            if (nb >= C_CQ) {
                float q = v.x * v.x + v.y * v.y + v.z * v.z + v.w * v.w;
                q += __shfl_xor(q, 1, 64); q += __shfl_xor(q, 2, 64); q += __shfl_xor(q, 4, 64); q += __shfl_xor(q, 8, 64);
                if (n == nb) SSQ[(size_t)t * 16 + ((nb - C_CQ) >> 6)] = q;
            }
        } else if (nb == C_KR) {
            const float4 up = make_float4(__shfl(v.x, lane + 4, 64), __shfl(v.y, lane + 4, 64), __shfl(v.z, lane + 4, 64), __shfl(v.w, lane + 4, 64));
            const float4 dn = make_float4(__shfl(v.x, lane - 4, 64), __shfl(v.y, lane - 4, 64), __shfl(v.z, lane - 4, 64), __shfl(v.w, lane - 4, 64));
            const int d = n - C_KR;
            if (d < 32) {
                const int b = t / S, s = t % S;
                const bool first = d < 16;
                const int f = first ? d : (d - 16);
                const float4 cs0 = *(const float4*)(rope + ((size_t)s * 16 + f) * 2), cs1 = *(const float4*)(rope + ((size_t)s * 16 + f) * 2 + 4);
                float4 o;
                if (first) o = make_float4(v.x * cs0.x - up.x * cs0.y, v.y * cs0.z - up.y * cs0.w, v.z * cs1.x - up.z * cs1.y, v.w * cs1.z - up.w * cs1.w);
                else       o = make_float4(v.x * cs0.x + dn.x * cs0.y, v.y * cs0.z + dn.y * cs0.w, v.z * cs1.x + dn.z * cs1.y, v.w * cs1.z + dn.w * cs1.w);
                uint2 u; u.x = cvtpk(o.x, o.y); u.y = cvtpk(o.z, o.w);
#pragma unroll
                for (int h = 0; h < NH; ++h) *(uint2*)(Kb + ((size_t)(b * NH + h) * S + s) * DQK + 64 + d) = u;
            }
        }
    }, [&](int t) { return XSc[t]; }, [](int, int) { return make_float4(0.f, 0.f, 0.f, 0.f); }, [&](int n) { return *(const float4*)(WIS + n); }, lds);
}
__device__ __forceinline__ void phase_gemm2(const Params& P, int l, char* lds) {
    unsigned char* ws = P.ws;
    const bf16* PROJ = (const bf16*)(ws + WS_PROJ);
    const float* rope = (const float*)(ws + WS_ROPE);
    const float* SSQ = (const float*)(ws + WS_SSQ);
    const int G = gridDim.x, bid = blockIdx.x;
    const int vb = ((G & 7) == 0) ? ((bid & 7) * (G >> 3) + (bid >> 3)) : bid;
    int qlo, qhi, klo, khi;
    if ((G & 1) == 0) {
        const int Gh = G >> 1, pq = (384 + Gh - 1) / Gh, pk = (512 + Gh - 1) / Gh;
        if (vb < Gh) { qlo = vb * pq; qhi = qlo + pq; if (qhi > 384) qhi = 384; if (qlo > 384) qlo = 384; klo = 0; khi = 0; }
        else { klo = (vb - Gh) * pk; khi = klo + pk; if (khi > 512) khi = 512; if (klo > 512) klo = 512; qlo = 0; qhi = 0; }
    } else { tile_range(384, qlo, qhi); tile_range(512, klo, khi); }
    {
        const bf16* W = (const bf16*)(ws + WS_WUQ) + (size_t)l * 768 * QR;
        bf16* Qb = (bf16*)(ws + WS_Q);
        gemm_t8<true, false, false>(W, QR, 768, PROJ + C_CQ, DINP, QR, qlo, qhi, 1,
            [&](int t, int n, const float4& v, const float4&) {
                const int b = t / S, s = t % S, h = n / DQK, d = n % DQK;
                float4 o = v;
                const int lane = tidx() & 63;
                const float4 up = make_float4(__shfl(v.x, lane + 4, 64), __shfl(v.y, lane + 4, 64), __shfl(v.z, lane + 4, 64), __shfl(v.w, lane + 4, 64));
                const float4 dn = make_float4(__shfl(v.x, lane - 4, 64), __shfl(v.y, lane - 4, 64), __shfl(v.z, lane - 4, 64), __shfl(v.w, lane - 4, 64));
                if (d >= 64) {
                    const bool first = d < 80;
                    const int f = first ? (d - 64) : (d - 80);
                    const float4 cs0 = *(const float4*)(rope + ((size_t)s * 16 + f) * 2), cs1 = *(const float4*)(rope + ((size_t)s * 16 + f) * 2 + 4);
                    if (first) o = make_float4(v.x * cs0.x - up.x * cs0.y, v.y * cs0.z - up.y * cs0.w, v.z * cs1.x - up.z * cs1.y, v.w * cs1.z - up.w * cs1.w);
                    else       o = make_float4(v.x * cs0.x + dn.x * cs0.y, v.y * cs0.z + dn.y * cs0.w, v.z * cs1.x + dn.z * cs1.y, v.w * cs1.z + dn.w * cs1.w);
                }
                uint2 u; u.x = cvtpk(o.x, o.y); u.y = cvtpk(o.z, o.w);
                *(uint2*)(Qb + ((size_t)(b * NH + h) * S + s) * DQK + d) = u;
            }, [&](int t) { const float4 a = *(const float4*)(SSQ + (size_t)t * 16); const float2 b = *(const float2*)(SSQ + (size_t)t * 16 + 4);
                            return rsqrtf(((a.x + a.y) + (a.z + a.w) + (b.x + b.y)) * (1.f / QR) + EPS) * QSCALE; }, [](int, int) { return make_float4(0.f, 0.f, 0.f, 0.f); }, [](int) { return make_float4(1.f, 1.f, 1.f, 1.f); }, lds);
    }
    {
        const bf16* W = (const bf16*)(ws + WS_WUKV) + (size_t)l * 1024 * KVR;
        bf16* Kb = (bf16*)(ws + WS_K); bf16* Vb = (bf16*)(ws + WS_V);
        gemm_t8<true, false, false>(W, KVR, 1024, PROJ + C_CKV, DINP, KVR, klo, khi, 1,
            [&](int t, int n, const float4& v, const float4&) {
                const int b = t / S, s = t % S;
                uint2 u; u.x = cvtpk(v.x, v.y); u.y = cvtpk(v.z, v.w);
                if (n < 512) *(uint2*)(Kb + ((size_t)(b * NH + (n >> 6)) * S + s) * DQK + (n & 63)) = u;
                else         *(uint2*)(Vb + ((size_t)(b * NH + ((n - 512) >> 6)) * S + s) * DV + (n & 63)) = u;
            }, [&](int t) { const float2 a = *(const float2*)(SSQ + (size_t)t * 16 + 6); const float2 b = *(const float2*)(SSQ + (size_t)t * 16 + 8);
                            return rsqrtf(((a.x + a.y) + (b.x + b.y)) * (1.f / KVR) + EPS); }, [](int, int) { return make_float4(0.f, 0.f, 0.f, 0.f); }, [](int) { return make_float4(1.f, 1.f, 1.f, 1.f); }, lds);
    }
}
constexpr size_t WS_YO = WS_PROJ;
__device__ __forceinline__ void phase_gemm3(const Params& P, int l, char* lds) {
    unsigned char* ws = P.ws;
    const bf16* Yb = (const bf16*)(ws + WS_XN);
    const bf16* W = (const bf16*)(ws + WS_WOUT) + (size_t)l * D * LDW;
    bf16* YO = (bf16*)(ws + WS_YO);
    int tlo, thi, tst; tile_rounds((T / 256) * (D / 256), tlo, thi, tst);
    gemm_t8<false, false, false>(W, LDW, D, Yb, LDX, D, tlo, thi, tst, [&](int t, int n, const float4& v, const float4&) {
        uint2 o; o.x = cvtpk(v.x, v.y); o.y = cvtpk(v.z, v.w);
        *(uint2*)(YO + (size_t)t * D + n) = o;
    }, [](int) { return 1.f; }, [](int, int) { return make_float4(0.f, 0.f, 0.f, 0.f); }, [](int) { return make_float4(1.f, 1.f, 1.f, 1.f); }, lds);
}

#define GSYNC() do { XcdBarrier xb_; { __attribute__((address_space(1))) char* gp_ = (__attribute__((address_space(1))) char*)(char*)(P.ws + WS_CTL); asm volatile("" : "+s"(gp_)); xb_.bar = (unsigned*)(char*)gp_; } \
    xb_.x = xb_xcc_id(); xb_.st = (volatile LAS unsigned*)&xb_words; xcd_barrier(xb_); } while (0)
#define PHASE(stmt) { const Params Q = launder(P); stmt; }
__global__ void __launch_bounds__(NTHREADS, 2) k_all(Params P) {
    __shared__ __attribute__((aligned(16))) char sm[LDS_TOTAL];
    __shared__ uint4 xb_words;
    cg::grid_group grid = cg::this_grid();
    if (__builtin_amdgcn_workitem_id_x() == 0) xb_words = make_uint4(0u, 0u, 0u, 0u);
    __syncthreads();
    (void)xcd_barrier_post((unsigned*)(P.ws + WS_CTL), (volatile LAS unsigned*)&xb_words);
    __shared__ int xinfo[8];
    if (__builtin_amdgcn_workitem_id_x() == 0) {
        const unsigned x = xb_xcc_id();
        xinfo[XI_X] = (int)x; xinfo[XI_RANK] = (int)xb_add((unsigned*)(P.ws + WS_CTL) + CTL_CENSUS + x, 1u);
    }
    PHASE(phase_prep(Q, sm));
    if (P.ws == nullptr) grid.sync();
    GSYNC();
    PHASE(phase_norm(Q.x, Q.norm_mix, (unsigned*)(Q.ws + WS_XQ), (float*)(Q.ws + WS_XS)));
    PHASE(quant_wrows((const bf16*)(Q.ws + WS_WPQ), DEPTH * 2048, Q.ws + WS_WC8, (float*)(Q.ws + WS_WCS)));
    PHASE(quant_wrows((const bf16*)(Q.ws + WS_WIN), DEPTH * DINP, Q.ws + WS_WI8, (float*)(Q.ws + WS_WIS)));
    GSYNC();
    if (__builtin_amdgcn_workitem_id_x() == 0) {
        unsigned* cen = (unsigned*)(P.ws + WS_CTL) + CTL_CENSUS;
        const int x = xinfo[XI_X]; int nx = 0, jj = 0;
        for (int q = 0; q < 16; ++q) { const unsigned cq = xb_ld(cen + q); if (cq) { if (q < x) ++jj; ++nx; } }
        xinfo[XI_J] = jj; xinfo[XI_NX] = nx; xinfo[XI_NLOC] = (int)xb_ld(cen + x);
    }
    __syncthreads();
    for (int l = 0; l < DEPTH; ++l) {
        PHASE(phase_gemm1(Q, l, sm));
#if PROBE_DUP & 2
        PHASE(phase_gemm1(Q, l, sm));
#endif
        GSYNC();
        PHASE(phase_mixlocal(Q, l, sm));
#if PROBE_DUP & 256
        PHASE(phase_mixlocal(Q, l, sm));
#endif
        PHASE(phase_gemm2(Q, l, sm));
#if PROBE_DUP & 4
        PHASE(phase_gemm2(Q, l, sm));
#endif
        GSYNC();
        PHASE(phase_attn(Q, sm));
#if PROBE_DUP & 8
        PHASE(phase_attn(Q, sm));
#endif
        GSYNC();
        PHASE(phase_gemm3(Q, l, sm));
#if PROBE_DUP & 16
        if (l == 0) PHASE(phase_gemm3(Q, l, sm));
#endif
        GSYNC();
        PHASE(phase_norm_q(Q, l));
#if PROBE_DUP & 512
        PHASE(phase_norm_q(Q, l));
#endif
        GSYNC();
        PHASE(phase_route(Q, l, sm));
#if PROBE_DUP & 32
        PHASE(phase_route(Q, l, sm));
#endif
        GSYNC();
        PHASE(phase_gu(Q, l, xinfo));
#if PROBE_DUP & 64
        PHASE(phase_gu(Q, l, xinfo));
#endif
        GSYNC();
        PHASE(phase_gw(Q, l));
#if PROBE_DUP & 128
        PHASE(phase_gw(Q, l));
#endif
        GSYNC();
        PHASE(phase_gv(Q, l, xinfo, sm));
        GSYNC();
        PHASE(phase_gnorm(Q, l));
        if (l + 1 < DEPTH) GSYNC();
    }
}

extern "C" void kernel_launch(void* const* d_in, const int* in_sizes, int n_in, void* d_out, int out_size, void* d_ws, size_t ws_size, hipStream_t stream) {
    static int grid = 0;
    if (grid == 0) {
        if (n_in != 18 || out_size != T * D || ws_size < WS_END) { fprintf(stderr, "kernel_launch: bad sizes n_in %d out %d ws %zu need %zu\n", n_in, out_size, ws_size, (size_t)WS_END); grid = -1; return; }
        int dev = 0, cus = 0, per_cu = 0;
        (void)hipGetDevice(&dev);
        (void)hipDeviceGetAttribute(&cus, hipDeviceAttributeMultiprocessorCount, dev);
        (void)hipOccupancyMaxActiveBlocksPerMultiprocessor(&per_cu, (const void*)k_all, NTHREADS, 0);
        if (per_cu > 1) per_cu = 1;
        if (per_cu < 1) { fprintf(stderr, "kernel_launch: occupancy query says %d\n", per_cu); grid = -1; return; }
        grid = cus * per_cu;
    }
    if (grid < 0) return;
    Params p{};
    p.x = (const float*)d_in[0]; p.norm_mix = (const float*)d_in[1]; p.w_in = (const float*)d_in[2]; p.conv_w = (const float*)d_in[3];
    p.pool_w = (const float*)d_in[4]; p.pool_scale = (const float*)d_in[5]; p.q_norm = (const float*)d_in[6]; p.w_uq = (const float*)d_in[7];
    p.kv_norm = (const float*)d_in[8]; p.w_uk = (const float*)d_in[9]; p.w_uv = (const float*)d_in[10]; p.w_out = (const float*)d_in[11];
    p.norm_ffn = (const float*)d_in[12]; p.peer_wq = (const float*)d_in[13]; p.peer_subkeys = (const float*)d_in[14]; p.peer_u = (const float*)d_in[15];
    p.peer_v = (const float*)d_in[16]; p.norm_final = (const float*)d_in[17];
    p.out = (float*)d_out; p.ws = (unsigned char*)d_ws;
    if (hipMemsetAsync((char*)d_ws + WS_CTL, 0, CTL_BYTES, stream) != hipSuccess) { fprintf(stderr, "kernel_launch: memset failed\n"); return; }
    void* args[] = {&p};
    hipError_t e = hipLaunchCooperativeKernel((const void*)k_all, dim3(grid), dim3(NTHREADS), args, 0, stream);
    if (e != hipSuccess) fprintf(stderr, "cooperative launch failed: %s (grid %d)\n", hipGetErrorString(e), grid);
}
```

```cpp
#include <hip/hip_runtime.h>
#include <type_traits>
#include <hip/hip_cooperative_groups.h>
#include <cstdio>
#include <cstdint>
namespace cg = cooperative_groups;

#ifndef TAB_FP8
#define TAB_FP8 1
#endif
#ifndef PROBE_DUP
#define PROBE_DUP 0
#endif

constexpr int NB = 4, S = 8192, T = NB * S, D = 1024, DEPTH = 2;
constexpr int DIN = 1696, DINP = 1792;
constexpr int C_BG = 0, C_CG = 256, C_HC = 512, C_HP = 768, C_CQ = 1024, C_CKV = 1408, C_KR = 1664;
constexpr int QR = 384, KVR = 256, NH = 8, DQK = 96, DV = 64;
constexpr int PH = 8, NKEY = 128, NEXP = NKEY * NKEY, TOPK = 16, HK = PH * TOPK;
constexpr float EPS = 1e-6f;
constexpr int LDX = 1088;
constexpr int LDW = 1088;

typedef unsigned short bf16;
constexpr int HP = 2 * D;

constexpr size_t WS_CTL   = 0;
constexpr size_t WS_ROPE  = 64 * 1024;
constexpr size_t WS_WIN   = WS_ROPE + (size_t)S * 16 * 2 * 4;
constexpr size_t WS_WUQ   = WS_WIN + (size_t)DEPTH * DINP * LDW * 2;
constexpr size_t WS_WUKV  = WS_WUQ + (size_t)DEPTH * 768 * QR * 2;
constexpr size_t WS_WOUT  = WS_WUKV + (size_t)DEPTH * 1024 * KVR * 2;
constexpr size_t WS_WPQ   = WS_WOUT + (size_t)DEPTH * D * LDW * 2;
constexpr size_t WS_XN    = ((WS_WPQ + (size_t)DEPTH * 2048 * LDW * 2 + 4095) / 4096) * 4096;
constexpr size_t WS_PROJ  = WS_XN + (size_t)T * LDX * 2;
constexpr size_t WS_Q     = WS_PROJ + (size_t)T * DINP * 2;
constexpr size_t WS_K     = WS_Q + (size_t)T * NH * DQK * 2;
constexpr size_t WS_V     = WS_K + (size_t)T * NH * DQK * 2;
constexpr size_t WS_EXP   = WS_V + (size_t)T * NH * DV * 2;
constexpr size_t WS_GATE  = WS_EXP + (size_t)T * HK * 4;
constexpr size_t TAB_ROWB = TAB_FP8 ? 1024 : 2048;
constexpr size_t WS_TABU  = WS_GATE + (size_t)T * HK * 4;
constexpr size_t WS_TABV  = WS_TABU + (size_t)DEPTH * NEXP * TAB_ROWB;
constexpr size_t WS_TSCU  = WS_TABV + (size_t)DEPTH * NEXP * TAB_ROWB;
constexpr size_t WS_TSCV  = WS_TSCU + (size_t)DEPTH * NEXP * 4;
constexpr size_t WS_XQ    = WS_TSCV + (size_t)DEPTH * NEXP * 4;
constexpr int XQP = 1088;
constexpr size_t WS_XS    = WS_XQ + (size_t)T * XQP;
constexpr size_t WS_WQ8   = WS_XS + (size_t)T * 4;
constexpr size_t WS_WSC   = WS_WQ8 + (size_t)T * HK;
constexpr size_t WS_SSQ   = WS_WSC + (size_t)T * 4;
constexpr size_t WS_WC8   = WS_SSQ + (size_t)T * 64;
constexpr size_t WS_WCS   = WS_WC8 + (size_t)DEPTH * 2048 * XQP;
constexpr size_t WS_WI8   = WS_WCS + (size_t)DEPTH * 2048 * 4;
constexpr size_t WS_WIS   = WS_WI8 + (size_t)DEPTH * DINP * XQP;
constexpr size_t WS_END   = WS_WIS + (size_t)DEPTH * DINP * 4;
static_assert(WS_END <= (size_t)512 * 1024 * 1024, "workspace budget");

struct Params {
    const float* x; const float* norm_mix; const float* w_in; const float* conv_w; const float* pool_w; const float* pool_scale;
    const float* q_norm; const float* w_uq; const float* kv_norm; const float* w_uk; const float* w_uv; const float* w_out;
    const float* norm_ffn; const float* peer_wq; const float* peer_subkeys; const float* peer_u; const float* peer_v; const float* norm_final;
    float* out; unsigned char* ws;
};

__device__ __forceinline__ bf16 f2bf(float f) { unsigned u = __float_as_uint(f); u += 0x7fffu + ((u >> 16) & 1u); return (bf16)(u >> 16); }
__device__ __forceinline__ float bf2f(bf16 h) { return __uint_as_float(((unsigned)h) << 16); }
__device__ __forceinline__ float bflo(unsigned u) { return __uint_as_float(u << 16); }
__device__ __forceinline__ float bfhi(unsigned u) { return __uint_as_float(u & 0xffff0000u); }
__device__ __forceinline__ unsigned pack2(float a, float b) { return (unsigned)f2bf(a) | ((unsigned)f2bf(b) << 16); }
__device__ __forceinline__ float wave_sum(float v) {
#pragma unroll
    for (int m = 32; m >= 1; m >>= 1) v += __shfl_xor(v, m, 64);
    return v;
}
__device__ __forceinline__ float gelu_exact(float x) { return 0.5f * x * (1.f + erff(x * 0.70710678118654752f)); }

#define NTHREADS 512
constexpr int NW = NTHREADS / 64;
__device__ __forceinline__ int tidx() { int t = (int)__builtin_amdgcn_workitem_id_x(); asm volatile("" : "+v"(t)); return t; }
__device__ __forceinline__ int gwave() { return blockIdx.x * (NTHREADS / 64) + (tidx() >> 6); }
__device__ __forceinline__ int nwave() { return gridDim.x * (NTHREADS / 64); }
__device__ __forceinline__ size_t gtid() { return (size_t)blockIdx.x * NTHREADS + tidx(); }
__device__ __forceinline__ size_t gnth() { return (size_t)gridDim.x * NTHREADS; }


__device__ __forceinline__ Params launder(const Params& P) {
    typedef __attribute__((address_space(1))) char* gp_t;
    gp_t g[20] = {(gp_t)(char*)P.x, (gp_t)(char*)P.norm_mix, (gp_t)(char*)P.w_in, (gp_t)(char*)P.conv_w, (gp_t)(char*)P.pool_w, (gp_t)(char*)P.pool_scale, (gp_t)(char*)P.q_norm, (gp_t)(char*)P.w_uq,
                  (gp_t)(char*)P.kv_norm, (gp_t)(char*)P.w_uk, (gp_t)(char*)P.w_uv, (gp_t)(char*)P.w_out, (gp_t)(char*)P.norm_ffn, (gp_t)(char*)P.peer_wq, (gp_t)(char*)P.peer_subkeys,
                  (gp_t)(char*)P.peer_u, (gp_t)(char*)P.peer_v, (gp_t)(char*)P.norm_final, (gp_t)(char*)P.out, (gp_t)(char*)P.ws};
    asm volatile("" : "+s"(g[0]), "+s"(g[1]), "+s"(g[2]), "+s"(g[3]), "+s"(g[4]), "+s"(g[5]), "+s"(g[6]), "+s"(g[7]), "+s"(g[8]), "+s"(g[9]));
    asm volatile("" : "+s"(g[10]), "+s"(g[11]), "+s"(g[12]), "+s"(g[13]), "+s"(g[14]), "+s"(g[15]), "+s"(g[16]), "+s"(g[17]), "+s"(g[18]), "+s"(g[19]));
    Params Q;
    Q.x = (const float*)(char*)g[0]; Q.norm_mix = (const float*)(char*)g[1]; Q.w_in = (const float*)(char*)g[2]; Q.conv_w = (const float*)(char*)g[3]; Q.pool_w = (const float*)(char*)g[4];
    Q.pool_scale = (const float*)(char*)g[5]; Q.q_norm = (const float*)(char*)g[6]; Q.w_uq = (const float*)(char*)g[7]; Q.kv_norm = (const float*)(char*)g[8]; Q.w_uk = (const float*)(char*)g[9];
    Q.w_uv = (const float*)(char*)g[10]; Q.w_out = (const float*)(char*)g[11]; Q.norm_ffn = (const float*)(char*)g[12]; Q.peer_wq = (const float*)(char*)g[13]; Q.peer_subkeys = (const float*)(char*)g[14];
    Q.peer_u = (const float*)(char*)g[15]; Q.peer_v = (const float*)(char*)g[16]; Q.norm_final = (const float*)(char*)g[17]; Q.out = (float*)(char*)g[18]; Q.ws = (unsigned char*)(char*)g[19];
    return Q;
}

typedef __attribute__((ext_vector_type(8))) short bf16x8;
typedef __attribute__((ext_vector_type(16))) float f32x16;
typedef __attribute__((ext_vector_type(2))) __bf16 bf2_t;
#define MFMA32(a, b, c) __builtin_amdgcn_mfma_f32_32x32x16_bf16(a, b, c, 0, 0, 0)
__device__ __forceinline__ int crow(int r, int hi) { return (r & 3) + 8 * (r >> 2) + 4 * hi; }
__device__ __forceinline__ float dot2bf(unsigned a, unsigned b, float c) { return __builtin_amdgcn_fdot2_f32_bf16(__builtin_bit_cast(bf2_t, a), __builtin_bit_cast(bf2_t, b), c, false); }
__device__ __forceinline__ unsigned cvtpk(float lo, float hi) { unsigned r; asm("v_cvt_pk_bf16_f32 %0, %1, %2" : "=v"(r) : "v"(lo), "v"(hi)); return r; }
constexpr int LDS_TOTAL = 140 * 1024;

template <int WT, bool ROWSS>
__device__ __forceinline__ void gemm_kloop(const bf16* __restrict__ Ag0, int lda, const bf16* __restrict__ Bg0, int ldb, int nk, f32x16 (&acc)[8], float (&ss)[4], char* lds, int tid) {
    constexpr int BROWS = (WT == 0) ? 256 : 128, NPB = BROWS / 64;
    constexpr int OPA = 256 * 128, G_BUF = OPA + BROWS * 128;
    const int lane = tid & 63, w = __builtin_amdgcn_readfirstlane(tid >> 6), r32 = lane & 31, hi = lane >> 5;
    const int srow = 8 * w + (lane >> 3);
    const int sch = (lane & 7) ^ ((srow >> 1) & 7);
    const bf16* Ag = Ag0 + (size_t)srow * lda + sch * 8;
    const bf16* Bg = Bg0 + (size_t)srow * ldb + sch * 8;
#pragma unroll
    for (int i = 0; i < 8; ++i)
#pragma unroll
        for (int r = 0; r < 16; ++r) acc[i][r] = 0.f;
    ss[0] = 0.f; ss[1] = 0.f; ss[2] = 0.f; ss[3] = 0.f;
    typedef __attribute__((address_space(3))) unsigned* ldsp_t;
    typedef const __attribute__((address_space(1))) unsigned* glbp_t;
#define G_DMA(buf, kofs) do { char* d_ = lds + (buf) * G_BUF + (8 * w) * 128; \
    _Pragma("unroll") for (int i = 0; i < 4; ++i) \
        __builtin_amdgcn_global_load_lds((glbp_t)(const void*)(Ag + (size_t)(64 * i) * lda + (kofs)), (ldsp_t)(void*)(d_ + i * 8192), 16, 0, 0); \
    _Pragma("unroll") for (int i = 0; i < NPB; ++i) \
        __builtin_amdgcn_global_load_lds((glbp_t)(const void*)(Bg + (size_t)(64 * i) * ldb + (kofs)), (ldsp_t)(void*)(d_ + OPA + i * 8192), 16, 0, 0); } while (0)
    const int xr = (r32 >> 1) & 7;
    const int o0 = ((0 + hi) ^ xr) << 4, o1 = ((2 + hi) ^ xr) << 4, o2 = ((4 + hi) ^ xr) << 4, o3 = ((6 + hi) ^ xr) << 4;
#define G_SS(s_, r_) do { union { bf16x8 v; uint4 u; } c_; c_.v = r_; s_ = dot2bf(c_.u.x, c_.u.x, s_); s_ = dot2bf(c_.u.y, c_.u.y, s_); s_ = dot2bf(c_.u.z, c_.u.z, s_); s_ = dot2bf(c_.u.w, c_.u.w, s_); } while (0)
#define G_STEP(pa, pb, off) do { \
    if (WT == 0) { \
        const bf16x8 a0 = *(const bf16x8*)(pa + off), a1 = *(const bf16x8*)(pa + 32 * 128 + off); \
        const bf16x8 b0 = *(const bf16x8*)(pb + off), b1 = *(const bf16x8*)(pb + 32 * 128 + off), b2 = *(const bf16x8*)(pb + 64 * 128 + off), b3 = *(const bf16x8*)(pb + 96 * 128 + off); \
        if (ROWSS) { G_SS(ss[0], b0); G_SS(ss[1], b1); G_SS(ss[2], b2); G_SS(ss[3], b3); } \
        acc[0] = MFMA32(a0, b0, acc[0]); acc[1] = MFMA32(a0, b1, acc[1]); acc[2] = MFMA32(a0, b2, acc[2]); acc[3] = MFMA32(a0, b3, acc[3]); \
        acc[4] = MFMA32(a1, b0, acc[4]); acc[5] = MFMA32(a1, b1, acc[5]); acc[6] = MFMA32(a1, b2, acc[6]); acc[7] = MFMA32(a1, b3, acc[7]); \
    } else if (WT == 2) { \
        const bf16x8 a0 = *(const bf16x8*)(pa + off), a1 = *(const bf16x8*)(pa + 32 * 128 + off); \
        const bf16x8 b0 = *(const bf16x8*)(pb + off), b1 = *(const bf16x8*)(pb + 32 * 128 + off); \
        if (ROWSS) { G_SS(ss[0], b0); G_SS(ss[1], b1); } \
        acc[0] = MFMA32(a0, b0, acc[0]); acc[1] = MFMA32(a0, b1, acc[1]); acc[2] = MFMA32(a1, b0, acc[2]); acc[3] = MFMA32(a1, b1, acc[3]); \
    } else { \
        const bf16x8 b0 = *(const bf16x8*)(pb + off); \
        const bf16x8 a0 = *(const bf16x8*)(pa + off), a1 = *(const bf16x8*)(pa + 32 * 128 + off); \
        const bf16x8 a2 = *(const bf16x8*)(pa + 64 * 128 + off), a3 = *(const bf16x8*)(pa + 96 * 128 + off); \
        if (ROWSS) { G_SS(ss[0], b0); } \
        acc[0] = MFMA32(a0, b0, acc[0]); acc[1] = MFMA32(a1, b0, acc[1]); \
        acc[2] = MFMA32(a2, b0, acc[2]); acc[3] = MFMA32(a3, b0, acc[3]); \
    } } while (0)
    const int arow = (WT == 1) ? ((w >> 2) * 128 + r32) : ((w >> 1) * 64 + r32);
    const int brow = (WT == 0) ? ((w & 1) * 128 + r32) : (WT == 2) ? ((w & 1) * 64 + r32) : ((w & 3) * 32 + r32);
    G_DMA(0, 0);
    for (int kt = 0; kt < nk; ++kt) {
        __syncthreads();
        if (kt + 1 < nk) G_DMA((kt + 1) & 1, (kt + 1) * 64);
        const char* pa = lds + (kt & 1) * G_BUF + arow * 128;
        const char* pb = lds + (kt & 1) * G_BUF + OPA + brow * 128;
        G_STEP(pa, pb, o0); G_STEP(pa, pb, o1); G_STEP(pa, pb, o2); G_STEP(pa, pb, o3);
    }
    if (ROWSS) { ss[0] += __shfl_xor(ss[0], 32, 64); ss[1] += __shfl_xor(ss[1], 32, 64); ss[2] += __shfl_xor(ss[2], 32, 64); ss[3] += __shfl_xor(ss[3], 32, 64); }
#undef G_DMA
#undef G_SS
#undef G_STEP
}

__device__ __forceinline__ void tile_range(int ntiles, int& lo, int& hi) {
    const int G = gridDim.x, b = blockIdx.x;
    const int vb = ((G & 7) == 0) ? ((b & 7) * (G >> 3) + (b >> 3)) : b;
    const int per = (ntiles + G - 1) / G;
    lo = vb * per; hi = lo + per; if (hi > ntiles) hi = ntiles;
}
constexpr int ST_P = 68;
static_assert(NW * 64 * ST_P * 4 <= LDS_TOTAL, "staging LDS");
template <bool ROWSS, class EPI, class EPIROW, class RSC>
__device__ __forceinline__ void gemm_t(const bf16* __restrict__ Wt, int ldw, int N, const bf16* __restrict__ X, int ldx, int M, int K, int tn_direct, EPI epi, EPIROW epirow, RSC rowscale, char* lds) {
    const int tid = tidx(), lane = tid & 63, w = tid >> 6, r32 = lane & 31, hi = lane >> 5;
    const int tilesN = N / 256, tilesM = M / 256, nk = K / 64;
    int tlo, thi; tile_range(tilesM * tilesN, tlo, thi);
    for (int tile = tlo; tile < thi; ++tile) {
        const int tm = tile / tilesN, tn = tile % tilesN;
        f32x16 acc[8]; float ss[4];
        gemm_kloop<0, ROWSS>(Wt + (size_t)(tn * 256) * ldw, ldw, X + (size_t)(tm * 256) * ldx, ldx, nk, acc, ss, lds, tid);
        if (tn < tn_direct) {
            __syncthreads();
            float* st = (float*)lds + w * (64 * ST_P);
            const int rr = lane >> 4, ch = lane & 15;
#pragma unroll
            for (int half = 0; half < 2; ++half) {
                const float m0_ = rowscale(ss[2 * half]), m1_ = rowscale(ss[2 * half + 1]);
#pragma unroll
                for (int i = 0; i < 2; ++i)
#pragma unroll
                    for (int jj = 0; jj < 2; ++jj)
#pragma unroll
                        for (int g = 0; g < 4; ++g) {
                            const float mj = jj ? m1_ : m0_;
                            const f32x16& a_ = acc[i * 4 + 2 * half + jj];
                            *(float4*)(st + (32 * jj + r32) * ST_P + 32 * i + 8 * g + 4 * hi) = make_float4(a_[4 * g] * mj, a_[4 * g + 1] * mj, a_[4 * g + 2] * mj, a_[4 * g + 3] * mj);
                        }
#pragma unroll 2
                for (int it = 0; it < 16; ++it) {
                    const int row = it * 4 + rr;
                    const float4 v = *(const float4*)(st + row * ST_P + ch * 4);
                    epirow(tm * 256 + (w & 1) * 128 + half * 64 + row, tn * 256 + (w >> 1) * 64 + ch * 4, v);
                }
            }
        } else {
#pragma unroll
            for (int i = 0; i < 2; ++i)
#pragma unroll
                for (int j = 0; j < 4; ++j)
                    epi(tn * 256 + (w >> 1) * 64 + i * 32, tm * 256 + (w & 1) * 128 + j * 32, acc[i * 4 + j], r32, hi, ss[j]);
        }
        __syncthreads();
    }
}

constexpr int ST1_P = 132;
static_assert(NW * 32 * ST1_P * 4 <= LDS_TOTAL, "staging LDS (128 x 32 wave tiles)");
template <class EPIROW, class RSC>
__device__ __forceinline__ void gemm_t1(const bf16* __restrict__ Wt, int ldw, int N, const bf16* __restrict__ X, int ldx, int M, int K, EPIROW epirow, RSC rowscale, char* lds) {
    const int tid = tidx(), lane = tid & 63, w = tid >> 6, r32 = lane & 31, hi = lane >> 5;
    const int tilesN = N / 256, tilesM = M / 128, nk = K / 64;
    int tlo, thi; tile_range(tilesM * tilesN, tlo, thi);
    for (int tile = tlo; tile < thi; ++tile) {
        const int tm = tile / tilesN, tn = tile % tilesN;
        f32x16 acc[8]; float ss[4];
        gemm_kloop<1, true>(Wt + (size_t)(tn * 256) * ldw, ldw, X + (size_t)(tm * 128) * ldx, ldx, nk, acc, ss, lds, tid);
        __syncthreads();
        float* st = (float*)lds + w * (32 * ST1_P);
        const float mj = rowscale(ss[0]);
#pragma unroll
        for (int mt = 0; mt < 4; ++mt)
#pragma unroll
            for (int g = 0; g < 4; ++g)
                *(float4*)(st + r32 * ST1_P + 32 * mt + 8 * g + 4 * hi) = make_float4(acc[mt][4 * g] * mj, acc[mt][4 * g + 1] * mj, acc[mt][4 * g + 2] * mj, acc[mt][4 * g + 3] * mj);
#pragma unroll 2
        for (int it = 0; it < 16; ++it) {
            const int row = it * 2 + hi;
            const float4 v = *(const float4*)(st + row * ST1_P + r32 * 4);
            epirow(tm * 128 + (w & 3) * 32 + row, tn * 256 + (w >> 2) * 128 + r32 * 4, v);
        }
        __syncthreads();
    }
}

template <class EPIROW>
__device__ __forceinline__ void gemm_t2(const bf16* __restrict__ Wt, int ldw, int N, const bf16* __restrict__ X, int ldx, int M, int K, EPIROW epirow, char* lds) {
    const int tid = tidx(), lane = tid & 63, w = tid >> 6, r32 = lane & 31, hi = lane >> 5;
    const int tilesN = N / 256, tilesM = M / 128, nk = K / 64;
    int tlo, thi; tile_range(tilesM * tilesN, tlo, thi);
    for (int tile = tlo; tile < thi; ++tile) {
        const int tm = tile / tilesN, tn = tile % tilesN;
        f32x16 acc[8]; float ss[4];
        gemm_kloop<2, false>(Wt + (size_t)(tn * 256) * ldw, ldw, X + (size_t)(tm * 128) * ldx, ldx, nk, acc, ss, lds, tid);
        __syncthreads();
        float* st = (float*)lds + w * (64 * ST_P);
#pragma unroll
        for (int i = 0; i < 2; ++i)
#pragma unroll
            for (int j = 0; j < 2; ++j)
#pragma unroll
                for (int g = 0; g < 4; ++g)
                    *(float4*)(st + (32 * j + r32) * ST_P + 32 * i + 8 * g + 4 * hi) = make_float4(acc[i * 2 + j][4 * g], acc[i * 2 + j][4 * g + 1], acc[i * 2 + j][4 * g + 2], acc[i * 2 + j][4 * g + 3]);
        const int rr = lane >> 4, ch = lane & 15;
#pragma unroll 4
        for (int it = 0; it < 16; ++it) {
            const int row = it * 4 + rr;
            const float4 v = *(const float4*)(st + row * ST_P + ch * 4);
            epirow(tm * 128 + (w & 1) * 64 + row, tn * 256 + (w >> 1) * 64 + ch * 4, v);
        }
        __syncthreads();
    }
}

typedef __attribute__((ext_vector_type(4))) float f32x4;
constexpr int G8_HT = 128 * 64;
__device__ __forceinline__ int g8_lds_byte(int r, int c) {
    const int st = (r >> 4) * 2 + (c >> 5), rr = r & 15, cc = c & 31, ob = rr * 64 + cc * 2;
    return st * 1024 + (ob ^ (((ob >> 9) & 1) << 5));
}
__device__ __forceinline__ void g8_stage_rc(int b, int& R, int& C) {
    const int st = b / 1024, sb = b % 1024, swz = sb ^ (((sb >> 9) & 1) << 5);
    R = (st >> 1) * 16 + swz / 64; C = (st & 1) * 32 + (swz % 64) / 2;
}
__device__ __forceinline__ float ssq8(const bf16x8& v, float s) {
    union { bf16x8 v; uint4 u; } c_; c_.v = v;
    s = dot2bf(c_.u.x, c_.u.x, s); s = dot2bf(c_.u.y, c_.u.y, s); s = dot2bf(c_.u.z, c_.u.z, s); return dot2bf(c_.u.w, c_.u.w, s);
}
typedef __attribute__((ext_vector_type(4))) int i32x4;
__device__ __forceinline__ f32x4 mma8(const bf16x8& a, const bf16x8& b, const f32x4& c) { return __builtin_amdgcn_mfma_f32_16x16x32_bf16(a, b, c, 0, 0, 0); }
__device__ __forceinline__ i32x4 mma8(const bf16x8& a, const bf16x8& b, const i32x4& c) { return __builtin_amdgcn_mfma_i32_16x16x64_i8(__builtin_bit_cast(i32x4, a), __builtin_bit_cast(i32x4, b), c, 0, 0, 0); }
template <bool ROWSS, bool APERM = false, class ACC = f32x4>
__device__ __forceinline__ void gemm8_kloop(const bf16* __restrict__ A, int lda, const bf16* __restrict__ Bt, int ldb, int nt, ACC (&acc)[2][2][4][2], float (&ss)[2][2], char* lds, int tid) {
    bf16* shm = (bf16*)lds;
    typedef __attribute__((address_space(3))) unsigned* ldsp_t;
    typedef const __attribute__((address_space(1))) unsigned* glbp_t;
#define SA(b, h) (shm + ((b) * 2 + (h)) * G8_HT)
#define SB(b, h) (shm + (4 + (b) * 2 + (h)) * G8_HT)
    int sr0, sc0; g8_stage_rc(tid * 16, sr0, sc0);
    const unsigned voa = (unsigned)((sr0 * lda + sc0) * 2), vob = (unsigned)((sr0 * ldb + sc0) * 2);
    const char* Ap = (const char*)A; const char* Bp = (const char*)Bt;
    const int wbase = __builtin_amdgcn_readfirstlane(tid >> 6) * 1024;
#define STAGE_(P, BASE, VO, LD, br, r2, kt) do { const char* g_ = BASE + ((size_t)(br) * LD + (kt) * 64) * 2; \
    __builtin_amdgcn_global_load_lds((glbp_t)(const void*)(g_ + VO), (ldsp_t)(void*)((char*)(P) + wbase), 16, 0, 0); \
    __builtin_amdgcn_global_load_lds((glbp_t)(const void*)(g_ + (size_t)(2 * (r2)) * LD + VO), (ldsp_t)(void*)((char*)(P) + wbase + 8192), 16, 0, 0); } while (0)
#define STAGEA(b, h, kt) STAGE_(SA(b, h), Ap, voa, lda, (APERM ? (h) * 64 : (h) * 128), (APERM ? 128 : 64), kt)
#define STAGEB(b, h, kt) STAGE_(SB(b, h), Bp, vob, ldb, (h) * 128, 64, kt)
    const int lane = tid & 63, wid = tid >> 6, wr = wid >> 2, wc = wid & 3, fr = lane & 15, fq = lane >> 4;
    int abase, bbase;
    { const int ob = fr * 64 + fq * 16, lp = ob ^ (((ob >> 9) & 1) << 5);
      abase = lp + wr * 8192; bbase = lp + wc * 4096 + 4 * G8_HT * 2;
      asm volatile("" : "+v"(abase), "+v"(bbase)); }
#define LDA(dst, b, h) _Pragma("unroll") for (int m = 0; m < 4; ++m) _Pragma("unroll") for (int k = 0; k < 2; ++k) \
    dst[m][k] = *reinterpret_cast<const bf16x8*>(lds + abase + (((b) * 2 + (h)) * G8_HT * 2 + m * 2048 + k * 1024))
#define LDB(dst, b, h) _Pragma("unroll") for (int n = 0; n < 2; ++n) _Pragma("unroll") for (int k = 0; k < 2; ++k) \
    dst[n][k] = *reinterpret_cast<const bf16x8*>(lds + bbase + (((b) * 2 + (h)) * G8_HT * 2 + n * 2048 + k * 1024))
#define MMA(ai, bj, At_, Bt_) do { __builtin_amdgcn_s_setprio(1); \
    _Pragma("unroll") for (int m = 0; m < 4; ++m) _Pragma("unroll") for (int n = 0; n < 2; ++n) _Pragma("unroll") for (int k = 0; k < 2; ++k) \
        acc[ai][bj][m][n] = mma8(At_[m][k], Bt_[n][k], acc[ai][bj][m][n]); \
    __builtin_amdgcn_s_setprio(0); } while (0)
#define SSQ(bj, Bt_) do { if (ROWSS) { _Pragma("unroll") for (int n = 0; n < 2; ++n) { ss[bj][n] = ssq8(Bt_[n][0], ss[bj][n]); ss[bj][n] = ssq8(Bt_[n][1], ss[bj][n]); } } } while (0)
#define WAIT_V(n) asm volatile("s_waitcnt vmcnt(" #n ")" ::: "memory")
#define WAIT_L(n) asm volatile("s_waitcnt lgkmcnt(" #n ")" ::: "memory")
#define BAR __builtin_amdgcn_s_barrier()
#define SCHED __builtin_amdgcn_sched_barrier(0)
#pragma unroll
    for (int a = 0; a < 2; ++a)
#pragma unroll
        for (int b = 0; b < 2; ++b)
#pragma unroll
            for (int m = 0; m < 4; ++m)
#pragma unroll
                for (int n = 0; n < 2; ++n) acc[a][b][m][n] = ACC{0, 0, 0, 0};
    ss[0][0] = 0.f; ss[0][1] = 0.f; ss[1][0] = 0.f; ss[1][1] = 0.f;
    bf16x8 At[4][2], B0[2][2], B1[2][2];
    STAGEB(0, 0, 0); STAGEA(0, 0, 0);
    STAGEB(0, 1, 0); STAGEA(0, 1, 0);
    if (wr == 1) BAR;
    WAIT_V(4); BAR;
    STAGEB(1, 0, 1); STAGEA(1, 0, 1); STAGEB(1, 1, 1);
    WAIT_V(6); BAR;
    for (int t = 0; t < nt - 2; t += 2) {
        LDB(B0, 0, 0); SCHED; LDA(At, 0, 0); STAGEA(1, 1, t + 1);
        WAIT_L(8); BAR; WAIT_L(0); MMA(0, 0, At, B0); SSQ(0, B0); BAR; SCHED;
        LDB(B1, 0, 1); STAGEB(0, 0, t + 2);
        BAR; WAIT_L(0); MMA(0, 1, At, B1); SSQ(1, B1); BAR;
        LDA(At, 0, 1); STAGEA(0, 0, t + 2);
        BAR; WAIT_L(0); MMA(1, 0, At, B0); BAR; SCHED;
        STAGEB(0, 1, t + 2);
        WAIT_V(6); BAR; MMA(1, 1, At, B1); BAR;
        LDB(B0, 1, 0); SCHED; LDA(At, 1, 0); STAGEA(0, 1, t + 2);
        WAIT_L(8); BAR; WAIT_L(0); MMA(0, 0, At, B0); SSQ(0, B0); BAR; SCHED;
        LDB(B1, 1, 1); STAGEB(1, 0, t + 3);
        BAR; WAIT_L(0); MMA(0, 1, At, B1); SSQ(1, B1); BAR;
        LDA(At, 1, 1); STAGEA(1, 0, t + 3);
        BAR; WAIT_L(0); MMA(1, 0, At, B0); BAR; SCHED;
        STAGEB(1, 1, t + 3);
        WAIT_V(6); BAR; MMA(1, 1, At, B1); BAR;
    }
    { LDB(B0, 0, 0); LDA(At, 0, 0); STAGEA(1, 1, nt - 1);
      BAR; WAIT_L(0); MMA(0, 0, At, B0); SSQ(0, B0); BAR;
      LDB(B1, 0, 1); BAR; WAIT_L(0); MMA(0, 1, At, B1); SSQ(1, B1); BAR;
      LDA(At, 0, 1); WAIT_V(4); BAR; WAIT_L(0); MMA(1, 0, At, B0); MMA(1, 1, At, B1); BAR; }
    { LDB(B0, 1, 0); LDA(At, 1, 0); WAIT_V(2); BAR; WAIT_L(0); MMA(0, 0, At, B0); SSQ(0, B0); BAR;
      LDB(B1, 1, 1); WAIT_V(0); BAR; WAIT_L(0); MMA(0, 1, At, B1); SSQ(1, B1); BAR;
      LDA(At, 1, 1); BAR; WAIT_L(0); MMA(1, 0, At, B0); MMA(1, 1, At, B1); BAR; }
    if (wr == 0) BAR;
    if (ROWSS) {
#pragma unroll
        for (int b = 0; b < 2; ++b)
#pragma unroll
            for (int n = 0; n < 2; ++n) { ss[b][n] += __shfl_xor(ss[b][n], 16, 64); ss[b][n] += __shfl_xor(ss[b][n], 32, 64); }
    }
#undef SSQ
#undef SA
#undef SB
#undef STAGE_
#undef STAGEA
#undef STAGEB
#undef LDA
#undef LDB
#undef MMA
#undef WAIT_V
#undef WAIT_L
#undef BAR
#undef SCHED
}
__device__ __forceinline__ void tile_rounds(int ntiles, int& lo, int& hi, int& step) {
    const int G = gridDim.x, b = blockIdx.x;
    if ((G & 7) == 0) { const int per = (ntiles + 7) >> 3, x = b & 7; lo = x * per + (b >> 3); hi = (x + 1) * per; if (hi > ntiles) hi = ntiles; step = G >> 3; }
    else { lo = b; hi = ntiles; step = G; }
}
template <bool SCALE, bool PRE, bool I8, class EPIROW, class RSC, class PREF, class CSC>
__device__ __forceinline__ void gemm_t8(const bf16* __restrict__ Wt, int ldw, int N, const bf16* __restrict__ X, int ldx, int K, int tlo, int thi, int tstep, EPIROW epirow, RSC rowscale, PREF pre, CSC colscale, char* lds) {
    typedef typename std::conditional<I8, i32x4, f32x4>::type ACC;
    const int tid = tidx();
    const int tilesN = N / 256; int nt = K / 64;
    asm volatile("" : "+s"(nt));
    for (int tile = tlo; tile < thi; tile += tstep) {
        const int tm = tile / tilesN, tn = tile % tilesN;
        ACC acc[2][2][4][2]; float ss[2][2];
        gemm8_kloop<false, false, ACC>(Wt + (size_t)(tn * 256) * ldw, ldw, X + (size_t)(tm * 256) * ldx, ldx, nt, acc, ss, lds, tid);
        __syncthreads();
        const int te = tidx();
        const int le = te & 63, w = te >> 6, wr = w >> 2, wc = w & 3, fr = le & 15, fq = le >> 4;
        float* st = (float*)lds + w * (32 * ST_P);
        const int rr = le >> 4, ch = le & 15;
        const int tb = tm * 256 + wc * 32 + rr, nb = tn * 256 + wr * 64 + ch * 4;
#pragma unroll
        for (int ai = 0; ai < 2; ++ai)
#pragma unroll
            for (int bj = 0; bj < 2; ++bj) {
                float4 pv[8];
                if (PRE) {
#pragma unroll
                    for (int it = 0; it < 8; ++it) pv[it] = pre(tb + bj * 128 + it * 4, nb + ai * 128);
                }
#pragma unroll
                for (int n = 0; n < 2; ++n) {
                    const float mj = SCALE ? rowscale(tm * 256 + bj * 128 + wc * 32 + n * 16 + fr) : 1.f;
#pragma unroll
                    for (int m = 0; m < 4; ++m) {
                        const ACC a_ = acc[ai][bj][m][n];
                        if (I8) {
                            const float4 cs = colscale(tn * 256 + ai * 128 + wr * 64 + m * 16 + fq * 4);
                            *(float4*)(st + (n * 16 + fr) * ST_P + m * 16 + fq * 4) = make_float4((float)a_[0] * (mj * cs.x), (float)a_[1] * (mj * cs.y), (float)a_[2] * (mj * cs.z), (float)a_[3] * (mj * cs.w));
                        } else
                        *(float4*)(st + (n * 16 + fr) * ST_P + m * 16 + fq * 4) = SCALE ? make_float4(a_[0] * mj, a_[1] * mj, a_[2] * mj, a_[3] * mj) : make_float4(a_[0], a_[1], a_[2], a_[3]);
                    }
                }
                if (PRE) {
#pragma unroll
                    for (int it = 0; it < 8; ++it) {
                        const float4 v = *(const float4*)(st + (it * 4 + rr) * ST_P + ch * 4);
                        epirow(tb + bj * 128 + it * 4, nb + ai * 128, v, pv[it]);
                    }
                } else {
#pragma unroll 2
                    for (int it = 0; it < 8; ++it) {
                        const float4 v = *(const float4*)(st + (it * 4 + rr) * ST_P + ch * 4);
                        epirow(tb + bj * 128 + it * 4, nb + ai * 128, v, make_float4(0.f, 0.f, 0.f, 0.f));
                    }
                }
            }
        __syncthreads();
    }
}

__device__ __forceinline__ void transpose_tiled(const float* __restrict__ W, bf16* __restrict__ Wt, int K, int N, int Npad, int ldk, const float* __restrict__ gain, char* lds) {
    float (*tl)[65] = (float (*)[65])lds;
    const int tid = tidx(), a = tid & 63, q = tid >> 6;
    const int tK = K / 64, tN = Npad / 64;
    for (int tile = blockIdx.x; tile < tK * tN; tile += gridDim.x) {
        const int k0 = (tile / tN) * 64, n0 = (tile % tN) * 64;
#pragma unroll 4
        for (int i = 0; i < 64 / NW; ++i) {
            const int k = k0 + q * (64 / NW) + i, n = n0 + a;
            float v = (n < N) ? W[(size_t)k * N + n] : 0.f;
            if (gain) v *= gain[k];
            tl[q * (64 / NW) + i][a] = v;
        }
        __syncthreads();
#pragma unroll 4
        for (int i = 0; i < 64 / NW; ++i) { const int nl = q * (64 / NW) + i; Wt[(size_t)(n0 + nl) * ldk + k0 + a] = f2bf(tl[a][nl]); }
        __syncthreads();
    }
}

__device__ __forceinline__ void quant_row(const float4 (&v)[4], unsigned char* __restrict__ dst, float* __restrict__ scl, int r, int lane) {
    float am = 0.f;
#pragma unroll
    for (int j = 0; j < 4; ++j) am = fmaxf(am, fmaxf(fmaxf(fabsf(v[j].x), fabsf(v[j].y)), fmaxf(fabsf(v[j].z), fabsf(v[j].w))));
#pragma unroll
    for (int m = 32; m >= 1; m >>= 1) am = fmaxf(am, __shfl_xor(am, m, 64));
    const float sc = (am > 0.f) ? am * (1.f / 448.f) : 1.f;
    const float is = 1.f / sc;
    uint4 o;
    { int w = 0; w = __builtin_amdgcn_cvt_pk_fp8_f32(v[0].x * is, v[0].y * is, w, false); w = __builtin_amdgcn_cvt_pk_fp8_f32(v[0].z * is, v[0].w * is, w, true); o.x = (unsigned)w; }
    { int w = 0; w = __builtin_amdgcn_cvt_pk_fp8_f32(v[1].x * is, v[1].y * is, w, false); w = __builtin_amdgcn_cvt_pk_fp8_f32(v[1].z * is, v[1].w * is, w, true); o.y = (unsigned)w; }
    { int w = 0; w = __builtin_amdgcn_cvt_pk_fp8_f32(v[2].x * is, v[2].y * is, w, false); w = __builtin_amdgcn_cvt_pk_fp8_f32(v[2].z * is, v[2].w * is, w, true); o.z = (unsigned)w; }
    { int w = 0; w = __builtin_amdgcn_cvt_pk_fp8_f32(v[3].x * is, v[3].y * is, w, false); w = __builtin_amdgcn_cvt_pk_fp8_f32(v[3].z * is, v[3].w * is, w, true); o.w = (unsigned)w; }
    { const int lay = r / NEXP, e = r % NEXP; *(uint4*)(dst + (((size_t)(lay * 8 + (lane >> 3)) * NEXP + e) * 128) + (lane & 7) * 16) = o; }
    if (lane == 0) scl[r] = sc;
}
__device__ __forceinline__ unsigned pack_i8x4(float a, float b, float c, float d) {
    const int ia = __float2int_rn(a), ib = __float2int_rn(b), ic = __float2int_rn(c), id = __float2int_rn(d);
    return (unsigned)(ia & 255) | ((unsigned)(ib & 255) << 8) | ((unsigned)(ic & 255) << 16) | ((unsigned)(id & 255) << 24);
}
__device__ __forceinline__ void quant_row_i8(const float4 (&v)[4], unsigned char* __restrict__ dst, float* __restrict__ scl, int r, int lane) {
    float am = 0.f;
#pragma unroll
    for (int j = 0; j < 4; ++j) am = fmaxf(am, fmaxf(fmaxf(fabsf(v[j].x), fabsf(v[j].y)), fmaxf(fabsf(v[j].z), fabsf(v[j].w))));
#pragma unroll
    for (int m = 32; m >= 1; m >>= 1) am = fmaxf(am, __shfl_xor(am, m, 64));
    const float sc = (am > 0.f) ? am * (1.f / 127.f) : 1.f;
    const float is = 1.f / sc;
    uint4 o;
    o.x = pack_i8x4(v[0].x * is, v[0].y * is, v[0].z * is, v[0].w * is); o.y = pack_i8x4(v[1].x * is, v[1].y * is, v[1].z * is, v[1].w * is);
    o.z = pack_i8x4(v[2].x * is, v[2].y * is, v[2].z * is, v[2].w * is); o.w = pack_i8x4(v[3].x * is, v[3].y * is, v[3].z * is, v[3].w * is);
    { const int lay = r / NEXP, e = r % NEXP; *(uint4*)(dst + (((size_t)(lay * 8 + (lane >> 3)) * NEXP + e) * 128) + (lane & 7) * 16) = o; }
    if (lane == 0) scl[r] = sc;
}
template <bool I8>
__device__ __forceinline__ void convert_table(const float* __restrict__ src, unsigned char* __restrict__ dst, float* __restrict__ scl, int rows) {
    static_assert(TAB_FP8, "fp8 tables");
    const int lane = tidx() & 63;
    const int nw = nwave();
    for (int r = gwave(); r < rows; r += 4 * nw) {
        float4 v[4][4]; int rr[4];
#pragma unroll
        for (int u = 0; u < 4; ++u) {
            rr[u] = (r + u * nw < rows) ? (r + u * nw) : r;
            const float4* s0 = (const float4*)(src + (size_t)rr[u] * D);
#pragma unroll
            for (int j = 0; j < 4; ++j) v[u][j] = s0[lane * 4 + j];
        }
#pragma unroll
        for (int u = 0; u < 4; ++u) {
            if (u == 0 || rr[u] != r) { if (I8) quant_row_i8(v[u], dst, scl, rr[u], lane); else quant_row(v[u], dst, scl, rr[u], lane); }
        }
    }
}
__device__ __forceinline__ void phase_prep(const Params& P, char* lds) {
    unsigned char* ws = P.ws;
    for (int l = 0; l < DEPTH; ++l) {
        transpose_tiled(P.w_in + (size_t)l * D * DIN, (bf16*)(ws + WS_WIN) + (size_t)l * DINP * LDW, D, DIN, DINP, LDW, nullptr, lds);
        transpose_tiled(P.w_uq + (size_t)l * QR * 768, (bf16*)(ws + WS_WUQ) + (size_t)l * 768 * QR, QR, 768, 768, QR, P.q_norm + l * QR, lds);
        transpose_tiled(P.w_uk + (size_t)l * KVR * 512, (bf16*)(ws + WS_WUKV) + (size_t)l * 1024 * KVR, KVR, 512, 512, KVR, P.kv_norm + l * KVR, lds);
        transpose_tiled(P.w_uv + (size_t)l * KVR * 512, (bf16*)(ws + WS_WUKV) + (size_t)l * 1024 * KVR + (size_t)512 * KVR, KVR, 512, 512, KVR, P.kv_norm + l * KVR, lds);
        transpose_tiled(P.w_out + (size_t)l * D * D, (bf16*)(ws + WS_WOUT) + (size_t)l * D * LDW, D, D, D, LDW, nullptr, lds);
    }
    {
        bf16* Wc = (bf16*)(ws + WS_WPQ);
        float (*As)[68] = (float (*)[68])lds;
        float (*Bs)[68] = (float (*)[68])(lds + 16 * 68 * 4);
        const int tid = tidx(), tx = tid & 15, ty = (tid >> 4) & 15;
        const int lr = (tid >> 2) & 63, ld4 = (tid & 3) * 4;
        for (int tile = blockIdx.x; tile < (DEPTH * 2048 / 64) * (D / 64); tile += gridDim.x) {
            const int row0 = (tile >> 4) * 64, k0 = (tile & 15) * 64;
            const int l = row0 >> 11, hp = (row0 >> 7) & 15, n0 = row0 & 127;
            const float* skp = P.peer_subkeys + (((size_t)l * 2 + (hp & 1)) * NKEY + n0 + lr) * 128 + ld4;
            const float* wqp = P.peer_wq + ((size_t)l * D + k0 + lr) * 2048 + hp * 128 + ld4;
            float acc[4][4];
#pragma unroll
            for (int i = 0; i < 4; ++i)
#pragma unroll
                for (int j = 0; j < 4; ++j) acc[i][j] = 0.f;
            for (int d0 = 0; d0 < 128; d0 += 16) {
                if (tid < 256) {
                    const float4 av = *(const float4*)(skp + d0), bv = *(const float4*)(wqp + d0);
                    As[ld4 + 0][lr] = av.x; As[ld4 + 1][lr] = av.y; As[ld4 + 2][lr] = av.z; As[ld4 + 3][lr] = av.w;
                    Bs[ld4 + 0][lr] = bv.x; Bs[ld4 + 1][lr] = bv.y; Bs[ld4 + 2][lr] = bv.z; Bs[ld4 + 3][lr] = bv.w;
                }
                __syncthreads();
#pragma unroll
                for (int kk = 0; kk < 16; ++kk) {
                    const float4 a4 = *(const float4*)&As[kk][ty * 4], b4 = *(const float4*)&Bs[kk][tx * 4];
                    const float aa[4] = {a4.x, a4.y, a4.z, a4.w}, bb[4] = {b4.x, b4.y, b4.z, b4.w};
#pragma unroll
                    for (int i = 0; i < 4; ++i)
#pragma unroll
                        for (int j = 0; j < 4; ++j) acc[i][j] = fmaf(aa[i], bb[j], acc[i][j]);
                }
                __syncthreads();
            }
            if (tid < 256) {
#pragma unroll
                for (int i = 0; i < 4; ++i) {
                    uint2 o; o.x = pack2(acc[i][0], acc[i][1]); o.y = pack2(acc[i][2], acc[i][3]);
                    *(uint2*)(Wc + (size_t)(row0 + ty * 4 + i) * LDW + k0 + tx * 4) = o;
                }
            }
        }
    }
    convert_table<true>(P.peer_u, ws + WS_TABU, (float*)(ws + WS_TSCU), DEPTH * NEXP);
    convert_table<false>(P.peer_v, ws + WS_TABV, (float*)(ws + WS_TSCV), DEPTH * NEXP);
    float* rope = (float*)(ws + WS_ROPE);
    for (size_t i = gtid(); i < (size_t)S * 16; i += gnth()) {
        const int s = (int)(i >> 4), f = (int)(i & 15);
        const double inv = pow(10000.0, -(double)f / 16.0);
        const double ang = (double)s * inv;
        rope[2 * i] = (float)cos(ang); rope[2 * i + 1] = (float)sin(ang);
    }
}

__device__ __forceinline__ void phase_norm(const float* __restrict__ h, const float* __restrict__ g, unsigned* __restrict__ xq, float* __restrict__ xsc) {
    const int lane = tidx() & 63, nw = nwave();
    for (int t = gwave(); t < T; t += 2 * nw) {
        const int t2 = (t + nw < T) ? (t + nw) : t;
        float4 v[2][4];
#pragma unroll
        for (int j = 0; j < 4; ++j) { v[0][j] = ((const float4*)(h + (size_t)t * D))[j * 64 + lane]; v[1][j] = ((const float4*)(h + (size_t)t2 * D))[j * 64 + lane]; }
#pragma unroll
        for (int u = 0; u < 2; ++u) {
            float ss = 0.f;
#pragma unroll
            for (int j = 0; j < 4; ++j) ss += v[u][j].x * v[u][j].x + v[u][j].y * v[u][j].y + v[u][j].z * v[u][j].z + v[u][j].w * v[u][j].w;
            ss = wave_sum(ss);
            const float r = rsqrtf(ss * (1.f / D) + EPS);
            const int tt = u ? t2 : t;
            if (u == 0 || t2 != t) {
                float am = 0.f;
#pragma unroll
                for (int j = 0; j < 4; ++j) {
                    const float4 gg = ((const float4*)g)[j * 64 + lane];
                    v[u][j].x *= r * gg.x; v[u][j].y *= r * gg.y; v[u][j].z *= r * gg.z; v[u][j].w *= r * gg.w;
                    am = fmaxf(am, fmaxf(fmaxf(fabsf(v[u][j].x), fabsf(v[u][j].y)), fmaxf(fabsf(v[u][j].z), fabsf(v[u][j].w))));
                }
#pragma unroll
                for (int m = 32; m >= 1; m >>= 1) am = fmaxf(am, __shfl_xor(am, m, 64));
                const float sc = (am > 0.f) ? am * (1.f / 127.f) : 1.f, is = 1.f / sc;
#pragma unroll
                for (int j = 0; j < 4; ++j) xq[(size_t)tt * (XQP / 4) + j * 64 + lane] = pack_i8x4(v[u][j].x * is, v[u][j].y * is, v[u][j].z * is, v[u][j].w * is);
                if (lane == 0) xsc[tt] = sc;
            }
        }
    }
}
__device__ __forceinline__ void quant_wrows(const bf16* __restrict__ W, int nrows, unsigned char* __restrict__ W8, float* __restrict__ WS8) {
    const int lane = tidx() & 63;
    for (int row = gwave(); row < nrows; row += nwave()) {
        const uint4 a = ((const uint4*)(W + (size_t)row * LDW))[lane * 2], b = ((const uint4*)(W + (size_t)row * LDW))[lane * 2 + 1];
        float v[16] = {bflo(a.x), bfhi(a.x), bflo(a.y), bfhi(a.y), bflo(a.z), bfhi(a.z), bflo(a.w), bfhi(a.w), bflo(b.x), bfhi(b.x), bflo(b.y), bfhi(b.y), bflo(b.z), bfhi(b.z), bflo(b.w), bfhi(b.w)};
        float am = 0.f;
#pragma unroll
        for (int i = 0; i < 16; ++i) am = fmaxf(am, fabsf(v[i]));
#pragma unroll
        for (int m = 32; m >= 1; m >>= 1) am = fmaxf(am, __shfl_xor(am, m, 64));
        const float sc = (am > 0.f) ? am * (1.f / 127.f) : 1.f, is = 1.f / sc;
        uint4 o;
        o.x = pack_i8x4(v[0] * is, v[1] * is, v[2] * is, v[3] * is); o.y = pack_i8x4(v[4] * is, v[5] * is, v[6] * is, v[7] * is);
        o.z = pack_i8x4(v[8] * is, v[9] * is, v[10] * is, v[11] * is); o.w = pack_i8x4(v[12] * is, v[13] * is, v[14] * is, v[15] * is);
        ((uint4*)(W8 + (size_t)row * XQP))[lane] = o;
        if (lane == 0) WS8[row] = sc;
    }
}
__device__ __forceinline__ void phase_norm_q(const Params& P, int l) {
    const int lane = tidx() & 63, nw = nwave();
    const float* g = P.norm_ffn + l * D;
    unsigned* xq = (unsigned*)(P.ws + WS_XQ);
    float* xsc = (float*)(P.ws + WS_XS);
    bf16* Hb = (bf16*)P.out;
    const bf16* yo = (const bf16*)(P.ws + WS_PROJ);
    for (int t = gwave(); t < T; t += 2 * nw) {
        const int t2 = (t + nw < T) ? (t + nw) : t;
        float4 v[2][4];
#pragma unroll
        for (int j = 0; j < 4; ++j) {
            if (l == 0) { v[0][j] = ((const float4*)(P.x + (size_t)t * D))[j * 64 + lane]; v[1][j] = ((const float4*)(P.x + (size_t)t2 * D))[j * 64 + lane]; }
            else {
                const uint2 a = ((const uint2*)(Hb + (size_t)t * HP))[j * 64 + lane], b = ((const uint2*)(Hb + (size_t)t2 * HP))[j * 64 + lane];
                v[0][j] = make_float4(bflo(a.x), bfhi(a.x), bflo(a.y), bfhi(a.y)); v[1][j] = make_float4(bflo(b.x), bfhi(b.x), bflo(b.y), bfhi(b.y));
            }
        }
        {
            uint2 y[2][4];
#pragma unroll
            for (int j = 0; j < 4; ++j) { y[0][j] = ((const uint2*)(yo + (size_t)t * D))[j * 64 + lane]; y[1][j] = ((const uint2*)(yo + (size_t)t2 * D))[j * 64 + lane]; }
#pragma unroll
            for (int u = 0; u < 2; ++u)
#pragma unroll
                for (int j = 0; j < 4; ++j) { v[u][j].x += bflo(y[u][j].x); v[u][j].y += bfhi(y[u][j].x); v[u][j].z += bflo(y[u][j].y); v[u][j].w += bfhi(y[u][j].y); }
#pragma unroll
            for (int j = 0; j < 4; ++j) {
                uint2 a, b; a.x = pack2(v[0][j].x, v[0][j].y); a.y = pack2(v[0][j].z, v[0][j].w); b.x = pack2(v[1][j].x, v[1][j].y); b.y = pack2(v[1][j].z, v[1][j].w);
                ((uint2*)(Hb + (size_t)t * HP))[j * 64 + lane] = a; if (t2 != t) ((uint2*)(Hb + (size_t)t2 * HP))[j * 64 + lane] = b;
            }
        }
#pragma unroll
        for (int u = 0; u < 2; ++u) {
            float ss = 0.f;
#pragma unroll
            for (int j = 0; j < 4; ++j) ss += v[u][j].x * v[u][j].x + v[u][j].y * v[u][j].y + v[u][j].z * v[u][j].z + v[u][j].w * v[u][j].w;
            ss = wave_sum(ss);
            const float r = rsqrtf(ss * (1.f / D) + EPS);
            const int tt = u ? t2 : t;
            if (u == 0 || t2 != t) {
                float am = 0.f;
#pragma unroll
                for (int j = 0; j < 4; ++j) {
                    const float4 gg = ((const float4*)g)[j * 64 + lane];
                    v[u][j].x *= r * gg.x; v[u][j].y *= r * gg.y; v[u][j].z *= r * gg.z; v[u][j].w *= r * gg.w;
                    am = fmaxf(am, fmaxf(fmaxf(fabsf(v[u][j].x), fabsf(v[u][j].y)), fmaxf(fabsf(v[u][j].z), fabsf(v[u][j].w))));
                }
#pragma unroll
                for (int m = 32; m >= 1; m >>= 1) am = fmaxf(am, __shfl_xor(am, m, 64));
                const float sc = (am > 0.f) ? am * (1.f / 127.f) : 1.f, is = 1.f / sc;
#pragma unroll
                for (int j = 0; j < 4; ++j) xq[(size_t)tt * (XQP / 4) + j * 64 + lane] = pack_i8x4(v[u][j].x * is, v[u][j].y * is, v[u][j].z * is, v[u][j].w * is);
                if (lane == 0) xsc[tt] = sc;
            }
        }
    }
}

__device__ __forceinline__ void phase_mixlocal(const Params& P, int l, char* lds) {
    const bf16* proj = (const bf16*)(P.ws + WS_PROJ);
    bf16* Y = (bf16*)(P.ws + WS_XN);
    const int tid = tidx();
    {
        const float* cw = P.conv_w + (size_t)l * 3 * 256;
        for (size_t i = gtid(); i < (size_t)T * 32; i += gnth()) {
            const int t = (int)(i >> 5), c0 = (int)(i & 31) * 8, s = t & (S - 1);
            const bf16* pr = proj + (size_t)t * DINP;
            float acc[8];
#pragma unroll
            for (int e = 0; e < 8; ++e) acc[e] = 0.f;
#pragma unroll
            for (int j = 0; j < 3; ++j) {
                if (s - 2 + j >= 0) {
                    const bf16* pp = pr - (size_t)(2 - j) * DINP;
                    const uint4 g = *(const uint4*)(pp + C_CG + c0), hc = *(const uint4*)(pp + C_HC + c0);
                    const float4 w0 = *(const float4*)(cw + j * 256 + c0), w1 = *(const float4*)(cw + j * 256 + c0 + 4);
                    acc[0] = fmaf(w0.x, bflo(g.x) * bflo(hc.x), acc[0]); acc[1] = fmaf(w0.y, bfhi(g.x) * bfhi(hc.x), acc[1]);
                    acc[2] = fmaf(w0.z, bflo(g.y) * bflo(hc.y), acc[2]); acc[3] = fmaf(w0.w, bfhi(g.y) * bfhi(hc.y), acc[3]);
                    acc[4] = fmaf(w1.x, bflo(g.z) * bflo(hc.z), acc[4]); acc[5] = fmaf(w1.y, bfhi(g.z) * bfhi(hc.z), acc[5]);
                    acc[6] = fmaf(w1.z, bflo(g.w) * bflo(hc.w), acc[6]); acc[7] = fmaf(w1.w, bfhi(g.w) * bfhi(hc.w), acc[7]);
                }
            }
            const uint4 bg = *(const uint4*)(pr + C_BG + c0);
            uint4 o;
            o.x = pack2(bflo(bg.x) * acc[0], bfhi(bg.x) * acc[1]); o.y = pack2(bflo(bg.y) * acc[2], bfhi(bg.y) * acc[3]);
            o.z = pack2(bflo(bg.z) * acc[4], bfhi(bg.z) * acc[5]); o.w = pack2(bflo(bg.w) * acc[6], bfhi(bg.w) * acc[7]);
            *(uint4*)(Y + (size_t)t * LDX + c0) = o;
        }
    }
    {
        float (*pl)[68] = (float (*)[68])lds;
        const float* pw = P.pool_w + (size_t)l * 4 * 64 * 64;
        const float* psc = P.pool_scale + l * 256;
        const int a = tid & 63, q = tid >> 6;
        for (int tile = blockIdx.x; tile < (T / (16 * NW)) * 4; tile += gridDim.x) {
            const int g = tile & 3, t0 = (tile >> 2) * (16 * NW);
            const int w = 2 << g;
            {
                const bf16* col = proj + C_HP + g * 64 + a;
                const int tf = t0 + q * 16, sf = tf & (S - 1);
                float xr[31];
#pragma unroll
                for (int d = 1; d <= 15; ++d) xr[15 - d] = (d < w && sf - d >= 0) ? bf2f(col[(size_t)(tf - d) * DINP]) : 0.f;
#pragma unroll
                for (int i = 0; i < 16; ++i) xr[15 + i] = bf2f(col[(size_t)(tf + i) * DINP]);
                float sum = 0.f;
#pragma unroll
                for (int d = 1; d <= 15; ++d) sum += xr[15 - d];
#pragma unroll
                for (int i = 0; i < 16; ++i) {
                    const int s = sf + i;
                    sum += xr[15 + i];
                    const int cnt = (s + 1 < w) ? (s + 1) : w;
                    pl[q * 16 + i][a] = sum / (float)cnt - xr[15 + i];
                    const int o = 15 + i + 1;
                    const float old = (g == 0) ? xr[o - 2] : (g == 1) ? xr[o - 4] : (g == 2) ? xr[o - 8] : xr[o - 16];
                    sum -= old;
                }
            }
            __syncthreads();
            {
                float pc[64];
#pragma unroll
                for (int c = 0; c < 64; ++c) pc[c] = pw[(g * 64 + c) * 64 + a];
                const float sc = psc[g * 64 + a];
#pragma unroll 2
                for (int i = 0; i < 16; ++i) {
                    const float4* row = (const float4*)&pl[q * 16 + i][0];
                    float m0 = 0.f, m1 = 0.f;
#pragma unroll
                    for (int c4 = 0; c4 < 16; ++c4) { const float4 v = row[c4]; m0 = fmaf(v.x, pc[4 * c4], m0); m1 = fmaf(v.y, pc[4 * c4 + 1], m1); m0 = fmaf(v.z, pc[4 * c4 + 2], m0); m1 = fmaf(v.w, pc[4 * c4 + 3], m1); }
                    Y[(size_t)(t0 + q * 16 + i) * LDX + 256 + g * 64 + a] = f2bf((m0 + m1) * sc);
                }
            }
            __syncthreads();
        }
    }
}

typedef short v4i16_t __attribute__((ext_vector_type(4)));
typedef __attribute__((address_space(3))) v4i16_t* lds_v4p;
__device__ __forceinline__ v4i16_t vtr(const char* p) { return __builtin_amdgcn_ds_read_tr16_b64_v4i16((lds_v4p)p); }
constexpr int A_KP = 208, A_VP = 192;
constexpr int A_KB = 64 * A_KP, A_VB = 64 * A_VP, A_BUF = A_KB + A_VB, ATTN_LDS = 3 * A_BUF;
static_assert(ATTN_LDS <= LDS_TOTAL, "attention LDS");

__device__ __forceinline__ void attn_unit(const bf16* __restrict__ Qb, const bf16* __restrict__ Kb, const bf16* __restrict__ Vb, bf16* __restrict__ Y, int bh, int qblk, char* lds) {
    const int tid = tidx(), lane = tid & 63, w = tid >> 6, r32 = lane & 31, hi = lane >> 5;
    const int q0 = qblk * (64 * NW), qw0 = q0 + w * 64;
    const int NT = (q0 + 64 * NW) / 64;
    bf16x8 qfa[6], qfb[6];
    {
        const bf16* qp = Qb + ((size_t)bh * S + qw0 + r32) * DQK + hi * 8;
#pragma unroll
        for (int ks = 0; ks < 6; ++ks) { qfa[ks] = *(const bf16x8*)(qp + ks * 16); qfb[ks] = *(const bf16x8*)(qp + 32 * DQK + ks * 16); }
    }
    f32x16 oa0, oa1, ob0, ob1;
#pragma unroll
    for (int r = 0; r < 16; ++r) { oa0[r] = 0.f; oa1[r] = 0.f; ob0[r] = 0.f; ob1[r] = 0.f; }
    float ma = -1e30f, mb = -1e30f, lsa = 0.f, lsb = 0.f;
    const int t8 = tid & 255; const bool isv = tid >= 256;
    const char* Tg = isv ? (const char*)(Vb + (size_t)bh * S * DV) : (const char*)(Kb + (size_t)bh * S * DQK);
    const int Ts = isv ? (64 * 128) : (64 * 192);
    const int g0 = t8 * 16, g1 = (t8 + 256) * 16, g2 = isv ? g1 : (t8 + 512) * 16;
    const int l0 = isv ? (A_KB + (t8 >> 3) * A_VP + (t8 & 7) * 16) : ((t8 / 12) * A_KP + (t8 % 12) * 16);
    const int l1 = isv ? (l0 + 32 * A_VP) : (((t8 + 256) / 12) * A_KP + ((t8 + 256) % 12) * 16);
    const int l2 = isv ? l1 : (((t8 + 512) / 12) * A_KP + ((t8 + 512) % 12) * 16);
    uint4 pk0, pk1, pk2, qk0, qk1, qk2;
#define A_LOAD(S, t) do { const char* tg = Tg + (size_t)(t) * Ts; S##k0 = *(const uint4*)(tg + g0); S##k1 = *(const uint4*)(tg + g1); S##k2 = *(const uint4*)(tg + g2); } while (0)
#define A_STORE(S, bK, bV) do { *(uint4*)(bK + l0) = S##k0; *(uint4*)(bK + l1) = S##k1; *(uint4*)(bK + l2) = S##k2; } while (0)
#define A_PV2(pa, pb, kofs) do { \
            { const v4i16_t lo = vtr(pv + (kofs) * A_VP), hh = vtr(pv + ((kofs) + 8) * A_VP); const bf16x8 vf = {lo[0], lo[1], lo[2], lo[3], hh[0], hh[1], hh[2], hh[3]}; oa0 = MFMA32(vf, pa.v, oa0); ob0 = MFMA32(vf, pb.v, ob0); } \
            { const v4i16_t lo = vtr(pv + (kofs) * A_VP + 64), hh = vtr(pv + ((kofs) + 8) * A_VP + 64); const bf16x8 vf = {lo[0], lo[1], lo[2], lo[3], hh[0], hh[1], hh[2], hh[3]}; oa1 = MFMA32(vf, pa.v, oa1); ob1 = MFMA32(vf, pb.v, ob1); } } while (0)
#define A_SOFT(s0, s1, m, ls, o0, o1, P0, P1, P2, P3) do { \
            float mx = fmaxf(s0[0], s1[0]); \
            _Pragma("unroll") for (int r = 1; r < 16; ++r) mx = fmaxf(mx, fmaxf(s0[r], s1[r])); \
            mx = fmaxf(mx, __shfl_xor(mx, 32, 64)); \
            const float mn = fmaxf(m, mx), m_prev = m; \
            const float alpha = __builtin_amdgcn_exp2f(m - mn); \
            m = mn; \
            float ps = 0.f; \
            _Pragma("unroll") for (int r = 0; r < 16; ++r) { s0[r] = __builtin_amdgcn_exp2f(s0[r] - mn); s1[r] = __builtin_amdgcn_exp2f(s1[r] - mn); ps += s0[r] + s1[r]; } \
            if (__builtin_amdgcn_ballot_w64(mn > m_prev) != 0ull) {     \
                ls *= alpha; \
                _Pragma("unroll") for (int r = 0; r < 16; ++r) { o0[r] *= alpha; o1[r] *= alpha; } } \
            ls += ps; \
            _Pragma("unroll") for (int j = 0; j < 4; ++j) { P0.u[j] = cvtpk(s0[2 * j], s0[2 * j + 1]); P1.u[j] = cvtpk(s0[8 + 2 * j], s0[9 + 2 * j]); P2.u[j] = cvtpk(s1[2 * j], s1[2 * j + 1]); P3.u[j] = cvtpk(s1[8 + 2 * j], s1[9 + 2 * j]); } } while (0)
    const int pvo = (4 * hi + ((lane & 15) >> 2)) * A_VP + (16 * ((lane >> 4) & 1) + 4 * (lane & 3)) * 2;
    A_LOAD(p, 0); A_LOAD(q, 1);
    for (int t2 = 0; t2 < NT; t2 += 2) {
#pragma unroll
        for (int half = 0; half < 2; ++half) {
            const int t = t2 + half;
            char* bK = lds + half * A_BUF; char* bV = bK + A_KB;
            if (half == 0) A_STORE(p, bK, bV); else A_STORE(q, bK, bV);
            __syncthreads();
            { const int tn = (t + 2 < NT) ? (t + 2) : (NT - 2 + half); if (half == 0) A_LOAD(p, tn); else A_LOAD(q, tn); }
            const int kt0 = t * 64;
            if (kt0 <= qw0) {
                f32x16 sa0, sa1, sb0, sb1;
#pragma unroll
                for (int r = 0; r < 16; ++r) { sa0[r] = 0.f; sa1[r] = 0.f; sb0[r] = 0.f; sb1[r] = 0.f; }
                const char* pk = bK + r32 * A_KP + hi * 16;
#pragma unroll
                for (int ks = 0; ks < 6; ++ks) {
                    const bf16x8 a0 = *(const bf16x8*)(pk + ks * 32), a1 = *(const bf16x8*)(pk + 32 * A_KP + ks * 32);
                    sa0 = MFMA32(a0, qfa[ks], sa0); sa1 = MFMA32(a1, qfa[ks], sa1);
                    sb0 = MFMA32(a0, qfb[ks], sb0); sb1 = MFMA32(a1, qfb[ks], sb1);
                }
                if (kt0 == qw0) {
                    const int qrow = qw0 + r32;
#pragma unroll
                    for (int r = 0; r < 16; ++r) {
                        const int key = kt0 + crow(r, hi);
                        if (key > qrow) sa0[r] = -INFINITY; if (key + 32 > qrow) sa1[r] = -INFINITY;
                        if (key > qrow + 32) sb0[r] = -INFINITY; if (key > qrow) sb1[r] = -INFINITY;
                    }
                }
                union { unsigned u[4]; bf16x8 v; } pa0, pa1, pa2, pa3, pb0, pb1, pb2, pb3;
                A_SOFT(sa0, sa1, ma, lsa, oa0, oa1, pa0, pa1, pa2, pa3);
                A_SOFT(sb0, sb1, mb, lsb, ob0, ob1, pb0, pb1, pb2, pb3);
                const char* pv = bV + pvo;
                A_PV2(pa0, pb0, 0); A_PV2(pa1, pb1, 16); A_PV2(pa2, pb2, 32); A_PV2(pa3, pb3, 48);
            }
        }
    }
#undef A_LOAD
#undef A_STORE
#undef A_PV2
#undef A_SOFT
    lsa += __shfl_xor(lsa, 32, 64); lsb += __shfl_xor(lsb, 32, 64);
    const float inva = 1.f / lsa, invb = 1.f / lsb;
    const int b = bh >> 3, h = bh & 7;
    bf16* yo = Y + (size_t)(b * S + qw0 + r32) * LDX + 512 + h * 64 + 4 * hi;
#pragma unroll
    for (int g = 0; g < 4; ++g) {
        uint2 a, c;
        a.x = cvtpk(oa0[4 * g] * inva, oa0[4 * g + 1] * inva); a.y = cvtpk(oa0[4 * g + 2] * inva, oa0[4 * g + 3] * inva);
        c.x = cvtpk(oa1[4 * g] * inva, oa1[4 * g + 1] * inva); c.y = cvtpk(oa1[4 * g + 2] * inva, oa1[4 * g + 3] * inva);
        *(uint2*)(yo + 8 * g) = a; *(uint2*)(yo + 32 + 8 * g) = c;
        a.x = cvtpk(ob0[4 * g] * invb, ob0[4 * g + 1] * invb); a.y = cvtpk(ob0[4 * g + 2] * invb, ob0[4 * g + 3] * invb);
        c.x = cvtpk(ob1[4 * g] * invb, ob1[4 * g + 1] * invb); c.y = cvtpk(ob1[4 * g + 2] * invb, ob1[4 * g + 3] * invb);
        *(uint2*)(yo + (size_t)32 * LDX + 8 * g) = a; *(uint2*)(yo + (size_t)32 * LDX + 32 + 8 * g) = c;
    }
    __syncthreads();
}
__device__ __forceinline__ void phase_attn(const Params& P, char* lds) {
    const bf16* Qb = (const bf16*)(P.ws + WS_Q);
    const bf16* Kb = (const bf16*)(P.ws + WS_K);
    const bf16* Vb = (const bf16*)(P.ws + WS_V);
    bf16* Y = (bf16*)(P.ws + WS_XN);
    for (int u = blockIdx.x; u < NB * NH * (S / 512); u += gridDim.x) {
        const int bh = u & 31, v = u >> 5;
        const int qblk = (v < 8) ? (15 - v) : (v - 8);
        attn_unit(Qb, Kb, Vb, Y, bh, qblk, lds);
    }
}

#define NET_HD __device__ __forceinline__
#define NET_U2F(u) __uint_as_float(u)
#define NET_F2U(f) __float_as_uint(f)
#define CE_DESC(a, b) do { const float hi__ = fmaxf(a, b), lo__ = fminf(a, b); a = hi__; b = lo__; } while (0)
NET_HD void sort16_desc(float (&v)[16]) {
#define CE2(a, b) CE_DESC(v[a], v[b])
    CE2(0,13); CE2(1,12); CE2(2,15); CE2(3,14); CE2(4,8); CE2(5,6); CE2(7,11); CE2(9,10);
    CE2(0,5); CE2(1,7); CE2(2,9); CE2(3,4); CE2(6,13); CE2(8,14); CE2(10,15); CE2(11,12);
    CE2(0,1); CE2(2,3); CE2(4,5); CE2(6,8); CE2(7,9); CE2(10,11); CE2(12,13); CE2(14,15);
    CE2(0,2); CE2(1,3); CE2(4,10); CE2(5,11); CE2(6,7); CE2(8,9); CE2(12,14); CE2(13,15);
    CE2(1,2); CE2(3,12); CE2(4,6); CE2(5,7); CE2(8,10); CE2(9,11); CE2(13,14);
    CE2(1,4); CE2(2,6); CE2(5,8); CE2(7,10); CE2(9,13); CE2(11,14);
    CE2(2,4); CE2(3,6); CE2(9,12); CE2(11,13);
    CE2(3,5); CE2(6,8); CE2(7,9); CE2(10,12);
    CE2(3,4); CE2(5,6); CE2(7,8); CE2(9,10); CE2(11,12);
    CE2(6,7); CE2(8,9);
#undef CE2
}
NET_HD void merge16_desc(float (&a)[16], const float (&b)[16]) {
#pragma unroll
    for (int i = 0; i < 16; ++i) a[i] = fmaxf(a[i], b[15 - i]);
#pragma unroll
    for (int j = 8; j > 0; j >>= 1) {
#pragma unroll
        for (int i = 0; i < 16; ++i) { const int l = i ^ j; if (l > i) CE_DESC(a[i], a[l]); }
    }
}
NET_HD void top16_of_64(float (&g0)[16], float (&g1)[16], float (&g2)[16], float (&g3)[16]) {
    sort16_desc(g0); sort16_desc(g1); sort16_desc(g2); sort16_desc(g3);
    merge16_desc(g0, g1); merge16_desc(g2, g3); merge16_desc(g0, g2);
}
NET_HD float u2f(unsigned u) { return NET_U2F(u); }
NET_HD unsigned f2u(float f) { return NET_F2U(f); }
template <class V16>
NET_HD void lane_top16(const V16& s0, const V16& s1, const V16& s2, const V16& s3, int hi, float (&out)[16]) {
    float g0[16], g1[16], g2[16], g3[16];
#pragma unroll
    for (int r = 0; r < 16; ++r) {
        const unsigned nb = (unsigned)((r & 3) + 8 * (r >> 2));
        g0[r] = u2f((f2u(s0[r]) & 0xFFFFFF80u) | nb); g1[r] = u2f((f2u(s1[r]) & 0xFFFFFF80u) | (nb + 32u));
        g2[r] = u2f((f2u(s2[r]) & 0xFFFFFF80u) | (nb + 64u)); g3[r] = u2f((f2u(s3[r]) & 0xFFFFFF80u) | (nb + 96u));
    }
    top16_of_64(g0, g1, g2, g3);
    const unsigned h4 = (unsigned)hi << 2;
#pragma unroll
    for (int i = 0; i < 16; ++i) out[i] = u2f(f2u(g0[i]) | h4);
}
constexpr int cand_slot(int a, int b) { int n = 0; for (int x = 0; x < 16; ++x) for (int y = 0; y < 16; ++y) { if (x == a && y == b) return n; if ((x + 1) * (y + 1) <= 16) ++n; } return n; }
NET_HD void cand_top16(const float (&s1)[16], const float (&s2)[16], float (&c)[16]) {
    float g0[16], g1[16], g2[16], g3[16];
#pragma unroll
    for (int i = 0; i < 16; ++i) { g0[i] = -3.0e38f; g1[i] = -3.0e38f; g2[i] = -3.0e38f; g3[i] = -3.0e38f; }
#pragma unroll
    for (int a = 0; a < 16; ++a) {
#pragma unroll
        for (int b = 0; b < 16; ++b) {
            if ((a + 1) * (b + 1) <= 16) {
                const int sl = cand_slot(a, b);
                const float v = u2f((f2u(s1[a] + s2[b]) & 0xFFFFFF00u) | (unsigned)(a * 16 + b));
                if (sl < 16) g0[sl & 15] = v; else if (sl < 32) g1[sl & 15] = v; else if (sl < 48) g2[sl & 15] = v; else g3[sl & 15] = v;
            }
        }
    }
    top16_of_64(g0, g1, g2, g3);
#pragma unroll
    for (int i = 0; i < 16; ++i) c[i] = g0[i];
}

__device__ __forceinline__ void phase_route(const Params& P, int l, char* lds) {
    const bf16* XQb = (const bf16*)(P.ws + WS_XQ);
    const bf16* Wc = (const bf16*)(P.ws + WS_WC8 + (size_t)l * 2048 * XQP);
    const float* WcS = (const float*)(P.ws + WS_WCS) + (size_t)l * 2048;
    const float* XSc = (const float*)(P.ws + WS_XS);
    int* EXPp = (int*)(P.ws + WS_EXP);
    float* GATEp = (float*)(P.ws + WS_GATE);
    const int tid = tidx();
    float* xch = (float*)(lds + 16384);
    int tlo, thi, tst; tile_rounds((T / 256) * PH, tlo, thi, tst);
    int nt = D / 128; asm volatile("" : "+s"(nt));
    for (int u = tlo; u < thi; u += tst) {
        const int tm = u >> 3, h = u & 7;
        float Lk[16];
        {
            i32x4 acc[2][2][4][2]; float ssd[2][2];
            gemm8_kloop<false, true, i32x4>(Wc + (size_t)(h * 256) * (XQP / 2), XQP / 2, XQb + (size_t)(tm * 256) * (XQP / 2), XQP / 2, nt, acc, ssd, lds, tid);
            const int te = tidx(), fq = (te >> 4) & 3;
            const unsigned fqb = (unsigned)fq << 2;
            float4 ks[2][4];
            { const float* kp = WcS + h * 256 + ((te >> 8) & 1) * 128 + fq * 4;
#pragma unroll
              for (int ai = 0; ai < 2; ++ai)
#pragma unroll
                  for (int m = 0; m < 4; ++m) ks[ai][m] = *(const float4*)(kp + ai * 64 + m * 16); }
#pragma unroll
            for (int i = 0; i < 16; ++i) Lk[i] = 0.f;
#pragma unroll
            for (int bj = 0; bj < 2; ++bj)
#pragma unroll
                for (int n = 0; n < 2; ++n) {
                    float g0[16], g1[16];
#pragma unroll
                    for (int m = 0; m < 4; ++m)
#pragma unroll
                        for (int j = 0; j < 4; ++j) {
                            const unsigned kb = (unsigned)(m * 16 + j) | fqb;
                            const float k0 = (j == 0) ? ks[0][m].x : (j == 1) ? ks[0][m].y : (j == 2) ? ks[0][m].z : ks[0][m].w;
                            const float k1 = (j == 0) ? ks[1][m].x : (j == 1) ? ks[1][m].y : (j == 2) ? ks[1][m].z : ks[1][m].w;
                            g0[m * 4 + j] = u2f((f2u((float)acc[0][bj][m][n][j] * k0) & 0xFFFFFF80u) | kb);
                            g1[m * 4 + j] = u2f((f2u((float)acc[1][bj][m][n][j] * k1) & 0xFFFFFF80u) | (kb + 64u));
                        }
                    sort16_desc(g0); sort16_desc(g1); merge16_desc(g0, g1);
                    float o[16];
#pragma unroll
                    for (int i = 0; i < 16; ++i) o[i] = __shfl_xor(g0[i], 16, 64);
                    merge16_desc(g0, o);
#pragma unroll
                    for (int i = 0; i < 16; ++i) o[i] = __shfl_xor(g0[i], 32, 64);
                    merge16_desc(g0, o);
                    const bool mine = fq == bj * 2 + n;
#pragma unroll
                    for (int i = 0; i < 16; ++i) Lk[i] = mine ? g0[i] : Lk[i];
                }
        }
        __syncthreads();
        const int te = tidx(), lane = te & 63, w = te >> 6, wr = w >> 2, wc = w & 3, fr = lane & 15, fq = lane >> 4;
        if (wr == 1) {
#pragma unroll
            for (int q = 0; q < 4; ++q) *(float4*)(xch + ((wc * 64 + lane) * 16) + 4 * q) = make_float4(Lk[4 * q], Lk[4 * q + 1], Lk[4 * q + 2], Lk[4 * q + 3]);
        }
        __syncthreads();
        if (wr == 0) {
            float L1[16];
#pragma unroll
            for (int q = 0; q < 4; ++q) { const float4 v = *(const float4*)(xch + ((wc * 64 + lane) * 16) + 4 * q); L1[4 * q] = v.x; L1[4 * q + 1] = v.y; L1[4 * q + 2] = v.z; L1[4 * q + 3] = v.w; }
            float c[16];
            cand_top16(Lk, L1, c);
            unsigned char* my = (unsigned char*)lds + te * 32;
            {
                uint4 a, b;
#define PK4(L, i) ((__float_as_uint(L[i]) & 127u) | ((__float_as_uint(L[i + 1]) & 127u) << 8) | ((__float_as_uint(L[i + 2]) & 127u) << 16) | ((__float_as_uint(L[i + 3]) & 127u) << 24))
                a.x = PK4(Lk, 0); a.y = PK4(Lk, 4); a.z = PK4(Lk, 8); a.w = PK4(Lk, 12);
                b.x = PK4(L1, 0); b.y = PK4(L1, 4); b.z = PK4(L1, 8); b.w = PK4(L1, 12);
#undef PK4
                *(uint4*)my = a; *(uint4*)(my + 16) = b;
            }
            const int t = tm * 256 + (fq >> 1) * 128 + wc * 32 + (fq & 1) * 16 + fr;
            const float xs_t = XSc[t];
            int ev[16]; float gv[16]; float den = 0.f;
#pragma unroll
            for (int k = 0; k < 16; ++k) {
                const unsigned ci = __float_as_uint(c[k]) & 255u;
                const int n1 = my[ci >> 4], n2 = my[16 + (ci & 15)];
                ev[k] = n1 * NKEY + n2;
                gv[k] = __expf((c[k] - c[0]) * xs_t); den += gv[k];
            }
            const float iden = 1.f / den;
            uint4* ep = (uint4*)(EXPp + (size_t)t * HK + h * 16);
            float4* gp = (float4*)(GATEp + (size_t)t * HK + h * 16);
#pragma unroll
            for (int q = 0; q < 4; ++q) {
                ep[q] = make_uint4((unsigned)ev[4 * q], (unsigned)ev[4 * q + 1], (unsigned)ev[4 * q + 2], (unsigned)ev[4 * q + 3]);
                gp[q] = make_float4(gv[4 * q] * iden, gv[4 * q + 1] * iden, gv[4 * q + 2] * iden, gv[4 * q + 3] * iden);
            }
        }
        __syncthreads();
    }
}

constexpr size_t WS_PART = WS_PROJ;
static_assert((size_t)8 * T * HK * 4 <= WS_K - WS_PROJ, "PART alias");
constexpr int XI_X = 0, XI_RANK = 1, XI_J = 2, XI_NX = 3, XI_NLOC = 4;
constexpr int CTL_CENSUS = 4096;
constexpr int CTL_BYTES = (CTL_CENSUS + 16) * 4;

template <int M1, int M2, int M3, class TT>
__device__ __forceinline__ void red16x3(TT (&p)[16], int lane) {
#pragma unroll
    for (int i = 0; i < 8; ++i) { const bool up = lane & M1; const TT send = up ? p[i] : p[i + 8], keep = up ? p[i + 8] : p[i]; p[i] = keep + __shfl_xor(send, M1, 64); }
#pragma unroll
    for (int i = 0; i < 4; ++i) { const bool up = lane & M2; const TT send = up ? p[i] : p[i + 4], keep = up ? p[i + 4] : p[i]; p[i] = keep + __shfl_xor(send, M2, 64); }
#pragma unroll
    for (int i = 0; i < 2; ++i) { const bool up = lane & M3; const TT send = up ? p[i] : p[i + 2], keep = up ? p[i + 2] : p[i]; p[i] = keep + __shfl_xor(send, M3, 64); }
}
__device__ __forceinline__ void phase_gu(const Params& P, int l, const volatile int* xi) {
    const unsigned char* XQ = P.ws + WS_XQ;
    const float* XSc = (const float*)(P.ws + WS_XS);
    const int* EXPp = (const int*)(P.ws + WS_EXP);
    float* PART = (float*)(P.ws + WS_PART);
    const int tid = tidx(), lane = tid & 63, w = tid >> 6, g = lane >> 3, c = lane & 7;
    int xo_ = 0; asm volatile("" : "+v"(xo_));
    const int j = __builtin_amdgcn_readfirstlane(xi[xo_ + XI_J]), nx = __builtin_amdgcn_readfirstlane(xi[xo_ + XI_NX]), nloc = __builtin_amdgcn_readfirstlane(xi[xo_ + XI_NLOC]), rank = __builtin_amdgcn_readfirstlane(xi[xo_ + XI_RANK]);
    const int t0 = rank * NW + w, st = nloc * NW;
    const int n = (t0 < T) ? (T - t0 + st - 1) / st : 0;
    const int i0 = 8 * (c & 1) + 4 * ((c >> 1) & 1) + 2 * ((c >> 2) & 1);
    for (int sl = j; sl < 8 && n > 0; sl += nx) {
        const unsigned char* Us = P.ws + WS_TABU + ((size_t)(l * 8 + sl) * NEXP) * 128;
        const unsigned co = (unsigned)c << 4;
        float* part = PART + (size_t)sl * T * HK;
        const unsigned char* xs = XQ + sl * 128 + c * 16;
#define GU_TK(k) (t0 + (((k) < n) ? (k) : (n - 1)) * st)
#define GU_LOADE(S, t) do { S##lo = EXPp[(size_t)(t) * HK + lane]; S##hi = EXPp[(size_t)(t) * HK + 64 + lane]; } while (0)
#define GU_LOADX(S, t) do { S##a = *(const uint4*)(xs + (size_t)(t) * XQP); S##s = XSc[t]; } while (0)
#define GU_ISSUE(R, S) do { _Pragma("unroll") for (int i = 0; i < 16; ++i) { \
            const int e = __builtin_amdgcn_ds_bpermute((((8 * i) & 63) + g) << 2, (i < 8) ? S##lo : S##hi); R[i] = *(const uint4*)(Us + (((unsigned)e << 7) | co)); } } while (0)
#define GU_FINISH(R, S, t) do { \
            int p[16]; \
            _Pragma("unroll") for (int i = 0; i < 16; ++i) { int d_ = __builtin_amdgcn_sdot4((int)S##a.x, (int)R[i].x, 0, false); d_ = __builtin_amdgcn_sdot4((int)S##a.y, (int)R[i].y, d_, false); \
                d_ = __builtin_amdgcn_sdot4((int)S##a.z, (int)R[i].z, d_, false); p[i] = __builtin_amdgcn_sdot4((int)S##a.w, (int)R[i].w, d_, false); } \
            red16x3<1, 2, 4, int>(p, lane); \
            part[(size_t)(t) * HK + 8 * i0 + g] = (float)p[0] * S##s; part[(size_t)(t) * HK + 8 * (i0 + 1) + g] = (float)p[1] * S##s; } while (0)
        int eAlo, eAhi, eBlo, eBhi; uint4 xAa, xBa; float xAs, xBs; uint4 rA[16], rB[16];
        GU_LOADE(eA, GU_TK(0)); GU_LOADX(xA, GU_TK(0)); GU_LOADE(eB, GU_TK(1));
        GU_ISSUE(rA, eA);
        for (int k = 0; k < n; k += 2) {
            GU_LOADX(xB, GU_TK(k + 1)); GU_ISSUE(rB, eB); GU_LOADE(eA, GU_TK(k + 2));
            GU_FINISH(rA, xA, GU_TK(k));
            GU_LOADX(xA, GU_TK(k + 2)); GU_ISSUE(rA, eA); GU_LOADE(eB, GU_TK(k + 3));
            GU_FINISH(rB, xB, GU_TK(k + 1));
        }
#undef GU_TK
#undef GU_LOADE
#undef GU_LOADX
#undef GU_ISSUE
#undef GU_FINISH
    }
}
__device__ __forceinline__ void phase_gw(const Params& P, int l) {
    const int* EXPp = (const int*)(P.ws + WS_EXP);
    const float* GATEp = (const float*)(P.ws + WS_GATE);
    const float* PART = (const float*)(P.ws + WS_PART);
    const float* SU = (const float*)(P.ws + WS_TSCU) + (size_t)l * NEXP;
    const float* SV = (const float*)(P.ws + WS_TSCV) + (size_t)l * NEXP;
    unsigned char* WQ = P.ws + WS_WQ8;
    float* WSC = (float*)(P.ws + WS_WSC);
    const int lane = tidx() & 63;
    for (int tb = gwave() * 4; tb < T; tb += nwave() * 4) {
        float wv[4][2];
#pragma unroll
        for (int q = 0; q < 4; ++q)
#pragma unroll
            for (int hk = 0; hk < 2; ++hk) {
                const size_t i = (size_t)(tb + q) * HK + hk * 64 + lane;
                float s = 0.f;
#pragma unroll
                for (int x = 0; x < 8; ++x) s += PART[(size_t)x * T * HK + i];
                const int e = EXPp[i];
                wv[q][hk] = GATEp[i] * gelu_exact(s * SU[e]) * SV[e];
            }
#pragma unroll
        for (int q = 0; q < 4; ++q) {
            float am = fmaxf(fabsf(wv[q][0]), fabsf(wv[q][1]));
#pragma unroll
            for (int m = 32; m >= 1; m >>= 1) am = fmaxf(am, __shfl_xor(am, m, 64));
            const float sc = (am > 0.f) ? am * (1.f / 448.f) : 1.f, is = 1.f / sc;
            const int pk = __builtin_amdgcn_cvt_pk_fp8_f32(wv[q][0] * is, wv[q][1] * is, 0, false);
            WQ[(size_t)(tb + q) * HK + lane] = (unsigned char)(pk & 255);
            WQ[(size_t)(tb + q) * HK + 64 + lane] = (unsigned char)((pk >> 8) & 255);
            if (lane == 0) WSC[tb + q] = sc;
        }
    }
}
typedef int v2i_t __attribute__((ext_vector_type(2)));
typedef unsigned u32x4_t __attribute__((ext_vector_type(4)));
typedef __attribute__((ext_vector_type(4))) float f32x4;
constexpr int GV_PIECE = 1024 + 16;
constexpr int GV_TILE = 16 * GV_PIECE;
static_assert(NW * GV_TILE + NW * 512 <= LDS_TOTAL, "gv LDS");
__device__ __forceinline__ void phase_gv(const Params& P, int l, const volatile int* xi, char* lds) {
    const int* EXPp = (const int*)(P.ws + WS_EXP);
    const unsigned char* WQ = P.ws + WS_WQ8;
    const float* WSC = (const float*)(P.ws + WS_WSC);
    const int tid = tidx(), lane = tid & 63, w = __builtin_amdgcn_readfirstlane(tid >> 6), g = lane >> 3, pos = lane & 7;
    int xo_ = 0; asm volatile("" : "+v"(xo_));
    const int j = __builtin_amdgcn_readfirstlane(xi[xo_ + XI_J]), nx = __builtin_amdgcn_readfirstlane(xi[xo_ + XI_NX]), nloc = __builtin_amdgcn_readfirstlane(xi[xo_ + XI_NLOC]), rank = __builtin_amdgcn_readfirstlane(xi[xo_ + XI_RANK]);
    const int t0 = rank * NW + w, st = nloc * NW;
    const int n = (t0 < T) ? (T - t0 + st - 1) / st : 0;
    char* tile = lds + w * GV_TILE;
    float* strip = (float*)(lds + NW * GV_TILE) + w * 128;
    typedef __attribute__((address_space(3))) v2i_t* ldsv2_t;
    const unsigned co = (unsigned)(pos ^ g) << 4;
    const int rr = (lane & 15) >> 1, kq = lane >> 4;
    const int rdo = kq * GV_PIECE + rr * 128 + (lane & 1) * 8;
    const bool row0 = (lane & 15) == 0;
    __syncthreads();
    for (int sl = j; sl < 8 && n > 0; sl += nx) {
        const unsigned char* Vs = P.ws + WS_TABV + ((size_t)(l * 8 + sl) * NEXP) * 128;
        const char* hrow = (const char*)P.out + sl * 256 + 4 * lane;
#define GV_TK(k) (t0 + (((k) < n) ? (k) : (n - 1)) * st)
#define GV_LOADE(S, t) do { S##el = EXPp[(size_t)(t) * HK + lane]; S##eh = EXPp[(size_t)(t) * HK + 64 + lane]; } while (0)
#define GV_ISSUE(R, S) do { _Pragma("unroll") for (int i = 0; i < 16; ++i) { \
            const int e = __builtin_amdgcn_ds_bpermute((((8 * i) & 63) + g) << 2, (i < 8) ? S##el : S##eh); R[i] = *(const u32x4_t*)(Vs + (((unsigned)e << 7) | co)); } } while (0)
#define GV_LOADT(S, kk) do { const int t_ = GV_TK(kk); \
            S##a0 = 0; S##a1 = 0; S##a2 = 0; S##a3 = 0; \
            if (row0) { const long* wp = (const long*)(WQ + (size_t)t_ * HK + kq * 8); S##a0 = wp[0]; S##a1 = wp[4]; S##a2 = wp[8]; S##a3 = wp[12]; } \
            S##ws = ((kk) < n) ? WSC[t_] : 0.f; \
            S##hv = *(const unsigned*)(hrow + (size_t)t_ * (HP * 2)); } while (0)
#define GV_TOKEN(R, S, kk) do { \
            const int t = GV_TK(kk); \
            _Pragma("unroll") for (int i = 0; i < 16; ++i) *(u32x4_t*)(tile + i * GV_PIECE + lane * 16) = R[i]; \
            f32x4 acc[8]; \
            _Pragma("unroll") for (int nt = 0; nt < 8; ++nt) acc[nt] = (f32x4){0.f, 0.f, 0.f, 0.f}; \
            _Pragma("unroll") for (int s4 = 0; s4 < 4; ++s4) { \
                const long av = (s4 == 0) ? S##a0 : (s4 == 1) ? S##a1 : (s4 == 2) ? S##a2 : S##a3; \
                _Pragma("unroll") for (int nt = 0; nt < 8; ++nt) { \
                    const v2i_t bv = __builtin_amdgcn_ds_read_tr8_b64_v2i32((ldsv2_t)(void*)(tile + (4 * s4) * GV_PIECE + rdo + ((nt ^ rr) << 4))); \
                    acc[nt] = __builtin_amdgcn_mfma_f32_16x16x32_fp8_fp8(av, __builtin_bit_cast(long, bv), acc[nt], 0, 0, 0); } } \
            if (lane < 16) { _Pragma("unroll") for (int nt = 0; nt < 8; ++nt) strip[16 * nt + lane] = acc[nt][0]; }        \
            { const float2 o2 = *(const float2*)(strip + 2 * lane); \
              if ((kk) < n) *(unsigned*)(hrow + (size_t)t * (HP * 2)) = pack2(bflo(S##hv) + S##ws * o2.x, bfhi(S##hv) + S##ws * o2.y); } } while (0)
        int Ael, Aeh, Bel, Beh; u32x4_t rA[16], rB[16];
        long Pa0, Pa1, Pa2, Pa3, Qa0, Qa1, Qa2, Qa3; float Pws, Qws; unsigned Phv, Qhv;
        GV_LOADE(A, GV_TK(0)); GV_LOADE(B, GV_TK(1));
        GV_ISSUE(rA, A); GV_LOADT(P, 0);
        for (int k = 0; k < n; k += 2) {
            GV_ISSUE(rB, B); GV_LOADE(A, GV_TK(k + 2)); GV_LOADT(Q, k + 1);
            GV_TOKEN(rA, P, k);
            GV_ISSUE(rA, A); GV_LOADE(B, GV_TK(k + 3)); GV_LOADT(P, k + 2);
            GV_TOKEN(rB, Q, k + 1);
        }
#undef GV_TK
#undef GV_LOADE
#undef GV_ISSUE
#undef GV_LOADT
#undef GV_TOKEN
    }
    __syncthreads();
}
__device__ __forceinline__ void phase_gnorm(const Params& P, int l) {
    const int lane = tidx() & 63, nw = nwave();
    unsigned* xq = (unsigned*)(P.ws + WS_XQ);
    float* xsc = (float*)(P.ws + WS_XS);
    const bf16* Hb = (const bf16*)P.out;
    const float4* g = (const float4*)((l == DEPTH - 1) ? P.norm_final : (P.norm_mix + (l + 1) * D));
    for (int t = gwave(); t < T; t += 2 * nw) {
        const int t2 = (t + nw < T) ? (t + nw) : t;
        float4 v[2][4];
#pragma unroll
        for (int q = 0; q < 4; ++q) {
            const uint2 a = ((const uint2*)(Hb + (size_t)t * HP))[q * 64 + lane], b = ((const uint2*)(Hb + (size_t)t2 * HP))[q * 64 + lane];
            v[0][q] = make_float4(bflo(a.x), bfhi(a.x), bflo(a.y), bfhi(a.y)); v[1][q] = make_float4(bflo(b.x), bfhi(b.x), bflo(b.y), bfhi(b.y));
        }
#pragma unroll
        for (int u = 0; u < 2; ++u) {
            float ss = 0.f;
#pragma unroll
            for (int q = 0; q < 4; ++q) ss += v[u][q].x * v[u][q].x + v[u][q].y * v[u][q].y + v[u][q].z * v[u][q].z + v[u][q].w * v[u][q].w;
            ss = wave_sum(ss);
            const float rn = rsqrtf(ss * (1.f / D) + EPS);
            const int tt = u ? t2 : t;
            if (u == 0 || t2 != t) {
                float4* hr = (float4*)(P.out + (size_t)tt * D);
                float am = 0.f;
#pragma unroll
                for (int q = 0; q < 4; ++q) {
                    const float4 gg = g[q * 64 + lane];
                    v[u][q] = make_float4(v[u][q].x * rn * gg.x, v[u][q].y * rn * gg.y, v[u][q].z * rn * gg.z, v[u][q].w * rn * gg.w);
                    am = fmaxf(am, fmaxf(fmaxf(fabsf(v[u][q].x), fabsf(v[u][q].y)), fmaxf(fabsf(v[u][q].z), fabsf(v[u][q].w))));
                    if (l == DEPTH - 1) hr[q * 64 + lane] = v[u][q];
                }
                if (l != DEPTH - 1) {
#pragma unroll
                    for (int m = 32; m >= 1; m >>= 1) am = fmaxf(am, __shfl_xor(am, m, 64));
                    const float sc = (am > 0.f) ? am * (1.f / 127.f) : 1.f, is = 1.f / sc;
#pragma unroll
                    for (int q = 0; q < 4; ++q) xq[(size_t)tt * (XQP / 4) + q * 64 + lane] = pack_i8x4(v[u][q].x * is, v[u][q].y * is, v[u][q].z * is, v[u][q].w * is);
                    if (lane == 0) xsc[tt] = sc;
                }
            }
        }
    }
}

#define XB_TMO      128
#define XB_XCNT(j)  (256  + 64 * (j))
#define XB_XSUB(j)  (1280 + 64 * (j))
#define XB_XGEN(j)  (2304 + 64 * (j))
#define XB_TOP      3328
#define XB_TOPGEN   3392
#define XCD_BAR_WORDS 3456
#define XB_SPIN_CAP (1u << 22)
#define LAS __attribute__((address_space(3)))
__device__ __forceinline__ unsigned xb_ld(unsigned* p)              { return __hip_atomic_load(p, __ATOMIC_RELAXED, __HIP_MEMORY_SCOPE_AGENT); }
__device__ __forceinline__ unsigned xb_add(unsigned* p, unsigned v) { return __hip_atomic_fetch_add(p, v, __ATOMIC_RELAXED, __HIP_MEMORY_SCOPE_AGENT); }
__device__ __forceinline__ unsigned xb_xcc_id() { return (unsigned)__builtin_amdgcn_s_getreg((3 << 11) | 20) & 0xFu; }
#define XB_SPIN(cond, bar) do { unsigned _sp = 0; while (cond) { __builtin_amdgcn_s_sleep(1); \
    if ((++_sp & 255u) == 0u) { if (xb_ld(&(bar)[XB_TMO])) break; if (_sp > XB_SPIN_CAP) { atomicAdd(&(bar)[XB_TMO], 1u); break; } } } } while (0)
struct XcdBarrier { unsigned* bar; unsigned x; volatile LAS unsigned* st; };
__device__ __forceinline__ XcdBarrier xcd_barrier_post(unsigned* bar, volatile LAS unsigned* st) {
    XcdBarrier b; b.bar = bar; b.x = xb_xcc_id(); b.st = st;
    if (__builtin_amdgcn_workitem_id_x() == 0) (void)xb_add(&bar[XB_XCNT(b.x)], 1u);
    return b;
}
__device__ __forceinline__ void xcd_barrier_complete(unsigned* bar, unsigned x, unsigned& nloc, unsigned& nx) {
    const unsigned G = gridDim.x * gridDim.y * gridDim.z;
    unsigned sum, cnt, mine, sp = 0u;
    for (;;) {
        sum = 0u; cnt = 0u; mine = 0u;
#pragma unroll
        for (unsigned j = 0; j < 16; ++j) { const unsigned c = xb_ld(&bar[XB_XCNT(j)]); sum += c; cnt += (c > 0u) ? 1u : 0u; mine = (j == x) ? c : mine; }
        if (sum == G) break;
        __builtin_amdgcn_s_sleep(1);
        if ((++sp & 255u) == 0u) { if (xb_ld(&bar[XB_TMO])) break; if (sp > XB_SPIN_CAP) { atomicAdd(&bar[XB_TMO], 1u); break; } }
    }
    nloc = mine > 0u ? mine : 1u; nx = cnt > 0u ? cnt : 1u;
}
__device__ __forceinline__ void xcd_barrier(const XcdBarrier& b) {
    asm volatile("s_waitcnt vmcnt(0)" ::: "memory");
    __syncthreads();
    if (__builtin_amdgcn_workitem_id_x() == 0) {
        unsigned* bar = b.bar;
        __builtin_amdgcn_s_waitcnt(0);
        unsigned nloc = b.st[0], nx = b.st[1];
        if (nloc == 0u) { xcd_barrier_complete(bar, b.x, nloc, nx); b.st[0] = nloc; b.st[1] = nx; }
        const unsigned old = xb_add(&bar[XB_XSUB(b.x)], 1u);
        const unsigned gen = old / nloc;
        if (old + 1u == (gen + 1u) * nloc) {
            __builtin_amdgcn_fence(__ATOMIC_RELEASE, "agent");
            asm volatile("s_waitcnt vmcnt(0)" ::: "memory");
            const unsigned og = xb_add(&bar[XB_TOP], 1u);
            const unsigned tg = og / nx;
            if (og + 1u == (tg + 1u) * nx) xb_add(&bar[XB_TOPGEN], 1u);
            else XB_SPIN(xb_ld(&bar[XB_TOPGEN]) == tg, bar);
            __builtin_amdgcn_fence(__ATOMIC_ACQUIRE, "agent");
            xb_add(&bar[XB_XGEN(b.x)], 1u);
            asm volatile("s_waitcnt vmcnt(0)" ::: "memory");
        } else {
            XB_SPIN(xb_ld(&bar[XB_XGEN(b.x)]) == gen, bar);
            __builtin_amdgcn_fence(__ATOMIC_ACQUIRE, "agent");
            asm volatile("s_waitcnt vmcnt(0)" ::: "memory");
        }
    }
    __syncthreads();
}

constexpr float QSCALE = 0.10206207261596575f * 1.4426950408889634f;

__device__ __forceinline__ void phase_gemm1(const Params& P, int l, char* lds) {
    unsigned char* ws = P.ws;
    const bf16* XN = (const bf16*)(ws + WS_XN);
    bf16* PROJ = (bf16*)(ws + WS_PROJ);
    bf16* Kb = (bf16*)(ws + WS_K);
    const float* rope = (const float*)(ws + WS_ROPE);
    const bf16* W = (const bf16*)(ws + WS_WIN) + (size_t)l * DINP * LDW;
    float* SSQ = (float*)(ws + WS_SSQ);
    const int lane = tidx() & 63;
    const bf16* W8 = (const bf16*)(ws + WS_WI8 + (size_t)l * DINP * XQP);
    const bf16* XQb = (const bf16*)(ws + WS_XQ);
    const float* XSc = (const float*)(ws + WS_XS);
    const float* WIS = (const float*)(ws + WS_WIS) + (size_t)l * DINP;
    int tlo, thi, tst; tile_rounds((T / 256) * (DINP / 256), tlo, thi, tst);
    gemm_t8<true, false, true>(W8, XQP / 2, DINP, XQb, XQP / 2, D / 2, tlo, thi, tst, [&](int t, int n, const float4& v, const float4&) {
        const int nb = __builtin_amdgcn_readfirstlane(n);
        if (nb < C_KR) {
            uint2 o; o.x = cvtpk(v.x, v.y); o.y = cvtpk(v.z, v.w);
            *(uint2*)(PROJ + (size_t)t * DINP + n) = o;
            if (nb >= C_CQ) {
                float q = v.x * v.x + v.y * v.y + v.z * v.z + v.w * v.w;
                q += __shfl_xor(q, 1, 64); q += __shfl_xor(q, 2, 64); q += __shfl_xor(q, 4, 64); q += __shfl_xor(q, 8, 64);
                if (n == nb) SSQ[(size_t)t * 16 + ((nb - C_CQ) >> 6)] = q;
            }
        } else if (nb == C_KR) {
            const float4 up = make_float4(__shfl(v.x, lane + 4, 64), __shfl(v.y, lane + 4, 64), __shfl(v.z, lane + 4, 64), __shfl(v.w, lane + 4, 64));
            const float4 dn = make_float4(__shfl(v.x, lane - 4, 64), __shfl(v.y, lane - 4, 64), __shfl(v.z, lane - 4, 64), __shfl(v.w, lane - 4, 64));
            const int d = n - C_KR;
            if (d < 32) {
                const int b = t / S, s = t % S;
                const bool first = d < 16;
                const int f = first ? d : (d - 16);
                const float4 cs0 = *(const float4*)(rope + ((size_t)s * 16 + f) * 2), cs1 = *(const float4*)(rope + ((size_t)s * 16 + f) * 2 + 4);
                float4 o;
                if (first) o = make_float4(v.x * cs0.x - up.x * cs0.y, v.y * cs0.z - up.y * cs0.w, v.z * cs1.x - up.z * cs1.y, v.w * cs1.z - up.w * cs1.w);
                else       o = make_float4(v.x * cs0.x + dn.x * cs0.y, v.y * cs0.z + dn.y * cs0.w, v.z * cs1.x + dn.z * cs1.y, v.w * cs1.z + dn.w * cs1.w);
                uint2 u; u.x = cvtpk(o.x, o.y); u.y = cvtpk(o.z, o.w);
#pragma unroll
                for (int h = 0; h < NH; ++h) *(uint2*)(Kb + ((size_t)(b * NH + h) * S + s) * DQK + 64 + d) = u;
            }
        }
    }, [&](int t) { return XSc[t]; }, [](int, int) { return make_float4(0.f, 0.f, 0.f, 0.f); }, [&](int n) { return *(const float4*)(WIS + n); }, lds);
}
__device__ __forceinline__ void phase_gemm2(const Params& P, int l, char* lds) {
    unsigned char* ws = P.ws;
    const bf16* PROJ = (const bf16*)(ws + WS_PROJ);
    const float* rope = (const float*)(ws + WS_ROPE);
    const float* SSQ = (const float*)(ws + WS_SSQ);
    const int G = gridDim.x, bid = blockIdx.x;
    const int vb = ((G & 7) == 0) ? ((bid & 7) * (G >> 3) + (bid >> 3)) : bid;
    int qlo, qhi, klo, khi;
    if ((G & 1) == 0) {
        const int Gh = G >> 1, pq = (384 + Gh - 1) / Gh, pk = (512 + Gh - 1) / Gh;
        if (vb < Gh) { qlo = vb * pq; qhi = qlo + pq; if (qhi > 384) qhi = 384; if (qlo > 384) qlo = 384; klo = 0; khi = 0; }
        else { klo = (vb - Gh) * pk; khi = klo + pk; if (khi > 512) khi = 512; if (klo > 512) klo = 512; qlo = 0; qhi = 0; }
    } else { tile_range(384, qlo, qhi); tile_range(512, klo, khi); }
    {
        const bf16* W = (const bf16*)(ws + WS_WUQ) + (size_t)l * 768 * QR;
        bf16* Qb = (bf16*)(ws + WS_Q);
        gemm_t8<true, false, false>(W, QR, 768, PROJ + C_CQ, DINP, QR, qlo, qhi, 1,
            [&](int t, int n, const float4& v, const float4&) {
                const int b = t / S, s = t % S, h = n / DQK, d = n % DQK;
                float4 o = v;
                const int lane = tidx() & 63;
                const float4 up = make_float4(__shfl(v.x, lane + 4, 64), __shfl(v.y, lane + 4, 64), __shfl(v.z, lane + 4, 64), __shfl(v.w, lane + 4, 64));
                const float4 dn = make_float4(__shfl(v.x, lane - 4, 64), __shfl(v.y, lane - 4, 64), __shfl(v.z, lane - 4, 64), __shfl(v.w, lane - 4, 64));
                if (d >= 64) {
                    const bool first = d < 80;
                    const int f = first ? (d - 64) : (d - 80);
                    const float4 cs0 = *(const float4*)(rope + ((size_t)s * 16 + f) * 2), cs1 = *(const float4*)(rope + ((size_t)s * 16 + f) * 2 + 4);
                    if (first) o = make_float4(v.x * cs0.x - up.x * cs0.y, v.y * cs0.z - up.y * cs0.w, v.z * cs1.x - up.z * cs1.y, v.w * cs1.z - up.w * cs1.w);
                    else       o = make_float4(v.x * cs0.x + dn.x * cs0.y, v.y * cs0.z + dn.y * cs0.w, v.z * cs1.x + dn.z * cs1.y, v.w * cs1.z + dn.w * cs1.w);
                }
                uint2 u; u.x = cvtpk(o.x, o.y); u.y = cvtpk(o.z, o.w);
                *(uint2*)(Qb + ((size_t)(b * NH + h) * S + s) * DQK + d) = u;
            }, [&](int t) { const float4 a = *(const float4*)(SSQ + (size_t)t * 16); const float2 b = *(const float2*)(SSQ + (size_t)t * 16 + 4);
                            return rsqrtf(((a.x + a.y) + (a.z + a.w) + (b.x + b.y)) * (1.f / QR) + EPS) * QSCALE; }, [](int, int) { return make_float4(0.f, 0.f, 0.f, 0.f); }, [](int) { return make_float4(1.f, 1.f, 1.f, 1.f); }, lds);
    }
    {
        const bf16* W = (const bf16*)(ws + WS_WUKV) + (size_t)l * 1024 * KVR;
        bf16* Kb = (bf16*)(ws + WS_K); bf16* Vb = (bf16*)(ws + WS_V);
        gemm_t8<true, false, false>(W, KVR, 1024, PROJ + C_CKV, DINP, KVR, klo, khi, 1,
            [&](int t, int n, const float4& v, const float4&) {
                const int b = t / S, s = t % S;
                uint2 u; u.x = cvtpk(v.x, v.y); u.y = cvtpk(v.z, v.w);
                if (n < 512) *(uint2*)(Kb + ((size_t)(b * NH + (n >> 6)) * S + s) * DQK + (n & 63)) = u;
                else         *(uint2*)(Vb + ((size_t)(b * NH + ((n - 512) >> 6)) * S + s) * DV + (n & 63)) = u;
            }, [&](int t) { const float2 a = *(const float2*)(SSQ + (size_t)t * 16 + 6); const float2 b = *(const float2*)(SSQ + (size_t)t * 16 + 8);
                            return rsqrtf(((a.x + a.y) + (b.x + b.y)) * (1.f / KVR) + EPS); }, [](int, int) { return make_float4(0.f, 0.f, 0.f, 0.f); }, [](int) { return make_float4(1.f, 1.f, 1.f, 1.f); }, lds);
    }
}
constexpr size_t WS_YO = WS_PROJ;
__device__ __forceinline__ void phase_gemm3(const Params& P, int l, char* lds) {
    unsigned char* ws = P.ws;
    const bf16* Yb = (const bf16*)(ws + WS_XN);
    const bf16* W = (const bf16*)(ws + WS_WOUT) + (size_t)l * D * LDW;
    bf16* YO = (bf16*)(ws + WS_YO);
    int tlo, thi, tst; tile_rounds((T / 256) * (D / 256), tlo, thi, tst);
    gemm_t8<false, false, false>(W, LDW, D, Yb, LDX, D, tlo, thi, tst, [&](int t, int n, const float4& v, const float4&) {
        uint2 o; o.x = cvtpk(v.x, v.y); o.y = cvtpk(v.z, v.w);
        *(uint2*)(YO + (size_t)t * D + n) = o;
    }, [](int) { return 1.f; }, [](int, int) { return make_float4(0.f, 0.f, 0.f, 0.f); }, [](int) { return make_float4(1.f, 1.f, 1.f, 1.f); }, lds);
}

#define GSYNC() do { XcdBarrier xb_; { __attribute__((address_space(1))) char* gp_ = (__attribute__((address_space(1))) char*)(char*)(P.ws + WS_CTL); asm volatile("" : "+s"(gp_)); xb_.bar = (unsigned*)(char*)gp_; } \
    xb_.x = xb_xcc_id(); xb_.st = (volatile LAS unsigned*)&xb_words; xcd_barrier(xb_); } while (0)
#define PHASE(stmt) { const Params Q = launder(P); stmt; }
__global__ void __launch_bounds__(NTHREADS, 2) k_all(Params P) {
    __shared__ __attribute__((aligned(16))) char sm[LDS_TOTAL];
    __shared__ uint4 xb_words;
    cg::grid_group grid = cg::this_grid();
    if (__builtin_amdgcn_workitem_id_x() == 0) xb_words = make_uint4(0u, 0u, 0u, 0u);
    __syncthreads();
    (void)xcd_barrier_post((unsigned*)(P.ws + WS_CTL), (volatile LAS unsigned*)&xb_words);
    __shared__ int xinfo[8];
    if (__builtin_amdgcn_workitem_id_x() == 0) {
        const unsigned x = xb_xcc_id();
        xinfo[XI_X] = (int)x; xinfo[XI_RANK] = (int)xb_add((unsigned*)(P.ws + WS_CTL) + CTL_CENSUS + x, 1u);
    }
    PHASE(phase_prep(Q, sm));
    if (P.ws == nullptr) grid.sync();
    GSYNC();
    PHASE(phase_norm(Q.x, Q.norm_mix, (unsigned*)(Q.ws + WS_XQ), (float*)(Q.ws + WS_XS)));
    PHASE(quant_wrows((const bf16*)(Q.ws + WS_WPQ), DEPTH * 2048, Q.ws + WS_WC8, (float*)(Q.ws + WS_WCS)));
    PHASE(quant_wrows((const bf16*)(Q.ws + WS_WIN), DEPTH * DINP, Q.ws + WS_WI8, (float*)(Q.ws + WS_WIS)));
    GSYNC();
    if (__builtin_amdgcn_workitem_id_x() == 0) {
        unsigned* cen = (unsigned*)(P.ws + WS_CTL) + CTL_CENSUS;
        const int x = xinfo[XI_X]; int nx = 0, jj = 0;
        for (int q = 0; q < 16; ++q) { const unsigned cq = xb_ld(cen + q); if (cq) { if (q < x) ++jj; ++nx; } }
        xinfo[XI_J] = jj; xinfo[XI_NX] = nx; xinfo[XI_NLOC] = (int)xb_ld(cen + x);
    }
    __syncthreads();
    for (int l = 0; l < DEPTH; ++l) {
        PHASE(phase_gemm1(Q, l, sm));
#if PROBE_DUP & 2
        PHASE(phase_gemm1(Q, l, sm));
#endif
        GSYNC();
        PHASE(phase_mixlocal(Q, l, sm));
#if PROBE_DUP & 256
        PHASE(phase_mixlocal(Q, l, sm));
#endif
        PHASE(phase_gemm2(Q, l, sm));
#if PROBE_DUP & 4
        PHASE(phase_gemm2(Q, l, sm));
#endif
        GSYNC();
        PHASE(phase_attn(Q, sm));
#if PROBE_DUP & 8
        PHASE(phase_attn(Q, sm));
#endif
        GSYNC();
        PHASE(phase_gemm3(Q, l, sm));
#if PROBE_DUP & 16
        if (l == 0) PHASE(phase_gemm3(Q, l, sm));
#endif
        GSYNC();
        PHASE(phase_norm_q(Q, l));
#if PROBE_DUP & 512
        PHASE(phase_norm_q(Q, l));
#endif
        GSYNC();
        PHASE(phase_route(Q, l, sm));
#if PROBE_DUP & 32
        PHASE(phase_route(Q, l, sm));
#endif
        GSYNC();
        PHASE(phase_gu(Q, l, xinfo));
#if PROBE_DUP & 64
        PHASE(phase_gu(Q, l, xinfo));
#endif
        GSYNC();
        PHASE(phase_gw(Q, l));
#if PROBE_DUP & 128
        PHASE(phase_gw(Q, l));
#endif
        GSYNC();
        PHASE(phase_gv(Q, l, xinfo, sm));
        GSYNC();
        PHASE(phase_gnorm(Q, l));
        if (l + 1 < DEPTH) GSYNC();
    }
}

extern "C" void kernel_launch(void* const* d_in, const int* in_sizes, int n_in, void* d_out, int out_size, void* d_ws, size_t ws_size, hipStream_t stream) {
    static int grid = 0;
    if (grid == 0) {
        if (n_in != 18 || out_size != T * D || ws_size < WS_END) { fprintf(stderr, "kernel_launch: bad sizes n_in %d out %d ws %zu need %zu\n", n_in, out_size, ws_size, (size_t)WS_END); grid = -1; return; }
        int dev = 0, cus = 0, per_cu = 0;
        (void)hipGetDevice(&dev);
        (void)hipDeviceGetAttribute(&cus, hipDeviceAttributeMultiprocessorCount, dev);
        (void)hipOccupancyMaxActiveBlocksPerMultiprocessor(&per_cu, (const void*)k_all, NTHREADS, 0);
        if (per_cu > 1) per_cu = 1;
        if (per_cu < 1) { fprintf(stderr, "kernel_launch: occupancy query says %d\n", per_cu); grid = -1; return; }
        grid = cus * per_cu;
    }
    if (grid < 0) return;
    Params p{};
    p.x = (const float*)d_in[0]; p.norm_mix = (const float*)d_in[1]; p.w_in = (const float*)d_in[2]; p.conv_w = (const float*)d_in[3];
    p.pool_w = (const float*)d_in[4]; p.pool_scale = (const float*)d_in[5]; p.q_norm = (const float*)d_in[6]; p.w_uq = (const float*)d_in[7];
    p.kv_norm = (const float*)d_in[8]; p.w_uk = (const float*)d_in[9]; p.w_uv = (const float*)d_in[10]; p.w_out = (const float*)d_in[11];
    p.norm_ffn = (const float*)d_in[12]; p.peer_wq = (const float*)d_in[13]; p.peer_subkeys = (const float*)d_in[14]; p.peer_u = (const float*)d_in[15];
    p.peer_v = (const float*)d_in[16]; p.norm_final = (const float*)d_in[17];
    p.out = (float*)d_out; p.ws = (unsigned char*)d_ws;
    if (hipMemsetAsync((char*)d_ws + WS_CTL, 0, CTL_BYTES, stream) != hipSuccess) { fprintf(stderr, "kernel_launch: memset failed\n"); return; }
    void* args[] = {&p};
    hipError_t e = hipLaunchCooperativeKernel((const void*)k_all, dim3(grid), dim3(NTHREADS), args, 0, stream);
    if (e != hipSuccess) fprintf(stderr, "cooperative launch failed: %s (grid %d)\n", hipGetErrorString(e), grid);
}
```

```cpp
#include <hip/hip_runtime.h>
#include <type_traits>
#include <hip/hip_cooperative_groups.h>
#include <cstdio>
#include <cstdint>
namespace cg = cooperative_groups;

#ifndef TAB_FP8
#define TAB_FP8 1
#endif
#ifndef PROBE_DUP
#define PROBE_DUP 0
#endif

constexpr int NB = 4, S = 8192, T = NB * S, D = 1024, DEPTH = 2;
constexpr int DIN = 1696, DINP = 1792;
constexpr int C_BG = 0, C_CG = 256, C_HC = 512, C_HP = 768, C_CQ = 1024, C_CKV = 1408, C_KR = 1664;
constexpr int QR = 384, KVR = 256, NH = 8, DQK = 96, DV = 64;
constexpr int PH = 8, NKEY = 128, NEXP = NKEY * NKEY, TOPK = 16, HK = PH * TOPK;
constexpr float EPS = 1e-6f;
constexpr int LDX = 1088;
constexpr int LDW = 1088;

typedef unsigned short bf16;
constexpr int HP = 2 * D;

constexpr size_t WS_CTL   = 0;
constexpr size_t WS_ROPE  = 64 * 1024;
constexpr size_t WS_WIN   = WS_ROPE + (size_t)S * 16 * 2 * 4;
constexpr size_t WS_WUQ   = WS_WIN + (size_t)DEPTH * DINP * LDW * 2;
constexpr size_t WS_WUKV  = WS_WUQ + (size_t)DEPTH * 768 * QR * 2;
constexpr size_t WS_WOUT  = WS_WUKV + (size_t)DEPTH * 1024 * KVR * 2;
constexpr size_t WS_WPQ   = WS_WOUT + (size_t)DEPTH * D * LDW * 2;
constexpr size_t WS_XN    = ((WS_WPQ + (size_t)DEPTH * 2048 * LDW * 2 + 4095) / 4096) * 4096;
constexpr size_t WS_PROJ  = WS_XN + (size_t)T * LDX * 2;
constexpr size_t WS_Q     = WS_PROJ + (size_t)T * DINP * 2;
constexpr size_t WS_K     = WS_Q + (size_t)T * NH * DQK * 2;
constexpr size_t WS_V     = WS_K + (size_t)T * NH * DQK * 2;
constexpr size_t WS_EXP   = WS_V + (size_t)T * NH * DV * 2;
constexpr size_t WS_GATE  = WS_EXP + (size_t)T * HK * 4;
constexpr size_t TAB_ROWB = TAB_FP8 ? 1024 : 2048;
constexpr size_t WS_TABU  = WS_GATE + (size_t)T * HK * 4;
constexpr size_t WS_TABV  = WS_TABU + (size_t)DEPTH * NEXP * TAB_ROWB;
constexpr size_t WS_TSCU  = WS_TABV + (size_t)DEPTH * NEXP * TAB_ROWB;
constexpr size_t WS_TSCV  = WS_TSCU + (size_t)DEPTH * NEXP * 4;
constexpr size_t WS_XQ    = WS_TSCV + (size_t)DEPTH * NEXP * 4;
constexpr int XQP = 1088;
constexpr size_t WS_XS    = WS_XQ + (size_t)T * XQP;
constexpr size_t WS_WQ8   = WS_XS + (size_t)T * 4;
constexpr size_t WS_WSC   = WS_WQ8 + (size_t)T * HK;
constexpr size_t WS_SSQ   = WS_WSC + (size_t)T * 4;
constexpr size_t WS_WC8   = WS_SSQ + (size_t)T * 64;
constexpr size_t WS_WCS   = WS_WC8 + (size_t)DEPTH * 2048 * XQP;
constexpr size_t WS_WI8   = WS_WCS + (size_t)DEPTH * 2048 * 4;
constexpr size_t WS_WIS   = WS_WI8 + (size_t)DEPTH * DINP * XQP;
constexpr size_t WS_END   = WS_WIS + (size_t)DEPTH * DINP * 4;
static_assert(WS_END <= (size_t)512 * 1024 * 1024, "workspace budget");

struct Params {
    const float* x; const float* norm_mix; const float* w_in; const float* conv_w; const float* pool_w; const float* pool_scale;
    const float* q_norm; const float* w_uq; const float* kv_norm; const float* w_uk; const float* w_uv; const float* w_out;
    const float* norm_ffn; const float* peer_wq; const float* peer_subkeys; const float* peer_u; const float* peer_v; const float* norm_final;
    float* out; unsigned char* ws;
};

__device__ __forceinline__ bf16 f2bf(float f) { unsigned u = __float_as_uint(f); u += 0x7fffu + ((u >> 16) & 1u); return (bf16)(u >> 16); }
__device__ __forceinline__ float bf2f(bf16 h) { return __uint_as_float(((unsigned)h) << 16); }
__device__ __forceinline__ float bflo(unsigned u) { return __uint_as_float(u << 16); }
__device__ __forceinline__ float bfhi(unsigned u) { return __uint_as_float(u & 0xffff0000u); }
__device__ __forceinline__ unsigned pack2(float a, float b) { return (unsigned)f2bf(a) | ((unsigned)f2bf(b) << 16); }
__device__ __forceinline__ float wave_sum(float v) {
#pragma unroll
    for (int m = 32; m >= 1; m >>= 1) v += __shfl_xor(v, m, 64);
    return v;
}
__device__ __forceinline__ float gelu_exact(float x) { return 0.5f * x * (1.f + erff(x * 0.70710678118654752f)); }

#define NTHREADS 512
constexpr int NW = NTHREADS / 64;
__device__ __forceinline__ int tidx() { int t = (int)__builtin_amdgcn_workitem_id_x(); asm volatile("" : "+v"(t)); return t; }
__device__ __forceinline__ int gwave() { return blockIdx.x * (NTHREADS / 64) + (tidx() >> 6); }
__device__ __forceinline__ int nwave() { return gridDim.x * (NTHREADS / 64); }
__device__ __forceinline__ size_t gtid() { return (size_t)blockIdx.x * NTHREADS + tidx(); }
__device__ __forceinline__ size_t gnth() { return (size_t)gridDim.x * NTHREADS; }


__device__ __forceinline__ Params launder(const Params& P) {
    typedef __attribute__((address_space(1))) char* gp_t;
    gp_t g[20] = {(gp_t)(char*)P.x, (gp_t)(char*)P.norm_mix, (gp_t)(char*)P.w_in, (gp_t)(char*)P.conv_w, (gp_t)(char*)P.pool_w, (gp_t)(char*)P.pool_scale, (gp_t)(char*)P.q_norm, (gp_t)(char*)P.w_uq,
                  (gp_t)(char*)P.kv_norm, (gp_t)(char*)P.w_uk, (gp_t)(char*)P.w_uv, (gp_t)(char*)P.w_out, (gp_t)(char*)P.norm_ffn, (gp_t)(char*)P.peer_wq, (gp_t)(char*)P.peer_subkeys,
                  (gp_t)(char*)P.peer_u, (gp_t)(char*)P.peer_v, (gp_t)(char*)P.norm_final, (gp_t)(char*)P.out, (gp_t)(char*)P.ws};
    asm volatile("" : "+s"(g[0]), "+s"(g[1]), "+s"(g[2]), "+s"(g[3]), "+s"(g[4]), "+s"(g[5]), "+s"(g[6]), "+s"(g[7]), "+s"(g[8]), "+s"(g[9]));
    asm volatile("" : "+s"(g[10]), "+s"(g[11]), "+s"(g[12]), "+s"(g[13]), "+s"(g[14]), "+s"(g[15]), "+s"(g[16]), "+s"(g[17]), "+s"(g[18]), "+s"(g[19]));
    Params Q;
    Q.x = (const float*)(char*)g[0]; Q.norm_mix = (const float*)(char*)g[1]; Q.w_in = (const float*)(char*)g[2]; Q.conv_w = (const float*)(char*)g[3]; Q.pool_w = (const float*)(char*)g[4];
    Q.pool_scale = (const float*)(char*)g[5]; Q.q_norm = (const float*)(char*)g[6]; Q.w_uq = (const float*)(char*)g[7]; Q.kv_norm = (const float*)(char*)g[8]; Q.w_uk = (const float*)(char*)g[9];
    Q.w_uv = (const float*)(char*)g[10]; Q.w_out = (const float*)(char*)g[11]; Q.norm_ffn = (const float*)(char*)g[12]; Q.peer_wq = (const float*)(char*)g[13]; Q.peer_subkeys = (const float*)(char*)g[14];
    Q.peer_u = (const float*)(char*)g[15]; Q.peer_v = (const float*)(char*)g[16]; Q.norm_final = (const float*)(char*)g[17]; Q.out = (float*)(char*)g[18]; Q.ws = (unsigned char*)(char*)g[19];
    return Q;
}

typedef __attribute__((ext_vector_type(8))) short bf16x8;
typedef __attribute__((ext_vector_type(16))) float f32x16;
typedef __attribute__((ext_vector_type(2))) __bf16 bf2_t;
#define MFMA32(a, b, c) __builtin_amdgcn_mfma_f32_32x32x16_bf16(a, b, c, 0, 0, 0)
__device__ __forceinline__ int crow(int r, int hi) { return (r & 3) + 8 * (r >> 2) + 4 * hi; }
__device__ __forceinline__ float dot2bf(unsigned a, unsigned b, float c) { return __builtin_amdgcn_fdot2_f32_bf16(__builtin_bit_cast(bf2_t, a), __builtin_bit_cast(bf2_t, b), c, false); }
__device__ __forceinline__ unsigned cvtpk(float lo, float hi) { unsigned r; asm("v_cvt_pk_bf16_f32 %0, %1, %2" : "=v"(r) : "v"(lo), "v"(hi)); return r; }
constexpr int LDS_TOTAL = 140 * 1024;

template <int WT, bool ROWSS>
__device__ __forceinline__ void gemm_kloop(const bf16* __restrict__ Ag0, int lda, const bf16* __restrict__ Bg0, int ldb, int nk, f32x16 (&acc)[8], float (&ss)[4], char* lds, int tid) {
    constexpr int BROWS = (WT == 0) ? 256 : 128, NPB = BROWS / 64;
    constexpr int OPA = 256 * 128, G_BUF = OPA + BROWS * 128;
    const int lane = tid & 63, w = __builtin_amdgcn_readfirstlane(tid >> 6), r32 = lane & 31, hi = lane >> 5;
    const int srow = 8 * w + (lane >> 3);
    const int sch = (lane & 7) ^ ((srow >> 1) & 7);
    const bf16* Ag = Ag0 + (size_t)srow * lda + sch * 8;
    const bf16* Bg = Bg0 + (size_t)srow * ldb + sch * 8;
#pragma unroll
    for (int i = 0; i < 8; ++i)
#pragma unroll
        for (int r = 0; r < 16; ++r) acc[i][r] = 0.f;
    ss[0] = 0.f; ss[1] = 0.f; ss[2] = 0.f; ss[3] = 0.f;
    typedef __attribute__((address_space(3))) unsigned* ldsp_t;
    typedef const __attribute__((address_space(1))) unsigned* glbp_t;
#define G_DMA(buf, kofs) do { char* d_ = lds + (buf) * G_BUF + (8 * w) * 128; \
    _Pragma("unroll") for (int i = 0; i < 4; ++i) \
        __builtin_amdgcn_global_load_lds((glbp_t)(const void*)(Ag + (size_t)(64 * i) * lda + (kofs)), (ldsp_t)(void*)(d_ + i * 8192), 16, 0, 0); \
    _Pragma("unroll") for (int i = 0; i < NPB; ++i) \
        __builtin_amdgcn_global_load_lds((glbp_t)(const void*)(Bg + (size_t)(64 * i) * ldb + (kofs)), (ldsp_t)(void*)(d_ + OPA + i * 8192), 16, 0, 0); } while (0)
    const int xr = (r32 >> 1) & 7;
    const int o0 = ((0 + hi) ^ xr) << 4, o1 = ((2 + hi) ^ xr) << 4, o2 = ((4 + hi) ^ xr) << 4, o3 = ((6 + hi) ^ xr) << 4;
#define G_SS(s_, r_) do { union { bf16x8 v; uint4 u; } c_; c_.v = r_; s_ = dot2bf(c_.u.x, c_.u.x, s_); s_ = dot2bf(c_.u.y, c_.u.y, s_); s_ = dot2bf(c_.u.z, c_.u.z, s_); s_ = dot2bf(c_.u.w, c_.u.w, s_); } while (0)
#define G_STEP(pa, pb, off) do { \
    if (WT == 0) { \
        const bf16x8 a0 = *(const bf16x8*)(pa + off), a1 = *(const bf16x8*)(pa + 32 * 128 + off); \
        const bf16x8 b0 = *(const bf16x8*)(pb + off), b1 = *(const bf16x8*)(pb + 32 * 128 + off), b2 = *(const bf16x8*)(pb + 64 * 128 + off), b3 = *(const bf16x8*)(pb + 96 * 128 + off); \
        if (ROWSS) { G_SS(ss[0], b0); G_SS(ss[1], b1); G_SS(ss[2], b2); G_SS(ss[3], b3); } \
        acc[0] = MFMA32(a0, b0, acc[0]); acc[1] = MFMA32(a0, b1, acc[1]); acc[2] = MFMA32(a0, b2, acc[2]); acc[3] = MFMA32(a0, b3, acc[3]); \
        acc[4] = MFMA32(a1, b0, acc[4]); acc[5] = MFMA32(a1, b1, acc[5]); acc[6] = MFMA32(a1, b2, acc[6]); acc[7] = MFMA32(a1, b3, acc[7]); \
    } else if (WT == 2) { \
        const bf16x8 a0 = *(const bf16x8*)(pa + off), a1 = *(const bf16x8*)(pa + 32 * 128 + off); \
        const bf16x8 b0 = *(const bf16x8*)(pb + off), b1 = *(const bf16x8*)(pb + 32 * 128 + off); \
        if (ROWSS) { G_SS(ss[0], b0); G_SS(ss[1], b1); } \
        acc[0] = MFMA32(a0, b0, acc[0]); acc[1] = MFMA32(a0, b1, acc[1]); acc[2] = MFMA32(a1, b0, acc[2]); acc[3] = MFMA32(a1, b1, acc[3]); \
    } else { \
        const bf16x8 b0 = *(const bf16x8*)(pb + off); \
        const bf16x8 a0 = *(const bf16x8*)(pa + off), a1 = *(const bf16x8*)(pa + 32 * 128 + off); \
        const bf16x8 a2 = *(const bf16x8*)(pa + 64 * 128 + off), a3 = *(const bf16x8*)(pa + 96 * 128 + off); \
        if (ROWSS) { G_SS(ss[0], b0); } \
        acc[0] = MFMA32(a0, b0, acc[0]); acc[1] = MFMA32(a1, b0, acc[1]); \
        acc[2] = MFMA32(a2, b0, acc[2]); acc[3] = MFMA32(a3, b0, acc[3]); \
    } } while (0)
    const int arow = (WT == 1) ? ((w >> 2) * 128 + r32) : ((w >> 1) * 64 + r32);
    const int brow = (WT == 0) ? ((w & 1) * 128 + r32) : (WT == 2) ? ((w & 1) * 64 + r32) : ((w & 3) * 32 + r32);
    G_DMA(0, 0);
    for (int kt = 0; kt < nk; ++kt) {
        __syncthreads();
        if (kt + 1 < nk) G_DMA((kt + 1) & 1, (kt + 1) * 64);
        const char* pa = lds + (kt & 1) * G_BUF + arow * 128;
        const char* pb = lds + (kt & 1) * G_BUF + OPA + brow * 128;
        G_STEP(pa, pb, o0); G_STEP(pa, pb, o1); G_STEP(pa, pb, o2); G_STEP(pa, pb, o3);
    }
    if (ROWSS) { ss[0] += __shfl_xor(ss[0], 32, 64); ss[1] += __shfl_xor(ss[1], 32, 64); ss[2] += __shfl_xor(ss[2], 32, 64); ss[3] += __shfl_xor(ss[3], 32, 64); }
#undef G_DMA
#undef G_SS
#undef G_STEP
}

__device__ __forceinline__ void tile_range(int ntiles, int& lo, int& hi) {
    const int G = gridDim.x, b = blockIdx.x;
    const int vb = ((G & 7) == 0) ? ((b & 7) * (G >> 3) + (b >> 3)) : b;
    const int per = (ntiles + G - 1) / G;
    lo = vb * per; hi = lo + per; if (hi > ntiles) hi = ntiles;
}
constexpr int ST_P = 68;
static_assert(NW * 64 * ST_P * 4 <= LDS_TOTAL, "staging LDS");
template <bool ROWSS, class EPI, class EPIROW, class RSC>
__device__ __forceinline__ void gemm_t(const bf16* __restrict__ Wt, int ldw, int N, const bf16* __restrict__ X, int ldx, int M, int K, int tn_direct, EPI epi, EPIROW epirow, RSC rowscale, char* lds) {
    const int tid = tidx(), lane = tid & 63, w = tid >> 6, r32 = lane & 31, hi = lane >> 5;
    const int tilesN = N / 256, tilesM = M / 256, nk = K / 64;
    int tlo, thi; tile_range(tilesM * tilesN, tlo, thi);
    for (int tile = tlo; tile < thi; ++tile) {
        const int tm = tile / tilesN, tn = tile % tilesN;
        f32x16 acc[8]; float ss[4];
        gemm_kloop<0, ROWSS>(Wt + (size_t)(tn * 256) * ldw, ldw, X + (size_t)(tm * 256) * ldx, ldx, nk, acc, ss, lds, tid);
        if (tn < tn_direct) {
            __syncthreads();
            float* st = (float*)lds + w * (64 * ST_P);
            const int rr = lane >> 4, ch = lane & 15;
#pragma unroll
            for (int half = 0; half < 2; ++half) {
                const float m0_ = rowscale(ss[2 * half]), m1_ = rowscale(ss[2 * half + 1]);
#pragma unroll
                for (int i = 0; i < 2; ++i)
#pragma unroll
                    for (int jj = 0; jj < 2; ++jj)
#pragma unroll
                        for (int g = 0; g < 4; ++g) {
                            const float mj = jj ? m1_ : m0_;
                            const f32x16& a_ = acc[i * 4 + 2 * half + jj];
                            *(float4*)(st + (32 * jj + r32) * ST_P + 32 * i + 8 * g + 4 * hi) = make_float4(a_[4 * g] * mj, a_[4 * g + 1] * mj, a_[4 * g + 2] * mj, a_[4 * g + 3] * mj);
                        }
#pragma unroll 2
                for (int it = 0; it < 16; ++it) {
                    const int row = it * 4 + rr;
                    const float4 v = *(const float4*)(st + row * ST_P + ch * 4);
                    epirow(tm * 256 + (w & 1) * 128 + half * 64 + row, tn * 256 + (w >> 1) * 64 + ch * 4, v);
                }
            }
        } else {
#pragma unroll
            for (int i = 0; i < 2; ++i)
#pragma unroll
                for (int j = 0; j < 4; ++j)
                    epi(tn * 256 + (w >> 1) * 64 + i * 32, tm * 256 + (w & 1) * 128 + j * 32, acc[i * 4 + j], r32, hi, ss[j]);
        }
        __syncthreads();
    }
}

constexpr int ST1_P = 132;
static_assert(NW * 32 * ST1_P * 4 <= LDS_TOTAL, "staging LDS (128 x 32 wave tiles)");
template <class EPIROW, class RSC>
__device__ __forceinline__ void gemm_t1(const bf16* __restrict__ Wt, int ldw, int N, const bf16* __restrict__ X, int ldx, int M, int K, EPIROW epirow, RSC rowscale, char* lds) {
    const int tid = tidx(), lane = tid & 63, w = tid >> 6, r32 = lane & 31, hi = lane >> 5;
    const int tilesN = N / 256, tilesM = M / 128, nk = K / 64;
    int tlo, thi; tile_range(tilesM * tilesN, tlo, thi);
    for (int tile = tlo; tile < thi; ++tile) {
        const int tm = tile / tilesN, tn = tile % tilesN;
        f32x16 acc[8]; float ss[4];
        gemm_kloop<1, true>(Wt + (size_t)(tn * 256) * ldw, ldw, X + (size_t)(tm * 128) * ldx, ldx, nk, acc, ss, lds, tid);
        __syncthreads();
        float* st = (float*)lds + w * (32 * ST1_P);
        const float mj = rowscale(ss[0]);
#pragma unroll
        for (int mt = 0; mt < 4; ++mt)
#pragma unroll
            for (int g = 0; g < 4; ++g)
                *(float4*)(st + r32 * ST1_P + 32 * mt + 8 * g + 4 * hi) = make_float4(acc[mt][4 * g] * mj, acc[mt][4 * g + 1] * mj, acc[mt][4 * g + 2] * mj, acc[mt][4 * g + 3] * mj);
#pragma unroll 2
        for (int it = 0; it < 16; ++it) {
            const int row = it * 2 + hi;
            const float4 v = *(const float4*)(st + row * ST1_P + r32 * 4);
            epirow(tm * 128 + (w & 3) * 32 + row, tn * 256 + (w >> 2) * 128 + r32 * 4, v);
        }
        __syncthreads();
    }
}

template <class EPIROW>
__device__ __forceinline__ void gemm_t2(const bf16* __restrict__ Wt, int ldw, int N, const bf16* __restrict__ X, int ldx, int M, int K, EPIROW epirow, char* lds) {
    const int tid = tidx(), lane = tid & 63, w = tid >> 6, r32 = lane & 31, hi = lane >> 5;
    const int tilesN = N / 256, tilesM = M / 128, nk = K / 64;
    int tlo, thi; tile_range(tilesM * tilesN, tlo, thi);
    for (int tile = tlo; tile < thi; ++tile) {
        const int tm = tile / tilesN, tn = tile % tilesN;
        f32x16 acc[8]; float ss[4];
        gemm_kloop<2, false>(Wt + (size_t)(tn * 256) * ldw, ldw, X + (size_t)(tm * 128) * ldx, ldx, nk, acc, ss, lds, tid);
        __syncthreads();
        float* st = (float*)lds + w * (64 * ST_P);
#pragma unroll
        for (int i = 0; i < 2; ++i)
#pragma unroll
            for (int j = 0; j < 2; ++j)
#pragma unroll
                for (int g = 0; g < 4; ++g)
                    *(float4*)(st + (32 * j + r32) * ST_P + 32 * i + 8 * g + 4 * hi) = make_float4(acc[i * 2 + j][4 * g], acc[i * 2 + j][4 * g + 1], acc[i * 2 + j][4 * g + 2], acc[i * 2 + j][4 * g + 3]);
        const int rr = lane >> 4, ch = lane & 15;
#pragma unroll 4
        for (int it = 0; it < 16; ++it) {
            const int row = it * 4 + rr;
            const float4 v = *(const float4*)(st + row * ST_P + ch * 4);
            epirow(tm * 128 + (w & 1) * 64 + row, tn * 256 + (w >> 1) * 64 + ch * 4, v);
        }
        __syncthreads();
    }
}

typedef __attribute__((ext_vector_type(4))) float f32x4;
constexpr int G8_HT = 128 * 64;
__device__ __forceinline__ int g8_lds_byte(int r, int c) {
    const int st = (r >> 4) * 2 + (c >> 5), rr = r & 15, cc = c & 31, ob = rr * 64 + cc * 2;
    return st * 1024 + (ob ^ (((ob >> 9) & 1) << 5));
}
__device__ __forceinline__ void g8_stage_rc(int b, int& R, int& C) {
    const int st = b / 1024, sb = b % 1024, swz = sb ^ (((sb >> 9) & 1) << 5);
    R = (st >> 1) * 16 + swz / 64; C = (st & 1) * 32 + (swz % 64) / 2;
}
__device__ __forceinline__ float ssq8(const bf16x8& v, float s) {
    union { bf16x8 v; uint4 u; } c_; c_.v = v;
    s = dot2bf(c_.u.x, c_.u.x, s); s = dot2bf(c_.u.y, c_.u.y, s); s = dot2bf(c_.u.z, c_.u.z, s); return dot2bf(c_.u.w, c_.u.w, s);
}
typedef __attribute__((ext_vector_type(4))) int i32x4;
__device__ __forceinline__ f32x4 mma8(const bf16x8& a, const bf16x8& b, const f32x4& c) { return __builtin_amdgcn_mfma_f32_16x16x32_bf16(a, b, c, 0, 0, 0); }
__device__ __forceinline__ i32x4 mma8(const bf16x8& a, const bf16x8& b, const i32x4& c) { return __builtin_amdgcn_mfma_i32_16x16x64_i8(__builtin_bit_cast(i32x4, a), __builtin_bit_cast(i32x4, b), c, 0, 0, 0); }
template <bool ROWSS, bool APERM = false, class ACC = f32x4>
__device__ __forceinline__ void gemm8_kloop(const bf16* __restrict__ A, int lda, const bf16* __restrict__ Bt, int ldb, int nt, ACC (&acc)[2][2][4][2], float (&ss)[2][2], char* lds, int tid) {
    bf16* shm = (bf16*)lds;
    typedef __attribute__((address_space(3))) unsigned* ldsp_t;
    typedef const __attribute__((address_space(1))) unsigned* glbp_t;
#define SA(b, h) (shm + ((b) * 2 + (h)) * G8_HT)
#define SB(b, h) (shm + (4 + (b) * 2 + (h)) * G8_HT)
    int sr0, sc0; g8_stage_rc(tid * 16, sr0, sc0);
    const unsigned voa = (unsigned)((sr0 * lda + sc0) * 2), vob = (unsigned)((sr0 * ldb + sc0) * 2);
    const char* Ap = (const char*)A; const char* Bp = (const char*)Bt;
    const int wbase = __builtin_amdgcn_readfirstlane(tid >> 6) * 1024;
#define STAGE_(P, BASE, VO, LD, br, r2, kt) do { const char* g_ = BASE + ((size_t)(br) * LD + (kt) * 64) * 2; \
    __builtin_amdgcn_global_load_lds((glbp_t)(const void*)(g_ + VO), (ldsp_t)(void*)((char*)(P) + wbase), 16, 0, 0); \
    __builtin_amdgcn_global_load_lds((glbp_t)(const void*)(g_ + (size_t)(2 * (r2)) * LD + VO), (ldsp_t)(void*)((char*)(P) + wbase + 8192), 16, 0, 0); } while (0)
#define STAGEA(b, h, kt) STAGE_(SA(b, h), Ap, voa, lda, (APERM ? (h) * 64 : (h) * 128), (APERM ? 128 : 64), kt)
#define STAGEB(b, h, kt) STAGE_(SB(b, h), Bp, vob, ldb, (h) * 128, 64, kt)
    const int lane = tid & 63, wid = tid >> 6, wr = wid >> 2, wc = wid & 3, fr = lane & 15, fq = lane >> 4;
    int abase, bbase;
    { const int ob = fr * 64 + fq * 16, lp = ob ^ (((ob >> 9) & 1) << 5);
      abase = lp + wr * 8192; bbase = lp + wc * 4096 + 4 * G8_HT * 2;
      asm volatile("" : "+v"(abase), "+v"(bbase)); }
#define LDA(dst, b, h) _Pragma("unroll") for (int m = 0; m < 4; ++m) _Pragma("unroll") for (int k = 0; k < 2; ++k) \
    dst[m][k] = *reinterpret_cast<const bf16x8*>(lds + abase + (((b) * 2 + (h)) * G8_HT * 2 + m * 2048 + k * 1024))
#define LDB(dst, b, h) _Pragma("unroll") for (int n = 0; n < 2; ++n) _Pragma("unroll") for (int k = 0; k < 2; ++k) \
    dst[n][k] = *reinterpret_cast<const bf16x8*>(lds + bbase + (((b) * 2 + (h)) * G8_HT * 2 + n * 2048 + k * 1024))
#define MMA(ai, bj, At_, Bt_) do { __builtin_amdgcn_s_setprio(1); \
    _Pragma("unroll") for (int m = 0; m < 4; ++m) _Pragma("unroll") for (int n = 0; n < 2; ++n) _Pragma("unroll") for (int k = 0; k < 2; ++k) \
        acc[ai][bj][m][n] = mma8(At_[m][k], Bt_[n][k], acc[ai][bj][m][n]); \
    __builtin_amdgcn_s_setprio(0); } while (0)
#define SSQ(bj, Bt_) do { if (ROWSS) { _Pragma("unroll") for (int n = 0; n < 2; ++n) { ss[bj][n] = ssq8(Bt_[n][0], ss[bj][n]); ss[bj][n] = ssq8(Bt_[n][1], ss[bj][n]); } } } while (0)
#define WAIT_V(n) asm volatile("s_waitcnt vmcnt(" #n ")" ::: "memory")
#define WAIT_L(n) asm volatile("s_waitcnt lgkmcnt(" #n ")" ::: "memory")
#define BAR __builtin_amdgcn_s_barrier()
#define SCHED __builtin_amdgcn_sched_barrier(0)
#pragma unroll
    for (int a = 0; a < 2; ++a)
#pragma unroll
        for (int b = 0; b < 2; ++b)
#pragma unroll
            for (int m = 0; m < 4; ++m)
#pragma unroll
                for (int n = 0; n < 2; ++n) acc[a][b][m][n] = ACC{0, 0, 0, 0};
    ss[0][0] = 0.f; ss[0][1] = 0.f; ss[1][0] = 0.f; ss[1][1] = 0.f;
    bf16x8 At[4][2], B0[2][2], B1[2][2];
    STAGEB(0, 0, 0); STAGEA(0, 0, 0);
    STAGEB(0, 1, 0); STAGEA(0, 1, 0);
    if (wr == 1) BAR;
    WAIT_V(4); BAR;
    STAGEB(1, 0, 1); STAGEA(1, 0, 1); STAGEB(1, 1, 1);
    WAIT_V(6); BAR;
    for (int t = 0; t < nt - 2; t += 2) {
        LDB(B0, 0, 0); SCHED; LDA(At, 0, 0); STAGEA(1, 1, t + 1);
        WAIT_L(8); BAR; WAIT_L(0); MMA(0, 0, At, B0); SSQ(0, B0); BAR; SCHED;
        LDB(B1, 0, 1); STAGEB(0, 0, t + 2);
        BAR; WAIT_L(0); MMA(0, 1, At, B1); SSQ(1, B1); BAR;
        LDA(At, 0, 1); STAGEA(0, 0, t + 2);
        BAR; WAIT_L(0); MMA(1, 0, At, B0); BAR; SCHED;
        STAGEB(0, 1, t + 2);
        WAIT_V(6); BAR; MMA(1, 1, At, B1); BAR;
        LDB(B0, 1, 0); SCHED; LDA(At, 1, 0); STAGEA(0, 1, t + 2);
        WAIT_L(8); BAR; WAIT_L(0); MMA(0, 0, At, B0); SSQ(0, B0); BAR; SCHED;
        LDB(B1, 1, 1); STAGEB(1, 0, t + 3);
        BAR; WAIT_L(0); MMA(0, 1, At, B1); SSQ(1, B1); BAR;
        LDA(At, 1, 1); STAGEA(1, 0, t + 3);
        BAR; WAIT_L(0); MMA(1, 0, At, B0); BAR; SCHED;
        STAGEB(1, 1, t + 3);
        WAIT_V(6); BAR; MMA(1, 1, At, B1); BAR;
    }
    { LDB(B0, 0, 0); LDA(At, 0, 0); STAGEA(1, 1, nt - 1);
      BAR; WAIT_L(0); MMA(0, 0, At, B0); SSQ(0, B0); BAR;
      LDB(B1, 0, 1); BAR; WAIT_L(0); MMA(0, 1, At, B1); SSQ(1, B1); BAR;
      LDA(At, 0, 1); WAIT_V(4); BAR; WAIT_L(0); MMA(1, 0, At, B0); MMA(1, 1, At, B1); BAR; }
    { LDB(B0, 1, 0); LDA(At, 1, 0); WAIT_V(2); BAR; WAIT_L(0); MMA(0, 0, At, B0); SSQ(0, B0); BAR;
      LDB(B1, 1, 1); WAIT_V(0); BAR; WAIT_L(0); MMA(0, 1, At, B1); SSQ(1, B1); BAR;
      LDA(At, 1, 1); BAR; WAIT_L(0); MMA(1, 0, At, B0); MMA(1, 1, At, B1); BAR; }
    if (wr == 0) BAR;
    if (ROWSS) {
#pragma unroll
        for (int b = 0; b < 2; ++b)
#pragma unroll
            for (int n = 0; n < 2; ++n) { ss[b][n] += __shfl_xor(ss[b][n], 16, 64); ss[b][n] += __shfl_xor(ss[b][n], 32, 64); }
    }
#undef SSQ
#undef SA
#undef SB
#undef STAGE_
#undef STAGEA
#undef STAGEB
#undef LDA
#undef LDB
#undef MMA
#undef WAIT_V
#undef WAIT_L
#undef BAR
#undef SCHED
}
__device__ __forceinline__ void tile_rounds(int ntiles, int& lo, int& hi, int& step) {
    const int G = gridDim.x, b = blockIdx.x;
    if ((G & 7) == 0) { const int per = (ntiles + 7) >> 3, x = b & 7; lo = x * per + (b >> 3); hi = (x + 1) * per; if (hi > ntiles) hi = ntiles; step = G >> 3; }
    else { lo = b; hi = ntiles; step = G; }
}
template <bool SCALE, bool PRE, bool I8, class EPIROW, class RSC, class PREF, class CSC>
__device__ __forceinline__ void gemm_t8(const bf16* __restrict__ Wt, int ldw, int N, const bf16* __restrict__ X, int ldx, int K, int tlo, int thi, int tstep, EPIROW epirow, RSC rowscale, PREF pre, CSC colscale, char* lds) {
    typedef typename std::conditional<I8, i32x4, f32x4>::type ACC;
    const int tid = tidx();
    const int tilesN = N / 256; int nt = K / 64;
    asm volatile("" : "+s"(nt));
    for (int tile = tlo; tile < thi; tile += tstep) {
        const int tm = tile / tilesN, tn = tile % tilesN;
        ACC acc[2][2][4][2]; float ss[2][2];
        gemm8_kloop<false, false, ACC>(Wt + (size_t)(tn * 256) * ldw, ldw, X + (size_t)(tm * 256) * ldx, ldx, nt, acc, ss, lds, tid);
        __syncthreads();
        const int te = tidx();
        const int le = te & 63, w = te >> 6, wr = w >> 2, wc = w & 3, fr = le & 15, fq = le >> 4;
        float* st = (float*)lds + w * (32 * ST_P);
        const int rr = le >> 4, ch = le & 15;
        const int tb = tm * 256 + wc * 32 + rr, nb = tn * 256 + wr * 64 + ch * 4;
#pragma unroll
        for (int ai = 0; ai < 2; ++ai)
#pragma unroll
            for (int bj = 0; bj < 2; ++bj) {
                float4 pv[8];
                if (PRE) {
#pragma unroll
                    for (int it = 0; it < 8; ++it) pv[it] = pre(tb + bj * 128 + it * 4, nb + ai * 128);
                }
#pragma unroll
                for (int n = 0; n < 2; ++n) {
                    const float mj = SCALE ? rowscale(tm * 256 + bj * 128 + wc * 32 + n * 16 + fr) : 1.f;
#pragma unroll
                    for (int m = 0; m < 4; ++m) {
                        const ACC a_ = acc[ai][bj][m][n];
                        if (I8) {
                            const float4 cs = colscale(tn * 256 + ai * 128 + wr * 64 + m * 16 + fq * 4);
                            *(float4*)(st + (n * 16 + fr) * ST_P + m * 16 + fq * 4) = make_float4((float)a_[0] * (mj * cs.x), (float)a_[1] * (mj * cs.y), (float)a_[2] * (mj * cs.z), (float)a_[3] * (mj * cs.w));
                        } else
                        *(float4*)(st + (n * 16 + fr) * ST_P + m * 16 + fq * 4) = SCALE ? make_float4(a_[0] * mj, a_[1] * mj, a_[2] * mj, a_[3] * mj) : make_float4(a_[0], a_[1], a_[2], a_[3]);
                    }
                }
                if (PRE) {
#pragma unroll
                    for (int it = 0; it < 8; ++it) {
                        const float4 v = *(const float4*)(st + (it * 4 + rr) * ST_P + ch * 4);
                        epirow(tb + bj * 128 + it * 4, nb + ai * 128, v, pv[it]);
                    }
                } else {
#pragma unroll 2
                    for (int it = 0; it < 8; ++it) {
                        const float4 v = *(const float4*)(st + (it * 4 + rr) * ST_P + ch * 4);
                        epirow(tb + bj * 128 + it * 4, nb + ai * 128, v, make_float4(0.f, 0.f, 0.f, 0.f));
                    }
                }
            }
        __syncthreads();
    }
}

__device__ __forceinline__ void transpose_tiled(const float* __restrict__ W, bf16* __restrict__ Wt, int K, int N, int Npad, int ldk, const float* __restrict__ gain, char* lds) {
    float (*tl)[65] = (float (*)[65])lds;
    const int tid = tidx(), a = tid & 63, q = tid >> 6;
    const int tK = K / 64, tN = Npad / 64;
    for (int tile = blockIdx.x; tile < tK * tN; tile += gridDim.x) {
        const int k0 = (tile / tN) * 64, n0 = (tile % tN) * 64;
#pragma unroll 4
        for (int i = 0; i < 64 / NW; ++i) {
            const int k = k0 + q * (64 / NW) + i, n = n0 + a;
            float v = (n < N) ? W[(size_t)k * N + n] : 0.f;
            if (gain) v *= gain[k];
            tl[q * (64 / NW) + i][a] = v;
        }
        __syncthreads();
#pragma unroll 4
        for (int i = 0; i < 64 / NW; ++i) { const int nl = q * (64 / NW) + i; Wt[(size_t)(n0 + nl) * ldk + k0 + a] = f2bf(tl[a][nl]); }
        __syncthreads();
    }
}

__device__ __forceinline__ void quant_row(const float4 (&v)[4], unsigned char* __restrict__ dst, float* __restrict__ scl, int r, int lane) {
    float am = 0.f;
#pragma unroll
    for (int j = 0; j < 4; ++j) am = fmaxf(am, fmaxf(fmaxf(fabsf(v[j].x), fabsf(v[j].y)), fmaxf(fabsf(v[j].z), fabsf(v[j].w))));
#pragma unroll
    for (int m = 32; m >= 1; m >>= 1) am = fmaxf(am, __shfl_xor(am, m, 64));
    const float sc = (am > 0.f) ? am * (1.f / 448.f) : 1.f;
    const float is = 1.f / sc;
    uint4 o;
    { int w = 0; w = __builtin_amdgcn_cvt_pk_fp8_f32(v[0].x * is, v[0].y * is, w, false); w = __builtin_amdgcn_cvt_pk_fp8_f32(v[0].z * is, v[0].w * is, w, true); o.x = (unsigned)w; }
    { int w = 0; w = __builtin_amdgcn_cvt_pk_fp8_f32(v[1].x * is, v[1].y * is, w, false); w = __builtin_amdgcn_cvt_pk_fp8_f32(v[1].z * is, v[1].w * is, w, true); o.y = (unsigned)w; }
    { int w = 0; w = __builtin_amdgcn_cvt_pk_fp8_f32(v[2].x * is, v[2].y * is, w, false); w = __builtin_amdgcn_cvt_pk_fp8_f32(v[2].z * is, v[2].w * is, w, true); o.z = (unsigned)w; }
    { int w = 0; w = __builtin_amdgcn_cvt_pk_fp8_f32(v[3].x * is, v[3].y * is, w, false); w = __builtin_amdgcn_cvt_pk_fp8_f32(v[3].z * is, v[3].w * is, w, true); o.w = (unsigned)w; }
    { const int lay = r / NEXP, e = r % NEXP; *(uint4*)(dst + (((size_t)(lay * 8 + (lane >> 3)) * NEXP + e) * 128) + (lane & 7) * 16) = o; }
    if (lane == 0) scl[r] = sc;
}
__device__ __forceinline__ unsigned pack_i8x4(float a, float b, float c, float d) {
    const int ia = __float2int_rn(a), ib = __float2int_rn(b), ic = __float2int_rn(c), id = __float2int_rn(d);
    return (unsigned)(ia & 255) | ((unsigned)(ib & 255) << 8) | ((unsigned)(ic & 255) << 16) | ((unsigned)(id & 255) << 24);
}
__device__ __forceinline__ void quant_row_i8(const float4 (&v)[4], unsigned char* __restrict__ dst, float* __restrict__ scl, int r, int lane) {
    float am = 0.f;
#pragma unroll
    for (int j = 0; j < 4; ++j) am = fmaxf(am, fmaxf(fmaxf(fabsf(v[j].x), fabsf(v[j].y)), fmaxf(fabsf(v[j].z), fabsf(v[j].w))));
#pragma unroll
    for (int m = 32; m >= 1; m >>= 1) am = fmaxf(am, __shfl_xor(am, m, 64));
    const float sc = (am > 0.f) ? am * (1.f / 127.f) : 1.f;
    const float is = 1.f / sc;
    uint4 o;
    o.x = pack_i8x4(v[0].x * is, v[0].y * is, v[0].z * is, v[0].w * is); o.y = pack_i8x4(v[1].x * is, v[1].y * is, v[1].z * is, v[1].w * is);
    o.z = pack_i8x4(v[2].x * is, v[2].y * is, v[2].z * is, v[2].w * is); o.w = pack_i8x4(v[3].x * is, v[3].y * is, v[3].z * is, v[3].w * is);
    { const int lay = r / NEXP, e = r % NEXP; *(uint4*)(dst + (((size_t)(lay * 8 + (lane >> 3)) * NEXP + e) * 128) + (lane & 7) * 16) = o; }
    if (lane == 0) scl[r] = sc;
}
template <bool I8>
__device__ __forceinline__ void convert_table(const float* __restrict__ src, unsigned char* __restrict__ dst, float* __restrict__ scl, int rows) {
    static_assert(TAB_FP8, "fp8 tables");
    const int lane = tidx() & 63;
    const int nw = nwave();
    for (int r = gwave(); r < rows; r += 4 * nw) {
        float4 v[4][4]; int rr[4];
#pragma unroll
        for (int u = 0; u < 4; ++u) {
            rr[u] = (r + u * nw < rows) ? (r + u * nw) : r;
            const float4* s0 = (const float4*)(src + (size_t)rr[u] * D);
#pragma unroll
            for (int j = 0; j < 4; ++j) v[u][j] = s0[lane * 4 + j];
        }
#pragma unroll
        for (int u = 0; u < 4; ++u) {
            if (u == 0 || rr[u] != r) { if (I8) quant_row_i8(v[u], dst, scl, rr[u], lane); else quant_row(v[u], dst, scl, rr[u], lane); }
        }
    }
}
__device__ __forceinline__ void phase_prep(const Params& P, char* lds) {
    unsigned char* ws = P.ws;
    for (int l = 0; l < DEPTH; ++l) {
        transpose_tiled(P.w_in + (size_t)l * D * DIN, (bf16*)(ws + WS_WIN) + (size_t)l * DINP * LDW, D, DIN, DINP, LDW, nullptr, lds);
        transpose_tiled(P.w_uq + (size_t)l * QR * 768, (bf16*)(ws + WS_WUQ) + (size_t)l * 768 * QR, QR, 768, 768, QR, P.q_norm + l * QR, lds);
        transpose_tiled(P.w_uk + (size_t)l * KVR * 512, (bf16*)(ws + WS_WUKV) + (size_t)l * 1024 * KVR, KVR, 512, 512, KVR, P.kv_norm + l * KVR, lds);
        transpose_tiled(P.w_uv + (size_t)l * KVR * 512, (bf16*)(ws + WS_WUKV) + (size_t)l * 1024 * KVR + (size_t)512 * KVR, KVR, 512, 512, KVR, P.kv_norm + l * KVR, lds);
        transpose_tiled(P.w_out + (size_t)l * D * D, (bf16*)(ws + WS_WOUT) + (size_t)l * D * LDW, D, D, D, LDW, nullptr, lds);
    }
    {
        bf16* Wc = (bf16*)(ws + WS_WPQ);
        float (*As)[68] = (float (*)[68])lds;
        float (*Bs)[68] = (float (*)[68])(lds + 16 * 68 * 4);
        const int tid = tidx(), tx = tid & 15, ty = (tid >> 4) & 15;
        const int lr = (tid >> 2) & 63, ld4 = (tid & 3) * 4;
        for (int tile = blockIdx.x; tile < (DEPTH * 2048 / 64) * (D / 64); tile += gridDim.x) {
            const int row0 = (tile >> 4) * 64, k0 = (tile & 15) * 64;
            const int l = row0 >> 11, hp = (row0 >> 7) & 15, n0 = row0 & 127;
            const float* skp = P.peer_subkeys + (((size_t)l * 2 + (hp & 1)) * NKEY + n0 + lr) * 128 + ld4;
            const float* wqp = P.peer_wq + ((size_t)l * D + k0 + lr) * 2048 + hp * 128 + ld4;
            float acc[4][4];
#pragma unroll
            for (int i = 0; i < 4; ++i)
#pragma unroll
                for (int j = 0; j < 4; ++j) acc[i][j] = 0.f;
            for (int d0 = 0; d0 < 128; d0 += 16) {
                if (tid < 256) {
                    const float4 av = *(const float4*)(skp + d0), bv = *(const float4*)(wqp + d0);
                    As[ld4 + 0][lr] = av.x; As[ld4 + 1][lr] = av.y; As[ld4 + 2][lr] = av.z; As[ld4 + 3][lr] = av.w;
                    Bs[ld4 + 0][lr] = bv.x; Bs[ld4 + 1][lr] = bv.y; Bs[ld4 + 2][lr] = bv.z; Bs[ld4 + 3][lr] = bv.w;
                }
                __syncthreads();
#pragma unroll
                for (int kk = 0; kk < 16; ++kk) {
                    const float4 a4 = *(const float4*)&As[kk][ty * 4], b4 = *(const float4*)&Bs[kk][tx * 4];
                    const float aa[4] = {a4.x, a4.y, a4.z, a4.w}, bb[4] = {b4.x, b4.y, b4.z, b4.w};
#pragma unroll
                    for (int i = 0; i < 4; ++i)
#pragma unroll
                        for (int j = 0; j < 4; ++j) acc[i][j] = fmaf(aa[i], bb[j], acc[i][j]);
                }
                __syncthreads();
            }
            if (tid < 256) {
#pragma unroll
                for (int i = 0; i < 4; ++i) {
                    uint2 o; o.x = pack2(acc[i][0], acc[i][1]); o.y = pack2(acc[i][2], acc[i][3]);
                    *(uint2*)(Wc + (size_t)(row0 + ty * 4 + i) * LDW + k0 + tx * 4) = o;
                }
            }
        }
    }
    convert_table<true>(P.peer_u, ws + WS_TABU, (float*)(ws + WS_TSCU), DEPTH * NEXP);
    convert_table<false>(P.peer_v, ws + WS_TABV, (float*)(ws + WS_TSCV), DEPTH * NEXP);
    float* rope = (float*)(ws + WS_ROPE);
    for (size_t i = gtid(); i < (size_t)S * 16; i += gnth()) {
        const int s = (int)(i >> 4), f = (int)(i & 15);
        const double inv = pow(10000.0, -(double)f / 16.0);
        const double ang = (double)s * inv;
        rope[2 * i] = (float)cos(ang); rope[2 * i + 1] = (float)sin(ang);
    }
}

__device__ __forceinline__ void phase_norm(const float* __restrict__ h, const float* __restrict__ g, unsigned* __restrict__ xq, float* __restrict__ xsc) {
    const int lane = tidx() & 63, nw = nwave();
    for (int t = gwave(); t < T; t += 2 * nw) {
        const int t2 = (t + nw < T) ? (t + nw) : t;
        float4 v[2][4];
#pragma unroll
        for (int j = 0; j < 4; ++j) { v[0][j] = ((const float4*)(h + (size_t)t * D))[j * 64 + lane]; v[1][j] = ((const float4*)(h + (size_t)t2 * D))[j * 64 + lane]; }
#pragma unroll
        for (int u = 0; u < 2; ++u) {
            float ss = 0.f;
#pragma unroll
            for (int j = 0; j < 4; ++j) ss += v[u][j].x * v[u][j].x + v[u][j].y * v[u][j].y + v[u][j].z * v[u][j].z + v[u][j].w * v[u][j].w;
            ss = wave_sum(ss);
            const float r = rsqrtf(ss * (1.f / D) + EPS);
            const int tt = u ? t2 : t;
            if (u == 0 || t2 != t) {
                float am = 0.f;
#pragma unroll
                for (int j = 0; j < 4; ++j) {
                    const float4 gg = ((const float4*)g)[j * 64 + lane];
                    v[u][j].x *= r * gg.x; v[u][j].y *= r * gg.y; v[u][j].z *= r * gg.z; v[u][j].w *= r * gg.w;
                    am = fmaxf(am, fmaxf(fmaxf(fabsf(v[u][j].x), fabsf(v[u][j].y)), fmaxf(fabsf(v[u][j].z), fabsf(v[u][j].w))));
                }
#pragma unroll
                for (int m = 32; m >= 1; m >>= 1) am = fmaxf(am, __shfl_xor(am, m, 64));
                const float sc = (am > 0.f) ? am * (1.f / 127.f) : 1.f, is = 1.f / sc;
#pragma unroll
                for (int j = 0; j < 4; ++j) xq[(size_t)tt * (XQP / 4) + j * 64 + lane] = pack_i8x4(v[u][j].x * is, v[u][j].y * is, v[u][j].z * is, v[u][j].w * is);
                if (lane == 0) xsc[tt] = sc;
            }
        }
    }
}
__device__ __forceinline__ void quant_wrows(const bf16* __restrict__ W, int nrows, unsigned char* __restrict__ W8, float* __restrict__ WS8) {
    const int lane = tidx() & 63;
    for (int row = gwave(); row < nrows; row += nwave()) {
        const uint4 a = ((const uint4*)(W + (size_t)row * LDW))[lane * 2], b = ((const uint4*)(W + (size_t)row * LDW))[lane * 2 + 1];
        float v[16] = {bflo(a.x), bfhi(a.x), bflo(a.y), bfhi(a.y), bflo(a.z), bfhi(a.z), bflo(a.w), bfhi(a.w), bflo(b.x), bfhi(b.x), bflo(b.y), bfhi(b.y), bflo(b.z), bfhi(b.z), bflo(b.w), bfhi(b.w)};
        float am = 0.f;
#pragma unroll
        for (int i = 0; i < 16; ++i) am = fmaxf(am, fabsf(v[i]));
#pragma unroll
        for (int m = 32; m >= 1; m >>= 1) am = fmaxf(am, __shfl_xor(am, m, 64));
        const float sc = (am > 0.f) ? am * (1.f / 127.f) : 1.f, is = 1.f / sc;
        uint4 o;
        o.x = pack_i8x4(v[0] * is, v[1] * is, v[2] * is, v[3] * is); o.y = pack_i8x4(v[4] * is, v[5] * is, v[6] * is, v[7] * is);
        o.z = pack_i8x4(v[8] * is, v[9] * is, v[10] * is, v[11] * is); o.w = pack_i8x4(v[12] * is, v[13] * is, v[14] * is, v[15] * is);
        ((uint4*)(W8 + (size_t)row * XQP))[lane] = o;
        if (lane == 0) WS8[row] = sc;
    }
}
__device__ __forceinline__ void phase_norm_q(const Params& P, int l) {
    const int lane = tidx() & 63, nw = nwave();
    const float* g = P.norm_ffn + l * D;
    unsigned* xq = (unsigned*)(P.ws + WS_XQ);
    float* xsc = (float*)(P.ws + WS_XS);
    bf16* Hb = (bf16*)P.out;
    const bf16* yo = (const bf16*)(P.ws + WS_PROJ);
    for (int t = gwave(); t < T; t += 2 * nw) {
        const int t2 = (t + nw < T) ? (t + nw) : t;
        float4 v[2][4];
#pragma unroll
        for (int j = 0; j < 4; ++j) {
            if (l == 0) { v[0][j] = ((const float4*)(P.x + (size_t)t * D))[j * 64 + lane]; v[1][j] = ((const float4*)(P.x + (size_t)t2 * D))[j * 64 + lane]; }
            else {
                const uint2 a = ((const uint2*)(Hb + (size_t)t * HP))[j * 64 + lane], b = ((const uint2*)(Hb + (size_t)t2 * HP))[j * 64 + lane];
                v[0][j] = make_float4(bflo(a.x), bfhi(a.x), bflo(a.y), bfhi(a.y)); v[1][j] = make_float4(bflo(b.x), bfhi(b.x), bflo(b.y), bfhi(b.y));
            }
        }
        {
            uint2 y[2][4];
#pragma unroll
            for (int j = 0; j < 4; ++j) { y[0][j] = ((const uint2*)(yo + (size_t)t * D))[j * 64 + lane]; y[1][j] = ((const uint2*)(yo + (size_t)t2 * D))[j * 64 + lane]; }
#pragma unroll
            for (int u = 0; u < 2; ++u)
#pragma unroll
                for (int j = 0; j < 4; ++j) { v[u][j].x += bflo(y[u][j].x); v[u][j].y += bfhi(y[u][j].x); v[u][j].z += bflo(y[u][j].y); v[u][j].w += bfhi(y[u][j].y); }
#pragma unroll
            for (int j = 0; j < 4; ++j) {
                uint2 a, b; a.x = pack2(v[0][j].x, v[0][j].y); a.y = pack2(v[0][j].z, v[0][j].w); b.x = pack2(v[1][j].x, v[1][j].y); b.y = pack2(v[1][j].z, v[1][j].w);
                ((uint2*)(Hb + (size_t)t * HP))[j * 64 + lane] = a; if (t2 != t) ((uint2*)(Hb + (size_t)t2 * HP))[j * 64 + lane] = b;
            }
        }
#pragma unroll
        for (int u = 0; u < 2; ++u) {
            float ss = 0.f;
#pragma unroll
            for (int j = 0; j < 4; ++j) ss += v[u][j].x * v[u][j].x + v[u][j].y * v[u][j].y + v[u][j].z * v[u][j].z + v[u][j].w * v[u][j].w;
            ss = wave_sum(ss);
            const float r = rsqrtf(ss * (1.f / D) + EPS);
            const int tt = u ? t2 : t;
            if (u == 0 || t2 != t) {
                float am = 0.f;
#pragma unroll
                for (int j = 0; j < 4; ++j) {
                    const float4 gg = ((const float4*)g)[j * 64 + lane];
                    v[u][j].x *= r * gg.x; v[u][j].y *= r * gg.y; v[u][j].z *= r * gg.z; v[u][j].w *= r * gg.w;
                    am = fmaxf(am, fmaxf(fmaxf(fabsf(v[u][j].x), fabsf(v[u][j].y)), fmaxf(fabsf(v[u][j].z), fabsf(v[u][j].w))));
                }
#pragma unroll
                for (int m = 32; m >= 1; m >>= 1) am = fmaxf(am, __shfl_xor(am, m, 64));
                const float sc = (am > 0.f) ? am * (1.f / 127.f) : 1.f, is = 1.f / sc;
#pragma unroll
                for (int j = 0; j < 4; ++j) xq[(size_t)tt * (XQP / 4) + j * 64 + lane] = pack_i8x4(v[u][j].x * is, v[u][j].y * is, v[u][j].z * is, v[u][j].w * is);
                if (lane == 0) xsc[tt] = sc;
            }
        }
    }
}

__device__ __forceinline__ void phase_mixlocal(const Params& P, int l, char* lds) {
    const bf16* proj = (const bf16*)(P.ws + WS_PROJ);
    bf16* Y = (bf16*)(P.ws + WS_XN);
    const int tid = tidx();
    {
        const float* cw = P.conv_w + (size_t)l * 3 * 256;
        const size_t nth = gnth();
        for (size_t i0 = gtid(); i0 < (size_t)T * 32; i0 += 4 * nth) {
            uint4 gq[4][3], hq[4][3], bq[4];
#pragma unroll
            for (int u = 0; u < 4; ++u) {
                const size_t i = (i0 + u * nth < (size_t)T * 32) ? (i0 + u * nth) : i0;
                const int t = (int)(i >> 5), c0 = (int)(i & 31) * 8, s = t & (S - 1);
                const bf16* pr = proj + (size_t)t * DINP;
#pragma unroll
                for (int j = 0; j < 3; ++j) {
                    const bf16* pp = pr - (size_t)((s - 2 + j >= 0) ? (2 - j) : 0) * DINP;
                    gq[u][j] = *(const uint4*)(pp + C_CG + c0); hq[u][j] = *(const uint4*)(pp + C_HC + c0);
                }
                bq[u] = *(const uint4*)(pr + C_BG + c0);
            }
#pragma unroll
            for (int u = 0; u < 4; ++u) {
                const size_t i = i0 + u * nth;
                if (i < (size_t)T * 32) {
                    const int t = (int)(i >> 5), c0 = (int)(i & 31) * 8, s = t & (S - 1);
                    float acc[8];
#pragma unroll
                    for (int e = 0; e < 8; ++e) acc[e] = 0.f;
#pragma unroll
                    for (int j = 0; j < 3; ++j) {
                        if (s - 2 + j >= 0) {
                            const uint4 g = gq[u][j], hc = hq[u][j];
                            const float4 w0 = *(const float4*)(cw + j * 256 + c0), w1 = *(const float4*)(cw + j * 256 + c0 + 4);
                            acc[0] = fmaf(w0.x, bflo(g.x) * bflo(hc.x), acc[0]); acc[1] = fmaf(w0.y, bfhi(g.x) * bfhi(hc.x), acc[1]);
                            acc[2] = fmaf(w0.z, bflo(g.y) * bflo(hc.y), acc[2]); acc[3] = fmaf(w0.w, bfhi(g.y) * bfhi(hc.y), acc[3]);
                            acc[4] = fmaf(w1.x, bflo(g.z) * bflo(hc.z), acc[4]); acc[5] = fmaf(w1.y, bfhi(g.z) * bfhi(hc.z), acc[5]);
                            acc[6] = fmaf(w1.z, bflo(g.w) * bflo(hc.w), acc[6]); acc[7] = fmaf(w1.w, bfhi(g.w) * bfhi(hc.w), acc[7]);
                        }
                    }
                    const uint4 bg = bq[u];
                    uint4 o;
                    o.x = pack2(bflo(bg.x) * acc[0], bfhi(bg.x) * acc[1]); o.y = pack2(bflo(bg.y) * acc[2], bfhi(bg.y) * acc[3]);
                    o.z = pack2(bflo(bg.z) * acc[4], bfhi(bg.z) * acc[5]); o.w = pack2(bflo(bg.w) * acc[6], bfhi(bg.w) * acc[7]);
                    *(uint4*)(Y + (size_t)t * LDX + c0) = o;
                }
            }
        }
    }
    {
        float (*pl)[68] = (float (*)[68])lds;
        const float* pw = P.pool_w + (size_t)l * 4 * 64 * 64;
        const float* psc = P.pool_scale + l * 256;
        const int a = tid & 63, q = tid >> 6;
        for (int tile = blockIdx.x; tile < (T / (16 * NW)) * 4; tile += gridDim.x) {
            const int g = tile & 3, t0 = (tile >> 2) * (16 * NW);
            const int w = 2 << g;
            {
                const bf16* col = proj + C_HP + g * 64 + a;
                const int tf = t0 + q * 16, sf = tf & (S - 1);
                float xr[31];
#pragma unroll
                for (int d = 1; d <= 15; ++d) xr[15 - d] = (d < w && sf - d >= 0) ? bf2f(col[(size_t)(tf - d) * DINP]) : 0.f;
#pragma unroll
                for (int i = 0; i < 16; ++i) xr[15 + i] = bf2f(col[(size_t)(tf + i) * DINP]);
                float sum = 0.f;
#pragma unroll
                for (int d = 1; d <= 15; ++d) sum += xr[15 - d];
#pragma unroll
                for (int i = 0; i < 16; ++i) {
                    const int s = sf + i;
                    sum += xr[15 + i];
                    const int cnt = (s + 1 < w) ? (s + 1) : w;
                    pl[q * 16 + i][a] = sum / (float)cnt - xr[15 + i];
                    const int o = 15 + i + 1;
                    const float old = (g == 0) ? xr[o - 2] : (g == 1) ? xr[o - 4] : (g == 2) ? xr[o - 8] : xr[o - 16];
                    sum -= old;
                }
            }
            __syncthreads();
            {
                float pc[64];
#pragma unroll
                for (int c = 0; c < 64; ++c) pc[c] = pw[(g * 64 + c) * 64 + a];
                const float sc = psc[g * 64 + a];
#pragma unroll 2
                for (int i = 0; i < 16; ++i) {
                    const float4* row = (const float4*)&pl[q * 16 + i][0];
                    float m0 = 0.f, m1 = 0.f;
#pragma unroll
                    for (int c4 = 0; c4 < 16; ++c4) { const float4 v = row[c4]; m0 = fmaf(v.x, pc[4 * c4], m0); m1 = fmaf(v.y, pc[4 * c4 + 1], m1); m0 = fmaf(v.z, pc[4 * c4 + 2], m0); m1 = fmaf(v.w, pc[4 * c4 + 3], m1); }
                    Y[(size_t)(t0 + q * 16 + i) * LDX + 256 + g * 64 + a] = f2bf((m0 + m1) * sc);
                }
            }
            __syncthreads();
        }
    }
}

typedef short v4i16_t __attribute__((ext_vector_type(4)));
typedef __attribute__((address_space(3))) v4i16_t* lds_v4p;
__device__ __forceinline__ v4i16_t vtr(const char* p) { return __builtin_amdgcn_ds_read_tr16_b64_v4i16((lds_v4p)p); }
constexpr int A_KP = 208, A_VP = 192;
constexpr int A_KB = 64 * A_KP, A_VB = 64 * A_VP, A_BUF = A_KB + A_VB, ATTN_LDS = 3 * A_BUF;
static_assert(ATTN_LDS <= LDS_TOTAL, "attention LDS");

__device__ __forceinline__ void attn_unit(const bf16* __restrict__ Qb, const bf16* __restrict__ Kb, const bf16* __restrict__ Vb, bf16* __restrict__ Y, int bh, int qblk, char* lds) {
    const int tid = tidx(), lane = tid & 63, w = tid >> 6, r32 = lane & 31, hi = lane >> 5;
    const int q0 = qblk * (64 * NW), qw0 = q0 + w * 64;
    const int NT = (q0 + 64 * NW) / 64;
    bf16x8 qfa[6], qfb[6];
    {
        const bf16* qp = Qb + ((size_t)bh * S + qw0 + r32) * DQK + hi * 8;
#pragma unroll
        for (int ks = 0; ks < 6; ++ks) { qfa[ks] = *(const bf16x8*)(qp + ks * 16); qfb[ks] = *(const bf16x8*)(qp + 32 * DQK + ks * 16); }
    }
    f32x16 oa0, oa1, ob0, ob1;
#pragma unroll
    for (int r = 0; r < 16; ++r) { oa0[r] = 0.f; oa1[r] = 0.f; ob0[r] = 0.f; ob1[r] = 0.f; }
    float ma = -1e30f, mb = -1e30f, lsa = 0.f, lsb = 0.f;
    const int t8 = tid & 255; const bool isv = tid >= 256;
    const char* Tg = isv ? (const char*)(Vb + (size_t)bh * S * DV) : (const char*)(Kb + (size_t)bh * S * DQK);
    const int Ts = isv ? (64 * 128) : (64 * 192);
    const int g0 = t8 * 16, g1 = (t8 + 256) * 16, g2 = isv ? g1 : (t8 + 512) * 16;
    const int l0 = isv ? (A_KB + (t8 >> 3) * A_VP + (t8 & 7) * 16) : ((t8 / 12) * A_KP + (t8 % 12) * 16);
    const int l1 = isv ? (l0 + 32 * A_VP) : (((t8 + 256) / 12) * A_KP + ((t8 + 256) % 12) * 16);
    const int l2 = isv ? l1 : (((t8 + 512) / 12) * A_KP + ((t8 + 512) % 12) * 16);
    uint4 pk0, pk1, pk2, qk0, qk1, qk2;
#define A_LOAD(S, t) do { const char* tg = Tg + (size_t)(t) * Ts; S##k0 = *(const uint4*)(tg + g0); S##k1 = *(const uint4*)(tg + g1); S##k2 = *(const uint4*)(tg + g2); } while (0)
#define A_STORE(S, bK, bV) do { *(uint4*)(bK + l0) = S##k0; *(uint4*)(bK + l1) = S##k1; *(uint4*)(bK + l2) = S##k2; } while (0)
#define A_PV2(pa, pb, kofs) do { \
            { const v4i16_t lo = vtr(pv + (kofs) * A_VP), hh = vtr(pv + ((kofs) + 8) * A_VP); const bf16x8 vf = {lo[0], lo[1], lo[2], lo[3], hh[0], hh[1], hh[2], hh[3]}; oa0 = MFMA32(vf, pa.v, oa0); ob0 = MFMA32(vf, pb.v, ob0); } \
            { const v4i16_t lo = vtr(pv + (kofs) * A_VP + 64), hh = vtr(pv + ((kofs) + 8) * A_VP + 64); const bf16x8 vf = {lo[0], lo[1], lo[2], lo[3], hh[0], hh[1], hh[2], hh[3]}; oa1 = MFMA32(vf, pa.v, oa1); ob1 = MFMA32(vf, pb.v, ob1); } } while (0)
#define A_SOFT(s0, s1, m, ls, o0, o1, P0, P1, P2, P3) do { \
            float mx = fmaxf(s0[0], s1[0]); \
            _Pragma("unroll") for (int r = 1; r < 16; ++r) mx = fmaxf(mx, fmaxf(s0[r], s1[r])); \
            mx = fmaxf(mx, __shfl_xor(mx, 32, 64)); \
            const float mn = fmaxf(m, mx), m_prev = m; \
            const float alpha = __builtin_amdgcn_exp2f(m - mn); \
            m = mn; \
            float ps = 0.f; \
            _Pragma("unroll") for (int r = 0; r < 16; ++r) { s0[r] = __builtin_amdgcn_exp2f(s0[r] - mn); s1[r] = __builtin_amdgcn_exp2f(s1[r] - mn); ps += s0[r] + s1[r]; } \
            if (__builtin_amdgcn_ballot_w64(mn > m_prev) != 0ull) {     \
                ls *= alpha; \
                _Pragma("unroll") for (int r = 0; r < 16; ++r) { o0[r] *= alpha; o1[r] *= alpha; } } \
            ls += ps; \
            _Pragma("unroll") for (int j = 0; j < 4; ++j) { P0.u[j] = cvtpk(s0[2 * j], s0[2 * j + 1]); P1.u[j] = cvtpk(s0[8 + 2 * j], s0[9 + 2 * j]); P2.u[j] = cvtpk(s1[2 * j], s1[2 * j + 1]); P3.u[j] = cvtpk(s1[8 + 2 * j], s1[9 + 2 * j]); } } while (0)
    const int pvo = (4 * hi + ((lane & 15) >> 2)) * A_VP + (16 * ((lane >> 4) & 1) + 4 * (lane & 3)) * 2;
    A_LOAD(p, 0); A_LOAD(q, 1);
    for (int t2 = 0; t2 < NT; t2 += 2) {
#pragma unroll
        for (int half = 0; half < 2; ++half) {
            const int t = t2 + half;
            char* bK = lds + half * A_BUF; char* bV = bK + A_KB;
            if (half == 0) A_STORE(p, bK, bV); else A_STORE(q, bK, bV);
            __syncthreads();
            { const int tn = (t + 2 < NT) ? (t + 2) : (NT - 2 + half); if (half == 0) A_LOAD(p, tn); else A_LOAD(q, tn); }
            const int kt0 = t * 64;
            if (kt0 <= qw0) {
                f32x16 sa0, sa1, sb0, sb1;
#pragma unroll
                for (int r = 0; r < 16; ++r) { sa0[r] = 0.f; sa1[r] = 0.f; sb0[r] = 0.f; sb1[r] = 0.f; }
                const char* pk = bK + r32 * A_KP + hi * 16;
#pragma unroll
                for (int ks = 0; ks < 6; ++ks) {
                    const bf16x8 a0 = *(const bf16x8*)(pk + ks * 32), a1 = *(const bf16x8*)(pk + 32 * A_KP + ks * 32);
                    sa0 = MFMA32(a0, qfa[ks], sa0); sa1 = MFMA32(a1, qfa[ks], sa1);
                    sb0 = MFMA32(a0, qfb[ks], sb0); sb1 = MFMA32(a1, qfb[ks], sb1);
                }
                if (kt0 == qw0) {
                    const int qrow = qw0 + r32;
#pragma unroll
                    for (int r = 0; r < 16; ++r) {
                        const int key = kt0 + crow(r, hi);
                        if (key > qrow) sa0[r] = -INFINITY; if (key + 32 > qrow) sa1[r] = -INFINITY;
                        if (key > qrow + 32) sb0[r] = -INFINITY; if (key > qrow) sb1[r] = -INFINITY;
                    }
                }
                union { unsigned u[4]; bf16x8 v; } pa0, pa1, pa2, pa3, pb0, pb1, pb2, pb3;
                A_SOFT(sa0, sa1, ma, lsa, oa0, oa1, pa0, pa1, pa2, pa3);
                A_SOFT(sb0, sb1, mb, lsb, ob0, ob1, pb0, pb1, pb2, pb3);
                const char* pv = bV + pvo;
                A_PV2(pa0, pb0, 0); A_PV2(pa1, pb1, 16); A_PV2(pa2, pb2, 32); A_PV2(pa3, pb3, 48);
            }
        }
    }
#undef A_LOAD
#undef A_STORE
#undef A_PV2
#undef A_SOFT
    lsa += __shfl_xor(lsa, 32, 64); lsb += __shfl_xor(lsb, 32, 64);
    const float inva = 1.f / lsa, invb = 1.f / lsb;
    const int b = bh >> 3, h = bh & 7;
    bf16* yo = Y + (size_t)(b * S + qw0 + r32) * LDX + 512 + h * 64 + 4 * hi;
#pragma unroll
    for (int g = 0; g < 4; ++g) {
        uint2 a, c;
        a.x = cvtpk(oa0[4 * g] * inva, oa0[4 * g + 1] * inva); a.y = cvtpk(oa0[4 * g + 2] * inva, oa0[4 * g + 3] * inva);
        c.x = cvtpk(oa1[4 * g] * inva, oa1[4 * g + 1] * inva); c.y = cvtpk(oa1[4 * g + 2] * inva, oa1[4 * g + 3] * inva);
        *(uint2*)(yo + 8 * g) = a; *(uint2*)(yo + 32 + 8 * g) = c;
        a.x = cvtpk(ob0[4 * g] * invb, ob0[4 * g + 1] * invb); a.y = cvtpk(ob0[4 * g + 2] * invb, ob0[4 * g + 3] * invb);
        c.x = cvtpk(ob1[4 * g] * invb, ob1[4 * g + 1] * invb); c.y = cvtpk(ob1[4 * g + 2] * invb, ob1[4 * g + 3] * invb);
        *(uint2*)(yo + (size_t)32 * LDX + 8 * g) = a; *(uint2*)(yo + (size_t)32 * LDX + 32 + 8 * g) = c;
    }
    __syncthreads();
}
__device__ __forceinline__ void phase_attn(const Params& P, char* lds) {
    const bf16* Qb = (const bf16*)(P.ws + WS_Q);
    const bf16* Kb = (const bf16*)(P.ws + WS_K);
    const bf16* Vb = (const bf16*)(P.ws + WS_V);
    bf16* Y = (bf16*)(P.ws + WS_XN);
    for (int u = blockIdx.x; u < NB * NH * (S / 512); u += gridDim.x) {
        const int bh = u & 31, v = u >> 5;
        const int qblk = (v < 8) ? (15 - v) : (v - 8);
        attn_unit(Qb, Kb, Vb, Y, bh, qblk, lds);
    }
}

#define NET_HD __device__ __forceinline__
#define NET_U2F(u) __uint_as_float(u)
#define NET_F2U(f) __float_as_uint(f)
#define CE_DESC(a, b) do { const float hi__ = fmaxf(a, b), lo__ = fminf(a, b); a = hi__; b = lo__; } while (0)
NET_HD void sort16_desc(float (&v)[16]) {
#define CE2(a, b) CE_DESC(v[a], v[b])
    CE2(0,13); CE2(1,12); CE2(2,15); CE2(3,14); CE2(4,8); CE2(5,6); CE2(7,11); CE2(9,10);
    CE2(0,5); CE2(1,7); CE2(2,9); CE2(3,4); CE2(6,13); CE2(8,14); CE2(10,15); CE2(11,12);
    CE2(0,1); CE2(2,3); CE2(4,5); CE2(6,8); CE2(7,9); CE2(10,11); CE2(12,13); CE2(14,15);
    CE2(0,2); CE2(1,3); CE2(4,10); CE2(5,11); CE2(6,7); CE2(8,9); CE2(12,14); CE2(13,15);
    CE2(1,2); CE2(3,12); CE2(4,6); CE2(5,7); CE2(8,10); CE2(9,11); CE2(13,14);
    CE2(1,4); CE2(2,6); CE2(5,8); CE2(7,10); CE2(9,13); CE2(11,14);
    CE2(2,4); CE2(3,6); CE2(9,12); CE2(11,13);
    CE2(3,5); CE2(6,8); CE2(7,9); CE2(10,12);
    CE2(3,4); CE2(5,6); CE2(7,8); CE2(9,10); CE2(11,12);
    CE2(6,7); CE2(8,9);
#undef CE2
}
NET_HD void merge16_desc(float (&a)[16], const float (&b)[16]) {
#pragma unroll
    for (int i = 0; i < 16; ++i) a[i] = fmaxf(a[i], b[15 - i]);
#pragma unroll
    for (int j = 8; j > 0; j >>= 1) {
#pragma unroll
        for (int i = 0; i < 16; ++i) { const int l = i ^ j; if (l > i) CE_DESC(a[i], a[l]); }
    }
}
NET_HD void top16_of_64(float (&g0)[16], float (&g1)[16], float (&g2)[16], float (&g3)[16]) {
    sort16_desc(g0); sort16_desc(g1); sort16_desc(g2); sort16_desc(g3);
    merge16_desc(g0, g1); merge16_desc(g2, g3); merge16_desc(g0, g2);
}
NET_HD float u2f(unsigned u) { return NET_U2F(u); }
NET_HD unsigned f2u(float f) { return NET_F2U(f); }
template <class V16>
NET_HD void lane_top16(const V16& s0, const V16& s1, const V16& s2, const V16& s3, int hi, float (&out)[16]) {
    float g0[16], g1[16], g2[16], g3[16];
#pragma unroll
    for (int r = 0; r < 16; ++r) {
        const unsigned nb = (unsigned)((r & 3) + 8 * (r >> 2));
        g0[r] = u2f((f2u(s0[r]) & 0xFFFFFF80u) | nb); g1[r] = u2f((f2u(s1[r]) & 0xFFFFFF80u) | (nb + 32u));
        g2[r] = u2f((f2u(s2[r]) & 0xFFFFFF80u) | (nb + 64u)); g3[r] = u2f((f2u(s3[r]) & 0xFFFFFF80u) | (nb + 96u));
    }
    top16_of_64(g0, g1, g2, g3);
    const unsigned h4 = (unsigned)hi << 2;
#pragma unroll
    for (int i = 0; i < 16; ++i) out[i] = u2f(f2u(g0[i]) | h4);
}
constexpr int cand_slot(int a, int b) { int n = 0; for (int x = 0; x < 16; ++x) for (int y = 0; y < 16; ++y) { if (x == a && y == b) return n; if ((x + 1) * (y + 1) <= 16) ++n; } return n; }
NET_HD void cand_top16(const float (&s1)[16], const float (&s2)[16], float (&c)[16]) {
    float g0[16], g1[16], g2[16], g3[16];
#pragma unroll
    for (int i = 0; i < 16; ++i) { g0[i] = -3.0e38f; g1[i] = -3.0e38f; g2[i] = -3.0e38f; g3[i] = -3.0e38f; }
#pragma unroll
    for (int a = 0; a < 16; ++a) {
#pragma unroll
        for (int b = 0; b < 16; ++b) {
            if ((a + 1) * (b + 1) <= 16) {
                const int sl = cand_slot(a, b);
                const float v = u2f((f2u(s1[a] + s2[b]) & 0xFFFFFF00u) | (unsigned)(a * 16 + b));
                if (sl < 16) g0[sl & 15] = v; else if (sl < 32) g1[sl & 15] = v; else if (sl < 48) g2[sl & 15] = v; else g3[sl & 15] = v;
            }
        }
    }
    top16_of_64(g0, g1, g2, g3);
#pragma unroll
    for (int i = 0; i < 16; ++i) c[i] = g0[i];
}

__device__ __forceinline__ void phase_route(const Params& P, int l, char* lds) {
    const bf16* XQb = (const bf16*)(P.ws + WS_XQ);
    const bf16* Wc = (const bf16*)(P.ws + WS_WC8 + (size_t)l * 2048 * XQP);
    const float* WcS = (const float*)(P.ws + WS_WCS) + (size_t)l * 2048;
    const float* XSc = (const float*)(P.ws + WS_XS);
    int* EXPp = (int*)(P.ws + WS_EXP);
    float* GATEp = (float*)(P.ws + WS_GATE);
    const int tid = tidx();
    float* xch = (float*)(lds + 16384);
    int tlo, thi, tst; tile_rounds((T / 256) * PH, tlo, thi, tst);
    int nt = D / 128; asm volatile("" : "+s"(nt));
    for (int u = tlo; u < thi; u += tst) {
        const int tm = u >> 3, h = u & 7;
        float Lk[16];
        {
            i32x4 acc[2][2][4][2]; float ssd[2][2];
            gemm8_kloop<false, true, i32x4>(Wc + (size_t)(h * 256) * (XQP / 2), XQP / 2, XQb + (size_t)(tm * 256) * (XQP / 2), XQP / 2, nt, acc, ssd, lds, tid);
            const int te = tidx(), fq = (te >> 4) & 3;
            const unsigned fqb = (unsigned)fq << 2;
            float4 ks[2][4];
            { const float* kp = WcS + h * 256 + ((te >> 8) & 1) * 128 + fq * 4;
#pragma unroll
              for (int ai = 0; ai < 2; ++ai)
#pragma unroll
                  for (int m = 0; m < 4; ++m) ks[ai][m] = *(const float4*)(kp + ai * 64 + m * 16); }
#pragma unroll
            for (int i = 0; i < 16; ++i) Lk[i] = 0.f;
#pragma unroll
            for (int bj = 0; bj < 2; ++bj)
#pragma unroll
                for (int n = 0; n < 2; ++n) {
                    float g0[16], g1[16];
#pragma unroll
                    for (int m = 0; m < 4; ++m)
#pragma unroll
                        for (int j = 0; j < 4; ++j) {
                            const unsigned kb = (unsigned)(m * 16 + j) | fqb;
                            const float k0 = (j == 0) ? ks[0][m].x : (j == 1) ? ks[0][m].y : (j == 2) ? ks[0][m].z : ks[0][m].w;
                            const float k1 = (j == 0) ? ks[1][m].x : (j == 1) ? ks[1][m].y : (j == 2) ? ks[1][m].z : ks[1][m].w;
                            g0[m * 4 + j] = u2f((f2u((float)acc[0][bj][m][n][j] * k0) & 0xFFFFFF80u) | kb);
                            g1[m * 4 + j] = u2f((f2u((float)acc[1][bj][m][n][j] * k1) & 0xFFFFFF80u) | (kb + 64u));
                        }
                    sort16_desc(g0); sort16_desc(g1); merge16_desc(g0, g1);
                    float o[16];
#pragma unroll
                    for (int i = 0; i < 16; ++i) o[i] = __shfl_xor(g0[i], 16, 64);
                    merge16_desc(g0, o);
#pragma unroll
                    for (int i = 0; i < 16; ++i) o[i] = __shfl_xor(g0[i], 32, 64);
                    merge16_desc(g0, o);
                    const bool mine = fq == bj * 2 + n;
#pragma unroll
                    for (int i = 0; i < 16; ++i) Lk[i] = mine ? g0[i] : Lk[i];
                }
        }
        __syncthreads();
        const int te = tidx(), lane = te & 63, w = te >> 6, wr = w >> 2, wc = w & 3, fr = lane & 15, fq = lane >> 4;
        if (wr == 1) {
#pragma unroll
            for (int q = 0; q < 4; ++q) *(float4*)(xch + ((wc * 64 + lane) * 16) + 4 * q) = make_float4(Lk[4 * q], Lk[4 * q + 1], Lk[4 * q + 2], Lk[4 * q + 3]);
        }
        __syncthreads();
        if (wr == 0) {
            float L1[16];
#pragma unroll
            for (int q = 0; q < 4; ++q) { const float4 v = *(const float4*)(xch + ((wc * 64 + lane) * 16) + 4 * q); L1[4 * q] = v.x; L1[4 * q + 1] = v.y; L1[4 * q + 2] = v.z; L1[4 * q + 3] = v.w; }
            float c[16];
            cand_top16(Lk, L1, c);
            unsigned char* my = (unsigned char*)lds + te * 32;
            {
                uint4 a, b;
#define PK4(L, i) ((__float_as_uint(L[i]) & 127u) | ((__float_as_uint(L[i + 1]) & 127u) << 8) | ((__float_as_uint(L[i + 2]) & 127u) << 16) | ((__float_as_uint(L[i + 3]) & 127u) << 24))
                a.x = PK4(Lk, 0); a.y = PK4(Lk, 4); a.z = PK4(Lk, 8); a.w = PK4(Lk, 12);
                b.x = PK4(L1, 0); b.y = PK4(L1, 4); b.z = PK4(L1, 8); b.w = PK4(L1, 12);
#undef PK4
                *(uint4*)my = a; *(uint4*)(my + 16) = b;
            }
            const int t = tm * 256 + (fq >> 1) * 128 + wc * 32 + (fq & 1) * 16 + fr;
            const float xs_t = XSc[t];
            int ev[16]; float gv[16]; float den = 0.f;
#pragma unroll
            for (int k = 0; k < 16; ++k) {
                const unsigned ci = __float_as_uint(c[k]) & 255u;
                const int n1 = my[ci >> 4], n2 = my[16 + (ci & 15)];
                ev[k] = n1 * NKEY + n2;
                gv[k] = __expf((c[k] - c[0]) * xs_t); den += gv[k];
            }
            const float iden = 1.f / den;
            uint4* ep = (uint4*)(EXPp + (size_t)t * HK + h * 16);
            float4* gp = (float4*)(GATEp + (size_t)t * HK + h * 16);
#pragma unroll
            for (int q = 0; q < 4; ++q) {
                ep[q] = make_uint4((unsigned)ev[4 * q], (unsigned)ev[4 * q + 1], (unsigned)ev[4 * q + 2], (unsigned)ev[4 * q + 3]);
                gp[q] = make_float4(gv[4 * q] * iden, gv[4 * q + 1] * iden, gv[4 * q + 2] * iden, gv[4 * q + 3] * iden);
            }
        }
        __syncthreads();
    }
}

constexpr size_t WS_PART = WS_PROJ;
static_assert((size_t)8 * T * HK * 4 <= WS_K - WS_PROJ, "PART alias");
constexpr int XI_X = 0, XI_RANK = 1, XI_J = 2, XI_NX = 3, XI_NLOC = 4;
constexpr int CTL_CENSUS = 4096;
constexpr int CTL_BYTES = (CTL_CENSUS + 16) * 4;

template <int M1, int M2, int M3, class TT>
__device__ __forceinline__ void red16x3(TT (&p)[16], int lane) {
#pragma unroll
    for (int i = 0; i < 8; ++i) { const bool up = lane & M1; const TT send = up ? p[i] : p[i + 8], keep = up ? p[i + 8] : p[i]; p[i] = keep + __shfl_xor(send, M1, 64); }
#pragma unroll
    for (int i = 0; i < 4; ++i) { const bool up = lane & M2; const TT send = up ? p[i] : p[i + 4], keep = up ? p[i + 4] : p[i]; p[i] = keep + __shfl_xor(send, M2, 64); }
#pragma unroll
    for (int i = 0; i < 2; ++i) { const bool up = lane & M3; const TT send = up ? p[i] : p[i + 2], keep = up ? p[i + 2] : p[i]; p[i] = keep + __shfl_xor(send, M3, 64); }
}
__device__ __forceinline__ void phase_gu(const Params& P, int l, const volatile int* xi) {
    const unsigned char* XQ = P.ws + WS_XQ;
    const float* XSc = (const float*)(P.ws + WS_XS);
    const int* EXPp = (const int*)(P.ws + WS_EXP);
    float* PART = (float*)(P.ws + WS_PART);
    const int tid = tidx(), lane = tid & 63, w = tid >> 6, g = lane >> 3, c = lane & 7;
    int xo_ = 0; asm volatile("" : "+v"(xo_));
    const int j = __builtin_amdgcn_readfirstlane(xi[xo_ + XI_J]), nx = __builtin_amdgcn_readfirstlane(xi[xo_ + XI_NX]), nloc = __builtin_amdgcn_readfirstlane(xi[xo_ + XI_NLOC]), rank = __builtin_amdgcn_readfirstlane(xi[xo_ + XI_RANK]);
    const int t0 = rank * NW + w, st = nloc * NW;
    const int n = (t0 < T) ? (T - t0 + st - 1) / st : 0;
    const int i0 = 8 * (c & 1) + 4 * ((c >> 1) & 1) + 2 * ((c >> 2) & 1);
    for (int sl = j; sl < 8 && n > 0; sl += nx) {
        const unsigned char* Us = P.ws + WS_TABU + ((size_t)(l * 8 + sl) * NEXP) * 128;
        const unsigned co = (unsigned)c << 4;
        float* part = PART + (size_t)sl * T * HK;
        const unsigned char* xs = XQ + sl * 128 + c * 16;
#define GU_TK(k) (t0 + (((k) < n) ? (k) : (n - 1)) * st)
#define GU_LOADE(S, t) do { S##lo = EXPp[(size_t)(t) * HK + lane]; S##hi = EXPp[(size_t)(t) * HK + 64 + lane]; } while (0)
#define GU_LOADX(S, t) do { S##a = *(const uint4*)(xs + (size_t)(t) * XQP); S##s = XSc[t]; } while (0)
#define GU_ISSUE(R, S) do { _Pragma("unroll") for (int i = 0; i < 16; ++i) { \
            const int e = __builtin_amdgcn_ds_bpermute((((8 * i) & 63) + g) << 2, (i < 8) ? S##lo : S##hi); R[i] = *(const uint4*)(Us + (((unsigned)e << 7) | co)); } } while (0)
#define GU_FINISH(R, S, t) do { \
            int p[16]; \
            _Pragma("unroll") for (int i = 0; i < 16; ++i) { int d_ = __builtin_amdgcn_sdot4((int)S##a.x, (int)R[i].x, 0, false); d_ = __builtin_amdgcn_sdot4((int)S##a.y, (int)R[i].y, d_, false); \
                d_ = __builtin_amdgcn_sdot4((int)S##a.z, (int)R[i].z, d_, false); p[i] = __builtin_amdgcn_sdot4((int)S##a.w, (int)R[i].w, d_, false); } \
            red16x3<1, 2, 4, int>(p, lane); \
            part[(size_t)(t) * HK + 8 * i0 + g] = (float)p[0] * S##s; part[(size_t)(t) * HK + 8 * (i0 + 1) + g] = (float)p[1] * S##s; } while (0)
        int eAlo, eAhi, eBlo, eBhi; uint4 xAa, xBa; float xAs, xBs; uint4 rA[16], rB[16];
        GU_LOADE(eA, GU_TK(0)); GU_LOADX(xA, GU_TK(0)); GU_LOADE(eB, GU_TK(1));
        GU_ISSUE(rA, eA);
        for (int k = 0; k < n; k += 2) {
            GU_LOADX(xB, GU_TK(k + 1)); GU_ISSUE(rB, eB); GU_LOADE(eA, GU_TK(k + 2));
            GU_FINISH(rA, xA, GU_TK(k));
            GU_LOADX(xA, GU_TK(k + 2)); GU_ISSUE(rA, eA); GU_LOADE(eB, GU_TK(k + 3));
            GU_FINISH(rB, xB, GU_TK(k + 1));
        }
#undef GU_TK
#undef GU_LOADE
#undef GU_LOADX
#undef GU_ISSUE
#undef GU_FINISH
    }
}
__device__ __forceinline__ void phase_gw(const Params& P, int l) {
    const int* EXPp = (const int*)(P.ws + WS_EXP);
    const float* GATEp = (const float*)(P.ws + WS_GATE);
    const float* PART = (const float*)(P.ws + WS_PART);
    const float* SU = (const float*)(P.ws + WS_TSCU) + (size_t)l * NEXP;
    const float* SV = (const float*)(P.ws + WS_TSCV) + (size_t)l * NEXP;
    unsigned char* WQ = P.ws + WS_WQ8;
    float* WSC = (float*)(P.ws + WS_WSC);
    const int lane = tidx() & 63;
    for (int tb = gwave() * 4; tb < T; tb += nwave() * 4) {
        float wv[4][2];
#pragma unroll
        for (int q = 0; q < 4; ++q)
#pragma unroll
            for (int hk = 0; hk < 2; ++hk) {
                const size_t i = (size_t)(tb + q) * HK + hk * 64 + lane;
                float s = 0.f;
#pragma unroll
                for (int x = 0; x < 8; ++x) s += PART[(size_t)x * T * HK + i];
                const int e = EXPp[i];
                wv[q][hk] = GATEp[i] * gelu_exact(s * SU[e]) * SV[e];
            }
#pragma unroll
        for (int q = 0; q < 4; ++q) {
            float am = fmaxf(fabsf(wv[q][0]), fabsf(wv[q][1]));
#pragma unroll
            for (int m = 32; m >= 1; m >>= 1) am = fmaxf(am, __shfl_xor(am, m, 64));
            const float sc = (am > 0.f) ? am * (1.f / 448.f) : 1.f, is = 1.f / sc;
            const int pk = __builtin_amdgcn_cvt_pk_fp8_f32(wv[q][0] * is, wv[q][1] * is, 0, false);
            WQ[(size_t)(tb + q) * HK + lane] = (unsigned char)(pk & 255);
            WQ[(size_t)(tb + q) * HK + 64 + lane] = (unsigned char)((pk >> 8) & 255);
            if (lane == 0) WSC[tb + q] = sc;
        }
    }
}
typedef int v2i_t __attribute__((ext_vector_type(2)));
typedef unsigned u32x4_t __attribute__((ext_vector_type(4)));
typedef __attribute__((ext_vector_type(4))) float f32x4;
constexpr int GV_PIECE = 1024 + 16;
constexpr int GV_TILE = 16 * GV_PIECE;
static_assert(NW * GV_TILE + NW * 512 <= LDS_TOTAL, "gv LDS");
__device__ __forceinline__ void phase_gv(const Params& P, int l, const volatile int* xi, char* lds) {
    const int* EXPp = (const int*)(P.ws + WS_EXP);
    const unsigned char* WQ = P.ws + WS_WQ8;
    const float* WSC = (const float*)(P.ws + WS_WSC);
    const int tid = tidx(), lane = tid & 63, w = __builtin_amdgcn_readfirstlane(tid >> 6), g = lane >> 3, pos = lane & 7;
    int xo_ = 0; asm volatile("" : "+v"(xo_));
    const int j = __builtin_amdgcn_readfirstlane(xi[xo_ + XI_J]), nx = __builtin_amdgcn_readfirstlane(xi[xo_ + XI_NX]), nloc = __builtin_amdgcn_readfirstlane(xi[xo_ + XI_NLOC]), rank = __builtin_amdgcn_readfirstlane(xi[xo_ + XI_RANK]);
    const int t0 = rank * NW + w, st = nloc * NW;
    const int n = (t0 < T) ? (T - t0 + st - 1) / st : 0;
    char* tile = lds + w * GV_TILE;
    float* strip = (float*)(lds + NW * GV_TILE) + w * 128;
    typedef __attribute__((address_space(3))) v2i_t* ldsv2_t;
    const unsigned co = (unsigned)(pos ^ g) << 4;
    const int rr = (lane & 15) >> 1, kq = lane >> 4;
    const int rdo = kq * GV_PIECE + rr * 128 + (lane & 1) * 8;
    const bool row0 = (lane & 15) == 0;
    __syncthreads();
    for (int sl = j; sl < 8 && n > 0; sl += nx) {
        const unsigned char* Vs = P.ws + WS_TABV + ((size_t)(l * 8 + sl) * NEXP) * 128;
        const char* hrow = (const char*)P.out + sl * 256 + 4 * lane;
#define GV_TK(k) (t0 + (((k) < n) ? (k) : (n - 1)) * st)
#define GV_LOADE(S, t) do { S##el = EXPp[(size_t)(t) * HK + lane]; S##eh = EXPp[(size_t)(t) * HK + 64 + lane]; } while (0)
#define GV_ISSUE(R, S) do { _Pragma("unroll") for (int i = 0; i < 16; ++i) { \
            const int e = __builtin_amdgcn_ds_bpermute((((8 * i) & 63) + g) << 2, (i < 8) ? S##el : S##eh); R[i] = *(const u32x4_t*)(Vs + (((unsigned)e << 7) | co)); } } while (0)
#define GV_LOADT(S, kk) do { const int t_ = GV_TK(kk); \
            S##a0 = 0; S##a1 = 0; S##a2 = 0; S##a3 = 0; \
            if (row0) { const long* wp = (const long*)(WQ + (size_t)t_ * HK + kq * 8); S##a0 = wp[0]; S##a1 = wp[4]; S##a2 = wp[8]; S##a3 = wp[12]; } \
            S##ws = ((kk) < n) ? WSC[t_] : 0.f; \
            S##hv = *(const unsigned*)(hrow + (size_t)t_ * (HP * 2)); } while (0)
#define GV_TOKEN(R, S, kk) do { \
            const int t = GV_TK(kk); \
            _Pragma("unroll") for (int i = 0; i < 16; ++i) *(u32x4_t*)(tile + i * GV_PIECE + lane * 16) = R[i]; \
            f32x4 acc[8]; \
            _Pragma("unroll") for (int nt = 0; nt < 8; ++nt) acc[nt] = (f32x4){0.f, 0.f, 0.f, 0.f}; \
            _Pragma("unroll") for (int s4 = 0; s4 < 4; ++s4) { \
                const long av = (s4 == 0) ? S##a0 : (s4 == 1) ? S##a1 : (s4 == 2) ? S##a2 : S##a3; \
                _Pragma("unroll") for (int nt = 0; nt < 8; ++nt) { \
                    const v2i_t bv = __builtin_amdgcn_ds_read_tr8_b64_v2i32((ldsv2_t)(void*)(tile + (4 * s4) * GV_PIECE + rdo + ((nt ^ rr) << 4))); \
                    acc[nt] = __builtin_amdgcn_mfma_f32_16x16x32_fp8_fp8(av, __builtin_bit_cast(long, bv), acc[nt], 0, 0, 0); } } \
            if (lane < 16) { _Pragma("unroll") for (int nt = 0; nt < 8; ++nt) strip[16 * nt + lane] = acc[nt][0]; }        \
            { const float2 o2 = *(const float2*)(strip + 2 * lane); \
              if ((kk) < n) *(unsigned*)(hrow + (size_t)t * (HP * 2)) = pack2(bflo(S##hv) + S##ws * o2.x, bfhi(S##hv) + S##ws * o2.y); } } while (0)
        int Ael, Aeh, Bel, Beh; u32x4_t rA[16], rB[16];
        long Pa0, Pa1, Pa2, Pa3, Qa0, Qa1, Qa2, Qa3; float Pws, Qws; unsigned Phv, Qhv;
        GV_LOADE(A, GV_TK(0)); GV_LOADE(B, GV_TK(1));
        GV_ISSUE(rA, A); GV_LOADT(P, 0);
        for (int k = 0; k < n; k += 2) {
            GV_ISSUE(rB, B); GV_LOADE(A, GV_TK(k + 2)); GV_LOADT(Q, k + 1);
            GV_TOKEN(rA, P, k);
            GV_ISSUE(rA, A); GV_LOADE(B, GV_TK(k + 3)); GV_LOADT(P, k + 2);
            GV_TOKEN(rB, Q, k + 1);
        }
#undef GV_TK
#undef GV_LOADE
#undef GV_ISSUE
#undef GV_LOADT
#undef GV_TOKEN
    }
    __syncthreads();
}
__device__ __forceinline__ void phase_gnorm(const Params& P, int l) {
    const int lane = tidx() & 63, nw = nwave();
    unsigned* xq = (unsigned*)(P.ws + WS_XQ);
    float* xsc = (float*)(P.ws + WS_XS);
    const bf16* Hb = (const bf16*)P.out;
    const float4* g = (const float4*)((l == DEPTH - 1) ? P.norm_final : (P.norm_mix + (l + 1) * D));
    for (int t = gwave(); t < T; t += 2 * nw) {
        const int t2 = (t + nw < T) ? (t + nw) : t;
        float4 v[2][4];
#pragma unroll
        for (int q = 0; q < 4; ++q) {
            const uint2 a = ((const uint2*)(Hb + (size_t)t * HP))[q * 64 + lane], b = ((const uint2*)(Hb + (size_t)t2 * HP))[q * 64 + lane];
            v[0][q] = make_float4(bflo(a.x), bfhi(a.x), bflo(a.y), bfhi(a.y)); v[1][q] = make_float4(bflo(b.x), bfhi(b.x), bflo(b.y), bfhi(b.y));
        }
#pragma unroll
        for (int u = 0; u < 2; ++u) {
            float ss = 0.f;
#pragma unroll
            for (int q = 0; q < 4; ++q) ss += v[u][q].x * v[u][q].x + v[u][q].y * v[u][q].y + v[u][q].z * v[u][q].z + v[u][q].w * v[u][q].w;
            ss = wave_sum(ss);
            const float rn = rsqrtf(ss * (1.f / D) + EPS);
            const int tt = u ? t2 : t;
            if (u == 0 || t2 != t) {
                float4* hr = (float4*)(P.out + (size_t)tt * D);
                float am = 0.f;
#pragma unroll
                for (int q = 0; q < 4; ++q) {
                    const float4 gg = g[q * 64 + lane];
                    v[u][q] = make_float4(v[u][q].x * rn * gg.x, v[u][q].y * rn * gg.y, v[u][q].z * rn * gg.z, v[u][q].w * rn * gg.w);
                    am = fmaxf(am, fmaxf(fmaxf(fabsf(v[u][q].x), fabsf(v[u][q].y)), fmaxf(fabsf(v[u][q].z), fabsf(v[u][q].w))));
                    if (l == DEPTH - 1) hr[q * 64 + lane] = v[u][q];
                }
                if (l != DEPTH - 1) {
#pragma unroll
                    for (int m = 32; m >= 1; m >>= 1) am = fmaxf(am, __shfl_xor(am, m, 64));
                    const float sc = (am > 0.f) ? am * (1.f / 127.f) : 1.f, is = 1.f / sc;
#pragma unroll
                    for (int q = 0; q < 4; ++q) xq[(size_t)tt * (XQP / 4) + q * 64 + lane] = pack_i8x4(v[u][q].x * is, v[u][q].y * is, v[u][q].z * is, v[u][q].w * is);
                    if (lane == 0) xsc[tt] = sc;
                }
            }
        }
    }
}

#define XB_TMO      128
#define XB_XCNT(j)  (256  + 64 * (j))
#define XB_XSUB(j)  (1280 + 64 * (j))
#define XB_XGEN(j)  (2304 + 64 * (j))
#define XB_TOP      3328
#define XB_TOPGEN   3392
#define XCD_BAR_WORDS 3456
#define XB_SPIN_CAP (1u << 22)
#define LAS __attribute__((address_space(3)))
__device__ __forceinline__ unsigned xb_ld(unsigned* p)              { return __hip_atomic_load(p, __ATOMIC_RELAXED, __HIP_MEMORY_SCOPE_AGENT); }
__device__ __forceinline__ unsigned xb_add(unsigned* p, unsigned v) { return __hip_atomic_fetch_add(p, v, __ATOMIC_RELAXED, __HIP_MEMORY_SCOPE_AGENT); }
__device__ __forceinline__ unsigned xb_xcc_id() { return (unsigned)__builtin_amdgcn_s_getreg((3 << 11) | 20) & 0xFu; }
#define XB_SPIN(cond, bar) do { unsigned _sp = 0; while (cond) { __builtin_amdgcn_s_sleep(1); \
    if ((++_sp & 255u) == 0u) { if (xb_ld(&(bar)[XB_TMO])) break; if (_sp > XB_SPIN_CAP) { atomicAdd(&(bar)[XB_TMO], 1u); break; } } } } while (0)
struct XcdBarrier { unsigned* bar; unsigned x; volatile LAS unsigned* st; };
__device__ __forceinline__ XcdBarrier xcd_barrier_post(unsigned* bar, volatile LAS unsigned* st) {
    XcdBarrier b; b.bar = bar; b.x = xb_xcc_id(); b.st = st;
    if (__builtin_amdgcn_workitem_id_x() == 0) (void)xb_add(&bar[XB_XCNT(b.x)], 1u);
    return b;
}
__device__ __forceinline__ void xcd_barrier_complete(unsigned* bar, unsigned x, unsigned& nloc, unsigned& nx) {
    const unsigned G = gridDim.x * gridDim.y * gridDim.z;
    unsigned sum, cnt, mine, sp = 0u;
    for (;;) {
        sum = 0u; cnt = 0u; mine = 0u;
#pragma unroll
        for (unsigned j = 0; j < 16; ++j) { const unsigned c = xb_ld(&bar[XB_XCNT(j)]); sum += c; cnt += (c > 0u) ? 1u : 0u; mine = (j == x) ? c : mine; }
        if (sum == G) break;
        __builtin_amdgcn_s_sleep(1);
        if ((++sp & 255u) == 0u) { if (xb_ld(&bar[XB_TMO])) break; if (sp > XB_SPIN_CAP) { atomicAdd(&bar[XB_TMO], 1u); break; } }
    }
    nloc = mine > 0u ? mine : 1u; nx = cnt > 0u ? cnt : 1u;
}
__device__ __forceinline__ void xcd_barrier(const XcdBarrier& b) {
    asm volatile("s_waitcnt vmcnt(0)" ::: "memory");
    __syncthreads();
    if (__builtin_amdgcn_workitem_id_x() == 0) {
        unsigned* bar = b.bar;
        __builtin_amdgcn_s_waitcnt(0);
        unsigned nloc = b.st[0], nx = b.st[1];
        if (nloc == 0u) { xcd_barrier_complete(bar, b.x, nloc, nx); b.st[0] = nloc; b.st[1] = nx; }
        const unsigned old = xb_add(&bar[XB_XSUB(b.x)], 1u);
        const unsigned gen = old / nloc;
        if (old + 1u == (gen + 1u) * nloc) {
            __builtin_amdgcn_fence(__ATOMIC_RELEASE, "agent");
            asm volatile("s_waitcnt vmcnt(0)" ::: "memory");
            const unsigned og = xb_add(&bar[XB_TOP], 1u);
            const unsigned tg = og / nx;
            if (og + 1u == (tg + 1u) * nx) xb_add(&bar[XB_TOPGEN], 1u);
            else XB_SPIN(xb_ld(&bar[XB_TOPGEN]) == tg, bar);
            __builtin_amdgcn_fence(__ATOMIC_ACQUIRE, "agent");
            xb_add(&bar[XB_XGEN(b.x)], 1u);
            asm volatile("s_waitcnt vmcnt(0)" ::: "memory");
        } else {
            XB_SPIN(xb_ld(&bar[XB_XGEN(b.x)]) == gen, bar);
            __builtin_amdgcn_fence(__ATOMIC_ACQUIRE, "agent");
            asm volatile("s_waitcnt vmcnt(0)" ::: "memory");
        }
    }
    __syncthreads();
}

constexpr float QSCALE = 0.10206207261596575f * 1.4426950408889634f;

__device__ __forceinline__ void phase_gemm1(const Params& P, int l, char* lds) {
    unsigned char* ws = P.ws;
    const bf16* XN = (const bf16*)(ws + WS_XN);
    bf16* PROJ = (bf16*)(ws + WS_PROJ);
    bf16* Kb = (bf16*)(ws + WS_K);
    const float* rope = (const float*)(ws + WS_ROPE);
    const bf16* W = (const bf16*)(ws + WS_WIN) + (size_t)l * DINP * LDW;
    float* SSQ = (float*)(ws + WS_SSQ);
    const int lane = tidx() & 63;
    const bf16* W8 = (const bf16*)(ws + WS_WI8 + (size_t)l * DINP * XQP);
    const bf16* XQb = (const bf16*)(ws + WS_XQ);
    const float* XSc = (const float*)(ws + WS_XS);
    const float* WIS = (const float*)(ws + WS_WIS) + (size_t)l * DINP;
    int tlo, thi, tst; tile_rounds((T / 256) * (DINP / 256), tlo, thi, tst);
    gemm_t8<true, false, true>(W8, XQP / 2, DINP, XQb, XQP / 2, D / 2, tlo, thi, tst, [&](int t, int n, const float4& v, const float4&) {
        const int nb = __builtin_amdgcn_readfirstlane(n);
        if (nb < C_KR) {
            uint2 o; o.x = cvtpk(v.x, v.y); o.y = cvtpk(v.z, v.w);
            *(uint2*)(PROJ + (size_t)t * DINP + n) = o;
            if (nb >= C_CQ) {
                float q = v.x * v.x + v.y * v.y + v.z * v.z + v.w * v.w;
                q += __shfl_xor(q, 1, 64); q += __shfl_xor(q, 2, 64); q += __shfl_xor(q, 4, 64); q += __shfl_xor(q, 8, 64);
                if (n == nb) SSQ[(size_t)t * 16 + ((nb - C_CQ) >> 6)] = q;
            }
        } else if (nb == C_KR) {
            const float4 up = make_float4(__shfl(v.x, lane + 4, 64), __shfl(v.y, lane + 4, 64), __shfl(v.z, lane + 4, 64), __shfl(v.w, lane + 4, 64));
            const float4 dn = make_float4(__shfl(v.x, lane - 4, 64), __shfl(v.y, lane - 4, 64), __shfl(v.z, lane - 4, 64), __shfl(v.w, lane - 4, 64));
            const int d = n - C_KR;
            if (d < 32) {
                const int b = t / S, s = t % S;
                const bool first = d < 16;
                const int f = first ? d : (d - 16);
                const float4 cs0 = *(const float4*)(rope + ((size_t)s * 16 + f) * 2), cs1 = *(const float4*)(rope + ((size_t)s * 16 + f) * 2 + 4);
                float4 o;
                if (first) o = make_float4(v.x * cs0.x - up.x * cs0.y, v.y * cs0.z - up.y * cs0.w, v.z * cs1.x - up.z * cs1.y, v.w * cs1.z - up.w * cs1.w);
                else       o = make_float4(v.x * cs0.x + dn.x * cs0.y, v.y * cs0.z + dn.y * cs0.w, v.z * cs1.x + dn.z * cs1.y, v.w * cs1.z + dn.w * cs1.w);
                uint2 u; u.x = cvtpk(o.x, o.y); u.y = cvtpk(o.z, o.w);
#pragma unroll
                for (int h = 0; h < NH; ++h) *(uint2*)(Kb + ((size_t)(b * NH + h) * S + s) * DQK + 64 + d) = u;
            }
        }
    }, [&](int t) { return XSc[t]; }, [](int, int) { return make_float4(0.f, 0.f, 0.f, 0.f); }, [&](int n) { return *(const float4*)(WIS + n); }, lds);
}
__device__ __forceinline__ void phase_gemm2(const Params& P, int l, char* lds) {
    unsigned char* ws = P.ws;
    const bf16* PROJ = (const bf16*)(ws + WS_PROJ);
    const float* rope = (const float*)(ws + WS_ROPE);
    const float* SSQ = (const float*)(ws + WS_SSQ);
    const int G = gridDim.x, bid = blockIdx.x;
    const int vb = ((G & 7) == 0) ? ((bid & 7) * (G >> 3) + (bid >> 3)) : bid;
    int qlo, qhi, klo, khi;
    if ((G & 1) == 0) {
        const int Gh = G >> 1, pq = (384 + Gh - 1) / Gh, pk = (512 + Gh - 1) / Gh;
        if (vb < Gh) { qlo = vb * pq; qhi = qlo + pq; if (qhi > 384) qhi = 384; if (qlo > 384) qlo = 384; klo = 0; khi = 0; }
        else { klo = (vb - Gh) * pk; khi = klo + pk; if (khi > 512) khi = 512; if (klo > 512) klo = 512; qlo = 0; qhi = 0; }
    } else { tile_range(384, qlo, qhi); tile_range(512, klo, khi); }
    {
        const bf16* W = (const bf16*)(ws + WS_WUQ) + (size_t)l * 768 * QR;
        bf16* Qb = (bf16*)(ws + WS_Q);
        gemm_t8<true, false, false>(W, QR, 768, PROJ + C_CQ, DINP, QR, qlo, qhi, 1,
            [&](int t, int n, const float4& v, const float4&) {
                const int b = t / S, s = t % S, h = n / DQK, d = n % DQK;
                float4 o = v;
                const int lane = tidx() & 63;
                const float4 up = make_float4(__shfl(v.x, lane + 4, 64), __shfl(v.y, lane + 4, 64), __shfl(v.z, lane + 4, 64), __shfl(v.w, lane + 4, 64));
                const float4 dn = make_float4(__shfl(v.x, lane - 4, 64), __shfl(v.y, lane - 4, 64), __shfl(v.z, lane - 4, 64), __shfl(v.w, lane - 4, 64));
                if (d >= 64) {
                    const bool first = d < 80;
                    const int f = first ? (d - 64) : (d - 80);
                    const float4 cs0 = *(const float4*)(rope + ((size_t)s * 16 + f) * 2), cs1 = *(const float4*)(rope + ((size_t)s * 16 + f) * 2 + 4);
                    if (first) o = make_float4(v.x * cs0.x - up.x * cs0.y, v.y * cs0.z - up.y * cs0.w, v.z * cs1.x - up.z * cs1.y, v.w * cs1.z - up.w * cs1.w);
                    else       o = make_float4(v.x * cs0.x + dn.x * cs0.y, v.y * cs0.z + dn.y * cs0.w, v.z * cs1.x + dn.z * cs1.y, v.w * cs1.z + dn.w * cs1.w);
                }
                uint2 u; u.x = cvtpk(o.x, o.y); u.y = cvtpk(o.z, o.w);
                *(uint2*)(Qb + ((size_t)(b * NH + h) * S + s) * DQK + d) = u;
            }, [&](int t) { const float4 a = *(const float4*)(SSQ + (size_t)t * 16); const float2 b = *(const float2*)(SSQ + (size_t)t * 16 + 4);
                            return rsqrtf(((a.x + a.y) + (a.z + a.w) + (b.x + b.y)) * (1.f / QR) + EPS) * QSCALE; }, [](int, int) { return make_float4(0.f, 0.f, 0.f, 0.f); }, [](int) { return make_float4(1.f, 1.f, 1.f, 1.f); }, lds);
    }
    {
        const bf16* W = (const bf16*)(ws + WS_WUKV) + (size_t)l * 1024 * KVR;
        bf16* Kb = (bf16*)(ws + WS_K); bf16* Vb = (bf16*)(ws + WS_V);
        gemm_t8<true, false, false>(W, KVR, 1024, PROJ + C_CKV, DINP, KVR, klo, khi, 1,
            [&](int t, int n, const float4& v, const float4&) {
                const int b = t / S, s = t % S;
                uint2 u; u.x = cvtpk(v.x, v.y); u.y = cvtpk(v.z, v.w);
                if (n < 512) *(uint2*)(Kb + ((size_t)(b * NH + (n >> 6)) * S + s) * DQK + (n & 63)) = u;
                else         *(uint2*)(Vb + ((size_t)(b * NH + ((n - 512) >> 6)) * S + s) * DV + (n & 63)) = u;
            }, [&](int t) { const float2 a = *(const float2*)(SSQ + (size_t)t * 16 + 6); const float2 b = *(const float2*)(SSQ + (size_t)t * 16 + 8);
                            return rsqrtf(((a.x + a.y) + (b.x + b.y)) * (1.f / KVR) + EPS); }, [](int, int) { return make_float4(0.f, 0.f, 0.f, 0.f); }, [](int) { return make_float4(1.f, 1.f, 1.f, 1.f); }, lds);
    }
}
constexpr size_t WS_YO = WS_PROJ;
__device__ __forceinline__ void phase_gemm3(const Params& P, int l, char* lds) {
    unsigned char* ws = P.ws;
    const bf16* Yb = (const bf16*)(ws + WS_XN);
    const bf16* W = (const bf16*)(ws + WS_WOUT) + (size_t)l * D * LDW;
    bf16* YO = (bf16*)(ws + WS_YO);
    int tlo, thi, tst; tile_rounds((T / 256) * (D / 256), tlo, thi, tst);
    gemm_t8<false, false, false>(W, LDW, D, Yb, LDX, D, tlo, thi, tst, [&](int t, int n, const float4& v, const float4&) {
        uint2 o; o.x = cvtpk(v.x, v.y); o.y = cvtpk(v.z, v.w);
        *(uint2*)(YO + (size_t)t * D + n) = o;
    }, [](int) { return 1.f; }, [](int, int) { return make_float4(0.f, 0.f, 0.f, 0.f); }, [](int) { return make_float4(1.f, 1.f, 1.f, 1.f); }, lds);
}

#define GSYNC() do { XcdBarrier xb_; { __attribute__((address_space(1))) char* gp_ = (__attribute__((address_space(1))) char*)(char*)(P.ws + WS_CTL); asm volatile("" : "+s"(gp_)); xb_.bar = (unsigned*)(char*)gp_; } \
    xb_.x = xb_xcc_id(); xb_.st = (volatile LAS unsigned*)&xb_words; xcd_barrier(xb_); } while (0)
#define PHASE(stmt) { const Params Q = launder(P); stmt; }
__global__ void __launch_bounds__(NTHREADS, 2) k_all(Params P) {
    __shared__ __attribute__((aligned(16))) char sm[LDS_TOTAL];
    __shared__ uint4 xb_words;
    cg::grid_group grid = cg::this_grid();
    if (__builtin_amdgcn_workitem_id_x() == 0) xb_words = make_uint4(0u, 0u, 0u, 0u);
    __syncthreads();
    (void)xcd_barrier_post((unsigned*)(P.ws + WS_CTL), (volatile LAS unsigned*)&xb_words);
    __shared__ int xinfo[8];
    if (__builtin_amdgcn_workitem_id_x() == 0) {
        const unsigned x = xb_xcc_id();
        xinfo[XI_X] = (int)x; xinfo[XI_RANK] = (int)xb_add((unsigned*)(P.ws + WS_CTL) + CTL_CENSUS + x, 1u);
    }
    PHASE(phase_prep(Q, sm));
    if (P.ws == nullptr) grid.sync();
    GSYNC();
    PHASE(phase_norm(Q.x, Q.norm_mix, (unsigned*)(Q.ws + WS_XQ), (float*)(Q.ws + WS_XS)));
    PHASE(quant_wrows((const bf16*)(Q.ws + WS_WPQ), DEPTH * 2048, Q.ws + WS_WC8, (float*)(Q.ws + WS_WCS)));
    PHASE(quant_wrows((const bf16*)(Q.ws + WS_WIN), DEPTH * DINP, Q.ws + WS_WI8, (float*)(Q.ws + WS_WIS)));
    GSYNC();
    if (__builtin_amdgcn_workitem_id_x() == 0) {
        unsigned* cen = (unsigned*)(P.ws + WS_CTL) + CTL_CENSUS;
        const int x = xinfo[XI_X]; int nx = 0, jj = 0;
        for (int q = 0; q < 16; ++q) { const unsigned cq = xb_ld(cen + q); if (cq) { if (q < x) ++jj; ++nx; } }
        xinfo[XI_J] = jj; xinfo[XI_NX] = nx; xinfo[XI_NLOC] = (int)xb_ld(cen + x);
    }
    __syncthreads();
    for (int l = 0; l < DEPTH; ++l) {
        PHASE(phase_gemm1(Q, l, sm));
#if PROBE_DUP & 2
        PHASE(phase_gemm1(Q, l, sm));
#endif
        GSYNC();
        PHASE(phase_mixlocal(Q, l, sm));
#if PROBE_DUP & 256
        PHASE(phase_mixlocal(Q, l, sm));
#endif
        PHASE(phase_gemm2(Q, l, sm));
#if PROBE_DUP & 4
        PHASE(phase_gemm2(Q, l, sm));
#endif
        GSYNC();
        PHASE(phase_attn(Q, sm));
#if PROBE_DUP & 8
        PHASE(phase_attn(Q, sm));
#endif
        GSYNC();
        PHASE(phase_gemm3(Q, l, sm));
#if PROBE_DUP & 16
        if (l == 0) PHASE(phase_gemm3(Q, l, sm));
#endif
        GSYNC();
        PHASE(phase_norm_q(Q, l));
#if PROBE_DUP & 512
        PHASE(phase_norm_q(Q, l));
#endif
        GSYNC();
        PHASE(phase_route(Q, l, sm));
#if PROBE_DUP & 32
        PHASE(phase_route(Q, l, sm));
#endif
        GSYNC();
        PHASE(phase_gu(Q, l, xinfo));
#if PROBE_DUP & 64
        PHASE(phase_gu(Q, l, xinfo));
#endif
        GSYNC();
        PHASE(phase_gw(Q, l));
#if PROBE_DUP & 128
        PHASE(phase_gw(Q, l));
#endif
        GSYNC();
        PHASE(phase_gv(Q, l, xinfo, sm));
        GSYNC();
        PHASE(phase_gnorm(Q, l));
        if (l + 1 < DEPTH) GSYNC();
    }
}

extern "C" void kernel_launch(void* const* d_in, const int* in_sizes, int n_in, void* d_out, int out_size, void* d_ws, size_t ws_size, hipStream_t stream) {
    static int grid = 0;
    if (grid == 0) {
        if (n_in != 18 || out_size != T * D || ws_size < WS_END) { fprintf(stderr, "kernel_launch: bad sizes n_in %d out %d ws %zu need %zu\n", n_in, out_size, ws_size, (size_t)WS_END); grid = -1; return; }
        int dev = 0, cus = 0, per_cu = 0;
        (void)hipGetDevice(&dev);
        (void)hipDeviceGetAttribute(&cus, hipDeviceAttributeMultiprocessorCount, dev);
        (void)hipOccupancyMaxActiveBlocksPerMultiprocessor(&per_cu, (const void*)k_all, NTHREADS, 0);
        if (per_cu > 1) per_cu = 1;
        if (per_cu < 1) { fprintf(stderr, "kernel_launch: occupancy query says %d\n", per_cu); grid = -1; return; }
        grid = cus * per_cu;
    }
    if (grid < 0) return;
    Params p{};
    p.x = (const float*)d_in[0]; p.norm_mix = (const float*)d_in[1]; p.w_in = (const float*)d_in[2]; p.conv_w = (const float*)d_in[3];
    p.pool_w = (const float*)d_in[4]; p.pool_scale = (const float*)d_in[5]; p.q_norm = (const float*)d_in[6]; p.w_uq = (const float*)d_in[7];
    p.kv_norm = (const float*)d_in[8]; p.w_uk = (const float*)d_in[9]; p.w_uv = (const float*)d_in[10]; p.w_out = (const float*)d_in[11];
    p.norm_ffn = (const float*)d_in[12]; p.peer_wq = (const float*)d_in[13]; p.peer_subkeys = (const float*)d_in[14]; p.peer_u = (const float*)d_in[15];
    p.peer_v = (const float*)d_in[16]; p.norm_final = (const float*)d_in[17];
    p.out = (float*)d_out; p.ws = (unsigned char*)d_ws;
    if (hipMemsetAsync((char*)d_ws + WS_CTL, 0, CTL_BYTES, stream) != hipSuccess) { fprintf(stderr, "kernel_launch: memset failed\n"); return; }
    void* args[] = {&p};
    hipError_t e = hipLaunchCooperativeKernel((const void*)k_all, dim3(grid), dim3(NTHREADS), args, 0, stream);
    if (e != hipSuccess) fprintf(stderr, "cooperative launch failed: %s (grid %d)\n", hipGetErrorString(e), grid);
}
```

```cpp
#include <hip/hip_runtime.h>
#include <type_traits>
#include <hip/hip_cooperative_groups.h>
#include <cstdio>
#include <cstdint>
namespace cg = cooperative_groups;

#ifndef TAB_FP8
#define TAB_FP8 1
#endif
#ifndef PROBE_DUP
#define PROBE_DUP 0
#endif

constexpr int NB = 4, S = 8192, T = NB * S, D = 1024, DEPTH = 2;
constexpr int DIN = 1696, DINP = 1792;
constexpr int C_BG = 0, C_CG = 256, C_HC = 512, C_HP = 768, C_CQ = 1024, C_CKV = 1408, C_KR = 1664;
constexpr int QR = 384, KVR = 256, NH = 8, DQK = 96, DV = 64;
constexpr int PH = 8, NKEY = 128, NEXP = NKEY * NKEY, TOPK = 16, HK = PH * TOPK;
constexpr float EPS = 1e-6f;
constexpr int LDX = 1088;
constexpr int LDW = 1088;

typedef unsigned short bf16;
constexpr int HP = 2 * D;

constexpr size_t WS_CTL   = 0;
constexpr size_t WS_ROPE  = 64 * 1024;
constexpr size_t WS_WIN   = WS_ROPE + (size_t)S * 16 * 2 * 4;
constexpr size_t WS_WUQ   = WS_WIN + (size_t)DEPTH * DINP * LDW * 2;
constexpr size_t WS_WUKV  = WS_WUQ + (size_t)DEPTH * 768 * QR * 2;
constexpr size_t WS_WOUT  = WS_WUKV + (size_t)DEPTH * 1024 * KVR * 2;
constexpr size_t WS_WPQ   = WS_WOUT + (size_t)DEPTH * D * LDW * 2;
constexpr size_t WS_XN    = ((WS_WPQ + (size_t)DEPTH * 2048 * LDW * 2 + 4095) / 4096) * 4096;
constexpr size_t WS_PROJ  = WS_XN + (size_t)T * LDX * 2;
constexpr size_t WS_Q     = WS_PROJ + (size_t)T * DINP * 2;
constexpr size_t WS_K     = WS_Q + (size_t)T * NH * DQK * 2;
constexpr size_t WS_V     = WS_K + (size_t)T * NH * DQK * 2;
constexpr size_t WS_EXP   = WS_V + (size_t)T * NH * DV * 2;
constexpr size_t WS_GATE  = WS_EXP + (size_t)T * HK * 4;
constexpr size_t TAB_ROWB = TAB_FP8 ? 1024 : 2048;
constexpr size_t WS_TABU  = WS_GATE + (size_t)T * HK * 4;
constexpr size_t WS_TABV  = WS_TABU + (size_t)DEPTH * NEXP * TAB_ROWB;
constexpr size_t WS_TSCU  = WS_TABV + (size_t)DEPTH * NEXP * TAB_ROWB;
constexpr size_t WS_TSCV  = WS_TSCU + (size_t)DEPTH * NEXP * 4;
constexpr size_t WS_XQ    = WS_TSCV + (size_t)DEPTH * NEXP * 4;
constexpr int XQP = 1088;
constexpr size_t WS_XS    = WS_XQ + (size_t)T * XQP;
constexpr size_t WS_WQ8   = WS_XS + (size_t)T * 4;
constexpr size_t WS_WSC   = WS_WQ8 + (size_t)T * HK;
constexpr size_t WS_SSQ   = WS_WSC + (size_t)T * 4;
constexpr size_t WS_WC8   = WS_SSQ + (size_t)T * 64;
constexpr size_t WS_WCS   = WS_WC8 + (size_t)DEPTH * 2048 * XQP;
constexpr size_t WS_WI8   = WS_WCS + (size_t)DEPTH * 2048 * 4;
constexpr size_t WS_WIS   = WS_WI8 + (size_t)DEPTH * DINP * XQP;
constexpr size_t WS_END   = WS_WIS + (size_t)DEPTH * DINP * 4;
static_assert(WS_END <= (size_t)512 * 1024 * 1024, "workspace budget");

struct Params {
    const float* x; const float* norm_mix; const float* w_in; const float* conv_w; const float* pool_w; const float* pool_scale;
    const float* q_norm; const float* w_uq; const float* kv_norm; const float* w_uk; const float* w_uv; const float* w_out;
    const float* norm_ffn; const float* peer_wq; const float* peer_subkeys; const float* peer_u; const float* peer_v; const float* norm_final;
    float* out; unsigned char* ws;
};

__device__ __forceinline__ bf16 f2bf(float f) { unsigned u = __float_as_uint(f); u += 0x7fffu + ((u >> 16) & 1u); return (bf16)(u >> 16); }
__device__ __forceinline__ float bf2f(bf16 h) { return __uint_as_float(((unsigned)h) << 16); }
__device__ __forceinline__ float bflo(unsigned u) { return __uint_as_float(u << 16); }
__device__ __forceinline__ float bfhi(unsigned u) { return __uint_as_float(u & 0xffff0000u); }
__device__ __forceinline__ unsigned pack2(float a, float b) { return (unsigned)f2bf(a) | ((unsigned)f2bf(b) << 16); }
__device__ __forceinline__ float wave_sum(float v) {
#pragma unroll
    for (int m = 32; m >= 1; m >>= 1) v += __shfl_xor(v, m, 64);
    return v;
}
__device__ __forceinline__ float gelu_exact(float x) { return 0.5f * x * (1.f + erff(x * 0.70710678118654752f)); }

#define NTHREADS 512
constexpr int NW = NTHREADS / 64;
__device__ __forceinline__ int tidx() { int t = (int)__builtin_amdgcn_workitem_id_x(); asm volatile("" : "+v"(t)); return t; }
__device__ __forceinline__ int gwave() { return blockIdx.x * (NTHREADS / 64) + (tidx() >> 6); }
__device__ __forceinline__ int nwave() { return gridDim.x * (NTHREADS / 64); }
__device__ __forceinline__ size_t gtid() { return (size_t)blockIdx.x * NTHREADS + tidx(); }
__device__ __forceinline__ size_t gnth() { return (size_t)gridDim.x * NTHREADS; }


__device__ __forceinline__ Params launder(const Params& P) {
    typedef __attribute__((address_space(1))) char* gp_t;
    gp_t g[20] = {(gp_t)(char*)P.x, (gp_t)(char*)P.norm_mix, (gp_t)(char*)P.w_in, (gp_t)(char*)P.conv_w, (gp_t)(char*)P.pool_w, (gp_t)(char*)P.pool_scale, (gp_t)(char*)P.q_norm, (gp_t)(char*)P.w_uq,
                  (gp_t)(char*)P.kv_norm, (gp_t)(char*)P.w_uk, (gp_t)(char*)P.w_uv, (gp_t)(char*)P.w_out, (gp_t)(char*)P.norm_ffn, (gp_t)(char*)P.peer_wq, (gp_t)(char*)P.peer_subkeys,
                  (gp_t)(char*)P.peer_u, (gp_t)(char*)P.peer_v, (gp_t)(char*)P.norm_final, (gp_t)(char*)P.out, (gp_t)(char*)P.ws};
    asm volatile("" : "+s"(g[0]), "+s"(g[1]), "+s"(g[2]), "+s"(g[3]), "+s"(g[4]), "+s"(g[5]), "+s"(g[6]), "+s"(g[7]), "+s"(g[8]), "+s"(g[9]));
    asm volatile("" : "+s"(g[10]), "+s"(g[11]), "+s"(g[12]), "+s"(g[13]), "+s"(g[14]), "+s"(g[15]), "+s"(g[16]), "+s"(g[17]), "+s"(g[18]), "+s"(g[19]));
    Params Q;
    Q.x = (const float*)(char*)g[0]; Q.norm_mix = (const float*)(char*)g[1]; Q.w_in = (const float*)(char*)g[2]; Q.conv_w = (const float*)(char*)g[3]; Q.pool_w = (const float*)(char*)g[4];
    Q.pool_scale = (const float*)(char*)g[5]; Q.q_norm = (const float*)(char*)g[6]; Q.w_uq = (const float*)(char*)g[7]; Q.kv_norm = (const float*)(char*)g[8]; Q.w_uk = (const float*)(char*)g[9];
    Q.w_uv = (const float*)(char*)g[10]; Q.w_out = (const float*)(char*)g[11]; Q.norm_ffn = (const float*)(char*)g[12]; Q.peer_wq = (const float*)(char*)g[13]; Q.peer_subkeys = (const float*)(char*)g[14];
    Q.peer_u = (const float*)(char*)g[15]; Q.peer_v = (const float*)(char*)g[16]; Q.norm_final = (const float*)(char*)g[17]; Q.out = (float*)(char*)g[18]; Q.ws = (unsigned char*)(char*)g[19];
    return Q;
}

typedef __attribute__((ext_vector_type(8))) short bf16x8;
typedef __attribute__((ext_vector_type(16))) float f32x16;
typedef __attribute__((ext_vector_type(2))) __bf16 bf2_t;
#define MFMA32(a, b, c) __builtin_amdgcn_mfma_f32_32x32x16_bf16(a, b, c, 0, 0, 0)
__device__ __forceinline__ int crow(int r, int hi) { return (r & 3) + 8 * (r >> 2) + 4 * hi; }
__device__ __forceinline__ float dot2bf(unsigned a, unsigned b, float c) { return __builtin_amdgcn_fdot2_f32_bf16(__builtin_bit_cast(bf2_t, a), __builtin_bit_cast(bf2_t, b), c, false); }
__device__ __forceinline__ unsigned cvtpk(float lo, float hi) { unsigned r; asm("v_cvt_pk_bf16_f32 %0, %1, %2" : "=v"(r) : "v"(lo), "v"(hi)); return r; }
constexpr int LDS_TOTAL = 140 * 1024;

template <int WT, bool ROWSS>
__device__ __forceinline__ void gemm_kloop(const bf16* __restrict__ Ag0, int lda, const bf16* __restrict__ Bg0, int ldb, int nk, f32x16 (&acc)[8], float (&ss)[4], char* lds, int tid) {
    constexpr int BROWS = (WT == 0) ? 256 : 128, NPB = BROWS / 64;
    constexpr int OPA = 256 * 128, G_BUF = OPA + BROWS * 128;
    const int lane = tid & 63, w = __builtin_amdgcn_readfirstlane(tid >> 6), r32 = lane & 31, hi = lane >> 5;
    const int srow = 8 * w + (lane >> 3);
    const int sch = (lane & 7) ^ ((srow >> 1) & 7);
    const bf16* Ag = Ag0 + (size_t)srow * lda + sch * 8;
    const bf16* Bg = Bg0 + (size_t)srow * ldb + sch * 8;
#pragma unroll
    for (int i = 0; i < 8; ++i)
#pragma unroll
        for (int r = 0; r < 16; ++r) acc[i][r] = 0.f;
    ss[0] = 0.f; ss[1] = 0.f; ss[2] = 0.f; ss[3] = 0.f;
    typedef __attribute__((address_space(3))) unsigned* ldsp_t;
    typedef const __attribute__((address_space(1))) unsigned* glbp_t;
#define G_DMA(buf, kofs) do { char* d_ = lds + (buf) * G_BUF + (8 * w) * 128; \
    _Pragma("unroll") for (int i = 0; i < 4; ++i) \
        __builtin_amdgcn_global_load_lds((glbp_t)(const void*)(Ag + (size_t)(64 * i) * lda + (kofs)), (ldsp_t)(void*)(d_ + i * 8192), 16, 0, 0); \
    _Pragma("unroll") for (int i = 0; i < NPB; ++i) \
        __builtin_amdgcn_global_load_lds((glbp_t)(const void*)(Bg + (size_t)(64 * i) * ldb + (kofs)), (ldsp_t)(void*)(d_ + OPA + i * 8192), 16, 0, 0); } while (0)
    const int xr = (r32 >> 1) & 7;
    const int o0 = ((0 + hi) ^ xr) << 4, o1 = ((2 + hi) ^ xr) << 4, o2 = ((4 + hi) ^ xr) << 4, o3 = ((6 + hi) ^ xr) << 4;
#define G_SS(s_, r_) do { union { bf16x8 v; uint4 u; } c_; c_.v = r_; s_ = dot2bf(c_.u.x, c_.u.x, s_); s_ = dot2bf(c_.u.y, c_.u.y, s_); s_ = dot2bf(c_.u.z, c_.u.z, s_); s_ = dot2bf(c_.u.w, c_.u.w, s_); } while (0)
#define G_STEP(pa, pb, off) do { \
    if (WT == 0) { \
        const bf16x8 a0 = *(const bf16x8*)(pa + off), a1 = *(const bf16x8*)(pa + 32 * 128 + off); \
        const bf16x8 b0 = *(const bf16x8*)(pb + off), b1 = *(const bf16x8*)(pb + 32 * 128 + off), b2 = *(const bf16x8*)(pb + 64 * 128 + off), b3 = *(const bf16x8*)(pb + 96 * 128 + off); \
        if (ROWSS) { G_SS(ss[0], b0); G_SS(ss[1], b1); G_SS(ss[2], b2); G_SS(ss[3], b3); } \
        acc[0] = MFMA32(a0, b0, acc[0]); acc[1] = MFMA32(a0, b1, acc[1]); acc[2] = MFMA32(a0, b2, acc[2]); acc[3] = MFMA32(a0, b3, acc[3]); \
        acc[4] = MFMA32(a1, b0, acc[4]); acc[5] = MFMA32(a1, b1, acc[5]); acc[6] = MFMA32(a1, b2, acc[6]); acc[7] = MFMA32(a1, b3, acc[7]); \
    } else if (WT == 2) { \
        const bf16x8 a0 = *(const bf16x8*)(pa + off), a1 = *(const bf16x8*)(pa + 32 * 128 + off); \
        const bf16x8 b0 = *(const bf16x8*)(pb + off), b1 = *(const bf16x8*)(pb + 32 * 128 + off); \
        if (ROWSS) { G_SS(ss[0], b0); G_SS(ss[1], b1); } \
        acc[0] = MFMA32(a0, b0, acc[0]); acc[1] = MFMA32(a0, b1, acc[1]); acc[2] = MFMA32(a1, b0, acc[2]); acc[3] = MFMA32(a1, b1, acc[3]); \
    } else { \
        const bf16x8 b0 = *(const bf16x8*)(pb + off); \
        const bf16x8 a0 = *(const bf16x8*)(pa + off), a1 = *(const bf16x8*)(pa + 32 * 128 + off); \
        const bf16x8 a2 = *(const bf16x8*)(pa + 64 * 128 + off), a3 = *(const bf16x8*)(pa + 96 * 128 + off); \
        if (ROWSS) { G_SS(ss[0], b0); } \
        acc[0] = MFMA32(a0, b0, acc[0]); acc[1] = MFMA32(a1, b0, acc[1]); \
        acc[2] = MFMA32(a2, b0, acc[2]); acc[3] = MFMA32(a3, b0, acc[3]); \
    } } while (0)
    const int arow = (WT == 1) ? ((w >> 2) * 128 + r32) : ((w >> 1) * 64 + r32);
    const int brow = (WT == 0) ? ((w & 1) * 128 + r32) : (WT == 2) ? ((w & 1) * 64 + r32) : ((w & 3) * 32 + r32);
    G_DMA(0, 0);
    for (int kt = 0; kt < nk; ++kt) {
        __syncthreads();
        if (kt + 1 < nk) G_DMA((kt + 1) & 1, (kt + 1) * 64);
        const char* pa = lds + (kt & 1) * G_BUF + arow * 128;
        const char* pb = lds + (kt & 1) * G_BUF + OPA + brow * 128;
        G_STEP(pa, pb, o0); G_STEP(pa, pb, o1); G_STEP(pa, pb, o2); G_STEP(pa, pb, o3);
    }
    if (ROWSS) { ss[0] += __shfl_xor(ss[0], 32, 64); ss[1] += __shfl_xor(ss[1], 32, 64); ss[2] += __shfl_xor(ss[2], 32, 64); ss[3] += __shfl_xor(ss[3], 32, 64); }
#undef G_DMA
#undef G_SS
#undef G_STEP
}

__device__ __forceinline__ void tile_range(int ntiles, int& lo, int& hi) {
    const int G = gridDim.x, b = blockIdx.x;
    const int vb = ((G & 7) == 0) ? ((b & 7) * (G >> 3) + (b >> 3)) : b;
    const int per = (ntiles + G - 1) / G;
    lo = vb * per; hi = lo + per; if (hi > ntiles) hi = ntiles;
}
constexpr int ST_P = 68;
static_assert(NW * 64 * ST_P * 4 <= LDS_TOTAL, "staging LDS");
template <bool ROWSS, class EPI, class EPIROW, class RSC>
__device__ __forceinline__ void gemm_t(const bf16* __restrict__ Wt, int ldw, int N, const bf16* __restrict__ X, int ldx, int M, int K, int tn_direct, EPI epi, EPIROW epirow, RSC rowscale, char* lds) {
    const int tid = tidx(), lane = tid & 63, w = tid >> 6, r32 = lane & 31, hi = lane >> 5;
    const int tilesN = N / 256, tilesM = M / 256, nk = K / 64;
    int tlo, thi; tile_range(tilesM * tilesN, tlo, thi);
    for (int tile = tlo; tile < thi; ++tile) {
        const int tm = tile / tilesN, tn = tile % tilesN;
        f32x16 acc[8]; float ss[4];
        gemm_kloop<0, ROWSS>(Wt + (size_t)(tn * 256) * ldw, ldw, X + (size_t)(tm * 256) * ldx, ldx, nk, acc, ss, lds, tid);
        if (tn < tn_direct) {
            __syncthreads();
            float* st = (float*)lds + w * (64 * ST_P);
            const int rr = lane >> 4, ch = lane & 15;
#pragma unroll
            for (int half = 0; half < 2; ++half) {
                const float m0_ = rowscale(ss[2 * half]), m1_ = rowscale(ss[2 * half + 1]);
#pragma unroll
                for (int i = 0; i < 2; ++i)
#pragma unroll
                    for (int jj = 0; jj < 2; ++jj)
#pragma unroll
                        for (int g = 0; g < 4; ++g) {
                            const float mj = jj ? m1_ : m0_;
                            const f32x16& a_ = acc[i * 4 + 2 * half + jj];
                            *(float4*)(st + (32 * jj + r32) * ST_P + 32 * i + 8 * g + 4 * hi) = make_float4(a_[4 * g] * mj, a_[4 * g + 1] * mj, a_[4 * g + 2] * mj, a_[4 * g + 3] * mj);
                        }
#pragma unroll 2
                for (int it = 0; it < 16; ++it) {
                    const int row = it * 4 + rr;
                    const float4 v = *(const float4*)(st + row * ST_P + ch * 4);
                    epirow(tm * 256 + (w & 1) * 128 + half * 64 + row, tn * 256 + (w >> 1) * 64 + ch * 4, v);
                }
            }
        } else {
#pragma unroll
            for (int i = 0; i < 2; ++i)
#pragma unroll
                for (int j = 0; j < 4; ++j)
                    epi(tn * 256 + (w >> 1) * 64 + i * 32, tm * 256 + (w & 1) * 128 + j * 32, acc[i * 4 + j], r32, hi, ss[j]);
        }
        __syncthreads();
    }
}

constexpr int ST1_P = 132;
static_assert(NW * 32 * ST1_P * 4 <= LDS_TOTAL, "staging LDS (128 x 32 wave tiles)");
template <class EPIROW, class RSC>
__device__ __forceinline__ void gemm_t1(const bf16* __restrict__ Wt, int ldw, int N, const bf16* __restrict__ X, int ldx, int M, int K, EPIROW epirow, RSC rowscale, char* lds) {
    const int tid = tidx(), lane = tid & 63, w = tid >> 6, r32 = lane & 31, hi = lane >> 5;
    const int tilesN = N / 256, tilesM = M / 128, nk = K / 64;
    int tlo, thi; tile_range(tilesM * tilesN, tlo, thi);
    for (int tile = tlo; tile < thi; ++tile) {
        const int tm = tile / tilesN, tn = tile % tilesN;
        f32x16 acc[8]; float ss[4];
        gemm_kloop<1, true>(Wt + (size_t)(tn * 256) * ldw, ldw, X + (size_t)(tm * 128) * ldx, ldx, nk, acc, ss, lds, tid);
        __syncthreads();
        float* st = (float*)lds + w * (32 * ST1_P);
        const float mj = rowscale(ss[0]);
#pragma unroll
        for (int mt = 0; mt < 4; ++mt)
#pragma unroll
            for (int g = 0; g < 4; ++g)
                *(float4*)(st + r32 * ST1_P + 32 * mt + 8 * g + 4 * hi) = make_float4(acc[mt][4 * g] * mj, acc[mt][4 * g + 1] * mj, acc[mt][4 * g + 2] * mj, acc[mt][4 * g + 3] * mj);
#pragma unroll 2
        for (int it = 0; it < 16; ++it) {
            const int row = it * 2 + hi;
            const float4 v = *(const float4*)(st + row * ST1_P + r32 * 4);
            epirow(tm * 128 + (w & 3) * 32 + row, tn * 256 + (w >> 2) * 128 + r32 * 4, v);
        }
        __syncthreads();
    }
}

template <class EPIROW>
__device__ __forceinline__ void gemm_t2(const bf16* __restrict__ Wt, int ldw, int N, const bf16* __restrict__ X, int ldx, int M, int K, EPIROW epirow, char* lds) {
    const int tid = tidx(), lane = tid & 63, w = tid >> 6, r32 = lane & 31, hi = lane >> 5;
    const int tilesN = N / 256, tilesM = M / 128, nk = K / 64;
    int tlo, thi; tile_range(tilesM * tilesN, tlo, thi);
    for (int tile = tlo; tile < thi; ++tile) {
        const int tm = tile / tilesN, tn = tile % tilesN;
        f32x16 acc[8]; float ss[4];
        gemm_kloop<2, false>(Wt + (size_t)(tn * 256) * ldw, ldw, X + (size_t)(tm * 128) * ldx, ldx, nk, acc, ss, lds, tid);
        __syncthreads();
        float* st = (float*)lds + w * (64 * ST_P);
#pragma unroll
        for (int i = 0; i < 2; ++i)
#pragma unroll
            for (int j = 0; j < 2; ++j)
#pragma unroll
                for (int g = 0; g < 4; ++g)
                    *(float4*)(st + (32 * j + r32) * ST_P + 32 * i + 8 * g + 4 * hi) = make_float4(acc[i * 2 + j][4 * g], acc[i * 2 + j][4 * g + 1], acc[i * 2 + j][4 * g + 2], acc[i * 2 + j][4 * g + 3]);
        const int rr = lane >> 4, ch = lane & 15;
#pragma unroll 4
        for (int it = 0; it < 16; ++it) {
            const int row = it * 4 + rr;
            const float4 v = *(const float4*)(st + row * ST_P + ch * 4);
            epirow(tm * 128 + (w & 1) * 64 + row, tn * 256 + (w >> 1) * 64 + ch * 4, v);
        }
        __syncthreads();
    }
}

typedef __attribute__((ext_vector_type(4))) float f32x4;
constexpr int G8_HT = 128 * 64;
__device__ __forceinline__ int g8_lds_byte(int r, int c) {
    const int st = (r >> 4) * 2 + (c >> 5), rr = r & 15, cc = c & 31, ob = rr * 64 + cc * 2;
    return st * 1024 + (ob ^ (((ob >> 9) & 1) << 5));
}
__device__ __forceinline__ void g8_stage_rc(int b, int& R, int& C) {
    const int st = b / 1024, sb = b % 1024, swz = sb ^ (((sb >> 9) & 1) << 5);
    R = (st >> 1) * 16 + swz / 64; C = (st & 1) * 32 + (swz % 64) / 2;
}
__device__ __forceinline__ float ssq8(const bf16x8& v, float s) {
    union { bf16x8 v; uint4 u; } c_; c_.v = v;
    s = dot2bf(c_.u.x, c_.u.x, s); s = dot2bf(c_.u.y, c_.u.y, s); s = dot2bf(c_.u.z, c_.u.z, s); return dot2bf(c_.u.w, c_.u.w, s);
}
typedef __attribute__((ext_vector_type(4))) int i32x4;
__device__ __forceinline__ f32x4 mma8(const bf16x8& a, const bf16x8& b, const f32x4& c) { return __builtin_amdgcn_mfma_f32_16x16x32_bf16(a, b, c, 0, 0, 0); }
__device__ __forceinline__ i32x4 mma8(const bf16x8& a, const bf16x8& b, const i32x4& c) { return __builtin_amdgcn_mfma_i32_16x16x64_i8(__builtin_bit_cast(i32x4, a), __builtin_bit_cast(i32x4, b), c, 0, 0, 0); }
template <bool ROWSS, bool APERM = false, class ACC = f32x4>
__device__ __forceinline__ void gemm8_kloop(const bf16* __restrict__ A, int lda, const bf16* __restrict__ Bt, int ldb, int nt, ACC (&acc)[2][2][4][2], float (&ss)[2][2], char* lds, int tid) {
    bf16* shm = (bf16*)lds;
    typedef __attribute__((address_space(3))) unsigned* ldsp_t;
    typedef const __attribute__((address_space(1))) unsigned* glbp_t;
#define SA(b, h) (shm + ((b) * 2 + (h)) * G8_HT)
#define SB(b, h) (shm + (4 + (b) * 2 + (h)) * G8_HT)
    int sr0, sc0; g8_stage_rc(tid * 16, sr0, sc0);
    const unsigned voa = (unsigned)((sr0 * lda + sc0) * 2), vob = (unsigned)((sr0 * ldb + sc0) * 2);
    const char* Ap = (const char*)A; const char* Bp = (const char*)Bt;
    const int wbase = __builtin_amdgcn_readfirstlane(tid >> 6) * 1024;
#define STAGE_(P, BASE, VO, LD, br, r2, kt) do { const char* g_ = BASE + ((size_t)(br) * LD + (kt) * 64) * 2; \
    __builtin_amdgcn_global_load_lds((glbp_t)(const void*)(g_ + VO), (ldsp_t)(void*)((char*)(P) + wbase), 16, 0, 0); \
    __builtin_amdgcn_global_load_lds((glbp_t)(const void*)(g_ + (size_t)(2 * (r2)) * LD + VO), (ldsp_t)(void*)((char*)(P) + wbase + 8192), 16, 0, 0); } while (0)
#define STAGEA(b, h, kt) STAGE_(SA(b, h), Ap, voa, lda, (APERM ? (h) * 64 : (h) * 128), (APERM ? 128 : 64), kt)
#define STAGEB(b, h, kt) STAGE_(SB(b, h), Bp, vob, ldb, (h) * 128, 64, kt)
    const int lane = tid & 63, wid = tid >> 6, wr = wid >> 2, wc = wid & 3, fr = lane & 15, fq = lane >> 4;
    int abase, bbase;
    { const int ob = fr * 64 + fq * 16, lp = ob ^ (((ob >> 9) & 1) << 5);
      abase = lp + wr * 8192; bbase = lp + wc * 4096 + 4 * G8_HT * 2;
      asm volatile("" : "+v"(abase), "+v"(bbase)); }
#define LDA(dst, b, h) _Pragma("unroll") for (int m = 0; m < 4; ++m) _Pragma("unroll") for (int k = 0; k < 2; ++k) \
    dst[m][k] = *reinterpret_cast<const bf16x8*>(lds + abase + (((b) * 2 + (h)) * G8_HT * 2 + m * 2048 + k * 1024))
#define LDB(dst, b, h) _Pragma("unroll") for (int n = 0; n < 2; ++n) _Pragma("unroll") for (int k = 0; k < 2; ++k) \
    dst[n][k] = *reinterpret_cast<const bf16x8*>(lds + bbase + (((b) * 2 + (h)) * G8_HT * 2 + n * 2048 + k * 1024))
#define MMA(ai, bj, At_, Bt_) do { __builtin_amdgcn_s_setprio(1); \
    _Pragma("unroll") for (int m = 0; m < 4; ++m) _Pragma("unroll") for (int n = 0; n < 2; ++n) _Pragma("unroll") for (int k = 0; k < 2; ++k) \
        acc[ai][bj][m][n] = mma8(At_[m][k], Bt_[n][k], acc[ai][bj][m][n]); \
    __builtin_amdgcn_s_setprio(0); } while (0)
#define SSQ(bj, Bt_) do { if (ROWSS) { _Pragma("unroll") for (int n = 0; n < 2; ++n) { ss[bj][n] = ssq8(Bt_[n][0], ss[bj][n]); ss[bj][n] = ssq8(Bt_[n][1], ss[bj][n]); } } } while (0)
#define WAIT_V(n) asm volatile("s_waitcnt vmcnt(" #n ")" ::: "memory")
#define WAIT_L(n) asm volatile("s_waitcnt lgkmcnt(" #n ")" ::: "memory")
#define BAR __builtin_amdgcn_s_barrier()
#define SCHED __builtin_amdgcn_sched_barrier(0)
#pragma unroll
    for (int a = 0; a < 2; ++a)
#pragma unroll
        for (int b = 0; b < 2; ++b)
#pragma unroll
            for (int m = 0; m < 4; ++m)
#pragma unroll
                for (int n = 0; n < 2; ++n) acc[a][b][m][n] = ACC{0, 0, 0, 0};
    ss[0][0] = 0.f; ss[0][1] = 0.f; ss[1][0] = 0.f; ss[1][1] = 0.f;
    bf16x8 At[4][2], B0[2][2], B1[2][2];
    STAGEB(0, 0, 0); STAGEA(0, 0, 0);
    STAGEB(0, 1, 0); STAGEA(0, 1, 0);
    if (wr == 1) BAR;
    WAIT_V(4); BAR;
    STAGEB(1, 0, 1); STAGEA(1, 0, 1); STAGEB(1, 1, 1);
    WAIT_V(6); BAR;
    for (int t = 0; t < nt - 2; t += 2) {
        LDB(B0, 0, 0); SCHED; LDA(At, 0, 0); STAGEA(1, 1, t + 1);
        WAIT_L(8); BAR; WAIT_L(0); MMA(0, 0, At, B0); SSQ(0, B0); BAR; SCHED;
        LDB(B1, 0, 1); STAGEB(0, 0, t + 2);
        BAR; WAIT_L(0); MMA(0, 1, At, B1); SSQ(1, B1); BAR;
        LDA(At, 0, 1); STAGEA(0, 0, t + 2);
        BAR; WAIT_L(0); MMA(1, 0, At, B0); BAR; SCHED;
        STAGEB(0, 1, t + 2);
        WAIT_V(6); BAR; MMA(1, 1, At, B1); BAR;
        LDB(B0, 1, 0); SCHED; LDA(At, 1, 0); STAGEA(0, 1, t + 2);
        WAIT_L(8); BAR; WAIT_L(0); MMA(0, 0, At, B0); SSQ(0, B0); BAR; SCHED;
        LDB(B1, 1, 1); STAGEB(1, 0, t + 3);
        BAR; WAIT_L(0); MMA(0, 1, At, B1); SSQ(1, B1); BAR;
        LDA(At, 1, 1); STAGEA(1, 0, t + 3);
        BAR; WAIT_L(0); MMA(1, 0, At, B0); BAR; SCHED;
        STAGEB(1, 1, t + 3);
        WAIT_V(6); BAR; MMA(1, 1, At, B1); BAR;
    }
    { LDB(B0, 0, 0); LDA(At, 0, 0); STAGEA(1, 1, nt - 1);
      BAR; WAIT_L(0); MMA(0, 0, At, B0); SSQ(0, B0); BAR;
      LDB(B1, 0, 1); BAR; WAIT_L(0); MMA(0, 1, At, B1); SSQ(1, B1); BAR;
      LDA(At, 0, 1); WAIT_V(4); BAR; WAIT_L(0); MMA(1, 0, At, B0); MMA(1, 1, At, B1); BAR; }
    { LDB(B0, 1, 0); LDA(At, 1, 0); WAIT_V(2); BAR; WAIT_L(0); MMA(0, 0, At, B0); SSQ(0, B0); BAR;
      LDB(B1, 1, 1); WAIT_V(0); BAR; WAIT_L(0); MMA(0, 1, At, B1); SSQ(1, B1); BAR;
      LDA(At, 1, 1); BAR; WAIT_L(0); MMA(1, 0, At, B0); MMA(1, 1, At, B1); BAR; }
    if (wr == 0) BAR;
    if (ROWSS) {
#pragma unroll
        for (int b = 0; b < 2; ++b)
#pragma unroll
            for (int n = 0; n < 2; ++n) { ss[b][n] += __shfl_xor(ss[b][n], 16, 64); ss[b][n] += __shfl_xor(ss[b][n], 32, 64); }
    }
#undef SSQ
#undef SA
#undef SB
#undef STAGE_
#undef STAGEA
#undef STAGEB
#undef LDA
#undef LDB
#undef MMA
#undef WAIT_V
#undef WAIT_L
#undef BAR
#undef SCHED
}
__device__ __forceinline__ void tile_rounds(int ntiles, int& lo, int& hi, int& step) {
    const int G = gridDim.x, b = blockIdx.x;
    if ((G & 7) == 0) { const int per = (ntiles + 7) >> 3, x = b & 7; lo = x * per + (b >> 3); hi = (x + 1) * per; if (hi > ntiles) hi = ntiles; step = G >> 3; }
    else { lo = b; hi = ntiles; step = G; }
}
template <bool SCALE, bool PRE, bool I8, class EPIROW, class RSC, class PREF, class CSC>
__device__ __forceinline__ void gemm_t8(const bf16* __restrict__ Wt, int ldw, int N, const bf16* __restrict__ X, int ldx, int K, int tlo, int thi, int tstep, EPIROW epirow, RSC rowscale, PREF pre, CSC colscale, char* lds) {
    typedef typename std::conditional<I8, i32x4, f32x4>::type ACC;
    const int tid = tidx();
    const int tilesN = N / 256; int nt = K / 64;
    asm volatile("" : "+s"(nt));
    for (int tile = tlo; tile < thi; tile += tstep) {
        const int tm = tile / tilesN, tn = tile % tilesN;
        ACC acc[2][2][4][2]; float ss[2][2];
        gemm8_kloop<false, false, ACC>(Wt + (size_t)(tn * 256) * ldw, ldw, X + (size_t)(tm * 256) * ldx, ldx, nt, acc, ss, lds, tid);
        __syncthreads();
        const int te = tidx();
        const int le = te & 63, w = te >> 6, wr = w >> 2, wc = w & 3, fr = le & 15, fq = le >> 4;
        float* st = (float*)lds + w * (32 * ST_P);
        const int rr = le >> 4, ch = le & 15;
        const int tb = tm * 256 + wc * 32 + rr, nb = tn * 256 + wr * 64 + ch * 4;
#pragma unroll
        for (int ai = 0; ai < 2; ++ai)
#pragma unroll
            for (int bj = 0; bj < 2; ++bj) {
                float4 pv[8];
                if (PRE) {
#pragma unroll
                    for (int it = 0; it < 8; ++it) pv[it] = pre(tb + bj * 128 + it * 4, nb + ai * 128);
                }
#pragma unroll
                for (int n = 0; n < 2; ++n) {
                    const float mj = SCALE ? rowscale(tm * 256 + bj * 128 + wc * 32 + n * 16 + fr) : 1.f;
#pragma unroll
                    for (int m = 0; m < 4; ++m) {
                        const ACC a_ = acc[ai][bj][m][n];
                        if (I8) {
                            const float4 cs = colscale(tn * 256 + ai * 128 + wr * 64 + m * 16 + fq * 4);
                            *(float4*)(st + (n * 16 + fr) * ST_P + m * 16 + fq * 4) = make_float4((float)a_[0] * (mj * cs.x), (float)a_[1] * (mj * cs.y), (float)a_[2] * (mj * cs.z), (float)a_[3] * (mj * cs.w));
                        } else
                        *(float4*)(st + (n * 16 + fr) * ST_P + m * 16 + fq * 4) = SCALE ? make_float4(a_[0] * mj, a_[1] * mj, a_[2] * mj, a_[3] * mj) : make_float4(a_[0], a_[1], a_[2], a_[3]);
                    }
                }
                if (PRE) {
#pragma unroll
                    for (int it = 0; it < 8; ++it) {
                        const float4 v = *(const float4*)(st + (it * 4 + rr) * ST_P + ch * 4);
                        epirow(tb + bj * 128 + it * 4, nb + ai * 128, v, pv[it]);
                    }
                } else {
#pragma unroll 2
                    for (int it = 0; it < 8; ++it) {
                        const float4 v = *(const float4*)(st + (it * 4 + rr) * ST_P + ch * 4);
                        epirow(tb + bj * 128 + it * 4, nb + ai * 128, v, make_float4(0.f, 0.f, 0.f, 0.f));
                    }
                }
            }
        __syncthreads();
    }
}

__device__ __forceinline__ void transpose_tiled(const float* __restrict__ W, bf16* __restrict__ Wt, int K, int N, int Npad, int ldk, const float* __restrict__ gain, char* lds) {
    float (*tl)[65] = (float (*)[65])lds;
    const int tid = tidx(), a = tid & 63, q = tid >> 6;
    const int tK = K / 64, tN = Npad / 64;
    for (int tile = blockIdx.x; tile < tK * tN; tile += gridDim.x) {
        const int k0 = (tile / tN) * 64, n0 = (tile % tN) * 64;
#pragma unroll 4
        for (int i = 0; i < 64 / NW; ++i) {
            const int k = k0 + q * (64 / NW) + i, n = n0 + a;
            float v = (n < N) ? W[(size_t)k * N + n] : 0.f;
            if (gain) v *= gain[k];
            tl[q * (64 / NW) + i][a] = v;
        }
        __syncthreads();
#pragma unroll 4
        for (int i = 0; i < 64 / NW; ++i) { const int nl = q * (64 / NW) + i; Wt[(size_t)(n0 + nl) * ldk + k0 + a] = f2bf(tl[a][nl]); }
        __syncthreads();
    }
}

__device__ __forceinline__ void quant_row(const float4 (&v)[4], unsigned char* __restrict__ dst, float* __restrict__ scl, int r, int lane) {
    float am = 0.f;
#pragma unroll
    for (int j = 0; j < 4; ++j) am = fmaxf(am, fmaxf(fmaxf(fabsf(v[j].x), fabsf(v[j].y)), fmaxf(fabsf(v[j].z), fabsf(v[j].w))));
#pragma unroll
    for (int m = 32; m >= 1; m >>= 1) am = fmaxf(am, __shfl_xor(am, m, 64));
    const float sc = (am > 0.f) ? am * (1.f / 448.f) : 1.f;
    const float is = 1.f / sc;
    uint4 o;
    { int w = 0; w = __builtin_amdgcn_cvt_pk_fp8_f32(v[0].x * is, v[0].y * is, w, false); w = __builtin_amdgcn_cvt_pk_fp8_f32(v[0].z * is, v[0].w * is, w, true); o.x = (unsigned)w; }
    { int w = 0; w = __builtin_amdgcn_cvt_pk_fp8_f32(v[1].x * is, v[1].y * is, w, false); w = __builtin_amdgcn_cvt_pk_fp8_f32(v[1].z * is, v[1].w * is, w, true); o.y = (unsigned)w; }
    { int w = 0; w = __builtin_amdgcn_cvt_pk_fp8_f32(v[2].x * is, v[2].y * is, w, false); w = __builtin_amdgcn_cvt_pk_fp8_f32(v[2].z * is, v[2].w * is, w, true); o.z = (unsigned)w; }
    { int w = 0; w = __builtin_amdgcn_cvt_pk_fp8_f32(v[3].x * is, v[3].y * is, w, false); w = __builtin_amdgcn_cvt_pk_fp8_f32(v[3].z * is, v[3].w * is, w, true); o.w = (unsigned)w; }
    { const int lay = r / NEXP, e = r % NEXP; *(uint4*)(dst + (((size_t)(lay * 8 + (lane >> 3)) * NEXP + e) * 128) + (lane & 7) * 16) = o; }
    if (lane == 0) scl[r] = sc;
}
__device__ __forceinline__ unsigned pack_i8x4(float a, float b, float c, float d) {
    const int ia = __float2int_rn(a), ib = __float2int_rn(b), ic = __float2int_rn(c), id = __float2int_rn(d);
    return (unsigned)(ia & 255) | ((unsigned)(ib & 255) << 8) | ((unsigned)(ic & 255) << 16) | ((unsigned)(id & 255) << 24);
}
__device__ __forceinline__ void quant_row_i8(const float4 (&v)[4], unsigned char* __restrict__ dst, float* __restrict__ scl, int r, int lane) {
    float am = 0.f;
#pragma unroll
    for (int j = 0; j < 4; ++j) am = fmaxf(am, fmaxf(fmaxf(fabsf(v[j].x), fabsf(v[j].y)), fmaxf(fabsf(v[j].z), fabsf(v[j].w))));
#pragma unroll
    for (int m = 32; m >= 1; m >>= 1) am = fmaxf(am, __shfl_xor(am, m, 64));
    const float sc = (am > 0.f) ? am * (1.f / 127.f) : 1.f;
    const float is = 1.f / sc;
    uint4 o;
    o.x = pack_i8x4(v[0].x * is, v[0].y * is, v[0].z * is, v[0].w * is); o.y = pack_i8x4(v[1].x * is, v[1].y * is, v[1].z * is, v[1].w * is);
    o.z = pack_i8x4(v[2].x * is, v[2].y * is, v[2].z * is, v[2].w * is); o.w = pack_i8x4(v[3].x * is, v[3].y * is, v[3].z * is, v[3].w * is);
    { const int lay = r / NEXP, e = r % NEXP; *(uint4*)(dst + (((size_t)(lay * 8 + (lane >> 3)) * NEXP + e) * 128) + (lane & 7) * 16) = o; }
    if (lane == 0) scl[r] = sc;
}
template <bool I8>
__device__ __forceinline__ void convert_table(const float* __restrict__ src, unsigned char* __restrict__ dst, float* __restrict__ scl, int rows) {
    static_assert(TAB_FP8, "fp8 tables");
    const int lane = tidx() & 63;
    const int nw = nwave();
    for (int r = gwave(); r < rows; r += 4 * nw) {
        float4 v[4][4]; int rr[4];
#pragma unroll
        for (int u = 0; u < 4; ++u) {
            rr[u] = (r + u * nw < rows) ? (r + u * nw) : r;
            const float4* s0 = (const float4*)(src + (size_t)rr[u] * D);
#pragma unroll
            for (int j = 0; j < 4; ++j) v[u][j] = s0[lane * 4 + j];
        }
#pragma unroll
        for (int u = 0; u < 4; ++u) {
            if (u == 0 || rr[u] != r) { if (I8) quant_row_i8(v[u], dst, scl, rr[u], lane); else quant_row(v[u], dst, scl, rr[u], lane); }
        }
    }
}
__device__ __forceinline__ void phase_prep(const Params& P, char* lds) {
    unsigned char* ws = P.ws;
    for (int l = 0; l < DEPTH; ++l) {
        transpose_tiled(P.w_in + (size_t)l * D * DIN, (bf16*)(ws + WS_WIN) + (size_t)l * DINP * LDW, D, DIN, DINP, LDW, nullptr, lds);
        transpose_tiled(P.w_uq + (size_t)l * QR * 768, (bf16*)(ws + WS_WUQ) + (size_t)l * 768 * QR, QR, 768, 768, QR, P.q_norm + l * QR, lds);
        transpose_tiled(P.w_uk + (size_t)l * KVR * 512, (bf16*)(ws + WS_WUKV) + (size_t)l * 1024 * KVR, KVR, 512, 512, KVR, P.kv_norm + l * KVR, lds);
        transpose_tiled(P.w_uv + (size_t)l * KVR * 512, (bf16*)(ws + WS_WUKV) + (size_t)l * 1024 * KVR + (size_t)512 * KVR, KVR, 512, 512, KVR, P.kv_norm + l * KVR, lds);
        transpose_tiled(P.w_out + (size_t)l * D * D, (bf16*)(ws + WS_WOUT) + (size_t)l * D * LDW, D, D, D, LDW, nullptr, lds);
    }
    {
        bf16* Wc = (bf16*)(ws + WS_WPQ);
        float (*As)[68] = (float (*)[68])lds;
        float (*Bs)[68] = (float (*)[68])(lds + 16 * 68 * 4);
        const int tid = tidx(), tx = tid & 15, ty = (tid >> 4) & 15;
        const int lr = (tid >> 2) & 63, ld4 = (tid & 3) * 4;
        for (int tile = blockIdx.x; tile < (DEPTH * 2048 / 64) * (D / 64); tile += gridDim.x) {
            const int row0 = (tile >> 4) * 64, k0 = (tile & 15) * 64;
            const int l = row0 >> 11, hp = (row0 >> 7) & 15, n0 = row0 & 127;
            const float* skp = P.peer_subkeys + (((size_t)l * 2 + (hp & 1)) * NKEY + n0 + lr) * 128 + ld4;
            const float* wqp = P.peer_wq + ((size_t)l * D + k0 + lr) * 2048 + hp * 128 + ld4;
            float acc[4][4];
#pragma unroll
            for (int i = 0; i < 4; ++i)
#pragma unroll
                for (int j = 0; j < 4; ++j) acc[i][j] = 0.f;
            for (int d0 = 0; d0 < 128; d0 += 16) {
                if (tid < 256) {
                    const float4 av = *(const float4*)(skp + d0), bv = *(const float4*)(wqp + d0);
                    As[ld4 + 0][lr] = av.x; As[ld4 + 1][lr] = av.y; As[ld4 + 2][lr] = av.z; As[ld4 + 3][lr] = av.w;
                    Bs[ld4 + 0][lr] = bv.x; Bs[ld4 + 1][lr] = bv.y; Bs[ld4 + 2][lr] = bv.z; Bs[ld4 + 3][lr] = bv.w;
                }
                __syncthreads();
#pragma unroll
                for (int kk = 0; kk < 16; ++kk) {
                    const float4 a4 = *(const float4*)&As[kk][ty * 4], b4 = *(const float4*)&Bs[kk][tx * 4];
                    const float aa[4] = {a4.x, a4.y, a4.z, a4.w}, bb[4] = {b4.x, b4.y, b4.z, b4.w};
#pragma unroll
                    for (int i = 0; i < 4; ++i)
#pragma unroll
                        for (int j = 0; j < 4; ++j) acc[i][j] = fmaf(aa[i], bb[j], acc[i][j]);
                }
                __syncthreads();
            }
            if (tid < 256) {
#pragma unroll
                for (int i = 0; i < 4; ++i) {
                    uint2 o; o.x = pack2(acc[i][0], acc[i][1]); o.y = pack2(acc[i][2], acc[i][3]);
                    *(uint2*)(Wc + (size_t)(row0 + ty * 4 + i) * LDW + k0 + tx * 4) = o;
                }
            }
        }
    }
    convert_table<true>(P.peer_u, ws + WS_TABU, (float*)(ws + WS_TSCU), DEPTH * NEXP);
    convert_table<false>(P.peer_v, ws + WS_TABV, (float*)(ws + WS_TSCV), DEPTH * NEXP);
    float* rope = (float*)(ws + WS_ROPE);
    for (size_t i = gtid(); i < (size_t)S * 16; i += gnth()) {
        const int s = (int)(i >> 4), f = (int)(i & 15);
        const double inv = pow(10000.0, -(double)f / 16.0);
        const double ang = (double)s * inv;
        rope[2 * i] = (float)cos(ang); rope[2 * i + 1] = (float)sin(ang);
    }
}

__device__ __forceinline__ void phase_norm(const float* __restrict__ h, const float* __restrict__ g, unsigned* __restrict__ xq, float* __restrict__ xsc) {
    const int lane = tidx() & 63, nw = nwave();
    for (int t = gwave(); t < T; t += 2 * nw) {
        const int t2 = (t + nw < T) ? (t + nw) : t;
        float4 v[2][4];
#pragma unroll
        for (int j = 0; j < 4; ++j) { v[0][j] = ((const float4*)(h + (size_t)t * D))[j * 64 + lane]; v[1][j] = ((const float4*)(h + (size_t)t2 * D))[j * 64 + lane]; }
#pragma unroll
        for (int u = 0; u < 2; ++u) {
            float ss = 0.f;
#pragma unroll
            for (int j = 0; j < 4; ++j) ss += v[u][j].x * v[u][j].x + v[u][j].y * v[u][j].y + v[u][j].z * v[u][j].z + v[u][j].w * v[u][j].w;
            ss = wave_sum(ss);
            const float r = rsqrtf(ss * (1.f / D) + EPS);
            const int tt = u ? t2 : t;
            if (u == 0 || t2 != t) {
                float am = 0.f;
#pragma unroll
                for (int j = 0; j < 4; ++j) {
                    const float4 gg = ((const float4*)g)[j * 64 + lane];
                    v[u][j].x *= r * gg.x; v[u][j].y *= r * gg.y; v[u][j].z *= r * gg.z; v[u][j].w *= r * gg.w;
                    am = fmaxf(am, fmaxf(fmaxf(fabsf(v[u][j].x), fabsf(v[u][j].y)), fmaxf(fabsf(v[u][j].z), fabsf(v[u][j].w))));
                }
#pragma unroll
                for (int m = 32; m >= 1; m >>= 1) am = fmaxf(am, __shfl_xor(am, m, 64));
                const float sc = (am > 0.f) ? am * (1.f / 127.f) : 1.f, is = 1.f / sc;
#pragma unroll
                for (int j = 0; j < 4; ++j) xq[(size_t)tt * (XQP / 4) + j * 64 + lane] = pack_i8x4(v[u][j].x * is, v[u][j].y * is, v[u][j].z * is, v[u][j].w * is);
                if (lane == 0) xsc[tt] = sc;
            }
        }
    }
}
__device__ __forceinline__ void quant_wrows(const bf16* __restrict__ W, int nrows, unsigned char* __restrict__ W8, float* __restrict__ WS8) {
    const int lane = tidx() & 63;
    for (int row = gwave(); row < nrows; row += nwave()) {
        const uint4 a = ((const uint4*)(W + (size_t)row * LDW))[lane * 2], b = ((const uint4*)(W + (size_t)row * LDW))[lane * 2 + 1];
        float v[16] = {bflo(a.x), bfhi(a.x), bflo(a.y), bfhi(a.y), bflo(a.z), bfhi(a.z), bflo(a.w), bfhi(a.w), bflo(b.x), bfhi(b.x), bflo(b.y), bfhi(b.y), bflo(b.z), bfhi(b.z), bflo(b.w), bfhi(b.w)};
        float am = 0.f;
#pragma unroll
        for (int i = 0; i < 16; ++i) am = fmaxf(am, fabsf(v[i]));
#pragma unroll
        for (int m = 32; m >= 1; m >>= 1) am = fmaxf(am, __shfl_xor(am, m, 64));
        const float sc = (am > 0.f) ? am * (1.f / 127.f) : 1.f, is = 1.f / sc;
        uint4 o;
        o.x = pack_i8x4(v[0] * is, v[1] * is, v[2] * is, v[3] * is); o.y = pack_i8x4(v[4] * is, v[5] * is, v[6] * is, v[7] * is);
        o.z = pack_i8x4(v[8] * is, v[9] * is, v[10] * is, v[11] * is); o.w = pack_i8x4(v[12] * is, v[13] * is, v[14] * is, v[15] * is);
        ((uint4*)(W8 + (size_t)row * XQP))[lane] = o;
        if (lane == 0) WS8[row] = sc;
    }
}
__device__ __forceinline__ void phase_norm_q(const Params& P, int l) {
    const int lane = tidx() & 63, nw = nwave();
    const float* g = P.norm_ffn + l * D;
    unsigned* xq = (unsigned*)(P.ws + WS_XQ);
    float* xsc = (float*)(P.ws + WS_XS);
    bf16* Hb = (bf16*)P.out;
    const bf16* yo = (const bf16*)(P.ws + WS_PROJ);
    for (int t = gwave(); t < T; t += 2 * nw) {
        const int t2 = (t + nw < T) ? (t + nw) : t;
        float4 v[2][4];
#pragma unroll
        for (int j = 0; j < 4; ++j) {
            if (l == 0) { v[0][j] = ((const float4*)(P.x + (size_t)t * D))[j * 64 + lane]; v[1][j] = ((const float4*)(P.x + (size_t)t2 * D))[j * 64 + lane]; }
            else {
                const uint2 a = ((const uint2*)(Hb + (size_t)t * HP))[j * 64 + lane], b = ((const uint2*)(Hb + (size_t)t2 * HP))[j * 64 + lane];
                v[0][j] = make_float4(bflo(a.x), bfhi(a.x), bflo(a.y), bfhi(a.y)); v[1][j] = make_float4(bflo(b.x), bfhi(b.x), bflo(b.y), bfhi(b.y));
            }
        }
        {
            uint2 y[2][4];
#pragma unroll
            for (int j = 0; j < 4; ++j) { y[0][j] = ((const uint2*)(yo + (size_t)t * D))[j * 64 + lane]; y[1][j] = ((const uint2*)(yo + (size_t)t2 * D))[j * 64 + lane]; }
#pragma unroll
            for (int u = 0; u < 2; ++u)
#pragma unroll
                for (int j = 0; j < 4; ++j) { v[u][j].x += bflo(y[u][j].x); v[u][j].y += bfhi(y[u][j].x); v[u][j].z += bflo(y[u][j].y); v[u][j].w += bfhi(y[u][j].y); }
#pragma unroll
            for (int j = 0; j < 4; ++j) {
                uint2 a, b; a.x = pack2(v[0][j].x, v[0][j].y); a.y = pack2(v[0][j].z, v[0][j].w); b.x = pack2(v[1][j].x, v[1][j].y); b.y = pack2(v[1][j].z, v[1][j].w);
                ((uint2*)(Hb + (size_t)t * HP))[j * 64 + lane] = a; if (t2 != t) ((uint2*)(Hb + (size_t)t2 * HP))[j * 64 + lane] = b;
            }
        }
#pragma unroll
        for (int u = 0; u < 2; ++u) {
            float ss = 0.f;
#pragma unroll
            for (int j = 0; j < 4; ++j) ss += v[u][j].x * v[u][j].x + v[u][j].y * v[u][j].y + v[u][j].z * v[u][j].z + v[u][j].w * v[u][j].w;
            ss = wave_sum(ss);
            const float r = rsqrtf(ss * (1.f / D) + EPS);
            const int tt = u ? t2 : t;
            if (u == 0 || t2 != t) {
                float am = 0.f;
#pragma unroll
                for (int j = 0; j < 4; ++j) {
                    const float4 gg = ((const float4*)g)[j * 64 + lane];
                    v[u][j].x *= r * gg.x; v[u][j].y *= r * gg.y; v[u][j].z *= r * gg.z; v[u][j].w *= r * gg.w;
                    am = fmaxf(am, fmaxf(fmaxf(fabsf(v[u][j].x), fabsf(v[u][j].y)), fmaxf(fabsf(v[u][j].z), fabsf(v[u][j].w))));
                }
#pragma unroll
                for (int m = 32; m >= 1; m >>= 1) am = fmaxf(am, __shfl_xor(am, m, 64));
                const float sc = (am > 0.f) ? am * (1.f / 127.f) : 1.f, is = 1.f / sc;
#pragma unroll
                for (int j = 0; j < 4; ++j) xq[(size_t)tt * (XQP / 4) + j * 64 + lane] = pack_i8x4(v[u][j].x * is, v[u][j].y * is, v[u][j].z * is, v[u][j].w * is);
                if (lane == 0) xsc[tt] = sc;
            }
        }
    }
}

__device__ __forceinline__ void phase_mixlocal(const Params& P, int l, char* lds) {
    const bf16* proj = (const bf16*)(P.ws + WS_PROJ);
    bf16* Y = (bf16*)(P.ws + WS_XN);
    const int tid = tidx();
    {
        const float* cw = P.conv_w + (size_t)l * 3 * 256;
        const size_t nth = gnth();
        for (size_t i0 = gtid(); i0 < (size_t)T * 32; i0 += 4 * nth) {
            uint4 gq[4][3], hq[4][3], bq[4];
#pragma unroll
            for (int u = 0; u < 4; ++u) {
                const size_t i = (i0 + u * nth < (size_t)T * 32) ? (i0 + u * nth) : i0;
                const int t = (int)(i >> 5), c0 = (int)(i & 31) * 8, s = t & (S - 1);
                const bf16* pr = proj + (size_t)t * DINP;
#pragma unroll
                for (int j = 0; j < 3; ++j) {
                    const bf16* pp = pr - (size_t)((s - 2 + j >= 0) ? (2 - j) : 0) * DINP;
                    gq[u][j] = *(const uint4*)(pp + C_CG + c0); hq[u][j] = *(const uint4*)(pp + C_HC + c0);
                }
                bq[u] = *(const uint4*)(pr + C_BG + c0);
            }
#pragma unroll
            for (int u = 0; u < 4; ++u) {
                const size_t i = i0 + u * nth;
                if (i < (size_t)T * 32) {
                    const int t = (int)(i >> 5), c0 = (int)(i & 31) * 8, s = t & (S - 1);
                    float acc[8];
#pragma unroll
                    for (int e = 0; e < 8; ++e) acc[e] = 0.f;
#pragma unroll
                    for (int j = 0; j < 3; ++j) {
                        if (s - 2 + j >= 0) {
                            const uint4 g = gq[u][j], hc = hq[u][j];
                            const float4 w0 = *(const float4*)(cw + j * 256 + c0), w1 = *(const float4*)(cw + j * 256 + c0 + 4);
                            acc[0] = fmaf(w0.x, bflo(g.x) * bflo(hc.x), acc[0]); acc[1] = fmaf(w0.y, bfhi(g.x) * bfhi(hc.x), acc[1]);
                            acc[2] = fmaf(w0.z, bflo(g.y) * bflo(hc.y), acc[2]); acc[3] = fmaf(w0.w, bfhi(g.y) * bfhi(hc.y), acc[3]);
                            acc[4] = fmaf(w1.x, bflo(g.z) * bflo(hc.z), acc[4]); acc[5] = fmaf(w1.y, bfhi(g.z) * bfhi(hc.z), acc[5]);
                            acc[6] = fmaf(w1.z, bflo(g.w) * bflo(hc.w), acc[6]); acc[7] = fmaf(w1.w, bfhi(g.w) * bfhi(hc.w), acc[7]);
                        }
                    }
                    const uint4 bg = bq[u];
                    uint4 o;
                    o.x = pack2(bflo(bg.x) * acc[0], bfhi(bg.x) * acc[1]); o.y = pack2(bflo(bg.y) * acc[2], bfhi(bg.y) * acc[3]);
                    o.z = pack2(bflo(bg.z) * acc[4], bfhi(bg.z) * acc[5]); o.w = pack2(bflo(bg.w) * acc[6], bfhi(bg.w) * acc[7]);
                    *(uint4*)(Y + (size_t)t * LDX + c0) = o;
                }
            }
        }
    }
    {
        float (*pl)[68] = (float (*)[68])lds;
        const float* pw = P.pool_w + (size_t)l * 4 * 64 * 64;
        const float* psc = P.pool_scale + l * 256;
        const int a = tid & 63, q = tid >> 6;
        for (int tile = blockIdx.x; tile < (T / (16 * NW)) * 4; tile += gridDim.x) {
            const int g = tile & 3, t0 = (tile >> 2) * (16 * NW);
            const int w = 2 << g;
            {
                const bf16* col = proj + C_HP + g * 64 + a;
                const int tf = t0 + q * 16, sf = tf & (S - 1);
                float xr[31];
#pragma unroll
                for (int d = 1; d <= 15; ++d) xr[15 - d] = (d < w && sf - d >= 0) ? bf2f(col[(size_t)(tf - d) * DINP]) : 0.f;
#pragma unroll
                for (int i = 0; i < 16; ++i) xr[15 + i] = bf2f(col[(size_t)(tf + i) * DINP]);
                float sum = 0.f;
#pragma unroll
                for (int d = 1; d <= 15; ++d) sum += xr[15 - d];
#pragma unroll
                for (int i = 0; i < 16; ++i) {
                    const int s = sf + i;
                    sum += xr[15 + i];
                    const int cnt = (s + 1 < w) ? (s + 1) : w;
                    pl[q * 16 + i][a] = sum / (float)cnt - xr[15 + i];
                    const int o = 15 + i + 1;
                    const float old = (g == 0) ? xr[o - 2] : (g == 1) ? xr[o - 4] : (g == 2) ? xr[o - 8] : xr[o - 16];
                    sum -= old;
                }
            }
            __syncthreads();
            {
                float pc[64];
#pragma unroll
                for (int c = 0; c < 64; ++c) pc[c] = pw[(g * 64 + c) * 64 + a];
                const float sc = psc[g * 64 + a];
#pragma unroll 2
                for (int i = 0; i < 16; ++i) {
                    const float4* row = (const float4*)&pl[q * 16 + i][0];
                    float m0 = 0.f, m1 = 0.f;
#pragma unroll
                    for (int c4 = 0; c4 < 16; ++c4) { const float4 v = row[c4]; m0 = fmaf(v.x, pc[4 * c4], m0); m1 = fmaf(v.y, pc[4 * c4 + 1], m1); m0 = fmaf(v.z, pc[4 * c4 + 2], m0); m1 = fmaf(v.w, pc[4 * c4 + 3], m1); }
                    Y[(size_t)(t0 + q * 16 + i) * LDX + 256 + g * 64 + a] = f2bf((m0 + m1) * sc);
                }
            }
            __syncthreads();
        }
    }
}

typedef short v4i16_t __attribute__((ext_vector_type(4)));
typedef __attribute__((address_space(3))) v4i16_t* lds_v4p;
__device__ __forceinline__ v4i16_t vtr(const char* p) { return __builtin_amdgcn_ds_read_tr16_b64_v4i16((lds_v4p)p); }
constexpr int A_KP = 208, A_VP = 192;
constexpr int A_KB = 64 * A_KP, A_VB = 64 * A_VP, A_BUF = A_KB + A_VB, ATTN_LDS = 3 * A_BUF;
static_assert(ATTN_LDS <= LDS_TOTAL, "attention LDS");

__device__ __forceinline__ void attn_unit(const bf16* __restrict__ Qb, const bf16* __restrict__ Kb, const bf16* __restrict__ Vb, bf16* __restrict__ Y, int bh, int qblk, char* lds) {
    const int tid = tidx(), lane = tid & 63, w = tid >> 6, r32 = lane & 31, hi = lane >> 5;
    const int q0 = qblk * (64 * NW), qw0 = q0 + w * 64;
    const int NT = (q0 + 64 * NW) / 64;
    bf16x8 qfa[6], qfb[6];
    {
        const bf16* qp = Qb + ((size_t)bh * S + qw0 + r32) * DQK + hi * 8;
#pragma unroll
        for (int ks = 0; ks < 6; ++ks) { qfa[ks] = *(const bf16x8*)(qp + ks * 16); qfb[ks] = *(const bf16x8*)(qp + 32 * DQK + ks * 16); }
    }
    f32x16 oa0, oa1, ob0, ob1;
#pragma unroll
    for (int r = 0; r < 16; ++r) { oa0[r] = 0.f; oa1[r] = 0.f; ob0[r] = 0.f; ob1[r] = 0.f; }
    float ma = -1e30f, mb = -1e30f, lsa = 0.f, lsb = 0.f;
    const int t8 = tid & 255; const bool isv = tid >= 256;
    const char* Tg = isv ? (const char*)(Vb + (size_t)bh * S * DV) : (const char*)(Kb + (size_t)bh * S * DQK);
    const int Ts = isv ? (64 * 128) : (64 * 192);
    const int g0 = t8 * 16, g1 = (t8 + 256) * 16, g2 = isv ? g1 : (t8 + 512) * 16;
    const int l0 = isv ? (A_KB + (t8 >> 3) * A_VP + (t8 & 7) * 16) : ((t8 / 12) * A_KP + (t8 % 12) * 16);
    const int l1 = isv ? (l0 + 32 * A_VP) : (((t8 + 256) / 12) * A_KP + ((t8 + 256) % 12) * 16);
    const int l2 = isv ? l1 : (((t8 + 512) / 12) * A_KP + ((t8 + 512) % 12) * 16);
    uint4 pk0, pk1, pk2, qk0, qk1, qk2;
#define A_LOAD(S, t) do { const char* tg = Tg + (size_t)(t) * Ts; S##k0 = *(const uint4*)(tg + g0); S##k1 = *(const uint4*)(tg + g1); S##k2 = *(const uint4*)(tg + g2); } while (0)
#define A_STORE(S, bK, bV) do { *(uint4*)(bK + l0) = S##k0; *(uint4*)(bK + l1) = S##k1; *(uint4*)(bK + l2) = S##k2; } while (0)
#define A_PV2(pa, pb, kofs) do { \
            { const v4i16_t lo = vtr(pv + (kofs) * A_VP), hh = vtr(pv + ((kofs) + 8) * A_VP); const bf16x8 vf = {lo[0], lo[1], lo[2], lo[3], hh[0], hh[1], hh[2], hh[3]}; oa0 = MFMA32(vf, pa.v, oa0); ob0 = MFMA32(vf, pb.v, ob0); } \
            { const v4i16_t lo = vtr(pv + (kofs) * A_VP + 64), hh = vtr(pv + ((kofs) + 8) * A_VP + 64); const bf16x8 vf = {lo[0], lo[1], lo[2], lo[3], hh[0], hh[1], hh[2], hh[3]}; oa1 = MFMA32(vf, pa.v, oa1); ob1 = MFMA32(vf, pb.v, ob1); } } while (0)
#define A_SOFT(s0, s1, m, ls, o0, o1, P0, P1, P2, P3) do { \
            float mx = fmaxf(s0[0], s1[0]); \
            _Pragma("unroll") for (int r = 1; r < 16; ++r) mx = fmaxf(mx, fmaxf(s0[r], s1[r])); \
            mx = fmaxf(mx, __shfl_xor(mx, 32, 64)); \
            const float mn = fmaxf(m, mx), m_prev = m; \
            const float alpha = __builtin_amdgcn_exp2f(m - mn); \
            m = mn; \
            float ps = 0.f; \
            _Pragma("unroll") for (int r = 0; r < 16; ++r) { s0[r] = __builtin_amdgcn_exp2f(s0[r] - mn); s1[r] = __builtin_amdgcn_exp2f(s1[r] - mn); ps += s0[r] + s1[r]; } \
            if (__builtin_amdgcn_ballot_w64(mn > m_prev) != 0ull) {     \
                ls *= alpha; \
                _Pragma("unroll") for (int r = 0; r < 16; ++r) { o0[r] *= alpha; o1[r] *= alpha; } } \
            ls += ps; \
            _Pragma("unroll") for (int j = 0; j < 4; ++j) { P0.u[j] = cvtpk(s0[2 * j], s0[2 * j + 1]); P1.u[j] = cvtpk(s0[8 + 2 * j], s0[9 + 2 * j]); P2.u[j] = cvtpk(s1[2 * j], s1[2 * j + 1]); P3.u[j] = cvtpk(s1[8 + 2 * j], s1[9 + 2 * j]); } } while (0)
    const int pvo = (4 * hi + ((lane & 15) >> 2)) * A_VP + (16 * ((lane >> 4) & 1) + 4 * (lane & 3)) * 2;
    A_LOAD(p, 0); A_LOAD(q, 1);
    for (int t2 = 0; t2 < NT; t2 += 2) {
#pragma unroll
        for (int half = 0; half < 2; ++half) {
            const int t = t2 + half;
            char* bK = lds + half * A_BUF; char* bV = bK + A_KB;
            if (half == 0) A_STORE(p, bK, bV); else A_STORE(q, bK, bV);
            __syncthreads();
            { const int tn = (t + 2 < NT) ? (t + 2) : (NT - 2 + half); if (half == 0) A_LOAD(p, tn); else A_LOAD(q, tn); }
            const int kt0 = t * 64;
            if (kt0 <= qw0) {
                f32x16 sa0, sa1, sb0, sb1;
#pragma unroll
                for (int r = 0; r < 16; ++r) { sa0[r] = 0.f; sa1[r] = 0.f; sb0[r] = 0.f; sb1[r] = 0.f; }
                const char* pk = bK + r32 * A_KP + hi * 16;
#pragma unroll
                for (int ks = 0; ks < 6; ++ks) {
                    const bf16x8 a0 = *(const bf16x8*)(pk + ks * 32), a1 = *(const bf16x8*)(pk + 32 * A_KP + ks * 32);
                    sa0 = MFMA32(a0, qfa[ks], sa0); sa1 = MFMA32(a1, qfa[ks], sa1);
                    sb0 = MFMA32(a0, qfb[ks], sb0); sb1 = MFMA32(a1, qfb[ks], sb1);
                }
                if (kt0 == qw0) {
                    const int qrow = qw0 + r32;
#pragma unroll
                    for (int r = 0; r < 16; ++r) {
                        const int key = kt0 + crow(r, hi);
                        if (key > qrow) sa0[r] = -INFINITY; if (key + 32 > qrow) sa1[r] = -INFINITY;
                        if (key > qrow + 32) sb0[r] = -INFINITY; if (key > qrow) sb1[r] = -INFINITY;
                    }
                }
                union { unsigned u[4]; bf16x8 v; } pa0, pa1, pa2, pa3, pb0, pb1, pb2, pb3;
                A_SOFT(sa0, sa1, ma, lsa, oa0, oa1, pa0, pa1, pa2, pa3);
                A_SOFT(sb0, sb1, mb, lsb, ob0, ob1, pb0, pb1, pb2, pb3);
                const char* pv = bV + pvo;
                A_PV2(pa0, pb0, 0); A_PV2(pa1, pb1, 16); A_PV2(pa2, pb2, 32); A_PV2(pa3, pb3, 48);
            }
        }
    }
#undef A_LOAD
#undef A_STORE
#undef A_PV2
#undef A_SOFT
    lsa += __shfl_xor(lsa, 32, 64); lsb += __shfl_xor(lsb, 32, 64);
    const float inva = 1.f / lsa, invb = 1.f / lsb;
    const int b = bh >> 3, h = bh & 7;
    bf16* yo = Y + (size_t)(b * S + qw0 + r32) * LDX + 512 + h * 64 + 4 * hi;
#pragma unroll
    for (int g = 0; g < 4; ++g) {
        uint2 a, c;
        a.x = cvtpk(oa0[4 * g] * inva, oa0[4 * g + 1] * inva); a.y = cvtpk(oa0[4 * g + 2] * inva, oa0[4 * g + 3] * inva);
        c.x = cvtpk(oa1[4 * g] * inva, oa1[4 * g + 1] * inva); c.y = cvtpk(oa1[4 * g + 2] * inva, oa1[4 * g + 3] * inva);
        *(uint2*)(yo + 8 * g) = a; *(uint2*)(yo + 32 + 8 * g) = c;
        a.x = cvtpk(ob0[4 * g] * invb, ob0[4 * g + 1] * invb); a.y = cvtpk(ob0[4 * g + 2] * invb, ob0[4 * g + 3] * invb);
        c.x = cvtpk(ob1[4 * g] * invb, ob1[4 * g + 1] * invb); c.y = cvtpk(ob1[4 * g + 2] * invb, ob1[4 * g + 3] * invb);
        *(uint2*)(yo + (size_t)32 * LDX + 8 * g) = a; *(uint2*)(yo + (size_t)32 * LDX + 32 + 8 * g) = c;
    }
    __syncthreads();
}
__device__ __forceinline__ void phase_attn(const Params& P, char* lds) {
    const bf16* Qb = (const bf16*)(P.ws + WS_Q);
    const bf16* Kb = (const bf16*)(P.ws + WS_K);
    const bf16* Vb = (const bf16*)(P.ws + WS_V);
    bf16* Y = (bf16*)(P.ws + WS_XN);
    for (int u = blockIdx.x; u < NB * NH * (S / 512); u += gridDim.x) {
        const int bh = u & 31, v = u >> 5;
        const int qblk = (v < 8) ? (15 - v) : (v - 8);
        attn_unit(Qb, Kb, Vb, Y, bh, qblk, lds);
    }
}

#define NET_HD __device__ __forceinline__
#define NET_U2F(u) __uint_as_float(u)
#define NET_F2U(f) __float_as_uint(f)
#define CE_DESC(a, b) do { const float hi__ = fmaxf(a, b), lo__ = fminf(a, b); a = hi__; b = lo__; } while (0)
NET_HD void sort16_desc(float (&v)[16]) {
#define CE2(a, b) CE_DESC(v[a], v[b])
    CE2(0,13); CE2(1,12); CE2(2,15); CE2(3,14); CE2(4,8); CE2(5,6); CE2(7,11); CE2(9,10);
    CE2(0,5); CE2(1,7); CE2(2,9); CE2(3,4); CE2(6,13); CE2(8,14); CE2(10,15); CE2(11,12);
    CE2(0,1); CE2(2,3); CE2(4,5); CE2(6,8); CE2(7,9); CE2(10,11); CE2(12,13); CE2(14,15);
    CE2(0,2); CE2(1,3); CE2(4,10); CE2(5,11); CE2(6,7); CE2(8,9); CE2(12,14); CE2(13,15);
    CE2(1,2); CE2(3,12); CE2(4,6); CE2(5,7); CE2(8,10); CE2(9,11); CE2(13,14);
    CE2(1,4); CE2(2,6); CE2(5,8); CE2(7,10); CE2(9,13); CE2(11,14);
    CE2(2,4); CE2(3,6); CE2(9,12); CE2(11,13);
    CE2(3,5); CE2(6,8); CE2(7,9); CE2(10,12);
    CE2(3,4); CE2(5,6); CE2(7,8); CE2(9,10); CE2(11,12);
    CE2(6,7); CE2(8,9);
#undef CE2
}
NET_HD void merge16_desc(float (&a)[16], const float (&b)[16]) {
#pragma unroll
    for (int i = 0; i < 16; ++i) a[i] = fmaxf(a[i], b[15 - i]);
#pragma unroll
    for (int j = 8; j > 0; j >>= 1) {
#pragma unroll
        for (int i = 0; i < 16; ++i) { const int l = i ^ j; if (l > i) CE_DESC(a[i], a[l]); }
    }
}
NET_HD void top16_of_64(float (&g0)[16], float (&g1)[16], float (&g2)[16], float (&g3)[16]) {
    sort16_desc(g0); sort16_desc(g1); sort16_desc(g2); sort16_desc(g3);
    merge16_desc(g0, g1); merge16_desc(g2, g3); merge16_desc(g0, g2);
}
NET_HD float u2f(unsigned u) { return NET_U2F(u); }
NET_HD unsigned f2u(float f) { return NET_F2U(f); }
template <class V16>
NET_HD void lane_top16(const V16& s0, const V16& s1, const V16& s2, const V16& s3, int hi, float (&out)[16]) {
    float g0[16], g1[16], g2[16], g3[16];
#pragma unroll
    for (int r = 0; r < 16; ++r) {
        const unsigned nb = (unsigned)((r & 3) + 8 * (r >> 2));
        g0[r] = u2f((f2u(s0[r]) & 0xFFFFFF80u) | nb); g1[r] = u2f((f2u(s1[r]) & 0xFFFFFF80u) | (nb + 32u));
        g2[r] = u2f((f2u(s2[r]) & 0xFFFFFF80u) | (nb + 64u)); g3[r] = u2f((f2u(s3[r]) & 0xFFFFFF80u) | (nb + 96u));
    }
    top16_of_64(g0, g1, g2, g3);
    const unsigned h4 = (unsigned)hi << 2;
#pragma unroll
    for (int i = 0; i < 16; ++i) out[i] = u2f(f2u(g0[i]) | h4);
}
constexpr int cand_slot(int a, int b) { int n = 0; for (int x = 0; x < 16; ++x) for (int y = 0; y < 16; ++y) { if (x == a && y == b) return n; if ((x + 1) * (y + 1) <= 16) ++n; } return n; }
NET_HD void cand_top16(const float (&s1)[16], const float (&s2)[16], float (&c)[16]) {
    float g0[16], g1[16], g2[16], g3[16];
#pragma unroll
    for (int i = 0; i < 16; ++i) { g0[i] = -3.0e38f; g1[i] = -3.0e38f; g2[i] = -3.0e38f; g3[i] = -3.0e38f; }
#pragma unroll
    for (int a = 0; a < 16; ++a) {
#pragma unroll
        for (int b = 0; b < 16; ++b) {
            if ((a + 1) * (b + 1) <= 16) {
                const int sl = cand_slot(a, b);
                const float v = u2f((f2u(s1[a] + s2[b]) & 0xFFFFFF00u) | (unsigned)(a * 16 + b));
                if (sl < 16) g0[sl & 15] = v; else if (sl < 32) g1[sl & 15] = v; else if (sl < 48) g2[sl & 15] = v; else g3[sl & 15] = v;
            }
        }
    }
    top16_of_64(g0, g1, g2, g3);
#pragma unroll
    for (int i = 0; i < 16; ++i) c[i] = g0[i];
}

__device__ __forceinline__ void phase_route(const Params& P, int l, char* lds) {
    const bf16* XQb = (const bf16*)(P.ws + WS_XQ);
    const bf16* Wc = (const bf16*)(P.ws + WS_WC8 + (size_t)l * 2048 * XQP);
    const float* WcS = (const float*)(P.ws + WS_WCS) + (size_t)l * 2048;
    const float* XSc = (const float*)(P.ws + WS_XS);
    int* EXPp = (int*)(P.ws + WS_EXP);
    float* GATEp = (float*)(P.ws + WS_GATE);
    const int tid = tidx();
    float* xch = (float*)(lds + 16384);
    int tlo, thi, tst; tile_rounds((T / 256) * PH, tlo, thi, tst);
    int nt = D / 128; asm volatile("" : "+s"(nt));
    for (int u = tlo; u < thi; u += tst) {
        const int tm = u >> 3, h = u & 7;
        float Lk[16];
        {
            i32x4 acc[2][2][4][2]; float ssd[2][2];
            gemm8_kloop<false, true, i32x4>(Wc + (size_t)(h * 256) * (XQP / 2), XQP / 2, XQb + (size_t)(tm * 256) * (XQP / 2), XQP / 2, nt, acc, ssd, lds, tid);
            const int te = tidx(), fq = (te >> 4) & 3;
            const unsigned fqb = (unsigned)fq << 2;
            float4 ks[2][4];
            { const float* kp = WcS + h * 256 + ((te >> 8) & 1) * 128 + fq * 4;
#pragma unroll
              for (int ai = 0; ai < 2; ++ai)
#pragma unroll
                  for (int m = 0; m < 4; ++m) ks[ai][m] = *(const float4*)(kp + ai * 64 + m * 16); }
#pragma unroll
            for (int i = 0; i < 16; ++i) Lk[i] = 0.f;
#pragma unroll
            for (int bj = 0; bj < 2; ++bj)
#pragma unroll
                for (int n = 0; n < 2; ++n) {
                    float g0[16], g1[16];
#pragma unroll
                    for (int m = 0; m < 4; ++m)
#pragma unroll
                        for (int j = 0; j < 4; ++j) {
                            const unsigned kb = (unsigned)(m * 16 + j) | fqb;
                            const float k0 = (j == 0) ? ks[0][m].x : (j == 1) ? ks[0][m].y : (j == 2) ? ks[0][m].z : ks[0][m].w;
                            const float k1 = (j == 0) ? ks[1][m].x : (j == 1) ? ks[1][m].y : (j == 2) ? ks[1][m].z : ks[1][m].w;
                            g0[m * 4 + j] = u2f((f2u((float)acc[0][bj][m][n][j] * k0) & 0xFFFFFF80u) | kb);
                            g1[m * 4 + j] = u2f((f2u((float)acc[1][bj][m][n][j] * k1) & 0xFFFFFF80u) | (kb + 64u));
                        }
                    sort16_desc(g0); sort16_desc(g1); merge16_desc(g0, g1);
                    float o[16];
#pragma unroll
                    for (int i = 0; i < 16; ++i) o[i] = __shfl_xor(g0[i], 16, 64);
                    merge16_desc(g0, o);
#pragma unroll
                    for (int i = 0; i < 16; ++i) o[i] = __shfl_xor(g0[i], 32, 64);
                    merge16_desc(g0, o);
                    const bool mine = fq == bj * 2 + n;
#pragma unroll
                    for (int i = 0; i < 16; ++i) Lk[i] = mine ? g0[i] : Lk[i];
                }
        }
        __syncthreads();
        const int te = tidx(), lane = te & 63, w = te >> 6, wr = w >> 2, wc = w & 3, fr = lane & 15, fq = lane >> 4;
        if (wr == 1) {
#pragma unroll
            for (int q = 0; q < 4; ++q) *(float4*)(xch + ((wc * 64 + lane) * 16) + 4 * q) = make_float4(Lk[4 * q], Lk[4 * q + 1], Lk[4 * q + 2], Lk[4 * q + 3]);
        }
        __syncthreads();
        if (wr == 0) {
            float L1[16];
#pragma unroll
            for (int q = 0; q < 4; ++q) { const float4 v = *(const float4*)(xch + ((wc * 64 + lane) * 16) + 4 * q); L1[4 * q] = v.x; L1[4 * q + 1] = v.y; L1[4 * q + 2] = v.z; L1[4 * q + 3] = v.w; }
            float c[16];
            cand_top16(Lk, L1, c);
            unsigned char* my = (unsigned char*)lds + te * 32;
            {
                uint4 a, b;
#define PK4(L, i) ((__float_as_uint(L[i]) & 127u) | ((__float_as_uint(L[i + 1]) & 127u) << 8) | ((__float_as_uint(L[i + 2]) & 127u) << 16) | ((__float_as_uint(L[i + 3]) & 127u) << 24))
                a.x = PK4(Lk, 0); a.y = PK4(Lk, 4); a.z = PK4(Lk, 8); a.w = PK4(Lk, 12);
                b.x = PK4(L1, 0); b.y = PK4(L1, 4); b.z = PK4(L1, 8); b.w = PK4(L1, 12);
#undef PK4
                *(uint4*)my = a; *(uint4*)(my + 16) = b;
            }
            const int t = tm * 256 + (fq >> 1) * 128 + wc * 32 + (fq & 1) * 16 + fr;
            const float xs_t = XSc[t];
            int ev[16]; float gv[16]; float den = 0.f;
#pragma unroll
            for (int k = 0; k < 16; ++k) {
                const unsigned ci = __float_as_uint(c[k]) & 255u;
                const int n1 = my[ci >> 4], n2 = my[16 + (ci & 15)];
                ev[k] = n1 * NKEY + n2;
                gv[k] = __expf((c[k] - c[0]) * xs_t); den += gv[k];
            }
            const float iden = 1.f / den;
            uint4* ep = (uint4*)(EXPp + (size_t)t * HK + h * 16);
            float4* gp = (float4*)(GATEp + (size_t)t * HK + h * 16);
#pragma unroll
            for (int q = 0; q < 4; ++q) {
                ep[q] = make_uint4((unsigned)ev[4 * q], (unsigned)ev[4 * q + 1], (unsigned)ev[4 * q + 2], (unsigned)ev[4 * q + 3]);
                gp[q] = make_float4(gv[4 * q] * iden, gv[4 * q + 1] * iden, gv[4 * q + 2] * iden, gv[4 * q + 3] * iden);
            }
        }
        __syncthreads();
    }
}

constexpr size_t WS_PART = WS_PROJ;
static_assert((size_t)8 * T * HK * 4 <= WS_K - WS_PROJ, "PART alias");
constexpr int XI_X = 0, XI_RANK = 1, XI_J = 2, XI_NX = 3, XI_NLOC = 4;
constexpr int CTL_CENSUS = 4096;
constexpr int CTL_BYTES = (CTL_CENSUS + 16) * 4;

template <int M1, int M2, int M3, class TT>
__device__ __forceinline__ void red16x3(TT (&p)[16], int lane) {
#pragma unroll
    for (int i = 0; i < 8; ++i) { const bool up = lane & M1; const TT send = up ? p[i] : p[i + 8], keep = up ? p[i + 8] : p[i]; p[i] = keep + __shfl_xor(send, M1, 64); }
#pragma unroll
    for (int i = 0; i < 4; ++i) { const bool up = lane & M2; const TT send = up ? p[i] : p[i + 4], keep = up ? p[i + 4] : p[i]; p[i] = keep + __shfl_xor(send, M2, 64); }
#pragma unroll
    for (int i = 0; i < 2; ++i) { const bool up = lane & M3; const TT send = up ? p[i] : p[i + 2], keep = up ? p[i + 2] : p[i]; p[i] = keep + __shfl_xor(send, M3, 64); }
}
__device__ __forceinline__ void phase_gu(const Params& P, int l, const volatile int* xi) {
    const unsigned char* XQ = P.ws + WS_XQ;
    const float* XSc = (const float*)(P.ws + WS_XS);
    const int* EXPp = (const int*)(P.ws + WS_EXP);
    float* PART = (float*)(P.ws + WS_PART);
    const int tid = tidx(), lane = tid & 63, w = tid >> 6, g = lane >> 3, c = lane & 7;
    int xo_ = 0; asm volatile("" : "+v"(xo_));
    const int j = __builtin_amdgcn_readfirstlane(xi[xo_ + XI_J]), nx = __builtin_amdgcn_readfirstlane(xi[xo_ + XI_NX]), nloc = __builtin_amdgcn_readfirstlane(xi[xo_ + XI_NLOC]), rank = __builtin_amdgcn_readfirstlane(xi[xo_ + XI_RANK]);
    const int t0 = rank * NW + w, st = nloc * NW;
    const int n = (t0 < T) ? (T - t0 + st - 1) / st : 0;
    const int i0 = 8 * (c & 1) + 4 * ((c >> 1) & 1) + 2 * ((c >> 2) & 1);
    for (int sl = j; sl < 8 && n > 0; sl += nx) {
        const unsigned char* Us = P.ws + WS_TABU + ((size_t)(l * 8 + sl) * NEXP) * 128;
        const unsigned co = (unsigned)c << 4;
        float* part = PART + (size_t)sl * T * HK;
        const unsigned char* xs = XQ + sl * 128 + c * 16;
#define GU_TK(k) (t0 + (((k) < n) ? (k) : (n - 1)) * st)
#define GU_LOADE(S, t) do { S##lo = EXPp[(size_t)(t) * HK + lane]; S##hi = EXPp[(size_t)(t) * HK + 64 + lane]; } while (0)
#define GU_LOADX(S, t) do { S##a = *(const uint4*)(xs + (size_t)(t) * XQP); S##s = XSc[t]; } while (0)
#define GU_ISSUE(R, S) do { _Pragma("unroll") for (int i = 0; i < 16; ++i) { \
            const int e = __builtin_amdgcn_ds_bpermute((((8 * i) & 63) + g) << 2, (i < 8) ? S##lo : S##hi); R[i] = *(const uint4*)(Us + (((unsigned)e << 7) | co)); } } while (0)
#define GU_FINISH(R, S, t) do { \
            int p[16]; \
            _Pragma("unroll") for (int i = 0; i < 16; ++i) { int d_ = __builtin_amdgcn_sdot4((int)S##a.x, (int)R[i].x, 0, false); d_ = __builtin_amdgcn_sdot4((int)S##a.y, (int)R[i].y, d_, false); \
                d_ = __builtin_amdgcn_sdot4((int)S##a.z, (int)R[i].z, d_, false); p[i] = __builtin_amdgcn_sdot4((int)S##a.w, (int)R[i].w, d_, false); } \
            red16x3<1, 2, 4, int>(p, lane); \
            part[(size_t)(t) * HK + 8 * i0 + g] = (float)p[0] * S##s; part[(size_t)(t) * HK + 8 * (i0 + 1) + g] = (float)p[1] * S##s; } while (0)
        int eAlo, eAhi, eBlo, eBhi; uint4 xAa, xBa; float xAs, xBs; uint4 rA[16], rB[16];
        GU_LOADE(eA, GU_TK(0)); GU_LOADX(xA, GU_TK(0)); GU_LOADE(eB, GU_TK(1));
        GU_ISSUE(rA, eA);
        for (int k = 0; k < n; k += 2) {
            GU_LOADX(xB, GU_TK(k + 1)); GU_ISSUE(rB, eB); GU_LOADE(eA, GU_TK(k + 2));
            GU_FINISH(rA, xA, GU_TK(k));
            GU_LOADX(xA, GU_TK(k + 2)); GU_ISSUE(rA, eA); GU_LOADE(eB, GU_TK(k + 3));
            GU_FINISH(rB, xB, GU_TK(k + 1));
        }
#undef GU_TK
#undef GU_LOADE
#undef GU_LOADX
#undef GU_ISSUE
#undef GU_FINISH
    }
}
__device__ __forceinline__ void phase_gw(const Params& P, int l) {
    const int* EXPp = (const int*)(P.ws + WS_EXP);
    const float* GATEp = (const float*)(P.ws + WS_GATE);
    const float* PART = (const float*)(P.ws + WS_PART);
    const float* SU = (const float*)(P.ws + WS_TSCU) + (size_t)l * NEXP;
    const float* SV = (const float*)(P.ws + WS_TSCV) + (size_t)l * NEXP;
    unsigned char* WQ = P.ws + WS_WQ8;
    float* WSC = (float*)(P.ws + WS_WSC);
    const int lane = tidx() & 63, hw = lane >> 5, l5 = lane & 31;
    for (int tb = gwave() * 8; tb < T; tb += nwave() * 8) {
        float wv[4][4];
#pragma unroll
        for (int q = 0; q < 4; ++q) {
            const size_t i = (size_t)(tb + 2 * q + hw) * HK + 4 * l5;
            float4 s = *(const float4*)(PART + i);
#pragma unroll
            for (int x = 1; x < 8; ++x) { const float4 p = *(const float4*)(PART + (size_t)x * T * HK + i); s.x += p.x; s.y += p.y; s.z += p.z; s.w += p.w; }
            const int4 e = *(const int4*)(EXPp + i);
            const float4 gt = *(const float4*)(GATEp + i);
            wv[q][0] = gt.x * gelu_exact(s.x * SU[e.x]) * SV[e.x]; wv[q][1] = gt.y * gelu_exact(s.y * SU[e.y]) * SV[e.y];
            wv[q][2] = gt.z * gelu_exact(s.z * SU[e.z]) * SV[e.z]; wv[q][3] = gt.w * gelu_exact(s.w * SU[e.w]) * SV[e.w];
        }
#pragma unroll
        for (int q = 0; q < 4; ++q) {
            float am = fmaxf(fmaxf(fabsf(wv[q][0]), fabsf(wv[q][1])), fmaxf(fabsf(wv[q][2]), fabsf(wv[q][3])));
#pragma unroll
            for (int m = 16; m >= 1; m >>= 1) am = fmaxf(am, __shfl_xor(am, m, 64));
            const float sc = (am > 0.f) ? am * (1.f / 448.f) : 1.f, is = 1.f / sc;
            int pk = __builtin_amdgcn_cvt_pk_fp8_f32(wv[q][0] * is, wv[q][1] * is, 0, false);
            pk = __builtin_amdgcn_cvt_pk_fp8_f32(wv[q][2] * is, wv[q][3] * is, pk, true);
            const int t = tb + 2 * q + hw;
            *(int*)(WQ + (size_t)t * HK + 4 * l5) = pk;
            if (l5 == 0) WSC[t] = sc;
        }
    }
}
typedef int v2i_t __attribute__((ext_vector_type(2)));
typedef unsigned u32x4_t __attribute__((ext_vector_type(4)));
typedef __attribute__((ext_vector_type(4))) float f32x4;
constexpr int GV_PIECE = 1024 + 16;
constexpr int GV_TILE = 16 * GV_PIECE;
static_assert(NW * GV_TILE + NW * 512 <= LDS_TOTAL, "gv LDS");
__device__ __forceinline__ void phase_gv(const Params& P, int l, const volatile int* xi, char* lds) {
    const int* EXPp = (const int*)(P.ws + WS_EXP);
    const unsigned char* WQ = P.ws + WS_WQ8;
    const float* WSC = (const float*)(P.ws + WS_WSC);
    const int tid = tidx(), lane = tid & 63, w = __builtin_amdgcn_readfirstlane(tid >> 6), g = lane >> 3, pos = lane & 7;
    int xo_ = 0; asm volatile("" : "+v"(xo_));
    const int j = __builtin_amdgcn_readfirstlane(xi[xo_ + XI_J]), nx = __builtin_amdgcn_readfirstlane(xi[xo_ + XI_NX]), nloc = __builtin_amdgcn_readfirstlane(xi[xo_ + XI_NLOC]), rank = __builtin_amdgcn_readfirstlane(xi[xo_ + XI_RANK]);
    const int t0 = rank * NW + w, st = nloc * NW;
    const int n = (t0 < T) ? (T - t0 + st - 1) / st : 0;
    char* tile = lds + w * GV_TILE;
    float* strip = (float*)(lds + NW * GV_TILE) + w * 128;
    typedef __attribute__((address_space(3))) v2i_t* ldsv2_t;
    const unsigned co = (unsigned)(pos ^ g) << 4;
    const int rr = (lane & 15) >> 1, kq = lane >> 4;
    const int rdo = kq * GV_PIECE + rr * 128 + (lane & 1) * 8;
    const bool row0 = (lane & 15) == 0;
    __syncthreads();
    for (int sl = j; sl < 8 && n > 0; sl += nx) {
        const unsigned char* Vs = P.ws + WS_TABV + ((size_t)(l * 8 + sl) * NEXP) * 128;
        const char* hrow = (const char*)P.out + sl * 256 + 4 * lane;
#define GV_TK(k) (t0 + (((k) < n) ? (k) : (n - 1)) * st)
#define GV_LOADE(S, t) do { S##el = EXPp[(size_t)(t) * HK + lane]; S##eh = EXPp[(size_t)(t) * HK + 64 + lane]; } while (0)
#define GV_ISSUE(R, S) do { _Pragma("unroll") for (int i = 0; i < 16; ++i) { \
            const int e = __builtin_amdgcn_ds_bpermute((((8 * i) & 63) + g) << 2, (i < 8) ? S##el : S##eh); R[i] = *(const u32x4_t*)(Vs + (((unsigned)e << 7) | co)); } } while (0)
#define GV_LOADT(S, kk) do { const int t_ = GV_TK(kk); \
            S##a0 = 0; S##a1 = 0; S##a2 = 0; S##a3 = 0; \
            if (row0) { const long* wp = (const long*)(WQ + (size_t)t_ * HK + kq * 8); S##a0 = wp[0]; S##a1 = wp[4]; S##a2 = wp[8]; S##a3 = wp[12]; } \
            S##ws = ((kk) < n) ? WSC[t_] : 0.f; \
            S##hv = *(const unsigned*)(hrow + (size_t)t_ * (HP * 2)); } while (0)
#define GV_TOKEN(R, S, kk) do { \
            const int t = GV_TK(kk); \
            _Pragma("unroll") for (int i = 0; i < 16; ++i) *(u32x4_t*)(tile + i * GV_PIECE + lane * 16) = R[i]; \
            f32x4 acc[8]; \
            _Pragma("unroll") for (int nt = 0; nt < 8; ++nt) acc[nt] = (f32x4){0.f, 0.f, 0.f, 0.f}; \
            _Pragma("unroll") for (int s4 = 0; s4 < 4; ++s4) { \
                const long av = (s4 == 0) ? S##a0 : (s4 == 1) ? S##a1 : (s4 == 2) ? S##a2 : S##a3; \
                _Pragma("unroll") for (int nt = 0; nt < 8; ++nt) { \
                    const v2i_t bv = __builtin_amdgcn_ds_read_tr8_b64_v2i32((ldsv2_t)(void*)(tile + (4 * s4) * GV_PIECE + rdo + ((nt ^ rr) << 4))); \
                    acc[nt] = __builtin_amdgcn_mfma_f32_16x16x32_fp8_fp8(av, __builtin_bit_cast(long, bv), acc[nt], 0, 0, 0); } } \
            if (lane < 16) { _Pragma("unroll") for (int nt = 0; nt < 8; ++nt) strip[16 * nt + lane] = acc[nt][0]; }        \
            { const float2 o2 = *(const float2*)(strip + 2 * lane); \
              if ((kk) < n) *(unsigned*)(hrow + (size_t)t * (HP * 2)) = pack2(bflo(S##hv) + S##ws * o2.x, bfhi(S##hv) + S##ws * o2.y); } } while (0)
        int Ael, Aeh, Bel, Beh; u32x4_t rA[16], rB[16];
        long Pa0, Pa1, Pa2, Pa3, Qa0, Qa1, Qa2, Qa3; float Pws, Qws; unsigned Phv, Qhv;
        GV_LOADE(A, GV_TK(0)); GV_LOADE(B, GV_TK(1));
        GV_ISSUE(rA, A); GV_LOADT(P, 0);
        for (int k = 0; k < n; k += 2) {
            GV_ISSUE(rB, B); GV_LOADE(A, GV_TK(k + 2)); GV_LOADT(Q, k + 1);
            GV_TOKEN(rA, P, k);
            GV_ISSUE(rA, A); GV_LOADE(B, GV_TK(k + 3)); GV_LOADT(P, k + 2);
            GV_TOKEN(rB, Q, k + 1);
        }
#undef GV_TK
#undef GV_LOADE
#undef GV_ISSUE
#undef GV_LOADT
#undef GV_TOKEN
    }
    __syncthreads();
}
__device__ __forceinline__ void phase_gnorm(const Params& P, int l) {
    const int lane = tidx() & 63, nw = nwave();
    unsigned* xq = (unsigned*)(P.ws + WS_XQ);
    float* xsc = (float*)(P.ws + WS_XS);
    const bf16* Hb = (const bf16*)P.out;
    const float4* g = (const float4*)((l == DEPTH - 1) ? P.norm_final : (P.norm_mix + (l + 1) * D));
    for (int t = gwave(); t < T; t += 2 * nw) {
        const int t2 = (t + nw < T) ? (t + nw) : t;
        float4 v[2][4];
#pragma unroll
        for (int q = 0; q < 4; ++q) {
            const uint2 a = ((const uint2*)(Hb + (size_t)t * HP))[q * 64 + lane], b = ((const uint2*)(Hb + (size_t)t2 * HP))[q * 64 + lane];
            v[0][q] = make_float4(bflo(a.x), bfhi(a.x), bflo(a.y), bfhi(a.y)); v[1][q] = make_float4(bflo(b.x), bfhi(b.x), bflo(b.y), bfhi(b.y));
        }
#pragma unroll
        for (int u = 0; u < 2; ++u) {
            float ss = 0.f;
#pragma unroll
            for (int q = 0; q < 4; ++q) ss += v[u][q].x * v[u][q].x + v[u][q].y * v[u][q].y + v[u][q].z * v[u][q].z + v[u][q].w * v[u][q].w;
            ss = wave_sum(ss);
            const float rn = rsqrtf(ss * (1.f / D) + EPS);
            const int tt = u ? t2 : t;
            if (u == 0 || t2 != t) {
                float4* hr = (float4*)(P.out + (size_t)tt * D);
                float am = 0.f;
#pragma unroll
                for (int q = 0; q < 4; ++q) {
                    const float4 gg = g[q * 64 + lane];
                    v[u][q] = make_float4(v[u][q].x * rn * gg.x, v[u][q].y * rn * gg.y, v[u][q].z * rn * gg.z, v[u][q].w * rn * gg.w);
                    am = fmaxf(am, fmaxf(fmaxf(fabsf(v[u][q].x), fabsf(v[u][q].y)), fmaxf(fabsf(v[u][q].z), fabsf(v[u][q].w))));
                    if (l == DEPTH - 1) hr[q * 64 + lane] = v[u][q];
                }
                if (l != DEPTH - 1) {
#pragma unroll
                    for (int m = 32; m >= 1; m >>= 1) am = fmaxf(am, __shfl_xor(am, m, 64));
                    const float sc = (am > 0.f) ? am * (1.f / 127.f) : 1.f, is = 1.f / sc;
#pragma unroll
                    for (int q = 0; q < 4; ++q) xq[(size_t)tt * (XQP / 4) + q * 64 + lane] = pack_i8x4(v[u][q].x * is, v[u][q].y * is, v[u][q].z * is, v[u][q].w * is);
                    if (lane == 0) xsc[tt] = sc;
                }
            }
        }
    }
}

#define XB_TMO      128
#define XB_XCNT(j)  (256  + 64 * (j))
#define XB_XSUB(j)  (1280 + 64 * (j))
#define XB_XGEN(j)  (2304 + 64 * (j))
#define XB_TOP      3328
#define XB_TOPGEN   3392
#define XCD_BAR_WORDS 3456
#define XB_SPIN_CAP (1u << 22)
#define LAS __attribute__((address_space(3)))
__device__ __forceinline__ unsigned xb_ld(unsigned* p)              { return __hip_atomic_load(p, __ATOMIC_RELAXED, __HIP_MEMORY_SCOPE_AGENT); }
__device__ __forceinline__ unsigned xb_add(unsigned* p, unsigned v) { return __hip_atomic_fetch_add(p, v, __ATOMIC_RELAXED, __HIP_MEMORY_SCOPE_AGENT); }
__device__ __forceinline__ unsigned xb_xcc_id() { return (unsigned)__builtin_amdgcn_s_getreg((3 << 11) | 20) & 0xFu; }
#define XB_SPIN(cond, bar) do { unsigned _sp = 0; while (cond) { __builtin_amdgcn_s_sleep(1); \
    if ((++_sp & 255u) == 0u) { if (xb_ld(&(bar)[XB_TMO])) break; if (_sp > XB_SPIN_CAP) { atomicAdd(&(bar)[XB_TMO], 1u); break; } } } } while (0)
struct XcdBarrier { unsigned* bar; unsigned x; volatile LAS unsigned* st; };
__device__ __forceinline__ XcdBarrier xcd_barrier_post(unsigned* bar, volatile LAS unsigned* st) {
    XcdBarrier b; b.bar = bar; b.x = xb_xcc_id(); b.st = st;
    if (__builtin_amdgcn_workitem_id_x() == 0) (void)xb_add(&bar[XB_XCNT(b.x)], 1u);
    return b;
}
__device__ __forceinline__ void xcd_barrier_complete(unsigned* bar, unsigned x, unsigned& nloc, unsigned& nx) {
    const unsigned G = gridDim.x * gridDim.y * gridDim.z;
    unsigned sum, cnt, mine, sp = 0u;
    for (;;) {
        sum = 0u; cnt = 0u; mine = 0u;
#pragma unroll
        for (unsigned j = 0; j < 16; ++j) { const unsigned c = xb_ld(&bar[XB_XCNT(j)]); sum += c; cnt += (c > 0u) ? 1u : 0u; mine = (j == x) ? c : mine; }
        if (sum == G) break;
        __builtin_amdgcn_s_sleep(1);
        if ((++sp & 255u) == 0u) { if (xb_ld(&bar[XB_TMO])) break; if (sp > XB_SPIN_CAP) { atomicAdd(&bar[XB_TMO], 1u); break; } }
    }
    nloc = mine > 0u ? mine : 1u; nx = cnt > 0u ? cnt : 1u;
}
__device__ __forceinline__ void xcd_barrier(const XcdBarrier& b) {
    asm volatile("s_waitcnt vmcnt(0)" ::: "memory");
    __syncthreads();
    if (__builtin_amdgcn_workitem_id_x() == 0) {
        unsigned* bar = b.bar;
        __builtin_amdgcn_s_waitcnt(0);
        unsigned nloc = b.st[0], nx = b.st[1];
        if (nloc == 0u) { xcd_barrier_complete(bar, b.x, nloc, nx); b.st[0] = nloc; b.st[1] = nx; }
        const unsigned old = xb_add(&bar[XB_XSUB(b.x)], 1u);
        const unsigned gen = old / nloc;
        if (old + 1u == (gen + 1u) * nloc) {
            __builtin_amdgcn_fence(__ATOMIC_RELEASE, "agent");
            asm volatile("s_waitcnt vmcnt(0)" ::: "memory");
            const unsigned og = xb_add(&bar[XB_TOP], 1u);
            const unsigned tg = og / nx;
            if (og + 1u == (tg + 1u) * nx) xb_add(&bar[XB_TOPGEN], 1u);
            else XB_SPIN(xb_ld(&bar[XB_TOPGEN]) == tg, bar);
            __builtin_amdgcn_fence(__ATOMIC_ACQUIRE, "agent");
            xb_add(&bar[XB_XGEN(b.x)], 1u);
            asm volatile("s_waitcnt vmcnt(0)" ::: "memory");
        } else {
            XB_SPIN(xb_ld(&bar[XB_XGEN(b.x)]) == gen, bar);
            __builtin_amdgcn_fence(__ATOMIC_ACQUIRE, "agent");
            asm volatile("s_waitcnt vmcnt(0)" ::: "memory");
        }
    }
    __syncthreads();
}

constexpr float QSCALE = 0.10206207261596575f * 1.4426950408889634f;

__device__ __forceinline__ void phase_gemm1(const Params& P, int l, char* lds) {
    unsigned char* ws = P.ws;
    const bf16* XN = (const bf16*)(ws + WS_XN);
    bf16* PROJ = (bf16*)(ws + WS_PROJ);
    bf16* Kb = (bf16*)(ws + WS_K);
    const float* rope = (const float*)(ws + WS_ROPE);
    const bf16* W = (const bf16*)(ws + WS_WIN) + (size_t)l * DINP * LDW;
    float* SSQ = (float*)(ws + WS_SSQ);
    const int lane = tidx() & 63;
    const bf16* W8 = (const bf16*)(ws + WS_WI8 + (size_t)l * DINP * XQP);
    const bf16* XQb = (const bf16*)(ws + WS_XQ);
    const float* XSc = (const float*)(ws + WS_XS);
    const float* WIS = (const float*)(ws + WS_WIS) + (size_t)l * DINP;
    int tlo, thi, tst; tile_rounds((T / 256) * (DINP / 256), tlo, thi, tst);
    gemm_t8<true, false, true>(W8, XQP / 2, DINP, XQb, XQP / 2, D / 2, tlo, thi, tst, [&](int t, int n, const float4& v, const float4&) {
        const int nb = __builtin_amdgcn_readfirstlane(n);
        if (nb < C_KR) {
            uint2 o; o.x = cvtpk(v.x, v.y); o.y = cvtpk(v.z, v.w);
            *(uint2*)(PROJ + (size_t)t * DINP + n) = o;
            if (nb >= C_CQ) {
                float q = v.x * v.x + v.y * v.y + v.z * v.z + v.w * v.w;
                q += __shfl_xor(q, 1, 64); q += __shfl_xor(q, 2, 64); q += __shfl_xor(q, 4, 64); q += __shfl_xor(q, 8, 64);
                if (n == nb) SSQ[(size_t)t * 16 + ((nb - C_CQ) >> 6)] = q;
            }
        } else if (nb == C_KR) {
            const float4 up = make_float4(__shfl(v.x, lane + 4, 64), __shfl(v.y, lane + 4, 64), __shfl(v.z, lane + 4, 64), __shfl(v.w, lane + 4, 64));
            const float4 dn = make_float4(__shfl(v.x, lane - 4, 64), __shfl(v.y, lane - 4, 64), __shfl(v.z, lane - 4, 64), __shfl(v.w, lane - 4, 64));
            const int d = n - C_KR;
            if (d < 32) {
                const int b = t / S, s = t % S;
                const bool first = d < 16;
                const int f = first ? d : (d - 16);
                const float4 cs0 = *(const float4*)(rope + ((size_t)s * 16 + f) * 2), cs1 = *(const float4*)(rope + ((size_t)s * 16 + f) * 2 + 4);
                float4 o;
                if (first) o = make_float4(v.x * cs0.x - up.x * cs0.y, v.y * cs0.z - up.y * cs0.w, v.z * cs1.x - up.z * cs1.y, v.w * cs1.z - up.w * cs1.w);
                else       o = make_float4(v.x * cs0.x + dn.x * cs0.y, v.y * cs0.z + dn.y * cs0.w, v.z * cs1.x + dn.z * cs1.y, v.w * cs1.z + dn.w * cs1.w);
                uint2 u; u.x = cvtpk(o.x, o.y); u.y = cvtpk(o.z, o.w);
#pragma unroll
                for (int h = 0; h < NH; ++h) *(uint2*)(Kb + ((size_t)(b * NH + h) * S + s) * DQK + 64 + d) = u;
            }
        }
    }, [&](int t) { return XSc[t]; }, [](int, int) { return make_float4(0.f, 0.f, 0.f, 0.f); }, [&](int n) { return *(const float4*)(WIS + n); }, lds);
}
__device__ __forceinline__ void phase_gemm2(const Params& P, int l, char* lds) {
    unsigned char* ws = P.ws;
    const bf16* PROJ = (const bf16*)(ws + WS_PROJ);
    const float* rope = (const float*)(ws + WS_ROPE);
    const float* SSQ = (const float*)(ws + WS_SSQ);
    const int G = gridDim.x, bid = blockIdx.x;
    const int vb = ((G & 7) == 0) ? ((bid & 7) * (G >> 3) + (bid >> 3)) : bid;
    int qlo, qhi, klo, khi;
    if ((G & 1) == 0) {
        const int Gh = G >> 1, pq = (384 + Gh - 1) / Gh, pk = (512 + Gh - 1) / Gh;
        if (vb < Gh) { qlo = vb * pq; qhi = qlo + pq; if (qhi > 384) qhi = 384; if (qlo > 384) qlo = 384; klo = 0; khi = 0; }
        else { klo = (vb - Gh) * pk; khi = klo + pk; if (khi > 512) khi = 512; if (klo > 512) klo = 512; qlo = 0; qhi = 0; }
    } else { tile_range(384, qlo, qhi); tile_range(512, klo, khi); }
    {
        const bf16* W = (const bf16*)(ws + WS_WUQ) + (size_t)l * 768 * QR;
        bf16* Qb = (bf16*)(ws + WS_Q);
        gemm_t8<true, false, false>(W, QR, 768, PROJ + C_CQ, DINP, QR, qlo, qhi, 1,
            [&](int t, int n, const float4& v, const float4&) {
                const int b = t / S, s = t % S, h = n / DQK, d = n % DQK;
                float4 o = v;
                const int lane = tidx() & 63;
                const float4 up = make_float4(__shfl(v.x, lane + 4, 64), __shfl(v.y, lane + 4, 64), __shfl(v.z, lane + 4, 64), __shfl(v.w, lane + 4, 64));
                const float4 dn = make_float4(__shfl(v.x, lane - 4, 64), __shfl(v.y, lane - 4, 64), __shfl(v.z, lane - 4, 64), __shfl(v.w, lane - 4, 64));
                if (d >= 64) {
                    const bool first = d < 80;
                    const int f = first ? (d - 64) : (d - 80);
                    const float4 cs0 = *(const float4*)(rope + ((size_t)s * 16 + f) * 2), cs1 = *(const float4*)(rope + ((size_t)s * 16 + f) * 2 + 4);
                    if (first) o = make_float4(v.x * cs0.x - up.x * cs0.y, v.y * cs0.z - up.y * cs0.w, v.z * cs1.x - up.z * cs1.y, v.w * cs1.z - up.w * cs1.w);
                    else       o = make_float4(v.x * cs0.x + dn.x * cs0.y, v.y * cs0.z + dn.y * cs0.w, v.z * cs1.x + dn.z * cs1.y, v.w * cs1.z + dn.w * cs1.w);
                }
                uint2 u; u.x = cvtpk(o.x, o.y); u.y = cvtpk(o.z, o.w);
                *(uint2*)(Qb + ((size_t)(b * NH + h) * S + s) * DQK + d) = u;
            }, [&](int t) { const float4 a = *(const float4*)(SSQ + (size_t)t * 16); const float2 b = *(const float2*)(SSQ + (size_t)t * 16 + 4);
                            return rsqrtf(((a.x + a.y) + (a.z + a.w) + (b.x + b.y)) * (1.f / QR) + EPS) * QSCALE; }, [](int, int) { return make_float4(0.f, 0.f, 0.f, 0.f); }, [](int) { return make_float4(1.f, 1.f, 1.f, 1.f); }, lds);
    }
    {
        const bf16* W = (const bf16*)(ws + WS_WUKV) + (size_t)l * 1024 * KVR;
        bf16* Kb = (bf16*)(ws + WS_K); bf16* Vb = (bf16*)(ws + WS_V);
        gemm_t8<true, false, false>(W, KVR, 1024, PROJ + C_CKV, DINP, KVR, klo, khi, 1,
            [&](int t, int n, const float4& v, const float4&) {
                const int b = t / S, s = t % S;
                uint2 u; u.x = cvtpk(v.x, v.y); u.y = cvtpk(v.z, v.w);
                if (n < 512) *(uint2*)(Kb + ((size_t)(b * NH + (n >> 6)) * S + s) * DQK + (n & 63)) = u;
                else         *(uint2*)(Vb + ((size_t)(b * NH + ((n - 512) >> 6)) * S + s) * DV + (n & 63)) = u;
            }, [&](int t) { const float2 a = *(const float2*)(SSQ + (size_t)t * 16 + 6); const float2 b = *(const float2*)(SSQ + (size_t)t * 16 + 8);
                            return rsqrtf(((a.x + a.y) + (b.x + b.y)) * (1.f / KVR) + EPS); }, [](int, int) { return make_float4(0.f, 0.f, 0.f, 0.f); }, [](int) { return make_float4(1.f, 1.f, 1.f, 1.f); }, lds);
    }
}
constexpr size_t WS_YO = WS_PROJ;
__device__ __forceinline__ void phase_gemm3(const Params& P, int l, char* lds) {
    unsigned char* ws = P.ws;
    const bf16* Yb = (const bf16*)(ws + WS_XN);
    const bf16* W = (const bf16*)(ws + WS_WOUT) + (size_t)l * D * LDW;
    bf16* YO = (bf16*)(ws + WS_YO);
    int tlo, thi, tst; tile_rounds((T / 256) * (D / 256), tlo, thi, tst);
    gemm_t8<false, false, false>(W, LDW, D, Yb, LDX, D, tlo, thi, tst, [&](int t, int n, const float4& v, const float4&) {
        uint2 o; o.x = cvtpk(v.x, v.y); o.y = cvtpk(v.z, v.w);
        *(uint2*)(YO + (size_t)t * D + n) = o;
    }, [](int) { return 1.f; }, [](int, int) { return make_float4(0.f, 0.f, 0.f, 0.f); }, [](int) { return make_float4(1.f, 1.f, 1.f, 1.f); }, lds);
}

#define GSYNC() do { XcdBarrier xb_; { __attribute__((address_space(1))) char* gp_ = (__attribute__((address_space(1))) char*)(char*)(P.ws + WS_CTL); asm volatile("" : "+s"(gp_)); xb_.bar = (unsigned*)(char*)gp_; } \
    xb_.x = xb_xcc_id(); xb_.st = (volatile LAS unsigned*)&xb_words; xcd_barrier(xb_); } while (0)
#define PHASE(stmt) { const Params Q = launder(P); stmt; }
__global__ void __launch_bounds__(NTHREADS, 2) k_all(Params P) {
    __shared__ __attribute__((aligned(16))) char sm[LDS_TOTAL];
    __shared__ uint4 xb_words;
    cg::grid_group grid = cg::this_grid();
    if (__builtin_amdgcn_workitem_id_x() == 0) xb_words = make_uint4(0u, 0u, 0u, 0u);
    __syncthreads();
    (void)xcd_barrier_post((unsigned*)(P.ws + WS_CTL), (volatile LAS unsigned*)&xb_words);
    __shared__ int xinfo[8];
    if (__builtin_amdgcn_workitem_id_x() == 0) {
        const unsigned x = xb_xcc_id();
        xinfo[XI_X] = (int)x; xinfo[XI_RANK] = (int)xb_add((unsigned*)(P.ws + WS_CTL) + CTL_CENSUS + x, 1u);
    }
    PHASE(phase_prep(Q, sm));
    if (P.ws == nullptr) grid.sync();
    GSYNC();
    PHASE(phase_norm(Q.x, Q.norm_mix, (unsigned*)(Q.ws + WS_XQ), (float*)(Q.ws + WS_XS)));
    PHASE(quant_wrows((const bf16*)(Q.ws + WS_WPQ), DEPTH * 2048, Q.ws + WS_WC8, (float*)(Q.ws + WS_WCS)));
    PHASE(quant_wrows((const bf16*)(Q.ws + WS_WIN), DEPTH * DINP, Q.ws + WS_WI8, (float*)(Q.ws + WS_WIS)));
    GSYNC();
    if (__builtin_amdgcn_workitem_id_x() == 0) {
        unsigned* cen = (unsigned*)(P.ws + WS_CTL) + CTL_CENSUS;
        const int x = xinfo[XI_X]; int nx = 0, jj = 0;
        for (int q = 0; q < 16; ++q) { const unsigned cq = xb_ld(cen + q); if (cq) { if (q < x) ++jj; ++nx; } }
        xinfo[XI_J] = jj; xinfo[XI_NX] = nx; xinfo[XI_NLOC] = (int)xb_ld(cen + x);
    }
    __syncthreads();
    for (int l = 0; l < DEPTH; ++l) {
        PHASE(phase_gemm1(Q, l, sm));
#if PROBE_DUP & 2
        PHASE(phase_gemm1(Q, l, sm));
#endif
        GSYNC();
        PHASE(phase_mixlocal(Q, l, sm));
#if PROBE_DUP & 256
        PHASE(phase_mixlocal(Q, l, sm));
#endif
        PHASE(phase_gemm2(Q, l, sm));
#if PROBE_DUP & 4
        PHASE(phase_gemm2(Q, l, sm));
#endif
        GSYNC();
        PHASE(phase_attn(Q, sm));
#if PROBE_DUP & 8
        PHASE(phase_attn(Q, sm));
#endif
        GSYNC();
        PHASE(phase_gemm3(Q, l, sm));
#if PROBE_DUP & 16
        if (l == 0) PHASE(phase_gemm3(Q, l, sm));
#endif
        GSYNC();
        PHASE(phase_norm_q(Q, l));
#if PROBE_DUP & 512
        PHASE(phase_norm_q(Q, l));
#endif
        GSYNC();
        PHASE(phase_route(Q, l, sm));
#if PROBE_DUP & 32
        PHASE(phase_route(Q, l, sm));
#endif
        GSYNC();
        PHASE(phase_gu(Q, l, xinfo));
#if PROBE_DUP & 64
        PHASE(phase_gu(Q, l, xinfo));
#endif
        GSYNC();
        PHASE(phase_gw(Q, l));
#if PROBE_DUP & 128
        PHASE(phase_gw(Q, l));
#endif
        GSYNC();
        PHASE(phase_gv(Q, l, xinfo, sm));
        GSYNC();
        PHASE(phase_gnorm(Q, l));
        if (l + 1 < DEPTH) GSYNC();
    }
}

extern "C" void kernel_launch(void* const* d_in, const int* in_sizes, int n_in, void* d_out, int out_size, void* d_ws, size_t ws_size, hipStream_t stream) {
    static int grid = 0;
    if (grid == 0) {
        if (n_in != 18 || out_size != T * D || ws_size < WS_END) { fprintf(stderr, "kernel_launch: bad sizes n_in %d out %d ws %zu need %zu\n", n_in, out_size, ws_size, (size_t)WS_END); grid = -1; return; }
        int dev = 0, cus = 0, per_cu = 0;
        (void)hipGetDevice(&dev);
        (void)hipDeviceGetAttribute(&cus, hipDeviceAttributeMultiprocessorCount, dev);
        (void)hipOccupancyMaxActiveBlocksPerMultiprocessor(&per_cu, (const void*)k_all, NTHREADS, 0);
        if (per_cu > 1) per_cu = 1;
        if (per_cu < 1) { fprintf(stderr, "kernel_launch: occupancy query says %d\n", per_cu); grid = -1; return; }
        grid = cus * per_cu;
    }
    if (grid < 0) return;
    Params p{};
    p.x = (const float*)d_in[0]; p.norm_mix = (const float*)d_in[1]; p.w_in = (const float*)d_in[2]; p.conv_w = (const float*)d_in[3];
    p.pool_w = (const float*)d_in[4]; p.pool_scale = (const float*)d_in[5]; p.q_norm = (const float*)d_in[6]; p.w_uq = (const float*)d_in[7];
    p.kv_norm = (const float*)d_in[8]; p.w_uk = (const float*)d_in[9]; p.w_uv = (const float*)d_in[10]; p.w_out = (const float*)d_in[11];
    p.norm_ffn = (const float*)d_in[12]; p.peer_wq = (const float*)d_in[13]; p.peer_subkeys = (const float*)d_in[14]; p.peer_u = (const float*)d_in[15];
    p.peer_v = (const float*)d_in[16]; p.norm_final = (const float*)d_in[17];
    p.out = (float*)d_out; p.ws = (unsigned char*)d_ws;
    if (hipMemsetAsync((char*)d_ws + WS_CTL, 0, CTL_BYTES, stream) != hipSuccess) { fprintf(stderr, "kernel_launch: memset failed\n"); return; }
    void* args[] = {&p};
    hipError_t e = hipLaunchCooperativeKernel((const void*)k_all, dim3(grid), dim3(NTHREADS), args, 0, stream);
    if (e != hipSuccess) fprintf(stderr, "cooperative launch failed: %s (grid %d)\n", hipGetErrorString(e), grid);
}
```

```cpp
#include <hip/hip_runtime.h>
#include <type_traits>
#include <hip/hip_cooperative_groups.h>
#include <cstdio>
#include <cstdint>
namespace cg = cooperative_groups;

#ifndef TAB_FP8
#define TAB_FP8 1
#endif
#ifndef PROBE_DUP
#define PROBE_DUP 0
#endif

constexpr int NB = 4, S = 8192, T = NB * S, D = 1024, DEPTH = 2;
constexpr int DIN = 1696, DINP = 1792;
constexpr int C_BG = 0, C_CG = 256, C_HC = 512, C_HP = 768, C_CQ = 1024, C_CKV = 1408, C_KR = 1664;
constexpr int QR = 384, KVR = 256, NH = 8, DQK = 96, DV = 64;
constexpr int PH = 8, NKEY = 128, NEXP = NKEY * NKEY, TOPK = 16, HK = PH * TOPK;
constexpr float EPS = 1e-6f;
constexpr int LDX = 1088;
constexpr int LDW = 1088;

typedef unsigned short bf16;
constexpr int HP = 2 * D;

constexpr size_t WS_CTL   = 0;
constexpr size_t WS_ROPE  = 64 * 1024;
constexpr size_t WS_WIN   = WS_ROPE + (size_t)S * 16 * 2 * 4;
constexpr size_t WS_WUQ   = WS_WIN + (size_t)DEPTH * DINP * LDW * 2;
constexpr size_t WS_WUKV  = WS_WUQ + (size_t)DEPTH * 768 * QR * 2;
constexpr size_t WS_WOUT  = WS_WUKV + (size_t)DEPTH * 1024 * KVR * 2;
constexpr size_t WS_WPQ   = WS_WOUT + (size_t)DEPTH * D * LDW * 2;
constexpr size_t WS_XN    = ((WS_WPQ + (size_t)DEPTH * 2048 * LDW * 2 + 4095) / 4096) * 4096;
constexpr size_t WS_PROJ  = WS_XN + (size_t)T * LDX * 2;
constexpr size_t WS_Q     = WS_PROJ + (size_t)T * DINP * 2;
constexpr size_t WS_K     = WS_Q + (size_t)T * NH * DQK * 2;
constexpr size_t WS_V     = WS_K + (size_t)T * NH * DQK * 2;
constexpr size_t WS_EXP   = WS_V + (size_t)T * NH * DV * 2;
constexpr size_t WS_GATE  = WS_EXP + (size_t)T * HK * 4;
constexpr size_t TAB_ROWB = TAB_FP8 ? 1024 : 2048;
constexpr size_t WS_TABU  = WS_GATE + (size_t)T * HK * 4;
constexpr size_t WS_TABV  = WS_TABU + (size_t)DEPTH * NEXP * TAB_ROWB;
constexpr size_t WS_TSCU  = WS_TABV + (size_t)DEPTH * NEXP * TAB_ROWB;
constexpr size_t WS_TSCV  = WS_TSCU + (size_t)DEPTH * NEXP * 4;
constexpr size_t WS_XQ    = WS_TSCV + (size_t)DEPTH * NEXP * 4;
constexpr int XQP = 1088;
constexpr size_t WS_XS    = WS_XQ + (size_t)T * XQP;
constexpr size_t WS_WQ8   = WS_XS + (size_t)T * 4;
constexpr size_t WS_WSC   = WS_WQ8 + (size_t)T * HK;
constexpr size_t WS_SSQ   = WS_WSC + (size_t)T * 4;
constexpr size_t WS_WC8   = WS_SSQ + (size_t)T * 64;
constexpr size_t WS_WCS   = WS_WC8 + (size_t)DEPTH * 2048 * XQP;
constexpr size_t WS_WI8   = WS_WCS + (size_t)DEPTH * 2048 * 4;
constexpr size_t WS_WIS   = WS_WI8 + (size_t)DEPTH * DINP * XQP;
constexpr size_t WS_END   = WS_WIS + (size_t)DEPTH * DINP * 4;
static_assert(WS_END <= (size_t)512 * 1024 * 1024, "workspace budget");

struct Params {
    const float* x; const float* norm_mix; const float* w_in; const float* conv_w; const float* pool_w; const float* pool_scale;
    const float* q_norm; const float* w_uq; const float* kv_norm; const float* w_uk; const float* w_uv; const float* w_out;
    const float* norm_ffn; const float* peer_wq; const float* peer_subkeys; const float* peer_u; const float* peer_v; const float* norm_final;
    float* out; unsigned char* ws;
};

__device__ __forceinline__ bf16 f2bf(float f) { unsigned u = __float_as_uint(f); u += 0x7fffu + ((u >> 16) & 1u); return (bf16)(u >> 16); }
__device__ __forceinline__ float bf2f(bf16 h) { return __uint_as_float(((unsigned)h) << 16); }
__device__ __forceinline__ float bflo(unsigned u) { return __uint_as_float(u << 16); }
__device__ __forceinline__ float bfhi(unsigned u) { return __uint_as_float(u & 0xffff0000u); }
__device__ __forceinline__ unsigned pack2(float a, float b) { return (unsigned)f2bf(a) | ((unsigned)f2bf(b) << 16); }
__device__ __forceinline__ float wave_sum(float v) {
#pragma unroll
    for (int m = 32; m >= 1; m >>= 1) v += __shfl_xor(v, m, 64);
    return v;
}
__device__ __forceinline__ float gelu_exact(float x) { return 0.5f * x * (1.f + erff(x * 0.70710678118654752f)); }

#define NTHREADS 512
constexpr int NW = NTHREADS / 64;
__device__ __forceinline__ int tidx() { int t = (int)__builtin_amdgcn_workitem_id_x(); asm volatile("" : "+v"(t)); return t; }
__device__ __forceinline__ int gwave() { return blockIdx.x * (NTHREADS / 64) + (tidx() >> 6); }
__device__ __forceinline__ int nwave() { return gridDim.x * (NTHREADS / 64); }
__device__ __forceinline__ size_t gtid() { return (size_t)blockIdx.x * NTHREADS + tidx(); }
__device__ __forceinline__ size_t gnth() { return (size_t)gridDim.x * NTHREADS; }


__device__ __forceinline__ Params launder(const Params& P) {
    typedef __attribute__((address_space(1))) char* gp_t;
    gp_t g[20] = {(gp_t)(char*)P.x, (gp_t)(char*)P.norm_mix, (gp_t)(char*)P.w_in, (gp_t)(char*)P.conv_w, (gp_t)(char*)P.pool_w, (gp_t)(char*)P.pool_scale, (gp_t)(char*)P.q_norm, (gp_t)(char*)P.w_uq,
                  (gp_t)(char*)P.kv_norm, (gp_t)(char*)P.w_uk, (gp_t)(char*)P.w_uv, (gp_t)(char*)P.w_out, (gp_t)(char*)P.norm_ffn, (gp_t)(char*)P.peer_wq, (gp_t)(char*)P.peer_subkeys,
                  (gp_t)(char*)P.peer_u, (gp_t)(char*)P.peer_v, (gp_t)(char*)P.norm_final, (gp_t)(char*)P.out, (gp_t)(char*)P.ws};
    asm volatile("" : "+s"(g[0]), "+s"(g[1]), "+s"(g[2]), "+s"(g[3]), "+s"(g[4]), "+s"(g[5]), "+s"(g[6]), "+s"(g[7]), "+s"(g[8]), "+s"(g[9]));
    asm volatile("" : "+s"(g[10]), "+s"(g[11]), "+s"(g[12]), "+s"(g[13]), "+s"(g[14]), "+s"(g[15]), "+s"(g[16]), "+s"(g[17]), "+s"(g[18]), "+s"(g[19]));
    Params Q;
    Q.x = (const float*)(char*)g[0]; Q.norm_mix = (const float*)(char*)g[1]; Q.w_in = (const float*)(char*)g[2]; Q.conv_w = (const float*)(char*)g[3]; Q.pool_w = (const float*)(char*)g[4];
    Q.pool_scale = (const float*)(char*)g[5]; Q.q_norm = (const float*)(char*)g[6]; Q.w_uq = (const float*)(char*)g[7]; Q.kv_norm = (const float*)(char*)g[8]; Q.w_uk = (const float*)(char*)g[9];
    Q.w_uv = (const float*)(char*)g[10]; Q.w_out = (const float*)(char*)g[11]; Q.norm_ffn = (const float*)(char*)g[12]; Q.peer_wq = (const float*)(char*)g[13]; Q.peer_subkeys = (const float*)(char*)g[14];
    Q.peer_u = (const float*)(char*)g[15]; Q.peer_v = (const float*)(char*)g[16]; Q.norm_final = (const float*)(char*)g[17]; Q.out = (float*)(char*)g[18]; Q.ws = (unsigned char*)(char*)g[19];
    return Q;
}

typedef __attribute__((ext_vector_type(8))) short bf16x8;
typedef __attribute__((ext_vector_type(16))) float f32x16;
typedef __attribute__((ext_vector_type(2))) __bf16 bf2_t;
#define MFMA32(a, b, c) __builtin_amdgcn_mfma_f32_32x32x16_bf16(a, b, c, 0, 0, 0)
__device__ __forceinline__ int crow(int r, int hi) { return (r & 3) + 8 * (r >> 2) + 4 * hi; }
__device__ __forceinline__ float dot2bf(unsigned a, unsigned b, float c) { return __builtin_amdgcn_fdot2_f32_bf16(__builtin_bit_cast(bf2_t, a), __builtin_bit_cast(bf2_t, b), c, false); }
__device__ __forceinline__ unsigned cvtpk(float lo, float hi) { unsigned r; asm("v_cvt_pk_bf16_f32 %0, %1, %2" : "=v"(r) : "v"(lo), "v"(hi)); return r; }
constexpr int LDS_TOTAL = 140 * 1024;

template <int WT, bool ROWSS>
__device__ __forceinline__ void gemm_kloop(const bf16* __restrict__ Ag0, int lda, const bf16* __restrict__ Bg0, int ldb, int nk, f32x16 (&acc)[8], float (&ss)[4], char* lds, int tid) {
    constexpr int BROWS = (WT == 0) ? 256 : 128, NPB = BROWS / 64;
    constexpr int OPA = 256 * 128, G_BUF = OPA + BROWS * 128;
    const int lane = tid & 63, w = __builtin_amdgcn_readfirstlane(tid >> 6), r32 = lane & 31, hi = lane >> 5;
    const int srow = 8 * w + (lane >> 3);
    const int sch = (lane & 7) ^ ((srow >> 1) & 7);
    const bf16* Ag = Ag0 + (size_t)srow * lda + sch * 8;
    const bf16* Bg = Bg0 + (size_t)srow * ldb + sch * 8;
#pragma unroll
    for (int i = 0; i < 8; ++i)
#pragma unroll
        for (int r = 0; r < 16; ++r) acc[i][r] = 0.f;
    ss[0] = 0.f; ss[1] = 0.f; ss[2] = 0.f; ss[3] = 0.f;
    typedef __attribute__((address_space(3))) unsigned* ldsp_t;
    typedef const __attribute__((address_space(1))) unsigned* glbp_t;
#define G_DMA(buf, kofs) do { char* d_ = lds + (buf) * G_BUF + (8 * w) * 128; \
    _Pragma("unroll") for (int i = 0; i < 4; ++i) \
        __builtin_amdgcn_global_load_lds((glbp_t)(const void*)(Ag + (size_t)(64 * i) * lda + (kofs)), (ldsp_t)(void*)(d_ + i * 8192), 16, 0, 0); \
    _Pragma("unroll") for (int i = 0; i < NPB; ++i) \
        __builtin_amdgcn_global_load_lds((glbp_t)(const void*)(Bg + (size_t)(64 * i) * ldb + (kofs)), (ldsp_t)(void*)(d_ + OPA + i * 8192), 16, 0, 0); } while (0)
    const int xr = (r32 >> 1) & 7;
    const int o0 = ((0 + hi) ^ xr) << 4, o1 = ((2 + hi) ^ xr) << 4, o2 = ((4 + hi) ^ xr) << 4, o3 = ((6 + hi) ^ xr) << 4;
#define G_SS(s_, r_) do { union { bf16x8 v; uint4 u; } c_; c_.v = r_; s_ = dot2bf(c_.u.x, c_.u.x, s_); s_ = dot2bf(c_.u.y, c_.u.y, s_); s_ = dot2bf(c_.u.z, c_.u.z, s_); s_ = dot2bf(c_.u.w, c_.u.w, s_); } while (0)
#define G_STEP(pa, pb, off) do { \
    if (WT == 0) { \
        const bf16x8 a0 = *(const bf16x8*)(pa + off), a1 = *(const bf16x8*)(pa + 32 * 128 + off); \
        const bf16x8 b0 = *(const bf16x8*)(pb + off), b1 = *(const bf16x8*)(pb + 32 * 128 + off), b2 = *(const bf16x8*)(pb + 64 * 128 + off), b3 = *(const bf16x8*)(pb + 96 * 128 + off); \
        if (ROWSS) { G_SS(ss[0], b0); G_SS(ss[1], b1); G_SS(ss[2], b2); G_SS(ss[3], b3); } \
        acc[0] = MFMA32(a0, b0, acc[0]); acc[1] = MFMA32(a0, b1, acc[1]); acc[2] = MFMA32(a0, b2, acc[2]); acc[3] = MFMA32(a0, b3, acc[3]); \
        acc[4] = MFMA32(a1, b0, acc[4]); acc[5] = MFMA32(a1, b1, acc[5]); acc[6] = MFMA32(a1, b2, acc[6]); acc[7] = MFMA32(a1, b3, acc[7]); \
    } else if (WT == 2) { \
        const bf16x8 a0 = *(const bf16x8*)(pa + off), a1 = *(const bf16x8*)(pa + 32 * 128 + off); \
        const bf16x8 b0 = *(const bf16x8*)(pb + off), b1 = *(const bf16x8*)(pb + 32 * 128 + off); \
        if (ROWSS) { G_SS(ss[0], b0); G_SS(ss[1], b1); } \
        acc[0] = MFMA32(a0, b0, acc[0]); acc[1] = MFMA32(a0, b1, acc[1]); acc[2] = MFMA32(a1, b0, acc[2]); acc[3] = MFMA32(a1, b1, acc[3]); \
    } else { \
        const bf16x8 b0 = *(const bf16x8*)(pb + off); \
        const bf16x8 a0 = *(const bf16x8*)(pa + off), a1 = *(const bf16x8*)(pa + 32 * 128 + off); \
        const bf16x8 a2 = *(const bf16x8*)(pa + 64 * 128 + off), a3 = *(const bf16x8*)(pa + 96 * 128 + off); \
        if (ROWSS) { G_SS(ss[0], b0); } \
        acc[0] = MFMA32(a0, b0, acc[0]); acc[1] = MFMA32(a1, b0, acc[1]); \
        acc[2] = MFMA32(a2, b0, acc[2]); acc[3] = MFMA32(a3, b0, acc[3]); \
    } } while (0)
    const int arow = (WT == 1) ? ((w >> 2) * 128 + r32) : ((w >> 1) * 64 + r32);
    const int brow = (WT == 0) ? ((w & 1) * 128 + r32) : (WT == 2) ? ((w & 1) * 64 + r32) : ((w & 3) * 32 + r32);
    G_DMA(0, 0);
    for (int kt = 0; kt < nk; ++kt) {
        __syncthreads();
        if (kt + 1 < nk) G_DMA((kt + 1) & 1, (kt + 1) * 64);
        const char* pa = lds + (kt & 1) * G_BUF + arow * 128;
        const char* pb = lds + (kt & 1) * G_BUF + OPA + brow * 128;
        G_STEP(pa, pb, o0); G_STEP(pa, pb, o1); G_STEP(pa, pb, o2); G_STEP(pa, pb, o3);
    }
    if (ROWSS) { ss[0] += __shfl_xor(ss[0], 32, 64); ss[1] += __shfl_xor(ss[1], 32, 64); ss[2] += __shfl_xor(ss[2], 32, 64); ss[3] += __shfl_xor(ss[3], 32, 64); }
#undef G_DMA
#undef G_SS
#undef G_STEP
}

__device__ __forceinline__ void tile_range(int ntiles, int& lo, int& hi) {
    const int G = gridDim.x, b = blockIdx.x;
    const int vb = ((G & 7) == 0) ? ((b & 7) * (G >> 3) + (b >> 3)) : b;
    const int per = (ntiles + G - 1) / G;
    lo = vb * per; hi = lo + per; if (hi > ntiles) hi = ntiles;
}
constexpr int ST_P = 68;
static_assert(NW * 64 * ST_P * 4 <= LDS_TOTAL, "staging LDS");
template <bool ROWSS, class EPI, class EPIROW, class RSC>
__device__ __forceinline__ void gemm_t(const bf16* __restrict__ Wt, int ldw, int N, const bf16* __restrict__ X, int ldx, int M, int K, int tn_direct, EPI epi, EPIROW epirow, RSC rowscale, char* lds) {
    const int tid = tidx(), lane = tid & 63, w = tid >> 6, r32 = lane & 31, hi = lane >> 5;
    const int tilesN = N / 256, tilesM = M / 256, nk = K / 64;
    int tlo, thi; tile_range(tilesM * tilesN, tlo, thi);
    for (int tile = tlo; tile < thi; ++tile) {
        const int tm = tile / tilesN, tn = tile % tilesN;
        f32x16 acc[8]; float ss[4];
        gemm_kloop<0, ROWSS>(Wt + (size_t)(tn * 256) * ldw, ldw, X + (size_t)(tm * 256) * ldx, ldx, nk, acc, ss, lds, tid);
        if (tn < tn_direct) {
            __syncthreads();
            float* st = (float*)lds + w * (64 * ST_P);
            const int rr = lane >> 4, ch = lane & 15;
#pragma unroll
            for (int half = 0; half < 2; ++half) {
                const float m0_ = rowscale(ss[2 * half]), m1_ = rowscale(ss[2 * half + 1]);
#pragma unroll
                for (int i = 0; i < 2; ++i)
#pragma unroll
                    for (int jj = 0; jj < 2; ++jj)
#pragma unroll
                        for (int g = 0; g < 4; ++g) {
                            const float mj = jj ? m1_ : m0_;
                            const f32x16& a_ = acc[i * 4 + 2 * half + jj];
                            *(float4*)(st + (32 * jj + r32) * ST_P + 32 * i + 8 * g + 4 * hi) = make_float4(a_[4 * g] * mj, a_[4 * g + 1] * mj, a_[4 * g + 2] * mj, a_[4 * g + 3] * mj);
                        }
#pragma unroll 2
                for (int it = 0; it < 16; ++it) {
                    const int row = it * 4 + rr;
                    const float4 v = *(const float4*)(st + row * ST_P + ch * 4);
                    epirow(tm * 256 + (w & 1) * 128 + half * 64 + row, tn * 256 + (w >> 1) * 64 + ch * 4, v);
                }
            }
        } else {
#pragma unroll
            for (int i = 0; i < 2; ++i)
#pragma unroll
                for (int j = 0; j < 4; ++j)
                    epi(tn * 256 + (w >> 1) * 64 + i * 32, tm * 256 + (w & 1) * 128 + j * 32, acc[i * 4 + j], r32, hi, ss[j]);
        }
        __syncthreads();
    }
}

constexpr int ST1_P = 132;
static_assert(NW * 32 * ST1_P * 4 <= LDS_TOTAL, "staging LDS (128 x 32 wave tiles)");
template <class EPIROW, class RSC>
__device__ __forceinline__ void gemm_t1(const bf16* __restrict__ Wt, int ldw, int N, const bf16* __restrict__ X, int ldx, int M, int K, EPIROW epirow, RSC rowscale, char* lds) {
    const int tid = tidx(), lane = tid & 63, w = tid >> 6, r32 = lane & 31, hi = lane >> 5;
    const int tilesN = N / 256, tilesM = M / 128, nk = K / 64;
    int tlo, thi; tile_range(tilesM * tilesN, tlo, thi);
    for (int tile = tlo; tile < thi; ++tile) {
        const int tm = tile / tilesN, tn = tile % tilesN;
        f32x16 acc[8]; float ss[4];
        gemm_kloop<1, true>(Wt + (size_t)(tn * 256) * ldw, ldw, X + (size_t)(tm * 128) * ldx, ldx, nk, acc, ss, lds, tid);
        __syncthreads();
        float* st = (float*)lds + w * (32 * ST1_P);
        const float mj = rowscale(ss[0]);
#pragma unroll
        for (int mt = 0; mt < 4; ++mt)
#pragma unroll
            for (int g = 0; g < 4; ++g)
                *(float4*)(st + r32 * ST1_P + 32 * mt + 8 * g + 4 * hi) = make_float4(acc[mt][4 * g] * mj, acc[mt][4 * g + 1] * mj, acc[mt][4 * g + 2] * mj, acc[mt][4 * g + 3] * mj);
#pragma unroll 2
        for (int it = 0; it < 16; ++it) {
            const int row = it * 2 + hi;
            const float4 v = *(const float4*)(st + row * ST1_P + r32 * 4);
            epirow(tm * 128 + (w & 3) * 32 + row, tn * 256 + (w >> 2) * 128 + r32 * 4, v);
        }
        __syncthreads();
    }
}

template <class EPIROW>
__device__ __forceinline__ void gemm_t2(const bf16* __restrict__ Wt, int ldw, int N, const bf16* __restrict__ X, int ldx, int M, int K, EPIROW epirow, char* lds) {
    const int tid = tidx(), lane = tid & 63, w = tid >> 6, r32 = lane & 31, hi = lane >> 5;
    const int tilesN = N / 256, tilesM = M / 128, nk = K / 64;
    int tlo, thi; tile_range(tilesM * tilesN, tlo, thi);
    for (int tile = tlo; tile < thi; ++tile) {
        const int tm = tile / tilesN, tn = tile % tilesN;
        f32x16 acc[8]; float ss[4];
        gemm_kloop<2, false>(Wt + (size_t)(tn * 256) * ldw, ldw, X + (size_t)(tm * 128) * ldx, ldx, nk, acc, ss, lds, tid);
        __syncthreads();
        float* st = (float*)lds + w * (64 * ST_P);
#pragma unroll
        for (int i = 0; i < 2; ++i)
#pragma unroll
            for (int j = 0; j < 2; ++j)
#pragma unroll
                for (int g = 0; g < 4; ++g)
                    *(float4*)(st + (32 * j + r32) * ST_P + 32 * i + 8 * g + 4 * hi) = make_float4(acc[i * 2 + j][4 * g], acc[i * 2 + j][4 * g + 1], acc[i * 2 + j][4 * g + 2], acc[i * 2 + j][4 * g + 3]);
        const int rr = lane >> 4, ch = lane & 15;
#pragma unroll 4
        for (int it = 0; it < 16; ++it) {
            const int row = it * 4 + rr;
            const float4 v = *(const float4*)(st + row * ST_P + ch * 4);
            epirow(tm * 128 + (w & 1) * 64 + row, tn * 256 + (w >> 1) * 64 + ch * 4, v);
        }
        __syncthreads();
    }
}

typedef __attribute__((ext_vector_type(4))) float f32x4;
constexpr int G8_HT = 128 * 64;
__device__ __forceinline__ int g8_lds_byte(int r, int c) {
    const int st = (r >> 4) * 2 + (c >> 5), rr = r & 15, cc = c & 31, ob = rr * 64 + cc * 2;
    return st * 1024 + (ob ^ (((ob >> 9) & 1) << 5));
}
__device__ __forceinline__ void g8_stage_rc(int b, int& R, int& C) {
    const int st = b / 1024, sb = b % 1024, swz = sb ^ (((sb >> 9) & 1) << 5);
    R = (st >> 1) * 16 + swz / 64; C = (st & 1) * 32 + (swz % 64) / 2;
}
__device__ __forceinline__ float ssq8(const bf16x8& v, float s) {
    union { bf16x8 v; uint4 u; } c_; c_.v = v;
    s = dot2bf(c_.u.x, c_.u.x, s); s = dot2bf(c_.u.y, c_.u.y, s); s = dot2bf(c_.u.z, c_.u.z, s); return dot2bf(c_.u.w, c_.u.w, s);
}
typedef __attribute__((ext_vector_type(4))) int i32x4;
__device__ __forceinline__ f32x4 mma8(const bf16x8& a, const bf16x8& b, const f32x4& c) { return __builtin_amdgcn_mfma_f32_16x16x32_bf16(a, b, c, 0, 0, 0); }
__device__ __forceinline__ i32x4 mma8(const bf16x8& a, const bf16x8& b, const i32x4& c) { return __builtin_amdgcn_mfma_i32_16x16x64_i8(__builtin_bit_cast(i32x4, a), __builtin_bit_cast(i32x4, b), c, 0, 0, 0); }
template <bool ROWSS, bool APERM = false, class ACC = f32x4>
__device__ __forceinline__ void gemm8_kloop(const bf16* __restrict__ A, int lda, const bf16* __restrict__ Bt, int ldb, int nt, ACC (&acc)[2][2][4][2], float (&ss)[2][2], char* lds, int tid) {
    bf16* shm = (bf16*)lds;
    typedef __attribute__((address_space(3))) unsigned* ldsp_t;
    typedef const __attribute__((address_space(1))) unsigned* glbp_t;
#define SA(b, h) (shm + ((b) * 2 + (h)) * G8_HT)
#define SB(b, h) (shm + (4 + (b) * 2 + (h)) * G8_HT)
    int sr0, sc0; g8_stage_rc(tid * 16, sr0, sc0);
    const unsigned voa = (unsigned)((sr0 * lda + sc0) * 2), vob = (unsigned)((sr0 * ldb + sc0) * 2);
    const char* Ap = (const char*)A; const char* Bp = (const char*)Bt;
    const int wbase = __builtin_amdgcn_readfirstlane(tid >> 6) * 1024;
#define STAGE_(P, BASE, VO, LD, br, r2, kt) do { const char* g_ = BASE + ((size_t)(br) * LD + (kt) * 64) * 2; \
    __builtin_amdgcn_global_load_lds((glbp_t)(const void*)(g_ + VO), (ldsp_t)(void*)((char*)(P) + wbase), 16, 0, 0); \
    __builtin_amdgcn_global_load_lds((glbp_t)(const void*)(g_ + (size_t)(2 * (r2)) * LD + VO), (ldsp_t)(void*)((char*)(P) + wbase + 8192), 16, 0, 0); } while (0)
#define STAGEA(b, h, kt) STAGE_(SA(b, h), Ap, voa, lda, (APERM ? (h) * 64 : (h) * 128), (APERM ? 128 : 64), kt)
#define STAGEB(b, h, kt) STAGE_(SB(b, h), Bp, vob, ldb, (h) * 128, 64, kt)
    const int lane = tid & 63, wid = tid >> 6, wr = wid >> 2, wc = wid & 3, fr = lane & 15, fq = lane >> 4;
    int abase, bbase;
    { const int ob = fr * 64 + fq * 16, lp = ob ^ (((ob >> 9) & 1) << 5);
      abase = lp + wr * 8192; bbase = lp + wc * 4096 + 4 * G8_HT * 2;
      asm volatile("" : "+v"(abase), "+v"(bbase)); }
#define LDA(dst, b, h) _Pragma("unroll") for (int m = 0; m < 4; ++m) _Pragma("unroll") for (int k = 0; k < 2; ++k) \
    dst[m][k] = *reinterpret_cast<const bf16x8*>(lds + abase + (((b) * 2 + (h)) * G8_HT * 2 + m * 2048 + k * 1024))
#define LDB(dst, b, h) _Pragma("unroll") for (int n = 0; n < 2; ++n) _Pragma("unroll") for (int k = 0; k < 2; ++k) \
    dst[n][k] = *reinterpret_cast<const bf16x8*>(lds + bbase + (((b) * 2 + (h)) * G8_HT * 2 + n * 2048 + k * 1024))
#define MMA(ai, bj, At_, Bt_) do { __builtin_amdgcn_s_setprio(1); \
    _Pragma("unroll") for (int m = 0; m < 4; ++m) _Pragma("unroll") for (int n = 0; n < 2; ++n) _Pragma("unroll") for (int k = 0; k < 2; ++k) \
        acc[ai][bj][m][n] = mma8(At_[m][k], Bt_[n][k], acc[ai][bj][m][n]); \
    __builtin_amdgcn_s_setprio(0); } while (0)
#define SSQ(bj, Bt_) do { if (ROWSS) { _Pragma("unroll") for (int n = 0; n < 2; ++n) { ss[bj][n] = ssq8(Bt_[n][0], ss[bj][n]); ss[bj][n] = ssq8(Bt_[n][1], ss[bj][n]); } } } while (0)
#define WAIT_V(n) asm volatile("s_waitcnt vmcnt(" #n ")" ::: "memory")
#define WAIT_L(n) asm volatile("s_waitcnt lgkmcnt(" #n ")" ::: "memory")
#define BAR __builtin_amdgcn_s_barrier()
#define SCHED __builtin_amdgcn_sched_barrier(0)
#pragma unroll
    for (int a = 0; a < 2; ++a)
#pragma unroll
        for (int b = 0; b < 2; ++b)
#pragma unroll
            for (int m = 0; m < 4; ++m)
#pragma unroll
                for (int n = 0; n < 2; ++n) acc[a][b][m][n] = ACC{0, 0, 0, 0};
    ss[0][0] = 0.f; ss[0][1] = 0.f; ss[1][0] = 0.f; ss[1][1] = 0.f;
    bf16x8 At[4][2], B0[2][2], B1[2][2];
    STAGEB(0, 0, 0); STAGEA(0, 0, 0);
    STAGEB(0, 1, 0); STAGEA(0, 1, 0);
    if (wr == 1) BAR;
    WAIT_V(4); BAR;
    STAGEB(1, 0, 1); STAGEA(1, 0, 1); STAGEB(1, 1, 1);
    WAIT_V(6); BAR;
    for (int t = 0; t < nt - 2; t += 2) {
        LDB(B0, 0, 0); SCHED; LDA(At, 0, 0); STAGEA(1, 1, t + 1);
        WAIT_L(8); BAR; WAIT_L(0); MMA(0, 0, At, B0); SSQ(0, B0); BAR; SCHED;
        LDB(B1, 0, 1); STAGEB(0, 0, t + 2);
        BAR; WAIT_L(0); MMA(0, 1, At, B1); SSQ(1, B1); BAR;
        LDA(At, 0, 1); STAGEA(0, 0, t + 2);
        BAR; WAIT_L(0); MMA(1, 0, At, B0); BAR; SCHED;
        STAGEB(0, 1, t + 2);
        WAIT_V(6); BAR; MMA(1, 1, At, B1); BAR;
        LDB(B0, 1, 0); SCHED; LDA(At, 1, 0); STAGEA(0, 1, t + 2);
        WAIT_L(8); BAR; WAIT_L(0); MMA(0, 0, At, B0); SSQ(0, B0); BAR; SCHED;
        LDB(B1, 1, 1); STAGEB(1, 0, t + 3);
        BAR; WAIT_L(0); MMA(0, 1, At, B1); SSQ(1, B1); BAR;
        LDA(At, 1, 1); STAGEA(1, 0, t + 3);
        BAR; WAIT_L(0); MMA(1, 0, At, B0); BAR; SCHED;
        STAGEB(1, 1, t + 3);
        WAIT_V(6); BAR; MMA(1, 1, At, B1); BAR;
    }
    { LDB(B0, 0, 0); LDA(At, 0, 0); STAGEA(1, 1, nt - 1);
      BAR; WAIT_L(0); MMA(0, 0, At, B0); SSQ(0, B0); BAR;
      LDB(B1, 0, 1); BAR; WAIT_L(0); MMA(0, 1, At, B1); SSQ(1, B1); BAR;
      LDA(At, 0, 1); WAIT_V(4); BAR; WAIT_L(0); MMA(1, 0, At, B0); MMA(1, 1, At, B1); BAR; }
    { LDB(B0, 1, 0); LDA(At, 1, 0); WAIT_V(2); BAR; WAIT_L(0); MMA(0, 0, At, B0); SSQ(0, B0); BAR;
      LDB(B1, 1, 1); WAIT_V(0); BAR; WAIT_L(0); MMA(0, 1, At, B1); SSQ(1, B1); BAR;
      LDA(At, 1, 1); BAR; WAIT_L(0); MMA(1, 0, At, B0); MMA(1, 1, At, B1); BAR; }
    if (wr == 0) BAR;
    if (ROWSS) {
#pragma unroll
        for (int b = 0; b < 2; ++b)
#pragma unroll
            for (int n = 0; n < 2; ++n) { ss[b][n] += __shfl_xor(ss[b][n], 16, 64); ss[b][n] += __shfl_xor(ss[b][n], 32, 64); }
    }
#undef SSQ
#undef SA
#undef SB
#undef STAGE_
#undef STAGEA
#undef STAGEB
#undef LDA
#undef LDB
#undef MMA
#undef WAIT_V
#undef WAIT_L
#undef BAR
#undef SCHED
}
__device__ __forceinline__ void tile_rounds(int ntiles, int& lo, int& hi, int& step) {
    const int G = gridDim.x, b = blockIdx.x;
    if ((G & 7) == 0) { const int per = (ntiles + 7) >> 3, x = b & 7; lo = x * per + (b >> 3); hi = (x + 1) * per; if (hi > ntiles) hi = ntiles; step = G >> 3; }
    else { lo = b; hi = ntiles; step = G; }
}
template <bool SCALE, bool PRE, bool I8, class EPIROW, class RSC, class PREF, class CSC>
__device__ __forceinline__ void gemm_t8(const bf16* __restrict__ Wt, int ldw, int N, const bf16* __restrict__ X, int ldx, int K, int tlo, int thi, int tstep, EPIROW epirow, RSC rowscale, PREF pre, CSC colscale, char* lds) {
    typedef typename std::conditional<I8, i32x4, f32x4>::type ACC;
    const int tid = tidx();
    const int tilesN = N / 256; int nt = K / 64;
    asm volatile("" : "+s"(nt));
    for (int tile = tlo; tile < thi; tile += tstep) {
        const int tm = tile / tilesN, tn = tile % tilesN;
        ACC acc[2][2][4][2]; float ss[2][2];
        gemm8_kloop<false, false, ACC>(Wt + (size_t)(tn * 256) * ldw, ldw, X + (size_t)(tm * 256) * ldx, ldx, nt, acc, ss, lds, tid);
        __syncthreads();
        const int te = tidx();
        const int le = te & 63, w = te >> 6, wr = w >> 2, wc = w & 3, fr = le & 15, fq = le >> 4;
        float* st = (float*)lds + w * (32 * ST_P);
        const int rr = le >> 4, ch = le & 15;
        const int tb = tm * 256 + wc * 32 + rr, nb = tn * 256 + wr * 64 + ch * 4;
#pragma unroll
        for (int ai = 0; ai < 2; ++ai)
#pragma unroll
            for (int bj = 0; bj < 2; ++bj) {
                float4 pv[8];
                if (PRE) {
#pragma unroll
                    for (int it = 0; it < 8; ++it) pv[it] = pre(tb + bj * 128 + it * 4, nb + ai * 128);
                }
#pragma unroll
                for (int n = 0; n < 2; ++n) {
                    const float mj = SCALE ? rowscale(tm * 256 + bj * 128 + wc * 32 + n * 16 + fr) : 1.f;
#pragma unroll
                    for (int m = 0; m < 4; ++m) {
                        const ACC a_ = acc[ai][bj][m][n];
                        if (I8) {
                            const float4 cs = colscale(tn * 256 + ai * 128 + wr * 64 + m * 16 + fq * 4);
                            *(float4*)(st + (n * 16 + fr) * ST_P + m * 16 + fq * 4) = make_float4((float)a_[0] * (mj * cs.x), (float)a_[1] * (mj * cs.y), (float)a_[2] * (mj * cs.z), (float)a_[3] * (mj * cs.w));
                        } else
                        *(float4*)(st + (n * 16 + fr) * ST_P + m * 16 + fq * 4) = SCALE ? make_float4(a_[0] * mj, a_[1] * mj, a_[2] * mj, a_[3] * mj) : make_float4(a_[0], a_[1], a_[2], a_[3]);
                    }
                }
                if (PRE) {
#pragma unroll
                    for (int it = 0; it < 8; ++it) {
                        const float4 v = *(const float4*)(st + (it * 4 + rr) * ST_P + ch * 4);
                        epirow(tb + bj * 128 + it * 4, nb + ai * 128, v, pv[it]);
                    }
                } else {
#pragma unroll 2
                    for (int it = 0; it < 8; ++it) {
                        const float4 v = *(const float4*)(st + (it * 4 + rr) * ST_P + ch * 4);
                        epirow(tb + bj * 128 + it * 4, nb + ai * 128, v, make_float4(0.f, 0.f, 0.f, 0.f));
                    }
                }
            }
        __syncthreads();
    }
}

__device__ __forceinline__ void transpose_tiled(const float* __restrict__ W, bf16* __restrict__ Wt, int K, int N, int Npad, int ldk, const float* __restrict__ gain, char* lds,
                                                const float* __restrict__ mixw = nullptr, int mix_lo = 0) {
    float (*tl)[65] = (float (*)[65])lds;
    const int tid = tidx(), a = tid & 63, q = tid >> 6;
    const int tK = K / 64, tN = Npad / 64;
    constexpr int RPT = 64 / NW;
    float cur[RPT], nxt[RPT];
#define TT_LOAD(R, tile_) do { const int k0_ = ((tile_) / tN) * 64, n0_ = ((tile_) % tN) * 64; \
        _Pragma("unroll") for (int i = 0; i < RPT; ++i) { const int k = k0_ + q * RPT + i, n = n0_ + a; float v = (n < N) ? W[(size_t)k * N + n] : 0.f; if (gain) v *= gain[k]; R[i] = v; } } while (0)
    if ((int)blockIdx.x < tK * tN) TT_LOAD(cur, (int)blockIdx.x);
    for (int tile = blockIdx.x; tile < tK * tN; tile += gridDim.x) {
        const int k0 = (tile / tN) * 64, n0 = (tile % tN) * 64;
#pragma unroll
        for (int i = 0; i < RPT; ++i) tl[q * RPT + i][a] = cur[i];
        __syncthreads();
        { const int tn_ = (tile + (int)gridDim.x < tK * tN) ? (tile + (int)gridDim.x) : tile; TT_LOAD(nxt, tn_); }
        if (mixw != nullptr && n0 >= mix_lo && n0 < mix_lo + 256) {
            const float* mw = mixw + (size_t)((n0 - mix_lo) >> 6) * 64 * 64;
            float o[RPT];
#pragma unroll
            for (int i = 0; i < RPT; ++i) o[i] = 0.f;
            for (int c = 0; c < 64; ++c) {
                const float x = tl[a][c];
#pragma unroll
                for (int i = 0; i < RPT; ++i) o[i] = fmaf(x, mw[c * 64 + q * RPT + i], o[i]);
            }
#pragma unroll
            for (int i = 0; i < RPT; ++i) Wt[(size_t)(n0 + q * RPT + i) * ldk + k0 + a] = f2bf(o[i]);
        } else {
#pragma unroll
            for (int i = 0; i < RPT; ++i) { const int nl = q * RPT + i; Wt[(size_t)(n0 + nl) * ldk + k0 + a] = f2bf(tl[a][nl]); }
        }
        __syncthreads();
#pragma unroll
        for (int i = 0; i < RPT; ++i) cur[i] = nxt[i];
    }
#undef TT_LOAD
}

__device__ __forceinline__ void quant_row(const float4 (&v)[4], unsigned char* __restrict__ dst, float* __restrict__ scl, int r, int lane) {
    float am = 0.f;
#pragma unroll
    for (int j = 0; j < 4; ++j) am = fmaxf(am, fmaxf(fmaxf(fabsf(v[j].x), fabsf(v[j].y)), fmaxf(fabsf(v[j].z), fabsf(v[j].w))));
#pragma unroll
    for (int m = 32; m >= 1; m >>= 1) am = fmaxf(am, __shfl_xor(am, m, 64));
    const float sc = (am > 0.f) ? am * (1.f / 448.f) : 1.f;
    const float is = 1.f / sc;
    uint4 o;
    { int w = 0; w = __builtin_amdgcn_cvt_pk_fp8_f32(v[0].x * is, v[0].y * is, w, false); w = __builtin_amdgcn_cvt_pk_fp8_f32(v[0].z * is, v[0].w * is, w, true); o.x = (unsigned)w; }
    { int w = 0; w = __builtin_amdgcn_cvt_pk_fp8_f32(v[1].x * is, v[1].y * is, w, false); w = __builtin_amdgcn_cvt_pk_fp8_f32(v[1].z * is, v[1].w * is, w, true); o.y = (unsigned)w; }
    { int w = 0; w = __builtin_amdgcn_cvt_pk_fp8_f32(v[2].x * is, v[2].y * is, w, false); w = __builtin_amdgcn_cvt_pk_fp8_f32(v[2].z * is, v[2].w * is, w, true); o.z = (unsigned)w; }
    { int w = 0; w = __builtin_amdgcn_cvt_pk_fp8_f32(v[3].x * is, v[3].y * is, w, false); w = __builtin_amdgcn_cvt_pk_fp8_f32(v[3].z * is, v[3].w * is, w, true); o.w = (unsigned)w; }
    { const int lay = r / NEXP, e = r % NEXP; *(uint4*)(dst + (((size_t)(lay * 8 + (lane >> 3)) * NEXP + e) * 128) + (lane & 7) * 16) = o; }
    if (lane == 0) scl[r] = sc;
}
__device__ __forceinline__ unsigned pack_i8x4(float a, float b, float c, float d) {
    const int ia = __float2int_rn(a), ib = __float2int_rn(b), ic = __float2int_rn(c), id = __float2int_rn(d);
    return (unsigned)(ia & 255) | ((unsigned)(ib & 255) << 8) | ((unsigned)(ic & 255) << 16) | ((unsigned)(id & 255) << 24);
}
__device__ __forceinline__ void quant_row_i8(const float4 (&v)[4], unsigned char* __restrict__ dst, float* __restrict__ scl, int r, int lane) {
    float am = 0.f;
#pragma unroll
    for (int j = 0; j < 4; ++j) am = fmaxf(am, fmaxf(fmaxf(fabsf(v[j].x), fabsf(v[j].y)), fmaxf(fabsf(v[j].z), fabsf(v[j].w))));
#pragma unroll
    for (int m = 32; m >= 1; m >>= 1) am = fmaxf(am, __shfl_xor(am, m, 64));
    const float sc = (am > 0.f) ? am * (1.f / 127.f) : 1.f;
    const float is = 1.f / sc;
    uint4 o;
    o.x = pack_i8x4(v[0].x * is, v[0].y * is, v[0].z * is, v[0].w * is); o.y = pack_i8x4(v[1].x * is, v[1].y * is, v[1].z * is, v[1].w * is);
    o.z = pack_i8x4(v[2].x * is, v[2].y * is, v[2].z * is, v[2].w * is); o.w = pack_i8x4(v[3].x * is, v[3].y * is, v[3].z * is, v[3].w * is);
    { const int lay = r / NEXP, e = r % NEXP; *(uint4*)(dst + (((size_t)(lay * 8 + (lane >> 3)) * NEXP + e) * 128) + (lane & 7) * 16) = o; }
    if (lane == 0) scl[r] = sc;
}
template <bool I8>
__device__ __forceinline__ void convert_table(const float* __restrict__ src, unsigned char* __restrict__ dst, float* __restrict__ scl, int rows) {
    static_assert(TAB_FP8, "fp8 tables");
    const int lane = tidx() & 63;
    const int nw = nwave();
    for (int r = gwave(); r < rows; r += 4 * nw) {
        float4 v[4][4]; int rr[4];
#pragma unroll
        for (int u = 0; u < 4; ++u) {
            rr[u] = (r + u * nw < rows) ? (r + u * nw) : r;
            const float4* s0 = (const float4*)(src + (size_t)rr[u] * D);
#pragma unroll
            for (int j = 0; j < 4; ++j) v[u][j] = s0[lane * 4 + j];
        }
#pragma unroll
        for (int u = 0; u < 4; ++u) {
            if (u == 0 || rr[u] != r) { if (I8) quant_row_i8(v[u], dst, scl, rr[u], lane); else quant_row(v[u], dst, scl, rr[u], lane); }
        }
    }
}
__device__ __forceinline__ void phase_prep(const Params& P, char* lds) {
    unsigned char* ws = P.ws;
    for (int l = 0; l < DEPTH; ++l) {
        transpose_tiled(P.w_in + (size_t)l * D * DIN, (bf16*)(ws + WS_WIN) + (size_t)l * DINP * LDW, D, DIN, DINP, LDW, nullptr, lds, P.pool_w + (size_t)l * 4 * 64 * 64, C_HP);
        transpose_tiled(P.w_uq + (size_t)l * QR * 768, (bf16*)(ws + WS_WUQ) + (size_t)l * 768 * QR, QR, 768, 768, QR, P.q_norm + l * QR, lds);
        transpose_tiled(P.w_uk + (size_t)l * KVR * 512, (bf16*)(ws + WS_WUKV) + (size_t)l * 1024 * KVR, KVR, 512, 512, KVR, P.kv_norm + l * KVR, lds);
        transpose_tiled(P.w_uv + (size_t)l * KVR * 512, (bf16*)(ws + WS_WUKV) + (size_t)l * 1024 * KVR + (size_t)512 * KVR, KVR, 512, 512, KVR, P.kv_norm + l * KVR, lds);
        transpose_tiled(P.w_out + (size_t)l * D * D, (bf16*)(ws + WS_WOUT) + (size_t)l * D * LDW, D, D, D, LDW, nullptr, lds);
    }
    {
        bf16* Wc = (bf16*)(ws + WS_WPQ);
        float (*As)[68] = (float (*)[68])lds;
        float (*Bs)[68] = (float (*)[68])(lds + 16 * 68 * 4);
        const int tid = tidx(), tx = tid & 15, ty = tid >> 4;
        const int lr = (tid >> 2) & 63, ld4 = (tid & 3) * 4;
        for (int tile = blockIdx.x; tile < (DEPTH * 2048 / 64) * (D / 64); tile += gridDim.x) {
            const int row0 = (tile >> 4) * 64, k0 = (tile & 15) * 64;
            const int l = row0 >> 11, hp = (row0 >> 7) & 15, n0 = row0 & 127;
            const float* skp = P.peer_subkeys + (((size_t)l * 2 + (hp & 1)) * NKEY + n0 + lr) * 128 + ld4;
            const float* wqp = P.peer_wq + ((size_t)l * D + k0 + lr) * 2048 + hp * 128 + ld4;
            float acc[2][4];
#pragma unroll
            for (int i = 0; i < 2; ++i)
#pragma unroll
                for (int j = 0; j < 4; ++j) acc[i][j] = 0.f;
            for (int d0 = 0; d0 < 128; d0 += 16) {
                if (tid < 256) {
                    const float4 av = *(const float4*)(skp + d0), bv = *(const float4*)(wqp + d0);
                    As[ld4 + 0][lr] = av.x; As[ld4 + 1][lr] = av.y; As[ld4 + 2][lr] = av.z; As[ld4 + 3][lr] = av.w;
                    Bs[ld4 + 0][lr] = bv.x; Bs[ld4 + 1][lr] = bv.y; Bs[ld4 + 2][lr] = bv.z; Bs[ld4 + 3][lr] = bv.w;
                }
                __syncthreads();
#pragma unroll
                for (int kk = 0; kk < 16; ++kk) {
                    const float2 a2 = *(const float2*)&As[kk][ty * 2]; const float4 b4 = *(const float4*)&Bs[kk][tx * 4];
                    const float aa[2] = {a2.x, a2.y}, bb[4] = {b4.x, b4.y, b4.z, b4.w};
#pragma unroll
                    for (int i = 0; i < 2; ++i)
#pragma unroll
                        for (int j = 0; j < 4; ++j) acc[i][j] = fmaf(aa[i], bb[j], acc[i][j]);
                }
                __syncthreads();
            }
#pragma unroll
            for (int i = 0; i < 2; ++i) {
                uint2 o; o.x = pack2(acc[i][0], acc[i][1]); o.y = pack2(acc[i][2], acc[i][3]);
                *(uint2*)(Wc + (size_t)(row0 + ty * 2 + i) * LDW + k0 + tx * 4) = o;
            }
        }
    }
    convert_table<true>(P.peer_u, ws + WS_TABU, (float*)(ws + WS_TSCU), DEPTH * NEXP);
    convert_table<false>(P.peer_v, ws + WS_TABV, (float*)(ws + WS_TSCV), DEPTH * NEXP);
    float* rope = (float*)(ws + WS_ROPE);
    for (size_t i = gtid(); i < (size_t)S * 16; i += gnth()) {
        const int s = (int)(i >> 4), f = (int)(i & 15);
        const double inv = pow(10000.0, -(double)f / 16.0);
        const double ang = (double)s * inv;
        rope[2 * i] = (float)cos(ang); rope[2 * i + 1] = (float)sin(ang);
    }
}

__device__ __forceinline__ void phase_norm(const float* __restrict__ h, const float* __restrict__ g, unsigned* __restrict__ xq, float* __restrict__ xsc) {
    const int lane = tidx() & 63, nw = nwave();
    for (int t = gwave(); t < T; t += 2 * nw) {
        const int t2 = (t + nw < T) ? (t + nw) : t;
        float4 v[2][4];
#pragma unroll
        for (int j = 0; j < 4; ++j) { v[0][j] = ((const float4*)(h + (size_t)t * D))[j * 64 + lane]; v[1][j] = ((const float4*)(h + (size_t)t2 * D))[j * 64 + lane]; }
#pragma unroll
        for (int u = 0; u < 2; ++u) {
            float ss = 0.f;
#pragma unroll
            for (int j = 0; j < 4; ++j) ss += v[u][j].x * v[u][j].x + v[u][j].y * v[u][j].y + v[u][j].z * v[u][j].z + v[u][j].w * v[u][j].w;
            ss = wave_sum(ss);
            const float r = rsqrtf(ss * (1.f / D) + EPS);
            const int tt = u ? t2 : t;
            if (u == 0 || t2 != t) {
                float am = 0.f;
#pragma unroll
                for (int j = 0; j < 4; ++j) {
                    const float4 gg = ((const float4*)g)[j * 64 + lane];
                    v[u][j].x *= r * gg.x; v[u][j].y *= r * gg.y; v[u][j].z *= r * gg.z; v[u][j].w *= r * gg.w;
                    am = fmaxf(am, fmaxf(fmaxf(fabsf(v[u][j].x), fabsf(v[u][j].y)), fmaxf(fabsf(v[u][j].z), fabsf(v[u][j].w))));
                }
#pragma unroll
                for (int m = 32; m >= 1; m >>= 1) am = fmaxf(am, __shfl_xor(am, m, 64));
                const float sc = (am > 0.f) ? am * (1.f / 127.f) : 1.f, is = 1.f / sc;
#pragma unroll
                for (int j = 0; j < 4; ++j) xq[(size_t)tt * (XQP / 4) + j * 64 + lane] = pack_i8x4(v[u][j].x * is, v[u][j].y * is, v[u][j].z * is, v[u][j].w * is);
                if (lane == 0) xsc[tt] = sc;
            }
        }
    }
}
__device__ __forceinline__ void quant_wrows(const bf16* __restrict__ W, int nrows, unsigned char* __restrict__ W8, float* __restrict__ WS8) {
    const int lane = tidx() & 63;
    for (int row = gwave(); row < nrows; row += nwave()) {
        const uint4 a = ((const uint4*)(W + (size_t)row * LDW))[lane * 2], b = ((const uint4*)(W + (size_t)row * LDW))[lane * 2 + 1];
        float v[16] = {bflo(a.x), bfhi(a.x), bflo(a.y), bfhi(a.y), bflo(a.z), bfhi(a.z), bflo(a.w), bfhi(a.w), bflo(b.x), bfhi(b.x), bflo(b.y), bfhi(b.y), bflo(b.z), bfhi(b.z), bflo(b.w), bfhi(b.w)};
        float am = 0.f;
#pragma unroll
        for (int i = 0; i < 16; ++i) am = fmaxf(am, fabsf(v[i]));
#pragma unroll
        for (int m = 32; m >= 1; m >>= 1) am = fmaxf(am, __shfl_xor(am, m, 64));
        const float sc = (am > 0.f) ? am * (1.f / 127.f) : 1.f, is = 1.f / sc;
        uint4 o;
        o.x = pack_i8x4(v[0] * is, v[1] * is, v[2] * is, v[3] * is); o.y = pack_i8x4(v[4] * is, v[5] * is, v[6] * is, v[7] * is);
        o.z = pack_i8x4(v[8] * is, v[9] * is, v[10] * is, v[11] * is); o.w = pack_i8x4(v[12] * is, v[13] * is, v[14] * is, v[15] * is);
        ((uint4*)(W8 + (size_t)row * XQP))[lane] = o;
        if (lane == 0) WS8[row] = sc;
    }
}
__device__ __forceinline__ void phase_norm_q(const Params& P, int l) {
    const int lane = tidx() & 63, nw = nwave();
    const float* g = P.norm_ffn + l * D;
    unsigned* xq = (unsigned*)(P.ws + WS_XQ);
    float* xsc = (float*)(P.ws + WS_XS);
    bf16* Hb = (bf16*)P.out;
    const bf16* yo = (const bf16*)(P.ws + WS_PROJ);
    for (int t = gwave(); t < T; t += 2 * nw) {
        const int t2 = (t + nw < T) ? (t + nw) : t;
        float4 v[2][4];
#pragma unroll
        for (int j = 0; j < 4; ++j) {
            if (l == 0) { v[0][j] = ((const float4*)(P.x + (size_t)t * D))[j * 64 + lane]; v[1][j] = ((const float4*)(P.x + (size_t)t2 * D))[j * 64 + lane]; }
            else {
                const uint2 a = ((const uint2*)(Hb + (size_t)t * HP))[j * 64 + lane], b = ((const uint2*)(Hb + (size_t)t2 * HP))[j * 64 + lane];
                v[0][j] = make_float4(bflo(a.x), bfhi(a.x), bflo(a.y), bfhi(a.y)); v[1][j] = make_float4(bflo(b.x), bfhi(b.x), bflo(b.y), bfhi(b.y));
            }
        }
        {
            uint2 y[2][4];
#pragma unroll
            for (int j = 0; j < 4; ++j) { y[0][j] = ((const uint2*)(yo + (size_t)t * D))[j * 64 + lane]; y[1][j] = ((const uint2*)(yo + (size_t)t2 * D))[j * 64 + lane]; }
#pragma unroll
            for (int u = 0; u < 2; ++u)
#pragma unroll
                for (int j = 0; j < 4; ++j) { v[u][j].x += bflo(y[u][j].x); v[u][j].y += bfhi(y[u][j].x); v[u][j].z += bflo(y[u][j].y); v[u][j].w += bfhi(y[u][j].y); }
#pragma unroll
            for (int j = 0; j < 4; ++j) {
                uint2 a, b; a.x = pack2(v[0][j].x, v[0][j].y); a.y = pack2(v[0][j].z, v[0][j].w); b.x = pack2(v[1][j].x, v[1][j].y); b.y = pack2(v[1][j].z, v[1][j].w);
                ((uint2*)(Hb + (size_t)t * HP))[j * 64 + lane] = a; if (t2 != t) ((uint2*)(Hb + (size_t)t2 * HP))[j * 64 + lane] = b;
            }
        }
#pragma unroll
        for (int u = 0; u < 2; ++u) {
            float ss = 0.f;
#pragma unroll
            for (int j = 0; j < 4; ++j) ss += v[u][j].x * v[u][j].x + v[u][j].y * v[u][j].y + v[u][j].z * v[u][j].z + v[u][j].w * v[u][j].w;
            ss = wave_sum(ss);
            const float r = rsqrtf(ss * (1.f / D) + EPS);
            const int tt = u ? t2 : t;
            if (u == 0 || t2 != t) {
                float am = 0.f;
#pragma unroll
                for (int j = 0; j < 4; ++j) {
                    const float4 gg = ((const float4*)g)[j * 64 + lane];
                    v[u][j].x *= r * gg.x; v[u][j].y *= r * gg.y; v[u][j].z *= r * gg.z; v[u][j].w *= r * gg.w;
                    am = fmaxf(am, fmaxf(fmaxf(fabsf(v[u][j].x), fabsf(v[u][j].y)), fmaxf(fabsf(v[u][j].z), fabsf(v[u][j].w))));
                }
#pragma unroll
                for (int m = 32; m >= 1; m >>= 1) am = fmaxf(am, __shfl_xor(am, m, 64));
                const float sc = (am > 0.f) ? am * (1.f / 127.f) : 1.f, is = 1.f / sc;
#pragma unroll
                for (int j = 0; j < 4; ++j) xq[(size_t)tt * (XQP / 4) + j * 64 + lane] = pack_i8x4(v[u][j].x * is, v[u][j].y * is, v[u][j].z * is, v[u][j].w * is);
                if (lane == 0) xsc[tt] = sc;
            }
        }
    }
}

__device__ __forceinline__ void phase_mixlocal(const Params& P, int l, char* lds) {
    const bf16* proj = (const bf16*)(P.ws + WS_PROJ);
    bf16* Y = (bf16*)(P.ws + WS_XN);
    const int tid = tidx();
    {
        const float* cw = P.conv_w + (size_t)l * 3 * 256;
        const size_t nth = gnth();
        for (size_t it = gtid(); it < (size_t)(T / 8) * 32; it += nth) {
            const int c0 = (int)(it & 31) * 8, tf = (int)(it >> 5) * 8, sf = tf & (S - 1);
            const bf16* pr = proj + (size_t)tf * DINP;
            uint4 gq[10], hq[10], bq[8];
#pragma unroll
            for (int r = 0; r < 10; ++r) {
                const int dr = (sf + r - 2 >= 0) ? (r - 2) : 0;
                gq[r] = *(const uint4*)(pr + (ptrdiff_t)dr * DINP + C_CG + c0); hq[r] = *(const uint4*)(pr + (ptrdiff_t)dr * DINP + C_HC + c0);
            }
#pragma unroll
            for (int i = 0; i < 8; ++i) bq[i] = *(const uint4*)(pr + (size_t)i * DINP + C_BG + c0);
            float wj[3][8];
#pragma unroll
            for (int j = 0; j < 3; ++j) {
                const float4 w0 = *(const float4*)(cw + j * 256 + c0), w1 = *(const float4*)(cw + j * 256 + c0 + 4);
                wj[j][0] = w0.x; wj[j][1] = w0.y; wj[j][2] = w0.z; wj[j][3] = w0.w; wj[j][4] = w1.x; wj[j][5] = w1.y; wj[j][6] = w1.z; wj[j][7] = w1.w;
            }
            float pp[10][8];
#pragma unroll
            for (int r = 0; r < 10; ++r) {
                const float z = (sf + r - 2 >= 0) ? 1.f : 0.f;
                pp[r][0] = bflo(gq[r].x) * bflo(hq[r].x) * z; pp[r][1] = bfhi(gq[r].x) * bfhi(hq[r].x) * z;
                pp[r][2] = bflo(gq[r].y) * bflo(hq[r].y) * z; pp[r][3] = bfhi(gq[r].y) * bfhi(hq[r].y) * z;
                pp[r][4] = bflo(gq[r].z) * bflo(hq[r].z) * z; pp[r][5] = bfhi(gq[r].z) * bfhi(hq[r].z) * z;
                pp[r][6] = bflo(gq[r].w) * bflo(hq[r].w) * z; pp[r][7] = bfhi(gq[r].w) * bfhi(hq[r].w) * z;
            }
#pragma unroll
            for (int i = 0; i < 8; ++i) {
                float acc[8];
#pragma unroll
                for (int e = 0; e < 8; ++e) acc[e] = fmaf(wj[2][e], pp[i + 2][e], fmaf(wj[1][e], pp[i + 1][e], wj[0][e] * pp[i][e]));
                const uint4 bg = bq[i];
                uint4 o;
                o.x = pack2(bflo(bg.x) * acc[0], bfhi(bg.x) * acc[1]); o.y = pack2(bflo(bg.y) * acc[2], bfhi(bg.y) * acc[3]);
                o.z = pack2(bflo(bg.z) * acc[4], bfhi(bg.z) * acc[5]); o.w = pack2(bflo(bg.w) * acc[6], bfhi(bg.w) * acc[7]);
                *(uint4*)(Y + (size_t)(tf + i) * LDX + c0) = o;
            }
        }
    }
    {
        const float* psc = P.pool_scale + l * 256;
        const size_t nth = gnth();
        for (size_t it = gtid(); it < (size_t)(T / 8) * 64; it += nth) {
            const int cq = (int)(it & 63), tf = (int)(it >> 6) * 8, g = cq >> 4, sf = tf & (S - 1);
            const int w = 2 << g;
            const bf16* col = proj + C_HP + 4 * cq;
            f32x4 xr[23];
#pragma unroll
            for (int d = 1; d <= 15; ++d) {
                const bool ok = d < w && sf - d >= 0;
                const uint2 u = *(const uint2*)(col + (size_t)(tf - (ok ? d : 0)) * DINP);
                const float z = ok ? 1.f : 0.f;
                xr[15 - d] = f32x4{bflo(u.x) * z, bfhi(u.x) * z, bflo(u.y) * z, bfhi(u.y) * z};
            }
#pragma unroll
            for (int i = 0; i < 8; ++i) { const uint2 u = *(const uint2*)(col + (size_t)(tf + i) * DINP); xr[15 + i] = f32x4{bflo(u.x), bfhi(u.x), bflo(u.y), bfhi(u.y)}; }
            const float4 sc = *(const float4*)(psc + 4 * cq);
            f32x4 sum = f32x4{0.f, 0.f, 0.f, 0.f};
#pragma unroll
            for (int d = 1; d <= 15; ++d) sum += xr[15 - d];
#pragma unroll
            for (int i = 0; i < 8; ++i) {
                const int s_ = sf + i;
                const f32x4 xc = xr[15 + i];
                sum += xc;
                const float ic = 1.f / (float)((s_ + 1 < w) ? (s_ + 1) : w);
                const f32x4 o4 = sum * ic - xc;
                uint2 o; o.x = pack2(o4[0] * sc.x, o4[1] * sc.y); o.y = pack2(o4[2] * sc.z, o4[3] * sc.w);
                *(uint2*)(Y + (size_t)(tf + i) * LDX + 256 + 4 * cq) = o;
                const f32x4 old = (g == 0) ? xr[14 + i] : (g == 1) ? xr[12 + i] : (g == 2) ? xr[8 + i] : xr[i];
                sum -= old;
            }
        }
    }
}

__device__ __forceinline__ float dpp_up4(float v) { return __int_as_float(__builtin_amdgcn_update_dpp(0, __float_as_int(v), 0x104, 0xF, 0xF, true)); }
__device__ __forceinline__ float dpp_dn4(float v) { return __int_as_float(__builtin_amdgcn_update_dpp(0, __float_as_int(v), 0x114, 0xF, 0xF, true)); }
__device__ __forceinline__ float max3f(float a, float b, float c) { float r; asm("v_max3_f32 %0, %1, %2, %3" : "=v"(r) : "v"(a), "v"(b), "v"(c)); return r; }
typedef short v4i16_t __attribute__((ext_vector_type(4)));
typedef __attribute__((address_space(3))) v4i16_t* lds_v4p;
__device__ __forceinline__ v4i16_t vtr(const char* p) { return __builtin_amdgcn_ds_read_tr16_b64_v4i16((lds_v4p)p); }
constexpr int A_KP = 208, A_VP = 192;
constexpr int A_KB = 64 * A_KP, A_VB = 64 * A_VP, A_BUF = A_KB + A_VB, ATTN_LDS = 3 * A_BUF;
static_assert(ATTN_LDS <= LDS_TOTAL, "attention LDS");

__device__ __forceinline__ void attn_unit(const bf16* __restrict__ Qb, const bf16* __restrict__ Kb, const bf16* __restrict__ Vb, bf16* __restrict__ Y, int bh, int qblk, char* lds) {
    const int tid = tidx(), lane = tid & 63, w = tid >> 6, r32 = lane & 31, hi = lane >> 5;
    const int q0 = qblk * (64 * NW), qw0 = q0 + w * 64;
    const int NT = (q0 + 64 * NW) / 64;
    bf16x8 qfa[6], qfb[6];
    {
        const bf16* qp = Qb + ((size_t)bh * S + qw0 + r32) * DQK + hi * 8;
#pragma unroll
        for (int ks = 0; ks < 6; ++ks) { qfa[ks] = *(const bf16x8*)(qp + ks * 16); qfb[ks] = *(const bf16x8*)(qp + 32 * DQK + ks * 16); }
    }
    f32x16 oa0, oa1, ob0, ob1;
#pragma unroll
    for (int r = 0; r < 16; ++r) { oa0[r] = 0.f; oa1[r] = 0.f; ob0[r] = 0.f; ob1[r] = 0.f; }
    float ma = -1e30f, mb = -1e30f, lsa = 0.f, lsb = 0.f;
    const int t8 = tid & 255; const bool isv = tid >= 256;
    const char* Tg = isv ? (const char*)(Vb + (size_t)bh * S * DV) : (const char*)(Kb + (size_t)bh * S * DQK);
    const int Ts = isv ? (64 * 128) : (64 * 192);
    const int g0 = t8 * 16, g1 = (t8 + 256) * 16, g2 = isv ? g1 : (t8 + 512) * 16;
    const int l0 = isv ? (A_KB + (t8 >> 3) * A_VP + (t8 & 7) * 16) : ((t8 / 12) * A_KP + (t8 % 12) * 16);
    const int l1 = isv ? (l0 + 32 * A_VP) : (((t8 + 256) / 12) * A_KP + ((t8 + 256) % 12) * 16);
    const int l2 = isv ? l1 : (((t8 + 512) / 12) * A_KP + ((t8 + 512) % 12) * 16);
    uint4 pk0, pk1, pk2, qk0, qk1, qk2;
#define A_LOAD(S, t) do { const char* tg = Tg + (size_t)(t) * Ts; S##k0 = *(const uint4*)(tg + g0); S##k1 = *(const uint4*)(tg + g1); S##k2 = *(const uint4*)(tg + g2); } while (0)
#define A_STORE(S, bK, bV) do { *(uint4*)(bK + l0) = S##k0; *(uint4*)(bK + l1) = S##k1; *(uint4*)(bK + l2) = S##k2; } while (0)
#define A_PV2(pa, pb, kofs) do { \
            { const v4i16_t lo = vtr(pv + (kofs) * A_VP), hh = vtr(pv + ((kofs) + 8) * A_VP); const bf16x8 vf = {lo[0], lo[1], lo[2], lo[3], hh[0], hh[1], hh[2], hh[3]}; oa0 = MFMA32(vf, pa.v, oa0); ob0 = MFMA32(vf, pb.v, ob0); } \
            { const v4i16_t lo = vtr(pv + (kofs) * A_VP + 64), hh = vtr(pv + ((kofs) + 8) * A_VP + 64); const bf16x8 vf = {lo[0], lo[1], lo[2], lo[3], hh[0], hh[1], hh[2], hh[3]}; oa1 = MFMA32(vf, pa.v, oa1); ob1 = MFMA32(vf, pb.v, ob1); } } while (0)
#define A_SOFT(s0, s1, m, ls, o0, o1, P0, P1, P2, P3) do { \
            float mx; \
            { float a_ = max3f(s0[0], s0[1], s1[0]), b_ = max3f(s0[2], s0[3], s1[1]); a_ = max3f(a_, s1[2], s1[3]);        \
              _Pragma("unroll") for (int r = 4; r < 16; r += 4) { a_ = max3f(a_, s0[r], s0[r + 1]); b_ = max3f(b_, s0[r + 2], s0[r + 3]); a_ = max3f(a_, s1[r], s1[r + 1]); b_ = max3f(b_, s1[r + 2], s1[r + 3]); } \
              mx = fmaxf(a_, b_); } \
            { const auto rr_ = __builtin_amdgcn_permlane32_swap(__float_as_uint(mx), __float_as_uint(mx), false, false); mx = fmaxf(__uint_as_float(rr_[0]), __uint_as_float(rr_[1])); }     \
              \
            if (__builtin_amdgcn_ballot_w64(mx - m > A_THR) != 0ull) { \
                const float mn = fmaxf(m, mx); \
                const float alpha = __builtin_amdgcn_exp2f(m - mn); \
                m = mn; ls *= alpha; \
                _Pragma("unroll") for (int r = 0; r < 16; ++r) { o0[r] *= alpha; o1[r] *= alpha; } } \
            float ps = 0.f; \
            _Pragma("unroll") for (int r = 0; r < 16; ++r) { s0[r] = __builtin_amdgcn_exp2f(s0[r] - m); s1[r] = __builtin_amdgcn_exp2f(s1[r] - m); ps += s0[r] + s1[r]; } \
            ls += ps; \
            _Pragma("unroll") for (int j = 0; j < 4; ++j) { P0.u[j] = cvtpk(s0[2 * j], s0[2 * j + 1]); P1.u[j] = cvtpk(s0[8 + 2 * j], s0[9 + 2 * j]); P2.u[j] = cvtpk(s1[2 * j], s1[2 * j + 1]); P3.u[j] = cvtpk(s1[8 + 2 * j], s1[9 + 2 * j]); } } while (0)
    constexpr float A_THR = 8.f;
    const int pvo = (4 * hi + ((lane & 15) >> 2)) * A_VP + (16 * ((lane >> 4) & 1) + 4 * (lane & 3)) * 2;
    A_LOAD(p, 0); A_LOAD(q, 1);
    for (int t2 = 0; t2 < NT; t2 += 2) {
#pragma unroll
        for (int half = 0; half < 2; ++half) {
            const int t = t2 + half;
            char* bK = lds + half * A_BUF; char* bV = bK + A_KB;
            if (half == 0) A_STORE(p, bK, bV); else A_STORE(q, bK, bV);
            __syncthreads();
            { const int tn = (t + 2 < NT) ? (t + 2) : (NT - 2 + half); if (half == 0) A_LOAD(p, tn); else A_LOAD(q, tn); }
            const int kt0 = t * 64;
            if (kt0 <= qw0) {
                f32x16 sa0, sa1, sb0, sb1;
#pragma unroll
                for (int r = 0; r < 16; ++r) { sa0[r] = 0.f; sa1[r] = 0.f; sb0[r] = 0.f; sb1[r] = 0.f; }
                const char* pk = bK + r32 * A_KP + hi * 16;
#pragma unroll
                for (int ks = 0; ks < 6; ++ks) {
                    const bf16x8 a0 = *(const bf16x8*)(pk + ks * 32), a1 = *(const bf16x8*)(pk + 32 * A_KP + ks * 32);
                    sa0 = MFMA32(a0, qfa[ks], sa0); sa1 = MFMA32(a1, qfa[ks], sa1);
                    sb0 = MFMA32(a0, qfb[ks], sb0); sb1 = MFMA32(a1, qfb[ks], sb1);
                }
                if (kt0 == qw0) {
                    const int qrow = qw0 + r32;
#pragma unroll
                    for (int r = 0; r < 16; ++r) {
                        const int key = kt0 + crow(r, hi);
                        if (key > qrow) sa0[r] = -INFINITY; if (key + 32 > qrow) sa1[r] = -INFINITY;
                        if (key > qrow + 32) sb0[r] = -INFINITY; if (key > qrow) sb1[r] = -INFINITY;
                    }
                }
                union { unsigned u[4]; bf16x8 v; } pa0, pa1, pa2, pa3, pb0, pb1, pb2, pb3;
                A_SOFT(sa0, sa1, ma, lsa, oa0, oa1, pa0, pa1, pa2, pa3);
                A_SOFT(sb0, sb1, mb, lsb, ob0, ob1, pb0, pb1, pb2, pb3);
                const char* pv = bV + pvo;
                A_PV2(pa0, pb0, 0); A_PV2(pa1, pb1, 16); A_PV2(pa2, pb2, 32); A_PV2(pa3, pb3, 48);
            }
        }
    }
#undef A_LOAD
#undef A_STORE
#undef A_PV2
#undef A_SOFT
    lsa += __shfl_xor(lsa, 32, 64); lsb += __shfl_xor(lsb, 32, 64);
    const float inva = 1.f / lsa, invb = 1.f / lsb;
    const int b = bh >> 3, h = bh & 7;
    bf16* yo = Y + (size_t)(b * S + qw0 + r32) * LDX + 512 + h * 64 + 4 * hi;
#pragma unroll
    for (int g = 0; g < 4; ++g) {
        uint2 a, c;
        a.x = cvtpk(oa0[4 * g] * inva, oa0[4 * g + 1] * inva); a.y = cvtpk(oa0[4 * g + 2] * inva, oa0[4 * g + 3] * inva);
        c.x = cvtpk(oa1[4 * g] * inva, oa1[4 * g + 1] * inva); c.y = cvtpk(oa1[4 * g + 2] * inva, oa1[4 * g + 3] * inva);
        *(uint2*)(yo + 8 * g) = a; *(uint2*)(yo + 32 + 8 * g) = c;
        a.x = cvtpk(ob0[4 * g] * invb, ob0[4 * g + 1] * invb); a.y = cvtpk(ob0[4 * g + 2] * invb, ob0[4 * g + 3] * invb);
        c.x = cvtpk(ob1[4 * g] * invb, ob1[4 * g + 1] * invb); c.y = cvtpk(ob1[4 * g + 2] * invb, ob1[4 * g + 3] * invb);
        *(uint2*)(yo + (size_t)32 * LDX + 8 * g) = a; *(uint2*)(yo + (size_t)32 * LDX + 32 + 8 * g) = c;
    }
    __syncthreads();
}
__device__ __forceinline__ void phase_attn(const Params& P, char* lds) {
    const bf16* Qb = (const bf16*)(P.ws + WS_Q);
    const bf16* Kb = (const bf16*)(P.ws + WS_K);
    const bf16* Vb = (const bf16*)(P.ws + WS_V);
    bf16* Y = (bf16*)(P.ws + WS_XN);
    for (int u = blockIdx.x; u < NB * NH * (S / 512); u += gridDim.x) {
        const int bh = u & 31, v = u >> 5;
        const int qblk = (v < 8) ? (15 - v) : (v - 8);
        attn_unit(Qb, Kb, Vb, Y, bh, qblk, lds);
    }
}

#define NET_HD __device__ __forceinline__
#define NET_U2F(u) __uint_as_float(u)
#define NET_F2U(f) __float_as_uint(f)
#define CE_DESC(a, b) do { const float hi__ = fmaxf(a, b), lo__ = fminf(a, b); a = hi__; b = lo__; } while (0)
NET_HD void sort16_desc(float (&v)[16]) {
#define CE2(a, b) CE_DESC(v[a], v[b])
    CE2(0,13); CE2(1,12); CE2(2,15); CE2(3,14); CE2(4,8); CE2(5,6); CE2(7,11); CE2(9,10);
    CE2(0,5); CE2(1,7); CE2(2,9); CE2(3,4); CE2(6,13); CE2(8,14); CE2(10,15); CE2(11,12);
    CE2(0,1); CE2(2,3); CE2(4,5); CE2(6,8); CE2(7,9); CE2(10,11); CE2(12,13); CE2(14,15);
    CE2(0,2); CE2(1,3); CE2(4,10); CE2(5,11); CE2(6,7); CE2(8,9); CE2(12,14); CE2(13,15);
    CE2(1,2); CE2(3,12); CE2(4,6); CE2(5,7); CE2(8,10); CE2(9,11); CE2(13,14);
    CE2(1,4); CE2(2,6); CE2(5,8); CE2(7,10); CE2(9,13); CE2(11,14);
    CE2(2,4); CE2(3,6); CE2(9,12); CE2(11,13);
    CE2(3,5); CE2(6,8); CE2(7,9); CE2(10,12);
    CE2(3,4); CE2(5,6); CE2(7,8); CE2(9,10); CE2(11,12);
    CE2(6,7); CE2(8,9);
#undef CE2
}
NET_HD void merge16_desc(float (&a)[16], const float (&b)[16]) {
#pragma unroll
    for (int i = 0; i < 16; ++i) a[i] = fmaxf(a[i], b[15 - i]);
#pragma unroll
    for (int j = 8; j > 0; j >>= 1) {
#pragma unroll
        for (int i = 0; i < 16; ++i) { const int l = i ^ j; if (l > i) CE_DESC(a[i], a[l]); }
    }
}
NET_HD void top16_of_64(float (&g0)[16], float (&g1)[16], float (&g2)[16], float (&g3)[16]) {
    sort16_desc(g0); sort16_desc(g1); sort16_desc(g2); sort16_desc(g3);
    merge16_desc(g0, g1); merge16_desc(g2, g3); merge16_desc(g0, g2);
}
NET_HD float u2f(unsigned u) { return NET_U2F(u); }
NET_HD unsigned f2u(float f) { return NET_F2U(f); }
template <class V16>
NET_HD void lane_top16(const V16& s0, const V16& s1, const V16& s2, const V16& s3, int hi, float (&out)[16]) {
    float g0[16], g1[16], g2[16], g3[16];
#pragma unroll
    for (int r = 0; r < 16; ++r) {
        const unsigned nb = (unsigned)((r & 3) + 8 * (r >> 2));
        g0[r] = u2f((f2u(s0[r]) & 0xFFFFFF80u) | nb); g1[r] = u2f((f2u(s1[r]) & 0xFFFFFF80u) | (nb + 32u));
        g2[r] = u2f((f2u(s2[r]) & 0xFFFFFF80u) | (nb + 64u)); g3[r] = u2f((f2u(s3[r]) & 0xFFFFFF80u) | (nb + 96u));
    }
    top16_of_64(g0, g1, g2, g3);
    const unsigned h4 = (unsigned)hi << 2;
#pragma unroll
    for (int i = 0; i < 16; ++i) out[i] = u2f(f2u(g0[i]) | h4);
}
constexpr int cand_slot(int a, int b) { int n = 0; for (int x = 0; x < 16; ++x) for (int y = 0; y < 16; ++y) { if (x == a && y == b) return n; if ((x + 1) * (y + 1) <= 16) ++n; } return n; }
NET_HD void cand_top16(const float (&s1)[16], const float (&s2)[16], float (&c)[16]) {
    float g0[16], g1[16], g2[16], g3[16];
#pragma unroll
    for (int i = 0; i < 16; ++i) { g0[i] = -3.0e38f; g1[i] = -3.0e38f; g2[i] = -3.0e38f; g3[i] = -3.0e38f; }
#pragma unroll
    for (int a = 0; a < 16; ++a) {
#pragma unroll
        for (int b = 0; b < 16; ++b) {
            if ((a + 1) * (b + 1) <= 16) {
                const int sl = cand_slot(a, b);
                const float v = u2f((f2u(s1[a] + s2[b]) & 0xFFFFFF00u) | (unsigned)(a * 16 + b));
                if (sl < 16) g0[sl & 15] = v; else if (sl < 32) g1[sl & 15] = v; else if (sl < 48) g2[sl & 15] = v; else g3[sl & 15] = v;
            }
        }
    }
    top16_of_64(g0, g1, g2, g3);
#pragma unroll
    for (int i = 0; i < 16; ++i) c[i] = g0[i];
}

__device__ __forceinline__ void phase_route(const Params& P, int l, char* lds) {
    const bf16* XQb = (const bf16*)(P.ws + WS_XQ);
    const bf16* Wc = (const bf16*)(P.ws + WS_WC8 + (size_t)l * 2048 * XQP);
    const float* WcS = (const float*)(P.ws + WS_WCS) + (size_t)l * 2048;
    const float* XSc = (const float*)(P.ws + WS_XS);
    int* EXPp = (int*)(P.ws + WS_EXP);
    float* GATEp = (float*)(P.ws + WS_GATE);
    const int tid = tidx();
    float* xch = (float*)(lds + 16384);
    int tlo, thi, tst; tile_rounds((T / 256) * PH, tlo, thi, tst);
    int nt = D / 128; asm volatile("" : "+s"(nt));
    for (int u = tlo; u < thi; u += tst) {
        const int tm = u >> 3, h = u & 7;
        float Lk[16];
        {
            i32x4 acc[2][2][4][2]; float ssd[2][2];
            gemm8_kloop<false, true, i32x4>(Wc + (size_t)(h * 256) * (XQP / 2), XQP / 2, XQb + (size_t)(tm * 256) * (XQP / 2), XQP / 2, nt, acc, ssd, lds, tid);
            const int te = tidx(), fq = (te >> 4) & 3;
            const unsigned fqb = (unsigned)fq << 2;
            float4 ks[2][4];
            { const float* kp = WcS + h * 256 + ((te >> 8) & 1) * 128 + fq * 4;
#pragma unroll
              for (int ai = 0; ai < 2; ++ai)
#pragma unroll
                  for (int m = 0; m < 4; ++m) ks[ai][m] = *(const float4*)(kp + ai * 64 + m * 16); }
#pragma unroll
            for (int i = 0; i < 16; ++i) Lk[i] = 0.f;
#pragma unroll
            for (int bj = 0; bj < 2; ++bj)
#pragma unroll
                for (int n = 0; n < 2; ++n) {
                    float g0[16], g1[16];
#pragma unroll
                    for (int m = 0; m < 4; ++m)
#pragma unroll
                        for (int j = 0; j < 4; ++j) {
                            const unsigned kb = (unsigned)(m * 16 + j) | fqb;
                            const float k0 = (j == 0) ? ks[0][m].x : (j == 1) ? ks[0][m].y : (j == 2) ? ks[0][m].z : ks[0][m].w;
                            const float k1 = (j == 0) ? ks[1][m].x : (j == 1) ? ks[1][m].y : (j == 2) ? ks[1][m].z : ks[1][m].w;
                            g0[m * 4 + j] = u2f((f2u((float)acc[0][bj][m][n][j] * k0) & 0xFFFFFF80u) | kb);
                            g1[m * 4 + j] = u2f((f2u((float)acc[1][bj][m][n][j] * k1) & 0xFFFFFF80u) | (kb + 64u));
                        }
                    sort16_desc(g0); sort16_desc(g1); merge16_desc(g0, g1);
                    float o[16];
#pragma unroll
                    for (int i = 0; i < 16; ++i) o[i] = __shfl_xor(g0[i], 16, 64);
                    merge16_desc(g0, o);
#pragma unroll
                    for (int i = 0; i < 16; ++i) o[i] = __shfl_xor(g0[i], 32, 64);
                    merge16_desc(g0, o);
                    const bool mine = fq == bj * 2 + n;
#pragma unroll
                    for (int i = 0; i < 16; ++i) Lk[i] = mine ? g0[i] : Lk[i];
                }
        }
        __syncthreads();
        const int te = tidx(), lane = te & 63, w = te >> 6, wr = w >> 2, wc = w & 3, fr = lane & 15, fq = lane >> 4;
        if (wr == 1) {
#pragma unroll
            for (int q = 0; q < 4; ++q) *(float4*)(xch + ((wc * 64 + lane) * 16) + 4 * q) = make_float4(Lk[4 * q], Lk[4 * q + 1], Lk[4 * q + 2], Lk[4 * q + 3]);
        }
        __syncthreads();
        if (wr == 0) {
            float L1[16];
#pragma unroll
            for (int q = 0; q < 4; ++q) { const float4 v = *(const float4*)(xch + ((wc * 64 + lane) * 16) + 4 * q); L1[4 * q] = v.x; L1[4 * q + 1] = v.y; L1[4 * q + 2] = v.z; L1[4 * q + 3] = v.w; }
            float c[16];
            cand_top16(Lk, L1, c);
            unsigned char* my = (unsigned char*)lds + te * 32;
            {
                uint4 a, b;
#define PK4(L, i) ((__float_as_uint(L[i]) & 127u) | ((__float_as_uint(L[i + 1]) & 127u) << 8) | ((__float_as_uint(L[i + 2]) & 127u) << 16) | ((__float_as_uint(L[i + 3]) & 127u) << 24))
                a.x = PK4(Lk, 0); a.y = PK4(Lk, 4); a.z = PK4(Lk, 8); a.w = PK4(Lk, 12);
                b.x = PK4(L1, 0); b.y = PK4(L1, 4); b.z = PK4(L1, 8); b.w = PK4(L1, 12);
#undef PK4
                *(uint4*)my = a; *(uint4*)(my + 16) = b;
            }
            const int t = tm * 256 + (fq >> 1) * 128 + wc * 32 + (fq & 1) * 16 + fr;
            const float xs_t = XSc[t];
            int ev[16]; float gv[16]; float den = 0.f;
#pragma unroll
            for (int k = 0; k < 16; ++k) {
                const unsigned ci = __float_as_uint(c[k]) & 255u;
                const int n1 = my[ci >> 4], n2 = my[16 + (ci & 15)];
                ev[k] = n1 * NKEY + n2;
                gv[k] = __expf((c[k] - c[0]) * xs_t); den += gv[k];
            }
            const float iden = 1.f / den;
            uint4* ep = (uint4*)(EXPp + (size_t)t * HK + h * 16);
            float4* gp = (float4*)(GATEp + (size_t)t * HK + h * 16);
#pragma unroll
            for (int q = 0; q < 4; ++q) {
                ep[q] = make_uint4((unsigned)ev[4 * q], (unsigned)ev[4 * q + 1], (unsigned)ev[4 * q + 2], (unsigned)ev[4 * q + 3]);
                gp[q] = make_float4(gv[4 * q] * iden, gv[4 * q + 1] * iden, gv[4 * q + 2] * iden, gv[4 * q + 3] * iden);
            }
        }
        __syncthreads();
    }
}

constexpr size_t WS_PART = WS_PROJ;
static_assert((size_t)8 * T * HK * 4 <= WS_K - WS_PROJ, "PART alias");
constexpr int XI_X = 0, XI_RANK = 1, XI_J = 2, XI_NX = 3, XI_NLOC = 4;
constexpr int CTL_CENSUS = 4096;
constexpr int CTL_BYTES = (CTL_CENSUS + 16) * 4;

template <int M1, int M2, int M3, class TT>
__device__ __forceinline__ void red16x3(TT (&p)[16], int lane) {
#pragma unroll
    for (int i = 0; i < 8; ++i) { const bool up = lane & M1; const TT send = up ? p[i] : p[i + 8], keep = up ? p[i + 8] : p[i]; p[i] = keep + __shfl_xor(send, M1, 64); }
#pragma unroll
    for (int i = 0; i < 4; ++i) { const bool up = lane & M2; const TT send = up ? p[i] : p[i + 4], keep = up ? p[i + 4] : p[i]; p[i] = keep + __shfl_xor(send, M2, 64); }
#pragma unroll
    for (int i = 0; i < 2; ++i) { const bool up = lane & M3; const TT send = up ? p[i] : p[i + 2], keep = up ? p[i + 2] : p[i]; p[i] = keep + __shfl_xor(send, M3, 64); }
}
__device__ __forceinline__ void phase_gu(const Params& P, int l, const volatile int* xi) {
    const unsigned char* XQ = P.ws + WS_XQ;
    const float* XSc = (const float*)(P.ws + WS_XS);
    const int* EXPp = (const int*)(P.ws + WS_EXP);
    float* PART = (float*)(P.ws + WS_PART);
    const int tid = tidx(), lane = tid & 63, w = tid >> 6, g = lane >> 3, c = lane & 7;
    int xo_ = 0; asm volatile("" : "+v"(xo_));
    const int j = __builtin_amdgcn_readfirstlane(xi[xo_ + XI_J]), nx = __builtin_amdgcn_readfirstlane(xi[xo_ + XI_NX]), nloc = __builtin_amdgcn_readfirstlane(xi[xo_ + XI_NLOC]), rank = __builtin_amdgcn_readfirstlane(xi[xo_ + XI_RANK]);
    const int t0 = rank * NW + w, st = nloc * NW;
    const int n = (t0 < T) ? (T - t0 + st - 1) / st : 0;
    const int i0 = 8 * (c & 1) + 4 * ((c >> 1) & 1) + 2 * ((c >> 2) & 1);
    for (int sl = j; sl < 8 && n > 0; sl += nx) {
        const unsigned char* Us = P.ws + WS_TABU + ((size_t)(l * 8 + sl) * NEXP) * 128;
        const unsigned co = (unsigned)c << 4;
        float* part = PART + (size_t)sl * T * HK;
        const unsigned char* xs = XQ + sl * 128 + c * 16;
#define GU_TK(k) (t0 + (((k) < n) ? (k) : (n - 1)) * st)
#define GU_LOADE(S, t) do { S##lo = EXPp[(size_t)(t) * HK + lane]; S##hi = EXPp[(size_t)(t) * HK + 64 + lane]; } while (0)
#define GU_LOADX(S, t) do { S##a = *(const uint4*)(xs + (size_t)(t) * XQP); S##s = XSc[t]; } while (0)
#define GU_ISSUE(R, S) do { _Pragma("unroll") for (int i = 0; i < 16; ++i) { \
            const int e = __builtin_amdgcn_ds_bpermute((((8 * i) & 63) + g) << 2, (i < 8) ? S##lo : S##hi); R[i] = *(const uint4*)(Us + (((unsigned)e << 7) | co)); } } while (0)
#define GU_FINISH(R, S, t) do { \
            int p[16]; \
            _Pragma("unroll") for (int i = 0; i < 16; ++i) { int d_ = __builtin_amdgcn_sdot4((int)S##a.x, (int)R[i].x, 0, false); d_ = __builtin_amdgcn_sdot4((int)S##a.y, (int)R[i].y, d_, false); \
                d_ = __builtin_amdgcn_sdot4((int)S##a.z, (int)R[i].z, d_, false); p[i] = __builtin_amdgcn_sdot4((int)S##a.w, (int)R[i].w, d_, false); } \
            red16x3<1, 2, 4, int>(p, lane); \
            part[(size_t)(t) * HK + 8 * i0 + g] = (float)p[0] * S##s; part[(size_t)(t) * HK + 8 * (i0 + 1) + g] = (float)p[1] * S##s; } while (0)
        int eAlo, eAhi, eBlo, eBhi; uint4 xAa, xBa; float xAs, xBs; uint4 rA[16], rB[16];
        GU_LOADE(eA, GU_TK(0)); GU_LOADX(xA, GU_TK(0)); GU_LOADE(eB, GU_TK(1));
        GU_ISSUE(rA, eA);
        for (int k = 0; k < n; k += 2) {
            GU_LOADX(xB, GU_TK(k + 1)); GU_ISSUE(rB, eB); GU_LOADE(eA, GU_TK(k + 2));
            GU_FINISH(rA, xA, GU_TK(k));
            GU_LOADX(xA, GU_TK(k + 2)); GU_ISSUE(rA, eA); GU_LOADE(eB, GU_TK(k + 3));
            GU_FINISH(rB, xB, GU_TK(k + 1));
        }
#undef GU_TK
#undef GU_LOADE
#undef GU_LOADX
#undef GU_ISSUE
#undef GU_FINISH
    }
}
__device__ __forceinline__ void phase_gw(const Params& P, int l) {
    const int* EXPp = (const int*)(P.ws + WS_EXP);
    const float* GATEp = (const float*)(P.ws + WS_GATE);
    const float* PART = (const float*)(P.ws + WS_PART);
    const float* SU = (const float*)(P.ws + WS_TSCU) + (size_t)l * NEXP;
    const float* SV = (const float*)(P.ws + WS_TSCV) + (size_t)l * NEXP;
    unsigned char* WQ = P.ws + WS_WQ8;
    float* WSC = (float*)(P.ws + WS_WSC);
    const int lane = tidx() & 63, hw = lane >> 5, l5 = lane & 31;
    for (int tb = gwave() * 8; tb < T; tb += nwave() * 8) {
        float wv[4][4];
#pragma unroll
        for (int q = 0; q < 4; ++q) {
            const size_t i = (size_t)(tb + 2 * q + hw) * HK + 4 * l5;
            float4 s = *(const float4*)(PART + i);
#pragma unroll
            for (int x = 1; x < 8; ++x) { const float4 p = *(const float4*)(PART + (size_t)x * T * HK + i); s.x += p.x; s.y += p.y; s.z += p.z; s.w += p.w; }
            const int4 e = *(const int4*)(EXPp + i);
            const float4 gt = *(const float4*)(GATEp + i);
            wv[q][0] = gt.x * gelu_exact(s.x * SU[e.x]) * SV[e.x]; wv[q][1] = gt.y * gelu_exact(s.y * SU[e.y]) * SV[e.y];
            wv[q][2] = gt.z * gelu_exact(s.z * SU[e.z]) * SV[e.z]; wv[q][3] = gt.w * gelu_exact(s.w * SU[e.w]) * SV[e.w];
        }
#pragma unroll
        for (int q = 0; q < 4; ++q) {
            float am = fmaxf(fmaxf(fabsf(wv[q][0]), fabsf(wv[q][1])), fmaxf(fabsf(wv[q][2]), fabsf(wv[q][3])));
#pragma unroll
            for (int m = 16; m >= 1; m >>= 1) am = fmaxf(am, __shfl_xor(am, m, 64));
            const float sc = (am > 0.f) ? am * (1.f / 448.f) : 1.f, is = 1.f / sc;
            int pk = __builtin_amdgcn_cvt_pk_fp8_f32(wv[q][0] * is, wv[q][1] * is, 0, false);
            pk = __builtin_amdgcn_cvt_pk_fp8_f32(wv[q][2] * is, wv[q][3] * is, pk, true);
            const int t = tb + 2 * q + hw;
            *(int*)(WQ + (size_t)t * HK + 4 * l5) = pk;
            if (l5 == 0) WSC[t] = sc;
        }
    }
}
typedef int v2i_t __attribute__((ext_vector_type(2)));
typedef unsigned u32x4_t __attribute__((ext_vector_type(4)));
typedef __attribute__((ext_vector_type(4))) float f32x4;
constexpr int GV_PIECE = 1024 + 16;
constexpr int GV_TILE = 16 * GV_PIECE;
static_assert(NW * GV_TILE + NW * 512 <= LDS_TOTAL, "gv LDS");
__device__ __forceinline__ void phase_gv(const Params& P, int l, const volatile int* xi, char* lds) {
    const int* EXPp = (const int*)(P.ws + WS_EXP);
    const unsigned char* WQ = P.ws + WS_WQ8;
    const float* WSC = (const float*)(P.ws + WS_WSC);
    const int tid = tidx(), lane = tid & 63, w = __builtin_amdgcn_readfirstlane(tid >> 6), g = lane >> 3, pos = lane & 7;
    int xo_ = 0; asm volatile("" : "+v"(xo_));
    const int j = __builtin_amdgcn_readfirstlane(xi[xo_ + XI_J]), nx = __builtin_amdgcn_readfirstlane(xi[xo_ + XI_NX]), nloc = __builtin_amdgcn_readfirstlane(xi[xo_ + XI_NLOC]), rank = __builtin_amdgcn_readfirstlane(xi[xo_ + XI_RANK]);
    const int t0 = rank * NW + w, st = nloc * NW;
    const int n = (t0 < T) ? (T - t0 + st - 1) / st : 0;
    char* tile = lds + w * GV_TILE;
    float* strip = (float*)(lds + NW * GV_TILE) + w * 128;
    typedef __attribute__((address_space(3))) v2i_t* ldsv2_t;
    const unsigned co = (unsigned)(pos ^ g) << 4;
    const int rr = (lane & 15) >> 1, kq = lane >> 4;
    const int rdo = kq * GV_PIECE + rr * 128 + (lane & 1) * 8;
    const bool row0 = (lane & 15) == 0;
    __syncthreads();
    for (int sl = j; sl < 8 && n > 0; sl += nx) {
        const unsigned char* Vs = P.ws + WS_TABV + ((size_t)(l * 8 + sl) * NEXP) * 128;
        const char* hrow = (const char*)P.out + sl * 256 + 4 * lane;
#define GV_TK(k) (t0 + (((k) < n) ? (k) : (n - 1)) * st)
#define GV_LOADE(S, t) do { S##el = EXPp[(size_t)(t) * HK + lane]; S##eh = EXPp[(size_t)(t) * HK + 64 + lane]; } while (0)
#define GV_ISSUE(R, S) do { _Pragma("unroll") for (int i = 0; i < 16; ++i) { \
            const int e = __builtin_amdgcn_ds_bpermute((((8 * i) & 63) + g) << 2, (i < 8) ? S##el : S##eh); R[i] = *(const u32x4_t*)(Vs + (((unsigned)e << 7) | co)); } } while (0)
#define GV_LOADT(S, kk) do { const int t_ = GV_TK(kk); \
            S##a0 = 0; S##a1 = 0; S##a2 = 0; S##a3 = 0; \
            if (row0) { const long* wp = (const long*)(WQ + (size_t)t_ * HK + kq * 8); S##a0 = wp[0]; S##a1 = wp[4]; S##a2 = wp[8]; S##a3 = wp[12]; } \
            S##ws = ((kk) < n) ? WSC[t_] : 0.f; \
            S##hv = *(const unsigned*)(hrow + (size_t)t_ * (HP * 2)); } while (0)
#define GV_TOKEN(R, S, kk) do { \
            const int t = GV_TK(kk); \
            _Pragma("unroll") for (int i = 0; i < 16; ++i) *(u32x4_t*)(tile + i * GV_PIECE + lane * 16) = R[i]; \
            f32x4 acc[8]; \
            __builtin_amdgcn_s_setprio(1); \
            _Pragma("unroll") for (int s4 = 0; s4 < 4; ++s4) { \
                const long av = (s4 == 0) ? S##a0 : (s4 == 1) ? S##a1 : (s4 == 2) ? S##a2 : S##a3; \
                _Pragma("unroll") for (int nt = 0; nt < 8; ++nt) { \
                    const v2i_t bv = __builtin_amdgcn_ds_read_tr8_b64_v2i32((ldsv2_t)(void*)(tile + (4 * s4) * GV_PIECE + rdo + ((nt ^ rr) << 4))); \
                    acc[nt] = __builtin_amdgcn_mfma_f32_16x16x32_fp8_fp8(av, __builtin_bit_cast(long, bv), (s4 == 0) ? (f32x4){0.f, 0.f, 0.f, 0.f} : acc[nt], 0, 0, 0); } }     \
            if (lane < 16) { _Pragma("unroll") for (int nt = 0; nt < 8; ++nt) strip[16 * nt + lane] = acc[nt][0]; }        \
            { const float2 o2 = *(const float2*)(strip + 2 * lane); \
              if ((kk) < n) *(unsigned*)(hrow + (size_t)t * (HP * 2)) = pack2(bflo(S##hv) + S##ws * o2.x, bfhi(S##hv) + S##ws * o2.y); } \
            __builtin_amdgcn_s_setprio(0); } while (0)
        int Ael, Aeh, Bel, Beh; u32x4_t rA[16], rB[16];
        long Pa0, Pa1, Pa2, Pa3, Qa0, Qa1, Qa2, Qa3; float Pws, Qws; unsigned Phv, Qhv;
        GV_LOADE(A, GV_TK(0)); GV_LOADE(B, GV_TK(1));
        GV_ISSUE(rA, A); GV_LOADT(P, 0);
        for (int k = 0; k < n; k += 2) {
            GV_ISSUE(rB, B); GV_LOADE(A, GV_TK(k + 2)); GV_LOADT(Q, k + 1);
            GV_TOKEN(rA, P, k);
            GV_ISSUE(rA, A); GV_LOADE(B, GV_TK(k + 3)); GV_LOADT(P, k + 2);
            GV_TOKEN(rB, Q, k + 1);
        }
#undef GV_TK
#undef GV_LOADE
#undef GV_ISSUE
#undef GV_LOADT
#undef GV_TOKEN
    }
    __syncthreads();
}
__device__ __forceinline__ void phase_gnorm(const Params& P, int l) {
    const int lane = tidx() & 63, nw = nwave();
    unsigned* xq = (unsigned*)(P.ws + WS_XQ);
    float* xsc = (float*)(P.ws + WS_XS);
    const bf16* Hb = (const bf16*)P.out;
    const float4* g = (const float4*)((l == DEPTH - 1) ? P.norm_final : (P.norm_mix + (l + 1) * D));
    for (int t = gwave(); t < T; t += 2 * nw) {
        const int t2 = (t + nw < T) ? (t + nw) : t;
        float4 v[2][4];
#pragma unroll
        for (int q = 0; q < 4; ++q) {
            const uint2 a = ((const uint2*)(Hb + (size_t)t * HP))[q * 64 + lane], b = ((const uint2*)(Hb + (size_t)t2 * HP))[q * 64 + lane];
            v[0][q] = make_float4(bflo(a.x), bfhi(a.x), bflo(a.y), bfhi(a.y)); v[1][q] = make_float4(bflo(b.x), bfhi(b.x), bflo(b.y), bfhi(b.y));
        }
#pragma unroll
        for (int u = 0; u < 2; ++u) {
            float ss = 0.f;
#pragma unroll
            for (int q = 0; q < 4; ++q) ss += v[u][q].x * v[u][q].x + v[u][q].y * v[u][q].y + v[u][q].z * v[u][q].z + v[u][q].w * v[u][q].w;
            ss = wave_sum(ss);
            const float rn = rsqrtf(ss * (1.f / D) + EPS);
            const int tt = u ? t2 : t;
            if (u == 0 || t2 != t) {
                float4* hr = (float4*)(P.out + (size_t)tt * D);
                float am = 0.f;
#pragma unroll
                for (int q = 0; q < 4; ++q) {
                    const float4 gg = g[q * 64 + lane];
                    v[u][q] = make_float4(v[u][q].x * rn * gg.x, v[u][q].y * rn * gg.y, v[u][q].z * rn * gg.z, v[u][q].w * rn * gg.w);
                    am = fmaxf(am, fmaxf(fmaxf(fabsf(v[u][q].x), fabsf(v[u][q].y)), fmaxf(fabsf(v[u][q].z), fabsf(v[u][q].w))));
                    if (l == DEPTH - 1) hr[q * 64 + lane] = v[u][q];
                }
                if (l != DEPTH - 1) {
#pragma unroll
                    for (int m = 32; m >= 1; m >>= 1) am = fmaxf(am, __shfl_xor(am, m, 64));
                    const float sc = (am > 0.f) ? am * (1.f / 127.f) : 1.f, is = 1.f / sc;
#pragma unroll
                    for (int q = 0; q < 4; ++q) xq[(size_t)tt * (XQP / 4) + q * 64 + lane] = pack_i8x4(v[u][q].x * is, v[u][q].y * is, v[u][q].z * is, v[u][q].w * is);
                    if (lane == 0) xsc[tt] = sc;
                }
            }
        }
    }
}

#define XB_TMO      128
#define XB_XCNT(j)  (256  + 64 * (j))
#define XB_XSUB(j)  (1280 + 64 * (j))
#define XB_XGEN(j)  (2304 + 64 * (j))
#define XB_TOP      3328
#define XB_TOPGEN   3392
#define XCD_BAR_WORDS 3456
#define XB_SPIN_CAP (1u << 22)
#define LAS __attribute__((address_space(3)))
__device__ __forceinline__ unsigned xb_ld(unsigned* p)              { return __hip_atomic_load(p, __ATOMIC_RELAXED, __HIP_MEMORY_SCOPE_AGENT); }
__device__ __forceinline__ unsigned xb_add(unsigned* p, unsigned v) { return __hip_atomic_fetch_add(p, v, __ATOMIC_RELAXED, __HIP_MEMORY_SCOPE_AGENT); }
__device__ __forceinline__ unsigned xb_xcc_id() { return (unsigned)__builtin_amdgcn_s_getreg((3 << 11) | 20) & 0xFu; }
#define XB_SPIN(cond, bar) do { unsigned _sp = 0; while (cond) { __builtin_amdgcn_s_sleep(1); \
    if ((++_sp & 255u) == 0u) { if (xb_ld(&(bar)[XB_TMO])) break; if (_sp > XB_SPIN_CAP) { atomicAdd(&(bar)[XB_TMO], 1u); break; } } } } while (0)
struct XcdBarrier { unsigned* bar; unsigned x; volatile LAS unsigned* st; };
__device__ __forceinline__ XcdBarrier xcd_barrier_post(unsigned* bar, volatile LAS unsigned* st) {
    XcdBarrier b; b.bar = bar; b.x = xb_xcc_id(); b.st = st;
    if (__builtin_amdgcn_workitem_id_x() == 0) (void)xb_add(&bar[XB_XCNT(b.x)], 1u);
    return b;
}
__device__ __forceinline__ void xcd_barrier_complete(unsigned* bar, unsigned x, unsigned& nloc, unsigned& nx) {
    const unsigned G = gridDim.x * gridDim.y * gridDim.z;
    unsigned sum, cnt, mine, sp = 0u;
    for (;;) {
        sum = 0u; cnt = 0u; mine = 0u;
#pragma unroll
        for (unsigned j = 0; j < 16; ++j) { const unsigned c = xb_ld(&bar[XB_XCNT(j)]); sum += c; cnt += (c > 0u) ? 1u : 0u; mine = (j == x) ? c : mine; }
        if (sum == G) break;
        __builtin_amdgcn_s_sleep(1);
        if ((++sp & 255u) == 0u) { if (xb_ld(&bar[XB_TMO])) break; if (sp > XB_SPIN_CAP) { atomicAdd(&bar[XB_TMO], 1u); break; } }
    }
    nloc = mine > 0u ? mine : 1u; nx = cnt > 0u ? cnt : 1u;
}
__device__ __forceinline__ void xcd_barrier(const XcdBarrier& b) {
    asm volatile("s_waitcnt vmcnt(0)" ::: "memory");
    __syncthreads();
    if (__builtin_amdgcn_workitem_id_x() == 0) {
        unsigned* bar = b.bar;
        __builtin_amdgcn_s_waitcnt(0);
        unsigned nloc = b.st[0], nx = b.st[1];
        if (nloc == 0u) { xcd_barrier_complete(bar, b.x, nloc, nx); b.st[0] = nloc; b.st[1] = nx; }
        const unsigned old = xb_add(&bar[XB_XSUB(b.x)], 1u);
        const unsigned gen = old / nloc;
        if (old + 1u == (gen + 1u) * nloc) {
            __builtin_amdgcn_fence(__ATOMIC_RELEASE, "agent");
            asm volatile("s_waitcnt vmcnt(0)" ::: "memory");
            const unsigned og = xb_add(&bar[XB_TOP], 1u);
            const unsigned tg = og / nx;
            if (og + 1u == (tg + 1u) * nx) xb_add(&bar[XB_TOPGEN], 1u);
            else XB_SPIN(xb_ld(&bar[XB_TOPGEN]) == tg, bar);
            __builtin_amdgcn_fence(__ATOMIC_ACQUIRE, "agent");
            xb_add(&bar[XB_XGEN(b.x)], 1u);
            asm volatile("s_waitcnt vmcnt(0)" ::: "memory");
        } else {
            XB_SPIN(xb_ld(&bar[XB_XGEN(b.x)]) == gen, bar);
            __builtin_amdgcn_fence(__ATOMIC_ACQUIRE, "agent");
            asm volatile("s_waitcnt vmcnt(0)" ::: "memory");
        }
    }
    __syncthreads();
}

constexpr float QSCALE = 0.10206207261596575f * 1.4426950408889634f;

__device__ __forceinline__ void phase_gemm1(const Params& P, int l, char* lds) {
    unsigned char* ws = P.ws;
    const bf16* XN = (const bf16*)(ws + WS_XN);
    bf16* PROJ = (bf16*)(ws + WS_PROJ);
    bf16* Kb = (bf16*)(ws + WS_K);
    const float* rope = (const float*)(ws + WS_ROPE);
    const bf16* W = (const bf16*)(ws + WS_WIN) + (size_t)l * DINP * LDW;
    float* SSQ = (float*)(ws + WS_SSQ);
    const int lane = tidx() & 63;
    const bf16* W8 = (const bf16*)(ws + WS_WI8 + (size_t)l * DINP * XQP);
    const bf16* XQb = (const bf16*)(ws + WS_XQ);
    const float* XSc = (const float*)(ws + WS_XS);
    const float* WIS = (const float*)(ws + WS_WIS) + (size_t)l * DINP;
    int tlo, thi, tst; tile_rounds((T / 256) * (DINP / 256), tlo, thi, tst);
    gemm_t8<true, false, true>(W8, XQP / 2, DINP, XQb, XQP / 2, D / 2, tlo, thi, tst, [&](int t, int n, const float4& v, const float4&) {
        const int nb = __builtin_amdgcn_readfirstlane(n);
        if (nb < C_KR) {
            uint2 o; o.x = cvtpk(v.x, v.y); o.y = cvtpk(v.z, v.w);
            *(uint2*)(PROJ + (size_t)t * DINP + n) = o;
            if (nb >= C_CQ) {
                float q = v.x * v.x + v.y * v.y + v.z * v.z + v.w * v.w;
                q += __int_as_float(__builtin_amdgcn_update_dpp(0, __float_as_int(q), 0xB1, 0xF, 0xF, true)); q += __int_as_float(__builtin_amdgcn_update_dpp(0, __float_as_int(q), 0x4E, 0xF, 0xF, true));
                q += __int_as_float(__builtin_amdgcn_update_dpp(0, __float_as_int(q), 0x124, 0xF, 0xF, true)); q += __int_as_float(__builtin_amdgcn_update_dpp(0, __float_as_int(q), 0x128, 0xF, 0xF, true));
                if (n == nb) SSQ[(size_t)t * 16 + ((nb - C_CQ) >> 6)] = q;
            }
        } else if (nb == C_KR) {
            const float4 up = make_float4(dpp_up4(v.x), dpp_up4(v.y), dpp_up4(v.z), dpp_up4(v.w));
            const float4 dn = make_float4(dpp_dn4(v.x), dpp_dn4(v.y), dpp_dn4(v.z), dpp_dn4(v.w));
            const int d = n - C_KR;
            if (d < 32) {
                const int b = t / S, s = t % S;
                const bool first = d < 16;
                const int f = first ? d : (d - 16);
                const float4 cs0 = *(const float4*)(rope + ((size_t)s * 16 + f) * 2), cs1 = *(const float4*)(rope + ((size_t)s * 16 + f) * 2 + 4);
                float4 o;
                if (first) o = make_float4(v.x * cs0.x - up.x * cs0.y, v.y * cs0.z - up.y * cs0.w, v.z * cs1.x - up.z * cs1.y, v.w * cs1.z - up.w * cs1.w);
                else       o = make_float4(v.x * cs0.x + dn.x * cs0.y, v.y * cs0.z + dn.y * cs0.w, v.z * cs1.x + dn.z * cs1.y, v.w * cs1.z + dn.w * cs1.w);
                uint2 u; u.x = cvtpk(o.x, o.y); u.y = cvtpk(o.z, o.w);
#pragma unroll
                for (int h = 0; h < NH; ++h) *(uint2*)(Kb + ((size_t)(b * NH + h) * S + s) * DQK + 64 + d) = u;
            }
        }
    }, [&](int t) { return XSc[t]; }, [](int, int) { return make_float4(0.f, 0.f, 0.f, 0.f); }, [&](int n) { return *(const float4*)(WIS + n); }, lds);
}
__device__ __forceinline__ void phase_gemm2(const Params& P, int l, char* lds) {
    unsigned char* ws = P.ws;
    const bf16* PROJ = (const bf16*)(ws + WS_PROJ);
    const float* rope = (const float*)(ws + WS_ROPE);
    const float* SSQ = (const float*)(ws + WS_SSQ);
    const int G = gridDim.x, bid = blockIdx.x;
    const int vb = ((G & 7) == 0) ? ((bid & 7) * (G >> 3) + (bid >> 3)) : bid;
    int qlo, qhi, klo, khi;
    if ((G & 1) == 0) {
        const int Gh = G >> 1, pq = (384 + Gh - 1) / Gh, pk = (512 + Gh - 1) / Gh;
        if (vb < Gh) { qlo = vb * pq; qhi = qlo + pq; if (qhi > 384) qhi = 384; if (qlo > 384) qlo = 384; klo = 0; khi = 0; }
        else { klo = (vb - Gh) * pk; khi = klo + pk; if (khi > 512) khi = 512; if (klo > 512) klo = 512; qlo = 0; qhi = 0; }
    } else { tile_range(384, qlo, qhi); tile_range(512, klo, khi); }
    {
        const bf16* W = (const bf16*)(ws + WS_WUQ) + (size_t)l * 768 * QR;
        bf16* Qb = (bf16*)(ws + WS_Q);
        gemm_t8<true, false, false>(W, QR, 768, PROJ + C_CQ, DINP, QR, qlo, qhi, 1,
            [&](int t, int n, const float4& v, const float4&) {
                const int b = t / S, s = t % S, h = n / DQK, d = n % DQK;
                float4 o = v;
                const int lane = tidx() & 63;
                const float4 up = make_float4(dpp_up4(v.x), dpp_up4(v.y), dpp_up4(v.z), dpp_up4(v.w));
                const float4 dn = make_float4(dpp_dn4(v.x), dpp_dn4(v.y), dpp_dn4(v.z), dpp_dn4(v.w));
                if (d >= 64) {
                    const bool first = d < 80;
                    const int f = first ? (d - 64) : (d - 80);
                    const float4 cs0 = *(const float4*)(rope + ((size_t)s * 16 + f) * 2), cs1 = *(const float4*)(rope + ((size_t)s * 16 + f) * 2 + 4);
                    if (first) o = make_float4(v.x * cs0.x - up.x * cs0.y, v.y * cs0.z - up.y * cs0.w, v.z * cs1.x - up.z * cs1.y, v.w * cs1.z - up.w * cs1.w);
                    else       o = make_float4(v.x * cs0.x + dn.x * cs0.y, v.y * cs0.z + dn.y * cs0.w, v.z * cs1.x + dn.z * cs1.y, v.w * cs1.z + dn.w * cs1.w);
                }
                uint2 u; u.x = cvtpk(o.x, o.y); u.y = cvtpk(o.z, o.w);
                *(uint2*)(Qb + ((size_t)(b * NH + h) * S + s) * DQK + d) = u;
            }, [&](int t) { const float4 a = *(const float4*)(SSQ + (size_t)t * 16); const float2 b = *(const float2*)(SSQ + (size_t)t * 16 + 4);
                            return rsqrtf(((a.x + a.y) + (a.z + a.w) + (b.x + b.y)) * (1.f / QR) + EPS) * QSCALE; }, [](int, int) { return make_float4(0.f, 0.f, 0.f, 0.f); }, [](int) { return make_float4(1.f, 1.f, 1.f, 1.f); }, lds);
    }
    {
        const bf16* W = (const bf16*)(ws + WS_WUKV) + (size_t)l * 1024 * KVR;
        bf16* Kb = (bf16*)(ws + WS_K); bf16* Vb = (bf16*)(ws + WS_V);
        gemm_t8<true, false, false>(W, KVR, 1024, PROJ + C_CKV, DINP, KVR, klo, khi, 1,
            [&](int t, int n, const float4& v, const float4&) {
                const int b = t / S, s = t % S;
                uint2 u; u.x = cvtpk(v.x, v.y); u.y = cvtpk(v.z, v.w);
                if (n < 512) *(uint2*)(Kb + ((size_t)(b * NH + (n >> 6)) * S + s) * DQK + (n & 63)) = u;
                else         *(uint2*)(Vb + ((size_t)(b * NH + ((n - 512) >> 6)) * S + s) * DV + (n & 63)) = u;
            }, [&](int t) { const float2 a = *(const float2*)(SSQ + (size_t)t * 16 + 6); const float2 b = *(const float2*)(SSQ + (size_t)t * 16 + 8);
                            return rsqrtf(((a.x + a.y) + (b.x + b.y)) * (1.f / KVR) + EPS); }, [](int, int) { return make_float4(0.f, 0.f, 0.f, 0.f); }, [](int) { return make_float4(1.f, 1.f, 1.f, 1.f); }, lds);
    }
}
constexpr size_t WS_YO = WS_PROJ;
__device__ __forceinline__ void phase_gemm3(const Params& P, int l, char* lds) {
    unsigned char* ws = P.ws;
    const bf16* Yb = (const bf16*)(ws + WS_XN);
    const bf16* W = (const bf16*)(ws + WS_WOUT) + (size_t)l * D * LDW;
    bf16* YO = (bf16*)(ws + WS_YO);
    int tlo, thi, tst; tile_rounds((T / 256) * (D / 256), tlo, thi, tst);
    gemm_t8<false, false, false>(W, LDW, D, Yb, LDX, D, tlo, thi, tst, [&](int t, int n, const float4& v, const float4&) {
        uint2 o; o.x = cvtpk(v.x, v.y); o.y = cvtpk(v.z, v.w);
        *(uint2*)(YO + (size_t)t * D + n) = o;
    }, [](int) { return 1.f; }, [](int, int) { return make_float4(0.f, 0.f, 0.f, 0.f); }, [](int) { return make_float4(1.f, 1.f, 1.f, 1.f); }, lds);
}

#define GSYNC() do { XcdBarrier xb_; { __attribute__((address_space(1))) char* gp_ = (__attribute__((address_space(1))) char*)(char*)(P.ws + WS_CTL); asm volatile("" : "+s"(gp_)); xb_.bar = (unsigned*)(char*)gp_; } \
    xb_.x = xb_xcc_id(); xb_.st = (volatile LAS unsigned*)&xb_words; xcd_barrier(xb_); } while (0)
#define PHASE(stmt) { const Params Q = launder(P); stmt; }
__global__ void __launch_bounds__(NTHREADS, 2) k_all(Params P) {
    __shared__ __attribute__((aligned(16))) char sm[LDS_TOTAL];
    __shared__ uint4 xb_words;
    cg::grid_group grid = cg::this_grid();
    if (__builtin_amdgcn_workitem_id_x() == 0) xb_words = make_uint4(0u, 0u, 0u, 0u);
    __syncthreads();
    (void)xcd_barrier_post((unsigned*)(P.ws + WS_CTL), (volatile LAS unsigned*)&xb_words);
    __shared__ int xinfo[8];
    if (__builtin_amdgcn_workitem_id_x() == 0) {
        const unsigned x = xb_xcc_id();
        xinfo[XI_X] = (int)x; xinfo[XI_RANK] = (int)xb_add((unsigned*)(P.ws + WS_CTL) + CTL_CENSUS + x, 1u);
    }
    PHASE(phase_prep(Q, sm));
    if (P.ws == nullptr) grid.sync();
    GSYNC();
    PHASE(phase_norm(Q.x, Q.norm_mix, (unsigned*)(Q.ws + WS_XQ), (float*)(Q.ws + WS_XS)));
    PHASE(quant_wrows((const bf16*)(Q.ws + WS_WPQ), DEPTH * 2048, Q.ws + WS_WC8, (float*)(Q.ws + WS_WCS)));
    PHASE(quant_wrows((const bf16*)(Q.ws + WS_WIN), DEPTH * DINP, Q.ws + WS_WI8, (float*)(Q.ws + WS_WIS)));
    GSYNC();
    if (__builtin_amdgcn_workitem_id_x() == 0) {
        unsigned* cen = (unsigned*)(P.ws + WS_CTL) + CTL_CENSUS;
        const int x = xinfo[XI_X]; int nx = 0, jj = 0;
        for (int q = 0; q < 16; ++q) { const unsigned cq = xb_ld(cen + q); if (cq) { if (q < x) ++jj; ++nx; } }
        xinfo[XI_J] = jj; xinfo[XI_NX] = nx; xinfo[XI_NLOC] = (int)xb_ld(cen + x);
    }
    __syncthreads();
    for (int l = 0; l < DEPTH; ++l) {
        PHASE(phase_gemm1(Q, l, sm));
#if PROBE_DUP & 2
        PHASE(phase_gemm1(Q, l, sm));
#endif
        GSYNC();
        PHASE(phase_mixlocal(Q, l, sm));
#if PROBE_DUP & 256
        PHASE(phase_mixlocal(Q, l, sm));
#endif
        PHASE(phase_gemm2(Q, l, sm));
#if PROBE_DUP & 4
        PHASE(phase_gemm2(Q, l, sm));
#endif
        GSYNC();
        PHASE(phase_attn(Q, sm));
#if PROBE_DUP & 8
        PHASE(phase_attn(Q, sm));
#endif
        GSYNC();
        PHASE(phase_gemm3(Q, l, sm));
#if PROBE_DUP & 16
        if (l == 0) PHASE(phase_gemm3(Q, l, sm));
#endif
        GSYNC();
        PHASE(phase_norm_q(Q, l));
#if PROBE_DUP & 512
        PHASE(phase_norm_q(Q, l));
#endif
        GSYNC();
        PHASE(phase_route(Q, l, sm));
#if PROBE_DUP & 32
        PHASE(phase_route(Q, l, sm));
#endif
        GSYNC();
        PHASE(phase_gu(Q, l, xinfo));
#if PROBE_DUP & 64
        PHASE(phase_gu(Q, l, xinfo));
#endif
        GSYNC();
        PHASE(phase_gw(Q, l));
#if PROBE_DUP & 128
        PHASE(phase_gw(Q, l));
#endif
        GSYNC();
        PHASE(phase_gv(Q, l, xinfo, sm));
        GSYNC();
        PHASE(phase_gnorm(Q, l));
        if (l + 1 < DEPTH) GSYNC();
    }
}

extern "C" void kernel_launch(void* const* d_in, const int* in_sizes, int n_in, void* d_out, int out_size, void* d_ws, size_t ws_size, hipStream_t stream) {
    static int grid = 0;
    if (grid == 0) {
        if (n_in != 18 || out_size != T * D || ws_size < WS_END) { fprintf(stderr, "kernel_launch: bad sizes n_in %d out %d ws %zu need %zu\n", n_in, out_size, ws_size, (size_t)WS_END); grid = -1; return; }
        int dev = 0, cus = 0, per_cu = 0;
        (void)hipGetDevice(&dev);
        (void)hipDeviceGetAttribute(&cus, hipDeviceAttributeMultiprocessorCount, dev);
        (void)hipOccupancyMaxActiveBlocksPerMultiprocessor(&per_cu, (const void*)k_all, NTHREADS, 0);
        if (per_cu > 1) per_cu = 1;
        if (per_cu < 1) { fprintf(stderr, "kernel_launch: occupancy query says %d\n", per_cu); grid = -1; return; }
        grid = cus * per_cu;
    }
    if (grid < 0) return;
    Params p{};
    p.x = (const float*)d_in[0]; p.norm_mix = (const float*)d_in[1]; p.w_in = (const float*)d_in[2]; p.conv_w = (const float*)d_in[3];
    p.pool_w = (const float*)d_in[4]; p.pool_scale = (const float*)d_in[5]; p.q_norm = (const float*)d_in[6]; p.w_uq = (const float*)d_in[7];
    p.kv_norm = (const float*)d_in[8]; p.w_uk = (const float*)d_in[9]; p.w_uv = (const float*)d_in[10]; p.w_out = (const float*)d_in[11];
    p.norm_ffn = (const float*)d_in[12]; p.peer_wq = (const float*)d_in[13]; p.peer_subkeys = (const float*)d_in[14]; p.peer_u = (const float*)d_in[15];
    p.peer_v = (const float*)d_in[16]; p.norm_final = (const float*)d_in[17];
    p.out = (float*)d_out; p.ws = (unsigned char*)d_ws;
    if (hipMemsetAsync((char*)d_ws + WS_CTL, 0, CTL_BYTES, stream) != hipSuccess) { fprintf(stderr, "kernel_launch: memset failed\n"); return; }
    void* args[] = {&p};
    hipError_t e = hipLaunchCooperativeKernel((const void*)k_all, dim3(grid), dim3(NTHREADS), args, 0, stream);
    if (e != hipSuccess) fprintf(stderr, "cooperative launch failed: %s (grid %d)\n", hipGetErrorString(e), grid);
}
```
